# Optimizing an MI355X kernel written in HIP

```python
import math
import jax, jax.numpy as jnp
from jax import lax
import numpy as np


D_MODEL = 1024
BATCH = 2
SEQ = 8192
DEPTH = 2

CHUNK = 64
N_META = 16
Q_BLOCK = 128

SB_HEADS = 8
SB_HEAD_DIM = 64
SB_WIDTH = SB_HEADS * SB_HEAD_DIM

RWKV_HEADS = 8
RWKV_HEAD_DIM = 64
RWKV_WIDTH = RWKV_HEADS * RWKV_HEAD_DIM
W_LORA = 64
A_LORA = 64
G_LORA = 128
RWKV_SHIFT_WIDTH = 3 * RWKV_WIDTH + W_LORA + A_LORA + G_LORA
DECAY_SCALE = math.exp(-0.5)
LNX_EPS = 64e-5

C_IN = 3 * SB_WIDTH + RWKV_SHIFT_WIDTH + 2 * D_MODEL
SPLITS = [int(s) for s in np.cumsum([SB_WIDTH, SB_WIDTH, SB_WIDTH, RWKV_SHIFT_WIDTH, D_MODEL])]
RWKV_SPLITS = [int(s) for s in np.cumsum([RWKV_WIDTH, RWKV_WIDTH, RWKV_WIDTH, W_LORA, A_LORA])]

N_EXPERTS = 16
N_GROUPS = 4
EXPERTS_PER_GROUP = N_EXPERTS // N_GROUPS
TOP_K = 2
D_EXPERT = 512

ALPHA = (2 * DEPTH) ** 0.25
BETA_INIT = (8 * DEPTH) ** -0.25
LN_EPS = 1e-5

kernel_name = "hybrid_stickbreak_rwkv7_moe_encoder"


def layer_norm(x, g, b):
    xf = x.astype(jnp.float32)
    mu = jnp.mean(xf, axis=-1, keepdims=True)
    var = jnp.mean(jnp.square(xf - mu), axis=-1, keepdims=True)
    return ((xf - mu) * lax.rsqrt(var + LN_EPS) * g + b).astype(x.dtype)


def token_shift(p):
    return jnp.pad(p[:, :-1], ((0, 0), (1, 0), (0, 0)))


def stick_breaking_attention(q, k, v):
    B, H, L, N = q.shape
    nblk = -(-L // Q_BLOCK)
    Lp = nblk * Q_BLOCK
    pad = ((0, 0), (0, 0), (0, Lp - L), (0, 0))
    q, k, v = jnp.pad(q, pad), jnp.pad(k, pad), jnp.pad(v, pad)
    scale = N ** -0.5
    key_pos = jnp.arange(Lp)

    def block(i):
        q_blk = lax.dynamic_slice_in_dim(q, i * Q_BLOCK, Q_BLOCK, axis=2)
        z = jnp.einsum('bhqn,bhkn->bhqk', q_blk, k) * scale
        q_pos = i * Q_BLOCK + jnp.arange(Q_BLOCK)
        mask = key_pos[None, :] < q_pos[:, None]
        u = jnp.where(mask, jax.nn.log_sigmoid(-z), 0.0)
        rest = lax.cumsum(u, axis=3, reverse=True) - u
        A = jnp.where(mask, jnp.exp(jax.nn.log_sigmoid(z) + rest), 0.0)
        return jnp.einsum('bhqk,bhkn->bhqn', A, v)

    out = lax.map(block, jnp.arange(nblk))
    out = jnp.moveaxis(out, 0, 2).reshape(B, H, Lp, N)
    return out[:, :, :L]


def rwkv7_scan(r, w, k, v, kk, a):
    B, L, H, N = r.shape

    def step(S, inp):
        r_t, w_t, k_t, v_t, kk_t, a_t = inp
        sa = jnp.einsum('bhvk,bhk->bhv', S, -kk_t)
        S = (S * w_t[:, :, None, :]
             + sa[..., None] * (kk_t * a_t)[:, :, None, :]
             + v_t[..., None] * k_t[:, :, None, :])
        y = jnp.einsum('bhvk,bhk->bhv', S, r_t)
        return S, y

    xs = tuple(jnp.moveaxis(t, 1, 0) for t in (r, w, k, v, kk, a))
    S0 = jnp.zeros((B, H, N, N), jnp.float32)
    _, ys = lax.scan(step, S0, xs)
    return jnp.moveaxis(ys, 0, 1)


def rwkv7_time_mix(p_rw, mu, w0, w_up, a0, a_up, g_up, k_k, k_a, r_k, lnx_g, lnx_b):
    B, L, _ = p_rw.shape
    x = p_rw + (token_shift(p_rw) - p_rw) * mu
    r, k, v, wd, ad, gd = jnp.split(x, RWKV_SPLITS, axis=-1)
    w = jnp.exp(-DECAY_SCALE * jax.nn.sigmoid(w0 + jnp.tanh(wd) @ w_up))
    a = jax.nn.sigmoid(a0 + ad @ a_up)
    g = jax.nn.sigmoid(gd) @ g_up

    def heads(t):
        return t.reshape(B, L, RWKV_HEADS, RWKV_HEAD_DIM)

    kk = heads(k * k_k)
    kk = kk / jnp.maximum(jnp.sqrt(jnp.sum(kk * kk, axis=-1, keepdims=True)), 1e-12)
    k = k * (1.0 + (a - 1.0) * k_a)
    r, k, v, w, a = heads(r), heads(k), heads(v), heads(w), heads(a)
    y = rwkv7_scan(r, w, k, v, kk, a)
    mean = jnp.mean(y, axis=-1, keepdims=True)
    var = jnp.mean(jnp.square(y - mean), axis=-1, keepdims=True)
    yn = ((y - mean) * lax.rsqrt(var + LNX_EPS)).reshape(B, L, RWKV_WIDTH) * lnx_g + lnx_b
    bonus = (jnp.sum(r * k * r_k, axis=-1, keepdims=True) * v).reshape(B, L, RWKV_WIDTH)
    return (yn + bonus) * g


def hybrid_mixer(h, w_in, mu, w0, w_up, a0, a_up, g_up, k_k, k_a, r_k,
                 lnx_g, lnx_b, p_sb, p_rwkv, w_out):
    B, L, _ = h.shape
    p = jnp.einsum('bld,dc->blc', h, w_in).astype(jnp.float32)
    q_sb, k_sb, v_sb, p_rw, gate_sb, gate_rw = jnp.split(p, SPLITS, axis=-1)

    def heads(t):
        return t.reshape(B, L, SB_HEADS, SB_HEAD_DIM).transpose(0, 2, 1, 3)

    o_sb = stick_breaking_attention(heads(q_sb), heads(k_sb), heads(v_sb))
    o_sb = o_sb.transpose(0, 2, 1, 3).reshape(B, L, SB_WIDTH)
    o_rw = rwkv7_time_mix(p_rw, mu, w0, w_up, a0, a_up, g_up, k_k, k_a, r_k, lnx_g, lnx_b)
    merged = (jax.nn.sigmoid(gate_sb) * (o_sb @ p_sb)
              + jax.nn.sigmoid(gate_rw) * (o_rw @ p_rwkv))
    return (merged @ w_out).astype(h.dtype)


def moe_ffn(h, router_w, router_b, wg, wu, wd):
    B, L, D = h.shape
    t = h.reshape(B * L, D)
    logits = (t @ router_w).astype(jnp.float32) + router_b.astype(jnp.float32)
    probs = jax.nn.softmax(logits, axis=-1)
    grouped = probs.reshape(-1, N_GROUPS, EXPERTS_PER_GROUP)
    group_score = jnp.sum(lax.top_k(grouped, TOP_K)[0], axis=-1)
    g_sel = jnp.argmax(group_score, axis=-1)
    in_group = (jnp.arange(N_EXPERTS) // EXPERTS_PER_GROUP)[None, :] == g_sel[:, None]
    top_val, top_idx = lax.top_k(jnp.where(in_group, probs, -1.0), TOP_K)
    gate = top_val / jnp.sum(top_val, axis=-1, keepdims=True)
    combine = jnp.sum(jax.nn.one_hot(top_idx, N_EXPERTS, dtype=jnp.float32) * gate[..., None], axis=1)
    out = jnp.zeros((B * L, D), jnp.float32)
    for e in range(N_EXPERTS):
        hid = jax.nn.silu(t @ wg[e]) * (t @ wu[e])
        out = out + combine[:, e:e + 1] * (hid @ wd[e])
    return out.astype(h.dtype).reshape(B, L, D)


def setup_inputs(seed: int = 0) -> dict:
    key = jax.random.key(seed)
    ks = jax.random.split(key, 32)
    f32 = jnp.float32

    def nrm(k, shape, scale):
        return jax.random.normal(k, shape, f32) * scale

    return {
        "x": nrm(ks[0], (BATCH, SEQ, D_MODEL), 1.0),
        "meta": nrm(ks[1], (N_META, D_MODEL), 1.0),
        "emb_ln_g": 1.0 + nrm(ks[2], (D_MODEL,), 0.02),
        "emb_ln_b": nrm(ks[3], (D_MODEL,), 0.02),
        "w_in": nrm(ks[4], (DEPTH, D_MODEL, C_IN), D_MODEL ** -0.5),
        "rwkv_mu": jax.random.uniform(ks[5], (DEPTH, RWKV_SHIFT_WIDTH), f32),
        "w0": nrm(ks[6], (DEPTH, RWKV_WIDTH), 0.5),
        "w_up": nrm(ks[7], (DEPTH, W_LORA, RWKV_WIDTH), W_LORA ** -0.5),
        "a0": nrm(ks[8], (DEPTH, RWKV_WIDTH), 0.5),
        "a_up": nrm(ks[9], (DEPTH, A_LORA, RWKV_WIDTH), A_LORA ** -0.5),
        "g_up": nrm(ks[10], (DEPTH, G_LORA, RWKV_WIDTH), G_LORA ** -0.5),
        "k_k": 0.85 + nrm(ks[11], (DEPTH, RWKV_WIDTH), 0.05),
        "k_a": 1.0 + nrm(ks[12], (DEPTH, RWKV_WIDTH), 0.05),
        "r_k": nrm(ks[13], (DEPTH, RWKV_HEADS, RWKV_HEAD_DIM), 0.1),
        "lnx_g": 1.0 + nrm(ks[14], (DEPTH, RWKV_WIDTH), 0.02),
        "lnx_b": nrm(ks[15], (DEPTH, RWKV_WIDTH), 0.02),
        "p_sb": nrm(ks[16], (DEPTH, SB_WIDTH, D_MODEL), SB_WIDTH ** -0.5),
        "p_rwkv": nrm(ks[17], (DEPTH, RWKV_WIDTH, D_MODEL), RWKV_WIDTH ** -0.5),
        "w_out": nrm(ks[18], (DEPTH, D_MODEL, D_MODEL), D_MODEL ** -0.5 * BETA_INIT),
        "ln1_g": 1.0 + nrm(ks[19], (DEPTH, D_MODEL), 0.02),
        "ln1_b": nrm(ks[20], (DEPTH, D_MODEL), 0.02),
        "router_w": nrm(ks[21], (D_MODEL, N_EXPERTS), D_MODEL ** -0.5),
        "router_b": nrm(ks[22], (N_EXPERTS,), 0.01),
        "exp_w_gate": nrm(ks[23], (DEPTH, N_EXPERTS, D_MODEL, D_EXPERT), D_MODEL ** -0.5),
        "exp_w_up": nrm(ks[24], (DEPTH, N_EXPERTS, D_MODEL, D_EXPERT), D_MODEL ** -0.5),
        "exp_w_down": nrm(ks[25], (DEPTH, N_EXPERTS, D_EXPERT, D_MODEL), D_EXPERT ** -0.5 * BETA_INIT),
        "ln2_g": 1.0 + nrm(ks[26], (DEPTH, D_MODEL), 0.02),
        "ln2_b": nrm(ks[27], (DEPTH, D_MODEL), 0.02),
    }


def reference(x, meta, emb_ln_g, emb_ln_b, w_in, rwkv_mu, w0, w_up, a0, a_up, g_up,
              k_k, k_a, r_k, lnx_g, lnx_b, p_sb, p_rwkv, w_out, ln1_g, ln1_b,
              router_w, router_b, exp_w_gate, exp_w_up, exp_w_down, ln2_g, ln2_b):
    B = x.shape[0]
    meta_b = jnp.broadcast_to(meta.astype(x.dtype)[None], (B, N_META, D_MODEL))
    h = layer_norm(jnp.concatenate([meta_b, x], axis=1), emb_ln_g, emb_ln_b)
    for l in range(DEPTH):
        mix = hybrid_mixer(h, w_in[l], rwkv_mu[l], w0[l], w_up[l], a0[l], a_up[l], g_up[l],
                           k_k[l], k_a[l], r_k[l], lnx_g[l], lnx_b[l], p_sb[l], p_rwkv[l], w_out[l])
        h = layer_norm(ALPHA * h + mix, ln1_g[l], ln1_b[l])
        ff = moe_ffn(h, router_w, router_b, exp_w_gate[l], exp_w_up[l], exp_w_down[l])
        h = layer_norm(ALPHA * h + ff, ln2_g[l], ln2_b[l])
    return h[:, N_META:]
```

```cpp
#include <hip/hip_runtime.h>
#include <stdint.h>
#include <string.h>

#define DI __device__ __forceinline__
typedef unsigned short bf16_t;
typedef short bf16x8 __attribute__((ext_vector_type(8)));
typedef float f32x4 __attribute__((ext_vector_type(4)));
typedef unsigned u32x4 __attribute__((ext_vector_type(4)));
typedef unsigned u32x2 __attribute__((ext_vector_type(2)));

constexpr int D = 1024, NBATCH = 2, SEQ = 8192, NMETA = 16, L = SEQ + NMETA, T = NBATCH * L, TP = 16640;
constexpr int DEPTH = 2, HEADS = 8, HD = 64;
constexpr int CIN = 5376, CP = 3328;
constexpr int OFF_Q = 0, OFF_K = 512, OFF_V = 1024, OFF_RW = 1536;
constexpr int RW_R = 0, RW_K = 512, RW_V = 1024, RW_WD = 1536, RW_AD = 1600, RW_GD = 1664, RSW = 1792;
constexpr int NE = 16, DE = 512;
constexpr float ALPHA = 1.41421356237309515f;
constexpr float DECAY_SCALE = 0.60653065971263342f;
constexpr int NTHR = 512;

struct Params {
    const float *x, *meta, *emb_g, *emb_b, *w_in, *mu, *w0, *w_up, *a0, *a_up, *g_up, *k_k, *k_a, *r_k, *lnx_g, *lnx_b, *p_sb, *p_rwkv, *w_out,
        *ln1_g, *ln1_b, *router_w, *router_b, *ew_gate, *ew_up, *ew_down, *ln2_g, *ln2_b;
    float* out;
    unsigned* bar;
    int* counts;
    bf16_t *WtIn, *WtPsb, *WtPrw, *WtOut, *WtGU, *WtD, *hb, *P, *osb, *orw, *wdec, *aval, *gval;
    float* hmeta;
    bf16_t *gates, *merged, *hid, *fo;
    int* list;
    float* tokg;
};

DI float bf2f(bf16_t v) { return __uint_as_float((unsigned)v << 16); }
DI bf16_t f2bf(float f) { unsigned u = __float_as_uint(f); u += 0x7FFFu + ((u >> 16) & 1u); return (bf16_t)(u >> 16); }
DI unsigned pack2(float lo, float hi) { return (unsigned)f2bf(lo) | ((unsigned)f2bf(hi) << 16); }
DI float lo_bf(unsigned u) { return __uint_as_float(u << 16); }
DI float hi_bf(unsigned u) { return __uint_as_float(u & 0xFFFF0000u); }
DI float wave_sum(float v) {
#pragma unroll
    for (int m = 32; m >= 1; m >>= 1) v += __shfl_xor(v, m);
    return v;
}
DI float sigmoidf_(float x) { return 1.0f / (1.0f + __expf(-x)); }
DI void wave_sync() { asm volatile("s_waitcnt lgkmcnt(0)" ::: "memory"); __builtin_amdgcn_wave_barrier(); }

DI float* hrow2(float* hmeta, float* out, int tok) {
    const int b = tok >= L ? 1 : 0, t = tok - b * L;
    return t < NMETA ? hmeta + (size_t)(b * NMETA + t) * D : out + ((size_t)b * SEQ + (t - NMETA)) * D;
}
DI float* hrow(const Params& p, int tok) { return hrow2(p.hmeta, p.out, tok); }

DI void transpose_convert(const float* __restrict__ src, int ld, int K, int N, bf16_t* __restrict__ dst, int mult, int off, int bid, int nb, char* smem) {
    float* tile = (float*)smem;
    const int tk = K / 64, tn = N / 64, tid = threadIdx.x;
    for (int t = bid; t < tk * tn; t += nb) {
        const int k0 = (t / tn) * 64, n0 = (t % tn) * 64;
        __syncthreads();
#pragma unroll
        for (int i = 0; i < 2; ++i) {
            const int k = (tid >> 4) + 32 * i, n4 = (tid & 15) * 4;
            const f32x4 v = *(const f32x4*)(src + (size_t)(k0 + k) * ld + n0 + n4);
            tile[k * 65 + n4 + 0] = v[0]; tile[k * 65 + n4 + 1] = v[1]; tile[k * 65 + n4 + 2] = v[2]; tile[k * 65 + n4 + 3] = v[3];
        }
        __syncthreads();
        const int n = tid >> 3, kc = (tid & 7) * 8;
        u32x4 o;
#pragma unroll
        for (int j = 0; j < 4; ++j) o[j] = pack2(tile[(kc + 2 * j) * 65 + n], tile[(kc + 2 * j + 1) * 65 + n]);
        *(u32x4*)(dst + (size_t)((n0 + n) * mult + off) * K + k0 + kc) = o;
    }
}

DI void convert_experts(const Params& p, int layer, int bid, int nb, char* smem) {
    for (int e = 0; e < NE; ++e) {
        const size_t eo = ((size_t)layer * NE + e) * (size_t)D * DE;
        transpose_convert(p.ew_gate + eo, DE, D, DE, p.WtGU + (size_t)e * 1024 * 1024, 2, 0, bid, nb, smem);
        transpose_convert(p.ew_up + eo, DE, D, DE, p.WtGU + (size_t)e * 1024 * 1024, 2, 1, bid, nb, smem);
        transpose_convert(p.ew_down + eo, D, DE, D, p.WtD + (size_t)e * 1024 * 512, 1, 0, bid, nb, smem);
    }
}

DI void phase_prologue_weights(const Params& p, int bid, int nb, char* smem) {
    for (int l = 0; l < DEPTH; ++l) {
        transpose_convert(p.w_in + (size_t)l * D * CIN, CIN, D, CIN, p.WtIn + (size_t)l * CIN * D, 1, 0, bid, nb, smem);
        transpose_convert(p.p_sb + (size_t)l * 512 * D, D, 512, D, p.WtPsb + (size_t)l * D * 512, 1, 0, bid, nb, smem);
        transpose_convert(p.p_rwkv + (size_t)l * 512 * D, D, 512, D, p.WtPrw + (size_t)l * D * 512, 1, 0, bid, nb, smem);
        transpose_convert(p.w_out + (size_t)l * D * D, D, D, D, p.WtOut + (size_t)l * D * D, 1, 0, bid, nb, smem);
    }
    convert_experts(p, 0, bid, nb, smem);
}

DI void ln16(float (&v)[16], const float* __restrict__ g, const float* __restrict__ b, int lane) {
    float s = 0.f;
#pragma unroll
    for (int i = 0; i < 16; ++i) s += v[i];
    const float mean = wave_sum(s) * (1.0f / D);
    float q = 0.f;
#pragma unroll
    for (int i = 0; i < 16; ++i) { v[i] -= mean; q += v[i] * v[i]; }
    const float rstd = rsqrtf(wave_sum(q) * (1.0f / D) + 1e-5f);
#pragma unroll
    for (int j = 0; j < 4; ++j) {
        const f32x4 gv = *(const f32x4*)(g + 256 * j + 4 * lane), bv = *(const f32x4*)(b + 256 * j + 4 * lane);
#pragma unroll
        for (int i = 0; i < 4; ++i) v[4 * j + i] = v[4 * j + i] * rstd * gv[i] + bv[i];
    }
}
DI void store_row(float* __restrict__ hf, bf16_t* __restrict__ hb, const float (&v)[16], int lane) {
#pragma unroll
    for (int j = 0; j < 4; ++j) {
        *(f32x4*)(hf + 256 * j + 4 * lane) = (f32x4){v[4 * j], v[4 * j + 1], v[4 * j + 2], v[4 * j + 3]};
        *(u32x2*)(hb + 256 * j + 4 * lane) = (u32x2){pack2(v[4 * j], v[4 * j + 1]), pack2(v[4 * j + 2], v[4 * j + 3])};
    }
}

DI void phase_embed(const Params& p, int bid, int nb) {
    const int lane = threadIdx.x & 63, wid = threadIdx.x >> 6;
    for (int tok = bid * 8 + wid; tok < T; tok += nb * 8) {
        const int b = tok >= L ? 1 : 0, t = tok - b * L;
        const float* src = t < NMETA ? p.meta + (size_t)t * D : p.x + ((size_t)b * SEQ + (t - NMETA)) * D;
        float v[16];
#pragma unroll
        for (int j = 0; j < 4; ++j) { const f32x4 a = *(const f32x4*)(src + 256 * j + 4 * lane); v[4 * j] = a[0]; v[4 * j + 1] = a[1]; v[4 * j + 2] = a[2]; v[4 * j + 3] = a[3]; }
        ln16(v, p.emb_g, p.emb_b, lane);
        store_row(hrow(p, tok), p.hb + (size_t)tok * D, v, lane);
    }
}

constexpr int LDT = 72;
constexpr int GEMM_LDS = 2 * 128 * LDT * 2;
template <class ARow, class Epi>
DI void gemm_tile128(ARow arow, const bf16_t* __restrict__ Bt, int ldb, int K, int m0, int n0, char* smem, Epi epi) {
    const int tid = threadIdx.x, lane = tid & 63, wid = tid >> 6, fr = lane & 15, fq = lane >> 4;
    const int wr = wid >> 1, wc = wid & 1;
    bf16_t* As = (bf16_t*)smem;
    bf16_t* Bs = As + 128 * LDT;
    const bf16_t* ap[2]; const bf16_t* bp[2]; int so[2];
#pragma unroll
    for (int i = 0; i < 2; ++i) {
        const int c = tid + NTHR * i, row = c >> 3, kc = c & 7;
        const bf16_t* ar = arow(m0 + row);
        ap[i] = ar ? ar + kc * 8 : nullptr;
        bp[i] = Bt + (size_t)(n0 + row) * ldb + kc * 8;
        so[i] = row * LDT + kc * 8;
    }
    f32x4 acc[2][4];
#pragma unroll
    for (int mi = 0; mi < 2; ++mi)
#pragma unroll
        for (int ni = 0; ni < 4; ++ni) acc[mi][ni] = (f32x4){0.f, 0.f, 0.f, 0.f};
    u32x4 ra[2], rb[2];
#pragma unroll
    for (int i = 0; i < 2; ++i) { ra[i] = ap[i] ? *(const u32x4*)(ap[i]) : (u32x4){0u, 0u, 0u, 0u}; rb[i] = *(const u32x4*)(bp[i]); }
    for (int k0 = 0; k0 < K; k0 += 64) {
        __syncthreads();
#pragma unroll
        for (int i = 0; i < 2; ++i) { *(u32x4*)(As + so[i]) = ra[i]; *(u32x4*)(Bs + so[i]) = rb[i]; }
        __syncthreads();
        if (k0 + 64 < K) {
#pragma unroll
            for (int i = 0; i < 2; ++i) { ra[i] = ap[i] ? *(const u32x4*)(ap[i] + k0 + 64) : (u32x4){0u, 0u, 0u, 0u}; rb[i] = *(const u32x4*)(bp[i] + k0 + 64); }
        }
#pragma unroll
        for (int ks = 0; ks < 2; ++ks) {
            bf16x8 af[2], bf[4];
#pragma unroll
            for (int mi = 0; mi < 2; ++mi) af[mi] = *(const bf16x8*)(As + (wr * 32 + mi * 16 + fr) * LDT + ks * 32 + fq * 8);
#pragma unroll
            for (int ni = 0; ni < 4; ++ni) bf[ni] = *(const bf16x8*)(Bs + (wc * 64 + ni * 16 + fr) * LDT + ks * 32 + fq * 8);
#pragma unroll
            for (int mi = 0; mi < 2; ++mi)
#pragma unroll
                for (int ni = 0; ni < 4; ++ni) acc[mi][ni] = __builtin_amdgcn_mfma_f32_16x16x32_bf16(bf[ni], af[mi], acc[mi][ni], 0, 0, 0);
        }
    }
#pragma unroll
    for (int mi = 0; mi < 2; ++mi)
#pragma unroll
        for (int ni = 0; ni < 4; ++ni) epi(m0 + wr * 32 + mi * 16 + fr, n0 + wc * 64 + ni * 16 + fq * 4, acc[mi][ni]);
}

DI void phase_inproj(const Params& p, int layer, int bid, int nb, char* smem) {
    const bf16_t* hb = p.hb; bf16_t* P = p.P;
    const bf16_t* Bt = p.WtIn + (size_t)layer * CIN * D;
    constexpr int NT = CP / 128, MT = TP / 128;
    for (int t = bid; t < MT * NT; t += nb) {
        const int m0 = (t / NT) * 128, n0 = (t % NT) * 128;
        gemm_tile128([=](int r) { return r < T ? hb + (size_t)r * D : (const bf16_t*)nullptr; }, Bt, D, D, m0, n0, smem,
                     [=](int r, int c, f32x4 v) { if (r < T) *(u32x2*)(P + (size_t)r * CP + c) = (u32x2){pack2(v[0], v[1]), pack2(v[2], v[3])}; });
    }
}

DI void phase_lora(const Params& p, int layer, int bid, int nb, char* smem) {
    float* xs = (float*)smem;
    const int tid = threadIdx.x;
    const float* mu = p.mu + (size_t)layer * RSW + RW_WD;
    const float* w_up = p.w_up + (size_t)layer * 64 * 512, *a_up = p.a_up + (size_t)layer * 64 * 512, *g_up = p.g_up + (size_t)layer * 128 * 512;
    for (int blk = bid; blk < T / 16; blk += nb) {
        const int tok0 = blk * 16;
        __syncthreads();
#pragma unroll
        for (int i = 0; i < 8; ++i) {
            const int idx = tid + NTHR * i, tk = idx >> 8, c = idx & 255, tok = tok0 + tk, t = tok >= L ? tok - L : tok;
            const float xc = bf2f(p.P[(size_t)tok * CP + OFF_RW + RW_WD + c]);
            const float xp = t > 0 ? bf2f(p.P[(size_t)(tok - 1) * CP + OFF_RW + RW_WD + c]) : 0.f;
            float v = xc + (xp - xc) * mu[c];
            if (c < 64) v = tanhf(v); else if (c >= 128) v = sigmoidf_(v);
            xs[tk * 256 + c] = v;
        }
        __syncthreads();
        float aw[16], aa[16], ag[16];
#pragma unroll
        for (int tk = 0; tk < 16; ++tk) { aw[tk] = 0.f; aa[tk] = 0.f; ag[tk] = 0.f; }
        for (int j = 0; j < 64; j += 4) {
            float wv[4], av[4];
#pragma unroll
            for (int jj = 0; jj < 4; ++jj) { wv[jj] = w_up[(j + jj) * 512 + tid]; av[jj] = a_up[(j + jj) * 512 + tid]; }
#pragma unroll
            for (int tk = 0; tk < 16; ++tk) {
                const f32x4 xw = *(const f32x4*)(xs + tk * 256 + j), xa = *(const f32x4*)(xs + tk * 256 + 64 + j);
#pragma unroll
                for (int jj = 0; jj < 4; ++jj) { aw[tk] += xw[jj] * wv[jj]; aa[tk] += xa[jj] * av[jj]; }
            }
        }
        for (int j = 0; j < 128; j += 4) {
            float gv[4];
#pragma unroll
            for (int jj = 0; jj < 4; ++jj) gv[jj] = g_up[(j + jj) * 512 + tid];
#pragma unroll
            for (int tk = 0; tk < 16; ++tk) {
                const f32x4 xg = *(const f32x4*)(xs + tk * 256 + 128 + j);
#pragma unroll
                for (int jj = 0; jj < 4; ++jj) ag[tk] += xg[jj] * gv[jj];
            }
        }
        const float w0 = p.w0[layer * 512 + tid], a0 = p.a0[layer * 512 + tid];
#pragma unroll
        for (int tk = 0; tk < 16; ++tk) {
            const size_t o = (size_t)(tok0 + tk) * 512 + tid;
            p.wdec[o] = f2bf(__expf(-DECAY_SCALE * sigmoidf_(w0 + aw[tk])));
            p.aval[o] = f2bf(sigmoidf_(a0 + aa[tk]));
            p.gval[o] = f2bf(ag[tk]);
        }
    }
}

constexpr int RSTEP = 16;
DI void phase_rwkv_naive(const Params& p, int layer, int bid, int nb, char* smem) {
    const int lane = threadIdx.x & 63, wid = threadIdx.x >> 6;
    if (wid != 0) return;
    float* sR = (float*)smem; float* sW = sR + RSTEP * 64; float* sK = sW + RSTEP * 64; float* sKK = sK + RSTEP * 64; float* sB = sKK + RSTEP * 64;
    float* sV = sB + RSTEP * 64; float* sG = sV + RSTEP * 64; float* sBon = sG + RSTEP * 64;
    for (int u = bid; u < NBATCH * HEADS; u += nb) {
        const int b = u / HEADS, h = u % HEADS, c = h * 64 + lane;
        const float mu_r = p.mu[layer * RSW + RW_R + c], mu_k = p.mu[layer * RSW + RW_K + c], mu_v = p.mu[layer * RSW + RW_V + c];
        const float kkc = p.k_k[layer * 512 + c], kac = p.k_a[layer * 512 + c], rkc = p.r_k[layer * 512 + c];
        const float lg = p.lnx_g[layer * 512 + c], lb = p.lnx_b[layer * 512 + c];
        float S[64];
#pragma unroll
        for (int k = 0; k < 64; ++k) S[k] = 0.f;
        float rp = 0.f, kp = 0.f, vp = 0.f;
        for (int t0 = 0; t0 < L; t0 += RSTEP) {
            wave_sync();
            for (int s = 0; s < RSTEP; ++s) {
                const int tok = b * L + t0 + s;
                const bf16_t* pr = p.P + (size_t)tok * CP + OFF_RW;
                const float rc = bf2f(pr[RW_R + c]), kc = bf2f(pr[RW_K + c]), vc = bf2f(pr[RW_V + c]);
                const float r = rc + (rp - rc) * mu_r, kr = kc + (kp - kc) * mu_k, v = vc + (vp - vc) * mu_v;
                rp = rc; kp = kc; vp = vc;
                const float w = bf2f(p.wdec[(size_t)tok * 512 + c]), a = bf2f(p.aval[(size_t)tok * 512 + c]), g = bf2f(p.gval[(size_t)tok * 512 + c]);
                float kk = kr * kkc;
                const float nrm = sqrtf(wave_sum(kk * kk));
                kk = kk / fmaxf(nrm, 1e-12f);
                const float kq = kr * (1.0f + (a - 1.0f) * kac);
                const float bon = wave_sum(r * kq * rkc);
                sR[s * 64 + lane] = r; sW[s * 64 + lane] = w; sK[s * 64 + lane] = kq; sKK[s * 64 + lane] = kk; sB[s * 64 + lane] = kk * a;
                sV[s * 64 + lane] = v; sG[s * 64 + lane] = g; if (lane == 0) sBon[s] = bon;
            }
            wave_sync();
            for (int s = 0; s < RSTEP; ++s) {
                const float v = sV[s * 64 + lane];
                float sa0 = 0.f, sa1 = 0.f, sa2 = 0.f, sa3 = 0.f;
#pragma unroll
                for (int k = 0; k < 64; k += 4) {
                    const f32x4 q = *(const f32x4*)(sKK + s * 64 + k);
                    sa0 += S[k] * q[0]; sa1 += S[k + 1] * q[1]; sa2 += S[k + 2] * q[2]; sa3 += S[k + 3] * q[3];
                }
                const float sa = (sa0 + sa1) + (sa2 + sa3);
                float y0 = 0.f, y1 = 0.f, y2 = 0.f, y3 = 0.f;
#pragma unroll
                for (int k = 0; k < 64; k += 4) {
                    const f32x4 wv = *(const f32x4*)(sW + s * 64 + k), kv = *(const f32x4*)(sK + s * 64 + k), bv = *(const f32x4*)(sB + s * 64 + k), rv = *(const f32x4*)(sR + s * 64 + k);
                    S[k] = S[k] * wv[0] + (v * kv[0] - sa * bv[0]); y0 += S[k] * rv[0];
                    S[k + 1] = S[k + 1] * wv[1] + (v * kv[1] - sa * bv[1]); y1 += S[k + 1] * rv[1];
                    S[k + 2] = S[k + 2] * wv[2] + (v * kv[2] - sa * bv[2]); y2 += S[k + 2] * rv[2];
                    S[k + 3] = S[k + 3] * wv[3] + (v * kv[3] - sa * bv[3]); y3 += S[k + 3] * rv[3];
                }
                const float y = (y0 + y1) + (y2 + y3);
                const float mean = wave_sum(y) * (1.0f / 64.f), d = y - mean;
                const float var = wave_sum(d * d) * (1.0f / 64.f);
                const float yn = d * rsqrtf(var + 64e-5f);
                const float o = (yn * lg + lb + sBon[s] * v) * sG[s * 64 + lane];
                p.orw[(size_t)(b * L + t0 + s) * 512 + c] = f2bf(o);
            }
        }
    }
}

DI void phase_sb_naive(const Params& p, int bid, int nb) {
    constexpr int NTB = (L + NTHR - 1) / NTHR;
    for (int u = bid; u < NBATCH * HEADS * NTB; u += nb) {
        const int tb = u / (NBATCH * HEADS), bh = u % (NBATCH * HEADS), b = bh / HEADS, h = bh % HEADS;
        const int t = tb * NTHR + threadIdx.x;
        if (t >= L) continue;
        const size_t tok = (size_t)b * L + t;
        float q[64], acc[64];
        {
            const bf16_t* qp = p.P + tok * CP + OFF_Q + h * 64;
#pragma unroll
            for (int i = 0; i < 8; ++i) {
                const u32x4 v = *(const u32x4*)(qp + 8 * i);
#pragma unroll
                for (int j = 0; j < 4; ++j) { q[8 * i + 2 * j] = lo_bf(v[j]) * 0.125f; q[8 * i + 2 * j + 1] = hi_bf(v[j]) * 0.125f; }
            }
        }
#pragma unroll
        for (int i = 0; i < 64; ++i) acc[i] = 0.f;
        float R = 0.f;
        for (int s = t - 1; s >= 0; --s) {
            const bf16_t* kp = p.P + ((size_t)b * L + s) * CP + OFF_K + h * 64;
            float z0 = 0.f, z1 = 0.f;
#pragma unroll
            for (int i = 0; i < 8; ++i) {
                const u32x4 v = *(const u32x4*)(kp + 8 * i);
#pragma unroll
                for (int j = 0; j < 4; ++j) { z0 += q[8 * i + 2 * j] * lo_bf(v[j]); z1 += q[8 * i + 2 * j + 1] * hi_bf(v[j]); }
            }
            const float z = z0 + z1;
            const float l1 = __logf(1.0f + __expf(-fabsf(z)));
            const float lsneg = -(fmaxf(z, 0.f) + l1);
            const float A = __expf(lsneg + z + R);
            const bf16_t* vp = kp + (OFF_V - OFF_K);
#pragma unroll
            for (int i = 0; i < 8; ++i) {
                const u32x4 v = *(const u32x4*)(vp + 8 * i);
#pragma unroll
                for (int j = 0; j < 4; ++j) { acc[8 * i + 2 * j] += A * lo_bf(v[j]); acc[8 * i + 2 * j + 1] += A * hi_bf(v[j]); }
            }
            R += lsneg;
            if (R < -104.0f) break;
        }
        bf16_t* op = p.osb + tok * 512 + h * 64;
#pragma unroll
        for (int i = 0; i < 8; ++i) {
            u32x4 o;
#pragma unroll
            for (int j = 0; j < 4; ++j) o[j] = pack2(acc[8 * i + 2 * j], acc[8 * i + 2 * j + 1]);
            *(u32x4*)(op + 8 * i) = o;
        }
    }
}

DI void phase_gates(const Params& p, int layer, int bid, int nb, char* smem) {
    const bf16_t* hb = p.hb; bf16_t* G = p.gates;
    const bf16_t* Bt = p.WtIn + ((size_t)layer * CIN + CP) * D;
    constexpr int NT = 2048 / 128, MT = TP / 128;
    for (int t = bid; t < MT * NT; t += nb) {
        const int m0 = (t / NT) * 128, n0 = (t % NT) * 128;
        gemm_tile128([=](int r) { return r < T ? hb + (size_t)r * D : (const bf16_t*)nullptr; }, Bt, D, D, m0, n0, smem,
                     [=](int r, int c, f32x4 v) { if (r < T) *(u32x2*)(G + (size_t)r * 2048 + c) = (u32x2){pack2(sigmoidf_(v[0]), sigmoidf_(v[1])), pack2(sigmoidf_(v[2]), sigmoidf_(v[3]))}; });
    }
}
DI void phase_branch(const Params& p, int layer, int which, int bid, int nb, char* smem) {
    const bf16_t* A = which ? p.orw : p.osb; const bf16_t* G = p.gates + which * 1024; bf16_t* M = p.merged;
    const bf16_t* Bt = (which ? p.WtPrw : p.WtPsb) + (size_t)layer * D * 512;
    constexpr int NT = D / 128, MT = TP / 128;
    for (int t = bid; t < MT * NT; t += nb) {
        const int m0 = (t / NT) * 128, n0 = (t % NT) * 128;
        gemm_tile128([=](int r) { return r < T ? A + (size_t)r * 512 : (const bf16_t*)nullptr; }, Bt, 512, 512, m0, n0, smem,
                     [=](int r, int c, f32x4 v) {
                         if (r >= T) return;
                         const u32x2 g = *(const u32x2*)(G + (size_t)r * 2048 + c);
                         float o0 = lo_bf(g[0]) * v[0], o1 = hi_bf(g[0]) * v[1], o2 = lo_bf(g[1]) * v[2], o3 = hi_bf(g[1]) * v[3];
                         u32x2* mp = (u32x2*)(M + (size_t)r * D + c);
                         if (which) { const u32x2 m = *mp; o0 += lo_bf(m[0]); o1 += hi_bf(m[0]); o2 += lo_bf(m[1]); o3 += hi_bf(m[1]); }
                         *mp = (u32x2){pack2(o0, o1), pack2(o2, o3)};
                     });
    }
}
DI void phase_outproj(const Params& p, int layer, int bid, int nb, char* smem) {
    const bf16_t* A = p.merged; float* const hmeta = p.hmeta; float* const outp = p.out;
    const bf16_t* Bt = p.WtOut + (size_t)layer * D * D;
    constexpr int NT = D / 128, MT = TP / 128;
    if (bid == 0 && threadIdx.x < NE) p.counts[threadIdx.x] = 0;
    for (int t = bid; t < MT * NT; t += nb) {
        const int m0 = (t / NT) * 128, n0 = (t % NT) * 128;
        gemm_tile128([=](int r) { return r < T ? A + (size_t)r * D : (const bf16_t*)nullptr; }, Bt, D, D, m0, n0, smem,
                     [=](int r, int c, f32x4 v) {
                         if (r >= T) return;
                         f32x4* hp = (f32x4*)(hrow2(hmeta, outp, r) + c);
                         const f32x4 h = *hp;
                         *hp = (f32x4){ALPHA * h[0] + v[0], ALPHA * h[1] + v[1], ALPHA * h[2] + v[2], ALPHA * h[3] + v[3]};
                     });
    }
}

DI void phase_ln1_router(const Params& p, int layer, int bid, int nb) {
    const int lane = threadIdx.x & 63, wid = threadIdx.x >> 6;
    for (int tok = bid * 8 + wid; tok < T; tok += nb * 8) {
        float* hf = hrow(p, tok);
        float v[16];
#pragma unroll
        for (int j = 0; j < 4; ++j) { const f32x4 a = *(const f32x4*)(hf + 256 * j + 4 * lane); v[4 * j] = a[0]; v[4 * j + 1] = a[1]; v[4 * j + 2] = a[2]; v[4 * j + 3] = a[3]; }
        ln16(v, p.ln1_g + layer * D, p.ln1_b + layer * D, lane);
        store_row(hf, p.hb + (size_t)tok * D, v, lane);
        float lg[16];
#pragma unroll
        for (int e = 0; e < 16; ++e) lg[e] = 0.f;
#pragma unroll
        for (int j = 0; j < 4; ++j)
#pragma unroll
            for (int i = 0; i < 4; ++i) {
                const float* rw = p.router_w + (size_t)(256 * j + 4 * lane + i) * NE;
#pragma unroll
                for (int e4 = 0; e4 < 4; ++e4) {
                    const f32x4 w = *(const f32x4*)(rw + 4 * e4);
#pragma unroll
                    for (int q = 0; q < 4; ++q) lg[4 * e4 + q] += v[4 * j + i] * w[q];
                }
            }
        float mx = -3.0e38f;
#pragma unroll
        for (int e = 0; e < 16; ++e) { lg[e] = wave_sum(lg[e]) + p.router_b[e]; mx = fmaxf(mx, lg[e]); }
        float sum = 0.f;
#pragma unroll
        for (int e = 0; e < 16; ++e) { lg[e] = __expf(lg[e] - mx); sum += lg[e]; }
        const float inv = 1.0f / sum;
        float bs = -1.f, bv1 = 0.f, bv2 = 0.f; int be1 = 0, be2 = 1;
#pragma unroll
        for (int g = 0; g < 4; ++g) {
            float v1 = -1.f, v2 = -1.f; int i1 = 0, i2 = 0;
#pragma unroll
            for (int i = 0; i < 4; ++i) {
                const float pv = lg[4 * g + i] * inv;
                if (pv > v1) { v2 = v1; i2 = i1; v1 = pv; i1 = i; } else if (pv > v2) { v2 = pv; i2 = i; }
            }
            const float sc = v1 + v2;
            if (sc > bs) { bs = sc; bv1 = v1; bv2 = v2; be1 = 4 * g + i1; be2 = 4 * g + i2; }
        }
        if (lane == 0) {
            const float gs = 1.0f / (bv1 + bv2);
            const int s1 = atomicAdd(&p.counts[be1], 1), s2 = atomicAdd(&p.counts[be2], 1);
            p.list[be1 * T + s1] = tok * 2; p.list[be2 * T + s2] = tok * 2 + 1;
            p.tokg[tok * 2] = bv1 * gs; p.tokg[tok * 2 + 1] = bv2 * gs;
        }
    }
}

struct MoeTile { int e, slot0, off, cnt, total; };
DI MoeTile moe_tile(const int* counts, int tm) {
    MoeTile r; r.e = -1; r.slot0 = 0; r.off = 0; r.cnt = 0;
    int start = 0, off = 0;
#pragma unroll
    for (int e = 0; e < NE; ++e) {
        const int c = counts[e], nt = (c + 127) >> 7;
        if (tm >= start && tm < start + nt) { r.e = e; r.slot0 = (tm - start) * 128; r.off = off; r.cnt = c; }
        start += nt; off += c;
    }
    r.total = start;
    return r;
}
DI void phase_moe_up(const Params& p, int bid, int nb, char* smem) {
    const bf16_t* hb = p.hb; bf16_t* hid = p.hid; const int* list = p.list;
    const int total = moe_tile(p.counts, 0).total;
    for (int t = bid; t < total * 8; t += nb) {
        const MoeTile mt = moe_tile(p.counts, t >> 3);
        const int n0 = (t & 7) * 128, e = mt.e, slot0 = mt.slot0, cnt = mt.cnt, off = mt.off;
        gemm_tile128([=](int r) { const int s = slot0 + r; return s < cnt ? hb + (size_t)(list[e * T + s] >> 1) * D : (const bf16_t*)nullptr; },
                     p.WtGU + (size_t)e * 1024 * 1024, D, D, 0, n0, smem,
                     [=](int r, int c, f32x4 v) {
                         const int s = slot0 + r;
                         if (s >= cnt) return;
                         const float h0 = v[0] * sigmoidf_(v[0]) * v[1], h1 = v[2] * sigmoidf_(v[2]) * v[3];
                         *(unsigned*)(hid + (size_t)(off + s) * DE + (c >> 1)) = pack2(h0, h1);
                     });
    }
}
DI void phase_moe_down(const Params& p, int bid, int nb, char* smem) {
    const bf16_t* hid = p.hid; bf16_t* fo = p.fo; const int* list = p.list; const float* tokg = p.tokg;
    const int total = moe_tile(p.counts, 0).total;
    for (int t = bid; t < total * 8; t += nb) {
        const MoeTile mt = moe_tile(p.counts, t >> 3);
        const int n0 = (t & 7) * 128, e = mt.e, slot0 = mt.slot0, cnt = mt.cnt, off = mt.off;
        gemm_tile128([=](int r) { const int s = slot0 + r; return s < cnt ? hid + (size_t)(off + s) * DE : (const bf16_t*)nullptr; },
                     p.WtD + (size_t)e * 1024 * 512, DE, DE, 0, n0, smem,
                     [=](int r, int c, f32x4 v) {
                         const int s = slot0 + r;
                         if (s >= cnt) return;
                         const int ent = list[e * T + s], tok = ent >> 1, kc = ent & 1;
                         const float g = tokg[ent];
                         *(u32x2*)(fo + ((size_t)kc * TP + tok) * D + c) = (u32x2){pack2(g * v[0], g * v[1]), pack2(g * v[2], g * v[3])};
                     });
    }
}
DI void phase_ln2(const Params& p, int layer, int bid, int nb) {
    const int lane = threadIdx.x & 63, wid = threadIdx.x >> 6;
    for (int tok = bid * 8 + wid; tok < T; tok += nb * 8) {
        float* hf = hrow(p, tok);
        float v[16];
#pragma unroll
        for (int j = 0; j < 4; ++j) {
            const f32x4 a = *(const f32x4*)(hf + 256 * j + 4 * lane);
            const u32x2 f0 = *(const u32x2*)(p.fo + (size_t)tok * D + 256 * j + 4 * lane), f1 = *(const u32x2*)(p.fo + ((size_t)TP + tok) * D + 256 * j + 4 * lane);
            v[4 * j] = ALPHA * a[0] + lo_bf(f0[0]) + lo_bf(f1[0]); v[4 * j + 1] = ALPHA * a[1] + hi_bf(f0[0]) + hi_bf(f1[0]);
            v[4 * j + 2] = ALPHA * a[2] + lo_bf(f0[1]) + lo_bf(f1[1]); v[4 * j + 3] = ALPHA * a[3] + hi_bf(f0[1]) + hi_bf(f1[1]);
        }
        ln16(v, p.ln2_g + layer * D, p.ln2_b + layer * D, lane);
        store_row(hf, p.hb + (size_t)tok * D, v, lane);
    }
}

extern __shared__ __attribute__((aligned(16))) char dyn_smem[];
constexpr int SMEM_BYTES = GEMM_LDS;

template <int PH> __global__ void __launch_bounds__(NTHR, 2) k_phase(Params p, int layer) {
    const int bid = blockIdx.x, nb = gridDim.x;
    if (PH == 0) phase_prologue_weights(p, bid, nb, dyn_smem);
    if (PH == 1) phase_embed(p, bid, nb);
    if (PH == 2) phase_inproj(p, layer, bid, nb, dyn_smem);
    if (PH == 3) phase_lora(p, layer, bid, nb, dyn_smem);
    if (PH == 4) phase_rwkv_naive(p, layer, bid, nb, dyn_smem);
    if (PH == 5) phase_sb_naive(p, bid, nb);
    if (PH == 6) phase_gates(p, layer, bid, nb, dyn_smem);
    if (PH == 7) phase_branch(p, layer, 0, bid, nb, dyn_smem);
    if (PH == 8) phase_branch(p, layer, 1, bid, nb, dyn_smem);
    if (PH == 9) phase_outproj(p, layer, bid, nb, dyn_smem);
    if (PH == 10) phase_ln1_router(p, layer, bid, nb);
    if (PH == 11) phase_moe_up(p, bid, nb, dyn_smem);
    if (PH == 12) phase_moe_down(p, bid, nb, dyn_smem);
    if (PH == 13) phase_ln2(p, layer, bid, nb);
    if (PH == 14) convert_experts(p, layer, bid, nb, dyn_smem);
}

extern "C" void kernel_launch(void* const* d_in, const int* in_sizes, int n_in, void* d_out, int out_size, void* d_ws, size_t ws_size, hipStream_t stream) {
    (void)in_sizes; (void)n_in; (void)out_size;
    Params p;
    memset(&p, 0, sizeof(p));
    const float* const* in = (const float* const*)d_in;
    p.x = in[0]; p.meta = in[1]; p.emb_g = in[2]; p.emb_b = in[3]; p.w_in = in[4]; p.mu = in[5]; p.w0 = in[6]; p.w_up = in[7]; p.a0 = in[8]; p.a_up = in[9];
    p.g_up = in[10]; p.k_k = in[11]; p.k_a = in[12]; p.r_k = in[13]; p.lnx_g = in[14]; p.lnx_b = in[15]; p.p_sb = in[16]; p.p_rwkv = in[17]; p.w_out = in[18];
    p.ln1_g = in[19]; p.ln1_b = in[20]; p.router_w = in[21]; p.router_b = in[22]; p.ew_gate = in[23]; p.ew_up = in[24]; p.ew_down = in[25]; p.ln2_g = in[26]; p.ln2_b = in[27];
    p.out = (float*)d_out;
    char* ws = (char*)d_ws; size_t o = 0;
    auto take = [&](size_t bytes) { char* r = ws + o; o += (bytes + 255) & ~(size_t)255; return r; };
    p.bar = (unsigned*)take(16384);
    p.counts = (int*)take(256);
    p.WtIn = (bf16_t*)take((size_t)DEPTH * CIN * D * 2);
    p.WtPsb = (bf16_t*)take((size_t)DEPTH * D * 512 * 2);
    p.WtPrw = (bf16_t*)take((size_t)DEPTH * D * 512 * 2);
    p.WtOut = (bf16_t*)take((size_t)DEPTH * D * D * 2);
    p.WtGU = (bf16_t*)take((size_t)NE * 1024 * 1024 * 2);
    p.WtD = (bf16_t*)take((size_t)NE * 1024 * 512 * 2);
    p.hb = (bf16_t*)take((size_t)TP * D * 2);
    p.hmeta = (float*)take((size_t)NBATCH * NMETA * D * 4);
    p.P = (bf16_t*)take((size_t)TP * CP * 2);
    p.osb = (bf16_t*)take((size_t)TP * 512 * 2);
    p.orw = (bf16_t*)take((size_t)TP * 512 * 2);
    p.wdec = (bf16_t*)take((size_t)T * 512 * 2);
    p.aval = (bf16_t*)take((size_t)T * 512 * 2);
    p.gval = (bf16_t*)take((size_t)T * 512 * 2);
    p.list = (int*)take((size_t)NE * T * 4);
    p.tokg = (float*)take((size_t)T * 2 * 4);
    p.gates = p.P;
    p.merged = p.P + (size_t)TP * 2048;
    p.hid = p.P;
    p.fo = p.P + (size_t)(2 * T + 128) * DE;
    if (o > ws_size) return;
    const dim3 blk(NTHR);
    const int G = 1024;
#define LAUNCH(PH, grid, layer) hipLaunchKernelGGL((k_phase<PH>), dim3(grid), blk, SMEM_BYTES, stream, p, layer)
    LAUNCH(0, G, 0);
    LAUNCH(1, G, 0);
    for (int l = 0; l < DEPTH; ++l) {
        LAUNCH(2, G, l);
        LAUNCH(3, G, l);
        LAUNCH(4, NBATCH * HEADS, l);
        LAUNCH(5, G, l);
        LAUNCH(6, G, l);
        LAUNCH(7, G, l);
        LAUNCH(8, G, l);
        LAUNCH(9, G, l);
        LAUNCH(10, G, l);
        LAUNCH(11, G, l);
        LAUNCH(12, G, l);
        if (l + 1 < DEPTH) LAUNCH(14, G, l + 1);
        LAUNCH(13, G, l);
    }
}
```

```cpp
#include <hip/hip_runtime.h>
#include <stdint.h>
#include <string.h>

#define DI __device__ __forceinline__
typedef unsigned short bf16_t;
typedef short bf16x8 __attribute__((ext_vector_type(8)));
typedef float f32x4 __attribute__((ext_vector_type(4)));
typedef unsigned u32x4 __attribute__((ext_vector_type(4)));
typedef unsigned u32x2 __attribute__((ext_vector_type(2)));

constexpr int D = 1024, NBATCH = 2, SEQ = 8192, NMETA = 16, L = SEQ + NMETA, T = NBATCH * L, TP = 16640;
constexpr int DEPTH = 2, HEADS = 8, HD = 64;
constexpr int CIN = 5376, CP = 3328;
constexpr int OFF_Q = 0, OFF_K = 512, OFF_V = 1024, OFF_RW = 1536;
constexpr int RW_R = 0, RW_K = 512, RW_V = 1024, RW_WD = 1536, RW_AD = 1600, RW_GD = 1664, RSW = 1792;
constexpr int NE = 16, DE = 512;
constexpr float ALPHA = 1.41421356237309515f;
constexpr float DECAY_SCALE = 0.60653065971263342f;
constexpr int NTHR = 512;

#define XB_TMO      128
#define XB_XCNT(j)  (256  + 64 * (j))
#define XB_XSUB(j)  (1280 + 64 * (j))
#define XB_XGEN(j)  (2304 + 64 * (j))
#define XB_TOP      3328
#define XB_TOPGEN   3392
#define XCD_BAR_WORDS 3456
#define XB_SPIN_CAP (1u << 18)
#define LAS __attribute__((address_space(3)))

__device__ __forceinline__ unsigned xb_ld(unsigned* p)              { return __hip_atomic_load(p, __ATOMIC_RELAXED, __HIP_MEMORY_SCOPE_AGENT); }
__device__ __forceinline__ unsigned xb_add(unsigned* p, unsigned v) { return __hip_atomic_fetch_add(p, v, __ATOMIC_RELAXED, __HIP_MEMORY_SCOPE_AGENT); }
__device__ __forceinline__ unsigned xb_xcc_id() { return (unsigned)__builtin_amdgcn_s_getreg((3 << 11) | 20) & 0xFu; }
#define XB_SPIN(cond, bar) do { unsigned _sp = 0; while (cond) { __builtin_amdgcn_s_sleep(1); \
    if ((++_sp & 255u) == 0u) { if (xb_ld(&(bar)[XB_TMO])) break; if (_sp > XB_SPIN_CAP) { atomicAdd(&(bar)[XB_TMO], 1u); break; } } } } while (0)

struct XcdBarrier {
    unsigned* bar; unsigned x;
    volatile LAS unsigned* st;
};

__device__ __forceinline__ XcdBarrier xcd_barrier_post(unsigned* bar, volatile LAS unsigned* st) {
    XcdBarrier b; b.bar = bar; b.x = xb_xcc_id(); b.st = st;
    if (threadIdx.x == 0) (void)xb_add(&bar[XB_XCNT(b.x)], 1u);
    return b;
}
__device__ __forceinline__ void xcd_barrier_complete(unsigned* bar, unsigned x, unsigned& nloc, unsigned& nx) {
    const unsigned G = gridDim.x * gridDim.y * gridDim.z;
    unsigned sum, cnt, mine, sp = 0u;
    for (;;) {
        sum = 0u; cnt = 0u; mine = 0u;
#pragma unroll
        for (unsigned j = 0; j < 16; ++j) { const unsigned c = xb_ld(&bar[XB_XCNT(j)]); sum += c; cnt += (c > 0u) ? 1u : 0u; mine = (j == x) ? c : mine; }
        if (sum == G) break;
        __builtin_amdgcn_s_sleep(1);
        if ((++sp & 255u) == 0u) { if (xb_ld(&bar[XB_TMO])) break; if (sp > XB_SPIN_CAP) { atomicAdd(&bar[XB_TMO], 1u); break; } }
    }
    nloc = mine > 0u ? mine : 1u; nx = cnt > 0u ? cnt : 1u;
}

__device__ __forceinline__ void xcd_barrier(const XcdBarrier& b) {
    asm volatile("s_waitcnt vmcnt(0)" ::: "memory");
    __syncthreads();
    if (threadIdx.x == 0) {
        unsigned* bar = b.bar;
        __builtin_amdgcn_s_waitcnt(0);
        unsigned nloc = b.st[0], nx = b.st[1];
        if (nloc == 0u) { xcd_barrier_complete(bar, b.x, nloc, nx); b.st[0] = nloc; b.st[1] = nx; }
        const unsigned old = xb_add(&bar[XB_XSUB(b.x)], 1u);
        const unsigned gen = old / nloc;
        if (old + 1u == (gen + 1u) * nloc) {
            __builtin_amdgcn_fence(__ATOMIC_RELEASE, "agent");
            asm volatile("s_waitcnt vmcnt(0)" ::: "memory");
            const unsigned og = xb_add(&bar[XB_TOP], 1u);
            const unsigned tg = og / nx;
            if (og + 1u == (tg + 1u) * nx) xb_add(&bar[XB_TOPGEN], 1u);
            else XB_SPIN(xb_ld(&bar[XB_TOPGEN]) == tg, bar);
            __builtin_amdgcn_fence(__ATOMIC_ACQUIRE, "agent");
            xb_add(&bar[XB_XGEN(b.x)], 1u);
            asm volatile("s_waitcnt vmcnt(0)" ::: "memory");
        } else {
            XB_SPIN(xb_ld(&bar[XB_XGEN(b.x)]) == gen, bar);
            __builtin_amdgcn_fence(__ATOMIC_ACQUIRE, "agent");
            asm volatile("s_waitcnt vmcnt(0)" ::: "memory");
        }
    }
    __syncthreads();
}


struct Params {
    const float *x, *meta, *emb_g, *emb_b, *w_in, *mu, *w0, *w_up, *a0, *a_up, *g_up, *k_k, *k_a, *r_k, *lnx_g, *lnx_b, *p_sb, *p_rwkv, *w_out,
        *ln1_g, *ln1_b, *router_w, *router_b, *ew_gate, *ew_up, *ew_down, *ln2_g, *ln2_b;
    float* out;
    unsigned* bar;
    int* counts;
    bf16_t *WtIn, *WtPsb, *WtPrw, *WtOut, *WtGU, *WtD, *hb, *P, *osb, *orw, *wdec, *aval, *gval;
    float* hmeta;
    bf16_t *gates, *merged, *hid, *fo;
    int* list;
    float* tokg;
};

DI float bf2f(bf16_t v) { return __uint_as_float((unsigned)v << 16); }
DI bf16_t f2bf(float f) { unsigned u = __float_as_uint(f); u += 0x7FFFu + ((u >> 16) & 1u); return (bf16_t)(u >> 16); }
DI unsigned pack2(float lo, float hi) { return (unsigned)f2bf(lo) | ((unsigned)f2bf(hi) << 16); }
DI float lo_bf(unsigned u) { return __uint_as_float(u << 16); }
DI float hi_bf(unsigned u) { return __uint_as_float(u & 0xFFFF0000u); }
DI float wave_sum(float v) {
#pragma unroll
    for (int m = 32; m >= 1; m >>= 1) v += __shfl_xor(v, m);
    return v;
}
DI int tid_() { int t = threadIdx.x; asm volatile("" : "+v"(t)); return t; }
DI float sigmoidf_(float x) { return 1.0f / (1.0f + __expf(-x)); }
DI void wave_sync() { asm volatile("s_waitcnt lgkmcnt(0)" ::: "memory"); __builtin_amdgcn_wave_barrier(); }

DI float* hrow2(float* hmeta, float* out, int tok) {
    const int b = tok >= L ? 1 : 0, t = tok - b * L;
    return t < NMETA ? hmeta + (size_t)(b * NMETA + t) * D : out + ((size_t)b * SEQ + (t - NMETA)) * D;
}
DI float* hrow(const Params& p, int tok) { return hrow2(p.hmeta, p.out, tok); }

DI void transpose_convert(const float* __restrict__ src, int ld, int K, int N, bf16_t* __restrict__ dst, int mult, int off, int bid, int nb, char* smem) {
    float* tile = (float*)smem;
    const int tk = K / 64, tn = N / 64, tid = tid_();
    for (int t = bid; t < tk * tn; t += nb) {
        const int k0 = (t / tn) * 64, n0 = (t % tn) * 64;
        __syncthreads();
#pragma unroll
        for (int i = 0; i < 2; ++i) {
            const int k = (tid >> 4) + 32 * i, n4 = (tid & 15) * 4;
            const f32x4 v = *(const f32x4*)(src + (size_t)(k0 + k) * ld + n0 + n4);
            tile[k * 65 + n4 + 0] = v[0]; tile[k * 65 + n4 + 1] = v[1]; tile[k * 65 + n4 + 2] = v[2]; tile[k * 65 + n4 + 3] = v[3];
        }
        __syncthreads();
        const int n = tid >> 3, kc = (tid & 7) * 8;
        u32x4 o;
#pragma unroll
        for (int j = 0; j < 4; ++j) o[j] = pack2(tile[(kc + 2 * j) * 65 + n], tile[(kc + 2 * j + 1) * 65 + n]);
        *(u32x4*)(dst + (size_t)((n0 + n) * mult + off) * K + k0 + kc) = o;
    }
}

DI void convert_experts(const Params& p, int layer, int bid, int nb, char* smem) {
    for (int e = 0; e < NE; ++e) {
        const size_t eo = ((size_t)layer * NE + e) * (size_t)D * DE;
        transpose_convert(p.ew_gate + eo, DE, D, DE, p.WtGU + (size_t)e * 1024 * 1024, 2, 0, bid, nb, smem);
        transpose_convert(p.ew_up + eo, DE, D, DE, p.WtGU + (size_t)e * 1024 * 1024, 2, 1, bid, nb, smem);
        transpose_convert(p.ew_down + eo, D, DE, D, p.WtD + (size_t)e * 1024 * 512, 1, 0, bid, nb, smem);
    }
}

DI void phase_prologue_weights(const Params& p, int bid, int nb, char* smem) {
    for (int l = 0; l < DEPTH; ++l) {
        transpose_convert(p.w_in + (size_t)l * D * CIN, CIN, D, CIN, p.WtIn + (size_t)l * CIN * D, 1, 0, bid, nb, smem);
        transpose_convert(p.p_sb + (size_t)l * 512 * D, D, 512, D, p.WtPsb + (size_t)l * D * 512, 1, 0, bid, nb, smem);
        transpose_convert(p.p_rwkv + (size_t)l * 512 * D, D, 512, D, p.WtPrw + (size_t)l * D * 512, 1, 0, bid, nb, smem);
        transpose_convert(p.w_out + (size_t)l * D * D, D, D, D, p.WtOut + (size_t)l * D * D, 1, 0, bid, nb, smem);
    }
    convert_experts(p, 0, bid, nb, smem);
}

DI void ln16(float (&v)[16], const float* __restrict__ g, const float* __restrict__ b, int lane) {
    float s = 0.f;
#pragma unroll
    for (int i = 0; i < 16; ++i) s += v[i];
    const float mean = wave_sum(s) * (1.0f / D);
    float q = 0.f;
#pragma unroll
    for (int i = 0; i < 16; ++i) { v[i] -= mean; q += v[i] * v[i]; }
    const float rstd = rsqrtf(wave_sum(q) * (1.0f / D) + 1e-5f);
#pragma unroll
    for (int j = 0; j < 4; ++j) {
        const f32x4 gv = *(const f32x4*)(g + 256 * j + 4 * lane), bv = *(const f32x4*)(b + 256 * j + 4 * lane);
#pragma unroll
        for (int i = 0; i < 4; ++i) v[4 * j + i] = v[4 * j + i] * rstd * gv[i] + bv[i];
    }
}
DI void store_row(float* __restrict__ hf, bf16_t* __restrict__ hb, const float (&v)[16], int lane) {
#pragma unroll
    for (int j = 0; j < 4; ++j) {
        *(f32x4*)(hf + 256 * j + 4 * lane) = (f32x4){v[4 * j], v[4 * j + 1], v[4 * j + 2], v[4 * j + 3]};
        *(u32x2*)(hb + 256 * j + 4 * lane) = (u32x2){pack2(v[4 * j], v[4 * j + 1]), pack2(v[4 * j + 2], v[4 * j + 3])};
    }
}

DI void phase_embed(const Params& p, int bid, int nb) {
    const int lane = tid_() & 63, wid = tid_() >> 6;
    for (int tok = bid * 8 + wid; tok < T; tok += nb * 8) {
        const int b = tok >= L ? 1 : 0, t = tok - b * L;
        const float* src = t < NMETA ? p.meta + (size_t)t * D : p.x + ((size_t)b * SEQ + (t - NMETA)) * D;
        float v[16];
#pragma unroll
        for (int j = 0; j < 4; ++j) { const f32x4 a = *(const f32x4*)(src + 256 * j + 4 * lane); v[4 * j] = a[0]; v[4 * j + 1] = a[1]; v[4 * j + 2] = a[2]; v[4 * j + 3] = a[3]; }
        ln16(v, p.emb_g, p.emb_b, lane);
        store_row(hrow(p, tok), p.hb + (size_t)tok * D, v, lane);
    }
}

constexpr int LDT = 72;
constexpr int GEMM_LDS = 2 * 128 * LDT * 2;
template <class ARow, class Epi>
DI void gemm_tile128(ARow arow, const bf16_t* __restrict__ Bt, int ldb, int K, int m0, int n0, char* smem, Epi epi) {
    const int tid = tid_(), lane = tid & 63, wid = tid >> 6, fr = lane & 15, fq = lane >> 4;
    const int wr = wid >> 1, wc = wid & 1;
    bf16_t* As = (bf16_t*)smem;
    bf16_t* Bs = As + 128 * LDT;
    const bf16_t* ap[2]; const bf16_t* bp[2]; int so[2];
#pragma unroll
    for (int i = 0; i < 2; ++i) {
        const int c = tid + NTHR * i, row = c >> 3, kc = c & 7;
        const bf16_t* ar = arow(m0 + row);
        ap[i] = ar ? ar + kc * 8 : nullptr;
        bp[i] = Bt + (size_t)(n0 + row) * ldb + kc * 8;
        so[i] = row * LDT + kc * 8;
    }
    f32x4 acc[2][4];
#pragma unroll
    for (int mi = 0; mi < 2; ++mi)
#pragma unroll
        for (int ni = 0; ni < 4; ++ni) acc[mi][ni] = (f32x4){0.f, 0.f, 0.f, 0.f};
    u32x4 ra[2], rb[2];
#pragma unroll
    for (int i = 0; i < 2; ++i) { ra[i] = ap[i] ? *(const u32x4*)(ap[i]) : (u32x4){0u, 0u, 0u, 0u}; rb[i] = *(const u32x4*)(bp[i]); }
    for (int k0 = 0; k0 < K; k0 += 64) {
        __syncthreads();
#pragma unroll
        for (int i = 0; i < 2; ++i) { *(u32x4*)(As + so[i]) = ra[i]; *(u32x4*)(Bs + so[i]) = rb[i]; }
        __syncthreads();
        if (k0 + 64 < K) {
#pragma unroll
            for (int i = 0; i < 2; ++i) { ra[i] = ap[i] ? *(const u32x4*)(ap[i] + k0 + 64) : (u32x4){0u, 0u, 0u, 0u}; rb[i] = *(const u32x4*)(bp[i] + k0 + 64); }
        }
#pragma unroll
        for (int ks = 0; ks < 2; ++ks) {
            bf16x8 af[2], bf[4];
#pragma unroll
            for (int mi = 0; mi < 2; ++mi) af[mi] = *(const bf16x8*)(As + (wr * 32 + mi * 16 + fr) * LDT + ks * 32 + fq * 8);
#pragma unroll
            for (int ni = 0; ni < 4; ++ni) bf[ni] = *(const bf16x8*)(Bs + (wc * 64 + ni * 16 + fr) * LDT + ks * 32 + fq * 8);
#pragma unroll
            for (int mi = 0; mi < 2; ++mi)
#pragma unroll
                for (int ni = 0; ni < 4; ++ni) acc[mi][ni] = __builtin_amdgcn_mfma_f32_16x16x32_bf16(bf[ni], af[mi], acc[mi][ni], 0, 0, 0);
        }
    }
#pragma unroll
    for (int mi = 0; mi < 2; ++mi)
#pragma unroll
        for (int ni = 0; ni < 4; ++ni) epi(m0 + wr * 32 + mi * 16 + fr, n0 + wc * 64 + ni * 16 + fq * 4, acc[mi][ni]);
}

DI void phase_inproj(const Params& p, int layer, int bid, int nb, char* smem) {
    const bf16_t* hb = p.hb; bf16_t* P = p.P;
    const bf16_t* Bt = p.WtIn + (size_t)layer * CIN * D;
    constexpr int NT = CP / 128, MT = TP / 128;
    for (int t = bid; t < MT * NT; t += nb) {
        const int m0 = (t / NT) * 128, n0 = (t % NT) * 128;
        gemm_tile128([=](int r) { return r < T ? hb + (size_t)r * D : (const bf16_t*)nullptr; }, Bt, D, D, m0, n0, smem,
                     [=](int r, int c, f32x4 v) { if (r < T) *(u32x2*)(P + (size_t)r * CP + c) = (u32x2){pack2(v[0], v[1]), pack2(v[2], v[3])}; });
    }
}

DI void phase_lora(const Params& p, int layer, int bid, int nb, char* smem) {
    float* xs = (float*)smem;
    const int tid = tid_();
    const float* mu = p.mu + (size_t)layer * RSW + RW_WD;
    const float* w_up = p.w_up + (size_t)layer * 64 * 512, *a_up = p.a_up + (size_t)layer * 64 * 512, *g_up = p.g_up + (size_t)layer * 128 * 512;
    for (int blk = bid; blk < T / 16; blk += nb) {
        const int tok0 = blk * 16;
        __syncthreads();
#pragma unroll
        for (int i = 0; i < 8; ++i) {
            const int idx = tid + NTHR * i, tk = idx >> 8, c = idx & 255, tok = tok0 + tk, t = tok >= L ? tok - L : tok;
            const float xc = bf2f(p.P[(size_t)tok * CP + OFF_RW + RW_WD + c]);
            const float xp = t > 0 ? bf2f(p.P[(size_t)(tok - 1) * CP + OFF_RW + RW_WD + c]) : 0.f;
            float v = xc + (xp - xc) * mu[c];
            if (c < 64) v = tanhf(v); else if (c >= 128) v = sigmoidf_(v);
            xs[tk * 256 + c] = v;
        }
        __syncthreads();
        float aw[16], aa[16], ag[16];
#pragma unroll
        for (int tk = 0; tk < 16; ++tk) { aw[tk] = 0.f; aa[tk] = 0.f; ag[tk] = 0.f; }
        for (int j = 0; j < 64; j += 4) {
            float wv[4], av[4];
#pragma unroll
            for (int jj = 0; jj < 4; ++jj) { wv[jj] = w_up[(j + jj) * 512 + tid]; av[jj] = a_up[(j + jj) * 512 + tid]; }
#pragma unroll
            for (int tk = 0; tk < 16; ++tk) {
                const f32x4 xw = *(const f32x4*)(xs + tk * 256 + j), xa = *(const f32x4*)(xs + tk * 256 + 64 + j);
#pragma unroll
                for (int jj = 0; jj < 4; ++jj) { aw[tk] += xw[jj] * wv[jj]; aa[tk] += xa[jj] * av[jj]; }
            }
        }
        for (int j = 0; j < 128; j += 4) {
            float gv[4];
#pragma unroll
            for (int jj = 0; jj < 4; ++jj) gv[jj] = g_up[(j + jj) * 512 + tid];
#pragma unroll
            for (int tk = 0; tk < 16; ++tk) {
                const f32x4 xg = *(const f32x4*)(xs + tk * 256 + 128 + j);
#pragma unroll
                for (int jj = 0; jj < 4; ++jj) ag[tk] += xg[jj] * gv[jj];
            }
        }
        const float w0 = p.w0[layer * 512 + tid], a0 = p.a0[layer * 512 + tid];
#pragma unroll
        for (int tk = 0; tk < 16; ++tk) {
            const size_t o = (size_t)(tok0 + tk) * 512 + tid;
            p.wdec[o] = f2bf(__expf(-DECAY_SCALE * sigmoidf_(w0 + aw[tk])));
            p.aval[o] = f2bf(sigmoidf_(a0 + aa[tk]));
            p.gval[o] = f2bf(ag[tk]);
        }
    }
}

constexpr int RSTEP = 16;
DI void phase_rwkv_naive(const Params& p, int layer, int bid, int nb, char* smem) {
    const int lane = tid_() & 63, wid = tid_() >> 6;
    if (wid == 0) {
    float* sR = (float*)smem; float* sW = sR + RSTEP * 64; float* sK = sW + RSTEP * 64; float* sKK = sK + RSTEP * 64; float* sB = sKK + RSTEP * 64;
    float* sV = sB + RSTEP * 64; float* sG = sV + RSTEP * 64; float* sBon = sG + RSTEP * 64;
    for (int u = bid; u < NBATCH * HEADS; u += nb) {
        const int b = u / HEADS, h = u % HEADS, c = h * 64 + lane;
        const float mu_r = p.mu[layer * RSW + RW_R + c], mu_k = p.mu[layer * RSW + RW_K + c], mu_v = p.mu[layer * RSW + RW_V + c];
        const float kkc = p.k_k[layer * 512 + c], kac = p.k_a[layer * 512 + c], rkc = p.r_k[layer * 512 + c];
        const float lg = p.lnx_g[layer * 512 + c], lb = p.lnx_b[layer * 512 + c];
        float S[64];
#pragma unroll
        for (int k = 0; k < 64; ++k) S[k] = 0.f;
        float rp = 0.f, kp = 0.f, vp = 0.f;
        for (int t0 = 0; t0 < L; t0 += RSTEP) {
            wave_sync();
            for (int s = 0; s < RSTEP; ++s) {
                const int tok = b * L + t0 + s;
                const bf16_t* pr = p.P + (size_t)tok * CP + OFF_RW;
                const float rc = bf2f(pr[RW_R + c]), kc = bf2f(pr[RW_K + c]), vc = bf2f(pr[RW_V + c]);
                const float r = rc + (rp - rc) * mu_r, kr = kc + (kp - kc) * mu_k, v = vc + (vp - vc) * mu_v;
                rp = rc; kp = kc; vp = vc;
                const float w = bf2f(p.wdec[(size_t)tok * 512 + c]), a = bf2f(p.aval[(size_t)tok * 512 + c]), g = bf2f(p.gval[(size_t)tok * 512 + c]);
                float kk = kr * kkc;
                const float nrm = sqrtf(wave_sum(kk * kk));
                kk = kk / fmaxf(nrm, 1e-12f);
                const float kq = kr * (1.0f + (a - 1.0f) * kac);
                const float bon = wave_sum(r * kq * rkc);
                sR[s * 64 + lane] = r; sW[s * 64 + lane] = w; sK[s * 64 + lane] = kq; sKK[s * 64 + lane] = kk; sB[s * 64 + lane] = kk * a;
                sV[s * 64 + lane] = v; sG[s * 64 + lane] = g; if (lane == 0) sBon[s] = bon;
            }
            wave_sync();
            for (int s = 0; s < RSTEP; ++s) {
                const float v = sV[s * 64 + lane];
                float sa0 = 0.f, sa1 = 0.f, sa2 = 0.f, sa3 = 0.f;
#pragma unroll
                for (int k = 0; k < 64; k += 4) {
                    const f32x4 q = *(const f32x4*)(sKK + s * 64 + k);
                    sa0 += S[k] * q[0]; sa1 += S[k + 1] * q[1]; sa2 += S[k + 2] * q[2]; sa3 += S[k + 3] * q[3];
                }
                const float sa = (sa0 + sa1) + (sa2 + sa3);
                float y0 = 0.f, y1 = 0.f, y2 = 0.f, y3 = 0.f;
#pragma unroll
                for (int k = 0; k < 64; k += 4) {
                    const f32x4 wv = *(const f32x4*)(sW + s * 64 + k), kv = *(const f32x4*)(sK + s * 64 + k), bv = *(const f32x4*)(sB + s * 64 + k), rv = *(const f32x4*)(sR + s * 64 + k);
                    S[k] = S[k] * wv[0] + (v * kv[0] - sa * bv[0]); y0 += S[k] * rv[0];
                    S[k + 1] = S[k + 1] * wv[1] + (v * kv[1] - sa * bv[1]); y1 += S[k + 1] * rv[1];
                    S[k + 2] = S[k + 2] * wv[2] + (v * kv[2] - sa * bv[2]); y2 += S[k + 2] * rv[2];
                    S[k + 3] = S[k + 3] * wv[3] + (v * kv[3] - sa * bv[3]); y3 += S[k + 3] * rv[3];
                }
                const float y = (y0 + y1) + (y2 + y3);
                const float mean = wave_sum(y) * (1.0f / 64.f), d = y - mean;
                const float var = wave_sum(d * d) * (1.0f / 64.f);
                const float yn = d * rsqrtf(var + 64e-5f);
                const float o = (yn * lg + lb + sBon[s] * v) * sG[s * 64 + lane];
                p.orw[(size_t)(b * L + t0 + s) * 512 + c] = f2bf(o);
            }
        }
    }
    }
}

DI void phase_sb_naive(const Params& p, int bid, int nb) {
    constexpr int QB = NTHR / 2, NTB = (L + QB - 1) / QB;
    const int half = tid_() & 1;
    for (int u = bid; u < NBATCH * HEADS * NTB; u += nb) {
        const int tb = u / (NBATCH * HEADS), bh = u % (NBATCH * HEADS), b = bh / HEADS, h = bh % HEADS;
        const int t = tb * QB + (tid_() >> 1);
        const bool live = t < L;
        const size_t tok = (size_t)b * L + (live ? t : 0);
        float q[32], acc[32];
        {
            const bf16_t* qp = p.P + tok * CP + OFF_Q + h * 64 + half * 32;
#pragma unroll
            for (int i = 0; i < 4; ++i) {
                const u32x4 v = *(const u32x4*)(qp + 8 * i);
#pragma unroll
                for (int j = 0; j < 4; ++j) { q[8 * i + 2 * j] = lo_bf(v[j]) * 0.125f; q[8 * i + 2 * j + 1] = hi_bf(v[j]) * 0.125f; }
            }
        }
#pragma unroll
        for (int i = 0; i < 32; ++i) acc[i] = 0.f;
        float R = 0.f;
        for (int s = live ? t - 1 : -1; s >= 0; --s) {
            const bf16_t* kp = p.P + ((size_t)b * L + s) * CP + OFF_K + h * 64 + half * 32;
            float z0 = 0.f, z1 = 0.f;
#pragma unroll
            for (int i = 0; i < 4; ++i) {
                const u32x4 v = *(const u32x4*)(kp + 8 * i);
#pragma unroll
                for (int j = 0; j < 4; ++j) { z0 += q[8 * i + 2 * j] * lo_bf(v[j]); z1 += q[8 * i + 2 * j + 1] * hi_bf(v[j]); }
            }
            float z = z0 + z1;
            z += __shfl_xor(z, 1);
            const float l1 = __logf(1.0f + __expf(-fabsf(z)));
            const float lsneg = -(fmaxf(z, 0.f) + l1);
            const float A = __expf(lsneg + z + R);
            const bf16_t* vp = kp + (OFF_V - OFF_K);
#pragma unroll
            for (int i = 0; i < 4; ++i) {
                const u32x4 v = *(const u32x4*)(vp + 8 * i);
#pragma unroll
                for (int j = 0; j < 4; ++j) { acc[8 * i + 2 * j] += A * lo_bf(v[j]); acc[8 * i + 2 * j + 1] += A * hi_bf(v[j]); }
            }
            R += lsneg;
            if (R < -104.0f) break;
        }
        if (live) {
            bf16_t* op = p.osb + tok * 512 + h * 64 + half * 32;
#pragma unroll
            for (int i = 0; i < 4; ++i) {
                u32x4 o;
#pragma unroll
                for (int j = 0; j < 4; ++j) o[j] = pack2(acc[8 * i + 2 * j], acc[8 * i + 2 * j + 1]);
                *(u32x4*)(op + 8 * i) = o;
            }
        }
    }
}

DI void phase_gates(const Params& p, int layer, int bid, int nb, char* smem) {
    const bf16_t* hb = p.hb; bf16_t* G = p.gates;
    const bf16_t* Bt = p.WtIn + ((size_t)layer * CIN + CP) * D;
    constexpr int NT = 2048 / 128, MT = TP / 128;
    for (int t = bid; t < MT * NT; t += nb) {
        const int m0 = (t / NT) * 128, n0 = (t % NT) * 128;
        gemm_tile128([=](int r) { return r < T ? hb + (size_t)r * D : (const bf16_t*)nullptr; }, Bt, D, D, m0, n0, smem,
                     [=](int r, int c, f32x4 v) { if (r < T) *(u32x2*)(G + (size_t)r * 2048 + c) = (u32x2){pack2(sigmoidf_(v[0]), sigmoidf_(v[1])), pack2(sigmoidf_(v[2]), sigmoidf_(v[3]))}; });
    }
}
DI void phase_branch(const Params& p, int layer, int which, int bid, int nb, char* smem) {
    const bf16_t* A = which ? p.orw : p.osb; const bf16_t* G = p.gates + which * 1024; bf16_t* M = p.merged;
    const bf16_t* Bt = (which ? p.WtPrw : p.WtPsb) + (size_t)layer * D * 512;
    constexpr int NT = D / 128, MT = TP / 128;
    for (int t = bid; t < MT * NT; t += nb) {
        const int m0 = (t / NT) * 128, n0 = (t % NT) * 128;
        gemm_tile128([=](int r) { return r < T ? A + (size_t)r * 512 : (const bf16_t*)nullptr; }, Bt, 512, 512, m0, n0, smem,
                     [=](int r, int c, f32x4 v) {
                         if (r >= T) return;
                         const u32x2 g = *(const u32x2*)(G + (size_t)r * 2048 + c);
                         float o0 = lo_bf(g[0]) * v[0], o1 = hi_bf(g[0]) * v[1], o2 = lo_bf(g[1]) * v[2], o3 = hi_bf(g[1]) * v[3];
                         u32x2* mp = (u32x2*)(M + (size_t)r * D + c);
                         if (which) { const u32x2 m = *mp; o0 += lo_bf(m[0]); o1 += hi_bf(m[0]); o2 += lo_bf(m[1]); o3 += hi_bf(m[1]); }
                         *mp = (u32x2){pack2(o0, o1), pack2(o2, o3)};
                     });
    }
}
DI void phase_outproj(const Params& p, int layer, int bid, int nb, char* smem) {
    const bf16_t* A = p.merged; float* const hmeta = p.hmeta; float* const outp = p.out;
    const bf16_t* Bt = p.WtOut + (size_t)layer * D * D;
    constexpr int NT = D / 128, MT = TP / 128;
    if (bid == 0 && tid_() < NE) p.counts[tid_()] = 0;
    for (int t = bid; t < MT * NT; t += nb) {
        const int m0 = (t / NT) * 128, n0 = (t % NT) * 128;
        gemm_tile128([=](int r) { return r < T ? A + (size_t)r * D : (const bf16_t*)nullptr; }, Bt, D, D, m0, n0, smem,
                     [=](int r, int c, f32x4 v) {
                         if (r >= T) return;
                         f32x4* hp = (f32x4*)(hrow2(hmeta, outp, r) + c);
                         const f32x4 h = *hp;
                         *hp = (f32x4){ALPHA * h[0] + v[0], ALPHA * h[1] + v[1], ALPHA * h[2] + v[2], ALPHA * h[3] + v[3]};
                     });
    }
}

DI void phase_ln1_router(const Params& p, int layer, int bid, int nb) {
    const int lane = tid_() & 63, wid = tid_() >> 6;
    for (int tok = bid * 8 + wid; tok < T; tok += nb * 8) {
        float* hf = hrow(p, tok);
        float v[16];
#pragma unroll
        for (int j = 0; j < 4; ++j) { const f32x4 a = *(const f32x4*)(hf + 256 * j + 4 * lane); v[4 * j] = a[0]; v[4 * j + 1] = a[1]; v[4 * j + 2] = a[2]; v[4 * j + 3] = a[3]; }
        ln16(v, p.ln1_g + layer * D, p.ln1_b + layer * D, lane);
        store_row(hf, p.hb + (size_t)tok * D, v, lane);
        float lg[16];
#pragma unroll
        for (int e = 0; e < 16; ++e) lg[e] = 0.f;
#pragma unroll
        for (int j = 0; j < 4; ++j)
#pragma unroll
            for (int i = 0; i < 4; ++i) {
                const float* rw = p.router_w + (size_t)(256 * j + 4 * lane + i) * NE;
#pragma unroll
                for (int e4 = 0; e4 < 4; ++e4) {
                    const f32x4 w = *(const f32x4*)(rw + 4 * e4);
#pragma unroll
                    for (int q = 0; q < 4; ++q) lg[4 * e4 + q] += v[4 * j + i] * w[q];
                }
            }
        float mx = -3.0e38f;
#pragma unroll
        for (int e = 0; e < 16; ++e) { lg[e] = wave_sum(lg[e]) + p.router_b[e]; mx = fmaxf(mx, lg[e]); }
        float sum = 0.f;
#pragma unroll
        for (int e = 0; e < 16; ++e) { lg[e] = __expf(lg[e] - mx); sum += lg[e]; }
        const float inv = 1.0f / sum;
        float bs = -1.f, bv1 = 0.f, bv2 = 0.f; int be1 = 0, be2 = 1;
#pragma unroll
        for (int g = 0; g < 4; ++g) {
            float v1 = -1.f, v2 = -1.f; int i1 = 0, i2 = 0;
#pragma unroll
            for (int i = 0; i < 4; ++i) {
                const float pv = lg[4 * g + i] * inv;
                if (pv > v1) { v2 = v1; i2 = i1; v1 = pv; i1 = i; } else if (pv > v2) { v2 = pv; i2 = i; }
            }
            const float sc = v1 + v2;
            if (sc > bs) { bs = sc; bv1 = v1; bv2 = v2; be1 = 4 * g + i1; be2 = 4 * g + i2; }
        }
        if (lane == 0) {
            const float gs = 1.0f / (bv1 + bv2);
            const int s1 = atomicAdd(&p.counts[be1], 1), s2 = atomicAdd(&p.counts[be2], 1);
            p.list[be1 * T + s1] = tok * 2; p.list[be2 * T + s2] = tok * 2 + 1;
            p.tokg[tok * 2] = bv1 * gs; p.tokg[tok * 2 + 1] = bv2 * gs;
        }
    }
}

struct MoeTile { int e, slot0, off, cnt, total; };
DI MoeTile moe_tile(const int* counts, int tm) {
    MoeTile r; r.e = -1; r.slot0 = 0; r.off = 0; r.cnt = 0;
    int start = 0, off = 0;
#pragma unroll
    for (int e = 0; e < NE; ++e) {
        const int c = counts[e], nt = (c + 127) >> 7;
        if (tm >= start && tm < start + nt) { r.e = e; r.slot0 = (tm - start) * 128; r.off = off; r.cnt = c; }
        start += nt; off += c;
    }
    r.total = start;
    return r;
}
DI void phase_moe_up(const Params& p, int bid, int nb, char* smem) {
    const bf16_t* hb = p.hb; bf16_t* hid = p.hid; const int* list = p.list;
    const int total = moe_tile(p.counts, 0).total;
    for (int t = bid; t < total * 8; t += nb) {
        const MoeTile mt = moe_tile(p.counts, t >> 3);
        const int n0 = (t & 7) * 128, e = mt.e, slot0 = mt.slot0, cnt = mt.cnt, off = mt.off;
        gemm_tile128([=](int r) { const int s = slot0 + r; return s < cnt ? hb + (size_t)(list[e * T + s] >> 1) * D : (const bf16_t*)nullptr; },
                     p.WtGU + (size_t)e * 1024 * 1024, D, D, 0, n0, smem,
                     [=](int r, int c, f32x4 v) {
                         const int s = slot0 + r;
                         if (s >= cnt) return;
                         const float h0 = v[0] * sigmoidf_(v[0]) * v[1], h1 = v[2] * sigmoidf_(v[2]) * v[3];
                         *(unsigned*)(hid + (size_t)(off + s) * DE + (c >> 1)) = pack2(h0, h1);
                     });
    }
}
DI void phase_moe_down(const Params& p, int bid, int nb, char* smem) {
    const bf16_t* hid = p.hid; bf16_t* fo = p.fo; const int* list = p.list; const float* tokg = p.tokg;
    const int total = moe_tile(p.counts, 0).total;
    for (int t = bid; t < total * 8; t += nb) {
        const MoeTile mt = moe_tile(p.counts, t >> 3);
        const int n0 = (t & 7) * 128, e = mt.e, slot0 = mt.slot0, cnt = mt.cnt, off = mt.off;
        gemm_tile128([=](int r) { const int s = slot0 + r; return s < cnt ? hid + (size_t)(off + s) * DE : (const bf16_t*)nullptr; },
                     p.WtD + (size_t)e * 1024 * 512, DE, DE, 0, n0, smem,
                     [=](int r, int c, f32x4 v) {
                         const int s = slot0 + r;
                         if (s >= cnt) return;
                         const int ent = list[e * T + s], tok = ent >> 1, kc = ent & 1;
                         const float g = tokg[ent];
                         *(u32x2*)(fo + ((size_t)kc * TP + tok) * D + c) = (u32x2){pack2(g * v[0], g * v[1]), pack2(g * v[2], g * v[3])};
                     });
    }
}
DI void phase_ln2(const Params& p, int layer, int bid, int nb) {
    const int lane = tid_() & 63, wid = tid_() >> 6;
    for (int tok = bid * 8 + wid; tok < T; tok += nb * 8) {
        float* hf = hrow(p, tok);
        float v[16];
#pragma unroll
        for (int j = 0; j < 4; ++j) {
            const f32x4 a = *(const f32x4*)(hf + 256 * j + 4 * lane);
            const u32x2 f0 = *(const u32x2*)(p.fo + (size_t)tok * D + 256 * j + 4 * lane), f1 = *(const u32x2*)(p.fo + ((size_t)TP + tok) * D + 256 * j + 4 * lane);
            v[4 * j] = ALPHA * a[0] + lo_bf(f0[0]) + lo_bf(f1[0]); v[4 * j + 1] = ALPHA * a[1] + hi_bf(f0[0]) + hi_bf(f1[0]);
            v[4 * j + 2] = ALPHA * a[2] + lo_bf(f0[1]) + lo_bf(f1[1]); v[4 * j + 3] = ALPHA * a[3] + hi_bf(f0[1]) + hi_bf(f1[1]);
        }
        ln16(v, p.ln2_g + layer * D, p.ln2_b + layer * D, lane);
        store_row(hf, p.hb + (size_t)tok * D, v, lane);
    }
}

extern __shared__ __attribute__((aligned(16))) char dyn_smem[];
constexpr int SMEM_BYTES = GEMM_LDS + 16;

__global__ void __launch_bounds__(NTHR, 2) k_forward(Params p) {
    const int bid = blockIdx.x, nb = gridDim.x;
    char* smem = dyn_smem;
    uint4* xbw = (uint4*)(dyn_smem + GEMM_LDS);
    if (threadIdx.x == 0) *xbw = make_uint4(0u, 0u, 0u, 0u);
    __syncthreads();
    XcdBarrier bar = xcd_barrier_post(p.bar, (volatile LAS unsigned*)xbw);
    phase_prologue_weights(p, bid, nb, smem);
    phase_embed(p, bid, nb);
    xcd_barrier(bar);
    for (int l = 0; l < DEPTH; ++l) {
        phase_inproj(p, l, bid, nb, smem);
        xcd_barrier(bar);
        phase_lora(p, l, bid, nb, smem);
        xcd_barrier(bar);
        if (bid < NBATCH * HEADS) phase_rwkv_naive(p, l, bid, NBATCH * HEADS, smem);
        else phase_sb_naive(p, bid - NBATCH * HEADS, nb - NBATCH * HEADS);
        xcd_barrier(bar);
        phase_gates(p, l, bid, nb, smem);
        xcd_barrier(bar);
        phase_branch(p, l, 0, bid, nb, smem);
        xcd_barrier(bar);
        phase_branch(p, l, 1, bid, nb, smem);
        xcd_barrier(bar);
        phase_outproj(p, l, bid, nb, smem);
        xcd_barrier(bar);
        phase_ln1_router(p, l, bid, nb);
        xcd_barrier(bar);
        phase_moe_up(p, bid, nb, smem);
        xcd_barrier(bar);
        phase_moe_down(p, bid, nb, smem);
        xcd_barrier(bar);
        if (l + 1 < DEPTH) convert_experts(p, l + 1, bid, nb, smem);
        phase_ln2(p, l, bid, nb);
        xcd_barrier(bar);
    }
}

extern "C" void kernel_launch(void* const* d_in, const int* in_sizes, int n_in, void* d_out, int out_size, void* d_ws, size_t ws_size, hipStream_t stream) {
    (void)in_sizes; (void)n_in; (void)out_size;
    Params p;
    memset(&p, 0, sizeof(p));
    const float* const* in = (const float* const*)d_in;
    p.x = in[0]; p.meta = in[1]; p.emb_g = in[2]; p.emb_b = in[3]; p.w_in = in[4]; p.mu = in[5]; p.w0 = in[6]; p.w_up = in[7]; p.a0 = in[8]; p.a_up = in[9];
    p.g_up = in[10]; p.k_k = in[11]; p.k_a = in[12]; p.r_k = in[13]; p.lnx_g = in[14]; p.lnx_b = in[15]; p.p_sb = in[16]; p.p_rwkv = in[17]; p.w_out = in[18];
    p.ln1_g = in[19]; p.ln1_b = in[20]; p.router_w = in[21]; p.router_b = in[22]; p.ew_gate = in[23]; p.ew_up = in[24]; p.ew_down = in[25]; p.ln2_g = in[26]; p.ln2_b = in[27];
    p.out = (float*)d_out;
    char* ws = (char*)d_ws; size_t o = 0;
    auto take = [&](size_t bytes) { char* r = ws + o; o += (bytes + 255) & ~(size_t)255; return r; };
    p.bar = (unsigned*)take(XCD_BAR_WORDS * sizeof(unsigned));
    p.counts = (int*)take(256);
    p.WtIn = (bf16_t*)take((size_t)DEPTH * CIN * D * 2);
    p.WtPsb = (bf16_t*)take((size_t)DEPTH * D * 512 * 2);
    p.WtPrw = (bf16_t*)take((size_t)DEPTH * D * 512 * 2);
    p.WtOut = (bf16_t*)take((size_t)DEPTH * D * D * 2);
    p.WtGU = (bf16_t*)take((size_t)NE * 1024 * 1024 * 2);
    p.WtD = (bf16_t*)take((size_t)NE * 1024 * 512 * 2);
    p.hb = (bf16_t*)take((size_t)TP * D * 2);
    p.hmeta = (float*)take((size_t)NBATCH * NMETA * D * 4);
    p.P = (bf16_t*)take((size_t)TP * CP * 2);
    p.osb = (bf16_t*)take((size_t)TP * 512 * 2);
    p.orw = (bf16_t*)take((size_t)TP * 512 * 2);
    p.wdec = (bf16_t*)take((size_t)T * 512 * 2);
    p.aval = (bf16_t*)take((size_t)T * 512 * 2);
    p.gval = (bf16_t*)take((size_t)T * 512 * 2);
    p.list = (int*)take((size_t)NE * T * 4);
    p.tokg = (float*)take((size_t)T * 2 * 4);
    p.gates = p.P;
    p.merged = p.P + (size_t)TP * 2048;
    p.hid = p.P;
    p.fo = p.P + (size_t)(2 * T + 128) * DE;
    if (o > ws_size) return;
    static int grid = 0;
    if (!grid) {
        int dev = 0, cus = 0, per_cu = 0;
        hipGetDevice(&dev);
        hipDeviceGetAttribute(&cus, hipDeviceAttributeMultiprocessorCount, dev);
        hipOccupancyMaxActiveBlocksPerMultiprocessor(&per_cu, k_forward, NTHR, SMEM_BYTES);
        grid = per_cu >= 1 ? cus : 0;
    }
    if (!grid) return;
    hipMemsetAsync(p.bar, 0, XCD_BAR_WORDS * sizeof(unsigned), stream);
    hipLaunchKernelGGL(k_forward, dim3(grid), dim3(NTHR), SMEM_BYTES, stream, p);
}
```

```cpp
#include <hip/hip_runtime.h>
#include <stdint.h>
#include <string.h>

#define DI __device__ __forceinline__
typedef unsigned short bf16_t;
typedef short bf16x8 __attribute__((ext_vector_type(8)));
typedef float f32x4 __attribute__((ext_vector_type(4)));
typedef unsigned u32x4 __attribute__((ext_vector_type(4)));
typedef unsigned u32x2 __attribute__((ext_vector_type(2)));

constexpr int D = 1024, NBATCH = 2, SEQ = 8192, NMETA = 16, L = SEQ + NMETA, T = NBATCH * L, TP = 16640;
constexpr int DEPTH = 2, HEADS = 8, HD = 64;
constexpr int CIN = 5376, CP = 3328;
constexpr int OFF_Q = 0, OFF_K = 512, OFF_V = 1024, OFF_RW = 1536;
constexpr int RW_R = 0, RW_K = 512, RW_V = 1024, RW_WD = 1536, RW_AD = 1600, RW_GD = 1664, RSW = 1792;
constexpr int NE = 16, DE = 512;
constexpr float ALPHA = 1.41421356237309515f;
constexpr float DECAY_SCALE = 0.60653065971263342f;
constexpr int NTHR = 512;

#define XB_TMO      128
#define XB_XCNT(j)  (256  + 64 * (j))
#define XB_XSUB(j)  (1280 + 64 * (j))
#define XB_XGEN(j)  (2304 + 64 * (j))
#define XB_TOP      3328
#define XB_TOPGEN   3392
#define XCD_BAR_WORDS 3456
#define XB_SPIN_CAP (1u << 18)
#define LAS __attribute__((address_space(3)))

__device__ __forceinline__ unsigned xb_ld(unsigned* p)              { return __hip_atomic_load(p, __ATOMIC_RELAXED, __HIP_MEMORY_SCOPE_AGENT); }
__device__ __forceinline__ unsigned xb_add(unsigned* p, unsigned v) { return __hip_atomic_fetch_add(p, v, __ATOMIC_RELAXED, __HIP_MEMORY_SCOPE_AGENT); }
__device__ __forceinline__ unsigned xb_xcc_id() { return (unsigned)__builtin_amdgcn_s_getreg((3 << 11) | 20) & 0xFu; }
#define XB_SPIN(cond, bar) do { unsigned _sp = 0; while (cond) { __builtin_amdgcn_s_sleep(1); \
    if ((++_sp & 255u) == 0u) { if (xb_ld(&(bar)[XB_TMO])) break; if (_sp > XB_SPIN_CAP) { atomicAdd(&(bar)[XB_TMO], 1u); break; } } } } while (0)

struct XcdBarrier {
    unsigned* bar; unsigned x;
    volatile LAS unsigned* st;
};

__device__ __forceinline__ XcdBarrier xcd_barrier_post(unsigned* bar, volatile LAS unsigned* st) {
    XcdBarrier b; b.bar = bar; b.x = xb_xcc_id(); b.st = st;
    if (threadIdx.x == 0) (void)xb_add(&bar[XB_XCNT(b.x)], 1u);
    return b;
}
__device__ __forceinline__ void xcd_barrier_complete(unsigned* bar, unsigned x, unsigned& nloc, unsigned& nx) {
    const unsigned G = gridDim.x * gridDim.y * gridDim.z;
    unsigned sum, cnt, mine, sp = 0u;
    for (;;) {
        sum = 0u; cnt = 0u; mine = 0u;
#pragma unroll
        for (unsigned j = 0; j < 16; ++j) { const unsigned c = xb_ld(&bar[XB_XCNT(j)]); sum += c; cnt += (c > 0u) ? 1u : 0u; mine = (j == x) ? c : mine; }
        if (sum == G) break;
        __builtin_amdgcn_s_sleep(1);
        if ((++sp & 255u) == 0u) { if (xb_ld(&bar[XB_TMO])) break; if (sp > XB_SPIN_CAP) { atomicAdd(&bar[XB_TMO], 1u); break; } }
    }
    nloc = mine > 0u ? mine : 1u; nx = cnt > 0u ? cnt : 1u;
}

__device__ __forceinline__ void xcd_barrier(const XcdBarrier& b) {
    asm volatile("s_waitcnt vmcnt(0)" ::: "memory");
    __syncthreads();
    if (threadIdx.x == 0) {
        unsigned* bar = b.bar;
        __builtin_amdgcn_s_waitcnt(0);
        unsigned nloc = b.st[0], nx = b.st[1];
        if (nloc == 0u) { xcd_barrier_complete(bar, b.x, nloc, nx); b.st[0] = nloc; b.st[1] = nx; }
        const unsigned old = xb_add(&bar[XB_XSUB(b.x)], 1u);
        const unsigned gen = old / nloc;
        if (old + 1u == (gen + 1u) * nloc) {
            __builtin_amdgcn_fence(__ATOMIC_RELEASE, "agent");
            asm volatile("s_waitcnt vmcnt(0)" ::: "memory");
            const unsigned og = xb_add(&bar[XB_TOP], 1u);
            const unsigned tg = og / nx;
            if (og + 1u == (tg + 1u) * nx) xb_add(&bar[XB_TOPGEN], 1u);
            else XB_SPIN(xb_ld(&bar[XB_TOPGEN]) == tg, bar);
            __builtin_amdgcn_fence(__ATOMIC_ACQUIRE, "agent");
            xb_add(&bar[XB_XGEN(b.x)], 1u);
            asm volatile("s_waitcnt vmcnt(0)" ::: "memory");
        } else {
            XB_SPIN(xb_ld(&bar[XB_XGEN(b.x)]) == gen, bar);
            __builtin_amdgcn_fence(__ATOMIC_ACQUIRE, "agent");
            asm volatile("s_waitcnt vmcnt(0)" ::: "memory");
        }
    }
    __syncthreads();
}


struct Params {
    const float *x, *meta, *emb_g, *emb_b, *w_in, *mu, *w0, *w_up, *a0, *a_up, *g_up, *k_k, *k_a, *r_k, *lnx_g, *lnx_b, *p_sb, *p_rwkv, *w_out,
        *ln1_g, *ln1_b, *router_w, *router_b, *ew_gate, *ew_up, *ew_down, *ln2_g, *ln2_b;
    float* out;
    unsigned* bar;
    int* counts;
    bf16_t *WtIn, *WtPsb, *WtPrw, *WtOut, *WtGU, *WtD, *hb, *P, *osb, *orw, *WupT, *AupT, *GupT;
    bf16_t *PcG, *QcG, *RhG, *Y0G, *GG, *SG;
    float* bonG;
    float* hmeta;
    bf16_t *gates, *merged, *hid, *fo;
    int* list;
    float* tokg;
};

DI float bf2f(bf16_t v) { return __uint_as_float((unsigned)v << 16); }
typedef __bf16 bf16x2_t __attribute__((ext_vector_type(2)));
DI bf16_t f2bf(float f) { return __builtin_bit_cast(bf16_t, (__bf16)f); }
DI unsigned pack2(float lo, float hi) { bf16x2_t v = {(__bf16)lo, (__bf16)hi}; return __builtin_bit_cast(unsigned, v); }
DI float lo_bf(unsigned u) { return __uint_as_float(u << 16); }
DI float hi_bf(unsigned u) { return __uint_as_float(u & 0xFFFF0000u); }
DI float wave_sum(float v) {
#pragma unroll
    for (int m = 32; m >= 1; m >>= 1) v += __shfl_xor(v, m);
    return v;
}
DI int tid_() { int t = threadIdx.x; asm volatile("" : "+v"(t)); return t; }
DI float sigmoidf_(float x) { return 1.0f / (1.0f + __expf(-x)); }
DI void wave_sync() { asm volatile("s_waitcnt lgkmcnt(0)" ::: "memory"); __builtin_amdgcn_wave_barrier(); }

DI float* hrow2(float* hmeta, float* out, int tok) {
    const int b = tok >= L ? 1 : 0, t = tok - b * L;
    return t < NMETA ? hmeta + (size_t)(b * NMETA + t) * D : out + ((size_t)b * SEQ + (t - NMETA)) * D;
}
DI float* hrow(const Params& p, int tok) { return hrow2(p.hmeta, p.out, tok); }

DI void transpose_convert(const float* __restrict__ src, int ld, int K, int N, bf16_t* __restrict__ dst, int mult, int off, int bid, int nb, char* smem) {
    float* tile = (float*)smem;
    const int tk = K / 64, tn = N / 64, tid = tid_();
    for (int t = bid; t < tk * tn; t += nb) {
        const int k0 = (t / tn) * 64, n0 = (t % tn) * 64;
        __syncthreads();
#pragma unroll
        for (int i = 0; i < 2; ++i) {
            const int k = (tid >> 4) + 32 * i, n4 = (tid & 15) * 4;
            const f32x4 v = *(const f32x4*)(src + (size_t)(k0 + k) * ld + n0 + n4);
            tile[k * 65 + n4 + 0] = v[0]; tile[k * 65 + n4 + 1] = v[1]; tile[k * 65 + n4 + 2] = v[2]; tile[k * 65 + n4 + 3] = v[3];
        }
        __syncthreads();
        const int n = tid >> 3, kc = (tid & 7) * 8;
        u32x4 o;
#pragma unroll
        for (int j = 0; j < 4; ++j) o[j] = pack2(tile[(kc + 2 * j) * 65 + n], tile[(kc + 2 * j + 1) * 65 + n]);
        *(u32x4*)(dst + (size_t)((n0 + n) * mult + off) * K + k0 + kc) = o;
    }
}

DI void convert_experts(const Params& p, int layer, int bid, int nb, char* smem) {
    for (int e = 0; e < NE; ++e) {
        const size_t eo = ((size_t)layer * NE + e) * (size_t)D * DE;
        transpose_convert(p.ew_gate + eo, DE, D, DE, p.WtGU + (size_t)e * 1024 * 1024, 2, 0, bid, nb, smem);
        transpose_convert(p.ew_up + eo, DE, D, DE, p.WtGU + (size_t)e * 1024 * 1024, 2, 1, bid, nb, smem);
        transpose_convert(p.ew_down + eo, D, DE, D, p.WtD + (size_t)e * 1024 * 512, 1, 0, bid, nb, smem);
    }
}

DI void phase_prologue_weights(const Params& p, int bid, int nb, char* smem) {
    for (int l = 0; l < DEPTH; ++l) {
        transpose_convert(p.w_in + (size_t)l * D * CIN, CIN, D, CIN, p.WtIn + (size_t)l * CIN * D, 1, 0, bid, nb, smem);
        transpose_convert(p.p_sb + (size_t)l * 512 * D, D, 512, D, p.WtPsb + (size_t)l * D * 512, 1, 0, bid, nb, smem);
        transpose_convert(p.p_rwkv + (size_t)l * 512 * D, D, 512, D, p.WtPrw + (size_t)l * D * 512, 1, 0, bid, nb, smem);
        transpose_convert(p.w_out + (size_t)l * D * D, D, D, D, p.WtOut + (size_t)l * D * D, 1, 0, bid, nb, smem);
        transpose_convert(p.w_up + (size_t)l * 64 * 512, 512, 64, 512, p.WupT + (size_t)l * 512 * 64, 1, 0, bid, nb, smem);
        transpose_convert(p.a_up + (size_t)l * 64 * 512, 512, 64, 512, p.AupT + (size_t)l * 512 * 64, 1, 0, bid, nb, smem);
        transpose_convert(p.g_up + (size_t)l * 128 * 512, 512, 128, 512, p.GupT + (size_t)l * 512 * 128, 1, 0, bid, nb, smem);
    }
}

DI void ln16(float (&v)[16], const float* __restrict__ g, const float* __restrict__ b, int lane) {
    float s = 0.f;
#pragma unroll
    for (int i = 0; i < 16; ++i) s += v[i];
    const float mean = wave_sum(s) * (1.0f / D);
    float q = 0.f;
#pragma unroll
    for (int i = 0; i < 16; ++i) { v[i] -= mean; q += v[i] * v[i]; }
    const float rstd = rsqrtf(wave_sum(q) * (1.0f / D) + 1e-5f);
#pragma unroll
    for (int j = 0; j < 4; ++j) {
        const f32x4 gv = *(const f32x4*)(g + 256 * j + 4 * lane), bv = *(const f32x4*)(b + 256 * j + 4 * lane);
#pragma unroll
        for (int i = 0; i < 4; ++i) v[4 * j + i] = v[4 * j + i] * rstd * gv[i] + bv[i];
    }
}
DI void store_row(float* __restrict__ hf, bf16_t* __restrict__ hb, const float (&v)[16], int lane) {
#pragma unroll
    for (int j = 0; j < 4; ++j) {
        *(f32x4*)(hf + 256 * j + 4 * lane) = (f32x4){v[4 * j], v[4 * j + 1], v[4 * j + 2], v[4 * j + 3]};
        *(u32x2*)(hb + 256 * j + 4 * lane) = (u32x2){pack2(v[4 * j], v[4 * j + 1]), pack2(v[4 * j + 2], v[4 * j + 3])};
    }
}

DI void phase_embed(const Params& p, int bid, int nb) {
    const int lane = tid_() & 63, wid = __builtin_amdgcn_readfirstlane(tid_() >> 6);
    for (int tok = bid * 8 + wid; tok < T; tok += nb * 8) {
        const int b = tok >= L ? 1 : 0, t = tok - b * L;
        const float* src = t < NMETA ? p.meta + (size_t)t * D : p.x + ((size_t)b * SEQ + (t - NMETA)) * D;
        float v[16];
#pragma unroll
        for (int j = 0; j < 4; ++j) { const f32x4 a = *(const f32x4*)(src + 256 * j + 4 * lane); v[4 * j] = a[0]; v[4 * j + 1] = a[1]; v[4 * j + 2] = a[2]; v[4 * j + 3] = a[3]; }
        ln16(v, p.emb_g, p.emb_b, lane);
        store_row(hrow(p, tok), p.hb + (size_t)tok * D, v, lane);
    }
}

constexpr int LDT = 72;
constexpr int GEMM_LDS = 2 * 128 * LDT * 2;
template <class ARow, class Epi>
DI void gemm_tile128(ARow arow, const bf16_t* __restrict__ Bt, int ldb, int K, int m0, int n0, char* smem, Epi epi) {
    const int tid = tid_(), lane = tid & 63, wid = __builtin_amdgcn_readfirstlane(tid >> 6), fr = lane & 15, fq = lane >> 4;
    const int wr = wid >> 1, wc = wid & 1;
    bf16_t* As = (bf16_t*)smem;
    bf16_t* Bs = As + 128 * LDT;
    const bf16_t* ap[2]; const bf16_t* bp[2]; int so[2];
#pragma unroll
    for (int i = 0; i < 2; ++i) {
        const int c = tid + NTHR * i, row = c >> 3, kc = c & 7;
        const bf16_t* ar = arow(m0 + row);
        ap[i] = ar ? ar + kc * 8 : nullptr;
        bp[i] = Bt + (size_t)(n0 + row) * ldb + kc * 8;
        so[i] = row * LDT + kc * 8;
    }
    f32x4 acc[2][4];
#pragma unroll
    for (int mi = 0; mi < 2; ++mi)
#pragma unroll
        for (int ni = 0; ni < 4; ++ni) acc[mi][ni] = (f32x4){0.f, 0.f, 0.f, 0.f};
    u32x4 ra[2], rb[2];
#pragma unroll
    for (int i = 0; i < 2; ++i) { ra[i] = ap[i] ? *(const u32x4*)(ap[i]) : (u32x4){0u, 0u, 0u, 0u}; rb[i] = *(const u32x4*)(bp[i]); }
    for (int k0 = 0; k0 < K; k0 += 64) {
        __syncthreads();
#pragma unroll
        for (int i = 0; i < 2; ++i) { *(u32x4*)(As + so[i]) = ra[i]; *(u32x4*)(Bs + so[i]) = rb[i]; }
        __syncthreads();
        if (k0 + 64 < K) {
#pragma unroll
            for (int i = 0; i < 2; ++i) { ra[i] = ap[i] ? *(const u32x4*)(ap[i] + k0 + 64) : (u32x4){0u, 0u, 0u, 0u}; rb[i] = *(const u32x4*)(bp[i] + k0 + 64); }
        }
#pragma unroll
        for (int ks = 0; ks < 2; ++ks) {
            bf16x8 af[2], bf[4];
#pragma unroll
            for (int mi = 0; mi < 2; ++mi) af[mi] = *(const bf16x8*)(As + (wr * 32 + mi * 16 + fr) * LDT + ks * 32 + fq * 8);
#pragma unroll
            for (int ni = 0; ni < 4; ++ni) bf[ni] = *(const bf16x8*)(Bs + (wc * 64 + ni * 16 + fr) * LDT + ks * 32 + fq * 8);
#pragma unroll
            for (int mi = 0; mi < 2; ++mi)
#pragma unroll
                for (int ni = 0; ni < 4; ++ni) acc[mi][ni] = __builtin_amdgcn_mfma_f32_16x16x32_bf16(bf[ni], af[mi], acc[mi][ni], 0, 0, 0);
        }
    }
#pragma unroll
    for (int mi = 0; mi < 2; ++mi)
#pragma unroll
        for (int ni = 0; ni < 4; ++ni) epi(m0 + wr * 32 + mi * 16 + fr, n0 + wc * 64 + ni * 16 + fq * 4, acc[mi][ni]);
}

DI void phase_inproj(const Params& p, int layer, int bid, int nb, char* smem) {
    const bf16_t* hb = p.hb; bf16_t* P = p.P;
    const bf16_t* Bt = p.WtIn + (size_t)layer * CIN * D;
    constexpr int NT = CP / 128, MT = TP / 128;
    for (int t = bid; t < MT * NT; t += nb) {
        const int m0 = (t / NT) * 128, n0 = (t % NT) * 128;
        gemm_tile128([=](int r) { return r < T ? hb + (size_t)r * D : (const bf16_t*)nullptr; }, Bt, D, D, m0, n0, smem,
                     [=](int r, int c, f32x4 v) { if (r < T) *(u32x2*)(P + (size_t)r * CP + c) = (u32x2){pack2(v[0], v[1]), pack2(v[2], v[3])}; });
    }
}

constexpr int NCHUNK = (L + 63) / 64, NUNIT = NBATCH * HEADS * NCHUNK;
constexpr int LS = 72, RB = 64 * LS * 2;
constexpr int R1_LDS = 16 * RB + 4096;
#define RBUF(i) ((bf16_t*)(smem + (i) * RB))
typedef float f32x16 __attribute__((ext_vector_type(16)));

template <int KK> DI f32x4 mm16(const bf16_t* F, int ldf, const bf16_t* S, int lds_, f32x4 acc, int lane) {
    const int fr = lane & 15, fq = lane >> 4;
#pragma unroll
    for (int ks = 0; ks < KK / 32; ++ks) {
        const bf16x8 f = *(const bf16x8*)(F + fr * ldf + ks * 32 + fq * 8);
        const bf16x8 g = *(const bf16x8*)(S + fr * lds_ + ks * 32 + fq * 8);
        acc = __builtin_amdgcn_mfma_f32_16x16x32_bf16(f, g, acc, 0, 0, 0);
    }
    return acc;
}
DI u32x2 pk4(f32x4 v) { return (u32x2){pack2(v[0], v[1]), pack2(v[2], v[3])}; }
DI f32x4 up4(u32x2 v) { return (f32x4){lo_bf(v[0]), hi_bf(v[0]), lo_bf(v[1]), hi_bf(v[1])}; }

DI void phase_rwkv_r1(const Params& p, int layer, int bid, int nb, char* smem) {
    const int tid = tid_(), lane = tid & 63, wv = __builtin_amdgcn_readfirstlane(tid >> 6), fr = lane & 15, fq = lane >> 4;
    const f32x4 zero = (f32x4){0.f, 0.f, 0.f, 0.f};
    float* lwT = (float*)RBUF(4);
    float* aT = (float*)RBUF(6);
    float* gt = (float*)(smem + 16 * RB);
    float* gammaC = gt + 512;
    bf16_t* Xt0 = RBUF(14);
    bf16_t* Xt1 = RBUF(4);
    const bf16_t* WupT = p.WupT + (size_t)layer * 512 * 64, *AupT = p.AupT + (size_t)layer * 512 * 64, *GupT = p.GupT + (size_t)layer * 512 * 128;
    const float* mu = p.mu + (size_t)layer * RSW;
    for (int u = bid; u < NUNIT; u += nb) {
        const int c = u % NCHUNK, bh = u / NCHUNK, h = bh % HEADS, bb = bh / HEADS;
        const size_t tok0 = (size_t)bb * L + c * 64;
        __syncthreads();
#pragma unroll 1
        for (int it = 0; it < 7; ++it) {
            const int cid = tid + NTHR * it, i = cid / 56, cc = cid % 56;
            int col; bf16_t* dst;
            if (cc < 8) { col = RW_R + h * 64 + cc * 8; dst = RBUF(8) + i * LS + cc * 8; }
            else if (cc < 16) { col = RW_K + h * 64 + (cc - 8) * 8; dst = RBUF(9) + i * LS + (cc - 8) * 8; }
            else if (cc < 24) { col = RW_V + h * 64 + (cc - 16) * 8; dst = RBUF(10) + i * LS + (cc - 16) * 8; }
            else if (cc < 32) { col = RW_WD + (cc - 24) * 8; dst = RBUF(0) + i * LS + (cc - 24) * 8; }
            else if (cc < 40) { col = RW_AD + (cc - 32) * 8; dst = RBUF(1) + i * LS + (cc - 32) * 8; }
            else { col = RW_GD + (cc - 40) * 8; dst = RBUF(2) + i * 136 + (cc - 40) * 8; }
            const int t = c * 64 + i;
            u32x4 cur = (u32x4){0u, 0u, 0u, 0u}, prv = (u32x4){0u, 0u, 0u, 0u};
            if (t < L) cur = *(const u32x4*)(p.P + (tok0 + i) * CP + OFF_RW + col);
            if (t < L && t > 0) prv = *(const u32x4*)(p.P + (tok0 + i - 1) * CP + OFF_RW + col);
            const f32x4 m0 = *(const f32x4*)(mu + col), m1 = *(const f32x4*)(mu + col + 4);
            float x[8];
#pragma unroll
            for (int j = 0; j < 4; ++j) {
                const float c0 = lo_bf(cur[j]), c1 = hi_bf(cur[j]), p0 = lo_bf(prv[j]), p1 = hi_bf(prv[j]);
                const float mm0 = j < 2 ? m0[2 * j] : m1[2 * j - 4], mm1 = j < 2 ? m0[2 * j + 1] : m1[2 * j - 3];
                x[2 * j] = c0 + (p0 - c0) * mm0; x[2 * j + 1] = c1 + (p1 - c1) * mm1;
            }
            if (cc >= 24 && cc < 32) {
#pragma unroll
                for (int j = 0; j < 8; ++j) x[j] = tanhf(x[j]);
            } else if (cc >= 40) {
#pragma unroll
                for (int j = 0; j < 8; ++j) x[j] = sigmoidf_(x[j]);
            }
            *(u32x4*)dst = (u32x4){pack2(x[0], x[1]), pack2(x[2], x[3]), pack2(x[4], x[5]), pack2(x[6], x[7])};
        }
        __syncthreads();
#pragma unroll 1
        for (int tl = wv * 2; tl < wv * 2 + 2; ++tl) {
            const int pt = tl >> 2, qt = tl & 3;
            const f32x4 aw = mm16<64>(RBUF(0) + pt * 16 * LS, LS, WupT + (size_t)(h * 64 + qt * 16) * 64, 64, zero, lane);
            const f32x4 aa = mm16<64>(RBUF(1) + pt * 16 * LS, LS, AupT + (size_t)(h * 64 + qt * 16) * 64, 64, zero, lane);
            const int ch = qt * 16 + fr;
            const float w0 = p.w0[layer * 512 + h * 64 + ch], a0 = p.a0[layer * 512 + h * 64 + ch];
            f32x4 lw, av;
#pragma unroll
            for (int e = 0; e < 4; ++e) { lw[e] = -DECAY_SCALE * sigmoidf_(w0 + aw[e]); av[e] = sigmoidf_(a0 + aa[e]); }
            *(f32x4*)(lwT + ch * 68 + pt * 16 + fq * 4) = lw;
            *(f32x4*)(aT + ch * 68 + pt * 16 + fq * 4) = av;
            const f32x4 ag = mm16<128>(GupT + (size_t)(h * 64 + pt * 16) * 128, 128, RBUF(2) + qt * 16 * 136, 136, zero, lane);
            *(u32x2*)(p.GG + ((size_t)u * 64 + qt * 16 + fr) * 64 + pt * 16 + fq * 4) = pk4(ag);
        }
        __syncthreads();
        {
            const int ch = lane, cg = layer * 512 + h * 64 + ch;
            float lw[8], av[8], cum[8];
            {
                const f32x4 l0 = *(const f32x4*)(lwT + ch * 68 + wv * 8), l1 = *(const f32x4*)(lwT + ch * 68 + wv * 8 + 4);
                const f32x4 a0 = *(const f32x4*)(aT + ch * 68 + wv * 8), a1 = *(const f32x4*)(aT + ch * 68 + wv * 8 + 4);
#pragma unroll
                for (int e = 0; e < 4; ++e) { lw[e] = l0[e]; lw[e + 4] = l1[e]; av[e] = a0[e]; av[e + 4] = a1[e]; }
            }
            float run = 0.f;
#pragma unroll
            for (int e = 0; e < 8; ++e) { run += lw[e]; cum[e] = run; }
            gt[wv * 64 + ch] = run;
            __syncthreads();
            float offs = 0.f, tot = 0.f;
#pragma unroll
            for (int g2 = 0; g2 < 8; ++g2) { const float gv = gt[g2 * 64 + ch]; offs += g2 < wv ? gv : 0.f; tot += gv; }
            if (wv == 0) gammaC[ch] = __expf(tot);
            const float kkc = p.k_k[cg], kac = p.k_a[cg], rkc = p.r_k[cg];
            float at_[8], kt_[8], bt_[8], vt_[8];
#pragma unroll
            for (int e = 0; e < 8; ++e) {
                const int i = wv * 8 + e;
                const float xr = bf2f(RBUF(8)[i * LS + ch]), xk = bf2f(RBUF(9)[i * LS + ch]), xv = bf2f(RBUF(10)[i * LS + ch]);
                const float cm = cum[e] + offs;
                const float kkr = xk * kkc;
                const float kk = kkr / fmaxf(sqrtf(wave_sum(kkr * kkr)), 1e-12f);
                const float kq = xk * (1.0f + (av[e] - 1.0f) * kac);
                const float bon = wave_sum(xr * kq * rkc);
                if (lane == 0) p.bonG[(size_t)u * 64 + i] = bon;
                if (c * 64 + i < L) p.orw[(tok0 + i) * 512 + h * 64 + ch] = RBUF(10)[i * LS + ch];
                const float eneg = __expf(-cm), epos = __expf(cm), eexc = __expf(cm - lw[e]);
                at_[e] = -kk * eexc; kt_[e] = kq * eneg; bt_[e] = kk * av[e] * eneg; vt_[e] = xv;
                RBUF(3)[i * LS + ch] = f2bf(xr * epos);
            }
            __syncthreads();
#pragma unroll
            for (int e = 0; e < 8; ++e) {
                const int i = wv * 8 + e;
                RBUF(0)[i * LS + ch] = f2bf(at_[e]); RBUF(1)[i * LS + ch] = f2bf(kt_[e]); RBUF(2)[i * LS + ch] = f2bf(bt_[e]);
            }
            *(u32x4*)(RBUF(11) + ch * LS + wv * 8) = (u32x4){pack2(kt_[0], kt_[1]), pack2(kt_[2], kt_[3]), pack2(kt_[4], kt_[5]), pack2(kt_[6], kt_[7])};
            *(u32x4*)(RBUF(12) + ch * LS + wv * 8) = (u32x4){pack2(bt_[0], bt_[1]), pack2(bt_[2], bt_[3]), pack2(bt_[4], bt_[5]), pack2(bt_[6], bt_[7])};
            *(u32x4*)(RBUF(13) + ch * LS + wv * 8) = (u32x4){pack2(vt_[0], vt_[1]), pack2(vt_[2], vt_[3]), pack2(vt_[4], vt_[5]), pack2(vt_[6], vt_[7])};
            *(u32x4*)(Xt0 + ch * LS + wv * 8) = (u32x4){pack2(at_[0], at_[1]), pack2(at_[2], at_[3]), pack2(at_[4], at_[5]), pack2(at_[6], at_[7])};
        }
        __syncthreads();
#pragma unroll
        for (int prod = 0; prod < 5; ++prod) {
            const bf16_t* F = prod == 0 ? RBUF(1) : prod == 1 ? RBUF(2) : prod == 2 ? RBUF(0) : prod == 3 ? RBUF(1) : RBUF(2);
            const bf16_t* S = prod == 0 ? RBUF(0) : prod == 1 ? RBUF(0) : prod == 2 ? RBUF(2) : RBUF(3);
            bf16_t* O = prod == 0 ? RBUF(6) : prod == 1 ? RBUF(7) : prod == 2 ? RBUF(8) : prod == 3 ? RBUF(9) : RBUF(10);
            const int mode = prod < 2 ? 0 : prod == 2 ? 2 : 1;
#pragma unroll
            for (int rep = 0; rep < 2; ++rep) {
                const int tl = wv + 8 * rep, pt = tl >> 2, qt = tl & 3;
                f32x4 acc = mm16<64>(F + pt * 16 * LS, LS, S + qt * 16 * LS, LS, zero, lane);
                const int qi = qt * 16 + fr;
#pragma unroll
                for (int e = 0; e < 4; ++e) {
                    const int pi = pt * 16 + fq * 4 + e;
                    const bool keep = mode == 0 ? pi < qi : (mode == 1 ? pi <= qi : qi < pi);
                    acc[e] = keep ? acc[e] : 0.f;
                }
                *(u32x2*)(O + qi * LS + pt * 16 + fq * 4) = pk4(acc);
            }
        }
        __syncthreads();
        f32x4 X[4];
        if (wv < 4) {
#pragma unroll
            for (int pt = 0; pt < 4; ++pt) X[pt] = up4(*(const u32x2*)(Xt0 + (wv * 16 + fr) * LS + pt * 16 + fq * 4));
        } else {
#pragma unroll
            for (int pt = 0; pt < 4; ++pt) {
                X[pt] = mm16<64>(RBUF(6) + pt * 16 * LS, LS, RBUF(13) + (wv - 4) * 16 * LS, LS, zero, lane);
                *(u32x2*)(Xt0 + (wv * 16 + fr) * LS + pt * 16 + fq * 4) = pk4(X[pt]);
            }
        }
        __syncthreads();
#pragma unroll
        for (int k = 0; k < 6; ++k) {
            const bf16_t* Mk = (k & 1) ? RBUF(0) : RBUF(7);
            const bf16_t* Mkt = (k & 1) ? RBUF(6) : RBUF(8);
            bf16_t* Mn = (k & 1) ? RBUF(7) : RBUF(0);
            bf16_t* Mnt = (k & 1) ? RBUF(8) : RBUF(6);
            const bf16_t* Xc = (k & 1) ? Xt1 : Xt0;
            bf16_t* Xn = (k & 1) ? Xt0 : Xt1;
#pragma unroll
            for (int pt = 0; pt < 4; ++pt) {
                X[pt] = mm16<64>(Mk + pt * 16 * LS, LS, Xc + wv * 16 * LS, LS, X[pt], lane);
                *(u32x2*)(Xn + (wv * 16 + fr) * LS + pt * 16 + fq * 4) = pk4(X[pt]);
            }
            if (k < 5) {
#pragma unroll
                for (int which = 0; which < 2; ++which) {
                    const bf16_t* F = which ? Mk : Mkt; const bf16_t* S = which ? Mkt : Mk; bf16_t* O = which ? Mnt : Mn;
#pragma unroll
                    for (int rep = 0; rep < 2; ++rep) {
                        const int t2 = wv + 8 * rep, pt = t2 >> 2, qt = t2 & 3;
                        const f32x4 acc = mm16<64>(F + pt * 16 * LS, LS, S + qt * 16 * LS, LS, zero, lane);
                        *(u32x2*)(O + (qt * 16 + fr) * LS + pt * 16 + fq * 4) = pk4(acc);
                    }
                }
            }
            __syncthreads();
        }
#pragma unroll
        for (int rep = 0; rep < 2; ++rep) {
            const int tl = wv + 8 * rep, pt = tl >> 2, qt = tl & 3;
            const int pi0 = pt * 16 + fq * 4, qi = qt * 16 + fr;
            const size_t go = ((size_t)u * 64 + qi) * 64 + pi0;
            {
                f32x4 acc = mm16<64>(Xt0 + pt * 16 * LS, LS, RBUF(12) + qt * 16 * LS, LS, zero, lane);
                const float gc = gammaC[qi];
#pragma unroll
                for (int e = 0; e < 4; ++e) acc[e] = (acc[e] + (pi0 + e == qi ? 1.f : 0.f)) * gc;
                *(u32x2*)(p.PcG + go) = pk4(acc);
            }
            {
                f32x4 acc = mm16<64>(RBUF(11) + pt * 16 * LS, LS, RBUF(13) + qt * 16 * LS, LS, zero, lane);
                acc = mm16<64>(RBUF(12) + pt * 16 * LS, LS, Xt0 + (64 + qt * 16) * LS, LS, acc, lane);
                const f32x4 gc = *(const f32x4*)(gammaC + pi0);
#pragma unroll
                for (int e = 0; e < 4; ++e) acc[e] *= gc[e];
                *(u32x2*)(p.QcG + go) = pk4(acc);
            }
            {
                f32x4 acc = mm16<64>(Xt0 + pt * 16 * LS, LS, RBUF(10) + qt * 16 * LS, LS, zero, lane);
                const f32x4 rr = up4(*(const u32x2*)(RBUF(3) + qi * LS + pi0));
#pragma unroll
                for (int e = 0; e < 4; ++e) acc[e] += rr[e];
                *(u32x2*)(p.RhG + go) = pk4(acc);
            }
            {
                f32x4 acc = mm16<64>(RBUF(13) + pt * 16 * LS, LS, RBUF(9) + qt * 16 * LS, LS, zero, lane);
                acc = mm16<64>(Xt0 + (64 + pt * 16) * LS, LS, RBUF(10) + qt * 16 * LS, LS, acc, lane);
                *(u32x2*)(p.Y0G + go) = pk4(acc);
            }
        }
    }
}

DI void phase_rwkv_r2(const Params& p, int chain) {
    const int lane = tid_() & 63, wv = __builtin_amdgcn_readfirstlane(tid_() >> 6);
    if (wv != 0) return;
    const int bh = chain >> 1, vh = chain & 1, r = lane & 31, hh = lane >> 5, v = vh * 32 + r;
    f32x16 S[2];
#pragma unroll
    for (int e = 0; e < 16; ++e) { S[0][e] = 0.f; S[1][e] = 0.f; }
#pragma unroll 1
    for (int c = 0; c < NCHUNK; ++c) {
        const size_t u = (size_t)bh * NCHUNK + c;
        bf16_t* sg = p.SG + (u * 64 + v) * 64 + 4 * hh;
#pragma unroll
        for (int kt = 0; kt < 2; ++kt)
#pragma unroll
            for (int qd = 0; qd < 4; ++qd)
                *(u32x2*)(sg + 32 * kt + 8 * qd) = (u32x2){pack2(S[kt][4 * qd], S[kt][4 * qd + 1]), pack2(S[kt][4 * qd + 2], S[kt][4 * qd + 3])};
        if (c == NCHUNK - 1) break;
        bf16x8 bfr[2][2];
#pragma unroll
        for (int tl = 0; tl < 2; ++tl)
#pragma unroll
            for (int sp = 0; sp < 2; ++sp) {
                const u32x4 pk = (u32x4){pack2(S[tl][8 * sp], S[tl][8 * sp + 1]), pack2(S[tl][8 * sp + 2], S[tl][8 * sp + 3]),
                                         pack2(S[tl][8 * sp + 4], S[tl][8 * sp + 5]), pack2(S[tl][8 * sp + 6], S[tl][8 * sp + 7])};
                bfr[tl][sp] = __builtin_bit_cast(bf16x8, pk);
            }
        const bf16_t* qg = p.QcG + (u * 64 + v) * 64 + 4 * hh;
#pragma unroll
        for (int kt = 0; kt < 2; ++kt)
#pragma unroll
            for (int qd = 0; qd < 4; ++qd) {
                const f32x4 q = up4(*(const u32x2*)(qg + 32 * kt + 8 * qd));
                S[kt][4 * qd] = q[0]; S[kt][4 * qd + 1] = q[1]; S[kt][4 * qd + 2] = q[2]; S[kt][4 * qd + 3] = q[3];
            }
#pragma unroll
        for (int kt = 0; kt < 2; ++kt)
#pragma unroll
            for (int tl = 0; tl < 2; ++tl)
#pragma unroll
                for (int sp = 0; sp < 2; ++sp) {
                    const bf16_t* pr = p.PcG + (u * 64 + 32 * kt + r) * 64 + 32 * tl + 16 * sp + 4 * hh;
                    const u32x2 a0 = *(const u32x2*)pr, a1 = *(const u32x2*)(pr + 8);
                    const bf16x8 af = __builtin_bit_cast(bf16x8, ((u32x4){a0[0], a0[1], a1[0], a1[1]}));
                    S[kt] = __builtin_amdgcn_mfma_f32_32x32x16_bf16(af, bfr[tl][sp], S[kt], 0, 0, 0);
                }
    }
}

DI void phase_rwkv_r3(const Params& p, int layer, int bid, int nb) {
    const int tid = tid_(), lane = tid & 63, wv = __builtin_amdgcn_readfirstlane(tid >> 6), fr = lane & 15, fq = lane >> 4;
    for (int task = bid * 8 + wv; task < NUNIT * 4; task += nb * 8) {
        const int u = task >> 2, it = task & 3;
        const int c = u % NCHUNK, bh = u / NCHUNK, h = bh % HEADS, bb = bh / HEADS;
        const int i = it * 16 + fr, t = c * 64 + i;
        const size_t tok = (size_t)bb * L + t;
        bf16x8 sf[2];
#pragma unroll
        for (int ks = 0; ks < 2; ++ks) sf[ks] = *(const bf16x8*)(p.RhG + ((size_t)u * 64 + i) * 64 + ks * 32 + fq * 8);
        f32x4 y[4];
#pragma unroll
        for (int vt = 0; vt < 4; ++vt) {
            y[vt] = up4(*(const u32x2*)(p.Y0G + ((size_t)u * 64 + i) * 64 + vt * 16 + fq * 4));
#pragma unroll
            for (int ks = 0; ks < 2; ++ks) {
                const bf16x8 f = *(const bf16x8*)(p.SG + ((size_t)u * 64 + vt * 16 + fr) * 64 + ks * 32 + fq * 8);
                y[vt] = __builtin_amdgcn_mfma_f32_16x16x32_bf16(f, sf[ks], y[vt], 0, 0, 0);
            }
        }
        float s = 0.f;
#pragma unroll
        for (int vt = 0; vt < 4; ++vt) s += (y[vt][0] + y[vt][1]) + (y[vt][2] + y[vt][3]);
        s += __shfl_xor(s, 16); s += __shfl_xor(s, 32);
        const float mean = s * (1.0f / 64.f);
        float q = 0.f;
#pragma unroll
        for (int vt = 0; vt < 4; ++vt)
#pragma unroll
            for (int e = 0; e < 4; ++e) { y[vt][e] -= mean; q += y[vt][e] * y[vt][e]; }
        q += __shfl_xor(q, 16); q += __shfl_xor(q, 32);
        const float rstd = rsqrtf(q * (1.0f / 64.f) + 64e-5f);
        if (t < L) {
            const float bon = p.bonG[(size_t)u * 64 + i];
#pragma unroll
            for (int vt = 0; vt < 4; ++vt) {
                const int v0 = vt * 16 + fq * 4, cg = h * 64 + v0;
                const f32x4 xv = up4(*(const u32x2*)(p.orw + tok * 512 + cg));
                const f32x4 g = up4(*(const u32x2*)(p.GG + ((size_t)u * 64 + i) * 64 + v0));
                const f32x4 lg = *(const f32x4*)(p.lnx_g + layer * 512 + cg), lb = *(const f32x4*)(p.lnx_b + layer * 512 + cg);
                f32x4 o;
#pragma unroll
                for (int e = 0; e < 4; ++e) {
                    o[e] = (y[vt][e] * rstd * lg[e] + lb[e] + bon * xv[e]) * g[e];
                }
                *(u32x2*)(p.orw + tok * 512 + cg) = pk4(o);
            }
        }
    }
}

DI void phase_sb_naive(const Params& p, int bid, int nb) {
    constexpr int QB = NTHR / 2, NTB = (L + QB - 1) / QB;
    const int half = tid_() & 1;
    for (int u = bid; u < NBATCH * HEADS * NTB; u += nb) {
        const int tb = u / (NBATCH * HEADS), bh = u % (NBATCH * HEADS), b = bh / HEADS, h = bh % HEADS;
        const int t = tb * QB + (tid_() >> 1);
        const bool live = t < L;
        const size_t tok = (size_t)b * L + (live ? t : 0);
        float q[32], acc[32];
        {
            const bf16_t* qp = p.P + tok * CP + OFF_Q + h * 64 + half * 32;
#pragma unroll
            for (int i = 0; i < 4; ++i) {
                const u32x4 v = *(const u32x4*)(qp + 8 * i);
#pragma unroll
                for (int j = 0; j < 4; ++j) { q[8 * i + 2 * j] = lo_bf(v[j]) * 0.125f; q[8 * i + 2 * j + 1] = hi_bf(v[j]) * 0.125f; }
            }
        }
#pragma unroll
        for (int i = 0; i < 32; ++i) acc[i] = 0.f;
        float R = 0.f;
        for (int s = live ? t - 1 : -1; s >= 0; --s) {
            const bf16_t* kp = p.P + ((size_t)b * L + s) * CP + OFF_K + h * 64 + half * 32;
            float z0 = 0.f, z1 = 0.f;
#pragma unroll
            for (int i = 0; i < 4; ++i) {
                const u32x4 v = *(const u32x4*)(kp + 8 * i);
#pragma unroll
                for (int j = 0; j < 4; ++j) { z0 += q[8 * i + 2 * j] * lo_bf(v[j]); z1 += q[8 * i + 2 * j + 1] * hi_bf(v[j]); }
            }
            float z = z0 + z1;
            z += __shfl_xor(z, 1);
            const float l1 = __logf(1.0f + __expf(-fabsf(z)));
            const float lsneg = -(fmaxf(z, 0.f) + l1);
            const float A = __expf(lsneg + z + R);
            const bf16_t* vp = kp + (OFF_V - OFF_K);
#pragma unroll
            for (int i = 0; i < 4; ++i) {
                const u32x4 v = *(const u32x4*)(vp + 8 * i);
#pragma unroll
                for (int j = 0; j < 4; ++j) { acc[8 * i + 2 * j] += A * lo_bf(v[j]); acc[8 * i + 2 * j + 1] += A * hi_bf(v[j]); }
            }
            R += lsneg;
            if (R < -104.0f) break;
        }
        if (live) {
            bf16_t* op = p.osb + tok * 512 + h * 64 + half * 32;
#pragma unroll
            for (int i = 0; i < 4; ++i) {
                u32x4 o;
#pragma unroll
                for (int j = 0; j < 4; ++j) o[j] = pack2(acc[8 * i + 2 * j], acc[8 * i + 2 * j + 1]);
                *(u32x4*)(op + 8 * i) = o;
            }
        }
    }
}

DI void phase_gates(const Params& p, int layer, int bid, int nb, char* smem) {
    const bf16_t* hb = p.hb; bf16_t* G = p.gates;
    const bf16_t* Bt = p.WtIn + ((size_t)layer * CIN + CP) * D;
    constexpr int NT = 2048 / 128, MT = TP / 128;
    for (int t = bid; t < MT * NT; t += nb) {
        const int m0 = (t / NT) * 128, n0 = (t % NT) * 128;
        gemm_tile128([=](int r) { return r < T ? hb + (size_t)r * D : (const bf16_t*)nullptr; }, Bt, D, D, m0, n0, smem,
                     [=](int r, int c, f32x4 v) { if (r < T) *(u32x2*)(G + (size_t)r * 2048 + c) = (u32x2){pack2(sigmoidf_(v[0]), sigmoidf_(v[1])), pack2(sigmoidf_(v[2]), sigmoidf_(v[3]))}; });
    }
}
DI void phase_branch(const Params& p, int layer, int which, int bid, int nb, char* smem) {
    const bf16_t* A = which ? p.orw : p.osb; const bf16_t* G = p.gates + which * 1024; bf16_t* M = p.merged;
    const bf16_t* Bt = (which ? p.WtPrw : p.WtPsb) + (size_t)layer * D * 512;
    constexpr int NT = D / 128, MT = TP / 128;
    for (int t = bid; t < MT * NT; t += nb) {
        const int m0 = (t / NT) * 128, n0 = (t % NT) * 128;
        gemm_tile128([=](int r) { return r < T ? A + (size_t)r * 512 : (const bf16_t*)nullptr; }, Bt, 512, 512, m0, n0, smem,
                     [=](int r, int c, f32x4 v) {
                         if (r >= T) return;
                         const u32x2 g = *(const u32x2*)(G + (size_t)r * 2048 + c);
                         float o0 = lo_bf(g[0]) * v[0], o1 = hi_bf(g[0]) * v[1], o2 = lo_bf(g[1]) * v[2], o3 = hi_bf(g[1]) * v[3];
                         u32x2* mp = (u32x2*)(M + (size_t)r * D + c);
                         if (which) { const u32x2 m = *mp; o0 += lo_bf(m[0]); o1 += hi_bf(m[0]); o2 += lo_bf(m[1]); o3 += hi_bf(m[1]); }
                         *mp = (u32x2){pack2(o0, o1), pack2(o2, o3)};
                     });
    }
}
DI void phase_outproj(const Params& p, int layer, int bid, int nb, char* smem) {
    const bf16_t* A = p.merged; float* const hmeta = p.hmeta; float* const outp = p.out;
    const bf16_t* Bt = p.WtOut + (size_t)layer * D * D;
    constexpr int NT = D / 128, MT = TP / 128;
    if (bid == 0 && tid_() < NE) p.counts[tid_()] = 0;
    for (int t = bid; t < MT * NT; t += nb) {
        const int m0 = (t / NT) * 128, n0 = (t % NT) * 128;
        gemm_tile128([=](int r) { return r < T ? A + (size_t)r * D : (const bf16_t*)nullptr; }, Bt, D, D, m0, n0, smem,
                     [=](int r, int c, f32x4 v) {
                         if (r >= T) return;
                         f32x4* hp = (f32x4*)(hrow2(hmeta, outp, r) + c);
                         const f32x4 h = *hp;
                         *hp = (f32x4){ALPHA * h[0] + v[0], ALPHA * h[1] + v[1], ALPHA * h[2] + v[2], ALPHA * h[3] + v[3]};
                     });
    }
}

DI void phase_ln1_router(const Params& p, int layer, int bid, int nb) {
    const int lane = tid_() & 63, wid = __builtin_amdgcn_readfirstlane(tid_() >> 6);
    for (int tok = bid * 8 + wid; tok < T; tok += nb * 8) {
        float* hf = hrow(p, tok);
        float v[16];
#pragma unroll
        for (int j = 0; j < 4; ++j) { const f32x4 a = *(const f32x4*)(hf + 256 * j + 4 * lane); v[4 * j] = a[0]; v[4 * j + 1] = a[1]; v[4 * j + 2] = a[2]; v[4 * j + 3] = a[3]; }
        ln16(v, p.ln1_g + layer * D, p.ln1_b + layer * D, lane);
        store_row(hf, p.hb + (size_t)tok * D, v, lane);
        float lg[16];
#pragma unroll
        for (int e = 0; e < 16; ++e) lg[e] = 0.f;
#pragma unroll
        for (int j = 0; j < 4; ++j)
#pragma unroll
            for (int i = 0; i < 4; ++i) {
                const float* rw = p.router_w + (size_t)(256 * j + 4 * lane + i) * NE;
#pragma unroll
                for (int e4 = 0; e4 < 4; ++e4) {
                    const f32x4 w = *(const f32x4*)(rw + 4 * e4);
#pragma unroll
                    for (int q = 0; q < 4; ++q) lg[4 * e4 + q] += v[4 * j + i] * w[q];
                }
            }
        float mx = -3.0e38f;
#pragma unroll
        for (int e = 0; e < 16; ++e) { lg[e] = wave_sum(lg[e]) + p.router_b[e]; mx = fmaxf(mx, lg[e]); }
        float sum = 0.f;
#pragma unroll
        for (int e = 0; e < 16; ++e) { lg[e] = __expf(lg[e] - mx); sum += lg[e]; }
        const float inv = 1.0f / sum;
        float bs = -1.f, bv1 = 0.f, bv2 = 0.f; int be1 = 0, be2 = 1;
#pragma unroll
        for (int g = 0; g < 4; ++g) {
            float v1 = -1.f, v2 = -1.f; int i1 = 0, i2 = 0;
#pragma unroll
            for (int i = 0; i < 4; ++i) {
                const float pv = lg[4 * g + i] * inv;
                if (pv > v1) { v2 = v1; i2 = i1; v1 = pv; i1 = i; } else if (pv > v2) { v2 = pv; i2 = i; }
            }
            const float sc = v1 + v2;
            if (sc > bs) { bs = sc; bv1 = v1; bv2 = v2; be1 = 4 * g + i1; be2 = 4 * g + i2; }
        }
        if (lane == 0) {
            const float gs = 1.0f / (bv1 + bv2);
            const int s1 = atomicAdd(&p.counts[be1], 1), s2 = atomicAdd(&p.counts[be2], 1);
            p.list[be1 * T + s1] = tok * 2; p.list[be2 * T + s2] = tok * 2 + 1;
            p.tokg[tok * 2] = bv1 * gs; p.tokg[tok * 2 + 1] = bv2 * gs;
        }
    }
}

struct MoeTile { int e, slot0, off, cnt, total; };
DI MoeTile moe_tile(const int* counts, int tm) {
    MoeTile r; r.e = -1; r.slot0 = 0; r.off = 0; r.cnt = 0;
    int start = 0, off = 0;
#pragma unroll
    for (int e = 0; e < NE; ++e) {
        const int c = counts[e], nt = (c + 127) >> 7;
        if (tm >= start && tm < start + nt) { r.e = e; r.slot0 = (tm - start) * 128; r.off = off; r.cnt = c; }
        start += nt; off += c;
    }
    r.total = start;
    return r;
}
DI void phase_moe_up(const Params& p, int bid, int nb, char* smem) {
    const bf16_t* hb = p.hb; bf16_t* hid = p.hid; const int* list = p.list;
    const int total = moe_tile(p.counts, 0).total;
    for (int t = bid; t < total * 8; t += nb) {
        const MoeTile mt = moe_tile(p.counts, t >> 3);
        const int n0 = (t & 7) * 128, e = mt.e, slot0 = mt.slot0, cnt = mt.cnt, off = mt.off;
        gemm_tile128([=](int r) { const int s = slot0 + r; return s < cnt ? hb + (size_t)(list[e * T + s] >> 1) * D : (const bf16_t*)nullptr; },
                     p.WtGU + (size_t)e * 1024 * 1024, D, D, 0, n0, smem,
                     [=](int r, int c, f32x4 v) {
                         const int s = slot0 + r;
                         if (s >= cnt) return;
                         const float h0 = v[0] * sigmoidf_(v[0]) * v[1], h1 = v[2] * sigmoidf_(v[2]) * v[3];
                         *(unsigned*)(hid + (size_t)(off + s) * DE + (c >> 1)) = pack2(h0, h1);
                     });
    }
}
DI void phase_moe_down(const Params& p, int bid, int nb, char* smem) {
    const bf16_t* hid = p.hid; bf16_t* fo = p.fo; const int* list = p.list; const float* tokg = p.tokg;
    const int total = moe_tile(p.counts, 0).total;
    for (int t = bid; t < total * 8; t += nb) {
        const MoeTile mt = moe_tile(p.counts, t >> 3);
        const int n0 = (t & 7) * 128, e = mt.e, slot0 = mt.slot0, cnt = mt.cnt, off = mt.off;
        gemm_tile128([=](int r) { const int s = slot0 + r; return s < cnt ? hid + (size_t)(off + s) * DE : (const bf16_t*)nullptr; },
                     p.WtD + (size_t)e * 1024 * 512, DE, DE, 0, n0, smem,
                     [=](int r, int c, f32x4 v) {
                         const int s = slot0 + r;
                         if (s >= cnt) return;
                         const int ent = list[e * T + s], tok = ent >> 1, kc = ent & 1;
                         const float g = tokg[ent];
                         *(u32x2*)(fo + ((size_t)kc * TP + tok) * D + c) = (u32x2){pack2(g * v[0], g * v[1]), pack2(g * v[2], g * v[3])};
                     });
    }
}
DI void phase_ln2(const Params& p, int layer, int bid, int nb) {
    const int lane = tid_() & 63, wid = __builtin_amdgcn_readfirstlane(tid_() >> 6);
    for (int tok = bid * 8 + wid; tok < T; tok += nb * 8) {
        float* hf = hrow(p, tok);
        float v[16];
#pragma unroll
        for (int j = 0; j < 4; ++j) {
            const f32x4 a = *(const f32x4*)(hf + 256 * j + 4 * lane);
            const u32x2 f0 = *(const u32x2*)(p.fo + (size_t)tok * D + 256 * j + 4 * lane), f1 = *(const u32x2*)(p.fo + ((size_t)TP + tok) * D + 256 * j + 4 * lane);
            v[4 * j] = ALPHA * a[0] + lo_bf(f0[0]) + lo_bf(f1[0]); v[4 * j + 1] = ALPHA * a[1] + hi_bf(f0[0]) + hi_bf(f1[0]);
            v[4 * j + 2] = ALPHA * a[2] + lo_bf(f0[1]) + lo_bf(f1[1]); v[4 * j + 3] = ALPHA * a[3] + hi_bf(f0[1]) + hi_bf(f1[1]);
        }
        ln16(v, p.ln2_g + layer * D, p.ln2_b + layer * D, lane);
        store_row(hf, p.hb + (size_t)tok * D, v, lane);
    }
}

extern __shared__ __attribute__((aligned(16))) char dyn_smem[];
constexpr int SMEM_MAIN = R1_LDS > GEMM_LDS ? R1_LDS : GEMM_LDS;
constexpr int SMEM_BYTES = SMEM_MAIN + 16;

__global__ void __launch_bounds__(NTHR, 2) k_forward(Params p) {
    const int bid = blockIdx.x, nb = gridDim.x;
    char* smem = dyn_smem;
    uint4* xbw = (uint4*)(dyn_smem + SMEM_MAIN);
    if (threadIdx.x == 0) *xbw = make_uint4(0u, 0u, 0u, 0u);
    __syncthreads();
    XcdBarrier bar = xcd_barrier_post(p.bar, (volatile LAS unsigned*)xbw);
    phase_prologue_weights(p, bid, nb, smem);
    phase_embed(p, bid, nb);
    xcd_barrier(bar);
    for (int l = 0; l < DEPTH; ++l) {
        phase_inproj(p, l, bid, nb, smem);
        xcd_barrier(bar);
        phase_rwkv_r1(p, l, bid, nb, smem);
        xcd_barrier(bar);
        if (bid < 32) phase_rwkv_r2(p, bid);
        else phase_sb_naive(p, bid - 32, nb - 32);
        xcd_barrier(bar);
        phase_rwkv_r3(p, l, bid, nb);
        phase_gates(p, l, bid, nb, smem);
        xcd_barrier(bar);
        convert_experts(p, l, bid, nb, smem);
        phase_branch(p, l, 0, bid, nb, smem);
        xcd_barrier(bar);
        phase_branch(p, l, 1, bid, nb, smem);
        xcd_barrier(bar);
        phase_outproj(p, l, bid, nb, smem);
        xcd_barrier(bar);
        phase_ln1_router(p, l, bid, nb);
        xcd_barrier(bar);
        phase_moe_up(p, bid, nb, smem);
        xcd_barrier(bar);
        phase_moe_down(p, bid, nb, smem);
        xcd_barrier(bar);
        phase_ln2(p, l, bid, nb);
        xcd_barrier(bar);
    }
}

extern "C" void kernel_launch(void* const* d_in, const int* in_sizes, int n_in, void* d_out, int out_size, void* d_ws, size_t ws_size, hipStream_t stream) {
    (void)in_sizes; (void)n_in; (void)out_size;
    Params p;
    memset(&p, 0, sizeof(p));
    const float* const* in = (const float* const*)d_in;
    p.x = in[0]; p.meta = in[1]; p.emb_g = in[2]; p.emb_b = in[3]; p.w_in = in[4]; p.mu = in[5]; p.w0 = in[6]; p.w_up = in[7]; p.a0 = in[8]; p.a_up = in[9];
    p.g_up = in[10]; p.k_k = in[11]; p.k_a = in[12]; p.r_k = in[13]; p.lnx_g = in[14]; p.lnx_b = in[15]; p.p_sb = in[16]; p.p_rwkv = in[17]; p.w_out = in[18];
    p.ln1_g = in[19]; p.ln1_b = in[20]; p.router_w = in[21]; p.router_b = in[22]; p.ew_gate = in[23]; p.ew_up = in[24]; p.ew_down = in[25]; p.ln2_g = in[26]; p.ln2_b = in[27];
    p.out = (float*)d_out;
    char* ws = (char*)d_ws; size_t o = 0;
    auto take = [&](size_t bytes) { char* r = ws + o; o += (bytes + 255) & ~(size_t)255; return r; };
    p.bar = (unsigned*)take(XCD_BAR_WORDS * sizeof(unsigned));
    p.counts = (int*)take(256);
    p.WtIn = (bf16_t*)take((size_t)DEPTH * CIN * D * 2);
    p.WtPsb = (bf16_t*)take((size_t)DEPTH * D * 512 * 2);
    p.WtPrw = (bf16_t*)take((size_t)DEPTH * D * 512 * 2);
    p.WtOut = (bf16_t*)take((size_t)DEPTH * D * D * 2);
    p.WupT = (bf16_t*)take((size_t)DEPTH * 512 * 64 * 2);
    p.AupT = (bf16_t*)take((size_t)DEPTH * 512 * 64 * 2);
    p.GupT = (bf16_t*)take((size_t)DEPTH * 512 * 128 * 2);
    {
        const size_t ub = (size_t)NUNIT * 64 * 64 * 2, need_r = 6 * ub + (size_t)NUNIT * 64 * 4, need_e = (size_t)NE * 1024 * 1024 * 2 + (size_t)NE * 1024 * 512 * 2;
        char* e = take(need_r > need_e ? need_r : need_e);
        p.WtGU = (bf16_t*)e; p.WtD = (bf16_t*)(e + (size_t)NE * 1024 * 1024 * 2);
        p.PcG = (bf16_t*)e; p.QcG = (bf16_t*)(e + ub); p.RhG = (bf16_t*)(e + 2 * ub); p.Y0G = (bf16_t*)(e + 3 * ub); p.GG = (bf16_t*)(e + 4 * ub); p.SG = (bf16_t*)(e + 5 * ub);
        p.bonG = (float*)(e + 6 * ub);
    }
    p.hb = (bf16_t*)take((size_t)TP * D * 2);
    p.hmeta = (float*)take((size_t)NBATCH * NMETA * D * 4);
    p.P = (bf16_t*)take((size_t)TP * CP * 2);
    p.osb = (bf16_t*)take((size_t)TP * 512 * 2);
    p.orw = (bf16_t*)take((size_t)TP * 512 * 2);
    p.list = (int*)take((size_t)NE * T * 4);
    p.tokg = (float*)take((size_t)T * 2 * 4);
    p.gates = p.P;
    p.merged = p.P + (size_t)TP * 2048;
    p.hid = p.P;
    p.fo = p.P + (size_t)(2 * T + 128) * DE;
    if (o > ws_size) return;
    static int grid = 0;
    if (!grid) {
        int dev = 0, cus = 0, per_cu = 0;
        (void)hipGetDevice(&dev);
        (void)hipDeviceGetAttribute(&cus, hipDeviceAttributeMultiprocessorCount, dev);
        (void)hipFuncSetAttribute((const void*)k_forward, hipFuncAttributeMaxDynamicSharedMemorySize, SMEM_BYTES);
        (void)hipOccupancyMaxActiveBlocksPerMultiprocessor(&per_cu, k_forward, NTHR, SMEM_BYTES);
        grid = per_cu >= 1 ? cus : 0;
    }
    if (!grid) return;
    (void)hipMemsetAsync(p.bar, 0, XCD_BAR_WORDS * sizeof(unsigned), stream);
    hipLaunchKernelGGL(k_forward, dim3(grid), dim3(NTHR), SMEM_BYTES, stream, p);
}
```

```cpp
#include <hip/hip_runtime.h>
#include <stdint.h>
#include <string.h>

#define DI __device__ __forceinline__
typedef unsigned short bf16_t;
typedef short bf16x8 __attribute__((ext_vector_type(8)));
typedef float f32x4 __attribute__((ext_vector_type(4)));
typedef unsigned u32x4 __attribute__((ext_vector_type(4)));
typedef unsigned u32x2 __attribute__((ext_vector_type(2)));

constexpr int D = 1024, NBATCH = 2, SEQ = 8192, NMETA = 16, L = SEQ + NMETA, T = NBATCH * L, TP = 16640;
constexpr int DEPTH = 2, HEADS = 8, HD = 64;
constexpr int CIN = 5376, CP = 3328;
constexpr int OFF_Q = 0, OFF_K = 512, OFF_V = 1024, OFF_RW = 1536;
constexpr int RW_R = 0, RW_K = 512, RW_V = 1024, RW_WD = 1536, RW_AD = 1600, RW_GD = 1664, RSW = 1792;
constexpr int NE = 16, DE = 512;
constexpr float ALPHA = 1.41421356237309515f;
constexpr float DECAY_SCALE = 0.60653065971263342f;
constexpr int NTHR = 512;

#define XB_TMO      128
#define XB_XCNT(j)  (256  + 64 * (j))
#define XB_XSUB(j)  (1280 + 64 * (j))
#define XB_XGEN(j)  (2304 + 64 * (j))
#define XB_TOP      3328
#define XB_TOPGEN   3392
#define XCD_BAR_WORDS 3456
#define XB_SPIN_CAP (1u << 18)
#define LAS __attribute__((address_space(3)))

__device__ __forceinline__ unsigned xb_ld(unsigned* p)              { return __hip_atomic_load(p, __ATOMIC_RELAXED, __HIP_MEMORY_SCOPE_AGENT); }
__device__ __forceinline__ unsigned xb_add(unsigned* p, unsigned v) { return __hip_atomic_fetch_add(p, v, __ATOMIC_RELAXED, __HIP_MEMORY_SCOPE_AGENT); }
__device__ __forceinline__ unsigned xb_xcc_id() { return (unsigned)__builtin_amdgcn_s_getreg((3 << 11) | 20) & 0xFu; }
#define XB_SPIN(cond, bar) do { unsigned _sp = 0; while (cond) { __builtin_amdgcn_s_sleep(1); \
    if ((++_sp & 255u) == 0u) { if (xb_ld(&(bar)[XB_TMO])) break; if (_sp > XB_SPIN_CAP) { atomicAdd(&(bar)[XB_TMO], 1u); break; } } } } while (0)

struct XcdBarrier {
    unsigned* bar; unsigned x;
    volatile LAS unsigned* st;
};

__device__ __forceinline__ XcdBarrier xcd_barrier_post(unsigned* bar, volatile LAS unsigned* st) {
    XcdBarrier b; b.bar = bar; b.x = xb_xcc_id(); b.st = st;
    if (threadIdx.x == 0) (void)xb_add(&bar[XB_XCNT(b.x)], 1u);
    return b;
}
__device__ __forceinline__ void xcd_barrier_complete(unsigned* bar, unsigned x, unsigned& nloc, unsigned& nx) {
    const unsigned G = gridDim.x * gridDim.y * gridDim.z;
    unsigned sum, cnt, mine, sp = 0u;
    for (;;) {
        sum = 0u; cnt = 0u; mine = 0u;
#pragma unroll
        for (unsigned j = 0; j < 16; ++j) { const unsigned c = xb_ld(&bar[XB_XCNT(j)]); sum += c; cnt += (c > 0u) ? 1u : 0u; mine = (j == x) ? c : mine; }
        if (sum == G) break;
        __builtin_amdgcn_s_sleep(1);
        if ((++sp & 255u) == 0u) { if (xb_ld(&bar[XB_TMO])) break; if (sp > XB_SPIN_CAP) { atomicAdd(&bar[XB_TMO], 1u); break; } }
    }
    nloc = mine > 0u ? mine : 1u; nx = cnt > 0u ? cnt : 1u;
}

__device__ __forceinline__ void xcd_barrier(const XcdBarrier& b) {
    asm volatile("s_waitcnt vmcnt(0)" ::: "memory");
    __syncthreads();
    if (threadIdx.x == 0) {
        unsigned* bar = b.bar;
        __builtin_amdgcn_s_waitcnt(0);
        unsigned nloc = b.st[0], nx = b.st[1];
        if (nloc == 0u) { xcd_barrier_complete(bar, b.x, nloc, nx); b.st[0] = nloc; b.st[1] = nx; }
        const unsigned old = xb_add(&bar[XB_XSUB(b.x)], 1u);
        const unsigned gen = old / nloc;
        if (old + 1u == (gen + 1u) * nloc) {
            __builtin_amdgcn_fence(__ATOMIC_RELEASE, "agent");
            asm volatile("s_waitcnt vmcnt(0)" ::: "memory");
            const unsigned og = xb_add(&bar[XB_TOP], 1u);
            const unsigned tg = og / nx;
            if (og + 1u == (tg + 1u) * nx) xb_add(&bar[XB_TOPGEN], 1u);
            else XB_SPIN(xb_ld(&bar[XB_TOPGEN]) == tg, bar);
            __builtin_amdgcn_fence(__ATOMIC_ACQUIRE, "agent");
            xb_add(&bar[XB_XGEN(b.x)], 1u);
            asm volatile("s_waitcnt vmcnt(0)" ::: "memory");
        } else {
            XB_SPIN(xb_ld(&bar[XB_XGEN(b.x)]) == gen, bar);
            __builtin_amdgcn_fence(__ATOMIC_ACQUIRE, "agent");
            asm volatile("s_waitcnt vmcnt(0)" ::: "memory");
        }
    }
    __syncthreads();
}


struct Params {
    const float *x, *meta, *emb_g, *emb_b, *w_in, *mu, *w0, *w_up, *a0, *a_up, *g_up, *k_k, *k_a, *r_k, *lnx_g, *lnx_b, *p_sb, *p_rwkv, *w_out,
        *ln1_g, *ln1_b, *router_w, *router_b, *ew_gate, *ew_up, *ew_down, *ln2_g, *ln2_b;
    float* out;
    unsigned* bar;
    int* counts;
    bf16_t *WtIn, *WtPsb, *WtPrw, *WtOut, *WtGU, *WtD, *hb, *P, *osb, *orw, *WupT, *AupT, *GupT;
    bf16_t *PcG, *QcG, *RhG, *Y0G, *GG, *SG;
    float* bonG;
    float* hmeta;
    bf16_t *gates, *merged, *hid, *fo;
    int* list;
    float* tokg;
};

DI float bf2f(bf16_t v) { return __uint_as_float((unsigned)v << 16); }
typedef __bf16 bf16x2_t __attribute__((ext_vector_type(2)));
DI bf16_t f2bf(float f) { return __builtin_bit_cast(bf16_t, (__bf16)f); }
DI unsigned pack2(float lo, float hi) { bf16x2_t v = {(__bf16)lo, (__bf16)hi}; return __builtin_bit_cast(unsigned, v); }
DI float lo_bf(unsigned u) { return __uint_as_float(u << 16); }
DI float hi_bf(unsigned u) { return __uint_as_float(u & 0xFFFF0000u); }
template <int CTRL> DI float dpp_mov(float v) { return __builtin_bit_cast(float, __builtin_amdgcn_update_dpp(0, __builtin_bit_cast(int, v), CTRL, 0xF, 0xF, true)); }
DI float sum8(float v) {
    v += dpp_mov<0xB1>(v);
    v += dpp_mov<0x4E>(v);
    v += dpp_mov<0x141>(v);
    return v;
}
DI float sum16(float v) { v = sum8(v); v += dpp_mov<0x140>(v); return v; }
DI float wave_sum(float v) { v = sum16(v); v += __shfl_xor(v, 16); v += __shfl_xor(v, 32); return v; }
DI int tid_() { int t = threadIdx.x; asm volatile("" : "+v"(t)); return t; }
DI float sigmoidf_(float x) { return 1.0f / (1.0f + __expf(-x)); }
DI void wave_sync() { asm volatile("s_waitcnt lgkmcnt(0)" ::: "memory"); __builtin_amdgcn_wave_barrier(); }

DI float* hrow2(float* hmeta, float* out, int tok) {
    const int b = tok >= L ? 1 : 0, t = tok - b * L;
    return t < NMETA ? hmeta + (size_t)(b * NMETA + t) * D : out + ((size_t)b * SEQ + (t - NMETA)) * D;
}
DI float* hrow(const Params& p, int tok) { return hrow2(p.hmeta, p.out, tok); }

DI void transpose_convert(const float* __restrict__ src, int ld, int K, int N, bf16_t* __restrict__ dst, int mult, int off, int bid, int nb, char* smem) {
    float* tile = (float*)smem;
    const int tk = K / 64, tn = N / 64, tid = tid_();
    for (int t = bid; t < tk * tn; t += nb) {
        const int k0 = (t / tn) * 64, n0 = (t % tn) * 64;
        __syncthreads();
#pragma unroll
        for (int i = 0; i < 2; ++i) {
            const int k = (tid >> 4) + 32 * i, n4 = (tid & 15) * 4;
            const f32x4 v = *(const f32x4*)(src + (size_t)(k0 + k) * ld + n0 + n4);
            tile[k * 65 + n4 + 0] = v[0]; tile[k * 65 + n4 + 1] = v[1]; tile[k * 65 + n4 + 2] = v[2]; tile[k * 65 + n4 + 3] = v[3];
        }
        __syncthreads();
        const int n = tid >> 3, kc = (tid & 7) * 8;
        u32x4 o;
#pragma unroll
        for (int j = 0; j < 4; ++j) o[j] = pack2(tile[(kc + 2 * j) * 65 + n], tile[(kc + 2 * j + 1) * 65 + n]);
        *(u32x4*)(dst + (size_t)((n0 + n) * mult + off) * K + k0 + kc) = o;
    }
}

DI void convert_experts(const Params& p, int layer, int bid, int nb, char* smem) {
    for (int e = 0; e < NE; ++e) {
        const size_t eo = ((size_t)layer * NE + e) * (size_t)D * DE;
        transpose_convert(p.ew_gate + eo, DE, D, DE, p.WtGU + (size_t)e * 1024 * 1024, 2, 0, bid, nb, smem);
        transpose_convert(p.ew_up + eo, DE, D, DE, p.WtGU + (size_t)e * 1024 * 1024, 2, 1, bid, nb, smem);
        transpose_convert(p.ew_down + eo, D, DE, D, p.WtD + (size_t)e * 1024 * 512, 1, 0, bid, nb, smem);
    }
}

DI void phase_prologue_weights(const Params& p, int bid, int nb, char* smem) {
    for (int l = 0; l < DEPTH; ++l) {
        transpose_convert(p.w_in + (size_t)l * D * CIN, CIN, D, CIN, p.WtIn + (size_t)l * CIN * D, 1, 0, bid, nb, smem);
        transpose_convert(p.p_sb + (size_t)l * 512 * D, D, 512, D, p.WtPsb + (size_t)l * D * 512, 1, 0, bid, nb, smem);
        transpose_convert(p.p_rwkv + (size_t)l * 512 * D, D, 512, D, p.WtPrw + (size_t)l * D * 512, 1, 0, bid, nb, smem);
        transpose_convert(p.w_out + (size_t)l * D * D, D, D, D, p.WtOut + (size_t)l * D * D, 1, 0, bid, nb, smem);
        transpose_convert(p.w_up + (size_t)l * 64 * 512, 512, 64, 512, p.WupT + (size_t)l * 512 * 64, 1, 0, bid, nb, smem);
        transpose_convert(p.a_up + (size_t)l * 64 * 512, 512, 64, 512, p.AupT + (size_t)l * 512 * 64, 1, 0, bid, nb, smem);
        transpose_convert(p.g_up + (size_t)l * 128 * 512, 512, 128, 512, p.GupT + (size_t)l * 512 * 128, 1, 0, bid, nb, smem);
    }
}

DI void ln16(float (&v)[16], const float* __restrict__ g, const float* __restrict__ b, int lane) {
    float s = 0.f;
#pragma unroll
    for (int i = 0; i < 16; ++i) s += v[i];
    const float mean = wave_sum(s) * (1.0f / D);
    float q = 0.f;
#pragma unroll
    for (int i = 0; i < 16; ++i) { v[i] -= mean; q += v[i] * v[i]; }
    const float rstd = rsqrtf(wave_sum(q) * (1.0f / D) + 1e-5f);
#pragma unroll
    for (int j = 0; j < 4; ++j) {
        const f32x4 gv = *(const f32x4*)(g + 256 * j + 4 * lane), bv = *(const f32x4*)(b + 256 * j + 4 * lane);
#pragma unroll
        for (int i = 0; i < 4; ++i) v[4 * j + i] = v[4 * j + i] * rstd * gv[i] + bv[i];
    }
}
DI void store_row(float* __restrict__ hf, bf16_t* __restrict__ hb, const float (&v)[16], int lane) {
#pragma unroll
    for (int j = 0; j < 4; ++j) {
        *(f32x4*)(hf + 256 * j + 4 * lane) = (f32x4){v[4 * j], v[4 * j + 1], v[4 * j + 2], v[4 * j + 3]};
        *(u32x2*)(hb + 256 * j + 4 * lane) = (u32x2){pack2(v[4 * j], v[4 * j + 1]), pack2(v[4 * j + 2], v[4 * j + 3])};
    }
}

DI void phase_embed(const Params& p, int bid, int nb) {
    const int lane = tid_() & 63, wid = __builtin_amdgcn_readfirstlane(tid_() >> 6);
    for (int tok = bid * 8 + wid; tok < T; tok += nb * 8) {
        const int b = tok >= L ? 1 : 0, t = tok - b * L;
        const float* src = t < NMETA ? p.meta + (size_t)t * D : p.x + ((size_t)b * SEQ + (t - NMETA)) * D;
        float v[16];
#pragma unroll
        for (int j = 0; j < 4; ++j) { const f32x4 a = *(const f32x4*)(src + 256 * j + 4 * lane); v[4 * j] = a[0]; v[4 * j + 1] = a[1]; v[4 * j + 2] = a[2]; v[4 * j + 3] = a[3]; }
        ln16(v, p.emb_g, p.emb_b, lane);
        store_row(hrow(p, tok), p.hb + (size_t)tok * D, v, lane);
    }
}

constexpr int LDT = 72;
constexpr int GEMM_LDS = 2 * 128 * LDT * 2;
template <class ARow, class Epi>
DI void gemm_tile128(ARow arow, const bf16_t* __restrict__ Bt, int ldb, int K, int m0, int n0, char* smem, Epi epi) {
    const int tid = tid_(), lane = tid & 63, wid = __builtin_amdgcn_readfirstlane(tid >> 6), fr = lane & 15, fq = lane >> 4;
    const int wr = wid >> 1, wc = wid & 1;
    bf16_t* As = (bf16_t*)smem;
    bf16_t* Bs = As + 128 * LDT;
    const bf16_t* ap[2]; const bf16_t* bp[2]; int so[2];
#pragma unroll
    for (int i = 0; i < 2; ++i) {
        const int c = tid + NTHR * i, row = c >> 3, kc = c & 7;
        const bf16_t* ar = arow(m0 + row);
        ap[i] = ar ? ar + kc * 8 : nullptr;
        bp[i] = Bt + (size_t)(n0 + row) * ldb + kc * 8;
        so[i] = row * LDT + kc * 8;
    }
    f32x4 acc[2][4];
#pragma unroll
    for (int mi = 0; mi < 2; ++mi)
#pragma unroll
        for (int ni = 0; ni < 4; ++ni) acc[mi][ni] = (f32x4){0.f, 0.f, 0.f, 0.f};
    u32x4 ra[2], rb[2];
#pragma unroll
    for (int i = 0; i < 2; ++i) { ra[i] = ap[i] ? *(const u32x4*)(ap[i]) : (u32x4){0u, 0u, 0u, 0u}; rb[i] = *(const u32x4*)(bp[i]); }
    for (int k0 = 0; k0 < K; k0 += 64) {
        __syncthreads();
#pragma unroll
        for (int i = 0; i < 2; ++i) { *(u32x4*)(As + so[i]) = ra[i]; *(u32x4*)(Bs + so[i]) = rb[i]; }
        __syncthreads();
        if (k0 + 64 < K) {
#pragma unroll
            for (int i = 0; i < 2; ++i) { ra[i] = ap[i] ? *(const u32x4*)(ap[i] + k0 + 64) : (u32x4){0u, 0u, 0u, 0u}; rb[i] = *(const u32x4*)(bp[i] + k0 + 64); }
        }
#pragma unroll
        for (int ks = 0; ks < 2; ++ks) {
            bf16x8 af[2], bf[4];
#pragma unroll
            for (int mi = 0; mi < 2; ++mi) af[mi] = *(const bf16x8*)(As + (wr * 32 + mi * 16 + fr) * LDT + ks * 32 + fq * 8);
#pragma unroll
            for (int ni = 0; ni < 4; ++ni) bf[ni] = *(const bf16x8*)(Bs + (wc * 64 + ni * 16 + fr) * LDT + ks * 32 + fq * 8);
#pragma unroll
            for (int mi = 0; mi < 2; ++mi)
#pragma unroll
                for (int ni = 0; ni < 4; ++ni) acc[mi][ni] = __builtin_amdgcn_mfma_f32_16x16x32_bf16(bf[ni], af[mi], acc[mi][ni], 0, 0, 0);
        }
    }
#pragma unroll
    for (int mi = 0; mi < 2; ++mi)
#pragma unroll
        for (int ni = 0; ni < 4; ++ni) epi(m0 + wr * 32 + mi * 16 + fr, n0 + wc * 64 + ni * 16 + fq * 4, acc[mi][ni]);
}

DI void phase_inproj(const Params& p, int layer, int bid, int nb, char* smem) {
    const bf16_t* hb = p.hb; bf16_t* P = p.P;
    const bf16_t* Bt = p.WtIn + (size_t)layer * CIN * D;
    constexpr int NT = CP / 128, MT = TP / 128;
    for (int t = bid; t < MT * NT; t += nb) {
        const int m0 = (t / NT) * 128, n0 = (t % NT) * 128;
        gemm_tile128([=](int r) { return r < T ? hb + (size_t)r * D : (const bf16_t*)nullptr; }, Bt, D, D, m0, n0, smem,
                     [=](int r, int c, f32x4 v) { if (r < T) *(u32x2*)(P + (size_t)r * CP + c) = (u32x2){pack2(v[0], v[1]), pack2(v[2], v[3])}; });
    }
}

constexpr int NCHUNK = (L + 63) / 64, NUNIT = NBATCH * HEADS * NCHUNK;
constexpr int LS = 72, RB = 64 * LS * 2;
constexpr int R1_LDS = 16 * RB + 4096;
#define RBUF(i) ((bf16_t*)(smem + (i) * RB))
typedef float f32x16 __attribute__((ext_vector_type(16)));

template <int KK> DI f32x4 mm16(const bf16_t* F, int ldf, const bf16_t* S, int lds_, f32x4 acc, int lane) {
    const int fr = lane & 15, fq = lane >> 4;
#pragma unroll
    for (int ks = 0; ks < KK / 32; ++ks) {
        const bf16x8 f = *(const bf16x8*)(F + fr * ldf + ks * 32 + fq * 8);
        const bf16x8 g = *(const bf16x8*)(S + fr * lds_ + ks * 32 + fq * 8);
        acc = __builtin_amdgcn_mfma_f32_16x16x32_bf16(f, g, acc, 0, 0, 0);
    }
    return acc;
}
DI u32x2 pk4(f32x4 v) { return (u32x2){pack2(v[0], v[1]), pack2(v[2], v[3])}; }
DI f32x4 up4(u32x2 v) { return (f32x4){lo_bf(v[0]), hi_bf(v[0]), lo_bf(v[1]), hi_bf(v[1])}; }

DI void phase_rwkv_r1(const Params& p, int layer, int bid, int nb, char* smem) {
    const int tid = tid_(), lane = tid & 63, wv = __builtin_amdgcn_readfirstlane(tid >> 6), fr = lane & 15, fq = lane >> 4;
    const f32x4 zero = (f32x4){0.f, 0.f, 0.f, 0.f};
    float* lwT = (float*)RBUF(4);
    float* aT = (float*)RBUF(6);
    float* gt = (float*)(smem + 16 * RB);
    float* gammaC = gt + 512;
    bf16_t* Xt0 = RBUF(14);
    bf16_t* Xt1 = RBUF(4);
    const bf16_t* WupT = p.WupT + (size_t)layer * 512 * 64, *AupT = p.AupT + (size_t)layer * 512 * 64, *GupT = p.GupT + (size_t)layer * 512 * 128;
    const float* mu = p.mu + (size_t)layer * RSW;
    for (int u = bid; u < NUNIT; u += nb) {
        const int c = u % NCHUNK, bh = u / NCHUNK, h = bh % HEADS, bb = bh / HEADS;
        const size_t tok0 = (size_t)bb * L + c * 64;
        __syncthreads();
#pragma unroll
        for (int it = 0; it < 7; ++it) {
            const int cid = tid + NTHR * it, i = cid / 56, cc = cid % 56;
            int col; bf16_t* dst;
            if (cc < 8) { col = RW_R + h * 64 + cc * 8; dst = RBUF(8) + i * LS + cc * 8; }
            else if (cc < 16) { col = RW_K + h * 64 + (cc - 8) * 8; dst = RBUF(9) + i * LS + (cc - 8) * 8; }
            else if (cc < 24) { col = RW_V + h * 64 + (cc - 16) * 8; dst = RBUF(10) + i * LS + (cc - 16) * 8; }
            else if (cc < 32) { col = RW_WD + (cc - 24) * 8; dst = RBUF(0) + i * LS + (cc - 24) * 8; }
            else if (cc < 40) { col = RW_AD + (cc - 32) * 8; dst = RBUF(1) + i * LS + (cc - 32) * 8; }
            else { col = RW_GD + (cc - 40) * 8; dst = RBUF(2) + i * 136 + (cc - 40) * 8; }
            const int t = c * 64 + i;
            u32x4 cur = (u32x4){0u, 0u, 0u, 0u}, prv = (u32x4){0u, 0u, 0u, 0u};
            if (t < L) cur = *(const u32x4*)(p.P + (tok0 + i) * CP + OFF_RW + col);
            if (t < L && t > 0) prv = *(const u32x4*)(p.P + (tok0 + i - 1) * CP + OFF_RW + col);
            const f32x4 m0 = *(const f32x4*)(mu + col), m1 = *(const f32x4*)(mu + col + 4);
            float x[8];
#pragma unroll
            for (int j = 0; j < 4; ++j) {
                const float c0 = lo_bf(cur[j]), c1 = hi_bf(cur[j]), p0 = lo_bf(prv[j]), p1 = hi_bf(prv[j]);
                const float mm0 = j < 2 ? m0[2 * j] : m1[2 * j - 4], mm1 = j < 2 ? m0[2 * j + 1] : m1[2 * j - 3];
                x[2 * j] = c0 + (p0 - c0) * mm0; x[2 * j + 1] = c1 + (p1 - c1) * mm1;
            }
            if (cc >= 24 && cc < 32) {
#pragma unroll
                for (int j = 0; j < 8; ++j) x[j] = tanhf(x[j]);
            } else if (cc >= 40) {
#pragma unroll
                for (int j = 0; j < 8; ++j) x[j] = sigmoidf_(x[j]);
            }
            *(u32x4*)dst = (u32x4){pack2(x[0], x[1]), pack2(x[2], x[3]), pack2(x[4], x[5]), pack2(x[6], x[7])};
        }
        __syncthreads();
#pragma unroll 1
        for (int tl = wv * 2; tl < wv * 2 + 2; ++tl) {
            const int pt = tl >> 2, qt = tl & 3;
            const f32x4 aw = mm16<64>(RBUF(0) + pt * 16 * LS, LS, WupT + (size_t)(h * 64 + qt * 16) * 64, 64, zero, lane);
            const f32x4 aa = mm16<64>(AupT + (size_t)(h * 64 + pt * 16) * 64, 64, RBUF(1) + qt * 16 * LS, LS, zero, lane);
            const int ch = qt * 16 + fr;
            const float w0 = p.w0[layer * 512 + h * 64 + ch];
            const f32x4 a0 = *(const f32x4*)(p.a0 + layer * 512 + h * 64 + pt * 16 + fq * 4);
            f32x4 lw, av;
#pragma unroll
            for (int e = 0; e < 4; ++e) { lw[e] = -DECAY_SCALE * sigmoidf_(w0 + aw[e]); av[e] = sigmoidf_(a0[e] + aa[e]); }
            *(f32x4*)(lwT + ch * 68 + pt * 16 + fq * 4) = lw;
            *(f32x4*)(aT + (qt * 16 + fr) * 68 + pt * 16 + fq * 4) = av;
            const f32x4 ag = mm16<128>(GupT + (size_t)(h * 64 + pt * 16) * 128, 128, RBUF(2) + qt * 16 * 136, 136, zero, lane);
            *(u32x2*)(p.GG + ((size_t)u * 64 + qt * 16 + fr) * 64 + pt * 16 + fq * 4) = pk4(ag);
        }
        __syncthreads();
        {
            const int i = tid >> 3, c8 = (tid & 7) * 8, cg = layer * 512 + h * 64 + c8;
            const u32x4 xr = *(const u32x4*)(RBUF(8) + i * LS + c8), xk = *(const u32x4*)(RBUF(9) + i * LS + c8);
            const f32x4 a0 = *(const f32x4*)(aT + i * 68 + c8), a1 = *(const f32x4*)(aT + i * 68 + c8 + 4);
            const f32x4 kk0 = *(const f32x4*)(p.k_k + cg), kk1 = *(const f32x4*)(p.k_k + cg + 4), ka0 = *(const f32x4*)(p.k_a + cg), ka1 = *(const f32x4*)(p.k_a + cg + 4);
            const f32x4 rk0 = *(const f32x4*)(p.r_k + cg), rk1 = *(const f32x4*)(p.r_k + cg + 4);
            float n2 = 0.f, bon = 0.f;
#pragma unroll
            for (int j = 0; j < 8; ++j) {
                const float r_ = (j & 1) ? hi_bf(xr[j >> 1]) : lo_bf(xr[j >> 1]), k_ = (j & 1) ? hi_bf(xk[j >> 1]) : lo_bf(xk[j >> 1]);
                const float a_ = j < 4 ? a0[j & 3] : a1[j & 3], kkc = j < 4 ? kk0[j & 3] : kk1[j & 3], kac = j < 4 ? ka0[j & 3] : ka1[j & 3], rkc = j < 4 ? rk0[j & 3] : rk1[j & 3];
                const float kkr = k_ * kkc;
                n2 += kkr * kkr;
                bon += r_ * (k_ * (1.0f + (a_ - 1.0f) * kac)) * rkc;
            }
            n2 = sum8(n2); bon = sum8(bon);
            if ((tid & 7) == 0) { gt[576 + i] = 1.0f / fmaxf(sqrtf(n2), 1e-12f); p.bonG[(size_t)u * 64 + i] = bon; }
        }
        __syncthreads();
        {
            const int ch = lane, cg = layer * 512 + h * 64 + ch;
            float lw[8], av[8], cum[8];
            {
                const f32x4 l0 = *(const f32x4*)(lwT + ch * 68 + wv * 8), l1 = *(const f32x4*)(lwT + ch * 68 + wv * 8 + 4);
#pragma unroll
                for (int e = 0; e < 4; ++e) { lw[e] = l0[e]; lw[e + 4] = l1[e]; }
#pragma unroll
                for (int e = 0; e < 8; ++e) av[e] = aT[(wv * 8 + e) * 68 + ch];
            }
            float run = 0.f;
#pragma unroll
            for (int e = 0; e < 8; ++e) { run += lw[e]; cum[e] = run; }
            gt[wv * 64 + ch] = run;
            __syncthreads();
            float offs = 0.f, tot = 0.f;
#pragma unroll
            for (int g2 = 0; g2 < 8; ++g2) { const float gv = gt[g2 * 64 + ch]; offs += g2 < wv ? gv : 0.f; tot += gv; }
            if (wv == 0) gammaC[ch] = __expf(tot);
            const float kkc = p.k_k[cg], kac = p.k_a[cg];
            float at_[8], kt_[8], bt_[8], vt_[8];
#pragma unroll
            for (int e = 0; e < 8; ++e) {
                const int i = wv * 8 + e;
                const float xr = bf2f(RBUF(8)[i * LS + ch]), xk = bf2f(RBUF(9)[i * LS + ch]), xv = bf2f(RBUF(10)[i * LS + ch]);
                const float cm = cum[e] + offs;
                const float kk = xk * kkc * gt[576 + i];
                const float kq = xk * (1.0f + (av[e] - 1.0f) * kac);
                if (c * 64 + i < L) p.orw[(tok0 + i) * 512 + h * 64 + ch] = RBUF(10)[i * LS + ch];
                const float eneg = __expf(-cm), epos = __expf(cm), eexc = __expf(cm - lw[e]);
                at_[e] = -kk * eexc; kt_[e] = kq * eneg; bt_[e] = kk * av[e] * eneg; vt_[e] = xv;
                RBUF(3)[i * LS + ch] = f2bf(xr * epos);
            }
            __syncthreads();
#pragma unroll
            for (int e = 0; e < 8; ++e) {
                const int i = wv * 8 + e;
                RBUF(0)[i * LS + ch] = f2bf(at_[e]); RBUF(1)[i * LS + ch] = f2bf(kt_[e]); RBUF(2)[i * LS + ch] = f2bf(bt_[e]);
            }
            *(u32x4*)(RBUF(11) + ch * LS + wv * 8) = (u32x4){pack2(kt_[0], kt_[1]), pack2(kt_[2], kt_[3]), pack2(kt_[4], kt_[5]), pack2(kt_[6], kt_[7])};
            *(u32x4*)(RBUF(12) + ch * LS + wv * 8) = (u32x4){pack2(bt_[0], bt_[1]), pack2(bt_[2], bt_[3]), pack2(bt_[4], bt_[5]), pack2(bt_[6], bt_[7])};
            *(u32x4*)(RBUF(13) + ch * LS + wv * 8) = (u32x4){pack2(vt_[0], vt_[1]), pack2(vt_[2], vt_[3]), pack2(vt_[4], vt_[5]), pack2(vt_[6], vt_[7])};
            *(u32x4*)(Xt0 + ch * LS + wv * 8) = (u32x4){pack2(at_[0], at_[1]), pack2(at_[2], at_[3]), pack2(at_[4], at_[5]), pack2(at_[6], at_[7])};
        }
        __syncthreads();
#pragma unroll
        for (int prod = 0; prod < 5; ++prod) {
            const bf16_t* F = prod == 0 ? RBUF(1) : prod == 1 ? RBUF(2) : prod == 2 ? RBUF(0) : prod == 3 ? RBUF(1) : RBUF(2);
            const bf16_t* S = prod == 0 ? RBUF(0) : prod == 1 ? RBUF(0) : prod == 2 ? RBUF(2) : RBUF(3);
            bf16_t* O = prod == 0 ? RBUF(6) : prod == 1 ? RBUF(7) : prod == 2 ? RBUF(8) : prod == 3 ? RBUF(9) : RBUF(10);
            const int mode = prod < 2 ? 0 : prod == 2 ? 2 : 1;
#pragma unroll
            for (int rep = 0; rep < 2; ++rep) {
                const int tl = wv + 8 * rep, pt = tl >> 2, qt = tl & 3;
                f32x4 acc = mm16<64>(F + pt * 16 * LS, LS, S + qt * 16 * LS, LS, zero, lane);
                const int qi = qt * 16 + fr;
#pragma unroll
                for (int e = 0; e < 4; ++e) {
                    const int pi = pt * 16 + fq * 4 + e;
                    const bool keep = mode == 0 ? pi < qi : (mode == 1 ? pi <= qi : qi < pi);
                    acc[e] = keep ? acc[e] : 0.f;
                }
                *(u32x2*)(O + qi * LS + pt * 16 + fq * 4) = pk4(acc);
            }
        }
        __syncthreads();
        f32x4 X[4];
        if (wv < 4) {
#pragma unroll
            for (int pt = 0; pt < 4; ++pt) X[pt] = up4(*(const u32x2*)(Xt0 + (wv * 16 + fr) * LS + pt * 16 + fq * 4));
        } else {
#pragma unroll
            for (int pt = 0; pt < 4; ++pt) {
                X[pt] = mm16<64>(RBUF(6) + pt * 16 * LS, LS, RBUF(13) + (wv - 4) * 16 * LS, LS, zero, lane);
                *(u32x2*)(Xt0 + (wv * 16 + fr) * LS + pt * 16 + fq * 4) = pk4(X[pt]);
            }
        }
        __syncthreads();
#pragma unroll
        for (int k = 0; k < 6; ++k) {
            const bf16_t* Mk = (k & 1) ? RBUF(0) : RBUF(7);
            const bf16_t* Mkt = (k & 1) ? RBUF(6) : RBUF(8);
            bf16_t* Mn = (k & 1) ? RBUF(7) : RBUF(0);
            bf16_t* Mnt = (k & 1) ? RBUF(8) : RBUF(6);
            const bf16_t* Xc = (k & 1) ? Xt1 : Xt0;
            bf16_t* Xn = (k & 1) ? Xt0 : Xt1;
#pragma unroll
            for (int pt = 0; pt < 4; ++pt) {
                X[pt] = mm16<64>(Mk + pt * 16 * LS, LS, Xc + wv * 16 * LS, LS, X[pt], lane);
                *(u32x2*)(Xn + (wv * 16 + fr) * LS + pt * 16 + fq * 4) = pk4(X[pt]);
            }
            if (k < 5) {
#pragma unroll
                for (int which = 0; which < 2; ++which) {
                    const bf16_t* F = which ? Mk : Mkt; const bf16_t* S = which ? Mkt : Mk; bf16_t* O = which ? Mnt : Mn;
#pragma unroll
                    for (int rep = 0; rep < 2; ++rep) {
                        const int t2 = wv + 8 * rep, pt = t2 >> 2, qt = t2 & 3;
                        const f32x4 acc = mm16<64>(F + pt * 16 * LS, LS, S + qt * 16 * LS, LS, zero, lane);
                        *(u32x2*)(O + (qt * 16 + fr) * LS + pt * 16 + fq * 4) = pk4(acc);
                    }
                }
            }
            __syncthreads();
        }
#pragma unroll
        for (int rep = 0; rep < 2; ++rep) {
            const int tl = wv + 8 * rep, pt = tl >> 2, qt = tl & 3;
            const int pi0 = pt * 16 + fq * 4, qi = qt * 16 + fr;
            const size_t go = ((size_t)u * 64 + qi) * 64 + pi0;
            {
                f32x4 acc = mm16<64>(Xt0 + pt * 16 * LS, LS, RBUF(12) + qt * 16 * LS, LS, zero, lane);
                const float gc = gammaC[qi];
#pragma unroll
                for (int e = 0; e < 4; ++e) acc[e] = (acc[e] + (pi0 + e == qi ? 1.f : 0.f)) * gc;
                {
                    const size_t d = (((size_t)u * 8 + (qi >> 5) * 4 + (pi0 >> 4)) * 64 + (qi & 31) + 32 * ((pi0 >> 2) & 1)) * 8 + ((pi0 >> 3) & 1) * 4;
                    *(u32x2*)(p.PcG + d) = pk4(acc);
                }
            }
            {
                f32x4 acc = mm16<64>(RBUF(11) + pt * 16 * LS, LS, RBUF(13) + qt * 16 * LS, LS, zero, lane);
                acc = mm16<64>(RBUF(12) + pt * 16 * LS, LS, Xt0 + (64 + qt * 16) * LS, LS, acc, lane);
                const f32x4 gc = *(const f32x4*)(gammaC + pi0);
#pragma unroll
                for (int e = 0; e < 4; ++e) acc[e] *= gc[e];
                {
                    const int kk = pi0 & 31;
                    const size_t d = (((size_t)u * 4 + (qi >> 5) * 2 + (pi0 >> 5)) * 64 + (qi & 31) + 32 * ((kk >> 2) & 1)) * 16 + (kk >> 3) * 4;
                    *(u32x2*)(p.QcG + d) = pk4(acc);
                }
            }
            {
                f32x4 acc = mm16<64>(Xt0 + pt * 16 * LS, LS, RBUF(10) + qt * 16 * LS, LS, zero, lane);
                const f32x4 rr = up4(*(const u32x2*)(RBUF(3) + qi * LS + pi0));
#pragma unroll
                for (int e = 0; e < 4; ++e) acc[e] += rr[e];
                *(u32x2*)(p.RhG + go) = pk4(acc);
            }
            {
                f32x4 acc = mm16<64>(RBUF(13) + pt * 16 * LS, LS, RBUF(9) + qt * 16 * LS, LS, zero, lane);
                acc = mm16<64>(Xt0 + (64 + pt * 16) * LS, LS, RBUF(10) + qt * 16 * LS, LS, acc, lane);
                *(u32x2*)(p.Y0G + go) = pk4(acc);
            }
        }
    }
}

struct R2Set { u32x4 a[8]; u32x4 q[4]; };
DI void r2_load(R2Set& st, const Params& p, size_t u, int lane, int vh) {
#pragma unroll
    for (int kt = 0; kt < 2; ++kt) {
        const bf16_t* qg = p.QcG + ((u * 4 + vh * 2 + kt) * 64 + lane) * 16;
        st.q[kt * 2] = *(const u32x4*)qg; st.q[kt * 2 + 1] = *(const u32x4*)(qg + 8);
    }
#pragma unroll
    for (int f = 0; f < 8; ++f) st.a[f] = *(const u32x4*)(p.PcG + ((u * 8 + f) * 64 + lane) * 8);
}
DI void r2_step(f32x16 (&S)[2], const R2Set& st, const Params& p, size_t u, int lane, int vh, bool last) {
#pragma unroll
    for (int kt = 0; kt < 2; ++kt) {
        bf16_t* sg = p.SG + ((u * 4 + vh * 2 + kt) * 64 + lane) * 16;
        *(u32x4*)sg = (u32x4){pack2(S[kt][0], S[kt][1]), pack2(S[kt][2], S[kt][3]), pack2(S[kt][4], S[kt][5]), pack2(S[kt][6], S[kt][7])};
        *(u32x4*)(sg + 8) = (u32x4){pack2(S[kt][8], S[kt][9]), pack2(S[kt][10], S[kt][11]), pack2(S[kt][12], S[kt][13]), pack2(S[kt][14], S[kt][15])};
    }
    if (last) return;
    bf16x8 bfr[4];
#pragma unroll
    for (int ts = 0; ts < 4; ++ts) {
        const int tl = ts >> 1, sp = ts & 1;
        const u32x4 pk = (u32x4){pack2(S[tl][8 * sp], S[tl][8 * sp + 1]), pack2(S[tl][8 * sp + 2], S[tl][8 * sp + 3]),
                                 pack2(S[tl][8 * sp + 4], S[tl][8 * sp + 5]), pack2(S[tl][8 * sp + 6], S[tl][8 * sp + 7])};
        bfr[ts] = __builtin_bit_cast(bf16x8, pk);
    }
#pragma unroll
    for (int kt = 0; kt < 2; ++kt)
#pragma unroll
        for (int hf = 0; hf < 2; ++hf)
#pragma unroll
            for (int w = 0; w < 4; ++w) { S[kt][8 * hf + 2 * w] = lo_bf(st.q[kt * 2 + hf][w]); S[kt][8 * hf + 2 * w + 1] = hi_bf(st.q[kt * 2 + hf][w]); }
#pragma unroll
    for (int ts = 0; ts < 4; ++ts)
#pragma unroll
        for (int kt = 0; kt < 2; ++kt)
            S[kt] = __builtin_amdgcn_mfma_f32_32x32x16_bf16(__builtin_bit_cast(bf16x8, st.a[kt * 4 + ts]), bfr[ts], S[kt], 0, 0, 0);
}
DI void phase_rwkv_r2(const Params& p, int chain) {
    const int lane = tid_() & 63, wv = __builtin_amdgcn_readfirstlane(tid_() >> 6);
    if (wv != 0) return;
    const int bh = chain >> 1, vh = chain & 1;
    const size_t u0 = (size_t)bh * NCHUNK;
    f32x16 S[2];
#pragma unroll
    for (int e = 0; e < 16; ++e) { S[0][e] = 0.f; S[1][e] = 0.f; }
    R2Set A, B;
    r2_load(A, p, u0, lane, vh);
    r2_load(B, p, u0 + 1, lane, vh);
#pragma unroll 1
    for (int c = 0; c < NCHUNK; c += 2) {
        r2_step(S, A, p, u0 + c, lane, vh, c == NCHUNK - 1);
        if (c == NCHUNK - 1) break;
        if (c + 2 < NCHUNK - 1) r2_load(A, p, u0 + c + 2, lane, vh);
        r2_step(S, B, p, u0 + c + 1, lane, vh, false);
        if (c + 3 < NCHUNK - 1) r2_load(B, p, u0 + c + 3, lane, vh);
    }
}

DI void phase_rwkv_r3(const Params& p, int layer, int bid, int nb) {
    const int tid = tid_(), lane = tid & 63, wv = __builtin_amdgcn_readfirstlane(tid >> 6), fr = lane & 15, fq = lane >> 4;
    for (int task = bid * 8 + wv; task < NUNIT * 4; task += nb * 8) {
        const int u = task >> 2, it = task & 3;
        const int c = u % NCHUNK, bh = u / NCHUNK, h = bh % HEADS, bb = bh / HEADS;
        const int i = it * 16 + fr, t = c * 64 + i;
        const size_t tok = (size_t)bb * L + t;
        bf16x8 sf[2];
#pragma unroll
        for (int ks = 0; ks < 2; ++ks) sf[ks] = *(const bf16x8*)(p.RhG + ((size_t)u * 64 + i) * 64 + ks * 32 + fq * 8);
        f32x4 y[4];
#pragma unroll
        for (int vt = 0; vt < 4; ++vt) {
            y[vt] = up4(*(const u32x2*)(p.Y0G + ((size_t)u * 64 + i) * 64 + vt * 16 + fq * 4));
#pragma unroll
            for (int ks = 0; ks < 2; ++ks) {
                const int vv = vt * 16 + fr;
                const bf16_t* sp = p.SG + (((size_t)u * 4 + (vv >> 5) * 2 + ks) * 64 + (vv & 31)) * 16 + 4 * fq;
                const u32x2 s0 = *(const u32x2*)sp, s1 = *(const u32x2*)(sp + 32 * 16);
                const bf16x8 f = __builtin_bit_cast(bf16x8, ((u32x4){s0[0], s0[1], s1[0], s1[1]}));
                y[vt] = __builtin_amdgcn_mfma_f32_16x16x32_bf16(f, sf[ks], y[vt], 0, 0, 0);
            }
        }
        float s = 0.f;
#pragma unroll
        for (int vt = 0; vt < 4; ++vt) s += (y[vt][0] + y[vt][1]) + (y[vt][2] + y[vt][3]);
        s += __shfl_xor(s, 16); s += __shfl_xor(s, 32);
        const float mean = s * (1.0f / 64.f);
        float q = 0.f;
#pragma unroll
        for (int vt = 0; vt < 4; ++vt)
#pragma unroll
            for (int e = 0; e < 4; ++e) { y[vt][e] -= mean; q += y[vt][e] * y[vt][e]; }
        q += __shfl_xor(q, 16); q += __shfl_xor(q, 32);
        const float rstd = rsqrtf(q * (1.0f / 64.f) + 64e-5f);
        if (t < L) {
            const float bon = p.bonG[(size_t)u * 64 + i];
#pragma unroll
            for (int vt = 0; vt < 4; ++vt) {
                const int v0 = vt * 16 + fq * 4, cg = h * 64 + v0;
                const f32x4 xv = up4(*(const u32x2*)(p.orw + tok * 512 + cg));
                const f32x4 g = up4(*(const u32x2*)(p.GG + ((size_t)u * 64 + i) * 64 + v0));
                const f32x4 lg = *(const f32x4*)(p.lnx_g + layer * 512 + cg), lb = *(const f32x4*)(p.lnx_b + layer * 512 + cg);
                f32x4 o;
#pragma unroll
                for (int e = 0; e < 4; ++e) {
                    o[e] = (y[vt][e] * rstd * lg[e] + lb[e] + bon * xv[e]) * g[e];
                }
                *(u32x2*)(p.orw + tok * 512 + cg) = pk4(o);
            }
        }
    }
}

constexpr int SB_LDS = 2 * RB + 64;
DI void phase_sb(const Params& p, int bid0, int nb, char* smem) {
    const int tid = tid_(), lane = tid & 63, wv = __builtin_amdgcn_readfirstlane(tid >> 6), fr = lane & 15, fq = lane >> 4;
    bf16_t* Ks = (bf16_t*)smem;
    bf16_t* Vt = Ks + 64 * LS;
    int* flags = (int*)(smem + 2 * RB);
    bf16x8 tri[4][2];
#pragma unroll
    for (int st = 0; st < 4; ++st)
#pragma unroll
        for (int k2 = 0; k2 < 2; ++k2)
#pragma unroll
            for (int jj = 0; jj < 8; ++jj) tri[st][k2][jj] = (32 * k2 + 16 * (jj >> 2) + 4 * fq + (jj & 3) > 16 * st + fr) ? (short)0x3F80 : (short)0;
    constexpr int NQB = (L + 127) / 128;
    const int ldkey = tid >> 3, lddc = (tid & 7) * 8;
    for (int u = bid0; u < NBATCH * HEADS * NQB; u += nb) {
        const int bh = u % (NBATCH * HEADS), b = bh / HEADS, h = bh % HEADS, q0 = (u / (NBATCH * HEADS)) * 128;
        const int qlo = q0 + 16 * wv, query = qlo + fr;
        const size_t tokb = (size_t)b * L;
        bf16x8 qf[2];
#pragma unroll
        for (int ks = 0; ks < 2; ++ks) qf[ks] = *(const bf16x8*)(p.P + (tokb + query) * CP + OFF_Q + h * 64 + ks * 32 + fq * 8);
        const int qmax = (q0 + 127 < L - 1) ? q0 + 127 : L - 1;
        int kt = (qmax - 1) >> 6;
        float R = 0.f;
        f32x4 ot[4];
#pragma unroll
        for (int dt = 0; dt < 4; ++dt) ot[dt] = (f32x4){0.f, 0.f, 0.f, 0.f};
        bool done = qlo >= L;
        u32x4 kreg, vreg;
        {
            const int s = kt * 64 + ldkey;
            const bf16_t* src = p.P + (tokb + s) * CP + h * 64 + lddc;
            kreg = s < L ? *(const u32x4*)(src + OFF_K) : (u32x4){0u, 0u, 0u, 0u};
            vreg = s < L ? *(const u32x4*)(src + OFF_V) : (u32x4){0u, 0u, 0u, 0u};
        }
        for (;;) {
            __syncthreads();
            *(u32x4*)(Ks + ldkey * LS + lddc) = kreg;
#pragma unroll
            for (int j = 0; j < 4; ++j) { Vt[(lddc + 2 * j) * LS + ldkey] = (bf16_t)(vreg[j] & 0xFFFFu); Vt[(lddc + 2 * j + 1) * LS + ldkey] = (bf16_t)(vreg[j] >> 16); }
            __syncthreads();
            if (kt > 0) {
                const int s = (kt - 1) * 64 + ldkey;
                const bf16_t* src = p.P + (tokb + s) * CP + h * 64 + lddc;
                kreg = *(const u32x4*)(src + OFF_K); vreg = *(const u32x4*)(src + OFF_V);
            }
            if (!done && kt * 64 < qlo + 15) {
                f32x4 uu[4], lsp[4];
                float tot = 0.f;
#pragma unroll
                for (int kk = 0; kk < 4; ++kk) {
                    f32x4 z = (f32x4){0.f, 0.f, 0.f, 0.f};
#pragma unroll
                    for (int ks = 0; ks < 2; ++ks) {
                        const bf16x8 f = *(const bf16x8*)(Ks + (16 * kk + fr) * LS + ks * 32 + fq * 8);
                        z = __builtin_amdgcn_mfma_f32_16x16x32_bf16(f, qf[ks], z, 0, 0, 0);
                    }
#pragma unroll
                    for (int e = 0; e < 4; ++e) {
                        const float zz = z[e] * 0.125f;
                        const float lsneg = -(fmaxf(zz, 0.f) + __logf(1.0f + __expf(-fabsf(zz))));
                        const bool valid = kt * 64 + 16 * kk + 4 * fq + e < query;
                        uu[kk][e] = valid ? lsneg : 0.f;
                        lsp[kk][e] = valid ? lsneg + zz : -1.0e30f;
                        tot += uu[kk][e];
                    }
                }
                tot += __shfl_xor(tot, 16); tot += __shfl_xor(tot, 32);
                f32x4 rest[4];
#pragma unroll
                for (int st = 0; st < 4; ++st) rest[st] = (f32x4){0.f, 0.f, 0.f, 0.f};
#pragma unroll
                for (int k2 = 0; k2 < 2; ++k2) {
                    u32x4 hi, lo;
#pragma unroll
                    for (int t2 = 0; t2 < 2; ++t2) {
                        const f32x4 a = uu[2 * k2 + t2];
                        const unsigned h0 = pack2(a[0], a[1]), h1 = pack2(a[2], a[3]);
                        hi[2 * t2] = h0; hi[2 * t2 + 1] = h1;
                        lo[2 * t2] = pack2(a[0] - lo_bf(h0), a[1] - hi_bf(h0)); lo[2 * t2 + 1] = pack2(a[2] - lo_bf(h1), a[3] - hi_bf(h1));
                    }
                    const bf16x8 fh = __builtin_bit_cast(bf16x8, hi), fl = __builtin_bit_cast(bf16x8, lo);
#pragma unroll
                    for (int st = 0; st < 4; ++st) {
                        rest[st] = __builtin_amdgcn_mfma_f32_16x16x32_bf16(tri[st][k2], fh, rest[st], 0, 0, 0);
                        rest[st] = __builtin_amdgcn_mfma_f32_16x16x32_bf16(tri[st][k2], fl, rest[st], 0, 0, 0);
                    }
                }
                bf16x8 af[2];
#pragma unroll
                for (int k2 = 0; k2 < 2; ++k2) {
                    u32x4 pk;
#pragma unroll
                    for (int t2 = 0; t2 < 2; ++t2) {
                        const int kk = 2 * k2 + t2;
                        float a4[4];
#pragma unroll
                        for (int e = 0; e < 4; ++e) a4[e] = __expf(lsp[kk][e] + R + rest[kk][e]);
                        pk[2 * t2] = pack2(a4[0], a4[1]); pk[2 * t2 + 1] = pack2(a4[2], a4[3]);
                    }
                    af[k2] = __builtin_bit_cast(bf16x8, pk);
                }
                R += tot;
#pragma unroll
                for (int dt = 0; dt < 4; ++dt)
#pragma unroll
                    for (int k2 = 0; k2 < 2; ++k2) {
                        const bf16_t* vp = Vt + (16 * dt + fr) * LS + 32 * k2 + 4 * fq;
                        const u32x2 v0 = *(const u32x2*)vp, v1 = *(const u32x2*)(vp + 16);
                        const bf16x8 f = __builtin_bit_cast(bf16x8, ((u32x4){v0[0], v0[1], v1[0], v1[1]}));
                        ot[dt] = __builtin_amdgcn_mfma_f32_16x16x32_bf16(f, af[k2], ot[dt], 0, 0, 0);
                    }
                done = __all((R < -104.0f) || (query >= L));
            }
            if (lane == 0) flags[wv] = done ? 1 : 0;
            __syncthreads();
            int alld = 1;
#pragma unroll
            for (int w = 0; w < 8; ++w) alld &= flags[w];
            if (alld || kt == 0) break;
            --kt;
        }
        if (query < L) {
#pragma unroll
            for (int dt = 0; dt < 4; ++dt) *(u32x2*)(p.osb + (tokb + query) * 512 + h * 64 + 16 * dt + 4 * fq) = pk4(ot[dt]);
        }
    }
}

DI void phase_gates(const Params& p, int layer, int bid, int nb, char* smem) {
    const bf16_t* hb = p.hb; bf16_t* G = p.gates;
    const bf16_t* Bt = p.WtIn + ((size_t)layer * CIN + CP) * D;
    constexpr int NT = 2048 / 128, MT = TP / 128;
    for (int t = bid; t < MT * NT; t += nb) {
        const int m0 = (t / NT) * 128, n0 = (t % NT) * 128;
        gemm_tile128([=](int r) { return r < T ? hb + (size_t)r * D : (const bf16_t*)nullptr; }, Bt, D, D, m0, n0, smem,
                     [=](int r, int c, f32x4 v) { if (r < T) *(u32x2*)(G + (size_t)r * 2048 + c) = (u32x2){pack2(sigmoidf_(v[0]), sigmoidf_(v[1])), pack2(sigmoidf_(v[2]), sigmoidf_(v[3]))}; });
    }
}
DI void phase_branch(const Params& p, int layer, int which, int bid, int nb, char* smem) {
    const bf16_t* A = which ? p.orw : p.osb; const bf16_t* G = p.gates + which * 1024; bf16_t* M = p.merged;
    const bf16_t* Bt = (which ? p.WtPrw : p.WtPsb) + (size_t)layer * D * 512;
    constexpr int NT = D / 128, MT = TP / 128;
    for (int t = bid; t < MT * NT; t += nb) {
        const int m0 = (t / NT) * 128, n0 = (t % NT) * 128;
        gemm_tile128([=](int r) { return r < T ? A + (size_t)r * 512 : (const bf16_t*)nullptr; }, Bt, 512, 512, m0, n0, smem,
                     [=](int r, int c, f32x4 v) {
                         if (r >= T) return;
                         const u32x2 g = *(const u32x2*)(G + (size_t)r * 2048 + c);
                         float o0 = lo_bf(g[0]) * v[0], o1 = hi_bf(g[0]) * v[1], o2 = lo_bf(g[1]) * v[2], o3 = hi_bf(g[1]) * v[3];
                         u32x2* mp = (u32x2*)(M + (size_t)r * D + c);
                         if (which) { const u32x2 m = *mp; o0 += lo_bf(m[0]); o1 += hi_bf(m[0]); o2 += lo_bf(m[1]); o3 += hi_bf(m[1]); }
                         *mp = (u32x2){pack2(o0, o1), pack2(o2, o3)};
                     });
    }
}
DI void phase_outproj(const Params& p, int layer, int bid, int nb, char* smem) {
    const bf16_t* A = p.merged; float* const hmeta = p.hmeta; float* const outp = p.out;
    const bf16_t* Bt = p.WtOut + (size_t)layer * D * D;
    constexpr int NT = D / 128, MT = TP / 128;
    if (bid == 0 && tid_() < NE) p.counts[tid_()] = 0;
    for (int t = bid; t < MT * NT; t += nb) {
        const int m0 = (t / NT) * 128, n0 = (t % NT) * 128;
        gemm_tile128([=](int r) { return r < T ? A + (size_t)r * D : (const bf16_t*)nullptr; }, Bt, D, D, m0, n0, smem,
                     [=](int r, int c, f32x4 v) {
                         if (r >= T) return;
                         f32x4* hp = (f32x4*)(hrow2(hmeta, outp, r) + c);
                         const f32x4 h = *hp;
                         *hp = (f32x4){ALPHA * h[0] + v[0], ALPHA * h[1] + v[1], ALPHA * h[2] + v[2], ALPHA * h[3] + v[3]};
                     });
    }
}

DI void phase_ln1_router(const Params& p, int layer, int bid, int nb) {
    const int lane = tid_() & 63, wid = __builtin_amdgcn_readfirstlane(tid_() >> 6);
    for (int tok = bid * 8 + wid; tok < T; tok += nb * 8) {
        float* hf = hrow(p, tok);
        float v[16];
#pragma unroll
        for (int j = 0; j < 4; ++j) { const f32x4 a = *(const f32x4*)(hf + 256 * j + 4 * lane); v[4 * j] = a[0]; v[4 * j + 1] = a[1]; v[4 * j + 2] = a[2]; v[4 * j + 3] = a[3]; }
        ln16(v, p.ln1_g + layer * D, p.ln1_b + layer * D, lane);
        store_row(hf, p.hb + (size_t)tok * D, v, lane);
        float lg[16];
#pragma unroll
        for (int e = 0; e < 16; ++e) lg[e] = 0.f;
#pragma unroll
        for (int j = 0; j < 4; ++j)
#pragma unroll
            for (int i = 0; i < 4; ++i) {
                const float* rw = p.router_w + (size_t)(256 * j + 4 * lane + i) * NE;
#pragma unroll
                for (int e4 = 0; e4 < 4; ++e4) {
                    const f32x4 w = *(const f32x4*)(rw + 4 * e4);
#pragma unroll
                    for (int q = 0; q < 4; ++q) lg[4 * e4 + q] += v[4 * j + i] * w[q];
                }
            }
        float mx = -3.0e38f;
#pragma unroll
        for (int e = 0; e < 16; ++e) { lg[e] = wave_sum(lg[e]) + p.router_b[e]; mx = fmaxf(mx, lg[e]); }
        float sum = 0.f;
#pragma unroll
        for (int e = 0; e < 16; ++e) { lg[e] = __expf(lg[e] - mx); sum += lg[e]; }
        const float inv = 1.0f / sum;
        float bs = -1.f, bv1 = 0.f, bv2 = 0.f; int be1 = 0, be2 = 1;
#pragma unroll
        for (int g = 0; g < 4; ++g) {
            float v1 = -1.f, v2 = -1.f; int i1 = 0, i2 = 0;
#pragma unroll
            for (int i = 0; i < 4; ++i) {
                const float pv = lg[4 * g + i] * inv;
                if (pv > v1) { v2 = v1; i2 = i1; v1 = pv; i1 = i; } else if (pv > v2) { v2 = pv; i2 = i; }
            }
            const float sc = v1 + v2;
            if (sc > bs) { bs = sc; bv1 = v1; bv2 = v2; be1 = 4 * g + i1; be2 = 4 * g + i2; }
        }
        if (lane == 0) {
            const float gs = 1.0f / (bv1 + bv2);
            const int s1 = atomicAdd(&p.counts[be1], 1), s2 = atomicAdd(&p.counts[be2], 1);
            p.list[be1 * T + s1] = tok * 2; p.list[be2 * T + s2] = tok * 2 + 1;
            p.tokg[tok * 2] = bv1 * gs; p.tokg[tok * 2 + 1] = bv2 * gs;
        }
    }
}

struct MoeTile { int e, slot0, off, cnt, total; };
DI MoeTile moe_tile(const int* counts, int tm) {
    MoeTile r; r.e = -1; r.slot0 = 0; r.off = 0; r.cnt = 0;
    int start = 0, off = 0;
#pragma unroll
    for (int e = 0; e < NE; ++e) {
        const int c = counts[e], nt = (c + 127) >> 7;
        if (tm >= start && tm < start + nt) { r.e = e; r.slot0 = (tm - start) * 128; r.off = off; r.cnt = c; }
        start += nt; off += c;
    }
    r.total = start;
    return r;
}
DI void phase_moe_up(const Params& p, int bid, int nb, char* smem) {
    const bf16_t* hb = p.hb; bf16_t* hid = p.hid; const int* list = p.list;
    const int total = moe_tile(p.counts, 0).total;
    for (int t = bid; t < total * 8; t += nb) {
        const MoeTile mt = moe_tile(p.counts, t >> 3);
        const int n0 = (t & 7) * 128, e = mt.e, slot0 = mt.slot0, cnt = mt.cnt, off = mt.off;
        gemm_tile128([=](int r) { const int s = slot0 + r; return s < cnt ? hb + (size_t)(list[e * T + s] >> 1) * D : (const bf16_t*)nullptr; },
                     p.WtGU + (size_t)e * 1024 * 1024, D, D, 0, n0, smem,
                     [=](int r, int c, f32x4 v) {
                         const int s = slot0 + r;
                         if (s >= cnt) return;
                         const float h0 = v[0] * sigmoidf_(v[0]) * v[1], h1 = v[2] * sigmoidf_(v[2]) * v[3];
                         *(unsigned*)(hid + (size_t)(off + s) * DE + (c >> 1)) = pack2(h0, h1);
                     });
    }
}
DI void phase_moe_down(const Params& p, int bid, int nb, char* smem) {
    const bf16_t* hid = p.hid; bf16_t* fo = p.fo; const int* list = p.list; const float* tokg = p.tokg;
    const int total = moe_tile(p.counts, 0).total;
    for (int t = bid; t < total * 8; t += nb) {
        const MoeTile mt = moe_tile(p.counts, t >> 3);
        const int n0 = (t & 7) * 128, e = mt.e, slot0 = mt.slot0, cnt = mt.cnt, off = mt.off;
        gemm_tile128([=](int r) { const int s = slot0 + r; return s < cnt ? hid + (size_t)(off + s) * DE : (const bf16_t*)nullptr; },
                     p.WtD + (size_t)e * 1024 * 512, DE, DE, 0, n0, smem,
                     [=](int r, int c, f32x4 v) {
                         const int s = slot0 + r;
                         if (s >= cnt) return;
                         const int ent = list[e * T + s], tok = ent >> 1, kc = ent & 1;
                         const float g = tokg[ent];
                         *(u32x2*)(fo + ((size_t)kc * TP + tok) * D + c) = (u32x2){pack2(g * v[0], g * v[1]), pack2(g * v[2], g * v[3])};
                     });
    }
}
DI void phase_ln2(const Params& p, int layer, int bid, int nb) {
    const int lane = tid_() & 63, wid = __builtin_amdgcn_readfirstlane(tid_() >> 6);
    for (int tok = bid * 8 + wid; tok < T; tok += nb * 8) {
        float* hf = hrow(p, tok);
        float v[16];
#pragma unroll
        for (int j = 0; j < 4; ++j) {
            const f32x4 a = *(const f32x4*)(hf + 256 * j + 4 * lane);
            const u32x2 f0 = *(const u32x2*)(p.fo + (size_t)tok * D + 256 * j + 4 * lane), f1 = *(const u32x2*)(p.fo + ((size_t)TP + tok) * D + 256 * j + 4 * lane);
            v[4 * j] = ALPHA * a[0] + lo_bf(f0[0]) + lo_bf(f1[0]); v[4 * j + 1] = ALPHA * a[1] + hi_bf(f0[0]) + hi_bf(f1[0]);
            v[4 * j + 2] = ALPHA * a[2] + lo_bf(f0[1]) + lo_bf(f1[1]); v[4 * j + 3] = ALPHA * a[3] + hi_bf(f0[1]) + hi_bf(f1[1]);
        }
        ln16(v, p.ln2_g + layer * D, p.ln2_b + layer * D, lane);
        store_row(hf, p.hb + (size_t)tok * D, v, lane);
    }
}

extern __shared__ __attribute__((aligned(16))) char dyn_smem[];
constexpr int SMEM_MAIN = R1_LDS > GEMM_LDS ? R1_LDS : GEMM_LDS;
constexpr int SMEM_BYTES = SMEM_MAIN + 16;

__global__ void __launch_bounds__(NTHR, 2) k_forward(Params p) {
    const int bid = blockIdx.x, nb = gridDim.x;
    char* smem = dyn_smem;
    uint4* xbw = (uint4*)(dyn_smem + SMEM_MAIN);
    if (threadIdx.x == 0) *xbw = make_uint4(0u, 0u, 0u, 0u);
    __syncthreads();
    XcdBarrier bar = xcd_barrier_post(p.bar, (volatile LAS unsigned*)xbw);
    phase_prologue_weights(p, bid, nb, smem);
    phase_embed(p, bid, nb);
    xcd_barrier(bar);
    for (int l = 0; l < DEPTH; ++l) {
        phase_inproj(p, l, bid, nb, smem);
        xcd_barrier(bar);
        phase_rwkv_r1(p, l, bid, nb, smem);
        xcd_barrier(bar);
        if (bid < 32) phase_rwkv_r2(p, bid);
        else phase_sb(p, bid - 32, nb - 32, smem);
        xcd_barrier(bar);
        phase_rwkv_r3(p, l, bid, nb);
        phase_gates(p, l, bid, nb, smem);
        xcd_barrier(bar);
        convert_experts(p, l, bid, nb, smem);
        phase_branch(p, l, 0, bid, nb, smem);
        xcd_barrier(bar);
        phase_branch(p, l, 1, bid, nb, smem);
        xcd_barrier(bar);
        phase_outproj(p, l, bid, nb, smem);
        xcd_barrier(bar);
        phase_ln1_router(p, l, bid, nb);
        xcd_barrier(bar);
        phase_moe_up(p, bid, nb, smem);
        xcd_barrier(bar);
        phase_moe_down(p, bid, nb, smem);
        xcd_barrier(bar);
        phase_ln2(p, l, bid, nb);
        xcd_barrier(bar);
    }
}

extern "C" void kernel_launch(void* const* d_in, const int* in_sizes, int n_in, void* d_out, int out_size, void* d_ws, size_t ws_size, hipStream_t stream) {
    (void)in_sizes; (void)n_in; (void)out_size;
    Params p;
    memset(&p, 0, sizeof(p));
    const float* const* in = (const float* const*)d_in;
    p.x = in[0]; p.meta = in[1]; p.emb_g = in[2]; p.emb_b = in[3]; p.w_in = in[4]; p.mu = in[5]; p.w0 = in[6]; p.w_up = in[7]; p.a0 = in[8]; p.a_up = in[9];
    p.g_up = in[10]; p.k_k = in[11]; p.k_a = in[12]; p.r_k = in[13]; p.lnx_g = in[14]; p.lnx_b = in[15]; p.p_sb = in[16]; p.p_rwkv = in[17]; p.w_out = in[18];
    p.ln1_g = in[19]; p.ln1_b = in[20]; p.router_w = in[21]; p.router_b = in[22]; p.ew_gate = in[23]; p.ew_up = in[24]; p.ew_down = in[25]; p.ln2_g = in[26]; p.ln2_b = in[27];
    p.out = (float*)d_out;
    char* ws = (char*)d_ws; size_t o = 0;
    auto take = [&](size_t bytes) { char* r = ws + o; o += (bytes + 255) & ~(size_t)255; return r; };
    p.bar = (unsigned*)take(XCD_BAR_WORDS * sizeof(unsigned));
    p.counts = (int*)take(256);
    p.WtIn = (bf16_t*)take((size_t)DEPTH * CIN * D * 2);
    p.WtPsb = (bf16_t*)take((size_t)DEPTH * D * 512 * 2);
    p.WtPrw = (bf16_t*)take((size_t)DEPTH * D * 512 * 2);
    p.WtOut = (bf16_t*)take((size_t)DEPTH * D * D * 2);
    p.WupT = (bf16_t*)take((size_t)DEPTH * 512 * 64 * 2);
    p.AupT = (bf16_t*)take((size_t)DEPTH * 512 * 64 * 2);
    p.GupT = (bf16_t*)take((size_t)DEPTH * 512 * 128 * 2);
    {
        const size_t ub = (size_t)NUNIT * 64 * 64 * 2, need_r = 6 * ub + (size_t)NUNIT * 64 * 4, need_e = (size_t)NE * 1024 * 1024 * 2 + (size_t)NE * 1024 * 512 * 2;
        char* e = take(need_r > need_e ? need_r : need_e);
        p.WtGU = (bf16_t*)e; p.WtD = (bf16_t*)(e + (size_t)NE * 1024 * 1024 * 2);
        p.PcG = (bf16_t*)e; p.QcG = (bf16_t*)(e + ub); p.RhG = (bf16_t*)(e + 2 * ub); p.Y0G = (bf16_t*)(e + 3 * ub); p.GG = (bf16_t*)(e + 4 * ub); p.SG = (bf16_t*)(e + 5 * ub);
        p.bonG = (float*)(e + 6 * ub);
    }
    p.hb = (bf16_t*)take((size_t)TP * D * 2);
    p.hmeta = (float*)take((size_t)NBATCH * NMETA * D * 4);
    p.P = (bf16_t*)take((size_t)TP * CP * 2);
    p.osb = (bf16_t*)take((size_t)TP * 512 * 2);
    p.orw = (bf16_t*)take((size_t)TP * 512 * 2);
    p.list = (int*)take((size_t)NE * T * 4);
    p.tokg = (float*)take((size_t)T * 2 * 4);
    p.gates = p.P;
    p.merged = p.P + (size_t)TP * 2048;
    p.hid = p.P;
    p.fo = p.P + (size_t)(2 * T + 128) * DE;
    if (o > ws_size) return;
    static int grid = 0;
    if (!grid) {
        int dev = 0, cus = 0, per_cu = 0;
        (void)hipGetDevice(&dev);
        (void)hipDeviceGetAttribute(&cus, hipDeviceAttributeMultiprocessorCount, dev);
        (void)hipFuncSetAttribute((const void*)k_forward, hipFuncAttributeMaxDynamicSharedMemorySize, SMEM_BYTES);
        (void)hipOccupancyMaxActiveBlocksPerMultiprocessor(&per_cu, k_forward, NTHR, SMEM_BYTES);
        grid = per_cu >= 1 ? cus : 0;
    }
    if (!grid) return;
    (void)hipMemsetAsync(p.bar, 0, XCD_BAR_WORDS * sizeof(unsigned), stream);
    hipLaunchKernelGGL(k_forward, dim3(grid), dim3(NTHR), SMEM_BYTES, stream, p);
}
```

```cpp
#include <hip/hip_runtime.h>
#include <stdint.h>
#include <string.h>

#define DI __device__ __forceinline__
typedef unsigned short bf16_t;
typedef short bf16x8 __attribute__((ext_vector_type(8)));
typedef float f32x4 __attribute__((ext_vector_type(4)));
typedef unsigned u32x4 __attribute__((ext_vector_type(4)));
typedef unsigned u32x2 __attribute__((ext_vector_type(2)));

constexpr int D = 1024, NBATCH = 2, SEQ = 8192, NMETA = 16, L = SEQ + NMETA, T = NBATCH * L, TP = 16640;
constexpr int DEPTH = 2, HEADS = 8, HD = 64;
constexpr int CIN = 5376, CP = 3328;
constexpr int OFF_Q = 0, OFF_K = 512, OFF_V = 1024, OFF_RW = 1536;
constexpr int RW_R = 0, RW_K = 512, RW_V = 1024, RW_WD = 1536, RW_AD = 1600, RW_GD = 1664, RSW = 1792;
constexpr int NE = 16, DE = 512;
constexpr float ALPHA = 1.41421356237309515f;
constexpr float DECAY_SCALE = 0.60653065971263342f;
constexpr int NTHR = 512;

#define XB_TMO      128
#define XB_XCNT(j)  (256  + 64 * (j))
#define XB_XSUB(j)  (1280 + 64 * (j))
#define XB_XGEN(j)  (2304 + 64 * (j))
#define XB_TOP      3328
#define XB_TOPGEN   3392
#define XCD_BAR_WORDS 3456
#define XB_SPIN_CAP (1u << 18)
#define LAS __attribute__((address_space(3)))

__device__ __forceinline__ unsigned xb_ld(unsigned* p)              { return __hip_atomic_load(p, __ATOMIC_RELAXED, __HIP_MEMORY_SCOPE_AGENT); }
__device__ __forceinline__ unsigned xb_add(unsigned* p, unsigned v) { return __hip_atomic_fetch_add(p, v, __ATOMIC_RELAXED, __HIP_MEMORY_SCOPE_AGENT); }
__device__ __forceinline__ unsigned xb_xcc_id() { return (unsigned)__builtin_amdgcn_s_getreg((3 << 11) | 20) & 0xFu; }
#define XB_SPIN(cond, bar) do { unsigned _sp = 0; while (cond) { __builtin_amdgcn_s_sleep(1); \
    if ((++_sp & 255u) == 0u) { if (xb_ld(&(bar)[XB_TMO])) break; if (_sp > XB_SPIN_CAP) { atomicAdd(&(bar)[XB_TMO], 1u); break; } } } } while (0)

struct XcdBarrier {
    unsigned* bar; unsigned x;
    volatile LAS unsigned* st;
};

__device__ __forceinline__ XcdBarrier xcd_barrier_post(unsigned* bar, volatile LAS unsigned* st) {
    XcdBarrier b; b.bar = bar; b.x = xb_xcc_id(); b.st = st;
    if (threadIdx.x == 0) (void)xb_add(&bar[XB_XCNT(b.x)], 1u);
    return b;
}
__device__ __forceinline__ void xcd_barrier_complete(unsigned* bar, unsigned x, unsigned& nloc, unsigned& nx) {
    const unsigned G = gridDim.x * gridDim.y * gridDim.z;
    unsigned sum, cnt, mine, sp = 0u;
    for (;;) {
        sum = 0u; cnt = 0u; mine = 0u;
#pragma unroll
        for (unsigned j = 0; j < 16; ++j) { const unsigned c = xb_ld(&bar[XB_XCNT(j)]); sum += c; cnt += (c > 0u) ? 1u : 0u; mine = (j == x) ? c : mine; }
        if (sum == G) break;
        __builtin_amdgcn_s_sleep(1);
        if ((++sp & 255u) == 0u) { if (xb_ld(&bar[XB_TMO])) break; if (sp > XB_SPIN_CAP) { atomicAdd(&bar[XB_TMO], 1u); break; } }
    }
    nloc = mine > 0u ? mine : 1u; nx = cnt > 0u ? cnt : 1u;
}

__device__ __forceinline__ void xcd_barrier(const XcdBarrier& b) {
    asm volatile("s_waitcnt vmcnt(0)" ::: "memory");
    __syncthreads();
    if (threadIdx.x == 0) {
        unsigned* bar = b.bar;
        unsigned bx = b.x; asm volatile("" : "+s"(bx));
        __builtin_amdgcn_s_waitcnt(0);
        unsigned nloc = b.st[0], nx = b.st[1];
        if (nloc == 0u) { xcd_barrier_complete(bar, bx, nloc, nx); b.st[0] = nloc; b.st[1] = nx; }
        const unsigned old = xb_add(&bar[XB_XSUB(bx)], 1u);
        const unsigned gen = old / nloc;
        if (old + 1u == (gen + 1u) * nloc) {
            __builtin_amdgcn_fence(__ATOMIC_RELEASE, "agent");
            asm volatile("s_waitcnt vmcnt(0)" ::: "memory");
            const unsigned og = xb_add(&bar[XB_TOP], 1u);
            const unsigned tg = og / nx;
            if (og + 1u == (tg + 1u) * nx) xb_add(&bar[XB_TOPGEN], 1u);
            else XB_SPIN(xb_ld(&bar[XB_TOPGEN]) == tg, bar);
            __builtin_amdgcn_fence(__ATOMIC_ACQUIRE, "agent");
            xb_add(&bar[XB_XGEN(bx)], 1u);
            asm volatile("s_waitcnt vmcnt(0)" ::: "memory");
        } else {
            XB_SPIN(xb_ld(&bar[XB_XGEN(bx)]) == gen, bar);
            __builtin_amdgcn_fence(__ATOMIC_ACQUIRE, "agent");
            asm volatile("s_waitcnt vmcnt(0)" ::: "memory");
        }
    }
    __syncthreads();
}


struct Params {
    const float *x, *meta, *emb_g, *emb_b, *w_in, *mu, *w0, *w_up, *a0, *a_up, *g_up, *k_k, *k_a, *r_k, *lnx_g, *lnx_b, *p_sb, *p_rwkv, *w_out,
        *ln1_g, *ln1_b, *router_w, *router_b, *ew_gate, *ew_up, *ew_down, *ln2_g, *ln2_b;
    float* out;
    unsigned* bar;
    int* counts;
    bf16_t *WtIn, *WtPsb, *WtPrw, *WtOut, *WtGU, *WtD, *hb, *P, *osb, *orw, *WupT, *AupT, *GupT;
    bf16_t *PcG, *QcG, *RhG, *Y0G, *GG, *SG;
    float* bonG;
    float* hmeta;
    bf16_t *gates, *merged, *hid, *fo;
    int* list;
    float* tokg;
};

DI float bf2f(bf16_t v) { return __uint_as_float((unsigned)v << 16); }
typedef __bf16 bf16x2_t __attribute__((ext_vector_type(2)));
DI bf16_t f2bf(float f) { return __builtin_bit_cast(bf16_t, (__bf16)f); }
DI unsigned pack2(float lo, float hi) { bf16x2_t v = {(__bf16)lo, (__bf16)hi}; return __builtin_bit_cast(unsigned, v); }
DI float lo_bf(unsigned u) { return __uint_as_float(u << 16); }
DI float hi_bf(unsigned u) { return __uint_as_float(u & 0xFFFF0000u); }
template <int CTRL> DI float dpp_mov(float v) { return __builtin_bit_cast(float, __builtin_amdgcn_update_dpp(0, __builtin_bit_cast(int, v), CTRL, 0xF, 0xF, true)); }
DI float sum8(float v) {
    v += dpp_mov<0xB1>(v);
    v += dpp_mov<0x4E>(v);
    v += dpp_mov<0x141>(v);
    return v;
}
DI float sum16(float v) { v = sum8(v); v += dpp_mov<0x140>(v); return v; }
DI float wave_sum(float v) { v = sum16(v); v += __shfl_xor(v, 16); v += __shfl_xor(v, 32); return v; }
struct Params;
DI const Params& kparams() {
    auto k = __builtin_amdgcn_kernarg_segment_ptr();
    asm volatile("" : "+s"(k));
    return *(const Params*)k;
}
DI int tid_() { int t = threadIdx.x; asm volatile("" : "+v"(t)); return t; }
DI float sigmoidf_(float x) { return 1.0f / (1.0f + __expf(-x)); }
DI void wave_sync() { asm volatile("s_waitcnt lgkmcnt(0)" ::: "memory"); __builtin_amdgcn_wave_barrier(); }

DI float* hrow2(float* hmeta, float* out, int tok) {
    const int b = tok >= L ? 1 : 0, t = tok - b * L;
    return t < NMETA ? hmeta + (size_t)(b * NMETA + t) * D : out + ((size_t)b * SEQ + (t - NMETA)) * D;
}
DI float* hrow(const Params& p, int tok) { return hrow2(p.hmeta, p.out, tok); }

DI void transpose_convert(const float* __restrict__ src, int ld, int K, int N, bf16_t* __restrict__ dst, int mult, int off, int bid, int nb, char* smem) {
    float* tile = (float*)smem;
    const int tk = K / 64, tn = N / 64, tid = tid_();
    for (int t = bid; t < tk * tn; t += nb) {
        const int k0 = (t / tn) * 64, n0 = (t % tn) * 64;
        __syncthreads();
#pragma unroll
        for (int i = 0; i < 2; ++i) {
            const int k = (tid >> 4) + 32 * i, n4 = (tid & 15) * 4;
            const f32x4 v = *(const f32x4*)(src + (size_t)(k0 + k) * ld + n0 + n4);
            tile[k * 65 + n4 + 0] = v[0]; tile[k * 65 + n4 + 1] = v[1]; tile[k * 65 + n4 + 2] = v[2]; tile[k * 65 + n4 + 3] = v[3];
        }
        __syncthreads();
        const int n = tid >> 3, kc = (tid & 7) * 8;
        u32x4 o;
#pragma unroll
        for (int j = 0; j < 4; ++j) o[j] = pack2(tile[(kc + 2 * j) * 65 + n], tile[(kc + 2 * j + 1) * 65 + n]);
        *(u32x4*)(dst + (size_t)((n0 + n) * mult + off) * K + k0 + kc) = o;
    }
}

DI void convert_experts(const Params& p, int layer, int bid, int nb, char* smem) {
    for (int e = 0; e < NE; ++e) {
        const size_t eo = ((size_t)layer * NE + e) * (size_t)D * DE;
        transpose_convert(p.ew_gate + eo, DE, D, DE, p.WtGU + (size_t)e * 1024 * 1024, 2, 0, bid, nb, smem);
        transpose_convert(p.ew_up + eo, DE, D, DE, p.WtGU + (size_t)e * 1024 * 1024, 2, 1, bid, nb, smem);
        transpose_convert(p.ew_down + eo, D, DE, D, p.WtD + (size_t)e * 1024 * 512, 1, 0, bid, nb, smem);
    }
}

DI void phase_prologue_weights(const Params& p, int bid, int nb, char* smem) {
    for (int l = 0; l < DEPTH; ++l) {
        transpose_convert(p.w_in + (size_t)l * D * CIN, CIN, D, CIN, p.WtIn + (size_t)l * CIN * D, 1, 0, bid, nb, smem);
        transpose_convert(p.p_sb + (size_t)l * 512 * D, D, 512, D, p.WtPsb + (size_t)l * D * 512, 1, 0, bid, nb, smem);
        transpose_convert(p.p_rwkv + (size_t)l * 512 * D, D, 512, D, p.WtPrw + (size_t)l * D * 512, 1, 0, bid, nb, smem);
        transpose_convert(p.w_out + (size_t)l * D * D, D, D, D, p.WtOut + (size_t)l * D * D, 1, 0, bid, nb, smem);
        transpose_convert(p.w_up + (size_t)l * 64 * 512, 512, 64, 512, p.WupT + (size_t)l * 512 * 64, 1, 0, bid, nb, smem);
        transpose_convert(p.a_up + (size_t)l * 64 * 512, 512, 64, 512, p.AupT + (size_t)l * 512 * 64, 1, 0, bid, nb, smem);
        transpose_convert(p.g_up + (size_t)l * 128 * 512, 512, 128, 512, p.GupT + (size_t)l * 512 * 128, 1, 0, bid, nb, smem);
    }
}

DI void ln16(float (&v)[16], const float* __restrict__ g, const float* __restrict__ b, int lane) {
    float s = 0.f;
#pragma unroll
    for (int i = 0; i < 16; ++i) s += v[i];
    const float mean = wave_sum(s) * (1.0f / D);
    float q = 0.f;
#pragma unroll
    for (int i = 0; i < 16; ++i) { v[i] -= mean; q += v[i] * v[i]; }
    const float rstd = rsqrtf(wave_sum(q) * (1.0f / D) + 1e-5f);
#pragma unroll
    for (int j = 0; j < 4; ++j) {
        const f32x4 gv = *(const f32x4*)(g + 256 * j + 4 * lane), bv = *(const f32x4*)(b + 256 * j + 4 * lane);
#pragma unroll
        for (int i = 0; i < 4; ++i) v[4 * j + i] = v[4 * j + i] * rstd * gv[i] + bv[i];
    }
}
DI void store_row(float* __restrict__ hf, bf16_t* __restrict__ hb, const float (&v)[16], int lane) {
#pragma unroll
    for (int j = 0; j < 4; ++j) {
        *(f32x4*)(hf + 256 * j + 4 * lane) = (f32x4){v[4 * j], v[4 * j + 1], v[4 * j + 2], v[4 * j + 3]};
        *(u32x2*)(hb + 256 * j + 4 * lane) = (u32x2){pack2(v[4 * j], v[4 * j + 1]), pack2(v[4 * j + 2], v[4 * j + 3])};
    }
}

DI void phase_embed(const Params& p, int bid, int nb) {
    const int lane = tid_() & 63, wid = __builtin_amdgcn_readfirstlane(tid_() >> 6);
    for (int tok = bid * 8 + wid; tok < T; tok += nb * 8) {
        const int b = tok >= L ? 1 : 0, t = tok - b * L;
        const float* src = t < NMETA ? p.meta + (size_t)t * D : p.x + ((size_t)b * SEQ + (t - NMETA)) * D;
        float v[16];
#pragma unroll
        for (int j = 0; j < 4; ++j) { const f32x4 a = *(const f32x4*)(src + 256 * j + 4 * lane); v[4 * j] = a[0]; v[4 * j + 1] = a[1]; v[4 * j + 2] = a[2]; v[4 * j + 3] = a[3]; }
        ln16(v, p.emb_g, p.emb_b, lane);
        store_row(hrow(p, tok), p.hb + (size_t)tok * D, v, lane);
    }
}

constexpr int LDT = 72;
constexpr int GEMM_LDS = 2 * 128 * LDT * 2;
template <class ARow, class Epi>
DI void gemm_tile128(ARow arow, const bf16_t* __restrict__ Bt, int ldb, int K, int m0, int n0, char* smem, Epi epi) {
    const int tid = tid_(), lane = tid & 63, wid = __builtin_amdgcn_readfirstlane(tid >> 6), fr = lane & 15, fq = lane >> 4;
    const int wr = wid >> 1, wc = wid & 1;
    bf16_t* As = (bf16_t*)smem;
    bf16_t* Bs = As + 128 * LDT;
    const bf16_t* ap[2]; const bf16_t* bp[2]; int so[2];
#pragma unroll
    for (int i = 0; i < 2; ++i) {
        const int c = tid + NTHR * i, row = c >> 3, kc = c & 7;
        const bf16_t* ar = arow(m0 + row);
        ap[i] = ar ? ar + kc * 8 : nullptr;
        bp[i] = Bt + (size_t)(n0 + row) * ldb + kc * 8;
        so[i] = row * LDT + kc * 8;
    }
    f32x4 acc[2][4];
#pragma unroll
    for (int mi = 0; mi < 2; ++mi)
#pragma unroll
        for (int ni = 0; ni < 4; ++ni) acc[mi][ni] = (f32x4){0.f, 0.f, 0.f, 0.f};
    u32x4 ra[2], rb[2];
#pragma unroll
    for (int i = 0; i < 2; ++i) { ra[i] = ap[i] ? *(const u32x4*)(ap[i]) : (u32x4){0u, 0u, 0u, 0u}; rb[i] = *(const u32x4*)(bp[i]); }
    for (int k0 = 0; k0 < K; k0 += 64) {
        __syncthreads();
#pragma unroll
        for (int i = 0; i < 2; ++i) { *(u32x4*)(As + so[i]) = ra[i]; *(u32x4*)(Bs + so[i]) = rb[i]; }
        __syncthreads();
        if (k0 + 64 < K) {
#pragma unroll
            for (int i = 0; i < 2; ++i) { ra[i] = ap[i] ? *(const u32x4*)(ap[i] + k0 + 64) : (u32x4){0u, 0u, 0u, 0u}; rb[i] = *(const u32x4*)(bp[i] + k0 + 64); }
        }
#pragma unroll
        for (int ks = 0; ks < 2; ++ks) {
            bf16x8 af[2], bf[4];
#pragma unroll
            for (int mi = 0; mi < 2; ++mi) af[mi] = *(const bf16x8*)(As + (wr * 32 + mi * 16 + fr) * LDT + ks * 32 + fq * 8);
#pragma unroll
            for (int ni = 0; ni < 4; ++ni) bf[ni] = *(const bf16x8*)(Bs + (wc * 64 + ni * 16 + fr) * LDT + ks * 32 + fq * 8);
#pragma unroll
            for (int mi = 0; mi < 2; ++mi)
#pragma unroll
                for (int ni = 0; ni < 4; ++ni) acc[mi][ni] = __builtin_amdgcn_mfma_f32_16x16x32_bf16(bf[ni], af[mi], acc[mi][ni], 0, 0, 0);
        }
    }
#pragma unroll
    for (int mi = 0; mi < 2; ++mi)
#pragma unroll
        for (int ni = 0; ni < 4; ++ni) epi(m0 + wr * 32 + mi * 16 + fr, n0 + wc * 64 + ni * 16 + fq * 4, acc[mi][ni]);
}

namespace g8 {
#define G8_LAS __attribute__((address_space(3)))
constexpr int BM = 256, BK = 64, HALF = 128, HTB = HALF * BK * 2, STAGE_BYTES = 8 * HTB, NXCD = 8, WGM = 8;
DI int lds_byte(int r, int c) { const int st = (r >> 4) * 2 + (c >> 5), rr = r & 15, cc = c & 31, ob = rr * 64 + cc * 2; return st * 1024 + (ob ^ (((ob >> 9) & 1) << 5)); }
DI void stage_rc(int b, int& R, int& C) { const int st = b / 1024, sb = b % 1024, swz = sb ^ (((sb >> 9) & 1) << 5); R = (st >> 1) * 16 + swz / 64; C = (st & 1) * 32 + (swz % 64) / 2; }
DI int perm32(int rho) { const int n = rho >> 4, i = rho & 15; return 8 * (i >> 2) + 4 * n + (i & 3); }
struct Unit { int pm, pn; const char* A; const char* B; int e, slot0, cnt; };

struct DenseOrder {
    int nM, nN, nwg, G, c; const char* A; const char* B; size_t tstep;
    DI void init(const bf16_t* A_, const bf16_t* Bt_, int nM_, int nN_, int K, int G_, int c_) { nM = nM_; nN = nN_; nwg = nM * nN; G = G_; c = c_; A = (const char*)A_; B = (const char*)Bt_; tstep = (size_t)BM * K * 2; }
    DI bool next(int i, Unit& u) const {
        const long Lq = (long)i * G + c; if (Lq >= nwg) return false;
        int wgid = (int)Lq; { const int q = nwg / NXCD, r = nwg % NXCD, xcd = wgid % NXCD, off = wgid / NXCD; wgid = (xcd < r ? xcd * (q + 1) : r * (q + 1) + (xcd - r) * q) + off; }
        const int nig = WGM * nN, gid = wgid / nig, fm = gid * WGM, gsz = (nM - fm) < WGM ? (nM - fm) : WGM;
        u.pm = fm + ((wgid % nig) % gsz); u.pn = (wgid % nig) / gsz; u.A = A + (size_t)u.pm * tstep; u.B = B + (size_t)u.pn * tstep; u.e = 0; u.slot0 = 0; u.cnt = 0; return true;
    }
    DI unsigned row_off(const Unit&, int) const { return 0u; }
};

template <bool GATHER, class Epi, class Sched>
DI void gemm8(G8_LAS unsigned char* lds, const int K, const Sched& S, const Epi& E) {
    const int tid = tid_(), wid = __builtin_amdgcn_readfirstlane(tid >> 6), lane = tid & 63, wr = wid >> 2, wc = wid & 3, fr = lane & 15, fq = lane >> 4;
    const int nt = K / BK;
    int Rr[2], Cc[2]; unsigned voffB[2], voffA[2];
#pragma unroll
    for (int i = 0; i < 2; ++i) { stage_rc(tid * 16 + i * 8192, Rr[i], Cc[i]); const int Rb = Epi::PERM ? ((Rr[i] & ~31) + perm32(Rr[i] & 31)) : Rr[i]; voffB[i] = (unsigned)(Rb * K + Cc[i]) * 2u; voffA[i] = (unsigned)(Rr[i] * K + Cc[i]) * 2u; }
    const size_t kstep = (size_t)(BK * 2), hstep = (size_t)HALF * K * 2;
    const unsigned ldsw = (unsigned)wid * 1024u;
    const int aoff = lds_byte(wr * 64 + fr, fq * 8), boff = lds_byte(wc * 32 + fr, fq * 8);
#define G8_SA(b, h) (((b) * 2 + (h)) * HTB)
#define G8_SB(b, h) ((4 + (b) * 2 + (h)) * HTB)
#define G8_STAGE(bufoff, gbase, voff) do { _Pragma("unroll") for (int _i = 0; _i < 2; ++_i) \
        __builtin_amdgcn_global_load_lds((const unsigned*)((const char*)(gbase) + (voff)[_i]), (G8_LAS unsigned*)(lds + (bufoff) + ldsw + _i * 8192), 16, 0, 0); } while (0)
#define G8_LDA(dst, b, h) do { _Pragma("unroll") for (int m = 0; m < 4; ++m) _Pragma("unroll") for (int k = 0; k < 2; ++k) dst[m][k] = *(const G8_LAS bf16x8*)(lds + G8_SA(b, h) + aoff + m * 2048 + k * 1024); } while (0)
#define G8_LDB(dst, b, h) do { _Pragma("unroll") for (int n = 0; n < 2; ++n) _Pragma("unroll") for (int k = 0; k < 2; ++k) dst[n][k] = *(const G8_LAS bf16x8*)(lds + G8_SB(b, h) + boff + n * 2048 + k * 1024); } while (0)
#define G8_MMA(ai, bj, At, Bt) do { __builtin_amdgcn_s_setprio(1); _Pragma("unroll") for (int m = 0; m < 4; ++m) _Pragma("unroll") for (int n = 0; n < 2; ++n) _Pragma("unroll") for (int k = 0; k < 2; ++k) \
        acc[ai][bj][m][n] = __builtin_amdgcn_mfma_f32_16x16x32_bf16(Bt[n][k], At[m][k], acc[ai][bj][m][n], 0, 0, 0); __builtin_amdgcn_s_setprio(0); } while (0)
#define G8_WAIT_V(n) asm volatile("s_waitcnt vmcnt(" #n ")" ::: "memory")
#define G8_WAIT_L(n) asm volatile("s_waitcnt lgkmcnt(" #n ")" ::: "memory")
#define G8_BAR __builtin_amdgcn_s_barrier()
#define G8_SCHED __builtin_amdgcn_sched_barrier(0)
#define G8_AOFF(dst, un) do { if (GATHER) { _Pragma("unroll") for (int _h = 0; _h < 2; ++_h) _Pragma("unroll") for (int _i = 0; _i < 2; ++_i) \
        dst[_h][_i] = S.row_off(un, _h * HALF + Rr[_i]) + (unsigned)Cc[_i] * 2u; } } while (0)
#define G8_STAGE_A(bufoff, gb, vo, h) do { if (GATHER) { G8_STAGE(bufoff, gb, vo[h]); } else { G8_STAGE(bufoff, (gb) + (h) * hstep, voffA); } } while (0)
    Unit cur, nxt; int ui = 0;
    if (!S.next(0, cur)) return;
    f32x4 acc[2][2][4][2];
#pragma unroll
    for (int a = 0; a < 2; ++a)
#pragma unroll
        for (int b = 0; b < 2; ++b)
#pragma unroll
            for (int m = 0; m < 4; ++m)
#pragma unroll
                for (int n = 0; n < 2; ++n) acc[a][b][m][n] = (f32x4){0.f, 0.f, 0.f, 0.f};
    bf16x8 At[4][2], B0[2][2], B1[2][2];
    unsigned cvA[2][2], nvA[2][2];
    G8_AOFF(cvA, cur);
    const char* cA = cur.A; const char* cB = cur.B;
    G8_STAGE(G8_SB(0, 0), cB, voffB); G8_STAGE_A(G8_SA(0, 0), cA, cvA, 0); G8_STAGE(G8_SB(0, 1), cB + hstep, voffB); G8_STAGE_A(G8_SA(0, 1), cA, cvA, 1);
    if (wr == 1) G8_BAR;
    G8_WAIT_V(4); G8_BAR;
    G8_STAGE(G8_SB(1, 0), cB + kstep, voffB); G8_STAGE_A(G8_SA(1, 0), cA + kstep, cvA, 0); G8_STAGE(G8_SB(1, 1), cB + hstep + kstep, voffB);
    G8_WAIT_V(6); G8_BAR;
    for (;;) {
        const bool has_next = S.next(ui + 1, nxt);
        const char* nA = has_next ? nxt.A : cA; const char* nB = has_next ? nxt.B : cB;
        if (GATHER) {
            if (has_next) { G8_AOFF(nvA, nxt); } else {
#pragma unroll
                for (int h = 0; h < 2; ++h)
#pragma unroll
                    for (int i = 0; i < 2; ++i) nvA[h][i] = cvA[h][i];
            }
        }
        for (int t = 0; t < nt; t += 2) {
            const bool last = (t == nt - 2);
            const char* a1 = cA + (size_t)(t + 1) * kstep;
            const char* a2 = last ? nA : cA + (size_t)(t + 2) * kstep; const char* b2 = last ? nB : cB + (size_t)(t + 2) * kstep;
            const char* a3 = a2 + kstep; const char* b3 = b2 + kstep;

            G8_LDB(B0, 0, 0); G8_SCHED; G8_LDA(At, 0, 0); G8_STAGE_A(G8_SA(1, 1), a1, cvA, 1);
            if (GATHER && last) {
#pragma unroll
                for (int h = 0; h < 2; ++h)
#pragma unroll
                    for (int i = 0; i < 2; ++i) cvA[h][i] = nvA[h][i];
            }
            G8_WAIT_L(8); G8_BAR; G8_WAIT_L(0); G8_MMA(0, 0, At, B0); G8_BAR; G8_SCHED;
            G8_LDB(B1, 0, 1); G8_STAGE(G8_SB(0, 0), b2, voffB);
            G8_BAR; G8_WAIT_L(0); G8_MMA(0, 1, At, B1); G8_BAR;
            G8_LDA(At, 0, 1); G8_STAGE_A(G8_SA(0, 0), a2, cvA, 0);
            G8_BAR; G8_WAIT_L(0); G8_MMA(1, 0, At, B0); G8_BAR; G8_SCHED;
            G8_STAGE(G8_SB(0, 1), b2 + hstep, voffB);
            G8_WAIT_V(6); G8_BAR; G8_MMA(1, 1, At, B1); G8_BAR;
            G8_LDB(B0, 1, 0); G8_SCHED; G8_LDA(At, 1, 0); G8_STAGE_A(G8_SA(0, 1), a2, cvA, 1);
            G8_WAIT_L(8); G8_BAR; G8_WAIT_L(0); G8_MMA(0, 0, At, B0); G8_BAR; G8_SCHED;
            G8_LDB(B1, 1, 1); G8_STAGE(G8_SB(1, 0), b3, voffB);
            G8_BAR; G8_WAIT_L(0); G8_MMA(0, 1, At, B1); G8_BAR;
            G8_LDA(At, 1, 1); G8_STAGE_A(G8_SA(1, 0), a3, cvA, 0);
            G8_BAR; G8_WAIT_L(0); G8_MMA(1, 0, At, B0); G8_BAR; G8_SCHED;
            G8_STAGE(G8_SB(1, 1), b3 + hstep, voffB);
            G8_WAIT_V(6); G8_BAR; G8_MMA(1, 1, At, B1); G8_BAR;
        }
        { int fr2 = fr, fq2 = fq; asm volatile("" : "+v"(fr2), "+v"(fq2)); E(acc, cur, wr, wc, fr2, fq2); }
        if (!has_next) break;
#pragma unroll
        for (int a = 0; a < 2; ++a)
#pragma unroll
            for (int b = 0; b < 2; ++b)
#pragma unroll
                for (int m = 0; m < 4; ++m)
#pragma unroll
                    for (int n = 0; n < 2; ++n) acc[a][b][m][n] = (f32x4){0.f, 0.f, 0.f, 0.f};
        cur = nxt; cA = nA; cB = nB; ++ui;
    }
    G8_WAIT_V(0);
    if (wr == 0) G8_BAR;
    G8_BAR;
#undef G8_SA
#undef G8_SB
#undef G8_STAGE
#undef G8_LDA
#undef G8_LDB
#undef G8_MMA
#undef G8_WAIT_V
#undef G8_WAIT_L
#undef G8_BAR
#undef G8_SCHED
#undef G8_AOFF
#undef G8_STAGE_A
}
}

constexpr int MFULL = 64, M0_LEFT = MFULL * 256;
struct EpiStore {
    static constexpr bool PERM = true;
    bf16_t* O; int ldc; bool sig;
    DI void operator()(const f32x4 (&acc)[2][2][4][2], const g8::Unit& u, int wr, int wc, int fr, int fq) const {
#pragma unroll
        for (int ai = 0; ai < 2; ++ai)
#pragma unroll
            for (int m = 0; m < 4; ++m) {
                bf16_t* rowp = O + (size_t)(u.pm * 256 + ai * 128 + wr * 64 + m * 16 + fr) * ldc + u.pn * 256 + wc * 32 + 8 * fq;
#pragma unroll
                for (int bj = 0; bj < 2; ++bj) {
                    f32x4 v0 = acc[ai][bj][m][0], v1 = acc[ai][bj][m][1];
                    if (sig) {
#pragma unroll
                        for (int e = 0; e < 4; ++e) { v0[e] = sigmoidf_(v0[e]); v1[e] = sigmoidf_(v1[e]); }
                    }
                    *(u32x4*)(rowp + bj * 128) = (u32x4){pack2(v0[0], v0[1]), pack2(v0[2], v0[3]), pack2(v1[0], v1[1]), pack2(v1[2], v1[3])};
                }
            }
    }
};
DI int left_first(int units, int bid, int nb) { return (bid - units % nb + nb) % nb; }

DI void phase_inproj(const Params& p, int layer, int bid, int nb, char* smem) {
    const bf16_t* hb = p.hb; bf16_t* P = p.P;
    const bf16_t* Bt = p.WtIn + (size_t)layer * CIN * D;
    g8::DenseOrder S; S.init(hb, Bt, MFULL, CP / 256, D, nb, bid);
    g8::gemm8<false>((G8_LAS unsigned char*)smem, D, S, EpiStore{P, CP, false});
    for (int t = left_first(MFULL * (CP / 256), bid, nb); t < CP / 128; t += nb)
        gemm_tile128([=](int r) { return r < T ? hb + (size_t)r * D : (const bf16_t*)nullptr; }, Bt, D, D, M0_LEFT, t * 128, smem,
                     [=](int r, int c, f32x4 v) { if (r < T) *(u32x2*)(P + (size_t)r * CP + c) = (u32x2){pack2(v[0], v[1]), pack2(v[2], v[3])}; });
}

constexpr int NCHUNK = (L + 63) / 64, NUNIT = NBATCH * HEADS * NCHUNK;
constexpr int LS = 72, RB = 64 * LS * 2;
constexpr int R1_LDS = 16 * RB + 4096;
#define RBUF(i) ((bf16_t*)(smem + (i) * RB))
typedef float f32x16 __attribute__((ext_vector_type(16)));

template <int KK> DI f32x4 mm16(const bf16_t* F, int ldf, const bf16_t* S, int lds_, f32x4 acc, int lane) {
    const int fr = lane & 15, fq = lane >> 4;
#pragma unroll
    for (int ks = 0; ks < KK / 32; ++ks) {
        const bf16x8 f = *(const bf16x8*)(F + fr * ldf + ks * 32 + fq * 8);
        const bf16x8 g = *(const bf16x8*)(S + fr * lds_ + ks * 32 + fq * 8);
        acc = __builtin_amdgcn_mfma_f32_16x16x32_bf16(f, g, acc, 0, 0, 0);
    }
    return acc;
}
DI u32x2 pk4(f32x4 v) { return (u32x2){pack2(v[0], v[1]), pack2(v[2], v[3])}; }
DI f32x4 up4(u32x2 v) { return (f32x4){lo_bf(v[0]), hi_bf(v[0]), lo_bf(v[1]), hi_bf(v[1])}; }

DI void phase_rwkv_r1(const Params& p, int layer, int bid, int nb, char* smem) {
    const int tid = tid_(), lane = tid & 63, wv = __builtin_amdgcn_readfirstlane(tid >> 6), fr = lane & 15, fq = lane >> 4;
    const f32x4 zero = (f32x4){0.f, 0.f, 0.f, 0.f};
    float* lwT = (float*)RBUF(4);
    float* aT = (float*)RBUF(6);
    float* gt = (float*)(smem + 16 * RB);
    float* gammaC = gt + 512;
    bf16_t* Xt0 = RBUF(14);
    bf16_t* Xt1 = RBUF(4);
    const bf16_t* WupT = p.WupT + (size_t)layer * 512 * 64, *AupT = p.AupT + (size_t)layer * 512 * 64, *GupT = p.GupT + (size_t)layer * 512 * 128;
    const float* mu = p.mu + (size_t)layer * RSW;
    for (int u = bid; u < NUNIT; u += nb) {
        const int c = u % NCHUNK, bh = u / NCHUNK, h = bh % HEADS, bb = bh / HEADS;
        const size_t tok0 = (size_t)bb * L + c * 64;
        __syncthreads();
#pragma unroll
        for (int it = 0; it < 7; ++it) {
            const int cid = tid + NTHR * it, i = cid / 56, cc = cid % 56;
            int col; bf16_t* dst;
            if (cc < 8) { col = RW_R + h * 64 + cc * 8; dst = RBUF(8) + i * LS + cc * 8; }
            else if (cc < 16) { col = RW_K + h * 64 + (cc - 8) * 8; dst = RBUF(9) + i * LS + (cc - 8) * 8; }
            else if (cc < 24) { col = RW_V + h * 64 + (cc - 16) * 8; dst = RBUF(10) + i * LS + (cc - 16) * 8; }
            else if (cc < 32) { col = RW_WD + (cc - 24) * 8; dst = RBUF(0) + i * LS + (cc - 24) * 8; }
            else if (cc < 40) { col = RW_AD + (cc - 32) * 8; dst = RBUF(1) + i * LS + (cc - 32) * 8; }
            else { col = RW_GD + (cc - 40) * 8; dst = RBUF(2) + i * 136 + (cc - 40) * 8; }
            const int t = c * 64 + i;
            u32x4 cur = (u32x4){0u, 0u, 0u, 0u}, prv = (u32x4){0u, 0u, 0u, 0u};
            if (t < L) cur = *(const u32x4*)(p.P + (tok0 + i) * CP + OFF_RW + col);
            if (t < L && t > 0) prv = *(const u32x4*)(p.P + (tok0 + i - 1) * CP + OFF_RW + col);
            const f32x4 m0 = *(const f32x4*)(mu + col), m1 = *(const f32x4*)(mu + col + 4);
            float x[8];
#pragma unroll
            for (int j = 0; j < 4; ++j) {
                const float c0 = lo_bf(cur[j]), c1 = hi_bf(cur[j]), p0 = lo_bf(prv[j]), p1 = hi_bf(prv[j]);
                const float mm0 = j < 2 ? m0[2 * j] : m1[2 * j - 4], mm1 = j < 2 ? m0[2 * j + 1] : m1[2 * j - 3];
                x[2 * j] = c0 + (p0 - c0) * mm0; x[2 * j + 1] = c1 + (p1 - c1) * mm1;
            }
            if (cc >= 24 && cc < 32) {
#pragma unroll
                for (int j = 0; j < 8; ++j) x[j] = tanhf(x[j]);
            } else if (cc >= 40) {
#pragma unroll
                for (int j = 0; j < 8; ++j) x[j] = sigmoidf_(x[j]);
            }
            *(u32x4*)dst = (u32x4){pack2(x[0], x[1]), pack2(x[2], x[3]), pack2(x[4], x[5]), pack2(x[6], x[7])};
        }
        __syncthreads();
#pragma unroll 1
        for (int tl = wv * 2; tl < wv * 2 + 2; ++tl) {
            const int pt = tl >> 2, qt = tl & 3;
            const f32x4 aw = mm16<64>(RBUF(0) + pt * 16 * LS, LS, WupT + (size_t)(h * 64 + qt * 16) * 64, 64, zero, lane);
            const f32x4 aa = mm16<64>(AupT + (size_t)(h * 64 + pt * 16) * 64, 64, RBUF(1) + qt * 16 * LS, LS, zero, lane);
            const int ch = qt * 16 + fr;
            const float w0 = p.w0[layer * 512 + h * 64 + ch];
            const f32x4 a0 = *(const f32x4*)(p.a0 + layer * 512 + h * 64 + pt * 16 + fq * 4);
            f32x4 lw, av;
#pragma unroll
            for (int e = 0; e < 4; ++e) { lw[e] = -DECAY_SCALE * sigmoidf_(w0 + aw[e]); av[e] = sigmoidf_(a0[e] + aa[e]); }
            *(f32x4*)(lwT + ch * 68 + pt * 16 + fq * 4) = lw;
            *(f32x4*)(aT + (qt * 16 + fr) * 68 + pt * 16 + fq * 4) = av;
            const f32x4 ag = mm16<128>(GupT + (size_t)(h * 64 + pt * 16) * 128, 128, RBUF(2) + qt * 16 * 136, 136, zero, lane);
            *(u32x2*)(p.GG + ((size_t)u * 64 + qt * 16 + fr) * 64 + pt * 16 + fq * 4) = pk4(ag);
        }
        __syncthreads();
        {
            const int i = tid >> 3, c8 = (tid & 7) * 8, cg = layer * 512 + h * 64 + c8;
            const u32x4 xr = *(const u32x4*)(RBUF(8) + i * LS + c8), xk = *(const u32x4*)(RBUF(9) + i * LS + c8);
            const f32x4 a0 = *(const f32x4*)(aT + i * 68 + c8), a1 = *(const f32x4*)(aT + i * 68 + c8 + 4);
            const f32x4 kk0 = *(const f32x4*)(p.k_k + cg), kk1 = *(const f32x4*)(p.k_k + cg + 4), ka0 = *(const f32x4*)(p.k_a + cg), ka1 = *(const f32x4*)(p.k_a + cg + 4);
            const f32x4 rk0 = *(const f32x4*)(p.r_k + cg), rk1 = *(const f32x4*)(p.r_k + cg + 4);
            float n2 = 0.f, bon = 0.f;
#pragma unroll
            for (int j = 0; j < 8; ++j) {
                const float r_ = (j & 1) ? hi_bf(xr[j >> 1]) : lo_bf(xr[j >> 1]), k_ = (j & 1) ? hi_bf(xk[j >> 1]) : lo_bf(xk[j >> 1]);
                const float a_ = j < 4 ? a0[j & 3] : a1[j & 3], kkc = j < 4 ? kk0[j & 3] : kk1[j & 3], kac = j < 4 ? ka0[j & 3] : ka1[j & 3], rkc = j < 4 ? rk0[j & 3] : rk1[j & 3];
                const float kkr = k_ * kkc;
                n2 += kkr * kkr;
                bon += r_ * (k_ * (1.0f + (a_ - 1.0f) * kac)) * rkc;
            }
            n2 = sum8(n2); bon = sum8(bon);
            if ((tid & 7) == 0) { gt[576 + i] = 1.0f / fmaxf(sqrtf(n2), 1e-12f); p.bonG[(size_t)u * 64 + i] = bon; }
        }
        __syncthreads();
        {
            const int ch = lane, cg = layer * 512 + h * 64 + ch;
            float lw[8], av[8], cum[8];
            {
                const f32x4 l0 = *(const f32x4*)(lwT + ch * 68 + wv * 8), l1 = *(const f32x4*)(lwT + ch * 68 + wv * 8 + 4);
#pragma unroll
                for (int e = 0; e < 4; ++e) { lw[e] = l0[e]; lw[e + 4] = l1[e]; }
#pragma unroll
                for (int e = 0; e < 8; ++e) av[e] = aT[(wv * 8 + e) * 68 + ch];
            }
            float run = 0.f;
#pragma unroll
            for (int e = 0; e < 8; ++e) { run += lw[e]; cum[e] = run; }
            gt[wv * 64 + ch] = run;
            __syncthreads();
            float offs = 0.f, tot = 0.f;
#pragma unroll
            for (int g2 = 0; g2 < 8; ++g2) { const float gv = gt[g2 * 64 + ch]; offs += g2 < wv ? gv : 0.f; tot += gv; }
            if (wv == 0) gammaC[ch] = __expf(tot);
            const float kkc = p.k_k[cg], kac = p.k_a[cg];
            float at_[8], kt_[8], bt_[8], vt_[8];
#pragma unroll
            for (int e = 0; e < 8; ++e) {
                const int i = wv * 8 + e;
                const float xr = bf2f(RBUF(8)[i * LS + ch]), xk = bf2f(RBUF(9)[i * LS + ch]), xv = bf2f(RBUF(10)[i * LS + ch]);
                const float cm = cum[e] + offs;
                const float kk = xk * kkc * gt[576 + i];
                const float kq = xk * (1.0f + (av[e] - 1.0f) * kac);
                if (c * 64 + i < L) p.orw[(tok0 + i) * 512 + h * 64 + ch] = RBUF(10)[i * LS + ch];
                const float eneg = __expf(-cm), epos = __expf(cm), eexc = __expf(cm - lw[e]);
                at_[e] = -kk * eexc; kt_[e] = kq * eneg; bt_[e] = kk * av[e] * eneg; vt_[e] = xv;
                RBUF(3)[i * LS + ch] = f2bf(xr * epos);
            }
            __syncthreads();
#pragma unroll
            for (int e = 0; e < 8; ++e) {
                const int i = wv * 8 + e;
                RBUF(0)[i * LS + ch] = f2bf(at_[e]); RBUF(1)[i * LS + ch] = f2bf(kt_[e]); RBUF(2)[i * LS + ch] = f2bf(bt_[e]);
            }
            *(u32x4*)(RBUF(11) + ch * LS + wv * 8) = (u32x4){pack2(kt_[0], kt_[1]), pack2(kt_[2], kt_[3]), pack2(kt_[4], kt_[5]), pack2(kt_[6], kt_[7])};
            *(u32x4*)(RBUF(12) + ch * LS + wv * 8) = (u32x4){pack2(bt_[0], bt_[1]), pack2(bt_[2], bt_[3]), pack2(bt_[4], bt_[5]), pack2(bt_[6], bt_[7])};
            *(u32x4*)(RBUF(13) + ch * LS + wv * 8) = (u32x4){pack2(vt_[0], vt_[1]), pack2(vt_[2], vt_[3]), pack2(vt_[4], vt_[5]), pack2(vt_[6], vt_[7])};
            *(u32x4*)(Xt0 + ch * LS + wv * 8) = (u32x4){pack2(at_[0], at_[1]), pack2(at_[2], at_[3]), pack2(at_[4], at_[5]), pack2(at_[6], at_[7])};
        }
        __syncthreads();
#pragma unroll
        for (int prod = 0; prod < 5; ++prod) {
            const bf16_t* F = prod == 0 ? RBUF(1) : prod == 1 ? RBUF(2) : prod == 2 ? RBUF(0) : prod == 3 ? RBUF(1) : RBUF(2);
            const bf16_t* S = prod == 0 ? RBUF(0) : prod == 1 ? RBUF(0) : prod == 2 ? RBUF(2) : RBUF(3);
            bf16_t* O = prod == 0 ? RBUF(6) : prod == 1 ? RBUF(7) : prod == 2 ? RBUF(8) : prod == 3 ? RBUF(9) : RBUF(10);
            const int mode = prod < 2 ? 0 : prod == 2 ? 2 : 1;
#pragma unroll
            for (int rep = 0; rep < 2; ++rep) {
                const int tl = wv + 8 * rep, pt = tl >> 2, qt = tl & 3;
                f32x4 acc = mm16<64>(F + pt * 16 * LS, LS, S + qt * 16 * LS, LS, zero, lane);
                const int qi = qt * 16 + fr;
#pragma unroll
                for (int e = 0; e < 4; ++e) {
                    const int pi = pt * 16 + fq * 4 + e;
                    const bool keep = mode == 0 ? pi < qi : (mode == 1 ? pi <= qi : qi < pi);
                    acc[e] = keep ? acc[e] : 0.f;
                }
                *(u32x2*)(O + qi * LS + pt * 16 + fq * 4) = pk4(acc);
            }
        }
        __syncthreads();
        f32x4 X[4];
        if (wv < 4) {
#pragma unroll
            for (int pt = 0; pt < 4; ++pt) X[pt] = up4(*(const u32x2*)(Xt0 + (wv * 16 + fr) * LS + pt * 16 + fq * 4));
        } else {
#pragma unroll
            for (int pt = 0; pt < 4; ++pt) {
                X[pt] = mm16<64>(RBUF(6) + pt * 16 * LS, LS, RBUF(13) + (wv - 4) * 16 * LS, LS, zero, lane);
                *(u32x2*)(Xt0 + (wv * 16 + fr) * LS + pt * 16 + fq * 4) = pk4(X[pt]);
            }
        }
        __syncthreads();
#pragma unroll
        for (int k = 0; k < 6; ++k) {
            const bf16_t* Mk = (k & 1) ? RBUF(0) : RBUF(7);
            const bf16_t* Mkt = (k & 1) ? RBUF(6) : RBUF(8);
            bf16_t* Mn = (k & 1) ? RBUF(7) : RBUF(0);
            bf16_t* Mnt = (k & 1) ? RBUF(8) : RBUF(6);
            const bf16_t* Xc = (k & 1) ? Xt1 : Xt0;
            bf16_t* Xn = (k & 1) ? Xt0 : Xt1;
#pragma unroll
            for (int pt = 0; pt < 4; ++pt) {
                X[pt] = mm16<64>(Mk + pt * 16 * LS, LS, Xc + wv * 16 * LS, LS, X[pt], lane);
                *(u32x2*)(Xn + (wv * 16 + fr) * LS + pt * 16 + fq * 4) = pk4(X[pt]);
            }
            if (k < 5) {
#pragma unroll
                for (int which = 0; which < 2; ++which) {
                    const bf16_t* F = which ? Mk : Mkt; const bf16_t* S = which ? Mkt : Mk; bf16_t* O = which ? Mnt : Mn;
#pragma unroll
                    for (int rep = 0; rep < 2; ++rep) {
                        const int t2 = wv + 8 * rep, pt = t2 >> 2, qt = t2 & 3;
                        const f32x4 acc = mm16<64>(F + pt * 16 * LS, LS, S + qt * 16 * LS, LS, zero, lane);
                        *(u32x2*)(O + (qt * 16 + fr) * LS + pt * 16 + fq * 4) = pk4(acc);
                    }
                }
            }
            __syncthreads();
        }
#pragma unroll
        for (int rep = 0; rep < 2; ++rep) {
            const int tl = wv + 8 * rep, pt = tl >> 2, qt = tl & 3;
            const int pi0 = pt * 16 + fq * 4, qi = qt * 16 + fr;
            const size_t go = ((size_t)u * 64 + qi) * 64 + pi0;
            {
                f32x4 acc = mm16<64>(Xt0 + pt * 16 * LS, LS, RBUF(12) + qt * 16 * LS, LS, zero, lane);
                const float gc = gammaC[qi];
#pragma unroll
                for (int e = 0; e < 4; ++e) acc[e] = (acc[e] + (pi0 + e == qi ? 1.f : 0.f)) * gc;
                {
                    const size_t d = (((size_t)u * 8 + (qi >> 5) * 4 + (pi0 >> 4)) * 64 + (qi & 31) + 32 * ((pi0 >> 2) & 1)) * 8 + ((pi0 >> 3) & 1) * 4;
                    *(u32x2*)(p.PcG + d) = pk4(acc);
                }
            }
            {
                f32x4 acc = mm16<64>(RBUF(11) + pt * 16 * LS, LS, RBUF(13) + qt * 16 * LS, LS, zero, lane);
                acc = mm16<64>(RBUF(12) + pt * 16 * LS, LS, Xt0 + (64 + qt * 16) * LS, LS, acc, lane);
                const f32x4 gc = *(const f32x4*)(gammaC + pi0);
#pragma unroll
                for (int e = 0; e < 4; ++e) acc[e] *= gc[e];
                {
                    const int kk = pi0 & 31;
                    const size_t d = (((size_t)u * 4 + (qi >> 5) * 2 + (pi0 >> 5)) * 64 + (qi & 31) + 32 * ((kk >> 2) & 1)) * 16 + (kk >> 3) * 4;
                    *(u32x2*)(p.QcG + d) = pk4(acc);
                }
            }
            {
                f32x4 acc = mm16<64>(Xt0 + pt * 16 * LS, LS, RBUF(10) + qt * 16 * LS, LS, zero, lane);
                const f32x4 rr = up4(*(const u32x2*)(RBUF(3) + qi * LS + pi0));
#pragma unroll
                for (int e = 0; e < 4; ++e) acc[e] += rr[e];
                *(u32x2*)(p.RhG + go) = pk4(acc);
            }
            {
                f32x4 acc = mm16<64>(RBUF(13) + pt * 16 * LS, LS, RBUF(9) + qt * 16 * LS, LS, zero, lane);
                acc = mm16<64>(Xt0 + (64 + pt * 16) * LS, LS, RBUF(10) + qt * 16 * LS, LS, acc, lane);
                *(u32x2*)(p.Y0G + go) = pk4(acc);
            }
        }
    }
}

struct R2Set { u32x4 a[8]; u32x4 q[4]; };
DI void r2_load(R2Set& st, const Params& p, size_t u, int lane, int vh) {
#pragma unroll
    for (int kt = 0; kt < 2; ++kt) {
        const bf16_t* qg = p.QcG + ((u * 4 + vh * 2 + kt) * 64 + lane) * 16;
        st.q[kt * 2] = *(const u32x4*)qg; st.q[kt * 2 + 1] = *(const u32x4*)(qg + 8);
    }
#pragma unroll
    for (int f = 0; f < 8; ++f) st.a[f] = *(const u32x4*)(p.PcG + ((u * 8 + f) * 64 + lane) * 8);
}
DI void r2_step(f32x16 (&S)[2], const R2Set& st, const Params& p, size_t u, int lane, int vh, bool last) {
#pragma unroll
    for (int kt = 0; kt < 2; ++kt) {
        bf16_t* sg = p.SG + ((u * 4 + vh * 2 + kt) * 64 + lane) * 16;
        *(u32x4*)sg = (u32x4){pack2(S[kt][0], S[kt][1]), pack2(S[kt][2], S[kt][3]), pack2(S[kt][4], S[kt][5]), pack2(S[kt][6], S[kt][7])};
        *(u32x4*)(sg + 8) = (u32x4){pack2(S[kt][8], S[kt][9]), pack2(S[kt][10], S[kt][11]), pack2(S[kt][12], S[kt][13]), pack2(S[kt][14], S[kt][15])};
    }
    if (last) return;
    bf16x8 bfr[4];
#pragma unroll
    for (int ts = 0; ts < 4; ++ts) {
        const int tl = ts >> 1, sp = ts & 1;
        const u32x4 pk = (u32x4){pack2(S[tl][8 * sp], S[tl][8 * sp + 1]), pack2(S[tl][8 * sp + 2], S[tl][8 * sp + 3]),
                                 pack2(S[tl][8 * sp + 4], S[tl][8 * sp + 5]), pack2(S[tl][8 * sp + 6], S[tl][8 * sp + 7])};
        bfr[ts] = __builtin_bit_cast(bf16x8, pk);
    }
#pragma unroll
    for (int kt = 0; kt < 2; ++kt)
#pragma unroll
        for (int hf = 0; hf < 2; ++hf)
#pragma unroll
            for (int w = 0; w < 4; ++w) { S[kt][8 * hf + 2 * w] = lo_bf(st.q[kt * 2 + hf][w]); S[kt][8 * hf + 2 * w + 1] = hi_bf(st.q[kt * 2 + hf][w]); }
#pragma unroll
    for (int ts = 0; ts < 4; ++ts)
#pragma unroll
        for (int kt = 0; kt < 2; ++kt)
            S[kt] = __builtin_amdgcn_mfma_f32_32x32x16_bf16(__builtin_bit_cast(bf16x8, st.a[kt * 4 + ts]), bfr[ts], S[kt], 0, 0, 0);
}
DI void phase_rwkv_r2(const Params& p, int chain) {
    const int lane = tid_() & 63, wv = __builtin_amdgcn_readfirstlane(tid_() >> 6);
    if (wv != 0) return;
    const int bh = chain >> 1, vh = chain & 1;
    const size_t u0 = (size_t)bh * NCHUNK;
    f32x16 S[2];
#pragma unroll
    for (int e = 0; e < 16; ++e) { S[0][e] = 0.f; S[1][e] = 0.f; }
    R2Set A, B;
    r2_load(A, p, u0, lane, vh);
    r2_load(B, p, u0 + 1, lane, vh);
#pragma unroll 1
    for (int c = 0; c < NCHUNK; c += 2) {
        r2_step(S, A, p, u0 + c, lane, vh, c == NCHUNK - 1);
        if (c == NCHUNK - 1) break;
        if (c + 2 < NCHUNK - 1) r2_load(A, p, u0 + c + 2, lane, vh);
        r2_step(S, B, p, u0 + c + 1, lane, vh, false);
        if (c + 3 < NCHUNK - 1) r2_load(B, p, u0 + c + 3, lane, vh);
    }
}

DI void phase_rwkv_r3(const Params& p, int layer, int bid, int nb) {
    const int tid = tid_(), lane = tid & 63, wv = __builtin_amdgcn_readfirstlane(tid >> 6), fr = lane & 15, fq = lane >> 4;
    for (int task = bid * 8 + wv; task < NUNIT * 4; task += nb * 8) {
        const int u = task >> 2, it = task & 3;
        const int c = u % NCHUNK, bh = u / NCHUNK, h = bh % HEADS, bb = bh / HEADS;
        const int i = it * 16 + fr, t = c * 64 + i;
        const size_t tok = (size_t)bb * L + t;
        bf16x8 sf[2];
#pragma unroll
        for (int ks = 0; ks < 2; ++ks) sf[ks] = *(const bf16x8*)(p.RhG + ((size_t)u * 64 + i) * 64 + ks * 32 + fq * 8);
        f32x4 y[4];
#pragma unroll
        for (int vt = 0; vt < 4; ++vt) {
            y[vt] = up4(*(const u32x2*)(p.Y0G + ((size_t)u * 64 + i) * 64 + vt * 16 + fq * 4));
#pragma unroll
            for (int ks = 0; ks < 2; ++ks) {
                const int vv = vt * 16 + fr;
                const bf16_t* sp = p.SG + (((size_t)u * 4 + (vv >> 5) * 2 + ks) * 64 + (vv & 31)) * 16 + 4 * fq;
                const u32x2 s0 = *(const u32x2*)sp, s1 = *(const u32x2*)(sp + 32 * 16);
                const bf16x8 f = __builtin_bit_cast(bf16x8, ((u32x4){s0[0], s0[1], s1[0], s1[1]}));
                y[vt] = __builtin_amdgcn_mfma_f32_16x16x32_bf16(f, sf[ks], y[vt], 0, 0, 0);
            }
        }
        float s = 0.f;
#pragma unroll
        for (int vt = 0; vt < 4; ++vt) s += (y[vt][0] + y[vt][1]) + (y[vt][2] + y[vt][3]);
        s += __shfl_xor(s, 16); s += __shfl_xor(s, 32);
        const float mean = s * (1.0f / 64.f);
        float q = 0.f;
#pragma unroll
        for (int vt = 0; vt < 4; ++vt)
#pragma unroll
            for (int e = 0; e < 4; ++e) { y[vt][e] -= mean; q += y[vt][e] * y[vt][e]; }
        q += __shfl_xor(q, 16); q += __shfl_xor(q, 32);
        const float rstd = rsqrtf(q * (1.0f / 64.f) + 64e-5f);
        if (t < L) {
            const float bon = p.bonG[(size_t)u * 64 + i];
#pragma unroll
            for (int vt = 0; vt < 4; ++vt) {
                const int v0 = vt * 16 + fq * 4, cg = h * 64 + v0;
                const f32x4 xv = up4(*(const u32x2*)(p.orw + tok * 512 + cg));
                const f32x4 g = up4(*(const u32x2*)(p.GG + ((size_t)u * 64 + i) * 64 + v0));
                const f32x4 lg = *(const f32x4*)(p.lnx_g + layer * 512 + cg), lb = *(const f32x4*)(p.lnx_b + layer * 512 + cg);
                f32x4 o;
#pragma unroll
                for (int e = 0; e < 4; ++e) {
                    o[e] = (y[vt][e] * rstd * lg[e] + lb[e] + bon * xv[e]) * g[e];
                }
                *(u32x2*)(p.orw + tok * 512 + cg) = pk4(o);
            }
        }
    }
}

constexpr int SB_LDS = 2 * RB + 64;
DI void phase_sb(const Params& p, int bid0, int nb, char* smem) {
    const int tid = tid_(), lane = tid & 63, wv = __builtin_amdgcn_readfirstlane(tid >> 6), fr = lane & 15, fq = lane >> 4;
    bf16_t* Ks = (bf16_t*)smem;
    bf16_t* Vt = Ks + 64 * LS;
    int* flags = (int*)(smem + 2 * RB);
    bf16x8 tri[4][2];
#pragma unroll
    for (int st = 0; st < 4; ++st)
#pragma unroll
        for (int k2 = 0; k2 < 2; ++k2)
#pragma unroll
            for (int jj = 0; jj < 8; ++jj) tri[st][k2][jj] = (32 * k2 + 16 * (jj >> 2) + 4 * fq + (jj & 3) > 16 * st + fr) ? (short)0x3F80 : (short)0;
    constexpr int NQB = (L + 127) / 128;
    const int ldkey = tid >> 3, lddc = (tid & 7) * 8;
    for (int u = bid0; u < NBATCH * HEADS * NQB; u += nb) {
        const int bh = u % (NBATCH * HEADS), b = bh / HEADS, h = bh % HEADS, q0 = (u / (NBATCH * HEADS)) * 128;
        const int qlo = q0 + 16 * wv, query = qlo + fr;
        const size_t tokb = (size_t)b * L;
        bf16x8 qf[2];
#pragma unroll
        for (int ks = 0; ks < 2; ++ks) qf[ks] = *(const bf16x8*)(p.P + (tokb + query) * CP + OFF_Q + h * 64 + ks * 32 + fq * 8);
        const int qmax = (q0 + 127 < L - 1) ? q0 + 127 : L - 1;
        int kt = (qmax - 1) >> 6;
        float R = 0.f;
        f32x4 ot[4];
#pragma unroll
        for (int dt = 0; dt < 4; ++dt) ot[dt] = (f32x4){0.f, 0.f, 0.f, 0.f};
        bool done = qlo >= L;
        u32x4 kreg, vreg;
        {
            const int s = kt * 64 + ldkey;
            const bf16_t* src = p.P + (tokb + s) * CP + h * 64 + lddc;
            kreg = s < L ? *(const u32x4*)(src + OFF_K) : (u32x4){0u, 0u, 0u, 0u};
            vreg = s < L ? *(const u32x4*)(src + OFF_V) : (u32x4){0u, 0u, 0u, 0u};
        }
        for (;;) {
            __syncthreads();
            *(u32x4*)(Ks + ldkey * LS + lddc) = kreg;
#pragma unroll
            for (int j = 0; j < 4; ++j) { Vt[(lddc + 2 * j) * LS + ldkey] = (bf16_t)(vreg[j] & 0xFFFFu); Vt[(lddc + 2 * j + 1) * LS + ldkey] = (bf16_t)(vreg[j] >> 16); }
            __syncthreads();
            if (kt > 0) {
                const int s = (kt - 1) * 64 + ldkey;
                const bf16_t* src = p.P + (tokb + s) * CP + h * 64 + lddc;
                kreg = *(const u32x4*)(src + OFF_K); vreg = *(const u32x4*)(src + OFF_V);
            }
            if (!done && kt * 64 < qlo + 15) {
                f32x4 uu[4], lsp[4];
                float tot = 0.f;
#pragma unroll
                for (int kk = 0; kk < 4; ++kk) {
                    f32x4 z = (f32x4){0.f, 0.f, 0.f, 0.f};
#pragma unroll
                    for (int ks = 0; ks < 2; ++ks) {
                        const bf16x8 f = *(const bf16x8*)(Ks + (16 * kk + fr) * LS + ks * 32 + fq * 8);
                        z = __builtin_amdgcn_mfma_f32_16x16x32_bf16(f, qf[ks], z, 0, 0, 0);
                    }
#pragma unroll
                    for (int e = 0; e < 4; ++e) {
                        const float zz = z[e] * 0.125f;
                        const float lsneg = -(fmaxf(zz, 0.f) + __logf(1.0f + __expf(-fabsf(zz))));
                        const bool valid = kt * 64 + 16 * kk + 4 * fq + e < query;
                        uu[kk][e] = valid ? lsneg : 0.f;
                        lsp[kk][e] = valid ? lsneg + zz : -1.0e30f;
                        tot += uu[kk][e];
                    }
                }
                tot += __shfl_xor(tot, 16); tot += __shfl_xor(tot, 32);
                f32x4 rest[4];
#pragma unroll
                for (int st = 0; st < 4; ++st) rest[st] = (f32x4){0.f, 0.f, 0.f, 0.f};
#pragma unroll
                for (int k2 = 0; k2 < 2; ++k2) {
                    u32x4 hi, lo;
#pragma unroll
                    for (int t2 = 0; t2 < 2; ++t2) {
                        const f32x4 a = uu[2 * k2 + t2];
                        const unsigned h0 = pack2(a[0], a[1]), h1 = pack2(a[2], a[3]);
                        hi[2 * t2] = h0; hi[2 * t2 + 1] = h1;
                        lo[2 * t2] = pack2(a[0] - lo_bf(h0), a[1] - hi_bf(h0)); lo[2 * t2 + 1] = pack2(a[2] - lo_bf(h1), a[3] - hi_bf(h1));
                    }
                    const bf16x8 fh = __builtin_bit_cast(bf16x8, hi), fl = __builtin_bit_cast(bf16x8, lo);
#pragma unroll
                    for (int st = 0; st < 4; ++st) {
                        rest[st] = __builtin_amdgcn_mfma_f32_16x16x32_bf16(tri[st][k2], fh, rest[st], 0, 0, 0);
                        rest[st] = __builtin_amdgcn_mfma_f32_16x16x32_bf16(tri[st][k2], fl, rest[st], 0, 0, 0);
                    }
                }
                bf16x8 af[2];
#pragma unroll
                for (int k2 = 0; k2 < 2; ++k2) {
                    u32x4 pk;
#pragma unroll
                    for (int t2 = 0; t2 < 2; ++t2) {
                        const int kk = 2 * k2 + t2;
                        float a4[4];
#pragma unroll
                        for (int e = 0; e < 4; ++e) a4[e] = __expf(lsp[kk][e] + R + rest[kk][e]);
                        pk[2 * t2] = pack2(a4[0], a4[1]); pk[2 * t2 + 1] = pack2(a4[2], a4[3]);
                    }
                    af[k2] = __builtin_bit_cast(bf16x8, pk);
                }
                R += tot;
#pragma unroll
                for (int dt = 0; dt < 4; ++dt)
#pragma unroll
                    for (int k2 = 0; k2 < 2; ++k2) {
                        const bf16_t* vp = Vt + (16 * dt + fr) * LS + 32 * k2 + 4 * fq;
                        const u32x2 v0 = *(const u32x2*)vp, v1 = *(const u32x2*)(vp + 16);
                        const bf16x8 f = __builtin_bit_cast(bf16x8, ((u32x4){v0[0], v0[1], v1[0], v1[1]}));
                        ot[dt] = __builtin_amdgcn_mfma_f32_16x16x32_bf16(f, af[k2], ot[dt], 0, 0, 0);
                    }
                done = __all((R < -104.0f) || (query >= L));
            }
            if (lane == 0) flags[wv] = done ? 1 : 0;
            __syncthreads();
            int alld = 1;
#pragma unroll
            for (int w = 0; w < 8; ++w) alld &= flags[w];
            if (alld || kt == 0) break;
            --kt;
        }
        if (query < L) {
#pragma unroll
            for (int dt = 0; dt < 4; ++dt) *(u32x2*)(p.osb + (tokb + query) * 512 + h * 64 + 16 * dt + 4 * fq) = pk4(ot[dt]);
        }
    }
}

DI void phase_gates(const Params& p, int layer, int bid, int nb, char* smem) {
    const bf16_t* hb = p.hb; bf16_t* G = p.gates;
    const bf16_t* Bt = p.WtIn + ((size_t)layer * CIN + CP) * D;
    g8::DenseOrder S; S.init(hb, Bt, MFULL, 2048 / 256, D, nb, bid);
    g8::gemm8<false>((G8_LAS unsigned char*)smem, D, S, EpiStore{G, 2048, true});
    for (int t = left_first(MFULL * 8, bid, nb); t < 2048 / 128; t += nb)
        gemm_tile128([=](int r) { return r < T ? hb + (size_t)r * D : (const bf16_t*)nullptr; }, Bt, D, D, M0_LEFT, t * 128, smem,
                     [=](int r, int c, f32x4 v) { if (r < T) *(u32x2*)(G + (size_t)r * 2048 + c) = (u32x2){pack2(sigmoidf_(v[0]), sigmoidf_(v[1])), pack2(sigmoidf_(v[2]), sigmoidf_(v[3]))}; });
}
struct EpiBranch {
    static constexpr bool PERM = true;
    const bf16_t* G; bf16_t* M; bool add;
    DI void operator()(const f32x4 (&acc)[2][2][4][2], const g8::Unit& u, int wr, int wc, int fr, int fq) const {
#pragma unroll
        for (int ai = 0; ai < 2; ++ai)
#pragma unroll
            for (int m = 0; m < 4; ++m) {
                const size_t r = (size_t)(u.pm * 256 + ai * 128 + wr * 64 + m * 16 + fr);
                const int c0 = u.pn * 256 + wc * 32 + 8 * fq;
#pragma unroll
                for (int bj = 0; bj < 2; ++bj) {
                    const u32x4 g = *(const u32x4*)(G + r * 2048 + c0 + bj * 128);
                    u32x4* mp = (u32x4*)(M + r * D + c0 + bj * 128);
                    const f32x4 v0 = acc[ai][bj][m][0], v1 = acc[ai][bj][m][1];
                    float o[8] = {lo_bf(g[0]) * v0[0], hi_bf(g[0]) * v0[1], lo_bf(g[1]) * v0[2], hi_bf(g[1]) * v0[3], lo_bf(g[2]) * v1[0], hi_bf(g[2]) * v1[1], lo_bf(g[3]) * v1[2], hi_bf(g[3]) * v1[3]};
                    if (add) {
                        const u32x4 mo = *mp;
#pragma unroll
                        for (int q = 0; q < 4; ++q) { o[2 * q] += lo_bf(mo[q]); o[2 * q + 1] += hi_bf(mo[q]); }
                    }
                    *mp = (u32x4){pack2(o[0], o[1]), pack2(o[2], o[3]), pack2(o[4], o[5]), pack2(o[6], o[7])};
                }
            }
    }
};
DI void phase_branch(const Params& p, int layer, int which, int bid, int nb, char* smem) {
    const bf16_t* A = which ? p.orw : p.osb; const bf16_t* G = p.gates + which * 1024; bf16_t* M = p.merged;
    const bf16_t* Bt = (which ? p.WtPrw : p.WtPsb) + (size_t)layer * D * 512;
    g8::DenseOrder S; S.init(A, Bt, MFULL, D / 256, 512, nb, bid);
    g8::gemm8<false>((G8_LAS unsigned char*)smem, 512, S, EpiBranch{G, M, which != 0});
    for (int t = left_first(MFULL * 4, bid, nb); t < D / 128; t += nb)
        gemm_tile128([=](int r) { return r < T ? A + (size_t)r * 512 : (const bf16_t*)nullptr; }, Bt, 512, 512, M0_LEFT, t * 128, smem,
                     [=](int r, int c, f32x4 v) {
                         if (r >= T) return;
                         const u32x2 g = *(const u32x2*)(G + (size_t)r * 2048 + c);
                         float o0 = lo_bf(g[0]) * v[0], o1 = hi_bf(g[0]) * v[1], o2 = lo_bf(g[1]) * v[2], o3 = hi_bf(g[1]) * v[3];
                         u32x2* mp = (u32x2*)(M + (size_t)r * D + c);
                         if (which) { const u32x2 m = *mp; o0 += lo_bf(m[0]); o1 += hi_bf(m[0]); o2 += lo_bf(m[1]); o3 += hi_bf(m[1]); }
                         *mp = (u32x2){pack2(o0, o1), pack2(o2, o3)};
                     });
}
struct EpiOut {
    static constexpr bool PERM = false;
    float* hmeta; float* out;
    DI void operator()(const f32x4 (&acc)[2][2][4][2], const g8::Unit& u, int wr, int wc, int fr, int fq) const {
#pragma unroll
        for (int ai = 0; ai < 2; ++ai)
#pragma unroll
            for (int m = 0; m < 4; ++m) {
                float* rowp = hrow2(hmeta, out, u.pm * 256 + ai * 128 + wr * 64 + m * 16 + fr) + u.pn * 256 + wc * 32 + 4 * fq;
#pragma unroll
                for (int bj = 0; bj < 2; ++bj)
#pragma unroll
                    for (int n = 0; n < 2; ++n) {
                        f32x4* hp = (f32x4*)(rowp + bj * 128 + n * 16);
                        const f32x4 h = *hp, v = acc[ai][bj][m][n];
                        *hp = (f32x4){ALPHA * h[0] + v[0], ALPHA * h[1] + v[1], ALPHA * h[2] + v[2], ALPHA * h[3] + v[3]};
                    }
            }
    }
};
DI void phase_outproj(const Params& p, int layer, int bid, int nb, char* smem) {
    const bf16_t* A = p.merged; float* const hmeta = p.hmeta; float* const outp = p.out;
    const bf16_t* Bt = p.WtOut + (size_t)layer * D * D;
    if (bid == 0 && tid_() < NE) p.counts[tid_()] = 0;
    g8::DenseOrder S; S.init(A, Bt, MFULL, D / 256, D, nb, bid);
    g8::gemm8<false>((G8_LAS unsigned char*)smem, D, S, EpiOut{hmeta, outp});
    for (int t = left_first(MFULL * 4, bid, nb); t < D / 128; t += nb)
        gemm_tile128([=](int r) { return r < T ? A + (size_t)r * D : (const bf16_t*)nullptr; }, Bt, D, D, M0_LEFT, t * 128, smem,
                     [=](int r, int c, f32x4 v) {
                         if (r >= T) return;
                         f32x4* hp = (f32x4*)(hrow2(hmeta, outp, r) + c);
                         const f32x4 h = *hp;
                         *hp = (f32x4){ALPHA * h[0] + v[0], ALPHA * h[1] + v[1], ALPHA * h[2] + v[2], ALPHA * h[3] + v[3]};
                     });
}

DI void phase_ln1_router(const Params& p, int layer, int bid, int nb) {
    const int lane = tid_() & 63, wid = __builtin_amdgcn_readfirstlane(tid_() >> 6);
    for (int tok = bid * 8 + wid; tok < T; tok += nb * 8) {
        float* hf = hrow(p, tok);
        float v[16];
#pragma unroll
        for (int j = 0; j < 4; ++j) { const f32x4 a = *(const f32x4*)(hf + 256 * j + 4 * lane); v[4 * j] = a[0]; v[4 * j + 1] = a[1]; v[4 * j + 2] = a[2]; v[4 * j + 3] = a[3]; }
        ln16(v, p.ln1_g + layer * D, p.ln1_b + layer * D, lane);
        store_row(hf, p.hb + (size_t)tok * D, v, lane);
        float lg[16];
#pragma unroll
        for (int e = 0; e < 16; ++e) lg[e] = 0.f;
#pragma unroll
        for (int j = 0; j < 4; ++j)
#pragma unroll
            for (int i = 0; i < 4; ++i) {
                const float* rw = p.router_w + (size_t)(256 * j + 4 * lane + i) * NE;
#pragma unroll
                for (int e4 = 0; e4 < 4; ++e4) {
                    const f32x4 w = *(const f32x4*)(rw + 4 * e4);
#pragma unroll
                    for (int q = 0; q < 4; ++q) lg[4 * e4 + q] += v[4 * j + i] * w[q];
                }
            }
        float mx = -3.0e38f;
#pragma unroll
        for (int e = 0; e < 16; ++e) { lg[e] = wave_sum(lg[e]) + p.router_b[e]; mx = fmaxf(mx, lg[e]); }
        float sum = 0.f;
#pragma unroll
        for (int e = 0; e < 16; ++e) { lg[e] = __expf(lg[e] - mx); sum += lg[e]; }
        const float inv = 1.0f / sum;
        float bs = -1.f, bv1 = 0.f, bv2 = 0.f; int be1 = 0, be2 = 1;
#pragma unroll
        for (int g = 0; g < 4; ++g) {
            float v1 = -1.f, v2 = -1.f; int i1 = 0, i2 = 0;
#pragma unroll
            for (int i = 0; i < 4; ++i) {
                const float pv = lg[4 * g + i] * inv;
                if (pv > v1) { v2 = v1; i2 = i1; v1 = pv; i1 = i; } else if (pv > v2) { v2 = pv; i2 = i; }
            }
            const float sc = v1 + v2;
            if (sc > bs) { bs = sc; bv1 = v1; bv2 = v2; be1 = 4 * g + i1; be2 = 4 * g + i2; }
        }
        if (lane == 0) {
            const float gs = 1.0f / (bv1 + bv2);
            const int s1 = atomicAdd(&p.counts[be1], 1), s2 = atomicAdd(&p.counts[be2], 1);
            p.list[be1 * T + s1] = tok * 2; p.list[be2 * T + s2] = tok * 2 + 1;
            p.tokg[tok * 2] = bv1 * gs; p.tokg[tok * 2 + 1] = bv2 * gs;
        }
    }
}

template <bool UP> struct MoeOrder {
    const int* counts; const int* list; int G, c; const char* A; const char* B;
    DI bool next(int i, g8::Unit& u) const {
        const int Lq = i * G + c, tm = Lq >> 2;
        int start = 0, fe = -1, fs = 0, fc = 0;
#pragma unroll
        for (int e = 0; e < NE; ++e) {
            const int cn = counts[e], nt = (cn + 255) >> 8;
            const bool hit = tm >= start && tm < start + nt;
            fe = hit ? e : fe; fs = hit ? (tm - start) * 256 : fs; fc = hit ? cn : fc;
            start += nt;
        }
        fe = __builtin_amdgcn_readfirstlane(fe); fs = __builtin_amdgcn_readfirstlane(fs); fc = __builtin_amdgcn_readfirstlane(fc);
        if (fe < 0) return false;
        u.e = fe; u.slot0 = fs; u.cnt = fc; u.pm = tm; u.pn = Lq & 3;
        u.A = UP ? A : A + (size_t)tm * ((size_t)256 * DE * 2);
        u.B = UP ? B + (size_t)fe * ((size_t)1024 * 1024 * 2) + (size_t)u.pn * ((size_t)256 * D * 2) : B + (size_t)fe * ((size_t)1024 * 512 * 2) + (size_t)u.pn * ((size_t)256 * DE * 2);
        return true;
    }
    DI unsigned row_off(const g8::Unit& u, int r) const {
        const __amdgpu_buffer_rsrc_t rs = __builtin_amdgcn_make_buffer_rsrc((void*)list, 0, NE * T * 4, 0x00020000);
        const int ent = __builtin_amdgcn_raw_buffer_load_b32(rs, r * 4, (u.e * T + u.slot0) * 4, 0);
        return u.slot0 + r < u.cnt ? (unsigned)(ent >> 1) * (unsigned)(D * 2) : 0u;
    }
};
struct EpiMoeUp {
    static constexpr bool PERM = true;
    bf16_t* hid;
    DI void operator()(const f32x4 (&acc)[2][2][4][2], const g8::Unit& u, int wr, int wc, int fr, int fq) const {
#pragma unroll
        for (int ai = 0; ai < 2; ++ai)
#pragma unroll
            for (int m = 0; m < 4; ++m) {
                const int r = ai * 128 + wr * 64 + m * 16 + fr;
                if (u.slot0 + r >= u.cnt) continue;
                bf16_t* rowp = hid + ((size_t)u.pm * 256 + r) * DE + ((u.pn * 256 + wc * 32 + 8 * fq) >> 1);
#pragma unroll
                for (int bj = 0; bj < 2; ++bj) {
                    const f32x4 v0 = acc[ai][bj][m][0], v1 = acc[ai][bj][m][1];
                    *(u32x2*)(rowp + bj * 64) = (u32x2){pack2(v0[0] * sigmoidf_(v0[0]) * v0[1], v0[2] * sigmoidf_(v0[2]) * v0[3]), pack2(v1[0] * sigmoidf_(v1[0]) * v1[1], v1[2] * sigmoidf_(v1[2]) * v1[3])};
                }
            }
    }
};
struct EpiMoeDown {
    static constexpr bool PERM = true;
    bf16_t* fo; const int* list; const float* tokg;
    DI void operator()(const f32x4 (&acc)[2][2][4][2], const g8::Unit& u, int wr, int wc, int fr, int fq) const {
#pragma unroll
        for (int ai = 0; ai < 2; ++ai)
#pragma unroll
            for (int m = 0; m < 4; ++m) {
                const int sl = u.slot0 + ai * 128 + wr * 64 + m * 16 + fr;
                if (sl >= u.cnt) continue;
                const int ent = list[u.e * T + sl];
                const float g = tokg[ent];
                bf16_t* rowp = fo + ((size_t)(ent & 1) * TP + (ent >> 1)) * D + u.pn * 256 + wc * 32 + 8 * fq;
#pragma unroll
                for (int bj = 0; bj < 2; ++bj) {
                    const f32x4 v0 = acc[ai][bj][m][0], v1 = acc[ai][bj][m][1];
                    *(u32x4*)(rowp + bj * 128) = (u32x4){pack2(g * v0[0], g * v0[1]), pack2(g * v0[2], g * v0[3]), pack2(g * v1[0], g * v1[1]), pack2(g * v1[2], g * v1[3])};
                }
            }
    }
};
DI void phase_moe_up(const Params& p, int bid, int nb, char* smem) {
    const MoeOrder<true> S{p.counts, p.list, nb, bid, (const char*)p.hb, (const char*)p.WtGU};
    g8::gemm8<true>((G8_LAS unsigned char*)smem, D, S, EpiMoeUp{p.hid});
}
DI void phase_moe_down(const Params& p, int bid, int nb, char* smem) {
    const MoeOrder<false> S{p.counts, p.list, nb, bid, (const char*)p.hid, (const char*)p.WtD};
    g8::gemm8<false>((G8_LAS unsigned char*)smem, DE, S, EpiMoeDown{p.fo, p.list, p.tokg});
}
DI void phase_ln2(const Params& p, int layer, int bid, int nb) {
    const int lane = tid_() & 63, wid = __builtin_amdgcn_readfirstlane(tid_() >> 6);
    for (int tok = bid * 8 + wid; tok < T; tok += nb * 8) {
        float* hf = hrow(p, tok);
        float v[16];
#pragma unroll
        for (int j = 0; j < 4; ++j) {
            const f32x4 a = *(const f32x4*)(hf + 256 * j + 4 * lane);
            const u32x2 f0 = *(const u32x2*)(p.fo + (size_t)tok * D + 256 * j + 4 * lane), f1 = *(const u32x2*)(p.fo + ((size_t)TP + tok) * D + 256 * j + 4 * lane);
            v[4 * j] = ALPHA * a[0] + lo_bf(f0[0]) + lo_bf(f1[0]); v[4 * j + 1] = ALPHA * a[1] + hi_bf(f0[0]) + hi_bf(f1[0]);
            v[4 * j + 2] = ALPHA * a[2] + lo_bf(f0[1]) + lo_bf(f1[1]); v[4 * j + 3] = ALPHA * a[3] + hi_bf(f0[1]) + hi_bf(f1[1]);
        }
        ln16(v, p.ln2_g + layer * D, p.ln2_b + layer * D, lane);
        store_row(hf, p.hb + (size_t)tok * D, v, lane);
    }
}

extern __shared__ __attribute__((aligned(16))) char dyn_smem[];
constexpr int SMEM_MAIN = R1_LDS > GEMM_LDS ? R1_LDS : GEMM_LDS;
constexpr int SMEM_BYTES = SMEM_MAIN + 16;

__global__ void __launch_bounds__(NTHR, 2) k_forward(Params p) {
    const int bid = blockIdx.x, nb = gridDim.x;
    char* smem = dyn_smem;
    uint4* xbw = (uint4*)(dyn_smem + SMEM_MAIN);
    if (threadIdx.x == 0) *xbw = make_uint4(0u, 0u, 0u, 0u);
    __syncthreads();
    XcdBarrier bar = xcd_barrier_post(p.bar, (volatile LAS unsigned*)xbw);
    phase_prologue_weights(p, bid, nb, smem);
    phase_embed(p, bid, nb);
    xcd_barrier(bar);
    for (int l = 0; l < DEPTH; ++l) {
        phase_inproj(p, l, bid, nb, smem);
        xcd_barrier(bar);
        phase_rwkv_r1(p, l, bid, nb, smem);
        xcd_barrier(bar);
        if (bid < 32) phase_rwkv_r2(p, bid);
        else phase_sb(p, bid - 32, nb - 32, smem);
        xcd_barrier(bar);
        phase_rwkv_r3(p, l, bid, nb);
        phase_gates(p, l, bid, nb, smem);
        xcd_barrier(bar);
        convert_experts(p, l, bid, nb, smem);
        phase_branch(p, l, 0, bid, nb, smem);
        xcd_barrier(bar);
        phase_branch(p, l, 1, bid, nb, smem);
        xcd_barrier(bar);
        phase_outproj(p, l, bid, nb, smem);
        xcd_barrier(bar);
        phase_ln1_router(p, l, bid, nb);
        xcd_barrier(bar);
        phase_moe_up(p, bid, nb, smem);
        xcd_barrier(bar);
        phase_moe_down(p, bid, nb, smem);
        xcd_barrier(bar);
        phase_ln2(p, l, bid, nb);
        xcd_barrier(bar);
    }
}

extern "C" void kernel_launch(void* const* d_in, const int* in_sizes, int n_in, void* d_out, int out_size, void* d_ws, size_t ws_size, hipStream_t stream) {
    (void)in_sizes; (void)n_in; (void)out_size;
    Params p;
    memset(&p, 0, sizeof(p));
    const float* const* in = (const float* const*)d_in;
    p.x = in[0]; p.meta = in[1]; p.emb_g = in[2]; p.emb_b = in[3]; p.w_in = in[4]; p.mu = in[5]; p.w0 = in[6]; p.w_up = in[7]; p.a0 = in[8]; p.a_up = in[9];
    p.g_up = in[10]; p.k_k = in[11]; p.k_a = in[12]; p.r_k = in[13]; p.lnx_g = in[14]; p.lnx_b = in[15]; p.p_sb = in[16]; p.p_rwkv = in[17]; p.w_out = in[18];
    p.ln1_g = in[19]; p.ln1_b = in[20]; p.router_w = in[21]; p.router_b = in[22]; p.ew_gate = in[23]; p.ew_up = in[24]; p.ew_down = in[25]; p.ln2_g = in[26]; p.ln2_b = in[27];
    p.out = (float*)d_out;
    char* ws = (char*)d_ws; size_t o = 0;
    auto take = [&](size_t bytes) { char* r = ws + o; o += (bytes + 255) & ~(size_t)255; return r; };
    p.bar = (unsigned*)take(XCD_BAR_WORDS * sizeof(unsigned));
    p.counts = (int*)take(256);
    p.WtIn = (bf16_t*)take((size_t)DEPTH * CIN * D * 2);
    p.WtPsb = (bf16_t*)take((size_t)DEPTH * D * 512 * 2);
    p.WtPrw = (bf16_t*)take((size_t)DEPTH * D * 512 * 2);
    p.WtOut = (bf16_t*)take((size_t)DEPTH * D * D * 2);
    p.WupT = (bf16_t*)take((size_t)DEPTH * 512 * 64 * 2);
    p.AupT = (bf16_t*)take((size_t)DEPTH * 512 * 64 * 2);
    p.GupT = (bf16_t*)take((size_t)DEPTH * 512 * 128 * 2);
    {
        const size_t ub = (size_t)NUNIT * 64 * 64 * 2, need_r = 6 * ub + (size_t)NUNIT * 64 * 4, need_e = (size_t)NE * 1024 * 1024 * 2 + (size_t)NE * 1024 * 512 * 2;
        char* e = take(need_r > need_e ? need_r : need_e);
        p.WtGU = (bf16_t*)e; p.WtD = (bf16_t*)(e + (size_t)NE * 1024 * 1024 * 2);
        p.PcG = (bf16_t*)e; p.QcG = (bf16_t*)(e + ub); p.RhG = (bf16_t*)(e + 2 * ub); p.Y0G = (bf16_t*)(e + 3 * ub); p.GG = (bf16_t*)(e + 4 * ub); p.SG = (bf16_t*)(e + 5 * ub);
        p.bonG = (float*)(e + 6 * ub);
    }
    p.hb = (bf16_t*)take((size_t)TP * D * 2);
    p.hmeta = (float*)take((size_t)NBATCH * NMETA * D * 4);
    p.P = (bf16_t*)take((size_t)TP * CP * 2);
    p.osb = (bf16_t*)take((size_t)TP * 512 * 2);
    p.orw = (bf16_t*)take((size_t)TP * 512 * 2);
    p.list = (int*)take((size_t)NE * T * 4);
    p.tokg = (float*)take((size_t)T * 2 * 4);
    p.gates = p.P;
    p.merged = p.P + (size_t)TP * 2048;
    p.hid = p.P;
    p.fo = p.P + (size_t)(2 * T + 16 * 256) * DE;
    if (o > ws_size) return;
    static int grid = 0;
    if (!grid) {
        int dev = 0, cus = 0, per_cu = 0;
        (void)hipGetDevice(&dev);
        (void)hipDeviceGetAttribute(&cus, hipDeviceAttributeMultiprocessorCount, dev);
        (void)hipFuncSetAttribute((const void*)k_forward, hipFuncAttributeMaxDynamicSharedMemorySize, SMEM_BYTES);
        (void)hipOccupancyMaxActiveBlocksPerMultiprocessor(&per_cu, k_forward, NTHR, SMEM_BYTES);
        grid = per_cu >= 1 ? cus : 0;
    }
    if (!grid) return;
    (void)hipMemsetAsync(p.bar, 0, XCD_BAR_WORDS * sizeof(unsigned), stream);
    hipLaunchKernelGGL(k_forward, dim3(grid), dim3(NTHR), SMEM_BYTES, stream, p);
}
```

```cpp
#include <hip/hip_runtime.h>
#include <stdint.h>
#include <string.h>

#define DI __device__ __forceinline__
typedef unsigned short bf16_t;
typedef short bf16x8 __attribute__((ext_vector_type(8)));
typedef float f32x4 __attribute__((ext_vector_type(4)));
typedef unsigned u32x4 __attribute__((ext_vector_type(4)));
typedef unsigned u32x2 __attribute__((ext_vector_type(2)));

constexpr int D = 1024, NBATCH = 2, SEQ = 8192, NMETA = 16, L = SEQ + NMETA, T = NBATCH * L, TP = 16640;
constexpr int DEPTH = 2, HEADS = 8, HD = 64;
constexpr int CIN = 5376, CP = 3328;
constexpr int OFF_Q = 0, OFF_K = 512, OFF_V = 1024, OFF_RW = 1536;
constexpr int RW_R = 0, RW_K = 512, RW_V = 1024, RW_WD = 1536, RW_AD = 1600, RW_GD = 1664, RSW = 1792;
constexpr int NE = 16, DE = 512;
constexpr float ALPHA = 1.41421356237309515f;
constexpr float DECAY_SCALE = 0.60653065971263342f;
constexpr int NTHR = 512;

#define XB_TMO      128
#define XB_XCNT(j)  (256  + 64 * (j))
#define XB_XSUB(j)  (1280 + 64 * (j))
#define XB_XGEN(j)  (2304 + 64 * (j))
#define XB_TOP      3328
#define XB_TOPGEN   3392
#define XCD_BAR_WORDS 3456
#define XB_SPIN_CAP (1u << 18)
#define LAS __attribute__((address_space(3)))

__device__ __forceinline__ unsigned xb_ld(unsigned* p)              { return __hip_atomic_load(p, __ATOMIC_RELAXED, __HIP_MEMORY_SCOPE_AGENT); }
__device__ __forceinline__ unsigned xb_add(unsigned* p, unsigned v) { return __hip_atomic_fetch_add(p, v, __ATOMIC_RELAXED, __HIP_MEMORY_SCOPE_AGENT); }
__device__ __forceinline__ unsigned xb_xcc_id() { return (unsigned)__builtin_amdgcn_s_getreg((3 << 11) | 20) & 0xFu; }
#define XB_SPIN(cond, bar) do { unsigned _sp = 0; while (cond) { __builtin_amdgcn_s_sleep(1); \
    if ((++_sp & 255u) == 0u) { if (xb_ld(&(bar)[XB_TMO])) break; if (_sp > XB_SPIN_CAP) { atomicAdd(&(bar)[XB_TMO], 1u); break; } } } } while (0)

struct XcdBarrier {
    unsigned* bar; unsigned x;
    volatile LAS unsigned* st;
};

__device__ __forceinline__ XcdBarrier xcd_barrier_post(unsigned* bar, volatile LAS unsigned* st) {
    XcdBarrier b; b.bar = bar; b.x = xb_xcc_id(); b.st = st;
    if (threadIdx.x == 0) (void)xb_add(&bar[XB_XCNT(b.x)], 1u);
    return b;
}
__device__ __forceinline__ void xcd_barrier_complete(unsigned* bar, unsigned x, unsigned& nloc, unsigned& nx) {
    const unsigned G = gridDim.x * gridDim.y * gridDim.z;
    unsigned sum, cnt, mine, sp = 0u;
    for (;;) {
        sum = 0u; cnt = 0u; mine = 0u;
#pragma unroll
        for (unsigned j = 0; j < 16; ++j) { const unsigned c = xb_ld(&bar[XB_XCNT(j)]); sum += c; cnt += (c > 0u) ? 1u : 0u; mine = (j == x) ? c : mine; }
        if (sum == G) break;
        __builtin_amdgcn_s_sleep(1);
        if ((++sp & 255u) == 0u) { if (xb_ld(&bar[XB_TMO])) break; if (sp > XB_SPIN_CAP) { atomicAdd(&bar[XB_TMO], 1u); break; } }
    }
    nloc = mine > 0u ? mine : 1u; nx = cnt > 0u ? cnt : 1u;
}

__device__ __forceinline__ void xcd_barrier(const XcdBarrier& b) {
    asm volatile("s_waitcnt vmcnt(0)" ::: "memory");
    __syncthreads();
    if (threadIdx.x == 0) {
        unsigned* bar = b.bar;
        unsigned bx = b.x; asm volatile("" : "+s"(bx));
        __builtin_amdgcn_s_waitcnt(0);
        unsigned nloc = b.st[0], nx = b.st[1];
        if (nloc == 0u) { xcd_barrier_complete(bar, bx, nloc, nx); b.st[0] = nloc; b.st[1] = nx; }
        const unsigned old = xb_add(&bar[XB_XSUB(bx)], 1u);
        const unsigned gen = old / nloc;
        if (old + 1u == (gen + 1u) * nloc) {
            __builtin_amdgcn_fence(__ATOMIC_RELEASE, "agent");
            asm volatile("s_waitcnt vmcnt(0)" ::: "memory");
            const unsigned og = xb_add(&bar[XB_TOP], 1u);
            const unsigned tg = og / nx;
            if (og + 1u == (tg + 1u) * nx) xb_add(&bar[XB_TOPGEN], 1u);
            else XB_SPIN(xb_ld(&bar[XB_TOPGEN]) == tg, bar);
            __builtin_amdgcn_fence(__ATOMIC_ACQUIRE, "agent");
            xb_add(&bar[XB_XGEN(bx)], 1u);
            asm volatile("s_waitcnt vmcnt(0)" ::: "memory");
        } else {
            XB_SPIN(xb_ld(&bar[XB_XGEN(bx)]) == gen, bar);
            __builtin_amdgcn_fence(__ATOMIC_ACQUIRE, "agent");
            asm volatile("s_waitcnt vmcnt(0)" ::: "memory");
        }
    }
    __syncthreads();
}


struct Params {
    const float *x, *meta, *emb_g, *emb_b, *w_in, *mu, *w0, *w_up, *a0, *a_up, *g_up, *k_k, *k_a, *r_k, *lnx_g, *lnx_b, *p_sb, *p_rwkv, *w_out,
        *ln1_g, *ln1_b, *router_w, *router_b, *ew_gate, *ew_up, *ew_down, *ln2_g, *ln2_b;
    float* out;
    unsigned* bar;
    int* counts;
    bf16_t *WtIn, *WtPsb, *WtPrw, *WtOut, *WtGU, *WtD, *hb, *P, *osb, *orw, *WupT, *AupT, *GupT;
    bf16_t *PcG, *QcG, *RhG, *Y0G, *GG, *SG;
    bf16_t *RwHi, *RwLo;
    float* bonG;
    float* hmeta;
    bf16_t *gates, *merged, *hid, *fo;
    int* list;
    float* tokg;
};

DI float bf2f(bf16_t v) { return __uint_as_float((unsigned)v << 16); }
typedef __bf16 bf16x2_t __attribute__((ext_vector_type(2)));
DI bf16_t f2bf(float f) { return __builtin_bit_cast(bf16_t, (__bf16)f); }
DI unsigned pack2(float lo, float hi) { bf16x2_t v = {(__bf16)lo, (__bf16)hi}; return __builtin_bit_cast(unsigned, v); }
DI float lo_bf(unsigned u) { return __uint_as_float(u << 16); }
DI float hi_bf(unsigned u) { return __uint_as_float(u & 0xFFFF0000u); }
template <int CTRL> DI float dpp_mov(float v) { return __builtin_bit_cast(float, __builtin_amdgcn_update_dpp(0, __builtin_bit_cast(int, v), CTRL, 0xF, 0xF, true)); }
DI float sum8(float v) {
    v += dpp_mov<0xB1>(v);
    v += dpp_mov<0x4E>(v);
    v += dpp_mov<0x141>(v);
    return v;
}
DI float sum16(float v) { v = sum8(v); v += dpp_mov<0x140>(v); return v; }
DI float wave_sum(float v) { v = sum16(v); v += __shfl_xor(v, 16); v += __shfl_xor(v, 32); return v; }
struct Params;
DI const Params& kparams() {
    auto k = __builtin_amdgcn_kernarg_segment_ptr();
    asm volatile("" : "+s"(k));
    return *(const Params*)k;
}
DI int tid_() { int t = threadIdx.x; asm volatile("" : "+v"(t)); return t; }
DI float sigmoidf_(float x) { return 1.0f / (1.0f + __expf(-x)); }
DI void wave_sync() { asm volatile("s_waitcnt lgkmcnt(0)" ::: "memory"); __builtin_amdgcn_wave_barrier(); }

DI float* hrow2(float* hmeta, float* out, int tok) {
    const int b = tok >= L ? 1 : 0, t = tok - b * L;
    const unsigned long long am = (unsigned long long)(hmeta + (long long)(b * NMETA + t) * D), ao = (unsigned long long)(out + ((long long)b * SEQ + (t - NMETA)) * D);
    const unsigned long long m = 0ull - (unsigned long long)(t < NMETA);
    return (float*)((am & m) | (ao & ~m));
}
DI float* hrow(const Params& p, int tok) { return hrow2(p.hmeta, p.out, tok); }
DI float* hrow_u(const Params& p, int tok) { return hrow2(p.hmeta, p.out, __builtin_amdgcn_readfirstlane(tok)); }

DI void transpose_convert(const float* __restrict__ src, int ld, int K, int N, bf16_t* __restrict__ dst, int mult, int off, int bid, int nb, char* smem) {
    float* tile = (float*)smem;
    const int tk = K / 64, tn = N / 64, tid = tid_();
    for (int t = bid; t < tk * tn; t += nb) {
        const int k0 = (t / tn) * 64, n0 = (t % tn) * 64;
        __syncthreads();
#pragma unroll
        for (int i = 0; i < 2; ++i) {
            const int k = (tid >> 4) + 32 * i, n4 = (tid & 15) * 4;
            const f32x4 v = *(const f32x4*)(src + (size_t)(k0 + k) * ld + n0 + n4);
            tile[k * 65 + n4 + 0] = v[0]; tile[k * 65 + n4 + 1] = v[1]; tile[k * 65 + n4 + 2] = v[2]; tile[k * 65 + n4 + 3] = v[3];
        }
        __syncthreads();
        const int n = tid >> 3, kc = (tid & 7) * 8;
        u32x4 o;
#pragma unroll
        for (int j = 0; j < 4; ++j) o[j] = pack2(tile[(kc + 2 * j) * 65 + n], tile[(kc + 2 * j + 1) * 65 + n]);
        *(u32x4*)(dst + (size_t)((n0 + n) * mult + off) * K + k0 + kc) = o;
    }
}

DI void convert_experts(const Params& p, int layer, int bid, int nb, char* smem) {
    for (int e = 0; e < NE; ++e) {
        const size_t eo = ((size_t)layer * NE + e) * (size_t)D * DE;
        transpose_convert(p.ew_gate + eo, DE, D, DE, p.WtGU + (size_t)e * 1024 * 1024, 2, 0, bid, nb, smem);
        transpose_convert(p.ew_up + eo, DE, D, DE, p.WtGU + (size_t)e * 1024 * 1024, 2, 1, bid, nb, smem);
        transpose_convert(p.ew_down + eo, D, DE, D, p.WtD + (size_t)e * 1024 * 512, 1, 0, bid, nb, smem);
    }
}

DI void phase_prologue_weights(const Params& p, int bid, int nb, char* smem) {
    for (int i = bid * NTHR + tid_(); i < NE * D; i += nb * NTHR) {
        const int e = i / D, k = i % D;
        const float w = p.router_w[(size_t)k * NE + e];
        const bf16_t hi = f2bf(w);
        p.RwHi[i] = hi; p.RwLo[i] = f2bf(w - bf2f(hi));
    }
    for (int l = 0; l < DEPTH; ++l) {
        transpose_convert(p.w_in + (size_t)l * D * CIN, CIN, D, CIN, p.WtIn + (size_t)l * CIN * D, 1, 0, bid, nb, smem);
        transpose_convert(p.p_sb + (size_t)l * 512 * D, D, 512, D, p.WtPsb + (size_t)l * D * 512, 1, 0, bid, nb, smem);
        transpose_convert(p.p_rwkv + (size_t)l * 512 * D, D, 512, D, p.WtPrw + (size_t)l * D * 512, 1, 0, bid, nb, smem);
        transpose_convert(p.w_out + (size_t)l * D * D, D, D, D, p.WtOut + (size_t)l * D * D, 1, 0, bid, nb, smem);
        transpose_convert(p.w_up + (size_t)l * 64 * 512, 512, 64, 512, p.WupT + (size_t)l * 512 * 64, 1, 0, bid, nb, smem);
        transpose_convert(p.a_up + (size_t)l * 64 * 512, 512, 64, 512, p.AupT + (size_t)l * 512 * 64, 1, 0, bid, nb, smem);
        transpose_convert(p.g_up + (size_t)l * 128 * 512, 512, 128, 512, p.GupT + (size_t)l * 512 * 128, 1, 0, bid, nb, smem);
    }
}

DI void ln16(float (&v)[16], const float* __restrict__ g, const float* __restrict__ b, int lane) {
    float s = 0.f;
#pragma unroll
    for (int i = 0; i < 16; ++i) s += v[i];
    const float mean = wave_sum(s) * (1.0f / D);
    float q = 0.f;
#pragma unroll
    for (int i = 0; i < 16; ++i) { v[i] -= mean; q += v[i] * v[i]; }
    const float rstd = rsqrtf(wave_sum(q) * (1.0f / D) + 1e-5f);
#pragma unroll
    for (int j = 0; j < 4; ++j) {
        const f32x4 gv = *(const f32x4*)(g + 256 * j + 4 * lane), bv = *(const f32x4*)(b + 256 * j + 4 * lane);
#pragma unroll
        for (int i = 0; i < 4; ++i) v[4 * j + i] = v[4 * j + i] * rstd * gv[i] + bv[i];
    }
}
DI void store_row(float* __restrict__ hf, bf16_t* __restrict__ hb, const float (&v)[16], int lane) {
#pragma unroll
    for (int j = 0; j < 4; ++j) {
        *(f32x4*)(hf + 256 * j + 4 * lane) = (f32x4){v[4 * j], v[4 * j + 1], v[4 * j + 2], v[4 * j + 3]};
        *(u32x2*)(hb + 256 * j + 4 * lane) = (u32x2){pack2(v[4 * j], v[4 * j + 1]), pack2(v[4 * j + 2], v[4 * j + 3])};
    }
}

DI void phase_embed(const Params& p, int bid, int nb) {
    const int lane = tid_() & 63, wid = __builtin_amdgcn_readfirstlane(tid_() >> 6);
    for (int tok = bid * 8 + wid; tok < T; tok += nb * 8) {
        const int b = tok >= L ? 1 : 0, t = tok - b * L;
        const float* src = t < NMETA ? p.meta + (size_t)t * D : p.x + ((size_t)b * SEQ + (t - NMETA)) * D;
        float v[16];
#pragma unroll
        for (int j = 0; j < 4; ++j) { const f32x4 a = *(const f32x4*)(src + 256 * j + 4 * lane); v[4 * j] = a[0]; v[4 * j + 1] = a[1]; v[4 * j + 2] = a[2]; v[4 * j + 3] = a[3]; }
        ln16(v, p.emb_g, p.emb_b, lane);
        store_row(hrow(p, tok), p.hb + (size_t)tok * D, v, lane);
    }
}

constexpr int LDT = 72;
constexpr int GEMM_LDS = 2 * 128 * LDT * 2;
template <class ARow, class Epi>
DI void gemm_tile128(ARow arow, const bf16_t* __restrict__ Bt, int ldb, int K, int m0, int n0, char* smem, Epi epi) {
    const int tid = tid_(), lane = tid & 63, wid = __builtin_amdgcn_readfirstlane(tid >> 6), fr = lane & 15, fq = lane >> 4;
    const int wr = wid >> 1, wc = wid & 1;
    bf16_t* As = (bf16_t*)smem;
    bf16_t* Bs = As + 128 * LDT;
    const bf16_t* ap[2]; const bf16_t* bp[2]; int so[2];
#pragma unroll
    for (int i = 0; i < 2; ++i) {
        const int c = tid + NTHR * i, row = c >> 3, kc = c & 7;
        const bf16_t* ar = arow(m0 + row);
        ap[i] = ar ? ar + kc * 8 : nullptr;
        bp[i] = Bt + (size_t)(n0 + row) * ldb + kc * 8;
        so[i] = row * LDT + kc * 8;
    }
    f32x4 acc[2][4];
#pragma unroll
    for (int mi = 0; mi < 2; ++mi)
#pragma unroll
        for (int ni = 0; ni < 4; ++ni) acc[mi][ni] = (f32x4){0.f, 0.f, 0.f, 0.f};
    u32x4 ra[2], rb[2];
#pragma unroll
    for (int i = 0; i < 2; ++i) { ra[i] = ap[i] ? *(const u32x4*)(ap[i]) : (u32x4){0u, 0u, 0u, 0u}; rb[i] = *(const u32x4*)(bp[i]); }
    for (int k0 = 0; k0 < K; k0 += 64) {
        __syncthreads();
#pragma unroll
        for (int i = 0; i < 2; ++i) { *(u32x4*)(As + so[i]) = ra[i]; *(u32x4*)(Bs + so[i]) = rb[i]; }
        __syncthreads();
        if (k0 + 64 < K) {
#pragma unroll
            for (int i = 0; i < 2; ++i) { ra[i] = ap[i] ? *(const u32x4*)(ap[i] + k0 + 64) : (u32x4){0u, 0u, 0u, 0u}; rb[i] = *(const u32x4*)(bp[i] + k0 + 64); }
        }
#pragma unroll
        for (int ks = 0; ks < 2; ++ks) {
            bf16x8 af[2], bf[4];
#pragma unroll
            for (int mi = 0; mi < 2; ++mi) af[mi] = *(const bf16x8*)(As + (wr * 32 + mi * 16 + fr) * LDT + ks * 32 + fq * 8);
#pragma unroll
            for (int ni = 0; ni < 4; ++ni) bf[ni] = *(const bf16x8*)(Bs + (wc * 64 + ni * 16 + fr) * LDT + ks * 32 + fq * 8);
#pragma unroll
            for (int mi = 0; mi < 2; ++mi)
#pragma unroll
                for (int ni = 0; ni < 4; ++ni) acc[mi][ni] = __builtin_amdgcn_mfma_f32_16x16x32_bf16(bf[ni], af[mi], acc[mi][ni], 0, 0, 0);
        }
    }
#pragma unroll
    for (int mi = 0; mi < 2; ++mi)
#pragma unroll
        for (int ni = 0; ni < 4; ++ni) epi(m0 + wr * 32 + mi * 16 + fr, n0 + wc * 64 + ni * 16 + fq * 4, acc[mi][ni]);
}

namespace g8 {
#define G8_LAS __attribute__((address_space(3)))
constexpr int BM = 256, BK = 64, HALF = 128, HTB = HALF * BK * 2, STAGE_BYTES = 8 * HTB, NXCD = 8, WGM = 8;
DI int lds_byte(int r, int c) { const int st = (r >> 4) * 2 + (c >> 5), rr = r & 15, cc = c & 31, ob = rr * 64 + cc * 2; return st * 1024 + (ob ^ (((ob >> 9) & 1) << 5)); }
DI void stage_rc(int b, int& R, int& C) { const int st = b / 1024, sb = b % 1024, swz = sb ^ (((sb >> 9) & 1) << 5); R = (st >> 1) * 16 + swz / 64; C = (st & 1) * 32 + (swz % 64) / 2; }
DI int perm32(int rho) { const int n = rho >> 4, i = rho & 15; return 8 * (i >> 2) + 4 * n + (i & 3); }
struct Unit { int pm, pn; const char* A; const char* B; int e, slot0, cnt; };

struct DenseOrder {
    int nM, nN, nwg, G, c; const char* A; const char* B; size_t tstep;
    DI void init(const bf16_t* A_, const bf16_t* Bt_, int nM_, int nN_, int K, int G_, int c_) { nM = nM_; nN = nN_; nwg = nM * nN; G = G_; c = c_; A = (const char*)A_; B = (const char*)Bt_; tstep = (size_t)BM * K * 2; }
    DI bool next(int i, Unit& u) const {
        const long Lq = (long)i * G + c; if (Lq >= nwg) return false;
        int wgid = (int)Lq; { const int q = nwg / NXCD, r = nwg % NXCD, xcd = wgid % NXCD, off = wgid / NXCD; wgid = (xcd < r ? xcd * (q + 1) : r * (q + 1) + (xcd - r) * q) + off; }
        const int nig = WGM * nN, gid = wgid / nig, fm = gid * WGM, gsz = (nM - fm) < WGM ? (nM - fm) : WGM;
        u.pm = fm + ((wgid % nig) % gsz); u.pn = (wgid % nig) / gsz; u.A = A + (size_t)u.pm * tstep; u.B = B + (size_t)u.pn * tstep; u.e = 0; u.slot0 = 0; u.cnt = 0; return true;
    }
    DI unsigned row_off(const Unit&, int) const { return 0u; }
};

template <bool GATHER, class Epi, class Sched>
DI void gemm8(G8_LAS unsigned char* lds, const int K, const Sched& S, const Epi& E) {
    const int tid = tid_(), wid = __builtin_amdgcn_readfirstlane(tid >> 6), lane = tid & 63, wr = wid >> 2, wc = wid & 3, fr = lane & 15, fq = lane >> 4;
    const int nt = K / BK;
    int Rr[2], Cc[2]; unsigned voffB[2], voffA[2];
#pragma unroll
    for (int i = 0; i < 2; ++i) { stage_rc(tid * 16 + i * 8192, Rr[i], Cc[i]); const int Rb = Epi::PERM ? ((Rr[i] & ~31) + perm32(Rr[i] & 31)) : Rr[i]; voffB[i] = (unsigned)(Rb * K + Cc[i]) * 2u; voffA[i] = (unsigned)(Rr[i] * K + Cc[i]) * 2u; }
    const size_t kstep = (size_t)(BK * 2), hstep = (size_t)HALF * K * 2;
    const unsigned ldsw = (unsigned)wid * 1024u;
    const int aoff = lds_byte(wr * 64 + fr, fq * 8), boff = lds_byte(wc * 32 + fr, fq * 8);
#define G8_SA(b, h) (((b) * 2 + (h)) * HTB)
#define G8_SB(b, h) ((4 + (b) * 2 + (h)) * HTB)
#define G8_STAGE(bufoff, gbase, voff) do { _Pragma("unroll") for (int _i = 0; _i < 2; ++_i) \
        __builtin_amdgcn_global_load_lds((const unsigned*)((const char*)(gbase) + (voff)[_i]), (G8_LAS unsigned*)(lds + (bufoff) + ldsw + _i * 8192), 16, 0, 0); } while (0)
#define G8_LDA(dst, b, h) do { _Pragma("unroll") for (int m = 0; m < 4; ++m) _Pragma("unroll") for (int k = 0; k < 2; ++k) dst[m][k] = *(const G8_LAS bf16x8*)(lds + G8_SA(b, h) + aoff + m * 2048 + k * 1024); } while (0)
#define G8_LDB(dst, b, h) do { _Pragma("unroll") for (int n = 0; n < 2; ++n) _Pragma("unroll") for (int k = 0; k < 2; ++k) dst[n][k] = *(const G8_LAS bf16x8*)(lds + G8_SB(b, h) + boff + n * 2048 + k * 1024); } while (0)
#define G8_MMA(ai, bj, At, Bt) do { __builtin_amdgcn_s_setprio(1); _Pragma("unroll") for (int m = 0; m < 4; ++m) _Pragma("unroll") for (int n = 0; n < 2; ++n) _Pragma("unroll") for (int k = 0; k < 2; ++k) \
        acc[ai][bj][m][n] = __builtin_amdgcn_mfma_f32_16x16x32_bf16(Bt[n][k], At[m][k], acc[ai][bj][m][n], 0, 0, 0); __builtin_amdgcn_s_setprio(0); } while (0)
#define G8_WAIT_V(n) asm volatile("s_waitcnt vmcnt(" #n ")" ::: "memory")
#define G8_WAIT_L(n) asm volatile("s_waitcnt lgkmcnt(" #n ")" ::: "memory")
#define G8_BAR __builtin_amdgcn_s_barrier()
#define G8_SCHED __builtin_amdgcn_sched_barrier(0)
#define G8_AOFF(dst, un) do { if (GATHER) { _Pragma("unroll") for (int _h = 0; _h < 2; ++_h) _Pragma("unroll") for (int _i = 0; _i < 2; ++_i) \
        dst[_h][_i] = S.row_off(un, _h * HALF + Rr[_i]) + (unsigned)Cc[_i] * 2u; } } while (0)
#define G8_STAGE_A(bufoff, gb, vo, h) do { if (GATHER) { G8_STAGE(bufoff, gb, vo[h]); } else { G8_STAGE(bufoff, (gb) + (h) * hstep, voffA); } } while (0)
    Unit cur, nxt; int ui = 0;
    if (!S.next(0, cur)) return;
    f32x4 acc[2][2][4][2];
#pragma unroll
    for (int a = 0; a < 2; ++a)
#pragma unroll
        for (int b = 0; b < 2; ++b)
#pragma unroll
            for (int m = 0; m < 4; ++m)
#pragma unroll
                for (int n = 0; n < 2; ++n) acc[a][b][m][n] = (f32x4){0.f, 0.f, 0.f, 0.f};
    bf16x8 At[4][2], B0[2][2], B1[2][2];
    unsigned cvA[2][2], nvA[2][2];
    G8_AOFF(cvA, cur);
    const char* cA = cur.A; const char* cB = cur.B;
    G8_STAGE(G8_SB(0, 0), cB, voffB); G8_STAGE_A(G8_SA(0, 0), cA, cvA, 0); G8_STAGE(G8_SB(0, 1), cB + hstep, voffB); G8_STAGE_A(G8_SA(0, 1), cA, cvA, 1);
    if (wr == 1) G8_BAR;
    G8_WAIT_V(4); G8_BAR;
    G8_STAGE(G8_SB(1, 0), cB + kstep, voffB); G8_STAGE_A(G8_SA(1, 0), cA + kstep, cvA, 0); G8_STAGE(G8_SB(1, 1), cB + hstep + kstep, voffB);
    G8_WAIT_V(6); G8_BAR;
    for (;;) {
        const bool has_next = S.next(ui + 1, nxt);
        const char* nA = has_next ? nxt.A : cA; const char* nB = has_next ? nxt.B : cB;
        if (GATHER) {
            if (has_next) { G8_AOFF(nvA, nxt); } else {
#pragma unroll
                for (int h = 0; h < 2; ++h)
#pragma unroll
                    for (int i = 0; i < 2; ++i) nvA[h][i] = cvA[h][i];
            }
        }
        for (int t = 0; t < nt; t += 2) {
            const bool last = (t == nt - 2);
            const char* a1 = cA + (size_t)(t + 1) * kstep;
            const char* a2 = last ? nA : cA + (size_t)(t + 2) * kstep; const char* b2 = last ? nB : cB + (size_t)(t + 2) * kstep;
            const char* a3 = a2 + kstep; const char* b3 = b2 + kstep;

            G8_LDB(B0, 0, 0); G8_SCHED; G8_LDA(At, 0, 0); G8_STAGE_A(G8_SA(1, 1), a1, cvA, 1);
            if (GATHER && last) {
#pragma unroll
                for (int h = 0; h < 2; ++h)
#pragma unroll
                    for (int i = 0; i < 2; ++i) cvA[h][i] = nvA[h][i];
            }
            G8_WAIT_L(8); G8_BAR; G8_WAIT_L(0); G8_MMA(0, 0, At, B0); G8_BAR; G8_SCHED;
            G8_LDB(B1, 0, 1); G8_STAGE(G8_SB(0, 0), b2, voffB);
            G8_BAR; G8_WAIT_L(0); G8_MMA(0, 1, At, B1); G8_BAR;
            G8_LDA(At, 0, 1); G8_STAGE_A(G8_SA(0, 0), a2, cvA, 0);
            G8_BAR; G8_WAIT_L(0); G8_MMA(1, 0, At, B0); G8_BAR; G8_SCHED;
            G8_STAGE(G8_SB(0, 1), b2 + hstep, voffB);
            G8_WAIT_V(6); G8_BAR; G8_MMA(1, 1, At, B1); G8_BAR;
            G8_LDB(B0, 1, 0); G8_SCHED; G8_LDA(At, 1, 0); G8_STAGE_A(G8_SA(0, 1), a2, cvA, 1);
            G8_WAIT_L(8); G8_BAR; G8_WAIT_L(0); G8_MMA(0, 0, At, B0); G8_BAR; G8_SCHED;
            G8_LDB(B1, 1, 1); G8_STAGE(G8_SB(1, 0), b3, voffB);
            G8_BAR; G8_WAIT_L(0); G8_MMA(0, 1, At, B1); G8_BAR;
            G8_LDA(At, 1, 1); G8_STAGE_A(G8_SA(1, 0), a3, cvA, 0);
            G8_BAR; G8_WAIT_L(0); G8_MMA(1, 0, At, B0); G8_BAR; G8_SCHED;
            G8_STAGE(G8_SB(1, 1), b3 + hstep, voffB);
            G8_WAIT_V(6); G8_BAR; G8_MMA(1, 1, At, B1); G8_BAR;
        }
        { int fr2 = fr, fq2 = fq; asm volatile("" : "+v"(fr2), "+v"(fq2)); E(acc, cur, wr, wc, fr2, fq2); }
        if (!has_next) break;
#pragma unroll
        for (int a = 0; a < 2; ++a)
#pragma unroll
            for (int b = 0; b < 2; ++b)
#pragma unroll
                for (int m = 0; m < 4; ++m)
#pragma unroll
                    for (int n = 0; n < 2; ++n) acc[a][b][m][n] = (f32x4){0.f, 0.f, 0.f, 0.f};
        cur = nxt; cA = nA; cB = nB; ++ui;
    }
    G8_WAIT_V(0);
    if (wr == 0) G8_BAR;
    G8_BAR;
#undef G8_SA
#undef G8_SB
#undef G8_STAGE
#undef G8_LDA
#undef G8_LDB
#undef G8_MMA
#undef G8_WAIT_V
#undef G8_WAIT_L
#undef G8_BAR
#undef G8_SCHED
#undef G8_AOFF
#undef G8_STAGE_A
}
}

constexpr int MFULL = 64, M0_LEFT = MFULL * 256;
struct EpiStore {
    static constexpr bool PERM = true;
    bf16_t* O; int ldc; bool sig;
    DI void operator()(const f32x4 (&acc)[2][2][4][2], const g8::Unit& u, int wr, int wc, int fr, int fq) const {
#pragma unroll
        for (int ai = 0; ai < 2; ++ai)
#pragma unroll
            for (int m = 0; m < 4; ++m) {
                bf16_t* rowp = O + (size_t)(u.pm * 256 + ai * 128 + wr * 64 + m * 16 + fr) * ldc + u.pn * 256 + wc * 32 + 8 * fq;
#pragma unroll
                for (int bj = 0; bj < 2; ++bj) {
                    f32x4 v0 = acc[ai][bj][m][0], v1 = acc[ai][bj][m][1];
                    if (sig) {
#pragma unroll
                        for (int e = 0; e < 4; ++e) { v0[e] = sigmoidf_(v0[e]); v1[e] = sigmoidf_(v1[e]); }
                    }
                    *(u32x4*)(rowp + bj * 128) = (u32x4){pack2(v0[0], v0[1]), pack2(v0[2], v0[3]), pack2(v1[0], v1[1]), pack2(v1[2], v1[3])};
                }
            }
    }
};
DI int left_first(int units, int bid, int nb) { return (bid - units % nb + nb) % nb; }

DI void phase_inproj(const Params& p, int layer, int bid, int nb, char* smem) {
    const bf16_t* hb = p.hb; bf16_t* P = p.P;
    const bf16_t* Bt = p.WtIn + (size_t)layer * CIN * D;
    g8::DenseOrder S; S.init(hb, Bt, MFULL, CP / 256, D, nb, bid);
    g8::gemm8<false>((G8_LAS unsigned char*)smem, D, S, EpiStore{P, CP, false});
    for (int t = left_first(MFULL * (CP / 256), bid, nb); t < CP / 128; t += nb)
        gemm_tile128([=](int r) { return r < T ? hb + (size_t)r * D : (const bf16_t*)nullptr; }, Bt, D, D, M0_LEFT, t * 128, smem,
                     [=](int r, int c, f32x4 v) { if (r < T) *(u32x2*)(P + (size_t)r * CP + c) = (u32x2){pack2(v[0], v[1]), pack2(v[2], v[3])}; });
}

constexpr int NCHUNK = (L + 63) / 64, NUNIT = NBATCH * HEADS * NCHUNK;
constexpr int LS = 72, RB = 64 * LS * 2;
constexpr int R1_LDS = 16 * RB + 4096;
#define RBUF(i) ((bf16_t*)(smem + (i) * RB))
typedef float f32x16 __attribute__((ext_vector_type(16)));

template <int KK> DI f32x4 mm16(const bf16_t* F, int ldf, const bf16_t* S, int lds_, f32x4 acc, int lane) {
    const int fr = lane & 15, fq = lane >> 4;
#pragma unroll
    for (int ks = 0; ks < KK / 32; ++ks) {
        const bf16x8 f = *(const bf16x8*)(F + fr * ldf + ks * 32 + fq * 8);
        const bf16x8 g = *(const bf16x8*)(S + fr * lds_ + ks * 32 + fq * 8);
        acc = __builtin_amdgcn_mfma_f32_16x16x32_bf16(f, g, acc, 0, 0, 0);
    }
    return acc;
}
DI u32x2 pk4(f32x4 v) { return (u32x2){pack2(v[0], v[1]), pack2(v[2], v[3])}; }
DI f32x4 up4(u32x2 v) { return (f32x4){lo_bf(v[0]), hi_bf(v[0]), lo_bf(v[1]), hi_bf(v[1])}; }

template <int MODE> DI void phase_rwkv_r1(const Params& p, int layer, int bid, int nb, char* smem) {
    const int wv = __builtin_amdgcn_readfirstlane(tid_() >> 6);
    const f32x4 zero = (f32x4){0.f, 0.f, 0.f, 0.f};
    float* lwT = (float*)RBUF(4);
    float* aT = (float*)RBUF(6);
    float* gt = (float*)(smem + 16 * RB);
    float* gammaC = gt + 512;
    bf16_t* Xt0 = RBUF(14);
    bf16_t* Xt1 = RBUF(4);
    const bf16_t* WupT = p.WupT + (size_t)layer * 512 * 64, *AupT = p.AupT + (size_t)layer * 512 * 64, *GupT = p.GupT + (size_t)layer * 512 * 128;
    const float* mu = p.mu + (size_t)layer * RSW;
    for (int it = 0;; ++it) {
        const int tid = tid_(), lane = tid & 63, fr = lane & 15, fq = lane >> 4;
        int c, bh;
        if (MODE == 0) {
            const int Lq = it * nb + bid, q = Lq >> 3, cb = (q >> 3) * 8 + (Lq & 7);
            if (cb >= NBATCH * (NCHUNK - 1)) break;
            c = cb % (NCHUNK - 1); bh = (cb / (NCHUNK - 1)) * HEADS + (q & 7);
        } else {
            if (it > 0) break;
            c = NCHUNK - 1; bh = bid;
        }
        const int u = bh * NCHUNK + c, h = bh % HEADS, bb = bh / HEADS;
        const size_t tok0 = (size_t)bb * L + c * 64;
        bf16x8 fw[2][2], fa[2][2], fg[2][4];
#pragma unroll
        for (int t2 = 0; t2 < 2; ++t2) {
            const int tl = wv * 2 + t2, pt = tl >> 2, qt = tl & 3;
#pragma unroll
            for (int ks = 0; ks < 2; ++ks) {
                fw[t2][ks] = *(const bf16x8*)(WupT + (size_t)(h * 64 + qt * 16 + fr) * 64 + ks * 32 + fq * 8);
                fa[t2][ks] = *(const bf16x8*)(AupT + (size_t)(h * 64 + pt * 16 + fr) * 64 + ks * 32 + fq * 8);
            }
        }
        __syncthreads();
#pragma unroll
        for (int it = 0; it < 7; ++it) {
            const int cid = tid + NTHR * it, i = cid / 56, cc = cid % 56;
            int col; bf16_t* dst;
            if (cc < 8) { col = RW_R + h * 64 + cc * 8; dst = RBUF(8) + i * LS + cc * 8; }
            else if (cc < 16) { col = RW_K + h * 64 + (cc - 8) * 8; dst = RBUF(9) + i * LS + (cc - 8) * 8; }
            else if (cc < 24) { col = RW_V + h * 64 + (cc - 16) * 8; dst = RBUF(10) + i * LS + (cc - 16) * 8; }
            else if (cc < 32) { col = RW_WD + (cc - 24) * 8; dst = RBUF(0) + i * LS + (cc - 24) * 8; }
            else if (cc < 40) { col = RW_AD + (cc - 32) * 8; dst = RBUF(1) + i * LS + (cc - 32) * 8; }
            else { col = RW_GD + (cc - 40) * 8; dst = RBUF(2) + i * 136 + (cc - 40) * 8; }
            const int t = c * 64 + i;
            u32x4 cur = (u32x4){0u, 0u, 0u, 0u}, prv = (u32x4){0u, 0u, 0u, 0u};
            if (t < L) cur = *(const u32x4*)(p.P + (tok0 + i) * CP + OFF_RW + col);
            if (t < L && t > 0) prv = *(const u32x4*)(p.P + (tok0 + i - 1) * CP + OFF_RW + col);
            const f32x4 m0 = *(const f32x4*)(mu + col), m1 = *(const f32x4*)(mu + col + 4);
            float x[8];
#pragma unroll
            for (int j = 0; j < 4; ++j) {
                const float c0 = lo_bf(cur[j]), c1 = hi_bf(cur[j]), p0 = lo_bf(prv[j]), p1 = hi_bf(prv[j]);
                const float mm0 = j < 2 ? m0[2 * j] : m1[2 * j - 4], mm1 = j < 2 ? m0[2 * j + 1] : m1[2 * j - 3];
                x[2 * j] = c0 + (p0 - c0) * mm0; x[2 * j + 1] = c1 + (p1 - c1) * mm1;
            }
            if (cc >= 24 && cc < 32) {
#pragma unroll
                for (int j = 0; j < 8; ++j) x[j] = tanhf(x[j]);
            } else if (cc >= 40) {
#pragma unroll
                for (int j = 0; j < 8; ++j) x[j] = sigmoidf_(x[j]);
            }
            *(u32x4*)dst = (u32x4){pack2(x[0], x[1]), pack2(x[2], x[3]), pack2(x[4], x[5]), pack2(x[6], x[7])};
        }
#pragma unroll
        for (int t2 = 0; t2 < 2; ++t2)
#pragma unroll
            for (int ks = 0; ks < 4; ++ks) fg[t2][ks] = *(const bf16x8*)(GupT + (size_t)(h * 64 + ((wv * 2 + t2) >> 2) * 16 + fr) * 128 + ks * 32 + fq * 8);
        __syncthreads();
#pragma unroll
        for (int t2 = 0; t2 < 2; ++t2) {
            const int tl = wv * 2 + t2, pt = tl >> 2, qt = tl & 3;
            f32x4 aw = zero, aa = zero, ag = zero;
#pragma unroll
            for (int ks = 0; ks < 2; ++ks) {
                const bf16x8 xw = *(const bf16x8*)(RBUF(0) + (pt * 16 + fr) * LS + ks * 32 + fq * 8);
                aw = __builtin_amdgcn_mfma_f32_16x16x32_bf16(xw, fw[t2][ks], aw, 0, 0, 0);
                const bf16x8 xa = *(const bf16x8*)(RBUF(1) + (qt * 16 + fr) * LS + ks * 32 + fq * 8);
                aa = __builtin_amdgcn_mfma_f32_16x16x32_bf16(fa[t2][ks], xa, aa, 0, 0, 0);
            }
#pragma unroll
            for (int ks = 0; ks < 4; ++ks) {
                const bf16x8 xg = *(const bf16x8*)(RBUF(2) + (qt * 16 + fr) * 136 + ks * 32 + fq * 8);
                ag = __builtin_amdgcn_mfma_f32_16x16x32_bf16(fg[t2][ks], xg, ag, 0, 0, 0);
            }
            const int ch = qt * 16 + fr;
            const float w0 = p.w0[layer * 512 + h * 64 + ch];
            const f32x4 a0 = *(const f32x4*)(p.a0 + layer * 512 + h * 64 + pt * 16 + fq * 4);
            f32x4 lw, av;
#pragma unroll
            for (int e = 0; e < 4; ++e) { lw[e] = -DECAY_SCALE * sigmoidf_(w0 + aw[e]); av[e] = sigmoidf_(a0[e] + aa[e]); }
            *(f32x4*)(lwT + ch * 68 + pt * 16 + fq * 4) = lw;
            *(f32x4*)(aT + (qt * 16 + fr) * 68 + pt * 16 + fq * 4) = av;
            *(u32x2*)(p.GG + ((size_t)u * 64 + qt * 16 + fr) * 64 + pt * 16 + fq * 4) = pk4(ag);
        }
        __syncthreads();
        {
            const int i = tid >> 3, c8 = (tid & 7) * 8, cg = layer * 512 + h * 64 + c8;
            const u32x4 xr = *(const u32x4*)(RBUF(8) + i * LS + c8), xk = *(const u32x4*)(RBUF(9) + i * LS + c8);
            const f32x4 a0 = *(const f32x4*)(aT + i * 68 + c8), a1 = *(const f32x4*)(aT + i * 68 + c8 + 4);
            const f32x4 kk0 = *(const f32x4*)(p.k_k + cg), kk1 = *(const f32x4*)(p.k_k + cg + 4), ka0 = *(const f32x4*)(p.k_a + cg), ka1 = *(const f32x4*)(p.k_a + cg + 4);
            const f32x4 rk0 = *(const f32x4*)(p.r_k + cg), rk1 = *(const f32x4*)(p.r_k + cg + 4);
            float n2 = 0.f, bon = 0.f;
#pragma unroll
            for (int j = 0; j < 8; ++j) {
                const float r_ = (j & 1) ? hi_bf(xr[j >> 1]) : lo_bf(xr[j >> 1]), k_ = (j & 1) ? hi_bf(xk[j >> 1]) : lo_bf(xk[j >> 1]);
                const float a_ = j < 4 ? a0[j & 3] : a1[j & 3], kkc = j < 4 ? kk0[j & 3] : kk1[j & 3], kac = j < 4 ? ka0[j & 3] : ka1[j & 3], rkc = j < 4 ? rk0[j & 3] : rk1[j & 3];
                const float kkr = k_ * kkc;
                n2 += kkr * kkr;
                bon += r_ * (k_ * (1.0f + (a_ - 1.0f) * kac)) * rkc;
            }
            n2 = sum8(n2); bon = sum8(bon);
            if ((tid & 7) == 0) { gt[576 + i] = 1.0f / fmaxf(sqrtf(n2), 1e-12f); p.bonG[(size_t)u * 64 + i] = bon; }
        }
        __syncthreads();
        {
            const int ch = lane, cg = layer * 512 + h * 64 + ch;
            float lw[8], av[8], cum[8];
            {
                const f32x4 l0 = *(const f32x4*)(lwT + ch * 68 + wv * 8), l1 = *(const f32x4*)(lwT + ch * 68 + wv * 8 + 4);
#pragma unroll
                for (int e = 0; e < 4; ++e) { lw[e] = l0[e]; lw[e + 4] = l1[e]; }
#pragma unroll
                for (int e = 0; e < 8; ++e) av[e] = aT[(wv * 8 + e) * 68 + ch];
            }
            float run = 0.f;
#pragma unroll
            for (int e = 0; e < 8; ++e) { run += lw[e]; cum[e] = run; }
            gt[wv * 64 + ch] = run;
            __syncthreads();
            float offs = 0.f, tot = 0.f;
#pragma unroll
            for (int g2 = 0; g2 < 8; ++g2) { const float gv = gt[g2 * 64 + ch]; offs += g2 < wv ? gv : 0.f; tot += gv; }
            if (wv == 0) gammaC[ch] = __expf(tot);
            const float kkc = p.k_k[cg], kac = p.k_a[cg];
            float at_[8], kt_[8], bt_[8], vt_[8];
#pragma unroll
            for (int e = 0; e < 8; ++e) {
                const int i = wv * 8 + e;
                const float xr = bf2f(RBUF(8)[i * LS + ch]), xk = bf2f(RBUF(9)[i * LS + ch]), xv = bf2f(RBUF(10)[i * LS + ch]);
                const float cm = cum[e] + offs;
                const float kk = xk * kkc * gt[576 + i];
                const float kq = xk * (1.0f + (av[e] - 1.0f) * kac);
                if (c * 64 + i < L) p.orw[(tok0 + i) * 512 + h * 64 + ch] = RBUF(10)[i * LS + ch];
                const float eneg = __expf(-cm), epos = __expf(cm), eexc = __expf(cm - lw[e]);
                at_[e] = -kk * eexc; kt_[e] = kq * eneg; bt_[e] = kk * av[e] * eneg; vt_[e] = xv;
                RBUF(3)[i * LS + ch] = f2bf(xr * epos);
            }
            __syncthreads();
#pragma unroll
            for (int e = 0; e < 8; ++e) {
                const int i = wv * 8 + e;
                RBUF(0)[i * LS + ch] = f2bf(at_[e]); RBUF(1)[i * LS + ch] = f2bf(kt_[e]); RBUF(2)[i * LS + ch] = f2bf(bt_[e]);
            }
            *(u32x4*)(RBUF(11) + ch * LS + wv * 8) = (u32x4){pack2(kt_[0], kt_[1]), pack2(kt_[2], kt_[3]), pack2(kt_[4], kt_[5]), pack2(kt_[6], kt_[7])};
            *(u32x4*)(RBUF(12) + ch * LS + wv * 8) = (u32x4){pack2(bt_[0], bt_[1]), pack2(bt_[2], bt_[3]), pack2(bt_[4], bt_[5]), pack2(bt_[6], bt_[7])};
            *(u32x4*)(RBUF(13) + ch * LS + wv * 8) = (u32x4){pack2(vt_[0], vt_[1]), pack2(vt_[2], vt_[3]), pack2(vt_[4], vt_[5]), pack2(vt_[6], vt_[7])};
            *(u32x4*)(Xt0 + ch * LS + wv * 8) = (u32x4){pack2(at_[0], at_[1]), pack2(at_[2], at_[3]), pack2(at_[4], at_[5]), pack2(at_[6], at_[7])};
        }
        __syncthreads();
#pragma unroll
        for (int prod = 0; prod < 5; ++prod) {
            const bf16_t* F = prod == 0 ? RBUF(1) : prod == 1 ? RBUF(2) : prod == 2 ? RBUF(0) : prod == 3 ? RBUF(1) : RBUF(2);
            const bf16_t* S = prod == 0 ? RBUF(0) : prod == 1 ? RBUF(0) : prod == 2 ? RBUF(2) : RBUF(3);
            bf16_t* O = prod == 0 ? RBUF(6) : prod == 1 ? RBUF(7) : prod == 2 ? RBUF(8) : prod == 3 ? RBUF(9) : RBUF(10);
            const int mode = prod < 2 ? 0 : prod == 2 ? 2 : 1;
#pragma unroll
            for (int rep = 0; rep < 2; ++rep) {
                const int tl = wv + 8 * rep, pt = tl >> 2, qt = tl & 3;
                f32x4 acc = mm16<64>(F + pt * 16 * LS, LS, S + qt * 16 * LS, LS, zero, lane);
                const int qi = qt * 16 + fr;
#pragma unroll
                for (int e = 0; e < 4; ++e) {
                    const int pi = pt * 16 + fq * 4 + e;
                    const bool keep = mode == 0 ? pi < qi : (mode == 1 ? pi <= qi : qi < pi);
                    acc[e] = keep ? acc[e] : 0.f;
                }
                *(u32x2*)(O + qi * LS + pt * 16 + fq * 4) = pk4(acc);
            }
        }
        __syncthreads();
        f32x4 X[4];
        if (wv < 4) {
#pragma unroll
            for (int pt = 0; pt < 4; ++pt) X[pt] = up4(*(const u32x2*)(Xt0 + (wv * 16 + fr) * LS + pt * 16 + fq * 4));
        } else {
#pragma unroll
            for (int pt = 0; pt < 4; ++pt) {
                X[pt] = mm16<64>(RBUF(6) + pt * 16 * LS, LS, RBUF(13) + (wv - 4) * 16 * LS, LS, zero, lane);
                *(u32x2*)(Xt0 + (wv * 16 + fr) * LS + pt * 16 + fq * 4) = pk4(X[pt]);
            }
        }
        __syncthreads();
#pragma unroll
        for (int k = 0; k < 6; ++k) {
            const bf16_t* Mk = (k & 1) ? RBUF(0) : RBUF(7);
            const bf16_t* Mkt = (k & 1) ? RBUF(6) : RBUF(8);
            bf16_t* Mn = (k & 1) ? RBUF(7) : RBUF(0);
            bf16_t* Mnt = (k & 1) ? RBUF(8) : RBUF(6);
            const bf16_t* Xc = (k & 1) ? Xt1 : Xt0;
            bf16_t* Xn = (k & 1) ? Xt0 : Xt1;
#pragma unroll
            for (int pt = 0; pt < 4; ++pt) {
                X[pt] = mm16<64>(Mk + pt * 16 * LS, LS, Xc + wv * 16 * LS, LS, X[pt], lane);
                *(u32x2*)(Xn + (wv * 16 + fr) * LS + pt * 16 + fq * 4) = pk4(X[pt]);
            }
            if (k < 5) {
#pragma unroll
                for (int which = 0; which < 2; ++which) {
                    const bf16_t* F = which ? Mk : Mkt; const bf16_t* S = which ? Mkt : Mk; bf16_t* O = which ? Mnt : Mn;
#pragma unroll
                    for (int rep = 0; rep < 2; ++rep) {
                        const int t2 = wv + 8 * rep, pt = t2 >> 2, qt = t2 & 3;
                        const f32x4 acc = mm16<64>(F + pt * 16 * LS, LS, S + qt * 16 * LS, LS, zero, lane);
                        *(u32x2*)(O + (qt * 16 + fr) * LS + pt * 16 + fq * 4) = pk4(acc);
                    }
                }
            }
            __syncthreads();
        }
#pragma unroll
        for (int rep = 0; rep < 2; ++rep) {
            const int tl = wv + 8 * rep, pt = tl >> 2, qt = tl & 3;
            const int pi0 = pt * 16 + fq * 4, qi = qt * 16 + fr;
            const size_t go = ((size_t)u * 64 + qi) * 64 + pi0;
            {
                f32x4 acc = mm16<64>(Xt0 + pt * 16 * LS, LS, RBUF(12) + qt * 16 * LS, LS, zero, lane);
                const float gc = gammaC[qi];
#pragma unroll
                for (int e = 0; e < 4; ++e) acc[e] = (acc[e] + (pi0 + e == qi ? 1.f : 0.f)) * gc;
                {
                    const size_t d = (((size_t)u * 8 + (qi >> 5) * 4 + (pi0 >> 4)) * 64 + (qi & 31) + 32 * ((pi0 >> 2) & 1)) * 8 + ((pi0 >> 3) & 1) * 4;
                    *(u32x2*)(p.PcG + d) = pk4(acc);
                }
            }
            {
                f32x4 acc = mm16<64>(RBUF(11) + pt * 16 * LS, LS, RBUF(13) + qt * 16 * LS, LS, zero, lane);
                acc = mm16<64>(RBUF(12) + pt * 16 * LS, LS, Xt0 + (64 + qt * 16) * LS, LS, acc, lane);
                const f32x4 gc = *(const f32x4*)(gammaC + pi0);
#pragma unroll
                for (int e = 0; e < 4; ++e) acc[e] *= gc[e];
                {
                    const int kk = pi0 & 31;
                    const size_t d = (((size_t)u * 4 + (qi >> 5) * 2 + (pi0 >> 5)) * 64 + (qi & 31) + 32 * ((kk >> 2) & 1)) * 16 + (kk >> 3) * 4;
                    *(u32x2*)(p.QcG + d) = pk4(acc);
                }
            }
            {
                f32x4 acc = mm16<64>(Xt0 + pt * 16 * LS, LS, RBUF(10) + qt * 16 * LS, LS, zero, lane);
                const f32x4 rr = up4(*(const u32x2*)(RBUF(3) + qi * LS + pi0));
#pragma unroll
                for (int e = 0; e < 4; ++e) acc[e] += rr[e];
                *(u32x2*)(p.RhG + go) = pk4(acc);
            }
            {
                f32x4 acc = mm16<64>(RBUF(13) + pt * 16 * LS, LS, RBUF(9) + qt * 16 * LS, LS, zero, lane);
                acc = mm16<64>(Xt0 + (64 + pt * 16) * LS, LS, RBUF(10) + qt * 16 * LS, LS, acc, lane);
                *(u32x2*)(p.Y0G + go) = pk4(acc);
            }
        }
    }
}

struct R2Set { u32x4 a[8]; u32x4 q[4]; };
DI void r2_load(R2Set& st, const Params& p, size_t u, int lane, int vh) {
#pragma unroll
    for (int kt = 0; kt < 2; ++kt) {
        const bf16_t* qg = p.QcG + ((u * 4 + vh * 2 + kt) * 64 + lane) * 16;
        st.q[kt * 2] = *(const u32x4*)qg; st.q[kt * 2 + 1] = *(const u32x4*)(qg + 8);
    }
#pragma unroll
    for (int f = 0; f < 8; ++f) st.a[f] = *(const u32x4*)(p.PcG + ((u * 8 + f) * 64 + lane) * 8);
}
DI void r2_step(f32x16 (&S)[2], const R2Set& st, const Params& p, size_t u, int lane, int vh, bool last) {
#pragma unroll
    for (int kt = 0; kt < 2; ++kt) {
        bf16_t* sg = p.SG + ((u * 4 + vh * 2 + kt) * 64 + lane) * 16;
        *(u32x4*)sg = (u32x4){pack2(S[kt][0], S[kt][1]), pack2(S[kt][2], S[kt][3]), pack2(S[kt][4], S[kt][5]), pack2(S[kt][6], S[kt][7])};
        *(u32x4*)(sg + 8) = (u32x4){pack2(S[kt][8], S[kt][9]), pack2(S[kt][10], S[kt][11]), pack2(S[kt][12], S[kt][13]), pack2(S[kt][14], S[kt][15])};
    }
    if (last) return;
    bf16x8 bfr[4];
#pragma unroll
    for (int ts = 0; ts < 4; ++ts) {
        const int tl = ts >> 1, sp = ts & 1;
        const u32x4 pk = (u32x4){pack2(S[tl][8 * sp], S[tl][8 * sp + 1]), pack2(S[tl][8 * sp + 2], S[tl][8 * sp + 3]),
                                 pack2(S[tl][8 * sp + 4], S[tl][8 * sp + 5]), pack2(S[tl][8 * sp + 6], S[tl][8 * sp + 7])};
        bfr[ts] = __builtin_bit_cast(bf16x8, pk);
    }
#pragma unroll
    for (int kt = 0; kt < 2; ++kt)
#pragma unroll
        for (int hf = 0; hf < 2; ++hf)
#pragma unroll
            for (int w = 0; w < 4; ++w) { S[kt][8 * hf + 2 * w] = lo_bf(st.q[kt * 2 + hf][w]); S[kt][8 * hf + 2 * w + 1] = hi_bf(st.q[kt * 2 + hf][w]); }
#pragma unroll
    for (int ts = 0; ts < 4; ++ts)
#pragma unroll
        for (int kt = 0; kt < 2; ++kt)
            S[kt] = __builtin_amdgcn_mfma_f32_32x32x16_bf16(__builtin_bit_cast(bf16x8, st.a[kt * 4 + ts]), bfr[ts], S[kt], 0, 0, 0);
}
DI void phase_rwkv_r2(const Params& p, int chain) {
    const int lane = tid_() & 63, wv = __builtin_amdgcn_readfirstlane(tid_() >> 6);
    if (wv != 0) return;
    const int bh = chain >> 1, vh = chain & 1;
    const size_t u0 = (size_t)bh * NCHUNK;
    f32x16 S[2];
#pragma unroll
    for (int e = 0; e < 16; ++e) { S[0][e] = 0.f; S[1][e] = 0.f; }
    R2Set A, B;
    r2_load(A, p, u0, lane, vh);
    r2_load(B, p, u0 + 1, lane, vh);
#pragma unroll 1
    for (int c = 0; c < NCHUNK; c += 2) {
        r2_step(S, A, p, u0 + c, lane, vh, c == NCHUNK - 1);
        if (c == NCHUNK - 1) break;
        if (c + 2 < NCHUNK - 1) r2_load(A, p, u0 + c + 2, lane, vh);
        r2_step(S, B, p, u0 + c + 1, lane, vh, false);
        if (c + 3 < NCHUNK - 1) r2_load(B, p, u0 + c + 3, lane, vh);
    }
}

DI void phase_rwkv_r3(const Params& p, int layer, int bid, int nb) {
    const int tid = tid_(), lane = tid & 63, wv = __builtin_amdgcn_readfirstlane(tid >> 6), fr = lane & 15, fq = lane >> 4;
    for (int task = bid * 8 + wv; task < NUNIT * 4; task += nb * 8) {
        const int u = task >> 2, it = task & 3;
        const int c = u % NCHUNK, bh = u / NCHUNK, h = bh % HEADS, bb = bh / HEADS;
        const int i = it * 16 + fr, t = c * 64 + i;
        const size_t tok = (size_t)bb * L + t;
        bf16x8 sf[2];
#pragma unroll
        for (int ks = 0; ks < 2; ++ks) sf[ks] = *(const bf16x8*)(p.RhG + ((size_t)u * 64 + i) * 64 + ks * 32 + fq * 8);
        f32x4 y[4];
#pragma unroll
        for (int vt = 0; vt < 4; ++vt) {
            y[vt] = up4(*(const u32x2*)(p.Y0G + ((size_t)u * 64 + i) * 64 + vt * 16 + fq * 4));
#pragma unroll
            for (int ks = 0; ks < 2; ++ks) {
                const int vv = vt * 16 + fr;
                const bf16_t* sp = p.SG + (((size_t)u * 4 + (vv >> 5) * 2 + ks) * 64 + (vv & 31)) * 16 + 4 * fq;
                const u32x2 s0 = *(const u32x2*)sp, s1 = *(const u32x2*)(sp + 32 * 16);
                const bf16x8 f = __builtin_bit_cast(bf16x8, ((u32x4){s0[0], s0[1], s1[0], s1[1]}));
                y[vt] = __builtin_amdgcn_mfma_f32_16x16x32_bf16(f, sf[ks], y[vt], 0, 0, 0);
            }
        }
        float s = 0.f;
#pragma unroll
        for (int vt = 0; vt < 4; ++vt) s += (y[vt][0] + y[vt][1]) + (y[vt][2] + y[vt][3]);
        s += __shfl_xor(s, 16); s += __shfl_xor(s, 32);
        const float mean = s * (1.0f / 64.f);
        float q = 0.f;
#pragma unroll
        for (int vt = 0; vt < 4; ++vt)
#pragma unroll
            for (int e = 0; e < 4; ++e) { y[vt][e] -= mean; q += y[vt][e] * y[vt][e]; }
        q += __shfl_xor(q, 16); q += __shfl_xor(q, 32);
        const float rstd = rsqrtf(q * (1.0f / 64.f) + 64e-5f);
        if (t < L) {
            const float bon = p.bonG[(size_t)u * 64 + i];
#pragma unroll
            for (int vt = 0; vt < 4; ++vt) {
                const int v0 = vt * 16 + fq * 4, cg = h * 64 + v0;
                const f32x4 xv = up4(*(const u32x2*)(p.orw + tok * 512 + cg));
                const f32x4 g = up4(*(const u32x2*)(p.GG + ((size_t)u * 64 + i) * 64 + v0));
                const f32x4 lg = *(const f32x4*)(p.lnx_g + layer * 512 + cg), lb = *(const f32x4*)(p.lnx_b + layer * 512 + cg);
                f32x4 o;
#pragma unroll
                for (int e = 0; e < 4; ++e) {
                    o[e] = (y[vt][e] * rstd * lg[e] + lb[e] + bon * xv[e]) * g[e];
                }
                *(u32x2*)(p.orw + tok * 512 + cg) = pk4(o);
            }
        }
    }
}

constexpr int SB_LDS = 2 * RB + 64;
DI void phase_sb(const Params& p, int bid0, int nb, char* smem) {
    const int tid = tid_(), lane = tid & 63, wv = __builtin_amdgcn_readfirstlane(tid >> 6), fr = lane & 15, fq = lane >> 4;
    bf16_t* Ks = (bf16_t*)smem;
    bf16_t* Vt = Ks + 64 * LS;
    int* flags = (int*)(smem + 2 * RB);
    bf16x8 tri[4][2];
#pragma unroll
    for (int st = 0; st < 4; ++st)
#pragma unroll
        for (int k2 = 0; k2 < 2; ++k2)
#pragma unroll
            for (int jj = 0; jj < 8; ++jj) tri[st][k2][jj] = (32 * k2 + 16 * (jj >> 2) + 4 * fq + (jj & 3) > 16 * st + fr) ? (short)0x3F80 : (short)0;
    constexpr int NQB = (L + 127) / 128;
    const int ldkey = tid >> 3, lddc = (tid & 7) * 8;
    for (int u = bid0; u < NBATCH * HEADS * NQB; u += nb) {
        const int bh = u % (NBATCH * HEADS), b = bh / HEADS, h = bh % HEADS, q0 = (u / (NBATCH * HEADS)) * 128;
        const int qlo = q0 + 16 * wv, query = qlo + fr;
        const size_t tokb = (size_t)b * L;
        bf16x8 qf[2];
#pragma unroll
        for (int ks = 0; ks < 2; ++ks) qf[ks] = *(const bf16x8*)(p.P + (tokb + query) * CP + OFF_Q + h * 64 + ks * 32 + fq * 8);
        const int qmax = (q0 + 127 < L - 1) ? q0 + 127 : L - 1;
        int kt = (qmax - 1) >> 6;
        float R = 0.f;
        f32x4 ot[4];
#pragma unroll
        for (int dt = 0; dt < 4; ++dt) ot[dt] = (f32x4){0.f, 0.f, 0.f, 0.f};
        bool done = qlo >= L;
        u32x4 kreg, vreg;
        {
            const int s = kt * 64 + ldkey;
            const bf16_t* src = p.P + (tokb + s) * CP + h * 64 + lddc;
            kreg = s < L ? *(const u32x4*)(src + OFF_K) : (u32x4){0u, 0u, 0u, 0u};
            vreg = s < L ? *(const u32x4*)(src + OFF_V) : (u32x4){0u, 0u, 0u, 0u};
        }
        for (;;) {
            __syncthreads();
            *(u32x4*)(Ks + ldkey * LS + lddc) = kreg;
#pragma unroll
            for (int j = 0; j < 4; ++j) { Vt[(lddc + 2 * j) * LS + ldkey] = (bf16_t)(vreg[j] & 0xFFFFu); Vt[(lddc + 2 * j + 1) * LS + ldkey] = (bf16_t)(vreg[j] >> 16); }
            __syncthreads();
            if (kt > 0) {
                const int s = (kt - 1) * 64 + ldkey;
                const bf16_t* src = p.P + (tokb + s) * CP + h * 64 + lddc;
                kreg = *(const u32x4*)(src + OFF_K); vreg = *(const u32x4*)(src + OFF_V);
            }
            if (!done && kt * 64 < qlo + 15) {
                f32x4 uu[4], lsp[4];
                float tot = 0.f;
#pragma unroll
                for (int kk = 0; kk < 4; ++kk) {
                    f32x4 z = (f32x4){0.f, 0.f, 0.f, 0.f};
#pragma unroll
                    for (int ks = 0; ks < 2; ++ks) {
                        const bf16x8 f = *(const bf16x8*)(Ks + (16 * kk + fr) * LS + ks * 32 + fq * 8);
                        z = __builtin_amdgcn_mfma_f32_16x16x32_bf16(f, qf[ks], z, 0, 0, 0);
                    }
#pragma unroll
                    for (int e = 0; e < 4; ++e) {
                        const float zz = z[e] * 0.125f;
                        const float lsneg = -(fmaxf(zz, 0.f) + __logf(1.0f + __expf(-fabsf(zz))));
                        const bool valid = kt * 64 + 16 * kk + 4 * fq + e < query;
                        uu[kk][e] = valid ? lsneg : 0.f;
                        lsp[kk][e] = valid ? lsneg + zz : -1.0e30f;
                        tot += uu[kk][e];
                    }
                }
                tot += __shfl_xor(tot, 16); tot += __shfl_xor(tot, 32);
                f32x4 rest[4];
#pragma unroll
                for (int st = 0; st < 4; ++st) rest[st] = (f32x4){0.f, 0.f, 0.f, 0.f};
#pragma unroll
                for (int k2 = 0; k2 < 2; ++k2) {
                    u32x4 hi, lo;
#pragma unroll
                    for (int t2 = 0; t2 < 2; ++t2) {
                        const f32x4 a = uu[2 * k2 + t2];
                        const unsigned h0 = pack2(a[0], a[1]), h1 = pack2(a[2], a[3]);
                        hi[2 * t2] = h0; hi[2 * t2 + 1] = h1;
                        lo[2 * t2] = pack2(a[0] - lo_bf(h0), a[1] - hi_bf(h0)); lo[2 * t2 + 1] = pack2(a[2] - lo_bf(h1), a[3] - hi_bf(h1));
                    }
                    const bf16x8 fh = __builtin_bit_cast(bf16x8, hi), fl = __builtin_bit_cast(bf16x8, lo);
#pragma unroll
                    for (int st = 0; st < 4; ++st) {
                        rest[st] = __builtin_amdgcn_mfma_f32_16x16x32_bf16(tri[st][k2], fh, rest[st], 0, 0, 0);
                        rest[st] = __builtin_amdgcn_mfma_f32_16x16x32_bf16(tri[st][k2], fl, rest[st], 0, 0, 0);
                    }
                }
                bf16x8 af[2];
#pragma unroll
                for (int k2 = 0; k2 < 2; ++k2) {
                    u32x4 pk;
#pragma unroll
                    for (int t2 = 0; t2 < 2; ++t2) {
                        const int kk = 2 * k2 + t2;
                        float a4[4];
#pragma unroll
                        for (int e = 0; e < 4; ++e) a4[e] = __expf(lsp[kk][e] + R + rest[kk][e]);
                        pk[2 * t2] = pack2(a4[0], a4[1]); pk[2 * t2 + 1] = pack2(a4[2], a4[3]);
                    }
                    af[k2] = __builtin_bit_cast(bf16x8, pk);
                }
                R += tot;
#pragma unroll
                for (int dt = 0; dt < 4; ++dt)
#pragma unroll
                    for (int k2 = 0; k2 < 2; ++k2) {
                        const bf16_t* vp = Vt + (16 * dt + fr) * LS + 32 * k2 + 4 * fq;
                        const u32x2 v0 = *(const u32x2*)vp, v1 = *(const u32x2*)(vp + 16);
                        const bf16x8 f = __builtin_bit_cast(bf16x8, ((u32x4){v0[0], v0[1], v1[0], v1[1]}));
                        ot[dt] = __builtin_amdgcn_mfma_f32_16x16x32_bf16(f, af[k2], ot[dt], 0, 0, 0);
                    }
                done = __all((R < -104.0f) || (query >= L));
            }
            if (lane == 0) flags[wv] = done ? 1 : 0;
            __syncthreads();
            int alld = 1;
#pragma unroll
            for (int w = 0; w < 8; ++w) alld &= flags[w];
            if (alld || kt == 0) break;
            --kt;
        }
        if (query < L) {
#pragma unroll
            for (int dt = 0; dt < 4; ++dt) *(u32x2*)(p.osb + (tokb + query) * 512 + h * 64 + 16 * dt + 4 * fq) = pk4(ot[dt]);
        }
    }
}

struct EpiBranch {
    static constexpr bool PERM = true;
    const bf16_t* G; bf16_t* M; bool add;
    DI void operator()(const f32x4 (&acc)[2][2][4][2], const g8::Unit& u, int wr, int wc, int fr, int fq) const {
#pragma unroll
        for (int ai = 0; ai < 2; ++ai)
#pragma unroll
            for (int m = 0; m < 4; ++m) {
                const size_t r = (size_t)(u.pm * 256 + ai * 128 + wr * 64 + m * 16 + fr);
                const int c0 = u.pn * 256 + wc * 32 + 8 * fq;
#pragma unroll
                for (int bj = 0; bj < 2; ++bj) {
                    const u32x4 g = *(const u32x4*)(G + r * 2048 + c0 + bj * 128);
                    u32x4* mp = (u32x4*)(M + r * D + c0 + bj * 128);
                    const f32x4 v0 = acc[ai][bj][m][0], v1 = acc[ai][bj][m][1];
                    float o[8] = {lo_bf(g[0]) * v0[0], hi_bf(g[0]) * v0[1], lo_bf(g[1]) * v0[2], hi_bf(g[1]) * v0[3], lo_bf(g[2]) * v1[0], hi_bf(g[2]) * v1[1], lo_bf(g[3]) * v1[2], hi_bf(g[3]) * v1[3]};
                    if (add) {
                        const u32x4 mo = *mp;
#pragma unroll
                        for (int q = 0; q < 4; ++q) { o[2 * q] += lo_bf(mo[q]); o[2 * q + 1] += hi_bf(mo[q]); }
                    }
                    *mp = (u32x4){pack2(o[0], o[1]), pack2(o[2], o[3]), pack2(o[4], o[5]), pack2(o[6], o[7])};
                }
            }
    }
};
struct GateOrder {
    g8::DenseOrder d;
    DI bool next(int i, g8::Unit& u) const { return d.next(i, u); }
    DI unsigned row_off(const g8::Unit&, int) const { return 0u; }
};
struct EpiGate {
    static constexpr bool PERM = true;
    bf16_t* G;
    DI void operator()(const f32x4 (&acc)[2][2][4][2], const g8::Unit& u, int wr, int wc, int fr, int fq) const {
#pragma unroll
        for (int ai = 0; ai < 2; ++ai)
#pragma unroll
            for (int m = 0; m < 4; ++m) {
                bf16_t* rowp = G + (size_t)(u.pm * 256 + ai * 128 + wr * 64 + m * 16 + fr) * 2048 + u.pn * 256 + wc * 32 + 8 * fq;
#pragma unroll
                for (int bj = 0; bj < 2; ++bj) {
                    const f32x4 v0 = acc[ai][bj][m][0], v1 = acc[ai][bj][m][1];
                    *(u32x4*)(rowp + bj * 128) = (u32x4){pack2(sigmoidf_(v0[0]), sigmoidf_(v0[1])), pack2(sigmoidf_(v0[2]), sigmoidf_(v0[3])), pack2(sigmoidf_(v1[0]), sigmoidf_(v1[1])), pack2(sigmoidf_(v1[2]), sigmoidf_(v1[3]))};
                }
            }
    }
};
template <int PART> DI void phase_merge(const Params& p, int layer, int bid, int nb, char* smem) {
    const bf16_t* hb = p.hb; bf16_t* G = p.gates; bf16_t* M = p.merged;
    const bf16_t* Wg = p.WtIn + ((size_t)layer * CIN + CP) * D;
    G8_LAS unsigned char* lds = (G8_LAS unsigned char*)smem;
    if (PART == 0) {
#pragma unroll
    for (int which = 0; which < 2; ++which) {
        g8::DenseOrder S; S.init(hb, Wg + (size_t)which * 1024 * D, MFULL, D / 256, D, nb, bid);
        g8::gemm8<false>(lds, D, S, EpiGate{G + which * 1024});
    }
    }
    if (PART == 1) {
#pragma unroll
    for (int which = 0; which < 2; ++which) {
        const bf16_t* A = which ? p.orw : p.osb;
        const bf16_t* Bt = (which ? p.WtPrw : p.WtPsb) + (size_t)layer * D * 512;
        g8::DenseOrder S; S.init(A, Bt, MFULL, D / 256, 512, nb, bid);
        g8::gemm8<false>(lds, 512, S, EpiBranch{G + which * 1024, M, which != 0});
    }
    }
    for (int t = left_first(MFULL * 4 * 2, bid, nb); t < D / 128; t += nb) {
        if (PART == 0)
#pragma unroll
        for (int which = 0; which < 2; ++which) {
            bf16_t* Gw = G + which * 1024;
            gemm_tile128([=](int r) { return r < T ? hb + (size_t)r * D : (const bf16_t*)nullptr; }, Wg + (size_t)which * 1024 * D, D, D, M0_LEFT, t * 128, smem,
                         [=](int r, int c, f32x4 v) { if (r < T) *(u32x2*)(Gw + (size_t)r * 2048 + c) = (u32x2){pack2(sigmoidf_(v[0]), sigmoidf_(v[1])), pack2(sigmoidf_(v[2]), sigmoidf_(v[3]))}; });
        }
        if (PART == 1)
#pragma unroll
        for (int which = 0; which < 2; ++which) {
            const bf16_t* A = which ? p.orw : p.osb; const bf16_t* Gw = G + which * 1024;
            const bf16_t* Bt = (which ? p.WtPrw : p.WtPsb) + (size_t)layer * D * 512;
            gemm_tile128([=](int r) { return r < T ? A + (size_t)r * 512 : (const bf16_t*)nullptr; }, Bt, 512, 512, M0_LEFT, t * 128, smem,
                         [=](int r, int c, f32x4 v) {
                             if (r >= T) return;
                             const u32x2 g = *(const u32x2*)(Gw + (size_t)r * 2048 + c);
                             float o0 = lo_bf(g[0]) * v[0], o1 = hi_bf(g[0]) * v[1], o2 = lo_bf(g[1]) * v[2], o3 = hi_bf(g[1]) * v[3];
                             u32x2* mp = (u32x2*)(M + (size_t)r * D + c);
                             if (which) { const u32x2 m = *mp; o0 += lo_bf(m[0]); o1 += hi_bf(m[0]); o2 += lo_bf(m[1]); o3 += hi_bf(m[1]); }
                             *mp = (u32x2){pack2(o0, o1), pack2(o2, o3)};
                         });
        }
    }
}
struct EpiOut {
    static constexpr bool PERM = false;
    float* hmeta; float* out;
    DI void operator()(const f32x4 (&acc)[2][2][4][2], const g8::Unit& u, int wr, int wc, int fr, int fq) const {
#pragma unroll
        for (int ai = 0; ai < 2; ++ai)
#pragma unroll
            for (int m = 0; m < 4; ++m) {
                float* rowp = hrow2(hmeta, out, u.pm * 256 + ai * 128 + wr * 64 + m * 16 + fr) + u.pn * 256 + wc * 32 + 4 * fq;
#pragma unroll
                for (int bj = 0; bj < 2; ++bj)
#pragma unroll
                    for (int n = 0; n < 2; ++n) {
                        f32x4* hp = (f32x4*)(rowp + bj * 128 + n * 16);
                        const f32x4 h = *hp, v = acc[ai][bj][m][n];
                        *hp = (f32x4){ALPHA * h[0] + v[0], ALPHA * h[1] + v[1], ALPHA * h[2] + v[2], ALPHA * h[3] + v[3]};
                    }
            }
    }
};
DI void phase_outproj(const Params& p, int layer, int bid, int nb, char* smem) {
    const bf16_t* A = p.merged; float* const hmeta = p.hmeta; float* const outp = p.out;
    const bf16_t* Bt = p.WtOut + (size_t)layer * D * D;
    if (bid == 0 && tid_() < NE) p.counts[tid_()] = 0;
    g8::DenseOrder S; S.init(A, Bt, MFULL, D / 256, D, nb, bid);
    g8::gemm8<false>((G8_LAS unsigned char*)smem, D, S, EpiOut{hmeta, outp});
    for (int t = left_first(MFULL * 4, bid, nb); t < D / 128; t += nb)
        gemm_tile128([=](int r) { return r < T ? A + (size_t)r * D : (const bf16_t*)nullptr; }, Bt, D, D, M0_LEFT, t * 128, smem,
                     [=](int r, int c, f32x4 v) {
                         if (r >= T) return;
                         f32x4* hp = (f32x4*)(hrow2(hmeta, outp, r) + c);
                         const f32x4 h = *hp;
                         *hp = (f32x4){ALPHA * h[0] + v[0], ALPHA * h[1] + v[1], ALPHA * h[2] + v[2], ALPHA * h[3] + v[3]};
                     });
}

constexpr int LN1_ROWB = 2 * D + 16;
constexpr int LN1_WAVE = 8 * LN1_ROWB;
constexpr int LN1_LDS = 8 * LN1_WAVE + 2048;
DI void phase_ln1_router(const Params& p, int layer, int bid, int nb, char* smem) {
    const int tid = tid_(), lane = tid & 63, wid = __builtin_amdgcn_readfirstlane(tid >> 6), fr = lane & 15, fq = lane >> 4;
    char* wl = smem + wid * LN1_WAVE;
    int* sel = (int*)(smem + 8 * LN1_WAVE);
    float* sgt = (float*)(smem + 8 * LN1_WAVE + 640);
    int* sbase = (int*)(smem + 8 * LN1_WAVE + 1280);
    const int nwaves = nb * 8, gw = bid * 8 + wid;
    const int base_n = T / nwaves, extra = T % nwaves;
    const int tok0 = gw * base_n + (gw < extra ? gw : extra), ntok = base_n + (gw < extra ? 1 : 0);
    const int btok0 = bid * 8 * base_n + (bid * 8 < extra ? bid * 8 : extra);
    const float* g1p = p.ln1_g + layer * D; const float* b1p = p.ln1_b + layer * D;
    __syncthreads();
    for (int g0 = 0; g0 < ntok; g0 += 4) {
        const int ng = ntok - g0 < 4 ? ntok - g0 : 4;
        float vn[16];
        { const float* hf = hrow_u(p, tok0 + g0);
#pragma unroll
          for (int j = 0; j < 4; ++j) { const f32x4 a = *(const f32x4*)(hf + 256 * j + 4 * lane); vn[4 * j] = a[0]; vn[4 * j + 1] = a[1]; vn[4 * j + 2] = a[2]; vn[4 * j + 3] = a[3]; } }
#pragma unroll 1
        for (int i = 0; i < ng; ++i) {
            const int tok = tok0 + g0 + i;
            float v[16];
#pragma unroll
            for (int q = 0; q < 16; ++q) v[q] = vn[q];
            if (i + 1 < ng) { const float* hn = hrow_u(p, tok + 1);
#pragma unroll
                for (int j = 0; j < 4; ++j) { const f32x4 a = *(const f32x4*)(hn + 256 * j + 4 * lane); vn[4 * j] = a[0]; vn[4 * j + 1] = a[1]; vn[4 * j + 2] = a[2]; vn[4 * j + 3] = a[3]; } }
            ln16(v, g1p, b1p, lane);
            float* hf = hrow_u(p, tok);
#pragma unroll
            for (int j = 0; j < 4; ++j) {
                *(f32x4*)(hf + 256 * j + 4 * lane) = (f32x4){v[4 * j], v[4 * j + 1], v[4 * j + 2], v[4 * j + 3]};
                const unsigned h0 = pack2(v[4 * j], v[4 * j + 1]), h1 = pack2(v[4 * j + 2], v[4 * j + 3]);
                *(u32x2*)(p.hb + (size_t)tok * D + 256 * j + 4 * lane) = (u32x2){h0, h1};
                *(u32x2*)(wl + i * LN1_ROWB + (256 * j + 4 * lane) * 2) = (u32x2){h0, h1};
                *(u32x2*)(wl + (4 + i) * LN1_ROWB + (256 * j + 4 * lane) * 2) = (u32x2){pack2(v[4 * j] - lo_bf(h0), v[4 * j + 1] - hi_bf(h0)), pack2(v[4 * j + 2] - lo_bf(h1), v[4 * j + 3] - hi_bf(h1))};
            }
        }
        asm volatile("s_waitcnt lgkmcnt(0)" ::: "memory");
        __builtin_amdgcn_wave_barrier();
        f32x4 acc = (f32x4){0.f, 0.f, 0.f, 0.f};
        const char* arow = wl + (fr & 3) * LN1_ROWB + fq * 16;
        const bf16_t* whi = p.RwHi + (size_t)fr * D + fq * 8; const bf16_t* wlo = p.RwLo + (size_t)fr * D + fq * 8;
#pragma unroll 4
        for (int ks = 0; ks < 32; ++ks) {
            const bf16x8 ah = *(const bf16x8*)(arow + ks * 64), al = *(const bf16x8*)(arow + 4 * LN1_ROWB + ks * 64);
            const bf16x8 bh = *(const bf16x8*)(whi + ks * 32), bl = *(const bf16x8*)(wlo + ks * 32);
            acc = __builtin_amdgcn_mfma_f32_16x16x32_bf16(bh, ah, acc, 0, 0, 0);
            acc = __builtin_amdgcn_mfma_f32_16x16x32_bf16(bh, al, acc, 0, 0, 0);
            acc = __builtin_amdgcn_mfma_f32_16x16x32_bf16(bl, ah, acc, 0, 0, 0);
        }
        float lg[4]; float mx = -3.0e38f;
#pragma unroll
        for (int e = 0; e < 4; ++e) { lg[e] = acc[e] + p.router_b[4 * fq + e]; mx = fmaxf(mx, lg[e]); }
        mx = fmaxf(mx, __shfl_xor(mx, 16)); mx = fmaxf(mx, __shfl_xor(mx, 32));
        float sum = 0.f;
#pragma unroll
        for (int e = 0; e < 4; ++e) { lg[e] = __expf(lg[e] - mx); sum += lg[e]; }
        sum += __shfl_xor(sum, 16); sum += __shfl_xor(sum, 32);
        const float inv = 1.0f / sum;
        float v1 = -1.f, v2 = -1.f; int i1 = 0, i2 = 0;
#pragma unroll
        for (int e = 0; e < 4; ++e) {
            const float pv = lg[e] * inv;
            if (pv > v1) { v2 = v1; i2 = i1; v1 = pv; i1 = e; } else if (pv > v2) { v2 = pv; i2 = e; }
        }
        const float sc = v1 + v2;
        float bsc = sc; int bg = fq;
#pragma unroll
        for (int m = 16; m <= 32; m <<= 1) {
            const float os = __shfl_xor(bsc, m); const int og = __shfl_xor(bg, m);
            if (os > bsc || (os == bsc && og < bg)) { bsc = os; bg = og; }
        }
        if (bg == fq && fr < ng) {
            const int li = tok0 + g0 + fr - btok0;
            const float gs = 1.0f / (v1 + v2);
            sel[li * 2] = 4 * fq + i1; sel[li * 2 + 1] = 4 * fq + i2; sgt[li * 2] = v1 * gs; sgt[li * 2 + 1] = v2 * gs;
        }
        asm volatile("s_waitcnt lgkmcnt(0)" ::: "memory");
        __builtin_amdgcn_wave_barrier();
    }
    __syncthreads();
    if (wid == 0) {
        const int nbt = 8 * base_n + ((bid * 8 + 8 <= extra) ? 8 : (bid * 8 < extra ? extra - bid * 8 : 0));
        for (int c0 = 0; c0 < nbt; c0 += 64) {
            const int li = c0 + lane; const bool on = li < nbt;
            const int e1 = on ? sel[li * 2] : -1, e2 = on ? sel[li * 2 + 1] : -1;
            const unsigned long long lt = (1ull << lane) - 1ull;
            int r1 = 0, r2 = 0, mycnt = 0;
#pragma unroll
            for (int e = 0; e < NE; ++e) {
                const unsigned long long m1 = __ballot(e1 == e), m2 = __ballot(e2 == e);
                const int c1 = __popcll(m1), c2 = __popcll(m2);
                if (e1 == e) r1 = __popcll(m1 & lt);
                if (e2 == e) r2 = c1 + __popcll(m2 & lt);
                if (lane == e) mycnt = c1 + c2;
            }
            if (lane < NE) sbase[lane] = mycnt > 0 ? atomicAdd(&p.counts[lane], mycnt) : 0;
            asm volatile("s_waitcnt vmcnt(0) lgkmcnt(0)" ::: "memory");
            __builtin_amdgcn_wave_barrier();
            if (on) {
                const int tok = btok0 + li;
                const int s1 = sbase[e1] + r1, s2 = sbase[e2] + r2;
                p.list[e1 * T + s1] = tok * 2; p.list[e2 * T + s2] = tok * 2 + 1;
                p.tokg[tok * 2] = sgt[li * 2]; p.tokg[tok * 2 + 1] = sgt[li * 2 + 1];
            }
            asm volatile("s_waitcnt lgkmcnt(0)" ::: "memory");
            __builtin_amdgcn_wave_barrier();
        }
    }
}

template <bool UP> struct MoeOrder {
    const int* counts; const int* list; int G, c; const char* A; const char* B;
    DI bool next(int i, g8::Unit& u) const {
        const int Lq = i * G + c, tm = Lq >> 2;
        int start = 0, fe = -1, fs = 0, fc = 0;
#pragma unroll
        for (int e = 0; e < NE; ++e) {
            const int cn = counts[e], nt = (cn + 255) >> 8;
            const bool hit = tm >= start && tm < start + nt;
            fe = hit ? e : fe; fs = hit ? (tm - start) * 256 : fs; fc = hit ? cn : fc;
            start += nt;
        }
        fe = __builtin_amdgcn_readfirstlane(fe); fs = __builtin_amdgcn_readfirstlane(fs); fc = __builtin_amdgcn_readfirstlane(fc);
        if (fe < 0) return false;
        u.e = fe; u.slot0 = fs; u.cnt = fc; u.pm = tm; u.pn = Lq & 3;
        u.A = UP ? A : A + (size_t)tm * ((size_t)256 * DE * 2);
        u.B = UP ? B + (size_t)fe * ((size_t)1024 * 1024 * 2) + (size_t)u.pn * ((size_t)256 * D * 2) : B + (size_t)fe * ((size_t)1024 * 512 * 2) + (size_t)u.pn * ((size_t)256 * DE * 2);
        return true;
    }
    DI unsigned row_off(const g8::Unit& u, int r) const {
        const __amdgpu_buffer_rsrc_t rs = __builtin_amdgcn_make_buffer_rsrc((void*)list, 0, NE * T * 4, 0x00020000);
        const int ent = __builtin_amdgcn_raw_buffer_load_b32(rs, r * 4, (u.e * T + u.slot0) * 4, 0);
        return u.slot0 + r < u.cnt ? (unsigned)(ent >> 1) * (unsigned)(D * 2) : 0u;
    }
};
struct EpiMoeUp {
    static constexpr bool PERM = true;
    bf16_t* hid;
    DI void operator()(const f32x4 (&acc)[2][2][4][2], const g8::Unit& u, int wr, int wc, int fr, int fq) const {
#pragma unroll
        for (int ai = 0; ai < 2; ++ai)
#pragma unroll
            for (int m = 0; m < 4; ++m) {
                const int r = ai * 128 + wr * 64 + m * 16 + fr;
                if (u.slot0 + r >= u.cnt) continue;
                bf16_t* rowp = hid + ((size_t)u.pm * 256 + r) * DE + ((u.pn * 256 + wc * 32 + 8 * fq) >> 1);
#pragma unroll
                for (int bj = 0; bj < 2; ++bj) {
                    const f32x4 v0 = acc[ai][bj][m][0], v1 = acc[ai][bj][m][1];
                    *(u32x2*)(rowp + bj * 64) = (u32x2){pack2(v0[0] * sigmoidf_(v0[0]) * v0[1], v0[2] * sigmoidf_(v0[2]) * v0[3]), pack2(v1[0] * sigmoidf_(v1[0]) * v1[1], v1[2] * sigmoidf_(v1[2]) * v1[3])};
                }
            }
    }
};
struct EpiMoeDown {
    static constexpr bool PERM = true;
    bf16_t* fo; const int* list; const float* tokg;
    DI void operator()(const f32x4 (&acc)[2][2][4][2], const g8::Unit& u, int wr, int wc, int fr, int fq) const {
#pragma unroll
        for (int ai = 0; ai < 2; ++ai)
#pragma unroll
            for (int m = 0; m < 4; ++m) {
                const int sl = u.slot0 + ai * 128 + wr * 64 + m * 16 + fr;
                if (sl >= u.cnt) continue;
                const int ent = list[u.e * T + sl];
                const float g = tokg[ent];
                bf16_t* rowp = fo + ((size_t)(ent & 1) * TP + (ent >> 1)) * D + u.pn * 256 + wc * 32 + 8 * fq;
#pragma unroll
                for (int bj = 0; bj < 2; ++bj) {
                    const f32x4 v0 = acc[ai][bj][m][0], v1 = acc[ai][bj][m][1];
                    *(u32x4*)(rowp + bj * 128) = (u32x4){pack2(g * v0[0], g * v0[1]), pack2(g * v0[2], g * v0[3]), pack2(g * v1[0], g * v1[1]), pack2(g * v1[2], g * v1[3])};
                }
            }
    }
};
DI void phase_moe_up(const Params& p, int bid, int nb, char* smem) {
    const MoeOrder<true> S{p.counts, p.list, nb, bid, (const char*)p.hb, (const char*)p.WtGU};
    g8::gemm8<true>((G8_LAS unsigned char*)smem, D, S, EpiMoeUp{p.hid});
}
DI void phase_moe_down(const Params& p, int bid, int nb, char* smem) {
    const MoeOrder<false> S{p.counts, p.list, nb, bid, (const char*)p.hid, (const char*)p.WtD};
    g8::gemm8<false>((G8_LAS unsigned char*)smem, DE, S, EpiMoeDown{p.fo, p.list, p.tokg});
}
DI void phase_ln2(const Params& p, int layer, int bid, int nb) {
    const int lane = tid_() & 63, wid = __builtin_amdgcn_readfirstlane(tid_() >> 6);
    for (int tok = bid * 8 + wid; tok < T; tok += nb * 8) {
        float* hf = hrow(p, tok);
        float v[16];
#pragma unroll
        for (int j = 0; j < 4; ++j) {
            const f32x4 a = *(const f32x4*)(hf + 256 * j + 4 * lane);
            const u32x2 f0 = *(const u32x2*)(p.fo + (size_t)tok * D + 256 * j + 4 * lane), f1 = *(const u32x2*)(p.fo + ((size_t)TP + tok) * D + 256 * j + 4 * lane);
            v[4 * j] = ALPHA * a[0] + lo_bf(f0[0]) + lo_bf(f1[0]); v[4 * j + 1] = ALPHA * a[1] + hi_bf(f0[0]) + hi_bf(f1[0]);
            v[4 * j + 2] = ALPHA * a[2] + lo_bf(f0[1]) + lo_bf(f1[1]); v[4 * j + 3] = ALPHA * a[3] + hi_bf(f0[1]) + hi_bf(f1[1]);
        }
        ln16(v, p.ln2_g + layer * D, p.ln2_b + layer * D, lane);
        store_row(hf, p.hb + (size_t)tok * D, v, lane);
    }
}

extern __shared__ __attribute__((aligned(16))) char dyn_smem[];
constexpr int SMEM_MAIN = R1_LDS > GEMM_LDS ? R1_LDS : GEMM_LDS;
constexpr int SMEM_BYTES = SMEM_MAIN + 16;

__global__ void __launch_bounds__(NTHR, 2) k_forward(Params p) {
    const int bid = blockIdx.x, nb = gridDim.x;
    char* smem = dyn_smem;
    uint4* xbw = (uint4*)(dyn_smem + SMEM_MAIN);
    if (threadIdx.x == 0) *xbw = make_uint4(0u, 0u, 0u, 0u);
    __syncthreads();
    XcdBarrier bar = xcd_barrier_post(p.bar, (volatile LAS unsigned*)xbw);
    phase_prologue_weights(p, bid, nb, smem);
    phase_embed(p, bid, nb);
    xcd_barrier(bar);
    for (int l = 0; l < DEPTH; ++l) {
        phase_inproj(p, l, bid, nb, smem);
        xcd_barrier(bar);
        phase_rwkv_r1<0>(p, l, bid, nb, smem);
        xcd_barrier(bar);
        if (bid < 32) phase_rwkv_r2(p, bid);
        else {
            const int sbid = bid - 32, snb = nb - 32, heavy = (NBATCH * HEADS * ((L + 127) / 128)) % snb;
            if (sbid >= heavy && sbid < heavy + NBATCH * HEADS) phase_rwkv_r1<1>(p, l, sbid - heavy, 1, smem);
            phase_sb(p, sbid, snb, smem);
        }
        xcd_barrier(bar);
        phase_rwkv_r3(p, l, bid, nb);
        convert_experts(p, l, bid, nb, smem);
        phase_merge<0>(p, l, bid, nb, smem);
        xcd_barrier(bar);
        phase_merge<1>(p, l, bid, nb, smem);
        xcd_barrier(bar);
        phase_outproj(p, l, bid, nb, smem);
        xcd_barrier(bar);
        phase_ln1_router(p, l, bid, nb, smem);
        xcd_barrier(bar);
        phase_moe_up(p, bid, nb, smem);
        xcd_barrier(bar);
        phase_moe_down(p, bid, nb, smem);
        xcd_barrier(bar);
        phase_ln2(p, l, bid, nb);
        xcd_barrier(bar);
    }
}

extern "C" void kernel_launch(void* const* d_in, const int* in_sizes, int n_in, void* d_out, int out_size, void* d_ws, size_t ws_size, hipStream_t stream) {
    (void)in_sizes; (void)n_in; (void)out_size;
    Params p;
    memset(&p, 0, sizeof(p));
    const float* const* in = (const float* const*)d_in;
    p.x = in[0]; p.meta = in[1]; p.emb_g = in[2]; p.emb_b = in[3]; p.w_in = in[4]; p.mu = in[5]; p.w0 = in[6]; p.w_up = in[7]; p.a0 = in[8]; p.a_up = in[9];
    p.g_up = in[10]; p.k_k = in[11]; p.k_a = in[12]; p.r_k = in[13]; p.lnx_g = in[14]; p.lnx_b = in[15]; p.p_sb = in[16]; p.p_rwkv = in[17]; p.w_out = in[18];
    p.ln1_g = in[19]; p.ln1_b = in[20]; p.router_w = in[21]; p.router_b = in[22]; p.ew_gate = in[23]; p.ew_up = in[24]; p.ew_down = in[25]; p.ln2_g = in[26]; p.ln2_b = in[27];
    p.out = (float*)d_out;
    char* ws = (char*)d_ws; size_t o = 0;
    auto take = [&](size_t bytes) { char* r = ws + o; o += (bytes + 255) & ~(size_t)255; return r; };
    p.bar = (unsigned*)take(XCD_BAR_WORDS * sizeof(unsigned));
    p.counts = (int*)take(256);
    p.WtIn = (bf16_t*)take((size_t)DEPTH * CIN * D * 2);
    p.WtPsb = (bf16_t*)take((size_t)DEPTH * D * 512 * 2);
    p.WtPrw = (bf16_t*)take((size_t)DEPTH * D * 512 * 2);
    p.WtOut = (bf16_t*)take((size_t)DEPTH * D * D * 2);
    p.WupT = (bf16_t*)take((size_t)DEPTH * 512 * 64 * 2);
    p.AupT = (bf16_t*)take((size_t)DEPTH * 512 * 64 * 2);
    p.GupT = (bf16_t*)take((size_t)DEPTH * 512 * 128 * 2);
    p.RwHi = (bf16_t*)take((size_t)NE * D * 2);
    p.RwLo = (bf16_t*)take((size_t)NE * D * 2);
    {
        const size_t ub = (size_t)NUNIT * 64 * 64 * 2, need_r = 6 * ub + (size_t)NUNIT * 64 * 4, need_e = (size_t)NE * 1024 * 1024 * 2 + (size_t)NE * 1024 * 512 * 2;
        char* e = take(need_r > need_e ? need_r : need_e);
        p.WtGU = (bf16_t*)e; p.WtD = (bf16_t*)(e + (size_t)NE * 1024 * 1024 * 2);
        p.PcG = (bf16_t*)e; p.QcG = (bf16_t*)(e + ub); p.RhG = (bf16_t*)(e + 2 * ub); p.Y0G = (bf16_t*)(e + 3 * ub); p.GG = (bf16_t*)(e + 4 * ub); p.SG = (bf16_t*)(e + 5 * ub);
        p.bonG = (float*)(e + 6 * ub);
    }
    p.hb = (bf16_t*)take((size_t)TP * D * 2);
    p.hmeta = (float*)take((size_t)NBATCH * NMETA * D * 4);
    p.P = (bf16_t*)take((size_t)TP * CP * 2);
    p.osb = (bf16_t*)take((size_t)TP * 512 * 2);
    p.orw = (bf16_t*)take((size_t)TP * 512 * 2);
    p.list = (int*)take((size_t)NE * T * 4);
    p.tokg = (float*)take((size_t)T * 2 * 4);
    p.gates = p.P;
    p.merged = p.P + (size_t)TP * 2048;
    p.hid = p.P;
    p.fo = p.P + (size_t)(2 * T + 16 * 256) * DE;
    if (o > ws_size) return;
    static int grid = 0;
    if (!grid) {
        int dev = 0, cus = 0, per_cu = 0;
        (void)hipGetDevice(&dev);
        (void)hipDeviceGetAttribute(&cus, hipDeviceAttributeMultiprocessorCount, dev);
        (void)hipFuncSetAttribute((const void*)k_forward, hipFuncAttributeMaxDynamicSharedMemorySize, SMEM_BYTES);
        (void)hipOccupancyMaxActiveBlocksPerMultiprocessor(&per_cu, k_forward, NTHR, SMEM_BYTES);
        grid = per_cu >= 1 ? cus : 0;
    }
    if (!grid) return;
    (void)hipMemsetAsync(p.bar, 0, XCD_BAR_WORDS * sizeof(unsigned), stream);
    hipLaunchKernelGGL(k_forward, dim3(grid), dim3(NTHR), SMEM_BYTES, stream, p);
}
```

```cpp
#include <hip/hip_runtime.h>
#include <stdint.h>
#include <string.h>

#define DI __device__ __forceinline__
typedef unsigned short bf16_t;
typedef short bf16x8 __attribute__((ext_vector_type(8)));
typedef float f32x4 __attribute__((ext_vector_type(4)));
typedef unsigned u32x4 __attribute__((ext_vector_type(4)));
typedef unsigned u32x2 __attribute__((ext_vector_type(2)));

constexpr int D = 1024, NBATCH = 2, SEQ = 8192, NMETA = 16, L = SEQ + NMETA, T = NBATCH * L, TP = 16640;
constexpr int DEPTH = 2, HEADS = 8, HD = 64;
constexpr int CIN = 5376, CP = 3328;
constexpr int OFF_Q = 0, OFF_K = 512, OFF_V = 1024, OFF_RW = 1536;
constexpr int RW_R = 0, RW_K = 512, RW_V = 1024, RW_WD = 1536, RW_AD = 1600, RW_GD = 1664, RSW = 1792;
constexpr int NE = 16, DE = 512;
constexpr float ALPHA = 1.41421356237309515f;
constexpr float DECAY_SCALE = 0.60653065971263342f;
constexpr int NTHR = 512;

#define XB_TMO      128
#define XB_XCNT(j)  (256  + 64 * (j))
#define XB_XSUB(j)  (1280 + 64 * (j))
#define XB_XGEN(j)  (2304 + 64 * (j))
#define XB_TOP      3328
#define XB_TOPGEN   3392
#define XCD_BAR_WORDS 3456
#define XB_SPIN_CAP (1u << 18)
#define LAS __attribute__((address_space(3)))

__device__ __forceinline__ unsigned xb_ld(unsigned* p)              { return __hip_atomic_load(p, __ATOMIC_RELAXED, __HIP_MEMORY_SCOPE_AGENT); }
__device__ __forceinline__ unsigned xb_add(unsigned* p, unsigned v) { return __hip_atomic_fetch_add(p, v, __ATOMIC_RELAXED, __HIP_MEMORY_SCOPE_AGENT); }
__device__ __forceinline__ unsigned xb_xcc_id() { return (unsigned)__builtin_amdgcn_s_getreg((3 << 11) | 20) & 0xFu; }
#define XB_SPIN(cond, bar) do { unsigned _sp = 0; while (cond) { __builtin_amdgcn_s_sleep(1); \
    if ((++_sp & 255u) == 0u) { if (xb_ld(&(bar)[XB_TMO])) break; if (_sp > XB_SPIN_CAP) { atomicAdd(&(bar)[XB_TMO], 1u); break; } } } } while (0)

struct XcdBarrier {
    unsigned* bar; unsigned x;
    volatile LAS unsigned* st;
};

__device__ __forceinline__ XcdBarrier xcd_barrier_post(unsigned* bar, volatile LAS unsigned* st) {
    XcdBarrier b; b.bar = bar; b.x = xb_xcc_id(); b.st = st;
    if (threadIdx.x == 0) (void)xb_add(&bar[XB_XCNT(b.x)], 1u);
    return b;
}
__device__ __forceinline__ void xcd_barrier_complete(unsigned* bar, unsigned x, unsigned& nloc, unsigned& nx) {
    const unsigned G = gridDim.x * gridDim.y * gridDim.z;
    unsigned sum, cnt, mine, sp = 0u;
    for (;;) {
        sum = 0u; cnt = 0u; mine = 0u;
#pragma unroll
        for (unsigned j = 0; j < 16; ++j) { const unsigned c = xb_ld(&bar[XB_XCNT(j)]); sum += c; cnt += (c > 0u) ? 1u : 0u; mine = (j == x) ? c : mine; }
        if (sum == G) break;
        __builtin_amdgcn_s_sleep(1);
        if ((++sp & 255u) == 0u) { if (xb_ld(&bar[XB_TMO])) break; if (sp > XB_SPIN_CAP) { atomicAdd(&bar[XB_TMO], 1u); break; } }
    }
    nloc = mine > 0u ? mine : 1u; nx = cnt > 0u ? cnt : 1u;
}

__device__ __forceinline__ void xcd_barrier(const XcdBarrier& b) {
    asm volatile("s_waitcnt vmcnt(0)" ::: "memory");
    __syncthreads();
    if (threadIdx.x == 0) {
        unsigned* bar = b.bar;
        unsigned bx = b.x; asm volatile("" : "+s"(bx));
        __builtin_amdgcn_s_waitcnt(0);
        unsigned nloc = b.st[0], nx = b.st[1];
        if (nloc == 0u) { xcd_barrier_complete(bar, bx, nloc, nx); b.st[0] = nloc; b.st[1] = nx; }
        const unsigned old = xb_add(&bar[XB_XSUB(bx)], 1u);
        const unsigned gen = old / nloc;
        if (old + 1u == (gen + 1u) * nloc) {
            __builtin_amdgcn_fence(__ATOMIC_RELEASE, "agent");
            asm volatile("s_waitcnt vmcnt(0)" ::: "memory");
            const unsigned og = xb_add(&bar[XB_TOP], 1u);
            const unsigned tg = og / nx;
            if (og + 1u == (tg + 1u) * nx) xb_add(&bar[XB_TOPGEN], 1u);
            else XB_SPIN(xb_ld(&bar[XB_TOPGEN]) == tg, bar);
            __builtin_amdgcn_fence(__ATOMIC_ACQUIRE, "agent");
            xb_add(&bar[XB_XGEN(bx)], 1u);
            asm volatile("s_waitcnt vmcnt(0)" ::: "memory");
        } else {
            XB_SPIN(xb_ld(&bar[XB_XGEN(bx)]) == gen, bar);
            __builtin_amdgcn_fence(__ATOMIC_ACQUIRE, "agent");
            asm volatile("s_waitcnt vmcnt(0)" ::: "memory");
        }
    }
    __syncthreads();
}


struct Params {
    const float *x, *meta, *emb_g, *emb_b, *w_in, *mu, *w0, *w_up, *a0, *a_up, *g_up, *k_k, *k_a, *r_k, *lnx_g, *lnx_b, *p_sb, *p_rwkv, *w_out,
        *ln1_g, *ln1_b, *router_w, *router_b, *ew_gate, *ew_up, *ew_down, *ln2_g, *ln2_b;
    float* out;
    unsigned* bar;
    int* counts;
    bf16_t *WtIn, *WtPsb, *WtPrw, *WtOut, *WtGU, *WtD, *hb, *P, *osb, *orw, *WupT, *AupT, *GupT;
    bf16_t *PcG, *QcG, *RhG, *Y0G, *GG, *SG;
    bf16_t *RwHi, *RwLo;
    float* bonG;
    float* hmeta;
    bf16_t *gates, *merged, *hid, *fo;
    int* list;
    float* tokg;
};

DI float bf2f(bf16_t v) { return __uint_as_float((unsigned)v << 16); }
typedef __bf16 bf16x2_t __attribute__((ext_vector_type(2)));
DI bf16_t f2bf(float f) { return __builtin_bit_cast(bf16_t, (__bf16)f); }
DI unsigned pack2(float lo, float hi) { bf16x2_t v = {(__bf16)lo, (__bf16)hi}; return __builtin_bit_cast(unsigned, v); }
DI float lo_bf(unsigned u) { return __uint_as_float(u << 16); }
DI float hi_bf(unsigned u) { return __uint_as_float(u & 0xFFFF0000u); }
template <int CTRL> DI float dpp_mov(float v) { return __builtin_bit_cast(float, __builtin_amdgcn_update_dpp(0, __builtin_bit_cast(int, v), CTRL, 0xF, 0xF, true)); }
DI float sum8(float v) {
    v += dpp_mov<0xB1>(v);
    v += dpp_mov<0x4E>(v);
    v += dpp_mov<0x141>(v);
    return v;
}
DI float sum16(float v) { v = sum8(v); v += dpp_mov<0x140>(v); return v; }
DI float wave_sum(float v) { v = sum16(v); v += __shfl_xor(v, 16); v += __shfl_xor(v, 32); return v; }
struct Params;
DI const Params& kparams() {
    auto k = __builtin_amdgcn_kernarg_segment_ptr();
    asm volatile("" : "+s"(k));
    return *(const Params*)k;
}
DI int tid_() { int t = threadIdx.x; asm volatile("" : "+v"(t)); return t; }
DI float sigmoidf_(float x) { return __builtin_amdgcn_rcpf(1.0f + __expf(-x)); }
DI float tanhf_(float x) { return 1.0f - 2.0f * __builtin_amdgcn_rcpf(1.0f + __expf(2.0f * x)); }
DI void wave_sync() { asm volatile("s_waitcnt lgkmcnt(0)" ::: "memory"); __builtin_amdgcn_wave_barrier(); }

DI float* hrow2(float* hmeta, float* out, int tok) {
    const int b = tok >= L ? 1 : 0, t = tok - b * L;
    const unsigned long long am = (unsigned long long)(hmeta + (long long)(b * NMETA + t) * D), ao = (unsigned long long)(out + ((long long)b * SEQ + (t - NMETA)) * D);
    const unsigned long long m = 0ull - (unsigned long long)(t < NMETA);
    return (float*)((am & m) | (ao & ~m));
}
DI float* hrow(const Params& p, int tok) { return hrow2(p.hmeta, p.out, tok); }
DI float* hrow_u(const Params& p, int tok) { return hrow2(p.hmeta, p.out, __builtin_amdgcn_readfirstlane(tok)); }

DI void transpose_convert(const float* __restrict__ src, int ld, int K, int N, bf16_t* __restrict__ dst, int mult, int off, int bid, int nb, char* smem) {
    float* tile = (float*)smem;
    const int tk = K / 64, tn = N / 64, tid = tid_();
    for (int t = bid; t < tk * tn; t += nb) {
        const int k0 = (t / tn) * 64, n0 = (t % tn) * 64;
        __syncthreads();
#pragma unroll
        for (int i = 0; i < 2; ++i) {
            const int k = (tid >> 4) + 32 * i, n4 = (tid & 15) * 4;
            const f32x4 v = *(const f32x4*)(src + (size_t)(k0 + k) * ld + n0 + n4);
            tile[k * 65 + n4 + 0] = v[0]; tile[k * 65 + n4 + 1] = v[1]; tile[k * 65 + n4 + 2] = v[2]; tile[k * 65 + n4 + 3] = v[3];
        }
        __syncthreads();
        const int n = tid >> 3, kc = (tid & 7) * 8;
        u32x4 o;
#pragma unroll
        for (int j = 0; j < 4; ++j) o[j] = pack2(tile[(kc + 2 * j) * 65 + n], tile[(kc + 2 * j + 1) * 65 + n]);
        *(u32x4*)(dst + (size_t)((n0 + n) * mult + off) * K + k0 + kc) = o;
    }
}

DI void convert_experts(const Params& p, int layer, int bid, int nb, char* smem) {
    for (int e = 0; e < NE; ++e) {
        const size_t eo = ((size_t)layer * NE + e) * (size_t)D * DE;
        transpose_convert(p.ew_gate + eo, DE, D, DE, p.WtGU + (size_t)e * 1024 * 1024, 2, 0, bid, nb, smem);
        transpose_convert(p.ew_up + eo, DE, D, DE, p.WtGU + (size_t)e * 1024 * 1024, 2, 1, bid, nb, smem);
        transpose_convert(p.ew_down + eo, D, DE, D, p.WtD + (size_t)e * 1024 * 512, 1, 0, bid, nb, smem);
    }
}

DI void phase_prologue_weights(const Params& p, int bid, int nb, char* smem) {
    for (int i = bid * NTHR + tid_(); i < NE * D; i += nb * NTHR) {
        const int e = i / D, k = i % D;
        const float w = p.router_w[(size_t)k * NE + e];
        const bf16_t hi = f2bf(w);
        p.RwHi[i] = hi; p.RwLo[i] = f2bf(w - bf2f(hi));
    }
    for (int l = 0; l < DEPTH; ++l) {
        transpose_convert(p.w_in + (size_t)l * D * CIN, CIN, D, CIN, p.WtIn + (size_t)l * CIN * D, 1, 0, bid, nb, smem);
        transpose_convert(p.p_sb + (size_t)l * 512 * D, D, 512, D, p.WtPsb + (size_t)l * D * 512, 1, 0, bid, nb, smem);
        transpose_convert(p.p_rwkv + (size_t)l * 512 * D, D, 512, D, p.WtPrw + (size_t)l * D * 512, 1, 0, bid, nb, smem);
        transpose_convert(p.w_out + (size_t)l * D * D, D, D, D, p.WtOut + (size_t)l * D * D, 1, 0, bid, nb, smem);
        transpose_convert(p.w_up + (size_t)l * 64 * 512, 512, 64, 512, p.WupT + (size_t)l * 512 * 64, 1, 0, bid, nb, smem);
        transpose_convert(p.a_up + (size_t)l * 64 * 512, 512, 64, 512, p.AupT + (size_t)l * 512 * 64, 1, 0, bid, nb, smem);
        transpose_convert(p.g_up + (size_t)l * 128 * 512, 512, 128, 512, p.GupT + (size_t)l * 512 * 128, 1, 0, bid, nb, smem);
    }
}

DI void ln16(float (&v)[16], const float* __restrict__ g, const float* __restrict__ b, int lane) {
    float s = 0.f;
#pragma unroll
    for (int i = 0; i < 16; ++i) s += v[i];
    const float mean = wave_sum(s) * (1.0f / D);
    float q = 0.f;
#pragma unroll
    for (int i = 0; i < 16; ++i) { v[i] -= mean; q += v[i] * v[i]; }
    const float rstd = rsqrtf(wave_sum(q) * (1.0f / D) + 1e-5f);
#pragma unroll
    for (int j = 0; j < 4; ++j) {
        const f32x4 gv = *(const f32x4*)(g + 256 * j + 4 * lane), bv = *(const f32x4*)(b + 256 * j + 4 * lane);
#pragma unroll
        for (int i = 0; i < 4; ++i) v[4 * j + i] = v[4 * j + i] * rstd * gv[i] + bv[i];
    }
}
DI void store_row(float* __restrict__ hf, bf16_t* __restrict__ hb, const float (&v)[16], int lane) {
#pragma unroll
    for (int j = 0; j < 4; ++j) {
        *(f32x4*)(hf + 256 * j + 4 * lane) = (f32x4){v[4 * j], v[4 * j + 1], v[4 * j + 2], v[4 * j + 3]};
        *(u32x2*)(hb + 256 * j + 4 * lane) = (u32x2){pack2(v[4 * j], v[4 * j + 1]), pack2(v[4 * j + 2], v[4 * j + 3])};
    }
}

DI void store_row_bf(bf16_t* __restrict__ hb, const float (&v)[16], int lane) {
#pragma unroll
    for (int j = 0; j < 4; ++j) *(u32x2*)(hb + 256 * j + 4 * lane) = (u32x2){pack2(v[4 * j], v[4 * j + 1]), pack2(v[4 * j + 2], v[4 * j + 3])};
}
DI void phase_embed(const Params& p, int bid, int nb) {
    const int lane = tid_() & 63, wid = __builtin_amdgcn_readfirstlane(tid_() >> 6);
    const int nwaves = nb * 8, gw = bid * 8 + wid, base_n = T / nwaves, extra = T % nwaves;
    const int tok0 = gw * base_n + (gw < extra ? gw : extra), ntok = base_n + (gw < extra ? 1 : 0);
    auto srcrow = [&](int tok) -> const float* {
        const int tk = __builtin_amdgcn_readfirstlane(tok), b = tk >= L ? 1 : 0, t = tk - b * L;
        const unsigned long long am = (unsigned long long)(p.meta + (long long)t * D), ao = (unsigned long long)(p.x + ((long long)b * SEQ + (t - NMETA)) * D);
        const unsigned long long m = 0ull - (unsigned long long)(t < NMETA);
        return (const float*)((am & m) | (ao & ~m));
    };
    f32x4 an[4];
    { const float* src = srcrow(tok0);
#pragma unroll
      for (int j = 0; j < 4; ++j) an[j] = *(const f32x4*)(src + 256 * j + 4 * lane); }
#pragma unroll 1
    for (int i = 0; i < ntok; ++i) {
        const int tok = tok0 + i;
        float v[16];
#pragma unroll
        for (int j = 0; j < 4; ++j) { v[4 * j] = an[j][0]; v[4 * j + 1] = an[j][1]; v[4 * j + 2] = an[j][2]; v[4 * j + 3] = an[j][3]; }
        if (i + 1 < ntok) { const float* src = srcrow(tok + 1);
#pragma unroll
            for (int j = 0; j < 4; ++j) an[j] = *(const f32x4*)(src + 256 * j + 4 * lane); }
        ln16(v, p.emb_g, p.emb_b, lane);
        store_row_bf(p.hb + (size_t)tok * D, v, lane);
    }
}

constexpr int LDT = 72;
constexpr int GEMM_LDS = 2 * 128 * LDT * 2;
template <class ARow, class Epi>
DI void gemm_tile128(ARow arow, const bf16_t* __restrict__ Bt, int ldb, int K, int m0, int n0, char* smem, Epi epi) {
    const int tid = tid_(), lane = tid & 63, wid = __builtin_amdgcn_readfirstlane(tid >> 6), fr = lane & 15, fq = lane >> 4;
    const int wr = wid >> 1, wc = wid & 1;
    bf16_t* As = (bf16_t*)smem;
    bf16_t* Bs = As + 128 * LDT;
    const bf16_t* ap[2]; const bf16_t* bp[2]; int so[2];
#pragma unroll
    for (int i = 0; i < 2; ++i) {
        const int c = tid + NTHR * i, row = c >> 3, kc = c & 7;
        const bf16_t* ar = arow(m0 + row);
        ap[i] = ar ? ar + kc * 8 : nullptr;
        bp[i] = Bt + (size_t)(n0 + row) * ldb + kc * 8;
        so[i] = row * LDT + kc * 8;
    }
    f32x4 acc[2][4];
#pragma unroll
    for (int mi = 0; mi < 2; ++mi)
#pragma unroll
        for (int ni = 0; ni < 4; ++ni) acc[mi][ni] = (f32x4){0.f, 0.f, 0.f, 0.f};
    u32x4 ra[2], rb[2];
#pragma unroll
    for (int i = 0; i < 2; ++i) { ra[i] = ap[i] ? *(const u32x4*)(ap[i]) : (u32x4){0u, 0u, 0u, 0u}; rb[i] = *(const u32x4*)(bp[i]); }
    for (int k0 = 0; k0 < K; k0 += 64) {
        __syncthreads();
#pragma unroll
        for (int i = 0; i < 2; ++i) { *(u32x4*)(As + so[i]) = ra[i]; *(u32x4*)(Bs + so[i]) = rb[i]; }
        __syncthreads();
        if (k0 + 64 < K) {
#pragma unroll
            for (int i = 0; i < 2; ++i) { ra[i] = ap[i] ? *(const u32x4*)(ap[i] + k0 + 64) : (u32x4){0u, 0u, 0u, 0u}; rb[i] = *(const u32x4*)(bp[i] + k0 + 64); }
        }
#pragma unroll
        for (int ks = 0; ks < 2; ++ks) {
            bf16x8 af[2], bf[4];
#pragma unroll
            for (int mi = 0; mi < 2; ++mi) af[mi] = *(const bf16x8*)(As + (wr * 32 + mi * 16 + fr) * LDT + ks * 32 + fq * 8);
#pragma unroll
            for (int ni = 0; ni < 4; ++ni) bf[ni] = *(const bf16x8*)(Bs + (wc * 64 + ni * 16 + fr) * LDT + ks * 32 + fq * 8);
#pragma unroll
            for (int mi = 0; mi < 2; ++mi)
#pragma unroll
                for (int ni = 0; ni < 4; ++ni) acc[mi][ni] = __builtin_amdgcn_mfma_f32_16x16x32_bf16(bf[ni], af[mi], acc[mi][ni], 0, 0, 0);
        }
    }
#pragma unroll
    for (int mi = 0; mi < 2; ++mi)
#pragma unroll
        for (int ni = 0; ni < 4; ++ni) epi(m0 + wr * 32 + mi * 16 + fr, n0 + wc * 64 + ni * 16 + fq * 4, acc[mi][ni]);
}

namespace g8 {
#define G8_LAS __attribute__((address_space(3)))
constexpr int BM = 256, BK = 64, HALF = 128, HTB = HALF * BK * 2, STAGE_BYTES = 8 * HTB, NXCD = 8, WGM = 8;
DI int lds_byte(int r, int c) { const int st = (r >> 4) * 2 + (c >> 5), rr = r & 15, cc = c & 31, ob = rr * 64 + cc * 2; return st * 1024 + (ob ^ (((ob >> 9) & 1) << 5)); }
DI void stage_rc(int b, int& R, int& C) { const int st = b / 1024, sb = b % 1024, swz = sb ^ (((sb >> 9) & 1) << 5); R = (st >> 1) * 16 + swz / 64; C = (st & 1) * 32 + (swz % 64) / 2; }
DI int perm32(int rho) { const int n = rho >> 4, i = rho & 15; return 8 * (i >> 2) + 4 * n + (i & 3); }
struct Unit { int pm, pn; const char* A; const char* B; int e, slot0, cnt; };

struct DenseOrder {
    int nM, nN, nwg, G, c; const char* A; const char* B; size_t tstep;
    DI void init(const bf16_t* A_, const bf16_t* Bt_, int nM_, int nN_, int K, int G_, int c_) { nM = nM_; nN = nN_; nwg = nM * nN; G = G_; c = c_; A = (const char*)A_; B = (const char*)Bt_; tstep = (size_t)BM * K * 2; }
    DI bool next(int i, Unit& u) const {
        const long Lq = (long)i * G + c; if (Lq >= nwg) return false;
        int wgid = (int)Lq; { const int q = nwg / NXCD, r = nwg % NXCD, xcd = wgid % NXCD, off = wgid / NXCD; wgid = (xcd < r ? xcd * (q + 1) : r * (q + 1) + (xcd - r) * q) + off; }
        const int nig = WGM * nN, gid = wgid / nig, fm = gid * WGM, gsz = (nM - fm) < WGM ? (nM - fm) : WGM;
        u.pm = fm + ((wgid % nig) % gsz); u.pn = (wgid % nig) / gsz; u.A = A + (size_t)u.pm * tstep; u.B = B + (size_t)u.pn * tstep; u.e = 0; u.slot0 = 0; u.cnt = 0; return true;
    }
    DI unsigned row_off(const Unit&, int) const { return 0u; }
};

template <bool GATHER, class Epi, class Sched>
DI void gemm8(G8_LAS unsigned char* lds, const int K, const Sched& S, const Epi& E) {
    const int tid = tid_(), wid = __builtin_amdgcn_readfirstlane(tid >> 6), lane = tid & 63, wr = wid >> 2, wc = wid & 3, fr = lane & 15, fq = lane >> 4;
    const int nt = K / BK;
    int Rr[2], Cc[2]; unsigned voffB[2], voffA[2];
#pragma unroll
    for (int i = 0; i < 2; ++i) { stage_rc(tid * 16 + i * 8192, Rr[i], Cc[i]); const int Rb = Epi::PERM ? ((Rr[i] & ~31) + perm32(Rr[i] & 31)) : Rr[i]; voffB[i] = (unsigned)(Rb * K + Cc[i]) * 2u; voffA[i] = (unsigned)(Rr[i] * K + Cc[i]) * 2u; }
    const size_t kstep = (size_t)(BK * 2), hstep = (size_t)HALF * K * 2;
    const unsigned ldsw = (unsigned)wid * 1024u;
    const int aoff = lds_byte(wr * 64 + fr, fq * 8), boff = lds_byte(wc * 32 + fr, fq * 8);
#define G8_SA(b, h) (((b) * 2 + (h)) * HTB)
#define G8_SB(b, h) ((4 + (b) * 2 + (h)) * HTB)
#define G8_STAGE(bufoff, gbase, voff) do { _Pragma("unroll") for (int _i = 0; _i < 2; ++_i) \
        __builtin_amdgcn_global_load_lds((const unsigned*)((const char*)(gbase) + (voff)[_i]), (G8_LAS unsigned*)(lds + (bufoff) + ldsw + _i * 8192), 16, 0, 0); } while (0)
#define G8_LDA(dst, b, h) do { _Pragma("unroll") for (int m = 0; m < 4; ++m) _Pragma("unroll") for (int k = 0; k < 2; ++k) dst[m][k] = *(const G8_LAS bf16x8*)(lds + G8_SA(b, h) + aoff + m * 2048 + k * 1024); } while (0)
#define G8_LDB(dst, b, h) do { _Pragma("unroll") for (int n = 0; n < 2; ++n) _Pragma("unroll") for (int k = 0; k < 2; ++k) dst[n][k] = *(const G8_LAS bf16x8*)(lds + G8_SB(b, h) + boff + n * 2048 + k * 1024); } while (0)
#define G8_MMA(ai, bj, At, Bt) do { __builtin_amdgcn_s_setprio(1); _Pragma("unroll") for (int m = 0; m < 4; ++m) _Pragma("unroll") for (int n = 0; n < 2; ++n) _Pragma("unroll") for (int k = 0; k < 2; ++k) \
        acc[ai][bj][m][n] = __builtin_amdgcn_mfma_f32_16x16x32_bf16(Bt[n][k], At[m][k], acc[ai][bj][m][n], 0, 0, 0); __builtin_amdgcn_s_setprio(0); } while (0)
#define G8_WAIT_V(n) asm volatile("s_waitcnt vmcnt(" #n ")" ::: "memory")
#define G8_WAIT_L(n) asm volatile("s_waitcnt lgkmcnt(" #n ")" ::: "memory")
#define G8_BAR __builtin_amdgcn_s_barrier()
#define G8_SCHED __builtin_amdgcn_sched_barrier(0)
#define G8_AOFF(dst, un) do { if (GATHER) { _Pragma("unroll") for (int _h = 0; _h < 2; ++_h) _Pragma("unroll") for (int _i = 0; _i < 2; ++_i) \
        dst[_h][_i] = S.row_off(un, _h * HALF + Rr[_i]) + (unsigned)Cc[_i] * 2u; } } while (0)
#define G8_STAGE_A(bufoff, gb, vo, h) do { if (GATHER) { G8_STAGE(bufoff, gb, vo[h]); } else { G8_STAGE(bufoff, (gb) + (h) * hstep, voffA); } } while (0)
    Unit cur, nxt; int ui = 0;
    if (!S.next(0, cur)) return;
    f32x4 acc[2][2][4][2];
#pragma unroll
    for (int a = 0; a < 2; ++a)
#pragma unroll
        for (int b = 0; b < 2; ++b)
#pragma unroll
            for (int m = 0; m < 4; ++m)
#pragma unroll
                for (int n = 0; n < 2; ++n) acc[a][b][m][n] = (f32x4){0.f, 0.f, 0.f, 0.f};
    bf16x8 At[4][2], B0[2][2], B1[2][2];
    unsigned cvA[2][2], nvA[2][2];
    G8_AOFF(cvA, cur);
    const char* cA = cur.A; const char* cB = cur.B;
    G8_STAGE(G8_SB(0, 0), cB, voffB); G8_STAGE_A(G8_SA(0, 0), cA, cvA, 0); G8_STAGE(G8_SB(0, 1), cB + hstep, voffB); G8_STAGE_A(G8_SA(0, 1), cA, cvA, 1);
    if (wr == 1) G8_BAR;
    G8_WAIT_V(4); G8_BAR;
    G8_STAGE(G8_SB(1, 0), cB + kstep, voffB); G8_STAGE_A(G8_SA(1, 0), cA + kstep, cvA, 0); G8_STAGE(G8_SB(1, 1), cB + hstep + kstep, voffB);
    G8_WAIT_V(6); G8_BAR;
    for (;;) {
        const bool has_next = S.next(ui + 1, nxt);
        const char* nA = has_next ? nxt.A : cA; const char* nB = has_next ? nxt.B : cB;
        if (GATHER) {
            if (has_next) { G8_AOFF(nvA, nxt); } else {
#pragma unroll
                for (int h = 0; h < 2; ++h)
#pragma unroll
                    for (int i = 0; i < 2; ++i) nvA[h][i] = cvA[h][i];
            }
        }
        for (int t = 0; t < nt; t += 2) {
            const bool last = (t == nt - 2);
            const char* a1 = cA + (size_t)(t + 1) * kstep;
            const char* a2 = last ? nA : cA + (size_t)(t + 2) * kstep; const char* b2 = last ? nB : cB + (size_t)(t + 2) * kstep;
            const char* a3 = a2 + kstep; const char* b3 = b2 + kstep;

            G8_LDB(B0, 0, 0); G8_SCHED; G8_LDA(At, 0, 0); G8_STAGE_A(G8_SA(1, 1), a1, cvA, 1);
            if (GATHER && last) {
#pragma unroll
                for (int h = 0; h < 2; ++h)
#pragma unroll
                    for (int i = 0; i < 2; ++i) cvA[h][i] = nvA[h][i];
            }
            G8_WAIT_L(8); G8_BAR; G8_WAIT_L(0); G8_MMA(0, 0, At, B0); G8_BAR; G8_SCHED;
            G8_LDB(B1, 0, 1); G8_STAGE(G8_SB(0, 0), b2, voffB);
            G8_BAR; G8_WAIT_L(0); G8_MMA(0, 1, At, B1); G8_BAR;
            G8_LDA(At, 0, 1); G8_STAGE_A(G8_SA(0, 0), a2, cvA, 0);
            G8_BAR; G8_WAIT_L(0); G8_MMA(1, 0, At, B0); G8_BAR; G8_SCHED;
            G8_STAGE(G8_SB(0, 1), b2 + hstep, voffB);
            G8_WAIT_V(6); G8_BAR; G8_MMA(1, 1, At, B1); G8_BAR;
            G8_LDB(B0, 1, 0); G8_SCHED; G8_LDA(At, 1, 0); G8_STAGE_A(G8_SA(0, 1), a2, cvA, 1);
            G8_WAIT_L(8); G8_BAR; G8_WAIT_L(0); G8_MMA(0, 0, At, B0); G8_BAR; G8_SCHED;
            G8_LDB(B1, 1, 1); G8_STAGE(G8_SB(1, 0), b3, voffB);
            G8_BAR; G8_WAIT_L(0); G8_MMA(0, 1, At, B1); G8_BAR;
            G8_LDA(At, 1, 1); G8_STAGE_A(G8_SA(1, 0), a3, cvA, 0);
            G8_BAR; G8_WAIT_L(0); G8_MMA(1, 0, At, B0); G8_BAR; G8_SCHED;
            G8_STAGE(G8_SB(1, 1), b3 + hstep, voffB);
            G8_WAIT_V(6); G8_BAR; G8_MMA(1, 1, At, B1); G8_BAR;
        }
        { int fr2 = fr, fq2 = fq; asm volatile("" : "+v"(fr2), "+v"(fq2)); E(acc, cur, wr, wc, fr2, fq2); }
        if (!has_next) break;
#pragma unroll
        for (int a = 0; a < 2; ++a)
#pragma unroll
            for (int b = 0; b < 2; ++b)
#pragma unroll
                for (int m = 0; m < 4; ++m)
#pragma unroll
                    for (int n = 0; n < 2; ++n) acc[a][b][m][n] = (f32x4){0.f, 0.f, 0.f, 0.f};
        cur = nxt; cA = nA; cB = nB; ++ui;
    }
    G8_WAIT_V(0);
    if (wr == 0) G8_BAR;
    G8_BAR;
#undef G8_SA
#undef G8_SB
#undef G8_STAGE
#undef G8_LDA
#undef G8_LDB
#undef G8_MMA
#undef G8_WAIT_V
#undef G8_WAIT_L
#undef G8_BAR
#undef G8_SCHED
#undef G8_AOFF
#undef G8_STAGE_A
}
}

constexpr int MFULL = 64, M0_LEFT = MFULL * 256;
struct EpiStore {
    static constexpr bool PERM = true;
    bf16_t* O; int ldc; bool sig;
    DI void operator()(const f32x4 (&acc)[2][2][4][2], const g8::Unit& u, int wr, int wc, int fr, int fq) const {
#pragma unroll
        for (int ai = 0; ai < 2; ++ai)
#pragma unroll
            for (int m = 0; m < 4; ++m) {
                bf16_t* rowp = O + (size_t)(u.pm * 256 + ai * 128 + wr * 64 + m * 16 + fr) * ldc + u.pn * 256 + wc * 32 + 8 * fq;
#pragma unroll
                for (int bj = 0; bj < 2; ++bj) {
                    f32x4 v0 = acc[ai][bj][m][0], v1 = acc[ai][bj][m][1];
                    if (sig) {
#pragma unroll
                        for (int e = 0; e < 4; ++e) { v0[e] = sigmoidf_(v0[e]); v1[e] = sigmoidf_(v1[e]); }
                    }
                    *(u32x4*)(rowp + bj * 128) = (u32x4){pack2(v0[0], v0[1]), pack2(v0[2], v0[3]), pack2(v1[0], v1[1]), pack2(v1[2], v1[3])};
                }
            }
    }
};
DI int left_first(int units, int bid, int nb) { return (bid - units % nb + nb) % nb; }

DI void phase_inproj(const Params& p, int layer, int bid, int nb, char* smem) {
    const bf16_t* hb = p.hb; bf16_t* P = p.P;
    const bf16_t* Bt = p.WtIn + (size_t)layer * CIN * D;
    g8::DenseOrder S; S.init(hb, Bt, MFULL, CP / 256, D, nb, bid);
    g8::gemm8<false>((G8_LAS unsigned char*)smem, D, S, EpiStore{P, CP, false});
    for (int t = left_first(MFULL * (CP / 256), bid, nb); t < CP / 128; t += nb)
        gemm_tile128([=](int r) { return r < T ? hb + (size_t)r * D : (const bf16_t*)nullptr; }, Bt, D, D, M0_LEFT, t * 128, smem,
                     [=](int r, int c, f32x4 v) { if (r < T) *(u32x2*)(P + (size_t)r * CP + c) = (u32x2){pack2(v[0], v[1]), pack2(v[2], v[3])}; });
}

constexpr int NCHUNK = (L + 63) / 64, NUNIT = NBATCH * HEADS * NCHUNK;
constexpr int LS = 72, RB = 64 * LS * 2;
constexpr int R1_LDS = 16 * RB + 4096 + 7168;
#define RBUF(i) ((bf16_t*)(smem + (i) * RB))
typedef float f32x16 __attribute__((ext_vector_type(16)));

template <int KK> DI f32x4 mm16(const bf16_t* F, int ldf, const bf16_t* S, int lds_, f32x4 acc, int lane) {
    const int fr = lane & 15, fq = lane >> 4;
#pragma unroll
    for (int ks = 0; ks < KK / 32; ++ks) {
        const bf16x8 f = *(const bf16x8*)(F + fr * ldf + ks * 32 + fq * 8);
        const bf16x8 g = *(const bf16x8*)(S + fr * lds_ + ks * 32 + fq * 8);
        acc = __builtin_amdgcn_mfma_f32_16x16x32_bf16(f, g, acc, 0, 0, 0);
    }
    return acc;
}
DI u32x2 pk4(f32x4 v) { return (u32x2){pack2(v[0], v[1]), pack2(v[2], v[3])}; }
DI f32x4 up4(u32x2 v) { return (f32x4){lo_bf(v[0]), hi_bf(v[0]), lo_bf(v[1]), hi_bf(v[1])}; }

template <int MODE> DI void phase_rwkv_r1(const Params& p, int layer, int bid, int nb, char* smem) {
    const int wv = __builtin_amdgcn_readfirstlane(tid_() >> 6);
    const f32x4 zero = (f32x4){0.f, 0.f, 0.f, 0.f};
    float* lwT = (float*)RBUF(4);
    float* aT = (float*)RBUF(6);
    float* gt = (float*)(smem + 16 * RB);
    float* gammaC = gt + 512;
    bf16_t* Xt0 = RBUF(14);
    bf16_t* Xt1 = RBUF(4);
    const bf16_t* WupT = p.WupT + (size_t)layer * 512 * 64, *AupT = p.AupT + (size_t)layer * 512 * 64, *GupT = p.GupT + (size_t)layer * 512 * 128;
    float* mu = (float*)(smem + 16 * RB + 4096);
    __syncthreads();
    for (int i = tid_(); i < RSW; i += NTHR) mu[i] = p.mu[(size_t)layer * RSW + i];
    for (int it = 0;; ++it) {
        const int tid = tid_(), lane = tid & 63, fr = lane & 15, fq = lane >> 4;
        int c, bh;
        if (MODE == 0) {
            const int Lq = it * nb + bid, q = Lq >> 3, cb = (q >> 3) * 8 + (Lq & 7);
            if (cb >= NBATCH * (NCHUNK - 1)) break;
            c = cb % (NCHUNK - 1); bh = (cb / (NCHUNK - 1)) * HEADS + (q & 7);
        } else {
            if (it > 0) break;
            c = NCHUNK - 1; bh = bid;
        }
        const int u = bh * NCHUNK + c, h = bh % HEADS, bb = bh / HEADS;
        const size_t tok0 = (size_t)bb * L + c * 64;
        bf16x8 fw[2][2], fa[2][2], fg[2][4];
#pragma unroll
        for (int t2 = 0; t2 < 2; ++t2) {
            const int tl = wv * 2 + t2, pt = tl >> 2, qt = tl & 3;
#pragma unroll
            for (int ks = 0; ks < 2; ++ks) {
                fw[t2][ks] = *(const bf16x8*)(WupT + (size_t)(h * 64 + qt * 16 + fr) * 64 + ks * 32 + fq * 8);
                fa[t2][ks] = *(const bf16x8*)(AupT + (size_t)(h * 64 + pt * 16 + fr) * 64 + ks * 32 + fq * 8);
            }
        }
        __syncthreads();
        {
            u32x4 curv[7], prvv[7];
#pragma unroll
            for (int it2 = 0; it2 < 7; ++it2) {
                const int cid = tid + NTHR * it2, i = cid / 56, cc = cid % 56;
                const int col = cc < 8 ? RW_R + h * 64 + cc * 8 : cc < 16 ? RW_K + h * 64 + (cc - 8) * 8 : cc < 24 ? RW_V + h * 64 + (cc - 16) * 8 : RW_WD + (cc - 24) * 8;
                const int t = c * 64 + i;
                curv[it2] = (u32x4){0u, 0u, 0u, 0u}; prvv[it2] = (u32x4){0u, 0u, 0u, 0u};
                if (t < L) curv[it2] = *(const u32x4*)(p.P + (tok0 + i) * CP + OFF_RW + col);
                if (t < L && t > 0) prvv[it2] = *(const u32x4*)(p.P + (tok0 + i - 1) * CP + OFF_RW + col);
            }
#pragma unroll
            for (int it2 = 0; it2 < 7; ++it2) {
                const int cid = tid + NTHR * it2, i = cid / 56, cc = cid % 56;
                const int col = cc < 8 ? RW_R + h * 64 + cc * 8 : cc < 16 ? RW_K + h * 64 + (cc - 8) * 8 : cc < 24 ? RW_V + h * 64 + (cc - 16) * 8 : RW_WD + (cc - 24) * 8;
                bf16_t* dst = cc < 8 ? RBUF(8) + i * LS + cc * 8 : cc < 16 ? RBUF(9) + i * LS + (cc - 8) * 8 : cc < 24 ? RBUF(10) + i * LS + (cc - 16) * 8
                            : cc < 32 ? RBUF(0) + i * LS + (cc - 24) * 8 : cc < 40 ? RBUF(1) + i * LS + (cc - 32) * 8 : RBUF(2) + i * 136 + (cc - 40) * 8;
                const f32x4 m0 = *(const f32x4*)(mu + col), m1 = *(const f32x4*)(mu + col + 4);
                const u32x4 cur = curv[it2], prv = prvv[it2];
                float x[8];
#pragma unroll
                for (int j2 = 0; j2 < 4; ++j2) {
                    const float c0 = lo_bf(cur[j2]), c1 = hi_bf(cur[j2]), p0 = lo_bf(prv[j2]), p1 = hi_bf(prv[j2]);
                    const float mm0 = j2 < 2 ? m0[2 * j2] : m1[2 * j2 - 4], mm1 = j2 < 2 ? m0[2 * j2 + 1] : m1[2 * j2 - 3];
                    x[2 * j2] = c0 + (p0 - c0) * mm0; x[2 * j2 + 1] = c1 + (p1 - c1) * mm1;
                }
                if (cc >= 24 && cc < 32) {
#pragma unroll
                    for (int j2 = 0; j2 < 8; ++j2) x[j2] = tanhf_(x[j2]);
                } else if (cc >= 40) {
#pragma unroll
                    for (int j2 = 0; j2 < 8; ++j2) x[j2] = sigmoidf_(x[j2]);
                }
                *(u32x4*)dst = (u32x4){pack2(x[0], x[1]), pack2(x[2], x[3]), pack2(x[4], x[5]), pack2(x[6], x[7])};
            }
        }
#pragma unroll
        for (int t2 = 0; t2 < 2; ++t2)
#pragma unroll
            for (int ks = 0; ks < 4; ++ks) fg[t2][ks] = *(const bf16x8*)(GupT + (size_t)(h * 64 + ((wv * 2 + t2) >> 2) * 16 + fr) * 128 + ks * 32 + fq * 8);
        __syncthreads();
#pragma unroll
        for (int t2 = 0; t2 < 2; ++t2) {
            const int tl = wv * 2 + t2, pt = tl >> 2, qt = tl & 3;
            f32x4 aw = zero, aa = zero, ag = zero;
#pragma unroll
            for (int ks = 0; ks < 2; ++ks) {
                const bf16x8 xw = *(const bf16x8*)(RBUF(0) + (pt * 16 + fr) * LS + ks * 32 + fq * 8);
                aw = __builtin_amdgcn_mfma_f32_16x16x32_bf16(xw, fw[t2][ks], aw, 0, 0, 0);
                const bf16x8 xa = *(const bf16x8*)(RBUF(1) + (qt * 16 + fr) * LS + ks * 32 + fq * 8);
                aa = __builtin_amdgcn_mfma_f32_16x16x32_bf16(fa[t2][ks], xa, aa, 0, 0, 0);
            }
#pragma unroll
            for (int ks = 0; ks < 4; ++ks) {
                const bf16x8 xg = *(const bf16x8*)(RBUF(2) + (qt * 16 + fr) * 136 + ks * 32 + fq * 8);
                ag = __builtin_amdgcn_mfma_f32_16x16x32_bf16(fg[t2][ks], xg, ag, 0, 0, 0);
            }
            const int ch = qt * 16 + fr;
            const float w0 = p.w0[layer * 512 + h * 64 + ch];
            const f32x4 a0 = *(const f32x4*)(p.a0 + layer * 512 + h * 64 + pt * 16 + fq * 4);
            f32x4 lw, av;
#pragma unroll
            for (int e = 0; e < 4; ++e) { lw[e] = -DECAY_SCALE * sigmoidf_(w0 + aw[e]); av[e] = sigmoidf_(a0[e] + aa[e]); }
            *(f32x4*)(lwT + ch * 68 + pt * 16 + fq * 4) = lw;
            *(f32x4*)(aT + (qt * 16 + fr) * 68 + pt * 16 + fq * 4) = av;
            *(u32x2*)(p.GG + ((size_t)u * 64 + qt * 16 + fr) * 64 + pt * 16 + fq * 4) = pk4(ag);
        }
        __syncthreads();
        {
            const int i = tid >> 3, c8 = (tid & 7) * 8, cg = layer * 512 + h * 64 + c8;
            const u32x4 xr = *(const u32x4*)(RBUF(8) + i * LS + c8), xk = *(const u32x4*)(RBUF(9) + i * LS + c8);
            const f32x4 a0 = *(const f32x4*)(aT + i * 68 + c8), a1 = *(const f32x4*)(aT + i * 68 + c8 + 4);
            const f32x4 kk0 = *(const f32x4*)(p.k_k + cg), kk1 = *(const f32x4*)(p.k_k + cg + 4), ka0 = *(const f32x4*)(p.k_a + cg), ka1 = *(const f32x4*)(p.k_a + cg + 4);
            const f32x4 rk0 = *(const f32x4*)(p.r_k + cg), rk1 = *(const f32x4*)(p.r_k + cg + 4);
            float n2 = 0.f, bon = 0.f;
#pragma unroll
            for (int j = 0; j < 8; ++j) {
                const float r_ = (j & 1) ? hi_bf(xr[j >> 1]) : lo_bf(xr[j >> 1]), k_ = (j & 1) ? hi_bf(xk[j >> 1]) : lo_bf(xk[j >> 1]);
                const float a_ = j < 4 ? a0[j & 3] : a1[j & 3], kkc = j < 4 ? kk0[j & 3] : kk1[j & 3], kac = j < 4 ? ka0[j & 3] : ka1[j & 3], rkc = j < 4 ? rk0[j & 3] : rk1[j & 3];
                const float kkr = k_ * kkc;
                n2 += kkr * kkr;
                bon += r_ * (k_ * (1.0f + (a_ - 1.0f) * kac)) * rkc;
            }
            n2 = sum8(n2); bon = sum8(bon);
            if ((tid & 7) == 0) { gt[576 + i] = 1.0f / fmaxf(sqrtf(n2), 1e-12f); p.bonG[(size_t)u * 64 + i] = bon; }
        }
        __syncthreads();
        {
            const int ch = lane, cg = layer * 512 + h * 64 + ch;
            float lw[8], av[8], cum[8];
            {
                const f32x4 l0 = *(const f32x4*)(lwT + ch * 68 + wv * 8), l1 = *(const f32x4*)(lwT + ch * 68 + wv * 8 + 4);
#pragma unroll
                for (int e = 0; e < 4; ++e) { lw[e] = l0[e]; lw[e + 4] = l1[e]; }
#pragma unroll
                for (int e = 0; e < 8; ++e) av[e] = aT[(wv * 8 + e) * 68 + ch];
            }
            float run = 0.f;
#pragma unroll
            for (int e = 0; e < 8; ++e) { run += lw[e]; cum[e] = run; }
            gt[wv * 64 + ch] = run;
            __syncthreads();
            float offs = 0.f, tot = 0.f;
#pragma unroll
            for (int g2 = 0; g2 < 8; ++g2) { const float gv = gt[g2 * 64 + ch]; offs += g2 < wv ? gv : 0.f; tot += gv; }
            if (wv == 0) gammaC[ch] = __expf(tot);
            const float kkc = p.k_k[cg], kac = p.k_a[cg];
            float at_[8], kt_[8], bt_[8], vt_[8];
#pragma unroll
            for (int e = 0; e < 8; ++e) {
                const int i = wv * 8 + e;
                const float xr = bf2f(RBUF(8)[i * LS + ch]), xk = bf2f(RBUF(9)[i * LS + ch]), xv = bf2f(RBUF(10)[i * LS + ch]);
                const float cm = cum[e] + offs;
                const float kk = xk * kkc * gt[576 + i];
                const float kq = xk * (1.0f + (av[e] - 1.0f) * kac);
                if (c * 64 + i < L) p.orw[(tok0 + i) * 512 + h * 64 + ch] = RBUF(10)[i * LS + ch];
                const float eneg = __expf(-cm), epos = __expf(cm), eexc = __expf(cm - lw[e]);
                at_[e] = -kk * eexc; kt_[e] = kq * eneg; bt_[e] = kk * av[e] * eneg; vt_[e] = xv;
                RBUF(3)[i * LS + ch] = f2bf(xr * epos);
            }
            __syncthreads();
#pragma unroll
            for (int e = 0; e < 8; ++e) {
                const int i = wv * 8 + e;
                RBUF(0)[i * LS + ch] = f2bf(at_[e]); RBUF(1)[i * LS + ch] = f2bf(kt_[e]); RBUF(2)[i * LS + ch] = f2bf(bt_[e]);
            }
            *(u32x4*)(RBUF(11) + ch * LS + wv * 8) = (u32x4){pack2(kt_[0], kt_[1]), pack2(kt_[2], kt_[3]), pack2(kt_[4], kt_[5]), pack2(kt_[6], kt_[7])};
            *(u32x4*)(RBUF(12) + ch * LS + wv * 8) = (u32x4){pack2(bt_[0], bt_[1]), pack2(bt_[2], bt_[3]), pack2(bt_[4], bt_[5]), pack2(bt_[6], bt_[7])};
            *(u32x4*)(RBUF(13) + ch * LS + wv * 8) = (u32x4){pack2(vt_[0], vt_[1]), pack2(vt_[2], vt_[3]), pack2(vt_[4], vt_[5]), pack2(vt_[6], vt_[7])};
            *(u32x4*)(Xt0 + ch * LS + wv * 8) = (u32x4){pack2(at_[0], at_[1]), pack2(at_[2], at_[3]), pack2(at_[4], at_[5]), pack2(at_[6], at_[7])};
        }
        __syncthreads();
#pragma unroll
        for (int prod = 0; prod < 5; ++prod) {
            const bf16_t* F = prod == 0 ? RBUF(1) : prod == 1 ? RBUF(2) : prod == 2 ? RBUF(0) : prod == 3 ? RBUF(1) : RBUF(2);
            const bf16_t* S = prod == 0 ? RBUF(0) : prod == 1 ? RBUF(0) : prod == 2 ? RBUF(2) : RBUF(3);
            bf16_t* O = prod == 0 ? RBUF(6) : prod == 1 ? RBUF(7) : prod == 2 ? RBUF(8) : prod == 3 ? RBUF(9) : RBUF(10);
            const int mode = prod < 2 ? 0 : prod == 2 ? 2 : 1;
#pragma unroll
            for (int rep = 0; rep < 2; ++rep) {
                const int tl = wv + 8 * rep, pt = tl >> 2, qt = tl & 3;
                f32x4 acc = zero;
                if (mode == 2 ? pt >= qt : pt <= qt) acc = mm16<64>(F + pt * 16 * LS, LS, S + qt * 16 * LS, LS, zero, lane);
                const int qi = qt * 16 + fr;
#pragma unroll
                for (int e = 0; e < 4; ++e) {
                    const int pi = pt * 16 + fq * 4 + e;
                    const bool keep = mode == 0 ? pi < qi : (mode == 1 ? pi <= qi : qi < pi);
                    acc[e] = keep ? acc[e] : 0.f;
                }
                *(u32x2*)(O + qi * LS + pt * 16 + fq * 4) = pk4(acc);
            }
        }
        __syncthreads();
        f32x4 X[4];
        if (wv < 4) {
#pragma unroll
            for (int pt = 0; pt < 4; ++pt) X[pt] = up4(*(const u32x2*)(Xt0 + (wv * 16 + fr) * LS + pt * 16 + fq * 4));
        } else {
#pragma unroll
            for (int pt = 0; pt < 4; ++pt) {
                X[pt] = mm16<64>(RBUF(6) + pt * 16 * LS, LS, RBUF(13) + (wv - 4) * 16 * LS, LS, zero, lane);
                *(u32x2*)(Xt0 + (wv * 16 + fr) * LS + pt * 16 + fq * 4) = pk4(X[pt]);
            }
        }
        __syncthreads();
#pragma unroll
        for (int k = 0; k < 6; ++k) {
            const bf16_t* Mk = (k & 1) ? RBUF(0) : RBUF(7);
            const bf16_t* Mkt = (k & 1) ? RBUF(6) : RBUF(8);
            bf16_t* Mn = (k & 1) ? RBUF(7) : RBUF(0);
            bf16_t* Mnt = (k & 1) ? RBUF(8) : RBUF(6);
            const bf16_t* Xc = (k & 1) ? Xt1 : Xt0;
            bf16_t* Xn = (k & 1) ? Xt0 : Xt1;
#pragma unroll
            for (int pt = 0; pt < 4; ++pt) {
                constexpr int dummy = 0; (void)dummy;
                const int maxj = 16 * pt + 15 - (1 << k);
                if (maxj >= 0) {
                    const int nks = maxj / 32 + 1;
#pragma unroll
                    for (int ks = 0; ks < 2; ++ks)
                        if (ks < nks) {
                            const bf16x8 f = *(const bf16x8*)(Mk + (pt * 16 + fr) * LS + ks * 32 + fq * 8);
                            const bf16x8 g = *(const bf16x8*)(Xc + (wv * 16 + fr) * LS + ks * 32 + fq * 8);
                            X[pt] = __builtin_amdgcn_mfma_f32_16x16x32_bf16(f, g, X[pt], 0, 0, 0);
                        }
                }
                *(u32x2*)(Xn + (wv * 16 + fr) * LS + pt * 16 + fq * 4) = pk4(X[pt]);
            }
            if (k < 5) {
#pragma unroll
                for (int which = 0; which < 2; ++which) {
                    const bf16_t* F = which ? Mk : Mkt; const bf16_t* S = which ? Mkt : Mk; bf16_t* O = which ? Mnt : Mn;
#pragma unroll
                    for (int rep = 0; rep < 2; ++rep) {
                        const int t2 = wv + 8 * rep, pt = t2 >> 2, qt = t2 & 3;
                        const int it = which ? pt : qt, jt = which ? qt : pt;
                        f32x4 acc = zero;
                        const int mlo = 16 * jt + (1 << k), mhi = 16 * it + 15 - (1 << k);
                        if (16 * it + 15 - 16 * jt >= (2 << k) && mhi >= mlo) {
                            const int k0 = mlo >> 5, k1 = mhi >> 5;
                            for (int ks = k0; ks <= k1; ++ks) {
                                const bf16x8 f = *(const bf16x8*)(F + (pt * 16 + fr) * LS + ks * 32 + fq * 8);
                                const bf16x8 g = *(const bf16x8*)(S + (qt * 16 + fr) * LS + ks * 32 + fq * 8);
                                acc = __builtin_amdgcn_mfma_f32_16x16x32_bf16(f, g, acc, 0, 0, 0);
                            }
                        }
                        *(u32x2*)(O + (qt * 16 + fr) * LS + pt * 16 + fq * 4) = pk4(acc);
                    }
                }
            }
            __syncthreads();
        }
#pragma unroll
        for (int rep = 0; rep < 2; ++rep) {
            const int tl = wv + 8 * rep, pt = tl >> 2, qt = tl & 3;
            const int pi0 = pt * 16 + fq * 4, qi = qt * 16 + fr;
            const size_t go = ((size_t)u * 64 + qi) * 64 + pi0;
            {
                f32x4 acc = mm16<64>(Xt0 + pt * 16 * LS, LS, RBUF(12) + qt * 16 * LS, LS, zero, lane);
                const float gc = gammaC[qi];
#pragma unroll
                for (int e = 0; e < 4; ++e) acc[e] = (acc[e] + (pi0 + e == qi ? 1.f : 0.f)) * gc;
                {
                    const size_t d = (((size_t)u * 8 + (qi >> 5) * 4 + (pi0 >> 4)) * 64 + (qi & 31) + 32 * ((pi0 >> 2) & 1)) * 8 + ((pi0 >> 3) & 1) * 4;
                    *(u32x2*)(p.PcG + d) = pk4(acc);
                }
            }
            {
                f32x4 acc = mm16<64>(RBUF(11) + pt * 16 * LS, LS, RBUF(13) + qt * 16 * LS, LS, zero, lane);
                acc = mm16<64>(RBUF(12) + pt * 16 * LS, LS, Xt0 + (64 + qt * 16) * LS, LS, acc, lane);
                const f32x4 gc = *(const f32x4*)(gammaC + pi0);
#pragma unroll
                for (int e = 0; e < 4; ++e) acc[e] *= gc[e];
                {
                    const int kk = pi0 & 31;
                    const size_t d = (((size_t)u * 4 + (qi >> 5) * 2 + (pi0 >> 5)) * 64 + (qi & 31) + 32 * ((kk >> 2) & 1)) * 16 + (kk >> 3) * 4;
                    *(u32x2*)(p.QcG + d) = pk4(acc);
                }
            }
            {
                f32x4 acc = mm16<64>(Xt0 + pt * 16 * LS, LS, RBUF(10) + qt * 16 * LS, LS, zero, lane);
                const f32x4 rr = up4(*(const u32x2*)(RBUF(3) + qi * LS + pi0));
#pragma unroll
                for (int e = 0; e < 4; ++e) acc[e] += rr[e];
                *(u32x2*)(p.RhG + go) = pk4(acc);
            }
            {
                f32x4 acc = mm16<64>(RBUF(13) + pt * 16 * LS, LS, RBUF(9) + qt * 16 * LS, LS, zero, lane);
                acc = mm16<64>(Xt0 + (64 + pt * 16) * LS, LS, RBUF(10) + qt * 16 * LS, LS, acc, lane);
                *(u32x2*)(p.Y0G + go) = pk4(acc);
            }
        }
    }
}

struct R2Set { u32x4 a[8]; u32x4 q[4]; };
DI void r2_load(R2Set& st, const Params& p, size_t u, int lane, int vh) {
#pragma unroll
    for (int kt = 0; kt < 2; ++kt) {
        const bf16_t* qg = p.QcG + ((u * 4 + vh * 2 + kt) * 64 + lane) * 16;
        st.q[kt * 2] = *(const u32x4*)qg; st.q[kt * 2 + 1] = *(const u32x4*)(qg + 8);
    }
#pragma unroll
    for (int f = 0; f < 8; ++f) st.a[f] = *(const u32x4*)(p.PcG + ((u * 8 + f) * 64 + lane) * 8);
}
DI void r2_step(f32x16 (&S)[2], const R2Set& st, const Params& p, size_t u, int lane, int vh, bool last) {
#pragma unroll
    for (int kt = 0; kt < 2; ++kt) {
        bf16_t* sg = p.SG + ((u * 4 + vh * 2 + kt) * 64 + lane) * 16;
        *(u32x4*)sg = (u32x4){pack2(S[kt][0], S[kt][1]), pack2(S[kt][2], S[kt][3]), pack2(S[kt][4], S[kt][5]), pack2(S[kt][6], S[kt][7])};
        *(u32x4*)(sg + 8) = (u32x4){pack2(S[kt][8], S[kt][9]), pack2(S[kt][10], S[kt][11]), pack2(S[kt][12], S[kt][13]), pack2(S[kt][14], S[kt][15])};
    }
    if (last) return;
    bf16x8 bfr[4];
#pragma unroll
    for (int ts = 0; ts < 4; ++ts) {
        const int tl = ts >> 1, sp = ts & 1;
        const u32x4 pk = (u32x4){pack2(S[tl][8 * sp], S[tl][8 * sp + 1]), pack2(S[tl][8 * sp + 2], S[tl][8 * sp + 3]),
                                 pack2(S[tl][8 * sp + 4], S[tl][8 * sp + 5]), pack2(S[tl][8 * sp + 6], S[tl][8 * sp + 7])};
        bfr[ts] = __builtin_bit_cast(bf16x8, pk);
    }
#pragma unroll
    for (int kt = 0; kt < 2; ++kt)
#pragma unroll
        for (int hf = 0; hf < 2; ++hf)
#pragma unroll
            for (int w = 0; w < 4; ++w) { S[kt][8 * hf + 2 * w] = lo_bf(st.q[kt * 2 + hf][w]); S[kt][8 * hf + 2 * w + 1] = hi_bf(st.q[kt * 2 + hf][w]); }
#pragma unroll
    for (int ts = 0; ts < 4; ++ts)
#pragma unroll
        for (int kt = 0; kt < 2; ++kt)
            S[kt] = __builtin_amdgcn_mfma_f32_32x32x16_bf16(__builtin_bit_cast(bf16x8, st.a[kt * 4 + ts]), bfr[ts], S[kt], 0, 0, 0);
}
DI void phase_rwkv_r2(const Params& p, int chain) {
    const int lane = tid_() & 63, wv = __builtin_amdgcn_readfirstlane(tid_() >> 6);
    if (wv != 0) return;
    const int bh = chain >> 1, vh = chain & 1;
    const size_t u0 = (size_t)bh * NCHUNK;
    f32x16 S[2];
#pragma unroll
    for (int e = 0; e < 16; ++e) { S[0][e] = 0.f; S[1][e] = 0.f; }
    R2Set A, B;
    r2_load(A, p, u0, lane, vh);
    r2_load(B, p, u0 + 1, lane, vh);
#pragma unroll 1
    for (int c = 0; c < NCHUNK; c += 2) {
        r2_step(S, A, p, u0 + c, lane, vh, c == NCHUNK - 1);
        if (c == NCHUNK - 1) break;
        if (c + 2 < NCHUNK - 1) r2_load(A, p, u0 + c + 2, lane, vh);
        r2_step(S, B, p, u0 + c + 1, lane, vh, false);
        if (c + 3 < NCHUNK - 1) r2_load(B, p, u0 + c + 3, lane, vh);
    }
}

DI void phase_rwkv_r3(const Params& p, int layer, int bid, int nb) {
    const int tid = tid_(), lane = tid & 63, wv = __builtin_amdgcn_readfirstlane(tid >> 6), fr = lane & 15, fq = lane >> 4;
    for (int task = bid * 8 + wv; task < NUNIT * 4; task += nb * 8) {
        const int u = task >> 2, it = task & 3;
        const int c = u % NCHUNK, bh = u / NCHUNK, h = bh % HEADS, bb = bh / HEADS;
        const int i = it * 16 + fr, t = c * 64 + i;
        const size_t tok = (size_t)bb * L + t;
        bf16x8 sf[2];
#pragma unroll
        for (int ks = 0; ks < 2; ++ks) sf[ks] = *(const bf16x8*)(p.RhG + ((size_t)u * 64 + i) * 64 + ks * 32 + fq * 8);
        f32x4 y[4];
#pragma unroll
        for (int vt = 0; vt < 4; ++vt) {
            y[vt] = up4(*(const u32x2*)(p.Y0G + ((size_t)u * 64 + i) * 64 + vt * 16 + fq * 4));
#pragma unroll
            for (int ks = 0; ks < 2; ++ks) {
                const int vv = vt * 16 + fr;
                const bf16_t* sp = p.SG + (((size_t)u * 4 + (vv >> 5) * 2 + ks) * 64 + (vv & 31)) * 16 + 4 * fq;
                const u32x2 s0 = *(const u32x2*)sp, s1 = *(const u32x2*)(sp + 32 * 16);
                const bf16x8 f = __builtin_bit_cast(bf16x8, ((u32x4){s0[0], s0[1], s1[0], s1[1]}));
                y[vt] = __builtin_amdgcn_mfma_f32_16x16x32_bf16(f, sf[ks], y[vt], 0, 0, 0);
            }
        }
        float s = 0.f;
#pragma unroll
        for (int vt = 0; vt < 4; ++vt) s += (y[vt][0] + y[vt][1]) + (y[vt][2] + y[vt][3]);
        s += __shfl_xor(s, 16); s += __shfl_xor(s, 32);
        const float mean = s * (1.0f / 64.f);
        float q = 0.f;
#pragma unroll
        for (int vt = 0; vt < 4; ++vt)
#pragma unroll
            for (int e = 0; e < 4; ++e) { y[vt][e] -= mean; q += y[vt][e] * y[vt][e]; }
        q += __shfl_xor(q, 16); q += __shfl_xor(q, 32);
        const float rstd = rsqrtf(q * (1.0f / 64.f) + 64e-5f);
        if (t < L) {
            const float bon = p.bonG[(size_t)u * 64 + i];
#pragma unroll
            for (int vt = 0; vt < 4; ++vt) {
                const int v0 = vt * 16 + fq * 4, cg = h * 64 + v0;
                const f32x4 xv = up4(*(const u32x2*)(p.orw + tok * 512 + cg));
                const f32x4 g = up4(*(const u32x2*)(p.GG + ((size_t)u * 64 + i) * 64 + v0));
                const f32x4 lg = *(const f32x4*)(p.lnx_g + layer * 512 + cg), lb = *(const f32x4*)(p.lnx_b + layer * 512 + cg);
                f32x4 o;
#pragma unroll
                for (int e = 0; e < 4; ++e) {
                    o[e] = (y[vt][e] * rstd * lg[e] + lb[e] + bon * xv[e]) * g[e];
                }
                *(u32x2*)(p.orw + tok * 512 + cg) = pk4(o);
            }
        }
    }
}

constexpr int SB_LDS = 2 * RB + 64;
DI void phase_sb(const Params& p, int bid0, int nb, char* smem) {
    const int tid = tid_(), lane = tid & 63, wv = __builtin_amdgcn_readfirstlane(tid >> 6), fr = lane & 15, fq = lane >> 4;
    bf16_t* Ks = (bf16_t*)smem;
    bf16_t* Vt = Ks + 64 * LS;
    int* flags = (int*)(smem + 2 * RB);
    bf16x8 tri[4][2];
#pragma unroll
    for (int st = 0; st < 4; ++st)
#pragma unroll
        for (int k2 = 0; k2 < 2; ++k2)
#pragma unroll
            for (int jj = 0; jj < 8; ++jj) tri[st][k2][jj] = (32 * k2 + 16 * (jj >> 2) + 4 * fq + (jj & 3) > 16 * st + fr) ? (short)0x3F80 : (short)0;
    constexpr int NQB = (L + 127) / 128;
    const int ldkey = tid >> 3, lddc = (tid & 7) * 8;
    for (int u = bid0; u < NBATCH * HEADS * NQB; u += nb) {
        const int bh = u % (NBATCH * HEADS), b = bh / HEADS, h = bh % HEADS, q0 = (u / (NBATCH * HEADS)) * 128;
        const int qlo = q0 + 16 * wv, query = qlo + fr;
        const size_t tokb = (size_t)b * L;
        bf16x8 qf[2];
#pragma unroll
        for (int ks = 0; ks < 2; ++ks) qf[ks] = *(const bf16x8*)(p.P + (tokb + query) * CP + OFF_Q + h * 64 + ks * 32 + fq * 8);
        const int qmax = (q0 + 127 < L - 1) ? q0 + 127 : L - 1;
        int kt = (qmax - 1) >> 6;
        float R = 0.f;
        f32x4 ot[4];
#pragma unroll
        for (int dt = 0; dt < 4; ++dt) ot[dt] = (f32x4){0.f, 0.f, 0.f, 0.f};
        bool done = qlo >= L;
        u32x4 kreg, vreg;
        {
            const int s = kt * 64 + ldkey;
            const bf16_t* src = p.P + (tokb + s) * CP + h * 64 + lddc;
            kreg = s < L ? *(const u32x4*)(src + OFF_K) : (u32x4){0u, 0u, 0u, 0u};
            vreg = s < L ? *(const u32x4*)(src + OFF_V) : (u32x4){0u, 0u, 0u, 0u};
        }
        for (;;) {
            __syncthreads();
            *(u32x4*)(Ks + ldkey * LS + lddc) = kreg;
#pragma unroll
            for (int j = 0; j < 4; ++j) { Vt[(lddc + 2 * j) * LS + ldkey] = (bf16_t)(vreg[j] & 0xFFFFu); Vt[(lddc + 2 * j + 1) * LS + ldkey] = (bf16_t)(vreg[j] >> 16); }
            __syncthreads();
            if (kt > 0) {
                const int s = (kt - 1) * 64 + ldkey;
                const bf16_t* src = p.P + (tokb + s) * CP + h * 64 + lddc;
                kreg = *(const u32x4*)(src + OFF_K); vreg = *(const u32x4*)(src + OFF_V);
            }
            if (!done && kt * 64 < qlo + 15) {
                f32x4 uu[4], lsp[4];
                float tot = 0.f;
#pragma unroll
                for (int kk = 0; kk < 4; ++kk) {
                    f32x4 z = (f32x4){0.f, 0.f, 0.f, 0.f};
#pragma unroll
                    for (int ks = 0; ks < 2; ++ks) {
                        const bf16x8 f = *(const bf16x8*)(Ks + (16 * kk + fr) * LS + ks * 32 + fq * 8);
                        z = __builtin_amdgcn_mfma_f32_16x16x32_bf16(f, qf[ks], z, 0, 0, 0);
                    }
#pragma unroll
                    for (int e = 0; e < 4; ++e) {
                        const float zz = z[e] * 0.125f;
                        const float lsneg = -(fmaxf(zz, 0.f) + __logf(1.0f + __expf(-fabsf(zz))));
                        const bool valid = kt * 64 + 16 * kk + 4 * fq + e < query;
                        uu[kk][e] = valid ? lsneg : 0.f;
                        lsp[kk][e] = valid ? lsneg + zz : -1.0e30f;
                        tot += uu[kk][e];
                    }
                }
                tot += __shfl_xor(tot, 16); tot += __shfl_xor(tot, 32);
                f32x4 rest[4];
#pragma unroll
                for (int st = 0; st < 4; ++st) rest[st] = (f32x4){0.f, 0.f, 0.f, 0.f};
#pragma unroll
                for (int k2 = 0; k2 < 2; ++k2) {
                    u32x4 hi, lo;
#pragma unroll
                    for (int t2 = 0; t2 < 2; ++t2) {
                        const f32x4 a = uu[2 * k2 + t2];
                        const unsigned h0 = pack2(a[0], a[1]), h1 = pack2(a[2], a[3]);
                        hi[2 * t2] = h0; hi[2 * t2 + 1] = h1;
                        lo[2 * t2] = pack2(a[0] - lo_bf(h0), a[1] - hi_bf(h0)); lo[2 * t2 + 1] = pack2(a[2] - lo_bf(h1), a[3] - hi_bf(h1));
                    }
                    const bf16x8 fh = __builtin_bit_cast(bf16x8, hi), fl = __builtin_bit_cast(bf16x8, lo);
#pragma unroll
                    for (int st = 0; st < 4; ++st) {
                        rest[st] = __builtin_amdgcn_mfma_f32_16x16x32_bf16(tri[st][k2], fh, rest[st], 0, 0, 0);
                        rest[st] = __builtin_amdgcn_mfma_f32_16x16x32_bf16(tri[st][k2], fl, rest[st], 0, 0, 0);
                    }
                }
                bf16x8 af[2];
#pragma unroll
                for (int k2 = 0; k2 < 2; ++k2) {
                    u32x4 pk;
#pragma unroll
                    for (int t2 = 0; t2 < 2; ++t2) {
                        const int kk = 2 * k2 + t2;
                        float a4[4];
#pragma unroll
                        for (int e = 0; e < 4; ++e) a4[e] = __expf(lsp[kk][e] + R + rest[kk][e]);
                        pk[2 * t2] = pack2(a4[0], a4[1]); pk[2 * t2 + 1] = pack2(a4[2], a4[3]);
                    }
                    af[k2] = __builtin_bit_cast(bf16x8, pk);
                }
                R += tot;
#pragma unroll
                for (int dt = 0; dt < 4; ++dt)
#pragma unroll
                    for (int k2 = 0; k2 < 2; ++k2) {
                        const bf16_t* vp = Vt + (16 * dt + fr) * LS + 32 * k2 + 4 * fq;
                        const u32x2 v0 = *(const u32x2*)vp, v1 = *(const u32x2*)(vp + 16);
                        const bf16x8 f = __builtin_bit_cast(bf16x8, ((u32x4){v0[0], v0[1], v1[0], v1[1]}));
                        ot[dt] = __builtin_amdgcn_mfma_f32_16x16x32_bf16(f, af[k2], ot[dt], 0, 0, 0);
                    }
                done = __all((R < -104.0f) || (query >= L));
            }
            if (lane == 0) flags[wv] = done ? 1 : 0;
            __syncthreads();
            int alld = 1;
#pragma unroll
            for (int w = 0; w < 8; ++w) alld &= flags[w];
            if (alld || kt == 0) break;
            --kt;
        }
        if (query < L) {
#pragma unroll
            for (int dt = 0; dt < 4; ++dt) *(u32x2*)(p.osb + (tokb + query) * 512 + h * 64 + 16 * dt + 4 * fq) = pk4(ot[dt]);
        }
    }
}

struct EpiBranch {
    static constexpr bool PERM = true;
    const bf16_t* G; bf16_t* M; bool add;
    DI void operator()(const f32x4 (&acc)[2][2][4][2], const g8::Unit& u, int wr, int wc, int fr, int fq) const {
#pragma unroll
        for (int ai = 0; ai < 2; ++ai)
#pragma unroll
            for (int m = 0; m < 4; ++m) {
                const size_t r = (size_t)(u.pm * 256 + ai * 128 + wr * 64 + m * 16 + fr);
                const int c0 = u.pn * 256 + wc * 32 + 8 * fq;
#pragma unroll
                for (int bj = 0; bj < 2; ++bj) {
                    const u32x4 g = *(const u32x4*)(G + r * 2048 + c0 + bj * 128);
                    u32x4* mp = (u32x4*)(M + r * D + c0 + bj * 128);
                    const f32x4 v0 = acc[ai][bj][m][0], v1 = acc[ai][bj][m][1];
                    float o[8] = {lo_bf(g[0]) * v0[0], hi_bf(g[0]) * v0[1], lo_bf(g[1]) * v0[2], hi_bf(g[1]) * v0[3], lo_bf(g[2]) * v1[0], hi_bf(g[2]) * v1[1], lo_bf(g[3]) * v1[2], hi_bf(g[3]) * v1[3]};
                    if (add) {
                        const u32x4 mo = *mp;
#pragma unroll
                        for (int q = 0; q < 4; ++q) { o[2 * q] += lo_bf(mo[q]); o[2 * q + 1] += hi_bf(mo[q]); }
                    }
                    *mp = (u32x4){pack2(o[0], o[1]), pack2(o[2], o[3]), pack2(o[4], o[5]), pack2(o[6], o[7])};
                }
            }
    }
};
struct GateOrder {
    g8::DenseOrder d;
    DI bool next(int i, g8::Unit& u) const { return d.next(i, u); }
    DI unsigned row_off(const g8::Unit&, int) const { return 0u; }
};
struct EpiGate {
    static constexpr bool PERM = true;
    bf16_t* G;
    DI void operator()(const f32x4 (&acc)[2][2][4][2], const g8::Unit& u, int wr, int wc, int fr, int fq) const {
#pragma unroll
        for (int ai = 0; ai < 2; ++ai)
#pragma unroll
            for (int m = 0; m < 4; ++m) {
                bf16_t* rowp = G + (size_t)(u.pm * 256 + ai * 128 + wr * 64 + m * 16 + fr) * 2048 + u.pn * 256 + wc * 32 + 8 * fq;
#pragma unroll
                for (int bj = 0; bj < 2; ++bj) {
                    const f32x4 v0 = acc[ai][bj][m][0], v1 = acc[ai][bj][m][1];
                    *(u32x4*)(rowp + bj * 128) = (u32x4){pack2(sigmoidf_(v0[0]), sigmoidf_(v0[1])), pack2(sigmoidf_(v0[2]), sigmoidf_(v0[3])), pack2(sigmoidf_(v1[0]), sigmoidf_(v1[1])), pack2(sigmoidf_(v1[2]), sigmoidf_(v1[3]))};
                }
            }
    }
};
template <int PART> DI void phase_merge(const Params& p, int layer, int bid, int nb, char* smem) {
    const bf16_t* hb = p.hb; bf16_t* G = p.gates; bf16_t* M = p.merged;
    const bf16_t* Wg = p.WtIn + ((size_t)layer * CIN + CP) * D;
    G8_LAS unsigned char* lds = (G8_LAS unsigned char*)smem;
    if (PART == 0) {
#pragma unroll
    for (int which = 0; which < 2; ++which) {
        g8::DenseOrder S; S.init(hb, Wg + (size_t)which * 1024 * D, MFULL, D / 256, D, nb, bid);
        g8::gemm8<false>(lds, D, S, EpiGate{G + which * 1024});
    }
    }
    if (PART == 1) {
#pragma unroll
    for (int which = 0; which < 2; ++which) {
        const bf16_t* A = which ? p.orw : p.osb;
        const bf16_t* Bt = (which ? p.WtPrw : p.WtPsb) + (size_t)layer * D * 512;
        g8::DenseOrder S; S.init(A, Bt, MFULL, D / 256, 512, nb, bid);
        g8::gemm8<false>(lds, 512, S, EpiBranch{G + which * 1024, M, which != 0});
    }
    }
    for (int t = left_first(MFULL * 4 * 2, bid, nb); t < D / 128; t += nb) {
        if (PART == 0)
#pragma unroll
        for (int which = 0; which < 2; ++which) {
            bf16_t* Gw = G + which * 1024;
            gemm_tile128([=](int r) { return r < T ? hb + (size_t)r * D : (const bf16_t*)nullptr; }, Wg + (size_t)which * 1024 * D, D, D, M0_LEFT, t * 128, smem,
                         [=](int r, int c, f32x4 v) { if (r < T) *(u32x2*)(Gw + (size_t)r * 2048 + c) = (u32x2){pack2(sigmoidf_(v[0]), sigmoidf_(v[1])), pack2(sigmoidf_(v[2]), sigmoidf_(v[3]))}; });
        }
        if (PART == 1)
#pragma unroll
        for (int which = 0; which < 2; ++which) {
            const bf16_t* A = which ? p.orw : p.osb; const bf16_t* Gw = G + which * 1024;
            const bf16_t* Bt = (which ? p.WtPrw : p.WtPsb) + (size_t)layer * D * 512;
            gemm_tile128([=](int r) { return r < T ? A + (size_t)r * 512 : (const bf16_t*)nullptr; }, Bt, 512, 512, M0_LEFT, t * 128, smem,
                         [=](int r, int c, f32x4 v) {
                             if (r >= T) return;
                             const u32x2 g = *(const u32x2*)(Gw + (size_t)r * 2048 + c);
                             float o0 = lo_bf(g[0]) * v[0], o1 = hi_bf(g[0]) * v[1], o2 = lo_bf(g[1]) * v[2], o3 = hi_bf(g[1]) * v[3];
                             u32x2* mp = (u32x2*)(M + (size_t)r * D + c);
                             if (which) { const u32x2 m = *mp; o0 += lo_bf(m[0]); o1 += hi_bf(m[0]); o2 += lo_bf(m[1]); o3 += hi_bf(m[1]); }
                             *mp = (u32x2){pack2(o0, o1), pack2(o2, o3)};
                         });
        }
    }
}
struct EpiOut {
    static constexpr bool PERM = false;
    float* hmeta; float* out; const bf16_t* hb;
    DI void operator()(const f32x4 (&acc)[2][2][4][2], const g8::Unit& u, int wr, int wc, int fr, int fq) const {
#pragma unroll
        for (int ai = 0; ai < 2; ++ai)
#pragma unroll
            for (int m = 0; m < 4; ++m) {
                const int r = u.pm * 256 + ai * 128 + wr * 64 + m * 16 + fr, c0 = u.pn * 256 + wc * 32 + 4 * fq;
                float* rowp = hrow2(hmeta, out, r) + c0;
                const bf16_t* hbp = hb + (size_t)r * D + c0;
#pragma unroll
                for (int bj = 0; bj < 2; ++bj)
#pragma unroll
                    for (int n = 0; n < 2; ++n) {
                        const f32x4 h = up4(*(const u32x2*)(hbp + bj * 128 + n * 16)), v = acc[ai][bj][m][n];
                        *(f32x4*)(rowp + bj * 128 + n * 16) = (f32x4){ALPHA * h[0] + v[0], ALPHA * h[1] + v[1], ALPHA * h[2] + v[2], ALPHA * h[3] + v[3]};
                    }
            }
    }
};
DI void phase_outproj(const Params& p, int layer, int bid, int nb, char* smem) {
    const bf16_t* A = p.merged; float* const hmeta = p.hmeta; float* const outp = p.out; const bf16_t* hbres = p.hb;
    const bf16_t* Bt = p.WtOut + (size_t)layer * D * D;
    if (bid == 0 && tid_() < NE) p.counts[tid_()] = 0;
    g8::DenseOrder S; S.init(A, Bt, MFULL, D / 256, D, nb, bid);
    g8::gemm8<false>((G8_LAS unsigned char*)smem, D, S, EpiOut{hmeta, outp, hbres});
    for (int t = left_first(MFULL * 4, bid, nb); t < D / 128; t += nb)
        gemm_tile128([=](int r) { return r < T ? A + (size_t)r * D : (const bf16_t*)nullptr; }, Bt, D, D, M0_LEFT, t * 128, smem,
                     [=](int r, int c, f32x4 v) {
                         if (r >= T) return;
                         const f32x4 h = up4(*(const u32x2*)(hbres + (size_t)r * D + c));
                         *(f32x4*)(hrow2(hmeta, outp, r) + c) = (f32x4){ALPHA * h[0] + v[0], ALPHA * h[1] + v[1], ALPHA * h[2] + v[2], ALPHA * h[3] + v[3]};
                     });
}

constexpr int LN1_ROWB = 2 * D + 16;
constexpr int LN1_WAVE = 8 * LN1_ROWB;
constexpr int LN1_LDS = 8 * LN1_WAVE + 2048;
DI void phase_ln1_router(const Params& p, int layer, int bid, int nb, char* smem) {
    const int tid = tid_(), lane = tid & 63, wid = __builtin_amdgcn_readfirstlane(tid >> 6), fr = lane & 15, fq = lane >> 4;
    char* wl = smem + wid * LN1_WAVE;
    int* sel = (int*)(smem + 8 * LN1_WAVE);
    float* sgt = (float*)(smem + 8 * LN1_WAVE + 640);
    int* sbase = (int*)(smem + 8 * LN1_WAVE + 1280);
    const int nwaves = nb * 8, gw = bid * 8 + wid;
    const int base_n = T / nwaves, extra = T % nwaves;
    const int tok0 = gw * base_n + (gw < extra ? gw : extra), ntok = base_n + (gw < extra ? 1 : 0);
    const int btok0 = bid * 8 * base_n + (bid * 8 < extra ? bid * 8 : extra);
    const float* g1p = p.ln1_g + layer * D; const float* b1p = p.ln1_b + layer * D;
    __syncthreads();
    for (int g0 = 0; g0 < ntok; g0 += 4) {
        const int ng = ntok - g0 < 4 ? ntok - g0 : 4;
        float vn[16];
        { const float* hf = hrow_u(p, tok0 + g0);
#pragma unroll
          for (int j = 0; j < 4; ++j) { const f32x4 a = *(const f32x4*)(hf + 256 * j + 4 * lane); vn[4 * j] = a[0]; vn[4 * j + 1] = a[1]; vn[4 * j + 2] = a[2]; vn[4 * j + 3] = a[3]; } }
#pragma unroll 1
        for (int i = 0; i < ng; ++i) {
            const int tok = tok0 + g0 + i;
            float v[16];
#pragma unroll
            for (int q = 0; q < 16; ++q) v[q] = vn[q];
            if (i + 1 < ng) { const float* hn = hrow_u(p, tok + 1);
#pragma unroll
                for (int j = 0; j < 4; ++j) { const f32x4 a = *(const f32x4*)(hn + 256 * j + 4 * lane); vn[4 * j] = a[0]; vn[4 * j + 1] = a[1]; vn[4 * j + 2] = a[2]; vn[4 * j + 3] = a[3]; } }
            ln16(v, g1p, b1p, lane);
#pragma unroll
            for (int j = 0; j < 4; ++j) {
                const unsigned h0 = pack2(v[4 * j], v[4 * j + 1]), h1 = pack2(v[4 * j + 2], v[4 * j + 3]);
                *(u32x2*)(p.hb + (size_t)tok * D + 256 * j + 4 * lane) = (u32x2){h0, h1};
                *(u32x2*)(wl + i * LN1_ROWB + (256 * j + 4 * lane) * 2) = (u32x2){h0, h1};
                *(u32x2*)(wl + (4 + i) * LN1_ROWB + (256 * j + 4 * lane) * 2) = (u32x2){pack2(v[4 * j] - lo_bf(h0), v[4 * j + 1] - hi_bf(h0)), pack2(v[4 * j + 2] - lo_bf(h1), v[4 * j + 3] - hi_bf(h1))};
            }
        }
        asm volatile("s_waitcnt lgkmcnt(0)" ::: "memory");
        __builtin_amdgcn_wave_barrier();
        f32x4 acc = (f32x4){0.f, 0.f, 0.f, 0.f};
        const char* arow = wl + (fr & 3) * LN1_ROWB + fq * 16;
        const bf16_t* whi = p.RwHi + (size_t)fr * D + fq * 8; const bf16_t* wlo = p.RwLo + (size_t)fr * D + fq * 8;
#pragma unroll 4
        for (int ks = 0; ks < 32; ++ks) {
            const bf16x8 ah = *(const bf16x8*)(arow + ks * 64), al = *(const bf16x8*)(arow + 4 * LN1_ROWB + ks * 64);
            const bf16x8 bh = *(const bf16x8*)(whi + ks * 32), bl = *(const bf16x8*)(wlo + ks * 32);
            acc = __builtin_amdgcn_mfma_f32_16x16x32_bf16(bh, ah, acc, 0, 0, 0);
            acc = __builtin_amdgcn_mfma_f32_16x16x32_bf16(bh, al, acc, 0, 0, 0);
            acc = __builtin_amdgcn_mfma_f32_16x16x32_bf16(bl, ah, acc, 0, 0, 0);
        }
        float lg[4]; float mx = -3.0e38f;
#pragma unroll
        for (int e = 0; e < 4; ++e) { lg[e] = acc[e] + p.router_b[4 * fq + e]; mx = fmaxf(mx, lg[e]); }
        mx = fmaxf(mx, __shfl_xor(mx, 16)); mx = fmaxf(mx, __shfl_xor(mx, 32));
        float sum = 0.f;
#pragma unroll
        for (int e = 0; e < 4; ++e) { lg[e] = __expf(lg[e] - mx); sum += lg[e]; }
        sum += __shfl_xor(sum, 16); sum += __shfl_xor(sum, 32);
        const float inv = 1.0f / sum;
        float v1 = -1.f, v2 = -1.f; int i1 = 0, i2 = 0;
#pragma unroll
        for (int e = 0; e < 4; ++e) {
            const float pv = lg[e] * inv;
            if (pv > v1) { v2 = v1; i2 = i1; v1 = pv; i1 = e; } else if (pv > v2) { v2 = pv; i2 = e; }
        }
        const float sc = v1 + v2;
        float bsc = sc; int bg = fq;
#pragma unroll
        for (int m = 16; m <= 32; m <<= 1) {
            const float os = __shfl_xor(bsc, m); const int og = __shfl_xor(bg, m);
            if (os > bsc || (os == bsc && og < bg)) { bsc = os; bg = og; }
        }
        if (bg == fq && fr < ng) {
            const int li = tok0 + g0 + fr - btok0;
            const float gs = 1.0f / (v1 + v2);
            sel[li * 2] = 4 * fq + i1; sel[li * 2 + 1] = 4 * fq + i2; sgt[li * 2] = v1 * gs; sgt[li * 2 + 1] = v2 * gs;
        }
        asm volatile("s_waitcnt lgkmcnt(0)" ::: "memory");
        __builtin_amdgcn_wave_barrier();
    }
    __syncthreads();
    if (wid == 0) {
        const int nbt = 8 * base_n + ((bid * 8 + 8 <= extra) ? 8 : (bid * 8 < extra ? extra - bid * 8 : 0));
        for (int c0 = 0; c0 < nbt; c0 += 64) {
            const int li = c0 + lane; const bool on = li < nbt;
            const int e1 = on ? sel[li * 2] : -1, e2 = on ? sel[li * 2 + 1] : -1;
            const unsigned long long lt = (1ull << lane) - 1ull;
            int r1 = 0, r2 = 0, mycnt = 0;
#pragma unroll
            for (int e = 0; e < NE; ++e) {
                const unsigned long long m1 = __ballot(e1 == e), m2 = __ballot(e2 == e);
                const int c1 = __popcll(m1), c2 = __popcll(m2);
                if (e1 == e) r1 = __popcll(m1 & lt);
                if (e2 == e) r2 = c1 + __popcll(m2 & lt);
                if (lane == e) mycnt = c1 + c2;
            }
            if (lane < NE) sbase[lane] = mycnt > 0 ? atomicAdd(&p.counts[lane], mycnt) : 0;
            asm volatile("s_waitcnt vmcnt(0) lgkmcnt(0)" ::: "memory");
            __builtin_amdgcn_wave_barrier();
            if (on) {
                const int tok = btok0 + li;
                const int s1 = sbase[e1] + r1, s2 = sbase[e2] + r2;
                p.list[e1 * T + s1] = tok * 2; p.list[e2 * T + s2] = tok * 2 + 1;
                p.tokg[tok * 2] = sgt[li * 2]; p.tokg[tok * 2 + 1] = sgt[li * 2 + 1];
            }
            asm volatile("s_waitcnt lgkmcnt(0)" ::: "memory");
            __builtin_amdgcn_wave_barrier();
        }
    }
}

template <bool UP> struct MoeOrder {
    const int* counts; const int* list; int G, c; const char* A; const char* B;
    DI bool next(int i, g8::Unit& u) const {
        const int Lq = i * G + c, tm = Lq >> 2;
        int start = 0, fe = -1, fs = 0, fc = 0;
#pragma unroll
        for (int e = 0; e < NE; ++e) {
            const int cn = counts[e], nt = (cn + 255) >> 8;
            const bool hit = tm >= start && tm < start + nt;
            fe = hit ? e : fe; fs = hit ? (tm - start) * 256 : fs; fc = hit ? cn : fc;
            start += nt;
        }
        fe = __builtin_amdgcn_readfirstlane(fe); fs = __builtin_amdgcn_readfirstlane(fs); fc = __builtin_amdgcn_readfirstlane(fc);
        if (fe < 0) return false;
        u.e = fe; u.slot0 = fs; u.cnt = fc; u.pm = tm; u.pn = Lq & 3;
        u.A = UP ? A : A + (size_t)tm * ((size_t)256 * DE * 2);
        u.B = UP ? B + (size_t)fe * ((size_t)1024 * 1024 * 2) + (size_t)u.pn * ((size_t)256 * D * 2) : B + (size_t)fe * ((size_t)1024 * 512 * 2) + (size_t)u.pn * ((size_t)256 * DE * 2);
        return true;
    }
    DI unsigned row_off(const g8::Unit& u, int r) const {
        const __amdgpu_buffer_rsrc_t rs = __builtin_amdgcn_make_buffer_rsrc((void*)list, 0, NE * T * 4, 0x00020000);
        const int ent = __builtin_amdgcn_raw_buffer_load_b32(rs, r * 4, (u.e * T + u.slot0) * 4, 0);
        return u.slot0 + r < u.cnt ? (unsigned)(ent >> 1) * (unsigned)(D * 2) : 0u;
    }
};
struct EpiMoeUp {
    static constexpr bool PERM = true;
    bf16_t* hid;
    DI void operator()(const f32x4 (&acc)[2][2][4][2], const g8::Unit& u, int wr, int wc, int fr, int fq) const {
#pragma unroll
        for (int ai = 0; ai < 2; ++ai)
#pragma unroll
            for (int m = 0; m < 4; ++m) {
                const int r = ai * 128 + wr * 64 + m * 16 + fr;
                if (u.slot0 + r >= u.cnt) continue;
                bf16_t* rowp = hid + ((size_t)u.pm * 256 + r) * DE + ((u.pn * 256 + wc * 32 + 8 * fq) >> 1);
#pragma unroll
                for (int bj = 0; bj < 2; ++bj) {
                    const f32x4 v0 = acc[ai][bj][m][0], v1 = acc[ai][bj][m][1];
                    *(u32x2*)(rowp + bj * 64) = (u32x2){pack2(v0[0] * sigmoidf_(v0[0]) * v0[1], v0[2] * sigmoidf_(v0[2]) * v0[3]), pack2(v1[0] * sigmoidf_(v1[0]) * v1[1], v1[2] * sigmoidf_(v1[2]) * v1[3])};
                }
            }
    }
};
struct EpiMoeDown {
    static constexpr bool PERM = true;
    bf16_t* fo; const int* list; const float* tokg;
    DI void operator()(const f32x4 (&acc)[2][2][4][2], const g8::Unit& u, int wr, int wc, int fr, int fq) const {
#pragma unroll
        for (int ai = 0; ai < 2; ++ai)
#pragma unroll
            for (int m = 0; m < 4; ++m) {
                const int sl = u.slot0 + ai * 128 + wr * 64 + m * 16 + fr;
                if (sl >= u.cnt) continue;
                const int ent = list[u.e * T + sl];
                const float g = tokg[ent];
                bf16_t* rowp = fo + ((size_t)(ent & 1) * TP + (ent >> 1)) * D + u.pn * 256 + wc * 32 + 8 * fq;
#pragma unroll
                for (int bj = 0; bj < 2; ++bj) {
                    const f32x4 v0 = acc[ai][bj][m][0], v1 = acc[ai][bj][m][1];
                    *(u32x4*)(rowp + bj * 128) = (u32x4){pack2(g * v0[0], g * v0[1]), pack2(g * v0[2], g * v0[3]), pack2(g * v1[0], g * v1[1]), pack2(g * v1[2], g * v1[3])};
                }
            }
    }
};
DI void phase_moe_up(const Params& p, int bid, int nb, char* smem) {
    const MoeOrder<true> S{p.counts, p.list, nb, bid, (const char*)p.hb, (const char*)p.WtGU};
    g8::gemm8<true>((G8_LAS unsigned char*)smem, D, S, EpiMoeUp{p.hid});
}
DI void phase_moe_down(const Params& p, int bid, int nb, char* smem) {
    const MoeOrder<false> S{p.counts, p.list, nb, bid, (const char*)p.hid, (const char*)p.WtD};
    g8::gemm8<false>((G8_LAS unsigned char*)smem, DE, S, EpiMoeDown{p.fo, p.list, p.tokg});
}
DI void phase_ln2(const Params& p, int layer, int bid, int nb) {
    const int lane = tid_() & 63, wid = __builtin_amdgcn_readfirstlane(tid_() >> 6);
    const int nwaves = nb * 8, gw = bid * 8 + wid, base_n = T / nwaves, extra = T % nwaves;
    const int tok0 = gw * base_n + (gw < extra ? gw : extra), ntok = base_n + (gw < extra ? 1 : 0);
    u32x2 an[4], f0n[4], f1n[4];
    {
#pragma unroll
        for (int j = 0; j < 4; ++j) {
            an[j] = *(const u32x2*)(p.hb + (size_t)tok0 * D + 256 * j + 4 * lane);
            f0n[j] = *(const u32x2*)(p.fo + (size_t)tok0 * D + 256 * j + 4 * lane); f1n[j] = *(const u32x2*)(p.fo + ((size_t)TP + tok0) * D + 256 * j + 4 * lane);
        }
    }
#pragma unroll 1
    for (int i = 0; i < ntok; ++i) {
        const int tok = tok0 + i;
        float v[16];
#pragma unroll
        for (int j = 0; j < 4; ++j) {
            v[4 * j] = ALPHA * lo_bf(an[j][0]) + lo_bf(f0n[j][0]) + lo_bf(f1n[j][0]); v[4 * j + 1] = ALPHA * hi_bf(an[j][0]) + hi_bf(f0n[j][0]) + hi_bf(f1n[j][0]);
            v[4 * j + 2] = ALPHA * lo_bf(an[j][1]) + lo_bf(f0n[j][1]) + lo_bf(f1n[j][1]); v[4 * j + 3] = ALPHA * hi_bf(an[j][1]) + hi_bf(f0n[j][1]) + hi_bf(f1n[j][1]);
        }
        if (i + 1 < ntok) {
#pragma unroll
            for (int j = 0; j < 4; ++j) {
                an[j] = *(const u32x2*)(p.hb + (size_t)(tok + 1) * D + 256 * j + 4 * lane);
                f0n[j] = *(const u32x2*)(p.fo + (size_t)(tok + 1) * D + 256 * j + 4 * lane); f1n[j] = *(const u32x2*)(p.fo + ((size_t)TP + tok + 1) * D + 256 * j + 4 * lane);
            }
        }
        ln16(v, p.ln2_g + layer * D, p.ln2_b + layer * D, lane);
        if (layer == DEPTH - 1) {
            float* of = hrow_u(p, tok);
#pragma unroll
            for (int j = 0; j < 4; ++j) *(f32x4*)(of + 256 * j + 4 * lane) = (f32x4){v[4 * j], v[4 * j + 1], v[4 * j + 2], v[4 * j + 3]};
        } else store_row_bf(p.hb + (size_t)tok * D, v, lane);
    }
}

extern __shared__ __attribute__((aligned(16))) char dyn_smem[];
constexpr int SMEM_MAIN = R1_LDS > GEMM_LDS ? R1_LDS : GEMM_LDS;
constexpr int SMEM_BYTES = SMEM_MAIN + 16;

__global__ void __launch_bounds__(NTHR, 2) k_forward(Params p) {
    const int bid = blockIdx.x, nb = gridDim.x;
    char* smem = dyn_smem;
    uint4* xbw = (uint4*)(dyn_smem + SMEM_MAIN);
    if (threadIdx.x == 0) *xbw = make_uint4(0u, 0u, 0u, 0u);
    __syncthreads();
    XcdBarrier bar = xcd_barrier_post(p.bar, (volatile LAS unsigned*)xbw);
    phase_prologue_weights(p, bid, nb, smem);
    phase_embed(p, bid, nb);
    xcd_barrier(bar);
    for (int l = 0; l < DEPTH; ++l) {
        phase_inproj(p, l, bid, nb, smem);
        xcd_barrier(bar);
        phase_rwkv_r1<0>(p, l, bid, nb, smem);
        xcd_barrier(bar);
        if (bid < 32) phase_rwkv_r2(p, bid);
        else {
            const int sbid = bid - 32, snb = nb - 32, heavy = (NBATCH * HEADS * ((L + 127) / 128)) % snb;
            if (sbid >= heavy && sbid < heavy + NBATCH * HEADS) phase_rwkv_r1<1>(p, l, sbid - heavy, 1, smem);
            phase_sb(p, sbid, snb, smem);
        }
        xcd_barrier(bar);
        phase_rwkv_r3(p, l, bid, nb);
        convert_experts(p, l, bid, nb, smem);
        phase_merge<0>(p, l, bid, nb, smem);
        xcd_barrier(bar);
        phase_merge<1>(p, l, bid, nb, smem);
        xcd_barrier(bar);
        phase_outproj(p, l, bid, nb, smem);
        xcd_barrier(bar);
        phase_ln1_router(p, l, bid, nb, smem);
        xcd_barrier(bar);
        phase_moe_up(p, bid, nb, smem);
        xcd_barrier(bar);
        phase_moe_down(p, bid, nb, smem);
        xcd_barrier(bar);
        phase_ln2(p, l, bid, nb);
        xcd_barrier(bar);
    }
}

extern "C" void kernel_launch(void* const* d_in, const int* in_sizes, int n_in, void* d_out, int out_size, void* d_ws, size_t ws_size, hipStream_t stream) {
    (void)in_sizes; (void)n_in; (void)out_size;
    Params p;
    memset(&p, 0, sizeof(p));
    const float* const* in = (const float* const*)d_in;
    p.x = in[0]; p.meta = in[1]; p.emb_g = in[2]; p.emb_b = in[3]; p.w_in = in[4]; p.mu = in[5]; p.w0 = in[6]; p.w_up = in[7]; p.a0 = in[8]; p.a_up = in[9];
    p.g_up = in[10]; p.k_k = in[11]; p.k_a = in[12]; p.r_k = in[13]; p.lnx_g = in[14]; p.lnx_b = in[15]; p.p_sb = in[16]; p.p_rwkv = in[17]; p.w_out = in[18];
    p.ln1_g = in[19]; p.ln1_b = in[20]; p.router_w = in[21]; p.router_b = in[22]; p.ew_gate = in[23]; p.ew_up = in[24]; p.ew_down = in[25]; p.ln2_g = in[26]; p.ln2_b = in[27];
    p.out = (float*)d_out;
    char* ws = (char*)d_ws; size_t o = 0;
    auto take = [&](size_t bytes) { char* r = ws + o; o += (bytes + 255) & ~(size_t)255; return r; };
    p.bar = (unsigned*)take(XCD_BAR_WORDS * sizeof(unsigned));
    p.counts = (int*)take(256);
    p.WtIn = (bf16_t*)take((size_t)DEPTH * CIN * D * 2);
    p.WtPsb = (bf16_t*)take((size_t)DEPTH * D * 512 * 2);
    p.WtPrw = (bf16_t*)take((size_t)DEPTH * D * 512 * 2);
    p.WtOut = (bf16_t*)take((size_t)DEPTH * D * D * 2);
    p.WupT = (bf16_t*)take((size_t)DEPTH * 512 * 64 * 2);
    p.AupT = (bf16_t*)take((size_t)DEPTH * 512 * 64 * 2);
    p.GupT = (bf16_t*)take((size_t)DEPTH * 512 * 128 * 2);
    p.RwHi = (bf16_t*)take((size_t)NE * D * 2);
    p.RwLo = (bf16_t*)take((size_t)NE * D * 2);
    {
        const size_t ub = (size_t)NUNIT * 64 * 64 * 2, need_r = 6 * ub + (size_t)NUNIT * 64 * 4, need_e = (size_t)NE * 1024 * 1024 * 2 + (size_t)NE * 1024 * 512 * 2;
        char* e = take(need_r > need_e ? need_r : need_e);
        p.WtGU = (bf16_t*)e; p.WtD = (bf16_t*)(e + (size_t)NE * 1024 * 1024 * 2);
        p.PcG = (bf16_t*)e; p.QcG = (bf16_t*)(e + ub); p.RhG = (bf16_t*)(e + 2 * ub); p.Y0G = (bf16_t*)(e + 3 * ub); p.GG = (bf16_t*)(e + 4 * ub); p.SG = (bf16_t*)(e + 5 * ub);
        p.bonG = (float*)(e + 6 * ub);
    }
    p.hb = (bf16_t*)take((size_t)TP * D * 2);
    p.hmeta = (float*)take((size_t)NBATCH * NMETA * D * 4);
    p.P = (bf16_t*)take((size_t)TP * CP * 2);
    p.osb = (bf16_t*)take((size_t)TP * 512 * 2);
    p.orw = (bf16_t*)take((size_t)TP * 512 * 2);
    p.list = (int*)take((size_t)NE * T * 4);
    p.tokg = (float*)take((size_t)T * 2 * 4);
    p.gates = p.P;
    p.merged = p.P + (size_t)TP * 2048;
    p.hid = p.P;
    p.fo = p.P + (size_t)(2 * T + 16 * 256) * DE;
    if (o > ws_size) return;
    static int grid = 0;
    if (!grid) {
        int dev = 0, cus = 0, per_cu = 0;
        (void)hipGetDevice(&dev);
        (void)hipDeviceGetAttribute(&cus, hipDeviceAttributeMultiprocessorCount, dev);
        (void)hipFuncSetAttribute((const void*)k_forward, hipFuncAttributeMaxDynamicSharedMemorySize, SMEM_BYTES);
        (void)hipOccupancyMaxActiveBlocksPerMultiprocessor(&per_cu, k_forward, NTHR, SMEM_BYTES);
        grid = per_cu >= 1 ? cus : 0;
    }
    if (!grid) return;
    (void)hipMemsetAsync(p.bar, 0, XCD_BAR_WORDS * sizeof(unsigned), stream);
    hipLaunchKernelGGL(k_forward, dim3(grid), dim3(NTHR), SMEM_BYTES, stream, p);
}
```

```cpp
#include <hip/hip_runtime.h>
#include <stdint.h>
#include <string.h>

#define DI __device__ __forceinline__
typedef unsigned short bf16_t;
typedef short bf16x8 __attribute__((ext_vector_type(8)));
typedef float f32x4 __attribute__((ext_vector_type(4)));
typedef unsigned u32x4 __attribute__((ext_vector_type(4)));
typedef unsigned u32x2 __attribute__((ext_vector_type(2)));

constexpr int D = 1024, NBATCH = 2, SEQ = 8192, NMETA = 16, L = SEQ + NMETA, T = NBATCH * L, TP = 16640;
constexpr int DEPTH = 2, HEADS = 8, HD = 64;
constexpr int CIN = 5376, CP = 3328;
constexpr int OFF_Q = 0, OFF_K = 512, OFF_V = 1024, OFF_RW = 1536;
constexpr int RW_R = 0, RW_K = 512, RW_V = 1024, RW_WD = 1536, RW_AD = 1600, RW_GD = 1664, RSW = 1792;
constexpr int NE = 16, DE = 512;
constexpr float ALPHA = 1.41421356237309515f;
constexpr float DECAY_SCALE = 0.60653065971263342f;
constexpr int NTHR = 512;

#define XB_TMO      128
#define XB_XCNT(j)  (256  + 64 * (j))
#define XB_XSUB(j)  (1280 + 64 * (j))
#define XB_XGEN(j)  (2304 + 64 * (j))
#define XB_TOP      3328
#define XB_TOPGEN   3392
#define XCD_BAR_WORDS 3456
#define XB_SPIN_CAP (1u << 18)
#define LAS __attribute__((address_space(3)))

__device__ __forceinline__ unsigned xb_ld(unsigned* p)              { return __hip_atomic_load(p, __ATOMIC_RELAXED, __HIP_MEMORY_SCOPE_AGENT); }
__device__ __forceinline__ unsigned xb_add(unsigned* p, unsigned v) { return __hip_atomic_fetch_add(p, v, __ATOMIC_RELAXED, __HIP_MEMORY_SCOPE_AGENT); }
__device__ __forceinline__ unsigned xb_xcc_id() { return (unsigned)__builtin_amdgcn_s_getreg((3 << 11) | 20) & 0xFu; }
#define XB_SPIN(cond, bar) do { unsigned _sp = 0; while (cond) { __builtin_amdgcn_s_sleep(1); \
    if ((++_sp & 255u) == 0u) { if (xb_ld(&(bar)[XB_TMO])) break; if (_sp > XB_SPIN_CAP) { atomicAdd(&(bar)[XB_TMO], 1u); break; } } } } while (0)

struct XcdBarrier {
    unsigned* bar; unsigned x;
    volatile LAS unsigned* st;
};

__device__ __forceinline__ XcdBarrier xcd_barrier_post(unsigned* bar, volatile LAS unsigned* st) {
    XcdBarrier b; b.bar = bar; b.x = xb_xcc_id(); b.st = st;
    if (threadIdx.x == 0) (void)xb_add(&bar[XB_XCNT(b.x)], 1u);
    return b;
}
__device__ __forceinline__ void xcd_barrier_complete(unsigned* bar, unsigned x, unsigned& nloc, unsigned& nx) {
    const unsigned G = gridDim.x * gridDim.y * gridDim.z;
    unsigned sum, cnt, mine, sp = 0u;
    for (;;) {
        sum = 0u; cnt = 0u; mine = 0u;
#pragma unroll
        for (unsigned j = 0; j < 16; ++j) { const unsigned c = xb_ld(&bar[XB_XCNT(j)]); sum += c; cnt += (c > 0u) ? 1u : 0u; mine = (j == x) ? c : mine; }
        if (sum == G) break;
        __builtin_amdgcn_s_sleep(1);
        if ((++sp & 255u) == 0u) { if (xb_ld(&bar[XB_TMO])) break; if (sp > XB_SPIN_CAP) { atomicAdd(&bar[XB_TMO], 1u); break; } }
    }
    nloc = mine > 0u ? mine : 1u; nx = cnt > 0u ? cnt : 1u;
}

__device__ __forceinline__ void xcd_barrier(const XcdBarrier& b) {
    asm volatile("s_waitcnt vmcnt(0)" ::: "memory");
    __syncthreads();
    if (threadIdx.x == 0) {
        unsigned* bar = b.bar;
        unsigned bx = b.x; asm volatile("" : "+s"(bx));
        __builtin_amdgcn_s_waitcnt(0);
        unsigned nloc = b.st[0], nx = b.st[1];
        if (nloc == 0u) { xcd_barrier_complete(bar, bx, nloc, nx); b.st[0] = nloc; b.st[1] = nx; }
        const unsigned old = xb_add(&bar[XB_XSUB(bx)], 1u);
        const unsigned gen = old / nloc;
        if (old + 1u == (gen + 1u) * nloc) {
            __builtin_amdgcn_fence(__ATOMIC_RELEASE, "agent");
            asm volatile("s_waitcnt vmcnt(0)" ::: "memory");
            const unsigned og = xb_add(&bar[XB_TOP], 1u);
            const unsigned tg = og / nx;
            if (og + 1u == (tg + 1u) * nx) xb_add(&bar[XB_TOPGEN], 1u);
            else XB_SPIN(xb_ld(&bar[XB_TOPGEN]) == tg, bar);
            __builtin_amdgcn_fence(__ATOMIC_ACQUIRE, "agent");
            xb_add(&bar[XB_XGEN(bx)], 1u);
            asm volatile("s_waitcnt vmcnt(0)" ::: "memory");
        } else {
            XB_SPIN(xb_ld(&bar[XB_XGEN(bx)]) == gen, bar);
            __builtin_amdgcn_fence(__ATOMIC_ACQUIRE, "agent");
            asm volatile("s_waitcnt vmcnt(0)" ::: "memory");
        }
    }
    __syncthreads();
}


struct Params {
    const float *x, *meta, *emb_g, *emb_b, *w_in, *mu, *w0, *w_up, *a0, *a_up, *g_up, *k_k, *k_a, *r_k, *lnx_g, *lnx_b, *p_sb, *p_rwkv, *w_out,
        *ln1_g, *ln1_b, *router_w, *router_b, *ew_gate, *ew_up, *ew_down, *ln2_g, *ln2_b;
    float* out;
    unsigned* bar;
    int* counts;
    bf16_t *WtIn, *WtPsb, *WtPrw, *WtOut, *WtGU, *WtD, *hb, *P, *osb, *orw, *WupT, *AupT, *GupT;
    bf16_t *PcG, *QcG, *RhG, *Y0G, *GG, *SG;
    bf16_t *RwHi, *RwLo, *gleft;
    float* bonG;
    float* hmeta;
    bf16_t *gates, *merged, *hid, *fo;
    int* list;
    float* tokg;
};

DI float bf2f(bf16_t v) { return __uint_as_float((unsigned)v << 16); }
typedef __bf16 bf16x2_t __attribute__((ext_vector_type(2)));
DI bf16_t f2bf(float f) { return __builtin_bit_cast(bf16_t, (__bf16)f); }
DI unsigned pack2(float lo, float hi) { bf16x2_t v = {(__bf16)lo, (__bf16)hi}; return __builtin_bit_cast(unsigned, v); }
DI float lo_bf(unsigned u) { return __uint_as_float(u << 16); }
DI float hi_bf(unsigned u) { return __uint_as_float(u & 0xFFFF0000u); }
template <int CTRL> DI float dpp_mov(float v) { return __builtin_bit_cast(float, __builtin_amdgcn_update_dpp(0, __builtin_bit_cast(int, v), CTRL, 0xF, 0xF, true)); }
DI float sum8(float v) {
    v += dpp_mov<0xB1>(v);
    v += dpp_mov<0x4E>(v);
    v += dpp_mov<0x141>(v);
    return v;
}
DI float sum16(float v) { v = sum8(v); v += dpp_mov<0x140>(v); return v; }
DI float wave_sum(float v) { v = sum16(v); v += __shfl_xor(v, 16); v += __shfl_xor(v, 32); return v; }
struct Params;
DI const Params& kparams() {
    auto k = __builtin_amdgcn_kernarg_segment_ptr();
    asm volatile("" : "+s"(k));
    return *(const Params*)k;
}
DI int tid_() { int t = threadIdx.x; asm volatile("" : "+v"(t)); return t; }
DI float sigmoidf_(float x) { return __builtin_amdgcn_rcpf(1.0f + __expf(-x)); }
DI float tanhf_(float x) { return 1.0f - 2.0f * __builtin_amdgcn_rcpf(1.0f + __expf(2.0f * x)); }
DI void wave_sync() { asm volatile("s_waitcnt lgkmcnt(0)" ::: "memory"); __builtin_amdgcn_wave_barrier(); }

DI float* hrow2(float* hmeta, float* out, int tok) {
    const int b = tok >= L ? 1 : 0, t = tok - b * L;
    const unsigned long long am = (unsigned long long)(hmeta + (long long)(b * NMETA + t) * D), ao = (unsigned long long)(out + ((long long)b * SEQ + (t - NMETA)) * D);
    const unsigned long long m = 0ull - (unsigned long long)(t < NMETA);
    return (float*)((am & m) | (ao & ~m));
}
DI float* hrow(const Params& p, int tok) { return hrow2(p.hmeta, p.out, tok); }
DI float* hrow_u(const Params& p, int tok) { return hrow2(p.hmeta, p.out, __builtin_amdgcn_readfirstlane(tok)); }

DI void transpose_convert(const float* __restrict__ src, int ld, int K, int N, bf16_t* __restrict__ dst, int mult, int off, int bid, int nb, char* smem) {
    float* tile = (float*)smem;
    const int tk = K / 64, tn = N / 64, tid = tid_();
    for (int t = bid; t < tk * tn; t += nb) {
        const int k0 = (t / tn) * 64, n0 = (t % tn) * 64;
        __syncthreads();
#pragma unroll
        for (int i = 0; i < 2; ++i) {
            const int k = (tid >> 4) + 32 * i, n4 = (tid & 15) * 4;
            const f32x4 v = *(const f32x4*)(src + (size_t)(k0 + k) * ld + n0 + n4);
            tile[k * 65 + n4 + 0] = v[0]; tile[k * 65 + n4 + 1] = v[1]; tile[k * 65 + n4 + 2] = v[2]; tile[k * 65 + n4 + 3] = v[3];
        }
        __syncthreads();
        const int n = tid >> 3, kc = (tid & 7) * 8;
        u32x4 o;
#pragma unroll
        for (int j = 0; j < 4; ++j) o[j] = pack2(tile[(kc + 2 * j) * 65 + n], tile[(kc + 2 * j + 1) * 65 + n]);
        *(u32x4*)(dst + (size_t)((n0 + n) * mult + off) * K + k0 + kc) = o;
    }
}

DI void convert_experts(const Params& p, int layer, int bid, int nb, char* smem) {
    for (int e = 0; e < NE; ++e) {
        const size_t eo = ((size_t)layer * NE + e) * (size_t)D * DE;
        transpose_convert(p.ew_gate + eo, DE, D, DE, p.WtGU + (size_t)e * 1024 * 1024, 2, 0, bid, nb, smem);
        transpose_convert(p.ew_up + eo, DE, D, DE, p.WtGU + (size_t)e * 1024 * 1024, 2, 1, bid, nb, smem);
        transpose_convert(p.ew_down + eo, D, DE, D, p.WtD + (size_t)e * 1024 * 512, 1, 0, bid, nb, smem);
    }
}

DI void phase_prologue_weights(const Params& p, int bid, int nb, char* smem) {
    for (int i = bid * NTHR + tid_(); i < NE * D; i += nb * NTHR) {
        const int e = i / D, k = i % D;
        const float w = p.router_w[(size_t)k * NE + e];
        const bf16_t hi = f2bf(w);
        p.RwHi[i] = hi; p.RwLo[i] = f2bf(w - bf2f(hi));
    }
    for (int l = 0; l < DEPTH; ++l) {
        transpose_convert(p.w_in + (size_t)l * D * CIN, CIN, D, CIN, p.WtIn + (size_t)l * CIN * D, 1, 0, bid, nb, smem);
        transpose_convert(p.p_sb + (size_t)l * 512 * D, D, 512, D, p.WtPsb + (size_t)l * D * 512, 1, 0, bid, nb, smem);
        transpose_convert(p.p_rwkv + (size_t)l * 512 * D, D, 512, D, p.WtPrw + (size_t)l * D * 512, 1, 0, bid, nb, smem);
        transpose_convert(p.w_out + (size_t)l * D * D, D, D, D, p.WtOut + (size_t)l * D * D, 1, 0, bid, nb, smem);
        transpose_convert(p.w_up + (size_t)l * 64 * 512, 512, 64, 512, p.WupT + (size_t)l * 512 * 64, 1, 0, bid, nb, smem);
        transpose_convert(p.a_up + (size_t)l * 64 * 512, 512, 64, 512, p.AupT + (size_t)l * 512 * 64, 1, 0, bid, nb, smem);
        transpose_convert(p.g_up + (size_t)l * 128 * 512, 512, 128, 512, p.GupT + (size_t)l * 512 * 128, 1, 0, bid, nb, smem);
    }
}

DI void ln16(float (&v)[16], const float* __restrict__ g, const float* __restrict__ b, int lane) {
    float s = 0.f;
#pragma unroll
    for (int i = 0; i < 16; ++i) s += v[i];
    const float mean = wave_sum(s) * (1.0f / D);
    float q = 0.f;
#pragma unroll
    for (int i = 0; i < 16; ++i) { v[i] -= mean; q += v[i] * v[i]; }
    const float rstd = rsqrtf(wave_sum(q) * (1.0f / D) + 1e-5f);
#pragma unroll
    for (int j = 0; j < 4; ++j) {
        const f32x4 gv = *(const f32x4*)(g + 256 * j + 4 * lane), bv = *(const f32x4*)(b + 256 * j + 4 * lane);
#pragma unroll
        for (int i = 0; i < 4; ++i) v[4 * j + i] = v[4 * j + i] * rstd * gv[i] + bv[i];
    }
}
DI void store_row(float* __restrict__ hf, bf16_t* __restrict__ hb, const float (&v)[16], int lane) {
#pragma unroll
    for (int j = 0; j < 4; ++j) {
        *(f32x4*)(hf + 256 * j + 4 * lane) = (f32x4){v[4 * j], v[4 * j + 1], v[4 * j + 2], v[4 * j + 3]};
        *(u32x2*)(hb + 256 * j + 4 * lane) = (u32x2){pack2(v[4 * j], v[4 * j + 1]), pack2(v[4 * j + 2], v[4 * j + 3])};
    }
}

DI void store_row_bf(bf16_t* __restrict__ hb, const float (&v)[16], int lane) {
#pragma unroll
    for (int j = 0; j < 4; ++j) *(u32x2*)(hb + 256 * j + 4 * lane) = (u32x2){pack2(v[4 * j], v[4 * j + 1]), pack2(v[4 * j + 2], v[4 * j + 3])};
}
DI void phase_embed(const Params& p, int bid, int nb) {
    const int lane = tid_() & 63, wid = __builtin_amdgcn_readfirstlane(tid_() >> 6);
    const int nwaves = nb * 8, gw = bid * 8 + wid, base_n = T / nwaves, extra = T % nwaves;
    const int tok0 = gw * base_n + (gw < extra ? gw : extra), ntok = base_n + (gw < extra ? 1 : 0);
    auto srcrow = [&](int tok) -> const float* {
        const int tk = __builtin_amdgcn_readfirstlane(tok), b = tk >= L ? 1 : 0, t = tk - b * L;
        const unsigned long long am = (unsigned long long)(p.meta + (long long)t * D), ao = (unsigned long long)(p.x + ((long long)b * SEQ + (t - NMETA)) * D);
        const unsigned long long m = 0ull - (unsigned long long)(t < NMETA);
        return (const float*)((am & m) | (ao & ~m));
    };
    f32x4 an[4];
    { const float* src = srcrow(tok0);
#pragma unroll
      for (int j = 0; j < 4; ++j) an[j] = *(const f32x4*)(src + 256 * j + 4 * lane); }
#pragma unroll 1
    for (int i = 0; i < ntok; ++i) {
        const int tok = tok0 + i;
        float v[16];
#pragma unroll
        for (int j = 0; j < 4; ++j) { v[4 * j] = an[j][0]; v[4 * j + 1] = an[j][1]; v[4 * j + 2] = an[j][2]; v[4 * j + 3] = an[j][3]; }
        if (i + 1 < ntok) { const float* src = srcrow(tok + 1);
#pragma unroll
            for (int j = 0; j < 4; ++j) an[j] = *(const f32x4*)(src + 256 * j + 4 * lane); }
        ln16(v, p.emb_g, p.emb_b, lane);
        store_row_bf(p.hb + (size_t)tok * D, v, lane);
    }
}

constexpr int LDT = 72;
constexpr int GEMM_LDS = 2 * 128 * LDT * 2;
template <class ARow, class Epi>
DI void gemm_tile128(ARow arow, const bf16_t* __restrict__ Bt, int ldb, int K, int m0, int n0, char* smem, Epi epi) {
    const int tid = tid_(), lane = tid & 63, wid = __builtin_amdgcn_readfirstlane(tid >> 6), fr = lane & 15, fq = lane >> 4;
    const int wr = wid >> 1, wc = wid & 1;
    bf16_t* As = (bf16_t*)smem;
    bf16_t* Bs = As + 128 * LDT;
    const bf16_t* ap[2]; const bf16_t* bp[2]; int so[2];
#pragma unroll
    for (int i = 0; i < 2; ++i) {
        const int c = tid + NTHR * i, row = c >> 3, kc = c & 7;
        const bf16_t* ar = arow(m0 + row);
        ap[i] = ar ? ar + kc * 8 : nullptr;
        bp[i] = Bt + (size_t)(n0 + row) * ldb + kc * 8;
        so[i] = row * LDT + kc * 8;
    }
    f32x4 acc[2][4];
#pragma unroll
    for (int mi = 0; mi < 2; ++mi)
#pragma unroll
        for (int ni = 0; ni < 4; ++ni) acc[mi][ni] = (f32x4){0.f, 0.f, 0.f, 0.f};
    u32x4 ra[2], rb[2];
#pragma unroll
    for (int i = 0; i < 2; ++i) { ra[i] = ap[i] ? *(const u32x4*)(ap[i]) : (u32x4){0u, 0u, 0u, 0u}; rb[i] = *(const u32x4*)(bp[i]); }
    for (int k0 = 0; k0 < K; k0 += 64) {
        __syncthreads();
#pragma unroll
        for (int i = 0; i < 2; ++i) { *(u32x4*)(As + so[i]) = ra[i]; *(u32x4*)(Bs + so[i]) = rb[i]; }
        __syncthreads();
        if (k0 + 64 < K) {
#pragma unroll
            for (int i = 0; i < 2; ++i) { ra[i] = ap[i] ? *(const u32x4*)(ap[i] + k0 + 64) : (u32x4){0u, 0u, 0u, 0u}; rb[i] = *(const u32x4*)(bp[i] + k0 + 64); }
        }
#pragma unroll
        for (int ks = 0; ks < 2; ++ks) {
            bf16x8 af[2], bf[4];
#pragma unroll
            for (int mi = 0; mi < 2; ++mi) af[mi] = *(const bf16x8*)(As + (wr * 32 + mi * 16 + fr) * LDT + ks * 32 + fq * 8);
#pragma unroll
            for (int ni = 0; ni < 4; ++ni) bf[ni] = *(const bf16x8*)(Bs + (wc * 64 + ni * 16 + fr) * LDT + ks * 32 + fq * 8);
#pragma unroll
            for (int mi = 0; mi < 2; ++mi)
#pragma unroll
                for (int ni = 0; ni < 4; ++ni) acc[mi][ni] = __builtin_amdgcn_mfma_f32_16x16x32_bf16(bf[ni], af[mi], acc[mi][ni], 0, 0, 0);
        }
    }
#pragma unroll
    for (int mi = 0; mi < 2; ++mi)
#pragma unroll
        for (int ni = 0; ni < 4; ++ni) epi(m0 + wr * 32 + mi * 16 + fr, n0 + wc * 64 + ni * 16 + fq * 4, acc[mi][ni]);
}

namespace g8 {
#define G8_LAS __attribute__((address_space(3)))
constexpr int BM = 256, BK = 64, HALF = 128, HTB = HALF * BK * 2, STAGE_BYTES = 8 * HTB, NXCD = 8, WGM = 8;
DI int lds_byte(int r, int c) { const int st = (r >> 4) * 2 + (c >> 5), rr = r & 15, cc = c & 31, ob = rr * 64 + cc * 2; return st * 1024 + (ob ^ (((ob >> 9) & 1) << 5)); }
DI void stage_rc(int b, int& R, int& C) { const int st = b / 1024, sb = b % 1024, swz = sb ^ (((sb >> 9) & 1) << 5); R = (st >> 1) * 16 + swz / 64; C = (st & 1) * 32 + (swz % 64) / 2; }
DI int perm32(int rho) { const int n = rho >> 4, i = rho & 15; return 8 * (i >> 2) + 4 * n + (i & 3); }
struct Unit { int pm, pn; const char* A; const char* B; int e, slot0, cnt; };

struct DenseOrder {
    int nM, nN, nwg, G, c; const char* A; const char* B; size_t tstep;
    DI void init(const bf16_t* A_, const bf16_t* Bt_, int nM_, int nN_, int K, int G_, int c_) { nM = nM_; nN = nN_; nwg = nM * nN; G = G_; c = c_; A = (const char*)A_; B = (const char*)Bt_; tstep = (size_t)BM * K * 2; }
    DI bool next(int i, Unit& u) const {
        const long Lq = (long)i * G + c; if (Lq >= nwg) return false;
        int wgid = (int)Lq; { const int q = nwg / NXCD, r = nwg % NXCD, xcd = wgid % NXCD, off = wgid / NXCD; wgid = (xcd < r ? xcd * (q + 1) : r * (q + 1) + (xcd - r) * q) + off; }
        const int nig = WGM * nN, gid = wgid / nig, fm = gid * WGM, gsz = (nM - fm) < WGM ? (nM - fm) : WGM;
        u.pm = fm + ((wgid % nig) % gsz); u.pn = (wgid % nig) / gsz; u.A = A + (size_t)u.pm * tstep; u.B = B + (size_t)u.pn * tstep; u.e = 0; u.slot0 = 0; u.cnt = 0; return true;
    }
    DI unsigned row_off(const Unit&, int) const { return 0u; }
};

template <bool GATHER, class Epi, class Sched>
DI void gemm8(G8_LAS unsigned char* lds, const int K, const Sched& S, const Epi& E) {
    const int tid = tid_(), wid = __builtin_amdgcn_readfirstlane(tid >> 6), lane = tid & 63, wr = wid >> 2, wc = wid & 3, fr = lane & 15, fq = lane >> 4;
    const int nt = K / BK;
    int Rr[2], Cc[2]; unsigned voffB[2], voffA[2];
#pragma unroll
    for (int i = 0; i < 2; ++i) { stage_rc(tid * 16 + i * 8192, Rr[i], Cc[i]); const int Rb = Epi::PERM ? ((Rr[i] & ~31) + perm32(Rr[i] & 31)) : Rr[i]; voffB[i] = (unsigned)(Rb * K + Cc[i]) * 2u; voffA[i] = (unsigned)(Rr[i] * K + Cc[i]) * 2u; }
    const size_t kstep = (size_t)(BK * 2), hstep = (size_t)HALF * K * 2;
    const unsigned ldsw = (unsigned)wid * 1024u;
    const int aoff = lds_byte(wr * 64 + fr, fq * 8), boff = lds_byte(wc * 32 + fr, fq * 8);
#define G8_SA(b, h) (((b) * 2 + (h)) * HTB)
#define G8_SB(b, h) ((4 + (b) * 2 + (h)) * HTB)
#define G8_STAGE(bufoff, gbase, voff) do { _Pragma("unroll") for (int _i = 0; _i < 2; ++_i) \
        __builtin_amdgcn_global_load_lds((const unsigned*)((const char*)(gbase) + (voff)[_i]), (G8_LAS unsigned*)(lds + (bufoff) + ldsw + _i * 8192), 16, 0, 0); } while (0)
#define G8_LDA(dst, b, h) do { _Pragma("unroll") for (int m = 0; m < 4; ++m) _Pragma("unroll") for (int k = 0; k < 2; ++k) dst[m][k] = *(const G8_LAS bf16x8*)(lds + G8_SA(b, h) + aoff + m * 2048 + k * 1024); } while (0)
#define G8_LDB(dst, b, h) do { _Pragma("unroll") for (int n = 0; n < 2; ++n) _Pragma("unroll") for (int k = 0; k < 2; ++k) dst[n][k] = *(const G8_LAS bf16x8*)(lds + G8_SB(b, h) + boff + n * 2048 + k * 1024); } while (0)
#define G8_MMA(ai, bj, At, Bt) do { __builtin_amdgcn_s_setprio(1); _Pragma("unroll") for (int m = 0; m < 4; ++m) _Pragma("unroll") for (int n = 0; n < 2; ++n) _Pragma("unroll") for (int k = 0; k < 2; ++k) \
        acc[ai][bj][m][n] = __builtin_amdgcn_mfma_f32_16x16x32_bf16(Bt[n][k], At[m][k], acc[ai][bj][m][n], 0, 0, 0); __builtin_amdgcn_s_setprio(0); } while (0)
#define G8_WAIT_V(n) asm volatile("s_waitcnt vmcnt(" #n ")" ::: "memory")
#define G8_WAIT_L(n) asm volatile("s_waitcnt lgkmcnt(" #n ")" ::: "memory")
#define G8_BAR __builtin_amdgcn_s_barrier()
#define G8_SCHED __builtin_amdgcn_sched_barrier(0)
#define G8_AOFF(dst, un) do { if (GATHER) { _Pragma("unroll") for (int _h = 0; _h < 2; ++_h) _Pragma("unroll") for (int _i = 0; _i < 2; ++_i) \
        dst[_h][_i] = S.row_off(un, _h * HALF + Rr[_i]) + (unsigned)Cc[_i] * 2u; } } while (0)
#define G8_STAGE_A(bufoff, gb, vo, h) do { if (GATHER) { G8_STAGE(bufoff, gb, vo[h]); } else { G8_STAGE(bufoff, (gb) + (h) * hstep, voffA); } } while (0)
    Unit cur, nxt; int ui = 0;
    if (!S.next(0, cur)) return;
    f32x4 acc[2][2][4][2];
#pragma unroll
    for (int a = 0; a < 2; ++a)
#pragma unroll
        for (int b = 0; b < 2; ++b)
#pragma unroll
            for (int m = 0; m < 4; ++m)
#pragma unroll
                for (int n = 0; n < 2; ++n) acc[a][b][m][n] = (f32x4){0.f, 0.f, 0.f, 0.f};
    bf16x8 At[4][2], B0[2][2], B1[2][2];
    unsigned cvA[2][2], nvA[2][2];
    G8_AOFF(cvA, cur);
    const char* cA = cur.A; const char* cB = cur.B;
    G8_STAGE(G8_SB(0, 0), cB, voffB); G8_STAGE_A(G8_SA(0, 0), cA, cvA, 0); G8_STAGE(G8_SB(0, 1), cB + hstep, voffB); G8_STAGE_A(G8_SA(0, 1), cA, cvA, 1);
    if (wr == 1) G8_BAR;
    G8_WAIT_V(4); G8_BAR;
    G8_STAGE(G8_SB(1, 0), cB + kstep, voffB); G8_STAGE_A(G8_SA(1, 0), cA + kstep, cvA, 0); G8_STAGE(G8_SB(1, 1), cB + hstep + kstep, voffB);
    G8_WAIT_V(6); G8_BAR;
    for (;;) {
        const bool has_next = S.next(ui + 1, nxt);
        const char* nA = has_next ? nxt.A : cA; const char* nB = has_next ? nxt.B : cB;
        if (GATHER) {
            if (has_next) { G8_AOFF(nvA, nxt); } else {
#pragma unroll
                for (int h = 0; h < 2; ++h)
#pragma unroll
                    for (int i = 0; i < 2; ++i) nvA[h][i] = cvA[h][i];
            }
        }
        for (int t = 0; t < nt; t += 2) {
            const bool last = (t == nt - 2);
            const char* a1 = cA + (size_t)(t + 1) * kstep;
            const char* a2 = last ? nA : cA + (size_t)(t + 2) * kstep; const char* b2 = last ? nB : cB + (size_t)(t + 2) * kstep;
            const char* a3 = a2 + kstep; const char* b3 = b2 + kstep;

            G8_LDB(B0, 0, 0); G8_SCHED; G8_LDA(At, 0, 0); G8_STAGE_A(G8_SA(1, 1), a1, cvA, 1);
            if (GATHER && last) {
#pragma unroll
                for (int h = 0; h < 2; ++h)
#pragma unroll
                    for (int i = 0; i < 2; ++i) cvA[h][i] = nvA[h][i];
            }
            G8_WAIT_L(8); G8_BAR; G8_WAIT_L(0); G8_MMA(0, 0, At, B0); G8_BAR; G8_SCHED;
            G8_LDB(B1, 0, 1); G8_STAGE(G8_SB(0, 0), b2, voffB);
            G8_BAR; G8_WAIT_L(0); G8_MMA(0, 1, At, B1); G8_BAR;
            G8_LDA(At, 0, 1); G8_STAGE_A(G8_SA(0, 0), a2, cvA, 0);
            G8_BAR; G8_WAIT_L(0); G8_MMA(1, 0, At, B0); G8_BAR; G8_SCHED;
            G8_STAGE(G8_SB(0, 1), b2 + hstep, voffB);
            G8_WAIT_V(6); G8_BAR; G8_MMA(1, 1, At, B1); G8_BAR;
            G8_LDB(B0, 1, 0); G8_SCHED; G8_LDA(At, 1, 0); G8_STAGE_A(G8_SA(0, 1), a2, cvA, 1);
            G8_WAIT_L(8); G8_BAR; G8_WAIT_L(0); G8_MMA(0, 0, At, B0); G8_BAR; G8_SCHED;
            G8_LDB(B1, 1, 1); G8_STAGE(G8_SB(1, 0), b3, voffB);
            G8_BAR; G8_WAIT_L(0); G8_MMA(0, 1, At, B1); G8_BAR;
            G8_LDA(At, 1, 1); G8_STAGE_A(G8_SA(1, 0), a3, cvA, 0);
            G8_BAR; G8_WAIT_L(0); G8_MMA(1, 0, At, B0); G8_BAR; G8_SCHED;
            G8_STAGE(G8_SB(1, 1), b3 + hstep, voffB);
            G8_WAIT_V(6); G8_BAR; G8_MMA(1, 1, At, B1); G8_BAR;
        }
        { int fr2 = fr, fq2 = fq; asm volatile("" : "+v"(fr2), "+v"(fq2)); E(acc, cur, wr, wc, fr2, fq2); }
        if (!has_next) break;
#pragma unroll
        for (int a = 0; a < 2; ++a)
#pragma unroll
            for (int b = 0; b < 2; ++b)
#pragma unroll
                for (int m = 0; m < 4; ++m)
#pragma unroll
                    for (int n = 0; n < 2; ++n) acc[a][b][m][n] = (f32x4){0.f, 0.f, 0.f, 0.f};
        cur = nxt; cA = nA; cB = nB; ++ui;
    }
    G8_WAIT_V(0);
    if (wr == 0) G8_BAR;
    G8_BAR;
#undef G8_SA
#undef G8_SB
#undef G8_STAGE
#undef G8_LDA
#undef G8_LDB
#undef G8_MMA
#undef G8_WAIT_V
#undef G8_WAIT_L
#undef G8_BAR
#undef G8_SCHED
#undef G8_AOFF
#undef G8_STAGE_A
}
}

constexpr int MFULL = 64, M0_LEFT = MFULL * 256;
struct EpiStore {
    static constexpr bool PERM = true;
    bf16_t* O; int ldc; bool sig;
    DI void operator()(const f32x4 (&acc)[2][2][4][2], const g8::Unit& u, int wr, int wc, int fr, int fq) const {
#pragma unroll
        for (int ai = 0; ai < 2; ++ai)
#pragma unroll
            for (int m = 0; m < 4; ++m) {
                bf16_t* rowp = O + (size_t)(u.pm * 256 + ai * 128 + wr * 64 + m * 16 + fr) * ldc + u.pn * 256 + wc * 32 + 8 * fq;
#pragma unroll
                for (int bj = 0; bj < 2; ++bj) {
                    f32x4 v0 = acc[ai][bj][m][0], v1 = acc[ai][bj][m][1];
                    if (sig) {
#pragma unroll
                        for (int e = 0; e < 4; ++e) { v0[e] = sigmoidf_(v0[e]); v1[e] = sigmoidf_(v1[e]); }
                    }
                    *(u32x4*)(rowp + bj * 128) = (u32x4){pack2(v0[0], v0[1]), pack2(v0[2], v0[3]), pack2(v1[0], v1[1]), pack2(v1[2], v1[3])};
                }
            }
    }
};
DI int left_first(int units, int bid, int nb) { return (bid - units % nb + nb) % nb; }

constexpr int LEFT_LDS = 2 * (32 + 128) * LDT * 2;
template <class ARow, class Epi>
DI void gemm_left32(ARow arow, const bf16_t* __restrict__ Bt, int ldb, int K, int n0, char* smem, Epi epi) {
    const int tid = tid_(), lane = tid & 63, wid = __builtin_amdgcn_readfirstlane(tid >> 6), fr = lane & 15, fq = lane >> 4;
    bf16_t* As = (bf16_t*)smem;
    bf16_t* Bs = As + 2 * 32 * LDT;
    const int arow_i = tid >> 4, akc = (tid & 15) * 4;
    const bf16_t* ap = arow(arow_i) + akc;
    const bf16_t* bp[2]; int bso[2];
#pragma unroll
    for (int i = 0; i < 2; ++i) { const int cc = tid + NTHR * i, row = cc >> 3, kc = cc & 7; bp[i] = Bt + (size_t)(n0 + row) * ldb + kc * 8; bso[i] = row * LDT + kc * 8; }
    const int nit = K / 64;
    u32x2 ra[4]; u32x4 rb[4][2];
#define GL_LOAD(slot, it) do { if ((it) < nit) { ra[slot] = *(const u32x2*)(ap + (it) * 64); rb[slot][0] = *(const u32x4*)(bp[0] + (it) * 64); rb[slot][1] = *(const u32x4*)(bp[1] + (it) * 64); } } while (0)
#define GL_WRITE(slot, buf) do { *(u32x2*)(As + (buf) * 32 * LDT + arow_i * LDT + akc) = ra[slot]; *(u32x4*)(Bs + (buf) * 128 * LDT + bso[0]) = rb[slot][0]; *(u32x4*)(Bs + (buf) * 128 * LDT + bso[1]) = rb[slot][1]; } while (0)
    f32x4 acc[2] = {(f32x4){0.f, 0.f, 0.f, 0.f}, (f32x4){0.f, 0.f, 0.f, 0.f}};
    GL_LOAD(0, 0); GL_LOAD(1, 1); GL_LOAD(2, 2); GL_LOAD(3, 3);
    __syncthreads();
    GL_WRITE(0, 0);
    __syncthreads();
#define GL_STEP(slot, it) do { \
        GL_LOAD(slot, (it) + 4); \
        const int buf = (it) & 1; \
        _Pragma("unroll") for (int ks = 0; ks < 2; ++ks) { \
            const bf16x8 bf = *(const bf16x8*)(Bs + buf * 128 * LDT + (wid * 16 + fr) * LDT + ks * 32 + fq * 8); \
            _Pragma("unroll") for (int mt = 0; mt < 2; ++mt) { \
                const bf16x8 af = *(const bf16x8*)(As + buf * 32 * LDT + (mt * 16 + fr) * LDT + ks * 32 + fq * 8); \
                acc[mt] = __builtin_amdgcn_mfma_f32_16x16x32_bf16(bf, af, acc[mt], 0, 0, 0); } } \
        if ((it) + 1 < nit) { GL_WRITE(((slot) + 1) & 3, buf ^ 1); } \
        __syncthreads(); } while (0)
    for (int it = 0; it < nit; it += 4) {
        GL_STEP(0, it);
        if (it + 1 < nit) GL_STEP(1, it + 1);
        if (it + 2 < nit) GL_STEP(2, it + 2);
        if (it + 3 < nit) GL_STEP(3, it + 3);
    }
#undef GL_LOAD
#undef GL_WRITE
#undef GL_STEP
#pragma unroll
    for (int mt = 0; mt < 2; ++mt) epi(mt * 16 + fr, n0 + wid * 16 + fq * 4, acc[mt]);
}

DI void phase_inproj(const Params& p, int layer, int bid, int nb, char* smem) {
    const bf16_t* hb = p.hb; bf16_t* P = p.P;
    const bf16_t* Bt = p.WtIn + (size_t)layer * CIN * D;
    g8::DenseOrder S; S.init(hb, Bt, MFULL, CP / 256, D, nb, bid);
    g8::gemm8<false>((G8_LAS unsigned char*)smem, D, S, EpiStore{P, CP, false});
    bf16_t* G = p.gleft - (size_t)M0_LEFT * 2048; const bf16_t* Wg = p.WtIn + ((size_t)layer * CIN + CP) * D;
    for (int t = left_first(MFULL * (CP / 256), bid, nb); t < CP / 128 + 2048 / 128; t += nb) {
        if (t < CP / 128)
            gemm_left32([=](int r) { return hb + (size_t)(M0_LEFT + r) * D; }, Bt, D, D, t * 128, smem,
                        [=](int r, int c, f32x4 v) { *(u32x2*)(P + (size_t)(M0_LEFT + r) * CP + c) = (u32x2){pack2(v[0], v[1]), pack2(v[2], v[3])}; });
        else
            gemm_left32([=](int r) { return hb + (size_t)(M0_LEFT + r) * D; }, Wg, D, D, (t - CP / 128) * 128, smem,
                        [=](int r, int c, f32x4 v) { *(u32x2*)(G + (size_t)(M0_LEFT + r) * 2048 + c) = (u32x2){pack2(sigmoidf_(v[0]), sigmoidf_(v[1])), pack2(sigmoidf_(v[2]), sigmoidf_(v[3]))}; });
    }
}

constexpr int NCHUNK = (L + 63) / 64, NUNIT = NBATCH * HEADS * NCHUNK;
constexpr int LS = 72, RB = 64 * LS * 2;
constexpr int R1_LDS = 16 * RB + 4096 + 7168;
#define RBUF(i) ((bf16_t*)(smem + (i) * RB))
typedef float f32x16 __attribute__((ext_vector_type(16)));

template <int KK> DI f32x4 mm16(const bf16_t* F, int ldf, const bf16_t* S, int lds_, f32x4 acc, int lane) {
    const int fr = lane & 15, fq = lane >> 4;
#pragma unroll
    for (int ks = 0; ks < KK / 32; ++ks) {
        const bf16x8 f = *(const bf16x8*)(F + fr * ldf + ks * 32 + fq * 8);
        const bf16x8 g = *(const bf16x8*)(S + fr * lds_ + ks * 32 + fq * 8);
        acc = __builtin_amdgcn_mfma_f32_16x16x32_bf16(f, g, acc, 0, 0, 0);
    }
    return acc;
}
DI u32x2 pk4(f32x4 v) { return (u32x2){pack2(v[0], v[1]), pack2(v[2], v[3])}; }
DI f32x4 up4(u32x2 v) { return (f32x4){lo_bf(v[0]), hi_bf(v[0]), lo_bf(v[1]), hi_bf(v[1])}; }

template <int MODE> DI void phase_rwkv_r1(const Params& p, int layer, int bid, int nb, char* smem) {
    const int wv = __builtin_amdgcn_readfirstlane(tid_() >> 6);
    const f32x4 zero = (f32x4){0.f, 0.f, 0.f, 0.f};
    float* lwT = (float*)RBUF(4);
    float* aT = (float*)RBUF(6);
    float* gt = (float*)(smem + 16 * RB);
    float* gammaC = gt + 512;
    bf16_t* Xt0 = RBUF(14);
    bf16_t* Xt1 = RBUF(4);
    const bf16_t* WupT = p.WupT + (size_t)layer * 512 * 64, *AupT = p.AupT + (size_t)layer * 512 * 64, *GupT = p.GupT + (size_t)layer * 512 * 128;
    float* mu = (float*)(smem + 16 * RB + 4096);
    __syncthreads();
    for (int i = tid_(); i < RSW; i += NTHR) mu[i] = p.mu[(size_t)layer * RSW + i];
    for (int it = 0;; ++it) {
        const int tid = tid_(), lane = tid & 63, fr = lane & 15, fq = lane >> 4;
        int c, bh;
        if (MODE == 0) {
            const int Lq = it * nb + bid, q = Lq >> 3, cb = (q >> 3) * 8 + (Lq & 7);
            if (cb >= NBATCH * (NCHUNK - 1)) break;
            c = cb % (NCHUNK - 1); bh = (cb / (NCHUNK - 1)) * HEADS + (q & 7);
        } else {
            if (it > 0) break;
            c = NCHUNK - 1; bh = bid;
        }
        const int u = bh * NCHUNK + c, h = bh % HEADS, bb = bh / HEADS;
        const size_t tok0 = (size_t)bb * L + c * 64;
        bf16x8 fw[2][2], fa[2][2], fg[2][4];
#pragma unroll
        for (int t2 = 0; t2 < 2; ++t2) {
            const int tl = wv * 2 + t2, pt = tl >> 2, qt = tl & 3;
#pragma unroll
            for (int ks = 0; ks < 2; ++ks) {
                fw[t2][ks] = *(const bf16x8*)(WupT + (size_t)(h * 64 + qt * 16 + fr) * 64 + ks * 32 + fq * 8);
                fa[t2][ks] = *(const bf16x8*)(AupT + (size_t)(h * 64 + pt * 16 + fr) * 64 + ks * 32 + fq * 8);
            }
        }
        __syncthreads();
        {
            u32x4 curv[7], prvv[7];
#pragma unroll
            for (int it2 = 0; it2 < 7; ++it2) {
                const int cid = tid + NTHR * it2, i = cid / 56, cc = cid % 56;
                const int col = cc < 8 ? RW_R + h * 64 + cc * 8 : cc < 16 ? RW_K + h * 64 + (cc - 8) * 8 : cc < 24 ? RW_V + h * 64 + (cc - 16) * 8 : RW_WD + (cc - 24) * 8;
                const int t = c * 64 + i;
                curv[it2] = (u32x4){0u, 0u, 0u, 0u}; prvv[it2] = (u32x4){0u, 0u, 0u, 0u};
                if (t < L) curv[it2] = *(const u32x4*)(p.P + (tok0 + i) * CP + OFF_RW + col);
                if (t < L && t > 0) prvv[it2] = *(const u32x4*)(p.P + (tok0 + i - 1) * CP + OFF_RW + col);
            }
#pragma unroll
            for (int it2 = 0; it2 < 7; ++it2) {
                const int cid = tid + NTHR * it2, i = cid / 56, cc = cid % 56;
                const int col = cc < 8 ? RW_R + h * 64 + cc * 8 : cc < 16 ? RW_K + h * 64 + (cc - 8) * 8 : cc < 24 ? RW_V + h * 64 + (cc - 16) * 8 : RW_WD + (cc - 24) * 8;
                bf16_t* dst = cc < 8 ? RBUF(8) + i * LS + cc * 8 : cc < 16 ? RBUF(9) + i * LS + (cc - 8) * 8 : cc < 24 ? RBUF(10) + i * LS + (cc - 16) * 8
                            : cc < 32 ? RBUF(0) + i * LS + (cc - 24) * 8 : cc < 40 ? RBUF(1) + i * LS + (cc - 32) * 8 : RBUF(2) + i * 136 + (cc - 40) * 8;
                const f32x4 m0 = *(const f32x4*)(mu + col), m1 = *(const f32x4*)(mu + col + 4);
                const u32x4 cur = curv[it2], prv = prvv[it2];
                float x[8];
#pragma unroll
                for (int j2 = 0; j2 < 4; ++j2) {
                    const float c0 = lo_bf(cur[j2]), c1 = hi_bf(cur[j2]), p0 = lo_bf(prv[j2]), p1 = hi_bf(prv[j2]);
                    const float mm0 = j2 < 2 ? m0[2 * j2] : m1[2 * j2 - 4], mm1 = j2 < 2 ? m0[2 * j2 + 1] : m1[2 * j2 - 3];
                    x[2 * j2] = c0 + (p0 - c0) * mm0; x[2 * j2 + 1] = c1 + (p1 - c1) * mm1;
                }
                if (cc >= 24 && cc < 32) {
#pragma unroll
                    for (int j2 = 0; j2 < 8; ++j2) x[j2] = tanhf_(x[j2]);
                } else if (cc >= 40) {
#pragma unroll
                    for (int j2 = 0; j2 < 8; ++j2) x[j2] = sigmoidf_(x[j2]);
                }
                *(u32x4*)dst = (u32x4){pack2(x[0], x[1]), pack2(x[2], x[3]), pack2(x[4], x[5]), pack2(x[6], x[7])};
            }
        }
#pragma unroll
        for (int t2 = 0; t2 < 2; ++t2)
#pragma unroll
            for (int ks = 0; ks < 4; ++ks) fg[t2][ks] = *(const bf16x8*)(GupT + (size_t)(h * 64 + ((wv * 2 + t2) >> 2) * 16 + fr) * 128 + ks * 32 + fq * 8);
        __syncthreads();
#pragma unroll
        for (int t2 = 0; t2 < 2; ++t2) {
            const int tl = wv * 2 + t2, pt = tl >> 2, qt = tl & 3;
            f32x4 aw = zero, aa = zero, ag = zero;
#pragma unroll
            for (int ks = 0; ks < 2; ++ks) {
                const bf16x8 xw = *(const bf16x8*)(RBUF(0) + (pt * 16 + fr) * LS + ks * 32 + fq * 8);
                aw = __builtin_amdgcn_mfma_f32_16x16x32_bf16(xw, fw[t2][ks], aw, 0, 0, 0);
                const bf16x8 xa = *(const bf16x8*)(RBUF(1) + (qt * 16 + fr) * LS + ks * 32 + fq * 8);
                aa = __builtin_amdgcn_mfma_f32_16x16x32_bf16(fa[t2][ks], xa, aa, 0, 0, 0);
            }
#pragma unroll
            for (int ks = 0; ks < 4; ++ks) {
                const bf16x8 xg = *(const bf16x8*)(RBUF(2) + (qt * 16 + fr) * 136 + ks * 32 + fq * 8);
                ag = __builtin_amdgcn_mfma_f32_16x16x32_bf16(fg[t2][ks], xg, ag, 0, 0, 0);
            }
            const int ch = qt * 16 + fr;
            const float w0 = p.w0[layer * 512 + h * 64 + ch];
            const f32x4 a0 = *(const f32x4*)(p.a0 + layer * 512 + h * 64 + pt * 16 + fq * 4);
            f32x4 lw, av;
#pragma unroll
            for (int e = 0; e < 4; ++e) { lw[e] = -DECAY_SCALE * sigmoidf_(w0 + aw[e]); av[e] = sigmoidf_(a0[e] + aa[e]); }
            *(f32x4*)(lwT + ch * 68 + pt * 16 + fq * 4) = lw;
            *(f32x4*)(aT + (qt * 16 + fr) * 68 + pt * 16 + fq * 4) = av;
            *(u32x2*)(p.GG + ((size_t)u * 64 + qt * 16 + fr) * 64 + pt * 16 + fq * 4) = pk4(ag);
        }
        __syncthreads();
        {
            const int i = tid >> 3, c8 = (tid & 7) * 8, cg = layer * 512 + h * 64 + c8;
            const u32x4 xr = *(const u32x4*)(RBUF(8) + i * LS + c8), xk = *(const u32x4*)(RBUF(9) + i * LS + c8);
            const f32x4 a0 = *(const f32x4*)(aT + i * 68 + c8), a1 = *(const f32x4*)(aT + i * 68 + c8 + 4);
            const f32x4 kk0 = *(const f32x4*)(p.k_k + cg), kk1 = *(const f32x4*)(p.k_k + cg + 4), ka0 = *(const f32x4*)(p.k_a + cg), ka1 = *(const f32x4*)(p.k_a + cg + 4);
            const f32x4 rk0 = *(const f32x4*)(p.r_k + cg), rk1 = *(const f32x4*)(p.r_k + cg + 4);
            float n2 = 0.f, bon = 0.f;
#pragma unroll
            for (int j = 0; j < 8; ++j) {
                const float r_ = (j & 1) ? hi_bf(xr[j >> 1]) : lo_bf(xr[j >> 1]), k_ = (j & 1) ? hi_bf(xk[j >> 1]) : lo_bf(xk[j >> 1]);
                const float a_ = j < 4 ? a0[j & 3] : a1[j & 3], kkc = j < 4 ? kk0[j & 3] : kk1[j & 3], kac = j < 4 ? ka0[j & 3] : ka1[j & 3], rkc = j < 4 ? rk0[j & 3] : rk1[j & 3];
                const float kkr = k_ * kkc;
                n2 += kkr * kkr;
                bon += r_ * (k_ * (1.0f + (a_ - 1.0f) * kac)) * rkc;
            }
            n2 = sum8(n2); bon = sum8(bon);
            if ((tid & 7) == 0) { gt[576 + i] = 1.0f / fmaxf(sqrtf(n2), 1e-12f); p.bonG[(size_t)u * 64 + i] = bon; }
        }
        __syncthreads();
        {
            const int ch = lane, cg = layer * 512 + h * 64 + ch;
            float lw[8], av[8], cum[8];
            {
                const f32x4 l0 = *(const f32x4*)(lwT + ch * 68 + wv * 8), l1 = *(const f32x4*)(lwT + ch * 68 + wv * 8 + 4);
#pragma unroll
                for (int e = 0; e < 4; ++e) { lw[e] = l0[e]; lw[e + 4] = l1[e]; }
#pragma unroll
                for (int e = 0; e < 8; ++e) av[e] = aT[(wv * 8 + e) * 68 + ch];
            }
            float run = 0.f;
#pragma unroll
            for (int e = 0; e < 8; ++e) { run += lw[e]; cum[e] = run; }
            gt[wv * 64 + ch] = run;
            __syncthreads();
            float offs = 0.f, tot = 0.f;
#pragma unroll
            for (int g2 = 0; g2 < 8; ++g2) { const float gv = gt[g2 * 64 + ch]; offs += g2 < wv ? gv : 0.f; tot += gv; }
            if (wv == 0) gammaC[ch] = __expf(tot);
            const float kkc = p.k_k[cg], kac = p.k_a[cg];
            float at_[8], kt_[8], bt_[8], vt_[8];
#pragma unroll
            for (int e = 0; e < 8; ++e) {
                const int i = wv * 8 + e;
                const float xr = bf2f(RBUF(8)[i * LS + ch]), xk = bf2f(RBUF(9)[i * LS + ch]), xv = bf2f(RBUF(10)[i * LS + ch]);
                const float cm = cum[e] + offs;
                const float kk = xk * kkc * gt[576 + i];
                const float kq = xk * (1.0f + (av[e] - 1.0f) * kac);
                if (c * 64 + i < L) p.orw[(tok0 + i) * 512 + h * 64 + ch] = RBUF(10)[i * LS + ch];
                const float eneg = __expf(-cm), epos = __expf(cm), eexc = __expf(cm - lw[e]);
                at_[e] = -kk * eexc; kt_[e] = kq * eneg; bt_[e] = kk * av[e] * eneg; vt_[e] = xv;
                RBUF(3)[i * LS + ch] = f2bf(xr * epos);
            }
            __syncthreads();
#pragma unroll
            for (int e = 0; e < 8; ++e) {
                const int i = wv * 8 + e;
                RBUF(0)[i * LS + ch] = f2bf(at_[e]); RBUF(1)[i * LS + ch] = f2bf(kt_[e]); RBUF(2)[i * LS + ch] = f2bf(bt_[e]);
            }
            *(u32x4*)(RBUF(11) + ch * LS + wv * 8) = (u32x4){pack2(kt_[0], kt_[1]), pack2(kt_[2], kt_[3]), pack2(kt_[4], kt_[5]), pack2(kt_[6], kt_[7])};
            *(u32x4*)(RBUF(12) + ch * LS + wv * 8) = (u32x4){pack2(bt_[0], bt_[1]), pack2(bt_[2], bt_[3]), pack2(bt_[4], bt_[5]), pack2(bt_[6], bt_[7])};
            *(u32x4*)(RBUF(13) + ch * LS + wv * 8) = (u32x4){pack2(vt_[0], vt_[1]), pack2(vt_[2], vt_[3]), pack2(vt_[4], vt_[5]), pack2(vt_[6], vt_[7])};
            *(u32x4*)(Xt0 + ch * LS + wv * 8) = (u32x4){pack2(at_[0], at_[1]), pack2(at_[2], at_[3]), pack2(at_[4], at_[5]), pack2(at_[6], at_[7])};
        }
        __syncthreads();
#pragma unroll
        for (int prod = 0; prod < 5; ++prod) {
            const bf16_t* F = prod == 0 ? RBUF(1) : prod == 1 ? RBUF(2) : prod == 2 ? RBUF(0) : prod == 3 ? RBUF(1) : RBUF(2);
            const bf16_t* S = prod == 0 ? RBUF(0) : prod == 1 ? RBUF(0) : prod == 2 ? RBUF(2) : RBUF(3);
            bf16_t* O = prod == 0 ? RBUF(6) : prod == 1 ? RBUF(7) : prod == 2 ? RBUF(8) : prod == 3 ? RBUF(9) : RBUF(10);
            const int mode = prod < 2 ? 0 : prod == 2 ? 2 : 1;
#pragma unroll
            for (int rep = 0; rep < 2; ++rep) {
                const int tl = wv + 8 * rep, pt = tl >> 2, qt = tl & 3;
                f32x4 acc = zero;
                if (mode == 2 ? pt >= qt : pt <= qt) acc = mm16<64>(F + pt * 16 * LS, LS, S + qt * 16 * LS, LS, zero, lane);
                const int qi = qt * 16 + fr;
#pragma unroll
                for (int e = 0; e < 4; ++e) {
                    const int pi = pt * 16 + fq * 4 + e;
                    const bool keep = mode == 0 ? pi < qi : (mode == 1 ? pi <= qi : qi < pi);
                    acc[e] = keep ? acc[e] : 0.f;
                }
                *(u32x2*)(O + qi * LS + pt * 16 + fq * 4) = pk4(acc);
            }
        }
        __syncthreads();
        f32x4 X[4];
        if (wv < 4) {
#pragma unroll
            for (int pt = 0; pt < 4; ++pt) X[pt] = up4(*(const u32x2*)(Xt0 + (wv * 16 + fr) * LS + pt * 16 + fq * 4));
        } else {
#pragma unroll
            for (int pt = 0; pt < 4; ++pt) {
                X[pt] = mm16<64>(RBUF(6) + pt * 16 * LS, LS, RBUF(13) + (wv - 4) * 16 * LS, LS, zero, lane);
                *(u32x2*)(Xt0 + (wv * 16 + fr) * LS + pt * 16 + fq * 4) = pk4(X[pt]);
            }
        }
        __syncthreads();
#pragma unroll
        for (int k = 0; k < 6; ++k) {
            const bf16_t* Mk = (k & 1) ? RBUF(0) : RBUF(7);
            const bf16_t* Mkt = (k & 1) ? RBUF(6) : RBUF(8);
            bf16_t* Mn = (k & 1) ? RBUF(7) : RBUF(0);
            bf16_t* Mnt = (k & 1) ? RBUF(8) : RBUF(6);
            const bf16_t* Xc = (k & 1) ? Xt1 : Xt0;
            bf16_t* Xn = (k & 1) ? Xt0 : Xt1;
#pragma unroll
            for (int pt = 0; pt < 4; ++pt) {
                constexpr int dummy = 0; (void)dummy;
                const int maxj = 16 * pt + 15 - (1 << k);
                if (maxj >= 0) {
                    const int nks = maxj / 32 + 1;
#pragma unroll
                    for (int ks = 0; ks < 2; ++ks)
                        if (ks < nks) {
                            const bf16x8 f = *(const bf16x8*)(Mk + (pt * 16 + fr) * LS + ks * 32 + fq * 8);
                            const bf16x8 g = *(const bf16x8*)(Xc + (wv * 16 + fr) * LS + ks * 32 + fq * 8);
                            X[pt] = __builtin_amdgcn_mfma_f32_16x16x32_bf16(f, g, X[pt], 0, 0, 0);
                        }
                }
                *(u32x2*)(Xn + (wv * 16 + fr) * LS + pt * 16 + fq * 4) = pk4(X[pt]);
            }
            if (k < 5) {
#pragma unroll
                for (int which = 0; which < 2; ++which) {
                    const bf16_t* F = which ? Mk : Mkt; const bf16_t* S = which ? Mkt : Mk; bf16_t* O = which ? Mnt : Mn;
#pragma unroll
                    for (int rep = 0; rep < 2; ++rep) {
                        const int t2 = wv + 8 * rep, pt = t2 >> 2, qt = t2 & 3;
                        const int it = which ? pt : qt, jt = which ? qt : pt;
                        f32x4 acc = zero;
                        const int mlo = 16 * jt + (1 << k), mhi = 16 * it + 15 - (1 << k);
                        if (16 * it + 15 - 16 * jt >= (2 << k) && mhi >= mlo) {
                            const int k0 = mlo >> 5, k1 = mhi >> 5;
                            for (int ks = k0; ks <= k1; ++ks) {
                                const bf16x8 f = *(const bf16x8*)(F + (pt * 16 + fr) * LS + ks * 32 + fq * 8);
                                const bf16x8 g = *(const bf16x8*)(S + (qt * 16 + fr) * LS + ks * 32 + fq * 8);
                                acc = __builtin_amdgcn_mfma_f32_16x16x32_bf16(f, g, acc, 0, 0, 0);
                            }
                        }
                        *(u32x2*)(O + (qt * 16 + fr) * LS + pt * 16 + fq * 4) = pk4(acc);
                    }
                }
            }
            __syncthreads();
        }
#pragma unroll
        for (int rep = 0; rep < 2; ++rep) {
            const int tl = wv + 8 * rep, pt = tl >> 2, qt = tl & 3;
            const int pi0 = pt * 16 + fq * 4, qi = qt * 16 + fr;
            const size_t go = ((size_t)u * 64 + qi) * 64 + pi0;
            {
                f32x4 acc = mm16<64>(Xt0 + pt * 16 * LS, LS, RBUF(12) + qt * 16 * LS, LS, zero, lane);
                const float gc = gammaC[qi];
#pragma unroll
                for (int e = 0; e < 4; ++e) acc[e] = (acc[e] + (pi0 + e == qi ? 1.f : 0.f)) * gc;
                {
                    const size_t d = (((size_t)u * 8 + (qi >> 5) * 4 + (pi0 >> 4)) * 64 + (qi & 31) + 32 * ((pi0 >> 2) & 1)) * 8 + ((pi0 >> 3) & 1) * 4;
                    *(u32x2*)(p.PcG + d) = pk4(acc);
                }
            }
            {
                f32x4 acc = mm16<64>(RBUF(11) + pt * 16 * LS, LS, RBUF(13) + qt * 16 * LS, LS, zero, lane);
                acc = mm16<64>(RBUF(12) + pt * 16 * LS, LS, Xt0 + (64 + qt * 16) * LS, LS, acc, lane);
                const f32x4 gc = *(const f32x4*)(gammaC + pi0);
#pragma unroll
                for (int e = 0; e < 4; ++e) acc[e] *= gc[e];
                {
                    const int kk = pi0 & 31;
                    const size_t d = (((size_t)u * 4 + (qi >> 5) * 2 + (pi0 >> 5)) * 64 + (qi & 31) + 32 * ((kk >> 2) & 1)) * 16 + (kk >> 3) * 4;
                    *(u32x2*)(p.QcG + d) = pk4(acc);
                }
            }
            {
                f32x4 acc = mm16<64>(Xt0 + pt * 16 * LS, LS, RBUF(10) + qt * 16 * LS, LS, zero, lane);
                const f32x4 rr = up4(*(const u32x2*)(RBUF(3) + qi * LS + pi0));
#pragma unroll
                for (int e = 0; e < 4; ++e) acc[e] += rr[e];
                *(u32x2*)(p.RhG + go) = pk4(acc);
            }
            {
                f32x4 acc = mm16<64>(RBUF(13) + pt * 16 * LS, LS, RBUF(9) + qt * 16 * LS, LS, zero, lane);
                acc = mm16<64>(Xt0 + (64 + pt * 16) * LS, LS, RBUF(10) + qt * 16 * LS, LS, acc, lane);
                *(u32x2*)(p.Y0G + go) = pk4(acc);
            }
        }
    }
}

struct R2Set { u32x4 a[8]; u32x4 q[4]; };
DI void r2_load(R2Set& st, const Params& p, size_t u, int lane, int vh) {
#pragma unroll
    for (int kt = 0; kt < 2; ++kt) {
        const bf16_t* qg = p.QcG + ((u * 4 + vh * 2 + kt) * 64 + lane) * 16;
        st.q[kt * 2] = *(const u32x4*)qg; st.q[kt * 2 + 1] = *(const u32x4*)(qg + 8);
    }
#pragma unroll
    for (int f = 0; f < 8; ++f) st.a[f] = *(const u32x4*)(p.PcG + ((u * 8 + f) * 64 + lane) * 8);
}
DI void r2_step(f32x16 (&S)[2], const R2Set& st, const Params& p, size_t u, int lane, int vh, bool last) {
#pragma unroll
    for (int kt = 0; kt < 2; ++kt) {
        bf16_t* sg = p.SG + ((u * 4 + vh * 2 + kt) * 64 + lane) * 16;
        *(u32x4*)sg = (u32x4){pack2(S[kt][0], S[kt][1]), pack2(S[kt][2], S[kt][3]), pack2(S[kt][4], S[kt][5]), pack2(S[kt][6], S[kt][7])};
        *(u32x4*)(sg + 8) = (u32x4){pack2(S[kt][8], S[kt][9]), pack2(S[kt][10], S[kt][11]), pack2(S[kt][12], S[kt][13]), pack2(S[kt][14], S[kt][15])};
    }
    if (last) return;
    bf16x8 bfr[4];
#pragma unroll
    for (int ts = 0; ts < 4; ++ts) {
        const int tl = ts >> 1, sp = ts & 1;
        const u32x4 pk = (u32x4){pack2(S[tl][8 * sp], S[tl][8 * sp + 1]), pack2(S[tl][8 * sp + 2], S[tl][8 * sp + 3]),
                                 pack2(S[tl][8 * sp + 4], S[tl][8 * sp + 5]), pack2(S[tl][8 * sp + 6], S[tl][8 * sp + 7])};
        bfr[ts] = __builtin_bit_cast(bf16x8, pk);
    }
#pragma unroll
    for (int kt = 0; kt < 2; ++kt)
#pragma unroll
        for (int hf = 0; hf < 2; ++hf)
#pragma unroll
            for (int w = 0; w < 4; ++w) { S[kt][8 * hf + 2 * w] = lo_bf(st.q[kt * 2 + hf][w]); S[kt][8 * hf + 2 * w + 1] = hi_bf(st.q[kt * 2 + hf][w]); }
#pragma unroll
    for (int ts = 0; ts < 4; ++ts)
#pragma unroll
        for (int kt = 0; kt < 2; ++kt)
            S[kt] = __builtin_amdgcn_mfma_f32_32x32x16_bf16(__builtin_bit_cast(bf16x8, st.a[kt * 4 + ts]), bfr[ts], S[kt], 0, 0, 0);
}
DI void phase_rwkv_r2(const Params& p, int chain) {
    const int lane = tid_() & 63, wv = __builtin_amdgcn_readfirstlane(tid_() >> 6);
    if (wv != 0) return;
    const int bh = chain >> 1, vh = chain & 1;
    const size_t u0 = (size_t)bh * NCHUNK;
    f32x16 S[2];
#pragma unroll
    for (int e = 0; e < 16; ++e) { S[0][e] = 0.f; S[1][e] = 0.f; }
    R2Set A, B;
    r2_load(A, p, u0, lane, vh);
    r2_load(B, p, u0 + 1, lane, vh);
#pragma unroll 1
    for (int c = 0; c < NCHUNK; c += 2) {
        r2_step(S, A, p, u0 + c, lane, vh, c == NCHUNK - 1);
        if (c == NCHUNK - 1) break;
        if (c + 2 < NCHUNK - 1) r2_load(A, p, u0 + c + 2, lane, vh);
        r2_step(S, B, p, u0 + c + 1, lane, vh, false);
        if (c + 3 < NCHUNK - 1) r2_load(B, p, u0 + c + 3, lane, vh);
    }
}

DI void phase_rwkv_r3(const Params& p, int layer, int bid, int nb) {
    const int tid = tid_(), lane = tid & 63, wv = __builtin_amdgcn_readfirstlane(tid >> 6), fr = lane & 15, fq = lane >> 4;
    for (int task = bid * 8 + wv; task < NUNIT * 4; task += nb * 8) {
        const int u = task >> 2, it = task & 3;
        const int c = u % NCHUNK, bh = u / NCHUNK, h = bh % HEADS, bb = bh / HEADS;
        const int i = it * 16 + fr, t = c * 64 + i;
        const size_t tok = (size_t)bb * L + t;
        bf16x8 sf[2];
#pragma unroll
        for (int ks = 0; ks < 2; ++ks) sf[ks] = *(const bf16x8*)(p.RhG + ((size_t)u * 64 + i) * 64 + ks * 32 + fq * 8);
        f32x4 y[4];
#pragma unroll
        for (int vt = 0; vt < 4; ++vt) {
            y[vt] = up4(*(const u32x2*)(p.Y0G + ((size_t)u * 64 + i) * 64 + vt * 16 + fq * 4));
#pragma unroll
            for (int ks = 0; ks < 2; ++ks) {
                const int vv = vt * 16 + fr;
                const bf16_t* sp = p.SG + (((size_t)u * 4 + (vv >> 5) * 2 + ks) * 64 + (vv & 31)) * 16 + 4 * fq;
                const u32x2 s0 = *(const u32x2*)sp, s1 = *(const u32x2*)(sp + 32 * 16);
                const bf16x8 f = __builtin_bit_cast(bf16x8, ((u32x4){s0[0], s0[1], s1[0], s1[1]}));
                y[vt] = __builtin_amdgcn_mfma_f32_16x16x32_bf16(f, sf[ks], y[vt], 0, 0, 0);
            }
        }
        float s = 0.f;
#pragma unroll
        for (int vt = 0; vt < 4; ++vt) s += (y[vt][0] + y[vt][1]) + (y[vt][2] + y[vt][3]);
        s += __shfl_xor(s, 16); s += __shfl_xor(s, 32);
        const float mean = s * (1.0f / 64.f);
        float q = 0.f;
#pragma unroll
        for (int vt = 0; vt < 4; ++vt)
#pragma unroll
            for (int e = 0; e < 4; ++e) { y[vt][e] -= mean; q += y[vt][e] * y[vt][e]; }
        q += __shfl_xor(q, 16); q += __shfl_xor(q, 32);
        const float rstd = rsqrtf(q * (1.0f / 64.f) + 64e-5f);
        if (t < L) {
            const float bon = p.bonG[(size_t)u * 64 + i];
#pragma unroll
            for (int vt = 0; vt < 4; ++vt) {
                const int v0 = vt * 16 + fq * 4, cg = h * 64 + v0;
                const f32x4 xv = up4(*(const u32x2*)(p.orw + tok * 512 + cg));
                const f32x4 g = up4(*(const u32x2*)(p.GG + ((size_t)u * 64 + i) * 64 + v0));
                const f32x4 lg = *(const f32x4*)(p.lnx_g + layer * 512 + cg), lb = *(const f32x4*)(p.lnx_b + layer * 512 + cg);
                f32x4 o;
#pragma unroll
                for (int e = 0; e < 4; ++e) {
                    o[e] = (y[vt][e] * rstd * lg[e] + lb[e] + bon * xv[e]) * g[e];
                }
                *(u32x2*)(p.orw + tok * 512 + cg) = pk4(o);
            }
        }
    }
}

constexpr int SB_LDS = 2 * RB + 64;
DI void phase_sb(const Params& p, int bid0, int nb, char* smem) {
    const int tid = tid_(), lane = tid & 63, wv = __builtin_amdgcn_readfirstlane(tid >> 6), fr = lane & 15, fq = lane >> 4;
    bf16_t* Ks = (bf16_t*)smem;
    bf16_t* Vt = Ks + 64 * LS;
    int* flags = (int*)(smem + 2 * RB);
    bf16x8 tri[4][2];
#pragma unroll
    for (int st = 0; st < 4; ++st)
#pragma unroll
        for (int k2 = 0; k2 < 2; ++k2)
#pragma unroll
            for (int jj = 0; jj < 8; ++jj) tri[st][k2][jj] = (32 * k2 + 16 * (jj >> 2) + 4 * fq + (jj & 3) > 16 * st + fr) ? (short)0x3F80 : (short)0;
    constexpr int NQB = (L + 127) / 128;
    const int ldkey = tid >> 3, lddc = (tid & 7) * 8;
    for (int u = bid0; u < NBATCH * HEADS * NQB; u += nb) {
        const int bh = u % (NBATCH * HEADS), b = bh / HEADS, h = bh % HEADS, q0 = (u / (NBATCH * HEADS)) * 128;
        const int qlo = q0 + 16 * wv, query = qlo + fr;
        const size_t tokb = (size_t)b * L;
        bf16x8 qf[2];
#pragma unroll
        for (int ks = 0; ks < 2; ++ks) qf[ks] = *(const bf16x8*)(p.P + (tokb + query) * CP + OFF_Q + h * 64 + ks * 32 + fq * 8);
        const int qmax = (q0 + 127 < L - 1) ? q0 + 127 : L - 1;
        int kt = (qmax - 1) >> 6;
        float R = 0.f;
        f32x4 ot[4];
#pragma unroll
        for (int dt = 0; dt < 4; ++dt) ot[dt] = (f32x4){0.f, 0.f, 0.f, 0.f};
        bool done = qlo >= L;
        u32x4 kreg, vreg;
        {
            const int s = kt * 64 + ldkey;
            const bf16_t* src = p.P + (tokb + s) * CP + h * 64 + lddc;
            kreg = s < L ? *(const u32x4*)(src + OFF_K) : (u32x4){0u, 0u, 0u, 0u};
            vreg = s < L ? *(const u32x4*)(src + OFF_V) : (u32x4){0u, 0u, 0u, 0u};
        }
        for (;;) {
            __syncthreads();
            *(u32x4*)(Ks + ldkey * LS + lddc) = kreg;
#pragma unroll
            for (int j = 0; j < 4; ++j) { Vt[(lddc + 2 * j) * LS + ldkey] = (bf16_t)(vreg[j] & 0xFFFFu); Vt[(lddc + 2 * j + 1) * LS + ldkey] = (bf16_t)(vreg[j] >> 16); }
            __syncthreads();
            if (kt > 0) {
                const int s = (kt - 1) * 64 + ldkey;
                const bf16_t* src = p.P + (tokb + s) * CP + h * 64 + lddc;
                kreg = *(const u32x4*)(src + OFF_K); vreg = *(const u32x4*)(src + OFF_V);
            }
            if (!done && kt * 64 < qlo + 15) {
                f32x4 uu[4], lsp[4];
                float tot = 0.f;
#pragma unroll
                for (int kk = 0; kk < 4; ++kk) {
                    f32x4 z = (f32x4){0.f, 0.f, 0.f, 0.f};
#pragma unroll
                    for (int ks = 0; ks < 2; ++ks) {
                        const bf16x8 f = *(const bf16x8*)(Ks + (16 * kk + fr) * LS + ks * 32 + fq * 8);
                        z = __builtin_amdgcn_mfma_f32_16x16x32_bf16(f, qf[ks], z, 0, 0, 0);
                    }
#pragma unroll
                    for (int e = 0; e < 4; ++e) {
                        const float zz = z[e] * 0.125f;
                        const float lsneg = -(fmaxf(zz, 0.f) + __logf(1.0f + __expf(-fabsf(zz))));
                        const bool valid = kt * 64 + 16 * kk + 4 * fq + e < query;
                        uu[kk][e] = valid ? lsneg : 0.f;
                        lsp[kk][e] = valid ? lsneg + zz : -1.0e30f;
                        tot += uu[kk][e];
                    }
                }
                tot += __shfl_xor(tot, 16); tot += __shfl_xor(tot, 32);
                f32x4 rest[4];
#pragma unroll
                for (int st = 0; st < 4; ++st) rest[st] = (f32x4){0.f, 0.f, 0.f, 0.f};
#pragma unroll
                for (int k2 = 0; k2 < 2; ++k2) {
                    u32x4 hi, lo;
#pragma unroll
                    for (int t2 = 0; t2 < 2; ++t2) {
                        const f32x4 a = uu[2 * k2 + t2];
                        const unsigned h0 = pack2(a[0], a[1]), h1 = pack2(a[2], a[3]);
                        hi[2 * t2] = h0; hi[2 * t2 + 1] = h1;
                        lo[2 * t2] = pack2(a[0] - lo_bf(h0), a[1] - hi_bf(h0)); lo[2 * t2 + 1] = pack2(a[2] - lo_bf(h1), a[3] - hi_bf(h1));
                    }
                    const bf16x8 fh = __builtin_bit_cast(bf16x8, hi), fl = __builtin_bit_cast(bf16x8, lo);
#pragma unroll
                    for (int st = 0; st < 4; ++st) {
                        rest[st] = __builtin_amdgcn_mfma_f32_16x16x32_bf16(tri[st][k2], fh, rest[st], 0, 0, 0);
                        rest[st] = __builtin_amdgcn_mfma_f32_16x16x32_bf16(tri[st][k2], fl, rest[st], 0, 0, 0);
                    }
                }
                bf16x8 af[2];
#pragma unroll
                for (int k2 = 0; k2 < 2; ++k2) {
                    u32x4 pk;
#pragma unroll
                    for (int t2 = 0; t2 < 2; ++t2) {
                        const int kk = 2 * k2 + t2;
                        float a4[4];
#pragma unroll
                        for (int e = 0; e < 4; ++e) a4[e] = __expf(lsp[kk][e] + R + rest[kk][e]);
                        pk[2 * t2] = pack2(a4[0], a4[1]); pk[2 * t2 + 1] = pack2(a4[2], a4[3]);
                    }
                    af[k2] = __builtin_bit_cast(bf16x8, pk);
                }
                R += tot;
#pragma unroll
                for (int dt = 0; dt < 4; ++dt)
#pragma unroll
                    for (int k2 = 0; k2 < 2; ++k2) {
                        const bf16_t* vp = Vt + (16 * dt + fr) * LS + 32 * k2 + 4 * fq;
                        const u32x2 v0 = *(const u32x2*)vp, v1 = *(const u32x2*)(vp + 16);
                        const bf16x8 f = __builtin_bit_cast(bf16x8, ((u32x4){v0[0], v0[1], v1[0], v1[1]}));
                        ot[dt] = __builtin_amdgcn_mfma_f32_16x16x32_bf16(f, af[k2], ot[dt], 0, 0, 0);
                    }
                done = __all((R < -104.0f) || (query >= L));
            }
            if (lane == 0) flags[wv] = done ? 1 : 0;
            __syncthreads();
            int alld = 1;
#pragma unroll
            for (int w = 0; w < 8; ++w) alld &= flags[w];
            if (alld || kt == 0) break;
            --kt;
        }
        if (query < L) {
#pragma unroll
            for (int dt = 0; dt < 4; ++dt) *(u32x2*)(p.osb + (tokb + query) * 512 + h * 64 + 16 * dt + 4 * fq) = pk4(ot[dt]);
        }
    }
}

struct EpiBranch {
    static constexpr bool PERM = true;
    const bf16_t* G; bf16_t* M; bool add;
    DI void operator()(const f32x4 (&acc)[2][2][4][2], const g8::Unit& u, int wr, int wc, int fr, int fq) const {
#pragma unroll
        for (int ai = 0; ai < 2; ++ai)
#pragma unroll
            for (int m = 0; m < 4; ++m) {
                const size_t r = (size_t)(u.pm * 256 + ai * 128 + wr * 64 + m * 16 + fr);
                const int c0 = u.pn * 256 + wc * 32 + 8 * fq;
#pragma unroll
                for (int bj = 0; bj < 2; ++bj) {
                    const u32x4 g = *(const u32x4*)(G + r * 2048 + c0 + bj * 128);
                    u32x4* mp = (u32x4*)(M + r * D + c0 + bj * 128);
                    const f32x4 v0 = acc[ai][bj][m][0], v1 = acc[ai][bj][m][1];
                    float o[8] = {lo_bf(g[0]) * v0[0], hi_bf(g[0]) * v0[1], lo_bf(g[1]) * v0[2], hi_bf(g[1]) * v0[3], lo_bf(g[2]) * v1[0], hi_bf(g[2]) * v1[1], lo_bf(g[3]) * v1[2], hi_bf(g[3]) * v1[3]};
                    if (add) {
                        const u32x4 mo = *mp;
#pragma unroll
                        for (int q = 0; q < 4; ++q) { o[2 * q] += lo_bf(mo[q]); o[2 * q + 1] += hi_bf(mo[q]); }
                    }
                    *mp = (u32x4){pack2(o[0], o[1]), pack2(o[2], o[3]), pack2(o[4], o[5]), pack2(o[6], o[7])};
                }
            }
    }
};
struct GateOrder {
    g8::DenseOrder d;
    DI bool next(int i, g8::Unit& u) const { return d.next(i, u); }
    DI unsigned row_off(const g8::Unit&, int) const { return 0u; }
};
struct EpiGate {
    static constexpr bool PERM = true;
    bf16_t* G;
    DI void operator()(const f32x4 (&acc)[2][2][4][2], const g8::Unit& u, int wr, int wc, int fr, int fq) const {
#pragma unroll
        for (int ai = 0; ai < 2; ++ai)
#pragma unroll
            for (int m = 0; m < 4; ++m) {
                bf16_t* rowp = G + (size_t)(u.pm * 256 + ai * 128 + wr * 64 + m * 16 + fr) * 2048 + u.pn * 256 + wc * 32 + 8 * fq;
#pragma unroll
                for (int bj = 0; bj < 2; ++bj) {
                    const f32x4 v0 = acc[ai][bj][m][0], v1 = acc[ai][bj][m][1];
                    *(u32x4*)(rowp + bj * 128) = (u32x4){pack2(sigmoidf_(v0[0]), sigmoidf_(v0[1])), pack2(sigmoidf_(v0[2]), sigmoidf_(v0[3])), pack2(sigmoidf_(v1[0]), sigmoidf_(v1[1])), pack2(sigmoidf_(v1[2]), sigmoidf_(v1[3]))};
                }
            }
    }
};
template <int PART> DI void phase_merge(const Params& p, int layer, int bid, int nb, char* smem) {
    const bf16_t* hb = p.hb; bf16_t* G = p.gates; bf16_t* M = p.merged;
    const bf16_t* Wg = p.WtIn + ((size_t)layer * CIN + CP) * D;
    G8_LAS unsigned char* lds = (G8_LAS unsigned char*)smem;
    if (PART == 0) {
#pragma unroll
    for (int which = 0; which < 2; ++which) {
        g8::DenseOrder S; S.init(hb, Wg + (size_t)which * 1024 * D, MFULL, D / 256, D, nb, bid);
        g8::gemm8<false>(lds, D, S, EpiGate{G + which * 1024});
    }
    }
    if (PART == 1) {
#pragma unroll
    for (int which = 0; which < 2; ++which) {
        const bf16_t* A = which ? p.orw : p.osb;
        const bf16_t* Bt = (which ? p.WtPrw : p.WtPsb) + (size_t)layer * D * 512;
        g8::DenseOrder S; S.init(A, Bt, MFULL, D / 256, 512, nb, bid);
        g8::gemm8<false>(lds, 512, S, EpiBranch{G + which * 1024, M, which != 0});
    }
    }
    if (PART == 1)
    for (int t = left_first(MFULL * 4 * 2, bid, nb); t < D / 128; t += nb) {
#pragma unroll
        for (int which = 0; which < 2; ++which) {
            const bf16_t* A = which ? p.orw : p.osb; const bf16_t* Gw = p.gleft - (size_t)M0_LEFT * 2048 + which * 1024;
            const bf16_t* Bt = (which ? p.WtPrw : p.WtPsb) + (size_t)layer * D * 512;
            gemm_left32([=](int r) { return A + (size_t)(M0_LEFT + r) * 512; }, Bt, 512, 512, t * 128, smem,
                        [=](int r0, int c, f32x4 v) {
                            const size_t r = (size_t)(M0_LEFT + r0);
                            const u32x2 g = *(const u32x2*)(Gw + r * 2048 + c);
                            float o0 = lo_bf(g[0]) * v[0], o1 = hi_bf(g[0]) * v[1], o2 = lo_bf(g[1]) * v[2], o3 = hi_bf(g[1]) * v[3];
                            u32x2* mp = (u32x2*)(M + r * D + c);
                            if (which) { const u32x2 m = *mp; o0 += lo_bf(m[0]); o1 += hi_bf(m[0]); o2 += lo_bf(m[1]); o3 += hi_bf(m[1]); }
                            *mp = (u32x2){pack2(o0, o1), pack2(o2, o3)};
                        });
        }
    }
}
struct EpiOut {
    static constexpr bool PERM = false;
    float* hmeta; float* out; const bf16_t* hb;
    DI void operator()(const f32x4 (&acc)[2][2][4][2], const g8::Unit& u, int wr, int wc, int fr, int fq) const {
#pragma unroll
        for (int ai = 0; ai < 2; ++ai)
#pragma unroll
            for (int m = 0; m < 4; ++m) {
                const int r = u.pm * 256 + ai * 128 + wr * 64 + m * 16 + fr, c0 = u.pn * 256 + wc * 32 + 4 * fq;
                float* rowp = hrow2(hmeta, out, r) + c0;
                const bf16_t* hbp = hb + (size_t)r * D + c0;
#pragma unroll
                for (int bj = 0; bj < 2; ++bj)
#pragma unroll
                    for (int n = 0; n < 2; ++n) {
                        const f32x4 h = up4(*(const u32x2*)(hbp + bj * 128 + n * 16)), v = acc[ai][bj][m][n];
                        *(f32x4*)(rowp + bj * 128 + n * 16) = (f32x4){ALPHA * h[0] + v[0], ALPHA * h[1] + v[1], ALPHA * h[2] + v[2], ALPHA * h[3] + v[3]};
                    }
            }
    }
};
DI void phase_outproj(const Params& p, int layer, int bid, int nb, char* smem) {
    const bf16_t* A = p.merged; float* const hmeta = p.hmeta; float* const outp = p.out; const bf16_t* hbres = p.hb;
    const bf16_t* Bt = p.WtOut + (size_t)layer * D * D;
    if (bid == 0 && tid_() < NE) p.counts[tid_()] = 0;
    g8::DenseOrder S; S.init(A, Bt, MFULL, D / 256, D, nb, bid);
    g8::gemm8<false>((G8_LAS unsigned char*)smem, D, S, EpiOut{hmeta, outp, hbres});
    for (int t = left_first(MFULL * 4, bid, nb); t < D / 128; t += nb)
        gemm_left32([=](int r) { return A + (size_t)(M0_LEFT + r) * D; }, Bt, D, D, t * 128, smem,
                    [=](int r0, int c, f32x4 v) {
                        const int r = M0_LEFT + r0;
                        const f32x4 h = up4(*(const u32x2*)(hbres + (size_t)r * D + c));
                        *(f32x4*)(hrow2(hmeta, outp, r) + c) = (f32x4){ALPHA * h[0] + v[0], ALPHA * h[1] + v[1], ALPHA * h[2] + v[2], ALPHA * h[3] + v[3]};
                    });
}

constexpr int LN1_ROWB = 2 * D + 16;
constexpr int LN1_WAVE = 8 * LN1_ROWB;
constexpr int LN1_LDS = 8 * LN1_WAVE + 2048;
DI void phase_ln1_router(const Params& p, int layer, int bid, int nb, char* smem) {
    const int tid = tid_(), lane = tid & 63, wid = __builtin_amdgcn_readfirstlane(tid >> 6), fr = lane & 15, fq = lane >> 4;
    char* wl = smem + wid * LN1_WAVE;
    int* sel = (int*)(smem + 8 * LN1_WAVE);
    float* sgt = (float*)(smem + 8 * LN1_WAVE + 640);
    int* sbase = (int*)(smem + 8 * LN1_WAVE + 1280);
    const int nwaves = nb * 8, gw = bid * 8 + wid;
    const int base_n = T / nwaves, extra = T % nwaves;
    const int tok0 = gw * base_n + (gw < extra ? gw : extra), ntok = base_n + (gw < extra ? 1 : 0);
    const int btok0 = bid * 8 * base_n + (bid * 8 < extra ? bid * 8 : extra);
    const float* g1p = p.ln1_g + layer * D; const float* b1p = p.ln1_b + layer * D;
    __syncthreads();
    for (int g0 = 0; g0 < ntok; g0 += 4) {
        const int ng = ntok - g0 < 4 ? ntok - g0 : 4;
        float vn[16];
        { const float* hf = hrow_u(p, tok0 + g0);
#pragma unroll
          for (int j = 0; j < 4; ++j) { const f32x4 a = *(const f32x4*)(hf + 256 * j + 4 * lane); vn[4 * j] = a[0]; vn[4 * j + 1] = a[1]; vn[4 * j + 2] = a[2]; vn[4 * j + 3] = a[3]; } }
#pragma unroll 1
        for (int i = 0; i < ng; ++i) {
            const int tok = tok0 + g0 + i;
            float v[16];
#pragma unroll
            for (int q = 0; q < 16; ++q) v[q] = vn[q];
            if (i + 1 < ng) { const float* hn = hrow_u(p, tok + 1);
#pragma unroll
                for (int j = 0; j < 4; ++j) { const f32x4 a = *(const f32x4*)(hn + 256 * j + 4 * lane); vn[4 * j] = a[0]; vn[4 * j + 1] = a[1]; vn[4 * j + 2] = a[2]; vn[4 * j + 3] = a[3]; } }
            ln16(v, g1p, b1p, lane);
#pragma unroll
            for (int j = 0; j < 4; ++j) {
                const unsigned h0 = pack2(v[4 * j], v[4 * j + 1]), h1 = pack2(v[4 * j + 2], v[4 * j + 3]);
                *(u32x2*)(p.hb + (size_t)tok * D + 256 * j + 4 * lane) = (u32x2){h0, h1};
                *(u32x2*)(wl + i * LN1_ROWB + (256 * j + 4 * lane) * 2) = (u32x2){h0, h1};
                *(u32x2*)(wl + (4 + i) * LN1_ROWB + (256 * j + 4 * lane) * 2) = (u32x2){pack2(v[4 * j] - lo_bf(h0), v[4 * j + 1] - hi_bf(h0)), pack2(v[4 * j + 2] - lo_bf(h1), v[4 * j + 3] - hi_bf(h1))};
            }
        }
        asm volatile("s_waitcnt lgkmcnt(0)" ::: "memory");
        __builtin_amdgcn_wave_barrier();
        f32x4 acc = (f32x4){0.f, 0.f, 0.f, 0.f};
        const char* arow = wl + (fr & 3) * LN1_ROWB + fq * 16;
        const bf16_t* whi = p.RwHi + (size_t)fr * D + fq * 8; const bf16_t* wlo = p.RwLo + (size_t)fr * D + fq * 8;
#pragma unroll 4
        for (int ks = 0; ks < 32; ++ks) {
            const bf16x8 ah = *(const bf16x8*)(arow + ks * 64), al = *(const bf16x8*)(arow + 4 * LN1_ROWB + ks * 64);
            const bf16x8 bh = *(const bf16x8*)(whi + ks * 32), bl = *(const bf16x8*)(wlo + ks * 32);
            acc = __builtin_amdgcn_mfma_f32_16x16x32_bf16(bh, ah, acc, 0, 0, 0);
            acc = __builtin_amdgcn_mfma_f32_16x16x32_bf16(bh, al, acc, 0, 0, 0);
            acc = __builtin_amdgcn_mfma_f32_16x16x32_bf16(bl, ah, acc, 0, 0, 0);
        }
        float lg[4]; float mx = -3.0e38f;
#pragma unroll
        for (int e = 0; e < 4; ++e) { lg[e] = acc[e] + p.router_b[4 * fq + e]; mx = fmaxf(mx, lg[e]); }
        mx = fmaxf(mx, __shfl_xor(mx, 16)); mx = fmaxf(mx, __shfl_xor(mx, 32));
        float sum = 0.f;
#pragma unroll
        for (int e = 0; e < 4; ++e) { lg[e] = __expf(lg[e] - mx); sum += lg[e]; }
        sum += __shfl_xor(sum, 16); sum += __shfl_xor(sum, 32);
        const float inv = 1.0f / sum;
        float v1 = -1.f, v2 = -1.f; int i1 = 0, i2 = 0;
#pragma unroll
        for (int e = 0; e < 4; ++e) {
            const float pv = lg[e] * inv;
            if (pv > v1) { v2 = v1; i2 = i1; v1 = pv; i1 = e; } else if (pv > v2) { v2 = pv; i2 = e; }
        }
        const float sc = v1 + v2;
        float bsc = sc; int bg = fq;
#pragma unroll
        for (int m = 16; m <= 32; m <<= 1) {
            const float os = __shfl_xor(bsc, m); const int og = __shfl_xor(bg, m);
            if (os > bsc || (os == bsc && og < bg)) { bsc = os; bg = og; }
        }
        if (bg == fq && fr < ng) {
            const int li = tok0 + g0 + fr - btok0;
            const float gs = 1.0f / (v1 + v2);
            sel[li * 2] = 4 * fq + i1; sel[li * 2 + 1] = 4 * fq + i2; sgt[li * 2] = v1 * gs; sgt[li * 2 + 1] = v2 * gs;
        }
        asm volatile("s_waitcnt lgkmcnt(0)" ::: "memory");
        __builtin_amdgcn_wave_barrier();
    }
    __syncthreads();
    if (wid == 0) {
        const int nbt = 8 * base_n + ((bid * 8 + 8 <= extra) ? 8 : (bid * 8 < extra ? extra - bid * 8 : 0));
        for (int c0 = 0; c0 < nbt; c0 += 64) {
            const int li = c0 + lane; const bool on = li < nbt;
            const int e1 = on ? sel[li * 2] : -1, e2 = on ? sel[li * 2 + 1] : -1;
            const unsigned long long lt = (1ull << lane) - 1ull;
            int r1 = 0, r2 = 0, mycnt = 0;
#pragma unroll
            for (int e = 0; e < NE; ++e) {
                const unsigned long long m1 = __ballot(e1 == e), m2 = __ballot(e2 == e);
                const int c1 = __popcll(m1), c2 = __popcll(m2);
                if (e1 == e) r1 = __popcll(m1 & lt);
                if (e2 == e) r2 = c1 + __popcll(m2 & lt);
                if (lane == e) mycnt = c1 + c2;
            }
            if (lane < NE) sbase[lane] = mycnt > 0 ? atomicAdd(&p.counts[lane], mycnt) : 0;
            asm volatile("s_waitcnt vmcnt(0) lgkmcnt(0)" ::: "memory");
            __builtin_amdgcn_wave_barrier();
            if (on) {
                const int tok = btok0 + li;
                const int s1 = sbase[e1] + r1, s2 = sbase[e2] + r2;
                p.list[e1 * T + s1] = tok * 2; p.list[e2 * T + s2] = tok * 2 + 1;
                p.tokg[tok * 2] = sgt[li * 2]; p.tokg[tok * 2 + 1] = sgt[li * 2 + 1];
            }
            asm volatile("s_waitcnt lgkmcnt(0)" ::: "memory");
            __builtin_amdgcn_wave_barrier();
        }
    }
}

constexpr int MOE_BIG = 8;
template <bool UP> struct MoeOrder {
    const int* counts; const int* list; int G, c; const char* A; const char* B;
    DI bool next(int i, g8::Unit& u) const {
        const int xcd = c & 7, w = c >> 3, mt = w >> 2, pn = w & 3;
        if (w >= 32) return false;
        int padp = 0, fe = -1, fc = 0, fp = 0, seen = 0;
#pragma unroll
        for (int e = 0; e < NE; ++e) {
            const int cn = counts[e], ntp = (cn + 255) >> 8, nt = ntp < MOE_BIG ? ntp : MOE_BIG;
            const bool mineok = ((e & 7) == xcd) && (mt < nt);
            const bool hit = mineok && (seen == i);
            fe = hit ? e : fe; fc = hit ? cn : fc; fp = hit ? padp + mt : fp;
            seen += mineok ? 1 : 0;
            padp += ntp;
        }
        fe = __builtin_amdgcn_readfirstlane(fe); fc = __builtin_amdgcn_readfirstlane(fc); fp = __builtin_amdgcn_readfirstlane(fp);
        if (fe < 0) return false;
        u.e = fe; u.slot0 = mt * 256; u.cnt = fc; u.pm = fp; u.pn = pn;
        u.A = UP ? A : A + (size_t)fp * ((size_t)256 * DE * 2);
        u.B = UP ? B + (size_t)fe * ((size_t)1024 * 1024 * 2) + (size_t)pn * ((size_t)256 * D * 2) : B + (size_t)fe * ((size_t)1024 * 512 * 2) + (size_t)pn * ((size_t)256 * DE * 2);
        return true;
    }
    DI unsigned row_off(const g8::Unit& u, int r) const {
        const __amdgpu_buffer_rsrc_t rs = __builtin_amdgcn_make_buffer_rsrc((void*)list, 0, NE * T * 4, 0x00020000);
        const int ent = __builtin_amdgcn_raw_buffer_load_b32(rs, r * 4, (u.e * T + u.slot0) * 4, 0);
        return u.slot0 + r < u.cnt ? (unsigned)(ent >> 1) * (unsigned)(D * 2) : 0u;
    }
};
struct EpiMoeUp {
    static constexpr bool PERM = true;
    bf16_t* hid;
    DI void operator()(const f32x4 (&acc)[2][2][4][2], const g8::Unit& u, int wr, int wc, int fr, int fq) const {
#pragma unroll
        for (int ai = 0; ai < 2; ++ai)
#pragma unroll
            for (int m = 0; m < 4; ++m) {
                const int r = ai * 128 + wr * 64 + m * 16 + fr;
                if (u.slot0 + r >= u.cnt) continue;
                bf16_t* rowp = hid + ((size_t)u.pm * 256 + r) * DE + ((u.pn * 256 + wc * 32 + 8 * fq) >> 1);
#pragma unroll
                for (int bj = 0; bj < 2; ++bj) {
                    const f32x4 v0 = acc[ai][bj][m][0], v1 = acc[ai][bj][m][1];
                    *(u32x2*)(rowp + bj * 64) = (u32x2){pack2(v0[0] * sigmoidf_(v0[0]) * v0[1], v0[2] * sigmoidf_(v0[2]) * v0[3]), pack2(v1[0] * sigmoidf_(v1[0]) * v1[1], v1[2] * sigmoidf_(v1[2]) * v1[3])};
                }
            }
    }
};
struct EpiMoeDown {
    static constexpr bool PERM = true;
    bf16_t* fo; const int* list; const float* tokg;
    DI void operator()(const f32x4 (&acc)[2][2][4][2], const g8::Unit& u, int wr, int wc, int fr, int fq) const {
#pragma unroll
        for (int ai = 0; ai < 2; ++ai)
#pragma unroll
            for (int m = 0; m < 4; ++m) {
                const int sl = u.slot0 + ai * 128 + wr * 64 + m * 16 + fr;
                if (sl >= u.cnt) continue;
                const int ent = list[u.e * T + sl];
                const float g = tokg[ent];
                bf16_t* rowp = fo + ((size_t)(ent & 1) * TP + (ent >> 1)) * D + u.pn * 256 + wc * 32 + 8 * fq;
#pragma unroll
                for (int bj = 0; bj < 2; ++bj) {
                    const f32x4 v0 = acc[ai][bj][m][0], v1 = acc[ai][bj][m][1];
                    *(u32x4*)(rowp + bj * 128) = (u32x4){pack2(g * v0[0], g * v0[1]), pack2(g * v0[2], g * v0[3]), pack2(g * v1[0], g * v1[1]), pack2(g * v1[2], g * v1[3])};
                }
            }
    }
};
DI void phase_moe_up(const Params& p, int bid, int nb, char* smem) {
    const MoeOrder<true> S{p.counts, p.list, nb, bid, (const char*)p.hb, (const char*)p.WtGU};
    g8::gemm8<true>((G8_LAS unsigned char*)smem, D, S, EpiMoeUp{p.hid});
    const bf16_t* hb = p.hb; bf16_t* hid = p.hid; const int* list = p.list;
    int big = 0, padr = 0, job = 0;
#pragma unroll 1
    for (int e = 0; e < NE; ++e) { const int cn = p.counts[e], ntp = (cn + 255) >> 8; big += (ntp < MOE_BIG ? ntp : MOE_BIG) * 4; }
    const int mine = bid; (void)big;
#pragma unroll 1
    for (int e = 0; e < NE; ++e) {
        const int cn = p.counts[e];
        for (int s0 = MOE_BIG * 256; s0 < cn; s0 += 128)
            for (int nt = 0; nt < 8; ++nt, ++job)
                if (job % nb == mine) {
                    const int prow = padr;
                    gemm_tile128([=](int r) { const int sl = s0 + r; return sl < cn ? hb + (size_t)(list[e * T + sl] >> 1) * D : (const bf16_t*)nullptr; },
                                 p.WtGU + (size_t)e * 1024 * 1024, D, D, 0, nt * 128, smem,
                                 [=](int r, int c, f32x4 v) {
                                     const int sl = s0 + r;
                                     if (sl >= cn) return;
                                     *(unsigned*)(hid + (size_t)(prow + sl) * DE + (c >> 1)) = pack2(v[0] * sigmoidf_(v[0]) * v[1], v[2] * sigmoidf_(v[2]) * v[3]);
                                 });
                }
        padr += ((cn + 255) >> 8) * 256;
    }
}
DI void phase_moe_down(const Params& p, int bid, int nb, char* smem) {
    const MoeOrder<false> S{p.counts, p.list, nb, bid, (const char*)p.hid, (const char*)p.WtD};
    g8::gemm8<false>((G8_LAS unsigned char*)smem, DE, S, EpiMoeDown{p.fo, p.list, p.tokg});
    const bf16_t* hid = p.hid; bf16_t* fo = p.fo; const int* list = p.list; const float* tokg = p.tokg;
    int big = 0, padr = 0, job = 0;
#pragma unroll 1
    for (int e = 0; e < NE; ++e) { const int cn = p.counts[e], ntp = (cn + 255) >> 8; big += (ntp < MOE_BIG ? ntp : MOE_BIG) * 4; }
    const int mine = bid; (void)big;
#pragma unroll 1
    for (int e = 0; e < NE; ++e) {
        const int cn = p.counts[e];
        for (int s0 = MOE_BIG * 256; s0 < cn; s0 += 128)
            for (int nt = 0; nt < 8; ++nt, ++job)
                if (job % nb == mine) {
                    const int prow = padr;
                    gemm_tile128([=](int r) { const int sl = s0 + r; return sl < cn ? hid + (size_t)(prow + sl) * DE : (const bf16_t*)nullptr; },
                                 p.WtD + (size_t)e * 1024 * 512, DE, DE, 0, nt * 128, smem,
                                 [=](int r, int c, f32x4 v) {
                                     const int sl = s0 + r;
                                     if (sl >= cn) return;
                                     const int ent = list[e * T + sl];
                                     const float g = tokg[ent];
                                     *(u32x2*)(fo + ((size_t)(ent & 1) * TP + (ent >> 1)) * D + c) = (u32x2){pack2(g * v[0], g * v[1]), pack2(g * v[2], g * v[3])};
                                 });
                }
        padr += ((cn + 255) >> 8) * 256;
    }
}
DI void phase_ln2(const Params& p, int layer, int bid, int nb) {
    const int lane = tid_() & 63, wid = __builtin_amdgcn_readfirstlane(tid_() >> 6);
    const int nwaves = nb * 8, gw = bid * 8 + wid, base_n = T / nwaves, extra = T % nwaves;
    const int tok0 = gw * base_n + (gw < extra ? gw : extra), ntok = base_n + (gw < extra ? 1 : 0);
    u32x2 an[4], f0n[4], f1n[4];
    {
#pragma unroll
        for (int j = 0; j < 4; ++j) {
            an[j] = *(const u32x2*)(p.hb + (size_t)tok0 * D + 256 * j + 4 * lane);
            f0n[j] = *(const u32x2*)(p.fo + (size_t)tok0 * D + 256 * j + 4 * lane); f1n[j] = *(const u32x2*)(p.fo + ((size_t)TP + tok0) * D + 256 * j + 4 * lane);
        }
    }
#pragma unroll 1
    for (int i = 0; i < ntok; ++i) {
        const int tok = tok0 + i;
        float v[16];
#pragma unroll
        for (int j = 0; j < 4; ++j) {
            v[4 * j] = ALPHA * lo_bf(an[j][0]) + lo_bf(f0n[j][0]) + lo_bf(f1n[j][0]); v[4 * j + 1] = ALPHA * hi_bf(an[j][0]) + hi_bf(f0n[j][0]) + hi_bf(f1n[j][0]);
            v[4 * j + 2] = ALPHA * lo_bf(an[j][1]) + lo_bf(f0n[j][1]) + lo_bf(f1n[j][1]); v[4 * j + 3] = ALPHA * hi_bf(an[j][1]) + hi_bf(f0n[j][1]) + hi_bf(f1n[j][1]);
        }
        if (i + 1 < ntok) {
#pragma unroll
            for (int j = 0; j < 4; ++j) {
                an[j] = *(const u32x2*)(p.hb + (size_t)(tok + 1) * D + 256 * j + 4 * lane);
                f0n[j] = *(const u32x2*)(p.fo + (size_t)(tok + 1) * D + 256 * j + 4 * lane); f1n[j] = *(const u32x2*)(p.fo + ((size_t)TP + tok + 1) * D + 256 * j + 4 * lane);
            }
        }
        ln16(v, p.ln2_g + layer * D, p.ln2_b + layer * D, lane);
        if (layer == DEPTH - 1) {
            float* of = hrow_u(p, tok);
#pragma unroll
            for (int j = 0; j < 4; ++j) *(f32x4*)(of + 256 * j + 4 * lane) = (f32x4){v[4 * j], v[4 * j + 1], v[4 * j + 2], v[4 * j + 3]};
        } else store_row_bf(p.hb + (size_t)tok * D, v, lane);
    }
}

extern __shared__ __attribute__((aligned(16))) char dyn_smem[];
constexpr int SMEM_MAIN = R1_LDS > GEMM_LDS ? R1_LDS : GEMM_LDS;
constexpr int SMEM_BYTES = SMEM_MAIN + 16;

__global__ void __launch_bounds__(NTHR, 2) k_forward(Params p) {
    const int bid = blockIdx.x, nb = gridDim.x;
    char* smem = dyn_smem;
    uint4* xbw = (uint4*)(dyn_smem + SMEM_MAIN);
    if (threadIdx.x == 0) *xbw = make_uint4(0u, 0u, 0u, 0u);
    __syncthreads();
    XcdBarrier bar = xcd_barrier_post(p.bar, (volatile LAS unsigned*)xbw);
    phase_prologue_weights(p, bid, nb, smem);
    phase_embed(p, bid, nb);
    xcd_barrier(bar);
    for (int l = 0; l < DEPTH; ++l) {
        phase_inproj(p, l, bid, nb, smem);
        xcd_barrier(bar);
        phase_rwkv_r1<0>(p, l, bid, nb, smem);
        xcd_barrier(bar);
        if (bid < 32) phase_rwkv_r2(p, bid);
        else {
            const int sbid = bid - 32, snb = nb - 32, heavy = (NBATCH * HEADS * ((L + 127) / 128)) % snb;
            if (sbid >= heavy && sbid < heavy + NBATCH * HEADS) phase_rwkv_r1<1>(p, l, sbid - heavy, 1, smem);
            phase_sb(p, sbid, snb, smem);
        }
        xcd_barrier(bar);
        phase_rwkv_r3(p, l, bid, nb);
        convert_experts(p, l, bid, nb, smem);
        phase_merge<0>(p, l, bid, nb, smem);
        xcd_barrier(bar);
        phase_merge<1>(p, l, bid, nb, smem);
        xcd_barrier(bar);
        phase_outproj(p, l, bid, nb, smem);
        xcd_barrier(bar);
        phase_ln1_router(p, l, bid, nb, smem);
        xcd_barrier(bar);
        phase_moe_up(p, bid, nb, smem);
        xcd_barrier(bar);
        phase_moe_down(p, bid, nb, smem);
        xcd_barrier(bar);
        phase_ln2(p, l, bid, nb);
        xcd_barrier(bar);
    }
}

extern "C" void kernel_launch(void* const* d_in, const int* in_sizes, int n_in, void* d_out, int out_size, void* d_ws, size_t ws_size, hipStream_t stream) {
    (void)in_sizes; (void)n_in; (void)out_size;
    Params p;
    memset(&p, 0, sizeof(p));
    const float* const* in = (const float* const*)d_in;
    p.x = in[0]; p.meta = in[1]; p.emb_g = in[2]; p.emb_b = in[3]; p.w_in = in[4]; p.mu = in[5]; p.w0 = in[6]; p.w_up = in[7]; p.a0 = in[8]; p.a_up = in[9];
    p.g_up = in[10]; p.k_k = in[11]; p.k_a = in[12]; p.r_k = in[13]; p.lnx_g = in[14]; p.lnx_b = in[15]; p.p_sb = in[16]; p.p_rwkv = in[17]; p.w_out = in[18];
    p.ln1_g = in[19]; p.ln1_b = in[20]; p.router_w = in[21]; p.router_b = in[22]; p.ew_gate = in[23]; p.ew_up = in[24]; p.ew_down = in[25]; p.ln2_g = in[26]; p.ln2_b = in[27];
    p.out = (float*)d_out;
    char* ws = (char*)d_ws; size_t o = 0;
    auto take = [&](size_t bytes) { char* r = ws + o; o += (bytes + 255) & ~(size_t)255; return r; };
    p.bar = (unsigned*)take(XCD_BAR_WORDS * sizeof(unsigned));
    p.counts = (int*)take(256);
    p.WtIn = (bf16_t*)take((size_t)DEPTH * CIN * D * 2);
    p.WtPsb = (bf16_t*)take((size_t)DEPTH * D * 512 * 2);
    p.WtPrw = (bf16_t*)take((size_t)DEPTH * D * 512 * 2);
    p.WtOut = (bf16_t*)take((size_t)DEPTH * D * D * 2);
    p.WupT = (bf16_t*)take((size_t)DEPTH * 512 * 64 * 2);
    p.AupT = (bf16_t*)take((size_t)DEPTH * 512 * 64 * 2);
    p.GupT = (bf16_t*)take((size_t)DEPTH * 512 * 128 * 2);
    p.RwHi = (bf16_t*)take((size_t)NE * D * 2);
    p.RwLo = (bf16_t*)take((size_t)NE * D * 2);
    p.gleft = (bf16_t*)take((size_t)32 * 2048 * 2);
    {
        const size_t ub = (size_t)NUNIT * 64 * 64 * 2, need_r = 6 * ub + (size_t)NUNIT * 64 * 4, need_e = (size_t)NE * 1024 * 1024 * 2 + (size_t)NE * 1024 * 512 * 2;
        char* e = take(need_r > need_e ? need_r : need_e);
        p.WtGU = (bf16_t*)e; p.WtD = (bf16_t*)(e + (size_t)NE * 1024 * 1024 * 2);
        p.PcG = (bf16_t*)e; p.QcG = (bf16_t*)(e + ub); p.RhG = (bf16_t*)(e + 2 * ub); p.Y0G = (bf16_t*)(e + 3 * ub); p.GG = (bf16_t*)(e + 4 * ub); p.SG = (bf16_t*)(e + 5 * ub);
        p.bonG = (float*)(e + 6 * ub);
    }
    p.hb = (bf16_t*)take((size_t)TP * D * 2);
    p.hmeta = (float*)take((size_t)NBATCH * NMETA * D * 4);
    p.P = (bf16_t*)take((size_t)TP * CP * 2);
    p.osb = (bf16_t*)take((size_t)TP * 512 * 2);
    p.orw = (bf16_t*)take((size_t)TP * 512 * 2);
    p.list = (int*)take((size_t)NE * T * 4);
    p.tokg = (float*)take((size_t)T * 2 * 4);
    p.gates = p.P;
    p.merged = p.P + (size_t)TP * 2048;
    p.hid = p.P;
    p.fo = p.P + (size_t)(2 * T + 16 * 256) * DE;
    if (o > ws_size) return;
    static int grid = 0;
    if (!grid) {
        int dev = 0, cus = 0, per_cu = 0;
        (void)hipGetDevice(&dev);
        (void)hipDeviceGetAttribute(&cus, hipDeviceAttributeMultiprocessorCount, dev);
        (void)hipFuncSetAttribute((const void*)k_forward, hipFuncAttributeMaxDynamicSharedMemorySize, SMEM_BYTES);
        (void)hipOccupancyMaxActiveBlocksPerMultiprocessor(&per_cu, k_forward, NTHR, SMEM_BYTES);
        grid = per_cu >= 1 ? cus : 0;
    }
    if (!grid) return;
    (void)hipMemsetAsync(p.bar, 0, XCD_BAR_WORDS * sizeof(unsigned), stream);
    hipLaunchKernelGGL(k_forward, dim3(grid), dim3(NTHR), SMEM_BYTES, stream, p);
}
```

```cpp
#include <hip/hip_runtime.h>
#include <stdint.h>
#include <string.h>

#define DI __device__ __forceinline__
typedef unsigned short bf16_t;
typedef short bf16x8 __attribute__((ext_vector_type(8)));
typedef float f32x4 __attribute__((ext_vector_type(4)));
typedef unsigned u32x4 __attribute__((ext_vector_type(4)));
typedef unsigned u32x2 __attribute__((ext_vector_type(2)));

constexpr int D = 1024, NBATCH = 2, SEQ = 8192, NMETA = 16, L = SEQ + NMETA, T = NBATCH * L, TP = 16640;
constexpr int DEPTH = 2, HEADS = 8, HD = 64;
constexpr int CIN = 5376, CP = 3328;
constexpr int OFF_Q = 0, OFF_K = 512, OFF_V = 1024, OFF_RW = 1536;
constexpr int RW_R = 0, RW_K = 512, RW_V = 1024, RW_WD = 1536, RW_AD = 1600, RW_GD = 1664, RSW = 1792;
constexpr int NE = 16, DE = 512;
constexpr float ALPHA = 1.41421356237309515f;
constexpr float DECAY_SCALE = 0.60653065971263342f;
constexpr int NTHR = 512;

#define XB_TMO      128
#define XB_XCNT(j)  (256  + 64 * (j))
#define XB_XSUB(j)  (1280 + 64 * (j))
#define XB_XGEN(j)  (2304 + 64 * (j))
#define XB_TOP      3328
#define XB_TOPGEN   3392
#define XCD_BAR_WORDS 3456
#define XB_SPIN_CAP (1u << 18)
#define LAS __attribute__((address_space(3)))

__device__ __forceinline__ unsigned xb_ld(unsigned* p)              { return __hip_atomic_load(p, __ATOMIC_RELAXED, __HIP_MEMORY_SCOPE_AGENT); }
__device__ __forceinline__ unsigned xb_add(unsigned* p, unsigned v) { return __hip_atomic_fetch_add(p, v, __ATOMIC_RELAXED, __HIP_MEMORY_SCOPE_AGENT); }
__device__ __forceinline__ unsigned xb_xcc_id() { return (unsigned)__builtin_amdgcn_s_getreg((3 << 11) | 20) & 0xFu; }
#define XB_SPIN(cond, bar) do { unsigned _sp = 0; while (cond) { __builtin_amdgcn_s_sleep(1); \
    if ((++_sp & 255u) == 0u) { if (xb_ld(&(bar)[XB_TMO])) break; if (_sp > XB_SPIN_CAP) { atomicAdd(&(bar)[XB_TMO], 1u); break; } } } } while (0)

struct XcdBarrier {
    unsigned* bar; unsigned x;
    volatile LAS unsigned* st;
};

__device__ __forceinline__ XcdBarrier xcd_barrier_post(unsigned* bar, volatile LAS unsigned* st) {
    XcdBarrier b; b.bar = bar; b.x = xb_xcc_id(); b.st = st;
    if (threadIdx.x == 0) (void)xb_add(&bar[XB_XCNT(b.x)], 1u);
    return b;
}
__device__ __forceinline__ void xcd_barrier_complete(unsigned* bar, unsigned x, unsigned& nloc, unsigned& nx) {
    const unsigned G = gridDim.x * gridDim.y * gridDim.z;
    unsigned sum, cnt, mine, sp = 0u;
    for (;;) {
        sum = 0u; cnt = 0u; mine = 0u;
#pragma unroll
        for (unsigned j = 0; j < 16; ++j) { const unsigned c = xb_ld(&bar[XB_XCNT(j)]); sum += c; cnt += (c > 0u) ? 1u : 0u; mine = (j == x) ? c : mine; }
        if (sum == G) break;
        __builtin_amdgcn_s_sleep(1);
        if ((++sp & 255u) == 0u) { if (xb_ld(&bar[XB_TMO])) break; if (sp > XB_SPIN_CAP) { atomicAdd(&bar[XB_TMO], 1u); break; } }
    }
    nloc = mine > 0u ? mine : 1u; nx = cnt > 0u ? cnt : 1u;
}

__device__ __forceinline__ void xcd_barrier(const XcdBarrier& b) {
    asm volatile("s_waitcnt vmcnt(0)" ::: "memory");
    __syncthreads();
    if (threadIdx.x == 0) {
        unsigned* bar = b.bar;
        unsigned bx = b.x; asm volatile("" : "+s"(bx));
        __builtin_amdgcn_s_waitcnt(0);
        unsigned nloc = b.st[0], nx = b.st[1];
        if (nloc == 0u) { xcd_barrier_complete(bar, bx, nloc, nx); b.st[0] = nloc; b.st[1] = nx; }
        const unsigned old = xb_add(&bar[XB_XSUB(bx)], 1u);
        const unsigned gen = old / nloc;
        if (old + 1u == (gen + 1u) * nloc) {
            __builtin_amdgcn_fence(__ATOMIC_RELEASE, "agent");
            asm volatile("s_waitcnt vmcnt(0)" ::: "memory");
            const unsigned og = xb_add(&bar[XB_TOP], 1u);
            const unsigned tg = og / nx;
            if (og + 1u == (tg + 1u) * nx) xb_add(&bar[XB_TOPGEN], 1u);
            else XB_SPIN(xb_ld(&bar[XB_TOPGEN]) == tg, bar);
            __builtin_amdgcn_fence(__ATOMIC_ACQUIRE, "agent");
            xb_add(&bar[XB_XGEN(bx)], 1u);
            asm volatile("s_waitcnt vmcnt(0)" ::: "memory");
        } else {
            XB_SPIN(xb_ld(&bar[XB_XGEN(bx)]) == gen, bar);
            __builtin_amdgcn_fence(__ATOMIC_ACQUIRE, "agent");
            asm volatile("s_waitcnt vmcnt(0)" ::: "memory");
        }
    }
    __syncthreads();
}


struct Params {
    const float *x, *meta, *emb_g, *emb_b, *w_in, *mu, *w0, *w_up, *a0, *a_up, *g_up, *k_k, *k_a, *r_k, *lnx_g, *lnx_b, *p_sb, *p_rwkv, *w_out,
        *ln1_g, *ln1_b, *router_w, *router_b, *ew_gate, *ew_up, *ew_down, *ln2_g, *ln2_b;
    float* out;
    unsigned* bar;
    int* counts;
    bf16_t *WtIn, *WtPsb, *WtPrw, *WtOut, *WtGU, *WtD, *hb, *P, *osb, *orw, *WupT, *AupT, *GupT;
    bf16_t *PcG, *QcG, *RhG, *Y0G, *GG, *SG;
    bf16_t *RwHi, *RwLo, *gleft;
    float* bonG;
    float* hmeta;
    bf16_t *gates, *merged, *hid, *fo;
    int* list;
    float* tokg;
};

DI float bf2f(bf16_t v) { return __uint_as_float((unsigned)v << 16); }
typedef __bf16 bf16x2_t __attribute__((ext_vector_type(2)));
DI bf16_t f2bf(float f) { return __builtin_bit_cast(bf16_t, (__bf16)f); }
DI unsigned pack2(float lo, float hi) { bf16x2_t v = {(__bf16)lo, (__bf16)hi}; return __builtin_bit_cast(unsigned, v); }
DI float lo_bf(unsigned u) { return __uint_as_float(u << 16); }
DI float hi_bf(unsigned u) { return __uint_as_float(u & 0xFFFF0000u); }
template <int CTRL> DI float dpp_mov(float v) { return __builtin_bit_cast(float, __builtin_amdgcn_update_dpp(0, __builtin_bit_cast(int, v), CTRL, 0xF, 0xF, true)); }
DI float sum8(float v) {
    v += dpp_mov<0xB1>(v);
    v += dpp_mov<0x4E>(v);
    v += dpp_mov<0x141>(v);
    return v;
}
DI float sum16(float v) { v = sum8(v); v += dpp_mov<0x140>(v); return v; }
DI float wave_sum(float v) { v = sum16(v); v += __shfl_xor(v, 16); v += __shfl_xor(v, 32); return v; }
struct Params;
DI const Params& kparams() {
    auto k = __builtin_amdgcn_kernarg_segment_ptr();
    asm volatile("" : "+s"(k));
    return *(const Params*)k;
}
DI int tid_() { int t = threadIdx.x; asm volatile("" : "+v"(t)); return t; }
DI float sigmoidf_(float x) { return __builtin_amdgcn_rcpf(1.0f + __expf(-x)); }
DI float tanhf_(float x) { return 1.0f - 2.0f * __builtin_amdgcn_rcpf(1.0f + __expf(2.0f * x)); }
DI void wave_sync() { asm volatile("s_waitcnt lgkmcnt(0)" ::: "memory"); __builtin_amdgcn_wave_barrier(); }

DI float* hrow2(float* hmeta, float* out, int tok) {
    const int b = tok >= L ? 1 : 0, t = tok - b * L;
    const unsigned long long am = (unsigned long long)(hmeta + (long long)(b * NMETA + t) * D), ao = (unsigned long long)(out + ((long long)b * SEQ + (t - NMETA)) * D);
    const unsigned long long m = 0ull - (unsigned long long)(t < NMETA);
    return (float*)((am & m) | (ao & ~m));
}
DI float* hrow(const Params& p, int tok) { return hrow2(p.hmeta, p.out, tok); }
DI float* hrow_u(const Params& p, int tok) { return hrow2(p.hmeta, p.out, __builtin_amdgcn_readfirstlane(tok)); }

DI void transpose_convert(const float* __restrict__ src, int ld, int K, int N, bf16_t* __restrict__ dst, int mult, int off, int bid, int nb, char* smem) {
    float* tile = (float*)smem;
    const int tk = K / 64, tn = N / 64, tid = tid_();
    for (int t = bid; t < tk * tn; t += nb) {
        const int k0 = (t / tn) * 64, n0 = (t % tn) * 64;
        __syncthreads();
#pragma unroll
        for (int i = 0; i < 2; ++i) {
            const int k = (tid >> 4) + 32 * i, n4 = (tid & 15) * 4;
            const f32x4 v = *(const f32x4*)(src + (size_t)(k0 + k) * ld + n0 + n4);
            tile[k * 65 + n4 + 0] = v[0]; tile[k * 65 + n4 + 1] = v[1]; tile[k * 65 + n4 + 2] = v[2]; tile[k * 65 + n4 + 3] = v[3];
        }
        __syncthreads();
        const int n = tid >> 3, kc = (tid & 7) * 8;
        u32x4 o;
#pragma unroll
        for (int j = 0; j < 4; ++j) o[j] = pack2(tile[(kc + 2 * j) * 65 + n], tile[(kc + 2 * j + 1) * 65 + n]);
        *(u32x4*)(dst + (size_t)((n0 + n) * mult + off) * K + k0 + kc) = o;
    }
}

DI void convert_experts(const Params& p, int layer, int bid, int nb, char* smem) {
    for (int e = 0; e < NE; ++e) {
        const size_t eo = ((size_t)layer * NE + e) * (size_t)D * DE;
        transpose_convert(p.ew_gate + eo, DE, D, DE, p.WtGU + (size_t)e * 1024 * 1024, 2, 0, bid, nb, smem);
        transpose_convert(p.ew_up + eo, DE, D, DE, p.WtGU + (size_t)e * 1024 * 1024, 2, 1, bid, nb, smem);
        transpose_convert(p.ew_down + eo, D, DE, D, p.WtD + (size_t)e * 1024 * 512, 1, 0, bid, nb, smem);
    }
}

DI void phase_prologue_weights(const Params& p, int bid, int nb, char* smem) {
    for (int i = bid * NTHR + tid_(); i < NE * D; i += nb * NTHR) {
        const int e = i / D, k = i % D;
        const float w = p.router_w[(size_t)k * NE + e];
        const bf16_t hi = f2bf(w);
        p.RwHi[i] = hi; p.RwLo[i] = f2bf(w - bf2f(hi));
    }
    for (int l = 0; l < DEPTH; ++l) {
        transpose_convert(p.w_in + (size_t)l * D * CIN, CIN, D, CIN, p.WtIn + (size_t)l * CIN * D, 1, 0, bid, nb, smem);
        transpose_convert(p.p_sb + (size_t)l * 512 * D, D, 512, D, p.WtPsb + (size_t)l * D * 512, 1, 0, bid, nb, smem);
        transpose_convert(p.p_rwkv + (size_t)l * 512 * D, D, 512, D, p.WtPrw + (size_t)l * D * 512, 1, 0, bid, nb, smem);
        transpose_convert(p.w_out + (size_t)l * D * D, D, D, D, p.WtOut + (size_t)l * D * D, 1, 0, bid, nb, smem);
        transpose_convert(p.w_up + (size_t)l * 64 * 512, 512, 64, 512, p.WupT + (size_t)l * 512 * 64, 1, 0, bid, nb, smem);
        transpose_convert(p.a_up + (size_t)l * 64 * 512, 512, 64, 512, p.AupT + (size_t)l * 512 * 64, 1, 0, bid, nb, smem);
        transpose_convert(p.g_up + (size_t)l * 128 * 512, 512, 128, 512, p.GupT + (size_t)l * 512 * 128, 1, 0, bid, nb, smem);
    }
}

DI void ln16(float (&v)[16], const float* __restrict__ g, const float* __restrict__ b, int lane) {
    float s = 0.f;
#pragma unroll
    for (int i = 0; i < 16; ++i) s += v[i];
    const float mean = wave_sum(s) * (1.0f / D);
    float q = 0.f;
#pragma unroll
    for (int i = 0; i < 16; ++i) { v[i] -= mean; q += v[i] * v[i]; }
    const float rstd = rsqrtf(wave_sum(q) * (1.0f / D) + 1e-5f);
#pragma unroll
    for (int j = 0; j < 4; ++j) {
        const f32x4 gv = *(const f32x4*)(g + 256 * j + 4 * lane), bv = *(const f32x4*)(b + 256 * j + 4 * lane);
#pragma unroll
        for (int i = 0; i < 4; ++i) v[4 * j + i] = v[4 * j + i] * rstd * gv[i] + bv[i];
    }
}
DI void store_row(float* __restrict__ hf, bf16_t* __restrict__ hb, const float (&v)[16], int lane) {
#pragma unroll
    for (int j = 0; j < 4; ++j) {
        *(f32x4*)(hf + 256 * j + 4 * lane) = (f32x4){v[4 * j], v[4 * j + 1], v[4 * j + 2], v[4 * j + 3]};
        *(u32x2*)(hb + 256 * j + 4 * lane) = (u32x2){pack2(v[4 * j], v[4 * j + 1]), pack2(v[4 * j + 2], v[4 * j + 3])};
    }
}

DI void store_row_bf(bf16_t* __restrict__ hb, const float (&v)[16], int lane) {
#pragma unroll
    for (int j = 0; j < 4; ++j) *(u32x2*)(hb + 256 * j + 4 * lane) = (u32x2){pack2(v[4 * j], v[4 * j + 1]), pack2(v[4 * j + 2], v[4 * j + 3])};
}
DI void phase_embed(const Params& p, int bid, int nb) {
    const int lane = tid_() & 63, wid = __builtin_amdgcn_readfirstlane(tid_() >> 6);
    const int nwaves = nb * 8, gw = bid * 8 + wid, base_n = T / nwaves, extra = T % nwaves;
    const int tok0 = gw * base_n + (gw < extra ? gw : extra), ntok = base_n + (gw < extra ? 1 : 0);
    auto srcrow = [&](int tok) -> const float* {
        const int tk = __builtin_amdgcn_readfirstlane(tok), b = tk >= L ? 1 : 0, t = tk - b * L;
        const unsigned long long am = (unsigned long long)(p.meta + (long long)t * D), ao = (unsigned long long)(p.x + ((long long)b * SEQ + (t - NMETA)) * D);
        const unsigned long long m = 0ull - (unsigned long long)(t < NMETA);
        return (const float*)((am & m) | (ao & ~m));
    };
    f32x4 an[4];
    { const float* src = srcrow(tok0);
#pragma unroll
      for (int j = 0; j < 4; ++j) an[j] = *(const f32x4*)(src + 256 * j + 4 * lane); }
#pragma unroll 1
    for (int i = 0; i < ntok; ++i) {
        const int tok = tok0 + i;
        float v[16];
#pragma unroll
        for (int j = 0; j < 4; ++j) { v[4 * j] = an[j][0]; v[4 * j + 1] = an[j][1]; v[4 * j + 2] = an[j][2]; v[4 * j + 3] = an[j][3]; }
        if (i + 1 < ntok) { const float* src = srcrow(tok + 1);
#pragma unroll
            for (int j = 0; j < 4; ++j) an[j] = *(const f32x4*)(src + 256 * j + 4 * lane); }
        ln16(v, p.emb_g, p.emb_b, lane);
        store_row_bf(p.hb + (size_t)tok * D, v, lane);
    }
}

constexpr int LDT = 72;
constexpr int GEMM_LDS = 2 * 128 * LDT * 2;
template <class ARow, class Epi>
DI void gemm_tile128(ARow arow, const bf16_t* __restrict__ Bt, int ldb, int K, int m0, int n0, char* smem, Epi epi) {
    const int tid = tid_(), lane = tid & 63, wid = __builtin_amdgcn_readfirstlane(tid >> 6), fr = lane & 15, fq = lane >> 4;
    const int wr = wid >> 1, wc = wid & 1;
    bf16_t* As = (bf16_t*)smem;
    bf16_t* Bs = As + 128 * LDT;
    const bf16_t* ap[2]; const bf16_t* bp[2]; int so[2];
#pragma unroll
    for (int i = 0; i < 2; ++i) {
        const int c = tid + NTHR * i, row = c >> 3, kc = c & 7;
        const bf16_t* ar = arow(m0 + row);
        ap[i] = ar ? ar + kc * 8 : nullptr;
        bp[i] = Bt + (size_t)(n0 + row) * ldb + kc * 8;
        so[i] = row * LDT + kc * 8;
    }
    f32x4 acc[2][4];
#pragma unroll
    for (int mi = 0; mi < 2; ++mi)
#pragma unroll
        for (int ni = 0; ni < 4; ++ni) acc[mi][ni] = (f32x4){0.f, 0.f, 0.f, 0.f};
    u32x4 ra[2], rb[2];
#pragma unroll
    for (int i = 0; i < 2; ++i) { ra[i] = ap[i] ? *(const u32x4*)(ap[i]) : (u32x4){0u, 0u, 0u, 0u}; rb[i] = *(const u32x4*)(bp[i]); }
    for (int k0 = 0; k0 < K; k0 += 64) {
        __syncthreads();
#pragma unroll
        for (int i = 0; i < 2; ++i) { *(u32x4*)(As + so[i]) = ra[i]; *(u32x4*)(Bs + so[i]) = rb[i]; }
        __syncthreads();
        if (k0 + 64 < K) {
#pragma unroll
            for (int i = 0; i < 2; ++i) { ra[i] = ap[i] ? *(const u32x4*)(ap[i] + k0 + 64) : (u32x4){0u, 0u, 0u, 0u}; rb[i] = *(const u32x4*)(bp[i] + k0 + 64); }
        }
#pragma unroll
        for (int ks = 0; ks < 2; ++ks) {
            bf16x8 af[2], bf[4];
#pragma unroll
            for (int mi = 0; mi < 2; ++mi) af[mi] = *(const bf16x8*)(As + (wr * 32 + mi * 16 + fr) * LDT + ks * 32 + fq * 8);
#pragma unroll
            for (int ni = 0; ni < 4; ++ni) bf[ni] = *(const bf16x8*)(Bs + (wc * 64 + ni * 16 + fr) * LDT + ks * 32 + fq * 8);
#pragma unroll
            for (int mi = 0; mi < 2; ++mi)
#pragma unroll
                for (int ni = 0; ni < 4; ++ni) acc[mi][ni] = __builtin_amdgcn_mfma_f32_16x16x32_bf16(bf[ni], af[mi], acc[mi][ni], 0, 0, 0);
        }
    }
#pragma unroll
    for (int mi = 0; mi < 2; ++mi)
#pragma unroll
        for (int ni = 0; ni < 4; ++ni) epi(m0 + wr * 32 + mi * 16 + fr, n0 + wc * 64 + ni * 16 + fq * 4, acc[mi][ni]);
}

namespace g8 {
#define G8_LAS __attribute__((address_space(3)))
constexpr int BM = 256, BK = 64, HALF = 128, HTB = HALF * BK * 2, STAGE_BYTES = 8 * HTB, NXCD = 8, WGM = 8;
DI int lds_byte(int r, int c) { const int st = (r >> 4) * 2 + (c >> 5), rr = r & 15, cc = c & 31, ob = rr * 64 + cc * 2; return st * 1024 + (ob ^ (((ob >> 9) & 1) << 5)); }
DI void stage_rc(int b, int& R, int& C) { const int st = b / 1024, sb = b % 1024, swz = sb ^ (((sb >> 9) & 1) << 5); R = (st >> 1) * 16 + swz / 64; C = (st & 1) * 32 + (swz % 64) / 2; }
DI int perm32(int rho) { const int n = rho >> 4, i = rho & 15; return 8 * (i >> 2) + 4 * n + (i & 3); }
struct Unit { int pm, pn; const char* A; const char* B; int e, slot0, cnt; };

struct DenseOrder {
    int nM, nN, nwg, G, c; const char* A; const char* B; size_t tstep;
    DI void init(const bf16_t* A_, const bf16_t* Bt_, int nM_, int nN_, int K, int G_, int c_) { nM = nM_; nN = nN_; nwg = nM * nN; G = G_; c = c_; A = (const char*)A_; B = (const char*)Bt_; tstep = (size_t)BM * K * 2; }
    DI bool next(int i, Unit& u) const {
        const long Lq = (long)i * G + c; if (Lq >= nwg) return false;
        int wgid = (int)Lq; { const int q = nwg / NXCD, r = nwg % NXCD, xcd = wgid % NXCD, off = wgid / NXCD; wgid = (xcd < r ? xcd * (q + 1) : r * (q + 1) + (xcd - r) * q) + off; }
        const int nig = WGM * nN, gid = wgid / nig, fm = gid * WGM, gsz = (nM - fm) < WGM ? (nM - fm) : WGM;
        u.pm = fm + ((wgid % nig) % gsz); u.pn = (wgid % nig) / gsz; u.A = A + (size_t)u.pm * tstep; u.B = B + (size_t)u.pn * tstep; u.e = 0; u.slot0 = 0; u.cnt = 0; return true;
    }
    DI unsigned row_off(const Unit&, int) const { return 0u; }
};

template <bool GATHER, class Epi, class Sched>
DI void gemm8(G8_LAS unsigned char* lds, const int K, const Sched& S, const Epi& E) {
    const int tid = tid_(), wid = __builtin_amdgcn_readfirstlane(tid >> 6), lane = tid & 63, wr = wid >> 2, wc = wid & 3, fr = lane & 15, fq = lane >> 4;
    const int nt = K / BK;
    int Rr[2], Cc[2]; unsigned voffB[2], voffA[2];
#pragma unroll
    for (int i = 0; i < 2; ++i) { stage_rc(tid * 16 + i * 8192, Rr[i], Cc[i]); const int Rb = Epi::PERM ? ((Rr[i] & ~31) + perm32(Rr[i] & 31)) : Rr[i]; voffB[i] = (unsigned)(Rb * K + Cc[i]) * 2u; voffA[i] = (unsigned)(Rr[i] * K + Cc[i]) * 2u; }
    const size_t kstep = (size_t)(BK * 2), hstep = (size_t)HALF * K * 2;
    const unsigned ldsw = (unsigned)wid * 1024u;
    const int aoff = lds_byte(wr * 64 + fr, fq * 8), boff = lds_byte(wc * 32 + fr, fq * 8);
#define G8_SA(b, h) (((b) * 2 + (h)) * HTB)
#define G8_SB(b, h) ((4 + (b) * 2 + (h)) * HTB)
#define G8_STAGE(bufoff, gbase, voff) do { _Pragma("unroll") for (int _i = 0; _i < 2; ++_i) \
        __builtin_amdgcn_global_load_lds((const unsigned*)((const char*)(gbase) + (voff)[_i]), (G8_LAS unsigned*)(lds + (bufoff) + ldsw + _i * 8192), 16, 0, 0); } while (0)
#define G8_LDA(dst, b, h) do { _Pragma("unroll") for (int m = 0; m < 4; ++m) _Pragma("unroll") for (int k = 0; k < 2; ++k) dst[m][k] = *(const G8_LAS bf16x8*)(lds + G8_SA(b, h) + aoff + m * 2048 + k * 1024); } while (0)
#define G8_LDB(dst, b, h) do { _Pragma("unroll") for (int n = 0; n < 2; ++n) _Pragma("unroll") for (int k = 0; k < 2; ++k) dst[n][k] = *(const G8_LAS bf16x8*)(lds + G8_SB(b, h) + boff + n * 2048 + k * 1024); } while (0)
#define G8_MMA(ai, bj, At, Bt) do { __builtin_amdgcn_s_setprio(1); _Pragma("unroll") for (int m = 0; m < 4; ++m) _Pragma("unroll") for (int n = 0; n < 2; ++n) _Pragma("unroll") for (int k = 0; k < 2; ++k) \
        acc[ai][bj][m][n] = __builtin_amdgcn_mfma_f32_16x16x32_bf16(Bt[n][k], At[m][k], acc[ai][bj][m][n], 0, 0, 0); __builtin_amdgcn_s_setprio(0); } while (0)
#define G8_WAIT_V(n) asm volatile("s_waitcnt vmcnt(" #n ")" ::: "memory")
#define G8_WAIT_L(n) asm volatile("s_waitcnt lgkmcnt(" #n ")" ::: "memory")
#define G8_BAR __builtin_amdgcn_s_barrier()
#define G8_SCHED __builtin_amdgcn_sched_barrier(0)
#define G8_AOFF(dst, un) do { if (GATHER) { _Pragma("unroll") for (int _h = 0; _h < 2; ++_h) _Pragma("unroll") for (int _i = 0; _i < 2; ++_i) \
        dst[_h][_i] = S.row_off(un, _h * HALF + Rr[_i]) + (unsigned)Cc[_i] * 2u; } } while (0)
#define G8_STAGE_A(bufoff, gb, vo, h) do { if (GATHER) { G8_STAGE(bufoff, gb, vo[h]); } else { G8_STAGE(bufoff, (gb) + (h) * hstep, voffA); } } while (0)
    Unit cur, nxt; int ui = 0;
    if (!S.next(0, cur)) return;
    f32x4 acc[2][2][4][2];
#pragma unroll
    for (int a = 0; a < 2; ++a)
#pragma unroll
        for (int b = 0; b < 2; ++b)
#pragma unroll
            for (int m = 0; m < 4; ++m)
#pragma unroll
                for (int n = 0; n < 2; ++n) acc[a][b][m][n] = (f32x4){0.f, 0.f, 0.f, 0.f};
    bf16x8 At[4][2], B0[2][2], B1[2][2];
    unsigned cvA[2][2], nvA[2][2];
    G8_AOFF(cvA, cur);
    const char* cA = cur.A; const char* cB = cur.B;
    G8_STAGE(G8_SB(0, 0), cB, voffB); G8_STAGE_A(G8_SA(0, 0), cA, cvA, 0); G8_STAGE(G8_SB(0, 1), cB + hstep, voffB); G8_STAGE_A(G8_SA(0, 1), cA, cvA, 1);
    if (wr == 1) G8_BAR;
    G8_WAIT_V(4); G8_BAR;
    G8_STAGE(G8_SB(1, 0), cB + kstep, voffB); G8_STAGE_A(G8_SA(1, 0), cA + kstep, cvA, 0); G8_STAGE(G8_SB(1, 1), cB + hstep + kstep, voffB);
    G8_WAIT_V(6); G8_BAR;
    for (;;) {
        const bool has_next = S.next(ui + 1, nxt);
        const char* nA = has_next ? nxt.A : cA; const char* nB = has_next ? nxt.B : cB;
        if (GATHER) {
            if (has_next) { G8_AOFF(nvA, nxt); } else {
#pragma unroll
                for (int h = 0; h < 2; ++h)
#pragma unroll
                    for (int i = 0; i < 2; ++i) nvA[h][i] = cvA[h][i];
            }
        }
        for (int t = 0; t < nt; t += 2) {
            const bool last = (t == nt - 2);
            const char* a1 = cA + (size_t)(t + 1) * kstep;
            const char* a2 = last ? nA : cA + (size_t)(t + 2) * kstep; const char* b2 = last ? nB : cB + (size_t)(t + 2) * kstep;
            const char* a3 = a2 + kstep; const char* b3 = b2 + kstep;

            G8_LDB(B0, 0, 0); G8_SCHED; G8_LDA(At, 0, 0); G8_STAGE_A(G8_SA(1, 1), a1, cvA, 1);
            if (GATHER && last) {
#pragma unroll
                for (int h = 0; h < 2; ++h)
#pragma unroll
                    for (int i = 0; i < 2; ++i) cvA[h][i] = nvA[h][i];
            }
            G8_WAIT_L(8); G8_BAR; G8_WAIT_L(0); G8_MMA(0, 0, At, B0); G8_BAR; G8_SCHED;
            G8_LDB(B1, 0, 1); G8_STAGE(G8_SB(0, 0), b2, voffB);
            G8_BAR; G8_WAIT_L(0); G8_MMA(0, 1, At, B1); G8_BAR;
            G8_LDA(At, 0, 1); G8_STAGE_A(G8_SA(0, 0), a2, cvA, 0);
            G8_BAR; G8_WAIT_L(0); G8_MMA(1, 0, At, B0); G8_BAR; G8_SCHED;
            G8_STAGE(G8_SB(0, 1), b2 + hstep, voffB);
            G8_WAIT_V(6); G8_BAR; G8_MMA(1, 1, At, B1); G8_BAR;
            G8_LDB(B0, 1, 0); G8_SCHED; G8_LDA(At, 1, 0); G8_STAGE_A(G8_SA(0, 1), a2, cvA, 1);
            G8_WAIT_L(8); G8_BAR; G8_WAIT_L(0); G8_MMA(0, 0, At, B0); G8_BAR; G8_SCHED;
            G8_LDB(B1, 1, 1); G8_STAGE(G8_SB(1, 0), b3, voffB);
            G8_BAR; G8_WAIT_L(0); G8_MMA(0, 1, At, B1); G8_BAR;
            G8_LDA(At, 1, 1); G8_STAGE_A(G8_SA(1, 0), a3, cvA, 0);
            G8_BAR; G8_WAIT_L(0); G8_MMA(1, 0, At, B0); G8_BAR; G8_SCHED;
            G8_STAGE(G8_SB(1, 1), b3 + hstep, voffB);
            G8_WAIT_V(6); G8_BAR; G8_MMA(1, 1, At, B1); G8_BAR;
        }
        { int fr2 = fr, fq2 = fq; asm volatile("" : "+v"(fr2), "+v"(fq2)); E(acc, cur, wr, wc, fr2, fq2); }
        if (!has_next) break;
#pragma unroll
        for (int a = 0; a < 2; ++a)
#pragma unroll
            for (int b = 0; b < 2; ++b)
#pragma unroll
                for (int m = 0; m < 4; ++m)
#pragma unroll
                    for (int n = 0; n < 2; ++n) acc[a][b][m][n] = (f32x4){0.f, 0.f, 0.f, 0.f};
        cur = nxt; cA = nA; cB = nB; ++ui;
    }
    G8_WAIT_V(0);
    if (wr == 0) G8_BAR;
    G8_BAR;
#undef G8_SA
#undef G8_SB
#undef G8_STAGE
#undef G8_LDA
#undef G8_LDB
#undef G8_MMA
#undef G8_WAIT_V
#undef G8_WAIT_L
#undef G8_BAR
#undef G8_SCHED
#undef G8_AOFF
#undef G8_STAGE_A
}
}

constexpr int MFULL = 64, M0_LEFT = MFULL * 256;
struct EpiStore {
    static constexpr bool PERM = true;
    bf16_t* O; int ldc; bool sig;
    DI void operator()(const f32x4 (&acc)[2][2][4][2], const g8::Unit& u, int wr, int wc, int fr, int fq) const {
#pragma unroll
        for (int ai = 0; ai < 2; ++ai)
#pragma unroll
            for (int m = 0; m < 4; ++m) {
                bf16_t* rowp = O + (size_t)(u.pm * 256 + ai * 128 + wr * 64 + m * 16 + fr) * ldc + u.pn * 256 + wc * 32 + 8 * fq;
#pragma unroll
                for (int bj = 0; bj < 2; ++bj) {
                    f32x4 v0 = acc[ai][bj][m][0], v1 = acc[ai][bj][m][1];
                    if (sig) {
#pragma unroll
                        for (int e = 0; e < 4; ++e) { v0[e] = sigmoidf_(v0[e]); v1[e] = sigmoidf_(v1[e]); }
                    }
                    *(u32x4*)(rowp + bj * 128) = (u32x4){pack2(v0[0], v0[1]), pack2(v0[2], v0[3]), pack2(v1[0], v1[1]), pack2(v1[2], v1[3])};
                }
            }
    }
};
DI int left_first(int units, int bid, int nb) { return (bid - units % nb + nb) % nb; }

constexpr int LEFT_LDS = 2 * (32 + 128) * LDT * 2;
template <class ARow, class Epi>
DI void gemm_left32(ARow arow, const bf16_t* __restrict__ Bt, int ldb, int K, int n0, char* smem, Epi epi) {
    const int tid = tid_(), lane = tid & 63, wid = __builtin_amdgcn_readfirstlane(tid >> 6), fr = lane & 15, fq = lane >> 4;
    bf16_t* As = (bf16_t*)smem;
    bf16_t* Bs = As + 2 * 32 * LDT;
    const int arow_i = tid >> 4, akc = (tid & 15) * 4;
    const bf16_t* ap = arow(arow_i) + akc;
    const bf16_t* bp[2]; int bso[2];
#pragma unroll
    for (int i = 0; i < 2; ++i) { const int cc = tid + NTHR * i, row = cc >> 3, kc = cc & 7; bp[i] = Bt + (size_t)(n0 + row) * ldb + kc * 8; bso[i] = row * LDT + kc * 8; }
    const int nit = K / 64;
    u32x2 ra[4]; u32x4 rb[4][2];
#define GL_LOAD(slot, it) do { if ((it) < nit) { ra[slot] = *(const u32x2*)(ap + (it) * 64); rb[slot][0] = *(const u32x4*)(bp[0] + (it) * 64); rb[slot][1] = *(const u32x4*)(bp[1] + (it) * 64); } } while (0)
#define GL_WRITE(slot, buf) do { *(u32x2*)(As + (buf) * 32 * LDT + arow_i * LDT + akc) = ra[slot]; *(u32x4*)(Bs + (buf) * 128 * LDT + bso[0]) = rb[slot][0]; *(u32x4*)(Bs + (buf) * 128 * LDT + bso[1]) = rb[slot][1]; } while (0)
    f32x4 acc[2] = {(f32x4){0.f, 0.f, 0.f, 0.f}, (f32x4){0.f, 0.f, 0.f, 0.f}};
    GL_LOAD(0, 0); GL_LOAD(1, 1); GL_LOAD(2, 2); GL_LOAD(3, 3);
    __syncthreads();
    GL_WRITE(0, 0);
    __syncthreads();
#define GL_STEP(slot, it) do { \
        GL_LOAD(slot, (it) + 4); \
        const int buf = (it) & 1; \
        _Pragma("unroll") for (int ks = 0; ks < 2; ++ks) { \
            const bf16x8 bf = *(const bf16x8*)(Bs + buf * 128 * LDT + (wid * 16 + fr) * LDT + ks * 32 + fq * 8); \
            _Pragma("unroll") for (int mt = 0; mt < 2; ++mt) { \
                const bf16x8 af = *(const bf16x8*)(As + buf * 32 * LDT + (mt * 16 + fr) * LDT + ks * 32 + fq * 8); \
                acc[mt] = __builtin_amdgcn_mfma_f32_16x16x32_bf16(bf, af, acc[mt], 0, 0, 0); } } \
        if ((it) + 1 < nit) { GL_WRITE(((slot) + 1) & 3, buf ^ 1); } \
        __syncthreads(); } while (0)
    for (int it = 0; it < nit; it += 4) {
        GL_STEP(0, it);
        if (it + 1 < nit) GL_STEP(1, it + 1);
        if (it + 2 < nit) GL_STEP(2, it + 2);
        if (it + 3 < nit) GL_STEP(3, it + 3);
    }
#undef GL_LOAD
#undef GL_WRITE
#undef GL_STEP
#pragma unroll
    for (int mt = 0; mt < 2; ++mt) epi(mt * 16 + fr, n0 + wid * 16 + fq * 4, acc[mt]);
}

DI void phase_inproj(const Params& p, int layer, int bid, int nb, char* smem) {
    const bf16_t* hb = p.hb; bf16_t* P = p.P;
    const bf16_t* Bt = p.WtIn + (size_t)layer * CIN * D;
    g8::DenseOrder S; S.init(hb, Bt, MFULL, CP / 256, D, nb, bid);
    g8::gemm8<false>((G8_LAS unsigned char*)smem, D, S, EpiStore{P, CP, false});
    bf16_t* G = p.gleft - (size_t)M0_LEFT * 2048; const bf16_t* Wg = p.WtIn + ((size_t)layer * CIN + CP) * D;
    for (int t = left_first(MFULL * (CP / 256), bid, nb); t < CP / 128 + 2048 / 128; t += nb) {
        if (t < CP / 128)
            gemm_left32([=](int r) { return hb + (size_t)(M0_LEFT + r) * D; }, Bt, D, D, t * 128, smem,
                        [=](int r, int c, f32x4 v) { *(u32x2*)(P + (size_t)(M0_LEFT + r) * CP + c) = (u32x2){pack2(v[0], v[1]), pack2(v[2], v[3])}; });
        else
            gemm_left32([=](int r) { return hb + (size_t)(M0_LEFT + r) * D; }, Wg, D, D, (t - CP / 128) * 128, smem,
                        [=](int r, int c, f32x4 v) { *(u32x2*)(G + (size_t)(M0_LEFT + r) * 2048 + c) = (u32x2){pack2(sigmoidf_(v[0]), sigmoidf_(v[1])), pack2(sigmoidf_(v[2]), sigmoidf_(v[3]))}; });
    }
}

constexpr int NCHUNK = (L + 63) / 64, NUNIT = NBATCH * HEADS * NCHUNK;
constexpr int LS = 72, RB = 64 * LS * 2;
constexpr int R1_LDS = 16 * RB + 4096 + 7168;
#define RBUF(i) ((bf16_t*)(smem + (i) * RB))
typedef float f32x16 __attribute__((ext_vector_type(16)));

template <int KK> DI f32x4 mm16(const bf16_t* F, int ldf, const bf16_t* S, int lds_, f32x4 acc, int lane) {
    const int fr = lane & 15, fq = lane >> 4;
#pragma unroll
    for (int ks = 0; ks < KK / 32; ++ks) {
        const bf16x8 f = *(const bf16x8*)(F + fr * ldf + ks * 32 + fq * 8);
        const bf16x8 g = *(const bf16x8*)(S + fr * lds_ + ks * 32 + fq * 8);
        acc = __builtin_amdgcn_mfma_f32_16x16x32_bf16(f, g, acc, 0, 0, 0);
    }
    return acc;
}
DI u32x2 pk4(f32x4 v) { return (u32x2){pack2(v[0], v[1]), pack2(v[2], v[3])}; }
DI f32x4 up4(u32x2 v) { return (f32x4){lo_bf(v[0]), hi_bf(v[0]), lo_bf(v[1]), hi_bf(v[1])}; }

template <int MODE> DI void phase_rwkv_r1(const Params& p, int layer, int bid, int nb, char* smem) {
    const int wv = __builtin_amdgcn_readfirstlane(tid_() >> 6);
    const f32x4 zero = (f32x4){0.f, 0.f, 0.f, 0.f};
    float* lwT = (float*)RBUF(4);
    float* aT = (float*)RBUF(6);
    float* gt = (float*)(smem + 16 * RB);
    float* gammaC = gt + 512;
    bf16_t* Xt0 = RBUF(14);
    bf16_t* Xt1 = RBUF(4);
    const bf16_t* WupT = p.WupT + (size_t)layer * 512 * 64, *AupT = p.AupT + (size_t)layer * 512 * 64, *GupT = p.GupT + (size_t)layer * 512 * 128;
    float* mu = (float*)(smem + 16 * RB + 4096);
    __syncthreads();
    for (int i = tid_(); i < RSW; i += NTHR) mu[i] = p.mu[(size_t)layer * RSW + i];
    for (int it = 0;; ++it) {
        const int tid = tid_(), lane = tid & 63, fr = lane & 15, fq = lane >> 4;
        int c, bh;
        if (MODE == 0) {
            const int Lq = it * nb + bid, q = Lq >> 3, cb = (q >> 3) * 8 + (Lq & 7);
            if (cb >= NBATCH * (NCHUNK - 1)) break;
            c = cb % (NCHUNK - 1); bh = (cb / (NCHUNK - 1)) * HEADS + (q & 7);
        } else {
            if (it > 0) break;
            c = NCHUNK - 1; bh = bid;
        }
        const int u = bh * NCHUNK + c, h = bh % HEADS, bb = bh / HEADS;
        const size_t tok0 = (size_t)bb * L + c * 64;
        bf16x8 fw[2][2], fa[2][2], fg[2][4];
#pragma unroll
        for (int t2 = 0; t2 < 2; ++t2) {
            const int tl = wv * 2 + t2, pt = tl >> 2, qt = tl & 3;
#pragma unroll
            for (int ks = 0; ks < 2; ++ks) {
                fw[t2][ks] = *(const bf16x8*)(WupT + (size_t)(h * 64 + qt * 16 + fr) * 64 + ks * 32 + fq * 8);
                fa[t2][ks] = *(const bf16x8*)(AupT + (size_t)(h * 64 + pt * 16 + fr) * 64 + ks * 32 + fq * 8);
            }
        }
        __syncthreads();
        {
            u32x4 curv[7], prvv[7];
#pragma unroll
            for (int it2 = 0; it2 < 7; ++it2) {
                const int cid = tid + NTHR * it2, i = cid / 56, cc = cid % 56;
                const int col = cc < 8 ? RW_R + h * 64 + cc * 8 : cc < 16 ? RW_K + h * 64 + (cc - 8) * 8 : cc < 24 ? RW_V + h * 64 + (cc - 16) * 8 : RW_WD + (cc - 24) * 8;
                const int t = c * 64 + i;
                curv[it2] = (u32x4){0u, 0u, 0u, 0u}; prvv[it2] = (u32x4){0u, 0u, 0u, 0u};
                if (t < L) curv[it2] = *(const u32x4*)(p.P + (tok0 + i) * CP + OFF_RW + col);
                if (t < L && t > 0) prvv[it2] = *(const u32x4*)(p.P + (tok0 + i - 1) * CP + OFF_RW + col);
            }
#pragma unroll
            for (int it2 = 0; it2 < 7; ++it2) {
                const int cid = tid + NTHR * it2, i = cid / 56, cc = cid % 56;
                const int col = cc < 8 ? RW_R + h * 64 + cc * 8 : cc < 16 ? RW_K + h * 64 + (cc - 8) * 8 : cc < 24 ? RW_V + h * 64 + (cc - 16) * 8 : RW_WD + (cc - 24) * 8;
                bf16_t* dst = cc < 8 ? RBUF(8) + i * LS + cc * 8 : cc < 16 ? RBUF(9) + i * LS + (cc - 8) * 8 : cc < 24 ? RBUF(10) + i * LS + (cc - 16) * 8
                            : cc < 32 ? RBUF(0) + i * LS + (cc - 24) * 8 : cc < 40 ? RBUF(1) + i * LS + (cc - 32) * 8 : RBUF(2) + i * 136 + (cc - 40) * 8;
                const f32x4 m0 = *(const f32x4*)(mu + col), m1 = *(const f32x4*)(mu + col + 4);
                const u32x4 cur = curv[it2], prv = prvv[it2];
                float x[8];
#pragma unroll
                for (int j2 = 0; j2 < 4; ++j2) {
                    const float c0 = lo_bf(cur[j2]), c1 = hi_bf(cur[j2]), p0 = lo_bf(prv[j2]), p1 = hi_bf(prv[j2]);
                    const float mm0 = j2 < 2 ? m0[2 * j2] : m1[2 * j2 - 4], mm1 = j2 < 2 ? m0[2 * j2 + 1] : m1[2 * j2 - 3];
                    x[2 * j2] = c0 + (p0 - c0) * mm0; x[2 * j2 + 1] = c1 + (p1 - c1) * mm1;
                }
                if (cc >= 24 && cc < 32) {
#pragma unroll
                    for (int j2 = 0; j2 < 8; ++j2) x[j2] = tanhf_(x[j2]);
                } else if (cc >= 40) {
#pragma unroll
                    for (int j2 = 0; j2 < 8; ++j2) x[j2] = sigmoidf_(x[j2]);
                }
                *(u32x4*)dst = (u32x4){pack2(x[0], x[1]), pack2(x[2], x[3]), pack2(x[4], x[5]), pack2(x[6], x[7])};
            }
        }
#pragma unroll
        for (int t2 = 0; t2 < 2; ++t2)
#pragma unroll
            for (int ks = 0; ks < 4; ++ks) fg[t2][ks] = *(const bf16x8*)(GupT + (size_t)(h * 64 + ((wv * 2 + t2) >> 2) * 16 + fr) * 128 + ks * 32 + fq * 8);
        __syncthreads();
#pragma unroll
        for (int t2 = 0; t2 < 2; ++t2) {
            const int tl = wv * 2 + t2, pt = tl >> 2, qt = tl & 3;
            f32x4 aw = zero, aa = zero, ag = zero;
#pragma unroll
            for (int ks = 0; ks < 2; ++ks) {
                const bf16x8 xw = *(const bf16x8*)(RBUF(0) + (pt * 16 + fr) * LS + ks * 32 + fq * 8);
                aw = __builtin_amdgcn_mfma_f32_16x16x32_bf16(xw, fw[t2][ks], aw, 0, 0, 0);
                const bf16x8 xa = *(const bf16x8*)(RBUF(1) + (qt * 16 + fr) * LS + ks * 32 + fq * 8);
                aa = __builtin_amdgcn_mfma_f32_16x16x32_bf16(fa[t2][ks], xa, aa, 0, 0, 0);
            }
#pragma unroll
            for (int ks = 0; ks < 4; ++ks) {
                const bf16x8 xg = *(const bf16x8*)(RBUF(2) + (qt * 16 + fr) * 136 + ks * 32 + fq * 8);
                ag = __builtin_amdgcn_mfma_f32_16x16x32_bf16(fg[t2][ks], xg, ag, 0, 0, 0);
            }
            const int ch = qt * 16 + fr;
            const float w0 = p.w0[layer * 512 + h * 64 + ch];
            const f32x4 a0 = *(const f32x4*)(p.a0 + layer * 512 + h * 64 + pt * 16 + fq * 4);
            f32x4 lw, av;
#pragma unroll
            for (int e = 0; e < 4; ++e) { lw[e] = -DECAY_SCALE * sigmoidf_(w0 + aw[e]); av[e] = sigmoidf_(a0[e] + aa[e]); }
            *(f32x4*)(lwT + ch * 68 + pt * 16 + fq * 4) = lw;
            *(f32x4*)(aT + (qt * 16 + fr) * 68 + pt * 16 + fq * 4) = av;
            *(u32x2*)(p.GG + ((size_t)u * 64 + qt * 16 + fr) * 64 + pt * 16 + fq * 4) = pk4(ag);
        }
        __syncthreads();
        {
            const int i = tid >> 3, c8 = (tid & 7) * 8, cg = layer * 512 + h * 64 + c8;
            const u32x4 xr = *(const u32x4*)(RBUF(8) + i * LS + c8), xk = *(const u32x4*)(RBUF(9) + i * LS + c8);
            const f32x4 a0 = *(const f32x4*)(aT + i * 68 + c8), a1 = *(const f32x4*)(aT + i * 68 + c8 + 4);
            const f32x4 kk0 = *(const f32x4*)(p.k_k + cg), kk1 = *(const f32x4*)(p.k_k + cg + 4), ka0 = *(const f32x4*)(p.k_a + cg), ka1 = *(const f32x4*)(p.k_a + cg + 4);
            const f32x4 rk0 = *(const f32x4*)(p.r_k + cg), rk1 = *(const f32x4*)(p.r_k + cg + 4);
            float n2 = 0.f, bon = 0.f;
#pragma unroll
            for (int j = 0; j < 8; ++j) {
                const float r_ = (j & 1) ? hi_bf(xr[j >> 1]) : lo_bf(xr[j >> 1]), k_ = (j & 1) ? hi_bf(xk[j >> 1]) : lo_bf(xk[j >> 1]);
                const float a_ = j < 4 ? a0[j & 3] : a1[j & 3], kkc = j < 4 ? kk0[j & 3] : kk1[j & 3], kac = j < 4 ? ka0[j & 3] : ka1[j & 3], rkc = j < 4 ? rk0[j & 3] : rk1[j & 3];
                const float kkr = k_ * kkc;
                n2 += kkr * kkr;
                bon += r_ * (k_ * (1.0f + (a_ - 1.0f) * kac)) * rkc;
            }
            n2 = sum8(n2); bon = sum8(bon);
            if ((tid & 7) == 0) { gt[576 + i] = 1.0f / fmaxf(sqrtf(n2), 1e-12f); p.bonG[(size_t)u * 64 + i] = bon; }
        }
        __syncthreads();
        {
            const int ch = lane, cg = layer * 512 + h * 64 + ch;
            float lw[8], av[8], cum[8];
            {
                const f32x4 l0 = *(const f32x4*)(lwT + ch * 68 + wv * 8), l1 = *(const f32x4*)(lwT + ch * 68 + wv * 8 + 4);
#pragma unroll
                for (int e = 0; e < 4; ++e) { lw[e] = l0[e]; lw[e + 4] = l1[e]; }
#pragma unroll
                for (int e = 0; e < 8; ++e) av[e] = aT[(wv * 8 + e) * 68 + ch];
            }
            float run = 0.f;
#pragma unroll
            for (int e = 0; e < 8; ++e) { run += lw[e]; cum[e] = run; }
            gt[wv * 64 + ch] = run;
            __syncthreads();
            float offs = 0.f, tot = 0.f;
#pragma unroll
            for (int g2 = 0; g2 < 8; ++g2) { const float gv = gt[g2 * 64 + ch]; offs += g2 < wv ? gv : 0.f; tot += gv; }
            if (wv == 0) gammaC[ch] = __expf(tot);
            const float kkc = p.k_k[cg], kac = p.k_a[cg];
            float at_[8], kt_[8], bt_[8], vt_[8];
#pragma unroll
            for (int e = 0; e < 8; ++e) {
                const int i = wv * 8 + e;
                const float xr = bf2f(RBUF(8)[i * LS + ch]), xk = bf2f(RBUF(9)[i * LS + ch]), xv = bf2f(RBUF(10)[i * LS + ch]);
                const float cm = cum[e] + offs;
                const float kk = xk * kkc * gt[576 + i];
                const float kq = xk * (1.0f + (av[e] - 1.0f) * kac);
                if (c * 64 + i < L) p.orw[(tok0 + i) * 512 + h * 64 + ch] = RBUF(10)[i * LS + ch];
                const float eneg = __expf(-cm), epos = __expf(cm), eexc = __expf(cm - lw[e]);
                at_[e] = -kk * eexc; kt_[e] = kq * eneg; bt_[e] = kk * av[e] * eneg; vt_[e] = xv;
                RBUF(3)[i * LS + ch] = f2bf(xr * epos);
            }
            __syncthreads();
#pragma unroll
            for (int e = 0; e < 8; ++e) {
                const int i = wv * 8 + e;
                RBUF(0)[i * LS + ch] = f2bf(at_[e]); RBUF(1)[i * LS + ch] = f2bf(kt_[e]); RBUF(2)[i * LS + ch] = f2bf(bt_[e]);
            }
            *(u32x4*)(RBUF(11) + ch * LS + wv * 8) = (u32x4){pack2(kt_[0], kt_[1]), pack2(kt_[2], kt_[3]), pack2(kt_[4], kt_[5]), pack2(kt_[6], kt_[7])};
            *(u32x4*)(RBUF(12) + ch * LS + wv * 8) = (u32x4){pack2(bt_[0], bt_[1]), pack2(bt_[2], bt_[3]), pack2(bt_[4], bt_[5]), pack2(bt_[6], bt_[7])};
            *(u32x4*)(RBUF(13) + ch * LS + wv * 8) = (u32x4){pack2(vt_[0], vt_[1]), pack2(vt_[2], vt_[3]), pack2(vt_[4], vt_[5]), pack2(vt_[6], vt_[7])};
            *(u32x4*)(Xt0 + ch * LS + wv * 8) = (u32x4){pack2(at_[0], at_[1]), pack2(at_[2], at_[3]), pack2(at_[4], at_[5]), pack2(at_[6], at_[7])};
        }
        __syncthreads();
#pragma unroll
        for (int prod = 0; prod < 5; ++prod) {
            const bf16_t* F = prod == 0 ? RBUF(1) : prod == 1 ? RBUF(2) : prod == 2 ? RBUF(0) : prod == 3 ? RBUF(1) : RBUF(2);
            const bf16_t* S = prod == 0 ? RBUF(0) : prod == 1 ? RBUF(0) : prod == 2 ? RBUF(2) : RBUF(3);
            bf16_t* O = prod == 0 ? RBUF(6) : prod == 1 ? RBUF(7) : prod == 2 ? RBUF(8) : prod == 3 ? RBUF(9) : RBUF(10);
            const int mode = prod < 2 ? 0 : prod == 2 ? 2 : 1;
#pragma unroll
            for (int rep = 0; rep < 2; ++rep) {
                const int tl = wv + 8 * rep, pt = tl >> 2, qt = tl & 3;
                f32x4 acc = zero;
                if (mode == 2 ? pt >= qt : pt <= qt) acc = mm16<64>(F + pt * 16 * LS, LS, S + qt * 16 * LS, LS, zero, lane);
                const int qi = qt * 16 + fr;
#pragma unroll
                for (int e = 0; e < 4; ++e) {
                    const int pi = pt * 16 + fq * 4 + e;
                    const bool keep = mode == 0 ? pi < qi : (mode == 1 ? pi <= qi : qi < pi);
                    acc[e] = keep ? acc[e] : 0.f;
                }
                *(u32x2*)(O + qi * LS + pt * 16 + fq * 4) = pk4(acc);
            }
        }
        __syncthreads();
        f32x4 X[4];
        if (wv < 4) {
#pragma unroll
            for (int pt = 0; pt < 4; ++pt) X[pt] = up4(*(const u32x2*)(Xt0 + (wv * 16 + fr) * LS + pt * 16 + fq * 4));
        } else {
#pragma unroll
            for (int pt = 0; pt < 4; ++pt) {
                X[pt] = mm16<64>(RBUF(6) + pt * 16 * LS, LS, RBUF(13) + (wv - 4) * 16 * LS, LS, zero, lane);
                *(u32x2*)(Xt0 + (wv * 16 + fr) * LS + pt * 16 + fq * 4) = pk4(X[pt]);
            }
        }
        __syncthreads();
#pragma unroll
        for (int k = 0; k < 6; ++k) {
            const bf16_t* Mk = (k & 1) ? RBUF(0) : RBUF(7);
            const bf16_t* Mkt = (k & 1) ? RBUF(6) : RBUF(8);
            bf16_t* Mn = (k & 1) ? RBUF(7) : RBUF(0);
            bf16_t* Mnt = (k & 1) ? RBUF(8) : RBUF(6);
            const bf16_t* Xc = (k & 1) ? Xt1 : Xt0;
            bf16_t* Xn = (k & 1) ? Xt0 : Xt1;
#pragma unroll
            for (int pt = 0; pt < 4; ++pt) {
                constexpr int dummy = 0; (void)dummy;
                const int maxj = 16 * pt + 15 - (1 << k);
                if (maxj >= 0) {
                    const int nks = maxj / 32 + 1;
#pragma unroll
                    for (int ks = 0; ks < 2; ++ks)
                        if (ks < nks) {
                            const bf16x8 f = *(const bf16x8*)(Mk + (pt * 16 + fr) * LS + ks * 32 + fq * 8);
                            const bf16x8 g = *(const bf16x8*)(Xc + (wv * 16 + fr) * LS + ks * 32 + fq * 8);
                            X[pt] = __builtin_amdgcn_mfma_f32_16x16x32_bf16(f, g, X[pt], 0, 0, 0);
                        }
                }
                *(u32x2*)(Xn + (wv * 16 + fr) * LS + pt * 16 + fq * 4) = pk4(X[pt]);
            }
            if (k < 5) {
#pragma unroll
                for (int which = 0; which < 2; ++which) {
                    const bf16_t* F = which ? Mk : Mkt; const bf16_t* S = which ? Mkt : Mk; bf16_t* O = which ? Mnt : Mn;
#pragma unroll
                    for (int rep = 0; rep < 2; ++rep) {
                        const int t2 = wv + 8 * rep, pt = t2 >> 2, qt = t2 & 3;
                        const int it = which ? pt : qt, jt = which ? qt : pt;
                        f32x4 acc = zero;
                        const int mlo = 16 * jt + (1 << k), mhi = 16 * it + 15 - (1 << k);
                        if (16 * it + 15 - 16 * jt >= (2 << k) && mhi >= mlo) {
                            const int k0 = mlo >> 5, k1 = mhi >> 5;
                            for (int ks = k0; ks <= k1; ++ks) {
                                const bf16x8 f = *(const bf16x8*)(F + (pt * 16 + fr) * LS + ks * 32 + fq * 8);
                                const bf16x8 g = *(const bf16x8*)(S + (qt * 16 + fr) * LS + ks * 32 + fq * 8);
                                acc = __builtin_amdgcn_mfma_f32_16x16x32_bf16(f, g, acc, 0, 0, 0);
                            }
                        }
                        *(u32x2*)(O + (qt * 16 + fr) * LS + pt * 16 + fq * 4) = pk4(acc);
                    }
                }
            }
            __syncthreads();
        }
#pragma unroll
        for (int rep = 0; rep < 2; ++rep) {
            const int tl = wv + 8 * rep, pt = tl >> 2, qt = tl & 3;
            const int pi0 = pt * 16 + fq * 4, qi = qt * 16 + fr;
            const size_t go = ((size_t)u * 64 + qi) * 64 + pi0;
            {
                f32x4 acc = mm16<64>(Xt0 + pt * 16 * LS, LS, RBUF(12) + qt * 16 * LS, LS, zero, lane);
                const float gc = gammaC[qi];
#pragma unroll
                for (int e = 0; e < 4; ++e) acc[e] = (acc[e] + (pi0 + e == qi ? 1.f : 0.f)) * gc;
                {
                    const size_t d = (((size_t)u * 8 + (qi >> 5) * 4 + (pi0 >> 4)) * 64 + (qi & 31) + 32 * ((pi0 >> 2) & 1)) * 8 + ((pi0 >> 3) & 1) * 4;
                    *(u32x2*)(p.PcG + d) = pk4(acc);
                }
            }
            {
                f32x4 acc = mm16<64>(RBUF(11) + pt * 16 * LS, LS, RBUF(13) + qt * 16 * LS, LS, zero, lane);
                acc = mm16<64>(RBUF(12) + pt * 16 * LS, LS, Xt0 + (64 + qt * 16) * LS, LS, acc, lane);
                const f32x4 gc = *(const f32x4*)(gammaC + pi0);
#pragma unroll
                for (int e = 0; e < 4; ++e) acc[e] *= gc[e];
                {
                    const int kk = pi0 & 31;
                    const size_t d = (((size_t)u * 4 + (qi >> 5) * 2 + (pi0 >> 5)) * 64 + (qi & 31) + 32 * ((kk >> 2) & 1)) * 16 + (kk >> 3) * 4;
                    *(u32x2*)(p.QcG + d) = pk4(acc);
                }
            }
            {
                f32x4 acc = mm16<64>(Xt0 + pt * 16 * LS, LS, RBUF(10) + qt * 16 * LS, LS, zero, lane);
                const f32x4 rr = up4(*(const u32x2*)(RBUF(3) + qi * LS + pi0));
#pragma unroll
                for (int e = 0; e < 4; ++e) acc[e] += rr[e];
                *(u32x2*)(p.RhG + go) = pk4(acc);
            }
            {
                f32x4 acc = mm16<64>(RBUF(13) + pt * 16 * LS, LS, RBUF(9) + qt * 16 * LS, LS, zero, lane);
                acc = mm16<64>(Xt0 + (64 + pt * 16) * LS, LS, RBUF(10) + qt * 16 * LS, LS, acc, lane);
                *(u32x2*)(p.Y0G + go) = pk4(acc);
            }
        }
    }
}

struct R2Set { u32x4 a[8]; u32x4 q[4]; };
DI void r2_load(R2Set& st, const Params& p, size_t u, int lane, int vh) {
#pragma unroll
    for (int kt = 0; kt < 2; ++kt) {
        const bf16_t* qg = p.QcG + ((u * 4 + vh * 2 + kt) * 64 + lane) * 16;
        st.q[kt * 2] = *(const u32x4*)qg; st.q[kt * 2 + 1] = *(const u32x4*)(qg + 8);
    }
#pragma unroll
    for (int f = 0; f < 8; ++f) st.a[f] = *(const u32x4*)(p.PcG + ((u * 8 + f) * 64 + lane) * 8);
}
DI void r2_step(f32x16 (&S)[2], const R2Set& st, const Params& p, size_t u, int lane, int vh, bool last) {
#pragma unroll
    for (int kt = 0; kt < 2; ++kt) {
        bf16_t* sg = p.SG + ((u * 4 + vh * 2 + kt) * 64 + lane) * 16;
        *(u32x4*)sg = (u32x4){pack2(S[kt][0], S[kt][1]), pack2(S[kt][2], S[kt][3]), pack2(S[kt][4], S[kt][5]), pack2(S[kt][6], S[kt][7])};
        *(u32x4*)(sg + 8) = (u32x4){pack2(S[kt][8], S[kt][9]), pack2(S[kt][10], S[kt][11]), pack2(S[kt][12], S[kt][13]), pack2(S[kt][14], S[kt][15])};
    }
    if (last) return;
    bf16x8 bfr[4];
#pragma unroll
    for (int ts = 0; ts < 4; ++ts) {
        const int tl = ts >> 1, sp = ts & 1;
        const u32x4 pk = (u32x4){pack2(S[tl][8 * sp], S[tl][8 * sp + 1]), pack2(S[tl][8 * sp + 2], S[tl][8 * sp + 3]),
                                 pack2(S[tl][8 * sp + 4], S[tl][8 * sp + 5]), pack2(S[tl][8 * sp + 6], S[tl][8 * sp + 7])};
        bfr[ts] = __builtin_bit_cast(bf16x8, pk);
    }
#pragma unroll
    for (int kt = 0; kt < 2; ++kt)
#pragma unroll
        for (int hf = 0; hf < 2; ++hf)
#pragma unroll
            for (int w = 0; w < 4; ++w) { S[kt][8 * hf + 2 * w] = lo_bf(st.q[kt * 2 + hf][w]); S[kt][8 * hf + 2 * w + 1] = hi_bf(st.q[kt * 2 + hf][w]); }
#pragma unroll
    for (int ts = 0; ts < 4; ++ts)
#pragma unroll
        for (int kt = 0; kt < 2; ++kt)
            S[kt] = __builtin_amdgcn_mfma_f32_32x32x16_bf16(__builtin_bit_cast(bf16x8, st.a[kt * 4 + ts]), bfr[ts], S[kt], 0, 0, 0);
}
DI void phase_rwkv_r2(const Params& p, int chain) {
    const int lane = tid_() & 63, wv = __builtin_amdgcn_readfirstlane(tid_() >> 6);
    if (wv != 0) return;
    const int bh = chain >> 1, vh = chain & 1;
    const size_t u0 = (size_t)bh * NCHUNK;
    f32x16 S[2];
#pragma unroll
    for (int e = 0; e < 16; ++e) { S[0][e] = 0.f; S[1][e] = 0.f; }
    R2Set A, B;
    r2_load(A, p, u0, lane, vh);
    r2_load(B, p, u0 + 1, lane, vh);
#pragma unroll 1
    for (int c = 0; c < NCHUNK; c += 2) {
        r2_step(S, A, p, u0 + c, lane, vh, c == NCHUNK - 1);
        if (c == NCHUNK - 1) break;
        if (c + 2 < NCHUNK - 1) r2_load(A, p, u0 + c + 2, lane, vh);
        r2_step(S, B, p, u0 + c + 1, lane, vh, false);
        if (c + 3 < NCHUNK - 1) r2_load(B, p, u0 + c + 3, lane, vh);
    }
}

DI void phase_rwkv_r3(const Params& p, int layer, int bid, int nb) {
    const int tid = tid_(), lane = tid & 63, wv = __builtin_amdgcn_readfirstlane(tid >> 6), fr = lane & 15, fq = lane >> 4;
    for (int task = bid * 8 + wv; task < NUNIT * 4; task += nb * 8) {
        const int u = task >> 2, it = task & 3;
        const int c = u % NCHUNK, bh = u / NCHUNK, h = bh % HEADS, bb = bh / HEADS;
        const int i = it * 16 + fr, t = c * 64 + i;
        const size_t tok = (size_t)bb * L + t;
        bf16x8 sf[2];
#pragma unroll
        for (int ks = 0; ks < 2; ++ks) sf[ks] = *(const bf16x8*)(p.RhG + ((size_t)u * 64 + i) * 64 + ks * 32 + fq * 8);
        f32x4 y[4];
#pragma unroll
        for (int vt = 0; vt < 4; ++vt) {
            y[vt] = up4(*(const u32x2*)(p.Y0G + ((size_t)u * 64 + i) * 64 + vt * 16 + fq * 4));
#pragma unroll
            for (int ks = 0; ks < 2; ++ks) {
                const int vv = vt * 16 + fr;
                const bf16_t* sp = p.SG + (((size_t)u * 4 + (vv >> 5) * 2 + ks) * 64 + (vv & 31)) * 16 + 4 * fq;
                const u32x2 s0 = *(const u32x2*)sp, s1 = *(const u32x2*)(sp + 32 * 16);
                const bf16x8 f = __builtin_bit_cast(bf16x8, ((u32x4){s0[0], s0[1], s1[0], s1[1]}));
                y[vt] = __builtin_amdgcn_mfma_f32_16x16x32_bf16(f, sf[ks], y[vt], 0, 0, 0);
            }
        }
        float s = 0.f;
#pragma unroll
        for (int vt = 0; vt < 4; ++vt) s += (y[vt][0] + y[vt][1]) + (y[vt][2] + y[vt][3]);
        s += __shfl_xor(s, 16); s += __shfl_xor(s, 32);
        const float mean = s * (1.0f / 64.f);
        float q = 0.f;
#pragma unroll
        for (int vt = 0; vt < 4; ++vt)
#pragma unroll
            for (int e = 0; e < 4; ++e) { y[vt][e] -= mean; q += y[vt][e] * y[vt][e]; }
        q += __shfl_xor(q, 16); q += __shfl_xor(q, 32);
        const float rstd = rsqrtf(q * (1.0f / 64.f) + 64e-5f);
        if (t < L) {
            const float bon = p.bonG[(size_t)u * 64 + i];
#pragma unroll
            for (int vt = 0; vt < 4; ++vt) {
                const int v0 = vt * 16 + fq * 4, cg = h * 64 + v0;
                const f32x4 xv = up4(*(const u32x2*)(p.orw + tok * 512 + cg));
                const f32x4 g = up4(*(const u32x2*)(p.GG + ((size_t)u * 64 + i) * 64 + v0));
                const f32x4 lg = *(const f32x4*)(p.lnx_g + layer * 512 + cg), lb = *(const f32x4*)(p.lnx_b + layer * 512 + cg);
                f32x4 o;
#pragma unroll
                for (int e = 0; e < 4; ++e) {
                    o[e] = (y[vt][e] * rstd * lg[e] + lb[e] + bon * xv[e]) * g[e];
                }
                *(u32x2*)(p.orw + tok * 512 + cg) = pk4(o);
            }
        }
    }
}

constexpr int SB_LDS = 2 * RB + 64;
DI void phase_sb(const Params& p, int bid0, int nb, char* smem) {
    const int tid = tid_(), lane = tid & 63, wv = __builtin_amdgcn_readfirstlane(tid >> 6), fr = lane & 15, fq = lane >> 4;
    bf16_t* Ks = (bf16_t*)smem;
    bf16_t* Vt = Ks + 64 * LS;
    int* flags = (int*)(smem + 2 * RB);
    bf16x8 tri[4][2];
#pragma unroll
    for (int st = 0; st < 4; ++st)
#pragma unroll
        for (int k2 = 0; k2 < 2; ++k2)
#pragma unroll
            for (int jj = 0; jj < 8; ++jj) tri[st][k2][jj] = (32 * k2 + 16 * (jj >> 2) + 4 * fq + (jj & 3) > 16 * st + fr) ? (short)0x3F80 : (short)0;
    constexpr int NQB = (L + 127) / 128;
    const int ldkey = tid >> 3, lddc = (tid & 7) * 8;
    for (int u = bid0; u < NBATCH * HEADS * NQB; u += nb) {
        const int bh = u % (NBATCH * HEADS), b = bh / HEADS, h = bh % HEADS, q0 = (u / (NBATCH * HEADS)) * 128;
        const int qlo = q0 + 16 * wv, query = qlo + fr;
        const size_t tokb = (size_t)b * L;
        bf16x8 qf[2];
#pragma unroll
        for (int ks = 0; ks < 2; ++ks) qf[ks] = *(const bf16x8*)(p.P + (tokb + query) * CP + OFF_Q + h * 64 + ks * 32 + fq * 8);
        const int qmax = (q0 + 127 < L - 1) ? q0 + 127 : L - 1;
        int kt = (qmax - 1) >> 6;
        float R = 0.f;
        f32x4 ot[4];
#pragma unroll
        for (int dt = 0; dt < 4; ++dt) ot[dt] = (f32x4){0.f, 0.f, 0.f, 0.f};
        bool done = qlo >= L;
        u32x4 kreg, vreg;
        {
            const int s = kt * 64 + ldkey;
            const bf16_t* src = p.P + (tokb + s) * CP + h * 64 + lddc;
            kreg = s < L ? *(const u32x4*)(src + OFF_K) : (u32x4){0u, 0u, 0u, 0u};
            vreg = s < L ? *(const u32x4*)(src + OFF_V) : (u32x4){0u, 0u, 0u, 0u};
        }
        for (;;) {
            __syncthreads();
            *(u32x4*)(Ks + ldkey * LS + lddc) = kreg;
#pragma unroll
            for (int j = 0; j < 4; ++j) { Vt[(lddc + 2 * j) * LS + ldkey] = (bf16_t)(vreg[j] & 0xFFFFu); Vt[(lddc + 2 * j + 1) * LS + ldkey] = (bf16_t)(vreg[j] >> 16); }
            __syncthreads();
            if (kt > 0) {
                const int s = (kt - 1) * 64 + ldkey;
                const bf16_t* src = p.P + (tokb + s) * CP + h * 64 + lddc;
                kreg = *(const u32x4*)(src + OFF_K); vreg = *(const u32x4*)(src + OFF_V);
            }
            if (!done && kt * 64 < qlo + 15) {
                f32x4 uu[4], lsp[4];
                float tot = 0.f;
#pragma unroll
                for (int kk = 0; kk < 4; ++kk) {
                    f32x4 z = (f32x4){0.f, 0.f, 0.f, 0.f};
#pragma unroll
                    for (int ks = 0; ks < 2; ++ks) {
                        const bf16x8 f = *(const bf16x8*)(Ks + (16 * kk + fr) * LS + ks * 32 + fq * 8);
                        z = __builtin_amdgcn_mfma_f32_16x16x32_bf16(f, qf[ks], z, 0, 0, 0);
                    }
#pragma unroll
                    for (int e = 0; e < 4; ++e) {
                        const float zz = z[e] * 0.125f;
                        const float lsneg = -(fmaxf(zz, 0.f) + __logf(1.0f + __expf(-fabsf(zz))));
                        const bool valid = kt * 64 + 16 * kk + 4 * fq + e < query;
                        uu[kk][e] = valid ? lsneg : 0.f;
                        lsp[kk][e] = valid ? lsneg + zz : -1.0e30f;
                        tot += uu[kk][e];
                    }
                }
                tot += __shfl_xor(tot, 16); tot += __shfl_xor(tot, 32);
                f32x4 rest[4];
#pragma unroll
                for (int st = 0; st < 4; ++st) rest[st] = (f32x4){0.f, 0.f, 0.f, 0.f};
#pragma unroll
                for (int k2 = 0; k2 < 2; ++k2) {
                    u32x4 hi, lo;
#pragma unroll
                    for (int t2 = 0; t2 < 2; ++t2) {
                        const f32x4 a = uu[2 * k2 + t2];
                        const unsigned h0 = pack2(a[0], a[1]), h1 = pack2(a[2], a[3]);
                        hi[2 * t2] = h0; hi[2 * t2 + 1] = h1;
                        lo[2 * t2] = pack2(a[0] - lo_bf(h0), a[1] - hi_bf(h0)); lo[2 * t2 + 1] = pack2(a[2] - lo_bf(h1), a[3] - hi_bf(h1));
                    }
                    const bf16x8 fh = __builtin_bit_cast(bf16x8, hi), fl = __builtin_bit_cast(bf16x8, lo);
#pragma unroll
                    for (int st = 0; st < 4; ++st) {
                        rest[st] = __builtin_amdgcn_mfma_f32_16x16x32_bf16(tri[st][k2], fh, rest[st], 0, 0, 0);
                        rest[st] = __builtin_amdgcn_mfma_f32_16x16x32_bf16(tri[st][k2], fl, rest[st], 0, 0, 0);
                    }
                }
                bf16x8 af[2];
#pragma unroll
                for (int k2 = 0; k2 < 2; ++k2) {
                    u32x4 pk;
#pragma unroll
                    for (int t2 = 0; t2 < 2; ++t2) {
                        const int kk = 2 * k2 + t2;
                        float a4[4];
#pragma unroll
                        for (int e = 0; e < 4; ++e) a4[e] = __expf(lsp[kk][e] + R + rest[kk][e]);
                        pk[2 * t2] = pack2(a4[0], a4[1]); pk[2 * t2 + 1] = pack2(a4[2], a4[3]);
                    }
                    af[k2] = __builtin_bit_cast(bf16x8, pk);
                }
                R += tot;
#pragma unroll
                for (int dt = 0; dt < 4; ++dt)
#pragma unroll
                    for (int k2 = 0; k2 < 2; ++k2) {
                        const bf16_t* vp = Vt + (16 * dt + fr) * LS + 32 * k2 + 4 * fq;
                        const u32x2 v0 = *(const u32x2*)vp, v1 = *(const u32x2*)(vp + 16);
                        const bf16x8 f = __builtin_bit_cast(bf16x8, ((u32x4){v0[0], v0[1], v1[0], v1[1]}));
                        ot[dt] = __builtin_amdgcn_mfma_f32_16x16x32_bf16(f, af[k2], ot[dt], 0, 0, 0);
                    }
                done = __all((R < -104.0f) || (query >= L));
            }
            if (lane == 0) flags[wv] = done ? 1 : 0;
            __syncthreads();
            int alld = 1;
#pragma unroll
            for (int w = 0; w < 8; ++w) alld &= flags[w];
            if (alld || kt == 0) break;
            --kt;
        }
        if (query < L) {
#pragma unroll
            for (int dt = 0; dt < 4; ++dt) *(u32x2*)(p.osb + (tokb + query) * 512 + h * 64 + 16 * dt + 4 * fq) = pk4(ot[dt]);
        }
    }
}

struct EpiBranch {
    static constexpr bool PERM = true;
    const bf16_t* G; bf16_t* M; bool add;
    DI void operator()(const f32x4 (&acc)[2][2][4][2], const g8::Unit& u, int wr, int wc, int fr, int fq) const {
        const int c0 = u.pn * 256 + wc * 32 + 8 * fq;
#pragma unroll
        for (int ai = 0; ai < 2; ++ai) {
            u32x4 g[4][2], mo[4][2];
#pragma unroll
            for (int m = 0; m < 4; ++m)
#pragma unroll
                for (int bj = 0; bj < 2; ++bj) {
                    const size_t r = (size_t)(u.pm * 256 + ai * 128 + wr * 64 + m * 16 + fr);
                    g[m][bj] = *(const u32x4*)(G + r * 2048 + c0 + bj * 128);
                    mo[m][bj] = add ? *(const u32x4*)(M + r * D + c0 + bj * 128) : (u32x4){0u, 0u, 0u, 0u};
                }
#pragma unroll
            for (int m = 0; m < 4; ++m)
#pragma unroll
                for (int bj = 0; bj < 2; ++bj) {
                    const size_t r = (size_t)(u.pm * 256 + ai * 128 + wr * 64 + m * 16 + fr);
                    const f32x4 v0 = acc[ai][bj][m][0], v1 = acc[ai][bj][m][1];
                    const u32x4 gg = g[m][bj], mm = mo[m][bj];
                    float o[8] = {lo_bf(gg[0]) * v0[0], hi_bf(gg[0]) * v0[1], lo_bf(gg[1]) * v0[2], hi_bf(gg[1]) * v0[3], lo_bf(gg[2]) * v1[0], hi_bf(gg[2]) * v1[1], lo_bf(gg[3]) * v1[2], hi_bf(gg[3]) * v1[3]};
#pragma unroll
                    for (int q = 0; q < 4; ++q) { o[2 * q] += lo_bf(mm[q]); o[2 * q + 1] += hi_bf(mm[q]); }
                    *(u32x4*)(M + r * D + c0 + bj * 128) = (u32x4){pack2(o[0], o[1]), pack2(o[2], o[3]), pack2(o[4], o[5]), pack2(o[6], o[7])};
                }
        }
    }
};
struct GateOrder {
    g8::DenseOrder d;
    DI bool next(int i, g8::Unit& u) const { return d.next(i, u); }
    DI unsigned row_off(const g8::Unit&, int) const { return 0u; }
};
struct EpiGate {
    static constexpr bool PERM = true;
    bf16_t* G;
    DI void operator()(const f32x4 (&acc)[2][2][4][2], const g8::Unit& u, int wr, int wc, int fr, int fq) const {
#pragma unroll
        for (int ai = 0; ai < 2; ++ai)
#pragma unroll
            for (int m = 0; m < 4; ++m) {
                bf16_t* rowp = G + (size_t)(u.pm * 256 + ai * 128 + wr * 64 + m * 16 + fr) * 2048 + u.pn * 256 + wc * 32 + 8 * fq;
#pragma unroll
                for (int bj = 0; bj < 2; ++bj) {
                    const f32x4 v0 = acc[ai][bj][m][0], v1 = acc[ai][bj][m][1];
                    *(u32x4*)(rowp + bj * 128) = (u32x4){pack2(sigmoidf_(v0[0]), sigmoidf_(v0[1])), pack2(sigmoidf_(v0[2]), sigmoidf_(v0[3])), pack2(sigmoidf_(v1[0]), sigmoidf_(v1[1])), pack2(sigmoidf_(v1[2]), sigmoidf_(v1[3]))};
                }
            }
    }
};
template <int PART> DI void phase_merge(const Params& p, int layer, int bid, int nb, char* smem) {
    const bf16_t* hb = p.hb; bf16_t* G = p.gates; bf16_t* M = p.merged;
    const bf16_t* Wg = p.WtIn + ((size_t)layer * CIN + CP) * D;
    G8_LAS unsigned char* lds = (G8_LAS unsigned char*)smem;
    if (PART == 0) {
#pragma unroll
    for (int which = 0; which < 2; ++which) {
        g8::DenseOrder S; S.init(hb, Wg + (size_t)which * 1024 * D, MFULL, D / 256, D, nb, bid);
        g8::gemm8<false>(lds, D, S, EpiGate{G + which * 1024});
    }
    }
    if (PART == 1) {
#pragma unroll
    for (int which = 0; which < 2; ++which) {
        const bf16_t* A = which ? p.orw : p.osb;
        const bf16_t* Bt = (which ? p.WtPrw : p.WtPsb) + (size_t)layer * D * 512;
        g8::DenseOrder S; S.init(A, Bt, MFULL, D / 256, 512, nb, bid);
        g8::gemm8<false>(lds, 512, S, EpiBranch{G + which * 1024, M, which != 0});
    }
    }
    if (PART == 1)
    for (int t = left_first(MFULL * 4 * 2, bid, nb); t < D / 128; t += nb) {
#pragma unroll
        for (int which = 0; which < 2; ++which) {
            const bf16_t* A = which ? p.orw : p.osb; const bf16_t* Gw = p.gleft - (size_t)M0_LEFT * 2048 + which * 1024;
            const bf16_t* Bt = (which ? p.WtPrw : p.WtPsb) + (size_t)layer * D * 512;
            gemm_left32([=](int r) { return A + (size_t)(M0_LEFT + r) * 512; }, Bt, 512, 512, t * 128, smem,
                        [=](int r0, int c, f32x4 v) {
                            const size_t r = (size_t)(M0_LEFT + r0);
                            const u32x2 g = *(const u32x2*)(Gw + r * 2048 + c);
                            float o0 = lo_bf(g[0]) * v[0], o1 = hi_bf(g[0]) * v[1], o2 = lo_bf(g[1]) * v[2], o3 = hi_bf(g[1]) * v[3];
                            u32x2* mp = (u32x2*)(M + r * D + c);
                            if (which) { const u32x2 m = *mp; o0 += lo_bf(m[0]); o1 += hi_bf(m[0]); o2 += lo_bf(m[1]); o3 += hi_bf(m[1]); }
                            *mp = (u32x2){pack2(o0, o1), pack2(o2, o3)};
                        });
        }
    }
}
struct EpiOut {
    static constexpr bool PERM = false;
    float* hmeta; float* out; const bf16_t* hb;
    DI void operator()(const f32x4 (&acc)[2][2][4][2], const g8::Unit& u, int wr, int wc, int fr, int fq) const {
        const int c0 = u.pn * 256 + wc * 32 + 4 * fq;
#pragma unroll
        for (int ai = 0; ai < 2; ++ai) {
            u32x2 hv[4][2][2];
#pragma unroll
            for (int m = 0; m < 4; ++m) {
                const bf16_t* hbp = hb + (size_t)(u.pm * 256 + ai * 128 + wr * 64 + m * 16 + fr) * D + c0;
#pragma unroll
                for (int bj = 0; bj < 2; ++bj)
#pragma unroll
                    for (int n = 0; n < 2; ++n) hv[m][bj][n] = *(const u32x2*)(hbp + bj * 128 + n * 16);
            }
#pragma unroll
            for (int m = 0; m < 4; ++m) {
                float* rowp = hrow2(hmeta, out, u.pm * 256 + ai * 128 + wr * 64 + m * 16 + fr) + c0;
#pragma unroll
                for (int bj = 0; bj < 2; ++bj)
#pragma unroll
                    for (int n = 0; n < 2; ++n) {
                        const f32x4 h = up4(hv[m][bj][n]), v = acc[ai][bj][m][n];
                        *(f32x4*)(rowp + bj * 128 + n * 16) = (f32x4){ALPHA * h[0] + v[0], ALPHA * h[1] + v[1], ALPHA * h[2] + v[2], ALPHA * h[3] + v[3]};
                    }
            }
        }
    }
};
DI void phase_outproj(const Params& p, int layer, int bid, int nb, char* smem) {
    const bf16_t* A = p.merged; float* const hmeta = p.hmeta; float* const outp = p.out; const bf16_t* hbres = p.hb;
    const bf16_t* Bt = p.WtOut + (size_t)layer * D * D;
    if (bid == 0 && tid_() < NE) p.counts[tid_()] = 0;
    g8::DenseOrder S; S.init(A, Bt, MFULL, D / 256, D, nb, bid);
    g8::gemm8<false>((G8_LAS unsigned char*)smem, D, S, EpiOut{hmeta, outp, hbres});
    for (int t = left_first(MFULL * 4, bid, nb); t < D / 128; t += nb)
        gemm_left32([=](int r) { return A + (size_t)(M0_LEFT + r) * D; }, Bt, D, D, t * 128, smem,
                    [=](int r0, int c, f32x4 v) {
                        const int r = M0_LEFT + r0;
                        const f32x4 h = up4(*(const u32x2*)(hbres + (size_t)r * D + c));
                        *(f32x4*)(hrow2(hmeta, outp, r) + c) = (f32x4){ALPHA * h[0] + v[0], ALPHA * h[1] + v[1], ALPHA * h[2] + v[2], ALPHA * h[3] + v[3]};
                    });
}

constexpr int LN1_ROWB = 2 * D + 16;
constexpr int LN1_WAVE = 8 * LN1_ROWB;
constexpr int LN1_LDS = 8 * LN1_WAVE + 2048;
DI void phase_ln1_router(const Params& p, int layer, int bid, int nb, char* smem) {
    const int tid = tid_(), lane = tid & 63, wid = __builtin_amdgcn_readfirstlane(tid >> 6), fr = lane & 15, fq = lane >> 4;
    char* wl = smem + wid * LN1_WAVE;
    int* sel = (int*)(smem + 8 * LN1_WAVE);
    float* sgt = (float*)(smem + 8 * LN1_WAVE + 640);
    int* sbase = (int*)(smem + 8 * LN1_WAVE + 1280);
    const int nwaves = nb * 8, gw = bid * 8 + wid;
    const int base_n = T / nwaves, extra = T % nwaves;
    const int tok0 = gw * base_n + (gw < extra ? gw : extra), ntok = base_n + (gw < extra ? 1 : 0);
    const int btok0 = bid * 8 * base_n + (bid * 8 < extra ? bid * 8 : extra);
    const float* g1p = p.ln1_g + layer * D; const float* b1p = p.ln1_b + layer * D;
    __syncthreads();
    for (int g0 = 0; g0 < ntok; g0 += 4) {
        const int ng = ntok - g0 < 4 ? ntok - g0 : 4;
        float vn[16];
        { const float* hf = hrow_u(p, tok0 + g0);
#pragma unroll
          for (int j = 0; j < 4; ++j) { const f32x4 a = *(const f32x4*)(hf + 256 * j + 4 * lane); vn[4 * j] = a[0]; vn[4 * j + 1] = a[1]; vn[4 * j + 2] = a[2]; vn[4 * j + 3] = a[3]; } }
#pragma unroll 1
        for (int i = 0; i < ng; ++i) {
            const int tok = tok0 + g0 + i;
            float v[16];
#pragma unroll
            for (int q = 0; q < 16; ++q) v[q] = vn[q];
            if (i + 1 < ng) { const float* hn = hrow_u(p, tok + 1);
#pragma unroll
                for (int j = 0; j < 4; ++j) { const f32x4 a = *(const f32x4*)(hn + 256 * j + 4 * lane); vn[4 * j] = a[0]; vn[4 * j + 1] = a[1]; vn[4 * j + 2] = a[2]; vn[4 * j + 3] = a[3]; } }
            ln16(v, g1p, b1p, lane);
#pragma unroll
            for (int j = 0; j < 4; ++j) {
                const unsigned h0 = pack2(v[4 * j], v[4 * j + 1]), h1 = pack2(v[4 * j + 2], v[4 * j + 3]);
                *(u32x2*)(p.hb + (size_t)tok * D + 256 * j + 4 * lane) = (u32x2){h0, h1};
                *(u32x2*)(wl + i * LN1_ROWB + (256 * j + 4 * lane) * 2) = (u32x2){h0, h1};
                *(u32x2*)(wl + (4 + i) * LN1_ROWB + (256 * j + 4 * lane) * 2) = (u32x2){pack2(v[4 * j] - lo_bf(h0), v[4 * j + 1] - hi_bf(h0)), pack2(v[4 * j + 2] - lo_bf(h1), v[4 * j + 3] - hi_bf(h1))};
            }
        }
        asm volatile("s_waitcnt lgkmcnt(0)" ::: "memory");
        __builtin_amdgcn_wave_barrier();
        f32x4 acc = (f32x4){0.f, 0.f, 0.f, 0.f};
        const char* arow = wl + (fr & 3) * LN1_ROWB + fq * 16;
        const bf16_t* whi = p.RwHi + (size_t)fr * D + fq * 8; const bf16_t* wlo = p.RwLo + (size_t)fr * D + fq * 8;
#pragma unroll 4
        for (int ks = 0; ks < 32; ++ks) {
            const bf16x8 ah = *(const bf16x8*)(arow + ks * 64), al = *(const bf16x8*)(arow + 4 * LN1_ROWB + ks * 64);
            const bf16x8 bh = *(const bf16x8*)(whi + ks * 32), bl = *(const bf16x8*)(wlo + ks * 32);
            acc = __builtin_amdgcn_mfma_f32_16x16x32_bf16(bh, ah, acc, 0, 0, 0);
            acc = __builtin_amdgcn_mfma_f32_16x16x32_bf16(bh, al, acc, 0, 0, 0);
            acc = __builtin_amdgcn_mfma_f32_16x16x32_bf16(bl, ah, acc, 0, 0, 0);
        }
        float lg[4]; float mx = -3.0e38f;
#pragma unroll
        for (int e = 0; e < 4; ++e) { lg[e] = acc[e] + p.router_b[4 * fq + e]; mx = fmaxf(mx, lg[e]); }
        mx = fmaxf(mx, __shfl_xor(mx, 16)); mx = fmaxf(mx, __shfl_xor(mx, 32));
        float sum = 0.f;
#pragma unroll
        for (int e = 0; e < 4; ++e) { lg[e] = __expf(lg[e] - mx); sum += lg[e]; }
        sum += __shfl_xor(sum, 16); sum += __shfl_xor(sum, 32);
        const float inv = 1.0f / sum;
        float v1 = -1.f, v2 = -1.f; int i1 = 0, i2 = 0;
#pragma unroll
        for (int e = 0; e < 4; ++e) {
            const float pv = lg[e] * inv;
            if (pv > v1) { v2 = v1; i2 = i1; v1 = pv; i1 = e; } else if (pv > v2) { v2 = pv; i2 = e; }
        }
        const float sc = v1 + v2;
        float bsc = sc; int bg = fq;
#pragma unroll
        for (int m = 16; m <= 32; m <<= 1) {
            const float os = __shfl_xor(bsc, m); const int og = __shfl_xor(bg, m);
            if (os > bsc || (os == bsc && og < bg)) { bsc = os; bg = og; }
        }
        if (bg == fq && fr < ng) {
            const int li = tok0 + g0 + fr - btok0;
            const float gs = 1.0f / (v1 + v2);
            sel[li * 2] = 4 * fq + i1; sel[li * 2 + 1] = 4 * fq + i2; sgt[li * 2] = v1 * gs; sgt[li * 2 + 1] = v2 * gs;
        }
        asm volatile("s_waitcnt lgkmcnt(0)" ::: "memory");
        __builtin_amdgcn_wave_barrier();
    }
    __syncthreads();
    if (wid == 0) {
        const int nbt = 8 * base_n + ((bid * 8 + 8 <= extra) ? 8 : (bid * 8 < extra ? extra - bid * 8 : 0));
        for (int c0 = 0; c0 < nbt; c0 += 64) {
            const int li = c0 + lane; const bool on = li < nbt;
            const int e1 = on ? sel[li * 2] : -1, e2 = on ? sel[li * 2 + 1] : -1;
            const unsigned long long lt = (1ull << lane) - 1ull;
            int r1 = 0, r2 = 0, mycnt = 0;
#pragma unroll
            for (int e = 0; e < NE; ++e) {
                const unsigned long long m1 = __ballot(e1 == e), m2 = __ballot(e2 == e);
                const int c1 = __popcll(m1), c2 = __popcll(m2);
                if (e1 == e) r1 = __popcll(m1 & lt);
                if (e2 == e) r2 = c1 + __popcll(m2 & lt);
                if (lane == e) mycnt = c1 + c2;
            }
            if (lane < NE) sbase[lane] = mycnt > 0 ? atomicAdd(&p.counts[lane], mycnt) : 0;
            asm volatile("s_waitcnt vmcnt(0) lgkmcnt(0)" ::: "memory");
            __builtin_amdgcn_wave_barrier();
            if (on) {
                const int tok = btok0 + li;
                const int s1 = sbase[e1] + r1, s2 = sbase[e2] + r2;
                p.list[e1 * T + s1] = tok * 2; p.list[e2 * T + s2] = tok * 2 + 1;
                p.tokg[tok * 2] = sgt[li * 2]; p.tokg[tok * 2 + 1] = sgt[li * 2 + 1];
            }
            asm volatile("s_waitcnt lgkmcnt(0)" ::: "memory");
            __builtin_amdgcn_wave_barrier();
        }
    }
}

constexpr int MOE_BIG = 8;
template <bool UP> struct MoeOrder {
    const int* counts; const int* list; int G, c; const char* A; const char* B;
    DI bool next(int i, g8::Unit& u) const {
        const int xcd = c & 7, w = c >> 3, mt = (w >> 1) & 7, pn = 2 * (w & 1) + i, esel = xcd + 8 * (w >> 4);
        if (w >= 32 || i >= 2) return false;
        int padp = 0, fe = -1, fc = 0, fp = 0;
#pragma unroll
        for (int e = 0; e < NE; ++e) {
            const int cn = counts[e], ntp = (cn + 255) >> 8, nt = ntp < MOE_BIG ? ntp : MOE_BIG;
            const bool hit = (e == esel) && (mt < nt);
            fe = hit ? e : fe; fc = hit ? cn : fc; fp = hit ? padp + mt : fp;
            padp += ntp;
        }
        fe = __builtin_amdgcn_readfirstlane(fe); fc = __builtin_amdgcn_readfirstlane(fc); fp = __builtin_amdgcn_readfirstlane(fp);
        if (fe < 0) return false;
        u.e = fe; u.slot0 = mt * 256; u.cnt = fc; u.pm = fp; u.pn = pn;
        u.A = UP ? A : A + (size_t)fp * ((size_t)256 * DE * 2);
        u.B = UP ? B + (size_t)fe * ((size_t)1024 * 1024 * 2) + (size_t)pn * ((size_t)256 * D * 2) : B + (size_t)fe * ((size_t)1024 * 512 * 2) + (size_t)pn * ((size_t)256 * DE * 2);
        return true;
    }
    DI unsigned row_off(const g8::Unit& u, int r) const {
        const __amdgpu_buffer_rsrc_t rs = __builtin_amdgcn_make_buffer_rsrc((void*)list, 0, NE * T * 4, 0x00020000);
        const int ent = __builtin_amdgcn_raw_buffer_load_b32(rs, r * 4, (u.e * T + u.slot0) * 4, 0);
        return u.slot0 + r < u.cnt ? (unsigned)(ent >> 1) * (unsigned)(D * 2) : 0u;
    }
};
struct EpiMoeUp {
    static constexpr bool PERM = true;
    bf16_t* hid;
    DI void operator()(const f32x4 (&acc)[2][2][4][2], const g8::Unit& u, int wr, int wc, int fr, int fq) const {
#pragma unroll
        for (int ai = 0; ai < 2; ++ai)
#pragma unroll
            for (int m = 0; m < 4; ++m) {
                const int r = ai * 128 + wr * 64 + m * 16 + fr;
                if (u.slot0 + r >= u.cnt) continue;
                bf16_t* rowp = hid + ((size_t)u.pm * 256 + r) * DE + ((u.pn * 256 + wc * 32 + 8 * fq) >> 1);
#pragma unroll
                for (int bj = 0; bj < 2; ++bj) {
                    const f32x4 v0 = acc[ai][bj][m][0], v1 = acc[ai][bj][m][1];
                    *(u32x2*)(rowp + bj * 64) = (u32x2){pack2(v0[0] * sigmoidf_(v0[0]) * v0[1], v0[2] * sigmoidf_(v0[2]) * v0[3]), pack2(v1[0] * sigmoidf_(v1[0]) * v1[1], v1[2] * sigmoidf_(v1[2]) * v1[3])};
                }
            }
    }
};
struct EpiMoeDown {
    static constexpr bool PERM = true;
    bf16_t* fo; const int* list; const float* tokg;
    DI void operator()(const f32x4 (&acc)[2][2][4][2], const g8::Unit& u, int wr, int wc, int fr, int fq) const {
        int ent[8]; float g[8];
#pragma unroll
        for (int q = 0; q < 8; ++q) {
            const int sl = u.slot0 + (q >> 2) * 128 + wr * 64 + (q & 3) * 16 + fr;
            ent[q] = sl < u.cnt ? list[u.e * T + sl] : -1;
        }
#pragma unroll
        for (int q = 0; q < 8; ++q) g[q] = ent[q] >= 0 ? tokg[ent[q]] : 0.f;
#pragma unroll
        for (int ai = 0; ai < 2; ++ai)
#pragma unroll
            for (int m = 0; m < 4; ++m) {
                const int q = ai * 4 + m;
                if (ent[q] < 0) continue;
                const float gg = g[q];
                bf16_t* rowp = fo + ((size_t)(ent[q] & 1) * TP + (ent[q] >> 1)) * D + u.pn * 256 + wc * 32 + 8 * fq;
#pragma unroll
                for (int bj = 0; bj < 2; ++bj) {
                    const f32x4 v0 = acc[ai][bj][m][0], v1 = acc[ai][bj][m][1];
                    *(u32x4*)(rowp + bj * 128) = (u32x4){pack2(gg * v0[0], gg * v0[1]), pack2(gg * v0[2], gg * v0[3]), pack2(gg * v1[0], gg * v1[1]), pack2(gg * v1[2], gg * v1[3])};
                }
            }
    }
};
DI void phase_moe_up(const Params& p, int bid, int nb, char* smem) {
    const MoeOrder<true> S{p.counts, p.list, nb, bid, (const char*)p.hb, (const char*)p.WtGU};
    g8::gemm8<true>((G8_LAS unsigned char*)smem, D, S, EpiMoeUp{p.hid});
    const bf16_t* hb = p.hb; bf16_t* hid = p.hid; const int* list = p.list;
    int big = 0, padr = 0, job = 0;
#pragma unroll 1
    for (int e = 0; e < NE; ++e) { const int cn = p.counts[e], ntp = (cn + 255) >> 8; big += (ntp < MOE_BIG ? ntp : MOE_BIG) * 4; }
    const int mine = bid; (void)big;
#pragma unroll 1
    for (int e = 0; e < NE; ++e) {
        const int cn = p.counts[e];
        for (int s0 = MOE_BIG * 256; s0 < cn; s0 += 128)
            for (int nt = 0; nt < 8; ++nt, ++job)
                if (job % nb == mine) {
                    const int prow = padr;
                    gemm_tile128([=](int r) { const int sl = s0 + r; return sl < cn ? hb + (size_t)(list[e * T + sl] >> 1) * D : (const bf16_t*)nullptr; },
                                 p.WtGU + (size_t)e * 1024 * 1024, D, D, 0, nt * 128, smem,
                                 [=](int r, int c, f32x4 v) {
                                     const int sl = s0 + r;
                                     if (sl >= cn) return;
                                     *(unsigned*)(hid + (size_t)(prow + sl) * DE + (c >> 1)) = pack2(v[0] * sigmoidf_(v[0]) * v[1], v[2] * sigmoidf_(v[2]) * v[3]);
                                 });
                }
        padr += ((cn + 255) >> 8) * 256;
    }
}
DI void phase_moe_down(const Params& p, int bid, int nb, char* smem) {
    const MoeOrder<false> S{p.counts, p.list, nb, bid, (const char*)p.hid, (const char*)p.WtD};
    g8::gemm8<false>((G8_LAS unsigned char*)smem, DE, S, EpiMoeDown{p.fo, p.list, p.tokg});
    const bf16_t* hid = p.hid; bf16_t* fo = p.fo; const int* list = p.list; const float* tokg = p.tokg;
    int big = 0, padr = 0, job = 0;
#pragma unroll 1
    for (int e = 0; e < NE; ++e) { const int cn = p.counts[e], ntp = (cn + 255) >> 8; big += (ntp < MOE_BIG ? ntp : MOE_BIG) * 4; }
    const int mine = bid; (void)big;
#pragma unroll 1
    for (int e = 0; e < NE; ++e) {
        const int cn = p.counts[e];
        for (int s0 = MOE_BIG * 256; s0 < cn; s0 += 128)
            for (int nt = 0; nt < 8; ++nt, ++job)
                if (job % nb == mine) {
                    const int prow = padr;
                    gemm_tile128([=](int r) { const int sl = s0 + r; return sl < cn ? hid + (size_t)(prow + sl) * DE : (const bf16_t*)nullptr; },
                                 p.WtD + (size_t)e * 1024 * 512, DE, DE, 0, nt * 128, smem,
                                 [=](int r, int c, f32x4 v) {
                                     const int sl = s0 + r;
                                     if (sl >= cn) return;
                                     const int ent = list[e * T + sl];
                                     const float g = tokg[ent];
                                     *(u32x2*)(fo + ((size_t)(ent & 1) * TP + (ent >> 1)) * D + c) = (u32x2){pack2(g * v[0], g * v[1]), pack2(g * v[2], g * v[3])};
                                 });
                }
        padr += ((cn + 255) >> 8) * 256;
    }
}
DI void phase_ln2(const Params& p, int layer, int bid, int nb) {
    const int lane = tid_() & 63, wid = __builtin_amdgcn_readfirstlane(tid_() >> 6);
    const int nwaves = nb * 8, gw = bid * 8 + wid, base_n = T / nwaves, extra = T % nwaves;
    const int tok0 = gw * base_n + (gw < extra ? gw : extra), ntok = base_n + (gw < extra ? 1 : 0);
    u32x2 an[4], f0n[4], f1n[4];
    {
#pragma unroll
        for (int j = 0; j < 4; ++j) {
            an[j] = *(const u32x2*)(p.hb + (size_t)tok0 * D + 256 * j + 4 * lane);
            f0n[j] = *(const u32x2*)(p.fo + (size_t)tok0 * D + 256 * j + 4 * lane); f1n[j] = *(const u32x2*)(p.fo + ((size_t)TP + tok0) * D + 256 * j + 4 * lane);
        }
    }
#pragma unroll 1
    for (int i = 0; i < ntok; ++i) {
        const int tok = tok0 + i;
        float v[16];
#pragma unroll
        for (int j = 0; j < 4; ++j) {
            v[4 * j] = ALPHA * lo_bf(an[j][0]) + lo_bf(f0n[j][0]) + lo_bf(f1n[j][0]); v[4 * j + 1] = ALPHA * hi_bf(an[j][0]) + hi_bf(f0n[j][0]) + hi_bf(f1n[j][0]);
            v[4 * j + 2] = ALPHA * lo_bf(an[j][1]) + lo_bf(f0n[j][1]) + lo_bf(f1n[j][1]); v[4 * j + 3] = ALPHA * hi_bf(an[j][1]) + hi_bf(f0n[j][1]) + hi_bf(f1n[j][1]);
        }
        if (i + 1 < ntok) {
#pragma unroll
            for (int j = 0; j < 4; ++j) {
                an[j] = *(const u32x2*)(p.hb + (size_t)(tok + 1) * D + 256 * j + 4 * lane);
                f0n[j] = *(const u32x2*)(p.fo + (size_t)(tok + 1) * D + 256 * j + 4 * lane); f1n[j] = *(const u32x2*)(p.fo + ((size_t)TP + tok + 1) * D + 256 * j + 4 * lane);
            }
        }
        ln16(v, p.ln2_g + layer * D, p.ln2_b + layer * D, lane);
        if (layer == DEPTH - 1) {
            float* of = hrow_u(p, tok);
#pragma unroll
            for (int j = 0; j < 4; ++j) *(f32x4*)(of + 256 * j + 4 * lane) = (f32x4){v[4 * j], v[4 * j + 1], v[4 * j + 2], v[4 * j + 3]};
        } else store_row_bf(p.hb + (size_t)tok * D, v, lane);
    }
}

extern __shared__ __attribute__((aligned(16))) char dyn_smem[];
constexpr int SMEM_MAIN = R1_LDS > GEMM_LDS ? R1_LDS : GEMM_LDS;
constexpr int SMEM_BYTES = SMEM_MAIN + 16;

__global__ void __launch_bounds__(NTHR, 2) k_forward(Params p) {
    const int bid = blockIdx.x, nb = gridDim.x;
    char* smem = dyn_smem;
    uint4* xbw = (uint4*)(dyn_smem + SMEM_MAIN);
    if (threadIdx.x == 0) *xbw = make_uint4(0u, 0u, 0u, 0u);
    __syncthreads();
    XcdBarrier bar = xcd_barrier_post(p.bar, (volatile LAS unsigned*)xbw);
    phase_prologue_weights(p, bid, nb, smem);
    phase_embed(p, bid, nb);
    xcd_barrier(bar);
    for (int l = 0; l < DEPTH; ++l) {
        phase_inproj(p, l, bid, nb, smem);
        xcd_barrier(bar);
        phase_rwkv_r1<0>(p, l, bid, nb, smem);
        xcd_barrier(bar);
        if (bid < 32) phase_rwkv_r2(p, bid);
        else {
            const int sbid = bid - 32, snb = nb - 32, heavy = (NBATCH * HEADS * ((L + 127) / 128)) % snb;
            if (sbid >= heavy && sbid < heavy + NBATCH * HEADS) phase_rwkv_r1<1>(p, l, sbid - heavy, 1, smem);
            phase_sb(p, sbid, snb, smem);
        }
        xcd_barrier(bar);
        phase_rwkv_r3(p, l, bid, nb);
        convert_experts(p, l, bid, nb, smem);
        phase_merge<0>(p, l, bid, nb, smem);
        xcd_barrier(bar);
        phase_merge<1>(p, l, bid, nb, smem);
        xcd_barrier(bar);
        phase_outproj(p, l, bid, nb, smem);
        xcd_barrier(bar);
        phase_ln1_router(p, l, bid, nb, smem);
        xcd_barrier(bar);
        phase_moe_up(p, bid, nb, smem);
        xcd_barrier(bar);
        phase_moe_down(p, bid, nb, smem);
        xcd_barrier(bar);
        phase_ln2(p, l, bid, nb);
        xcd_barrier(bar);
    }
}

extern "C" void kernel_launch(void* const* d_in, const int* in_sizes, int n_in, void* d_out, int out_size, void* d_ws, size_t ws_size, hipStream_t stream) {
    (void)in_sizes; (void)n_in; (void)out_size;
    Params p;
    memset(&p, 0, sizeof(p));
    const float* const* in = (const float* const*)d_in;
    p.x = in[0]; p.meta = in[1]; p.emb_g = in[2]; p.emb_b = in[3]; p.w_in = in[4]; p.mu = in[5]; p.w0 = in[6]; p.w_up = in[7]; p.a0 = in[8]; p.a_up = in[9];
    p.g_up = in[10]; p.k_k = in[11]; p.k_a = in[12]; p.r_k = in[13]; p.lnx_g = in[14]; p.lnx_b = in[15]; p.p_sb = in[16]; p.p_rwkv = in[17]; p.w_out = in[18];
    p.ln1_g = in[19]; p.ln1_b = in[20]; p.router_w = in[21]; p.router_b = in[22]; p.ew_gate = in[23]; p.ew_up = in[24]; p.ew_down = in[25]; p.ln2_g = in[26]; p.ln2_b = in[27];
    p.out = (float*)d_out;
    char* ws = (char*)d_ws; size_t o = 0;
    auto take = [&](size_t bytes) { char* r = ws + o; o += (bytes + 255) & ~(size_t)255; return r; };
    p.bar = (unsigned*)take(XCD_BAR_WORDS * sizeof(unsigned));
    p.counts = (int*)take(256);
    p.WtIn = (bf16_t*)take((size_t)DEPTH * CIN * D * 2);
    p.WtPsb = (bf16_t*)take((size_t)DEPTH * D * 512 * 2);
    p.WtPrw = (bf16_t*)take((size_t)DEPTH * D * 512 * 2);
    p.WtOut = (bf16_t*)take((size_t)DEPTH * D * D * 2);
    p.WupT = (bf16_t*)take((size_t)DEPTH * 512 * 64 * 2);
    p.AupT = (bf16_t*)take((size_t)DEPTH * 512 * 64 * 2);
    p.GupT = (bf16_t*)take((size_t)DEPTH * 512 * 128 * 2);
    p.RwHi = (bf16_t*)take((size_t)NE * D * 2);
    p.RwLo = (bf16_t*)take((size_t)NE * D * 2);
    p.gleft = (bf16_t*)take((size_t)32 * 2048 * 2);
    {
        const size_t ub = (size_t)NUNIT * 64 * 64 * 2, need_r = 6 * ub + (size_t)NUNIT * 64 * 4, need_e = (size_t)NE * 1024 * 1024 * 2 + (size_t)NE * 1024 * 512 * 2;
        char* e = take(need_r > need_e ? need_r : need_e);
        p.WtGU = (bf16_t*)e; p.WtD = (bf16_t*)(e + (size_t)NE * 1024 * 1024 * 2);
        p.PcG = (bf16_t*)e; p.QcG = (bf16_t*)(e + ub); p.RhG = (bf16_t*)(e + 2 * ub); p.Y0G = (bf16_t*)(e + 3 * ub); p.GG = (bf16_t*)(e + 4 * ub); p.SG = (bf16_t*)(e + 5 * ub);
        p.bonG = (float*)(e + 6 * ub);
    }
    p.hb = (bf16_t*)take((size_t)TP * D * 2);
    p.hmeta = (float*)take((size_t)NBATCH * NMETA * D * 4);
    p.P = (bf16_t*)take((size_t)TP * CP * 2);
    p.osb = (bf16_t*)take((size_t)TP * 512 * 2);
    p.orw = (bf16_t*)take((size_t)TP * 512 * 2);
    p.list = (int*)take((size_t)NE * T * 4);
    p.tokg = (float*)take((size_t)T * 2 * 4);
    p.gates = p.P;
    p.merged = p.P + (size_t)TP * 2048;
    p.hid = p.P;
    p.fo = p.P + (size_t)(2 * T + 16 * 256) * DE;
    if (o > ws_size) return;
    static int grid = 0;
    if (!grid) {
        int dev = 0, cus = 0, per_cu = 0;
        (void)hipGetDevice(&dev);
        (void)hipDeviceGetAttribute(&cus, hipDeviceAttributeMultiprocessorCount, dev);
        (void)hipFuncSetAttribute((const void*)k_forward, hipFuncAttributeMaxDynamicSharedMemorySize, SMEM_BYTES);
        (void)hipOccupancyMaxActiveBlocksPerMultiprocessor(&per_cu, k_forward, NTHR, SMEM_BYTES);
        grid = per_cu >= 1 ? cus : 0;
    }
    if (!grid) return;
    (void)hipMemsetAsync(p.bar, 0, XCD_BAR_WORDS * sizeof(unsigned), stream);
    hipLaunchKernelGGL(k_forward, dim3(grid), dim3(NTHR), SMEM_BYTES, stream, p);
}
```

```cpp
#include <hip/hip_runtime.h>
#include <stdint.h>
#include <string.h>

#define DI __device__ __forceinline__
typedef unsigned short bf16_t;
typedef short bf16x8 __attribute__((ext_vector_type(8)));
typedef float f32x4 __attribute__((ext_vector_type(4)));
typedef unsigned u32x4 __attribute__((ext_vector_type(4)));
typedef unsigned u32x2 __attribute__((ext_vector_type(2)));

constexpr int D = 1024, NBATCH = 2, SEQ = 8192, NMETA = 16, L = SEQ + NMETA, T = NBATCH * L, TP = 16640;
constexpr int DEPTH = 2, HEADS = 8, HD = 64;
constexpr int CIN = 5376, CP = 3328;
constexpr int OFF_Q = 0, OFF_K = 512, OFF_V = 1024, OFF_RW = 1536;
constexpr int RW_R = 0, RW_K = 512, RW_V = 1024, RW_WD = 1536, RW_AD = 1600, RW_GD = 1664, RSW = 1792;
constexpr int NE = 16, DE = 512;
constexpr float ALPHA = 1.41421356237309515f;
constexpr float DECAY_SCALE = 0.60653065971263342f;
constexpr int NTHR = 512;

#define XB_TMO      128
#define XB_XCNT(j)  (256  + 64 * (j))
#define XB_XSUB(j)  (1280 + 64 * (j))
#define XB_XGEN(j)  (2304 + 64 * (j))
#define XB_TOP      3328
#define XB_TOPGEN   3392
#define XCD_BAR_WORDS 3456
#define XB_SPIN_CAP (1u << 18)
#define LAS __attribute__((address_space(3)))

__device__ __forceinline__ unsigned xb_ld(unsigned* p)              { return __hip_atomic_load(p, __ATOMIC_RELAXED, __HIP_MEMORY_SCOPE_AGENT); }
__device__ __forceinline__ unsigned xb_add(unsigned* p, unsigned v) { return __hip_atomic_fetch_add(p, v, __ATOMIC_RELAXED, __HIP_MEMORY_SCOPE_AGENT); }
__device__ __forceinline__ unsigned xb_xcc_id() { return (unsigned)__builtin_amdgcn_s_getreg((3 << 11) | 20) & 0xFu; }
#define XB_SPIN(cond, bar) do { unsigned _sp = 0; while (cond) { __builtin_amdgcn_s_sleep(1); \
    if ((++_sp & 255u) == 0u) { if (xb_ld(&(bar)[XB_TMO])) break; if (_sp > XB_SPIN_CAP) { atomicAdd(&(bar)[XB_TMO], 1u); break; } } } } while (0)

struct XcdBarrier {
    unsigned* bar; unsigned x;
    volatile LAS unsigned* st;
};

__device__ __forceinline__ XcdBarrier xcd_barrier_post(unsigned* bar, volatile LAS unsigned* st) {
    XcdBarrier b; b.bar = bar; b.x = xb_xcc_id(); b.st = st;
    if (threadIdx.x == 0) (void)xb_add(&bar[XB_XCNT(b.x)], 1u);
    return b;
}
__device__ __forceinline__ void xcd_barrier_complete(unsigned* bar, unsigned x, unsigned& nloc, unsigned& nx) {
    const unsigned G = gridDim.x * gridDim.y * gridDim.z;
    unsigned sum, cnt, mine, sp = 0u;
    for (;;) {
        sum = 0u; cnt = 0u; mine = 0u;
#pragma unroll
        for (unsigned j = 0; j < 16; ++j) { const unsigned c = xb_ld(&bar[XB_XCNT(j)]); sum += c; cnt += (c > 0u) ? 1u : 0u; mine = (j == x) ? c : mine; }
        if (sum == G) break;
        __builtin_amdgcn_s_sleep(1);
        if ((++sp & 255u) == 0u) { if (xb_ld(&bar[XB_TMO])) break; if (sp > XB_SPIN_CAP) { atomicAdd(&bar[XB_TMO], 1u); break; } }
    }
    nloc = mine > 0u ? mine : 1u; nx = cnt > 0u ? cnt : 1u;
}

__device__ __forceinline__ void xcd_barrier(const XcdBarrier& b) {
    asm volatile("s_waitcnt vmcnt(0)" ::: "memory");
    __syncthreads();
    if (threadIdx.x == 0) {
        unsigned* bar = b.bar;
        unsigned bx = b.x; asm volatile("" : "+s"(bx));
        __builtin_amdgcn_s_waitcnt(0);
        unsigned nloc = b.st[0], nx = b.st[1];
        if (nloc == 0u) { xcd_barrier_complete(bar, bx, nloc, nx); b.st[0] = nloc; b.st[1] = nx; }
        const unsigned old = xb_add(&bar[XB_XSUB(bx)], 1u);
        const unsigned gen = old / nloc;
        if (old + 1u == (gen + 1u) * nloc) {
            __builtin_amdgcn_fence(__ATOMIC_RELEASE, "agent");
            asm volatile("s_waitcnt vmcnt(0)" ::: "memory");
            const unsigned og = xb_add(&bar[XB_TOP], 1u);
            const unsigned tg = og / nx;
            if (og + 1u == (tg + 1u) * nx) xb_add(&bar[XB_TOPGEN], 1u);
            else XB_SPIN(xb_ld(&bar[XB_TOPGEN]) == tg, bar);
            __builtin_amdgcn_fence(__ATOMIC_ACQUIRE, "agent");
            xb_add(&bar[XB_XGEN(bx)], 1u);
            asm volatile("s_waitcnt vmcnt(0)" ::: "memory");
        } else {
            XB_SPIN(xb_ld(&bar[XB_XGEN(bx)]) == gen, bar);
            __builtin_amdgcn_fence(__ATOMIC_ACQUIRE, "agent");
            asm volatile("s_waitcnt vmcnt(0)" ::: "memory");
        }
    }
    __syncthreads();
}


struct Params {
    const float *x, *meta, *emb_g, *emb_b, *w_in, *mu, *w0, *w_up, *a0, *a_up, *g_up, *k_k, *k_a, *r_k, *lnx_g, *lnx_b, *p_sb, *p_rwkv, *w_out,
        *ln1_g, *ln1_b, *router_w, *router_b, *ew_gate, *ew_up, *ew_down, *ln2_g, *ln2_b;
    float* out;
    unsigned* bar;
    int* counts;
    bf16_t *WtIn, *WtPsb, *WtPrw, *WtOut, *WtGU, *WtD, *hb, *P, *osb, *orw, *WupT, *AupT, *GupT;
    bf16_t *PcG, *QcG, *RhG, *Y0G, *GG, *SG;
    bf16_t *RwHi, *RwLo, *gleft;
    float* bonG;
    float* hmeta;
    bf16_t *gates, *merged, *hid, *fo;
    int* list;
    float* tokg;
};

DI float bf2f(bf16_t v) { return __uint_as_float((unsigned)v << 16); }
typedef __bf16 bf16x2_t __attribute__((ext_vector_type(2)));
DI bf16_t f2bf(float f) { return __builtin_bit_cast(bf16_t, (__bf16)f); }
DI unsigned pack2(float lo, float hi) { bf16x2_t v = {(__bf16)lo, (__bf16)hi}; return __builtin_bit_cast(unsigned, v); }
DI float lo_bf(unsigned u) { return __uint_as_float(u << 16); }
DI float hi_bf(unsigned u) { return __uint_as_float(u & 0xFFFF0000u); }
template <int CTRL> DI float dpp_mov(float v) { return __builtin_bit_cast(float, __builtin_amdgcn_update_dpp(0, __builtin_bit_cast(int, v), CTRL, 0xF, 0xF, true)); }
DI float sum8(float v) {
    v += dpp_mov<0xB1>(v);
    v += dpp_mov<0x4E>(v);
    v += dpp_mov<0x141>(v);
    return v;
}
DI float sum16(float v) { v = sum8(v); v += dpp_mov<0x140>(v); return v; }
DI float wave_sum(float v) { v = sum16(v); v += __shfl_xor(v, 16); v += __shfl_xor(v, 32); return v; }
struct Params;
DI const Params& kparams() {
    auto k = __builtin_amdgcn_kernarg_segment_ptr();
    asm volatile("" : "+s"(k));
    return *(const Params*)k;
}
DI int tid_() { int t = threadIdx.x; asm volatile("" : "+v"(t)); return t; }
DI float sigmoidf_(float x) { return __builtin_amdgcn_rcpf(1.0f + __expf(-x)); }
DI float tanhf_(float x) { return 1.0f - 2.0f * __builtin_amdgcn_rcpf(1.0f + __expf(2.0f * x)); }
DI void wave_sync() { asm volatile("s_waitcnt lgkmcnt(0)" ::: "memory"); __builtin_amdgcn_wave_barrier(); }

DI float* hrow2(float* hmeta, float* out, int tok) {
    const int b = tok >= L ? 1 : 0, t = tok - b * L;
    const unsigned long long am = (unsigned long long)(hmeta + (long long)(b * NMETA + t) * D), ao = (unsigned long long)(out + ((long long)b * SEQ + (t - NMETA)) * D);
    const unsigned long long m = 0ull - (unsigned long long)(t < NMETA);
    return (float*)((am & m) | (ao & ~m));
}
DI float* hrow(const Params& p, int tok) { return hrow2(p.hmeta, p.out, tok); }
DI float* hrow_u(const Params& p, int tok) { return hrow2(p.hmeta, p.out, __builtin_amdgcn_readfirstlane(tok)); }

DI void transpose_convert(const float* __restrict__ src, int ld, int K, int N, bf16_t* __restrict__ dst, int mult, int off, int bid, int nb, char* smem, int& rot) {
    float* tile = (float*)smem;
    const int tk = K / 64, tn = N / 256, tid = tid_();
    const int first = (bid - rot % nb + nb) % nb;
    rot += tk * tn;
    for (int t = first; t < tk * tn; t += nb) {
        const int k0 = (t / tn) * 64, n0 = (t % tn) * 256;
        f32x4 v[4][2];
#pragma unroll
        for (int q = 0; q < 4; ++q)
#pragma unroll
            for (int i = 0; i < 2; ++i) v[q][i] = *(const f32x4*)(src + (size_t)(k0 + (tid >> 4) + 32 * i) * ld + n0 + q * 64 + (tid & 15) * 4);
        __syncthreads();
#pragma unroll
        for (int q = 0; q < 4; ++q)
#pragma unroll
            for (int i = 0; i < 2; ++i) {
                float* tp = tile + q * 64 * 65 + ((tid >> 4) + 32 * i) * 65 + (tid & 15) * 4;
                tp[0] = v[q][i][0]; tp[1] = v[q][i][1]; tp[2] = v[q][i][2]; tp[3] = v[q][i][3];
            }
        __syncthreads();
        const int n = tid >> 3, kc = (tid & 7) * 8;
#pragma unroll
        for (int q = 0; q < 4; ++q) {
            const float* tq = tile + q * 64 * 65;
            u32x4 o;
#pragma unroll
            for (int jj = 0; jj < 4; ++jj) o[jj] = pack2(tq[(kc + 2 * jj) * 65 + n], tq[(kc + 2 * jj + 1) * 65 + n]);
            *(u32x4*)(dst + (size_t)((n0 + q * 64 + n) * mult + off) * K + k0 + kc) = o;
        }
    }
}

DI void convert_experts(const Params& p, int layer, int bid, int nb, char* smem) {
    int rot = 0;
    for (int e = 0; e < NE; ++e) {
        const size_t eo = ((size_t)layer * NE + e) * (size_t)D * DE;
        transpose_convert(p.ew_gate + eo, DE, D, DE, p.WtGU + (size_t)e * 1024 * 1024, 2, 0, bid, nb, smem, rot);
        transpose_convert(p.ew_up + eo, DE, D, DE, p.WtGU + (size_t)e * 1024 * 1024, 2, 1, bid, nb, smem, rot);
        transpose_convert(p.ew_down + eo, D, DE, D, p.WtD + (size_t)e * 1024 * 512, 1, 0, bid, nb, smem, rot);
    }
}

DI void phase_prologue_weights(const Params& p, int bid, int nb, char* smem) {
    int rot = 0;
    for (int i = bid * NTHR + tid_(); i < NE * D; i += nb * NTHR) {
        const int e = i / D, k = i % D;
        const float w = p.router_w[(size_t)k * NE + e];
        const bf16_t hi = f2bf(w);
        p.RwHi[i] = hi; p.RwLo[i] = f2bf(w - bf2f(hi));
    }
    for (int l = 0; l < DEPTH; ++l) {
        transpose_convert(p.w_in + (size_t)l * D * CIN, CIN, D, CIN, p.WtIn + (size_t)l * CIN * D, 1, 0, bid, nb, smem, rot);
        transpose_convert(p.p_sb + (size_t)l * 512 * D, D, 512, D, p.WtPsb + (size_t)l * D * 512, 1, 0, bid, nb, smem, rot);
        transpose_convert(p.p_rwkv + (size_t)l * 512 * D, D, 512, D, p.WtPrw + (size_t)l * D * 512, 1, 0, bid, nb, smem, rot);
        transpose_convert(p.w_out + (size_t)l * D * D, D, D, D, p.WtOut + (size_t)l * D * D, 1, 0, bid, nb, smem, rot);
        transpose_convert(p.w_up + (size_t)l * 64 * 512, 512, 64, 512, p.WupT + (size_t)l * 512 * 64, 1, 0, bid, nb, smem, rot);
        transpose_convert(p.a_up + (size_t)l * 64 * 512, 512, 64, 512, p.AupT + (size_t)l * 512 * 64, 1, 0, bid, nb, smem, rot);
        transpose_convert(p.g_up + (size_t)l * 128 * 512, 512, 128, 512, p.GupT + (size_t)l * 512 * 128, 1, 0, bid, nb, smem, rot);
    }
}

DI void ln16(float (&v)[16], const float* __restrict__ g, const float* __restrict__ b, int lane) {
    float s = 0.f;
#pragma unroll
    for (int i = 0; i < 16; ++i) s += v[i];
    const float mean = wave_sum(s) * (1.0f / D);
    float q = 0.f;
#pragma unroll
    for (int i = 0; i < 16; ++i) { v[i] -= mean; q += v[i] * v[i]; }
    const float rstd = rsqrtf(wave_sum(q) * (1.0f / D) + 1e-5f);
#pragma unroll
    for (int j = 0; j < 4; ++j) {
        const f32x4 gv = *(const f32x4*)(g + 256 * j + 4 * lane), bv = *(const f32x4*)(b + 256 * j + 4 * lane);
#pragma unroll
        for (int i = 0; i < 4; ++i) v[4 * j + i] = v[4 * j + i] * rstd * gv[i] + bv[i];
    }
}
DI void store_row(float* __restrict__ hf, bf16_t* __restrict__ hb, const float (&v)[16], int lane) {
#pragma unroll
    for (int j = 0; j < 4; ++j) {
        *(f32x4*)(hf + 256 * j + 4 * lane) = (f32x4){v[4 * j], v[4 * j + 1], v[4 * j + 2], v[4 * j + 3]};
        *(u32x2*)(hb + 256 * j + 4 * lane) = (u32x2){pack2(v[4 * j], v[4 * j + 1]), pack2(v[4 * j + 2], v[4 * j + 3])};
    }
}

DI void store_row_bf(bf16_t* __restrict__ hb, const float (&v)[16], int lane) {
#pragma unroll
    for (int j = 0; j < 4; ++j) *(u32x2*)(hb + 256 * j + 4 * lane) = (u32x2){pack2(v[4 * j], v[4 * j + 1]), pack2(v[4 * j + 2], v[4 * j + 3])};
}
DI void phase_embed(const Params& p, int bid, int nb) {
    const int lane = tid_() & 63, wid = __builtin_amdgcn_readfirstlane(tid_() >> 6);
    const int nwaves = nb * 8, gw = bid * 8 + wid, base_n = T / nwaves, extra = T % nwaves;
    const int tok0 = gw * base_n + (gw < extra ? gw : extra), ntok = base_n + (gw < extra ? 1 : 0);
    auto srcrow = [&](int tok) -> const float* {
        const int tk = __builtin_amdgcn_readfirstlane(tok), b = tk >= L ? 1 : 0, t = tk - b * L;
        const unsigned long long am = (unsigned long long)(p.meta + (long long)t * D), ao = (unsigned long long)(p.x + ((long long)b * SEQ + (t - NMETA)) * D);
        const unsigned long long m = 0ull - (unsigned long long)(t < NMETA);
        return (const float*)((am & m) | (ao & ~m));
    };
    f32x4 an[4];
    { const float* src = srcrow(tok0);
#pragma unroll
      for (int j = 0; j < 4; ++j) an[j] = *(const f32x4*)(src + 256 * j + 4 * lane); }
#pragma unroll 1
    for (int i = 0; i < ntok; ++i) {
        const int tok = tok0 + i;
        float v[16];
#pragma unroll
        for (int j = 0; j < 4; ++j) { v[4 * j] = an[j][0]; v[4 * j + 1] = an[j][1]; v[4 * j + 2] = an[j][2]; v[4 * j + 3] = an[j][3]; }
        if (i + 1 < ntok) { const float* src = srcrow(tok + 1);
#pragma unroll
            for (int j = 0; j < 4; ++j) an[j] = *(const f32x4*)(src + 256 * j + 4 * lane); }
        ln16(v, p.emb_g, p.emb_b, lane);
        store_row_bf(p.hb + (size_t)tok * D, v, lane);
    }
}

constexpr int LDT = 72;
constexpr int GEMM_LDS = 2 * 128 * LDT * 2;
template <class ARow, class Epi>
DI void gemm_tile128(ARow arow, const bf16_t* __restrict__ Bt, int ldb, int K, int m0, int n0, char* smem, Epi epi) {
    const int tid = tid_(), lane = tid & 63, wid = __builtin_amdgcn_readfirstlane(tid >> 6), fr = lane & 15, fq = lane >> 4;
    const int wr = wid >> 1, wc = wid & 1;
    bf16_t* As = (bf16_t*)smem;
    bf16_t* Bs = As + 128 * LDT;
    const bf16_t* ap[2]; const bf16_t* bp[2]; int so[2];
#pragma unroll
    for (int i = 0; i < 2; ++i) {
        const int c = tid + NTHR * i, row = c >> 3, kc = c & 7;
        const bf16_t* ar = arow(m0 + row);
        ap[i] = ar ? ar + kc * 8 : nullptr;
        bp[i] = Bt + (size_t)(n0 + row) * ldb + kc * 8;
        so[i] = row * LDT + kc * 8;
    }
    f32x4 acc[2][4];
#pragma unroll
    for (int mi = 0; mi < 2; ++mi)
#pragma unroll
        for (int ni = 0; ni < 4; ++ni) acc[mi][ni] = (f32x4){0.f, 0.f, 0.f, 0.f};
    u32x4 ra[2], rb[2];
#pragma unroll
    for (int i = 0; i < 2; ++i) { ra[i] = ap[i] ? *(const u32x4*)(ap[i]) : (u32x4){0u, 0u, 0u, 0u}; rb[i] = *(const u32x4*)(bp[i]); }
    for (int k0 = 0; k0 < K; k0 += 64) {
        __syncthreads();
#pragma unroll
        for (int i = 0; i < 2; ++i) { *(u32x4*)(As + so[i]) = ra[i]; *(u32x4*)(Bs + so[i]) = rb[i]; }
        __syncthreads();
        if (k0 + 64 < K) {
#pragma unroll
            for (int i = 0; i < 2; ++i) { ra[i] = ap[i] ? *(const u32x4*)(ap[i] + k0 + 64) : (u32x4){0u, 0u, 0u, 0u}; rb[i] = *(const u32x4*)(bp[i] + k0 + 64); }
        }
#pragma unroll
        for (int ks = 0; ks < 2; ++ks) {
            bf16x8 af[2], bf[4];
#pragma unroll
            for (int mi = 0; mi < 2; ++mi) af[mi] = *(const bf16x8*)(As + (wr * 32 + mi * 16 + fr) * LDT + ks * 32 + fq * 8);
#pragma unroll
            for (int ni = 0; ni < 4; ++ni) bf[ni] = *(const bf16x8*)(Bs + (wc * 64 + ni * 16 + fr) * LDT + ks * 32 + fq * 8);
#pragma unroll
            for (int mi = 0; mi < 2; ++mi)
#pragma unroll
                for (int ni = 0; ni < 4; ++ni) acc[mi][ni] = __builtin_amdgcn_mfma_f32_16x16x32_bf16(bf[ni], af[mi], acc[mi][ni], 0, 0, 0);
        }
    }
#pragma unroll
    for (int mi = 0; mi < 2; ++mi)
#pragma unroll
        for (int ni = 0; ni < 4; ++ni) epi(m0 + wr * 32 + mi * 16 + fr, n0 + wc * 64 + ni * 16 + fq * 4, acc[mi][ni]);
}

namespace g8 {
#define G8_LAS __attribute__((address_space(3)))
constexpr int BM = 256, BK = 64, HALF = 128, HTB = HALF * BK * 2, STAGE_BYTES = 8 * HTB, NXCD = 8, WGM = 8;
DI int lds_byte(int r, int c) { const int st = (r >> 4) * 2 + (c >> 5), rr = r & 15, cc = c & 31, ob = rr * 64 + cc * 2; return st * 1024 + (ob ^ (((ob >> 9) & 1) << 5)); }
DI void stage_rc(int b, int& R, int& C) { const int st = b / 1024, sb = b % 1024, swz = sb ^ (((sb >> 9) & 1) << 5); R = (st >> 1) * 16 + swz / 64; C = (st & 1) * 32 + (swz % 64) / 2; }
DI int perm32(int rho) { const int n = rho >> 4, i = rho & 15; return 8 * (i >> 2) + 4 * n + (i & 3); }
struct Unit { int pm, pn; const char* A; const char* B; int e, slot0, cnt; };

struct DenseOrder {
    int nM, nN, nwg, G, c; const char* A; const char* B; size_t tstep;
    DI void init(const bf16_t* A_, const bf16_t* Bt_, int nM_, int nN_, int K, int G_, int c_) { nM = nM_; nN = nN_; nwg = nM * nN; G = G_; c = c_; A = (const char*)A_; B = (const char*)Bt_; tstep = (size_t)BM * K * 2; }
    DI bool next(int i, Unit& u) const {
        const long Lq = (long)i * G + c; if (Lq >= nwg) return false;
        int wgid = (int)Lq; { const int q = nwg / NXCD, r = nwg % NXCD, xcd = wgid % NXCD, off = wgid / NXCD; wgid = (xcd < r ? xcd * (q + 1) : r * (q + 1) + (xcd - r) * q) + off; }
        const int nig = WGM * nN, gid = wgid / nig, fm = gid * WGM, gsz = (nM - fm) < WGM ? (nM - fm) : WGM;
        u.pm = fm + ((wgid % nig) % gsz); u.pn = (wgid % nig) / gsz; u.A = A + (size_t)u.pm * tstep; u.B = B + (size_t)u.pn * tstep; u.e = 0; u.slot0 = 0; u.cnt = 0; return true;
    }
    DI unsigned row_off(const Unit&, int) const { return 0u; }
};

template <bool GATHER, class Epi, class Sched>
DI void gemm8(G8_LAS unsigned char* lds, const int K, const Sched& S, const Epi& E) {
    const int tid = tid_(), wid = __builtin_amdgcn_readfirstlane(tid >> 6), lane = tid & 63, wr = wid >> 2, wc = wid & 3, fr = lane & 15, fq = lane >> 4;
    const int nt = K / BK;
    int Rr[2], Cc[2]; unsigned voffB[2], voffA[2];
#pragma unroll
    for (int i = 0; i < 2; ++i) { stage_rc(tid * 16 + i * 8192, Rr[i], Cc[i]); const int Rb = Epi::PERM ? ((Rr[i] & ~31) + perm32(Rr[i] & 31)) : Rr[i]; voffB[i] = (unsigned)(Rb * K + Cc[i]) * 2u; voffA[i] = (unsigned)(Rr[i] * K + Cc[i]) * 2u; }
    const size_t kstep = (size_t)(BK * 2), hstep = (size_t)HALF * K * 2;
    const unsigned ldsw = (unsigned)wid * 1024u;
    const int aoff = lds_byte(wr * 64 + fr, fq * 8), boff = lds_byte(wc * 32 + fr, fq * 8);
#define G8_SA(b, h) (((b) * 2 + (h)) * HTB)
#define G8_SB(b, h) ((4 + (b) * 2 + (h)) * HTB)
#define G8_STAGE(bufoff, gbase, voff) do { _Pragma("unroll") for (int _i = 0; _i < 2; ++_i) \
        __builtin_amdgcn_global_load_lds((const unsigned*)((const char*)(gbase) + (voff)[_i]), (G8_LAS unsigned*)(lds + (bufoff) + ldsw + _i * 8192), 16, 0, 0); } while (0)
#define G8_LDA(dst, b, h) do { _Pragma("unroll") for (int m = 0; m < 4; ++m) _Pragma("unroll") for (int k = 0; k < 2; ++k) dst[m][k] = *(const G8_LAS bf16x8*)(lds + G8_SA(b, h) + aoff + m * 2048 + k * 1024); } while (0)
#define G8_LDB(dst, b, h) do { _Pragma("unroll") for (int n = 0; n < 2; ++n) _Pragma("unroll") for (int k = 0; k < 2; ++k) dst[n][k] = *(const G8_LAS bf16x8*)(lds + G8_SB(b, h) + boff + n * 2048 + k * 1024); } while (0)
#define G8_MMA(ai, bj, At, Bt) do { __builtin_amdgcn_s_setprio(1); _Pragma("unroll") for (int m = 0; m < 4; ++m) _Pragma("unroll") for (int n = 0; n < 2; ++n) _Pragma("unroll") for (int k = 0; k < 2; ++k) \
        acc[ai][bj][m][n] = __builtin_amdgcn_mfma_f32_16x16x32_bf16(Bt[n][k], At[m][k], acc[ai][bj][m][n], 0, 0, 0); __builtin_amdgcn_s_setprio(0); } while (0)
#define G8_WAIT_V(n) asm volatile("s_waitcnt vmcnt(" #n ")" ::: "memory")
#define G8_WAIT_L(n) asm volatile("s_waitcnt lgkmcnt(" #n ")" ::: "memory")
#define G8_BAR __builtin_amdgcn_s_barrier()
#define G8_SCHED __builtin_amdgcn_sched_barrier(0)
#define G8_AOFF(dst, un) do { if (GATHER) { _Pragma("unroll") for (int _h = 0; _h < 2; ++_h) _Pragma("unroll") for (int _i = 0; _i < 2; ++_i) \
        dst[_h][_i] = S.row_off(un, _h * HALF + Rr[_i]) + (unsigned)Cc[_i] * 2u; } } while (0)
#define G8_STAGE_A(bufoff, gb, vo, h) do { if (GATHER) { G8_STAGE(bufoff, gb, vo[h]); } else { G8_STAGE(bufoff, (gb) + (h) * hstep, voffA); } } while (0)
    Unit cur, nxt; int ui = 0;
    if (!S.next(0, cur)) return;
    f32x4 acc[2][2][4][2];
#pragma unroll
    for (int a = 0; a < 2; ++a)
#pragma unroll
        for (int b = 0; b < 2; ++b)
#pragma unroll
            for (int m = 0; m < 4; ++m)
#pragma unroll
                for (int n = 0; n < 2; ++n) acc[a][b][m][n] = (f32x4){0.f, 0.f, 0.f, 0.f};
    bf16x8 At[4][2], B0[2][2], B1[2][2];
    unsigned cvA[2][2], nvA[2][2];
    G8_AOFF(cvA, cur);
    const char* cA = cur.A; const char* cB = cur.B;
    G8_STAGE(G8_SB(0, 0), cB, voffB); G8_STAGE_A(G8_SA(0, 0), cA, cvA, 0); G8_STAGE(G8_SB(0, 1), cB + hstep, voffB); G8_STAGE_A(G8_SA(0, 1), cA, cvA, 1);
    if (wr == 1) G8_BAR;
    G8_WAIT_V(4); G8_BAR;
    G8_STAGE(G8_SB(1, 0), cB + kstep, voffB); G8_STAGE_A(G8_SA(1, 0), cA + kstep, cvA, 0); G8_STAGE(G8_SB(1, 1), cB + hstep + kstep, voffB);
    G8_WAIT_V(6); G8_BAR;
    for (;;) {
        const bool has_next = S.next(ui + 1, nxt);
        const char* nA = has_next ? nxt.A : cA; const char* nB = has_next ? nxt.B : cB;
        if (GATHER) {
            if (has_next) { G8_AOFF(nvA, nxt); } else {
#pragma unroll
                for (int h = 0; h < 2; ++h)
#pragma unroll
                    for (int i = 0; i < 2; ++i) nvA[h][i] = cvA[h][i];
            }
        }
        for (int t = 0; t < nt; t += 2) {
            const bool last = (t == nt - 2);
            const char* a1 = cA + (size_t)(t + 1) * kstep;
            const char* a2 = last ? nA : cA + (size_t)(t + 2) * kstep; const char* b2 = last ? nB : cB + (size_t)(t + 2) * kstep;
            const char* a3 = a2 + kstep; const char* b3 = b2 + kstep;

            G8_LDB(B0, 0, 0); G8_SCHED; G8_LDA(At, 0, 0); G8_STAGE_A(G8_SA(1, 1), a1, cvA, 1);
            if (GATHER && last) {
#pragma unroll
                for (int h = 0; h < 2; ++h)
#pragma unroll
                    for (int i = 0; i < 2; ++i) cvA[h][i] = nvA[h][i];
            }
            G8_WAIT_L(8); G8_BAR; G8_WAIT_L(0); G8_MMA(0, 0, At, B0); G8_BAR; G8_SCHED;
            G8_LDB(B1, 0, 1); G8_STAGE(G8_SB(0, 0), b2, voffB);
            G8_BAR; G8_WAIT_L(0); G8_MMA(0, 1, At, B1); G8_BAR;
            G8_LDA(At, 0, 1); G8_STAGE_A(G8_SA(0, 0), a2, cvA, 0);
            G8_BAR; G8_WAIT_L(0); G8_MMA(1, 0, At, B0); G8_BAR; G8_SCHED;
            G8_STAGE(G8_SB(0, 1), b2 + hstep, voffB);
            G8_WAIT_V(6); G8_BAR; G8_MMA(1, 1, At, B1); G8_BAR;
            G8_LDB(B0, 1, 0); G8_SCHED; G8_LDA(At, 1, 0); G8_STAGE_A(G8_SA(0, 1), a2, cvA, 1);
            G8_WAIT_L(8); G8_BAR; G8_WAIT_L(0); G8_MMA(0, 0, At, B0); G8_BAR; G8_SCHED;
            G8_LDB(B1, 1, 1); G8_STAGE(G8_SB(1, 0), b3, voffB);
            G8_BAR; G8_WAIT_L(0); G8_MMA(0, 1, At, B1); G8_BAR;
            G8_LDA(At, 1, 1); G8_STAGE_A(G8_SA(1, 0), a3, cvA, 0);
            G8_BAR; G8_WAIT_L(0); G8_MMA(1, 0, At, B0); G8_BAR; G8_SCHED;
            G8_STAGE(G8_SB(1, 1), b3 + hstep, voffB);
            G8_WAIT_V(6); G8_BAR; G8_MMA(1, 1, At, B1); G8_BAR;
        }
        { int fr2 = fr, fq2 = fq; asm volatile("" : "+v"(fr2), "+v"(fq2)); E(acc, cur, wr, wc, fr2, fq2); }
        if (!has_next) break;
#pragma unroll
        for (int a = 0; a < 2; ++a)
#pragma unroll
            for (int b = 0; b < 2; ++b)
#pragma unroll
                for (int m = 0; m < 4; ++m)
#pragma unroll
                    for (int n = 0; n < 2; ++n) acc[a][b][m][n] = (f32x4){0.f, 0.f, 0.f, 0.f};
        cur = nxt; cA = nA; cB = nB; ++ui;
    }
    G8_WAIT_V(0);
    if (wr == 0) G8_BAR;
    G8_BAR;
#undef G8_SA
#undef G8_SB
#undef G8_STAGE
#undef G8_LDA
#undef G8_LDB
#undef G8_MMA
#undef G8_WAIT_V
#undef G8_WAIT_L
#undef G8_BAR
#undef G8_SCHED
#undef G8_AOFF
#undef G8_STAGE_A
}
}

constexpr int MFULL = 64, M0_LEFT = MFULL * 256;
struct EpiStore {
    static constexpr bool PERM = true;
    bf16_t* O; int ldc; bool sig;
    DI void operator()(const f32x4 (&acc)[2][2][4][2], const g8::Unit& u, int wr, int wc, int fr, int fq) const {
#pragma unroll
        for (int ai = 0; ai < 2; ++ai)
#pragma unroll
            for (int m = 0; m < 4; ++m) {
                bf16_t* rowp = O + (size_t)(u.pm * 256 + ai * 128 + wr * 64 + m * 16 + fr) * ldc + u.pn * 256 + wc * 32 + 8 * fq;
#pragma unroll
                for (int bj = 0; bj < 2; ++bj) {
                    f32x4 v0 = acc[ai][bj][m][0], v1 = acc[ai][bj][m][1];
                    if (sig) {
#pragma unroll
                        for (int e = 0; e < 4; ++e) { v0[e] = sigmoidf_(v0[e]); v1[e] = sigmoidf_(v1[e]); }
                    }
                    *(u32x4*)(rowp + bj * 128) = (u32x4){pack2(v0[0], v0[1]), pack2(v0[2], v0[3]), pack2(v1[0], v1[1]), pack2(v1[2], v1[3])};
                }
            }
    }
};
DI int left_first(int units, int bid, int nb) { return (bid - units % nb + nb) % nb; }

constexpr int LEFT_LDS = 2 * (32 + 128) * LDT * 2;
template <class ARow, class Epi>
DI void gemm_left32(ARow arow, const bf16_t* __restrict__ Bt, int ldb, int K, int n0, char* smem, Epi epi) {
    const int tid = tid_(), lane = tid & 63, wid = __builtin_amdgcn_readfirstlane(tid >> 6), fr = lane & 15, fq = lane >> 4;
    bf16_t* As = (bf16_t*)smem;
    bf16_t* Bs = As + 2 * 32 * LDT;
    const int arow_i = tid >> 4, akc = (tid & 15) * 4;
    const bf16_t* ap = arow(arow_i) + akc;
    const bf16_t* bp[2]; int bso[2];
#pragma unroll
    for (int i = 0; i < 2; ++i) { const int cc = tid + NTHR * i, row = cc >> 3, kc = cc & 7; bp[i] = Bt + (size_t)(n0 + row) * ldb + kc * 8; bso[i] = row * LDT + kc * 8; }
    const int nit = K / 64;
    u32x2 ra[4]; u32x4 rb[4][2];
#define GL_LOAD(slot, it) do { if ((it) < nit) { ra[slot] = *(const u32x2*)(ap + (it) * 64); rb[slot][0] = *(const u32x4*)(bp[0] + (it) * 64); rb[slot][1] = *(const u32x4*)(bp[1] + (it) * 64); } } while (0)
#define GL_WRITE(slot, buf) do { *(u32x2*)(As + (buf) * 32 * LDT + arow_i * LDT + akc) = ra[slot]; *(u32x4*)(Bs + (buf) * 128 * LDT + bso[0]) = rb[slot][0]; *(u32x4*)(Bs + (buf) * 128 * LDT + bso[1]) = rb[slot][1]; } while (0)
    f32x4 acc[2] = {(f32x4){0.f, 0.f, 0.f, 0.f}, (f32x4){0.f, 0.f, 0.f, 0.f}};
    GL_LOAD(0, 0); GL_LOAD(1, 1); GL_LOAD(2, 2); GL_LOAD(3, 3);
    __syncthreads();
    GL_WRITE(0, 0);
    __syncthreads();
#define GL_STEP(slot, it) do { \
        GL_LOAD(slot, (it) + 4); \
        const int buf = (it) & 1; \
        _Pragma("unroll") for (int ks = 0; ks < 2; ++ks) { \
            const bf16x8 bf = *(const bf16x8*)(Bs + buf * 128 * LDT + (wid * 16 + fr) * LDT + ks * 32 + fq * 8); \
            _Pragma("unroll") for (int mt = 0; mt < 2; ++mt) { \
                const bf16x8 af = *(const bf16x8*)(As + buf * 32 * LDT + (mt * 16 + fr) * LDT + ks * 32 + fq * 8); \
                acc[mt] = __builtin_amdgcn_mfma_f32_16x16x32_bf16(bf, af, acc[mt], 0, 0, 0); } } \
        if ((it) + 1 < nit) { GL_WRITE(((slot) + 1) & 3, buf ^ 1); } \
        __syncthreads(); } while (0)
    for (int it = 0; it < nit; it += 4) {
        GL_STEP(0, it);
        if (it + 1 < nit) GL_STEP(1, it + 1);
        if (it + 2 < nit) GL_STEP(2, it + 2);
        if (it + 3 < nit) GL_STEP(3, it + 3);
    }
#undef GL_LOAD
#undef GL_WRITE
#undef GL_STEP
#pragma unroll
    for (int mt = 0; mt < 2; ++mt) epi(mt * 16 + fr, n0 + wid * 16 + fq * 4, acc[mt]);
}

DI void phase_inproj(const Params& p, int layer, int bid, int nb, char* smem) {
    const bf16_t* hb = p.hb; bf16_t* P = p.P;
    const bf16_t* Bt = p.WtIn + (size_t)layer * CIN * D;
    g8::DenseOrder S; S.init(hb, Bt, MFULL, CP / 256, D, nb, bid);
    g8::gemm8<false>((G8_LAS unsigned char*)smem, D, S, EpiStore{P, CP, false});
    bf16_t* G = p.gleft - (size_t)M0_LEFT * 2048; const bf16_t* Wg = p.WtIn + ((size_t)layer * CIN + CP) * D;
    for (int t = left_first(MFULL * (CP / 256), bid, nb); t < CP / 128 + 2048 / 128; t += nb) {
        if (t < CP / 128)
            gemm_left32([=](int r) { return hb + (size_t)(M0_LEFT + r) * D; }, Bt, D, D, t * 128, smem,
                        [=](int r, int c, f32x4 v) { *(u32x2*)(P + (size_t)(M0_LEFT + r) * CP + c) = (u32x2){pack2(v[0], v[1]), pack2(v[2], v[3])}; });
        else
            gemm_left32([=](int r) { return hb + (size_t)(M0_LEFT + r) * D; }, Wg, D, D, (t - CP / 128) * 128, smem,
                        [=](int r, int c, f32x4 v) { *(u32x2*)(G + (size_t)(M0_LEFT + r) * 2048 + c) = (u32x2){pack2(sigmoidf_(v[0]), sigmoidf_(v[1])), pack2(sigmoidf_(v[2]), sigmoidf_(v[3]))}; });
    }
}

constexpr int NCHUNK = (L + 63) / 64, NUNIT = NBATCH * HEADS * NCHUNK;
constexpr int LS = 72, RB = 64 * LS * 2;
constexpr int R1_LDS = 16 * RB + 4096 + 7168;
#define RBUF(i) ((bf16_t*)(smem + (i) * RB))
typedef float f32x16 __attribute__((ext_vector_type(16)));

template <int KK> DI f32x4 mm16(const bf16_t* F, int ldf, const bf16_t* S, int lds_, f32x4 acc, int lane) {
    const int fr = lane & 15, fq = lane >> 4;
#pragma unroll
    for (int ks = 0; ks < KK / 32; ++ks) {
        const bf16x8 f = *(const bf16x8*)(F + fr * ldf + ks * 32 + fq * 8);
        const bf16x8 g = *(const bf16x8*)(S + fr * lds_ + ks * 32 + fq * 8);
        acc = __builtin_amdgcn_mfma_f32_16x16x32_bf16(f, g, acc, 0, 0, 0);
    }
    return acc;
}
DI u32x2 pk4(f32x4 v) { return (u32x2){pack2(v[0], v[1]), pack2(v[2], v[3])}; }
DI f32x4 up4(u32x2 v) { return (f32x4){lo_bf(v[0]), hi_bf(v[0]), lo_bf(v[1]), hi_bf(v[1])}; }

template <int MODE> DI void phase_rwkv_r1(const Params& p, int layer, int bid, int nb, char* smem) {
    const int wv = __builtin_amdgcn_readfirstlane(tid_() >> 6);
    const f32x4 zero = (f32x4){0.f, 0.f, 0.f, 0.f};
    float* lwT = (float*)RBUF(4);
    float* aT = (float*)RBUF(6);
    float* gt = (float*)(smem + 16 * RB);
    float* gammaC = gt + 512;
    bf16_t* Xt0 = RBUF(14);
    bf16_t* Xt1 = RBUF(4);
    const bf16_t* WupT = p.WupT + (size_t)layer * 512 * 64, *AupT = p.AupT + (size_t)layer * 512 * 64, *GupT = p.GupT + (size_t)layer * 512 * 128;
    float* mu = (float*)(smem + 16 * RB + 4096);
    __syncthreads();
    for (int i = tid_(); i < RSW; i += NTHR) mu[i] = p.mu[(size_t)layer * RSW + i];
    for (int it = 0;; ++it) {
        const int tid = tid_(), lane = tid & 63, fr = lane & 15, fq = lane >> 4;
        int c, bh;
        if (MODE == 0) {
            const int Lq = it * nb + bid, q = Lq >> 3, cb = (q >> 3) * 8 + (Lq & 7);
            if (cb >= NBATCH * (NCHUNK - 1)) break;
            c = cb % (NCHUNK - 1); bh = (cb / (NCHUNK - 1)) * HEADS + (q & 7);
        } else {
            if (it > 0) break;
            c = NCHUNK - 1; bh = bid;
        }
        const int u = bh * NCHUNK + c, h = bh % HEADS, bb = bh / HEADS;
        const size_t tok0 = (size_t)bb * L + c * 64;
        bf16x8 fw[2][2], fa[2][2], fg[2][4];
#pragma unroll
        for (int t2 = 0; t2 < 2; ++t2) {
            const int tl = wv * 2 + t2, pt = tl >> 2, qt = tl & 3;
#pragma unroll
            for (int ks = 0; ks < 2; ++ks) {
                fw[t2][ks] = *(const bf16x8*)(WupT + (size_t)(h * 64 + qt * 16 + fr) * 64 + ks * 32 + fq * 8);
                fa[t2][ks] = *(const bf16x8*)(AupT + (size_t)(h * 64 + pt * 16 + fr) * 64 + ks * 32 + fq * 8);
            }
        }
        __syncthreads();
        {
            u32x4 curv[7], prvv[7];
#pragma unroll
            for (int it2 = 0; it2 < 7; ++it2) {
                const int cid = tid + NTHR * it2, i = cid / 56, cc = cid % 56;
                const int col = cc < 8 ? RW_R + h * 64 + cc * 8 : cc < 16 ? RW_K + h * 64 + (cc - 8) * 8 : cc < 24 ? RW_V + h * 64 + (cc - 16) * 8 : RW_WD + (cc - 24) * 8;
                const int t = c * 64 + i;
                curv[it2] = (u32x4){0u, 0u, 0u, 0u}; prvv[it2] = (u32x4){0u, 0u, 0u, 0u};
                if (t < L) curv[it2] = *(const u32x4*)(p.P + (tok0 + i) * CP + OFF_RW + col);
                if (t < L && t > 0) prvv[it2] = *(const u32x4*)(p.P + (tok0 + i - 1) * CP + OFF_RW + col);
            }
#pragma unroll
            for (int it2 = 0; it2 < 7; ++it2) {
                const int cid = tid + NTHR * it2, i = cid / 56, cc = cid % 56;
                const int col = cc < 8 ? RW_R + h * 64 + cc * 8 : cc < 16 ? RW_K + h * 64 + (cc - 8) * 8 : cc < 24 ? RW_V + h * 64 + (cc - 16) * 8 : RW_WD + (cc - 24) * 8;
                bf16_t* dst = cc < 8 ? RBUF(8) + i * LS + cc * 8 : cc < 16 ? RBUF(9) + i * LS + (cc - 8) * 8 : cc < 24 ? RBUF(10) + i * LS + (cc - 16) * 8
                            : cc < 32 ? RBUF(0) + i * LS + (cc - 24) * 8 : cc < 40 ? RBUF(1) + i * LS + (cc - 32) * 8 : RBUF(2) + i * 136 + (cc - 40) * 8;
                const f32x4 m0 = *(const f32x4*)(mu + col), m1 = *(const f32x4*)(mu + col + 4);
                const u32x4 cur = curv[it2], prv = prvv[it2];
                float x[8];
#pragma unroll
                for (int j2 = 0; j2 < 4; ++j2) {
                    const float c0 = lo_bf(cur[j2]), c1 = hi_bf(cur[j2]), p0 = lo_bf(prv[j2]), p1 = hi_bf(prv[j2]);
                    const float mm0 = j2 < 2 ? m0[2 * j2] : m1[2 * j2 - 4], mm1 = j2 < 2 ? m0[2 * j2 + 1] : m1[2 * j2 - 3];
                    x[2 * j2] = c0 + (p0 - c0) * mm0; x[2 * j2 + 1] = c1 + (p1 - c1) * mm1;
                }
                if (cc >= 24 && cc < 32) {
#pragma unroll
                    for (int j2 = 0; j2 < 8; ++j2) x[j2] = tanhf_(x[j2]);
                } else if (cc >= 40) {
#pragma unroll
                    for (int j2 = 0; j2 < 8; ++j2) x[j2] = sigmoidf_(x[j2]);
                }
                *(u32x4*)dst = (u32x4){pack2(x[0], x[1]), pack2(x[2], x[3]), pack2(x[4], x[5]), pack2(x[6], x[7])};
            }
        }
#pragma unroll
        for (int t2 = 0; t2 < 2; ++t2)
#pragma unroll
            for (int ks = 0; ks < 4; ++ks) fg[t2][ks] = *(const bf16x8*)(GupT + (size_t)(h * 64 + ((wv * 2 + t2) >> 2) * 16 + fr) * 128 + ks * 32 + fq * 8);
        __syncthreads();
#pragma unroll
        for (int t2 = 0; t2 < 2; ++t2) {
            const int tl = wv * 2 + t2, pt = tl >> 2, qt = tl & 3;
            f32x4 aw = zero, aa = zero, ag = zero;
#pragma unroll
            for (int ks = 0; ks < 2; ++ks) {
                const bf16x8 xw = *(const bf16x8*)(RBUF(0) + (pt * 16 + fr) * LS + ks * 32 + fq * 8);
                aw = __builtin_amdgcn_mfma_f32_16x16x32_bf16(xw, fw[t2][ks], aw, 0, 0, 0);
                const bf16x8 xa = *(const bf16x8*)(RBUF(1) + (qt * 16 + fr) * LS + ks * 32 + fq * 8);
                aa = __builtin_amdgcn_mfma_f32_16x16x32_bf16(fa[t2][ks], xa, aa, 0, 0, 0);
            }
#pragma unroll
            for (int ks = 0; ks < 4; ++ks) {
                const bf16x8 xg = *(const bf16x8*)(RBUF(2) + (qt * 16 + fr) * 136 + ks * 32 + fq * 8);
                ag = __builtin_amdgcn_mfma_f32_16x16x32_bf16(fg[t2][ks], xg, ag, 0, 0, 0);
            }
            const int ch = qt * 16 + fr;
            const float w0 = p.w0[layer * 512 + h * 64 + ch];
            const f32x4 a0 = *(const f32x4*)(p.a0 + layer * 512 + h * 64 + pt * 16 + fq * 4);
            f32x4 lw, av;
#pragma unroll
            for (int e = 0; e < 4; ++e) { lw[e] = -DECAY_SCALE * sigmoidf_(w0 + aw[e]); av[e] = sigmoidf_(a0[e] + aa[e]); }
            *(f32x4*)(lwT + ch * 68 + pt * 16 + fq * 4) = lw;
            *(f32x4*)(aT + (qt * 16 + fr) * 68 + pt * 16 + fq * 4) = av;
            *(u32x2*)(p.GG + ((size_t)u * 64 + qt * 16 + fr) * 64 + pt * 16 + fq * 4) = pk4(ag);
        }
        __syncthreads();
        {
            const int i = tid >> 3, c8 = (tid & 7) * 8, cg = layer * 512 + h * 64 + c8;
            const u32x4 xr = *(const u32x4*)(RBUF(8) + i * LS + c8), xk = *(const u32x4*)(RBUF(9) + i * LS + c8);
            const f32x4 a0 = *(const f32x4*)(aT + i * 68 + c8), a1 = *(const f32x4*)(aT + i * 68 + c8 + 4);
            const f32x4 kk0 = *(const f32x4*)(p.k_k + cg), kk1 = *(const f32x4*)(p.k_k + cg + 4), ka0 = *(const f32x4*)(p.k_a + cg), ka1 = *(const f32x4*)(p.k_a + cg + 4);
            const f32x4 rk0 = *(const f32x4*)(p.r_k + cg), rk1 = *(const f32x4*)(p.r_k + cg + 4);
            float n2 = 0.f, bon = 0.f;
#pragma unroll
            for (int j = 0; j < 8; ++j) {
                const float r_ = (j & 1) ? hi_bf(xr[j >> 1]) : lo_bf(xr[j >> 1]), k_ = (j & 1) ? hi_bf(xk[j >> 1]) : lo_bf(xk[j >> 1]);
                const float a_ = j < 4 ? a0[j & 3] : a1[j & 3], kkc = j < 4 ? kk0[j & 3] : kk1[j & 3], kac = j < 4 ? ka0[j & 3] : ka1[j & 3], rkc = j < 4 ? rk0[j & 3] : rk1[j & 3];
                const float kkr = k_ * kkc;
                n2 += kkr * kkr;
                bon += r_ * (k_ * (1.0f + (a_ - 1.0f) * kac)) * rkc;
            }
            n2 = sum8(n2); bon = sum8(bon);
            if ((tid & 7) == 0) { gt[576 + i] = 1.0f / fmaxf(sqrtf(n2), 1e-12f); p.bonG[(size_t)u * 64 + i] = bon; }
        }
        __syncthreads();
        {
            const int ch = lane, cg = layer * 512 + h * 64 + ch;
            float lw[8], av[8], cum[8];
            {
                const f32x4 l0 = *(const f32x4*)(lwT + ch * 68 + wv * 8), l1 = *(const f32x4*)(lwT + ch * 68 + wv * 8 + 4);
#pragma unroll
                for (int e = 0; e < 4; ++e) { lw[e] = l0[e]; lw[e + 4] = l1[e]; }
#pragma unroll
                for (int e = 0; e < 8; ++e) av[e] = aT[(wv * 8 + e) * 68 + ch];
            }
            float run = 0.f;
#pragma unroll
            for (int e = 0; e < 8; ++e) { run += lw[e]; cum[e] = run; }
            gt[wv * 64 + ch] = run;
            __syncthreads();
            float offs = 0.f, tot = 0.f;
#pragma unroll
            for (int g2 = 0; g2 < 8; ++g2) { const float gv = gt[g2 * 64 + ch]; offs += g2 < wv ? gv : 0.f; tot += gv; }
            if (wv == 0) gammaC[ch] = __expf(tot);
            const float kkc = p.k_k[cg], kac = p.k_a[cg];
            float at_[8], kt_[8], bt_[8], vt_[8];
#pragma unroll
            for (int e = 0; e < 8; ++e) {
                const int i = wv * 8 + e;
                const float xr = bf2f(RBUF(8)[i * LS + ch]), xk = bf2f(RBUF(9)[i * LS + ch]), xv = bf2f(RBUF(10)[i * LS + ch]);
                const float cm = cum[e] + offs;
                const float kk = xk * kkc * gt[576 + i];
                const float kq = xk * (1.0f + (av[e] - 1.0f) * kac);
                if (c * 64 + i < L) p.orw[(tok0 + i) * 512 + h * 64 + ch] = RBUF(10)[i * LS + ch];
                const float eneg = __expf(-cm), epos = __expf(cm), eexc = __expf(cm - lw[e]);
                at_[e] = -kk * eexc; kt_[e] = kq * eneg; bt_[e] = kk * av[e] * eneg; vt_[e] = xv;
                RBUF(3)[i * LS + ch] = f2bf(xr * epos);
            }
            __syncthreads();
#pragma unroll
            for (int e = 0; e < 8; ++e) {
                const int i = wv * 8 + e;
                RBUF(0)[i * LS + ch] = f2bf(at_[e]); RBUF(1)[i * LS + ch] = f2bf(kt_[e]); RBUF(2)[i * LS + ch] = f2bf(bt_[e]);
            }
            *(u32x4*)(RBUF(11) + ch * LS + wv * 8) = (u32x4){pack2(kt_[0], kt_[1]), pack2(kt_[2], kt_[3]), pack2(kt_[4], kt_[5]), pack2(kt_[6], kt_[7])};
            *(u32x4*)(RBUF(12) + ch * LS + wv * 8) = (u32x4){pack2(bt_[0], bt_[1]), pack2(bt_[2], bt_[3]), pack2(bt_[4], bt_[5]), pack2(bt_[6], bt_[7])};
            *(u32x4*)(RBUF(13) + ch * LS + wv * 8) = (u32x4){pack2(vt_[0], vt_[1]), pack2(vt_[2], vt_[3]), pack2(vt_[4], vt_[5]), pack2(vt_[6], vt_[7])};
            *(u32x4*)(Xt0 + ch * LS + wv * 8) = (u32x4){pack2(at_[0], at_[1]), pack2(at_[2], at_[3]), pack2(at_[4], at_[5]), pack2(at_[6], at_[7])};
        }
        __syncthreads();
#pragma unroll
        for (int prod = 0; prod < 5; ++prod) {
            const bf16_t* F = prod == 0 ? RBUF(1) : prod == 1 ? RBUF(2) : prod == 2 ? RBUF(0) : prod == 3 ? RBUF(1) : RBUF(2);
            const bf16_t* S = prod == 0 ? RBUF(0) : prod == 1 ? RBUF(0) : prod == 2 ? RBUF(2) : RBUF(3);
            bf16_t* O = prod == 0 ? RBUF(6) : prod == 1 ? RBUF(7) : prod == 2 ? RBUF(8) : prod == 3 ? RBUF(9) : RBUF(10);
            const int mode = prod < 2 ? 0 : prod == 2 ? 2 : 1;
#pragma unroll
            for (int rep = 0; rep < 2; ++rep) {
                const int tl = wv + 8 * rep, pt = tl >> 2, qt = tl & 3;
                f32x4 acc = zero;
                if (mode == 2 ? pt >= qt : pt <= qt) acc = mm16<64>(F + pt * 16 * LS, LS, S + qt * 16 * LS, LS, zero, lane);
                const int qi = qt * 16 + fr;
#pragma unroll
                for (int e = 0; e < 4; ++e) {
                    const int pi = pt * 16 + fq * 4 + e;
                    const bool keep = mode == 0 ? pi < qi : (mode == 1 ? pi <= qi : qi < pi);
                    acc[e] = keep ? acc[e] : 0.f;
                }
                *(u32x2*)(O + qi * LS + pt * 16 + fq * 4) = pk4(acc);
            }
        }
        __syncthreads();
        f32x4 X[4];
        if (wv < 4) {
#pragma unroll
            for (int pt = 0; pt < 4; ++pt) X[pt] = up4(*(const u32x2*)(Xt0 + (wv * 16 + fr) * LS + pt * 16 + fq * 4));
        } else {
#pragma unroll
            for (int pt = 0; pt < 4; ++pt) {
                X[pt] = mm16<64>(RBUF(6) + pt * 16 * LS, LS, RBUF(13) + (wv - 4) * 16 * LS, LS, zero, lane);
                *(u32x2*)(Xt0 + (wv * 16 + fr) * LS + pt * 16 + fq * 4) = pk4(X[pt]);
            }
        }
        __syncthreads();
#pragma unroll
        for (int k = 0; k < 6; ++k) {
            const bf16_t* Mk = (k & 1) ? RBUF(0) : RBUF(7);
            const bf16_t* Mkt = (k & 1) ? RBUF(6) : RBUF(8);
            bf16_t* Mn = (k & 1) ? RBUF(7) : RBUF(0);
            bf16_t* Mnt = (k & 1) ? RBUF(8) : RBUF(6);
            const bf16_t* Xc = (k & 1) ? Xt1 : Xt0;
            bf16_t* Xn = (k & 1) ? Xt0 : Xt1;
#pragma unroll
            for (int pt = 0; pt < 4; ++pt) {
                constexpr int dummy = 0; (void)dummy;
                const int maxj = 16 * pt + 15 - (1 << k);
                if (maxj >= 0) {
                    const int nks = maxj / 32 + 1;
#pragma unroll
                    for (int ks = 0; ks < 2; ++ks)
                        if (ks < nks) {
                            const bf16x8 f = *(const bf16x8*)(Mk + (pt * 16 + fr) * LS + ks * 32 + fq * 8);
                            const bf16x8 g = *(const bf16x8*)(Xc + (wv * 16 + fr) * LS + ks * 32 + fq * 8);
                            X[pt] = __builtin_amdgcn_mfma_f32_16x16x32_bf16(f, g, X[pt], 0, 0, 0);
                        }
                }
                *(u32x2*)(Xn + (wv * 16 + fr) * LS + pt * 16 + fq * 4) = pk4(X[pt]);
            }
            if (k < 5) {
#pragma unroll
                for (int which = 0; which < 2; ++which) {
                    const bf16_t* F = which ? Mk : Mkt; const bf16_t* S = which ? Mkt : Mk; bf16_t* O = which ? Mnt : Mn;
#pragma unroll
                    for (int rep = 0; rep < 2; ++rep) {
                        const int t2 = wv + 8 * rep, pt = t2 >> 2, qt = t2 & 3;
                        const int it = which ? pt : qt, jt = which ? qt : pt;
                        f32x4 acc = zero;
                        const int mlo = 16 * jt + (1 << k), mhi = 16 * it + 15 - (1 << k);
                        if (16 * it + 15 - 16 * jt >= (2 << k) && mhi >= mlo) {
                            const int k0 = mlo >> 5, k1 = mhi >> 5;
                            for (int ks = k0; ks <= k1; ++ks) {
                                const bf16x8 f = *(const bf16x8*)(F + (pt * 16 + fr) * LS + ks * 32 + fq * 8);
                                const bf16x8 g = *(const bf16x8*)(S + (qt * 16 + fr) * LS + ks * 32 + fq * 8);
                                acc = __builtin_amdgcn_mfma_f32_16x16x32_bf16(f, g, acc, 0, 0, 0);
                            }
                        }
                        *(u32x2*)(O + (qt * 16 + fr) * LS + pt * 16 + fq * 4) = pk4(acc);
                    }
                }
            }
            __syncthreads();
        }
#pragma unroll
        for (int rep = 0; rep < 2; ++rep) {
            const int tl = wv + 8 * rep, pt = tl >> 2, qt = tl & 3;
            const int pi0 = pt * 16 + fq * 4, qi = qt * 16 + fr;
            const size_t go = ((size_t)u * 64 + qi) * 64 + pi0;
            {
                f32x4 acc = mm16<64>(Xt0 + pt * 16 * LS, LS, RBUF(12) + qt * 16 * LS, LS, zero, lane);
                const float gc = gammaC[qi];
#pragma unroll
                for (int e = 0; e < 4; ++e) acc[e] = (acc[e] + (pi0 + e == qi ? 1.f : 0.f)) * gc;
                {
                    const size_t d = (((size_t)u * 8 + (qi >> 5) * 4 + (pi0 >> 4)) * 64 + (qi & 31) + 32 * ((pi0 >> 2) & 1)) * 8 + ((pi0 >> 3) & 1) * 4;
                    *(u32x2*)(p.PcG + d) = pk4(acc);
                }
            }
            {
                f32x4 acc = mm16<64>(RBUF(11) + pt * 16 * LS, LS, RBUF(13) + qt * 16 * LS, LS, zero, lane);
                acc = mm16<64>(RBUF(12) + pt * 16 * LS, LS, Xt0 + (64 + qt * 16) * LS, LS, acc, lane);
                const f32x4 gc = *(const f32x4*)(gammaC + pi0);
#pragma unroll
                for (int e = 0; e < 4; ++e) acc[e] *= gc[e];
                {
                    const int kk = pi0 & 31;
                    const size_t d = (((size_t)u * 4 + (qi >> 5) * 2 + (pi0 >> 5)) * 64 + (qi & 31) + 32 * ((kk >> 2) & 1)) * 16 + (kk >> 3) * 4;
                    *(u32x2*)(p.QcG + d) = pk4(acc);
                }
            }
            {
                f32x4 acc = mm16<64>(Xt0 + pt * 16 * LS, LS, RBUF(10) + qt * 16 * LS, LS, zero, lane);
                const f32x4 rr = up4(*(const u32x2*)(RBUF(3) + qi * LS + pi0));
#pragma unroll
                for (int e = 0; e < 4; ++e) acc[e] += rr[e];
                *(u32x2*)(p.RhG + go) = pk4(acc);
            }
            {
                f32x4 acc = mm16<64>(RBUF(13) + pt * 16 * LS, LS, RBUF(9) + qt * 16 * LS, LS, zero, lane);
                acc = mm16<64>(Xt0 + (64 + pt * 16) * LS, LS, RBUF(10) + qt * 16 * LS, LS, acc, lane);
                *(u32x2*)(p.Y0G + go) = pk4(acc);
            }
        }
    }
}

struct R2Set { u32x4 a[8]; u32x4 q[4]; };
DI void r2_load(R2Set& st, const Params& p, size_t u, int lane, int vh) {
#pragma unroll
    for (int kt = 0; kt < 2; ++kt) {
        const bf16_t* qg = p.QcG + ((u * 4 + vh * 2 + kt) * 64 + lane) * 16;
        st.q[kt * 2] = *(const u32x4*)qg; st.q[kt * 2 + 1] = *(const u32x4*)(qg + 8);
    }
#pragma unroll
    for (int f = 0; f < 8; ++f) st.a[f] = *(const u32x4*)(p.PcG + ((u * 8 + f) * 64 + lane) * 8);
}
DI void r2_step(f32x16 (&S)[2], const R2Set& st, const Params& p, size_t u, int lane, int vh, bool last) {
#pragma unroll
    for (int kt = 0; kt < 2; ++kt) {
        bf16_t* sg = p.SG + ((u * 4 + vh * 2 + kt) * 64 + lane) * 16;
        *(u32x4*)sg = (u32x4){pack2(S[kt][0], S[kt][1]), pack2(S[kt][2], S[kt][3]), pack2(S[kt][4], S[kt][5]), pack2(S[kt][6], S[kt][7])};
        *(u32x4*)(sg + 8) = (u32x4){pack2(S[kt][8], S[kt][9]), pack2(S[kt][10], S[kt][11]), pack2(S[kt][12], S[kt][13]), pack2(S[kt][14], S[kt][15])};
    }
    if (last) return;
    bf16x8 bfr[4];
#pragma unroll
    for (int ts = 0; ts < 4; ++ts) {
        const int tl = ts >> 1, sp = ts & 1;
        const u32x4 pk = (u32x4){pack2(S[tl][8 * sp], S[tl][8 * sp + 1]), pack2(S[tl][8 * sp + 2], S[tl][8 * sp + 3]),
                                 pack2(S[tl][8 * sp + 4], S[tl][8 * sp + 5]), pack2(S[tl][8 * sp + 6], S[tl][8 * sp + 7])};
        bfr[ts] = __builtin_bit_cast(bf16x8, pk);
    }
#pragma unroll
    for (int kt = 0; kt < 2; ++kt)
#pragma unroll
        for (int hf = 0; hf < 2; ++hf)
#pragma unroll
            for (int w = 0; w < 4; ++w) { S[kt][8 * hf + 2 * w] = lo_bf(st.q[kt * 2 + hf][w]); S[kt][8 * hf + 2 * w + 1] = hi_bf(st.q[kt * 2 + hf][w]); }
#pragma unroll
    for (int ts = 0; ts < 4; ++ts)
#pragma unroll
        for (int kt = 0; kt < 2; ++kt)
            S[kt] = __builtin_amdgcn_mfma_f32_32x32x16_bf16(__builtin_bit_cast(bf16x8, st.a[kt * 4 + ts]), bfr[ts], S[kt], 0, 0, 0);
}
DI void phase_rwkv_r2(const Params& p, int chain) {
    const int lane = tid_() & 63, wv = __builtin_amdgcn_readfirstlane(tid_() >> 6);
    if (wv != 0) return;
    const int bh = chain >> 1, vh = chain & 1;
    const size_t u0 = (size_t)bh * NCHUNK;
    f32x16 S[2];
#pragma unroll
    for (int e = 0; e < 16; ++e) { S[0][e] = 0.f; S[1][e] = 0.f; }
    R2Set A, B;
    r2_load(A, p, u0, lane, vh);
    r2_load(B, p, u0 + 1, lane, vh);
#pragma unroll 1
    for (int c = 0; c < NCHUNK; c += 2) {
        r2_step(S, A, p, u0 + c, lane, vh, c == NCHUNK - 1);
        if (c == NCHUNK - 1) break;
        if (c + 2 < NCHUNK - 1) r2_load(A, p, u0 + c + 2, lane, vh);
        r2_step(S, B, p, u0 + c + 1, lane, vh, false);
        if (c + 3 < NCHUNK - 1) r2_load(B, p, u0 + c + 3, lane, vh);
    }
}

DI void phase_rwkv_r3(const Params& p, int layer, int bid, int nb) {
    const int tid = tid_(), lane = tid & 63, wv = __builtin_amdgcn_readfirstlane(tid >> 6), fr = lane & 15, fq = lane >> 4;
    for (int task = bid * 8 + wv; task < NUNIT * 4; task += nb * 8) {
        const int u = task >> 2, it = task & 3;
        const int c = u % NCHUNK, bh = u / NCHUNK, h = bh % HEADS, bb = bh / HEADS;
        const int i = it * 16 + fr, t = c * 64 + i;
        const size_t tok = (size_t)bb * L + t;
        bf16x8 sf[2];
#pragma unroll
        for (int ks = 0; ks < 2; ++ks) sf[ks] = *(const bf16x8*)(p.RhG + ((size_t)u * 64 + i) * 64 + ks * 32 + fq * 8);
        f32x4 y[4];
#pragma unroll
        for (int vt = 0; vt < 4; ++vt) {
            y[vt] = up4(*(const u32x2*)(p.Y0G + ((size_t)u * 64 + i) * 64 + vt * 16 + fq * 4));
#pragma unroll
            for (int ks = 0; ks < 2; ++ks) {
                const int vv = vt * 16 + fr;
                const bf16_t* sp = p.SG + (((size_t)u * 4 + (vv >> 5) * 2 + ks) * 64 + (vv & 31)) * 16 + 4 * fq;
                const u32x2 s0 = *(const u32x2*)sp, s1 = *(const u32x2*)(sp + 32 * 16);
                const bf16x8 f = __builtin_bit_cast(bf16x8, ((u32x4){s0[0], s0[1], s1[0], s1[1]}));
                y[vt] = __builtin_amdgcn_mfma_f32_16x16x32_bf16(f, sf[ks], y[vt], 0, 0, 0);
            }
        }
        float s = 0.f;
#pragma unroll
        for (int vt = 0; vt < 4; ++vt) s += (y[vt][0] + y[vt][1]) + (y[vt][2] + y[vt][3]);
        s += __shfl_xor(s, 16); s += __shfl_xor(s, 32);
        const float mean = s * (1.0f / 64.f);
        float q = 0.f;
#pragma unroll
        for (int vt = 0; vt < 4; ++vt)
#pragma unroll
            for (int e = 0; e < 4; ++e) { y[vt][e] -= mean; q += y[vt][e] * y[vt][e]; }
        q += __shfl_xor(q, 16); q += __shfl_xor(q, 32);
        const float rstd = rsqrtf(q * (1.0f / 64.f) + 64e-5f);
        if (t < L) {
            const float bon = p.bonG[(size_t)u * 64 + i];
#pragma unroll
            for (int vt = 0; vt < 4; ++vt) {
                const int v0 = vt * 16 + fq * 4, cg = h * 64 + v0;
                const f32x4 xv = up4(*(const u32x2*)(p.orw + tok * 512 + cg));
                const f32x4 g = up4(*(const u32x2*)(p.GG + ((size_t)u * 64 + i) * 64 + v0));
                const f32x4 lg = *(const f32x4*)(p.lnx_g + layer * 512 + cg), lb = *(const f32x4*)(p.lnx_b + layer * 512 + cg);
                f32x4 o;
#pragma unroll
                for (int e = 0; e < 4; ++e) {
                    o[e] = (y[vt][e] * rstd * lg[e] + lb[e] + bon * xv[e]) * g[e];
                }
                *(u32x2*)(p.orw + tok * 512 + cg) = pk4(o);
            }
        }
    }
}

constexpr int SB_LDS = 2 * RB + 64;
DI void phase_sb(const Params& p, int bid0, int nb, char* smem) {
    const int tid = tid_(), lane = tid & 63, wv = __builtin_amdgcn_readfirstlane(tid >> 6), fr = lane & 15, fq = lane >> 4;
    bf16_t* Ks = (bf16_t*)smem;
    bf16_t* Vt = Ks + 64 * LS;
    int* flags = (int*)(smem + 2 * RB);
    bf16x8 tri[4][2];
#pragma unroll
    for (int st = 0; st < 4; ++st)
#pragma unroll
        for (int k2 = 0; k2 < 2; ++k2)
#pragma unroll
            for (int jj = 0; jj < 8; ++jj) tri[st][k2][jj] = (32 * k2 + 16 * (jj >> 2) + 4 * fq + (jj & 3) > 16 * st + fr) ? (short)0x3F80 : (short)0;
    constexpr int NQB = (L + 127) / 128;
    const int ldkey = tid >> 3, lddc = (tid & 7) * 8;
    for (int u = bid0; u < NBATCH * HEADS * NQB; u += nb) {
        const int bh = u % (NBATCH * HEADS), b = bh / HEADS, h = bh % HEADS, q0 = (u / (NBATCH * HEADS)) * 128;
        const int qlo = q0 + 16 * wv, query = qlo + fr;
        const size_t tokb = (size_t)b * L;
        bf16x8 qf[2];
#pragma unroll
        for (int ks = 0; ks < 2; ++ks) qf[ks] = *(const bf16x8*)(p.P + (tokb + query) * CP + OFF_Q + h * 64 + ks * 32 + fq * 8);
        const int qmax = (q0 + 127 < L - 1) ? q0 + 127 : L - 1;
        int kt = (qmax - 1) >> 6;
        float R = 0.f;
        f32x4 ot[4];
#pragma unroll
        for (int dt = 0; dt < 4; ++dt) ot[dt] = (f32x4){0.f, 0.f, 0.f, 0.f};
        bool done = qlo >= L;
        u32x4 kreg, vreg;
        {
            const int s = kt * 64 + ldkey;
            const bf16_t* src = p.P + (tokb + s) * CP + h * 64 + lddc;
            kreg = s < L ? *(const u32x4*)(src + OFF_K) : (u32x4){0u, 0u, 0u, 0u};
            vreg = s < L ? *(const u32x4*)(src + OFF_V) : (u32x4){0u, 0u, 0u, 0u};
        }
        for (;;) {
            __syncthreads();
            *(u32x4*)(Ks + ldkey * LS + lddc) = kreg;
#pragma unroll
            for (int j = 0; j < 4; ++j) { Vt[(lddc + 2 * j) * LS + ldkey] = (bf16_t)(vreg[j] & 0xFFFFu); Vt[(lddc + 2 * j + 1) * LS + ldkey] = (bf16_t)(vreg[j] >> 16); }
            __syncthreads();
            if (kt > 0) {
                const int s = (kt - 1) * 64 + ldkey;
                const bf16_t* src = p.P + (tokb + s) * CP + h * 64 + lddc;
                kreg = *(const u32x4*)(src + OFF_K); vreg = *(const u32x4*)(src + OFF_V);
            }
            if (!done && kt * 64 < qlo + 15) {
                f32x4 uu[4], lsp[4];
                float tot = 0.f;
#pragma unroll
                for (int kk = 0; kk < 4; ++kk) {
                    f32x4 z = (f32x4){0.f, 0.f, 0.f, 0.f};
#pragma unroll
                    for (int ks = 0; ks < 2; ++ks) {
                        const bf16x8 f = *(const bf16x8*)(Ks + (16 * kk + fr) * LS + ks * 32 + fq * 8);
                        z = __builtin_amdgcn_mfma_f32_16x16x32_bf16(f, qf[ks], z, 0, 0, 0);
                    }
#pragma unroll
                    for (int e = 0; e < 4; ++e) {
                        const float zz = z[e] * 0.125f;
                        const float lsneg = -(fmaxf(zz, 0.f) + __logf(1.0f + __expf(-fabsf(zz))));
                        const bool valid = kt * 64 + 16 * kk + 4 * fq + e < query;
                        uu[kk][e] = valid ? lsneg : 0.f;
                        lsp[kk][e] = valid ? lsneg + zz : -1.0e30f;
                        tot += uu[kk][e];
                    }
                }
                tot += __shfl_xor(tot, 16); tot += __shfl_xor(tot, 32);
                f32x4 rest[4];
#pragma unroll
                for (int st = 0; st < 4; ++st) rest[st] = (f32x4){0.f, 0.f, 0.f, 0.f};
#pragma unroll
                for (int k2 = 0; k2 < 2; ++k2) {
                    u32x4 hi, lo;
#pragma unroll
                    for (int t2 = 0; t2 < 2; ++t2) {
                        const f32x4 a = uu[2 * k2 + t2];
                        const unsigned h0 = pack2(a[0], a[1]), h1 = pack2(a[2], a[3]);
                        hi[2 * t2] = h0; hi[2 * t2 + 1] = h1;
                        lo[2 * t2] = pack2(a[0] - lo_bf(h0), a[1] - hi_bf(h0)); lo[2 * t2 + 1] = pack2(a[2] - lo_bf(h1), a[3] - hi_bf(h1));
                    }
                    const bf16x8 fh = __builtin_bit_cast(bf16x8, hi), fl = __builtin_bit_cast(bf16x8, lo);
#pragma unroll
                    for (int st = 0; st < 4; ++st) {
                        rest[st] = __builtin_amdgcn_mfma_f32_16x16x32_bf16(tri[st][k2], fh, rest[st], 0, 0, 0);
                        rest[st] = __builtin_amdgcn_mfma_f32_16x16x32_bf16(tri[st][k2], fl, rest[st], 0, 0, 0);
                    }
                }
                bf16x8 af[2];
#pragma unroll
                for (int k2 = 0; k2 < 2; ++k2) {
                    u32x4 pk;
#pragma unroll
                    for (int t2 = 0; t2 < 2; ++t2) {
                        const int kk = 2 * k2 + t2;
                        float a4[4];
#pragma unroll
                        for (int e = 0; e < 4; ++e) a4[e] = __expf(lsp[kk][e] + R + rest[kk][e]);
                        pk[2 * t2] = pack2(a4[0], a4[1]); pk[2 * t2 + 1] = pack2(a4[2], a4[3]);
                    }
                    af[k2] = __builtin_bit_cast(bf16x8, pk);
                }
                R += tot;
#pragma unroll
                for (int dt = 0; dt < 4; ++dt)
#pragma unroll
                    for (int k2 = 0; k2 < 2; ++k2) {
                        const bf16_t* vp = Vt + (16 * dt + fr) * LS + 32 * k2 + 4 * fq;
                        const u32x2 v0 = *(const u32x2*)vp, v1 = *(const u32x2*)(vp + 16);
                        const bf16x8 f = __builtin_bit_cast(bf16x8, ((u32x4){v0[0], v0[1], v1[0], v1[1]}));
                        ot[dt] = __builtin_amdgcn_mfma_f32_16x16x32_bf16(f, af[k2], ot[dt], 0, 0, 0);
                    }
                done = __all((R < -104.0f) || (query >= L));
            }
            if (lane == 0) flags[wv] = done ? 1 : 0;
            __syncthreads();
            int alld = 1;
#pragma unroll
            for (int w = 0; w < 8; ++w) alld &= flags[w];
            if (alld || kt == 0) break;
            --kt;
        }
        if (query < L) {
#pragma unroll
            for (int dt = 0; dt < 4; ++dt) *(u32x2*)(p.osb + (tokb + query) * 512 + h * 64 + 16 * dt + 4 * fq) = pk4(ot[dt]);
        }
    }
}

struct EpiBranch {
    static constexpr bool PERM = true;
    const bf16_t* G; bf16_t* M; bool add;
    DI void operator()(const f32x4 (&acc)[2][2][4][2], const g8::Unit& u, int wr, int wc, int fr, int fq) const {
        const int c0 = u.pn * 256 + wc * 32 + 8 * fq;
#pragma unroll
        for (int ai = 0; ai < 2; ++ai) {
            u32x4 g[4][2], mo[4][2];
#pragma unroll
            for (int m = 0; m < 4; ++m)
#pragma unroll
                for (int bj = 0; bj < 2; ++bj) {
                    const size_t r = (size_t)(u.pm * 256 + ai * 128 + wr * 64 + m * 16 + fr);
                    g[m][bj] = *(const u32x4*)(G + r * 2048 + c0 + bj * 128);
                    mo[m][bj] = add ? *(const u32x4*)(M + r * D + c0 + bj * 128) : (u32x4){0u, 0u, 0u, 0u};
                }
#pragma unroll
            for (int m = 0; m < 4; ++m)
#pragma unroll
                for (int bj = 0; bj < 2; ++bj) {
                    const size_t r = (size_t)(u.pm * 256 + ai * 128 + wr * 64 + m * 16 + fr);
                    const f32x4 v0 = acc[ai][bj][m][0], v1 = acc[ai][bj][m][1];
                    const u32x4 gg = g[m][bj], mm = mo[m][bj];
                    float o[8] = {lo_bf(gg[0]) * v0[0], hi_bf(gg[0]) * v0[1], lo_bf(gg[1]) * v0[2], hi_bf(gg[1]) * v0[3], lo_bf(gg[2]) * v1[0], hi_bf(gg[2]) * v1[1], lo_bf(gg[3]) * v1[2], hi_bf(gg[3]) * v1[3]};
#pragma unroll
                    for (int q = 0; q < 4; ++q) { o[2 * q] += lo_bf(mm[q]); o[2 * q + 1] += hi_bf(mm[q]); }
                    *(u32x4*)(M + r * D + c0 + bj * 128) = (u32x4){pack2(o[0], o[1]), pack2(o[2], o[3]), pack2(o[4], o[5]), pack2(o[6], o[7])};
                }
        }
    }
};
struct GateOrder {
    g8::DenseOrder d;
    DI bool next(int i, g8::Unit& u) const { return d.next(i, u); }
    DI unsigned row_off(const g8::Unit&, int) const { return 0u; }
};
struct EpiGate {
    static constexpr bool PERM = true;
    bf16_t* G;
    DI void operator()(const f32x4 (&acc)[2][2][4][2], const g8::Unit& u, int wr, int wc, int fr, int fq) const {
#pragma unroll
        for (int ai = 0; ai < 2; ++ai)
#pragma unroll
            for (int m = 0; m < 4; ++m) {
                bf16_t* rowp = G + (size_t)(u.pm * 256 + ai * 128 + wr * 64 + m * 16 + fr) * 2048 + u.pn * 256 + wc * 32 + 8 * fq;
#pragma unroll
                for (int bj = 0; bj < 2; ++bj) {
                    const f32x4 v0 = acc[ai][bj][m][0], v1 = acc[ai][bj][m][1];
                    *(u32x4*)(rowp + bj * 128) = (u32x4){pack2(sigmoidf_(v0[0]), sigmoidf_(v0[1])), pack2(sigmoidf_(v0[2]), sigmoidf_(v0[3])), pack2(sigmoidf_(v1[0]), sigmoidf_(v1[1])), pack2(sigmoidf_(v1[2]), sigmoidf_(v1[3]))};
                }
            }
    }
};
template <int PART> DI void phase_merge(const Params& p, int layer, int bid, int nb, char* smem) {
    const bf16_t* hb = p.hb; bf16_t* G = p.gates; bf16_t* M = p.merged;
    const bf16_t* Wg = p.WtIn + ((size_t)layer * CIN + CP) * D;
    G8_LAS unsigned char* lds = (G8_LAS unsigned char*)smem;
    if (PART == 0) {
#pragma unroll
    for (int which = 0; which < 2; ++which) {
        g8::DenseOrder S; S.init(hb, Wg + (size_t)which * 1024 * D, MFULL, D / 256, D, nb, bid);
        g8::gemm8<false>(lds, D, S, EpiGate{G + which * 1024});
    }
    }
    if (PART == 1) {
#pragma unroll
    for (int which = 0; which < 2; ++which) {
        const bf16_t* A = which ? p.orw : p.osb;
        const bf16_t* Bt = (which ? p.WtPrw : p.WtPsb) + (size_t)layer * D * 512;
        g8::DenseOrder S; S.init(A, Bt, MFULL, D / 256, 512, nb, bid);
        g8::gemm8<false>(lds, 512, S, EpiBranch{G + which * 1024, M, which != 0});
    }
    }
    if (PART == 1)
    for (int t = left_first(MFULL * 4 * 2, bid, nb); t < D / 128; t += nb) {
#pragma unroll
        for (int which = 0; which < 2; ++which) {
            const bf16_t* A = which ? p.orw : p.osb; const bf16_t* Gw = p.gleft - (size_t)M0_LEFT * 2048 + which * 1024;
            const bf16_t* Bt = (which ? p.WtPrw : p.WtPsb) + (size_t)layer * D * 512;
            gemm_left32([=](int r) { return A + (size_t)(M0_LEFT + r) * 512; }, Bt, 512, 512, t * 128, smem,
                        [=](int r0, int c, f32x4 v) {
                            const size_t r = (size_t)(M0_LEFT + r0);
                            const u32x2 g = *(const u32x2*)(Gw + r * 2048 + c);
                            float o0 = lo_bf(g[0]) * v[0], o1 = hi_bf(g[0]) * v[1], o2 = lo_bf(g[1]) * v[2], o3 = hi_bf(g[1]) * v[3];
                            u32x2* mp = (u32x2*)(M + r * D + c);
                            if (which) { const u32x2 m = *mp; o0 += lo_bf(m[0]); o1 += hi_bf(m[0]); o2 += lo_bf(m[1]); o3 += hi_bf(m[1]); }
                            *mp = (u32x2){pack2(o0, o1), pack2(o2, o3)};
                        });
        }
    }
}
struct EpiOut {
    static constexpr bool PERM = false;
    float* hmeta; float* out; const bf16_t* hb;
    DI void operator()(const f32x4 (&acc)[2][2][4][2], const g8::Unit& u, int wr, int wc, int fr, int fq) const {
        const int c0 = u.pn * 256 + wc * 32 + 4 * fq;
#pragma unroll
        for (int ai = 0; ai < 2; ++ai) {
            u32x2 hv[4][2][2];
#pragma unroll
            for (int m = 0; m < 4; ++m) {
                const bf16_t* hbp = hb + (size_t)(u.pm * 256 + ai * 128 + wr * 64 + m * 16 + fr) * D + c0;
#pragma unroll
                for (int bj = 0; bj < 2; ++bj)
#pragma unroll
                    for (int n = 0; n < 2; ++n) hv[m][bj][n] = *(const u32x2*)(hbp + bj * 128 + n * 16);
            }
#pragma unroll
            for (int m = 0; m < 4; ++m) {
                float* rowp = hrow2(hmeta, out, u.pm * 256 + ai * 128 + wr * 64 + m * 16 + fr) + c0;
#pragma unroll
                for (int bj = 0; bj < 2; ++bj)
#pragma unroll
                    for (int n = 0; n < 2; ++n) {
                        const f32x4 h = up4(hv[m][bj][n]), v = acc[ai][bj][m][n];
                        *(f32x4*)(rowp + bj * 128 + n * 16) = (f32x4){ALPHA * h[0] + v[0], ALPHA * h[1] + v[1], ALPHA * h[2] + v[2], ALPHA * h[3] + v[3]};
                    }
            }
        }
    }
};
DI void phase_outproj(const Params& p, int layer, int bid, int nb, char* smem) {
    const bf16_t* A = p.merged; float* const hmeta = p.hmeta; float* const outp = p.out; const bf16_t* hbres = p.hb;
    const bf16_t* Bt = p.WtOut + (size_t)layer * D * D;
    if (bid == 0 && tid_() < NE) p.counts[tid_()] = 0;
    g8::DenseOrder S; S.init(A, Bt, MFULL, D / 256, D, nb, bid);
    g8::gemm8<false>((G8_LAS unsigned char*)smem, D, S, EpiOut{hmeta, outp, hbres});
    for (int t = left_first(MFULL * 4, bid, nb); t < D / 128; t += nb)
        gemm_left32([=](int r) { return A + (size_t)(M0_LEFT + r) * D; }, Bt, D, D, t * 128, smem,
                    [=](int r0, int c, f32x4 v) {
                        const int r = M0_LEFT + r0;
                        const f32x4 h = up4(*(const u32x2*)(hbres + (size_t)r * D + c));
                        *(f32x4*)(hrow2(hmeta, outp, r) + c) = (f32x4){ALPHA * h[0] + v[0], ALPHA * h[1] + v[1], ALPHA * h[2] + v[2], ALPHA * h[3] + v[3]};
                    });
}

constexpr int LN1_ROWB = 2 * D + 16;
constexpr int LN1_WAVE = 8 * LN1_ROWB;
constexpr int LN1_LDS = 8 * LN1_WAVE + 2048;
DI void phase_ln1_router(const Params& p, int layer, int bid, int nb, char* smem) {
    const int tid = tid_(), lane = tid & 63, wid = __builtin_amdgcn_readfirstlane(tid >> 6), fr = lane & 15, fq = lane >> 4;
    char* wl = smem + wid * LN1_WAVE;
    int* sel = (int*)(smem + 8 * LN1_WAVE);
    float* sgt = (float*)(smem + 8 * LN1_WAVE + 640);
    int* sbase = (int*)(smem + 8 * LN1_WAVE + 1280);
    const int nwaves = nb * 8, gw = bid * 8 + wid;
    const int base_n = T / nwaves, extra = T % nwaves;
    const int tok0 = gw * base_n + (gw < extra ? gw : extra), ntok = base_n + (gw < extra ? 1 : 0);
    const int btok0 = bid * 8 * base_n + (bid * 8 < extra ? bid * 8 : extra);
    const float* g1p = p.ln1_g + layer * D; const float* b1p = p.ln1_b + layer * D;
    __syncthreads();
    for (int g0 = 0; g0 < ntok; g0 += 4) {
        const int ng = ntok - g0 < 4 ? ntok - g0 : 4;
        float vn[16];
        { const float* hf = hrow_u(p, tok0 + g0);
#pragma unroll
          for (int j = 0; j < 4; ++j) { const f32x4 a = *(const f32x4*)(hf + 256 * j + 4 * lane); vn[4 * j] = a[0]; vn[4 * j + 1] = a[1]; vn[4 * j + 2] = a[2]; vn[4 * j + 3] = a[3]; } }
#pragma unroll 1
        for (int i = 0; i < ng; ++i) {
            const int tok = tok0 + g0 + i;
            float v[16];
#pragma unroll
            for (int q = 0; q < 16; ++q) v[q] = vn[q];
            if (i + 1 < ng) { const float* hn = hrow_u(p, tok + 1);
#pragma unroll
                for (int j = 0; j < 4; ++j) { const f32x4 a = *(const f32x4*)(hn + 256 * j + 4 * lane); vn[4 * j] = a[0]; vn[4 * j + 1] = a[1]; vn[4 * j + 2] = a[2]; vn[4 * j + 3] = a[3]; } }
            ln16(v, g1p, b1p, lane);
#pragma unroll
            for (int j = 0; j < 4; ++j) {
                const unsigned h0 = pack2(v[4 * j], v[4 * j + 1]), h1 = pack2(v[4 * j + 2], v[4 * j + 3]);
                *(u32x2*)(p.hb + (size_t)tok * D + 256 * j + 4 * lane) = (u32x2){h0, h1};
                *(u32x2*)(wl + i * LN1_ROWB + (256 * j + 4 * lane) * 2) = (u32x2){h0, h1};
                *(u32x2*)(wl + (4 + i) * LN1_ROWB + (256 * j + 4 * lane) * 2) = (u32x2){pack2(v[4 * j] - lo_bf(h0), v[4 * j + 1] - hi_bf(h0)), pack2(v[4 * j + 2] - lo_bf(h1), v[4 * j + 3] - hi_bf(h1))};
            }
        }
        asm volatile("s_waitcnt lgkmcnt(0)" ::: "memory");
        __builtin_amdgcn_wave_barrier();
        f32x4 acc = (f32x4){0.f, 0.f, 0.f, 0.f};
        const char* arow = wl + (fr & 3) * LN1_ROWB + fq * 16;
        const bf16_t* whi = p.RwHi + (size_t)fr * D + fq * 8; const bf16_t* wlo = p.RwLo + (size_t)fr * D + fq * 8;
#pragma unroll 4
        for (int ks = 0; ks < 32; ++ks) {
            const bf16x8 ah = *(const bf16x8*)(arow + ks * 64), al = *(const bf16x8*)(arow + 4 * LN1_ROWB + ks * 64);
            const bf16x8 bh = *(const bf16x8*)(whi + ks * 32), bl = *(const bf16x8*)(wlo + ks * 32);
            acc = __builtin_amdgcn_mfma_f32_16x16x32_bf16(bh, ah, acc, 0, 0, 0);
            acc = __builtin_amdgcn_mfma_f32_16x16x32_bf16(bh, al, acc, 0, 0, 0);
            acc = __builtin_amdgcn_mfma_f32_16x16x32_bf16(bl, ah, acc, 0, 0, 0);
        }
        float lg[4]; float mx = -3.0e38f;
#pragma unroll
        for (int e = 0; e < 4; ++e) { lg[e] = acc[e] + p.router_b[4 * fq + e]; mx = fmaxf(mx, lg[e]); }
        mx = fmaxf(mx, __shfl_xor(mx, 16)); mx = fmaxf(mx, __shfl_xor(mx, 32));
        float sum = 0.f;
#pragma unroll
        for (int e = 0; e < 4; ++e) { lg[e] = __expf(lg[e] - mx); sum += lg[e]; }
        sum += __shfl_xor(sum, 16); sum += __shfl_xor(sum, 32);
        const float inv = 1.0f / sum;
        float v1 = -1.f, v2 = -1.f; int i1 = 0, i2 = 0;
#pragma unroll
        for (int e = 0; e < 4; ++e) {
            const float pv = lg[e] * inv;
            if (pv > v1) { v2 = v1; i2 = i1; v1 = pv; i1 = e; } else if (pv > v2) { v2 = pv; i2 = e; }
        }
        const float sc = v1 + v2;
        float bsc = sc; int bg = fq;
#pragma unroll
        for (int m = 16; m <= 32; m <<= 1) {
            const float os = __shfl_xor(bsc, m); const int og = __shfl_xor(bg, m);
            if (os > bsc || (os == bsc && og < bg)) { bsc = os; bg = og; }
        }
        if (bg == fq && fr < ng) {
            const int li = tok0 + g0 + fr - btok0;
            const float gs = 1.0f / (v1 + v2);
            sel[li * 2] = 4 * fq + i1; sel[li * 2 + 1] = 4 * fq + i2; sgt[li * 2] = v1 * gs; sgt[li * 2 + 1] = v2 * gs;
        }
        asm volatile("s_waitcnt lgkmcnt(0)" ::: "memory");
        __builtin_amdgcn_wave_barrier();
    }
    __syncthreads();
    if (wid == 0) {
        const int nbt = 8 * base_n + ((bid * 8 + 8 <= extra) ? 8 : (bid * 8 < extra ? extra - bid * 8 : 0));
        for (int c0 = 0; c0 < nbt; c0 += 64) {
            const int li = c0 + lane; const bool on = li < nbt;
            const int e1 = on ? sel[li * 2] : -1, e2 = on ? sel[li * 2 + 1] : -1;
            const unsigned long long lt = (1ull << lane) - 1ull;
            int r1 = 0, r2 = 0, mycnt = 0;
#pragma unroll
            for (int e = 0; e < NE; ++e) {
                const unsigned long long m1 = __ballot(e1 == e), m2 = __ballot(e2 == e);
                const int c1 = __popcll(m1), c2 = __popcll(m2);
                if (e1 == e) r1 = __popcll(m1 & lt);
                if (e2 == e) r2 = c1 + __popcll(m2 & lt);
                if (lane == e) mycnt = c1 + c2;
            }
            if (lane < NE) sbase[lane] = mycnt > 0 ? atomicAdd(&p.counts[lane], mycnt) : 0;
            asm volatile("s_waitcnt vmcnt(0) lgkmcnt(0)" ::: "memory");
            __builtin_amdgcn_wave_barrier();
            if (on) {
                const int tok = btok0 + li;
                const int s1 = sbase[e1] + r1, s2 = sbase[e2] + r2;
                p.list[e1 * T + s1] = tok * 2; p.list[e2 * T + s2] = tok * 2 + 1;
                p.tokg[tok * 2] = sgt[li * 2]; p.tokg[tok * 2 + 1] = sgt[li * 2 + 1];
            }
            asm volatile("s_waitcnt lgkmcnt(0)" ::: "memory");
            __builtin_amdgcn_wave_barrier();
        }
    }
}

constexpr int MOE_BIG = 8;
template <bool UP> struct MoeOrder {
    const int* counts; const int* list; int G, c; const char* A; const char* B;
    DI bool next(int i, g8::Unit& u) const {
        const int xcd = c & 7, w = c >> 3, mt = (w >> 1) & 7, pn = 2 * (w & 1) + i, esel = xcd + 8 * (w >> 4);
        if (w >= 32 || i >= 2) return false;
        int padp = 0, fe = -1, fc = 0, fp = 0;
#pragma unroll
        for (int e = 0; e < NE; ++e) {
            const int cn = counts[e], ntp = (cn + 255) >> 8, nt = ntp < MOE_BIG ? ntp : MOE_BIG;
            const bool hit = (e == esel) && (mt < nt);
            fe = hit ? e : fe; fc = hit ? cn : fc; fp = hit ? padp + mt : fp;
            padp += ntp;
        }
        fe = __builtin_amdgcn_readfirstlane(fe); fc = __builtin_amdgcn_readfirstlane(fc); fp = __builtin_amdgcn_readfirstlane(fp);
        if (fe < 0) return false;
        u.e = fe; u.slot0 = mt * 256; u.cnt = fc; u.pm = fp; u.pn = pn;
        u.A = UP ? A : A + (size_t)fp * ((size_t)256 * DE * 2);
        u.B = UP ? B + (size_t)fe * ((size_t)1024 * 1024 * 2) + (size_t)pn * ((size_t)256 * D * 2) : B + (size_t)fe * ((size_t)1024 * 512 * 2) + (size_t)pn * ((size_t)256 * DE * 2);
        return true;
    }
    DI unsigned row_off(const g8::Unit& u, int r) const {
        const __amdgpu_buffer_rsrc_t rs = __builtin_amdgcn_make_buffer_rsrc((void*)list, 0, NE * T * 4, 0x00020000);
        const int ent = __builtin_amdgcn_raw_buffer_load_b32(rs, r * 4, (u.e * T + u.slot0) * 4, 0);
        return u.slot0 + r < u.cnt ? (unsigned)(ent >> 1) * (unsigned)(D * 2) : 0u;
    }
};
struct EpiMoeUp {
    static constexpr bool PERM = true;
    bf16_t* hid;
    DI void operator()(const f32x4 (&acc)[2][2][4][2], const g8::Unit& u, int wr, int wc, int fr, int fq) const {
#pragma unroll
        for (int ai = 0; ai < 2; ++ai)
#pragma unroll
            for (int m = 0; m < 4; ++m) {
                const int r = ai * 128 + wr * 64 + m * 16 + fr;
                if (u.slot0 + r >= u.cnt) continue;
                bf16_t* rowp = hid + ((size_t)u.pm * 256 + r) * DE + ((u.pn * 256 + wc * 32 + 8 * fq) >> 1);
#pragma unroll
                for (int bj = 0; bj < 2; ++bj) {
                    const f32x4 v0 = acc[ai][bj][m][0], v1 = acc[ai][bj][m][1];
                    *(u32x2*)(rowp + bj * 64) = (u32x2){pack2(v0[0] * sigmoidf_(v0[0]) * v0[1], v0[2] * sigmoidf_(v0[2]) * v0[3]), pack2(v1[0] * sigmoidf_(v1[0]) * v1[1], v1[2] * sigmoidf_(v1[2]) * v1[3])};
                }
            }
    }
};
struct EpiMoeDown {
    static constexpr bool PERM = true;
    bf16_t* fo; const int* list; const float* tokg;
    DI void operator()(const f32x4 (&acc)[2][2][4][2], const g8::Unit& u, int wr, int wc, int fr, int fq) const {
        int ent[8]; float g[8];
#pragma unroll
        for (int q = 0; q < 8; ++q) {
            const int sl = u.slot0 + (q >> 2) * 128 + wr * 64 + (q & 3) * 16 + fr;
            ent[q] = sl < u.cnt ? list[u.e * T + sl] : -1;
        }
#pragma unroll
        for (int q = 0; q < 8; ++q) g[q] = ent[q] >= 0 ? tokg[ent[q]] : 0.f;
#pragma unroll
        for (int ai = 0; ai < 2; ++ai)
#pragma unroll
            for (int m = 0; m < 4; ++m) {
                const int q = ai * 4 + m;
                if (ent[q] < 0) continue;
                const float gg = g[q];
                bf16_t* rowp = fo + ((size_t)(ent[q] & 1) * TP + (ent[q] >> 1)) * D + u.pn * 256 + wc * 32 + 8 * fq;
#pragma unroll
                for (int bj = 0; bj < 2; ++bj) {
                    const f32x4 v0 = acc[ai][bj][m][0], v1 = acc[ai][bj][m][1];
                    *(u32x4*)(rowp + bj * 128) = (u32x4){pack2(gg * v0[0], gg * v0[1]), pack2(gg * v0[2], gg * v0[3]), pack2(gg * v1[0], gg * v1[1]), pack2(gg * v1[2], gg * v1[3])};
                }
            }
    }
};
DI void phase_moe_up(const Params& p, int bid, int nb, char* smem) {
    const MoeOrder<true> S{p.counts, p.list, nb, bid, (const char*)p.hb, (const char*)p.WtGU};
    g8::gemm8<true>((G8_LAS unsigned char*)smem, D, S, EpiMoeUp{p.hid});
    const bf16_t* hb = p.hb; bf16_t* hid = p.hid; const int* list = p.list;
    int big = 0, padr = 0, job = 0;
#pragma unroll 1
    for (int e = 0; e < NE; ++e) { const int cn = p.counts[e], ntp = (cn + 255) >> 8; big += (ntp < MOE_BIG ? ntp : MOE_BIG) * 4; }
    const int mine = bid; (void)big;
#pragma unroll 1
    for (int e = 0; e < NE; ++e) {
        const int cn = p.counts[e];
        for (int s0 = MOE_BIG * 256; s0 < cn; s0 += 128)
            for (int nt = 0; nt < 8; ++nt, ++job)
                if (job % nb == mine) {
                    const int prow = padr;
                    gemm_tile128([=](int r) { const int sl = s0 + r; return sl < cn ? hb + (size_t)(list[e * T + sl] >> 1) * D : (const bf16_t*)nullptr; },
                                 p.WtGU + (size_t)e * 1024 * 1024, D, D, 0, nt * 128, smem,
                                 [=](int r, int c, f32x4 v) {
                                     const int sl = s0 + r;
                                     if (sl >= cn) return;
                                     *(unsigned*)(hid + (size_t)(prow + sl) * DE + (c >> 1)) = pack2(v[0] * sigmoidf_(v[0]) * v[1], v[2] * sigmoidf_(v[2]) * v[3]);
                                 });
                }
        padr += ((cn + 255) >> 8) * 256;
    }
}
DI void phase_moe_down(const Params& p, int bid, int nb, char* smem) {
    const MoeOrder<false> S{p.counts, p.list, nb, bid, (const char*)p.hid, (const char*)p.WtD};
    g8::gemm8<false>((G8_LAS unsigned char*)smem, DE, S, EpiMoeDown{p.fo, p.list, p.tokg});
    const bf16_t* hid = p.hid; bf16_t* fo = p.fo; const int* list = p.list; const float* tokg = p.tokg;
    int big = 0, padr = 0, job = 0;
#pragma unroll 1
    for (int e = 0; e < NE; ++e) { const int cn = p.counts[e], ntp = (cn + 255) >> 8; big += (ntp < MOE_BIG ? ntp : MOE_BIG) * 4; }
    const int mine = bid; (void)big;
#pragma unroll 1
    for (int e = 0; e < NE; ++e) {
        const int cn = p.counts[e];
        for (int s0 = MOE_BIG * 256; s0 < cn; s0 += 128)
            for (int nt = 0; nt < 8; ++nt, ++job)
                if (job % nb == mine) {
                    const int prow = padr;
                    gemm_tile128([=](int r) { const int sl = s0 + r; return sl < cn ? hid + (size_t)(prow + sl) * DE : (const bf16_t*)nullptr; },
                                 p.WtD + (size_t)e * 1024 * 512, DE, DE, 0, nt * 128, smem,
                                 [=](int r, int c, f32x4 v) {
                                     const int sl = s0 + r;
                                     if (sl >= cn) return;
                                     const int ent = list[e * T + sl];
                                     const float g = tokg[ent];
                                     *(u32x2*)(fo + ((size_t)(ent & 1) * TP + (ent >> 1)) * D + c) = (u32x2){pack2(g * v[0], g * v[1]), pack2(g * v[2], g * v[3])};
                                 });
                }
        padr += ((cn + 255) >> 8) * 256;
    }
}
DI void phase_ln2(const Params& p, int layer, int bid, int nb) {
    const int lane = tid_() & 63, wid = __builtin_amdgcn_readfirstlane(tid_() >> 6);
    const int nwaves = nb * 8, gw = bid * 8 + wid, base_n = T / nwaves, extra = T % nwaves;
    const int tok0 = gw * base_n + (gw < extra ? gw : extra), ntok = base_n + (gw < extra ? 1 : 0);
    u32x2 an[4], f0n[4], f1n[4];
    {
#pragma unroll
        for (int j = 0; j < 4; ++j) {
            an[j] = *(const u32x2*)(p.hb + (size_t)tok0 * D + 256 * j + 4 * lane);
            f0n[j] = *(const u32x2*)(p.fo + (size_t)tok0 * D + 256 * j + 4 * lane); f1n[j] = *(const u32x2*)(p.fo + ((size_t)TP + tok0) * D + 256 * j + 4 * lane);
        }
    }
#pragma unroll 1
    for (int i = 0; i < ntok; ++i) {
        const int tok = tok0 + i;
        float v[16];
#pragma unroll
        for (int j = 0; j < 4; ++j) {
            v[4 * j] = ALPHA * lo_bf(an[j][0]) + lo_bf(f0n[j][0]) + lo_bf(f1n[j][0]); v[4 * j + 1] = ALPHA * hi_bf(an[j][0]) + hi_bf(f0n[j][0]) + hi_bf(f1n[j][0]);
            v[4 * j + 2] = ALPHA * lo_bf(an[j][1]) + lo_bf(f0n[j][1]) + lo_bf(f1n[j][1]); v[4 * j + 3] = ALPHA * hi_bf(an[j][1]) + hi_bf(f0n[j][1]) + hi_bf(f1n[j][1]);
        }
        if (i + 1 < ntok) {
#pragma unroll
            for (int j = 0; j < 4; ++j) {
                an[j] = *(const u32x2*)(p.hb + (size_t)(tok + 1) * D + 256 * j + 4 * lane);
                f0n[j] = *(const u32x2*)(p.fo + (size_t)(tok + 1) * D + 256 * j + 4 * lane); f1n[j] = *(const u32x2*)(p.fo + ((size_t)TP + tok + 1) * D + 256 * j + 4 * lane);
            }
        }
        ln16(v, p.ln2_g + layer * D, p.ln2_b + layer * D, lane);
        if (layer == DEPTH - 1) {
            float* of = hrow_u(p, tok);
#pragma unroll
            for (int j = 0; j < 4; ++j) *(f32x4*)(of + 256 * j + 4 * lane) = (f32x4){v[4 * j], v[4 * j + 1], v[4 * j + 2], v[4 * j + 3]};
        } else store_row_bf(p.hb + (size_t)tok * D, v, lane);
    }
}

extern __shared__ __attribute__((aligned(16))) char dyn_smem[];
constexpr int SMEM_MAIN = R1_LDS > GEMM_LDS ? R1_LDS : GEMM_LDS;
constexpr int SMEM_BYTES = SMEM_MAIN + 16;

__global__ void __launch_bounds__(NTHR, 2) k_forward(Params p) {
    const int bid = blockIdx.x, nb = gridDim.x;
    char* smem = dyn_smem;
    uint4* xbw = (uint4*)(dyn_smem + SMEM_MAIN);
    if (threadIdx.x == 0) *xbw = make_uint4(0u, 0u, 0u, 0u);
    __syncthreads();
    XcdBarrier bar = xcd_barrier_post(p.bar, (volatile LAS unsigned*)xbw);
    phase_prologue_weights(p, bid, nb, smem);
    phase_embed(p, bid, nb);
    xcd_barrier(bar);
    for (int l = 0; l < DEPTH; ++l) {
        phase_inproj(p, l, bid, nb, smem);
        xcd_barrier(bar);
        phase_rwkv_r1<0>(p, l, bid, nb, smem);
        xcd_barrier(bar);
        if (bid < 32) phase_rwkv_r2(p, bid);
        else {
            const int sbid = bid - 32, snb = nb - 32, heavy = (NBATCH * HEADS * ((L + 127) / 128)) % snb;
            if (sbid >= heavy && sbid < heavy + NBATCH * HEADS) phase_rwkv_r1<1>(p, l, sbid - heavy, 1, smem);
            phase_sb(p, sbid, snb, smem);
        }
        xcd_barrier(bar);
        phase_rwkv_r3(p, l, bid, nb);
        convert_experts(p, l, bid, nb, smem);
        phase_merge<0>(p, l, bid, nb, smem);
        xcd_barrier(bar);
        phase_merge<1>(p, l, bid, nb, smem);
        xcd_barrier(bar);
        phase_outproj(p, l, bid, nb, smem);
        xcd_barrier(bar);
        phase_ln1_router(p, l, bid, nb, smem);
        xcd_barrier(bar);
        phase_moe_up(p, bid, nb, smem);
        xcd_barrier(bar);
        phase_moe_down(p, bid, nb, smem);
        xcd_barrier(bar);
        phase_ln2(p, l, bid, nb);
        xcd_barrier(bar);
    }
}

extern "C" void kernel_launch(void* const* d_in, const int* in_sizes, int n_in, void* d_out, int out_size, void* d_ws, size_t ws_size, hipStream_t stream) {
    (void)in_sizes; (void)n_in; (void)out_size;
    Params p;
    memset(&p, 0, sizeof(p));
    const float* const* in = (const float* const*)d_in;
    p.x = in[0]; p.meta = in[1]; p.emb_g = in[2]; p.emb_b = in[3]; p.w_in = in[4]; p.mu = in[5]; p.w0 = in[6]; p.w_up = in[7]; p.a0 = in[8]; p.a_up = in[9];
    p.g_up = in[10]; p.k_k = in[11]; p.k_a = in[12]; p.r_k = in[13]; p.lnx_g = in[14]; p.lnx_b = in[15]; p.p_sb = in[16]; p.p_rwkv = in[17]; p.w_out = in[18];
    p.ln1_g = in[19]; p.ln1_b = in[20]; p.router_w = in[21]; p.router_b = in[22]; p.ew_gate = in[23]; p.ew_up = in[24]; p.ew_down = in[25]; p.ln2_g = in[26]; p.ln2_b = in[27];
    p.out = (float*)d_out;
    char* ws = (char*)d_ws; size_t o = 0;
    auto take = [&](size_t bytes) { char* r = ws + o; o += (bytes + 255) & ~(size_t)255; return r; };
    p.bar = (unsigned*)take(XCD_BAR_WORDS * sizeof(unsigned));
    p.counts = (int*)take(256);
    p.WtIn = (bf16_t*)take((size_t)DEPTH * CIN * D * 2);
    p.WtPsb = (bf16_t*)take((size_t)DEPTH * D * 512 * 2);
    p.WtPrw = (bf16_t*)take((size_t)DEPTH * D * 512 * 2);
    p.WtOut = (bf16_t*)take((size_t)DEPTH * D * D * 2);
    p.WupT = (bf16_t*)take((size_t)DEPTH * 512 * 64 * 2);
    p.AupT = (bf16_t*)take((size_t)DEPTH * 512 * 64 * 2);
    p.GupT = (bf16_t*)take((size_t)DEPTH * 512 * 128 * 2);
    p.RwHi = (bf16_t*)take((size_t)NE * D * 2);
    p.RwLo = (bf16_t*)take((size_t)NE * D * 2);
    p.gleft = (bf16_t*)take((size_t)32 * 2048 * 2);
    {
        const size_t ub = (size_t)NUNIT * 64 * 64 * 2, need_r = 6 * ub + (size_t)NUNIT * 64 * 4, need_e = (size_t)NE * 1024 * 1024 * 2 + (size_t)NE * 1024 * 512 * 2;
        char* e = take(need_r > need_e ? need_r : need_e);
        p.WtGU = (bf16_t*)e; p.WtD = (bf16_t*)(e + (size_t)NE * 1024 * 1024 * 2);
        p.PcG = (bf16_t*)e; p.QcG = (bf16_t*)(e + ub); p.RhG = (bf16_t*)(e + 2 * ub); p.Y0G = (bf16_t*)(e + 3 * ub); p.GG = (bf16_t*)(e + 4 * ub); p.SG = (bf16_t*)(e + 5 * ub);
        p.bonG = (float*)(e + 6 * ub);
    }
    p.hb = (bf16_t*)take((size_t)TP * D * 2);
    p.hmeta = (float*)take((size_t)NBATCH * NMETA * D * 4);
    p.P = (bf16_t*)take((size_t)TP * CP * 2);
    p.osb = (bf16_t*)take((size_t)TP * 512 * 2);
    p.orw = (bf16_t*)take((size_t)TP * 512 * 2);
    p.list = (int*)take((size_t)NE * T * 4);
    p.tokg = (float*)take((size_t)T * 2 * 4);
    p.gates = p.P;
    p.merged = p.P + (size_t)TP * 2048;
    p.hid = p.P;
    p.fo = p.P + (size_t)(2 * T + 16 * 256) * DE;
    if (o > ws_size) return;
    static int grid = 0;
    if (!grid) {
        int dev = 0, cus = 0, per_cu = 0;
        (void)hipGetDevice(&dev);
        (void)hipDeviceGetAttribute(&cus, hipDeviceAttributeMultiprocessorCount, dev);
        (void)hipFuncSetAttribute((const void*)k_forward, hipFuncAttributeMaxDynamicSharedMemorySize, SMEM_BYTES);
        (void)hipOccupancyMaxActiveBlocksPerMultiprocessor(&per_cu, k_forward, NTHR, SMEM_BYTES);
        grid = per_cu >= 1 ? cus : 0;
    }
    if (!grid) return;
    (void)hipMemsetAsync(p.bar, 0, XCD_BAR_WORDS * sizeof(unsigned), stream);
    hipLaunchKernelGGL(k_forward, dim3(grid), dim3(NTHR), SMEM_BYTES, stream, p);
}
```

```cpp
#include <hip/hip_runtime.h>
#include <stdint.h>
#include <string.h>

#define DI __device__ __forceinline__
typedef unsigned short bf16_t;
typedef short bf16x8 __attribute__((ext_vector_type(8)));
typedef float f32x4 __attribute__((ext_vector_type(4)));
typedef unsigned u32x4 __attribute__((ext_vector_type(4)));
typedef unsigned u32x2 __attribute__((ext_vector_type(2)));

constexpr int D = 1024, NBATCH = 2, SEQ = 8192, NMETA = 16, L = SEQ + NMETA, T = NBATCH * L, TP = 16640;
constexpr int DEPTH = 2, HEADS = 8, HD = 64;
constexpr int CIN = 5376, CP = 3328;
constexpr int OFF_Q = 0, OFF_K = 512, OFF_V = 1024, OFF_RW = 1536;
constexpr int RW_R = 0, RW_K = 512, RW_V = 1024, RW_WD = 1536, RW_AD = 1600, RW_GD = 1664, RSW = 1792;
constexpr int NE = 16, DE = 512;
constexpr float ALPHA = 1.41421356237309515f;
constexpr float DECAY_SCALE = 0.60653065971263342f;
constexpr int NTHR = 512;

#define XB_TMO      128
#define XB_XCNT(j)  (256  + 64 * (j))
#define XB_XSUB(j)  (1280 + 64 * (j))
#define XB_XGEN(j)  (2304 + 64 * (j))
#define XB_TOP      3328
#define XB_TOPGEN   3392
#define XCD_BAR_WORDS 3456
#define XB_SPIN_CAP (1u << 18)
#define LAS __attribute__((address_space(3)))

__device__ __forceinline__ unsigned xb_ld(unsigned* p)              { return __hip_atomic_load(p, __ATOMIC_RELAXED, __HIP_MEMORY_SCOPE_AGENT); }
__device__ __forceinline__ unsigned xb_add(unsigned* p, unsigned v) { return __hip_atomic_fetch_add(p, v, __ATOMIC_RELAXED, __HIP_MEMORY_SCOPE_AGENT); }
__device__ __forceinline__ unsigned xb_xcc_id() { return (unsigned)__builtin_amdgcn_s_getreg((3 << 11) | 20) & 0xFu; }
#define XB_SPIN(cond, bar) do { unsigned _sp = 0; while (cond) { __builtin_amdgcn_s_sleep(1); \
    if ((++_sp & 255u) == 0u) { if (xb_ld(&(bar)[XB_TMO])) break; if (_sp > XB_SPIN_CAP) { atomicAdd(&(bar)[XB_TMO], 1u); break; } } } } while (0)

struct XcdBarrier {
    unsigned* bar; unsigned x;
    volatile LAS unsigned* st;
};

__device__ __forceinline__ XcdBarrier xcd_barrier_post(unsigned* bar, volatile LAS unsigned* st) {
    XcdBarrier b; b.bar = bar; b.x = xb_xcc_id(); b.st = st;
    if (threadIdx.x == 0) (void)xb_add(&bar[XB_XCNT(b.x)], 1u);
    return b;
}
__device__ __forceinline__ void xcd_barrier_complete(unsigned* bar, unsigned x, unsigned& nloc, unsigned& nx) {
    const unsigned G = gridDim.x * gridDim.y * gridDim.z;
    unsigned sum, cnt, mine, sp = 0u;
    for (;;) {
        sum = 0u; cnt = 0u; mine = 0u;
#pragma unroll
        for (unsigned j = 0; j < 16; ++j) { const unsigned c = xb_ld(&bar[XB_XCNT(j)]); sum += c; cnt += (c > 0u) ? 1u : 0u; mine = (j == x) ? c : mine; }
        if (sum == G) break;
        __builtin_amdgcn_s_sleep(1);
        if ((++sp & 255u) == 0u) { if (xb_ld(&bar[XB_TMO])) break; if (sp > XB_SPIN_CAP) { atomicAdd(&bar[XB_TMO], 1u); break; } }
    }
    nloc = mine > 0u ? mine : 1u; nx = cnt > 0u ? cnt : 1u;
}

__device__ __forceinline__ void xcd_barrier(const XcdBarrier& b) {
    asm volatile("s_waitcnt vmcnt(0)" ::: "memory");
    __syncthreads();
    if (threadIdx.x == 0) {
        unsigned* bar = b.bar;
        unsigned bx = b.x; asm volatile("" : "+s"(bx));
        __builtin_amdgcn_s_waitcnt(0);
        unsigned nloc = b.st[0], nx = b.st[1];
        if (nloc == 0u) { xcd_barrier_complete(bar, bx, nloc, nx); b.st[0] = nloc; b.st[1] = nx; }
        const unsigned old = xb_add(&bar[XB_XSUB(bx)], 1u);
        const unsigned gen = old / nloc;
        if (old + 1u == (gen + 1u) * nloc) {
            __builtin_amdgcn_fence(__ATOMIC_RELEASE, "agent");
            asm volatile("s_waitcnt vmcnt(0)" ::: "memory");
            const unsigned og = xb_add(&bar[XB_TOP], 1u);
            const unsigned tg = og / nx;
            if (og + 1u == (tg + 1u) * nx) xb_add(&bar[XB_TOPGEN], 1u);
            else XB_SPIN(xb_ld(&bar[XB_TOPGEN]) == tg, bar);
            __builtin_amdgcn_fence(__ATOMIC_ACQUIRE, "agent");
            xb_add(&bar[XB_XGEN(bx)], 1u);
            asm volatile("s_waitcnt vmcnt(0)" ::: "memory");
        } else {
            XB_SPIN(xb_ld(&bar[XB_XGEN(bx)]) == gen, bar);
            __builtin_amdgcn_fence(__ATOMIC_ACQUIRE, "agent");
            asm volatile("s_waitcnt vmcnt(0)" ::: "memory");
        }
    }
    __syncthreads();
}


struct Params {
    const float *x, *meta, *emb_g, *emb_b, *w_in, *mu, *w0, *w_up, *a0, *a_up, *g_up, *k_k, *k_a, *r_k, *lnx_g, *lnx_b, *p_sb, *p_rwkv, *w_out,
        *ln1_g, *ln1_b, *router_w, *router_b, *ew_gate, *ew_up, *ew_down, *ln2_g, *ln2_b;
    float* out;
    unsigned* bar;
    int* counts;
    bf16_t *WtIn, *WtPsb, *WtPrw, *WtOut, *WtGU, *WtD, *hb, *P, *osb, *orw, *WupT, *AupT, *GupT;
    bf16_t *PcG, *QcG, *RhG, *Y0G, *GG, *SG;
    bf16_t *RwHi, *RwLo, *gleft;
    float* bonG;
    float* hmeta;
    bf16_t *gates, *merged, *hid, *fo;
    int* list;
    float* tokg;
};

DI float bf2f(bf16_t v) { return __uint_as_float((unsigned)v << 16); }
typedef __bf16 bf16x2_t __attribute__((ext_vector_type(2)));
DI bf16_t f2bf(float f) { return __builtin_bit_cast(bf16_t, (__bf16)f); }
DI unsigned pack2(float lo, float hi) { bf16x2_t v = {(__bf16)lo, (__bf16)hi}; return __builtin_bit_cast(unsigned, v); }
DI float lo_bf(unsigned u) { return __uint_as_float(u << 16); }
DI float hi_bf(unsigned u) { return __uint_as_float(u & 0xFFFF0000u); }
template <int CTRL> DI float dpp_mov(float v) { return __builtin_bit_cast(float, __builtin_amdgcn_update_dpp(0, __builtin_bit_cast(int, v), CTRL, 0xF, 0xF, true)); }
DI float sum8(float v) {
    v += dpp_mov<0xB1>(v);
    v += dpp_mov<0x4E>(v);
    v += dpp_mov<0x141>(v);
    return v;
}
DI float sum16(float v) { v = sum8(v); v += dpp_mov<0x140>(v); return v; }
DI float wave_sum(float v) { v = sum16(v); v += __shfl_xor(v, 16); v += __shfl_xor(v, 32); return v; }
struct Params;
DI const Params& kparams() {
    auto k = __builtin_amdgcn_kernarg_segment_ptr();
    asm volatile("" : "+s"(k));
    return *(const Params*)k;
}
DI int tid_() { int t = threadIdx.x; asm volatile("" : "+v"(t)); return t; }
DI float sigmoidf_(float x) { return __builtin_amdgcn_rcpf(1.0f + __expf(-x)); }
DI float tanhf_(float x) { return 1.0f - 2.0f * __builtin_amdgcn_rcpf(1.0f + __expf(2.0f * x)); }
DI void wave_sync() { asm volatile("s_waitcnt lgkmcnt(0)" ::: "memory"); __builtin_amdgcn_wave_barrier(); }

DI float* hrow2(float* hmeta, float* out, int tok) {
    const int b = tok >= L ? 1 : 0, t = tok - b * L;
    const unsigned long long am = (unsigned long long)(hmeta + (long long)(b * NMETA + t) * D), ao = (unsigned long long)(out + ((long long)b * SEQ + (t - NMETA)) * D);
    const unsigned long long m = 0ull - (unsigned long long)(t < NMETA);
    return (float*)((am & m) | (ao & ~m));
}
DI float* hrow(const Params& p, int tok) { return hrow2(p.hmeta, p.out, tok); }
DI float* hrow_u(const Params& p, int tok) { return hrow2(p.hmeta, p.out, __builtin_amdgcn_readfirstlane(tok)); }

DI void transpose_convert(const float* __restrict__ src, int ld, int K, int N, bf16_t* __restrict__ dst, int mult, int off, int bid, int nb, char* smem, int& rot) {
    float* tile = (float*)smem;
    const int tk = K / 64, tn = N / 256, tid = tid_();
    const int first = (bid - rot % nb + nb) % nb;
    rot += tk * tn;
    for (int t = first; t < tk * tn; t += nb) {
        const int k0 = (t / tn) * 64, n0 = (t % tn) * 256;
        f32x4 v[4][2];
#pragma unroll
        for (int q = 0; q < 4; ++q)
#pragma unroll
            for (int i = 0; i < 2; ++i) v[q][i] = *(const f32x4*)(src + (size_t)(k0 + (tid >> 4) + 32 * i) * ld + n0 + q * 64 + (tid & 15) * 4);
        __syncthreads();
#pragma unroll
        for (int q = 0; q < 4; ++q)
#pragma unroll
            for (int i = 0; i < 2; ++i) {
                float* tp = tile + q * 64 * 65 + ((tid >> 4) + 32 * i) * 65 + (tid & 15) * 4;
                tp[0] = v[q][i][0]; tp[1] = v[q][i][1]; tp[2] = v[q][i][2]; tp[3] = v[q][i][3];
            }
        __syncthreads();
        const int n = tid >> 3, kc = (tid & 7) * 8;
#pragma unroll
        for (int q = 0; q < 4; ++q) {
            const float* tq = tile + q * 64 * 65;
            u32x4 o;
#pragma unroll
            for (int jj = 0; jj < 4; ++jj) o[jj] = pack2(tq[(kc + 2 * jj) * 65 + n], tq[(kc + 2 * jj + 1) * 65 + n]);
            *(u32x4*)(dst + (size_t)((n0 + q * 64 + n) * mult + off) * K + k0 + kc) = o;
        }
    }
}

DI void convert_experts(const Params& p, int layer, int e0, int e1, int bid, int nb, char* smem) {
    int rot = 0;
    for (int e = e0; e < e1; ++e) {
        const size_t eo = ((size_t)layer * NE + e) * (size_t)D * DE;
        transpose_convert(p.ew_gate + eo, DE, D, DE, p.WtGU + (size_t)e * 1024 * 1024, 2, 0, bid, nb, smem, rot);
        transpose_convert(p.ew_up + eo, DE, D, DE, p.WtGU + (size_t)e * 1024 * 1024, 2, 1, bid, nb, smem, rot);
        transpose_convert(p.ew_down + eo, D, DE, D, p.WtD + (size_t)e * 1024 * 512, 1, 0, bid, nb, smem, rot);
    }
}

DI void phase_prologue_weights(const Params& p, int bid, int nb, char* smem) {
    int rot = 0;
    for (int i = bid * NTHR + tid_(); i < NE * D; i += nb * NTHR) {
        const int e = i / D, k = i % D;
        const float w = p.router_w[(size_t)k * NE + e];
        const bf16_t hi = f2bf(w);
        p.RwHi[i] = hi; p.RwLo[i] = f2bf(w - bf2f(hi));
    }
    for (int l = 0; l < DEPTH; ++l) {
        transpose_convert(p.w_in + (size_t)l * D * CIN, CIN, D, CIN, p.WtIn + (size_t)l * CIN * D, 1, 0, bid, nb, smem, rot);
        transpose_convert(p.p_sb + (size_t)l * 512 * D, D, 512, D, p.WtPsb + (size_t)l * D * 512, 1, 0, bid, nb, smem, rot);
        transpose_convert(p.p_rwkv + (size_t)l * 512 * D, D, 512, D, p.WtPrw + (size_t)l * D * 512, 1, 0, bid, nb, smem, rot);
        transpose_convert(p.w_out + (size_t)l * D * D, D, D, D, p.WtOut + (size_t)l * D * D, 1, 0, bid, nb, smem, rot);
        transpose_convert(p.w_up + (size_t)l * 64 * 512, 512, 64, 512, p.WupT + (size_t)l * 512 * 64, 1, 0, bid, nb, smem, rot);
        transpose_convert(p.a_up + (size_t)l * 64 * 512, 512, 64, 512, p.AupT + (size_t)l * 512 * 64, 1, 0, bid, nb, smem, rot);
        transpose_convert(p.g_up + (size_t)l * 128 * 512, 512, 128, 512, p.GupT + (size_t)l * 512 * 128, 1, 0, bid, nb, smem, rot);
    }
}

DI void ln16(float (&v)[16], const float* __restrict__ g, const float* __restrict__ b, int lane) {
    float s = 0.f;
#pragma unroll
    for (int i = 0; i < 16; ++i) s += v[i];
    const float mean = wave_sum(s) * (1.0f / D);
    float q = 0.f;
#pragma unroll
    for (int i = 0; i < 16; ++i) { v[i] -= mean; q += v[i] * v[i]; }
    const float rstd = rsqrtf(wave_sum(q) * (1.0f / D) + 1e-5f);
#pragma unroll
    for (int j = 0; j < 4; ++j) {
        const f32x4 gv = *(const f32x4*)(g + 256 * j + 4 * lane), bv = *(const f32x4*)(b + 256 * j + 4 * lane);
#pragma unroll
        for (int i = 0; i < 4; ++i) v[4 * j + i] = v[4 * j + i] * rstd * gv[i] + bv[i];
    }
}
DI void store_row(float* __restrict__ hf, bf16_t* __restrict__ hb, const float (&v)[16], int lane) {
#pragma unroll
    for (int j = 0; j < 4; ++j) {
        *(f32x4*)(hf + 256 * j + 4 * lane) = (f32x4){v[4 * j], v[4 * j + 1], v[4 * j + 2], v[4 * j + 3]};
        *(u32x2*)(hb + 256 * j + 4 * lane) = (u32x2){pack2(v[4 * j], v[4 * j + 1]), pack2(v[4 * j + 2], v[4 * j + 3])};
    }
}

DI void store_row_bf(bf16_t* __restrict__ hb, const float (&v)[16], int lane) {
#pragma unroll
    for (int j = 0; j < 4; ++j) *(u32x2*)(hb + 256 * j + 4 * lane) = (u32x2){pack2(v[4 * j], v[4 * j + 1]), pack2(v[4 * j + 2], v[4 * j + 3])};
}
DI void phase_embed(const Params& p, int bid, int nb) {
    const int lane = tid_() & 63, wid = __builtin_amdgcn_readfirstlane(tid_() >> 6);
    const int nwaves = nb * 8, gw = bid * 8 + wid, base_n = T / nwaves, extra = T % nwaves;
    const int tok0 = gw * base_n + (gw < extra ? gw : extra), ntok = base_n + (gw < extra ? 1 : 0);
    auto srcrow = [&](int tok) -> const float* {
        const int tk = __builtin_amdgcn_readfirstlane(tok), b = tk >= L ? 1 : 0, t = tk - b * L;
        const unsigned long long am = (unsigned long long)(p.meta + (long long)t * D), ao = (unsigned long long)(p.x + ((long long)b * SEQ + (t - NMETA)) * D);
        const unsigned long long m = 0ull - (unsigned long long)(t < NMETA);
        return (const float*)((am & m) | (ao & ~m));
    };
    f32x4 an[4];
    { const float* src = srcrow(tok0);
#pragma unroll
      for (int j = 0; j < 4; ++j) an[j] = *(const f32x4*)(src + 256 * j + 4 * lane); }
#pragma unroll 1
    for (int i = 0; i < ntok; ++i) {
        const int tok = tok0 + i;
        float v[16];
#pragma unroll
        for (int j = 0; j < 4; ++j) { v[4 * j] = an[j][0]; v[4 * j + 1] = an[j][1]; v[4 * j + 2] = an[j][2]; v[4 * j + 3] = an[j][3]; }
        if (i + 1 < ntok) { const float* src = srcrow(tok + 1);
#pragma unroll
            for (int j = 0; j < 4; ++j) an[j] = *(const f32x4*)(src + 256 * j + 4 * lane); }
        ln16(v, p.emb_g, p.emb_b, lane);
        store_row_bf(p.hb + (size_t)tok * D, v, lane);
    }
}

constexpr int LDT = 72;
constexpr int GEMM_LDS = 2 * 128 * LDT * 2;
template <class ARow, class Epi>
DI void gemm_tile128(ARow arow, const bf16_t* __restrict__ Bt, int ldb, int K, int m0, int n0, char* smem, Epi epi) {
    const int tid = tid_(), lane = tid & 63, wid = __builtin_amdgcn_readfirstlane(tid >> 6), fr = lane & 15, fq = lane >> 4;
    const int wr = wid >> 1, wc = wid & 1;
    bf16_t* As = (bf16_t*)smem;
    bf16_t* Bs = As + 128 * LDT;
    const bf16_t* ap[2]; const bf16_t* bp[2]; int so[2];
#pragma unroll
    for (int i = 0; i < 2; ++i) {
        const int c = tid + NTHR * i, row = c >> 3, kc = c & 7;
        const bf16_t* ar = arow(m0 + row);
        ap[i] = ar ? ar + kc * 8 : nullptr;
        bp[i] = Bt + (size_t)(n0 + row) * ldb + kc * 8;
        so[i] = row * LDT + kc * 8;
    }
    f32x4 acc[2][4];
#pragma unroll
    for (int mi = 0; mi < 2; ++mi)
#pragma unroll
        for (int ni = 0; ni < 4; ++ni) acc[mi][ni] = (f32x4){0.f, 0.f, 0.f, 0.f};
    u32x4 ra[2], rb[2];
#pragma unroll
    for (int i = 0; i < 2; ++i) { ra[i] = ap[i] ? *(const u32x4*)(ap[i]) : (u32x4){0u, 0u, 0u, 0u}; rb[i] = *(const u32x4*)(bp[i]); }
    for (int k0 = 0; k0 < K; k0 += 64) {
        __syncthreads();
#pragma unroll
        for (int i = 0; i < 2; ++i) { *(u32x4*)(As + so[i]) = ra[i]; *(u32x4*)(Bs + so[i]) = rb[i]; }
        __syncthreads();
        if (k0 + 64 < K) {
#pragma unroll
            for (int i = 0; i < 2; ++i) { ra[i] = ap[i] ? *(const u32x4*)(ap[i] + k0 + 64) : (u32x4){0u, 0u, 0u, 0u}; rb[i] = *(const u32x4*)(bp[i] + k0 + 64); }
        }
#pragma unroll
        for (int ks = 0; ks < 2; ++ks) {
            bf16x8 af[2], bf[4];
#pragma unroll
            for (int mi = 0; mi < 2; ++mi) af[mi] = *(const bf16x8*)(As + (wr * 32 + mi * 16 + fr) * LDT + ks * 32 + fq * 8);
#pragma unroll
            for (int ni = 0; ni < 4; ++ni) bf[ni] = *(const bf16x8*)(Bs + (wc * 64 + ni * 16 + fr) * LDT + ks * 32 + fq * 8);
#pragma unroll
            for (int mi = 0; mi < 2; ++mi)
#pragma unroll
                for (int ni = 0; ni < 4; ++ni) acc[mi][ni] = __builtin_amdgcn_mfma_f32_16x16x32_bf16(bf[ni], af[mi], acc[mi][ni], 0, 0, 0);
        }
    }
#pragma unroll
    for (int mi = 0; mi < 2; ++mi)
#pragma unroll
        for (int ni = 0; ni < 4; ++ni) epi(m0 + wr * 32 + mi * 16 + fr, n0 + wc * 64 + ni * 16 + fq * 4, acc[mi][ni]);
}

namespace g8 {
#define G8_LAS __attribute__((address_space(3)))
constexpr int BM = 256, BK = 64, HALF = 128, HTB = HALF * BK * 2, STAGE_BYTES = 8 * HTB, NXCD = 8, WGM = 8;
DI int lds_byte(int r, int c) { const int st = (r >> 4) * 2 + (c >> 5), rr = r & 15, cc = c & 31, ob = rr * 64 + cc * 2; return st * 1024 + (ob ^ (((ob >> 9) & 1) << 5)); }
DI void stage_rc(int b, int& R, int& C) { const int st = b / 1024, sb = b % 1024, swz = sb ^ (((sb >> 9) & 1) << 5); R = (st >> 1) * 16 + swz / 64; C = (st & 1) * 32 + (swz % 64) / 2; }
DI int perm32(int rho) { const int n = rho >> 4, i = rho & 15; return 8 * (i >> 2) + 4 * n + (i & 3); }
struct Unit { int pm, pn; const char* A; const char* B; int e, slot0, cnt; };

struct DenseOrder {
    int nM, nN, nwg, G, c; const char* A; const char* B; size_t tstep;
    DI void init(const bf16_t* A_, const bf16_t* Bt_, int nM_, int nN_, int K, int G_, int c_) { nM = nM_; nN = nN_; nwg = nM * nN; G = G_; c = c_; A = (const char*)A_; B = (const char*)Bt_; tstep = (size_t)BM * K * 2; }
    DI bool next(int i, Unit& u) const {
        const long Lq = (long)i * G + c; if (Lq >= nwg) return false;
        int wgid = (int)Lq; { const int q = nwg / NXCD, r = nwg % NXCD, xcd = wgid % NXCD, off = wgid / NXCD; wgid = (xcd < r ? xcd * (q + 1) : r * (q + 1) + (xcd - r) * q) + off; }
        const int nig = WGM * nN, gid = wgid / nig, fm = gid * WGM, gsz = (nM - fm) < WGM ? (nM - fm) : WGM;
        u.pm = fm + ((wgid % nig) % gsz); u.pn = (wgid % nig) / gsz; u.A = A + (size_t)u.pm * tstep; u.B = B + (size_t)u.pn * tstep; u.e = 0; u.slot0 = 0; u.cnt = 0; return true;
    }
    DI unsigned row_off(const Unit&, int) const { return 0u; }
};

template <bool GATHER, class Epi, class Sched>
DI void gemm8(G8_LAS unsigned char* lds, const int K, const Sched& S, const Epi& E) {
    const int tid = tid_(), wid = __builtin_amdgcn_readfirstlane(tid >> 6), lane = tid & 63, wr = wid >> 2, wc = wid & 3, fr = lane & 15, fq = lane >> 4;
    const int nt = K / BK;
    int Rr[2], Cc[2]; unsigned voffB[2], voffA[2];
#pragma unroll
    for (int i = 0; i < 2; ++i) { stage_rc(tid * 16 + i * 8192, Rr[i], Cc[i]); const int Rb = Epi::PERM ? ((Rr[i] & ~31) + perm32(Rr[i] & 31)) : Rr[i]; voffB[i] = (unsigned)(Rb * K + Cc[i]) * 2u; voffA[i] = (unsigned)(Rr[i] * K + Cc[i]) * 2u; }
    const size_t kstep = (size_t)(BK * 2), hstep = (size_t)HALF * K * 2;
    const unsigned ldsw = (unsigned)wid * 1024u;
    const int aoff = lds_byte(wr * 64 + fr, fq * 8), boff = lds_byte(wc * 32 + fr, fq * 8);
#define G8_SA(b, h) (((b) * 2 + (h)) * HTB)
#define G8_SB(b, h) ((4 + (b) * 2 + (h)) * HTB)
#define G8_STAGE(bufoff, gbase, voff) do { _Pragma("unroll") for (int _i = 0; _i < 2; ++_i) \
        __builtin_amdgcn_global_load_lds((const unsigned*)((const char*)(gbase) + (voff)[_i]), (G8_LAS unsigned*)(lds + (bufoff) + ldsw + _i * 8192), 16, 0, 0); } while (0)
#define G8_LDA(dst, b, h) do { _Pragma("unroll") for (int m = 0; m < 4; ++m) _Pragma("unroll") for (int k = 0; k < 2; ++k) dst[m][k] = *(const G8_LAS bf16x8*)(lds + G8_SA(b, h) + aoff + m * 2048 + k * 1024); } while (0)
#define G8_LDB(dst, b, h) do { _Pragma("unroll") for (int n = 0; n < 2; ++n) _Pragma("unroll") for (int k = 0; k < 2; ++k) dst[n][k] = *(const G8_LAS bf16x8*)(lds + G8_SB(b, h) + boff + n * 2048 + k * 1024); } while (0)
#define G8_MMA(ai, bj, At, Bt) do { __builtin_amdgcn_s_setprio(1); _Pragma("unroll") for (int m = 0; m < 4; ++m) _Pragma("unroll") for (int n = 0; n < 2; ++n) _Pragma("unroll") for (int k = 0; k < 2; ++k) \
        acc[ai][bj][m][n] = __builtin_amdgcn_mfma_f32_16x16x32_bf16(Bt[n][k], At[m][k], acc[ai][bj][m][n], 0, 0, 0); __builtin_amdgcn_s_setprio(0); } while (0)
#define G8_WAIT_V(n) asm volatile("s_waitcnt vmcnt(" #n ")" ::: "memory")
#define G8_WAIT_L(n) asm volatile("s_waitcnt lgkmcnt(" #n ")" ::: "memory")
#define G8_BAR __builtin_amdgcn_s_barrier()
#define G8_SCHED __builtin_amdgcn_sched_barrier(0)
#define G8_AOFF(dst, un) do { if (GATHER) { _Pragma("unroll") for (int _h = 0; _h < 2; ++_h) _Pragma("unroll") for (int _i = 0; _i < 2; ++_i) \
        dst[_h][_i] = S.row_off(un, _h * HALF + Rr[_i]) + (unsigned)Cc[_i] * 2u; } } while (0)
#define G8_STAGE_A(bufoff, gb, vo, h) do { if (GATHER) { G8_STAGE(bufoff, gb, vo[h]); } else { G8_STAGE(bufoff, (gb) + (h) * hstep, voffA); } } while (0)
    Unit cur, nxt; int ui = 0;
    if (!S.next(0, cur)) return;
    f32x4 acc[2][2][4][2];
#pragma unroll
    for (int a = 0; a < 2; ++a)
#pragma unroll
        for (int b = 0; b < 2; ++b)
#pragma unroll
            for (int m = 0; m < 4; ++m)
#pragma unroll
                for (int n = 0; n < 2; ++n) acc[a][b][m][n] = (f32x4){0.f, 0.f, 0.f, 0.f};
    bf16x8 At[4][2], B0[2][2], B1[2][2];
    unsigned cvA[2][2], nvA[2][2];
    G8_AOFF(cvA, cur);
    const char* cA = cur.A; const char* cB = cur.B;
    G8_STAGE(G8_SB(0, 0), cB, voffB); G8_STAGE_A(G8_SA(0, 0), cA, cvA, 0); G8_STAGE(G8_SB(0, 1), cB + hstep, voffB); G8_STAGE_A(G8_SA(0, 1), cA, cvA, 1);
    if (wr == 1) G8_BAR;
    G8_WAIT_V(4); G8_BAR;
    G8_STAGE(G8_SB(1, 0), cB + kstep, voffB); G8_STAGE_A(G8_SA(1, 0), cA + kstep, cvA, 0); G8_STAGE(G8_SB(1, 1), cB + hstep + kstep, voffB);
    G8_WAIT_V(6); G8_BAR;
    for (;;) {
        const bool has_next = S.next(ui + 1, nxt);
        const char* nA = has_next ? nxt.A : cA; const char* nB = has_next ? nxt.B : cB;
        if (GATHER) {
            if (has_next) { G8_AOFF(nvA, nxt); } else {
#pragma unroll
                for (int h = 0; h < 2; ++h)
#pragma unroll
                    for (int i = 0; i < 2; ++i) nvA[h][i] = cvA[h][i];
            }
        }
        for (int t = 0; t < nt; t += 2) {
            const bool last = (t == nt - 2);
            const char* a1 = cA + (size_t)(t + 1) * kstep;
            const char* a2 = last ? nA : cA + (size_t)(t + 2) * kstep; const char* b2 = last ? nB : cB + (size_t)(t + 2) * kstep;
            const char* a3 = a2 + kstep; const char* b3 = b2 + kstep;

            G8_LDB(B0, 0, 0); G8_SCHED; G8_LDA(At, 0, 0); G8_STAGE_A(G8_SA(1, 1), a1, cvA, 1);
            if (GATHER && last) {
#pragma unroll
                for (int h = 0; h < 2; ++h)
#pragma unroll
                    for (int i = 0; i < 2; ++i) cvA[h][i] = nvA[h][i];
            }
            G8_WAIT_L(8); G8_BAR; G8_WAIT_L(0); G8_MMA(0, 0, At, B0); G8_BAR; G8_SCHED;
            G8_LDB(B1, 0, 1); G8_STAGE(G8_SB(0, 0), b2, voffB);
            G8_BAR; G8_WAIT_L(0); G8_MMA(0, 1, At, B1); G8_BAR;
            G8_LDA(At, 0, 1); G8_STAGE_A(G8_SA(0, 0), a2, cvA, 0);
            G8_BAR; G8_WAIT_L(0); G8_MMA(1, 0, At, B0); G8_BAR; G8_SCHED;
            G8_STAGE(G8_SB(0, 1), b2 + hstep, voffB);
            G8_WAIT_V(6); G8_BAR; G8_MMA(1, 1, At, B1); G8_BAR;
            G8_LDB(B0, 1, 0); G8_SCHED; G8_LDA(At, 1, 0); G8_STAGE_A(G8_SA(0, 1), a2, cvA, 1);
            G8_WAIT_L(8); G8_BAR; G8_WAIT_L(0); G8_MMA(0, 0, At, B0); G8_BAR; G8_SCHED;
            G8_LDB(B1, 1, 1); G8_STAGE(G8_SB(1, 0), b3, voffB);
            G8_BAR; G8_WAIT_L(0); G8_MMA(0, 1, At, B1); G8_BAR;
            G8_LDA(At, 1, 1); G8_STAGE_A(G8_SA(1, 0), a3, cvA, 0);
            G8_BAR; G8_WAIT_L(0); G8_MMA(1, 0, At, B0); G8_BAR; G8_SCHED;
            G8_STAGE(G8_SB(1, 1), b3 + hstep, voffB);
            G8_WAIT_V(6); G8_BAR; G8_MMA(1, 1, At, B1); G8_BAR;
        }
        { int fr2 = fr, fq2 = fq; asm volatile("" : "+v"(fr2), "+v"(fq2)); E(acc, cur, wr, wc, fr2, fq2); }
        if (!has_next) break;
#pragma unroll
        for (int a = 0; a < 2; ++a)
#pragma unroll
            for (int b = 0; b < 2; ++b)
#pragma unroll
                for (int m = 0; m < 4; ++m)
#pragma unroll
                    for (int n = 0; n < 2; ++n) acc[a][b][m][n] = (f32x4){0.f, 0.f, 0.f, 0.f};
        cur = nxt; cA = nA; cB = nB; ++ui;
    }
    G8_WAIT_V(0);
    if (wr == 0) G8_BAR;
    G8_BAR;
#undef G8_SA
#undef G8_SB
#undef G8_STAGE
#undef G8_LDA
#undef G8_LDB
#undef G8_MMA
#undef G8_WAIT_V
#undef G8_WAIT_L
#undef G8_BAR
#undef G8_SCHED
#undef G8_AOFF
#undef G8_STAGE_A
}
}

constexpr int MFULL = 64, M0_LEFT = MFULL * 256;
struct EpiStore {
    static constexpr bool PERM = true;
    bf16_t* O; int ldc; bool sig;
    DI void operator()(const f32x4 (&acc)[2][2][4][2], const g8::Unit& u, int wr, int wc, int fr, int fq) const {
#pragma unroll
        for (int ai = 0; ai < 2; ++ai)
#pragma unroll
            for (int m = 0; m < 4; ++m) {
                bf16_t* rowp = O + (size_t)(u.pm * 256 + ai * 128 + wr * 64 + m * 16 + fr) * ldc + u.pn * 256 + wc * 32 + 8 * fq;
#pragma unroll
                for (int bj = 0; bj < 2; ++bj) {
                    f32x4 v0 = acc[ai][bj][m][0], v1 = acc[ai][bj][m][1];
                    if (sig) {
#pragma unroll
                        for (int e = 0; e < 4; ++e) { v0[e] = sigmoidf_(v0[e]); v1[e] = sigmoidf_(v1[e]); }
                    }
                    *(u32x4*)(rowp + bj * 128) = (u32x4){pack2(v0[0], v0[1]), pack2(v0[2], v0[3]), pack2(v1[0], v1[1]), pack2(v1[2], v1[3])};
                }
            }
    }
};
DI int left_first(int units, int bid, int nb) { return (bid - units % nb + nb) % nb; }

constexpr int LEFT_LDS = 2 * (32 + 128) * LDT * 2;
template <class ARow, class Epi>
DI void gemm_left32(ARow arow, const bf16_t* __restrict__ Bt, int ldb, int K, int n0, char* smem, Epi epi) {
    const int tid = tid_(), lane = tid & 63, wid = __builtin_amdgcn_readfirstlane(tid >> 6), fr = lane & 15, fq = lane >> 4;
    bf16_t* As = (bf16_t*)smem;
    bf16_t* Bs = As + 2 * 32 * LDT;
    const int arow_i = tid >> 4, akc = (tid & 15) * 4;
    const bf16_t* ap = arow(arow_i) + akc;
    const bf16_t* bp[2]; int bso[2];
#pragma unroll
    for (int i = 0; i < 2; ++i) { const int cc = tid + NTHR * i, row = cc >> 3, kc = cc & 7; bp[i] = Bt + (size_t)(n0 + row) * ldb + kc * 8; bso[i] = row * LDT + kc * 8; }
    const int nit = K / 64;
    u32x2 ra[4]; u32x4 rb[4][2];
#define GL_LOAD(slot, it) do { if ((it) < nit) { ra[slot] = *(const u32x2*)(ap + (it) * 64); rb[slot][0] = *(const u32x4*)(bp[0] + (it) * 64); rb[slot][1] = *(const u32x4*)(bp[1] + (it) * 64); } } while (0)
#define GL_WRITE(slot, buf) do { *(u32x2*)(As + (buf) * 32 * LDT + arow_i * LDT + akc) = ra[slot]; *(u32x4*)(Bs + (buf) * 128 * LDT + bso[0]) = rb[slot][0]; *(u32x4*)(Bs + (buf) * 128 * LDT + bso[1]) = rb[slot][1]; } while (0)
    f32x4 acc[2] = {(f32x4){0.f, 0.f, 0.f, 0.f}, (f32x4){0.f, 0.f, 0.f, 0.f}};
    GL_LOAD(0, 0); GL_LOAD(1, 1); GL_LOAD(2, 2); GL_LOAD(3, 3);
    __syncthreads();
    GL_WRITE(0, 0);
    __syncthreads();
#define GL_STEP(slot, it) do { \
        GL_LOAD(slot, (it) + 4); \
        const int buf = (it) & 1; \
        _Pragma("unroll") for (int ks = 0; ks < 2; ++ks) { \
            const bf16x8 bf = *(const bf16x8*)(Bs + buf * 128 * LDT + (wid * 16 + fr) * LDT + ks * 32 + fq * 8); \
            _Pragma("unroll") for (int mt = 0; mt < 2; ++mt) { \
                const bf16x8 af = *(const bf16x8*)(As + buf * 32 * LDT + (mt * 16 + fr) * LDT + ks * 32 + fq * 8); \
                acc[mt] = __builtin_amdgcn_mfma_f32_16x16x32_bf16(bf, af, acc[mt], 0, 0, 0); } } \
        if ((it) + 1 < nit) { GL_WRITE(((slot) + 1) & 3, buf ^ 1); } \
        __syncthreads(); } while (0)
    for (int it = 0; it < nit; it += 4) {
        GL_STEP(0, it);
        if (it + 1 < nit) GL_STEP(1, it + 1);
        if (it + 2 < nit) GL_STEP(2, it + 2);
        if (it + 3 < nit) GL_STEP(3, it + 3);
    }
#undef GL_LOAD
#undef GL_WRITE
#undef GL_STEP
#pragma unroll
    for (int mt = 0; mt < 2; ++mt) epi(mt * 16 + fr, n0 + wid * 16 + fq * 4, acc[mt]);
}

DI void phase_inproj(const Params& p, int layer, int bid, int nb, char* smem) {
    const bf16_t* hb = p.hb; bf16_t* P = p.P;
    const bf16_t* Bt = p.WtIn + (size_t)layer * CIN * D;
    g8::DenseOrder S; S.init(hb, Bt, MFULL, CP / 256, D, nb, bid);
    g8::gemm8<false>((G8_LAS unsigned char*)smem, D, S, EpiStore{P, CP, false});
    {
        constexpr int UNITS = MFULL * (CP / 256);
        const int heavy = UNITS % nb;
        if (heavy > 0 && heavy < nb) { if (bid >= heavy) convert_experts(p, layer, 0, NE / 2, bid - heavy, nb - heavy, smem); }
        else convert_experts(p, layer, 0, NE / 2, bid, nb, smem);
    }
    bf16_t* G = p.gleft - (size_t)M0_LEFT * 2048; const bf16_t* Wg = p.WtIn + ((size_t)layer * CIN + CP) * D;
    for (int t = left_first(MFULL * (CP / 256), bid, nb); t < CP / 128 + 2048 / 128; t += nb) {
        if (t < CP / 128)
            gemm_left32([=](int r) { return hb + (size_t)(M0_LEFT + r) * D; }, Bt, D, D, t * 128, smem,
                        [=](int r, int c, f32x4 v) { *(u32x2*)(P + (size_t)(M0_LEFT + r) * CP + c) = (u32x2){pack2(v[0], v[1]), pack2(v[2], v[3])}; });
        else
            gemm_left32([=](int r) { return hb + (size_t)(M0_LEFT + r) * D; }, Wg, D, D, (t - CP / 128) * 128, smem,
                        [=](int r, int c, f32x4 v) { *(u32x2*)(G + (size_t)(M0_LEFT + r) * 2048 + c) = (u32x2){pack2(sigmoidf_(v[0]), sigmoidf_(v[1])), pack2(sigmoidf_(v[2]), sigmoidf_(v[3]))}; });
    }
}

constexpr int NCHUNK = (L + 63) / 64, NUNIT = NBATCH * HEADS * NCHUNK;
constexpr int LS = 72, RB = 64 * LS * 2;
constexpr int R1_LDS = 16 * RB + 4096 + 7168;
#define RBUF(i) ((bf16_t*)(smem + (i) * RB))
typedef float f32x16 __attribute__((ext_vector_type(16)));

template <int KK> DI f32x4 mm16(const bf16_t* F, int ldf, const bf16_t* S, int lds_, f32x4 acc, int lane) {
    const int fr = lane & 15, fq = lane >> 4;
#pragma unroll
    for (int ks = 0; ks < KK / 32; ++ks) {
        const bf16x8 f = *(const bf16x8*)(F + fr * ldf + ks * 32 + fq * 8);
        const bf16x8 g = *(const bf16x8*)(S + fr * lds_ + ks * 32 + fq * 8);
        acc = __builtin_amdgcn_mfma_f32_16x16x32_bf16(f, g, acc, 0, 0, 0);
    }
    return acc;
}
DI u32x2 pk4(f32x4 v) { return (u32x2){pack2(v[0], v[1]), pack2(v[2], v[3])}; }
DI f32x4 up4(u32x2 v) { return (f32x4){lo_bf(v[0]), hi_bf(v[0]), lo_bf(v[1]), hi_bf(v[1])}; }

template <int MODE> DI void phase_rwkv_r1(const Params& p, int layer, int bid, int nb, char* smem) {
    const int wv = __builtin_amdgcn_readfirstlane(tid_() >> 6);
    const f32x4 zero = (f32x4){0.f, 0.f, 0.f, 0.f};
    float* lwT = (float*)RBUF(4);
    float* aT = (float*)RBUF(6);
    float* gt = (float*)(smem + 16 * RB);
    float* gammaC = gt + 512;
    bf16_t* Xt0 = RBUF(14);
    bf16_t* Xt1 = RBUF(4);
    const bf16_t* WupT = p.WupT + (size_t)layer * 512 * 64, *AupT = p.AupT + (size_t)layer * 512 * 64, *GupT = p.GupT + (size_t)layer * 512 * 128;
    float* mu = (float*)(smem + 16 * RB + 4096);
    __syncthreads();
    for (int i = tid_(); i < RSW; i += NTHR) mu[i] = p.mu[(size_t)layer * RSW + i];
    for (int it = 0;; ++it) {
        const int tid = tid_(), lane = tid & 63, fr = lane & 15, fq = lane >> 4;
        int c, bh;
        if (MODE == 0) {
            const int Lq = it * nb + bid, q = Lq >> 3, cb = (q >> 3) * 8 + (Lq & 7);
            if (cb >= NBATCH * (NCHUNK - 1)) break;
            c = cb % (NCHUNK - 1); bh = (cb / (NCHUNK - 1)) * HEADS + (q & 7);
        } else {
            if (it > 0) break;
            c = NCHUNK - 1; bh = bid;
        }
        const int u = bh * NCHUNK + c, h = bh % HEADS, bb = bh / HEADS;
        const size_t tok0 = (size_t)bb * L + c * 64;
        bf16x8 fw[2][2], fa[2][2], fg[2][4];
#pragma unroll
        for (int t2 = 0; t2 < 2; ++t2) {
            const int tl = wv * 2 + t2, pt = tl >> 2, qt = tl & 3;
#pragma unroll
            for (int ks = 0; ks < 2; ++ks) {
                fw[t2][ks] = *(const bf16x8*)(WupT + (size_t)(h * 64 + qt * 16 + fr) * 64 + ks * 32 + fq * 8);
                fa[t2][ks] = *(const bf16x8*)(AupT + (size_t)(h * 64 + pt * 16 + fr) * 64 + ks * 32 + fq * 8);
            }
        }
        __syncthreads();
        {
            u32x4 curv[7], prvv[7];
#pragma unroll
            for (int it2 = 0; it2 < 7; ++it2) {
                const int cid = tid + NTHR * it2, i = cid / 56, cc = cid % 56;
                const int col = cc < 8 ? RW_R + h * 64 + cc * 8 : cc < 16 ? RW_K + h * 64 + (cc - 8) * 8 : cc < 24 ? RW_V + h * 64 + (cc - 16) * 8 : RW_WD + (cc - 24) * 8;
                const int t = c * 64 + i;
                curv[it2] = (u32x4){0u, 0u, 0u, 0u}; prvv[it2] = (u32x4){0u, 0u, 0u, 0u};
                if (t < L) curv[it2] = *(const u32x4*)(p.P + (tok0 + i) * CP + OFF_RW + col);
                if (t < L && t > 0) prvv[it2] = *(const u32x4*)(p.P + (tok0 + i - 1) * CP + OFF_RW + col);
            }
#pragma unroll
            for (int it2 = 0; it2 < 7; ++it2) {
                const int cid = tid + NTHR * it2, i = cid / 56, cc = cid % 56;
                const int col = cc < 8 ? RW_R + h * 64 + cc * 8 : cc < 16 ? RW_K + h * 64 + (cc - 8) * 8 : cc < 24 ? RW_V + h * 64 + (cc - 16) * 8 : RW_WD + (cc - 24) * 8;
                bf16_t* dst = cc < 8 ? RBUF(8) + i * LS + cc * 8 : cc < 16 ? RBUF(9) + i * LS + (cc - 8) * 8 : cc < 24 ? RBUF(10) + i * LS + (cc - 16) * 8
                            : cc < 32 ? RBUF(0) + i * LS + (cc - 24) * 8 : cc < 40 ? RBUF(1) + i * LS + (cc - 32) * 8 : RBUF(2) + i * 136 + (cc - 40) * 8;
                const f32x4 m0 = *(const f32x4*)(mu + col), m1 = *(const f32x4*)(mu + col + 4);
                const u32x4 cur = curv[it2], prv = prvv[it2];
                float x[8];
#pragma unroll
                for (int j2 = 0; j2 < 4; ++j2) {
                    const float c0 = lo_bf(cur[j2]), c1 = hi_bf(cur[j2]), p0 = lo_bf(prv[j2]), p1 = hi_bf(prv[j2]);
                    const float mm0 = j2 < 2 ? m0[2 * j2] : m1[2 * j2 - 4], mm1 = j2 < 2 ? m0[2 * j2 + 1] : m1[2 * j2 - 3];
                    x[2 * j2] = c0 + (p0 - c0) * mm0; x[2 * j2 + 1] = c1 + (p1 - c1) * mm1;
                }
                if (cc >= 24 && cc < 32) {
#pragma unroll
                    for (int j2 = 0; j2 < 8; ++j2) x[j2] = tanhf_(x[j2]);
                } else if (cc >= 40) {
#pragma unroll
                    for (int j2 = 0; j2 < 8; ++j2) x[j2] = sigmoidf_(x[j2]);
                }
                *(u32x4*)dst = (u32x4){pack2(x[0], x[1]), pack2(x[2], x[3]), pack2(x[4], x[5]), pack2(x[6], x[7])};
            }
        }
#pragma unroll
        for (int t2 = 0; t2 < 2; ++t2)
#pragma unroll
            for (int ks = 0; ks < 4; ++ks) fg[t2][ks] = *(const bf16x8*)(GupT + (size_t)(h * 64 + ((wv * 2 + t2) >> 2) * 16 + fr) * 128 + ks * 32 + fq * 8);
        __syncthreads();
#pragma unroll
        for (int t2 = 0; t2 < 2; ++t2) {
            const int tl = wv * 2 + t2, pt = tl >> 2, qt = tl & 3;
            f32x4 aw = zero, aa = zero, ag = zero;
#pragma unroll
            for (int ks = 0; ks < 2; ++ks) {
                const bf16x8 xw = *(const bf16x8*)(RBUF(0) + (pt * 16 + fr) * LS + ks * 32 + fq * 8);
                aw = __builtin_amdgcn_mfma_f32_16x16x32_bf16(xw, fw[t2][ks], aw, 0, 0, 0);
                const bf16x8 xa = *(const bf16x8*)(RBUF(1) + (qt * 16 + fr) * LS + ks * 32 + fq * 8);
                aa = __builtin_amdgcn_mfma_f32_16x16x32_bf16(fa[t2][ks], xa, aa, 0, 0, 0);
            }
#pragma unroll
            for (int ks = 0; ks < 4; ++ks) {
                const bf16x8 xg = *(const bf16x8*)(RBUF(2) + (qt * 16 + fr) * 136 + ks * 32 + fq * 8);
                ag = __builtin_amdgcn_mfma_f32_16x16x32_bf16(fg[t2][ks], xg, ag, 0, 0, 0);
            }
            const int ch = qt * 16 + fr;
            const float w0 = p.w0[layer * 512 + h * 64 + ch];
            const f32x4 a0 = *(const f32x4*)(p.a0 + layer * 512 + h * 64 + pt * 16 + fq * 4);
            f32x4 lw, av;
#pragma unroll
            for (int e = 0; e < 4; ++e) { lw[e] = -DECAY_SCALE * sigmoidf_(w0 + aw[e]); av[e] = sigmoidf_(a0[e] + aa[e]); }
            *(f32x4*)(lwT + ch * 68 + pt * 16 + fq * 4) = lw;
            *(f32x4*)(aT + (qt * 16 + fr) * 68 + pt * 16 + fq * 4) = av;
            *(u32x2*)(p.GG + ((size_t)u * 64 + qt * 16 + fr) * 64 + pt * 16 + fq * 4) = pk4(ag);
        }
        __syncthreads();
        {
            const int i = tid >> 3, c8 = (tid & 7) * 8, cg = layer * 512 + h * 64 + c8;
            const u32x4 xr = *(const u32x4*)(RBUF(8) + i * LS + c8), xk = *(const u32x4*)(RBUF(9) + i * LS + c8);
            const f32x4 a0 = *(const f32x4*)(aT + i * 68 + c8), a1 = *(const f32x4*)(aT + i * 68 + c8 + 4);
            const f32x4 kk0 = *(const f32x4*)(p.k_k + cg), kk1 = *(const f32x4*)(p.k_k + cg + 4), ka0 = *(const f32x4*)(p.k_a + cg), ka1 = *(const f32x4*)(p.k_a + cg + 4);
            const f32x4 rk0 = *(const f32x4*)(p.r_k + cg), rk1 = *(const f32x4*)(p.r_k + cg + 4);
            float n2 = 0.f, bon = 0.f;
#pragma unroll
            for (int j = 0; j < 8; ++j) {
                const float r_ = (j & 1) ? hi_bf(xr[j >> 1]) : lo_bf(xr[j >> 1]), k_ = (j & 1) ? hi_bf(xk[j >> 1]) : lo_bf(xk[j >> 1]);
                const float a_ = j < 4 ? a0[j & 3] : a1[j & 3], kkc = j < 4 ? kk0[j & 3] : kk1[j & 3], kac = j < 4 ? ka0[j & 3] : ka1[j & 3], rkc = j < 4 ? rk0[j & 3] : rk1[j & 3];
                const float kkr = k_ * kkc;
                n2 += kkr * kkr;
                bon += r_ * (k_ * (1.0f + (a_ - 1.0f) * kac)) * rkc;
            }
            n2 = sum8(n2); bon = sum8(bon);
            if ((tid & 7) == 0) { gt[576 + i] = 1.0f / fmaxf(sqrtf(n2), 1e-12f); p.bonG[(size_t)u * 64 + i] = bon; }
        }
        __syncthreads();
        {
            const int ch = lane, cg = layer * 512 + h * 64 + ch;
            float lw[8], av[8], cum[8];
            {
                const f32x4 l0 = *(const f32x4*)(lwT + ch * 68 + wv * 8), l1 = *(const f32x4*)(lwT + ch * 68 + wv * 8 + 4);
#pragma unroll
                for (int e = 0; e < 4; ++e) { lw[e] = l0[e]; lw[e + 4] = l1[e]; }
#pragma unroll
                for (int e = 0; e < 8; ++e) av[e] = aT[(wv * 8 + e) * 68 + ch];
            }
            float run = 0.f;
#pragma unroll
            for (int e = 0; e < 8; ++e) { run += lw[e]; cum[e] = run; }
            gt[wv * 64 + ch] = run;
            __syncthreads();
            float offs = 0.f, tot = 0.f;
#pragma unroll
            for (int g2 = 0; g2 < 8; ++g2) { const float gv = gt[g2 * 64 + ch]; offs += g2 < wv ? gv : 0.f; tot += gv; }
            if (wv == 0) gammaC[ch] = __expf(tot);
            const float kkc = p.k_k[cg], kac = p.k_a[cg];
            float at_[8], kt_[8], bt_[8], vt_[8];
#pragma unroll
            for (int e = 0; e < 8; ++e) {
                const int i = wv * 8 + e;
                const float xr = bf2f(RBUF(8)[i * LS + ch]), xk = bf2f(RBUF(9)[i * LS + ch]), xv = bf2f(RBUF(10)[i * LS + ch]);
                const float cm = cum[e] + offs;
                const float kk = xk * kkc * gt[576 + i];
                const float kq = xk * (1.0f + (av[e] - 1.0f) * kac);
                if (c * 64 + i < L) p.orw[(tok0 + i) * 512 + h * 64 + ch] = RBUF(10)[i * LS + ch];
                const float eneg = __expf(-cm), epos = __expf(cm), eexc = __expf(cm - lw[e]);
                at_[e] = -kk * eexc; kt_[e] = kq * eneg; bt_[e] = kk * av[e] * eneg; vt_[e] = xv;
                RBUF(3)[i * LS + ch] = f2bf(xr * epos);
            }
            __syncthreads();
#pragma unroll
            for (int e = 0; e < 8; ++e) {
                const int i = wv * 8 + e;
                RBUF(0)[i * LS + ch] = f2bf(at_[e]); RBUF(1)[i * LS + ch] = f2bf(kt_[e]); RBUF(2)[i * LS + ch] = f2bf(bt_[e]);
            }
            *(u32x4*)(RBUF(11) + ch * LS + wv * 8) = (u32x4){pack2(kt_[0], kt_[1]), pack2(kt_[2], kt_[3]), pack2(kt_[4], kt_[5]), pack2(kt_[6], kt_[7])};
            *(u32x4*)(RBUF(12) + ch * LS + wv * 8) = (u32x4){pack2(bt_[0], bt_[1]), pack2(bt_[2], bt_[3]), pack2(bt_[4], bt_[5]), pack2(bt_[6], bt_[7])};
            *(u32x4*)(RBUF(13) + ch * LS + wv * 8) = (u32x4){pack2(vt_[0], vt_[1]), pack2(vt_[2], vt_[3]), pack2(vt_[4], vt_[5]), pack2(vt_[6], vt_[7])};
            *(u32x4*)(Xt0 + ch * LS + wv * 8) = (u32x4){pack2(at_[0], at_[1]), pack2(at_[2], at_[3]), pack2(at_[4], at_[5]), pack2(at_[6], at_[7])};
        }
        __syncthreads();
#pragma unroll
        for (int prod = 0; prod < 5; ++prod) {
            const bf16_t* F = prod == 0 ? RBUF(1) : prod == 1 ? RBUF(2) : prod == 2 ? RBUF(0) : prod == 3 ? RBUF(1) : RBUF(2);
            const bf16_t* S = prod == 0 ? RBUF(0) : prod == 1 ? RBUF(0) : prod == 2 ? RBUF(2) : RBUF(3);
            bf16_t* O = prod == 0 ? RBUF(6) : prod == 1 ? RBUF(7) : prod == 2 ? RBUF(8) : prod == 3 ? RBUF(9) : RBUF(10);
            const int mode = prod < 2 ? 0 : prod == 2 ? 2 : 1;
#pragma unroll
            for (int rep = 0; rep < 2; ++rep) {
                const int tl = wv + 8 * rep, pt = tl >> 2, qt = tl & 3;
                f32x4 acc = zero;
                if (mode == 2 ? pt >= qt : pt <= qt) acc = mm16<64>(F + pt * 16 * LS, LS, S + qt * 16 * LS, LS, zero, lane);
                const int qi = qt * 16 + fr;
#pragma unroll
                for (int e = 0; e < 4; ++e) {
                    const int pi = pt * 16 + fq * 4 + e;
                    const bool keep = mode == 0 ? pi < qi : (mode == 1 ? pi <= qi : qi < pi);
                    acc[e] = keep ? acc[e] : 0.f;
                }
                *(u32x2*)(O + qi * LS + pt * 16 + fq * 4) = pk4(acc);
            }
        }
        __syncthreads();
        f32x4 X[4];
        if (wv < 4) {
#pragma unroll
            for (int pt = 0; pt < 4; ++pt) X[pt] = up4(*(const u32x2*)(Xt0 + (wv * 16 + fr) * LS + pt * 16 + fq * 4));
        } else {
#pragma unroll
            for (int pt = 0; pt < 4; ++pt) {
                X[pt] = mm16<64>(RBUF(6) + pt * 16 * LS, LS, RBUF(13) + (wv - 4) * 16 * LS, LS, zero, lane);
                *(u32x2*)(Xt0 + (wv * 16 + fr) * LS + pt * 16 + fq * 4) = pk4(X[pt]);
            }
        }
        __syncthreads();
#pragma unroll
        for (int k = 0; k < 6; ++k) {
            const bf16_t* Mk = (k & 1) ? RBUF(0) : RBUF(7);
            const bf16_t* Mkt = (k & 1) ? RBUF(6) : RBUF(8);
            bf16_t* Mn = (k & 1) ? RBUF(7) : RBUF(0);
            bf16_t* Mnt = (k & 1) ? RBUF(8) : RBUF(6);
            const bf16_t* Xc = (k & 1) ? Xt1 : Xt0;
            bf16_t* Xn = (k & 1) ? Xt0 : Xt1;
#pragma unroll
            for (int pt = 0; pt < 4; ++pt) {
                constexpr int dummy = 0; (void)dummy;
                const int maxj = 16 * pt + 15 - (1 << k);
                if (maxj >= 0) {
                    const int nks = maxj / 32 + 1;
#pragma unroll
                    for (int ks = 0; ks < 2; ++ks)
                        if (ks < nks) {
                            const bf16x8 f = *(const bf16x8*)(Mk + (pt * 16 + fr) * LS + ks * 32 + fq * 8);
                            const bf16x8 g = *(const bf16x8*)(Xc + (wv * 16 + fr) * LS + ks * 32 + fq * 8);
                            X[pt] = __builtin_amdgcn_mfma_f32_16x16x32_bf16(f, g, X[pt], 0, 0, 0);
                        }
                }
                *(u32x2*)(Xn + (wv * 16 + fr) * LS + pt * 16 + fq * 4) = pk4(X[pt]);
            }
            if (k < 5) {
#pragma unroll
                for (int which = 0; which < 2; ++which) {
                    const bf16_t* F = which ? Mk : Mkt; const bf16_t* S = which ? Mkt : Mk; bf16_t* O = which ? Mnt : Mn;
#pragma unroll
                    for (int rep = 0; rep < 2; ++rep) {
                        const int t2 = wv + 8 * rep, pt = t2 >> 2, qt = t2 & 3;
                        const int it = which ? pt : qt, jt = which ? qt : pt;
                        f32x4 acc = zero;
                        const int mlo = 16 * jt + (1 << k), mhi = 16 * it + 15 - (1 << k);
                        if (16 * it + 15 - 16 * jt >= (2 << k) && mhi >= mlo) {
                            const int k0 = mlo >> 5, k1 = mhi >> 5;
                            for (int ks = k0; ks <= k1; ++ks) {
                                const bf16x8 f = *(const bf16x8*)(F + (pt * 16 + fr) * LS + ks * 32 + fq * 8);
                                const bf16x8 g = *(const bf16x8*)(S + (qt * 16 + fr) * LS + ks * 32 + fq * 8);
                                acc = __builtin_amdgcn_mfma_f32_16x16x32_bf16(f, g, acc, 0, 0, 0);
                            }
                        }
                        *(u32x2*)(O + (qt * 16 + fr) * LS + pt * 16 + fq * 4) = pk4(acc);
                    }
                }
            }
            __syncthreads();
        }
#pragma unroll
        for (int rep = 0; rep < 2; ++rep) {
            const int tl = wv + 8 * rep, pt = tl >> 2, qt = tl & 3;
            const int pi0 = pt * 16 + fq * 4, qi = qt * 16 + fr;
            const size_t go = ((size_t)u * 64 + qi) * 64 + pi0;
            {
                f32x4 acc = mm16<64>(Xt0 + pt * 16 * LS, LS, RBUF(12) + qt * 16 * LS, LS, zero, lane);
                const float gc = gammaC[qi];
#pragma unroll
                for (int e = 0; e < 4; ++e) acc[e] = (acc[e] + (pi0 + e == qi ? 1.f : 0.f)) * gc;
                {
                    const size_t d = (((size_t)u * 8 + (qi >> 5) * 4 + (pi0 >> 4)) * 64 + (qi & 31) + 32 * ((pi0 >> 2) & 1)) * 8 + ((pi0 >> 3) & 1) * 4;
                    *(u32x2*)(p.PcG + d) = pk4(acc);
                }
            }
            {
                f32x4 acc = mm16<64>(RBUF(11) + pt * 16 * LS, LS, RBUF(13) + qt * 16 * LS, LS, zero, lane);
                acc = mm16<64>(RBUF(12) + pt * 16 * LS, LS, Xt0 + (64 + qt * 16) * LS, LS, acc, lane);
                const f32x4 gc = *(const f32x4*)(gammaC + pi0);
#pragma unroll
                for (int e = 0; e < 4; ++e) acc[e] *= gc[e];
                {
                    const int kk = pi0 & 31;
                    const size_t d = (((size_t)u * 4 + (qi >> 5) * 2 + (pi0 >> 5)) * 64 + (qi & 31) + 32 * ((kk >> 2) & 1)) * 16 + (kk >> 3) * 4;
                    *(u32x2*)(p.QcG + d) = pk4(acc);
                }
            }
            {
                f32x4 acc = mm16<64>(Xt0 + pt * 16 * LS, LS, RBUF(10) + qt * 16 * LS, LS, zero, lane);
                const f32x4 rr = up4(*(const u32x2*)(RBUF(3) + qi * LS + pi0));
#pragma unroll
                for (int e = 0; e < 4; ++e) acc[e] += rr[e];
                *(u32x2*)(p.RhG + go) = pk4(acc);
            }
            {
                f32x4 acc = mm16<64>(RBUF(13) + pt * 16 * LS, LS, RBUF(9) + qt * 16 * LS, LS, zero, lane);
                acc = mm16<64>(Xt0 + (64 + pt * 16) * LS, LS, RBUF(10) + qt * 16 * LS, LS, acc, lane);
                *(u32x2*)(p.Y0G + go) = pk4(acc);
            }
        }
    }
}

struct R2Set { u32x4 a[8]; u32x4 q[4]; };
DI void r2_load(R2Set& st, const Params& p, size_t u, int lane, int vh) {
#pragma unroll
    for (int kt = 0; kt < 2; ++kt) {
        const bf16_t* qg = p.QcG + ((u * 4 + vh * 2 + kt) * 64 + lane) * 16;
        st.q[kt * 2] = *(const u32x4*)qg; st.q[kt * 2 + 1] = *(const u32x4*)(qg + 8);
    }
#pragma unroll
    for (int f = 0; f < 8; ++f) st.a[f] = *(const u32x4*)(p.PcG + ((u * 8 + f) * 64 + lane) * 8);
}
DI void r2_step(f32x16 (&S)[2], const R2Set& st, const Params& p, size_t u, int lane, int vh, bool last) {
#pragma unroll
    for (int kt = 0; kt < 2; ++kt) {
        bf16_t* sg = p.SG + ((u * 4 + vh * 2 + kt) * 64 + lane) * 16;
        *(u32x4*)sg = (u32x4){pack2(S[kt][0], S[kt][1]), pack2(S[kt][2], S[kt][3]), pack2(S[kt][4], S[kt][5]), pack2(S[kt][6], S[kt][7])};
        *(u32x4*)(sg + 8) = (u32x4){pack2(S[kt][8], S[kt][9]), pack2(S[kt][10], S[kt][11]), pack2(S[kt][12], S[kt][13]), pack2(S[kt][14], S[kt][15])};
    }
    if (last) return;
    bf16x8 bfr[4];
#pragma unroll
    for (int ts = 0; ts < 4; ++ts) {
        const int tl = ts >> 1, sp = ts & 1;
        const u32x4 pk = (u32x4){pack2(S[tl][8 * sp], S[tl][8 * sp + 1]), pack2(S[tl][8 * sp + 2], S[tl][8 * sp + 3]),
                                 pack2(S[tl][8 * sp + 4], S[tl][8 * sp + 5]), pack2(S[tl][8 * sp + 6], S[tl][8 * sp + 7])};
        bfr[ts] = __builtin_bit_cast(bf16x8, pk);
    }
#pragma unroll
    for (int kt = 0; kt < 2; ++kt)
#pragma unroll
        for (int hf = 0; hf < 2; ++hf)
#pragma unroll
            for (int w = 0; w < 4; ++w) { S[kt][8 * hf + 2 * w] = lo_bf(st.q[kt * 2 + hf][w]); S[kt][8 * hf + 2 * w + 1] = hi_bf(st.q[kt * 2 + hf][w]); }
#pragma unroll
    for (int ts = 0; ts < 4; ++ts)
#pragma unroll
        for (int kt = 0; kt < 2; ++kt)
            S[kt] = __builtin_amdgcn_mfma_f32_32x32x16_bf16(__builtin_bit_cast(bf16x8, st.a[kt * 4 + ts]), bfr[ts], S[kt], 0, 0, 0);
}
DI void phase_rwkv_r2(const Params& p, int chain) {
    const int lane = tid_() & 63, wv = __builtin_amdgcn_readfirstlane(tid_() >> 6);
    if (wv != 0) return;
    const int bh = chain >> 1, vh = chain & 1;
    const size_t u0 = (size_t)bh * NCHUNK;
    f32x16 S[2];
#pragma unroll
    for (int e = 0; e < 16; ++e) { S[0][e] = 0.f; S[1][e] = 0.f; }
    R2Set A, B;
    r2_load(A, p, u0, lane, vh);
    r2_load(B, p, u0 + 1, lane, vh);
#pragma unroll 1
    for (int c = 0; c < NCHUNK; c += 2) {
        r2_step(S, A, p, u0 + c, lane, vh, c == NCHUNK - 1);
        if (c == NCHUNK - 1) break;
        if (c + 2 < NCHUNK - 1) r2_load(A, p, u0 + c + 2, lane, vh);
        r2_step(S, B, p, u0 + c + 1, lane, vh, false);
        if (c + 3 < NCHUNK - 1) r2_load(B, p, u0 + c + 3, lane, vh);
    }
}

DI void phase_rwkv_r3(const Params& p, int layer, int bid, int nb) {
    const int tid = tid_(), lane = tid & 63, wv = __builtin_amdgcn_readfirstlane(tid >> 6), fr = lane & 15, fq = lane >> 4;
    for (int task = bid * 8 + wv; task < NUNIT * 4; task += nb * 8) {
        const int u = task >> 2, it = task & 3;
        const int c = u % NCHUNK, bh = u / NCHUNK, h = bh % HEADS, bb = bh / HEADS;
        const int i = it * 16 + fr, t = c * 64 + i;
        const bool live = t < L;
        const size_t tok = (size_t)bb * L + (live ? t : 0);
        bf16x8 sf[2];
#pragma unroll
        for (int ks = 0; ks < 2; ++ks) sf[ks] = *(const bf16x8*)(p.RhG + ((size_t)u * 64 + i) * 64 + ks * 32 + fq * 8);
        u32x2 s0[4][2], s1[4][2], y0[4], xvv[4], gv[4];
#pragma unroll
        for (int vt = 0; vt < 4; ++vt) {
            const int vv = vt * 16 + fr;
#pragma unroll
            for (int ks = 0; ks < 2; ++ks) {
                const bf16_t* sp = p.SG + (((size_t)u * 4 + (vv >> 5) * 2 + ks) * 64 + (vv & 31)) * 16 + 4 * fq;
                s0[vt][ks] = *(const u32x2*)sp; s1[vt][ks] = *(const u32x2*)(sp + 32 * 16);
            }
            y0[vt] = *(const u32x2*)(p.Y0G + ((size_t)u * 64 + i) * 64 + vt * 16 + fq * 4);
            xvv[vt] = *(const u32x2*)(p.orw + tok * 512 + h * 64 + vt * 16 + fq * 4);
            gv[vt] = *(const u32x2*)(p.GG + ((size_t)u * 64 + i) * 64 + vt * 16 + fq * 4);
        }
        const float bon = p.bonG[(size_t)u * 64 + i];
        f32x4 y[4];
#pragma unroll
        for (int vt = 0; vt < 4; ++vt) {
            y[vt] = up4(y0[vt]);
#pragma unroll
            for (int ks = 0; ks < 2; ++ks) {
                const bf16x8 f = __builtin_bit_cast(bf16x8, ((u32x4){s0[vt][ks][0], s0[vt][ks][1], s1[vt][ks][0], s1[vt][ks][1]}));
                y[vt] = __builtin_amdgcn_mfma_f32_16x16x32_bf16(f, sf[ks], y[vt], 0, 0, 0);
            }
        }
        float s = 0.f;
#pragma unroll
        for (int vt = 0; vt < 4; ++vt) s += (y[vt][0] + y[vt][1]) + (y[vt][2] + y[vt][3]);
        s += __shfl_xor(s, 16); s += __shfl_xor(s, 32);
        const float mean = s * (1.0f / 64.f);
        float q = 0.f;
#pragma unroll
        for (int vt = 0; vt < 4; ++vt)
#pragma unroll
            for (int e = 0; e < 4; ++e) { y[vt][e] -= mean; q += y[vt][e] * y[vt][e]; }
        q += __shfl_xor(q, 16); q += __shfl_xor(q, 32);
        const float rstd = rsqrtf(q * (1.0f / 64.f) + 64e-5f);
        if (live) {
#pragma unroll
            for (int vt = 0; vt < 4; ++vt) {
                const int cg = h * 64 + vt * 16 + fq * 4;
                const f32x4 xv = up4(xvv[vt]), g = up4(gv[vt]);
                const f32x4 lg = *(const f32x4*)(p.lnx_g + layer * 512 + cg), lb = *(const f32x4*)(p.lnx_b + layer * 512 + cg);
                f32x4 o;
#pragma unroll
                for (int e = 0; e < 4; ++e) o[e] = (y[vt][e] * rstd * lg[e] + lb[e] + bon * xv[e]) * g[e];
                *(u32x2*)(p.orw + tok * 512 + cg) = pk4(o);
            }
        }
    }
}

constexpr int SB_LDS = 4 * RB + 64;
DI void phase_sb(const Params& p, int bid0, int nb, char* smem) {
    const int tid = tid_(), lane = tid & 63, wv = __builtin_amdgcn_readfirstlane(tid >> 6), fr = lane & 15, fq = lane >> 4;
    bf16_t* Ks0 = (bf16_t*)smem;
    bf16_t* Vt0 = Ks0 + 2 * 64 * LS;
    int* flags = (int*)(smem + 4 * RB);
    bf16x8 tri[4][2];
#pragma unroll
    for (int st = 0; st < 4; ++st)
#pragma unroll
        for (int k2 = 0; k2 < 2; ++k2)
#pragma unroll
            for (int jj = 0; jj < 8; ++jj) tri[st][k2][jj] = (32 * k2 + 16 * (jj >> 2) + 4 * fq + (jj & 3) > 16 * st + fr) ? (short)0x3F80 : (short)0;
    constexpr int NQB = (L + 127) / 128;
    const int ldkey = tid >> 3, lddc = (tid & 7) * 8;
    for (int u = bid0; u < NBATCH * HEADS * NQB; u += nb) {
        const int bh = u % (NBATCH * HEADS), b = bh / HEADS, h = bh % HEADS, q0 = (u / (NBATCH * HEADS)) * 128;
        const int qlo = q0 + 16 * wv, query = qlo + fr;
        const size_t tokb = (size_t)b * L;
        bf16x8 qf[2];
#pragma unroll
        for (int ks = 0; ks < 2; ++ks) qf[ks] = *(const bf16x8*)(p.P + (tokb + query) * CP + OFF_Q + h * 64 + ks * 32 + fq * 8);
        const int qmax = (q0 + 127 < L - 1) ? q0 + 127 : L - 1;
        int kt = (qmax - 1) >> 6;
        float R = 0.f;
        f32x4 ot[4];
#pragma unroll
        for (int dt = 0; dt < 4; ++dt) ot[dt] = (f32x4){0.f, 0.f, 0.f, 0.f};
        bool done = qlo >= L;
        u32x4 kreg, vreg;
        {
            const int s = kt * 64 + ldkey;
            const bf16_t* src = p.P + (tokb + s) * CP + h * 64 + lddc;
            kreg = s < L ? *(const u32x4*)(src + OFF_K) : (u32x4){0u, 0u, 0u, 0u};
            vreg = s < L ? *(const u32x4*)(src + OFF_V) : (u32x4){0u, 0u, 0u, 0u};
        }
        const int vsw = (tid & 7) << 2;
        __syncthreads();
        {
            *(u32x4*)(Ks0 + ldkey * LS + lddc) = kreg;
#pragma unroll
            for (int j = 0; j < 4; ++j) { Vt0[(lddc + 2 * j) * LS + (ldkey ^ vsw)] = (bf16_t)(vreg[j] & 0xFFFFu); Vt0[(lddc + 2 * j + 1) * LS + (ldkey ^ vsw)] = (bf16_t)(vreg[j] >> 16); }
        }
        __syncthreads();
        for (int itile = 0;; ++itile) {
            const bf16_t* Ks = Ks0 + (itile & 1) * 64 * LS; const bf16_t* Vt = Vt0 + (itile & 1) * 64 * LS;
            if (kt > 0) {
                const int s = (kt - 1) * 64 + ldkey;
                const bf16_t* src = p.P + (tokb + s) * CP + h * 64 + lddc;
                kreg = *(const u32x4*)(src + OFF_K); vreg = *(const u32x4*)(src + OFF_V);
            }
            if (!done && kt * 64 < qlo + 15) {
                f32x4 uu[4], lsp[4];
                float tot = 0.f;
#pragma unroll
                for (int kk = 0; kk < 4; ++kk) {
                    f32x4 z = (f32x4){0.f, 0.f, 0.f, 0.f};
#pragma unroll
                    for (int ks = 0; ks < 2; ++ks) {
                        const bf16x8 f = *(const bf16x8*)(Ks + (16 * kk + fr) * LS + ks * 32 + fq * 8);
                        z = __builtin_amdgcn_mfma_f32_16x16x32_bf16(f, qf[ks], z, 0, 0, 0);
                    }
#pragma unroll
                    for (int e = 0; e < 4; ++e) {
                        const float zz = z[e] * 0.125f;
                        const float lsneg = -(fmaxf(zz, 0.f) + __logf(1.0f + __expf(-fabsf(zz))));
                        const bool valid = kt * 64 + 16 * kk + 4 * fq + e < query;
                        uu[kk][e] = valid ? lsneg : 0.f;
                        lsp[kk][e] = valid ? lsneg + zz : -1.0e30f;
                        tot += uu[kk][e];
                    }
                }
                tot += __shfl_xor(tot, 16); tot += __shfl_xor(tot, 32);
                f32x4 rest[4];
#pragma unroll
                for (int st = 0; st < 4; ++st) rest[st] = (f32x4){0.f, 0.f, 0.f, 0.f};
#pragma unroll
                for (int k2 = 0; k2 < 2; ++k2) {
                    u32x4 hi, lo;
#pragma unroll
                    for (int t2 = 0; t2 < 2; ++t2) {
                        const f32x4 a = uu[2 * k2 + t2];
                        const unsigned h0 = pack2(a[0], a[1]), h1 = pack2(a[2], a[3]);
                        hi[2 * t2] = h0; hi[2 * t2 + 1] = h1;
                        lo[2 * t2] = pack2(a[0] - lo_bf(h0), a[1] - hi_bf(h0)); lo[2 * t2 + 1] = pack2(a[2] - lo_bf(h1), a[3] - hi_bf(h1));
                    }
                    const bf16x8 fh = __builtin_bit_cast(bf16x8, hi), fl = __builtin_bit_cast(bf16x8, lo);
#pragma unroll
                    for (int st = 0; st < 4; ++st) {
                        rest[st] = __builtin_amdgcn_mfma_f32_16x16x32_bf16(tri[st][k2], fh, rest[st], 0, 0, 0);
                        rest[st] = __builtin_amdgcn_mfma_f32_16x16x32_bf16(tri[st][k2], fl, rest[st], 0, 0, 0);
                    }
                }
                bf16x8 af[2];
#pragma unroll
                for (int k2 = 0; k2 < 2; ++k2) {
                    u32x4 pk;
#pragma unroll
                    for (int t2 = 0; t2 < 2; ++t2) {
                        const int kk = 2 * k2 + t2;
                        float a4[4];
#pragma unroll
                        for (int e = 0; e < 4; ++e) a4[e] = __expf(lsp[kk][e] + R + rest[kk][e]);
                        pk[2 * t2] = pack2(a4[0], a4[1]); pk[2 * t2 + 1] = pack2(a4[2], a4[3]);
                    }
                    af[k2] = __builtin_bit_cast(bf16x8, pk);
                }
                R += tot;
#pragma unroll
                for (int dt = 0; dt < 4; ++dt)
#pragma unroll
                    for (int k2 = 0; k2 < 2; ++k2) {
                        const int dsw = ((2 * dt + (fr >> 3)) & 7) << 2;
                        const bf16_t* vrow = Vt + (16 * dt + fr) * LS;
                        const u32x2 v0 = *(const u32x2*)(vrow + ((32 * k2 + 4 * fq) ^ dsw)), v1 = *(const u32x2*)(vrow + ((32 * k2 + 16 + 4 * fq) ^ dsw));
                        const bf16x8 f = __builtin_bit_cast(bf16x8, ((u32x4){v0[0], v0[1], v1[0], v1[1]}));
                        ot[dt] = __builtin_amdgcn_mfma_f32_16x16x32_bf16(f, af[k2], ot[dt], 0, 0, 0);
                    }
                done = __all((R < -104.0f) || (query >= L));
            }
            if (kt > 0) {
                bf16_t* Kn = Ks0 + ((itile & 1) ^ 1) * 64 * LS; bf16_t* Vn = Vt0 + ((itile & 1) ^ 1) * 64 * LS;
                *(u32x4*)(Kn + ldkey * LS + lddc) = kreg;
#pragma unroll
                for (int j = 0; j < 4; ++j) { Vn[(lddc + 2 * j) * LS + (ldkey ^ vsw)] = (bf16_t)(vreg[j] & 0xFFFFu); Vn[(lddc + 2 * j + 1) * LS + (ldkey ^ vsw)] = (bf16_t)(vreg[j] >> 16); }
            }
            if (lane == 0) flags[(itile & 1) * 8 + wv] = done ? 1 : 0;
            __syncthreads();
            int alld = 1;
#pragma unroll
            for (int w = 0; w < 8; ++w) alld &= flags[(itile & 1) * 8 + w];
            if (alld || kt == 0) break;
            --kt;
        }
        if (query < L) {
#pragma unroll
            for (int dt = 0; dt < 4; ++dt) *(u32x2*)(p.osb + (tokb + query) * 512 + h * 64 + 16 * dt + 4 * fq) = pk4(ot[dt]);
        }
    }
}

struct EpiBranch {
    static constexpr bool PERM = true;
    const bf16_t* G; bf16_t* M; bool add;
    DI void operator()(const f32x4 (&acc)[2][2][4][2], const g8::Unit& u, int wr, int wc, int fr, int fq) const {
        const int c0 = u.pn * 256 + wc * 32 + 8 * fq;
#pragma unroll
        for (int ai = 0; ai < 2; ++ai) {
            u32x4 g[4][2], mo[4][2];
#pragma unroll
            for (int m = 0; m < 4; ++m)
#pragma unroll
                for (int bj = 0; bj < 2; ++bj) {
                    const size_t r = (size_t)(u.pm * 256 + ai * 128 + wr * 64 + m * 16 + fr);
                    g[m][bj] = *(const u32x4*)(G + r * 2048 + c0 + bj * 128);
                    mo[m][bj] = add ? *(const u32x4*)(M + r * D + c0 + bj * 128) : (u32x4){0u, 0u, 0u, 0u};
                }
#pragma unroll
            for (int m = 0; m < 4; ++m)
#pragma unroll
                for (int bj = 0; bj < 2; ++bj) {
                    const size_t r = (size_t)(u.pm * 256 + ai * 128 + wr * 64 + m * 16 + fr);
                    const f32x4 v0 = acc[ai][bj][m][0], v1 = acc[ai][bj][m][1];
                    const u32x4 gg = g[m][bj], mm = mo[m][bj];
                    float o[8] = {lo_bf(gg[0]) * v0[0], hi_bf(gg[0]) * v0[1], lo_bf(gg[1]) * v0[2], hi_bf(gg[1]) * v0[3], lo_bf(gg[2]) * v1[0], hi_bf(gg[2]) * v1[1], lo_bf(gg[3]) * v1[2], hi_bf(gg[3]) * v1[3]};
#pragma unroll
                    for (int q = 0; q < 4; ++q) { o[2 * q] += lo_bf(mm[q]); o[2 * q + 1] += hi_bf(mm[q]); }
                    *(u32x4*)(M + r * D + c0 + bj * 128) = (u32x4){pack2(o[0], o[1]), pack2(o[2], o[3]), pack2(o[4], o[5]), pack2(o[6], o[7])};
                }
        }
    }
};
struct GateOrder {
    g8::DenseOrder d;
    DI bool next(int i, g8::Unit& u) const { return d.next(i, u); }
    DI unsigned row_off(const g8::Unit&, int) const { return 0u; }
};
struct EpiGate {
    static constexpr bool PERM = true;
    bf16_t* G;
    DI void operator()(const f32x4 (&acc)[2][2][4][2], const g8::Unit& u, int wr, int wc, int fr, int fq) const {
#pragma unroll
        for (int ai = 0; ai < 2; ++ai)
#pragma unroll
            for (int m = 0; m < 4; ++m) {
                bf16_t* rowp = G + (size_t)(u.pm * 256 + ai * 128 + wr * 64 + m * 16 + fr) * 2048 + u.pn * 256 + wc * 32 + 8 * fq;
#pragma unroll
                for (int bj = 0; bj < 2; ++bj) {
                    const f32x4 v0 = acc[ai][bj][m][0], v1 = acc[ai][bj][m][1];
                    *(u32x4*)(rowp + bj * 128) = (u32x4){pack2(sigmoidf_(v0[0]), sigmoidf_(v0[1])), pack2(sigmoidf_(v0[2]), sigmoidf_(v0[3])), pack2(sigmoidf_(v1[0]), sigmoidf_(v1[1])), pack2(sigmoidf_(v1[2]), sigmoidf_(v1[3]))};
                }
            }
    }
};
template <int PART> DI void phase_merge(const Params& p, int layer, int bid, int nb, char* smem) {
    const bf16_t* hb = p.hb; bf16_t* G = p.gates; bf16_t* M = p.merged;
    const bf16_t* Wg = p.WtIn + ((size_t)layer * CIN + CP) * D;
    G8_LAS unsigned char* lds = (G8_LAS unsigned char*)smem;
    if (PART == 0) {
#pragma unroll
    for (int which = 0; which < 2; ++which) {
        g8::DenseOrder S; S.init(hb, Wg + (size_t)which * 1024 * D, MFULL, D / 256, D, nb, bid);
        g8::gemm8<false>(lds, D, S, EpiGate{G + which * 1024});
    }
    }
    if (PART == 1) {
#pragma unroll
    for (int which = 0; which < 2; ++which) {
        const bf16_t* A = which ? p.orw : p.osb;
        const bf16_t* Bt = (which ? p.WtPrw : p.WtPsb) + (size_t)layer * D * 512;
        g8::DenseOrder S; S.init(A, Bt, MFULL, D / 256, 512, nb, bid);
        g8::gemm8<false>(lds, 512, S, EpiBranch{G + which * 1024, M, which != 0});
    }
    }
    if (PART == 1)
    for (int t = left_first(MFULL * 4 * 2, bid, nb); t < D / 128; t += nb) {
#pragma unroll
        for (int which = 0; which < 2; ++which) {
            const bf16_t* A = which ? p.orw : p.osb; const bf16_t* Gw = p.gleft - (size_t)M0_LEFT * 2048 + which * 1024;
            const bf16_t* Bt = (which ? p.WtPrw : p.WtPsb) + (size_t)layer * D * 512;
            gemm_left32([=](int r) { return A + (size_t)(M0_LEFT + r) * 512; }, Bt, 512, 512, t * 128, smem,
                        [=](int r0, int c, f32x4 v) {
                            const size_t r = (size_t)(M0_LEFT + r0);
                            const u32x2 g = *(const u32x2*)(Gw + r * 2048 + c);
                            float o0 = lo_bf(g[0]) * v[0], o1 = hi_bf(g[0]) * v[1], o2 = lo_bf(g[1]) * v[2], o3 = hi_bf(g[1]) * v[3];
                            u32x2* mp = (u32x2*)(M + r * D + c);
                            if (which) { const u32x2 m = *mp; o0 += lo_bf(m[0]); o1 += hi_bf(m[0]); o2 += lo_bf(m[1]); o3 += hi_bf(m[1]); }
                            *mp = (u32x2){pack2(o0, o1), pack2(o2, o3)};
                        });
        }
    }
}
struct EpiOut {
    static constexpr bool PERM = false;
    float* hmeta; float* out; const bf16_t* hb;
    DI void operator()(const f32x4 (&acc)[2][2][4][2], const g8::Unit& u, int wr, int wc, int fr, int fq) const {
        const int c0 = u.pn * 256 + wc * 32 + 4 * fq;
#pragma unroll
        for (int ai = 0; ai < 2; ++ai) {
            u32x2 hv[4][2][2];
#pragma unroll
            for (int m = 0; m < 4; ++m) {
                const bf16_t* hbp = hb + (size_t)(u.pm * 256 + ai * 128 + wr * 64 + m * 16 + fr) * D + c0;
#pragma unroll
                for (int bj = 0; bj < 2; ++bj)
#pragma unroll
                    for (int n = 0; n < 2; ++n) hv[m][bj][n] = *(const u32x2*)(hbp + bj * 128 + n * 16);
            }
#pragma unroll
            for (int m = 0; m < 4; ++m) {
                float* rowp = hrow2(hmeta, out, u.pm * 256 + ai * 128 + wr * 64 + m * 16 + fr) + c0;
#pragma unroll
                for (int bj = 0; bj < 2; ++bj)
#pragma unroll
                    for (int n = 0; n < 2; ++n) {
                        const f32x4 h = up4(hv[m][bj][n]), v = acc[ai][bj][m][n];
                        *(f32x4*)(rowp + bj * 128 + n * 16) = (f32x4){ALPHA * h[0] + v[0], ALPHA * h[1] + v[1], ALPHA * h[2] + v[2], ALPHA * h[3] + v[3]};
                    }
            }
        }
    }
};
DI void phase_outproj(const Params& p, int layer, int bid, int nb, char* smem) {
    const bf16_t* A = p.merged; float* const hmeta = p.hmeta; float* const outp = p.out; const bf16_t* hbres = p.hb;
    const bf16_t* Bt = p.WtOut + (size_t)layer * D * D;
    if (bid == 0 && tid_() < NE) p.counts[tid_()] = 0;
    g8::DenseOrder S; S.init(A, Bt, MFULL, D / 256, D, nb, bid);
    g8::gemm8<false>((G8_LAS unsigned char*)smem, D, S, EpiOut{hmeta, outp, hbres});
    for (int t = left_first(MFULL * 4, bid, nb); t < D / 128; t += nb)
        gemm_left32([=](int r) { return A + (size_t)(M0_LEFT + r) * D; }, Bt, D, D, t * 128, smem,
                    [=](int r0, int c, f32x4 v) {
                        const int r = M0_LEFT + r0;
                        const f32x4 h = up4(*(const u32x2*)(hbres + (size_t)r * D + c));
                        *(f32x4*)(hrow2(hmeta, outp, r) + c) = (f32x4){ALPHA * h[0] + v[0], ALPHA * h[1] + v[1], ALPHA * h[2] + v[2], ALPHA * h[3] + v[3]};
                    });
}

constexpr int LN1_ROWB = 2 * D + 16;
constexpr int LN1_WAVE = 8 * LN1_ROWB;
constexpr int LN1_LDS = 8 * LN1_WAVE + 2048;
DI void phase_ln1_router(const Params& p, int layer, int bid, int nb, char* smem) {
    const int tid = tid_(), lane = tid & 63, wid = __builtin_amdgcn_readfirstlane(tid >> 6), fr = lane & 15, fq = lane >> 4;
    char* wl = smem + wid * LN1_WAVE;
    int* sel = (int*)(smem + 8 * LN1_WAVE);
    float* sgt = (float*)(smem + 8 * LN1_WAVE + 640);
    int* sbase = (int*)(smem + 8 * LN1_WAVE + 1280);
    const int nwaves = nb * 8, gw = bid * 8 + wid;
    const int base_n = T / nwaves, extra = T % nwaves;
    const int tok0 = gw * base_n + (gw < extra ? gw : extra), ntok = base_n + (gw < extra ? 1 : 0);
    const int btok0 = bid * 8 * base_n + (bid * 8 < extra ? bid * 8 : extra);
    const float* g1p = p.ln1_g + layer * D; const float* b1p = p.ln1_b + layer * D;
    __syncthreads();
    for (int g0 = 0; g0 < ntok; g0 += 4) {
        const int ng = ntok - g0 < 4 ? ntok - g0 : 4;
        float vn[16];
        { const float* hf = hrow_u(p, tok0 + g0);
#pragma unroll
          for (int j = 0; j < 4; ++j) { const f32x4 a = *(const f32x4*)(hf + 256 * j + 4 * lane); vn[4 * j] = a[0]; vn[4 * j + 1] = a[1]; vn[4 * j + 2] = a[2]; vn[4 * j + 3] = a[3]; } }
#pragma unroll 1
        for (int i = 0; i < ng; ++i) {
            const int tok = tok0 + g0 + i;
            float v[16];
#pragma unroll
            for (int q = 0; q < 16; ++q) v[q] = vn[q];
            if (i + 1 < ng) { const float* hn = hrow_u(p, tok + 1);
#pragma unroll
                for (int j = 0; j < 4; ++j) { const f32x4 a = *(const f32x4*)(hn + 256 * j + 4 * lane); vn[4 * j] = a[0]; vn[4 * j + 1] = a[1]; vn[4 * j + 2] = a[2]; vn[4 * j + 3] = a[3]; } }
            ln16(v, g1p, b1p, lane);
#pragma unroll
            for (int j = 0; j < 4; ++j) {
                const unsigned h0 = pack2(v[4 * j], v[4 * j + 1]), h1 = pack2(v[4 * j + 2], v[4 * j + 3]);
                *(u32x2*)(p.hb + (size_t)tok * D + 256 * j + 4 * lane) = (u32x2){h0, h1};
                *(u32x2*)(wl + i * LN1_ROWB + (256 * j + 4 * lane) * 2) = (u32x2){h0, h1};
                *(u32x2*)(wl + (4 + i) * LN1_ROWB + (256 * j + 4 * lane) * 2) = (u32x2){pack2(v[4 * j] - lo_bf(h0), v[4 * j + 1] - hi_bf(h0)), pack2(v[4 * j + 2] - lo_bf(h1), v[4 * j + 3] - hi_bf(h1))};
            }
        }
        asm volatile("s_waitcnt lgkmcnt(0)" ::: "memory");
        __builtin_amdgcn_wave_barrier();
        f32x4 acc = (f32x4){0.f, 0.f, 0.f, 0.f};
        const char* arow = wl + (fr & 3) * LN1_ROWB + fq * 16;
        const bf16_t* whi = p.RwHi + (size_t)fr * D + fq * 8; const bf16_t* wlo = p.RwLo + (size_t)fr * D + fq * 8;
#pragma unroll 4
        for (int ks = 0; ks < 32; ++ks) {
            const bf16x8 ah = *(const bf16x8*)(arow + ks * 64), al = *(const bf16x8*)(arow + 4 * LN1_ROWB + ks * 64);
            const bf16x8 bh = *(const bf16x8*)(whi + ks * 32), bl = *(const bf16x8*)(wlo + ks * 32);
            acc = __builtin_amdgcn_mfma_f32_16x16x32_bf16(bh, ah, acc, 0, 0, 0);
            acc = __builtin_amdgcn_mfma_f32_16x16x32_bf16(bh, al, acc, 0, 0, 0);
            acc = __builtin_amdgcn_mfma_f32_16x16x32_bf16(bl, ah, acc, 0, 0, 0);
        }
        float lg[4]; float mx = -3.0e38f;
#pragma unroll
        for (int e = 0; e < 4; ++e) { lg[e] = acc[e] + p.router_b[4 * fq + e]; mx = fmaxf(mx, lg[e]); }
        mx = fmaxf(mx, __shfl_xor(mx, 16)); mx = fmaxf(mx, __shfl_xor(mx, 32));
        float sum = 0.f;
#pragma unroll
        for (int e = 0; e < 4; ++e) { lg[e] = __expf(lg[e] - mx); sum += lg[e]; }
        sum += __shfl_xor(sum, 16); sum += __shfl_xor(sum, 32);
        const float inv = 1.0f / sum;
        float v1 = -1.f, v2 = -1.f; int i1 = 0, i2 = 0;
#pragma unroll
        for (int e = 0; e < 4; ++e) {
            const float pv = lg[e] * inv;
            if (pv > v1) { v2 = v1; i2 = i1; v1 = pv; i1 = e; } else if (pv > v2) { v2 = pv; i2 = e; }
        }
        const float sc = v1 + v2;
        float bsc = sc; int bg = fq;
#pragma unroll
        for (int m = 16; m <= 32; m <<= 1) {
            const float os = __shfl_xor(bsc, m); const int og = __shfl_xor(bg, m);
            if (os > bsc || (os == bsc && og < bg)) { bsc = os; bg = og; }
        }
        if (bg == fq && fr < ng) {
            const int li = tok0 + g0 + fr - btok0;
            const float gs = 1.0f / (v1 + v2);
            sel[li * 2] = 4 * fq + i1; sel[li * 2 + 1] = 4 * fq + i2; sgt[li * 2] = v1 * gs; sgt[li * 2 + 1] = v2 * gs;
        }
        asm volatile("s_waitcnt lgkmcnt(0)" ::: "memory");
        __builtin_amdgcn_wave_barrier();
    }
    __syncthreads();
    if (wid == 0) {
        const int nbt = 8 * base_n + ((bid * 8 + 8 <= extra) ? 8 : (bid * 8 < extra ? extra - bid * 8 : 0));
        for (int c0 = 0; c0 < nbt; c0 += 64) {
            const int li = c0 + lane; const bool on = li < nbt;
            const int e1 = on ? sel[li * 2] : -1, e2 = on ? sel[li * 2 + 1] : -1;
            const unsigned long long lt = (1ull << lane) - 1ull;
            int r1 = 0, r2 = 0, mycnt = 0;
#pragma unroll
            for (int e = 0; e < NE; ++e) {
                const unsigned long long m1 = __ballot(e1 == e), m2 = __ballot(e2 == e);
                const int c1 = __popcll(m1), c2 = __popcll(m2);
                if (e1 == e) r1 = __popcll(m1 & lt);
                if (e2 == e) r2 = c1 + __popcll(m2 & lt);
                if (lane == e) mycnt = c1 + c2;
            }
            if (lane < NE) sbase[lane] = mycnt > 0 ? atomicAdd(&p.counts[lane], mycnt) : 0;
            asm volatile("s_waitcnt vmcnt(0) lgkmcnt(0)" ::: "memory");
            __builtin_amdgcn_wave_barrier();
            if (on) {
                const int tok = btok0 + li;
                const int s1 = sbase[e1] + r1, s2 = sbase[e2] + r2;
                p.list[e1 * T + s1] = tok * 2; p.list[e2 * T + s2] = tok * 2 + 1;
                p.tokg[tok * 2] = sgt[li * 2]; p.tokg[tok * 2 + 1] = sgt[li * 2 + 1];
            }
            asm volatile("s_waitcnt lgkmcnt(0)" ::: "memory");
            __builtin_amdgcn_wave_barrier();
        }
    }
}

constexpr int MOE_BIG = 8;
template <bool UP> struct MoeOrder {
    const int* counts; const int* list; int G, c; const char* A; const char* B;
    DI bool next(int i, g8::Unit& u) const {
        const int xcd = c & 7, w = c >> 3, mt = (w >> 1) & 7, pn = 2 * (w & 1) + i, esel = xcd + 8 * (w >> 4);
        if (w >= 32 || i >= 2) return false;
        int padp = 0, fe = -1, fc = 0, fp = 0;
#pragma unroll
        for (int e = 0; e < NE; ++e) {
            const int cn = counts[e], ntp = (cn + 255) >> 8, nt = ntp < MOE_BIG ? ntp : MOE_BIG;
            const bool hit = (e == esel) && (mt < nt);
            fe = hit ? e : fe; fc = hit ? cn : fc; fp = hit ? padp + mt : fp;
            padp += ntp;
        }
        fe = __builtin_amdgcn_readfirstlane(fe); fc = __builtin_amdgcn_readfirstlane(fc); fp = __builtin_amdgcn_readfirstlane(fp);
        if (fe < 0) return false;
        u.e = fe; u.slot0 = mt * 256; u.cnt = fc; u.pm = fp; u.pn = pn;
        u.A = UP ? A : A + (size_t)fp * ((size_t)256 * DE * 2);
        u.B = UP ? B + (size_t)fe * ((size_t)1024 * 1024 * 2) + (size_t)pn * ((size_t)256 * D * 2) : B + (size_t)fe * ((size_t)1024 * 512 * 2) + (size_t)pn * ((size_t)256 * DE * 2);
        return true;
    }
    DI unsigned row_off(const g8::Unit& u, int r) const {
        const __amdgpu_buffer_rsrc_t rs = __builtin_amdgcn_make_buffer_rsrc((void*)list, 0, NE * T * 4, 0x00020000);
        const int ent = __builtin_amdgcn_raw_buffer_load_b32(rs, r * 4, (u.e * T + u.slot0) * 4, 0);
        return u.slot0 + r < u.cnt ? (unsigned)(ent >> 1) * (unsigned)(D * 2) : 0u;
    }
};
struct EpiMoeUp {
    static constexpr bool PERM = true;
    bf16_t* hid;
    DI void operator()(const f32x4 (&acc)[2][2][4][2], const g8::Unit& u, int wr, int wc, int fr, int fq) const {
#pragma unroll
        for (int ai = 0; ai < 2; ++ai)
#pragma unroll
            for (int m = 0; m < 4; ++m) {
                const int r = ai * 128 + wr * 64 + m * 16 + fr;
                if (u.slot0 + r >= u.cnt) continue;
                bf16_t* rowp = hid + ((size_t)u.pm * 256 + r) * DE + ((u.pn * 256 + wc * 32 + 8 * fq) >> 1);
#pragma unroll
                for (int bj = 0; bj < 2; ++bj) {
                    const f32x4 v0 = acc[ai][bj][m][0], v1 = acc[ai][bj][m][1];
                    *(u32x2*)(rowp + bj * 64) = (u32x2){pack2(v0[0] * sigmoidf_(v0[0]) * v0[1], v0[2] * sigmoidf_(v0[2]) * v0[3]), pack2(v1[0] * sigmoidf_(v1[0]) * v1[1], v1[2] * sigmoidf_(v1[2]) * v1[3])};
                }
            }
    }
};
struct EpiMoeDown {
    static constexpr bool PERM = true;
    bf16_t* fo; const int* list; const float* tokg;
    DI void operator()(const f32x4 (&acc)[2][2][4][2], const g8::Unit& u, int wr, int wc, int fr, int fq) const {
        int ent[8]; float g[8];
#pragma unroll
        for (int q = 0; q < 8; ++q) {
            const int sl = u.slot0 + (q >> 2) * 128 + wr * 64 + (q & 3) * 16 + fr;
            ent[q] = sl < u.cnt ? list[u.e * T + sl] : -1;
        }
#pragma unroll
        for (int q = 0; q < 8; ++q) g[q] = ent[q] >= 0 ? tokg[ent[q]] : 0.f;
#pragma unroll
        for (int ai = 0; ai < 2; ++ai)
#pragma unroll
            for (int m = 0; m < 4; ++m) {
                const int q = ai * 4 + m;
                if (ent[q] < 0) continue;
                const float gg = g[q];
                bf16_t* rowp = fo + ((size_t)(ent[q] & 1) * TP + (ent[q] >> 1)) * D + u.pn * 256 + wc * 32 + 8 * fq;
#pragma unroll
                for (int bj = 0; bj < 2; ++bj) {
                    const f32x4 v0 = acc[ai][bj][m][0], v1 = acc[ai][bj][m][1];
                    *(u32x4*)(rowp + bj * 128) = (u32x4){pack2(gg * v0[0], gg * v0[1]), pack2(gg * v0[2], gg * v0[3]), pack2(gg * v1[0], gg * v1[1]), pack2(gg * v1[2], gg * v1[3])};
                }
            }
    }
};
DI void phase_moe_up(const Params& p, int bid, int nb, char* smem) {
    const MoeOrder<true> S{p.counts, p.list, nb, bid, (const char*)p.hb, (const char*)p.WtGU};
    g8::gemm8<true>((G8_LAS unsigned char*)smem, D, S, EpiMoeUp{p.hid});
    const bf16_t* hb = p.hb; bf16_t* hid = p.hid; const int* list = p.list;
    int big = 0, padr = 0, job = 0;
#pragma unroll 1
    for (int e = 0; e < NE; ++e) { const int cn = p.counts[e], ntp = (cn + 255) >> 8; big += (ntp < MOE_BIG ? ntp : MOE_BIG) * 4; }
    const int mine = bid; (void)big;
#pragma unroll 1
    for (int e = 0; e < NE; ++e) {
        const int cn = p.counts[e];
        for (int s0 = MOE_BIG * 256; s0 < cn; s0 += 128)
            for (int nt = 0; nt < 8; ++nt, ++job)
                if (job % nb == mine) {
                    const int prow = padr;
                    gemm_tile128([=](int r) { const int sl = s0 + r; return sl < cn ? hb + (size_t)(list[e * T + sl] >> 1) * D : (const bf16_t*)nullptr; },
                                 p.WtGU + (size_t)e * 1024 * 1024, D, D, 0, nt * 128, smem,
                                 [=](int r, int c, f32x4 v) {
                                     const int sl = s0 + r;
                                     if (sl >= cn) return;
                                     *(unsigned*)(hid + (size_t)(prow + sl) * DE + (c >> 1)) = pack2(v[0] * sigmoidf_(v[0]) * v[1], v[2] * sigmoidf_(v[2]) * v[3]);
                                 });
                }
        padr += ((cn + 255) >> 8) * 256;
    }
}
DI void phase_moe_down(const Params& p, int bid, int nb, char* smem) {
    const MoeOrder<false> S{p.counts, p.list, nb, bid, (const char*)p.hid, (const char*)p.WtD};
    g8::gemm8<false>((G8_LAS unsigned char*)smem, DE, S, EpiMoeDown{p.fo, p.list, p.tokg});
    const bf16_t* hid = p.hid; bf16_t* fo = p.fo; const int* list = p.list; const float* tokg = p.tokg;
    int big = 0, padr = 0, job = 0;
#pragma unroll 1
    for (int e = 0; e < NE; ++e) { const int cn = p.counts[e], ntp = (cn + 255) >> 8; big += (ntp < MOE_BIG ? ntp : MOE_BIG) * 4; }
    const int mine = bid; (void)big;
#pragma unroll 1
    for (int e = 0; e < NE; ++e) {
        const int cn = p.counts[e];
        for (int s0 = MOE_BIG * 256; s0 < cn; s0 += 128)
            for (int nt = 0; nt < 8; ++nt, ++job)
                if (job % nb == mine) {
                    const int prow = padr;
                    gemm_tile128([=](int r) { const int sl = s0 + r; return sl < cn ? hid + (size_t)(prow + sl) * DE : (const bf16_t*)nullptr; },
                                 p.WtD + (size_t)e * 1024 * 512, DE, DE, 0, nt * 128, smem,
                                 [=](int r, int c, f32x4 v) {
                                     const int sl = s0 + r;
                                     if (sl >= cn) return;
                                     const int ent = list[e * T + sl];
                                     const float g = tokg[ent];
                                     *(u32x2*)(fo + ((size_t)(ent & 1) * TP + (ent >> 1)) * D + c) = (u32x2){pack2(g * v[0], g * v[1]), pack2(g * v[2], g * v[3])};
                                 });
                }
        padr += ((cn + 255) >> 8) * 256;
    }
}
DI void phase_ln2(const Params& p, int layer, int bid, int nb) {
    const int lane = tid_() & 63, wid = __builtin_amdgcn_readfirstlane(tid_() >> 6);
    const int nwaves = nb * 8, gw = bid * 8 + wid, base_n = T / nwaves, extra = T % nwaves;
    const int tok0 = gw * base_n + (gw < extra ? gw : extra), ntok = base_n + (gw < extra ? 1 : 0);
    u32x2 an[4], f0n[4], f1n[4];
    {
#pragma unroll
        for (int j = 0; j < 4; ++j) {
            an[j] = *(const u32x2*)(p.hb + (size_t)tok0 * D + 256 * j + 4 * lane);
            f0n[j] = *(const u32x2*)(p.fo + (size_t)tok0 * D + 256 * j + 4 * lane); f1n[j] = *(const u32x2*)(p.fo + ((size_t)TP + tok0) * D + 256 * j + 4 * lane);
        }
    }
#pragma unroll 1
    for (int i = 0; i < ntok; ++i) {
        const int tok = tok0 + i;
        float v[16];
#pragma unroll
        for (int j = 0; j < 4; ++j) {
            v[4 * j] = ALPHA * lo_bf(an[j][0]) + lo_bf(f0n[j][0]) + lo_bf(f1n[j][0]); v[4 * j + 1] = ALPHA * hi_bf(an[j][0]) + hi_bf(f0n[j][0]) + hi_bf(f1n[j][0]);
            v[4 * j + 2] = ALPHA * lo_bf(an[j][1]) + lo_bf(f0n[j][1]) + lo_bf(f1n[j][1]); v[4 * j + 3] = ALPHA * hi_bf(an[j][1]) + hi_bf(f0n[j][1]) + hi_bf(f1n[j][1]);
        }
        if (i + 1 < ntok) {
#pragma unroll
            for (int j = 0; j < 4; ++j) {
                an[j] = *(const u32x2*)(p.hb + (size_t)(tok + 1) * D + 256 * j + 4 * lane);
                f0n[j] = *(const u32x2*)(p.fo + (size_t)(tok + 1) * D + 256 * j + 4 * lane); f1n[j] = *(const u32x2*)(p.fo + ((size_t)TP + tok + 1) * D + 256 * j + 4 * lane);
            }
        }
        ln16(v, p.ln2_g + layer * D, p.ln2_b + layer * D, lane);
        if (layer == DEPTH - 1) {
            float* of = hrow_u(p, tok);
#pragma unroll
            for (int j = 0; j < 4; ++j) *(f32x4*)(of + 256 * j + 4 * lane) = (f32x4){v[4 * j], v[4 * j + 1], v[4 * j + 2], v[4 * j + 3]};
        } else store_row_bf(p.hb + (size_t)tok * D, v, lane);
    }
}

extern __shared__ __attribute__((aligned(16))) char dyn_smem[];
constexpr int SMEM_MAIN = R1_LDS > GEMM_LDS ? R1_LDS : GEMM_LDS;
constexpr int SMEM_BYTES = SMEM_MAIN + 16;

__global__ void __launch_bounds__(NTHR, 2) k_forward(Params p) {
    const int bid = blockIdx.x, nb = gridDim.x;
    char* smem = dyn_smem;
    uint4* xbw = (uint4*)(dyn_smem + SMEM_MAIN);
    if (threadIdx.x == 0) *xbw = make_uint4(0u, 0u, 0u, 0u);
    __syncthreads();
    XcdBarrier bar = xcd_barrier_post(p.bar, (volatile LAS unsigned*)xbw);
    phase_prologue_weights(p, bid, nb, smem);
    phase_embed(p, bid, nb);
    xcd_barrier(bar);
    for (int l = 0; l < DEPTH; ++l) {
        phase_inproj(p, l, bid, nb, smem);
        xcd_barrier(bar);
        phase_rwkv_r1<0>(p, l, bid, nb, smem);
        xcd_barrier(bar);
        if (bid < 32) phase_rwkv_r2(p, bid);
        else {
            const int sbid = bid - 32, snb = nb - 32, heavy = (NBATCH * HEADS * ((L + 127) / 128)) % snb;
            if (sbid >= heavy && sbid < heavy + NBATCH * HEADS) phase_rwkv_r1<1>(p, l, sbid - heavy, 1, smem);
            phase_sb(p, sbid, snb, smem);
        }
        xcd_barrier(bar);
        phase_rwkv_r3(p, l, bid, nb);
        convert_experts(p, l, NE / 2, NE, bid, nb, smem);
        phase_merge<0>(p, l, bid, nb, smem);
        xcd_barrier(bar);
        phase_merge<1>(p, l, bid, nb, smem);
        xcd_barrier(bar);
        phase_outproj(p, l, bid, nb, smem);
        xcd_barrier(bar);
        phase_ln1_router(p, l, bid, nb, smem);
        xcd_barrier(bar);
        phase_moe_up(p, bid, nb, smem);
        xcd_barrier(bar);
        phase_moe_down(p, bid, nb, smem);
        xcd_barrier(bar);
        phase_ln2(p, l, bid, nb);
        xcd_barrier(bar);
    }
}

extern "C" void kernel_launch(void* const* d_in, const int* in_sizes, int n_in, void* d_out, int out_size, void* d_ws, size_t ws_size, hipStream_t stream) {
    (void)in_sizes; (void)n_in; (void)out_size;
    Params p;
    memset(&p, 0, sizeof(p));
    const float* const* in = (const float* const*)d_in;
    p.x = in[0]; p.meta = in[1]; p.emb_g = in[2]; p.emb_b = in[3]; p.w_in = in[4]; p.mu = in[5]; p.w0 = in[6]; p.w_up = in[7]; p.a0 = in[8]; p.a_up = in[9];
    p.g_up = in[10]; p.k_k = in[11]; p.k_a = in[12]; p.r_k = in[13]; p.lnx_g = in[14]; p.lnx_b = in[15]; p.p_sb = in[16]; p.p_rwkv = in[17]; p.w_out = in[18];
    p.ln1_g = in[19]; p.ln1_b = in[20]; p.router_w = in[21]; p.router_b = in[22]; p.ew_gate = in[23]; p.ew_up = in[24]; p.ew_down = in[25]; p.ln2_g = in[26]; p.ln2_b = in[27];
    p.out = (float*)d_out;
    char* ws = (char*)d_ws; size_t o = 0;
    auto take = [&](size_t bytes) { char* r = ws + o; o += (bytes + 255) & ~(size_t)255; return r; };
    p.bar = (unsigned*)take(XCD_BAR_WORDS * sizeof(unsigned));
    p.counts = (int*)take(256);
    p.WtIn = (bf16_t*)take((size_t)DEPTH * CIN * D * 2);
    p.WtPsb = (bf16_t*)take((size_t)DEPTH * D * 512 * 2);
    p.WtPrw = (bf16_t*)take((size_t)DEPTH * D * 512 * 2);
    p.WtOut = (bf16_t*)take((size_t)DEPTH * D * D * 2);
    p.WupT = (bf16_t*)take((size_t)DEPTH * 512 * 64 * 2);
    p.AupT = (bf16_t*)take((size_t)DEPTH * 512 * 64 * 2);
    p.GupT = (bf16_t*)take((size_t)DEPTH * 512 * 128 * 2);
    p.RwHi = (bf16_t*)take((size_t)NE * D * 2);
    p.RwLo = (bf16_t*)take((size_t)NE * D * 2);
    p.gleft = (bf16_t*)take((size_t)32 * 2048 * 2);
    {
        const size_t ub = (size_t)NUNIT * 64 * 64 * 2;
        p.WtGU = (bf16_t*)take((size_t)NE * 1024 * 1024 * 2);
        p.WtD = (bf16_t*)take((size_t)NE * 1024 * 512 * 2);
        p.PcG = (bf16_t*)d_out; p.QcG = (bf16_t*)((char*)d_out + ub); p.RhG = (bf16_t*)((char*)d_out + 2 * ub);
        p.Y0G = (bf16_t*)take(ub); p.GG = (bf16_t*)take(ub); p.SG = (bf16_t*)take(ub);
        p.bonG = (float*)take((size_t)NUNIT * 64 * 4);
    }
    p.hb = (bf16_t*)take((size_t)TP * D * 2);
    p.hmeta = (float*)take((size_t)NBATCH * NMETA * D * 4);
    p.P = (bf16_t*)take((size_t)TP * CP * 2);
    p.osb = (bf16_t*)take((size_t)TP * 512 * 2);
    p.orw = (bf16_t*)take((size_t)TP * 512 * 2);
    p.list = (int*)take((size_t)NE * T * 4);
    p.tokg = (float*)take((size_t)T * 2 * 4);
    p.gates = p.P;
    p.merged = p.P + (size_t)TP * 2048;
    p.hid = p.P;
    p.fo = p.P + (size_t)(2 * T + 16 * 256) * DE;
    if (o > ws_size) return;
    static int grid = 0;
    if (!grid) {
        int dev = 0, cus = 0, per_cu = 0;
        (void)hipGetDevice(&dev);
        (void)hipDeviceGetAttribute(&cus, hipDeviceAttributeMultiprocessorCount, dev);
        (void)hipFuncSetAttribute((const void*)k_forward, hipFuncAttributeMaxDynamicSharedMemorySize, SMEM_BYTES);
        (void)hipOccupancyMaxActiveBlocksPerMultiprocessor(&per_cu, k_forward, NTHR, SMEM_BYTES);
        grid = per_cu >= 1 ? cus : 0;
    }
    if (!grid) return;
    (void)hipMemsetAsync(p.bar, 0, XCD_BAR_WORDS * sizeof(unsigned), stream);
    hipLaunchKernelGGL(k_forward, dim3(grid), dim3(NTHR), SMEM_BYTES, stream, p);
}
```

```cpp
#include <hip/hip_runtime.h>
#include <stdint.h>
#include <string.h>

#define DI __device__ __forceinline__
typedef unsigned short bf16_t;
typedef short bf16x8 __attribute__((ext_vector_type(8)));
typedef float f32x4 __attribute__((ext_vector_type(4)));
typedef unsigned u32x4 __attribute__((ext_vector_type(4)));
typedef unsigned u32x2 __attribute__((ext_vector_type(2)));

constexpr int D = 1024, NBATCH = 2, SEQ = 8192, NMETA = 16, L = SEQ + NMETA, T = NBATCH * L, TP = 16640;
constexpr int DEPTH = 2, HEADS = 8, HD = 64;
constexpr int CIN = 5376, CP = 3328;
constexpr int OFF_Q = 0, OFF_K = 512, OFF_V = 1024, OFF_RW = 1536;
constexpr int RW_R = 0, RW_K = 512, RW_V = 1024, RW_WD = 1536, RW_AD = 1600, RW_GD = 1664, RSW = 1792;
constexpr int NE = 16, DE = 512;
constexpr float ALPHA = 1.41421356237309515f;
constexpr float DECAY_SCALE = 0.60653065971263342f;
constexpr int NTHR = 512;

#define XB_TMO      128
#define XB_XCNT(j)  (256  + 64 * (j))
#define XB_XSUB(j)  (1280 + 64 * (j))
#define XB_XGEN(j)  (2304 + 64 * (j))
#define XB_TOP      3328
#define XB_TOPGEN   3392
#define XCD_BAR_WORDS 3456
#define XB_SPIN_CAP (1u << 18)
#define LAS __attribute__((address_space(3)))

__device__ __forceinline__ unsigned xb_ld(unsigned* p)              { return __hip_atomic_load(p, __ATOMIC_RELAXED, __HIP_MEMORY_SCOPE_AGENT); }
__device__ __forceinline__ unsigned xb_add(unsigned* p, unsigned v) { return __hip_atomic_fetch_add(p, v, __ATOMIC_RELAXED, __HIP_MEMORY_SCOPE_AGENT); }
__device__ __forceinline__ unsigned xb_xcc_id() { return (unsigned)__builtin_amdgcn_s_getreg((3 << 11) | 20) & 0xFu; }
#define XB_SPIN(cond, bar) do { unsigned _sp = 0; while (cond) { __builtin_amdgcn_s_sleep(1); \
    if ((++_sp & 255u) == 0u) { if (xb_ld(&(bar)[XB_TMO])) break; if (_sp > XB_SPIN_CAP) { atomicAdd(&(bar)[XB_TMO], 1u); break; } } } } while (0)

struct XcdBarrier {
    unsigned* bar; unsigned x;
    volatile LAS unsigned* st;
};

__device__ __forceinline__ XcdBarrier xcd_barrier_post(unsigned* bar, volatile LAS unsigned* st) {
    XcdBarrier b; b.bar = bar; b.x = xb_xcc_id(); b.st = st;
    if (threadIdx.x == 0) (void)xb_add(&bar[XB_XCNT(b.x)], 1u);
    return b;
}
__device__ __forceinline__ void xcd_barrier_complete(unsigned* bar, unsigned x, unsigned& nloc, unsigned& nx) {
    const unsigned G = gridDim.x * gridDim.y * gridDim.z;
    unsigned sum, cnt, mine, sp = 0u;
    for (;;) {
        sum = 0u; cnt = 0u; mine = 0u;
#pragma unroll
        for (unsigned j = 0; j < 16; ++j) { const unsigned c = xb_ld(&bar[XB_XCNT(j)]); sum += c; cnt += (c > 0u) ? 1u : 0u; mine = (j == x) ? c : mine; }
        if (sum == G) break;
        __builtin_amdgcn_s_sleep(1);
        if ((++sp & 255u) == 0u) { if (xb_ld(&bar[XB_TMO])) break; if (sp > XB_SPIN_CAP) { atomicAdd(&bar[XB_TMO], 1u); break; } }
    }
    nloc = mine > 0u ? mine : 1u; nx = cnt > 0u ? cnt : 1u;
}

__device__ __forceinline__ void xcd_barrier(const XcdBarrier& b) {
    asm volatile("s_waitcnt vmcnt(0)" ::: "memory");
    __syncthreads();
    if (threadIdx.x == 0) {
        unsigned* bar = b.bar;
        unsigned bx = b.x; asm volatile("" : "+s"(bx));
        __builtin_amdgcn_s_waitcnt(0);
        unsigned nloc = b.st[0], nx = b.st[1];
        if (nloc == 0u) { xcd_barrier_complete(bar, bx, nloc, nx); b.st[0] = nloc; b.st[1] = nx; }
        const unsigned old = xb_add(&bar[XB_XSUB(bx)], 1u);
        const unsigned gen = old / nloc;
        if (old + 1u == (gen + 1u) * nloc) {
            __builtin_amdgcn_fence(__ATOMIC_RELEASE, "agent");
            asm volatile("s_waitcnt vmcnt(0)" ::: "memory");
            const unsigned og = xb_add(&bar[XB_TOP], 1u);
            const unsigned tg = og / nx;
            if (og + 1u == (tg + 1u) * nx) xb_add(&bar[XB_TOPGEN], 1u);
            else XB_SPIN(xb_ld(&bar[XB_TOPGEN]) == tg, bar);
            __builtin_amdgcn_fence(__ATOMIC_ACQUIRE, "agent");
            xb_add(&bar[XB_XGEN(bx)], 1u);
            asm volatile("s_waitcnt vmcnt(0)" ::: "memory");
        } else {
            XB_SPIN(xb_ld(&bar[XB_XGEN(bx)]) == gen, bar);
            __builtin_amdgcn_fence(__ATOMIC_ACQUIRE, "agent");
            asm volatile("s_waitcnt vmcnt(0)" ::: "memory");
        }
    }
    __syncthreads();
}


struct Params {
    const float *x, *meta, *emb_g, *emb_b, *w_in, *mu, *w0, *w_up, *a0, *a_up, *g_up, *k_k, *k_a, *r_k, *lnx_g, *lnx_b, *p_sb, *p_rwkv, *w_out,
        *ln1_g, *ln1_b, *router_w, *router_b, *ew_gate, *ew_up, *ew_down, *ln2_g, *ln2_b;
    float* out;
    unsigned* bar;
    int* counts;
    bf16_t *WtIn, *WtPsb, *WtPrw, *WtOut, *WtGU, *WtD, *hb, *P, *osb, *orw, *WupT, *AupT, *GupT;
    bf16_t *PcG, *QcG, *RhG, *Y0G, *GG, *SG;
    bf16_t *RwHi, *RwLo, *gleft;
    float* bonG;
    float* hmeta;
    bf16_t *gates, *merged, *hid, *fo;
    int* list;
    float* tokg;
};

DI float bf2f(bf16_t v) { return __uint_as_float((unsigned)v << 16); }
typedef __bf16 bf16x2_t __attribute__((ext_vector_type(2)));
DI bf16_t f2bf(float f) { return __builtin_bit_cast(bf16_t, (__bf16)f); }
DI unsigned pack2(float lo, float hi) { bf16x2_t v = {(__bf16)lo, (__bf16)hi}; return __builtin_bit_cast(unsigned, v); }
DI float lo_bf(unsigned u) { return __uint_as_float(u << 16); }
DI float hi_bf(unsigned u) { return __uint_as_float(u & 0xFFFF0000u); }
template <int CTRL> DI float dpp_mov(float v) { return __builtin_bit_cast(float, __builtin_amdgcn_update_dpp(0, __builtin_bit_cast(int, v), CTRL, 0xF, 0xF, true)); }
DI float sum8(float v) {
    v += dpp_mov<0xB1>(v);
    v += dpp_mov<0x4E>(v);
    v += dpp_mov<0x141>(v);
    return v;
}
DI float sum16(float v) { v = sum8(v); v += dpp_mov<0x140>(v); return v; }
DI float wave_sum(float v) { v = sum16(v); v += __shfl_xor(v, 16); v += __shfl_xor(v, 32); return v; }
struct Params;
DI const Params& kparams() {
    auto k = __builtin_amdgcn_kernarg_segment_ptr();
    asm volatile("" : "+s"(k));
    return *(const Params*)k;
}
DI int tid_() { int t = threadIdx.x; asm volatile("" : "+v"(t)); return t; }
DI float sigmoidf_(float x) { return __builtin_amdgcn_rcpf(1.0f + __expf(-x)); }
DI float tanhf_(float x) { return 1.0f - 2.0f * __builtin_amdgcn_rcpf(1.0f + __expf(2.0f * x)); }
DI void wave_sync() { asm volatile("s_waitcnt lgkmcnt(0)" ::: "memory"); __builtin_amdgcn_wave_barrier(); }

DI float* hrow2(float* hmeta, float* out, int tok) {
    const int b = tok >= L ? 1 : 0, t = tok - b * L;
    const unsigned long long am = (unsigned long long)(hmeta + (long long)(b * NMETA + t) * D), ao = (unsigned long long)(out + ((long long)b * SEQ + (t - NMETA)) * D);
    const unsigned long long m = 0ull - (unsigned long long)(t < NMETA);
    return (float*)((am & m) | (ao & ~m));
}
DI float* hrow(const Params& p, int tok) { return hrow2(p.hmeta, p.out, tok); }
DI float* hrow_u(const Params& p, int tok) { return hrow2(p.hmeta, p.out, __builtin_amdgcn_readfirstlane(tok)); }

DI void transpose_convert(const float* __restrict__ src, int ld, int K, int N, bf16_t* __restrict__ dst, int mult, int off, int bid, int nb, char* smem, int& rot) {
    float* tile = (float*)smem;
    const int tk = K / 64, tn = N / 256, tid = tid_();
    const int first = (bid - rot % nb + nb) % nb;
    rot += tk * tn;
    for (int t = first; t < tk * tn; t += nb) {
        const int k0 = (t / tn) * 64, n0 = (t % tn) * 256;
        f32x4 v[4][2];
#pragma unroll
        for (int q = 0; q < 4; ++q)
#pragma unroll
            for (int i = 0; i < 2; ++i) v[q][i] = *(const f32x4*)(src + (size_t)(k0 + (tid >> 4) + 32 * i) * ld + n0 + q * 64 + (tid & 15) * 4);
        __syncthreads();
#pragma unroll
        for (int q = 0; q < 4; ++q)
#pragma unroll
            for (int i = 0; i < 2; ++i) {
                float* tp = tile + q * 64 * 65 + ((tid >> 4) + 32 * i) * 65 + (tid & 15) * 4;
                tp[0] = v[q][i][0]; tp[1] = v[q][i][1]; tp[2] = v[q][i][2]; tp[3] = v[q][i][3];
            }
        __syncthreads();
        const int n = tid >> 3, kc = (tid & 7) * 8;
#pragma unroll
        for (int q = 0; q < 4; ++q) {
            const float* tq = tile + q * 64 * 65;
            u32x4 o;
#pragma unroll
            for (int jj = 0; jj < 4; ++jj) o[jj] = pack2(tq[(kc + 2 * jj) * 65 + n], tq[(kc + 2 * jj + 1) * 65 + n]);
            *(u32x4*)(dst + (size_t)((n0 + q * 64 + n) * mult + off) * K + k0 + kc) = o;
        }
    }
}

DI void convert_experts(const Params& p, int layer, int e0, int e1, int bid, int nb, char* smem) {
    int rot = 0;
    for (int e = e0; e < e1; ++e) {
        const size_t eo = ((size_t)layer * NE + e) * (size_t)D * DE;
        transpose_convert(p.ew_gate + eo, DE, D, DE, p.WtGU + (size_t)e * 1024 * 1024, 2, 0, bid, nb, smem, rot);
        transpose_convert(p.ew_up + eo, DE, D, DE, p.WtGU + (size_t)e * 1024 * 1024, 2, 1, bid, nb, smem, rot);
        transpose_convert(p.ew_down + eo, D, DE, D, p.WtD + (size_t)e * 1024 * 512, 1, 0, bid, nb, smem, rot);
    }
}

DI void phase_prologue_weights(const Params& p, int bid, int nb, char* smem) {
    int rot = 0;
    for (int i = bid * NTHR + tid_(); i < NE * D; i += nb * NTHR) {
        const int e = i / D, k = i % D;
        const float w = p.router_w[(size_t)k * NE + e];
        const bf16_t hi = f2bf(w);
        p.RwHi[i] = hi; p.RwLo[i] = f2bf(w - bf2f(hi));
    }
    for (int l = 0; l < DEPTH; ++l) {
        transpose_convert(p.w_in + (size_t)l * D * CIN, CIN, D, CIN, p.WtIn + (size_t)l * CIN * D, 1, 0, bid, nb, smem, rot);
        transpose_convert(p.p_sb + (size_t)l * 512 * D, D, 512, D, p.WtPsb + (size_t)l * D * 512, 1, 0, bid, nb, smem, rot);
        transpose_convert(p.p_rwkv + (size_t)l * 512 * D, D, 512, D, p.WtPrw + (size_t)l * D * 512, 1, 0, bid, nb, smem, rot);
        transpose_convert(p.w_out + (size_t)l * D * D, D, D, D, p.WtOut + (size_t)l * D * D, 1, 0, bid, nb, smem, rot);
        transpose_convert(p.w_up + (size_t)l * 64 * 512, 512, 64, 512, p.WupT + (size_t)l * 512 * 64, 1, 0, bid, nb, smem, rot);
        transpose_convert(p.a_up + (size_t)l * 64 * 512, 512, 64, 512, p.AupT + (size_t)l * 512 * 64, 1, 0, bid, nb, smem, rot);
        transpose_convert(p.g_up + (size_t)l * 128 * 512, 512, 128, 512, p.GupT + (size_t)l * 512 * 128, 1, 0, bid, nb, smem, rot);
    }
}

DI void ln16(float (&v)[16], const float* __restrict__ g, const float* __restrict__ b, int lane) {
    float s = 0.f;
#pragma unroll
    for (int i = 0; i < 16; ++i) s += v[i];
    const float mean = wave_sum(s) * (1.0f / D);
    float q = 0.f;
#pragma unroll
    for (int i = 0; i < 16; ++i) { v[i] -= mean; q += v[i] * v[i]; }
    const float rstd = rsqrtf(wave_sum(q) * (1.0f / D) + 1e-5f);
#pragma unroll
    for (int j = 0; j < 4; ++j) {
        const f32x4 gv = *(const f32x4*)(g + 256 * j + 4 * lane), bv = *(const f32x4*)(b + 256 * j + 4 * lane);
#pragma unroll
        for (int i = 0; i < 4; ++i) v[4 * j + i] = v[4 * j + i] * rstd * gv[i] + bv[i];
    }
}
DI void store_row(float* __restrict__ hf, bf16_t* __restrict__ hb, const float (&v)[16], int lane) {
#pragma unroll
    for (int j = 0; j < 4; ++j) {
        *(f32x4*)(hf + 256 * j + 4 * lane) = (f32x4){v[4 * j], v[4 * j + 1], v[4 * j + 2], v[4 * j + 3]};
        *(u32x2*)(hb + 256 * j + 4 * lane) = (u32x2){pack2(v[4 * j], v[4 * j + 1]), pack2(v[4 * j + 2], v[4 * j + 3])};
    }
}

DI void store_row_bf(bf16_t* __restrict__ hb, const float (&v)[16], int lane) {
#pragma unroll
    for (int j = 0; j < 4; ++j) *(u32x2*)(hb + 256 * j + 4 * lane) = (u32x2){pack2(v[4 * j], v[4 * j + 1]), pack2(v[4 * j + 2], v[4 * j + 3])};
}
DI void phase_embed(const Params& p, int bid, int nb) {
    const int lane = tid_() & 63, wid = __builtin_amdgcn_readfirstlane(tid_() >> 6);
    const int nwaves = nb * 8, gw = bid * 8 + wid, base_n = T / nwaves, extra = T % nwaves;
    const int tok0 = gw * base_n + (gw < extra ? gw : extra), ntok = base_n + (gw < extra ? 1 : 0);
    auto srcrow = [&](int tok) -> const float* {
        const int tk = __builtin_amdgcn_readfirstlane(tok), b = tk >= L ? 1 : 0, t = tk - b * L;
        const unsigned long long am = (unsigned long long)(p.meta + (long long)t * D), ao = (unsigned long long)(p.x + ((long long)b * SEQ + (t - NMETA)) * D);
        const unsigned long long m = 0ull - (unsigned long long)(t < NMETA);
        return (const float*)((am & m) | (ao & ~m));
    };
    f32x4 an[4];
    { const float* src = srcrow(tok0);
#pragma unroll
      for (int j = 0; j < 4; ++j) an[j] = *(const f32x4*)(src + 256 * j + 4 * lane); }
#pragma unroll 1
    for (int i = 0; i < ntok; ++i) {
        const int tok = tok0 + i;
        float v[16];
#pragma unroll
        for (int j = 0; j < 4; ++j) { v[4 * j] = an[j][0]; v[4 * j + 1] = an[j][1]; v[4 * j + 2] = an[j][2]; v[4 * j + 3] = an[j][3]; }
        if (i + 1 < ntok) { const float* src = srcrow(tok + 1);
#pragma unroll
            for (int j = 0; j < 4; ++j) an[j] = *(const f32x4*)(src + 256 * j + 4 * lane); }
        ln16(v, p.emb_g, p.emb_b, lane);
        store_row_bf(p.hb + (size_t)tok * D, v, lane);
    }
}

constexpr int LDT = 72;
constexpr int GEMM_LDS = 2 * 128 * LDT * 2;
template <class ARow, class Epi>
DI void gemm_tile128(ARow arow, const bf16_t* __restrict__ Bt, int ldb, int K, int m0, int n0, char* smem, Epi epi) {
    const int tid = tid_(), lane = tid & 63, wid = __builtin_amdgcn_readfirstlane(tid >> 6), fr = lane & 15, fq = lane >> 4;
    const int wr = wid >> 1, wc = wid & 1;
    bf16_t* As = (bf16_t*)smem;
    bf16_t* Bs = As + 128 * LDT;
    const bf16_t* ap[2]; const bf16_t* bp[2]; int so[2];
#pragma unroll
    for (int i = 0; i < 2; ++i) {
        const int c = tid + NTHR * i, row = c >> 3, kc = c & 7;
        const bf16_t* ar = arow(m0 + row);
        ap[i] = ar ? ar + kc * 8 : nullptr;
        bp[i] = Bt + (size_t)(n0 + row) * ldb + kc * 8;
        so[i] = row * LDT + kc * 8;
    }
    f32x4 acc[2][4];
#pragma unroll
    for (int mi = 0; mi < 2; ++mi)
#pragma unroll
        for (int ni = 0; ni < 4; ++ni) acc[mi][ni] = (f32x4){0.f, 0.f, 0.f, 0.f};
    u32x4 ra[2], rb[2];
#pragma unroll
    for (int i = 0; i < 2; ++i) { ra[i] = ap[i] ? *(const u32x4*)(ap[i]) : (u32x4){0u, 0u, 0u, 0u}; rb[i] = *(const u32x4*)(bp[i]); }
    for (int k0 = 0; k0 < K; k0 += 64) {
        __syncthreads();
#pragma unroll
        for (int i = 0; i < 2; ++i) { *(u32x4*)(As + so[i]) = ra[i]; *(u32x4*)(Bs + so[i]) = rb[i]; }
        __syncthreads();
        if (k0 + 64 < K) {
#pragma unroll
            for (int i = 0; i < 2; ++i) { ra[i] = ap[i] ? *(const u32x4*)(ap[i] + k0 + 64) : (u32x4){0u, 0u, 0u, 0u}; rb[i] = *(const u32x4*)(bp[i] + k0 + 64); }
        }
#pragma unroll
        for (int ks = 0; ks < 2; ++ks) {
            bf16x8 af[2], bf[4];
#pragma unroll
            for (int mi = 0; mi < 2; ++mi) af[mi] = *(const bf16x8*)(As + (wr * 32 + mi * 16 + fr) * LDT + ks * 32 + fq * 8);
#pragma unroll
            for (int ni = 0; ni < 4; ++ni) bf[ni] = *(const bf16x8*)(Bs + (wc * 64 + ni * 16 + fr) * LDT + ks * 32 + fq * 8);
#pragma unroll
            for (int mi = 0; mi < 2; ++mi)
#pragma unroll
                for (int ni = 0; ni < 4; ++ni) acc[mi][ni] = __builtin_amdgcn_mfma_f32_16x16x32_bf16(bf[ni], af[mi], acc[mi][ni], 0, 0, 0);
        }
    }
#pragma unroll
    for (int mi = 0; mi < 2; ++mi)
#pragma unroll
        for (int ni = 0; ni < 4; ++ni) epi(m0 + wr * 32 + mi * 16 + fr, n0 + wc * 64 + ni * 16 + fq * 4, acc[mi][ni]);
}

namespace g8 {
#define G8_LAS __attribute__((address_space(3)))
constexpr int BM = 256, BK = 64, HALF = 128, HTB = HALF * BK * 2, STAGE_BYTES = 8 * HTB, NXCD = 8, WGM = 8;
DI int lds_byte(int r, int c) { const int st = (r >> 4) * 2 + (c >> 5), rr = r & 15, cc = c & 31, ob = rr * 64 + cc * 2; return st * 1024 + (ob ^ (((ob >> 9) & 1) << 5)); }
DI void stage_rc(int b, int& R, int& C) { const int st = b / 1024, sb = b % 1024, swz = sb ^ (((sb >> 9) & 1) << 5); R = (st >> 1) * 16 + swz / 64; C = (st & 1) * 32 + (swz % 64) / 2; }
DI int perm32(int rho) { const int n = rho >> 4, i = rho & 15; return 8 * (i >> 2) + 4 * n + (i & 3); }
struct Unit { int pm, pn; const char* A; const char* B; int e, slot0, cnt; };

struct DenseOrder {
    int nM, nN, nwg, G, c; const char* A; const char* B; size_t tstep;
    DI void init(const bf16_t* A_, const bf16_t* Bt_, int nM_, int nN_, int K, int G_, int c_) { nM = nM_; nN = nN_; nwg = nM * nN; G = G_; c = c_; A = (const char*)A_; B = (const char*)Bt_; tstep = (size_t)BM * K * 2; }
    DI bool next(int i, Unit& u) const {
        const long Lq = (long)i * G + c; if (Lq >= nwg) return false;
        int wgid = (int)Lq; { const int q = nwg / NXCD, r = nwg % NXCD, xcd = wgid % NXCD, off = wgid / NXCD; wgid = (xcd < r ? xcd * (q + 1) : r * (q + 1) + (xcd - r) * q) + off; }
        const int nig = WGM * nN, gid = wgid / nig, fm = gid * WGM, gsz = (nM - fm) < WGM ? (nM - fm) : WGM;
        u.pm = fm + ((wgid % nig) % gsz); u.pn = (wgid % nig) / gsz; u.A = A + (size_t)u.pm * tstep; u.B = B + (size_t)u.pn * tstep; u.e = 0; u.slot0 = 0; u.cnt = 0; return true;
    }
    DI unsigned row_off(const Unit&, int) const { return 0u; }
};

template <bool GATHER, class Epi, class Sched>
DI void gemm8(G8_LAS unsigned char* lds, const int K, const Sched& S, const Epi& E) {
    const int tid = tid_(), wid = __builtin_amdgcn_readfirstlane(tid >> 6), lane = tid & 63, wr = wid >> 2, wc = wid & 3, fr = lane & 15, fq = lane >> 4;
    const int nt = K / BK;
    int Rr[2], Cc[2]; unsigned voffB[2], voffA[2];
#pragma unroll
    for (int i = 0; i < 2; ++i) { stage_rc(tid * 16 + i * 8192, Rr[i], Cc[i]); const int Rb = Epi::PERM ? ((Rr[i] & ~31) + perm32(Rr[i] & 31)) : Rr[i]; voffB[i] = (unsigned)(Rb * K + Cc[i]) * 2u; voffA[i] = (unsigned)(Rr[i] * K + Cc[i]) * 2u; }
    const size_t kstep = (size_t)(BK * 2), hstep = (size_t)HALF * K * 2;
    const unsigned ldsw = (unsigned)wid * 1024u;
    const int aoff = lds_byte(wr * 64 + fr, fq * 8), boff = lds_byte(wc * 32 + fr, fq * 8);
#define G8_SA(b, h) (((b) * 2 + (h)) * HTB)
#define G8_SB(b, h) ((4 + (b) * 2 + (h)) * HTB)
#define G8_STAGE(bufoff, gbase, voff) do { _Pragma("unroll") for (int _i = 0; _i < 2; ++_i) \
        __builtin_amdgcn_global_load_lds((const unsigned*)((const char*)(gbase) + (voff)[_i]), (G8_LAS unsigned*)(lds + (bufoff) + ldsw + _i * 8192), 16, 0, 0); } while (0)
#define G8_LDA(dst, b, h) do { _Pragma("unroll") for (int m = 0; m < 4; ++m) _Pragma("unroll") for (int k = 0; k < 2; ++k) dst[m][k] = *(const G8_LAS bf16x8*)(lds + G8_SA(b, h) + aoff + m * 2048 + k * 1024); } while (0)
#define G8_LDB(dst, b, h) do { _Pragma("unroll") for (int n = 0; n < 2; ++n) _Pragma("unroll") for (int k = 0; k < 2; ++k) dst[n][k] = *(const G8_LAS bf16x8*)(lds + G8_SB(b, h) + boff + n * 2048 + k * 1024); } while (0)
#define G8_MMA(ai, bj, At, Bt) do { __builtin_amdgcn_s_setprio(1); _Pragma("unroll") for (int m = 0; m < 4; ++m) _Pragma("unroll") for (int n = 0; n < 2; ++n) _Pragma("unroll") for (int k = 0; k < 2; ++k) \
        acc[ai][bj][m][n] = __builtin_amdgcn_mfma_f32_16x16x32_bf16(Bt[n][k], At[m][k], acc[ai][bj][m][n], 0, 0, 0); __builtin_amdgcn_s_setprio(0); } while (0)
#define G8_WAIT_V(n) asm volatile("s_waitcnt vmcnt(" #n ")" ::: "memory")
#define G8_WAIT_L(n) asm volatile("s_waitcnt lgkmcnt(" #n ")" ::: "memory")
#define G8_BAR __builtin_amdgcn_s_barrier()
#define G8_SCHED __builtin_amdgcn_sched_barrier(0)
#define G8_AOFF(dst, un) do { if (GATHER) { _Pragma("unroll") for (int _h = 0; _h < 2; ++_h) _Pragma("unroll") for (int _i = 0; _i < 2; ++_i) \
        dst[_h][_i] = S.row_off(un, _h * HALF + Rr[_i]) + (unsigned)Cc[_i] * 2u; } } while (0)
#define G8_STAGE_A(bufoff, gb, vo, h) do { if (GATHER) { G8_STAGE(bufoff, gb, vo[h]); } else { G8_STAGE(bufoff, (gb) + (h) * hstep, voffA); } } while (0)
    Unit cur, nxt; int ui = 0;
    if (!S.next(0, cur)) return;
    f32x4 acc[2][2][4][2];
#pragma unroll
    for (int a = 0; a < 2; ++a)
#pragma unroll
        for (int b = 0; b < 2; ++b)
#pragma unroll
            for (int m = 0; m < 4; ++m)
#pragma unroll
                for (int n = 0; n < 2; ++n) acc[a][b][m][n] = (f32x4){0.f, 0.f, 0.f, 0.f};
    bf16x8 At[4][2], B0[2][2], B1[2][2];
    unsigned cvA[2][2], nvA[2][2];
    G8_AOFF(cvA, cur);
    const char* cA = cur.A; const char* cB = cur.B;
    G8_STAGE(G8_SB(0, 0), cB, voffB); G8_STAGE_A(G8_SA(0, 0), cA, cvA, 0); G8_STAGE(G8_SB(0, 1), cB + hstep, voffB); G8_STAGE_A(G8_SA(0, 1), cA, cvA, 1);
    if (wr == 1) G8_BAR;
    G8_WAIT_V(4); G8_BAR;
    G8_STAGE(G8_SB(1, 0), cB + kstep, voffB); G8_STAGE_A(G8_SA(1, 0), cA + kstep, cvA, 0); G8_STAGE(G8_SB(1, 1), cB + hstep + kstep, voffB);
    G8_WAIT_V(6); G8_BAR;
    for (;;) {
        const bool has_next = S.next(ui + 1, nxt);
        const char* nA = has_next ? nxt.A : cA; const char* nB = has_next ? nxt.B : cB;
        if (GATHER) {
            if (has_next) { G8_AOFF(nvA, nxt); } else {
#pragma unroll
                for (int h = 0; h < 2; ++h)
#pragma unroll
                    for (int i = 0; i < 2; ++i) nvA[h][i] = cvA[h][i];
            }
        }
        for (int t = 0; t < nt; t += 2) {
            const bool last = (t == nt - 2);
            const char* a1 = cA + (size_t)(t + 1) * kstep;
            const char* a2 = last ? nA : cA + (size_t)(t + 2) * kstep; const char* b2 = last ? nB : cB + (size_t)(t + 2) * kstep;
            const char* a3 = a2 + kstep; const char* b3 = b2 + kstep;

            G8_LDB(B0, 0, 0); G8_SCHED; G8_LDA(At, 0, 0); G8_STAGE_A(G8_SA(1, 1), a1, cvA, 1);
            if (GATHER && last) {
#pragma unroll
                for (int h = 0; h < 2; ++h)
#pragma unroll
                    for (int i = 0; i < 2; ++i) cvA[h][i] = nvA[h][i];
            }
            G8_WAIT_L(8); G8_BAR; G8_WAIT_L(0); G8_MMA(0, 0, At, B0); G8_BAR; G8_SCHED;
            G8_LDB(B1, 0, 1); G8_STAGE(G8_SB(0, 0), b2, voffB);
            G8_BAR; G8_WAIT_L(0); G8_MMA(0, 1, At, B1); G8_BAR;
            G8_LDA(At, 0, 1); G8_STAGE_A(G8_SA(0, 0), a2, cvA, 0);
            G8_BAR; G8_WAIT_L(0); G8_MMA(1, 0, At, B0); G8_BAR; G8_SCHED;
            G8_STAGE(G8_SB(0, 1), b2 + hstep, voffB);
            G8_WAIT_V(6); G8_BAR; G8_MMA(1, 1, At, B1); G8_BAR;
            G8_LDB(B0, 1, 0); G8_SCHED; G8_LDA(At, 1, 0); G8_STAGE_A(G8_SA(0, 1), a2, cvA, 1);
            G8_WAIT_L(8); G8_BAR; G8_WAIT_L(0); G8_MMA(0, 0, At, B0); G8_BAR; G8_SCHED;
            G8_LDB(B1, 1, 1); G8_STAGE(G8_SB(1, 0), b3, voffB);
            G8_BAR; G8_WAIT_L(0); G8_MMA(0, 1, At, B1); G8_BAR;
            G8_LDA(At, 1, 1); G8_STAGE_A(G8_SA(1, 0), a3, cvA, 0);
            G8_BAR; G8_WAIT_L(0); G8_MMA(1, 0, At, B0); G8_BAR; G8_SCHED;
            G8_STAGE(G8_SB(1, 1), b3 + hstep, voffB);
            G8_WAIT_V(6); G8_BAR; G8_MMA(1, 1, At, B1); G8_BAR;
        }
        { int fr2 = fr, fq2 = fq; asm volatile("" : "+v"(fr2), "+v"(fq2)); E(acc, cur, wr, wc, fr2, fq2); }
        if (!has_next) break;
#pragma unroll
        for (int a = 0; a < 2; ++a)
#pragma unroll
            for (int b = 0; b < 2; ++b)
#pragma unroll
                for (int m = 0; m < 4; ++m)
#pragma unroll
                    for (int n = 0; n < 2; ++n) acc[a][b][m][n] = (f32x4){0.f, 0.f, 0.f, 0.f};
        cur = nxt; cA = nA; cB = nB; ++ui;
    }
    G8_WAIT_V(0);
    if (wr == 0) G8_BAR;
    G8_BAR;
#undef G8_SA
#undef G8_SB
#undef G8_STAGE
#undef G8_LDA
#undef G8_LDB
#undef G8_MMA
#undef G8_WAIT_V
#undef G8_WAIT_L
#undef G8_BAR
#undef G8_SCHED
#undef G8_AOFF
#undef G8_STAGE_A
}
}

constexpr int MFULL = 64, M0_LEFT = MFULL * 256;
struct EpiStore {
    static constexpr bool PERM = true;
    bf16_t* O; int ldc; bool sig;
    DI void operator()(const f32x4 (&acc)[2][2][4][2], const g8::Unit& u, int wr, int wc, int fr, int fq) const {
#pragma unroll
        for (int ai = 0; ai < 2; ++ai)
#pragma unroll
            for (int m = 0; m < 4; ++m) {
                bf16_t* rowp = O + (size_t)(u.pm * 256 + ai * 128 + wr * 64 + m * 16 + fr) * ldc + u.pn * 256 + wc * 32 + 8 * fq;
#pragma unroll
                for (int bj = 0; bj < 2; ++bj) {
                    f32x4 v0 = acc[ai][bj][m][0], v1 = acc[ai][bj][m][1];
                    if (sig) {
#pragma unroll
                        for (int e = 0; e < 4; ++e) { v0[e] = sigmoidf_(v0[e]); v1[e] = sigmoidf_(v1[e]); }
                    }
                    *(u32x4*)(rowp + bj * 128) = (u32x4){pack2(v0[0], v0[1]), pack2(v0[2], v0[3]), pack2(v1[0], v1[1]), pack2(v1[2], v1[3])};
                }
            }
    }
};
DI int left_first(int units, int bid, int nb) { return (bid - units % nb + nb) % nb; }

constexpr int LEFT_LDS = 2 * (32 + 128) * LDT * 2;
template <class ARow, class Epi>
DI void gemm_left32(ARow arow, const bf16_t* __restrict__ Bt, int ldb, int K, int n0, char* smem, Epi epi) {
    const int tid = tid_(), lane = tid & 63, wid = __builtin_amdgcn_readfirstlane(tid >> 6), fr = lane & 15, fq = lane >> 4;
    bf16_t* As = (bf16_t*)smem;
    bf16_t* Bs = As + 2 * 32 * LDT;
    const int arow_i = tid >> 4, akc = (tid & 15) * 4;
    const bf16_t* ap = arow(arow_i) + akc;
    const bf16_t* bp[2]; int bso[2];
#pragma unroll
    for (int i = 0; i < 2; ++i) { const int cc = tid + NTHR * i, row = cc >> 3, kc = cc & 7; bp[i] = Bt + (size_t)(n0 + row) * ldb + kc * 8; bso[i] = row * LDT + kc * 8; }
    const int nit = K / 64;
    u32x2 ra[4]; u32x4 rb[4][2];
#define GL_LOAD(slot, it) do { if ((it) < nit) { ra[slot] = *(const u32x2*)(ap + (it) * 64); rb[slot][0] = *(const u32x4*)(bp[0] + (it) * 64); rb[slot][1] = *(const u32x4*)(bp[1] + (it) * 64); } } while (0)
#define GL_WRITE(slot, buf) do { *(u32x2*)(As + (buf) * 32 * LDT + arow_i * LDT + akc) = ra[slot]; *(u32x4*)(Bs + (buf) * 128 * LDT + bso[0]) = rb[slot][0]; *(u32x4*)(Bs + (buf) * 128 * LDT + bso[1]) = rb[slot][1]; } while (0)
    f32x4 acc[2] = {(f32x4){0.f, 0.f, 0.f, 0.f}, (f32x4){0.f, 0.f, 0.f, 0.f}};
    GL_LOAD(0, 0); GL_LOAD(1, 1); GL_LOAD(2, 2); GL_LOAD(3, 3);
    __syncthreads();
    GL_WRITE(0, 0);
    __syncthreads();
#define GL_STEP(slot, it) do { \
        GL_LOAD(slot, (it) + 4); \
        const int buf = (it) & 1; \
        _Pragma("unroll") for (int ks = 0; ks < 2; ++ks) { \
            const bf16x8 bf = *(const bf16x8*)(Bs + buf * 128 * LDT + (wid * 16 + fr) * LDT + ks * 32 + fq * 8); \
            _Pragma("unroll") for (int mt = 0; mt < 2; ++mt) { \
                const bf16x8 af = *(const bf16x8*)(As + buf * 32 * LDT + (mt * 16 + fr) * LDT + ks * 32 + fq * 8); \
                acc[mt] = __builtin_amdgcn_mfma_f32_16x16x32_bf16(bf, af, acc[mt], 0, 0, 0); } } \
        if ((it) + 1 < nit) { GL_WRITE(((slot) + 1) & 3, buf ^ 1); } \
        __syncthreads(); } while (0)
    for (int it = 0; it < nit; it += 4) {
        GL_STEP(0, it);
        if (it + 1 < nit) GL_STEP(1, it + 1);
        if (it + 2 < nit) GL_STEP(2, it + 2);
        if (it + 3 < nit) GL_STEP(3, it + 3);
    }
#undef GL_LOAD
#undef GL_WRITE
#undef GL_STEP
#pragma unroll
    for (int mt = 0; mt < 2; ++mt) epi(mt * 16 + fr, n0 + wid * 16 + fq * 4, acc[mt]);
}

DI void phase_inproj(const Params& p, int layer, int bid, int nb, char* smem) {
    const bf16_t* hb = p.hb; bf16_t* P = p.P;
    const bf16_t* Bt = p.WtIn + (size_t)layer * CIN * D;
    g8::DenseOrder S; S.init(hb, Bt, MFULL, CP / 256, D, nb, bid);
    g8::gemm8<false>((G8_LAS unsigned char*)smem, D, S, EpiStore{P, CP, false});
    {
        constexpr int UNITS = MFULL * (CP / 256);
        const int heavy = UNITS % nb;
        if (heavy > 0 && heavy < nb) { if (bid >= heavy) convert_experts(p, layer, 0, NE / 2, bid - heavy, nb - heavy, smem); }
        else convert_experts(p, layer, 0, NE / 2, bid, nb, smem);
    }
    bf16_t* G = p.gleft - (size_t)M0_LEFT * 2048; const bf16_t* Wg = p.WtIn + ((size_t)layer * CIN + CP) * D;
    for (int t = left_first(MFULL * (CP / 256), bid, nb); t < CP / 128 + 2048 / 128; t += nb) {
        if (t < CP / 128)
            gemm_left32([=](int r) { return hb + (size_t)(M0_LEFT + r) * D; }, Bt, D, D, t * 128, smem,
                        [=](int r, int c, f32x4 v) { *(u32x2*)(P + (size_t)(M0_LEFT + r) * CP + c) = (u32x2){pack2(v[0], v[1]), pack2(v[2], v[3])}; });
        else
            gemm_left32([=](int r) { return hb + (size_t)(M0_LEFT + r) * D; }, Wg, D, D, (t - CP / 128) * 128, smem,
                        [=](int r, int c, f32x4 v) { *(u32x2*)(G + (size_t)(M0_LEFT + r) * 2048 + c) = (u32x2){pack2(sigmoidf_(v[0]), sigmoidf_(v[1])), pack2(sigmoidf_(v[2]), sigmoidf_(v[3]))}; });
    }
}

constexpr int NCHUNK = (L + 63) / 64, NUNIT = NBATCH * HEADS * NCHUNK;
constexpr int LS = 72, RB = 64 * LS * 2;
constexpr int R1_LDS = 16 * RB + 4096 + 7168;
#define RBUF(i) ((bf16_t*)(smem + (i) * RB))
typedef float f32x16 __attribute__((ext_vector_type(16)));

template <int KK> DI f32x4 mm16(const bf16_t* F, int ldf, const bf16_t* S, int lds_, f32x4 acc, int lane) {
    const int fr = lane & 15, fq = lane >> 4;
#pragma unroll
    for (int ks = 0; ks < KK / 32; ++ks) {
        const bf16x8 f = *(const bf16x8*)(F + fr * ldf + ks * 32 + fq * 8);
        const bf16x8 g = *(const bf16x8*)(S + fr * lds_ + ks * 32 + fq * 8);
        acc = __builtin_amdgcn_mfma_f32_16x16x32_bf16(f, g, acc, 0, 0, 0);
    }
    return acc;
}
DI u32x2 pk4(f32x4 v) { return (u32x2){pack2(v[0], v[1]), pack2(v[2], v[3])}; }
DI f32x4 up4(u32x2 v) { return (f32x4){lo_bf(v[0]), hi_bf(v[0]), lo_bf(v[1]), hi_bf(v[1])}; }

template <int MODE> DI void phase_rwkv_r1(const Params& p, int layer, int bid, int nb, char* smem) {
    const int wv = __builtin_amdgcn_readfirstlane(tid_() >> 6);
    const f32x4 zero = (f32x4){0.f, 0.f, 0.f, 0.f};
    float* lwT = (float*)RBUF(4);
    float* aT = (float*)RBUF(6);
    float* gt = (float*)(smem + 16 * RB);
    float* gammaC = gt + 512;
    bf16_t* Xt0 = RBUF(14);
    bf16_t* Xt1 = RBUF(4);
    const bf16_t* WupT = p.WupT + (size_t)layer * 512 * 64, *AupT = p.AupT + (size_t)layer * 512 * 64, *GupT = p.GupT + (size_t)layer * 512 * 128;
    float* mu = (float*)(smem + 16 * RB + 4096);
    __syncthreads();
    for (int i = tid_(); i < RSW; i += NTHR) mu[i] = p.mu[(size_t)layer * RSW + i];
    for (int it = 0;; ++it) {
        const int tid = tid_(), lane = tid & 63, fr = lane & 15, fq = lane >> 4;
        int c, bh;
        if (MODE == 0) {
            const int Lq = it * nb + bid, q = Lq >> 3, cb = (q >> 3) * 8 + (Lq & 7);
            if (cb >= NBATCH * (NCHUNK - 1)) break;
            c = cb % (NCHUNK - 1); bh = (cb / (NCHUNK - 1)) * HEADS + (q & 7);
        } else {
            if (it > 0) break;
            c = NCHUNK - 1; bh = bid;
        }
        const int u = bh * NCHUNK + c, h = bh % HEADS, bb = bh / HEADS;
        const size_t tok0 = (size_t)bb * L + c * 64;
        bf16x8 fw[2][2], fa[2][2], fg[2][4];
#pragma unroll
        for (int t2 = 0; t2 < 2; ++t2) {
            const int tl = wv * 2 + t2, pt = tl >> 2, qt = tl & 3;
#pragma unroll
            for (int ks = 0; ks < 2; ++ks) {
                fw[t2][ks] = *(const bf16x8*)(WupT + (size_t)(h * 64 + qt * 16 + fr) * 64 + ks * 32 + fq * 8);
                fa[t2][ks] = *(const bf16x8*)(AupT + (size_t)(h * 64 + pt * 16 + fr) * 64 + ks * 32 + fq * 8);
            }
        }
        __syncthreads();
        {
            u32x4 curv[7], prvv[7];
#pragma unroll
            for (int it2 = 0; it2 < 7; ++it2) {
                const int cid = tid + NTHR * it2, i = cid / 56, cc = cid % 56;
                const int col = cc < 8 ? RW_R + h * 64 + cc * 8 : cc < 16 ? RW_K + h * 64 + (cc - 8) * 8 : cc < 24 ? RW_V + h * 64 + (cc - 16) * 8 : RW_WD + (cc - 24) * 8;
                const int t = c * 64 + i;
                curv[it2] = (u32x4){0u, 0u, 0u, 0u}; prvv[it2] = (u32x4){0u, 0u, 0u, 0u};
                if (t < L) curv[it2] = *(const u32x4*)(p.P + (tok0 + i) * CP + OFF_RW + col);
                if (t < L && t > 0) prvv[it2] = *(const u32x4*)(p.P + (tok0 + i - 1) * CP + OFF_RW + col);
            }
#pragma unroll
            for (int it2 = 0; it2 < 7; ++it2) {
                const int cid = tid + NTHR * it2, i = cid / 56, cc = cid % 56;
                const int col = cc < 8 ? RW_R + h * 64 + cc * 8 : cc < 16 ? RW_K + h * 64 + (cc - 8) * 8 : cc < 24 ? RW_V + h * 64 + (cc - 16) * 8 : RW_WD + (cc - 24) * 8;
                bf16_t* dst = cc < 8 ? RBUF(8) + i * LS + cc * 8 : cc < 16 ? RBUF(9) + i * LS + (cc - 8) * 8 : cc < 24 ? RBUF(10) + i * LS + (cc - 16) * 8
                            : cc < 32 ? RBUF(0) + i * LS + (cc - 24) * 8 : cc < 40 ? RBUF(1) + i * LS + (cc - 32) * 8 : RBUF(2) + i * 136 + (cc - 40) * 8;
                const f32x4 m0 = *(const f32x4*)(mu + col), m1 = *(const f32x4*)(mu + col + 4);
                const u32x4 cur = curv[it2], prv = prvv[it2];
                float x[8];
#pragma unroll
                for (int j2 = 0; j2 < 4; ++j2) {
                    const float c0 = lo_bf(cur[j2]), c1 = hi_bf(cur[j2]), p0 = lo_bf(prv[j2]), p1 = hi_bf(prv[j2]);
                    const float mm0 = j2 < 2 ? m0[2 * j2] : m1[2 * j2 - 4], mm1 = j2 < 2 ? m0[2 * j2 + 1] : m1[2 * j2 - 3];
                    x[2 * j2] = c0 + (p0 - c0) * mm0; x[2 * j2 + 1] = c1 + (p1 - c1) * mm1;
                }
                if (cc >= 24 && cc < 32) {
#pragma unroll
                    for (int j2 = 0; j2 < 8; ++j2) x[j2] = tanhf_(x[j2]);
                } else if (cc >= 40) {
#pragma unroll
                    for (int j2 = 0; j2 < 8; ++j2) x[j2] = sigmoidf_(x[j2]);
                }
                *(u32x4*)dst = (u32x4){pack2(x[0], x[1]), pack2(x[2], x[3]), pack2(x[4], x[5]), pack2(x[6], x[7])};
            }
        }
#pragma unroll
        for (int t2 = 0; t2 < 2; ++t2)
#pragma unroll
            for (int ks = 0; ks < 4; ++ks) fg[t2][ks] = *(const bf16x8*)(GupT + (size_t)(h * 64 + ((wv * 2 + t2) >> 2) * 16 + fr) * 128 + ks * 32 + fq * 8);
        __syncthreads();
#pragma unroll
        for (int t2 = 0; t2 < 2; ++t2) {
            const int tl = wv * 2 + t2, pt = tl >> 2, qt = tl & 3;
            f32x4 aw = zero, aa = zero, ag = zero;
#pragma unroll
            for (int ks = 0; ks < 2; ++ks) {
                const bf16x8 xw = *(const bf16x8*)(RBUF(0) + (pt * 16 + fr) * LS + ks * 32 + fq * 8);
                aw = __builtin_amdgcn_mfma_f32_16x16x32_bf16(xw, fw[t2][ks], aw, 0, 0, 0);
                const bf16x8 xa = *(const bf16x8*)(RBUF(1) + (qt * 16 + fr) * LS + ks * 32 + fq * 8);
                aa = __builtin_amdgcn_mfma_f32_16x16x32_bf16(fa[t2][ks], xa, aa, 0, 0, 0);
            }
#pragma unroll
            for (int ks = 0; ks < 4; ++ks) {
                const bf16x8 xg = *(const bf16x8*)(RBUF(2) + (qt * 16 + fr) * 136 + ks * 32 + fq * 8);
                ag = __builtin_amdgcn_mfma_f32_16x16x32_bf16(fg[t2][ks], xg, ag, 0, 0, 0);
            }
            const int ch = qt * 16 + fr;
            const float w0 = p.w0[layer * 512 + h * 64 + ch];
            const f32x4 a0 = *(const f32x4*)(p.a0 + layer * 512 + h * 64 + pt * 16 + fq * 4);
            f32x4 lw, av;
#pragma unroll
            for (int e = 0; e < 4; ++e) { lw[e] = -DECAY_SCALE * sigmoidf_(w0 + aw[e]); av[e] = sigmoidf_(a0[e] + aa[e]); }
            *(f32x4*)(lwT + ch * 68 + pt * 16 + fq * 4) = lw;
            *(f32x4*)(aT + (qt * 16 + fr) * 68 + pt * 16 + fq * 4) = av;
            *(u32x2*)(p.GG + ((size_t)u * 64 + qt * 16 + fr) * 64 + pt * 16 + fq * 4) = pk4(ag);
        }
        __syncthreads();
        {
            const int i = tid >> 3, c8 = (tid & 7) * 8, cg = layer * 512 + h * 64 + c8;
            const u32x4 xr = *(const u32x4*)(RBUF(8) + i * LS + c8), xk = *(const u32x4*)(RBUF(9) + i * LS + c8);
            const f32x4 a0 = *(const f32x4*)(aT + i * 68 + c8), a1 = *(const f32x4*)(aT + i * 68 + c8 + 4);
            const f32x4 kk0 = *(const f32x4*)(p.k_k + cg), kk1 = *(const f32x4*)(p.k_k + cg + 4), ka0 = *(const f32x4*)(p.k_a + cg), ka1 = *(const f32x4*)(p.k_a + cg + 4);
            const f32x4 rk0 = *(const f32x4*)(p.r_k + cg), rk1 = *(const f32x4*)(p.r_k + cg + 4);
            float n2 = 0.f, bon = 0.f;
#pragma unroll
            for (int j = 0; j < 8; ++j) {
                const float r_ = (j & 1) ? hi_bf(xr[j >> 1]) : lo_bf(xr[j >> 1]), k_ = (j & 1) ? hi_bf(xk[j >> 1]) : lo_bf(xk[j >> 1]);
                const float a_ = j < 4 ? a0[j & 3] : a1[j & 3], kkc = j < 4 ? kk0[j & 3] : kk1[j & 3], kac = j < 4 ? ka0[j & 3] : ka1[j & 3], rkc = j < 4 ? rk0[j & 3] : rk1[j & 3];
                const float kkr = k_ * kkc;
                n2 += kkr * kkr;
                bon += r_ * (k_ * (1.0f + (a_ - 1.0f) * kac)) * rkc;
            }
            n2 = sum8(n2); bon = sum8(bon);
            if ((tid & 7) == 0) { gt[576 + i] = 1.0f / fmaxf(sqrtf(n2), 1e-12f); p.bonG[(size_t)u * 64 + i] = bon; }
        }
        __syncthreads();
        {
            const int ch = lane, cg = layer * 512 + h * 64 + ch;
            float lw[8], av[8], cum[8];
            {
                const f32x4 l0 = *(const f32x4*)(lwT + ch * 68 + wv * 8), l1 = *(const f32x4*)(lwT + ch * 68 + wv * 8 + 4);
#pragma unroll
                for (int e = 0; e < 4; ++e) { lw[e] = l0[e]; lw[e + 4] = l1[e]; }
#pragma unroll
                for (int e = 0; e < 8; ++e) av[e] = aT[(wv * 8 + e) * 68 + ch];
            }
            float run = 0.f;
#pragma unroll
            for (int e = 0; e < 8; ++e) { run += lw[e]; cum[e] = run; }
            gt[wv * 64 + ch] = run;
            __syncthreads();
            float offs = 0.f, tot = 0.f;
#pragma unroll
            for (int g2 = 0; g2 < 8; ++g2) { const float gv = gt[g2 * 64 + ch]; offs += g2 < wv ? gv : 0.f; tot += gv; }
            if (wv == 0) gammaC[ch] = __expf(tot);
            const float kkc = p.k_k[cg], kac = p.k_a[cg];
            float at_[8], kt_[8], bt_[8], vt_[8];
#pragma unroll
            for (int e = 0; e < 8; ++e) {
                const int i = wv * 8 + e;
                const float xr = bf2f(RBUF(8)[i * LS + ch]), xk = bf2f(RBUF(9)[i * LS + ch]), xv = bf2f(RBUF(10)[i * LS + ch]);
                const float cm = cum[e] + offs;
                const float kk = xk * kkc * gt[576 + i];
                const float kq = xk * (1.0f + (av[e] - 1.0f) * kac);
                if (c * 64 + i < L) p.orw[(tok0 + i) * 512 + h * 64 + ch] = RBUF(10)[i * LS + ch];
                const float eneg = __expf(-cm), epos = __expf(cm), eexc = __expf(cm - lw[e]);
                at_[e] = -kk * eexc; kt_[e] = kq * eneg; bt_[e] = kk * av[e] * eneg; vt_[e] = xv;
                RBUF(3)[i * LS + ch] = f2bf(xr * epos);
            }
            __syncthreads();
#pragma unroll
            for (int e = 0; e < 8; ++e) {
                const int i = wv * 8 + e;
                RBUF(0)[i * LS + ch] = f2bf(at_[e]); RBUF(1)[i * LS + ch] = f2bf(kt_[e]); RBUF(2)[i * LS + ch] = f2bf(bt_[e]);
            }
            *(u32x4*)(RBUF(11) + ch * LS + wv * 8) = (u32x4){pack2(kt_[0], kt_[1]), pack2(kt_[2], kt_[3]), pack2(kt_[4], kt_[5]), pack2(kt_[6], kt_[7])};
            *(u32x4*)(RBUF(12) + ch * LS + wv * 8) = (u32x4){pack2(bt_[0], bt_[1]), pack2(bt_[2], bt_[3]), pack2(bt_[4], bt_[5]), pack2(bt_[6], bt_[7])};
            *(u32x4*)(RBUF(13) + ch * LS + wv * 8) = (u32x4){pack2(vt_[0], vt_[1]), pack2(vt_[2], vt_[3]), pack2(vt_[4], vt_[5]), pack2(vt_[6], vt_[7])};
            *(u32x4*)(Xt0 + ch * LS + wv * 8) = (u32x4){pack2(at_[0], at_[1]), pack2(at_[2], at_[3]), pack2(at_[4], at_[5]), pack2(at_[6], at_[7])};
        }
        __syncthreads();
#pragma unroll
        for (int prod = 0; prod < 4; ++prod) {
            const bf16_t* F = (prod == 0 || prod == 2) ? RBUF(1) : RBUF(2);
            const bf16_t* S = prod < 2 ? RBUF(0) : RBUF(3);
            bf16_t* O = prod == 0 ? RBUF(6) : prod == 1 ? RBUF(7) : prod == 2 ? RBUF(9) : RBUF(10);
            const int mode = prod < 2 ? 0 : 1;
#pragma unroll
            for (int rep = 0; rep < 2; ++rep) {
                const int tl = wv + 8 * rep, pt = tl >> 2, qt = tl & 3;
                f32x4 acc = zero;
                if (pt <= qt) acc = mm16<64>(F + pt * 16 * LS, LS, S + qt * 16 * LS, LS, zero, lane);
                const int qi = qt * 16 + fr;
#pragma unroll
                for (int e = 0; e < 4; ++e) {
                    const int pi = pt * 16 + fq * 4 + e;
                    const bool keep = mode == 0 ? pi < qi : pi <= qi;
                    acc[e] = keep ? acc[e] : 0.f;
                }
                *(u32x2*)(O + qi * LS + pt * 16 + fq * 4) = pk4(acc);
                if (prod == 1) {
#pragma unroll
                    for (int e = 0; e < 4; ++e) RBUF(8)[(pt * 16 + fq * 4 + e) * LS + qi] = f2bf(acc[e]);
                }
            }
        }
        __syncthreads();
        f32x4 X[4];
        if (wv < 4) {
#pragma unroll
            for (int pt = 0; pt < 4; ++pt) X[pt] = up4(*(const u32x2*)(Xt0 + (wv * 16 + fr) * LS + pt * 16 + fq * 4));
        } else {
#pragma unroll
            for (int pt = 0; pt < 4; ++pt) {
                X[pt] = mm16<64>(RBUF(6) + pt * 16 * LS, LS, RBUF(13) + (wv - 4) * 16 * LS, LS, zero, lane);
                *(u32x2*)(Xt0 + (wv * 16 + fr) * LS + pt * 16 + fq * 4) = pk4(X[pt]);
            }
        }
        __syncthreads();
#pragma unroll
        for (int k = 0; k < 6; ++k) {
            const bf16_t* Mk = (k & 1) ? RBUF(0) : RBUF(7);
            const bf16_t* Mkt = (k & 1) ? RBUF(6) : RBUF(8);
            bf16_t* Mn = (k & 1) ? RBUF(7) : RBUF(0);
            bf16_t* Mnt = (k & 1) ? RBUF(8) : RBUF(6);
            const bf16_t* Xc = (k & 1) ? Xt1 : Xt0;
            bf16_t* Xn = (k & 1) ? Xt0 : Xt1;
#pragma unroll
            for (int pt = 0; pt < 4; ++pt) {
                constexpr int dummy = 0; (void)dummy;
                const int maxj = 16 * pt + 15 - (1 << k);
                if (maxj >= 0) {
                    const int nks = maxj / 32 + 1;
#pragma unroll
                    for (int ks = 0; ks < 2; ++ks)
                        if (ks < nks) {
                            const bf16x8 f = *(const bf16x8*)(Mk + (pt * 16 + fr) * LS + ks * 32 + fq * 8);
                            const bf16x8 g = *(const bf16x8*)(Xc + (wv * 16 + fr) * LS + ks * 32 + fq * 8);
                            X[pt] = __builtin_amdgcn_mfma_f32_16x16x32_bf16(f, g, X[pt], 0, 0, 0);
                        }
                }
                *(u32x2*)(Xn + (wv * 16 + fr) * LS + pt * 16 + fq * 4) = pk4(X[pt]);
            }
            if (k < 5) {
#pragma unroll
                for (int rep = 0; rep < 2; ++rep) {
                    const int t2 = wv + 8 * rep, pt = t2 >> 2, qt = t2 & 3;
                    f32x4 acc = zero;
                    const int mlo = 16 * pt + (1 << k), mhi = 16 * qt + 15 - (1 << k);
                    if (16 * qt + 15 - 16 * pt >= (2 << k) && mhi >= mlo) {
                        const int k0 = mlo >> 5, k1 = mhi >> 5;
                        for (int ks = k0; ks <= k1; ++ks) {
                            const bf16x8 f = *(const bf16x8*)(Mkt + (pt * 16 + fr) * LS + ks * 32 + fq * 8);
                            const bf16x8 g = *(const bf16x8*)(Mk + (qt * 16 + fr) * LS + ks * 32 + fq * 8);
                            acc = __builtin_amdgcn_mfma_f32_16x16x32_bf16(f, g, acc, 0, 0, 0);
                        }
                    }
                    *(u32x2*)(Mn + (qt * 16 + fr) * LS + pt * 16 + fq * 4) = pk4(acc);
#pragma unroll
                    for (int e = 0; e < 4; ++e) Mnt[(pt * 16 + fq * 4 + e) * LS + qt * 16 + fr] = f2bf(acc[e]);
                }
            }
            __syncthreads();
        }
#pragma unroll
        for (int rep = 0; rep < 2; ++rep) {
            const int tl = wv + 8 * rep, pt = tl >> 2, qt = tl & 3;
            const int pi0 = pt * 16 + fq * 4, qi = qt * 16 + fr;
            const size_t go = ((size_t)u * 64 + qi) * 64 + pi0;
            {
                f32x4 acc = mm16<64>(Xt0 + pt * 16 * LS, LS, RBUF(12) + qt * 16 * LS, LS, zero, lane);
                const float gc = gammaC[qi];
#pragma unroll
                for (int e = 0; e < 4; ++e) acc[e] = (acc[e] + (pi0 + e == qi ? 1.f : 0.f)) * gc;
                {
                    const size_t d = (((size_t)u * 8 + (qi >> 4) * 2 + (pi0 >> 5)) * 64 + (qi & 15) + 16 * ((pi0 >> 2) & 3)) * 8 + ((pi0 >> 4) & 1) * 4;
                    *(u32x2*)(p.PcG + d) = pk4(acc);
                }
            }
            {
                f32x4 acc = mm16<64>(RBUF(11) + pt * 16 * LS, LS, RBUF(13) + qt * 16 * LS, LS, zero, lane);
                acc = mm16<64>(RBUF(12) + pt * 16 * LS, LS, Xt0 + (64 + qt * 16) * LS, LS, acc, lane);
                const f32x4 gc = *(const f32x4*)(gammaC + pi0);
#pragma unroll
                for (int e = 0; e < 4; ++e) acc[e] *= gc[e];
                {
                    const size_t d = (((size_t)u * 4 + (qi >> 4)) * 64 + (qi & 15) + 16 * ((pi0 >> 2) & 3)) * 16 + (pi0 >> 4) * 4;
                    *(u32x2*)(p.QcG + d) = pk4(acc);
                }
            }
            {
                f32x4 acc = mm16<64>(Xt0 + pt * 16 * LS, LS, RBUF(10) + qt * 16 * LS, LS, zero, lane);
                const f32x4 rr = up4(*(const u32x2*)(RBUF(3) + qi * LS + pi0));
#pragma unroll
                for (int e = 0; e < 4; ++e) acc[e] += rr[e];
                *(u32x2*)(p.RhG + go) = pk4(acc);
            }
            {
                f32x4 acc = mm16<64>(RBUF(13) + pt * 16 * LS, LS, RBUF(9) + qt * 16 * LS, LS, zero, lane);
                acc = mm16<64>(Xt0 + (64 + pt * 16) * LS, LS, RBUF(10) + qt * 16 * LS, LS, acc, lane);
                *(u32x2*)(p.Y0G + go) = pk4(acc);
            }
        }
    }
}

struct R2Set { u32x4 a[8]; u32x4 q[2]; };
DI void r2_load(R2Set& st, const Params& p, size_t u, int lane, int vq) {
    const bf16_t* qg = p.QcG + ((u * 4 + vq) * 64 + lane) * 16;
    st.q[0] = *(const u32x4*)qg; st.q[1] = *(const u32x4*)(qg + 8);
#pragma unroll
    for (int f = 0; f < 8; ++f) st.a[f] = *(const u32x4*)(p.PcG + ((u * 8 + f) * 64 + lane) * 8);
}
DI void r2_step(f32x4 (&S)[4], const R2Set& st, const Params& p, size_t u, int lane, int vq, bool last) {
    const u32x4 b0 = (u32x4){pack2(S[0][0], S[0][1]), pack2(S[0][2], S[0][3]), pack2(S[1][0], S[1][1]), pack2(S[1][2], S[1][3])};
    const u32x4 b1 = (u32x4){pack2(S[2][0], S[2][1]), pack2(S[2][2], S[2][3]), pack2(S[3][0], S[3][1]), pack2(S[3][2], S[3][3])};
    bf16_t* sg = p.SG + ((u * 4 + vq) * 64 + lane) * 16;
    *(u32x4*)sg = b0; *(u32x4*)(sg + 8) = b1;
    if (last) return;
#pragma unroll
    for (int kt = 0; kt < 4; ++kt) {
        const u32x4 qq = st.q[kt >> 1];
        const unsigned w0 = qq[(kt & 1) * 2], w1 = qq[(kt & 1) * 2 + 1];
        S[kt] = (f32x4){lo_bf(w0), hi_bf(w0), lo_bf(w1), hi_bf(w1)};
    }
    const bf16x8 f0 = __builtin_bit_cast(bf16x8, b0), f1 = __builtin_bit_cast(bf16x8, b1);
#pragma unroll
    for (int kt = 0; kt < 4; ++kt) {
        S[kt] = __builtin_amdgcn_mfma_f32_16x16x32_bf16(__builtin_bit_cast(bf16x8, st.a[kt * 2]), f0, S[kt], 0, 0, 0);
        S[kt] = __builtin_amdgcn_mfma_f32_16x16x32_bf16(__builtin_bit_cast(bf16x8, st.a[kt * 2 + 1]), f1, S[kt], 0, 0, 0);
    }
}
DI void phase_rwkv_r2(const Params& p, int chain) {
    const int lane = tid_() & 63;
    const int bh = chain >> 2, vq = chain & 3;
    const size_t u0 = (size_t)bh * NCHUNK;
    f32x4 S[4];
#pragma unroll
    for (int kt = 0; kt < 4; ++kt) S[kt] = (f32x4){0.f, 0.f, 0.f, 0.f};
    R2Set A, B, C, E;
    r2_load(A, p, u0, lane, vq); r2_load(B, p, u0 + 1, lane, vq); r2_load(C, p, u0 + 2, lane, vq); r2_load(E, p, u0 + 3, lane, vq);
#define R2_ONE(SET, cc) do { r2_step(S, SET, p, u0 + (cc), lane, vq, (cc) == NCHUNK - 1); if ((cc) + 4 < NCHUNK - 1) r2_load(SET, p, u0 + (cc) + 4, lane, vq); } while (0)
#pragma unroll 1
    for (int c = 0; c < NCHUNK; c += 4) {
        R2_ONE(A, c);
        if (c == NCHUNK - 1) break;
        R2_ONE(B, c + 1);
        R2_ONE(C, c + 2);
        R2_ONE(E, c + 3);
    }
#undef R2_ONE
}

DI void phase_rwkv_r3(const Params& p, int layer, int bid, int nb) {
    const int tid = tid_(), lane = tid & 63, wv = __builtin_amdgcn_readfirstlane(tid >> 6), fr = lane & 15, fq = lane >> 4;
    for (int task = bid * 8 + wv; task < NUNIT * 4; task += nb * 8) {
        const int u = task >> 2, it = task & 3;
        const int c = u % NCHUNK, bh = u / NCHUNK, h = bh % HEADS, bb = bh / HEADS;
        const int i = it * 16 + fr, t = c * 64 + i;
        const bool live = t < L;
        const size_t tok = (size_t)bb * L + (live ? t : 0);
        bf16x8 sf[2];
#pragma unroll
        for (int ks = 0; ks < 2; ++ks) sf[ks] = *(const bf16x8*)(p.RhG + ((size_t)u * 64 + i) * 64 + ks * 32 + fq * 8);
        u32x2 s0[4][2], s1[4][2], y0[4], xvv[4], gv[4];
#pragma unroll
        for (int vt = 0; vt < 4; ++vt) {
            const int vv = vt * 16 + fr;
#pragma unroll
            for (int ks = 0; ks < 2; ++ks) {
                const bf16_t* sp = p.SG + (((size_t)u * 4 + vt) * 64 + fr + 32 * (fq & 1)) * 16 + (2 * ks + (fq >> 1)) * 4;
                s0[vt][ks] = *(const u32x2*)sp; s1[vt][ks] = *(const u32x2*)(sp + 16 * 16);
                (void)vv;
            }
            y0[vt] = *(const u32x2*)(p.Y0G + ((size_t)u * 64 + i) * 64 + vt * 16 + fq * 4);
            xvv[vt] = *(const u32x2*)(p.orw + tok * 512 + h * 64 + vt * 16 + fq * 4);
            gv[vt] = *(const u32x2*)(p.GG + ((size_t)u * 64 + i) * 64 + vt * 16 + fq * 4);
        }
        const float bon = p.bonG[(size_t)u * 64 + i];
        f32x4 y[4];
#pragma unroll
        for (int vt = 0; vt < 4; ++vt) {
            y[vt] = up4(y0[vt]);
#pragma unroll
            for (int ks = 0; ks < 2; ++ks) {
                const bf16x8 f = __builtin_bit_cast(bf16x8, ((u32x4){s0[vt][ks][0], s0[vt][ks][1], s1[vt][ks][0], s1[vt][ks][1]}));
                y[vt] = __builtin_amdgcn_mfma_f32_16x16x32_bf16(f, sf[ks], y[vt], 0, 0, 0);
            }
        }
        float s = 0.f;
#pragma unroll
        for (int vt = 0; vt < 4; ++vt) s += (y[vt][0] + y[vt][1]) + (y[vt][2] + y[vt][3]);
        s += __shfl_xor(s, 16); s += __shfl_xor(s, 32);
        const float mean = s * (1.0f / 64.f);
        float q = 0.f;
#pragma unroll
        for (int vt = 0; vt < 4; ++vt)
#pragma unroll
            for (int e = 0; e < 4; ++e) { y[vt][e] -= mean; q += y[vt][e] * y[vt][e]; }
        q += __shfl_xor(q, 16); q += __shfl_xor(q, 32);
        const float rstd = rsqrtf(q * (1.0f / 64.f) + 64e-5f);
        if (live) {
#pragma unroll
            for (int vt = 0; vt < 4; ++vt) {
                const int cg = h * 64 + vt * 16 + fq * 4;
                const f32x4 xv = up4(xvv[vt]), g = up4(gv[vt]);
                const f32x4 lg = *(const f32x4*)(p.lnx_g + layer * 512 + cg), lb = *(const f32x4*)(p.lnx_b + layer * 512 + cg);
                f32x4 o;
#pragma unroll
                for (int e = 0; e < 4; ++e) o[e] = (y[vt][e] * rstd * lg[e] + lb[e] + bon * xv[e]) * g[e];
                *(u32x2*)(p.orw + tok * 512 + cg) = pk4(o);
            }
        }
    }
}

constexpr int SB_LDS = 4 * RB + 64;
DI void phase_sb(const Params& p, int bid0, int nb, char* smem) {
    const int tid = tid_(), lane = tid & 63, wv = __builtin_amdgcn_readfirstlane(tid >> 6), fr = lane & 15, fq = lane >> 4;
    bf16_t* Ks0 = (bf16_t*)smem;
    bf16_t* Vt0 = Ks0 + 2 * 64 * LS;
    int* flags = (int*)(smem + 4 * RB);
    bf16x8 tri[4][2];
#pragma unroll
    for (int st = 0; st < 4; ++st)
#pragma unroll
        for (int k2 = 0; k2 < 2; ++k2)
#pragma unroll
            for (int jj = 0; jj < 8; ++jj) tri[st][k2][jj] = (32 * k2 + 16 * (jj >> 2) + 4 * fq + (jj & 3) > 16 * st + fr) ? (short)0x3F80 : (short)0;
    constexpr int NQB = (L + 127) / 128;
    const int ldkey = tid >> 3, lddc = (tid & 7) * 8;
    for (int u = bid0; u < NBATCH * HEADS * NQB; u += nb) {
        const int bh = u % (NBATCH * HEADS), b = bh / HEADS, h = bh % HEADS, q0 = (u / (NBATCH * HEADS)) * 128;
        const int qlo = q0 + 16 * wv, query = qlo + fr;
        const size_t tokb = (size_t)b * L;
        bf16x8 qf[2];
#pragma unroll
        for (int ks = 0; ks < 2; ++ks) qf[ks] = *(const bf16x8*)(p.P + (tokb + query) * CP + OFF_Q + h * 64 + ks * 32 + fq * 8);
        const int qmax = (q0 + 127 < L - 1) ? q0 + 127 : L - 1;
        int kt = (qmax - 1) >> 6;
        float R = 0.f;
        f32x4 ot[4];
#pragma unroll
        for (int dt = 0; dt < 4; ++dt) ot[dt] = (f32x4){0.f, 0.f, 0.f, 0.f};
        bool done = qlo >= L;
        u32x4 kreg, vreg;
        {
            const int s = kt * 64 + ldkey;
            const bf16_t* src = p.P + (tokb + s) * CP + h * 64 + lddc;
            kreg = s < L ? *(const u32x4*)(src + OFF_K) : (u32x4){0u, 0u, 0u, 0u};
            vreg = s < L ? *(const u32x4*)(src + OFF_V) : (u32x4){0u, 0u, 0u, 0u};
        }
        const int vsw = (tid & 7) << 2;
        __syncthreads();
        {
            *(u32x4*)(Ks0 + ldkey * LS + lddc) = kreg;
#pragma unroll
            for (int j = 0; j < 4; ++j) { Vt0[(lddc + 2 * j) * LS + (ldkey ^ vsw)] = (bf16_t)(vreg[j] & 0xFFFFu); Vt0[(lddc + 2 * j + 1) * LS + (ldkey ^ vsw)] = (bf16_t)(vreg[j] >> 16); }
        }
        __syncthreads();
        for (int itile = 0;; ++itile) {
            const bf16_t* Ks = Ks0 + (itile & 1) * 64 * LS; const bf16_t* Vt = Vt0 + (itile & 1) * 64 * LS;
            if (kt > 0) {
                const int s = (kt - 1) * 64 + ldkey;
                const bf16_t* src = p.P + (tokb + s) * CP + h * 64 + lddc;
                kreg = *(const u32x4*)(src + OFF_K); vreg = *(const u32x4*)(src + OFF_V);
            }
            if (!done && kt * 64 < qlo + 15) {
                f32x4 uu[4], lsp[4];
                float tot = 0.f;
                const bool full = kt * 64 + 63 < qlo;
#pragma unroll
                for (int kk = 0; kk < 4; ++kk) {
                    f32x4 z = (f32x4){0.f, 0.f, 0.f, 0.f};
#pragma unroll
                    for (int ks = 0; ks < 2; ++ks) {
                        const bf16x8 f = *(const bf16x8*)(Ks + (16 * kk + fr) * LS + ks * 32 + fq * 8);
                        z = __builtin_amdgcn_mfma_f32_16x16x32_bf16(f, qf[ks], z, 0, 0, 0);
                    }
#pragma unroll
                    for (int e = 0; e < 4; ++e) {
                        const float zz = z[e] * 0.18033688011112042f;
                        const float lsneg = -(fmaxf(zz, 0.f) + __builtin_amdgcn_logf(1.0f + __builtin_amdgcn_exp2f(-fabsf(zz))));
                        if (full) { uu[kk][e] = lsneg; lsp[kk][e] = lsneg + zz; }
                        else {
                            const bool valid = kt * 64 + 16 * kk + 4 * fq + e < query;
                            uu[kk][e] = valid ? lsneg : 0.f;
                            lsp[kk][e] = valid ? lsneg + zz : -1.0e30f;
                        }
                        tot += uu[kk][e];
                    }
                }
                tot += __shfl_xor(tot, 16); tot += __shfl_xor(tot, 32);
                f32x4 rest[4];
#pragma unroll
                for (int st = 0; st < 4; ++st) rest[st] = (f32x4){0.f, 0.f, 0.f, 0.f};
#pragma unroll
                for (int k2 = 0; k2 < 2; ++k2) {
                    u32x4 hi, lo;
#pragma unroll
                    for (int t2 = 0; t2 < 2; ++t2) {
                        const f32x4 a = uu[2 * k2 + t2];
                        const unsigned h0 = pack2(a[0], a[1]), h1 = pack2(a[2], a[3]);
                        hi[2 * t2] = h0; hi[2 * t2 + 1] = h1;
                        lo[2 * t2] = pack2(a[0] - lo_bf(h0), a[1] - hi_bf(h0)); lo[2 * t2 + 1] = pack2(a[2] - lo_bf(h1), a[3] - hi_bf(h1));
                    }
                    const bf16x8 fh = __builtin_bit_cast(bf16x8, hi), fl = __builtin_bit_cast(bf16x8, lo);
#pragma unroll
                    for (int st = 0; st < 4; ++st) {
                        rest[st] = __builtin_amdgcn_mfma_f32_16x16x32_bf16(tri[st][k2], fh, rest[st], 0, 0, 0);
                        rest[st] = __builtin_amdgcn_mfma_f32_16x16x32_bf16(tri[st][k2], fl, rest[st], 0, 0, 0);
                    }
                }
                bf16x8 af[2];
#pragma unroll
                for (int k2 = 0; k2 < 2; ++k2) {
                    u32x4 pk;
#pragma unroll
                    for (int t2 = 0; t2 < 2; ++t2) {
                        const int kk = 2 * k2 + t2;
                        float a4[4];
#pragma unroll
                        for (int e = 0; e < 4; ++e) a4[e] = __builtin_amdgcn_exp2f(lsp[kk][e] + R + rest[kk][e]);
                        pk[2 * t2] = pack2(a4[0], a4[1]); pk[2 * t2 + 1] = pack2(a4[2], a4[3]);
                    }
                    af[k2] = __builtin_bit_cast(bf16x8, pk);
                }
                R += tot;
#pragma unroll
                for (int dt = 0; dt < 4; ++dt)
#pragma unroll
                    for (int k2 = 0; k2 < 2; ++k2) {
                        const int dsw = ((2 * dt + (fr >> 3)) & 7) << 2;
                        const bf16_t* vrow = Vt + (16 * dt + fr) * LS;
                        const u32x2 v0 = *(const u32x2*)(vrow + ((32 * k2 + 4 * fq) ^ dsw)), v1 = *(const u32x2*)(vrow + ((32 * k2 + 16 + 4 * fq) ^ dsw));
                        const bf16x8 f = __builtin_bit_cast(bf16x8, ((u32x4){v0[0], v0[1], v1[0], v1[1]}));
                        ot[dt] = __builtin_amdgcn_mfma_f32_16x16x32_bf16(f, af[k2], ot[dt], 0, 0, 0);
                    }
                done = __all((R < -150.1f) || (query >= L));
            }
            if (kt > 0) {
                bf16_t* Kn = Ks0 + ((itile & 1) ^ 1) * 64 * LS; bf16_t* Vn = Vt0 + ((itile & 1) ^ 1) * 64 * LS;
                *(u32x4*)(Kn + ldkey * LS + lddc) = kreg;
#pragma unroll
                for (int j = 0; j < 4; ++j) { Vn[(lddc + 2 * j) * LS + (ldkey ^ vsw)] = (bf16_t)(vreg[j] & 0xFFFFu); Vn[(lddc + 2 * j + 1) * LS + (ldkey ^ vsw)] = (bf16_t)(vreg[j] >> 16); }
            }
            if (lane == 0) flags[(itile & 1) * 8 + wv] = done ? 1 : 0;
            __syncthreads();
            int alld = 1;
#pragma unroll
            for (int w = 0; w < 8; ++w) alld &= flags[(itile & 1) * 8 + w];
            if (alld || kt == 0) break;
            --kt;
        }
        if (query < L) {
#pragma unroll
            for (int dt = 0; dt < 4; ++dt) *(u32x2*)(p.osb + (tokb + query) * 512 + h * 64 + 16 * dt + 4 * fq) = pk4(ot[dt]);
        }
    }
}

struct EpiBranch {
    static constexpr bool PERM = true;
    const bf16_t* G; bf16_t* M; bool add;
    DI void operator()(const f32x4 (&acc)[2][2][4][2], const g8::Unit& u, int wr, int wc, int fr, int fq) const {
        const int c0 = u.pn * 256 + wc * 32 + 8 * fq;
#pragma unroll
        for (int ai = 0; ai < 2; ++ai) {
            u32x4 g[4][2], mo[4][2];
#pragma unroll
            for (int m = 0; m < 4; ++m)
#pragma unroll
                for (int bj = 0; bj < 2; ++bj) {
                    const size_t r = (size_t)(u.pm * 256 + ai * 128 + wr * 64 + m * 16 + fr);
                    g[m][bj] = *(const u32x4*)(G + r * 2048 + c0 + bj * 128);
                    mo[m][bj] = add ? *(const u32x4*)(M + r * D + c0 + bj * 128) : (u32x4){0u, 0u, 0u, 0u};
                }
#pragma unroll
            for (int m = 0; m < 4; ++m)
#pragma unroll
                for (int bj = 0; bj < 2; ++bj) {
                    const size_t r = (size_t)(u.pm * 256 + ai * 128 + wr * 64 + m * 16 + fr);
                    const f32x4 v0 = acc[ai][bj][m][0], v1 = acc[ai][bj][m][1];
                    const u32x4 gg = g[m][bj], mm = mo[m][bj];
                    float o[8] = {lo_bf(gg[0]) * v0[0], hi_bf(gg[0]) * v0[1], lo_bf(gg[1]) * v0[2], hi_bf(gg[1]) * v0[3], lo_bf(gg[2]) * v1[0], hi_bf(gg[2]) * v1[1], lo_bf(gg[3]) * v1[2], hi_bf(gg[3]) * v1[3]};
#pragma unroll
                    for (int q = 0; q < 4; ++q) { o[2 * q] += lo_bf(mm[q]); o[2 * q + 1] += hi_bf(mm[q]); }
                    *(u32x4*)(M + r * D + c0 + bj * 128) = (u32x4){pack2(o[0], o[1]), pack2(o[2], o[3]), pack2(o[4], o[5]), pack2(o[6], o[7])};
                }
        }
    }
};
struct GateOrder {
    g8::DenseOrder d;
    DI bool next(int i, g8::Unit& u) const { return d.next(i, u); }
    DI unsigned row_off(const g8::Unit&, int) const { return 0u; }
};
struct EpiGate {
    static constexpr bool PERM = true;
    bf16_t* G;
    DI void operator()(const f32x4 (&acc)[2][2][4][2], const g8::Unit& u, int wr, int wc, int fr, int fq) const {
#pragma unroll
        for (int ai = 0; ai < 2; ++ai)
#pragma unroll
            for (int m = 0; m < 4; ++m) {
                bf16_t* rowp = G + (size_t)(u.pm * 256 + ai * 128 + wr * 64 + m * 16 + fr) * 2048 + u.pn * 256 + wc * 32 + 8 * fq;
#pragma unroll
                for (int bj = 0; bj < 2; ++bj) {
                    const f32x4 v0 = acc[ai][bj][m][0], v1 = acc[ai][bj][m][1];
                    *(u32x4*)(rowp + bj * 128) = (u32x4){pack2(sigmoidf_(v0[0]), sigmoidf_(v0[1])), pack2(sigmoidf_(v0[2]), sigmoidf_(v0[3])), pack2(sigmoidf_(v1[0]), sigmoidf_(v1[1])), pack2(sigmoidf_(v1[2]), sigmoidf_(v1[3]))};
                }
            }
    }
};
template <int PART> DI void phase_merge(const Params& p, int layer, int bid, int nb, char* smem) {
    const bf16_t* hb = p.hb; bf16_t* G = p.gates; bf16_t* M = p.merged;
    const bf16_t* Wg = p.WtIn + ((size_t)layer * CIN + CP) * D;
    G8_LAS unsigned char* lds = (G8_LAS unsigned char*)smem;
    if (PART == 0) {
#pragma unroll
    for (int which = 0; which < 2; ++which) {
        g8::DenseOrder S; S.init(hb, Wg + (size_t)which * 1024 * D, MFULL, D / 256, D, nb, bid);
        g8::gemm8<false>(lds, D, S, EpiGate{G + which * 1024});
    }
    }
    if (PART == 1) {
#pragma unroll
    for (int which = 0; which < 2; ++which) {
        const bf16_t* A = which ? p.orw : p.osb;
        const bf16_t* Bt = (which ? p.WtPrw : p.WtPsb) + (size_t)layer * D * 512;
        g8::DenseOrder S; S.init(A, Bt, MFULL, D / 256, 512, nb, bid);
        g8::gemm8<false>(lds, 512, S, EpiBranch{G + which * 1024, M, which != 0});
    }
    }
    if (PART == 1)
    for (int t = left_first(MFULL * 4 * 2, bid, nb); t < D / 128; t += nb) {
#pragma unroll
        for (int which = 0; which < 2; ++which) {
            const bf16_t* A = which ? p.orw : p.osb; const bf16_t* Gw = p.gleft - (size_t)M0_LEFT * 2048 + which * 1024;
            const bf16_t* Bt = (which ? p.WtPrw : p.WtPsb) + (size_t)layer * D * 512;
            gemm_left32([=](int r) { return A + (size_t)(M0_LEFT + r) * 512; }, Bt, 512, 512, t * 128, smem,
                        [=](int r0, int c, f32x4 v) {
                            const size_t r = (size_t)(M0_LEFT + r0);
                            const u32x2 g = *(const u32x2*)(Gw + r * 2048 + c);
                            float o0 = lo_bf(g[0]) * v[0], o1 = hi_bf(g[0]) * v[1], o2 = lo_bf(g[1]) * v[2], o3 = hi_bf(g[1]) * v[3];
                            u32x2* mp = (u32x2*)(M + r * D + c);
                            if (which) { const u32x2 m = *mp; o0 += lo_bf(m[0]); o1 += hi_bf(m[0]); o2 += lo_bf(m[1]); o3 += hi_bf(m[1]); }
                            *mp = (u32x2){pack2(o0, o1), pack2(o2, o3)};
                        });
        }
    }
}
struct EpiOut {
    static constexpr bool PERM = false;
    float* hmeta; float* out; const bf16_t* hb;
    DI void operator()(const f32x4 (&acc)[2][2][4][2], const g8::Unit& u, int wr, int wc, int fr, int fq) const {
        const int c0 = u.pn * 256 + wc * 32 + 4 * fq;
#pragma unroll
        for (int ai = 0; ai < 2; ++ai) {
            u32x2 hv[4][2][2];
#pragma unroll
            for (int m = 0; m < 4; ++m) {
                const bf16_t* hbp = hb + (size_t)(u.pm * 256 + ai * 128 + wr * 64 + m * 16 + fr) * D + c0;
#pragma unroll
                for (int bj = 0; bj < 2; ++bj)
#pragma unroll
                    for (int n = 0; n < 2; ++n) hv[m][bj][n] = *(const u32x2*)(hbp + bj * 128 + n * 16);
            }
#pragma unroll
            for (int m = 0; m < 4; ++m) {
                float* rowp = hrow2(hmeta, out, u.pm * 256 + ai * 128 + wr * 64 + m * 16 + fr) + c0;
#pragma unroll
                for (int bj = 0; bj < 2; ++bj)
#pragma unroll
                    for (int n = 0; n < 2; ++n) {
                        const f32x4 h = up4(hv[m][bj][n]), v = acc[ai][bj][m][n];
                        *(f32x4*)(rowp + bj * 128 + n * 16) = (f32x4){ALPHA * h[0] + v[0], ALPHA * h[1] + v[1], ALPHA * h[2] + v[2], ALPHA * h[3] + v[3]};
                    }
            }
        }
    }
};
DI void phase_outproj(const Params& p, int layer, int bid, int nb, char* smem) {
    const bf16_t* A = p.merged; float* const hmeta = p.hmeta; float* const outp = p.out; const bf16_t* hbres = p.hb;
    const bf16_t* Bt = p.WtOut + (size_t)layer * D * D;
    if (bid == 0 && tid_() < NE) p.counts[tid_()] = 0;
    g8::DenseOrder S; S.init(A, Bt, MFULL, D / 256, D, nb, bid);
    g8::gemm8<false>((G8_LAS unsigned char*)smem, D, S, EpiOut{hmeta, outp, hbres});
    for (int t = left_first(MFULL * 4, bid, nb); t < D / 128; t += nb)
        gemm_left32([=](int r) { return A + (size_t)(M0_LEFT + r) * D; }, Bt, D, D, t * 128, smem,
                    [=](int r0, int c, f32x4 v) {
                        const int r = M0_LEFT + r0;
                        const f32x4 h = up4(*(const u32x2*)(hbres + (size_t)r * D + c));
                        *(f32x4*)(hrow2(hmeta, outp, r) + c) = (f32x4){ALPHA * h[0] + v[0], ALPHA * h[1] + v[1], ALPHA * h[2] + v[2], ALPHA * h[3] + v[3]};
                    });
}

constexpr int LN1_ROWB = 2 * D + 16;
constexpr int LN1_WAVE = 8 * LN1_ROWB;
constexpr int LN1_LDS = 8 * LN1_WAVE + 2048;
DI void phase_ln1_router(const Params& p, int layer, int bid, int nb, char* smem) {
    const int tid = tid_(), lane = tid & 63, wid = __builtin_amdgcn_readfirstlane(tid >> 6), fr = lane & 15, fq = lane >> 4;
    char* wl = smem + wid * LN1_WAVE;
    int* sel = (int*)(smem + 8 * LN1_WAVE);
    float* sgt = (float*)(smem + 8 * LN1_WAVE + 640);
    int* sbase = (int*)(smem + 8 * LN1_WAVE + 1280);
    const int nwaves = nb * 8, gw = bid * 8 + wid;
    const int base_n = T / nwaves, extra = T % nwaves;
    const int tok0 = gw * base_n + (gw < extra ? gw : extra), ntok = base_n + (gw < extra ? 1 : 0);
    const int btok0 = bid * 8 * base_n + (bid * 8 < extra ? bid * 8 : extra);
    const float* g1p = p.ln1_g + layer * D; const float* b1p = p.ln1_b + layer * D;
    __syncthreads();
    for (int g0 = 0; g0 < ntok; g0 += 4) {
        const int ng = ntok - g0 < 4 ? ntok - g0 : 4;
        float vn[16];
        { const float* hf = hrow_u(p, tok0 + g0);
#pragma unroll
          for (int j = 0; j < 4; ++j) { const f32x4 a = *(const f32x4*)(hf + 256 * j + 4 * lane); vn[4 * j] = a[0]; vn[4 * j + 1] = a[1]; vn[4 * j + 2] = a[2]; vn[4 * j + 3] = a[3]; } }
#pragma unroll 1
        for (int i = 0; i < ng; ++i) {
            const int tok = tok0 + g0 + i;
            float v[16];
#pragma unroll
            for (int q = 0; q < 16; ++q) v[q] = vn[q];
            if (i + 1 < ng) { const float* hn = hrow_u(p, tok + 1);
#pragma unroll
                for (int j = 0; j < 4; ++j) { const f32x4 a = *(const f32x4*)(hn + 256 * j + 4 * lane); vn[4 * j] = a[0]; vn[4 * j + 1] = a[1]; vn[4 * j + 2] = a[2]; vn[4 * j + 3] = a[3]; } }
            ln16(v, g1p, b1p, lane);
#pragma unroll
            for (int j = 0; j < 4; ++j) {
                const unsigned h0 = pack2(v[4 * j], v[4 * j + 1]), h1 = pack2(v[4 * j + 2], v[4 * j + 3]);
                *(u32x2*)(p.hb + (size_t)tok * D + 256 * j + 4 * lane) = (u32x2){h0, h1};
                *(u32x2*)(wl + i * LN1_ROWB + (256 * j + 4 * lane) * 2) = (u32x2){h0, h1};
                *(u32x2*)(wl + (4 + i) * LN1_ROWB + (256 * j + 4 * lane) * 2) = (u32x2){pack2(v[4 * j] - lo_bf(h0), v[4 * j + 1] - hi_bf(h0)), pack2(v[4 * j + 2] - lo_bf(h1), v[4 * j + 3] - hi_bf(h1))};
            }
        }
        asm volatile("s_waitcnt lgkmcnt(0)" ::: "memory");
        __builtin_amdgcn_wave_barrier();
        f32x4 acc = (f32x4){0.f, 0.f, 0.f, 0.f};
        const char* arow = wl + (fr & 3) * LN1_ROWB + fq * 16;
        const bf16_t* whi = p.RwHi + (size_t)fr * D + fq * 8; const bf16_t* wlo = p.RwLo + (size_t)fr * D + fq * 8;
#pragma unroll 4
        for (int ks = 0; ks < 32; ++ks) {
            const bf16x8 ah = *(const bf16x8*)(arow + ks * 64), al = *(const bf16x8*)(arow + 4 * LN1_ROWB + ks * 64);
            const bf16x8 bh = *(const bf16x8*)(whi + ks * 32), bl = *(const bf16x8*)(wlo + ks * 32);
            acc = __builtin_amdgcn_mfma_f32_16x16x32_bf16(bh, ah, acc, 0, 0, 0);
            acc = __builtin_amdgcn_mfma_f32_16x16x32_bf16(bh, al, acc, 0, 0, 0);
            acc = __builtin_amdgcn_mfma_f32_16x16x32_bf16(bl, ah, acc, 0, 0, 0);
        }
        float lg[4]; float mx = -3.0e38f;
#pragma unroll
        for (int e = 0; e < 4; ++e) { lg[e] = acc[e] + p.router_b[4 * fq + e]; mx = fmaxf(mx, lg[e]); }
        mx = fmaxf(mx, __shfl_xor(mx, 16)); mx = fmaxf(mx, __shfl_xor(mx, 32));
        float sum = 0.f;
#pragma unroll
        for (int e = 0; e < 4; ++e) { lg[e] = __expf(lg[e] - mx); sum += lg[e]; }
        sum += __shfl_xor(sum, 16); sum += __shfl_xor(sum, 32);
        const float inv = 1.0f / sum;
        float v1 = -1.f, v2 = -1.f; int i1 = 0, i2 = 0;
#pragma unroll
        for (int e = 0; e < 4; ++e) {
            const float pv = lg[e] * inv;
            if (pv > v1) { v2 = v1; i2 = i1; v1 = pv; i1 = e; } else if (pv > v2) { v2 = pv; i2 = e; }
        }
        const float sc = v1 + v2;
        float bsc = sc; int bg = fq;
#pragma unroll
        for (int m = 16; m <= 32; m <<= 1) {
            const float os = __shfl_xor(bsc, m); const int og = __shfl_xor(bg, m);
            if (os > bsc || (os == bsc && og < bg)) { bsc = os; bg = og; }
        }
        if (bg == fq && fr < ng) {
            const int li = tok0 + g0 + fr - btok0;
            const float gs = 1.0f / (v1 + v2);
            sel[li * 2] = 4 * fq + i1; sel[li * 2 + 1] = 4 * fq + i2; sgt[li * 2] = v1 * gs; sgt[li * 2 + 1] = v2 * gs;
        }
        asm volatile("s_waitcnt lgkmcnt(0)" ::: "memory");
        __builtin_amdgcn_wave_barrier();
    }
    __syncthreads();
    if (wid == 0) {
        const int nbt = 8 * base_n + ((bid * 8 + 8 <= extra) ? 8 : (bid * 8 < extra ? extra - bid * 8 : 0));
        for (int c0 = 0; c0 < nbt; c0 += 64) {
            const int li = c0 + lane; const bool on = li < nbt;
            const int e1 = on ? sel[li * 2] : -1, e2 = on ? sel[li * 2 + 1] : -1;
            const unsigned long long lt = (1ull << lane) - 1ull;
            int r1 = 0, r2 = 0, mycnt = 0;
#pragma unroll
            for (int e = 0; e < NE; ++e) {
                const unsigned long long m1 = __ballot(e1 == e), m2 = __ballot(e2 == e);
                const int c1 = __popcll(m1), c2 = __popcll(m2);
                if (e1 == e) r1 = __popcll(m1 & lt);
                if (e2 == e) r2 = c1 + __popcll(m2 & lt);
                if (lane == e) mycnt = c1 + c2;
            }
            if (lane < NE) sbase[lane] = mycnt > 0 ? atomicAdd(&p.counts[lane], mycnt) : 0;
            asm volatile("s_waitcnt vmcnt(0) lgkmcnt(0)" ::: "memory");
            __builtin_amdgcn_wave_barrier();
            if (on) {
                const int tok = btok0 + li;
                const int s1 = sbase[e1] + r1, s2 = sbase[e2] + r2;
                p.list[e1 * T + s1] = tok * 2; p.list[e2 * T + s2] = tok * 2 + 1;
                p.tokg[tok * 2] = sgt[li * 2]; p.tokg[tok * 2 + 1] = sgt[li * 2 + 1];
            }
            asm volatile("s_waitcnt lgkmcnt(0)" ::: "memory");
            __builtin_amdgcn_wave_barrier();
        }
    }
}

constexpr int MOE_BIG = 8;
template <bool UP> struct MoeOrder {
    const int* counts; const int* list; int G, c; const char* A; const char* B;
    DI bool next(int i, g8::Unit& u) const {
        const int xcd = c & 7, w = c >> 3, mt = (w >> 1) & 7, pn = 2 * (w & 1) + i, esel = xcd + 8 * (w >> 4);
        if (w >= 32 || i >= 2) return false;
        int padp = 0, fe = -1, fc = 0, fp = 0;
#pragma unroll
        for (int e = 0; e < NE; ++e) {
            const int cn = counts[e], ntp = (cn + 255) >> 8, nt = ntp < MOE_BIG ? ntp : MOE_BIG;
            const bool hit = (e == esel) && (mt < nt);
            fe = hit ? e : fe; fc = hit ? cn : fc; fp = hit ? padp + mt : fp;
            padp += ntp;
        }
        fe = __builtin_amdgcn_readfirstlane(fe); fc = __builtin_amdgcn_readfirstlane(fc); fp = __builtin_amdgcn_readfirstlane(fp);
        if (fe < 0) return false;
        u.e = fe; u.slot0 = mt * 256; u.cnt = fc; u.pm = fp; u.pn = pn;
        u.A = UP ? A : A + (size_t)fp * ((size_t)256 * DE * 2);
        u.B = UP ? B + (size_t)fe * ((size_t)1024 * 1024 * 2) + (size_t)pn * ((size_t)256 * D * 2) : B + (size_t)fe * ((size_t)1024 * 512 * 2) + (size_t)pn * ((size_t)256 * DE * 2);
        return true;
    }
    DI unsigned row_off(const g8::Unit& u, int r) const {
        const __amdgpu_buffer_rsrc_t rs = __builtin_amdgcn_make_buffer_rsrc((void*)list, 0, NE * T * 4, 0x00020000);
        const int ent = __builtin_amdgcn_raw_buffer_load_b32(rs, r * 4, (u.e * T + u.slot0) * 4, 0);
        return u.slot0 + r < u.cnt ? (unsigned)(ent >> 1) * (unsigned)(D * 2) : 0u;
    }
};
struct EpiMoeUp {
    static constexpr bool PERM = true;
    bf16_t* hid;
    DI void operator()(const f32x4 (&acc)[2][2][4][2], const g8::Unit& u, int wr, int wc, int fr, int fq) const {
#pragma unroll
        for (int ai = 0; ai < 2; ++ai)
#pragma unroll
            for (int m = 0; m < 4; ++m) {
                const int r = ai * 128 + wr * 64 + m * 16 + fr;
                if (u.slot0 + r >= u.cnt) continue;
                bf16_t* rowp = hid + ((size_t)u.pm * 256 + r) * DE + ((u.pn * 256 + wc * 32 + 8 * fq) >> 1);
#pragma unroll
                for (int bj = 0; bj < 2; ++bj) {
                    const f32x4 v0 = acc[ai][bj][m][0], v1 = acc[ai][bj][m][1];
                    *(u32x2*)(rowp + bj * 64) = (u32x2){pack2(v0[0] * sigmoidf_(v0[0]) * v0[1], v0[2] * sigmoidf_(v0[2]) * v0[3]), pack2(v1[0] * sigmoidf_(v1[0]) * v1[1], v1[2] * sigmoidf_(v1[2]) * v1[3])};
                }
            }
    }
};
struct EpiMoeDown {
    static constexpr bool PERM = true;
    bf16_t* fo; const int* list; const float* tokg;
    DI void operator()(const f32x4 (&acc)[2][2][4][2], const g8::Unit& u, int wr, int wc, int fr, int fq) const {
        int ent[8]; float g[8];
#pragma unroll
        for (int q = 0; q < 8; ++q) {
            const int sl = u.slot0 + (q >> 2) * 128 + wr * 64 + (q & 3) * 16 + fr;
            ent[q] = sl < u.cnt ? list[u.e * T + sl] : -1;
        }
#pragma unroll
        for (int q = 0; q < 8; ++q) g[q] = ent[q] >= 0 ? tokg[ent[q]] : 0.f;
#pragma unroll
        for (int ai = 0; ai < 2; ++ai)
#pragma unroll
            for (int m = 0; m < 4; ++m) {
                const int q = ai * 4 + m;
                if (ent[q] < 0) continue;
                const float gg = g[q];
                bf16_t* rowp = fo + ((size_t)(ent[q] & 1) * TP + (ent[q] >> 1)) * D + u.pn * 256 + wc * 32 + 8 * fq;
#pragma unroll
                for (int bj = 0; bj < 2; ++bj) {
                    const f32x4 v0 = acc[ai][bj][m][0], v1 = acc[ai][bj][m][1];
                    *(u32x4*)(rowp + bj * 128) = (u32x4){pack2(gg * v0[0], gg * v0[1]), pack2(gg * v0[2], gg * v0[3]), pack2(gg * v1[0], gg * v1[1]), pack2(gg * v1[2], gg * v1[3])};
                }
            }
    }
};
DI void phase_moe_up(const Params& p, int bid, int nb, char* smem) {
    const MoeOrder<true> S{p.counts, p.list, nb, bid, (const char*)p.hb, (const char*)p.WtGU};
    g8::gemm8<true>((G8_LAS unsigned char*)smem, D, S, EpiMoeUp{p.hid});
    const bf16_t* hb = p.hb; bf16_t* hid = p.hid; const int* list = p.list;
    int big = 0, padr = 0, job = 0;
#pragma unroll 1
    for (int e = 0; e < NE; ++e) { const int cn = p.counts[e], ntp = (cn + 255) >> 8; big += (ntp < MOE_BIG ? ntp : MOE_BIG) * 4; }
    const int mine = bid; (void)big;
#pragma unroll 1
    for (int e = 0; e < NE; ++e) {
        const int cn = p.counts[e];
        for (int s0 = MOE_BIG * 256; s0 < cn; s0 += 128)
            for (int nt = 0; nt < 8; ++nt, ++job)
                if (job % nb == mine) {
                    const int prow = padr;
                    gemm_tile128([=](int r) { const int sl = s0 + r; return sl < cn ? hb + (size_t)(list[e * T + sl] >> 1) * D : (const bf16_t*)nullptr; },
                                 p.WtGU + (size_t)e * 1024 * 1024, D, D, 0, nt * 128, smem,
                                 [=](int r, int c, f32x4 v) {
                                     const int sl = s0 + r;
                                     if (sl >= cn) return;
                                     *(unsigned*)(hid + (size_t)(prow + sl) * DE + (c >> 1)) = pack2(v[0] * sigmoidf_(v[0]) * v[1], v[2] * sigmoidf_(v[2]) * v[3]);
                                 });
                }
        padr += ((cn + 255) >> 8) * 256;
    }
}
DI void phase_moe_down(const Params& p, int bid, int nb, char* smem) {
    const MoeOrder<false> S{p.counts, p.list, nb, bid, (const char*)p.hid, (const char*)p.WtD};
    g8::gemm8<false>((G8_LAS unsigned char*)smem, DE, S, EpiMoeDown{p.fo, p.list, p.tokg});
    const bf16_t* hid = p.hid; bf16_t* fo = p.fo; const int* list = p.list; const float* tokg = p.tokg;
    int big = 0, padr = 0, job = 0;
#pragma unroll 1
    for (int e = 0; e < NE; ++e) { const int cn = p.counts[e], ntp = (cn + 255) >> 8; big += (ntp < MOE_BIG ? ntp : MOE_BIG) * 4; }
    const int mine = bid; (void)big;
#pragma unroll 1
    for (int e = 0; e < NE; ++e) {
        const int cn = p.counts[e];
        for (int s0 = MOE_BIG * 256; s0 < cn; s0 += 128)
            for (int nt = 0; nt < 8; ++nt, ++job)
                if (job % nb == mine) {
                    const int prow = padr;
                    gemm_tile128([=](int r) { const int sl = s0 + r; return sl < cn ? hid + (size_t)(prow + sl) * DE : (const bf16_t*)nullptr; },
                                 p.WtD + (size_t)e * 1024 * 512, DE, DE, 0, nt * 128, smem,
                                 [=](int r, int c, f32x4 v) {
                                     const int sl = s0 + r;
                                     if (sl >= cn) return;
                                     const int ent = list[e * T + sl];
                                     const float g = tokg[ent];
                                     *(u32x2*)(fo + ((size_t)(ent & 1) * TP + (ent >> 1)) * D + c) = (u32x2){pack2(g * v[0], g * v[1]), pack2(g * v[2], g * v[3])};
                                 });
                }
        padr += ((cn + 255) >> 8) * 256;
    }
}
DI void phase_ln2(const Params& p, int layer, int bid, int nb) {
    const int lane = tid_() & 63, wid = __builtin_amdgcn_readfirstlane(tid_() >> 6);
    const int nwaves = nb * 8, gw = bid * 8 + wid, base_n = T / nwaves, extra = T % nwaves;
    const int tok0 = gw * base_n + (gw < extra ? gw : extra), ntok = base_n + (gw < extra ? 1 : 0);
    u32x2 an[4], f0n[4], f1n[4];
    {
#pragma unroll
        for (int j = 0; j < 4; ++j) {
            an[j] = *(const u32x2*)(p.hb + (size_t)tok0 * D + 256 * j + 4 * lane);
            f0n[j] = *(const u32x2*)(p.fo + (size_t)tok0 * D + 256 * j + 4 * lane); f1n[j] = *(const u32x2*)(p.fo + ((size_t)TP + tok0) * D + 256 * j + 4 * lane);
        }
    }
#pragma unroll 1
    for (int i = 0; i < ntok; ++i) {
        const int tok = tok0 + i;
        float v[16];
#pragma unroll
        for (int j = 0; j < 4; ++j) {
            v[4 * j] = ALPHA * lo_bf(an[j][0]) + lo_bf(f0n[j][0]) + lo_bf(f1n[j][0]); v[4 * j + 1] = ALPHA * hi_bf(an[j][0]) + hi_bf(f0n[j][0]) + hi_bf(f1n[j][0]);
            v[4 * j + 2] = ALPHA * lo_bf(an[j][1]) + lo_bf(f0n[j][1]) + lo_bf(f1n[j][1]); v[4 * j + 3] = ALPHA * hi_bf(an[j][1]) + hi_bf(f0n[j][1]) + hi_bf(f1n[j][1]);
        }
        if (i + 1 < ntok) {
#pragma unroll
            for (int j = 0; j < 4; ++j) {
                an[j] = *(const u32x2*)(p.hb + (size_t)(tok + 1) * D + 256 * j + 4 * lane);
                f0n[j] = *(const u32x2*)(p.fo + (size_t)(tok + 1) * D + 256 * j + 4 * lane); f1n[j] = *(const u32x2*)(p.fo + ((size_t)TP + tok + 1) * D + 256 * j + 4 * lane);
            }
        }
        ln16(v, p.ln2_g + layer * D, p.ln2_b + layer * D, lane);
        if (layer == DEPTH - 1) {
            float* of = hrow_u(p, tok);
#pragma unroll
            for (int j = 0; j < 4; ++j) *(f32x4*)(of + 256 * j + 4 * lane) = (f32x4){v[4 * j], v[4 * j + 1], v[4 * j + 2], v[4 * j + 3]};
        } else store_row_bf(p.hb + (size_t)tok * D, v, lane);
    }
}

extern __shared__ __attribute__((aligned(16))) char dyn_smem[];
constexpr int SMEM_MAIN = R1_LDS > GEMM_LDS ? R1_LDS : GEMM_LDS;
constexpr int SMEM_BYTES = SMEM_MAIN + 16;

__global__ void __launch_bounds__(NTHR, 2) k_forward(Params p) {
    const int bid = blockIdx.x, nb = gridDim.x;
    char* smem = dyn_smem;
    uint4* xbw = (uint4*)(dyn_smem + SMEM_MAIN);
    if (threadIdx.x == 0) *xbw = make_uint4(0u, 0u, 0u, 0u);
    __syncthreads();
    XcdBarrier bar = xcd_barrier_post(p.bar, (volatile LAS unsigned*)xbw);
    phase_prologue_weights(p, bid, nb, smem);
    phase_embed(p, bid, nb);
    xcd_barrier(bar);
    for (int l = 0; l < DEPTH; ++l) {
        phase_inproj(p, l, bid, nb, smem);
        xcd_barrier(bar);
        phase_rwkv_r1<0>(p, l, bid, nb, smem);
        xcd_barrier(bar);
        if (bid < 16) { const int cw = __builtin_amdgcn_readfirstlane(tid_() >> 6); if (cw < 4) phase_rwkv_r2(p, bid * 4 + cw); }
        else {
            const int sbid = bid - 16, snb = nb - 16, heavy = (NBATCH * HEADS * ((L + 127) / 128)) % snb;
            if (sbid >= heavy && sbid < heavy + NBATCH * HEADS) phase_rwkv_r1<1>(p, l, sbid - heavy, 1, smem);
            phase_sb(p, sbid, snb, smem);
        }
        xcd_barrier(bar);
        phase_rwkv_r3(p, l, bid, nb);
        convert_experts(p, l, NE / 2, NE, bid, nb, smem);
        phase_merge<0>(p, l, bid, nb, smem);
        xcd_barrier(bar);
        phase_merge<1>(p, l, bid, nb, smem);
        xcd_barrier(bar);
        phase_outproj(p, l, bid, nb, smem);
        xcd_barrier(bar);
        phase_ln1_router(p, l, bid, nb, smem);
        xcd_barrier(bar);
        phase_moe_up(p, bid, nb, smem);
        xcd_barrier(bar);
        phase_moe_down(p, bid, nb, smem);
        xcd_barrier(bar);
        phase_ln2(p, l, bid, nb);
        xcd_barrier(bar);
    }
}

extern "C" void kernel_launch(void* const* d_in, const int* in_sizes, int n_in, void* d_out, int out_size, void* d_ws, size_t ws_size, hipStream_t stream) {
    (void)in_sizes; (void)n_in; (void)out_size;
    Params p;
    memset(&p, 0, sizeof(p));
    const float* const* in = (const float* const*)d_in;
    p.x = in[0]; p.meta = in[1]; p.emb_g = in[2]; p.emb_b = in[3]; p.w_in = in[4]; p.mu = in[5]; p.w0 = in[6]; p.w_up = in[7]; p.a0 = in[8]; p.a_up = in[9];
    p.g_up = in[10]; p.k_k = in[11]; p.k_a = in[12]; p.r_k = in[13]; p.lnx_g = in[14]; p.lnx_b = in[15]; p.p_sb = in[16]; p.p_rwkv = in[17]; p.w_out = in[18];
    p.ln1_g = in[19]; p.ln1_b = in[20]; p.router_w = in[21]; p.router_b = in[22]; p.ew_gate = in[23]; p.ew_up = in[24]; p.ew_down = in[25]; p.ln2_g = in[26]; p.ln2_b = in[27];
    p.out = (float*)d_out;
    char* ws = (char*)d_ws; size_t o = 0;
    auto take = [&](size_t bytes) { char* r = ws + o; o += (bytes + 255) & ~(size_t)255; return r; };
    p.bar = (unsigned*)take(XCD_BAR_WORDS * sizeof(unsigned));
    p.counts = (int*)take(256);
    p.WtIn = (bf16_t*)take((size_t)DEPTH * CIN * D * 2);
    p.WtPsb = (bf16_t*)take((size_t)DEPTH * D * 512 * 2);
    p.WtPrw = (bf16_t*)take((size_t)DEPTH * D * 512 * 2);
    p.WtOut = (bf16_t*)take((size_t)DEPTH * D * D * 2);
    p.WupT = (bf16_t*)take((size_t)DEPTH * 512 * 64 * 2);
    p.AupT = (bf16_t*)take((size_t)DEPTH * 512 * 64 * 2);
    p.GupT = (bf16_t*)take((size_t)DEPTH * 512 * 128 * 2);
    p.RwHi = (bf16_t*)take((size_t)NE * D * 2);
    p.RwLo = (bf16_t*)take((size_t)NE * D * 2);
    p.gleft = (bf16_t*)take((size_t)32 * 2048 * 2);
    {
        const size_t ub = (size_t)NUNIT * 64 * 64 * 2;
        p.WtGU = (bf16_t*)take((size_t)NE * 1024 * 1024 * 2);
        p.WtD = (bf16_t*)take((size_t)NE * 1024 * 512 * 2);
        p.PcG = (bf16_t*)d_out; p.QcG = (bf16_t*)((char*)d_out + ub); p.RhG = (bf16_t*)((char*)d_out + 2 * ub);
        p.Y0G = (bf16_t*)take(ub); p.GG = (bf16_t*)take(ub); p.SG = (bf16_t*)take(ub);
        p.bonG = (float*)take((size_t)NUNIT * 64 * 4);
    }
    p.hb = (bf16_t*)take((size_t)TP * D * 2);
    p.hmeta = (float*)take((size_t)NBATCH * NMETA * D * 4);
    p.P = (bf16_t*)take((size_t)TP * CP * 2);
    p.osb = (bf16_t*)take((size_t)TP * 512 * 2);
    p.orw = (bf16_t*)take((size_t)TP * 512 * 2);
    p.list = (int*)take((size_t)NE * T * 4);
    p.tokg = (float*)take((size_t)T * 2 * 4);
    p.gates = p.P;
    p.merged = p.P + (size_t)TP * 2048;
    p.hid = p.P;
    p.fo = p.P + (size_t)(2 * T + 16 * 256) * DE;
    if (o > ws_size) return;
    static int grid = 0;
    if (!grid) {
        int dev = 0, cus = 0, per_cu = 0;
        (void)hipGetDevice(&dev);
        (void)hipDeviceGetAttribute(&cus, hipDeviceAttributeMultiprocessorCount, dev);
        (void)hipFuncSetAttribute((const void*)k_forward, hipFuncAttributeMaxDynamicSharedMemorySize, SMEM_BYTES);
        (void)hipOccupancyMaxActiveBlocksPerMultiprocessor(&per_cu, k_forward, NTHR, SMEM_BYTES);
        grid = per_cu >= 1 ? cus : 0;
    }
    if (!grid) return;
    (void)hipMemsetAsync(p.bar, 0, XCD_BAR_WORDS * sizeof(unsigned), stream);
    hipLaunchKernelGGL(k_forward, dim3(grid), dim3(NTHR), SMEM_BYTES, stream, p);
}
```

```cpp
#include <hip/hip_runtime.h>
#include <stdint.h>
#include <string.h>

#define DI __device__ __forceinline__
typedef unsigned short bf16_t;
typedef short bf16x8 __attribute__((ext_vector_type(8)));
typedef float f32x4 __attribute__((ext_vector_type(4)));
typedef unsigned u32x4 __attribute__((ext_vector_type(4)));
typedef unsigned u32x2 __attribute__((ext_vector_type(2)));

constexpr int D = 1024, NBATCH = 2, SEQ = 8192, NMETA = 16, L = SEQ + NMETA, T = NBATCH * L, TP = 16640;
constexpr int DEPTH = 2, HEADS = 8, HD = 64;
constexpr int CIN = 5376, CP = 3328;
constexpr int OFF_Q = 0, OFF_K = 512, OFF_V = 1024, OFF_RW = 1536;
constexpr int RW_R = 0, RW_K = 512, RW_V = 1024, RW_WD = 1536, RW_AD = 1600, RW_GD = 1664, RSW = 1792;
constexpr int NE = 16, DE = 512;
constexpr float ALPHA = 1.41421356237309515f;
constexpr float DECAY_SCALE = 0.60653065971263342f;
constexpr int NTHR = 512;

#define XB_TMO      128
#define XB_XCNT(j)  (256  + 64 * (j))
#define XB_XSUB(j)  (1280 + 64 * (j))
#define XB_XGEN(j)  (2304 + 64 * (j))
#define XB_TOP      3328
#define XB_TOPGEN   3392
#define XCD_BAR_WORDS 3456
#define XB_SPIN_CAP (1u << 18)
#define LAS __attribute__((address_space(3)))

__device__ __forceinline__ unsigned xb_ld(unsigned* p)              { return __hip_atomic_load(p, __ATOMIC_RELAXED, __HIP_MEMORY_SCOPE_AGENT); }
__device__ __forceinline__ unsigned xb_add(unsigned* p, unsigned v) { return __hip_atomic_fetch_add(p, v, __ATOMIC_RELAXED, __HIP_MEMORY_SCOPE_AGENT); }
__device__ __forceinline__ unsigned xb_xcc_id() { return (unsigned)__builtin_amdgcn_s_getreg((3 << 11) | 20) & 0xFu; }
#define XB_SPIN(cond, bar) do { unsigned _sp = 0; while (cond) { __builtin_amdgcn_s_sleep(1); \
    if ((++_sp & 255u) == 0u) { if (xb_ld(&(bar)[XB_TMO])) break; if (_sp > XB_SPIN_CAP) { atomicAdd(&(bar)[XB_TMO], 1u); break; } } } } while (0)

struct XcdBarrier {
    unsigned* bar; unsigned x;
    volatile LAS unsigned* st;
};

__device__ __forceinline__ XcdBarrier xcd_barrier_post(unsigned* bar, volatile LAS unsigned* st) {
    XcdBarrier b; b.bar = bar; b.x = xb_xcc_id(); b.st = st;
    if (threadIdx.x == 0) (void)xb_add(&bar[XB_XCNT(b.x)], 1u);
    return b;
}
__device__ __forceinline__ void xcd_barrier_complete(unsigned* bar, unsigned x, unsigned& nloc, unsigned& nx) {
    const unsigned G = gridDim.x * gridDim.y * gridDim.z;
    unsigned sum, cnt, mine, sp = 0u;
    for (;;) {
        sum = 0u; cnt = 0u; mine = 0u;
#pragma unroll
        for (unsigned j = 0; j < 16; ++j) { const unsigned c = xb_ld(&bar[XB_XCNT(j)]); sum += c; cnt += (c > 0u) ? 1u : 0u; mine = (j == x) ? c : mine; }
        if (sum == G) break;
        __builtin_amdgcn_s_sleep(1);
        if ((++sp & 255u) == 0u) { if (xb_ld(&bar[XB_TMO])) break; if (sp > XB_SPIN_CAP) { atomicAdd(&bar[XB_TMO], 1u); break; } }
    }
    nloc = mine > 0u ? mine : 1u; nx = cnt > 0u ? cnt : 1u;
}

__device__ __forceinline__ void xcd_barrier(const XcdBarrier& b) {
    asm volatile("s_waitcnt vmcnt(0)" ::: "memory");
    __syncthreads();
    if (threadIdx.x == 0) {
        unsigned* bar = b.bar;
        unsigned bx = b.x; asm volatile("" : "+s"(bx));
        __builtin_amdgcn_s_waitcnt(0);
        unsigned nloc = b.st[0], nx = b.st[1];
        if (nloc == 0u) { xcd_barrier_complete(bar, bx, nloc, nx); b.st[0] = nloc; b.st[1] = nx; }
        const unsigned old = xb_add(&bar[XB_XSUB(bx)], 1u);
        const unsigned gen = old / nloc;
        if (old + 1u == (gen + 1u) * nloc) {
            __builtin_amdgcn_fence(__ATOMIC_RELEASE, "agent");
            asm volatile("s_waitcnt vmcnt(0)" ::: "memory");
            const unsigned og = xb_add(&bar[XB_TOP], 1u);
            const unsigned tg = og / nx;
            if (og + 1u == (tg + 1u) * nx) xb_add(&bar[XB_TOPGEN], 1u);
            else XB_SPIN(xb_ld(&bar[XB_TOPGEN]) == tg, bar);
            __builtin_amdgcn_fence(__ATOMIC_ACQUIRE, "agent");
            xb_add(&bar[XB_XGEN(bx)], 1u);
            asm volatile("s_waitcnt vmcnt(0)" ::: "memory");
        } else {
            XB_SPIN(xb_ld(&bar[XB_XGEN(bx)]) == gen, bar);
            __builtin_amdgcn_fence(__ATOMIC_ACQUIRE, "agent");
            asm volatile("s_waitcnt vmcnt(0)" ::: "memory");
        }
    }
    __syncthreads();
}


struct Params {
    const float *x, *meta, *emb_g, *emb_b, *w_in, *mu, *w0, *w_up, *a0, *a_up, *g_up, *k_k, *k_a, *r_k, *lnx_g, *lnx_b, *p_sb, *p_rwkv, *w_out,
        *ln1_g, *ln1_b, *router_w, *router_b, *ew_gate, *ew_up, *ew_down, *ln2_g, *ln2_b;
    float* out;
    unsigned* bar;
    int* counts;
    bf16_t *WtIn, *WtPsb, *WtPrw, *WtOut, *WtGU, *WtD, *hb, *P, *osb, *orw, *WupT, *AupT, *GupT;
    bf16_t *PcG, *QcG, *RhG, *Y0G, *GG, *SG;
    bf16_t *RwHi, *RwLo, *gleft;
    float* bonG;
    float* hmeta;
    bf16_t *gates, *merged, *hid, *fo;
    int* list;
    float* tokg;
};

DI float bf2f(bf16_t v) { return __uint_as_float((unsigned)v << 16); }
typedef __bf16 bf16x2_t __attribute__((ext_vector_type(2)));
DI bf16_t f2bf(float f) { return __builtin_bit_cast(bf16_t, (__bf16)f); }
DI unsigned pack2(float lo, float hi) { bf16x2_t v = {(__bf16)lo, (__bf16)hi}; return __builtin_bit_cast(unsigned, v); }
DI float lo_bf(unsigned u) { return __uint_as_float(u << 16); }
DI float hi_bf(unsigned u) { return __uint_as_float(u & 0xFFFF0000u); }
template <int CTRL> DI float dpp_mov(float v) { return __builtin_bit_cast(float, __builtin_amdgcn_update_dpp(0, __builtin_bit_cast(int, v), CTRL, 0xF, 0xF, true)); }
DI float sum8(float v) {
    v += dpp_mov<0xB1>(v);
    v += dpp_mov<0x4E>(v);
    v += dpp_mov<0x141>(v);
    return v;
}
DI float sum16(float v) { v = sum8(v); v += dpp_mov<0x140>(v); return v; }
DI float wave_sum(float v) { v = sum16(v); v += __shfl_xor(v, 16); v += __shfl_xor(v, 32); return v; }
struct Params;
DI const Params& kparams() {
    auto k = __builtin_amdgcn_kernarg_segment_ptr();
    asm volatile("" : "+s"(k));
    return *(const Params*)k;
}
DI int tid_() { int t = threadIdx.x; asm volatile("" : "+v"(t)); return t; }
DI float sigmoidf_(float x) { return __builtin_amdgcn_rcpf(1.0f + __expf(-x)); }
DI float tanhf_(float x) { return 1.0f - 2.0f * __builtin_amdgcn_rcpf(1.0f + __expf(2.0f * x)); }
DI void wave_sync() { asm volatile("s_waitcnt lgkmcnt(0)" ::: "memory"); __builtin_amdgcn_wave_barrier(); }

DI float* hrow2(float* hmeta, float* out, int tok) {
    const int b = tok >= L ? 1 : 0, t = tok - b * L;
    const unsigned long long am = (unsigned long long)(hmeta + (long long)(b * NMETA + t) * D), ao = (unsigned long long)(out + ((long long)b * SEQ + (t - NMETA)) * D);
    const unsigned long long m = 0ull - (unsigned long long)(t < NMETA);
    return (float*)((am & m) | (ao & ~m));
}
DI float* hrow(const Params& p, int tok) { return hrow2(p.hmeta, p.out, tok); }
DI float* hrow_u(const Params& p, int tok) { return hrow2(p.hmeta, p.out, __builtin_amdgcn_readfirstlane(tok)); }

DI void transpose_convert(const float* __restrict__ src, int ld, int K, int N, bf16_t* __restrict__ dst, int mult, int off, int bid, int nb, char* smem, int& rot) {
    float* tile = (float*)smem;
    const int tk = K / 64, tn = N / 256, tid = tid_();
    const int first = (bid - rot % nb + nb) % nb;
    rot += tk * tn;
    for (int t = first; t < tk * tn; t += nb) {
        const int k0 = (t / tn) * 64, n0 = (t % tn) * 256;
        f32x4 v[4][2];
#pragma unroll
        for (int q = 0; q < 4; ++q)
#pragma unroll
            for (int i = 0; i < 2; ++i) v[q][i] = *(const f32x4*)(src + (size_t)(k0 + (tid >> 4) + 32 * i) * ld + n0 + q * 64 + (tid & 15) * 4);
        __syncthreads();
#pragma unroll
        for (int q = 0; q < 4; ++q)
#pragma unroll
            for (int i = 0; i < 2; ++i) {
                float* tp = tile + q * 64 * 65 + ((tid >> 4) + 32 * i) * 65 + (tid & 15) * 4;
                tp[0] = v[q][i][0]; tp[1] = v[q][i][1]; tp[2] = v[q][i][2]; tp[3] = v[q][i][3];
            }
        __syncthreads();
        const int n = tid >> 3, kc = (tid & 7) * 8;
#pragma unroll
        for (int q = 0; q < 4; ++q) {
            const float* tq = tile + q * 64 * 65;
            u32x4 o;
#pragma unroll
            for (int jj = 0; jj < 4; ++jj) o[jj] = pack2(tq[(kc + 2 * jj) * 65 + n], tq[(kc + 2 * jj + 1) * 65 + n]);
            *(u32x4*)(dst + (size_t)((n0 + q * 64 + n) * mult + off) * K + k0 + kc) = o;
        }
    }
}

DI void convert_experts(const Params& p, int layer, int e0, int e1, int bid, int nb, char* smem) {
    int rot = 0;
    for (int e = e0; e < e1; ++e) {
        const size_t eo = ((size_t)layer * NE + e) * (size_t)D * DE;
        transpose_convert(p.ew_gate + eo, DE, D, DE, p.WtGU + (size_t)e * 1024 * 1024, 2, 0, bid, nb, smem, rot);
        transpose_convert(p.ew_up + eo, DE, D, DE, p.WtGU + (size_t)e * 1024 * 1024, 2, 1, bid, nb, smem, rot);
        transpose_convert(p.ew_down + eo, D, DE, D, p.WtD + (size_t)e * 1024 * 512, 1, 0, bid, nb, smem, rot);
    }
}

DI void phase_prologue_weights(const Params& p, int bid, int nb, char* smem) {
    int rot = 0;
    for (int i = bid * NTHR + tid_(); i < NE * D; i += nb * NTHR) {
        const int e = i / D, k = i % D;
        const float w = p.router_w[(size_t)k * NE + e];
        const bf16_t hi = f2bf(w);
        p.RwHi[i] = hi; p.RwLo[i] = f2bf(w - bf2f(hi));
    }
    for (int l = 0; l < DEPTH; ++l) {
        transpose_convert(p.w_in + (size_t)l * D * CIN, CIN, D, CIN, p.WtIn + (size_t)l * CIN * D, 1, 0, bid, nb, smem, rot);
        transpose_convert(p.p_sb + (size_t)l * 512 * D, D, 512, D, p.WtPsb + (size_t)l * D * 512, 1, 0, bid, nb, smem, rot);
        transpose_convert(p.p_rwkv + (size_t)l * 512 * D, D, 512, D, p.WtPrw + (size_t)l * D * 512, 1, 0, bid, nb, smem, rot);
        transpose_convert(p.w_out + (size_t)l * D * D, D, D, D, p.WtOut + (size_t)l * D * D, 1, 0, bid, nb, smem, rot);
        transpose_convert(p.w_up + (size_t)l * 64 * 512, 512, 64, 512, p.WupT + (size_t)l * 512 * 64, 1, 0, bid, nb, smem, rot);
        transpose_convert(p.a_up + (size_t)l * 64 * 512, 512, 64, 512, p.AupT + (size_t)l * 512 * 64, 1, 0, bid, nb, smem, rot);
        transpose_convert(p.g_up + (size_t)l * 128 * 512, 512, 128, 512, p.GupT + (size_t)l * 512 * 128, 1, 0, bid, nb, smem, rot);
    }
}

DI void ln16(float (&v)[16], const float* __restrict__ g, const float* __restrict__ b, int lane) {
    float s = 0.f;
#pragma unroll
    for (int i = 0; i < 16; ++i) s += v[i];
    const float mean = wave_sum(s) * (1.0f / D);
    float q = 0.f;
#pragma unroll
    for (int i = 0; i < 16; ++i) { v[i] -= mean; q += v[i] * v[i]; }
    const float rstd = rsqrtf(wave_sum(q) * (1.0f / D) + 1e-5f);
#pragma unroll
    for (int j = 0; j < 4; ++j) {
        const f32x4 gv = *(const f32x4*)(g + 256 * j + 4 * lane), bv = *(const f32x4*)(b + 256 * j + 4 * lane);
#pragma unroll
        for (int i = 0; i < 4; ++i) v[4 * j + i] = v[4 * j + i] * rstd * gv[i] + bv[i];
    }
}
DI void store_row(float* __restrict__ hf, bf16_t* __restrict__ hb, const float (&v)[16], int lane) {
#pragma unroll
    for (int j = 0; j < 4; ++j) {
        *(f32x4*)(hf + 256 * j + 4 * lane) = (f32x4){v[4 * j], v[4 * j + 1], v[4 * j + 2], v[4 * j + 3]};
        *(u32x2*)(hb + 256 * j + 4 * lane) = (u32x2){pack2(v[4 * j], v[4 * j + 1]), pack2(v[4 * j + 2], v[4 * j + 3])};
    }
}

DI void store_row_bf(bf16_t* __restrict__ hb, const float (&v)[16], int lane) {
#pragma unroll
    for (int j = 0; j < 4; ++j) *(u32x2*)(hb + 256 * j + 4 * lane) = (u32x2){pack2(v[4 * j], v[4 * j + 1]), pack2(v[4 * j + 2], v[4 * j + 3])};
}
DI void phase_embed(const Params& p, int bid, int nb) {
    const int lane = tid_() & 63, wid = __builtin_amdgcn_readfirstlane(tid_() >> 6);
    const int nwaves = nb * 8, gw = bid * 8 + wid, base_n = T / nwaves, extra = T % nwaves;
    const int tok0 = gw * base_n + (gw < extra ? gw : extra), ntok = base_n + (gw < extra ? 1 : 0);
    auto srcrow = [&](int tok) -> const float* {
        const int tk = __builtin_amdgcn_readfirstlane(tok), b = tk >= L ? 1 : 0, t = tk - b * L;
        const unsigned long long am = (unsigned long long)(p.meta + (long long)t * D), ao = (unsigned long long)(p.x + ((long long)b * SEQ + (t - NMETA)) * D);
        const unsigned long long m = 0ull - (unsigned long long)(t < NMETA);
        return (const float*)((am & m) | (ao & ~m));
    };
    f32x4 an[4];
    { const float* src = srcrow(tok0);
#pragma unroll
      for (int j = 0; j < 4; ++j) an[j] = *(const f32x4*)(src + 256 * j + 4 * lane); }
#pragma unroll 1
    for (int i = 0; i < ntok; ++i) {
        const int tok = tok0 + i;
        float v[16];
#pragma unroll
        for (int j = 0; j < 4; ++j) { v[4 * j] = an[j][0]; v[4 * j + 1] = an[j][1]; v[4 * j + 2] = an[j][2]; v[4 * j + 3] = an[j][3]; }
        if (i + 1 < ntok) { const float* src = srcrow(tok + 1);
#pragma unroll
            for (int j = 0; j < 4; ++j) an[j] = *(const f32x4*)(src + 256 * j + 4 * lane); }
        ln16(v, p.emb_g, p.emb_b, lane);
        store_row_bf(p.hb + (size_t)tok * D, v, lane);
    }
}

constexpr int LDT = 72;
constexpr int GEMM_LDS = 2 * 128 * LDT * 2;
template <class ARow, class Epi>
DI void gemm_tile128(ARow arow, const bf16_t* __restrict__ Bt, int ldb, int K, int m0, int n0, char* smem, Epi epi) {
    const int tid = tid_(), lane = tid & 63, wid = __builtin_amdgcn_readfirstlane(tid >> 6), fr = lane & 15, fq = lane >> 4;
    const int wr = wid >> 1, wc = wid & 1;
    bf16_t* As = (bf16_t*)smem;
    bf16_t* Bs = As + 128 * LDT;
    const bf16_t* ap[2]; const bf16_t* bp[2]; int so[2];
#pragma unroll
    for (int i = 0; i < 2; ++i) {
        const int c = tid + NTHR * i, row = c >> 3, kc = c & 7;
        const bf16_t* ar = arow(m0 + row);
        ap[i] = ar ? ar + kc * 8 : nullptr;
        bp[i] = Bt + (size_t)(n0 + row) * ldb + kc * 8;
        so[i] = row * LDT + kc * 8;
    }
    f32x4 acc[2][4];
#pragma unroll
    for (int mi = 0; mi < 2; ++mi)
#pragma unroll
        for (int ni = 0; ni < 4; ++ni) acc[mi][ni] = (f32x4){0.f, 0.f, 0.f, 0.f};
    u32x4 ra[2], rb[2];
#pragma unroll
    for (int i = 0; i < 2; ++i) { ra[i] = ap[i] ? *(const u32x4*)(ap[i]) : (u32x4){0u, 0u, 0u, 0u}; rb[i] = *(const u32x4*)(bp[i]); }
    for (int k0 = 0; k0 < K; k0 += 64) {
        __syncthreads();
#pragma unroll
        for (int i = 0; i < 2; ++i) { *(u32x4*)(As + so[i]) = ra[i]; *(u32x4*)(Bs + so[i]) = rb[i]; }
        __syncthreads();
        if (k0 + 64 < K) {
#pragma unroll
            for (int i = 0; i < 2; ++i) { ra[i] = ap[i] ? *(const u32x4*)(ap[i] + k0 + 64) : (u32x4){0u, 0u, 0u, 0u}; rb[i] = *(const u32x4*)(bp[i] + k0 + 64); }
        }
#pragma unroll
        for (int ks = 0; ks < 2; ++ks) {
            bf16x8 af[2], bf[4];
#pragma unroll
            for (int mi = 0; mi < 2; ++mi) af[mi] = *(const bf16x8*)(As + (wr * 32 + mi * 16 + fr) * LDT + ks * 32 + fq * 8);
#pragma unroll
            for (int ni = 0; ni < 4; ++ni) bf[ni] = *(const bf16x8*)(Bs + (wc * 64 + ni * 16 + fr) * LDT + ks * 32 + fq * 8);
#pragma unroll
            for (int mi = 0; mi < 2; ++mi)
#pragma unroll
                for (int ni = 0; ni < 4; ++ni) acc[mi][ni] = __builtin_amdgcn_mfma_f32_16x16x32_bf16(bf[ni], af[mi], acc[mi][ni], 0, 0, 0);
        }
    }
#pragma unroll
    for (int mi = 0; mi < 2; ++mi)
#pragma unroll
        for (int ni = 0; ni < 4; ++ni) epi(m0 + wr * 32 + mi * 16 + fr, n0 + wc * 64 + ni * 16 + fq * 4, acc[mi][ni]);
}

namespace g8 {
#define G8_LAS __attribute__((address_space(3)))
constexpr int BM = 256, BK = 64, HALF = 128, HTB = HALF * BK * 2, STAGE_BYTES = 8 * HTB, NXCD = 8, WGM = 8;
DI int lds_byte(int r, int c) { const int st = (r >> 4) * 2 + (c >> 5), rr = r & 15, cc = c & 31, ob = rr * 64 + cc * 2; return st * 1024 + (ob ^ (((ob >> 9) & 1) << 5)); }
DI void stage_rc(int b, int& R, int& C) { const int st = b / 1024, sb = b % 1024, swz = sb ^ (((sb >> 9) & 1) << 5); R = (st >> 1) * 16 + swz / 64; C = (st & 1) * 32 + (swz % 64) / 2; }
DI int perm32(int rho) { const int n = rho >> 4, i = rho & 15; return 8 * (i >> 2) + 4 * n + (i & 3); }
struct Unit { int pm, pn; const char* A; const char* B; int e, slot0, cnt; };

struct DenseOrder {
    int nM, nN, nwg, G, c; const char* A; const char* B; size_t tstep;
    DI void init(const bf16_t* A_, const bf16_t* Bt_, int nM_, int nN_, int K, int G_, int c_) { nM = nM_; nN = nN_; nwg = nM * nN; G = G_; c = c_; A = (const char*)A_; B = (const char*)Bt_; tstep = (size_t)BM * K * 2; }
    DI bool next(int i, Unit& u) const {
        const long Lq = (long)i * G + c; if (Lq >= nwg) return false;
        int wgid = (int)Lq; { const int q = nwg / NXCD, r = nwg % NXCD, xcd = wgid % NXCD, off = wgid / NXCD; wgid = (xcd < r ? xcd * (q + 1) : r * (q + 1) + (xcd - r) * q) + off; }
        const int nig = WGM * nN, gid = wgid / nig, fm = gid * WGM, gsz = (nM - fm) < WGM ? (nM - fm) : WGM;
        u.pm = fm + ((wgid % nig) % gsz); u.pn = (wgid % nig) / gsz; u.A = A + (size_t)u.pm * tstep; u.B = B + (size_t)u.pn * tstep; u.e = 0; u.slot0 = 0; u.cnt = 0; return true;
    }
    DI unsigned row_off(const Unit&, int) const { return 0u; }
};

template <bool GATHER, class Epi, class Sched>
DI void gemm8(G8_LAS unsigned char* lds, const int K, const Sched& S, const Epi& E) {
    const int tid = tid_(), wid = __builtin_amdgcn_readfirstlane(tid >> 6), lane = tid & 63, wr = wid >> 2, wc = wid & 3, fr = lane & 15, fq = lane >> 4;
    const int nt = K / BK;
    int Rr[2], Cc[2]; unsigned voffB[2], voffA[2];
#pragma unroll
    for (int i = 0; i < 2; ++i) { stage_rc(tid * 16 + i * 8192, Rr[i], Cc[i]); const int Rb = Epi::PERM ? ((Rr[i] & ~31) + perm32(Rr[i] & 31)) : Rr[i]; voffB[i] = (unsigned)(Rb * K + Cc[i]) * 2u; voffA[i] = (unsigned)(Rr[i] * K + Cc[i]) * 2u; }
    const size_t kstep = (size_t)(BK * 2), hstep = (size_t)HALF * K * 2;
    const unsigned ldsw = (unsigned)wid * 1024u;
    const int aoff = lds_byte(wr * 64 + fr, fq * 8), boff = lds_byte(wc * 32 + fr, fq * 8);
#define G8_SA(b, h) (((b) * 2 + (h)) * HTB)
#define G8_SB(b, h) ((4 + (b) * 2 + (h)) * HTB)
#define G8_STAGE(bufoff, gbase, voff) do { _Pragma("unroll") for (int _i = 0; _i < 2; ++_i) \
        __builtin_amdgcn_global_load_lds((const unsigned*)((const char*)(gbase) + (voff)[_i]), (G8_LAS unsigned*)(lds + (bufoff) + ldsw + _i * 8192), 16, 0, 0); } while (0)
#define G8_LDA(dst, b, h) do { _Pragma("unroll") for (int m = 0; m < 4; ++m) _Pragma("unroll") for (int k = 0; k < 2; ++k) dst[m][k] = *(const G8_LAS bf16x8*)(lds + G8_SA(b, h) + aoff + m * 2048 + k * 1024); } while (0)
#define G8_LDB(dst, b, h) do { _Pragma("unroll") for (int n = 0; n < 2; ++n) _Pragma("unroll") for (int k = 0; k < 2; ++k) dst[n][k] = *(const G8_LAS bf16x8*)(lds + G8_SB(b, h) + boff + n * 2048 + k * 1024); } while (0)
#define G8_MMA(ai, bj, At, Bt) do { __builtin_amdgcn_s_setprio(1); _Pragma("unroll") for (int m = 0; m < 4; ++m) _Pragma("unroll") for (int n = 0; n < 2; ++n) _Pragma("unroll") for (int k = 0; k < 2; ++k) \
        acc[ai][bj][m][n] = __builtin_amdgcn_mfma_f32_16x16x32_bf16(Bt[n][k], At[m][k], acc[ai][bj][m][n], 0, 0, 0); __builtin_amdgcn_s_setprio(0); } while (0)
#define G8_WAIT_V(n) asm volatile("s_waitcnt vmcnt(" #n ")" ::: "memory")
#define G8_WAIT_L(n) asm volatile("s_waitcnt lgkmcnt(" #n ")" ::: "memory")
#define G8_BAR __builtin_amdgcn_s_barrier()
#define G8_SCHED __builtin_amdgcn_sched_barrier(0)
#define G8_AOFF(dst, un) do { if (GATHER) { _Pragma("unroll") for (int _h = 0; _h < 2; ++_h) _Pragma("unroll") for (int _i = 0; _i < 2; ++_i) \
        dst[_h][_i] = S.row_off(un, _h * HALF + Rr[_i]) + (unsigned)Cc[_i] * 2u; } } while (0)
#define G8_STAGE_A(bufoff, gb, vo, h) do { if (GATHER) { G8_STAGE(bufoff, gb, vo[h]); } else { G8_STAGE(bufoff, (gb) + (h) * hstep, voffA); } } while (0)
    Unit cur, nxt; int ui = 0;
    if (!S.next(0, cur)) return;
    f32x4 acc[2][2][4][2];
#pragma unroll
    for (int a = 0; a < 2; ++a)
#pragma unroll
        for (int b = 0; b < 2; ++b)
#pragma unroll
            for (int m = 0; m < 4; ++m)
#pragma unroll
                for (int n = 0; n < 2; ++n) acc[a][b][m][n] = (f32x4){0.f, 0.f, 0.f, 0.f};
    bf16x8 At[4][2], B0[2][2], B1[2][2];
    unsigned cvA[2][2], nvA[2][2];
    G8_AOFF(cvA, cur);
    const char* cA = cur.A; const char* cB = cur.B;
    G8_STAGE(G8_SB(0, 0), cB, voffB); G8_STAGE_A(G8_SA(0, 0), cA, cvA, 0); G8_STAGE(G8_SB(0, 1), cB + hstep, voffB); G8_STAGE_A(G8_SA(0, 1), cA, cvA, 1);
    if (wr == 1) G8_BAR;
    G8_WAIT_V(4); G8_BAR;
    G8_STAGE(G8_SB(1, 0), cB + kstep, voffB); G8_STAGE_A(G8_SA(1, 0), cA + kstep, cvA, 0); G8_STAGE(G8_SB(1, 1), cB + hstep + kstep, voffB);
    G8_WAIT_V(6); G8_BAR;
    for (;;) {
        const bool has_next = S.next(ui + 1, nxt);
        const char* nA = has_next ? nxt.A : cA; const char* nB = has_next ? nxt.B : cB;
        if (GATHER) {
            if (has_next) { G8_AOFF(nvA, nxt); } else {
#pragma unroll
                for (int h = 0; h < 2; ++h)
#pragma unroll
                    for (int i = 0; i < 2; ++i) nvA[h][i] = cvA[h][i];
            }
        }
        for (int t = 0; t < nt; t += 2) {
            const bool last = (t == nt - 2);
            const char* a1 = cA + (size_t)(t + 1) * kstep;
            const char* a2 = last ? nA : cA + (size_t)(t + 2) * kstep; const char* b2 = last ? nB : cB + (size_t)(t + 2) * kstep;
            const char* a3 = a2 + kstep; const char* b3 = b2 + kstep;

            G8_LDB(B0, 0, 0); G8_SCHED; G8_LDA(At, 0, 0); G8_STAGE_A(G8_SA(1, 1), a1, cvA, 1);
            if (GATHER && last) {
#pragma unroll
                for (int h = 0; h < 2; ++h)
#pragma unroll
                    for (int i = 0; i < 2; ++i) cvA[h][i] = nvA[h][i];
            }
            G8_WAIT_L(8); G8_BAR; G8_WAIT_L(0); G8_MMA(0, 0, At, B0); G8_BAR; G8_SCHED;
            G8_LDB(B1, 0, 1); G8_STAGE(G8_SB(0, 0), b2, voffB);
            G8_BAR; G8_WAIT_L(0); G8_MMA(0, 1, At, B1); G8_BAR;
            G8_LDA(At, 0, 1); G8_STAGE_A(G8_SA(0, 0), a2, cvA, 0);
            G8_BAR; G8_WAIT_L(0); G8_MMA(1, 0, At, B0); G8_BAR; G8_SCHED;
            G8_STAGE(G8_SB(0, 1), b2 + hstep, voffB);
            G8_WAIT_V(6); G8_BAR; G8_MMA(1, 1, At, B1); G8_BAR;
            G8_LDB(B0, 1, 0); G8_SCHED; G8_LDA(At, 1, 0); G8_STAGE_A(G8_SA(0, 1), a2, cvA, 1);
            G8_WAIT_L(8); G8_BAR; G8_WAIT_L(0); G8_MMA(0, 0, At, B0); G8_BAR; G8_SCHED;
            G8_LDB(B1, 1, 1); G8_STAGE(G8_SB(1, 0), b3, voffB);
            G8_BAR; G8_WAIT_L(0); G8_MMA(0, 1, At, B1); G8_BAR;
            G8_LDA(At, 1, 1); G8_STAGE_A(G8_SA(1, 0), a3, cvA, 0);
            G8_BAR; G8_WAIT_L(0); G8_MMA(1, 0, At, B0); G8_BAR; G8_SCHED;
            G8_STAGE(G8_SB(1, 1), b3 + hstep, voffB);
            G8_WAIT_V(6); G8_BAR; G8_MMA(1, 1, At, B1); G8_BAR;
        }
        { int fr2 = fr, fq2 = fq; asm volatile("" : "+v"(fr2), "+v"(fq2)); E(acc, cur, wr, wc, fr2, fq2); }
        if (!has_next) break;
#pragma unroll
        for (int a = 0; a < 2; ++a)
#pragma unroll
            for (int b = 0; b < 2; ++b)
#pragma unroll
                for (int m = 0; m < 4; ++m)
#pragma unroll
                    for (int n = 0; n < 2; ++n) acc[a][b][m][n] = (f32x4){0.f, 0.f, 0.f, 0.f};
        cur = nxt; cA = nA; cB = nB; ++ui;
    }
    G8_WAIT_V(0);
    if (wr == 0) G8_BAR;
    G8_BAR;
#undef G8_SA
#undef G8_SB
#undef G8_STAGE
#undef G8_LDA
#undef G8_LDB
#undef G8_MMA
#undef G8_WAIT_V
#undef G8_WAIT_L
#undef G8_BAR
#undef G8_SCHED
#undef G8_AOFF
#undef G8_STAGE_A
}
}

constexpr int MFULL = 64, M0_LEFT = MFULL * 256;
struct EpiStore {
    static constexpr bool PERM = true;
    bf16_t* O; int ldc; bool sig;
    DI void operator()(const f32x4 (&acc)[2][2][4][2], const g8::Unit& u, int wr, int wc, int fr, int fq) const {
#pragma unroll
        for (int ai = 0; ai < 2; ++ai)
#pragma unroll
            for (int m = 0; m < 4; ++m) {
                bf16_t* rowp = O + (size_t)(u.pm * 256 + ai * 128 + wr * 64 + m * 16 + fr) * ldc + u.pn * 256 + wc * 32 + 8 * fq;
#pragma unroll
                for (int bj = 0; bj < 2; ++bj) {
                    f32x4 v0 = acc[ai][bj][m][0], v1 = acc[ai][bj][m][1];
                    if (sig) {
#pragma unroll
                        for (int e = 0; e < 4; ++e) { v0[e] = sigmoidf_(v0[e]); v1[e] = sigmoidf_(v1[e]); }
                    }
                    *(u32x4*)(rowp + bj * 128) = (u32x4){pack2(v0[0], v0[1]), pack2(v0[2], v0[3]), pack2(v1[0], v1[1]), pack2(v1[2], v1[3])};
                }
            }
    }
};
DI int left_first(int units, int bid, int nb) { return (bid - units % nb + nb) % nb; }

constexpr int LEFT_LDS = 2 * (32 + 128) * LDT * 2;
template <class ARow, class Epi>
DI void gemm_left32(ARow arow, const bf16_t* __restrict__ Bt, int ldb, int K, int n0, char* smem, Epi epi) {
    const int tid = tid_(), lane = tid & 63, wid = __builtin_amdgcn_readfirstlane(tid >> 6), fr = lane & 15, fq = lane >> 4;
    bf16_t* As = (bf16_t*)smem;
    bf16_t* Bs = As + 2 * 32 * LDT;
    const int arow_i = tid >> 4, akc = (tid & 15) * 4;
    const bf16_t* ap = arow(arow_i) + akc;
    const bf16_t* bp[2]; int bso[2];
#pragma unroll
    for (int i = 0; i < 2; ++i) { const int cc = tid + NTHR * i, row = cc >> 3, kc = cc & 7; bp[i] = Bt + (size_t)(n0 + row) * ldb + kc * 8; bso[i] = row * LDT + kc * 8; }
    const int nit = K / 64;
    u32x2 ra[4]; u32x4 rb[4][2];
#define GL_LOAD(slot, it) do { if ((it) < nit) { ra[slot] = *(const u32x2*)(ap + (it) * 64); rb[slot][0] = *(const u32x4*)(bp[0] + (it) * 64); rb[slot][1] = *(const u32x4*)(bp[1] + (it) * 64); } } while (0)
#define GL_WRITE(slot, buf) do { *(u32x2*)(As + (buf) * 32 * LDT + arow_i * LDT + akc) = ra[slot]; *(u32x4*)(Bs + (buf) * 128 * LDT + bso[0]) = rb[slot][0]; *(u32x4*)(Bs + (buf) * 128 * LDT + bso[1]) = rb[slot][1]; } while (0)
    f32x4 acc[2] = {(f32x4){0.f, 0.f, 0.f, 0.f}, (f32x4){0.f, 0.f, 0.f, 0.f}};
    GL_LOAD(0, 0); GL_LOAD(1, 1); GL_LOAD(2, 2); GL_LOAD(3, 3);
    __syncthreads();
    GL_WRITE(0, 0);
    __syncthreads();
#define GL_STEP(slot, it) do { \
        GL_LOAD(slot, (it) + 4); \
        const int buf = (it) & 1; \
        _Pragma("unroll") for (int ks = 0; ks < 2; ++ks) { \
            const bf16x8 bf = *(const bf16x8*)(Bs + buf * 128 * LDT + (wid * 16 + fr) * LDT + ks * 32 + fq * 8); \
            _Pragma("unroll") for (int mt = 0; mt < 2; ++mt) { \
                const bf16x8 af = *(const bf16x8*)(As + buf * 32 * LDT + (mt * 16 + fr) * LDT + ks * 32 + fq * 8); \
                acc[mt] = __builtin_amdgcn_mfma_f32_16x16x32_bf16(bf, af, acc[mt], 0, 0, 0); } } \
        if ((it) + 1 < nit) { GL_WRITE(((slot) + 1) & 3, buf ^ 1); } \
        __syncthreads(); } while (0)
    for (int it = 0; it < nit; it += 4) {
        GL_STEP(0, it);
        if (it + 1 < nit) GL_STEP(1, it + 1);
        if (it + 2 < nit) GL_STEP(2, it + 2);
        if (it + 3 < nit) GL_STEP(3, it + 3);
    }
#undef GL_LOAD
#undef GL_WRITE
#undef GL_STEP
#pragma unroll
    for (int mt = 0; mt < 2; ++mt) epi(mt * 16 + fr, n0 + wid * 16 + fq * 4, acc[mt]);
}

DI void phase_inproj(const Params& p, int layer, int bid, int nb, char* smem) {
    const bf16_t* hb = p.hb; bf16_t* P = p.P;
    const bf16_t* Bt = p.WtIn + (size_t)layer * CIN * D;
    g8::DenseOrder S; S.init(hb, Bt, MFULL, CP / 256, D, nb, bid);
    g8::gemm8<false>((G8_LAS unsigned char*)smem, D, S, EpiStore{P, CP, false});
    {
        constexpr int UNITS = MFULL * (CP / 256);
        const int heavy = UNITS % nb;
        if (heavy > 0 && heavy < nb) { if (bid >= heavy) convert_experts(p, layer, 0, NE / 2, bid - heavy, nb - heavy, smem); }
        else convert_experts(p, layer, 0, NE / 2, bid, nb, smem);
    }
    bf16_t* G = p.gleft - (size_t)M0_LEFT * 2048; const bf16_t* Wg = p.WtIn + ((size_t)layer * CIN + CP) * D;
    for (int t = left_first(MFULL * (CP / 256), bid, nb); t < CP / 128 + 2048 / 128; t += nb) {
        if (t < CP / 128)
            gemm_left32([=](int r) { return hb + (size_t)(M0_LEFT + r) * D; }, Bt, D, D, t * 128, smem,
                        [=](int r, int c, f32x4 v) { *(u32x2*)(P + (size_t)(M0_LEFT + r) * CP + c) = (u32x2){pack2(v[0], v[1]), pack2(v[2], v[3])}; });
        else
            gemm_left32([=](int r) { return hb + (size_t)(M0_LEFT + r) * D; }, Wg, D, D, (t - CP / 128) * 128, smem,
                        [=](int r, int c, f32x4 v) { *(u32x2*)(G + (size_t)(M0_LEFT + r) * 2048 + c) = (u32x2){pack2(sigmoidf_(v[0]), sigmoidf_(v[1])), pack2(sigmoidf_(v[2]), sigmoidf_(v[3]))}; });
    }
}

constexpr int NCHUNK = (L + 63) / 64, NUNIT = NBATCH * HEADS * NCHUNK;
constexpr int LS = 72, RB = 64 * LS * 2;
constexpr int R1_LDS = 16 * RB + 4096 + 7168;
#define RBUF(i) ((bf16_t*)(smem + (i) * RB))
typedef float f32x16 __attribute__((ext_vector_type(16)));

template <int KK> DI f32x4 mm16(const bf16_t* F, int ldf, const bf16_t* S, int lds_, f32x4 acc, int lane) {
    const int fr = lane & 15, fq = lane >> 4;
#pragma unroll
    for (int ks = 0; ks < KK / 32; ++ks) {
        const bf16x8 f = *(const bf16x8*)(F + fr * ldf + ks * 32 + fq * 8);
        const bf16x8 g = *(const bf16x8*)(S + fr * lds_ + ks * 32 + fq * 8);
        acc = __builtin_amdgcn_mfma_f32_16x16x32_bf16(f, g, acc, 0, 0, 0);
    }
    return acc;
}
DI u32x2 pk4(f32x4 v) { return (u32x2){pack2(v[0], v[1]), pack2(v[2], v[3])}; }
DI f32x4 up4(u32x2 v) { return (f32x4){lo_bf(v[0]), hi_bf(v[0]), lo_bf(v[1]), hi_bf(v[1])}; }

template <int MODE> DI void phase_rwkv_r1(const Params& p, int layer, int bid, int nb, char* smem) {
    const int wv = __builtin_amdgcn_readfirstlane(tid_() >> 6);
    const f32x4 zero = (f32x4){0.f, 0.f, 0.f, 0.f};
    float* lwT = (float*)RBUF(4);
    float* aT = (float*)RBUF(6);
    float* gt = (float*)(smem + 16 * RB);
    float* gammaC = gt + 512;
    bf16_t* Xt0 = RBUF(14);
    bf16_t* Xt1 = RBUF(4);
    const bf16_t* WupT = p.WupT + (size_t)layer * 512 * 64, *AupT = p.AupT + (size_t)layer * 512 * 64, *GupT = p.GupT + (size_t)layer * 512 * 128;
    float* mu = (float*)(smem + 16 * RB + 4096);
    __syncthreads();
    for (int i = tid_(); i < RSW; i += NTHR) mu[i] = p.mu[(size_t)layer * RSW + i];
    for (int it = 0;; ++it) {
        const int tid = tid_(), lane = tid & 63, fr = lane & 15, fq = lane >> 4;
        int c, bh;
        if (MODE == 0) {
            const int Lq = it * nb + bid, q = Lq >> 3, cb = (q >> 3) * 8 + (Lq & 7);
            if (cb >= NBATCH * (NCHUNK - 1)) break;
            c = cb % (NCHUNK - 1); bh = (cb / (NCHUNK - 1)) * HEADS + (q & 7);
        } else {
            if (it > 0) break;
            c = NCHUNK - 1; bh = bid;
        }
        const int u = bh * NCHUNK + c, h = bh % HEADS, bb = bh / HEADS;
        const size_t tok0 = (size_t)bb * L + c * 64;
        bf16x8 fw[2][2], fa[2][2], fg[2][4];
#pragma unroll
        for (int t2 = 0; t2 < 2; ++t2) {
            const int tl = wv * 2 + t2, pt = tl >> 2, qt = tl & 3;
#pragma unroll
            for (int ks = 0; ks < 2; ++ks) {
                fw[t2][ks] = *(const bf16x8*)(WupT + (size_t)(h * 64 + qt * 16 + fr) * 64 + ks * 32 + fq * 8);
                fa[t2][ks] = *(const bf16x8*)(AupT + (size_t)(h * 64 + pt * 16 + fr) * 64 + ks * 32 + fq * 8);
            }
        }
        __syncthreads();
        {
            u32x4 curv[7], prvv[7];
#pragma unroll
            for (int it2 = 0; it2 < 7; ++it2) {
                const int cid = tid + NTHR * it2, i = cid / 56, cc = cid % 56;
                const int col = cc < 8 ? RW_R + h * 64 + cc * 8 : cc < 16 ? RW_K + h * 64 + (cc - 8) * 8 : cc < 24 ? RW_V + h * 64 + (cc - 16) * 8 : RW_WD + (cc - 24) * 8;
                const int t = c * 64 + i;
                curv[it2] = (u32x4){0u, 0u, 0u, 0u}; prvv[it2] = (u32x4){0u, 0u, 0u, 0u};
                if (t < L) curv[it2] = *(const u32x4*)(p.P + (tok0 + i) * CP + OFF_RW + col);
                if (t < L && t > 0) prvv[it2] = *(const u32x4*)(p.P + (tok0 + i - 1) * CP + OFF_RW + col);
            }
#pragma unroll
            for (int it2 = 0; it2 < 7; ++it2) {
                const int cid = tid + NTHR * it2, i = cid / 56, cc = cid % 56;
                const int col = cc < 8 ? RW_R + h * 64 + cc * 8 : cc < 16 ? RW_K + h * 64 + (cc - 8) * 8 : cc < 24 ? RW_V + h * 64 + (cc - 16) * 8 : RW_WD + (cc - 24) * 8;
                bf16_t* dst = cc < 8 ? RBUF(8) + i * LS + cc * 8 : cc < 16 ? RBUF(9) + i * LS + (cc - 8) * 8 : cc < 24 ? RBUF(10) + i * LS + (cc - 16) * 8
                            : cc < 32 ? RBUF(0) + i * LS + (cc - 24) * 8 : cc < 40 ? RBUF(1) + i * LS + (cc - 32) * 8 : RBUF(2) + i * 136 + (cc - 40) * 8;
                const f32x4 m0 = *(const f32x4*)(mu + col), m1 = *(const f32x4*)(mu + col + 4);
                const u32x4 cur = curv[it2], prv = prvv[it2];
                float x[8];
#pragma unroll
                for (int j2 = 0; j2 < 4; ++j2) {
                    const float c0 = lo_bf(cur[j2]), c1 = hi_bf(cur[j2]), p0 = lo_bf(prv[j2]), p1 = hi_bf(prv[j2]);
                    const float mm0 = j2 < 2 ? m0[2 * j2] : m1[2 * j2 - 4], mm1 = j2 < 2 ? m0[2 * j2 + 1] : m1[2 * j2 - 3];
                    x[2 * j2] = c0 + (p0 - c0) * mm0; x[2 * j2 + 1] = c1 + (p1 - c1) * mm1;
                }
                if (cc >= 24 && cc < 32) {
#pragma unroll
                    for (int j2 = 0; j2 < 8; ++j2) x[j2] = tanhf_(x[j2]);
                } else if (cc >= 40) {
#pragma unroll
                    for (int j2 = 0; j2 < 8; ++j2) x[j2] = sigmoidf_(x[j2]);
                }
                *(u32x4*)dst = (u32x4){pack2(x[0], x[1]), pack2(x[2], x[3]), pack2(x[4], x[5]), pack2(x[6], x[7])};
            }
        }
#pragma unroll
        for (int t2 = 0; t2 < 2; ++t2)
#pragma unroll
            for (int ks = 0; ks < 4; ++ks) fg[t2][ks] = *(const bf16x8*)(GupT + (size_t)(h * 64 + ((wv * 2 + t2) >> 2) * 16 + fr) * 128 + ks * 32 + fq * 8);
        __syncthreads();
#pragma unroll
        for (int t2 = 0; t2 < 2; ++t2) {
            const int tl = wv * 2 + t2, pt = tl >> 2, qt = tl & 3;
            f32x4 aw = zero, aa = zero, ag = zero;
#pragma unroll
            for (int ks = 0; ks < 2; ++ks) {
                const bf16x8 xw = *(const bf16x8*)(RBUF(0) + (pt * 16 + fr) * LS + ks * 32 + fq * 8);
                aw = __builtin_amdgcn_mfma_f32_16x16x32_bf16(xw, fw[t2][ks], aw, 0, 0, 0);
                const bf16x8 xa = *(const bf16x8*)(RBUF(1) + (qt * 16 + fr) * LS + ks * 32 + fq * 8);
                aa = __builtin_amdgcn_mfma_f32_16x16x32_bf16(fa[t2][ks], xa, aa, 0, 0, 0);
            }
#pragma unroll
            for (int ks = 0; ks < 4; ++ks) {
                const bf16x8 xg = *(const bf16x8*)(RBUF(2) + (qt * 16 + fr) * 136 + ks * 32 + fq * 8);
                ag = __builtin_amdgcn_mfma_f32_16x16x32_bf16(fg[t2][ks], xg, ag, 0, 0, 0);
            }
            const int ch = qt * 16 + fr;
            const float w0 = p.w0[layer * 512 + h * 64 + ch];
            const f32x4 a0 = *(const f32x4*)(p.a0 + layer * 512 + h * 64 + pt * 16 + fq * 4);
            f32x4 lw, av;
#pragma unroll
            for (int e = 0; e < 4; ++e) { lw[e] = -DECAY_SCALE * sigmoidf_(w0 + aw[e]); av[e] = sigmoidf_(a0[e] + aa[e]); }
            *(f32x4*)(lwT + ch * 68 + pt * 16 + fq * 4) = lw;
            *(f32x4*)(aT + (qt * 16 + fr) * 68 + pt * 16 + fq * 4) = av;
            *(u32x2*)(p.GG + ((size_t)u * 64 + qt * 16 + fr) * 64 + pt * 16 + fq * 4) = pk4(ag);
        }
        __syncthreads();
        {
            const int i = tid >> 3, c8 = (tid & 7) * 8, cg = layer * 512 + h * 64 + c8;
            const u32x4 xr = *(const u32x4*)(RBUF(8) + i * LS + c8), xk = *(const u32x4*)(RBUF(9) + i * LS + c8);
            const f32x4 a0 = *(const f32x4*)(aT + i * 68 + c8), a1 = *(const f32x4*)(aT + i * 68 + c8 + 4);
            const f32x4 kk0 = *(const f32x4*)(p.k_k + cg), kk1 = *(const f32x4*)(p.k_k + cg + 4), ka0 = *(const f32x4*)(p.k_a + cg), ka1 = *(const f32x4*)(p.k_a + cg + 4);
            const f32x4 rk0 = *(const f32x4*)(p.r_k + cg), rk1 = *(const f32x4*)(p.r_k + cg + 4);
            float n2 = 0.f, bon = 0.f;
#pragma unroll
            for (int j = 0; j < 8; ++j) {
                const float r_ = (j & 1) ? hi_bf(xr[j >> 1]) : lo_bf(xr[j >> 1]), k_ = (j & 1) ? hi_bf(xk[j >> 1]) : lo_bf(xk[j >> 1]);
                const float a_ = j < 4 ? a0[j & 3] : a1[j & 3], kkc = j < 4 ? kk0[j & 3] : kk1[j & 3], kac = j < 4 ? ka0[j & 3] : ka1[j & 3], rkc = j < 4 ? rk0[j & 3] : rk1[j & 3];
                const float kkr = k_ * kkc;
                n2 += kkr * kkr;
                bon += r_ * (k_ * (1.0f + (a_ - 1.0f) * kac)) * rkc;
            }
            n2 = sum8(n2); bon = sum8(bon);
            if ((tid & 7) == 0) { gt[576 + i] = 1.0f / fmaxf(sqrtf(n2), 1e-12f); p.bonG[(size_t)u * 64 + i] = bon; }
        }
        __syncthreads();
        {
            const int ch = lane, cg = layer * 512 + h * 64 + ch;
            float lw[8], av[8], cum[8];
            {
                const f32x4 l0 = *(const f32x4*)(lwT + ch * 68 + wv * 8), l1 = *(const f32x4*)(lwT + ch * 68 + wv * 8 + 4);
#pragma unroll
                for (int e = 0; e < 4; ++e) { lw[e] = l0[e]; lw[e + 4] = l1[e]; }
#pragma unroll
                for (int e = 0; e < 8; ++e) av[e] = aT[(wv * 8 + e) * 68 + ch];
            }
            float run = 0.f;
#pragma unroll
            for (int e = 0; e < 8; ++e) { run += lw[e]; cum[e] = run; }
            gt[wv * 64 + ch] = run;
            __syncthreads();
            float offs = 0.f, tot = 0.f;
#pragma unroll
            for (int g2 = 0; g2 < 8; ++g2) { const float gv = gt[g2 * 64 + ch]; offs += g2 < wv ? gv : 0.f; tot += gv; }
            if (wv == 0) gammaC[ch] = __expf(tot);
            const float kkc = p.k_k[cg], kac = p.k_a[cg];
            float at_[8], kt_[8], bt_[8], vt_[8];
#pragma unroll
            for (int e = 0; e < 8; ++e) {
                const int i = wv * 8 + e;
                const float xr = bf2f(RBUF(8)[i * LS + ch]), xk = bf2f(RBUF(9)[i * LS + ch]), xv = bf2f(RBUF(10)[i * LS + ch]);
                const float cm = cum[e] + offs;
                const float kk = xk * kkc * gt[576 + i];
                const float kq = xk * (1.0f + (av[e] - 1.0f) * kac);
                if (c * 64 + i < L) p.orw[(tok0 + i) * 512 + h * 64 + ch] = RBUF(10)[i * LS + ch];
                const float eneg = __expf(-cm), epos = __expf(cm), eexc = __expf(cm - lw[e]);
                at_[e] = -kk * eexc; kt_[e] = kq * eneg; bt_[e] = kk * av[e] * eneg; vt_[e] = xv;
                RBUF(3)[i * LS + ch] = f2bf(xr * epos);
            }
            __syncthreads();
#pragma unroll
            for (int e = 0; e < 8; ++e) {
                const int i = wv * 8 + e;
                RBUF(0)[i * LS + ch] = f2bf(at_[e]); RBUF(1)[i * LS + ch] = f2bf(kt_[e]); RBUF(2)[i * LS + ch] = f2bf(bt_[e]);
            }
            *(u32x4*)(RBUF(11) + ch * LS + wv * 8) = (u32x4){pack2(kt_[0], kt_[1]), pack2(kt_[2], kt_[3]), pack2(kt_[4], kt_[5]), pack2(kt_[6], kt_[7])};
            *(u32x4*)(RBUF(12) + ch * LS + wv * 8) = (u32x4){pack2(bt_[0], bt_[1]), pack2(bt_[2], bt_[3]), pack2(bt_[4], bt_[5]), pack2(bt_[6], bt_[7])};
            *(u32x4*)(RBUF(13) + ch * LS + wv * 8) = (u32x4){pack2(vt_[0], vt_[1]), pack2(vt_[2], vt_[3]), pack2(vt_[4], vt_[5]), pack2(vt_[6], vt_[7])};
            *(u32x4*)(Xt0 + ch * LS + wv * 8) = (u32x4){pack2(at_[0], at_[1]), pack2(at_[2], at_[3]), pack2(at_[4], at_[5]), pack2(at_[6], at_[7])};
        }
        __syncthreads();
#pragma unroll
        for (int prod = 0; prod < 4; ++prod) {
            const bf16_t* F = (prod == 0 || prod == 2) ? RBUF(1) : RBUF(2);
            const bf16_t* S = prod < 2 ? RBUF(0) : RBUF(3);
            bf16_t* O = prod == 0 ? RBUF(6) : prod == 1 ? RBUF(7) : prod == 2 ? RBUF(9) : RBUF(10);
            const int mode = prod < 2 ? 0 : 1;
#pragma unroll
            for (int rep = 0; rep < 2; ++rep) {
                const int tl = wv + 8 * rep, pt = tl >> 2, qt = tl & 3;
                f32x4 acc = zero;
                if (pt <= qt) acc = mm16<64>(F + pt * 16 * LS, LS, S + qt * 16 * LS, LS, zero, lane);
                const int qi = qt * 16 + fr;
#pragma unroll
                for (int e = 0; e < 4; ++e) {
                    const int pi = pt * 16 + fq * 4 + e;
                    const bool keep = mode == 0 ? pi < qi : pi <= qi;
                    acc[e] = keep ? acc[e] : 0.f;
                }
                *(u32x2*)(O + qi * LS + pt * 16 + fq * 4) = pk4(acc);
                if (prod == 1) {
#pragma unroll
                    for (int e = 0; e < 4; ++e) RBUF(8)[(pt * 16 + fq * 4 + e) * LS + qi] = f2bf(acc[e]);
                }
            }
        }
        __syncthreads();
        f32x4 X[4];
        if (wv < 4) {
#pragma unroll
            for (int pt = 0; pt < 4; ++pt) X[pt] = up4(*(const u32x2*)(Xt0 + (wv * 16 + fr) * LS + pt * 16 + fq * 4));
        } else {
#pragma unroll
            for (int pt = 0; pt < 4; ++pt) {
                X[pt] = mm16<64>(RBUF(6) + pt * 16 * LS, LS, RBUF(13) + (wv - 4) * 16 * LS, LS, zero, lane);
                *(u32x2*)(Xt0 + (wv * 16 + fr) * LS + pt * 16 + fq * 4) = pk4(X[pt]);
            }
        }
        __syncthreads();
#pragma unroll
        for (int k = 0; k < 6; ++k) {
            const bf16_t* Mk = (k & 1) ? RBUF(0) : RBUF(7);
            const bf16_t* Mkt = (k & 1) ? RBUF(6) : RBUF(8);
            bf16_t* Mn = (k & 1) ? RBUF(7) : RBUF(0);
            bf16_t* Mnt = (k & 1) ? RBUF(8) : RBUF(6);
            const bf16_t* Xc = (k & 1) ? Xt1 : Xt0;
            bf16_t* Xn = (k & 1) ? Xt0 : Xt1;
#pragma unroll
            for (int pt = 0; pt < 4; ++pt) {
                constexpr int dummy = 0; (void)dummy;
                const int maxj = 16 * pt + 15 - (1 << k);
                if (maxj >= 0) {
                    const int nks = maxj / 32 + 1;
#pragma unroll
                    for (int ks = 0; ks < 2; ++ks)
                        if (ks < nks) {
                            const bf16x8 f = *(const bf16x8*)(Mk + (pt * 16 + fr) * LS + ks * 32 + fq * 8);
                            const bf16x8 g = *(const bf16x8*)(Xc + (wv * 16 + fr) * LS + ks * 32 + fq * 8);
                            X[pt] = __builtin_amdgcn_mfma_f32_16x16x32_bf16(f, g, X[pt], 0, 0, 0);
                        }
                }
                *(u32x2*)(Xn + (wv * 16 + fr) * LS + pt * 16 + fq * 4) = pk4(X[pt]);
            }
            if (k < 5) {
#pragma unroll
                for (int rep = 0; rep < 2; ++rep) {
                    const int t2 = wv + 8 * rep, pt = t2 >> 2, qt = t2 & 3;
                    f32x4 acc = zero;
                    const int mlo = 16 * pt + (1 << k), mhi = 16 * qt + 15 - (1 << k);
                    if (16 * qt + 15 - 16 * pt >= (2 << k) && mhi >= mlo) {
                        const int k0 = mlo >> 5, k1 = mhi >> 5;
                        for (int ks = k0; ks <= k1; ++ks) {
                            const bf16x8 f = *(const bf16x8*)(Mkt + (pt * 16 + fr) * LS + ks * 32 + fq * 8);
                            const bf16x8 g = *(const bf16x8*)(Mk + (qt * 16 + fr) * LS + ks * 32 + fq * 8);
                            acc = __builtin_amdgcn_mfma_f32_16x16x32_bf16(f, g, acc, 0, 0, 0);
                        }
                    }
                    *(u32x2*)(Mn + (qt * 16 + fr) * LS + pt * 16 + fq * 4) = pk4(acc);
#pragma unroll
                    for (int e = 0; e < 4; ++e) Mnt[(pt * 16 + fq * 4 + e) * LS + qt * 16 + fr] = f2bf(acc[e]);
                }
            }
            __syncthreads();
        }
#pragma unroll
        for (int rep = 0; rep < 2; ++rep) {
            const int tl = wv + 8 * rep, pt = tl >> 2, qt = tl & 3;
            const int pi0 = pt * 16 + fq * 4, qi = qt * 16 + fr;
            const size_t go = ((size_t)u * 64 + qi) * 64 + pi0;
            {
                f32x4 acc = mm16<64>(Xt0 + pt * 16 * LS, LS, RBUF(12) + qt * 16 * LS, LS, zero, lane);
                const float gc = gammaC[qi];
#pragma unroll
                for (int e = 0; e < 4; ++e) acc[e] = (acc[e] + (pi0 + e == qi ? 1.f : 0.f)) * gc;
                {
                    const size_t d = (((size_t)u * 8 + (qi >> 4) * 2 + (pi0 >> 5)) * 64 + (qi & 15) + 16 * ((pi0 >> 2) & 3)) * 8 + ((pi0 >> 4) & 1) * 4;
                    *(u32x2*)(p.PcG + d) = pk4(acc);
                }
            }
            {
                f32x4 acc = mm16<64>(RBUF(11) + pt * 16 * LS, LS, RBUF(13) + qt * 16 * LS, LS, zero, lane);
                acc = mm16<64>(RBUF(12) + pt * 16 * LS, LS, Xt0 + (64 + qt * 16) * LS, LS, acc, lane);
                const f32x4 gc = *(const f32x4*)(gammaC + pi0);
#pragma unroll
                for (int e = 0; e < 4; ++e) acc[e] *= gc[e];
                {
                    const size_t d = (((size_t)u * 4 + (qi >> 4)) * 64 + (qi & 15) + 16 * ((pi0 >> 2) & 3)) * 16 + (pi0 >> 4) * 4;
                    *(u32x2*)(p.QcG + d) = pk4(acc);
                }
            }
            {
                f32x4 acc = mm16<64>(Xt0 + pt * 16 * LS, LS, RBUF(10) + qt * 16 * LS, LS, zero, lane);
                const f32x4 rr = up4(*(const u32x2*)(RBUF(3) + qi * LS + pi0));
#pragma unroll
                for (int e = 0; e < 4; ++e) acc[e] += rr[e];
                *(u32x2*)(p.RhG + go) = pk4(acc);
            }
            {
                f32x4 acc = mm16<64>(RBUF(13) + pt * 16 * LS, LS, RBUF(9) + qt * 16 * LS, LS, zero, lane);
                acc = mm16<64>(Xt0 + (64 + pt * 16) * LS, LS, RBUF(10) + qt * 16 * LS, LS, acc, lane);
                *(u32x2*)(p.Y0G + go) = pk4(acc);
            }
        }
    }
}

struct R2Set { u32x4 a[8]; u32x4 q[2]; };
DI void r2_load(R2Set& st, const Params& p, size_t u, int lane, int vq) {
    const bf16_t* qg = p.QcG + ((u * 4 + vq) * 64 + lane) * 16;
    st.q[0] = *(const u32x4*)qg; st.q[1] = *(const u32x4*)(qg + 8);
#pragma unroll
    for (int f = 0; f < 8; ++f) st.a[f] = *(const u32x4*)(p.PcG + ((u * 8 + f) * 64 + lane) * 8);
}
DI void r2_step(f32x4 (&S)[4], const R2Set& st, const Params& p, size_t u, int lane, int vq, bool last) {
    const u32x4 b0 = (u32x4){pack2(S[0][0], S[0][1]), pack2(S[0][2], S[0][3]), pack2(S[1][0], S[1][1]), pack2(S[1][2], S[1][3])};
    const u32x4 b1 = (u32x4){pack2(S[2][0], S[2][1]), pack2(S[2][2], S[2][3]), pack2(S[3][0], S[3][1]), pack2(S[3][2], S[3][3])};
    bf16_t* sg = p.SG + ((u * 4 + vq) * 64 + lane) * 16;
    *(u32x4*)sg = b0; *(u32x4*)(sg + 8) = b1;
    if (last) return;
#pragma unroll
    for (int kt = 0; kt < 4; ++kt) {
        const u32x4 qq = st.q[kt >> 1];
        const unsigned w0 = qq[(kt & 1) * 2], w1 = qq[(kt & 1) * 2 + 1];
        S[kt] = (f32x4){lo_bf(w0), hi_bf(w0), lo_bf(w1), hi_bf(w1)};
    }
    const bf16x8 f0 = __builtin_bit_cast(bf16x8, b0), f1 = __builtin_bit_cast(bf16x8, b1);
#pragma unroll
    for (int kt = 0; kt < 4; ++kt) {
        S[kt] = __builtin_amdgcn_mfma_f32_16x16x32_bf16(__builtin_bit_cast(bf16x8, st.a[kt * 2]), f0, S[kt], 0, 0, 0);
        S[kt] = __builtin_amdgcn_mfma_f32_16x16x32_bf16(__builtin_bit_cast(bf16x8, st.a[kt * 2 + 1]), f1, S[kt], 0, 0, 0);
    }
}
DI void phase_rwkv_r2(const Params& p, int chain) {
    const int lane = tid_() & 63;
    const int bh = chain >> 2, vq = chain & 3;
    const size_t u0 = (size_t)bh * NCHUNK;
    f32x4 S[4];
#pragma unroll
    for (int kt = 0; kt < 4; ++kt) S[kt] = (f32x4){0.f, 0.f, 0.f, 0.f};
    R2Set A, B, C, E;
    r2_load(A, p, u0, lane, vq); r2_load(B, p, u0 + 1, lane, vq); r2_load(C, p, u0 + 2, lane, vq); r2_load(E, p, u0 + 3, lane, vq);
#define R2_ONE(SET, cc) do { r2_step(S, SET, p, u0 + (cc), lane, vq, (cc) == NCHUNK - 1); if ((cc) + 4 < NCHUNK - 1) r2_load(SET, p, u0 + (cc) + 4, lane, vq); } while (0)
#pragma unroll 1
    for (int c = 0; c < NCHUNK; c += 4) {
        R2_ONE(A, c);
        if (c == NCHUNK - 1) break;
        R2_ONE(B, c + 1);
        R2_ONE(C, c + 2);
        R2_ONE(E, c + 3);
    }
#undef R2_ONE
}

DI void phase_rwkv_r3(const Params& p, int layer, int bid, int nb) {
    const int tid = tid_(), lane = tid & 63, wv = __builtin_amdgcn_readfirstlane(tid >> 6), fr = lane & 15, fq = lane >> 4;
    for (int task = bid * 8 + wv; task < NUNIT * 4; task += nb * 8) {
        const int u = task >> 2, it = task & 3;
        const int c = u % NCHUNK, bh = u / NCHUNK, h = bh % HEADS, bb = bh / HEADS;
        const int i = it * 16 + fr, t = c * 64 + i;
        const bool live = t < L;
        const size_t tok = (size_t)bb * L + (live ? t : 0);
        bf16x8 sf[2];
#pragma unroll
        for (int ks = 0; ks < 2; ++ks) sf[ks] = *(const bf16x8*)(p.RhG + ((size_t)u * 64 + i) * 64 + ks * 32 + fq * 8);
        u32x2 s0[4][2], s1[4][2], y0[4], xvv[4], gv[4];
#pragma unroll
        for (int vt = 0; vt < 4; ++vt) {
            const int vv = vt * 16 + fr;
#pragma unroll
            for (int ks = 0; ks < 2; ++ks) {
                const bf16_t* sp = p.SG + (((size_t)u * 4 + vt) * 64 + fr + 32 * (fq & 1)) * 16 + (2 * ks + (fq >> 1)) * 4;
                s0[vt][ks] = *(const u32x2*)sp; s1[vt][ks] = *(const u32x2*)(sp + 16 * 16);
                (void)vv;
            }
            y0[vt] = *(const u32x2*)(p.Y0G + ((size_t)u * 64 + i) * 64 + vt * 16 + fq * 4);
            xvv[vt] = *(const u32x2*)(p.orw + tok * 512 + h * 64 + vt * 16 + fq * 4);
            gv[vt] = *(const u32x2*)(p.GG + ((size_t)u * 64 + i) * 64 + vt * 16 + fq * 4);
        }
        const float bon = p.bonG[(size_t)u * 64 + i];
        f32x4 y[4];
#pragma unroll
        for (int vt = 0; vt < 4; ++vt) {
            y[vt] = up4(y0[vt]);
#pragma unroll
            for (int ks = 0; ks < 2; ++ks) {
                const bf16x8 f = __builtin_bit_cast(bf16x8, ((u32x4){s0[vt][ks][0], s0[vt][ks][1], s1[vt][ks][0], s1[vt][ks][1]}));
                y[vt] = __builtin_amdgcn_mfma_f32_16x16x32_bf16(f, sf[ks], y[vt], 0, 0, 0);
            }
        }
        float s = 0.f;
#pragma unroll
        for (int vt = 0; vt < 4; ++vt) s += (y[vt][0] + y[vt][1]) + (y[vt][2] + y[vt][3]);
        s += __shfl_xor(s, 16); s += __shfl_xor(s, 32);
        const float mean = s * (1.0f / 64.f);
        float q = 0.f;
#pragma unroll
        for (int vt = 0; vt < 4; ++vt)
#pragma unroll
            for (int e = 0; e < 4; ++e) { y[vt][e] -= mean; q += y[vt][e] * y[vt][e]; }
        q += __shfl_xor(q, 16); q += __shfl_xor(q, 32);
        const float rstd = rsqrtf(q * (1.0f / 64.f) + 64e-5f);
        if (live) {
#pragma unroll
            for (int vt = 0; vt < 4; ++vt) {
                const int cg = h * 64 + vt * 16 + fq * 4;
                const f32x4 xv = up4(xvv[vt]), g = up4(gv[vt]);
                const f32x4 lg = *(const f32x4*)(p.lnx_g + layer * 512 + cg), lb = *(const f32x4*)(p.lnx_b + layer * 512 + cg);
                f32x4 o;
#pragma unroll
                for (int e = 0; e < 4; ++e) o[e] = (y[vt][e] * rstd * lg[e] + lb[e] + bon * xv[e]) * g[e];
                *(u32x2*)(p.orw + tok * 512 + cg) = pk4(o);
            }
        }
    }
}

constexpr int SB_LDS = 4 * RB + 64;
DI void phase_sb(const Params& p, int bid0, int nb, char* smem) {
    const int tid = tid_(), lane = tid & 63, wv = __builtin_amdgcn_readfirstlane(tid >> 6), fr = lane & 15, fq = lane >> 4;
    bf16_t* Ks0 = (bf16_t*)smem;
    bf16_t* Vt0 = Ks0 + 2 * 64 * LS;
    int* flags = (int*)(smem + 4 * RB);
    bf16x8 tri[4][2];
#pragma unroll
    for (int st = 0; st < 4; ++st)
#pragma unroll
        for (int k2 = 0; k2 < 2; ++k2)
#pragma unroll
            for (int jj = 0; jj < 8; ++jj) tri[st][k2][jj] = (32 * k2 + 16 * (jj >> 2) + 4 * fq + (jj & 3) > 16 * st + fr) ? (short)0x3F80 : (short)0;
    constexpr int NQB = (L + 127) / 128;
    const int ldkey = tid >> 3, lddc = (tid & 7) * 8;
    for (int u = bid0; u < NBATCH * HEADS * NQB; u += nb) {
        const int bh = u % (NBATCH * HEADS), b = bh / HEADS, h = bh % HEADS, q0 = (u / (NBATCH * HEADS)) * 128;
        const int qlo = q0 + 16 * wv, query = qlo + fr;
        const size_t tokb = (size_t)b * L;
        bf16x8 qf[2];
#pragma unroll
        for (int ks = 0; ks < 2; ++ks) qf[ks] = *(const bf16x8*)(p.P + (tokb + query) * CP + OFF_Q + h * 64 + ks * 32 + fq * 8);
        const int qmax = (q0 + 127 < L - 1) ? q0 + 127 : L - 1;
        int kt = (qmax - 1) >> 6;
        float R = 0.f;
        f32x4 ot[4];
#pragma unroll
        for (int dt = 0; dt < 4; ++dt) ot[dt] = (f32x4){0.f, 0.f, 0.f, 0.f};
        bool done = qlo >= L;
        u32x4 kreg, vreg;
        {
            const int s = kt * 64 + ldkey;
            const bf16_t* src = p.P + (tokb + s) * CP + h * 64 + lddc;
            kreg = s < L ? *(const u32x4*)(src + OFF_K) : (u32x4){0u, 0u, 0u, 0u};
            vreg = s < L ? *(const u32x4*)(src + OFF_V) : (u32x4){0u, 0u, 0u, 0u};
        }
        const int vsw = (tid & 7) << 2;
        __syncthreads();
        {
            *(u32x4*)(Ks0 + ldkey * LS + lddc) = kreg;
#pragma unroll
            for (int j = 0; j < 4; ++j) { Vt0[(lddc + 2 * j) * LS + (ldkey ^ vsw)] = (bf16_t)(vreg[j] & 0xFFFFu); Vt0[(lddc + 2 * j + 1) * LS + (ldkey ^ vsw)] = (bf16_t)(vreg[j] >> 16); }
        }
        __syncthreads();
        for (int itile = 0;; ++itile) {
            const bf16_t* Ks = Ks0 + (itile & 1) * 64 * LS; const bf16_t* Vt = Vt0 + (itile & 1) * 64 * LS;
            if (kt > 0) {
                const int s = (kt - 1) * 64 + ldkey;
                const bf16_t* src = p.P + (tokb + s) * CP + h * 64 + lddc;
                kreg = *(const u32x4*)(src + OFF_K); vreg = *(const u32x4*)(src + OFF_V);
            }
            if (!done && kt * 64 < qlo + 15) {
                f32x4 uu[4], lsp[4];
                float tot = 0.f;
                const bool full = kt * 64 + 63 < qlo;
#pragma unroll
                for (int kk = 0; kk < 4; ++kk) {
                    f32x4 z = (f32x4){0.f, 0.f, 0.f, 0.f};
#pragma unroll
                    for (int ks = 0; ks < 2; ++ks) {
                        const bf16x8 f = *(const bf16x8*)(Ks + (16 * kk + fr) * LS + ks * 32 + fq * 8);
                        z = __builtin_amdgcn_mfma_f32_16x16x32_bf16(f, qf[ks], z, 0, 0, 0);
                    }
#pragma unroll
                    for (int e = 0; e < 4; ++e) {
                        const float zz = z[e] * 0.18033688011112042f;
                        const float lsneg = -(fmaxf(zz, 0.f) + __builtin_amdgcn_logf(1.0f + __builtin_amdgcn_exp2f(-fabsf(zz))));
                        if (full) { uu[kk][e] = lsneg; lsp[kk][e] = lsneg + zz; }
                        else {
                            const bool valid = kt * 64 + 16 * kk + 4 * fq + e < query;
                            uu[kk][e] = valid ? lsneg : 0.f;
                            lsp[kk][e] = valid ? lsneg + zz : -1.0e30f;
                        }
                        tot += uu[kk][e];
                    }
                }
                tot += __shfl_xor(tot, 16); tot += __shfl_xor(tot, 32);
                f32x4 rest[4];
#pragma unroll
                for (int st = 0; st < 4; ++st) rest[st] = (f32x4){0.f, 0.f, 0.f, 0.f};
#pragma unroll
                for (int k2 = 0; k2 < 2; ++k2) {
                    u32x4 hi, lo;
#pragma unroll
                    for (int t2 = 0; t2 < 2; ++t2) {
                        const f32x4 a = uu[2 * k2 + t2];
                        const unsigned h0 = pack2(a[0], a[1]), h1 = pack2(a[2], a[3]);
                        hi[2 * t2] = h0; hi[2 * t2 + 1] = h1;
                        lo[2 * t2] = pack2(a[0] - lo_bf(h0), a[1] - hi_bf(h0)); lo[2 * t2 + 1] = pack2(a[2] - lo_bf(h1), a[3] - hi_bf(h1));
                    }
                    const bf16x8 fh = __builtin_bit_cast(bf16x8, hi), fl = __builtin_bit_cast(bf16x8, lo);
#pragma unroll
                    for (int st = 0; st < 4; ++st) {
                        rest[st] = __builtin_amdgcn_mfma_f32_16x16x32_bf16(tri[st][k2], fh, rest[st], 0, 0, 0);
                        rest[st] = __builtin_amdgcn_mfma_f32_16x16x32_bf16(tri[st][k2], fl, rest[st], 0, 0, 0);
                    }
                }
                bf16x8 af[2];
#pragma unroll
                for (int k2 = 0; k2 < 2; ++k2) {
                    u32x4 pk;
#pragma unroll
                    for (int t2 = 0; t2 < 2; ++t2) {
                        const int kk = 2 * k2 + t2;
                        float a4[4];
#pragma unroll
                        for (int e = 0; e < 4; ++e) a4[e] = __builtin_amdgcn_exp2f(lsp[kk][e] + R + rest[kk][e]);
                        pk[2 * t2] = pack2(a4[0], a4[1]); pk[2 * t2 + 1] = pack2(a4[2], a4[3]);
                    }
                    af[k2] = __builtin_bit_cast(bf16x8, pk);
                }
                R += tot;
#pragma unroll
                for (int dt = 0; dt < 4; ++dt)
#pragma unroll
                    for (int k2 = 0; k2 < 2; ++k2) {
                        const int dsw = ((2 * dt + (fr >> 3)) & 7) << 2;
                        const bf16_t* vrow = Vt + (16 * dt + fr) * LS;
                        const u32x2 v0 = *(const u32x2*)(vrow + ((32 * k2 + 4 * fq) ^ dsw)), v1 = *(const u32x2*)(vrow + ((32 * k2 + 16 + 4 * fq) ^ dsw));
                        const bf16x8 f = __builtin_bit_cast(bf16x8, ((u32x4){v0[0], v0[1], v1[0], v1[1]}));
                        ot[dt] = __builtin_amdgcn_mfma_f32_16x16x32_bf16(f, af[k2], ot[dt], 0, 0, 0);
                    }
                done = __all((R < -150.1f) || (query >= L));
            }
            if (kt > 0) {
                bf16_t* Kn = Ks0 + ((itile & 1) ^ 1) * 64 * LS; bf16_t* Vn = Vt0 + ((itile & 1) ^ 1) * 64 * LS;
                *(u32x4*)(Kn + ldkey * LS + lddc) = kreg;
#pragma unroll
                for (int j = 0; j < 4; ++j) { Vn[(lddc + 2 * j) * LS + (ldkey ^ vsw)] = (bf16_t)(vreg[j] & 0xFFFFu); Vn[(lddc + 2 * j + 1) * LS + (ldkey ^ vsw)] = (bf16_t)(vreg[j] >> 16); }
            }
            if (lane == 0) flags[(itile & 1) * 8 + wv] = done ? 1 : 0;
            __syncthreads();
            int alld = 1;
#pragma unroll
            for (int w = 0; w < 8; ++w) alld &= flags[(itile & 1) * 8 + w];
            if (alld || kt == 0) break;
            --kt;
        }
        if (query < L) {
#pragma unroll
            for (int dt = 0; dt < 4; ++dt) *(u32x2*)(p.osb + (tokb + query) * 512 + h * 64 + 16 * dt + 4 * fq) = pk4(ot[dt]);
        }
    }
}

struct EpiBranch {
    static constexpr bool PERM = true;
    const bf16_t* G; bf16_t* M; bool add;
    DI void operator()(const f32x4 (&acc)[2][2][4][2], const g8::Unit& u, int wr, int wc, int fr, int fq) const {
        const int c0 = u.pn * 256 + wc * 32 + 8 * fq;
#pragma unroll
        for (int ai = 0; ai < 2; ++ai) {
            u32x4 g[4][2], mo[4][2];
#pragma unroll
            for (int m = 0; m < 4; ++m)
#pragma unroll
                for (int bj = 0; bj < 2; ++bj) {
                    const size_t r = (size_t)(u.pm * 256 + ai * 128 + wr * 64 + m * 16 + fr);
                    g[m][bj] = *(const u32x4*)(G + r * 2048 + c0 + bj * 128);
                    mo[m][bj] = add ? *(const u32x4*)(M + r * D + c0 + bj * 128) : (u32x4){0u, 0u, 0u, 0u};
                }
#pragma unroll
            for (int m = 0; m < 4; ++m)
#pragma unroll
                for (int bj = 0; bj < 2; ++bj) {
                    const size_t r = (size_t)(u.pm * 256 + ai * 128 + wr * 64 + m * 16 + fr);
                    const f32x4 v0 = acc[ai][bj][m][0], v1 = acc[ai][bj][m][1];
                    const u32x4 gg = g[m][bj], mm = mo[m][bj];
                    float o[8] = {lo_bf(gg[0]) * v0[0], hi_bf(gg[0]) * v0[1], lo_bf(gg[1]) * v0[2], hi_bf(gg[1]) * v0[3], lo_bf(gg[2]) * v1[0], hi_bf(gg[2]) * v1[1], lo_bf(gg[3]) * v1[2], hi_bf(gg[3]) * v1[3]};
#pragma unroll
                    for (int q = 0; q < 4; ++q) { o[2 * q] += lo_bf(mm[q]); o[2 * q + 1] += hi_bf(mm[q]); }
                    *(u32x4*)(M + r * D + c0 + bj * 128) = (u32x4){pack2(o[0], o[1]), pack2(o[2], o[3]), pack2(o[4], o[5]), pack2(o[6], o[7])};
                }
        }
    }
};
struct GateOrder {
    g8::DenseOrder d;
    DI bool next(int i, g8::Unit& u) const { return d.next(i, u); }
    DI unsigned row_off(const g8::Unit&, int) const { return 0u; }
};
struct EpiGate {
    static constexpr bool PERM = true;
    bf16_t* G;
    DI void operator()(const f32x4 (&acc)[2][2][4][2], const g8::Unit& u, int wr, int wc, int fr, int fq) const {
#pragma unroll
        for (int ai = 0; ai < 2; ++ai)
#pragma unroll
            for (int m = 0; m < 4; ++m) {
                bf16_t* rowp = G + (size_t)(u.pm * 256 + ai * 128 + wr * 64 + m * 16 + fr) * 2048 + u.pn * 256 + wc * 32 + 8 * fq;
#pragma unroll
                for (int bj = 0; bj < 2; ++bj) {
                    const f32x4 v0 = acc[ai][bj][m][0], v1 = acc[ai][bj][m][1];
                    *(u32x4*)(rowp + bj * 128) = (u32x4){pack2(sigmoidf_(v0[0]), sigmoidf_(v0[1])), pack2(sigmoidf_(v0[2]), sigmoidf_(v0[3])), pack2(sigmoidf_(v1[0]), sigmoidf_(v1[1])), pack2(sigmoidf_(v1[2]), sigmoidf_(v1[3]))};
                }
            }
    }
};
template <int PART> DI void phase_merge(const Params& p, int layer, int bid, int nb, char* smem) {
    const bf16_t* hb = p.hb; bf16_t* G = p.gates; bf16_t* M = p.merged;
    const bf16_t* Wg = p.WtIn + ((size_t)layer * CIN + CP) * D;
    G8_LAS unsigned char* lds = (G8_LAS unsigned char*)smem;
    if (PART == 0) {
#pragma unroll
    for (int which = 0; which < 2; ++which) {
        g8::DenseOrder S; S.init(hb, Wg + (size_t)which * 1024 * D, MFULL, D / 256, D, nb, bid);
        g8::gemm8<false>(lds, D, S, EpiGate{G + which * 1024});
    }
    }
    if (PART == 1) {
#pragma unroll
    for (int which = 0; which < 2; ++which) {
        const bf16_t* A = which ? p.orw : p.osb;
        const bf16_t* Bt = (which ? p.WtPrw : p.WtPsb) + (size_t)layer * D * 512;
        g8::DenseOrder S; S.init(A, Bt, MFULL, D / 256, 512, nb, bid);
        g8::gemm8<false>(lds, 512, S, EpiBranch{G + which * 1024, M, which != 0});
    }
    }
    if (PART == 1)
    for (int t = left_first(MFULL * 4 * 2, bid, nb); t < D / 128; t += nb) {
#pragma unroll
        for (int which = 0; which < 2; ++which) {
            const bf16_t* A = which ? p.orw : p.osb; const bf16_t* Gw = p.gleft - (size_t)M0_LEFT * 2048 + which * 1024;
            const bf16_t* Bt = (which ? p.WtPrw : p.WtPsb) + (size_t)layer * D * 512;
            gemm_left32([=](int r) { return A + (size_t)(M0_LEFT + r) * 512; }, Bt, 512, 512, t * 128, smem,
                        [=](int r0, int c, f32x4 v) {
                            const size_t r = (size_t)(M0_LEFT + r0);
                            const u32x2 g = *(const u32x2*)(Gw + r * 2048 + c);
                            float o0 = lo_bf(g[0]) * v[0], o1 = hi_bf(g[0]) * v[1], o2 = lo_bf(g[1]) * v[2], o3 = hi_bf(g[1]) * v[3];
                            u32x2* mp = (u32x2*)(M + r * D + c);
                            if (which) { const u32x2 m = *mp; o0 += lo_bf(m[0]); o1 += hi_bf(m[0]); o2 += lo_bf(m[1]); o3 += hi_bf(m[1]); }
                            *mp = (u32x2){pack2(o0, o1), pack2(o2, o3)};
                        });
        }
    }
}
struct EpiOut {
    static constexpr bool PERM = false;
    float* hmeta; float* out; const bf16_t* hb;
    DI void operator()(const f32x4 (&acc)[2][2][4][2], const g8::Unit& u, int wr, int wc, int fr, int fq) const {
        const int c0 = u.pn * 256 + wc * 32 + 4 * fq;
#pragma unroll
        for (int ai = 0; ai < 2; ++ai) {
            u32x2 hv[4][2][2];
#pragma unroll
            for (int m = 0; m < 4; ++m) {
                const bf16_t* hbp = hb + (size_t)(u.pm * 256 + ai * 128 + wr * 64 + m * 16 + fr) * D + c0;
#pragma unroll
                for (int bj = 0; bj < 2; ++bj)
#pragma unroll
                    for (int n = 0; n < 2; ++n) hv[m][bj][n] = *(const u32x2*)(hbp + bj * 128 + n * 16);
            }
#pragma unroll
            for (int m = 0; m < 4; ++m) {
                float* rowp = hrow2(hmeta, out, u.pm * 256 + ai * 128 + wr * 64 + m * 16 + fr) + c0;
#pragma unroll
                for (int bj = 0; bj < 2; ++bj)
#pragma unroll
                    for (int n = 0; n < 2; ++n) {
                        const f32x4 h = up4(hv[m][bj][n]), v = acc[ai][bj][m][n];
                        *(f32x4*)(rowp + bj * 128 + n * 16) = (f32x4){ALPHA * h[0] + v[0], ALPHA * h[1] + v[1], ALPHA * h[2] + v[2], ALPHA * h[3] + v[3]};
                    }
            }
        }
    }
};
DI void phase_outproj(const Params& p, int layer, int bid, int nb, char* smem) {
    const bf16_t* A = p.merged; float* const hmeta = p.hmeta; float* const outp = p.out; const bf16_t* hbres = p.hb;
    const bf16_t* Bt = p.WtOut + (size_t)layer * D * D;
    if (bid == 0 && tid_() < NE) p.counts[tid_()] = 0;
    g8::DenseOrder S; S.init(A, Bt, MFULL, D / 256, D, nb, bid);
    g8::gemm8<false>((G8_LAS unsigned char*)smem, D, S, EpiOut{hmeta, outp, hbres});
    for (int t = left_first(MFULL * 4, bid, nb); t < D / 128; t += nb)
        gemm_left32([=](int r) { return A + (size_t)(M0_LEFT + r) * D; }, Bt, D, D, t * 128, smem,
                    [=](int r0, int c, f32x4 v) {
                        const int r = M0_LEFT + r0;
                        const f32x4 h = up4(*(const u32x2*)(hbres + (size_t)r * D + c));
                        *(f32x4*)(hrow2(hmeta, outp, r) + c) = (f32x4){ALPHA * h[0] + v[0], ALPHA * h[1] + v[1], ALPHA * h[2] + v[2], ALPHA * h[3] + v[3]};
                    });
}

constexpr int LN1_ROWB = 2 * D + 16;
constexpr int LN1_WAVE = 8 * LN1_ROWB;
constexpr int LN1_LDS = 8 * LN1_WAVE + 2048;
DI void phase_ln1_router(const Params& p, int layer, int bid, int nb, char* smem) {
    const int tid = tid_(), lane = tid & 63, wid = __builtin_amdgcn_readfirstlane(tid >> 6), fr = lane & 15, fq = lane >> 4;
    char* wl = smem + wid * LN1_WAVE;
    int* sel = (int*)(smem + 8 * LN1_WAVE);
    float* sgt = (float*)(smem + 8 * LN1_WAVE + 640);
    int* sbase = (int*)(smem + 8 * LN1_WAVE + 1280);
    const int nwaves = nb * 8, gw = bid * 8 + wid;
    const int base_n = T / nwaves, extra = T % nwaves;
    const int tok0 = gw * base_n + (gw < extra ? gw : extra), ntok = base_n + (gw < extra ? 1 : 0);
    const int btok0 = bid * 8 * base_n + (bid * 8 < extra ? bid * 8 : extra);
    const float* g1p = p.ln1_g + layer * D; const float* b1p = p.ln1_b + layer * D;
    __syncthreads();
    for (int g0 = 0; g0 < ntok; g0 += 8) {
        const int ng = ntok - g0 < 8 ? ntok - g0 : 8;
        float vn[16];
        { const float* hf = hrow_u(p, tok0 + g0);
#pragma unroll
          for (int j = 0; j < 4; ++j) { const f32x4 a = *(const f32x4*)(hf + 256 * j + 4 * lane); vn[4 * j] = a[0]; vn[4 * j + 1] = a[1]; vn[4 * j + 2] = a[2]; vn[4 * j + 3] = a[3]; } }
#pragma unroll 1
        for (int i = 0; i < ng; ++i) {
            const int tok = tok0 + g0 + i;
            float v[16];
#pragma unroll
            for (int q = 0; q < 16; ++q) v[q] = vn[q];
            if (i + 1 < ng) { const float* hn = hrow_u(p, tok + 1);
#pragma unroll
                for (int j = 0; j < 4; ++j) { const f32x4 a = *(const f32x4*)(hn + 256 * j + 4 * lane); vn[4 * j] = a[0]; vn[4 * j + 1] = a[1]; vn[4 * j + 2] = a[2]; vn[4 * j + 3] = a[3]; } }
            ln16(v, g1p, b1p, lane);
#pragma unroll
            for (int j = 0; j < 4; ++j) {
                const unsigned h0 = pack2(v[4 * j], v[4 * j + 1]), h1 = pack2(v[4 * j + 2], v[4 * j + 3]);
                *(u32x2*)(p.hb + (size_t)tok * D + 256 * j + 4 * lane) = (u32x2){h0, h1};
                *(u32x2*)(wl + i * LN1_ROWB + (256 * j + 4 * lane) * 2) = (u32x2){h0, h1};
            }
        }
        asm volatile("s_waitcnt lgkmcnt(0)" ::: "memory");
        __builtin_amdgcn_wave_barrier();
        f32x4 acc[2] = {(f32x4){0.f, 0.f, 0.f, 0.f}, (f32x4){0.f, 0.f, 0.f, 0.f}};
        const char* arow = wl + (fr & 7) * LN1_ROWB + fq * 16;
        const bf16_t* whi = p.RwHi + (size_t)fr * D + fq * 8;
#pragma unroll 4
        for (int ks = 0; ks < 32; ++ks) {
            const bf16x8 ah = *(const bf16x8*)(arow + ks * 64);
            const bf16x8 bh = *(const bf16x8*)(whi + ks * 32);
            acc[ks & 1] = __builtin_amdgcn_mfma_f32_16x16x32_bf16(bh, ah, acc[ks & 1], 0, 0, 0);
        }
        float lg[4]; float mx = -3.0e38f;
#pragma unroll
        for (int e = 0; e < 4; ++e) { lg[e] = acc[0][e] + acc[1][e] + p.router_b[4 * fq + e]; mx = fmaxf(mx, lg[e]); }
        mx = fmaxf(mx, __shfl_xor(mx, 16)); mx = fmaxf(mx, __shfl_xor(mx, 32));
        float sum = 0.f;
#pragma unroll
        for (int e = 0; e < 4; ++e) { lg[e] = __expf(lg[e] - mx); sum += lg[e]; }
        sum += __shfl_xor(sum, 16); sum += __shfl_xor(sum, 32);
        const float inv = 1.0f / sum;
        float v1 = -1.f, v2 = -1.f; int i1 = 0, i2 = 0;
#pragma unroll
        for (int e = 0; e < 4; ++e) {
            const float pv = lg[e] * inv;
            if (pv > v1) { v2 = v1; i2 = i1; v1 = pv; i1 = e; } else if (pv > v2) { v2 = pv; i2 = e; }
        }
        const float sc = v1 + v2;
        float bsc = sc; int bg = fq;
#pragma unroll
        for (int m = 16; m <= 32; m <<= 1) {
            const float os = __shfl_xor(bsc, m); const int og = __shfl_xor(bg, m);
            if (os > bsc || (os == bsc && og < bg)) { bsc = os; bg = og; }
        }
        if (bg == fq && fr < ng) {
            const int li = tok0 + g0 + fr - btok0;
            const float gs = 1.0f / (v1 + v2);
            sel[li * 2] = 4 * fq + i1; sel[li * 2 + 1] = 4 * fq + i2; sgt[li * 2] = v1 * gs; sgt[li * 2 + 1] = v2 * gs;
        }
        asm volatile("s_waitcnt lgkmcnt(0)" ::: "memory");
        __builtin_amdgcn_wave_barrier();
    }
    __syncthreads();
    if (wid == 0) {
        const int nbt = 8 * base_n + ((bid * 8 + 8 <= extra) ? 8 : (bid * 8 < extra ? extra - bid * 8 : 0));
        for (int c0 = 0; c0 < nbt; c0 += 64) {
            const int li = c0 + lane; const bool on = li < nbt;
            const int e1 = on ? sel[li * 2] : -1, e2 = on ? sel[li * 2 + 1] : -1;
            const unsigned long long lt = (1ull << lane) - 1ull;
            int r1 = 0, r2 = 0, mycnt = 0;
#pragma unroll
            for (int e = 0; e < NE; ++e) {
                const unsigned long long m1 = __ballot(e1 == e), m2 = __ballot(e2 == e);
                const int c1 = __popcll(m1), c2 = __popcll(m2);
                if (e1 == e) r1 = __popcll(m1 & lt);
                if (e2 == e) r2 = c1 + __popcll(m2 & lt);
                if (lane == e) mycnt = c1 + c2;
            }
            if (lane < NE) sbase[lane] = mycnt > 0 ? atomicAdd(&p.counts[lane], mycnt) : 0;
            asm volatile("s_waitcnt vmcnt(0) lgkmcnt(0)" ::: "memory");
            __builtin_amdgcn_wave_barrier();
            if (on) {
                const int tok = btok0 + li;
                const int s1 = sbase[e1] + r1, s2 = sbase[e2] + r2;
                p.list[e1 * T + s1] = tok * 2; p.list[e2 * T + s2] = tok * 2 + 1;
                p.tokg[tok * 2] = sgt[li * 2]; p.tokg[tok * 2 + 1] = sgt[li * 2 + 1];
            }
            asm volatile("s_waitcnt lgkmcnt(0)" ::: "memory");
            __builtin_amdgcn_wave_barrier();
        }
    }
}

constexpr int MOE_BIG = 8;
template <bool UP> struct MoeOrder {
    const int* counts; const int* list; int G, c; const char* A; const char* B;
    DI bool next(int i, g8::Unit& u) const {
        const int xcd = c & 7, w = c >> 3, mt = (w >> 1) & 7, pn = 2 * (w & 1) + i, esel = xcd + 8 * (w >> 4);
        if (w >= 32 || i >= 2) return false;
        int padp = 0, fe = -1, fc = 0, fp = 0;
#pragma unroll
        for (int e = 0; e < NE; ++e) {
            const int cn = counts[e], ntp = (cn + 255) >> 8, nt = ntp < MOE_BIG ? ntp : MOE_BIG;
            const bool hit = (e == esel) && (mt < nt);
            fe = hit ? e : fe; fc = hit ? cn : fc; fp = hit ? padp + mt : fp;
            padp += ntp;
        }
        fe = __builtin_amdgcn_readfirstlane(fe); fc = __builtin_amdgcn_readfirstlane(fc); fp = __builtin_amdgcn_readfirstlane(fp);
        if (fe < 0) return false;
        u.e = fe; u.slot0 = mt * 256; u.cnt = fc; u.pm = fp; u.pn = pn;
        u.A = UP ? A : A + (size_t)fp * ((size_t)256 * DE * 2);
        u.B = UP ? B + (size_t)fe * ((size_t)1024 * 1024 * 2) + (size_t)pn * ((size_t)256 * D * 2) : B + (size_t)fe * ((size_t)1024 * 512 * 2) + (size_t)pn * ((size_t)256 * DE * 2);
        return true;
    }
    DI unsigned row_off(const g8::Unit& u, int r) const {
        const __amdgpu_buffer_rsrc_t rs = __builtin_amdgcn_make_buffer_rsrc((void*)list, 0, NE * T * 4, 0x00020000);
        const int ent = __builtin_amdgcn_raw_buffer_load_b32(rs, r * 4, (u.e * T + u.slot0) * 4, 0);
        return u.slot0 + r < u.cnt ? (unsigned)(ent >> 1) * (unsigned)(D * 2) : 0u;
    }
};
struct EpiMoeUp {
    static constexpr bool PERM = true;
    bf16_t* hid;
    DI void operator()(const f32x4 (&acc)[2][2][4][2], const g8::Unit& u, int wr, int wc, int fr, int fq) const {
#pragma unroll
        for (int ai = 0; ai < 2; ++ai)
#pragma unroll
            for (int m = 0; m < 4; ++m) {
                const int r = ai * 128 + wr * 64 + m * 16 + fr;
                if (u.slot0 + r >= u.cnt) continue;
                bf16_t* rowp = hid + ((size_t)u.pm * 256 + r) * DE + ((u.pn * 256 + wc * 32 + 8 * fq) >> 1);
#pragma unroll
                for (int bj = 0; bj < 2; ++bj) {
                    const f32x4 v0 = acc[ai][bj][m][0], v1 = acc[ai][bj][m][1];
                    *(u32x2*)(rowp + bj * 64) = (u32x2){pack2(v0[0] * sigmoidf_(v0[0]) * v0[1], v0[2] * sigmoidf_(v0[2]) * v0[3]), pack2(v1[0] * sigmoidf_(v1[0]) * v1[1], v1[2] * sigmoidf_(v1[2]) * v1[3])};
                }
            }
    }
};
struct EpiMoeDown {
    static constexpr bool PERM = true;
    bf16_t* fo; const int* list; const float* tokg;
    DI void operator()(const f32x4 (&acc)[2][2][4][2], const g8::Unit& u, int wr, int wc, int fr, int fq) const {
        int ent[8]; float g[8];
#pragma unroll
        for (int q = 0; q < 8; ++q) {
            const int sl = u.slot0 + (q >> 2) * 128 + wr * 64 + (q & 3) * 16 + fr;
            ent[q] = sl < u.cnt ? list[u.e * T + sl] : -1;
        }
#pragma unroll
        for (int q = 0; q < 8; ++q) g[q] = ent[q] >= 0 ? tokg[ent[q]] : 0.f;
#pragma unroll
        for (int ai = 0; ai < 2; ++ai)
#pragma unroll
            for (int m = 0; m < 4; ++m) {
                const int q = ai * 4 + m;
                if (ent[q] < 0) continue;
                const float gg = g[q];
                bf16_t* rowp = fo + ((size_t)(ent[q] & 1) * TP + (ent[q] >> 1)) * D + u.pn * 256 + wc * 32 + 8 * fq;
#pragma unroll
                for (int bj = 0; bj < 2; ++bj) {
                    const f32x4 v0 = acc[ai][bj][m][0], v1 = acc[ai][bj][m][1];
                    *(u32x4*)(rowp + bj * 128) = (u32x4){pack2(gg * v0[0], gg * v0[1]), pack2(gg * v0[2], gg * v0[3]), pack2(gg * v1[0], gg * v1[1]), pack2(gg * v1[2], gg * v1[3])};
                }
            }
    }
};
DI void phase_moe_up(const Params& p, int bid, int nb, char* smem) {
    const MoeOrder<true> S{p.counts, p.list, nb, bid, (const char*)p.hb, (const char*)p.WtGU};
    g8::gemm8<true>((G8_LAS unsigned char*)smem, D, S, EpiMoeUp{p.hid});
    const bf16_t* hb = p.hb; bf16_t* hid = p.hid; const int* list = p.list;
    int big = 0, padr = 0, job = 0;
#pragma unroll 1
    for (int e = 0; e < NE; ++e) { const int cn = p.counts[e], ntp = (cn + 255) >> 8; big += (ntp < MOE_BIG ? ntp : MOE_BIG) * 4; }
    const int mine = bid; (void)big;
#pragma unroll 1
    for (int e = 0; e < NE; ++e) {
        const int cn = p.counts[e];
        for (int s0 = MOE_BIG * 256; s0 < cn; s0 += 128)
            for (int nt = 0; nt < 8; ++nt, ++job)
                if (job % nb == mine) {
                    const int prow = padr;
                    gemm_tile128([=](int r) { const int sl = s0 + r; return sl < cn ? hb + (size_t)(list[e * T + sl] >> 1) * D : (const bf16_t*)nullptr; },
                                 p.WtGU + (size_t)e * 1024 * 1024, D, D, 0, nt * 128, smem,
                                 [=](int r, int c, f32x4 v) {
                                     const int sl = s0 + r;
                                     if (sl >= cn) return;
                                     *(unsigned*)(hid + (size_t)(prow + sl) * DE + (c >> 1)) = pack2(v[0] * sigmoidf_(v[0]) * v[1], v[2] * sigmoidf_(v[2]) * v[3]);
                                 });
                }
        padr += ((cn + 255) >> 8) * 256;
    }
}
DI void phase_moe_down(const Params& p, int bid, int nb, char* smem) {
    const MoeOrder<false> S{p.counts, p.list, nb, bid, (const char*)p.hid, (const char*)p.WtD};
    g8::gemm8<false>((G8_LAS unsigned char*)smem, DE, S, EpiMoeDown{p.fo, p.list, p.tokg});
    const bf16_t* hid = p.hid; bf16_t* fo = p.fo; const int* list = p.list; const float* tokg = p.tokg;
    int big = 0, padr = 0, job = 0;
#pragma unroll 1
    for (int e = 0; e < NE; ++e) { const int cn = p.counts[e], ntp = (cn + 255) >> 8; big += (ntp < MOE_BIG ? ntp : MOE_BIG) * 4; }
    const int mine = bid; (void)big;
#pragma unroll 1
    for (int e = 0; e < NE; ++e) {
        const int cn = p.counts[e];
        for (int s0 = MOE_BIG * 256; s0 < cn; s0 += 128)
            for (int nt = 0; nt < 8; ++nt, ++job)
                if (job % nb == mine) {
                    const int prow = padr;
                    gemm_tile128([=](int r) { const int sl = s0 + r; return sl < cn ? hid + (size_t)(prow + sl) * DE : (const bf16_t*)nullptr; },
                                 p.WtD + (size_t)e * 1024 * 512, DE, DE, 0, nt * 128, smem,
                                 [=](int r, int c, f32x4 v) {
                                     const int sl = s0 + r;
                                     if (sl >= cn) return;
                                     const int ent = list[e * T + sl];
                                     const float g = tokg[ent];
                                     *(u32x2*)(fo + ((size_t)(ent & 1) * TP + (ent >> 1)) * D + c) = (u32x2){pack2(g * v[0], g * v[1]), pack2(g * v[2], g * v[3])};
                                 });
                }
        padr += ((cn + 255) >> 8) * 256;
    }
}
DI void phase_ln2(const Params& p, int layer, int bid, int nb) {
    const int lane = tid_() & 63, wid = __builtin_amdgcn_readfirstlane(tid_() >> 6);
    const int nwaves = nb * 8, gw = bid * 8 + wid, base_n = T / nwaves, extra = T % nwaves;
    const int tok0 = gw * base_n + (gw < extra ? gw : extra), ntok = base_n + (gw < extra ? 1 : 0);
    u32x2 an[4], f0n[4], f1n[4];
    {
#pragma unroll
        for (int j = 0; j < 4; ++j) {
            an[j] = *(const u32x2*)(p.hb + (size_t)tok0 * D + 256 * j + 4 * lane);
            f0n[j] = *(const u32x2*)(p.fo + (size_t)tok0 * D + 256 * j + 4 * lane); f1n[j] = *(const u32x2*)(p.fo + ((size_t)TP + tok0) * D + 256 * j + 4 * lane);
        }
    }
#pragma unroll 1
    for (int i = 0; i < ntok; ++i) {
        const int tok = tok0 + i;
        float v[16];
#pragma unroll
        for (int j = 0; j < 4; ++j) {
            v[4 * j] = ALPHA * lo_bf(an[j][0]) + lo_bf(f0n[j][0]) + lo_bf(f1n[j][0]); v[4 * j + 1] = ALPHA * hi_bf(an[j][0]) + hi_bf(f0n[j][0]) + hi_bf(f1n[j][0]);
            v[4 * j + 2] = ALPHA * lo_bf(an[j][1]) + lo_bf(f0n[j][1]) + lo_bf(f1n[j][1]); v[4 * j + 3] = ALPHA * hi_bf(an[j][1]) + hi_bf(f0n[j][1]) + hi_bf(f1n[j][1]);
        }
        if (i + 1 < ntok) {
#pragma unroll
            for (int j = 0; j < 4; ++j) {
                an[j] = *(const u32x2*)(p.hb + (size_t)(tok + 1) * D + 256 * j + 4 * lane);
                f0n[j] = *(const u32x2*)(p.fo + (size_t)(tok + 1) * D + 256 * j + 4 * lane); f1n[j] = *(const u32x2*)(p.fo + ((size_t)TP + tok + 1) * D + 256 * j + 4 * lane);
            }
        }
        ln16(v, p.ln2_g + layer * D, p.ln2_b + layer * D, lane);
        if (layer == DEPTH - 1) {
            float* of = hrow_u(p, tok);
#pragma unroll
            for (int j = 0; j < 4; ++j) *(f32x4*)(of + 256 * j + 4 * lane) = (f32x4){v[4 * j], v[4 * j + 1], v[4 * j + 2], v[4 * j + 3]};
        } else store_row_bf(p.hb + (size_t)tok * D, v, lane);
    }
}

extern __shared__ __attribute__((aligned(16))) char dyn_smem[];
constexpr int SMEM_MAIN = R1_LDS > GEMM_LDS ? R1_LDS : GEMM_LDS;
constexpr int SMEM_BYTES = SMEM_MAIN + 16;

__global__ void __launch_bounds__(NTHR, 2) k_forward(Params p) {
    const int bid = blockIdx.x, nb = gridDim.x;
    char* smem = dyn_smem;
    uint4* xbw = (uint4*)(dyn_smem + SMEM_MAIN);
    if (threadIdx.x == 0) *xbw = make_uint4(0u, 0u, 0u, 0u);
    __syncthreads();
    XcdBarrier bar = xcd_barrier_post(p.bar, (volatile LAS unsigned*)xbw);
    phase_prologue_weights(p, bid, nb, smem);
    phase_embed(p, bid, nb);
    xcd_barrier(bar);
    for (int l = 0; l < DEPTH; ++l) {
        phase_inproj(p, l, bid, nb, smem);
        xcd_barrier(bar);
        phase_rwkv_r1<0>(p, l, bid, nb, smem);
        xcd_barrier(bar);
        if (bid < 16) { const int cw = __builtin_amdgcn_readfirstlane(tid_() >> 6); if (cw < 4) phase_rwkv_r2(p, bid * 4 + cw); }
        else {
            const int sbid = bid - 16, snb = nb - 16, heavy = (NBATCH * HEADS * ((L + 127) / 128)) % snb;
            if (sbid >= heavy && sbid < heavy + NBATCH * HEADS) phase_rwkv_r1<1>(p, l, sbid - heavy, 1, smem);
            phase_sb(p, sbid, snb, smem);
        }
        xcd_barrier(bar);
        phase_rwkv_r3(p, l, bid, nb);
        convert_experts(p, l, NE / 2, NE, bid, nb, smem);
        phase_merge<0>(p, l, bid, nb, smem);
        xcd_barrier(bar);
        phase_merge<1>(p, l, bid, nb, smem);
        xcd_barrier(bar);
        phase_outproj(p, l, bid, nb, smem);
        xcd_barrier(bar);
        phase_ln1_router(p, l, bid, nb, smem);
        xcd_barrier(bar);
        phase_moe_up(p, bid, nb, smem);
        xcd_barrier(bar);
        phase_moe_down(p, bid, nb, smem);
        xcd_barrier(bar);
        phase_ln2(p, l, bid, nb);
        xcd_barrier(bar);
    }
}

extern "C" void kernel_launch(void* const* d_in, const int* in_sizes, int n_in, void* d_out, int out_size, void* d_ws, size_t ws_size, hipStream_t stream) {
    (void)in_sizes; (void)n_in; (void)out_size;
    Params p;
    memset(&p, 0, sizeof(p));
    const float* const* in = (const float* const*)d_in;
    p.x = in[0]; p.meta = in[1]; p.emb_g = in[2]; p.emb_b = in[3]; p.w_in = in[4]; p.mu = in[5]; p.w0 = in[6]; p.w_up = in[7]; p.a0 = in[8]; p.a_up = in[9];
    p.g_up = in[10]; p.k_k = in[11]; p.k_a = in[12]; p.r_k = in[13]; p.lnx_g = in[14]; p.lnx_b = in[15]; p.p_sb = in[16]; p.p_rwkv = in[17]; p.w_out = in[18];
    p.ln1_g = in[19]; p.ln1_b = in[20]; p.router_w = in[21]; p.router_b = in[22]; p.ew_gate = in[23]; p.ew_up = in[24]; p.ew_down = in[25]; p.ln2_g = in[26]; p.ln2_b = in[27];
    p.out = (float*)d_out;
    char* ws = (char*)d_ws; size_t o = 0;
    auto take = [&](size_t bytes) { char* r = ws + o; o += (bytes + 255) & ~(size_t)255; return r; };
    p.bar = (unsigned*)take(XCD_BAR_WORDS * sizeof(unsigned));
    p.counts = (int*)take(256);
    p.WtIn = (bf16_t*)take((size_t)DEPTH * CIN * D * 2);
    p.WtPsb = (bf16_t*)take((size_t)DEPTH * D * 512 * 2);
    p.WtPrw = (bf16_t*)take((size_t)DEPTH * D * 512 * 2);
    p.WtOut = (bf16_t*)take((size_t)DEPTH * D * D * 2);
    p.WupT = (bf16_t*)take((size_t)DEPTH * 512 * 64 * 2);
    p.AupT = (bf16_t*)take((size_t)DEPTH * 512 * 64 * 2);
    p.GupT = (bf16_t*)take((size_t)DEPTH * 512 * 128 * 2);
    p.RwHi = (bf16_t*)take((size_t)NE * D * 2);
    p.RwLo = (bf16_t*)take((size_t)NE * D * 2);
    p.gleft = (bf16_t*)take((size_t)32 * 2048 * 2);
    {
        const size_t ub = (size_t)NUNIT * 64 * 64 * 2;
        p.WtGU = (bf16_t*)take((size_t)NE * 1024 * 1024 * 2);
        p.WtD = (bf16_t*)take((size_t)NE * 1024 * 512 * 2);
        p.PcG = (bf16_t*)d_out; p.QcG = (bf16_t*)((char*)d_out + ub); p.RhG = (bf16_t*)((char*)d_out + 2 * ub);
        p.Y0G = (bf16_t*)take(ub); p.GG = (bf16_t*)take(ub); p.SG = (bf16_t*)take(ub);
        p.bonG = (float*)take((size_t)NUNIT * 64 * 4);
    }
    p.hb = (bf16_t*)take((size_t)TP * D * 2);
    p.hmeta = (float*)take((size_t)NBATCH * NMETA * D * 4);
    p.P = (bf16_t*)take((size_t)TP * CP * 2);
    p.osb = (bf16_t*)take((size_t)TP * 512 * 2);
    p.orw = (bf16_t*)take((size_t)TP * 512 * 2);
    p.list = (int*)take((size_t)NE * T * 4);
    p.tokg = (float*)take((size_t)T * 2 * 4);
    p.gates = p.P;
    p.merged = p.P + (size_t)TP * 2048;
    p.hid = p.P;
    p.fo = p.P + (size_t)(2 * T + 16 * 256) * DE;
    if (o > ws_size) return;
    static int grid = 0;
    if (!grid) {
        int dev = 0, cus = 0, per_cu = 0;
        (void)hipGetDevice(&dev);
        (void)hipDeviceGetAttribute(&cus, hipDeviceAttributeMultiprocessorCount, dev);
        (void)hipFuncSetAttribute((const void*)k_forward, hipFuncAttributeMaxDynamicSharedMemorySize, SMEM_BYTES);
        (void)hipOccupancyMaxActiveBlocksPerMultiprocessor(&per_cu, k_forward, NTHR, SMEM_BYTES);
        grid = per_cu >= 1 ? cus : 0;
    }
    if (!grid) return;
    (void)hipMemsetAsync(p.bar, 0, XCD_BAR_WORDS * sizeof(unsigned), stream);
    hipLaunchKernelGGL(k_forward, dim3(grid), dim3(NTHR), SMEM_BYTES, stream, p);
}
```

```cpp
#include <hip/hip_runtime.h>
#include <stdint.h>
#include <string.h>

#define DI __device__ __forceinline__
typedef unsigned short bf16_t;
typedef short bf16x8 __attribute__((ext_vector_type(8)));
typedef float f32x4 __attribute__((ext_vector_type(4)));
typedef unsigned u32x4 __attribute__((ext_vector_type(4)));
typedef unsigned u32x2 __attribute__((ext_vector_type(2)));

constexpr int D = 1024, NBATCH = 2, SEQ = 8192, NMETA = 16, L = SEQ + NMETA, T = NBATCH * L, TP = 16640;
constexpr int DEPTH = 2, HEADS = 8, HD = 64;
constexpr int CIN = 5376, CP = 3328;
constexpr int OFF_Q = 0, OFF_K = 512, OFF_V = 1024, OFF_RW = 1536;
constexpr int RW_R = 0, RW_K = 512, RW_V = 1024, RW_WD = 1536, RW_AD = 1600, RW_GD = 1664, RSW = 1792;
constexpr int NE = 16, DE = 512;
constexpr float ALPHA = 1.41421356237309515f;
constexpr float DECAY_SCALE = 0.60653065971263342f;
constexpr int NTHR = 512;

#define XB_TMO      128
#define XB_XCNT(j)  (256  + 64 * (j))
#define XB_XSUB(j)  (1280 + 64 * (j))
#define XB_XGEN(j)  (2304 + 64 * (j))
#define XB_TOP      3328
#define XB_TOPGEN   3392
#define XCD_BAR_WORDS 3456
#define XB_SPIN_CAP (1u << 18)
#define LAS __attribute__((address_space(3)))

__device__ __forceinline__ unsigned xb_ld(unsigned* p)              { return __hip_atomic_load(p, __ATOMIC_RELAXED, __HIP_MEMORY_SCOPE_AGENT); }
__device__ __forceinline__ unsigned xb_add(unsigned* p, unsigned v) { return __hip_atomic_fetch_add(p, v, __ATOMIC_RELAXED, __HIP_MEMORY_SCOPE_AGENT); }
__device__ __forceinline__ unsigned xb_xcc_id() { return (unsigned)__builtin_amdgcn_s_getreg((3 << 11) | 20) & 0xFu; }
#define XB_SPIN(cond, bar) do { unsigned _sp = 0; while (cond) { __builtin_amdgcn_s_sleep(1); \
    if ((++_sp & 255u) == 0u) { if (xb_ld(&(bar)[XB_TMO])) break; if (_sp > XB_SPIN_CAP) { atomicAdd(&(bar)[XB_TMO], 1u); break; } } } } while (0)

struct XcdBarrier {
    unsigned* bar; unsigned x;
    volatile LAS unsigned* st;
};

__device__ __forceinline__ XcdBarrier xcd_barrier_post(unsigned* bar, volatile LAS unsigned* st) {
    XcdBarrier b; b.bar = bar; b.x = xb_xcc_id(); b.st = st;
    if (threadIdx.x == 0) (void)xb_add(&bar[XB_XCNT(b.x)], 1u);
    return b;
}
__device__ __forceinline__ void xcd_barrier_complete(unsigned* bar, unsigned x, unsigned& nloc, unsigned& nx) {
    const unsigned G = gridDim.x * gridDim.y * gridDim.z;
    unsigned sum, cnt, mine, sp = 0u;
    for (;;) {
        sum = 0u; cnt = 0u; mine = 0u;
#pragma unroll
        for (unsigned j = 0; j < 16; ++j) { const unsigned c = xb_ld(&bar[XB_XCNT(j)]); sum += c; cnt += (c > 0u) ? 1u : 0u; mine = (j == x) ? c : mine; }
        if (sum == G) break;
        __builtin_amdgcn_s_sleep(1);
        if ((++sp & 255u) == 0u) { if (xb_ld(&bar[XB_TMO])) break; if (sp > XB_SPIN_CAP) { atomicAdd(&bar[XB_TMO], 1u); break; } }
    }
    nloc = mine > 0u ? mine : 1u; nx = cnt > 0u ? cnt : 1u;
}

__device__ __forceinline__ void xcd_barrier(const XcdBarrier& b) {
    asm volatile("s_waitcnt vmcnt(0)" ::: "memory");
    __syncthreads();
    if (threadIdx.x == 0) {
        unsigned* bar = b.bar;
        unsigned bx = b.x; asm volatile("" : "+s"(bx));
        __builtin_amdgcn_s_waitcnt(0);
        unsigned nloc = b.st[0], nx = b.st[1];
        if (nloc == 0u) { xcd_barrier_complete(bar, bx, nloc, nx); b.st[0] = nloc; b.st[1] = nx; }
        const unsigned old = xb_add(&bar[XB_XSUB(bx)], 1u);
        const unsigned gen = old / nloc;
        if (old + 1u == (gen + 1u) * nloc) {
            __builtin_amdgcn_fence(__ATOMIC_RELEASE, "agent");
            asm volatile("s_waitcnt vmcnt(0)" ::: "memory");
            const unsigned og = xb_add(&bar[XB_TOP], 1u);
            const unsigned tg = og / nx;
            if (og + 1u == (tg + 1u) * nx) xb_add(&bar[XB_TOPGEN], 1u);
            else XB_SPIN(xb_ld(&bar[XB_TOPGEN]) == tg, bar);
            __builtin_amdgcn_fence(__ATOMIC_ACQUIRE, "agent");
            xb_add(&bar[XB_XGEN(bx)], 1u);
            asm volatile("s_waitcnt vmcnt(0)" ::: "memory");
        } else {
            XB_SPIN(xb_ld(&bar[XB_XGEN(bx)]) == gen, bar);
            __builtin_amdgcn_fence(__ATOMIC_ACQUIRE, "agent");
            asm volatile("s_waitcnt vmcnt(0)" ::: "memory");
        }
    }
    __syncthreads();
}


struct Params {
    const float *x, *meta, *emb_g, *emb_b, *w_in, *mu, *w0, *w_up, *a0, *a_up, *g_up, *k_k, *k_a, *r_k, *lnx_g, *lnx_b, *p_sb, *p_rwkv, *w_out,
        *ln1_g, *ln1_b, *router_w, *router_b, *ew_gate, *ew_up, *ew_down, *ln2_g, *ln2_b;
    float* out;
    unsigned* bar;
    int* counts;
    bf16_t *WtIn, *WtPsb, *WtPrw, *WtOut, *WtGU, *WtD, *hb, *P, *osb, *orw, *WupT, *AupT, *GupT;
    bf16_t *PcG, *QcG, *RhG, *Y0G, *GG, *SG;
    bf16_t *RwHi, *gleft;
    float* bonG;
    float* hmeta;
    bf16_t *gates, *merged, *hid, *fo;
    int* list;
    float* tokg;
};

DI float bf2f(bf16_t v) { return __uint_as_float((unsigned)v << 16); }
typedef __bf16 bf16x2_t __attribute__((ext_vector_type(2)));
DI bf16_t f2bf(float f) { return __builtin_bit_cast(bf16_t, (__bf16)f); }
DI unsigned pack2(float lo, float hi) { bf16x2_t v = {(__bf16)lo, (__bf16)hi}; return __builtin_bit_cast(unsigned, v); }
DI float lo_bf(unsigned u) { return __uint_as_float(u << 16); }
DI float hi_bf(unsigned u) { return __uint_as_float(u & 0xFFFF0000u); }
template <int CTRL> DI float dpp_mov(float v) { return __builtin_bit_cast(float, __builtin_amdgcn_update_dpp(0, __builtin_bit_cast(int, v), CTRL, 0xF, 0xF, true)); }
DI float sum8(float v) {
    v += dpp_mov<0xB1>(v);
    v += dpp_mov<0x4E>(v);
    v += dpp_mov<0x141>(v);
    return v;
}
DI float sum16(float v) { v = sum8(v); v += dpp_mov<0x140>(v); return v; }
DI float wave_sum(float v) { v = sum16(v); v += __shfl_xor(v, 16); v += __shfl_xor(v, 32); return v; }
struct Params;
DI const Params& kparams() {
    auto k = __builtin_amdgcn_kernarg_segment_ptr();
    asm volatile("" : "+s"(k));
    return *(const Params*)k;
}
DI int tid_() { int t = threadIdx.x; asm volatile("" : "+v"(t)); return t; }
DI float sigmoidf_(float x) { return __builtin_amdgcn_rcpf(1.0f + __expf(-x)); }
DI float tanhf_(float x) { return 1.0f - 2.0f * __builtin_amdgcn_rcpf(1.0f + __expf(2.0f * x)); }

DI float* hrow2(float* hmeta, float* out, int tok) {
    const int b = tok >= L ? 1 : 0, t = tok - b * L;
    const unsigned long long am = (unsigned long long)(hmeta + (long long)(b * NMETA + t) * D), ao = (unsigned long long)(out + ((long long)b * SEQ + (t - NMETA)) * D);
    const unsigned long long m = 0ull - (unsigned long long)(t < NMETA);
    return (float*)((am & m) | (ao & ~m));
}
DI float* hrow(const Params& p, int tok) { return hrow2(p.hmeta, p.out, tok); }
DI float* hrow_u(const Params& p, int tok) { return hrow2(p.hmeta, p.out, __builtin_amdgcn_readfirstlane(tok)); }

DI void transpose_convert(const float* __restrict__ src, int ld, int K, int N, bf16_t* __restrict__ dst, int mult, int off, int bid, int nb, char* smem, int& rot) {
    float* tile = (float*)smem;
    const int tk = K / 64, tn = N / 256, tid = tid_();
    const int first = (bid - rot % nb + nb) % nb;
    rot += tk * tn;
    for (int t = first; t < tk * tn; t += nb) {
        const int k0 = (t / tn) * 64, n0 = (t % tn) * 256;
        f32x4 v[4][2];
#pragma unroll
        for (int q = 0; q < 4; ++q)
#pragma unroll
            for (int i = 0; i < 2; ++i) v[q][i] = *(const f32x4*)(src + (size_t)(k0 + (tid >> 4) + 32 * i) * ld + n0 + q * 64 + (tid & 15) * 4);
        __syncthreads();
#pragma unroll
        for (int q = 0; q < 4; ++q)
#pragma unroll
            for (int i = 0; i < 2; ++i) {
                float* tp = tile + q * 64 * 65 + ((tid >> 4) + 32 * i) * 65 + (tid & 15) * 4;
                tp[0] = v[q][i][0]; tp[1] = v[q][i][1]; tp[2] = v[q][i][2]; tp[3] = v[q][i][3];
            }
        __syncthreads();
        const int n = tid >> 3, kc = (tid & 7) * 8;
#pragma unroll
        for (int q = 0; q < 4; ++q) {
            const float* tq = tile + q * 64 * 65;
            u32x4 o;
#pragma unroll
            for (int jj = 0; jj < 4; ++jj) o[jj] = pack2(tq[(kc + 2 * jj) * 65 + n], tq[(kc + 2 * jj + 1) * 65 + n]);
            *(u32x4*)(dst + (size_t)((n0 + q * 64 + n) * mult + off) * K + k0 + kc) = o;
        }
    }
}

DI void convert_experts(const Params& p, int layer, int e0, int e1, int bid, int nb, char* smem) {
    int rot = 0;
    for (int e = e0; e < e1; ++e) {
        const size_t eo = ((size_t)layer * NE + e) * (size_t)D * DE;
        transpose_convert(p.ew_gate + eo, DE, D, DE, p.WtGU + (size_t)e * 1024 * 1024, 2, 0, bid, nb, smem, rot);
        transpose_convert(p.ew_up + eo, DE, D, DE, p.WtGU + (size_t)e * 1024 * 1024, 2, 1, bid, nb, smem, rot);
        transpose_convert(p.ew_down + eo, D, DE, D, p.WtD + (size_t)e * 1024 * 512, 1, 0, bid, nb, smem, rot);
    }
}

DI void convert_layer_weights(const Params& p, int l, int bid, int nb, char* smem) {
    int rot = 0;
    transpose_convert(p.w_in + (size_t)l * D * CIN, CIN, D, CIN, p.WtIn + (size_t)l * CIN * D, 1, 0, bid, nb, smem, rot);
    transpose_convert(p.p_sb + (size_t)l * 512 * D, D, 512, D, p.WtPsb + (size_t)l * D * 512, 1, 0, bid, nb, smem, rot);
    transpose_convert(p.p_rwkv + (size_t)l * 512 * D, D, 512, D, p.WtPrw + (size_t)l * D * 512, 1, 0, bid, nb, smem, rot);
    transpose_convert(p.w_out + (size_t)l * D * D, D, D, D, p.WtOut + (size_t)l * D * D, 1, 0, bid, nb, smem, rot);
    transpose_convert(p.w_up + (size_t)l * 64 * 512, 512, 64, 512, p.WupT + (size_t)l * 512 * 64, 1, 0, bid, nb, smem, rot);
    transpose_convert(p.a_up + (size_t)l * 64 * 512, 512, 64, 512, p.AupT + (size_t)l * 512 * 64, 1, 0, bid, nb, smem, rot);
    transpose_convert(p.g_up + (size_t)l * 128 * 512, 512, 128, 512, p.GupT + (size_t)l * 512 * 128, 1, 0, bid, nb, smem, rot);
}
DI void phase_prologue_weights(const Params& p, int bid, int nb, char* smem) {
    for (int i = bid * NTHR + tid_(); i < NE * D; i += nb * NTHR) {
        const int e = i / D, k = i % D;
        p.RwHi[i] = f2bf(p.router_w[(size_t)k * NE + e]);
    }
    for (int l = 0; l < DEPTH; ++l) convert_layer_weights(p, l, bid, nb, smem);
}

DI void ln16(float (&v)[16], const float* __restrict__ g, const float* __restrict__ b, int lane) {
    float s = 0.f;
#pragma unroll
    for (int i = 0; i < 16; ++i) s += v[i];
    const float mean = wave_sum(s) * (1.0f / D);
    float q = 0.f;
#pragma unroll
    for (int i = 0; i < 16; ++i) { v[i] -= mean; q += v[i] * v[i]; }
    const float rstd = rsqrtf(wave_sum(q) * (1.0f / D) + 1e-5f);
#pragma unroll
    for (int j = 0; j < 4; ++j) {
        const f32x4 gv = *(const f32x4*)(g + 256 * j + 4 * lane), bv = *(const f32x4*)(b + 256 * j + 4 * lane);
#pragma unroll
        for (int i = 0; i < 4; ++i) v[4 * j + i] = v[4 * j + i] * rstd * gv[i] + bv[i];
    }
}
DI void store_row_bf(bf16_t* __restrict__ hb, const float (&v)[16], int lane) {
#pragma unroll
    for (int j = 0; j < 4; ++j) *(u32x2*)(hb + 256 * j + 4 * lane) = (u32x2){pack2(v[4 * j], v[4 * j + 1]), pack2(v[4 * j + 2], v[4 * j + 3])};
}
DI void phase_embed(const Params& p, int bid, int nb) {
    const int lane = tid_() & 63, wid = __builtin_amdgcn_readfirstlane(tid_() >> 6);
    const int nwaves = nb * 8, gw = bid * 8 + wid, base_n = T / nwaves, extra = T % nwaves;
    const int tok0 = gw * base_n + (gw < extra ? gw : extra), ntok = base_n + (gw < extra ? 1 : 0);
    auto srcrow = [&](int tok) -> const float* {
        const int tk = __builtin_amdgcn_readfirstlane(tok), b = tk >= L ? 1 : 0, t = tk - b * L;
        const unsigned long long am = (unsigned long long)(p.meta + (long long)t * D), ao = (unsigned long long)(p.x + ((long long)b * SEQ + (t - NMETA)) * D);
        const unsigned long long m = 0ull - (unsigned long long)(t < NMETA);
        return (const float*)((am & m) | (ao & ~m));
    };
    f32x4 an[4];
    { const float* src = srcrow(tok0);
#pragma unroll
      for (int j = 0; j < 4; ++j) an[j] = *(const f32x4*)(src + 256 * j + 4 * lane); }
#pragma unroll 1
    for (int i = 0; i < ntok; ++i) {
        const int tok = tok0 + i;
        float v[16];
#pragma unroll
        for (int j = 0; j < 4; ++j) { v[4 * j] = an[j][0]; v[4 * j + 1] = an[j][1]; v[4 * j + 2] = an[j][2]; v[4 * j + 3] = an[j][3]; }
        if (i + 1 < ntok) { const float* src = srcrow(tok + 1);
#pragma unroll
            for (int j = 0; j < 4; ++j) an[j] = *(const f32x4*)(src + 256 * j + 4 * lane); }
        ln16(v, p.emb_g, p.emb_b, lane);
        store_row_bf(p.hb + (size_t)tok * D, v, lane);
    }
}

constexpr int LDT = 72;
constexpr int GEMM_LDS = 2 * 128 * LDT * 2;
template <class ARow, class Epi>
DI void gemm_tile128(ARow arow, const bf16_t* __restrict__ Bt, int ldb, int K, int m0, int n0, char* smem, Epi epi) {
    const int tid = tid_(), lane = tid & 63, wid = __builtin_amdgcn_readfirstlane(tid >> 6), fr = lane & 15, fq = lane >> 4;
    const int wr = wid >> 1, wc = wid & 1;
    bf16_t* As = (bf16_t*)smem;
    bf16_t* Bs = As + 128 * LDT;
    const bf16_t* ap[2]; const bf16_t* bp[2]; int so[2];
#pragma unroll
    for (int i = 0; i < 2; ++i) {
        const int c = tid + NTHR * i, row = c >> 3, kc = c & 7;
        const bf16_t* ar = arow(m0 + row);
        ap[i] = ar ? ar + kc * 8 : nullptr;
        bp[i] = Bt + (size_t)(n0 + row) * ldb + kc * 8;
        so[i] = row * LDT + kc * 8;
    }
    f32x4 acc[2][4];
#pragma unroll
    for (int mi = 0; mi < 2; ++mi)
#pragma unroll
        for (int ni = 0; ni < 4; ++ni) acc[mi][ni] = (f32x4){0.f, 0.f, 0.f, 0.f};
    u32x4 ra[2], rb[2];
#pragma unroll
    for (int i = 0; i < 2; ++i) { ra[i] = ap[i] ? *(const u32x4*)(ap[i]) : (u32x4){0u, 0u, 0u, 0u}; rb[i] = *(const u32x4*)(bp[i]); }
    for (int k0 = 0; k0 < K; k0 += 64) {
        __syncthreads();
#pragma unroll
        for (int i = 0; i < 2; ++i) { *(u32x4*)(As + so[i]) = ra[i]; *(u32x4*)(Bs + so[i]) = rb[i]; }
        __syncthreads();
        if (k0 + 64 < K) {
#pragma unroll
            for (int i = 0; i < 2; ++i) { ra[i] = ap[i] ? *(const u32x4*)(ap[i] + k0 + 64) : (u32x4){0u, 0u, 0u, 0u}; rb[i] = *(const u32x4*)(bp[i] + k0 + 64); }
        }
#pragma unroll
        for (int ks = 0; ks < 2; ++ks) {
            bf16x8 af[2], bf[4];
#pragma unroll
            for (int mi = 0; mi < 2; ++mi) af[mi] = *(const bf16x8*)(As + (wr * 32 + mi * 16 + fr) * LDT + ks * 32 + fq * 8);
#pragma unroll
            for (int ni = 0; ni < 4; ++ni) bf[ni] = *(const bf16x8*)(Bs + (wc * 64 + ni * 16 + fr) * LDT + ks * 32 + fq * 8);
#pragma unroll
            for (int mi = 0; mi < 2; ++mi)
#pragma unroll
                for (int ni = 0; ni < 4; ++ni) acc[mi][ni] = __builtin_amdgcn_mfma_f32_16x16x32_bf16(bf[ni], af[mi], acc[mi][ni], 0, 0, 0);
        }
    }
#pragma unroll
    for (int mi = 0; mi < 2; ++mi)
#pragma unroll
        for (int ni = 0; ni < 4; ++ni) epi(m0 + wr * 32 + mi * 16 + fr, n0 + wc * 64 + ni * 16 + fq * 4, acc[mi][ni]);
}

namespace g8 {
#define G8_LAS __attribute__((address_space(3)))
constexpr int BM = 256, BK = 64, HALF = 128, HTB = HALF * BK * 2, STAGE_BYTES = 8 * HTB, NXCD = 8, WGM = 8;
DI int lds_byte(int r, int c) { const int st = (r >> 4) * 2 + (c >> 5), rr = r & 15, cc = c & 31, ob = rr * 64 + cc * 2; return st * 1024 + (ob ^ (((ob >> 9) & 1) << 5)); }
DI void stage_rc(int b, int& R, int& C) { const int st = b / 1024, sb = b % 1024, swz = sb ^ (((sb >> 9) & 1) << 5); R = (st >> 1) * 16 + swz / 64; C = (st & 1) * 32 + (swz % 64) / 2; }
DI int perm32(int rho) { const int n = rho >> 4, i = rho & 15; return 8 * (i >> 2) + 4 * n + (i & 3); }
struct Unit { int pm, pn; const char* A; const char* B; int e, slot0, cnt; };

struct DenseOrder {
    int nM, nN, nwg, G, c; const char* A; const char* B; size_t tstep;
    DI void init(const bf16_t* A_, const bf16_t* Bt_, int nM_, int nN_, int K, int G_, int c_) { nM = nM_; nN = nN_; nwg = nM * nN; G = G_; c = c_; A = (const char*)A_; B = (const char*)Bt_; tstep = (size_t)BM * K * 2; }
    DI bool next(int i, Unit& u) const {
        const long Lq = (long)i * G + c; if (Lq >= nwg) return false;
        int wgid = (int)Lq; { const int q = nwg / NXCD, r = nwg % NXCD, xcd = wgid % NXCD, off = wgid / NXCD; wgid = (xcd < r ? xcd * (q + 1) : r * (q + 1) + (xcd - r) * q) + off; }
        const int nig = WGM * nN, gid = wgid / nig, fm = gid * WGM, gsz = (nM - fm) < WGM ? (nM - fm) : WGM;
        u.pm = fm + ((wgid % nig) % gsz); u.pn = (wgid % nig) / gsz; u.A = A + (size_t)u.pm * tstep; u.B = B + (size_t)u.pn * tstep; u.e = 0; u.slot0 = 0; u.cnt = 0; return true;
    }
    DI unsigned row_off(const Unit&, int) const { return 0u; }
};

template <bool GATHER, class Epi, class Sched>
DI void gemm8(G8_LAS unsigned char* lds, const int K, const Sched& S, const Epi& E) {
    const int tid = tid_(), wid = __builtin_amdgcn_readfirstlane(tid >> 6), lane = tid & 63, wr = wid >> 2, wc = wid & 3, fr = lane & 15, fq = lane >> 4;
    const int nt = K / BK;
    int Rr[2], Cc[2]; unsigned voffB[2], voffA[2];
#pragma unroll
    for (int i = 0; i < 2; ++i) { stage_rc(tid * 16 + i * 8192, Rr[i], Cc[i]); const int Rb = Epi::PERM ? ((Rr[i] & ~31) + perm32(Rr[i] & 31)) : Rr[i]; voffB[i] = (unsigned)(Rb * K + Cc[i]) * 2u; voffA[i] = (unsigned)(Rr[i] * K + Cc[i]) * 2u; }
    const size_t kstep = (size_t)(BK * 2), hstep = (size_t)HALF * K * 2;
    const unsigned ldsw = (unsigned)wid * 1024u;
    const int aoff = lds_byte(wr * 64 + fr, fq * 8), boff = lds_byte(wc * 32 + fr, fq * 8);
#define G8_SA(b, h) (((b) * 2 + (h)) * HTB)
#define G8_SB(b, h) ((4 + (b) * 2 + (h)) * HTB)
#define G8_STAGE(bufoff, gbase, voff) do { _Pragma("unroll") for (int _i = 0; _i < 2; ++_i) \
        __builtin_amdgcn_global_load_lds((const unsigned*)((const char*)(gbase) + (voff)[_i]), (G8_LAS unsigned*)(lds + (bufoff) + ldsw + _i * 8192), 16, 0, 0); } while (0)
#define G8_LDA(dst, b, h) do { _Pragma("unroll") for (int m = 0; m < 4; ++m) _Pragma("unroll") for (int k = 0; k < 2; ++k) dst[m][k] = *(const G8_LAS bf16x8*)(lds + G8_SA(b, h) + aoff + m * 2048 + k * 1024); } while (0)
#define G8_LDB(dst, b, h) do { _Pragma("unroll") for (int n = 0; n < 2; ++n) _Pragma("unroll") for (int k = 0; k < 2; ++k) dst[n][k] = *(const G8_LAS bf16x8*)(lds + G8_SB(b, h) + boff + n * 2048 + k * 1024); } while (0)
#define G8_MMA(ai, bj, At, Bt) do { __builtin_amdgcn_s_setprio(1); _Pragma("unroll") for (int m = 0; m < 4; ++m) _Pragma("unroll") for (int n = 0; n < 2; ++n) _Pragma("unroll") for (int k = 0; k < 2; ++k) \
        acc[ai][bj][m][n] = __builtin_amdgcn_mfma_f32_16x16x32_bf16(Bt[n][k], At[m][k], acc[ai][bj][m][n], 0, 0, 0); __builtin_amdgcn_s_setprio(0); } while (0)
#define G8_WAIT_V(n) asm volatile("s_waitcnt vmcnt(" #n ")" ::: "memory")
#define G8_WAIT_L(n) asm volatile("s_waitcnt lgkmcnt(" #n ")" ::: "memory")
#define G8_BAR __builtin_amdgcn_s_barrier()
#define G8_SCHED __builtin_amdgcn_sched_barrier(0)
#define G8_AOFF(dst, un) do { if (GATHER) { _Pragma("unroll") for (int _h = 0; _h < 2; ++_h) _Pragma("unroll") for (int _i = 0; _i < 2; ++_i) \
        dst[_h][_i] = S.row_off(un, _h * HALF + Rr[_i]) + (unsigned)Cc[_i] * 2u; } } while (0)
#define G8_STAGE_A(bufoff, gb, vo, h) do { if (GATHER) { G8_STAGE(bufoff, gb, vo[h]); } else { G8_STAGE(bufoff, (gb) + (h) * hstep, voffA); } } while (0)
    Unit cur, nxt; int ui = 0;
    if (!S.next(0, cur)) return;
    f32x4 acc[2][2][4][2];
#pragma unroll
    for (int a = 0; a < 2; ++a)
#pragma unroll
        for (int b = 0; b < 2; ++b)
#pragma unroll
            for (int m = 0; m < 4; ++m)
#pragma unroll
                for (int n = 0; n < 2; ++n) acc[a][b][m][n] = (f32x4){0.f, 0.f, 0.f, 0.f};
    bf16x8 At[4][2], B0[2][2], B1[2][2];
    unsigned cvA[2][2], nvA[2][2];
    G8_AOFF(cvA, cur);
    const char* cA = cur.A; const char* cB = cur.B;
    G8_STAGE(G8_SB(0, 0), cB, voffB); G8_STAGE_A(G8_SA(0, 0), cA, cvA, 0); G8_STAGE(G8_SB(0, 1), cB + hstep, voffB); G8_STAGE_A(G8_SA(0, 1), cA, cvA, 1);
    if (wr == 1) G8_BAR;
    G8_WAIT_V(4); G8_BAR;
    G8_STAGE(G8_SB(1, 0), cB + kstep, voffB); G8_STAGE_A(G8_SA(1, 0), cA + kstep, cvA, 0); G8_STAGE(G8_SB(1, 1), cB + hstep + kstep, voffB);
    G8_WAIT_V(6); G8_BAR;
    for (;;) {
        const bool has_next = S.next(ui + 1, nxt);
        const char* nA = has_next ? nxt.A : cA; const char* nB = has_next ? nxt.B : cB;
        if (GATHER) {
            if (has_next) { G8_AOFF(nvA, nxt); } else {
#pragma unroll
                for (int h = 0; h < 2; ++h)
#pragma unroll
                    for (int i = 0; i < 2; ++i) nvA[h][i] = cvA[h][i];
            }
        }
        for (int t = 0; t < nt; t += 2) {
            const bool last = (t == nt - 2);
            const char* a1 = cA + (size_t)(t + 1) * kstep;
            const char* a2 = last ? nA : cA + (size_t)(t + 2) * kstep; const char* b2 = last ? nB : cB + (size_t)(t + 2) * kstep;
            const char* a3 = a2 + kstep; const char* b3 = b2 + kstep;

            G8_LDB(B0, 0, 0); G8_SCHED; G8_LDA(At, 0, 0); G8_STAGE_A(G8_SA(1, 1), a1, cvA, 1);
            if (GATHER && last) {
#pragma unroll
                for (int h = 0; h < 2; ++h)
#pragma unroll
                    for (int i = 0; i < 2; ++i) cvA[h][i] = nvA[h][i];
            }
            G8_WAIT_L(8); G8_BAR; G8_WAIT_L(0); G8_MMA(0, 0, At, B0); G8_BAR; G8_SCHED;
            G8_LDB(B1, 0, 1); G8_STAGE(G8_SB(0, 0), b2, voffB);
            G8_BAR; G8_WAIT_L(0); G8_MMA(0, 1, At, B1); G8_BAR;
            G8_LDA(At, 0, 1); G8_STAGE_A(G8_SA(0, 0), a2, cvA, 0);
            G8_BAR; G8_WAIT_L(0); G8_MMA(1, 0, At, B0); G8_BAR; G8_SCHED;
            G8_STAGE(G8_SB(0, 1), b2 + hstep, voffB);
            G8_WAIT_V(6); G8_BAR; G8_MMA(1, 1, At, B1); G8_BAR;
            G8_LDB(B0, 1, 0); G8_SCHED; G8_LDA(At, 1, 0); G8_STAGE_A(G8_SA(0, 1), a2, cvA, 1);
            G8_WAIT_L(8); G8_BAR; G8_WAIT_L(0); G8_MMA(0, 0, At, B0); G8_BAR; G8_SCHED;
            G8_LDB(B1, 1, 1); G8_STAGE(G8_SB(1, 0), b3, voffB);
            G8_BAR; G8_WAIT_L(0); G8_MMA(0, 1, At, B1); G8_BAR;
            G8_LDA(At, 1, 1); G8_STAGE_A(G8_SA(1, 0), a3, cvA, 0);
            G8_BAR; G8_WAIT_L(0); G8_MMA(1, 0, At, B0); G8_BAR; G8_SCHED;
            G8_STAGE(G8_SB(1, 1), b3 + hstep, voffB);
            G8_WAIT_V(6); G8_BAR; G8_MMA(1, 1, At, B1); G8_BAR;
        }
        { int fr2 = fr, fq2 = fq; asm volatile("" : "+v"(fr2), "+v"(fq2)); E(acc, cur, wr, wc, fr2, fq2); }
        if (!has_next) break;
#pragma unroll
        for (int a = 0; a < 2; ++a)
#pragma unroll
            for (int b = 0; b < 2; ++b)
#pragma unroll
                for (int m = 0; m < 4; ++m)
#pragma unroll
                    for (int n = 0; n < 2; ++n) acc[a][b][m][n] = (f32x4){0.f, 0.f, 0.f, 0.f};
        cur = nxt; cA = nA; cB = nB; ++ui;
    }
    G8_WAIT_V(0);
    if (wr == 0) G8_BAR;
    G8_BAR;
#undef G8_SA
#undef G8_SB
#undef G8_STAGE
#undef G8_LDA
#undef G8_LDB
#undef G8_MMA
#undef G8_WAIT_V
#undef G8_WAIT_L
#undef G8_BAR
#undef G8_SCHED
#undef G8_AOFF
#undef G8_STAGE_A
}
}

constexpr int MFULL = 64, M0_LEFT = MFULL * 256;
struct EpiStore {
    static constexpr bool PERM = true;
    bf16_t* O; int ldc; bool sig;
    DI void operator()(const f32x4 (&acc)[2][2][4][2], const g8::Unit& u, int wr, int wc, int fr, int fq) const {
#pragma unroll
        for (int ai = 0; ai < 2; ++ai)
#pragma unroll
            for (int m = 0; m < 4; ++m) {
                bf16_t* rowp = O + (size_t)(u.pm * 256 + ai * 128 + wr * 64 + m * 16 + fr) * ldc + u.pn * 256 + wc * 32 + 8 * fq;
#pragma unroll
                for (int bj = 0; bj < 2; ++bj) {
                    f32x4 v0 = acc[ai][bj][m][0], v1 = acc[ai][bj][m][1];
                    if (sig) {
#pragma unroll
                        for (int e = 0; e < 4; ++e) { v0[e] = sigmoidf_(v0[e]); v1[e] = sigmoidf_(v1[e]); }
                    }
                    *(u32x4*)(rowp + bj * 128) = (u32x4){pack2(v0[0], v0[1]), pack2(v0[2], v0[3]), pack2(v1[0], v1[1]), pack2(v1[2], v1[3])};
                }
            }
    }
};
DI int left_first(int units, int bid, int nb) { return (bid - units % nb + nb) % nb; }

constexpr int LEFT_LDS = 2 * (32 + 128) * LDT * 2;
template <class ARow, class Epi>
DI void gemm_left32(ARow arow, const bf16_t* __restrict__ Bt, int ldb, int K, int n0, char* smem, Epi epi) {
    const int tid = tid_(), lane = tid & 63, wid = __builtin_amdgcn_readfirstlane(tid >> 6), fr = lane & 15, fq = lane >> 4;
    bf16_t* As = (bf16_t*)smem;
    bf16_t* Bs = As + 2 * 32 * LDT;
    const int arow_i = tid >> 4, akc = (tid & 15) * 4;
    const bf16_t* ap = arow(arow_i) + akc;
    const bf16_t* bp[2]; int bso[2];
#pragma unroll
    for (int i = 0; i < 2; ++i) { const int cc = tid + NTHR * i, row = cc >> 3, kc = cc & 7; bp[i] = Bt + (size_t)(n0 + row) * ldb + kc * 8; bso[i] = row * LDT + kc * 8; }
    const int nit = K / 64;
    u32x2 ra[4]; u32x4 rb[4][2];
#define GL_LOAD(slot, it) do { if ((it) < nit) { ra[slot] = *(const u32x2*)(ap + (it) * 64); rb[slot][0] = *(const u32x4*)(bp[0] + (it) * 64); rb[slot][1] = *(const u32x4*)(bp[1] + (it) * 64); } } while (0)
#define GL_WRITE(slot, buf) do { *(u32x2*)(As + (buf) * 32 * LDT + arow_i * LDT + akc) = ra[slot]; *(u32x4*)(Bs + (buf) * 128 * LDT + bso[0]) = rb[slot][0]; *(u32x4*)(Bs + (buf) * 128 * LDT + bso[1]) = rb[slot][1]; } while (0)
    f32x4 acc[2] = {(f32x4){0.f, 0.f, 0.f, 0.f}, (f32x4){0.f, 0.f, 0.f, 0.f}};
    GL_LOAD(0, 0); GL_LOAD(1, 1); GL_LOAD(2, 2); GL_LOAD(3, 3);
    __syncthreads();
    GL_WRITE(0, 0);
    __syncthreads();
#define GL_STEP(slot, it) do { \
        GL_LOAD(slot, (it) + 4); \
        const int buf = (it) & 1; \
        _Pragma("unroll") for (int ks = 0; ks < 2; ++ks) { \
            const bf16x8 bf = *(const bf16x8*)(Bs + buf * 128 * LDT + (wid * 16 + fr) * LDT + ks * 32 + fq * 8); \
            _Pragma("unroll") for (int mt = 0; mt < 2; ++mt) { \
                const bf16x8 af = *(const bf16x8*)(As + buf * 32 * LDT + (mt * 16 + fr) * LDT + ks * 32 + fq * 8); \
                acc[mt] = __builtin_amdgcn_mfma_f32_16x16x32_bf16(bf, af, acc[mt], 0, 0, 0); } } \
        if ((it) + 1 < nit) { GL_WRITE(((slot) + 1) & 3, buf ^ 1); } \
        __syncthreads(); } while (0)
    for (int it = 0; it < nit; it += 4) {
        GL_STEP(0, it);
        if (it + 1 < nit) GL_STEP(1, it + 1);
        if (it + 2 < nit) GL_STEP(2, it + 2);
        if (it + 3 < nit) GL_STEP(3, it + 3);
    }
#undef GL_LOAD
#undef GL_WRITE
#undef GL_STEP
#pragma unroll
    for (int mt = 0; mt < 2; ++mt) epi(mt * 16 + fr, n0 + wid * 16 + fq * 4, acc[mt]);
}

DI void phase_inproj(const Params& p, int layer, int bid, int nb, char* smem) {
    const bf16_t* hb = p.hb; bf16_t* P = p.P;
    const bf16_t* Bt = p.WtIn + (size_t)layer * CIN * D;
    g8::DenseOrder S; S.init(hb, Bt, MFULL, CP / 256, D, nb, bid);
    g8::gemm8<false>((G8_LAS unsigned char*)smem, D, S, EpiStore{P, CP, false});
    {
        constexpr int UNITS = MFULL * (CP / 256);
        const int heavy = UNITS % nb;
        if (heavy > 0 && heavy < nb) { if (bid >= heavy) convert_experts(p, layer, 0, NE / 2, bid - heavy, nb - heavy, smem); }
        else convert_experts(p, layer, 0, NE / 2, bid, nb, smem);
    }
    bf16_t* G = p.gleft - (size_t)M0_LEFT * 2048; const bf16_t* Wg = p.WtIn + ((size_t)layer * CIN + CP) * D;
    for (int t = left_first(MFULL * (CP / 256), bid, nb); t < CP / 128 + 2048 / 128; t += nb) {
        if (t < CP / 128)
            gemm_left32([=](int r) { return hb + (size_t)(M0_LEFT + r) * D; }, Bt, D, D, t * 128, smem,
                        [=](int r, int c, f32x4 v) { *(u32x2*)(P + (size_t)(M0_LEFT + r) * CP + c) = (u32x2){pack2(v[0], v[1]), pack2(v[2], v[3])}; });
        else
            gemm_left32([=](int r) { return hb + (size_t)(M0_LEFT + r) * D; }, Wg, D, D, (t - CP / 128) * 128, smem,
                        [=](int r, int c, f32x4 v) { *(u32x2*)(G + (size_t)(M0_LEFT + r) * 2048 + c) = (u32x2){pack2(sigmoidf_(v[0]), sigmoidf_(v[1])), pack2(sigmoidf_(v[2]), sigmoidf_(v[3]))}; });
    }
}

constexpr int NCHUNK = (L + 63) / 64, NUNIT = NBATCH * HEADS * NCHUNK;
constexpr int LS = 72, RB = 64 * LS * 2;
constexpr int R1_LDS = 16 * RB + 4096 + 7168;
#define RBUF(i) ((bf16_t*)(smem + (i) * RB))
typedef float f32x16 __attribute__((ext_vector_type(16)));

template <int KK> DI f32x4 mm16(const bf16_t* F, int ldf, const bf16_t* S, int lds_, f32x4 acc, int lane) {
    const int fr = lane & 15, fq = lane >> 4;
#pragma unroll
    for (int ks = 0; ks < KK / 32; ++ks) {
        const bf16x8 f = *(const bf16x8*)(F + fr * ldf + ks * 32 + fq * 8);
        const bf16x8 g = *(const bf16x8*)(S + fr * lds_ + ks * 32 + fq * 8);
        acc = __builtin_amdgcn_mfma_f32_16x16x32_bf16(f, g, acc, 0, 0, 0);
    }
    return acc;
}
DI u32x2 pk4(f32x4 v) { return (u32x2){pack2(v[0], v[1]), pack2(v[2], v[3])}; }
DI f32x4 up4(u32x2 v) { return (f32x4){lo_bf(v[0]), hi_bf(v[0]), lo_bf(v[1]), hi_bf(v[1])}; }

template <int MODE> DI void phase_rwkv_r1(const Params& p, int layer, int bid, int nb, char* smem) {
    const int wv = __builtin_amdgcn_readfirstlane(tid_() >> 6);
    const f32x4 zero = (f32x4){0.f, 0.f, 0.f, 0.f};
    float* lwT = (float*)RBUF(4);
    float* aT = (float*)RBUF(6);
    float* gt = (float*)(smem + 16 * RB);
    float* gammaC = gt + 512;
    bf16_t* Xt0 = RBUF(14);
    bf16_t* Xt1 = RBUF(4);
    const bf16_t* WupT = p.WupT + (size_t)layer * 512 * 64, *AupT = p.AupT + (size_t)layer * 512 * 64, *GupT = p.GupT + (size_t)layer * 512 * 128;
    float* mu = (float*)(smem + 16 * RB + 4096);
    __syncthreads();
    for (int i = tid_(); i < RSW; i += NTHR) mu[i] = p.mu[(size_t)layer * RSW + i];
    for (int it = 0;; ++it) {
        const int tid = tid_(), lane = tid & 63, fr = lane & 15, fq = lane >> 4;
        int c, bh;
        if (MODE == 0) {
            const int Lq = it * nb + bid, q = Lq >> 3, cb = (q >> 3) * 8 + (Lq & 7);
            if (cb >= NBATCH * (NCHUNK - 1)) break;
            c = cb % (NCHUNK - 1); bh = (cb / (NCHUNK - 1)) * HEADS + (q & 7);
        } else {
            if (it > 0) break;
            c = NCHUNK - 1; bh = bid;
        }
        const int u = bh * NCHUNK + c, h = bh % HEADS, bb = bh / HEADS;
        const size_t tok0 = (size_t)bb * L + c * 64;
        bf16x8 fw[2][2], fa[2][2], fg[2][4];
#pragma unroll
        for (int t2 = 0; t2 < 2; ++t2) {
            const int tl = wv * 2 + t2, pt = tl >> 2, qt = tl & 3;
#pragma unroll
            for (int ks = 0; ks < 2; ++ks) {
                fw[t2][ks] = *(const bf16x8*)(WupT + (size_t)(h * 64 + qt * 16 + fr) * 64 + ks * 32 + fq * 8);
                fa[t2][ks] = *(const bf16x8*)(AupT + (size_t)(h * 64 + pt * 16 + fr) * 64 + ks * 32 + fq * 8);
            }
        }
        __syncthreads();
        {
            u32x4 curv[7], prvv[7];
#pragma unroll
            for (int it2 = 0; it2 < 7; ++it2) {
                const int cid = tid + NTHR * it2, i = cid / 56, cc = cid % 56;
                const int col = cc < 8 ? RW_R + h * 64 + cc * 8 : cc < 16 ? RW_K + h * 64 + (cc - 8) * 8 : cc < 24 ? RW_V + h * 64 + (cc - 16) * 8 : RW_WD + (cc - 24) * 8;
                const int t = c * 64 + i;
                curv[it2] = (u32x4){0u, 0u, 0u, 0u}; prvv[it2] = (u32x4){0u, 0u, 0u, 0u};
                if (t < L) curv[it2] = *(const u32x4*)(p.P + (tok0 + i) * CP + OFF_RW + col);
                if (t < L && t > 0) prvv[it2] = *(const u32x4*)(p.P + (tok0 + i - 1) * CP + OFF_RW + col);
            }
#pragma unroll
            for (int it2 = 0; it2 < 7; ++it2) {
                const int cid = tid + NTHR * it2, i = cid / 56, cc = cid % 56;
                const int col = cc < 8 ? RW_R + h * 64 + cc * 8 : cc < 16 ? RW_K + h * 64 + (cc - 8) * 8 : cc < 24 ? RW_V + h * 64 + (cc - 16) * 8 : RW_WD + (cc - 24) * 8;
                bf16_t* dst = cc < 8 ? RBUF(8) + i * LS + cc * 8 : cc < 16 ? RBUF(9) + i * LS + (cc - 8) * 8 : cc < 24 ? RBUF(10) + i * LS + (cc - 16) * 8
                            : cc < 32 ? RBUF(0) + i * LS + (cc - 24) * 8 : cc < 40 ? RBUF(1) + i * LS + (cc - 32) * 8 : RBUF(2) + i * 136 + (cc - 40) * 8;
                const f32x4 m0 = *(const f32x4*)(mu + col), m1 = *(const f32x4*)(mu + col + 4);
                const u32x4 cur = curv[it2], prv = prvv[it2];
                float x[8];
#pragma unroll
                for (int j2 = 0; j2 < 4; ++j2) {
                    const float c0 = lo_bf(cur[j2]), c1 = hi_bf(cur[j2]), p0 = lo_bf(prv[j2]), p1 = hi_bf(prv[j2]);
                    const float mm0 = j2 < 2 ? m0[2 * j2] : m1[2 * j2 - 4], mm1 = j2 < 2 ? m0[2 * j2 + 1] : m1[2 * j2 - 3];
                    x[2 * j2] = c0 + (p0 - c0) * mm0; x[2 * j2 + 1] = c1 + (p1 - c1) * mm1;
                }
                if (cc >= 24 && cc < 32) {
#pragma unroll
                    for (int j2 = 0; j2 < 8; ++j2) x[j2] = tanhf_(x[j2]);
                } else if (cc >= 40) {
#pragma unroll
                    for (int j2 = 0; j2 < 8; ++j2) x[j2] = sigmoidf_(x[j2]);
                }
                *(u32x4*)dst = (u32x4){pack2(x[0], x[1]), pack2(x[2], x[3]), pack2(x[4], x[5]), pack2(x[6], x[7])};
            }
        }
#pragma unroll
        for (int t2 = 0; t2 < 2; ++t2)
#pragma unroll
            for (int ks = 0; ks < 4; ++ks) fg[t2][ks] = *(const bf16x8*)(GupT + (size_t)(h * 64 + ((wv * 2 + t2) >> 2) * 16 + fr) * 128 + ks * 32 + fq * 8);
        __syncthreads();
#pragma unroll
        for (int t2 = 0; t2 < 2; ++t2) {
            const int tl = wv * 2 + t2, pt = tl >> 2, qt = tl & 3;
            f32x4 aw = zero, aa = zero, ag = zero;
#pragma unroll
            for (int ks = 0; ks < 2; ++ks) {
                const bf16x8 xw = *(const bf16x8*)(RBUF(0) + (pt * 16 + fr) * LS + ks * 32 + fq * 8);
                aw = __builtin_amdgcn_mfma_f32_16x16x32_bf16(xw, fw[t2][ks], aw, 0, 0, 0);
                const bf16x8 xa = *(const bf16x8*)(RBUF(1) + (qt * 16 + fr) * LS + ks * 32 + fq * 8);
                aa = __builtin_amdgcn_mfma_f32_16x16x32_bf16(fa[t2][ks], xa, aa, 0, 0, 0);
            }
#pragma unroll
            for (int ks = 0; ks < 4; ++ks) {
                const bf16x8 xg = *(const bf16x8*)(RBUF(2) + (qt * 16 + fr) * 136 + ks * 32 + fq * 8);
                ag = __builtin_amdgcn_mfma_f32_16x16x32_bf16(fg[t2][ks], xg, ag, 0, 0, 0);
            }
            const int ch = qt * 16 + fr;
            const float w0 = p.w0[layer * 512 + h * 64 + ch];
            const f32x4 a0 = *(const f32x4*)(p.a0 + layer * 512 + h * 64 + pt * 16 + fq * 4);
            f32x4 lw, av;
#pragma unroll
            for (int e = 0; e < 4; ++e) { lw[e] = -DECAY_SCALE * sigmoidf_(w0 + aw[e]); av[e] = sigmoidf_(a0[e] + aa[e]); }
            *(f32x4*)(lwT + ch * 68 + pt * 16 + fq * 4) = lw;
            *(f32x4*)(aT + (qt * 16 + fr) * 68 + pt * 16 + fq * 4) = av;
            *(u32x2*)(p.GG + ((size_t)u * 64 + qt * 16 + fr) * 64 + pt * 16 + fq * 4) = pk4(ag);
        }
        __syncthreads();
        {
            const int i = tid >> 3, c8 = (tid & 7) * 8, cg = layer * 512 + h * 64 + c8;
            const u32x4 xr = *(const u32x4*)(RBUF(8) + i * LS + c8), xk = *(const u32x4*)(RBUF(9) + i * LS + c8);
            const f32x4 a0 = *(const f32x4*)(aT + i * 68 + c8), a1 = *(const f32x4*)(aT + i * 68 + c8 + 4);
            const f32x4 kk0 = *(const f32x4*)(p.k_k + cg), kk1 = *(const f32x4*)(p.k_k + cg + 4), ka0 = *(const f32x4*)(p.k_a + cg), ka1 = *(const f32x4*)(p.k_a + cg + 4);
            const f32x4 rk0 = *(const f32x4*)(p.r_k + cg), rk1 = *(const f32x4*)(p.r_k + cg + 4);
            float n2 = 0.f, bon = 0.f;
#pragma unroll
            for (int j = 0; j < 8; ++j) {
                const float r_ = (j & 1) ? hi_bf(xr[j >> 1]) : lo_bf(xr[j >> 1]), k_ = (j & 1) ? hi_bf(xk[j >> 1]) : lo_bf(xk[j >> 1]);
                const float a_ = j < 4 ? a0[j & 3] : a1[j & 3], kkc = j < 4 ? kk0[j & 3] : kk1[j & 3], kac = j < 4 ? ka0[j & 3] : ka1[j & 3], rkc = j < 4 ? rk0[j & 3] : rk1[j & 3];
                const float kkr = k_ * kkc;
                n2 += kkr * kkr;
                bon += r_ * (k_ * (1.0f + (a_ - 1.0f) * kac)) * rkc;
            }
            n2 = sum8(n2); bon = sum8(bon);
            if ((tid & 7) == 0) { gt[576 + i] = 1.0f / fmaxf(sqrtf(n2), 1e-12f); p.bonG[(size_t)u * 64 + i] = bon; }
        }
        __syncthreads();
        {
            const int ch = lane, cg = layer * 512 + h * 64 + ch;
            float lw[8], av[8], cum[8];
            {
                const f32x4 l0 = *(const f32x4*)(lwT + ch * 68 + wv * 8), l1 = *(const f32x4*)(lwT + ch * 68 + wv * 8 + 4);
#pragma unroll
                for (int e = 0; e < 4; ++e) { lw[e] = l0[e]; lw[e + 4] = l1[e]; }
#pragma unroll
                for (int e = 0; e < 8; ++e) av[e] = aT[(wv * 8 + e) * 68 + ch];
            }
            float run = 0.f;
#pragma unroll
            for (int e = 0; e < 8; ++e) { run += lw[e]; cum[e] = run; }
            gt[wv * 64 + ch] = run;
            __syncthreads();
            float offs = 0.f, tot = 0.f;
#pragma unroll
            for (int g2 = 0; g2 < 8; ++g2) { const float gv = gt[g2 * 64 + ch]; offs += g2 < wv ? gv : 0.f; tot += gv; }
            if (wv == 0) gammaC[ch] = __expf(tot);
            const float kkc = p.k_k[cg], kac = p.k_a[cg];
            float at_[8], kt_[8], bt_[8], vt_[8];
#pragma unroll
            for (int e = 0; e < 8; ++e) {
                const int i = wv * 8 + e;
                const float xr = bf2f(RBUF(8)[i * LS + ch]), xk = bf2f(RBUF(9)[i * LS + ch]), xv = bf2f(RBUF(10)[i * LS + ch]);
                const float cm = cum[e] + offs;
                const float kk = xk * kkc * gt[576 + i];
                const float kq = xk * (1.0f + (av[e] - 1.0f) * kac);
                if (c * 64 + i < L) p.orw[(tok0 + i) * 512 + h * 64 + ch] = RBUF(10)[i * LS + ch];
                const float eneg = __expf(-cm), epos = __expf(cm), eexc = __expf(cm - lw[e]);
                at_[e] = -kk * eexc; kt_[e] = kq * eneg; bt_[e] = kk * av[e] * eneg; vt_[e] = xv;
                RBUF(3)[i * LS + ch] = f2bf(xr * epos);
            }
            __syncthreads();
#pragma unroll
            for (int e = 0; e < 8; ++e) {
                const int i = wv * 8 + e;
                RBUF(0)[i * LS + ch] = f2bf(at_[e]); RBUF(1)[i * LS + ch] = f2bf(kt_[e]); RBUF(2)[i * LS + ch] = f2bf(bt_[e]);
            }
            *(u32x4*)(RBUF(11) + ch * LS + wv * 8) = (u32x4){pack2(kt_[0], kt_[1]), pack2(kt_[2], kt_[3]), pack2(kt_[4], kt_[5]), pack2(kt_[6], kt_[7])};
            *(u32x4*)(RBUF(12) + ch * LS + wv * 8) = (u32x4){pack2(bt_[0], bt_[1]), pack2(bt_[2], bt_[3]), pack2(bt_[4], bt_[5]), pack2(bt_[6], bt_[7])};
            *(u32x4*)(RBUF(13) + ch * LS + wv * 8) = (u32x4){pack2(vt_[0], vt_[1]), pack2(vt_[2], vt_[3]), pack2(vt_[4], vt_[5]), pack2(vt_[6], vt_[7])};
            *(u32x4*)(Xt0 + ch * LS + wv * 8) = (u32x4){pack2(at_[0], at_[1]), pack2(at_[2], at_[3]), pack2(at_[4], at_[5]), pack2(at_[6], at_[7])};
        }
        __syncthreads();
#pragma unroll
        for (int prod = 0; prod < 4; ++prod) {
            const bf16_t* F = (prod == 0 || prod == 2) ? RBUF(1) : RBUF(2);
            const bf16_t* S = prod < 2 ? RBUF(0) : RBUF(3);
            bf16_t* O = prod == 0 ? RBUF(6) : prod == 1 ? RBUF(7) : prod == 2 ? RBUF(9) : RBUF(10);
            const int mode = prod < 2 ? 0 : 1;
#pragma unroll
            for (int rep = 0; rep < 2; ++rep) {
                const int tl = wv + 8 * rep, pt = tl >> 2, qt = tl & 3;
                f32x4 acc = zero;
                if (pt <= qt) acc = mm16<64>(F + pt * 16 * LS, LS, S + qt * 16 * LS, LS, zero, lane);
                const int qi = qt * 16 + fr;
#pragma unroll
                for (int e = 0; e < 4; ++e) {
                    const int pi = pt * 16 + fq * 4 + e;
                    const bool keep = mode == 0 ? pi < qi : pi <= qi;
                    acc[e] = keep ? acc[e] : 0.f;
                }
                *(u32x2*)(O + qi * LS + pt * 16 + fq * 4) = pk4(acc);
                if (prod == 1) {
#pragma unroll
                    for (int e = 0; e < 4; ++e) RBUF(8)[(pt * 16 + fq * 4 + e) * LS + qi] = f2bf(acc[e]);
                }
            }
        }
        __syncthreads();
        f32x4 X[4];
        if (wv < 4) {
#pragma unroll
            for (int pt = 0; pt < 4; ++pt) X[pt] = up4(*(const u32x2*)(Xt0 + (wv * 16 + fr) * LS + pt * 16 + fq * 4));
        } else {
#pragma unroll
            for (int pt = 0; pt < 4; ++pt) {
                X[pt] = mm16<64>(RBUF(6) + pt * 16 * LS, LS, RBUF(13) + (wv - 4) * 16 * LS, LS, zero, lane);
                *(u32x2*)(Xt0 + (wv * 16 + fr) * LS + pt * 16 + fq * 4) = pk4(X[pt]);
            }
        }
        __syncthreads();
#pragma unroll
        for (int k = 0; k < 6; ++k) {
            const bf16_t* Mk = (k & 1) ? RBUF(0) : RBUF(7);
            const bf16_t* Mkt = (k & 1) ? RBUF(6) : RBUF(8);
            bf16_t* Mn = (k & 1) ? RBUF(7) : RBUF(0);
            bf16_t* Mnt = (k & 1) ? RBUF(8) : RBUF(6);
            const bf16_t* Xc = (k & 1) ? Xt1 : Xt0;
            bf16_t* Xn = (k & 1) ? Xt0 : Xt1;
#pragma unroll
            for (int pt = 0; pt < 4; ++pt) {
                constexpr int dummy = 0; (void)dummy;
                const int maxj = 16 * pt + 15 - (1 << k);
                if (maxj >= 0) {
                    const int nks = maxj / 32 + 1;
#pragma unroll
                    for (int ks = 0; ks < 2; ++ks)
                        if (ks < nks) {
                            const bf16x8 f = *(const bf16x8*)(Mk + (pt * 16 + fr) * LS + ks * 32 + fq * 8);
                            const bf16x8 g = *(const bf16x8*)(Xc + (wv * 16 + fr) * LS + ks * 32 + fq * 8);
                            X[pt] = __builtin_amdgcn_mfma_f32_16x16x32_bf16(f, g, X[pt], 0, 0, 0);
                        }
                }
                *(u32x2*)(Xn + (wv * 16 + fr) * LS + pt * 16 + fq * 4) = pk4(X[pt]);
            }
            if (k < 5) {
#pragma unroll
                for (int rep = 0; rep < 2; ++rep) {
                    const int t2 = wv + 8 * rep, pt = t2 >> 2, qt = t2 & 3;
                    f32x4 acc = zero;
                    const int mlo = 16 * pt + (1 << k), mhi = 16 * qt + 15 - (1 << k);
                    if (16 * qt + 15 - 16 * pt >= (2 << k) && mhi >= mlo) {
                        const int k0 = mlo >> 5, k1 = mhi >> 5;
                        for (int ks = k0; ks <= k1; ++ks) {
                            const bf16x8 f = *(const bf16x8*)(Mkt + (pt * 16 + fr) * LS + ks * 32 + fq * 8);
                            const bf16x8 g = *(const bf16x8*)(Mk + (qt * 16 + fr) * LS + ks * 32 + fq * 8);
                            acc = __builtin_amdgcn_mfma_f32_16x16x32_bf16(f, g, acc, 0, 0, 0);
                        }
                    }
                    *(u32x2*)(Mn + (qt * 16 + fr) * LS + pt * 16 + fq * 4) = pk4(acc);
#pragma unroll
                    for (int e = 0; e < 4; ++e) Mnt[(pt * 16 + fq * 4 + e) * LS + qt * 16 + fr] = f2bf(acc[e]);
                }
            }
            __syncthreads();
        }
#pragma unroll
        for (int rep = 0; rep < 2; ++rep) {
            const int tl = wv + 8 * rep, pt = tl >> 2, qt = tl & 3;
            const int pi0 = pt * 16 + fq * 4, qi = qt * 16 + fr;
            const size_t go = ((size_t)u * 64 + qi) * 64 + pi0;
            {
                f32x4 acc = mm16<64>(Xt0 + pt * 16 * LS, LS, RBUF(12) + qt * 16 * LS, LS, zero, lane);
                const float gc = gammaC[qi];
#pragma unroll
                for (int e = 0; e < 4; ++e) acc[e] = (acc[e] + (pi0 + e == qi ? 1.f : 0.f)) * gc;
                {
                    const size_t d = (((size_t)u * 8 + (qi >> 4) * 2 + (pi0 >> 5)) * 64 + (qi & 15) + 16 * ((pi0 >> 2) & 3)) * 8 + ((pi0 >> 4) & 1) * 4;
                    *(u32x2*)(p.PcG + d) = pk4(acc);
                }
            }
            {
                f32x4 acc = mm16<64>(RBUF(11) + pt * 16 * LS, LS, RBUF(13) + qt * 16 * LS, LS, zero, lane);
                acc = mm16<64>(RBUF(12) + pt * 16 * LS, LS, Xt0 + (64 + qt * 16) * LS, LS, acc, lane);
                const f32x4 gc = *(const f32x4*)(gammaC + pi0);
#pragma unroll
                for (int e = 0; e < 4; ++e) acc[e] *= gc[e];
                {
                    const size_t d = (((size_t)u * 4 + (qi >> 4)) * 64 + (qi & 15) + 16 * ((pi0 >> 2) & 3)) * 16 + (pi0 >> 4) * 4;
                    *(u32x2*)(p.QcG + d) = pk4(acc);
                }
            }
            {
                f32x4 acc = mm16<64>(Xt0 + pt * 16 * LS, LS, RBUF(10) + qt * 16 * LS, LS, zero, lane);
                const f32x4 rr = up4(*(const u32x2*)(RBUF(3) + qi * LS + pi0));
#pragma unroll
                for (int e = 0; e < 4; ++e) acc[e] += rr[e];
                *(u32x2*)(p.RhG + go) = pk4(acc);
            }
            {
                f32x4 acc = mm16<64>(RBUF(13) + pt * 16 * LS, LS, RBUF(9) + qt * 16 * LS, LS, zero, lane);
                acc = mm16<64>(Xt0 + (64 + pt * 16) * LS, LS, RBUF(10) + qt * 16 * LS, LS, acc, lane);
                *(u32x2*)(p.Y0G + go) = pk4(acc);
            }
        }
    }
}

struct R2Set { u32x4 a[8]; u32x4 q[2]; };
DI void r2_load(R2Set& st, const Params& p, size_t u, int lane, int vq) {
    const bf16_t* qg = p.QcG + ((u * 4 + vq) * 64 + lane) * 16;
    st.q[0] = *(const u32x4*)qg; st.q[1] = *(const u32x4*)(qg + 8);
#pragma unroll
    for (int f = 0; f < 8; ++f) st.a[f] = *(const u32x4*)(p.PcG + ((u * 8 + f) * 64 + lane) * 8);
}
DI void r2_step(f32x4 (&S)[4], const R2Set& st, const Params& p, size_t u, int lane, int vq, bool last) {
    const u32x4 b0 = (u32x4){pack2(S[0][0], S[0][1]), pack2(S[0][2], S[0][3]), pack2(S[1][0], S[1][1]), pack2(S[1][2], S[1][3])};
    const u32x4 b1 = (u32x4){pack2(S[2][0], S[2][1]), pack2(S[2][2], S[2][3]), pack2(S[3][0], S[3][1]), pack2(S[3][2], S[3][3])};
    bf16_t* sg = p.SG + ((u * 4 + vq) * 64 + lane) * 16;
    *(u32x4*)sg = b0; *(u32x4*)(sg + 8) = b1;
    if (last) return;
#pragma unroll
    for (int kt = 0; kt < 4; ++kt) {
        const u32x4 qq = st.q[kt >> 1];
        const unsigned w0 = qq[(kt & 1) * 2], w1 = qq[(kt & 1) * 2 + 1];
        S[kt] = (f32x4){lo_bf(w0), hi_bf(w0), lo_bf(w1), hi_bf(w1)};
    }
    const bf16x8 f0 = __builtin_bit_cast(bf16x8, b0), f1 = __builtin_bit_cast(bf16x8, b1);
#pragma unroll
    for (int kt = 0; kt < 4; ++kt) {
        S[kt] = __builtin_amdgcn_mfma_f32_16x16x32_bf16(__builtin_bit_cast(bf16x8, st.a[kt * 2]), f0, S[kt], 0, 0, 0);
        S[kt] = __builtin_amdgcn_mfma_f32_16x16x32_bf16(__builtin_bit_cast(bf16x8, st.a[kt * 2 + 1]), f1, S[kt], 0, 0, 0);
    }
}
DI void phase_rwkv_r2(const Params& p, int chain) {
    const int lane = tid_() & 63;
    const int bh = chain >> 2, vq = chain & 3;
    const size_t u0 = (size_t)bh * NCHUNK;
    f32x4 S[4];
#pragma unroll
    for (int kt = 0; kt < 4; ++kt) S[kt] = (f32x4){0.f, 0.f, 0.f, 0.f};
    R2Set A, B, C, E;
    r2_load(A, p, u0, lane, vq); r2_load(B, p, u0 + 1, lane, vq); r2_load(C, p, u0 + 2, lane, vq); r2_load(E, p, u0 + 3, lane, vq);
#define R2_ONE(SET, cc) do { r2_step(S, SET, p, u0 + (cc), lane, vq, (cc) == NCHUNK - 1); if ((cc) + 4 < NCHUNK - 1) r2_load(SET, p, u0 + (cc) + 4, lane, vq); } while (0)
#pragma unroll 1
    for (int c = 0; c < NCHUNK; c += 4) {
        R2_ONE(A, c);
        if (c == NCHUNK - 1) break;
        R2_ONE(B, c + 1);
        R2_ONE(C, c + 2);
        R2_ONE(E, c + 3);
    }
#undef R2_ONE
}

DI void phase_rwkv_r3(const Params& p, int layer, int bid, int nb) {
    const int tid = tid_(), lane = tid & 63, wv = __builtin_amdgcn_readfirstlane(tid >> 6), fr = lane & 15, fq = lane >> 4;
    constexpr int TPB = L / 16;
    for (int task = bid * 8 + wv; task < NBATCH * HEADS * TPB; task += nb * 8) {
        const int bh = task / TPB, tt = task % TPB, c = tt >> 2, it = tt & 3, u = bh * NCHUNK + c;
        const int h = bh % HEADS, bb = bh / HEADS;
        const int i = it * 16 + fr, t = c * 64 + i;
        const bool live = t < L;
        const size_t tok = (size_t)bb * L + (live ? t : 0);
        bf16x8 sf[2];
#pragma unroll
        for (int ks = 0; ks < 2; ++ks) sf[ks] = *(const bf16x8*)(p.RhG + ((size_t)u * 64 + i) * 64 + ks * 32 + fq * 8);
        u32x2 s0[4][2], s1[4][2], y0[4], xvv[4], gv[4];
#pragma unroll
        for (int vt = 0; vt < 4; ++vt) {
            const int vv = vt * 16 + fr;
#pragma unroll
            for (int ks = 0; ks < 2; ++ks) {
                const bf16_t* sp = p.SG + (((size_t)u * 4 + vt) * 64 + fr + 32 * (fq & 1)) * 16 + (2 * ks + (fq >> 1)) * 4;
                s0[vt][ks] = *(const u32x2*)sp; s1[vt][ks] = *(const u32x2*)(sp + 16 * 16);
                (void)vv;
            }
            y0[vt] = *(const u32x2*)(p.Y0G + ((size_t)u * 64 + i) * 64 + vt * 16 + fq * 4);
            xvv[vt] = *(const u32x2*)(p.orw + tok * 512 + h * 64 + vt * 16 + fq * 4);
            gv[vt] = *(const u32x2*)(p.GG + ((size_t)u * 64 + i) * 64 + vt * 16 + fq * 4);
        }
        const float bon = p.bonG[(size_t)u * 64 + i];
        f32x4 y[4];
#pragma unroll
        for (int vt = 0; vt < 4; ++vt) {
            y[vt] = up4(y0[vt]);
#pragma unroll
            for (int ks = 0; ks < 2; ++ks) {
                const bf16x8 f = __builtin_bit_cast(bf16x8, ((u32x4){s0[vt][ks][0], s0[vt][ks][1], s1[vt][ks][0], s1[vt][ks][1]}));
                y[vt] = __builtin_amdgcn_mfma_f32_16x16x32_bf16(f, sf[ks], y[vt], 0, 0, 0);
            }
        }
        float s = 0.f;
#pragma unroll
        for (int vt = 0; vt < 4; ++vt) s += (y[vt][0] + y[vt][1]) + (y[vt][2] + y[vt][3]);
        s += __shfl_xor(s, 16); s += __shfl_xor(s, 32);
        const float mean = s * (1.0f / 64.f);
        float q = 0.f;
#pragma unroll
        for (int vt = 0; vt < 4; ++vt)
#pragma unroll
            for (int e = 0; e < 4; ++e) { y[vt][e] -= mean; q += y[vt][e] * y[vt][e]; }
        q += __shfl_xor(q, 16); q += __shfl_xor(q, 32);
        const float rstd = rsqrtf(q * (1.0f / 64.f) + 64e-5f);
        if (live) {
#pragma unroll
            for (int vt = 0; vt < 4; ++vt) {
                const int cg = h * 64 + vt * 16 + fq * 4;
                const f32x4 xv = up4(xvv[vt]), g = up4(gv[vt]);
                const f32x4 lg = *(const f32x4*)(p.lnx_g + layer * 512 + cg), lb = *(const f32x4*)(p.lnx_b + layer * 512 + cg);
                f32x4 o;
#pragma unroll
                for (int e = 0; e < 4; ++e) o[e] = (y[vt][e] * rstd * lg[e] + lb[e] + bon * xv[e]) * g[e];
                *(u32x2*)(p.orw + tok * 512 + cg) = pk4(o);
            }
        }
    }
}

constexpr int SB_LDS = 4 * RB + 64;
DI void phase_sb(const Params& p, int bid0, int nb, char* smem) {
    const int tid = tid_(), lane = tid & 63, wv = __builtin_amdgcn_readfirstlane(tid >> 6), fr = lane & 15, fq = lane >> 4;
    bf16_t* Ks0 = (bf16_t*)smem;
    bf16_t* Vt0 = Ks0 + 2 * 64 * LS;
    int* flags = (int*)(smem + 4 * RB);
    bf16x8 tri[4][2];
#pragma unroll
    for (int st = 0; st < 4; ++st)
#pragma unroll
        for (int k2 = 0; k2 < 2; ++k2)
#pragma unroll
            for (int jj = 0; jj < 8; ++jj) tri[st][k2][jj] = (32 * k2 + 16 * (jj >> 2) + 4 * fq + (jj & 3) > 16 * st + fr) ? (short)0x3F80 : (short)0;
    constexpr int NQB = (L + 127) / 128;
    const int ldkey = tid >> 3, lddc = (tid & 7) * 8;
    for (int u = bid0; u < NBATCH * HEADS * NQB; u += nb) {
        const int bh = u % (NBATCH * HEADS), b = bh / HEADS, h = bh % HEADS, q0 = (NQB - 1 - u / (NBATCH * HEADS)) * 128;
        const int qlo = q0 + 16 * wv, query = qlo + fr;
        const size_t tokb = (size_t)b * L;
        bf16x8 qf[2];
#pragma unroll
        for (int ks = 0; ks < 2; ++ks) qf[ks] = *(const bf16x8*)(p.P + (tokb + query) * CP + OFF_Q + h * 64 + ks * 32 + fq * 8);
        const int qmax = (q0 + 127 < L - 1) ? q0 + 127 : L - 1;
        int kt = (qmax - 1) >> 6;
        float R = 0.f;
        f32x4 ot[4];
#pragma unroll
        for (int dt = 0; dt < 4; ++dt) ot[dt] = (f32x4){0.f, 0.f, 0.f, 0.f};
        bool done = qlo >= L;
        u32x4 kreg, vreg;
        {
            const int s = kt * 64 + ldkey;
            const bf16_t* src = p.P + (tokb + s) * CP + h * 64 + lddc;
            kreg = s < L ? *(const u32x4*)(src + OFF_K) : (u32x4){0u, 0u, 0u, 0u};
            vreg = s < L ? *(const u32x4*)(src + OFF_V) : (u32x4){0u, 0u, 0u, 0u};
        }
        const int vsw = (tid & 7) << 2;
        __syncthreads();
        {
            *(u32x4*)(Ks0 + ldkey * LS + lddc) = kreg;
#pragma unroll
            for (int j = 0; j < 4; ++j) { Vt0[(lddc + 2 * j) * LS + (ldkey ^ vsw)] = (bf16_t)(vreg[j] & 0xFFFFu); Vt0[(lddc + 2 * j + 1) * LS + (ldkey ^ vsw)] = (bf16_t)(vreg[j] >> 16); }
        }
        __syncthreads();
        for (int itile = 0;; ++itile) {
            const bf16_t* Ks = Ks0 + (itile & 1) * 64 * LS; const bf16_t* Vt = Vt0 + (itile & 1) * 64 * LS;
            if (kt > 0) {
                const int s = (kt - 1) * 64 + ldkey;
                const bf16_t* src = p.P + (tokb + s) * CP + h * 64 + lddc;
                kreg = *(const u32x4*)(src + OFF_K); vreg = *(const u32x4*)(src + OFF_V);
            }
            if (!done && kt * 64 < qlo + 15) {
                f32x4 uu[4], lsp[4];
                float tot = 0.f;
                const bool full = kt * 64 + 63 < qlo;
#pragma unroll
                for (int kk = 0; kk < 4; ++kk) {
                    f32x4 z = (f32x4){0.f, 0.f, 0.f, 0.f};
#pragma unroll
                    for (int ks = 0; ks < 2; ++ks) {
                        const bf16x8 f = *(const bf16x8*)(Ks + (16 * kk + fr) * LS + ks * 32 + fq * 8);
                        z = __builtin_amdgcn_mfma_f32_16x16x32_bf16(f, qf[ks], z, 0, 0, 0);
                    }
#pragma unroll
                    for (int e = 0; e < 4; ++e) {
                        const float zz = z[e] * 0.18033688011112042f;
                        const float lsneg = -(fmaxf(zz, 0.f) + __builtin_amdgcn_logf(1.0f + __builtin_amdgcn_exp2f(-fabsf(zz))));
                        if (full) { uu[kk][e] = lsneg; lsp[kk][e] = lsneg + zz; }
                        else {
                            const bool valid = kt * 64 + 16 * kk + 4 * fq + e < query;
                            uu[kk][e] = valid ? lsneg : 0.f;
                            lsp[kk][e] = valid ? lsneg + zz : -1.0e30f;
                        }
                        tot += uu[kk][e];
                    }
                }
                tot += __shfl_xor(tot, 16); tot += __shfl_xor(tot, 32);
                f32x4 rest[4];
#pragma unroll
                for (int st = 0; st < 4; ++st) rest[st] = (f32x4){0.f, 0.f, 0.f, 0.f};
#pragma unroll
                for (int k2 = 0; k2 < 2; ++k2) {
                    u32x4 hi, lo;
#pragma unroll
                    for (int t2 = 0; t2 < 2; ++t2) {
                        const f32x4 a = uu[2 * k2 + t2];
                        const unsigned h0 = pack2(a[0], a[1]), h1 = pack2(a[2], a[3]);
                        hi[2 * t2] = h0; hi[2 * t2 + 1] = h1;
                        lo[2 * t2] = pack2(a[0] - lo_bf(h0), a[1] - hi_bf(h0)); lo[2 * t2 + 1] = pack2(a[2] - lo_bf(h1), a[3] - hi_bf(h1));
                    }
                    const bf16x8 fh = __builtin_bit_cast(bf16x8, hi), fl = __builtin_bit_cast(bf16x8, lo);
#pragma unroll
                    for (int st = 0; st < 4; ++st) {
                        rest[st] = __builtin_amdgcn_mfma_f32_16x16x32_bf16(tri[st][k2], fh, rest[st], 0, 0, 0);
                        rest[st] = __builtin_amdgcn_mfma_f32_16x16x32_bf16(tri[st][k2], fl, rest[st], 0, 0, 0);
                    }
                }
                bf16x8 af[2];
#pragma unroll
                for (int k2 = 0; k2 < 2; ++k2) {
                    u32x4 pk;
#pragma unroll
                    for (int t2 = 0; t2 < 2; ++t2) {
                        const int kk = 2 * k2 + t2;
                        float a4[4];
#pragma unroll
                        for (int e = 0; e < 4; ++e) a4[e] = __builtin_amdgcn_exp2f(lsp[kk][e] + R + rest[kk][e]);
                        pk[2 * t2] = pack2(a4[0], a4[1]); pk[2 * t2 + 1] = pack2(a4[2], a4[3]);
                    }
                    af[k2] = __builtin_bit_cast(bf16x8, pk);
                }
                R += tot;
#pragma unroll
                for (int dt = 0; dt < 4; ++dt)
#pragma unroll
                    for (int k2 = 0; k2 < 2; ++k2) {
                        const int dsw = ((2 * dt + (fr >> 3)) & 7) << 2;
                        const bf16_t* vrow = Vt + (16 * dt + fr) * LS;
                        const u32x2 v0 = *(const u32x2*)(vrow + ((32 * k2 + 4 * fq) ^ dsw)), v1 = *(const u32x2*)(vrow + ((32 * k2 + 16 + 4 * fq) ^ dsw));
                        const bf16x8 f = __builtin_bit_cast(bf16x8, ((u32x4){v0[0], v0[1], v1[0], v1[1]}));
                        ot[dt] = __builtin_amdgcn_mfma_f32_16x16x32_bf16(f, af[k2], ot[dt], 0, 0, 0);
                    }
                done = __all((R < -150.1f) || (query >= L));
            }
            if (kt > 0) {
                bf16_t* Kn = Ks0 + ((itile & 1) ^ 1) * 64 * LS; bf16_t* Vn = Vt0 + ((itile & 1) ^ 1) * 64 * LS;
                *(u32x4*)(Kn + ldkey * LS + lddc) = kreg;
#pragma unroll
                for (int j = 0; j < 4; ++j) { Vn[(lddc + 2 * j) * LS + (ldkey ^ vsw)] = (bf16_t)(vreg[j] & 0xFFFFu); Vn[(lddc + 2 * j + 1) * LS + (ldkey ^ vsw)] = (bf16_t)(vreg[j] >> 16); }
            }
            if (lane == 0) flags[(itile & 1) * 8 + wv] = done ? 1 : 0;
            __syncthreads();
            int alld = 1;
#pragma unroll
            for (int w = 0; w < 8; ++w) alld &= flags[(itile & 1) * 8 + w];
            if (alld || kt == 0) break;
            --kt;
        }
        if (query < L) {
#pragma unroll
            for (int dt = 0; dt < 4; ++dt) *(u32x2*)(p.osb + (tokb + query) * 512 + h * 64 + 16 * dt + 4 * fq) = pk4(ot[dt]);
        }
    }
}

struct EpiBranch {
    static constexpr bool PERM = true;
    const bf16_t* G; bf16_t* M; bool add;
    DI void operator()(const f32x4 (&acc)[2][2][4][2], const g8::Unit& u, int wr, int wc, int fr, int fq) const {
        const int c0 = u.pn * 256 + wc * 32 + 8 * fq;
#pragma unroll
        for (int ai = 0; ai < 2; ++ai) {
            u32x4 g[4][2], mo[4][2];
#pragma unroll
            for (int m = 0; m < 4; ++m)
#pragma unroll
                for (int bj = 0; bj < 2; ++bj) {
                    const size_t r = (size_t)(u.pm * 256 + ai * 128 + wr * 64 + m * 16 + fr);
                    g[m][bj] = *(const u32x4*)(G + r * 2048 + c0 + bj * 128);
                    mo[m][bj] = add ? *(const u32x4*)(M + r * D + c0 + bj * 128) : (u32x4){0u, 0u, 0u, 0u};
                }
#pragma unroll
            for (int m = 0; m < 4; ++m)
#pragma unroll
                for (int bj = 0; bj < 2; ++bj) {
                    const size_t r = (size_t)(u.pm * 256 + ai * 128 + wr * 64 + m * 16 + fr);
                    const f32x4 v0 = acc[ai][bj][m][0], v1 = acc[ai][bj][m][1];
                    const u32x4 gg = g[m][bj], mm = mo[m][bj];
                    float o[8] = {lo_bf(gg[0]) * v0[0], hi_bf(gg[0]) * v0[1], lo_bf(gg[1]) * v0[2], hi_bf(gg[1]) * v0[3], lo_bf(gg[2]) * v1[0], hi_bf(gg[2]) * v1[1], lo_bf(gg[3]) * v1[2], hi_bf(gg[3]) * v1[3]};
#pragma unroll
                    for (int q = 0; q < 4; ++q) { o[2 * q] += lo_bf(mm[q]); o[2 * q + 1] += hi_bf(mm[q]); }
                    *(u32x4*)(M + r * D + c0 + bj * 128) = (u32x4){pack2(o[0], o[1]), pack2(o[2], o[3]), pack2(o[4], o[5]), pack2(o[6], o[7])};
                }
        }
    }
};
struct GateOrder {
    g8::DenseOrder d;
    DI bool next(int i, g8::Unit& u) const { return d.next(i, u); }
    DI unsigned row_off(const g8::Unit&, int) const { return 0u; }
};
struct EpiGate {
    static constexpr bool PERM = true;
    bf16_t* G;
    DI void operator()(const f32x4 (&acc)[2][2][4][2], const g8::Unit& u, int wr, int wc, int fr, int fq) const {
#pragma unroll
        for (int ai = 0; ai < 2; ++ai)
#pragma unroll
            for (int m = 0; m < 4; ++m) {
                bf16_t* rowp = G + (size_t)(u.pm * 256 + ai * 128 + wr * 64 + m * 16 + fr) * 2048 + u.pn * 256 + wc * 32 + 8 * fq;
#pragma unroll
                for (int bj = 0; bj < 2; ++bj) {
                    const f32x4 v0 = acc[ai][bj][m][0], v1 = acc[ai][bj][m][1];
                    *(u32x4*)(rowp + bj * 128) = (u32x4){pack2(sigmoidf_(v0[0]), sigmoidf_(v0[1])), pack2(sigmoidf_(v0[2]), sigmoidf_(v0[3])), pack2(sigmoidf_(v1[0]), sigmoidf_(v1[1])), pack2(sigmoidf_(v1[2]), sigmoidf_(v1[3]))};
                }
            }
    }
};
template <int PART> DI void phase_merge(const Params& p, int layer, int bid, int nb, char* smem) {
    const bf16_t* hb = p.hb; bf16_t* G = p.gates; bf16_t* M = p.merged;
    const bf16_t* Wg = p.WtIn + ((size_t)layer * CIN + CP) * D;
    G8_LAS unsigned char* lds = (G8_LAS unsigned char*)smem;
    if (PART == 0) {
#pragma unroll
    for (int which = 0; which < 2; ++which) {
        g8::DenseOrder S; S.init(hb, Wg + (size_t)which * 1024 * D, MFULL, D / 256, D, nb, bid);
        g8::gemm8<false>(lds, D, S, EpiGate{G + which * 1024});
    }
    }
    if (PART == 1) {
#pragma unroll
    for (int which = 0; which < 2; ++which) {
        const bf16_t* A = which ? p.orw : p.osb;
        const bf16_t* Bt = (which ? p.WtPrw : p.WtPsb) + (size_t)layer * D * 512;
        g8::DenseOrder S; S.init(A, Bt, MFULL, D / 256, 512, nb, bid);
        g8::gemm8<false>(lds, 512, S, EpiBranch{G + which * 1024, M, which != 0});
    }
    }
    if (PART == 1)
    for (int t = left_first(MFULL * 4 * 2, bid, nb); t < D / 128; t += nb) {
#pragma unroll
        for (int which = 0; which < 2; ++which) {
            const bf16_t* A = which ? p.orw : p.osb; const bf16_t* Gw = p.gleft - (size_t)M0_LEFT * 2048 + which * 1024;
            const bf16_t* Bt = (which ? p.WtPrw : p.WtPsb) + (size_t)layer * D * 512;
            gemm_left32([=](int r) { return A + (size_t)(M0_LEFT + r) * 512; }, Bt, 512, 512, t * 128, smem,
                        [=](int r0, int c, f32x4 v) {
                            const size_t r = (size_t)(M0_LEFT + r0);
                            const u32x2 g = *(const u32x2*)(Gw + r * 2048 + c);
                            float o0 = lo_bf(g[0]) * v[0], o1 = hi_bf(g[0]) * v[1], o2 = lo_bf(g[1]) * v[2], o3 = hi_bf(g[1]) * v[3];
                            u32x2* mp = (u32x2*)(M + r * D + c);
                            if (which) { const u32x2 m = *mp; o0 += lo_bf(m[0]); o1 += hi_bf(m[0]); o2 += lo_bf(m[1]); o3 += hi_bf(m[1]); }
                            *mp = (u32x2){pack2(o0, o1), pack2(o2, o3)};
                        });
        }
    }
}
struct EpiOut {
    static constexpr bool PERM = true;
    bf16_t* hb;
    DI void operator()(const f32x4 (&acc)[2][2][4][2], const g8::Unit& u, int wr, int wc, int fr, int fq) const {
        const int c0 = u.pn * 256 + wc * 32 + 8 * fq;
#pragma unroll
        for (int ai = 0; ai < 2; ++ai) {
            u32x4 hv[4][2];
#pragma unroll
            for (int m = 0; m < 4; ++m)
#pragma unroll
                for (int bj = 0; bj < 2; ++bj) hv[m][bj] = *(const u32x4*)(hb + (size_t)(u.pm * 256 + ai * 128 + wr * 64 + m * 16 + fr) * D + c0 + bj * 128);
#pragma unroll
            for (int m = 0; m < 4; ++m)
#pragma unroll
                for (int bj = 0; bj < 2; ++bj) {
                    const u32x4 h = hv[m][bj]; const f32x4 v0 = acc[ai][bj][m][0], v1 = acc[ai][bj][m][1];
                    *(u32x4*)(hb + (size_t)(u.pm * 256 + ai * 128 + wr * 64 + m * 16 + fr) * D + c0 + bj * 128) =
                        (u32x4){pack2(ALPHA * lo_bf(h[0]) + v0[0], ALPHA * hi_bf(h[0]) + v0[1]), pack2(ALPHA * lo_bf(h[1]) + v0[2], ALPHA * hi_bf(h[1]) + v0[3]),
                                pack2(ALPHA * lo_bf(h[2]) + v1[0], ALPHA * hi_bf(h[2]) + v1[1]), pack2(ALPHA * lo_bf(h[3]) + v1[2], ALPHA * hi_bf(h[3]) + v1[3])};
                }
        }
    }
};
DI void phase_outproj(const Params& p, int layer, int bid, int nb, char* smem) {
    const bf16_t* A = p.merged; bf16_t* const hbres = p.hb;
    const bf16_t* Bt = p.WtOut + (size_t)layer * D * D;
    if (bid == 0 && tid_() < NE) p.counts[tid_()] = 0;
    g8::DenseOrder S; S.init(A, Bt, MFULL, D / 256, D, nb, bid);
    g8::gemm8<false>((G8_LAS unsigned char*)smem, D, S, EpiOut{hbres});
    for (int t = left_first(MFULL * 4, bid, nb); t < D / 128; t += nb)
        gemm_left32([=](int r) { return A + (size_t)(M0_LEFT + r) * D; }, Bt, D, D, t * 128, smem,
                    [=](int r0, int c, f32x4 v) {
                        const int r = M0_LEFT + r0;
                        u32x2* hp = (u32x2*)(hbres + (size_t)r * D + c);
                        const f32x4 h = up4(*hp);
                        *hp = (u32x2){pack2(ALPHA * h[0] + v[0], ALPHA * h[1] + v[1]), pack2(ALPHA * h[2] + v[2], ALPHA * h[3] + v[3])};
                    });
}

constexpr int LN1_ROWB = 2 * D + 16;
constexpr int LN1_WAVE = 8 * LN1_ROWB;
constexpr int LN1_LDS = 8 * LN1_WAVE + 2048;
DI void phase_ln1_router(const Params& p, int layer, int bid, int nb, char* smem) {
    const int tid = tid_(), lane = tid & 63, wid = __builtin_amdgcn_readfirstlane(tid >> 6), fr = lane & 15, fq = lane >> 4;
    char* wl = smem + wid * LN1_WAVE;
    int* sel = (int*)(smem + 8 * LN1_WAVE);
    float* sgt = (float*)(smem + 8 * LN1_WAVE + 640);
    int* sbase = (int*)(smem + 8 * LN1_WAVE + 1280);
    const int nwaves = nb * 8, gw = bid * 8 + wid;
    const int base_n = T / nwaves, extra = T % nwaves;
    const int tok0 = gw * base_n + (gw < extra ? gw : extra), ntok = base_n + (gw < extra ? 1 : 0);
    const int btok0 = bid * 8 * base_n + (bid * 8 < extra ? bid * 8 : extra);
    const float* g1p = p.ln1_g + layer * D; const float* b1p = p.ln1_b + layer * D;
    __syncthreads();
    for (int g0 = 0; g0 < ntok; g0 += 8) {
        const int ng = ntok - g0 < 8 ? ntok - g0 : 8;
        float vn[16];
        { const bf16_t* hf = p.hb + (size_t)(tok0 + g0) * D;
#pragma unroll
          for (int j = 0; j < 4; ++j) { const f32x4 a = up4(*(const u32x2*)(hf + 256 * j + 4 * lane)); vn[4 * j] = a[0]; vn[4 * j + 1] = a[1]; vn[4 * j + 2] = a[2]; vn[4 * j + 3] = a[3]; } }
#pragma unroll 1
        for (int i = 0; i < ng; ++i) {
            const int tok = tok0 + g0 + i;
            float v[16];
#pragma unroll
            for (int q = 0; q < 16; ++q) v[q] = vn[q];
            if (i + 1 < ng) { const bf16_t* hn = p.hb + (size_t)(tok + 1) * D;
#pragma unroll
                for (int j = 0; j < 4; ++j) { const f32x4 a = up4(*(const u32x2*)(hn + 256 * j + 4 * lane)); vn[4 * j] = a[0]; vn[4 * j + 1] = a[1]; vn[4 * j + 2] = a[2]; vn[4 * j + 3] = a[3]; } }
            ln16(v, g1p, b1p, lane);
#pragma unroll
            for (int j = 0; j < 4; ++j) {
                const unsigned h0 = pack2(v[4 * j], v[4 * j + 1]), h1 = pack2(v[4 * j + 2], v[4 * j + 3]);
                *(u32x2*)(p.hb + (size_t)tok * D + 256 * j + 4 * lane) = (u32x2){h0, h1};
                *(u32x2*)(wl + i * LN1_ROWB + (256 * j + 4 * lane) * 2) = (u32x2){h0, h1};
            }
        }
        asm volatile("s_waitcnt lgkmcnt(0)" ::: "memory");
        __builtin_amdgcn_wave_barrier();
        f32x4 acc[2] = {(f32x4){0.f, 0.f, 0.f, 0.f}, (f32x4){0.f, 0.f, 0.f, 0.f}};
        const char* arow = wl + (fr & 7) * LN1_ROWB + fq * 16;
        const bf16_t* whi = p.RwHi + (size_t)fr * D + fq * 8;
#pragma unroll 4
        for (int ks = 0; ks < 32; ++ks) {
            const bf16x8 ah = *(const bf16x8*)(arow + ks * 64);
            const bf16x8 bh = *(const bf16x8*)(whi + ks * 32);
            acc[ks & 1] = __builtin_amdgcn_mfma_f32_16x16x32_bf16(bh, ah, acc[ks & 1], 0, 0, 0);
        }
        float lg[4]; float mx = -3.0e38f;
#pragma unroll
        for (int e = 0; e < 4; ++e) { lg[e] = acc[0][e] + acc[1][e] + p.router_b[4 * fq + e]; mx = fmaxf(mx, lg[e]); }
        mx = fmaxf(mx, __shfl_xor(mx, 16)); mx = fmaxf(mx, __shfl_xor(mx, 32));
        float sum = 0.f;
#pragma unroll
        for (int e = 0; e < 4; ++e) { lg[e] = __expf(lg[e] - mx); sum += lg[e]; }
        sum += __shfl_xor(sum, 16); sum += __shfl_xor(sum, 32);
        const float inv = 1.0f / sum;
        float v1 = -1.f, v2 = -1.f; int i1 = 0, i2 = 0;
#pragma unroll
        for (int e = 0; e < 4; ++e) {
            const float pv = lg[e] * inv;
            if (pv > v1) { v2 = v1; i2 = i1; v1 = pv; i1 = e; } else if (pv > v2) { v2 = pv; i2 = e; }
        }
        const float sc = v1 + v2;
        float bsc = sc; int bg = fq;
#pragma unroll
        for (int m = 16; m <= 32; m <<= 1) {
            const float os = __shfl_xor(bsc, m); const int og = __shfl_xor(bg, m);
            if (os > bsc || (os == bsc && og < bg)) { bsc = os; bg = og; }
        }
        if (bg == fq && fr < ng) {
            const int li = tok0 + g0 + fr - btok0;
            const float gs = 1.0f / (v1 + v2);
            sel[li * 2] = 4 * fq + i1; sel[li * 2 + 1] = 4 * fq + i2; sgt[li * 2] = v1 * gs; sgt[li * 2 + 1] = v2 * gs;
        }
        asm volatile("s_waitcnt lgkmcnt(0)" ::: "memory");
        __builtin_amdgcn_wave_barrier();
    }
    __syncthreads();
    if (wid == 0) {
        const int nbt = 8 * base_n + ((bid * 8 + 8 <= extra) ? 8 : (bid * 8 < extra ? extra - bid * 8 : 0));
        for (int c0 = 0; c0 < nbt; c0 += 64) {
            const int li = c0 + lane; const bool on = li < nbt;
            const int e1 = on ? sel[li * 2] : -1, e2 = on ? sel[li * 2 + 1] : -1;
            const unsigned long long lt = (1ull << lane) - 1ull;
            int r1 = 0, r2 = 0, mycnt = 0;
#pragma unroll
            for (int e = 0; e < NE; ++e) {
                const unsigned long long m1 = __ballot(e1 == e), m2 = __ballot(e2 == e);
                const int c1 = __popcll(m1), c2 = __popcll(m2);
                if (e1 == e) r1 = __popcll(m1 & lt);
                if (e2 == e) r2 = c1 + __popcll(m2 & lt);
                if (lane == e) mycnt = c1 + c2;
            }
            if (lane < NE) sbase[lane] = mycnt > 0 ? atomicAdd(&p.counts[lane], mycnt) : 0;
            asm volatile("s_waitcnt vmcnt(0) lgkmcnt(0)" ::: "memory");
            __builtin_amdgcn_wave_barrier();
            if (on) {
                const int tok = btok0 + li;
                const int s1 = sbase[e1] + r1, s2 = sbase[e2] + r2;
                p.list[e1 * T + s1] = tok * 2; p.list[e2 * T + s2] = tok * 2 + 1;
                p.tokg[tok * 2] = sgt[li * 2]; p.tokg[tok * 2 + 1] = sgt[li * 2 + 1];
            }
            asm volatile("s_waitcnt lgkmcnt(0)" ::: "memory");
            __builtin_amdgcn_wave_barrier();
        }
    }
}

constexpr int MOE_BIG = 8;
template <bool UP> struct MoeOrder {
    const int* counts; const int* list; int G, c; const char* A; const char* B;
    DI bool next(int i, g8::Unit& u) const {
        const int xcd = c & 7, w = c >> 3, mt = (w >> 1) & 7, pn = 2 * (w & 1) + i, esel = xcd + 8 * (w >> 4);
        if (w >= 32 || i >= 2) return false;
        int padp = 0, fe = -1, fc = 0, fp = 0;
#pragma unroll
        for (int e = 0; e < NE; ++e) {
            const int cn = counts[e], ntp = (cn + 255) >> 8, nt = ntp < MOE_BIG ? ntp : MOE_BIG;
            const bool hit = (e == esel) && (mt < nt);
            fe = hit ? e : fe; fc = hit ? cn : fc; fp = hit ? padp + mt : fp;
            padp += ntp;
        }
        fe = __builtin_amdgcn_readfirstlane(fe); fc = __builtin_amdgcn_readfirstlane(fc); fp = __builtin_amdgcn_readfirstlane(fp);
        if (fe < 0) return false;
        u.e = fe; u.slot0 = mt * 256; u.cnt = fc; u.pm = fp; u.pn = pn;
        u.A = UP ? A : A + (size_t)fp * ((size_t)256 * DE * 2);
        u.B = UP ? B + (size_t)fe * ((size_t)1024 * 1024 * 2) + (size_t)pn * ((size_t)256 * D * 2) : B + (size_t)fe * ((size_t)1024 * 512 * 2) + (size_t)pn * ((size_t)256 * DE * 2);
        return true;
    }
    DI unsigned row_off(const g8::Unit& u, int r) const {
        const __amdgpu_buffer_rsrc_t rs = __builtin_amdgcn_make_buffer_rsrc((void*)list, 0, NE * T * 4, 0x00020000);
        const int ent = __builtin_amdgcn_raw_buffer_load_b32(rs, r * 4, (u.e * T + u.slot0) * 4, 0);
        return u.slot0 + r < u.cnt ? (unsigned)(ent >> 1) * (unsigned)(D * 2) : 0u;
    }
};
struct EpiMoeUp {
    static constexpr bool PERM = true;
    bf16_t* hid;
    DI void operator()(const f32x4 (&acc)[2][2][4][2], const g8::Unit& u, int wr, int wc, int fr, int fq) const {
#pragma unroll
        for (int ai = 0; ai < 2; ++ai)
#pragma unroll
            for (int m = 0; m < 4; ++m) {
                const int r = ai * 128 + wr * 64 + m * 16 + fr;
                if (u.slot0 + r >= u.cnt) continue;
                bf16_t* rowp = hid + ((size_t)u.pm * 256 + r) * DE + ((u.pn * 256 + wc * 32 + 8 * fq) >> 1);
#pragma unroll
                for (int bj = 0; bj < 2; ++bj) {
                    const f32x4 v0 = acc[ai][bj][m][0], v1 = acc[ai][bj][m][1];
                    *(u32x2*)(rowp + bj * 64) = (u32x2){pack2(v0[0] * sigmoidf_(v0[0]) * v0[1], v0[2] * sigmoidf_(v0[2]) * v0[3]), pack2(v1[0] * sigmoidf_(v1[0]) * v1[1], v1[2] * sigmoidf_(v1[2]) * v1[3])};
                }
            }
    }
};
struct EpiMoeDown {
    static constexpr bool PERM = true;
    bf16_t* fo; const int* list; const float* tokg;
    DI void operator()(const f32x4 (&acc)[2][2][4][2], const g8::Unit& u, int wr, int wc, int fr, int fq) const {
        int ent[8]; float g[8];
#pragma unroll
        for (int q = 0; q < 8; ++q) {
            const int sl = u.slot0 + (q >> 2) * 128 + wr * 64 + (q & 3) * 16 + fr;
            ent[q] = sl < u.cnt ? list[u.e * T + sl] : -1;
        }
#pragma unroll
        for (int q = 0; q < 8; ++q) g[q] = ent[q] >= 0 ? tokg[ent[q]] : 0.f;
#pragma unroll
        for (int ai = 0; ai < 2; ++ai)
#pragma unroll
            for (int m = 0; m < 4; ++m) {
                const int q = ai * 4 + m;
                if (ent[q] < 0) continue;
                const float gg = g[q];
                bf16_t* rowp = fo + ((size_t)(ent[q] & 1) * TP + (ent[q] >> 1)) * D + u.pn * 256 + wc * 32 + 8 * fq;
#pragma unroll
                for (int bj = 0; bj < 2; ++bj) {
                    const f32x4 v0 = acc[ai][bj][m][0], v1 = acc[ai][bj][m][1];
                    *(u32x4*)(rowp + bj * 128) = (u32x4){pack2(gg * v0[0], gg * v0[1]), pack2(gg * v0[2], gg * v0[3]), pack2(gg * v1[0], gg * v1[1]), pack2(gg * v1[2], gg * v1[3])};
                }
            }
    }
};
DI void phase_moe_up(const Params& p, int bid, int nb, char* smem) {
    const MoeOrder<true> S{p.counts, p.list, nb, bid, (const char*)p.hb, (const char*)p.WtGU};
    g8::gemm8<true>((G8_LAS unsigned char*)smem, D, S, EpiMoeUp{p.hid});
    const bf16_t* hb = p.hb; bf16_t* hid = p.hid; const int* list = p.list;
    int big = 0, padr = 0, job = 0;
#pragma unroll 1
    for (int e = 0; e < NE; ++e) { const int cn = p.counts[e], ntp = (cn + 255) >> 8; big += (ntp < MOE_BIG ? ntp : MOE_BIG) * 4; }
    const int mine = bid; (void)big;
#pragma unroll 1
    for (int e = 0; e < NE; ++e) {
        const int cn = p.counts[e];
        for (int s0 = MOE_BIG * 256; s0 < cn; s0 += 128)
            for (int nt = 0; nt < 8; ++nt, ++job)
                if (job % nb == mine) {
                    const int prow = padr;
                    gemm_tile128([=](int r) { const int sl = s0 + r; return sl < cn ? hb + (size_t)(list[e * T + sl] >> 1) * D : (const bf16_t*)nullptr; },
                                 p.WtGU + (size_t)e * 1024 * 1024, D, D, 0, nt * 128, smem,
                                 [=](int r, int c, f32x4 v) {
                                     const int sl = s0 + r;
                                     if (sl >= cn) return;
                                     *(unsigned*)(hid + (size_t)(prow + sl) * DE + (c >> 1)) = pack2(v[0] * sigmoidf_(v[0]) * v[1], v[2] * sigmoidf_(v[2]) * v[3]);
                                 });
                }
        padr += ((cn + 255) >> 8) * 256;
    }
}
DI void phase_moe_down(const Params& p, int bid, int nb, char* smem) {
    const MoeOrder<false> S{p.counts, p.list, nb, bid, (const char*)p.hid, (const char*)p.WtD};
    g8::gemm8<false>((G8_LAS unsigned char*)smem, DE, S, EpiMoeDown{p.fo, p.list, p.tokg});
    const bf16_t* hid = p.hid; bf16_t* fo = p.fo; const int* list = p.list; const float* tokg = p.tokg;
    int big = 0, padr = 0, job = 0;
#pragma unroll 1
    for (int e = 0; e < NE; ++e) { const int cn = p.counts[e], ntp = (cn + 255) >> 8; big += (ntp < MOE_BIG ? ntp : MOE_BIG) * 4; }
    const int mine = bid; (void)big;
#pragma unroll 1
    for (int e = 0; e < NE; ++e) {
        const int cn = p.counts[e];
        for (int s0 = MOE_BIG * 256; s0 < cn; s0 += 128)
            for (int nt = 0; nt < 8; ++nt, ++job)
                if (job % nb == mine) {
                    const int prow = padr;
                    gemm_tile128([=](int r) { const int sl = s0 + r; return sl < cn ? hid + (size_t)(prow + sl) * DE : (const bf16_t*)nullptr; },
                                 p.WtD + (size_t)e * 1024 * 512, DE, DE, 0, nt * 128, smem,
                                 [=](int r, int c, f32x4 v) {
                                     const int sl = s0 + r;
                                     if (sl >= cn) return;
                                     const int ent = list[e * T + sl];
                                     const float g = tokg[ent];
                                     *(u32x2*)(fo + ((size_t)(ent & 1) * TP + (ent >> 1)) * D + c) = (u32x2){pack2(g * v[0], g * v[1]), pack2(g * v[2], g * v[3])};
                                 });
                }
        padr += ((cn + 255) >> 8) * 256;
    }
}
DI void phase_ln2(const Params& p, int layer, int bid, int nb) {
    const int lane = tid_() & 63, wid = __builtin_amdgcn_readfirstlane(tid_() >> 6);
    const int nwaves = nb * 8, gw = bid * 8 + wid, base_n = T / nwaves, extra = T % nwaves;
    const int tok0 = gw * base_n + (gw < extra ? gw : extra), ntok = base_n + (gw < extra ? 1 : 0);
    u32x2 an[4], f0n[4], f1n[4];
    {
#pragma unroll
        for (int j = 0; j < 4; ++j) {
            an[j] = *(const u32x2*)(p.hb + (size_t)tok0 * D + 256 * j + 4 * lane);
            f0n[j] = *(const u32x2*)(p.fo + (size_t)tok0 * D + 256 * j + 4 * lane); f1n[j] = *(const u32x2*)(p.fo + ((size_t)TP + tok0) * D + 256 * j + 4 * lane);
        }
    }
#pragma unroll 1
    for (int i = 0; i < ntok; ++i) {
        const int tok = tok0 + i;
        float v[16];
#pragma unroll
        for (int j = 0; j < 4; ++j) {
            v[4 * j] = ALPHA * lo_bf(an[j][0]) + lo_bf(f0n[j][0]) + lo_bf(f1n[j][0]); v[4 * j + 1] = ALPHA * hi_bf(an[j][0]) + hi_bf(f0n[j][0]) + hi_bf(f1n[j][0]);
            v[4 * j + 2] = ALPHA * lo_bf(an[j][1]) + lo_bf(f0n[j][1]) + lo_bf(f1n[j][1]); v[4 * j + 3] = ALPHA * hi_bf(an[j][1]) + hi_bf(f0n[j][1]) + hi_bf(f1n[j][1]);
        }
        if (i + 1 < ntok) {
#pragma unroll
            for (int j = 0; j < 4; ++j) {
                an[j] = *(const u32x2*)(p.hb + (size_t)(tok + 1) * D + 256 * j + 4 * lane);
                f0n[j] = *(const u32x2*)(p.fo + (size_t)(tok + 1) * D + 256 * j + 4 * lane); f1n[j] = *(const u32x2*)(p.fo + ((size_t)TP + tok + 1) * D + 256 * j + 4 * lane);
            }
        }
        ln16(v, p.ln2_g + layer * D, p.ln2_b + layer * D, lane);
        if (layer == DEPTH - 1) {
            float* of = hrow_u(p, tok);
#pragma unroll
            for (int j = 0; j < 4; ++j) *(f32x4*)(of + 256 * j + 4 * lane) = (f32x4){v[4 * j], v[4 * j + 1], v[4 * j + 2], v[4 * j + 3]};
        } else store_row_bf(p.hb + (size_t)tok * D, v, lane);
    }
}

extern __shared__ __attribute__((aligned(16))) char dyn_smem[];
constexpr int SMEM_MAIN = R1_LDS > GEMM_LDS ? R1_LDS : GEMM_LDS;
constexpr int SMEM_BYTES = SMEM_MAIN + 16;

__global__ void __launch_bounds__(NTHR, 2) k_forward(Params p) {
    const int bid = blockIdx.x, nb = gridDim.x;
    char* smem = dyn_smem;
    uint4* xbw = (uint4*)(dyn_smem + SMEM_MAIN);
    if (threadIdx.x == 0) *xbw = make_uint4(0u, 0u, 0u, 0u);
    __syncthreads();
    XcdBarrier bar = xcd_barrier_post(p.bar, (volatile LAS unsigned*)xbw);
    phase_prologue_weights(p, bid, nb, smem);
    phase_embed(p, bid, nb);
    xcd_barrier(bar);
    for (int l = 0; l < DEPTH; ++l) {
        phase_inproj(p, l, bid, nb, smem);
        xcd_barrier(bar);
        phase_rwkv_r1<0>(p, l, bid, nb, smem);
        xcd_barrier(bar);
        if (bid < 16) { const int cw = __builtin_amdgcn_readfirstlane(tid_() >> 6); if (cw < 4) phase_rwkv_r2(p, bid * 4 + cw); }
        else {
            const int sbid = bid - 16, snb = nb - 16, heavy = (NBATCH * HEADS * ((L + 127) / 128)) % snb;
            if (sbid >= heavy && sbid < heavy + NBATCH * HEADS) phase_rwkv_r1<1>(p, l, sbid - heavy, 1, smem);
            phase_sb(p, sbid, snb, smem);
        }
        xcd_barrier(bar);
        phase_rwkv_r3(p, l, bid, nb);
        convert_experts(p, l, NE / 2, NE, bid, nb, smem);
        phase_merge<0>(p, l, bid, nb, smem);
        xcd_barrier(bar);
        phase_merge<1>(p, l, bid, nb, smem);
        xcd_barrier(bar);
        phase_outproj(p, l, bid, nb, smem);
        xcd_barrier(bar);
        phase_ln1_router(p, l, bid, nb, smem);
        xcd_barrier(bar);
        phase_moe_up(p, bid, nb, smem);
        xcd_barrier(bar);
        phase_moe_down(p, bid, nb, smem);
        xcd_barrier(bar);
        phase_ln2(p, l, bid, nb);
        xcd_barrier(bar);
    }
}

extern "C" void kernel_launch(void* const* d_in, const int* in_sizes, int n_in, void* d_out, int out_size, void* d_ws, size_t ws_size, hipStream_t stream) {
    (void)in_sizes; (void)n_in; (void)out_size;
    Params p;
    memset(&p, 0, sizeof(p));
    const float* const* in = (const float* const*)d_in;
    p.x = in[0]; p.meta = in[1]; p.emb_g = in[2]; p.emb_b = in[3]; p.w_in = in[4]; p.mu = in[5]; p.w0 = in[6]; p.w_up = in[7]; p.a0 = in[8]; p.a_up = in[9];
    p.g_up = in[10]; p.k_k = in[11]; p.k_a = in[12]; p.r_k = in[13]; p.lnx_g = in[14]; p.lnx_b = in[15]; p.p_sb = in[16]; p.p_rwkv = in[17]; p.w_out = in[18];
    p.ln1_g = in[19]; p.ln1_b = in[20]; p.router_w = in[21]; p.router_b = in[22]; p.ew_gate = in[23]; p.ew_up = in[24]; p.ew_down = in[25]; p.ln2_g = in[26]; p.ln2_b = in[27];
    p.out = (float*)d_out;
    char* ws = (char*)d_ws; size_t o = 0;
    auto take = [&](size_t bytes) { char* r = ws + o; o += (bytes + 255) & ~(size_t)255; return r; };
    p.bar = (unsigned*)take(XCD_BAR_WORDS * sizeof(unsigned));
    p.counts = (int*)take(256);
    p.WtIn = (bf16_t*)take((size_t)DEPTH * CIN * D * 2);
    p.WtPsb = (bf16_t*)take((size_t)DEPTH * D * 512 * 2);
    p.WtPrw = (bf16_t*)take((size_t)DEPTH * D * 512 * 2);
    p.WtOut = (bf16_t*)take((size_t)DEPTH * D * D * 2);
    p.WupT = (bf16_t*)take((size_t)DEPTH * 512 * 64 * 2);
    p.AupT = (bf16_t*)take((size_t)DEPTH * 512 * 64 * 2);
    p.GupT = (bf16_t*)take((size_t)DEPTH * 512 * 128 * 2);
    p.RwHi = (bf16_t*)take((size_t)NE * D * 2);
    p.gleft = (bf16_t*)take((size_t)32 * 2048 * 2);
    {
        const size_t ub = (size_t)NUNIT * 64 * 64 * 2;
        p.WtGU = (bf16_t*)take((size_t)NE * 1024 * 1024 * 2);
        p.WtD = (bf16_t*)take((size_t)NE * 1024 * 512 * 2);
        p.PcG = (bf16_t*)d_out; p.QcG = (bf16_t*)((char*)d_out + ub); p.RhG = (bf16_t*)((char*)d_out + 2 * ub);
        p.Y0G = (bf16_t*)take(ub); p.GG = (bf16_t*)take(ub); p.SG = (bf16_t*)take(ub);
        p.bonG = (float*)take((size_t)NUNIT * 64 * 4);
    }
    p.hb = (bf16_t*)take((size_t)TP * D * 2);
    p.hmeta = (float*)take((size_t)NBATCH * NMETA * D * 4);
    p.P = (bf16_t*)take((size_t)TP * CP * 2);
    p.osb = (bf16_t*)take((size_t)TP * 512 * 2);
    p.orw = (bf16_t*)take((size_t)TP * 512 * 2);
    p.list = (int*)take((size_t)NE * T * 4);
    p.tokg = (float*)take((size_t)T * 2 * 4);
    p.gates = p.P;
    p.merged = p.P + (size_t)TP * 2048;
    p.hid = p.P;
    p.fo = p.P + (size_t)(2 * T + 16 * 256) * DE;
    if (o > ws_size) return;
    static int grid = 0;
    if (!grid) {
        int dev = 0, cus = 0, per_cu = 0;
        (void)hipGetDevice(&dev);
        (void)hipDeviceGetAttribute(&cus, hipDeviceAttributeMultiprocessorCount, dev);
        (void)hipFuncSetAttribute((const void*)k_forward, hipFuncAttributeMaxDynamicSharedMemorySize, SMEM_BYTES);
        (void)hipOccupancyMaxActiveBlocksPerMultiprocessor(&per_cu, k_forward, NTHR, SMEM_BYTES);
        grid = per_cu >= 1 ? cus : 0;
    }
    if (!grid) return;
    (void)hipMemsetAsync(p.bar, 0, XCD_BAR_WORDS * sizeof(unsigned), stream);
    hipLaunchKernelGGL(k_forward, dim3(grid), dim3(NTHR), SMEM_BYTES, stream, p);
}
```

```cpp
#include <hip/hip_runtime.h>
#include <stdint.h>
#include <string.h>

#define DI __device__ __forceinline__
typedef unsigned short bf16_t;
typedef short bf16x8 __attribute__((ext_vector_type(8)));
typedef float f32x4 __attribute__((ext_vector_type(4)));
typedef unsigned u32x4 __attribute__((ext_vector_type(4)));
typedef unsigned u32x2 __attribute__((ext_vector_type(2)));

constexpr int D = 1024, NBATCH = 2, SEQ = 8192, NMETA = 16, L = SEQ + NMETA, T = NBATCH * L, TP = 16640;
constexpr int DEPTH = 2, HEADS = 8, HD = 64;
constexpr int CIN = 5376, CP = 3328;
constexpr int OFF_Q = 0, OFF_K = 512, OFF_V = 1024, OFF_RW = 1536;
constexpr int RW_R = 0, RW_K = 512, RW_V = 1024, RW_WD = 1536, RW_AD = 1600, RW_GD = 1664, RSW = 1792;
constexpr int NE = 16, DE = 512;
constexpr float ALPHA = 1.41421356237309515f;
constexpr float DECAY_SCALE = 0.60653065971263342f;
constexpr int NTHR = 512;

#define XB_TMO      128
#define XB_XCNT(j)  (256  + 64 * (j))
#define XB_XSUB(j)  (1280 + 64 * (j))
#define XB_XGEN(j)  (2304 + 64 * (j))
#define XB_TOP      3328
#define XB_TOPGEN   3392
#define XCD_BAR_WORDS 3456
#define XB_SPIN_CAP (1u << 18)
#define LAS __attribute__((address_space(3)))

__device__ __forceinline__ unsigned xb_ld(unsigned* p)              { return __hip_atomic_load(p, __ATOMIC_RELAXED, __HIP_MEMORY_SCOPE_AGENT); }
__device__ __forceinline__ unsigned xb_add(unsigned* p, unsigned v) { return __hip_atomic_fetch_add(p, v, __ATOMIC_RELAXED, __HIP_MEMORY_SCOPE_AGENT); }
__device__ __forceinline__ unsigned xb_xcc_id() { return (unsigned)__builtin_amdgcn_s_getreg((3 << 11) | 20) & 0xFu; }
#define XB_SPIN(cond, bar) do { unsigned _sp = 0; while (cond) { __builtin_amdgcn_s_sleep(1); \
    if ((++_sp & 255u) == 0u) { if (xb_ld(&(bar)[XB_TMO])) break; if (_sp > XB_SPIN_CAP) { atomicAdd(&(bar)[XB_TMO], 1u); break; } } } } while (0)

struct XcdBarrier {
    unsigned* bar; unsigned x;
    volatile LAS unsigned* st;
};

__device__ __forceinline__ XcdBarrier xcd_barrier_post(unsigned* bar, volatile LAS unsigned* st) {
    XcdBarrier b; b.bar = bar; b.x = xb_xcc_id(); b.st = st;
    if (threadIdx.x == 0) (void)xb_add(&bar[XB_XCNT(b.x)], 1u);
    return b;
}
__device__ __forceinline__ void xcd_barrier_complete(unsigned* bar, unsigned x, unsigned& nloc, unsigned& nx) {
    const unsigned G = gridDim.x * gridDim.y * gridDim.z;
    unsigned sum, cnt, mine, sp = 0u;
    for (;;) {
        sum = 0u; cnt = 0u; mine = 0u;
#pragma unroll
        for (unsigned j = 0; j < 16; ++j) { const unsigned c = xb_ld(&bar[XB_XCNT(j)]); sum += c; cnt += (c > 0u) ? 1u : 0u; mine = (j == x) ? c : mine; }
        if (sum == G) break;
        __builtin_amdgcn_s_sleep(1);
        if ((++sp & 255u) == 0u) { if (xb_ld(&bar[XB_TMO])) break; if (sp > XB_SPIN_CAP) { atomicAdd(&bar[XB_TMO], 1u); break; } }
    }
    nloc = mine > 0u ? mine : 1u; nx = cnt > 0u ? cnt : 1u;
}

__device__ __forceinline__ void xcd_barrier(const XcdBarrier& b) {
    asm volatile("s_waitcnt vmcnt(0)" ::: "memory");
    __syncthreads();
    if (threadIdx.x == 0) {
        unsigned* bar = b.bar;
        unsigned bx = b.x; asm volatile("" : "+s"(bx));
        __builtin_amdgcn_s_waitcnt(0);
        unsigned nloc = b.st[0], nx = b.st[1];
        if (nloc == 0u) { xcd_barrier_complete(bar, bx, nloc, nx); b.st[0] = nloc; b.st[1] = nx; }
        const unsigned old = xb_add(&bar[XB_XSUB(bx)], 1u);
        const unsigned gen = old / nloc;
        if (old + 1u == (gen + 1u) * nloc) {
            __builtin_amdgcn_fence(__ATOMIC_RELEASE, "agent");
            asm volatile("s_waitcnt vmcnt(0)" ::: "memory");
            const unsigned og = xb_add(&bar[XB_TOP], 1u);
            const unsigned tg = og / nx;
            if (og + 1u == (tg + 1u) * nx) xb_add(&bar[XB_TOPGEN], 1u);
            else XB_SPIN(xb_ld(&bar[XB_TOPGEN]) == tg, bar);
            __builtin_amdgcn_fence(__ATOMIC_ACQUIRE, "agent");
            xb_add(&bar[XB_XGEN(bx)], 1u);
            asm volatile("s_waitcnt vmcnt(0)" ::: "memory");
        } else {
            XB_SPIN(xb_ld(&bar[XB_XGEN(bx)]) == gen, bar);
            __builtin_amdgcn_fence(__ATOMIC_ACQUIRE, "agent");
            asm volatile("s_waitcnt vmcnt(0)" ::: "memory");
        }
    }
    __syncthreads();
}


struct Params {
    const float *x, *meta, *emb_g, *emb_b, *w_in, *mu, *w0, *w_up, *a0, *a_up, *g_up, *k_k, *k_a, *r_k, *lnx_g, *lnx_b, *p_sb, *p_rwkv, *w_out,
        *ln1_g, *ln1_b, *router_w, *router_b, *ew_gate, *ew_up, *ew_down, *ln2_g, *ln2_b;
    float* out;
    unsigned* bar;
    int* counts;
    bf16_t *WtIn, *WtPsb, *WtPrw, *WtOut, *WtGU, *WtD, *hb, *P, *osb, *orw, *WupT, *AupT, *GupT;
    bf16_t *PcG, *QcG, *RhG, *Y0G, *GG, *SG;
    bf16_t *RwHi, *gleft;
    float* bonG;
    float* hmeta;
    bf16_t *gates, *merged, *hid, *fo;
    int* list;
    float* tokg;
};

DI float bf2f(bf16_t v) { return __uint_as_float((unsigned)v << 16); }
typedef __bf16 bf16x2_t __attribute__((ext_vector_type(2)));
DI bf16_t f2bf(float f) { return __builtin_bit_cast(bf16_t, (__bf16)f); }
DI unsigned pack2(float lo, float hi) { bf16x2_t v = {(__bf16)lo, (__bf16)hi}; return __builtin_bit_cast(unsigned, v); }
DI float lo_bf(unsigned u) { return __uint_as_float(u << 16); }
DI float hi_bf(unsigned u) { return __uint_as_float(u & 0xFFFF0000u); }
template <int CTRL> DI float dpp_mov(float v) { return __builtin_bit_cast(float, __builtin_amdgcn_update_dpp(0, __builtin_bit_cast(int, v), CTRL, 0xF, 0xF, true)); }
DI float sum8(float v) {
    v += dpp_mov<0xB1>(v);
    v += dpp_mov<0x4E>(v);
    v += dpp_mov<0x141>(v);
    return v;
}
DI float sum16(float v) { v = sum8(v); v += dpp_mov<0x140>(v); return v; }
DI float wave_sum(float v) { v = sum16(v); v += __shfl_xor(v, 16); v += __shfl_xor(v, 32); return v; }
struct Params;
DI const Params& kparams() {
    auto k = __builtin_amdgcn_kernarg_segment_ptr();
    asm volatile("" : "+s"(k));
    return *(const Params*)k;
}
DI int tid_() { int t = threadIdx.x; asm volatile("" : "+v"(t)); return t; }
DI float sigmoidf_(float x) { return __builtin_amdgcn_rcpf(1.0f + __expf(-x)); }
DI float tanhf_(float x) { return 1.0f - 2.0f * __builtin_amdgcn_rcpf(1.0f + __expf(2.0f * x)); }

DI float* hrow2(float* hmeta, float* out, int tok) {
    const int b = tok >= L ? 1 : 0, t = tok - b * L;
    const unsigned long long am = (unsigned long long)(hmeta + (long long)(b * NMETA + t) * D), ao = (unsigned long long)(out + ((long long)b * SEQ + (t - NMETA)) * D);
    const unsigned long long m = 0ull - (unsigned long long)(t < NMETA);
    return (float*)((am & m) | (ao & ~m));
}
DI float* hrow(const Params& p, int tok) { return hrow2(p.hmeta, p.out, tok); }
DI float* hrow_u(const Params& p, int tok) { return hrow2(p.hmeta, p.out, __builtin_amdgcn_readfirstlane(tok)); }

DI void transpose_convert(const float* __restrict__ src, int ld, int K, int N, bf16_t* __restrict__ dst, int mult, int off, int bid, int nb, char* smem, int& rot) {
    float* tile = (float*)smem;
    const int tk = K / 64, tn = N / 256, tid = tid_();
    const int first = (bid - rot % nb + nb) % nb;
    rot += tk * tn;
    for (int t = first; t < tk * tn; t += nb) {
        const int k0 = (t / tn) * 64, n0 = (t % tn) * 256;
        f32x4 v[4][2];
#pragma unroll
        for (int q = 0; q < 4; ++q)
#pragma unroll
            for (int i = 0; i < 2; ++i) v[q][i] = *(const f32x4*)(src + (size_t)(k0 + (tid >> 4) + 32 * i) * ld + n0 + q * 64 + (tid & 15) * 4);
        __syncthreads();
#pragma unroll
        for (int q = 0; q < 4; ++q)
#pragma unroll
            for (int i = 0; i < 2; ++i) {
                float* tp = tile + q * 64 * 65 + ((tid >> 4) + 32 * i) * 65 + (tid & 15) * 4;
                tp[0] = v[q][i][0]; tp[1] = v[q][i][1]; tp[2] = v[q][i][2]; tp[3] = v[q][i][3];
            }
        __syncthreads();
        const int n = tid >> 3, kc = (tid & 7) * 8;
#pragma unroll
        for (int q = 0; q < 4; ++q) {
            const float* tq = tile + q * 64 * 65;
            u32x4 o;
#pragma unroll
            for (int jj = 0; jj < 4; ++jj) o[jj] = pack2(tq[(kc + 2 * jj) * 65 + n], tq[(kc + 2 * jj + 1) * 65 + n]);
            *(u32x4*)(dst + (size_t)((n0 + q * 64 + n) * mult + off) * K + k0 + kc) = o;
        }
    }
}

DI void convert_experts(const Params& p, int layer, int e0, int e1, int bid, int nb, char* smem) {
    int rot = 0;
    for (int e = e0; e < e1; ++e) {
        const size_t eo = ((size_t)layer * NE + e) * (size_t)D * DE;
        transpose_convert(p.ew_gate + eo, DE, D, DE, p.WtGU + (size_t)e * 1024 * 1024, 2, 0, bid, nb, smem, rot);
        transpose_convert(p.ew_up + eo, DE, D, DE, p.WtGU + (size_t)e * 1024 * 1024, 2, 1, bid, nb, smem, rot);
        transpose_convert(p.ew_down + eo, D, DE, D, p.WtD + (size_t)e * 1024 * 512, 1, 0, bid, nb, smem, rot);
    }
}

DI void convert_layer_weights(const Params& p, int l, int bid, int nb, char* smem) {
    int rot = 0;
    transpose_convert(p.w_in + (size_t)l * D * CIN, CIN, D, CIN, p.WtIn + (size_t)l * CIN * D, 1, 0, bid, nb, smem, rot);
    transpose_convert(p.p_sb + (size_t)l * 512 * D, D, 512, D, p.WtPsb + (size_t)l * D * 512, 1, 0, bid, nb, smem, rot);
    transpose_convert(p.p_rwkv + (size_t)l * 512 * D, D, 512, D, p.WtPrw + (size_t)l * D * 512, 1, 0, bid, nb, smem, rot);
    transpose_convert(p.w_out + (size_t)l * D * D, D, D, D, p.WtOut + (size_t)l * D * D, 1, 0, bid, nb, smem, rot);
    transpose_convert(p.w_up + (size_t)l * 64 * 512, 512, 64, 512, p.WupT + (size_t)l * 512 * 64, 1, 0, bid, nb, smem, rot);
    transpose_convert(p.a_up + (size_t)l * 64 * 512, 512, 64, 512, p.AupT + (size_t)l * 512 * 64, 1, 0, bid, nb, smem, rot);
    transpose_convert(p.g_up + (size_t)l * 128 * 512, 512, 128, 512, p.GupT + (size_t)l * 512 * 128, 1, 0, bid, nb, smem, rot);
}
DI void phase_prologue_weights(const Params& p, int bid, int nb, char* smem) {
    for (int i = bid * NTHR + tid_(); i < NE * D; i += nb * NTHR) {
        const int e = i / D, k = i % D;
        p.RwHi[i] = f2bf(p.router_w[(size_t)k * NE + e]);
    }
    for (int l = 0; l < DEPTH; ++l) convert_layer_weights(p, l, bid, nb, smem);
}

DI void ln16(float (&v)[16], const float* __restrict__ g, const float* __restrict__ b, int lane) {
    float s = 0.f;
#pragma unroll
    for (int i = 0; i < 16; ++i) s += v[i];
    const float mean = wave_sum(s) * (1.0f / D);
    float q = 0.f;
#pragma unroll
    for (int i = 0; i < 16; ++i) { v[i] -= mean; q += v[i] * v[i]; }
    const float rstd = rsqrtf(wave_sum(q) * (1.0f / D) + 1e-5f);
#pragma unroll
    for (int j = 0; j < 4; ++j) {
        const f32x4 gv = *(const f32x4*)(g + 256 * j + 4 * lane), bv = *(const f32x4*)(b + 256 * j + 4 * lane);
#pragma unroll
        for (int i = 0; i < 4; ++i) v[4 * j + i] = v[4 * j + i] * rstd * gv[i] + bv[i];
    }
}
DI void store_row_bf(bf16_t* __restrict__ hb, const float (&v)[16], int lane) {
#pragma unroll
    for (int j = 0; j < 4; ++j) *(u32x2*)(hb + 256 * j + 4 * lane) = (u32x2){pack2(v[4 * j], v[4 * j + 1]), pack2(v[4 * j + 2], v[4 * j + 3])};
}
DI void phase_embed(const Params& p, int bid, int nb) {
    const int lane = tid_() & 63, wid = __builtin_amdgcn_readfirstlane(tid_() >> 6);
    const int nwaves = nb * 8, gw = bid * 8 + wid, base_n = T / nwaves, extra = T % nwaves;
    const int tok0 = gw * base_n + (gw < extra ? gw : extra), ntok = base_n + (gw < extra ? 1 : 0);
    auto srcrow = [&](int tok) -> const float* {
        const int tk = __builtin_amdgcn_readfirstlane(tok), b = tk >= L ? 1 : 0, t = tk - b * L;
        const unsigned long long am = (unsigned long long)(p.meta + (long long)t * D), ao = (unsigned long long)(p.x + ((long long)b * SEQ + (t - NMETA)) * D);
        const unsigned long long m = 0ull - (unsigned long long)(t < NMETA);
        return (const float*)((am & m) | (ao & ~m));
    };
    f32x4 an[4];
    { const float* src = srcrow(tok0);
#pragma unroll
      for (int j = 0; j < 4; ++j) an[j] = *(const f32x4*)(src + 256 * j + 4 * lane); }
#pragma unroll 1
    for (int i = 0; i < ntok; ++i) {
        const int tok = tok0 + i;
        float v[16];
#pragma unroll
        for (int j = 0; j < 4; ++j) { v[4 * j] = an[j][0]; v[4 * j + 1] = an[j][1]; v[4 * j + 2] = an[j][2]; v[4 * j + 3] = an[j][3]; }
        if (i + 1 < ntok) { const float* src = srcrow(tok + 1);
#pragma unroll
            for (int j = 0; j < 4; ++j) an[j] = *(const f32x4*)(src + 256 * j + 4 * lane); }
        ln16(v, p.emb_g, p.emb_b, lane);
        store_row_bf(p.hb + (size_t)tok * D, v, lane);
    }
}

constexpr int LDT = 72;
constexpr int GEMM_LDS = 2 * 128 * LDT * 2;
template <class ARow, class Epi>
DI void gemm_tile128(ARow arow, const bf16_t* __restrict__ Bt, int ldb, int K, int m0, int n0, char* smem, Epi epi) {
    const int tid = tid_(), lane = tid & 63, wid = __builtin_amdgcn_readfirstlane(tid >> 6), fr = lane & 15, fq = lane >> 4;
    const int wr = wid >> 1, wc = wid & 1;
    bf16_t* As = (bf16_t*)smem;
    bf16_t* Bs = As + 128 * LDT;
    const bf16_t* ap[2]; const bf16_t* bp[2]; int so[2];
#pragma unroll
    for (int i = 0; i < 2; ++i) {
        const int c = tid + NTHR * i, row = c >> 3, kc = c & 7;
        const bf16_t* ar = arow(m0 + row);
        ap[i] = ar ? ar + kc * 8 : nullptr;
        bp[i] = Bt + (size_t)(n0 + row) * ldb + kc * 8;
        so[i] = row * LDT + kc * 8;
    }
    f32x4 acc[2][4];
#pragma unroll
    for (int mi = 0; mi < 2; ++mi)
#pragma unroll
        for (int ni = 0; ni < 4; ++ni) acc[mi][ni] = (f32x4){0.f, 0.f, 0.f, 0.f};
    u32x4 ra[2], rb[2];
#pragma unroll
    for (int i = 0; i < 2; ++i) { ra[i] = ap[i] ? *(const u32x4*)(ap[i]) : (u32x4){0u, 0u, 0u, 0u}; rb[i] = *(const u32x4*)(bp[i]); }
    for (int k0 = 0; k0 < K; k0 += 64) {
        __syncthreads();
#pragma unroll
        for (int i = 0; i < 2; ++i) { *(u32x4*)(As + so[i]) = ra[i]; *(u32x4*)(Bs + so[i]) = rb[i]; }
        __syncthreads();
        if (k0 + 64 < K) {
#pragma unroll
            for (int i = 0; i < 2; ++i) { ra[i] = ap[i] ? *(const u32x4*)(ap[i] + k0 + 64) : (u32x4){0u, 0u, 0u, 0u}; rb[i] = *(const u32x4*)(bp[i] + k0 + 64); }
        }
#pragma unroll
        for (int ks = 0; ks < 2; ++ks) {
            bf16x8 af[2], bf[4];
#pragma unroll
            for (int mi = 0; mi < 2; ++mi) af[mi] = *(const bf16x8*)(As + (wr * 32 + mi * 16 + fr) * LDT + ks * 32 + fq * 8);
#pragma unroll
            for (int ni = 0; ni < 4; ++ni) bf[ni] = *(const bf16x8*)(Bs + (wc * 64 + ni * 16 + fr) * LDT + ks * 32 + fq * 8);
#pragma unroll
            for (int mi = 0; mi < 2; ++mi)
#pragma unroll
                for (int ni = 0; ni < 4; ++ni) acc[mi][ni] = __builtin_amdgcn_mfma_f32_16x16x32_bf16(bf[ni], af[mi], acc[mi][ni], 0, 0, 0);
        }
    }
#pragma unroll
    for (int mi = 0; mi < 2; ++mi)
#pragma unroll
        for (int ni = 0; ni < 4; ++ni) epi(m0 + wr * 32 + mi * 16 + fr, n0 + wc * 64 + ni * 16 + fq * 4, acc[mi][ni]);
}

namespace g8 {
#define G8_LAS __attribute__((address_space(3)))
constexpr int BM = 256, BK = 64, HALF = 128, HTB = HALF * BK * 2, STAGE_BYTES = 8 * HTB, NXCD = 8, WGM = 8;
DI int lds_byte(int r, int c) { const int st = (r >> 4) * 2 + (c >> 5), rr = r & 15, cc = c & 31, ob = rr * 64 + cc * 2; return st * 1024 + (ob ^ (((ob >> 9) & 1) << 5)); }
DI void stage_rc(int b, int& R, int& C) { const int st = b / 1024, sb = b % 1024, swz = sb ^ (((sb >> 9) & 1) << 5); R = (st >> 1) * 16 + swz / 64; C = (st & 1) * 32 + (swz % 64) / 2; }
DI int perm32(int rho) { const int n = rho >> 4, i = rho & 15; return 8 * (i >> 2) + 4 * n + (i & 3); }
struct Unit { int pm, pn; const char* A; const char* B; int e, slot0, cnt; };

struct DenseOrder {
    int nM, nN, nwg, G, c; const char* A; const char* B; size_t tstep;
    DI void init(const bf16_t* A_, const bf16_t* Bt_, int nM_, int nN_, int K, int G_, int c_) { nM = nM_; nN = nN_; nwg = nM * nN; G = G_; c = c_; A = (const char*)A_; B = (const char*)Bt_; tstep = (size_t)BM * K * 2; }
    DI bool next(int i, Unit& u) const {
        const long Lq = (long)i * G + c; if (Lq >= nwg) return false;
        int wgid = (int)Lq; { const int q = nwg / NXCD, r = nwg % NXCD, xcd = wgid % NXCD, off = wgid / NXCD; wgid = (xcd < r ? xcd * (q + 1) : r * (q + 1) + (xcd - r) * q) + off; }
        const int nig = WGM * nN, gid = wgid / nig, fm = gid * WGM, gsz = (nM - fm) < WGM ? (nM - fm) : WGM;
        u.pm = fm + ((wgid % nig) % gsz); u.pn = (wgid % nig) / gsz; u.A = A + (size_t)u.pm * tstep; u.B = B + (size_t)u.pn * tstep; u.e = 0; u.slot0 = 0; u.cnt = 0; return true;
    }
    DI unsigned row_off(const Unit&, int) const { return 0u; }
};

template <bool GATHER, class Epi, class Sched>
DI void gemm8(G8_LAS unsigned char* lds, const int K, const Sched& S, const Epi& E) {
    const int tid = tid_(), wid = __builtin_amdgcn_readfirstlane(tid >> 6), lane = tid & 63, wr = wid >> 2, wc = wid & 3, fr = lane & 15, fq = lane >> 4;
    const int nt = K / BK;
    int Rr[2], Cc[2]; unsigned voffB[2], voffA[2];
#pragma unroll
    for (int i = 0; i < 2; ++i) { stage_rc(tid * 16 + i * 8192, Rr[i], Cc[i]); const int Rb = Epi::PERM ? ((Rr[i] & ~31) + perm32(Rr[i] & 31)) : Rr[i]; voffB[i] = (unsigned)(Rb * K + Cc[i]) * 2u; voffA[i] = (unsigned)(Rr[i] * K + Cc[i]) * 2u; }
    const size_t kstep = (size_t)(BK * 2), hstep = (size_t)HALF * K * 2;
    const unsigned ldsw = (unsigned)wid * 1024u;
    const int aoff = lds_byte(wr * 64 + fr, fq * 8), boff = lds_byte(wc * 32 + fr, fq * 8);
#define G8_SA(b, h) (((b) * 2 + (h)) * HTB)
#define G8_SB(b, h) ((4 + (b) * 2 + (h)) * HTB)
#define G8_STAGE(bufoff, gbase, voff) do { _Pragma("unroll") for (int _i = 0; _i < 2; ++_i) \
        __builtin_amdgcn_global_load_lds((const unsigned*)((const char*)(gbase) + (voff)[_i]), (G8_LAS unsigned*)(lds + (bufoff) + ldsw + _i * 8192), 16, 0, 0); } while (0)
#define G8_LDA(dst, b, h) do { _Pragma("unroll") for (int m = 0; m < 4; ++m) _Pragma("unroll") for (int k = 0; k < 2; ++k) dst[m][k] = *(const G8_LAS bf16x8*)(lds + G8_SA(b, h) + aoff + m * 2048 + k * 1024); } while (0)
#define G8_LDB(dst, b, h) do { _Pragma("unroll") for (int n = 0; n < 2; ++n) _Pragma("unroll") for (int k = 0; k < 2; ++k) dst[n][k] = *(const G8_LAS bf16x8*)(lds + G8_SB(b, h) + boff + n * 2048 + k * 1024); } while (0)
#define G8_MMA(ai, bj, At, Bt) do { __builtin_amdgcn_s_setprio(1); _Pragma("unroll") for (int m = 0; m < 4; ++m) _Pragma("unroll") for (int n = 0; n < 2; ++n) _Pragma("unroll") for (int k = 0; k < 2; ++k) \
        acc[ai][bj][m][n] = __builtin_amdgcn_mfma_f32_16x16x32_bf16(Bt[n][k], At[m][k], acc[ai][bj][m][n], 0, 0, 0); __builtin_amdgcn_s_setprio(0); } while (0)
#define G8_WAIT_V(n) asm volatile("s_waitcnt vmcnt(" #n ")" ::: "memory")
#define G8_WAIT_L(n) asm volatile("s_waitcnt lgkmcnt(" #n ")" ::: "memory")
#define G8_BAR __builtin_amdgcn_s_barrier()
#define G8_SCHED __builtin_amdgcn_sched_barrier(0)
#define G8_AOFF(dst, un) do { if (GATHER) { _Pragma("unroll") for (int _h = 0; _h < 2; ++_h) _Pragma("unroll") for (int _i = 0; _i < 2; ++_i) \
        dst[_h][_i] = S.row_off(un, _h * HALF + Rr[_i]) + (unsigned)Cc[_i] * 2u; } } while (0)
#define G8_STAGE_A(bufoff, gb, vo, h) do { if (GATHER) { G8_STAGE(bufoff, gb, vo[h]); } else { G8_STAGE(bufoff, (gb) + (h) * hstep, voffA); } } while (0)
    Unit cur, nxt; int ui = 0;
    if (!S.next(0, cur)) return;
    f32x4 acc[2][2][4][2];
#pragma unroll
    for (int a = 0; a < 2; ++a)
#pragma unroll
        for (int b = 0; b < 2; ++b)
#pragma unroll
            for (int m = 0; m < 4; ++m)
#pragma unroll
                for (int n = 0; n < 2; ++n) acc[a][b][m][n] = (f32x4){0.f, 0.f, 0.f, 0.f};
    bf16x8 At[4][2], B0[2][2], B1[2][2];
    unsigned cvA[2][2], nvA[2][2];
    G8_AOFF(cvA, cur);
    const char* cA = cur.A; const char* cB = cur.B;
    G8_STAGE(G8_SB(0, 0), cB, voffB); G8_STAGE_A(G8_SA(0, 0), cA, cvA, 0); G8_STAGE(G8_SB(0, 1), cB + hstep, voffB); G8_STAGE_A(G8_SA(0, 1), cA, cvA, 1);
    if (wr == 1) G8_BAR;
    G8_WAIT_V(4); G8_BAR;
    G8_STAGE(G8_SB(1, 0), cB + kstep, voffB); G8_STAGE_A(G8_SA(1, 0), cA + kstep, cvA, 0); G8_STAGE(G8_SB(1, 1), cB + hstep + kstep, voffB);
    G8_WAIT_V(6); G8_BAR;
    for (;;) {
        const bool has_next = S.next(ui + 1, nxt);
        const char* nA = has_next ? nxt.A : cA; const char* nB = has_next ? nxt.B : cB;
        if (GATHER) {
            if (has_next) { G8_AOFF(nvA, nxt); } else {
#pragma unroll
                for (int h = 0; h < 2; ++h)
#pragma unroll
                    for (int i = 0; i < 2; ++i) nvA[h][i] = cvA[h][i];
            }
        }
        for (int t = 0; t < nt; t += 2) {
            const bool last = (t == nt - 2);
            const char* a1 = cA + (size_t)(t + 1) * kstep;
            const char* a2 = last ? nA : cA + (size_t)(t + 2) * kstep; const char* b2 = last ? nB : cB + (size_t)(t + 2) * kstep;
            const char* a3 = a2 + kstep; const char* b3 = b2 + kstep;

            G8_LDB(B0, 0, 0); G8_SCHED; G8_LDA(At, 0, 0); G8_STAGE_A(G8_SA(1, 1), a1, cvA, 1);
            if (GATHER && last) {
#pragma unroll
                for (int h = 0; h < 2; ++h)
#pragma unroll
                    for (int i = 0; i < 2; ++i) cvA[h][i] = nvA[h][i];
            }
            G8_WAIT_L(8); G8_BAR; G8_WAIT_L(0); G8_MMA(0, 0, At, B0); G8_BAR; G8_SCHED;
            G8_LDB(B1, 0, 1); G8_STAGE(G8_SB(0, 0), b2, voffB);
            G8_BAR; G8_WAIT_L(0); G8_MMA(0, 1, At, B1); G8_BAR;
            G8_LDA(At, 0, 1); G8_STAGE_A(G8_SA(0, 0), a2, cvA, 0);
            G8_BAR; G8_WAIT_L(0); G8_MMA(1, 0, At, B0); G8_BAR; G8_SCHED;
            G8_STAGE(G8_SB(0, 1), b2 + hstep, voffB);
            G8_WAIT_V(6); G8_BAR; G8_MMA(1, 1, At, B1); G8_BAR;
            G8_LDB(B0, 1, 0); G8_SCHED; G8_LDA(At, 1, 0); G8_STAGE_A(G8_SA(0, 1), a2, cvA, 1);
            G8_WAIT_L(8); G8_BAR; G8_WAIT_L(0); G8_MMA(0, 0, At, B0); G8_BAR; G8_SCHED;
            G8_LDB(B1, 1, 1); G8_STAGE(G8_SB(1, 0), b3, voffB);
            G8_BAR; G8_WAIT_L(0); G8_MMA(0, 1, At, B1); G8_BAR;
            G8_LDA(At, 1, 1); G8_STAGE_A(G8_SA(1, 0), a3, cvA, 0);
            G8_BAR; G8_WAIT_L(0); G8_MMA(1, 0, At, B0); G8_BAR; G8_SCHED;
            G8_STAGE(G8_SB(1, 1), b3 + hstep, voffB);
            G8_WAIT_V(6); G8_BAR; G8_MMA(1, 1, At, B1); G8_BAR;
        }
        { int fr2 = fr, fq2 = fq; asm volatile("" : "+v"(fr2), "+v"(fq2)); E(acc, cur, wr, wc, fr2, fq2); }
        if (!has_next) break;
#pragma unroll
        for (int a = 0; a < 2; ++a)
#pragma unroll
            for (int b = 0; b < 2; ++b)
#pragma unroll
                for (int m = 0; m < 4; ++m)
#pragma unroll
                    for (int n = 0; n < 2; ++n) acc[a][b][m][n] = (f32x4){0.f, 0.f, 0.f, 0.f};
        cur = nxt; cA = nA; cB = nB; ++ui;
    }
    G8_WAIT_V(0);
    if (wr == 0) G8_BAR;
    G8_BAR;
#undef G8_SA
#undef G8_SB
#undef G8_STAGE
#undef G8_LDA
#undef G8_LDB
#undef G8_MMA
#undef G8_WAIT_V
#undef G8_WAIT_L
#undef G8_BAR
#undef G8_SCHED
#undef G8_AOFF
#undef G8_STAGE_A
}
}

constexpr int MFULL = 64, M0_LEFT = MFULL * 256;
struct EpiStore {
    static constexpr bool PERM = true;
    bf16_t* O; int ldc; bool sig;
    DI void operator()(const f32x4 (&acc)[2][2][4][2], const g8::Unit& u, int wr, int wc, int fr, int fq) const {
#pragma unroll
        for (int ai = 0; ai < 2; ++ai)
#pragma unroll
            for (int m = 0; m < 4; ++m) {
                bf16_t* rowp = O + (size_t)(u.pm * 256 + ai * 128 + wr * 64 + m * 16 + fr) * ldc + u.pn * 256 + wc * 32 + 8 * fq;
#pragma unroll
                for (int bj = 0; bj < 2; ++bj) {
                    f32x4 v0 = acc[ai][bj][m][0], v1 = acc[ai][bj][m][1];
                    if (sig) {
#pragma unroll
                        for (int e = 0; e < 4; ++e) { v0[e] = sigmoidf_(v0[e]); v1[e] = sigmoidf_(v1[e]); }
                    }
                    *(u32x4*)(rowp + bj * 128) = (u32x4){pack2(v0[0], v0[1]), pack2(v0[2], v0[3]), pack2(v1[0], v1[1]), pack2(v1[2], v1[3])};
                }
            }
    }
};
DI int left_first(int units, int bid, int nb) { return (bid - units % nb + nb) % nb; }

constexpr int LEFT_LDS = 2 * (32 + 128) * LDT * 2;
template <class ARow, class Epi>
DI void gemm_left32(ARow arow, const bf16_t* __restrict__ Bt, int ldb, int K, int n0, char* smem, Epi epi) {
    const int tid = tid_(), lane = tid & 63, wid = __builtin_amdgcn_readfirstlane(tid >> 6), fr = lane & 15, fq = lane >> 4;
    bf16_t* As = (bf16_t*)smem;
    bf16_t* Bs = As + 2 * 32 * LDT;
    const int arow_i = tid >> 4, akc = (tid & 15) * 4;
    const bf16_t* ap = arow(arow_i) + akc;
    const bf16_t* bp[2]; int bso[2];
#pragma unroll
    for (int i = 0; i < 2; ++i) { const int cc = tid + NTHR * i, row = cc >> 3, kc = cc & 7; bp[i] = Bt + (size_t)(n0 + row) * ldb + kc * 8; bso[i] = row * LDT + kc * 8; }
    const int nit = K / 64;
    u32x2 ra[4]; u32x4 rb[4][2];
#define GL_LOAD(slot, it) do { if ((it) < nit) { ra[slot] = *(const u32x2*)(ap + (it) * 64); rb[slot][0] = *(const u32x4*)(bp[0] + (it) * 64); rb[slot][1] = *(const u32x4*)(bp[1] + (it) * 64); } } while (0)
#define GL_WRITE(slot, buf) do { *(u32x2*)(As + (buf) * 32 * LDT + arow_i * LDT + akc) = ra[slot]; *(u32x4*)(Bs + (buf) * 128 * LDT + bso[0]) = rb[slot][0]; *(u32x4*)(Bs + (buf) * 128 * LDT + bso[1]) = rb[slot][1]; } while (0)
    f32x4 acc[2] = {(f32x4){0.f, 0.f, 0.f, 0.f}, (f32x4){0.f, 0.f, 0.f, 0.f}};
    GL_LOAD(0, 0); GL_LOAD(1, 1); GL_LOAD(2, 2); GL_LOAD(3, 3);
    __syncthreads();
    GL_WRITE(0, 0);
    __syncthreads();
#define GL_STEP(slot, it) do { \
        GL_LOAD(slot, (it) + 4); \
        const int buf = (it) & 1; \
        _Pragma("unroll") for (int ks = 0; ks < 2; ++ks) { \
            const bf16x8 bf = *(const bf16x8*)(Bs + buf * 128 * LDT + (wid * 16 + fr) * LDT + ks * 32 + fq * 8); \
            _Pragma("unroll") for (int mt = 0; mt < 2; ++mt) { \
                const bf16x8 af = *(const bf16x8*)(As + buf * 32 * LDT + (mt * 16 + fr) * LDT + ks * 32 + fq * 8); \
                acc[mt] = __builtin_amdgcn_mfma_f32_16x16x32_bf16(bf, af, acc[mt], 0, 0, 0); } } \
        if ((it) + 1 < nit) { GL_WRITE(((slot) + 1) & 3, buf ^ 1); } \
        __syncthreads(); } while (0)
    for (int it = 0; it < nit; it += 4) {
        GL_STEP(0, it);
        if (it + 1 < nit) GL_STEP(1, it + 1);
        if (it + 2 < nit) GL_STEP(2, it + 2);
        if (it + 3 < nit) GL_STEP(3, it + 3);
    }
#undef GL_LOAD
#undef GL_WRITE
#undef GL_STEP
#pragma unroll
    for (int mt = 0; mt < 2; ++mt) epi(mt * 16 + fr, n0 + wid * 16 + fq * 4, acc[mt]);
}

DI void phase_inproj(const Params& p, int layer, int bid, int nb, char* smem) {
    const bf16_t* hb = p.hb; bf16_t* P = p.P;
    const bf16_t* Bt = p.WtIn + (size_t)layer * CIN * D;
    g8::DenseOrder S; S.init(hb, Bt, MFULL, CP / 256, D, nb, bid);
    g8::gemm8<false>((G8_LAS unsigned char*)smem, D, S, EpiStore{P, CP, false});
    {
        constexpr int UNITS = MFULL * (CP / 256);
        const int heavy = UNITS % nb;
        if (heavy > 0 && heavy < nb) { if (bid >= heavy) convert_experts(p, layer, 0, NE / 2, bid - heavy, nb - heavy, smem); }
        else convert_experts(p, layer, 0, NE / 2, bid, nb, smem);
    }
    bf16_t* G = p.gleft - (size_t)M0_LEFT * 2048; const bf16_t* Wg = p.WtIn + ((size_t)layer * CIN + CP) * D;
    for (int t = left_first(MFULL * (CP / 256), bid, nb); t < CP / 128 + 2048 / 128; t += nb) {
        if (t < CP / 128)
            gemm_left32([=](int r) { return hb + (size_t)(M0_LEFT + r) * D; }, Bt, D, D, t * 128, smem,
                        [=](int r, int c, f32x4 v) { *(u32x2*)(P + (size_t)(M0_LEFT + r) * CP + c) = (u32x2){pack2(v[0], v[1]), pack2(v[2], v[3])}; });
        else
            gemm_left32([=](int r) { return hb + (size_t)(M0_LEFT + r) * D; }, Wg, D, D, (t - CP / 128) * 128, smem,
                        [=](int r, int c, f32x4 v) { *(u32x2*)(G + (size_t)(M0_LEFT + r) * 2048 + c) = (u32x2){pack2(sigmoidf_(v[0]), sigmoidf_(v[1])), pack2(sigmoidf_(v[2]), sigmoidf_(v[3]))}; });
    }
}

constexpr int NCHUNK = (L + 63) / 64, NUNIT = NBATCH * HEADS * NCHUNK;
constexpr int LS = 72, RB = 64 * LS * 2;
constexpr int R1_LDS = 16 * RB + 4096 + 7168;
#define RBUF(i) ((bf16_t*)(smem + (i) * RB))
typedef float f32x16 __attribute__((ext_vector_type(16)));

template <int KK> DI f32x4 mm16(const bf16_t* F, int ldf, const bf16_t* S, int lds_, f32x4 acc, int lane) {
    const int fr = lane & 15, fq = lane >> 4;
#pragma unroll
    for (int ks = 0; ks < KK / 32; ++ks) {
        const bf16x8 f = *(const bf16x8*)(F + fr * ldf + ks * 32 + fq * 8);
        const bf16x8 g = *(const bf16x8*)(S + fr * lds_ + ks * 32 + fq * 8);
        acc = __builtin_amdgcn_mfma_f32_16x16x32_bf16(f, g, acc, 0, 0, 0);
    }
    return acc;
}
DI u32x2 pk4(f32x4 v) { return (u32x2){pack2(v[0], v[1]), pack2(v[2], v[3])}; }
DI f32x4 up4(u32x2 v) { return (f32x4){lo_bf(v[0]), hi_bf(v[0]), lo_bf(v[1]), hi_bf(v[1])}; }

typedef short s16x4 __attribute__((ext_vector_type(4)));
DI f32x4 mf16(u32x2 a, u32x2 b, f32x4 c) { return __builtin_amdgcn_mfma_f32_16x16x16bf16_1k(__builtin_bit_cast(s16x4, a), __builtin_bit_cast(s16x4, b), c, 0, 0, 0); }
#define TRI_M(a, b)  (*(const u32x2*)(Mt + (16 * (b) + fr) * LS + 16 * (a) + 4 * fq))
#define TRI_MT(a, b) (*(const u32x2*)(Mr + (16 * (a) + fr) * LS + 16 * (b) + 4 * fq))
#define TRI_ST(c, r, w) (*(u32x2*)(Tb + (16 * (r) + fr) * LS + 16 * (c) + 4 * fq) = (w))
DI void r1_tri_inverse(const bf16_t* Mr, const bf16_t* Mt, bf16_t* Tb, int lane) {
    const int fr = lane & 15, fq = lane >> 4;
    const f32x4 zero = (f32x4){0.f, 0.f, 0.f, 0.f};
    f32x4 eye;
#pragma unroll
    for (int e = 0; e < 4; ++e) eye[e] = (4 * fq + e == fr) ? 1.f : 0.f;
    u32x2 mk[4], mkt[4], y[4], yt[4];
    f32x4 Y[4], YT[4];
#pragma unroll
    for (int a = 0; a < 4; ++a) {
        mk[a] = TRI_M(a, a); mkt[a] = TRI_MT(a, a);
        Y[a] = up4(mk[a]) + eye; YT[a] = up4(mkt[a]) + eye;
        y[a] = pk4(Y[a]); yt[a] = pk4(YT[a]);
    }
    const u32x2 m10 = TRI_M(1, 0), m10t = TRI_MT(1, 0), m32 = TRI_M(3, 2), m20 = TRI_M(2, 0), m21 = TRI_M(2, 1), m30 = TRI_M(3, 0), m31 = TRI_M(3, 1);
#pragma unroll
    for (int k = 0; k < 3; ++k) {
        f32x4 s2[4], s2t[4];
#pragma unroll
        for (int a = 0; a < 4; ++a) { s2[a] = mf16(mkt[a], mk[a], zero); s2t[a] = mf16(mk[a], mkt[a], zero); }
#pragma unroll
        for (int a = 0; a < 4; ++a) { mk[a] = pk4(s2[a]); mkt[a] = pk4(s2t[a]); }
#pragma unroll
        for (int a = 0; a < 4; ++a) { Y[a] = mf16(mkt[a], y[a], Y[a]); YT[a] = mf16(mk[a], yt[a], YT[a]); }
#pragma unroll
        for (int a = 0; a < 4; ++a) { y[a] = pk4(Y[a]); yt[a] = pk4(YT[a]); }
    }
    const u32x2 e1 = pk4(mf16(m10t, y[0], zero));
    const u32x2 e2 = pk4(mf16(m10, yt[1], zero));
    const u32x2 g3 = pk4(mf16(m32, yt[3], zero));
    const u32x2 t10 = pk4(mf16(yt[1], e1, zero));
    const u32x2 t10t = pk4(mf16(y[0], e2, zero));
    const u32x2 t32t = pk4(mf16(y[2], g3, zero));
    const u32x2 h02 = pk4(mf16(m20, yt[2], zero)), h12 = pk4(mf16(m21, yt[2], zero));
    const u32x2 h03 = pk4(mf16(m30, yt[3], mf16(m20, t32t, zero))), h13 = pk4(mf16(m31, yt[3], mf16(m21, t32t, zero)));
    const u32x2 w02 = pk4(mf16(t10, h12, mf16(y[0], h02, zero))), w03 = pk4(mf16(t10, h13, mf16(y[0], h03, zero)));
    const u32x2 w12 = pk4(mf16(y[1], h12, zero)), w13 = pk4(mf16(y[1], h13, zero));
#pragma unroll
    for (int a = 0; a < 4; ++a) TRI_ST(a, a, yt[a]);
    TRI_ST(0, 1, t10t); TRI_ST(2, 3, t32t);
    TRI_ST(0, 2, w02); TRI_ST(0, 3, w03); TRI_ST(1, 2, w12); TRI_ST(1, 3, w13);
    const u32x2 z2 = (u32x2){0u, 0u};
    TRI_ST(1, 0, z2); TRI_ST(3, 2, z2);
}

template <int MODE> DI void phase_rwkv_r1(const Params& p, int layer, int bid, int nb, char* smem) {
    const int wv = __builtin_amdgcn_readfirstlane(tid_() >> 6);
    const f32x4 zero = (f32x4){0.f, 0.f, 0.f, 0.f};
    float* lwT = (float*)RBUF(4);
    float* aT = (float*)RBUF(6);
    float* gt = (float*)(smem + 16 * RB);
    float* gammaC = gt + 512;
    bf16_t* Xt0 = RBUF(14);
    bf16_t* Xt1 = RBUF(4);
    const bf16_t* WupT = p.WupT + (size_t)layer * 512 * 64, *AupT = p.AupT + (size_t)layer * 512 * 64, *GupT = p.GupT + (size_t)layer * 512 * 128;
    float* mu = (float*)(smem + 16 * RB + 4096);
    __syncthreads();
    for (int i = tid_(); i < RSW; i += NTHR) mu[i] = p.mu[(size_t)layer * RSW + i];
    for (int it = 0;; ++it) {
        const int tid = tid_(), lane = tid & 63, fr = lane & 15, fq = lane >> 4;
        int c, bh;
        if (MODE == 0) {
            const int Lq = it * nb + bid, q = Lq >> 3, cb = (q >> 3) * 8 + (Lq & 7);
            if (cb >= NBATCH * (NCHUNK - 1)) break;
            c = cb % (NCHUNK - 1); bh = (cb / (NCHUNK - 1)) * HEADS + (q & 7);
        } else {
            if (it > 0) break;
            c = NCHUNK - 1; bh = bid;
        }
        const int u = bh * NCHUNK + c, h = bh % HEADS, bb = bh / HEADS;
        const size_t tok0 = (size_t)bb * L + c * 64;
        bf16x8 fw[2][2], fa[2][2], fg[2][4];
#pragma unroll
        for (int t2 = 0; t2 < 2; ++t2) {
            const int tl = wv * 2 + t2, pt = tl >> 2, qt = tl & 3;
#pragma unroll
            for (int ks = 0; ks < 2; ++ks) {
                fw[t2][ks] = *(const bf16x8*)(WupT + (size_t)(h * 64 + qt * 16 + fr) * 64 + ks * 32 + fq * 8);
                fa[t2][ks] = *(const bf16x8*)(AupT + (size_t)(h * 64 + pt * 16 + fr) * 64 + ks * 32 + fq * 8);
            }
        }
        __syncthreads();
        {
            u32x4 curv[7], prvv[7];
#pragma unroll
            for (int it2 = 0; it2 < 7; ++it2) {
                const int cid = tid + NTHR * it2, i = cid / 56, cc = cid % 56;
                const int col = cc < 8 ? RW_R + h * 64 + cc * 8 : cc < 16 ? RW_K + h * 64 + (cc - 8) * 8 : cc < 24 ? RW_V + h * 64 + (cc - 16) * 8 : RW_WD + (cc - 24) * 8;
                const int t = c * 64 + i;
                curv[it2] = (u32x4){0u, 0u, 0u, 0u}; prvv[it2] = (u32x4){0u, 0u, 0u, 0u};
                if (t < L) curv[it2] = *(const u32x4*)(p.P + (tok0 + i) * CP + OFF_RW + col);
                if (t < L && t > 0) prvv[it2] = *(const u32x4*)(p.P + (tok0 + i - 1) * CP + OFF_RW + col);
            }
#pragma unroll
            for (int it2 = 0; it2 < 7; ++it2) {
                const int cid = tid + NTHR * it2, i = cid / 56, cc = cid % 56;
                const int col = cc < 8 ? RW_R + h * 64 + cc * 8 : cc < 16 ? RW_K + h * 64 + (cc - 8) * 8 : cc < 24 ? RW_V + h * 64 + (cc - 16) * 8 : RW_WD + (cc - 24) * 8;
                bf16_t* dst = cc < 8 ? RBUF(8) + i * LS + cc * 8 : cc < 16 ? RBUF(9) + i * LS + (cc - 8) * 8 : cc < 24 ? RBUF(10) + i * LS + (cc - 16) * 8
                            : cc < 32 ? RBUF(0) + i * LS + (cc - 24) * 8 : cc < 40 ? RBUF(1) + i * LS + (cc - 32) * 8 : RBUF(2) + i * 136 + (cc - 40) * 8;
                const f32x4 m0 = *(const f32x4*)(mu + col), m1 = *(const f32x4*)(mu + col + 4);
                const u32x4 cur = curv[it2], prv = prvv[it2];
                float x[8];
#pragma unroll
                for (int j2 = 0; j2 < 4; ++j2) {
                    const float c0 = lo_bf(cur[j2]), c1 = hi_bf(cur[j2]), p0 = lo_bf(prv[j2]), p1 = hi_bf(prv[j2]);
                    const float mm0 = j2 < 2 ? m0[2 * j2] : m1[2 * j2 - 4], mm1 = j2 < 2 ? m0[2 * j2 + 1] : m1[2 * j2 - 3];
                    x[2 * j2] = c0 + (p0 - c0) * mm0; x[2 * j2 + 1] = c1 + (p1 - c1) * mm1;
                }
                if (cc >= 24 && cc < 32) {
#pragma unroll
                    for (int j2 = 0; j2 < 8; ++j2) x[j2] = tanhf_(x[j2]);
                } else if (cc >= 40) {
#pragma unroll
                    for (int j2 = 0; j2 < 8; ++j2) x[j2] = sigmoidf_(x[j2]);
                }
                *(u32x4*)dst = (u32x4){pack2(x[0], x[1]), pack2(x[2], x[3]), pack2(x[4], x[5]), pack2(x[6], x[7])};
            }
        }
#pragma unroll
        for (int t2 = 0; t2 < 2; ++t2)
#pragma unroll
            for (int ks = 0; ks < 4; ++ks) fg[t2][ks] = *(const bf16x8*)(GupT + (size_t)(h * 64 + ((wv * 2 + t2) >> 2) * 16 + fr) * 128 + ks * 32 + fq * 8);
        __syncthreads();
#pragma unroll
        for (int t2 = 0; t2 < 2; ++t2) {
            const int tl = wv * 2 + t2, pt = tl >> 2, qt = tl & 3;
            f32x4 aw = zero, aa = zero, ag = zero;
#pragma unroll
            for (int ks = 0; ks < 2; ++ks) {
                const bf16x8 xw = *(const bf16x8*)(RBUF(0) + (pt * 16 + fr) * LS + ks * 32 + fq * 8);
                aw = __builtin_amdgcn_mfma_f32_16x16x32_bf16(xw, fw[t2][ks], aw, 0, 0, 0);
                const bf16x8 xa = *(const bf16x8*)(RBUF(1) + (qt * 16 + fr) * LS + ks * 32 + fq * 8);
                aa = __builtin_amdgcn_mfma_f32_16x16x32_bf16(fa[t2][ks], xa, aa, 0, 0, 0);
            }
#pragma unroll
            for (int ks = 0; ks < 4; ++ks) {
                const bf16x8 xg = *(const bf16x8*)(RBUF(2) + (qt * 16 + fr) * 136 + ks * 32 + fq * 8);
                ag = __builtin_amdgcn_mfma_f32_16x16x32_bf16(fg[t2][ks], xg, ag, 0, 0, 0);
            }
            const int ch = qt * 16 + fr;
            const float w0 = p.w0[layer * 512 + h * 64 + ch];
            const f32x4 a0 = *(const f32x4*)(p.a0 + layer * 512 + h * 64 + pt * 16 + fq * 4);
            f32x4 lw, av;
#pragma unroll
            for (int e = 0; e < 4; ++e) { lw[e] = -DECAY_SCALE * sigmoidf_(w0 + aw[e]); av[e] = sigmoidf_(a0[e] + aa[e]); }
            *(f32x4*)(lwT + ch * 68 + pt * 16 + fq * 4) = lw;
            *(f32x4*)(aT + (qt * 16 + fr) * 68 + pt * 16 + fq * 4) = av;
            *(u32x2*)(p.GG + ((size_t)u * 64 + qt * 16 + fr) * 64 + pt * 16 + fq * 4) = pk4(ag);
        }
        __syncthreads();
        {
            const int i = tid >> 3, c8 = (tid & 7) * 8, cg = layer * 512 + h * 64 + c8;
            const u32x4 xr = *(const u32x4*)(RBUF(8) + i * LS + c8), xk = *(const u32x4*)(RBUF(9) + i * LS + c8);
            const f32x4 a0 = *(const f32x4*)(aT + i * 68 + c8), a1 = *(const f32x4*)(aT + i * 68 + c8 + 4);
            const f32x4 kk0 = *(const f32x4*)(p.k_k + cg), kk1 = *(const f32x4*)(p.k_k + cg + 4), ka0 = *(const f32x4*)(p.k_a + cg), ka1 = *(const f32x4*)(p.k_a + cg + 4);
            const f32x4 rk0 = *(const f32x4*)(p.r_k + cg), rk1 = *(const f32x4*)(p.r_k + cg + 4);
            float n2 = 0.f, bon = 0.f;
#pragma unroll
            for (int j = 0; j < 8; ++j) {
                const float r_ = (j & 1) ? hi_bf(xr[j >> 1]) : lo_bf(xr[j >> 1]), k_ = (j & 1) ? hi_bf(xk[j >> 1]) : lo_bf(xk[j >> 1]);
                const float a_ = j < 4 ? a0[j & 3] : a1[j & 3], kkc = j < 4 ? kk0[j & 3] : kk1[j & 3], kac = j < 4 ? ka0[j & 3] : ka1[j & 3], rkc = j < 4 ? rk0[j & 3] : rk1[j & 3];
                const float kkr = k_ * kkc;
                n2 += kkr * kkr;
                bon += r_ * (k_ * (1.0f + (a_ - 1.0f) * kac)) * rkc;
            }
            n2 = sum8(n2); bon = sum8(bon);
            if ((tid & 7) == 0) { gt[576 + i] = 1.0f / fmaxf(sqrtf(n2), 1e-12f); p.bonG[(size_t)u * 64 + i] = bon; }
        }
        __syncthreads();
        {
            const int ch = lane, cg = layer * 512 + h * 64 + ch;
            float lw[8], av[8], cum[8];
            {
                const f32x4 l0 = *(const f32x4*)(lwT + ch * 68 + wv * 8), l1 = *(const f32x4*)(lwT + ch * 68 + wv * 8 + 4);
#pragma unroll
                for (int e = 0; e < 4; ++e) { lw[e] = l0[e]; lw[e + 4] = l1[e]; }
#pragma unroll
                for (int e = 0; e < 8; ++e) av[e] = aT[(wv * 8 + e) * 68 + ch];
            }
            float run = 0.f;
#pragma unroll
            for (int e = 0; e < 8; ++e) { run += lw[e]; cum[e] = run; }
            gt[wv * 64 + ch] = run;
            __syncthreads();
            float offs = 0.f, tot = 0.f;
#pragma unroll
            for (int g2 = 0; g2 < 8; ++g2) { const float gv = gt[g2 * 64 + ch]; offs += g2 < wv ? gv : 0.f; tot += gv; }
            if (wv == 0) gammaC[ch] = __expf(tot);
            const float kkc = p.k_k[cg], kac = p.k_a[cg];
            float at_[8], kt_[8], bt_[8], vt_[8];
#pragma unroll
            for (int e = 0; e < 8; ++e) {
                const int i = wv * 8 + e;
                const float xr = bf2f(RBUF(8)[i * LS + ch]), xk = bf2f(RBUF(9)[i * LS + ch]), xv = bf2f(RBUF(10)[i * LS + ch]);
                const float cm = cum[e] + offs;
                const float kk = xk * kkc * gt[576 + i];
                const float kq = xk * (1.0f + (av[e] - 1.0f) * kac);
                if (c * 64 + i < L) p.orw[(tok0 + i) * 512 + h * 64 + ch] = RBUF(10)[i * LS + ch];
                const float eneg = __expf(-cm), epos = __expf(cm), eexc = __expf(cm - lw[e]);
                at_[e] = -kk * eexc; kt_[e] = kq * eneg; bt_[e] = kk * av[e] * eneg; vt_[e] = xv;
                RBUF(3)[i * LS + ch] = f2bf(xr * epos);
            }
            __syncthreads();
#pragma unroll
            for (int e = 0; e < 8; ++e) {
                const int i = wv * 8 + e;
                RBUF(0)[i * LS + ch] = f2bf(at_[e]); RBUF(1)[i * LS + ch] = f2bf(kt_[e]); RBUF(2)[i * LS + ch] = f2bf(bt_[e]);
            }
            *(u32x4*)(RBUF(11) + ch * LS + wv * 8) = (u32x4){pack2(kt_[0], kt_[1]), pack2(kt_[2], kt_[3]), pack2(kt_[4], kt_[5]), pack2(kt_[6], kt_[7])};
            *(u32x4*)(RBUF(12) + ch * LS + wv * 8) = (u32x4){pack2(bt_[0], bt_[1]), pack2(bt_[2], bt_[3]), pack2(bt_[4], bt_[5]), pack2(bt_[6], bt_[7])};
            *(u32x4*)(RBUF(13) + ch * LS + wv * 8) = (u32x4){pack2(vt_[0], vt_[1]), pack2(vt_[2], vt_[3]), pack2(vt_[4], vt_[5]), pack2(vt_[6], vt_[7])};
            *(u32x4*)(Xt0 + ch * LS + wv * 8) = (u32x4){pack2(at_[0], at_[1]), pack2(at_[2], at_[3]), pack2(at_[4], at_[5]), pack2(at_[6], at_[7])};
        }
        __syncthreads();
#pragma unroll
        for (int prod = 0; prod < 4; ++prod) {
            const bf16_t* F = (prod == 0 || prod == 2) ? RBUF(1) : RBUF(2);
            const bf16_t* S = prod < 2 ? RBUF(0) : RBUF(3);
            bf16_t* O = prod == 0 ? RBUF(6) : prod == 1 ? RBUF(7) : prod == 2 ? RBUF(9) : RBUF(10);
            const int mode = prod < 2 ? 0 : 1;
#pragma unroll
            for (int rep = 0; rep < 2; ++rep) {
                const int tl = wv + 8 * rep, pt = tl >> 2, qt = tl & 3;
                f32x4 acc = zero;
                if (pt <= qt) acc = mm16<64>(F + pt * 16 * LS, LS, S + qt * 16 * LS, LS, zero, lane);
                const int qi = qt * 16 + fr;
#pragma unroll
                for (int e = 0; e < 4; ++e) {
                    const int pi = pt * 16 + fq * 4 + e;
                    const bool keep = mode == 0 ? pi < qi : pi <= qi;
                    acc[e] = keep ? acc[e] : 0.f;
                }
                *(u32x2*)(O + qi * LS + pt * 16 + fq * 4) = pk4(acc);
                if (prod == 1) {
#pragma unroll
                    for (int e = 0; e < 4; ++e) RBUF(8)[(pt * 16 + fq * 4 + e) * LS + qi] = f2bf(acc[e]);
                }
            }
        }
        __syncthreads();
        if (wv == 0) r1_tri_inverse(RBUF(7), RBUF(8), RBUF(0), lane);
        else if (wv >= 4) {
#pragma unroll
            for (int pt = 0; pt < 4; ++pt) {
                const f32x4 x = mm16<64>(RBUF(6) + pt * 16 * LS, LS, RBUF(13) + (wv - 4) * 16 * LS, LS, zero, lane);
                *(u32x2*)(Xt0 + (wv * 16 + fr) * LS + pt * 16 + fq * 4) = pk4(x);
            }
        }
        __syncthreads();
        {
            const bf16_t* Tb = RBUF(0);
            const bf16x8 g0 = *(const bf16x8*)(Xt0 + (wv * 16 + fr) * LS + fq * 8), g1 = *(const bf16x8*)(Xt0 + (wv * 16 + fr) * LS + 32 + fq * 8);
            f32x4 X[4];
#pragma unroll
            for (int pt = 0; pt < 4; ++pt) {
                X[pt] = __builtin_amdgcn_mfma_f32_16x16x32_bf16(*(const bf16x8*)(Tb + (pt * 16 + fr) * LS + fq * 8), g0, zero, 0, 0, 0);
                if (pt >= 2) X[pt] = __builtin_amdgcn_mfma_f32_16x16x32_bf16(*(const bf16x8*)(Tb + (pt * 16 + fr) * LS + 32 + fq * 8), g1, X[pt], 0, 0, 0);
            }
#pragma unroll
            for (int pt = 0; pt < 4; ++pt) *(u32x2*)(Xt0 + (wv * 16 + fr) * LS + pt * 16 + fq * 4) = pk4(X[pt]);
        }
        __syncthreads();
#pragma unroll
        for (int rep = 0; rep < 2; ++rep) {
            const int tl = wv + 8 * rep, pt = tl >> 2, qt = tl & 3;
            const int pi0 = pt * 16 + fq * 4, qi = qt * 16 + fr;
            const size_t go = ((size_t)u * 64 + qi) * 64 + pi0;
            {
                f32x4 acc = mm16<64>(Xt0 + pt * 16 * LS, LS, RBUF(12) + qt * 16 * LS, LS, zero, lane);
                const float gc = gammaC[qi];
#pragma unroll
                for (int e = 0; e < 4; ++e) acc[e] = (acc[e] + (pi0 + e == qi ? 1.f : 0.f)) * gc;
                {
                    const size_t d = (((size_t)u * 8 + (qi >> 4) * 2 + (pi0 >> 5)) * 64 + (qi & 15) + 16 * ((pi0 >> 2) & 3)) * 8 + ((pi0 >> 4) & 1) * 4;
                    *(u32x2*)(p.PcG + d) = pk4(acc);
                }
            }
            {
                f32x4 acc = mm16<64>(RBUF(11) + pt * 16 * LS, LS, RBUF(13) + qt * 16 * LS, LS, zero, lane);
                acc = mm16<64>(RBUF(12) + pt * 16 * LS, LS, Xt0 + (64 + qt * 16) * LS, LS, acc, lane);
                const f32x4 gc = *(const f32x4*)(gammaC + pi0);
#pragma unroll
                for (int e = 0; e < 4; ++e) acc[e] *= gc[e];
                {
                    const size_t d = (((size_t)u * 4 + (qi >> 4)) * 64 + (qi & 15) + 16 * ((pi0 >> 2) & 3)) * 16 + (pi0 >> 4) * 4;
                    *(u32x2*)(p.QcG + d) = pk4(acc);
                }
            }
            {
                f32x4 acc = mm16<64>(Xt0 + pt * 16 * LS, LS, RBUF(10) + qt * 16 * LS, LS, zero, lane);
                const f32x4 rr = up4(*(const u32x2*)(RBUF(3) + qi * LS + pi0));
#pragma unroll
                for (int e = 0; e < 4; ++e) acc[e] += rr[e];
                *(u32x2*)(p.RhG + go) = pk4(acc);
            }
            {
                f32x4 acc = mm16<64>(RBUF(13) + pt * 16 * LS, LS, RBUF(9) + qt * 16 * LS, LS, zero, lane);
                acc = mm16<64>(Xt0 + (64 + pt * 16) * LS, LS, RBUF(10) + qt * 16 * LS, LS, acc, lane);
                *(u32x2*)(p.Y0G + go) = pk4(acc);
            }
        }
    }
}

struct R2Set { u32x4 a[8]; u32x4 q[2]; };
DI void r2_load(R2Set& st, const Params& p, size_t u, int lane, int vq) {
    const bf16_t* qg = p.QcG + ((u * 4 + vq) * 64 + lane) * 16;
    st.q[0] = *(const u32x4*)qg; st.q[1] = *(const u32x4*)(qg + 8);
#pragma unroll
    for (int f = 0; f < 8; ++f) st.a[f] = *(const u32x4*)(p.PcG + ((u * 8 + f) * 64 + lane) * 8);
}
DI void r2_step(f32x4 (&S)[4], const R2Set& st, const Params& p, size_t u, int lane, int vq, bool last) {
    const u32x4 b0 = (u32x4){pack2(S[0][0], S[0][1]), pack2(S[0][2], S[0][3]), pack2(S[1][0], S[1][1]), pack2(S[1][2], S[1][3])};
    const u32x4 b1 = (u32x4){pack2(S[2][0], S[2][1]), pack2(S[2][2], S[2][3]), pack2(S[3][0], S[3][1]), pack2(S[3][2], S[3][3])};
    bf16_t* sg = p.SG + ((u * 4 + vq) * 64 + lane) * 16;
    *(u32x4*)sg = b0; *(u32x4*)(sg + 8) = b1;
    if (last) return;
#pragma unroll
    for (int kt = 0; kt < 4; ++kt) {
        const u32x4 qq = st.q[kt >> 1];
        const unsigned w0 = qq[(kt & 1) * 2], w1 = qq[(kt & 1) * 2 + 1];
        S[kt] = (f32x4){lo_bf(w0), hi_bf(w0), lo_bf(w1), hi_bf(w1)};
    }
    const bf16x8 f0 = __builtin_bit_cast(bf16x8, b0), f1 = __builtin_bit_cast(bf16x8, b1);
#pragma unroll
    for (int kt = 0; kt < 4; ++kt) {
        S[kt] = __builtin_amdgcn_mfma_f32_16x16x32_bf16(__builtin_bit_cast(bf16x8, st.a[kt * 2]), f0, S[kt], 0, 0, 0);
        S[kt] = __builtin_amdgcn_mfma_f32_16x16x32_bf16(__builtin_bit_cast(bf16x8, st.a[kt * 2 + 1]), f1, S[kt], 0, 0, 0);
    }
}
DI void phase_rwkv_r2(const Params& p, int chain) {
    const int lane = tid_() & 63;
    const int bh = chain >> 2, vq = chain & 3;
    const size_t u0 = (size_t)bh * NCHUNK;
    f32x4 S[4];
#pragma unroll
    for (int kt = 0; kt < 4; ++kt) S[kt] = (f32x4){0.f, 0.f, 0.f, 0.f};
    R2Set A, B, C, E;
    r2_load(A, p, u0, lane, vq); r2_load(B, p, u0 + 1, lane, vq); r2_load(C, p, u0 + 2, lane, vq); r2_load(E, p, u0 + 3, lane, vq);
#define R2_ONE(SET, cc) do { r2_step(S, SET, p, u0 + (cc), lane, vq, (cc) == NCHUNK - 1); if ((cc) + 4 < NCHUNK - 1) r2_load(SET, p, u0 + (cc) + 4, lane, vq); } while (0)
#pragma unroll 1
    for (int c = 0; c < NCHUNK; c += 4) {
        R2_ONE(A, c);
        if (c == NCHUNK - 1) break;
        R2_ONE(B, c + 1);
        R2_ONE(C, c + 2);
        R2_ONE(E, c + 3);
    }
#undef R2_ONE
}

DI void phase_rwkv_r3(const Params& p, int layer, int bid, int nb) {
    const int tid = tid_(), lane = tid & 63, wv = __builtin_amdgcn_readfirstlane(tid >> 6), fr = lane & 15, fq = lane >> 4;
    constexpr int TPB = L / 16;
    for (int task = bid * 8 + wv; task < NBATCH * HEADS * TPB; task += nb * 8) {
        const int bh = task / TPB, tt = task % TPB, c = tt >> 2, it = tt & 3, u = bh * NCHUNK + c;
        const int h = bh % HEADS, bb = bh / HEADS;
        const int i = it * 16 + fr, t = c * 64 + i;
        const bool live = t < L;
        const size_t tok = (size_t)bb * L + (live ? t : 0);
        bf16x8 sf[2];
#pragma unroll
        for (int ks = 0; ks < 2; ++ks) sf[ks] = *(const bf16x8*)(p.RhG + ((size_t)u * 64 + i) * 64 + ks * 32 + fq * 8);
        u32x2 s0[4][2], s1[4][2], y0[4], xvv[4], gv[4];
#pragma unroll
        for (int vt = 0; vt < 4; ++vt) {
            const int vv = vt * 16 + fr;
#pragma unroll
            for (int ks = 0; ks < 2; ++ks) {
                const bf16_t* sp = p.SG + (((size_t)u * 4 + vt) * 64 + fr + 32 * (fq & 1)) * 16 + (2 * ks + (fq >> 1)) * 4;
                s0[vt][ks] = *(const u32x2*)sp; s1[vt][ks] = *(const u32x2*)(sp + 16 * 16);
                (void)vv;
            }
            y0[vt] = *(const u32x2*)(p.Y0G + ((size_t)u * 64 + i) * 64 + vt * 16 + fq * 4);
            xvv[vt] = *(const u32x2*)(p.orw + tok * 512 + h * 64 + vt * 16 + fq * 4);
            gv[vt] = *(const u32x2*)(p.GG + ((size_t)u * 64 + i) * 64 + vt * 16 + fq * 4);
        }
        const float bon = p.bonG[(size_t)u * 64 + i];
        f32x4 y[4];
#pragma unroll
        for (int vt = 0; vt < 4; ++vt) {
            y[vt] = up4(y0[vt]);
#pragma unroll
            for (int ks = 0; ks < 2; ++ks) {
                const bf16x8 f = __builtin_bit_cast(bf16x8, ((u32x4){s0[vt][ks][0], s0[vt][ks][1], s1[vt][ks][0], s1[vt][ks][1]}));
                y[vt] = __builtin_amdgcn_mfma_f32_16x16x32_bf16(f, sf[ks], y[vt], 0, 0, 0);
            }
        }
        float s = 0.f;
#pragma unroll
        for (int vt = 0; vt < 4; ++vt) s += (y[vt][0] + y[vt][1]) + (y[vt][2] + y[vt][3]);
        s += __shfl_xor(s, 16); s += __shfl_xor(s, 32);
        const float mean = s * (1.0f / 64.f);
        float q = 0.f;
#pragma unroll
        for (int vt = 0; vt < 4; ++vt)
#pragma unroll
            for (int e = 0; e < 4; ++e) { y[vt][e] -= mean; q += y[vt][e] * y[vt][e]; }
        q += __shfl_xor(q, 16); q += __shfl_xor(q, 32);
        const float rstd = rsqrtf(q * (1.0f / 64.f) + 64e-5f);
        if (live) {
#pragma unroll
            for (int vt = 0; vt < 4; ++vt) {
                const int cg = h * 64 + vt * 16 + fq * 4;
                const f32x4 xv = up4(xvv[vt]), g = up4(gv[vt]);
                const f32x4 lg = *(const f32x4*)(p.lnx_g + layer * 512 + cg), lb = *(const f32x4*)(p.lnx_b + layer * 512 + cg);
                f32x4 o;
#pragma unroll
                for (int e = 0; e < 4; ++e) o[e] = (y[vt][e] * rstd * lg[e] + lb[e] + bon * xv[e]) * g[e];
                *(u32x2*)(p.orw + tok * 512 + cg) = pk4(o);
            }
        }
    }
}

constexpr int SB_LDS = 4 * RB + 64;
DI void phase_sb(const Params& p, int bid0, int nb, char* smem) {
    const int tid = tid_(), lane = tid & 63, wv = __builtin_amdgcn_readfirstlane(tid >> 6), fr = lane & 15, fq = lane >> 4;
    bf16_t* Ks0 = (bf16_t*)smem;
    bf16_t* Vt0 = Ks0 + 2 * 64 * LS;
    int* flags = (int*)(smem + 4 * RB);
    bf16x8 tri[4][2];
#pragma unroll
    for (int st = 0; st < 4; ++st)
#pragma unroll
        for (int k2 = 0; k2 < 2; ++k2)
#pragma unroll
            for (int jj = 0; jj < 8; ++jj) tri[st][k2][jj] = (32 * k2 + 16 * (jj >> 2) + 4 * fq + (jj & 3) > 16 * st + fr) ? (short)0x3F80 : (short)0;
    constexpr int NQB = (L + 127) / 128;
    const int ldkey = tid >> 3, lddc = (tid & 7) * 8;
    for (int u = bid0; u < NBATCH * HEADS * NQB; u += nb) {
        const int bh = u % (NBATCH * HEADS), b = bh / HEADS, h = bh % HEADS, q0 = (NQB - 1 - u / (NBATCH * HEADS)) * 128;
        const int qlo = q0 + 16 * wv, query = qlo + fr;
        const size_t tokb = (size_t)b * L;
        bf16x8 qf[2];
#pragma unroll
        for (int ks = 0; ks < 2; ++ks) qf[ks] = *(const bf16x8*)(p.P + (tokb + query) * CP + OFF_Q + h * 64 + ks * 32 + fq * 8);
        const int qmax = (q0 + 127 < L - 1) ? q0 + 127 : L - 1;
        int kt = (qmax - 1) >> 6;
        float R = 0.f;
        f32x4 ot[4];
#pragma unroll
        for (int dt = 0; dt < 4; ++dt) ot[dt] = (f32x4){0.f, 0.f, 0.f, 0.f};
        bool done = qlo >= L;
        u32x4 kreg, vreg;
        {
            const int s = kt * 64 + ldkey;
            const bf16_t* src = p.P + (tokb + s) * CP + h * 64 + lddc;
            kreg = s < L ? *(const u32x4*)(src + OFF_K) : (u32x4){0u, 0u, 0u, 0u};
            vreg = s < L ? *(const u32x4*)(src + OFF_V) : (u32x4){0u, 0u, 0u, 0u};
        }
        const int vsw = (tid & 7) << 2;
        __syncthreads();
        {
            *(u32x4*)(Ks0 + ldkey * LS + lddc) = kreg;
#pragma unroll
            for (int j = 0; j < 4; ++j) { Vt0[(lddc + 2 * j) * LS + (ldkey ^ vsw)] = (bf16_t)(vreg[j] & 0xFFFFu); Vt0[(lddc + 2 * j + 1) * LS + (ldkey ^ vsw)] = (bf16_t)(vreg[j] >> 16); }
        }
        __syncthreads();
        for (int itile = 0;; ++itile) {
            const bf16_t* Ks = Ks0 + (itile & 1) * 64 * LS; const bf16_t* Vt = Vt0 + (itile & 1) * 64 * LS;
            if (kt > 0) {
                const int s = (kt - 1) * 64 + ldkey;
                const bf16_t* src = p.P + (tokb + s) * CP + h * 64 + lddc;
                kreg = *(const u32x4*)(src + OFF_K); vreg = *(const u32x4*)(src + OFF_V);
            }
            if (!done && kt * 64 < qlo + 15) {
                f32x4 uu[4], lsp[4];
                float tot = 0.f;
                const bool full = kt * 64 + 63 < qlo;
#pragma unroll
                for (int kk = 0; kk < 4; ++kk) {
                    f32x4 z = (f32x4){0.f, 0.f, 0.f, 0.f};
#pragma unroll
                    for (int ks = 0; ks < 2; ++ks) {
                        const bf16x8 f = *(const bf16x8*)(Ks + (16 * kk + fr) * LS + ks * 32 + fq * 8);
                        z = __builtin_amdgcn_mfma_f32_16x16x32_bf16(f, qf[ks], z, 0, 0, 0);
                    }
#pragma unroll
                    for (int e = 0; e < 4; ++e) {
                        const float zz = z[e] * 0.18033688011112042f;
                        const float lsneg = -(fmaxf(zz, 0.f) + __builtin_amdgcn_logf(1.0f + __builtin_amdgcn_exp2f(-fabsf(zz))));
                        if (full) { uu[kk][e] = lsneg; lsp[kk][e] = lsneg + zz; }
                        else {
                            const bool valid = kt * 64 + 16 * kk + 4 * fq + e < query;
                            uu[kk][e] = valid ? lsneg : 0.f;
                            lsp[kk][e] = valid ? lsneg + zz : -1.0e30f;
                        }
                        tot += uu[kk][e];
                    }
                }
                tot += __shfl_xor(tot, 16); tot += __shfl_xor(tot, 32);
                f32x4 rest[4];
#pragma unroll
                for (int st = 0; st < 4; ++st) rest[st] = (f32x4){0.f, 0.f, 0.f, 0.f};
#pragma unroll
                for (int k2 = 0; k2 < 2; ++k2) {
                    u32x4 hi, lo;
#pragma unroll
                    for (int t2 = 0; t2 < 2; ++t2) {
                        const f32x4 a = uu[2 * k2 + t2];
                        const unsigned h0 = pack2(a[0], a[1]), h1 = pack2(a[2], a[3]);
                        hi[2 * t2] = h0; hi[2 * t2 + 1] = h1;
                        lo[2 * t2] = pack2(a[0] - lo_bf(h0), a[1] - hi_bf(h0)); lo[2 * t2 + 1] = pack2(a[2] - lo_bf(h1), a[3] - hi_bf(h1));
                    }
                    const bf16x8 fh = __builtin_bit_cast(bf16x8, hi), fl = __builtin_bit_cast(bf16x8, lo);
#pragma unroll
                    for (int st = 0; st < 4; ++st) {
                        rest[st] = __builtin_amdgcn_mfma_f32_16x16x32_bf16(tri[st][k2], fh, rest[st], 0, 0, 0);
                        rest[st] = __builtin_amdgcn_mfma_f32_16x16x32_bf16(tri[st][k2], fl, rest[st], 0, 0, 0);
                    }
                }
                bf16x8 af[2];
#pragma unroll
                for (int k2 = 0; k2 < 2; ++k2) {
                    u32x4 pk;
#pragma unroll
                    for (int t2 = 0; t2 < 2; ++t2) {
                        const int kk = 2 * k2 + t2;
                        float a4[4];
#pragma unroll
                        for (int e = 0; e < 4; ++e) a4[e] = __builtin_amdgcn_exp2f(lsp[kk][e] + R + rest[kk][e]);
                        pk[2 * t2] = pack2(a4[0], a4[1]); pk[2 * t2 + 1] = pack2(a4[2], a4[3]);
                    }
                    af[k2] = __builtin_bit_cast(bf16x8, pk);
                }
                R += tot;
#pragma unroll
                for (int dt = 0; dt < 4; ++dt)
#pragma unroll
                    for (int k2 = 0; k2 < 2; ++k2) {
                        const int dsw = ((2 * dt + (fr >> 3)) & 7) << 2;
                        const bf16_t* vrow = Vt + (16 * dt + fr) * LS;
                        const u32x2 v0 = *(const u32x2*)(vrow + ((32 * k2 + 4 * fq) ^ dsw)), v1 = *(const u32x2*)(vrow + ((32 * k2 + 16 + 4 * fq) ^ dsw));
                        const bf16x8 f = __builtin_bit_cast(bf16x8, ((u32x4){v0[0], v0[1], v1[0], v1[1]}));
                        ot[dt] = __builtin_amdgcn_mfma_f32_16x16x32_bf16(f, af[k2], ot[dt], 0, 0, 0);
                    }
                done = __all((R < -150.1f) || (query >= L));
            }
            if (kt > 0) {
                bf16_t* Kn = Ks0 + ((itile & 1) ^ 1) * 64 * LS; bf16_t* Vn = Vt0 + ((itile & 1) ^ 1) * 64 * LS;
                *(u32x4*)(Kn + ldkey * LS + lddc) = kreg;
#pragma unroll
                for (int j = 0; j < 4; ++j) { Vn[(lddc + 2 * j) * LS + (ldkey ^ vsw)] = (bf16_t)(vreg[j] & 0xFFFFu); Vn[(lddc + 2 * j + 1) * LS + (ldkey ^ vsw)] = (bf16_t)(vreg[j] >> 16); }
            }
            if (lane == 0) flags[(itile & 1) * 8 + wv] = done ? 1 : 0;
            __syncthreads();
            int alld = 1;
#pragma unroll
            for (int w = 0; w < 8; ++w) alld &= flags[(itile & 1) * 8 + w];
            if (alld || kt == 0) break;
            --kt;
        }
        if (query < L) {
#pragma unroll
            for (int dt = 0; dt < 4; ++dt) *(u32x2*)(p.osb + (tokb + query) * 512 + h * 64 + 16 * dt + 4 * fq) = pk4(ot[dt]);
        }
    }
}

struct EpiBranch {
    static constexpr bool PERM = true;
    const bf16_t* G; bf16_t* M; bool add;
    DI void operator()(const f32x4 (&acc)[2][2][4][2], const g8::Unit& u, int wr, int wc, int fr, int fq) const {
        const int c0 = u.pn * 256 + wc * 32 + 8 * fq;
#pragma unroll
        for (int ai = 0; ai < 2; ++ai) {
            u32x4 g[4][2], mo[4][2];
#pragma unroll
            for (int m = 0; m < 4; ++m)
#pragma unroll
                for (int bj = 0; bj < 2; ++bj) {
                    const size_t r = (size_t)(u.pm * 256 + ai * 128 + wr * 64 + m * 16 + fr);
                    g[m][bj] = *(const u32x4*)(G + r * 2048 + c0 + bj * 128);
                    mo[m][bj] = add ? *(const u32x4*)(M + r * D + c0 + bj * 128) : (u32x4){0u, 0u, 0u, 0u};
                }
#pragma unroll
            for (int m = 0; m < 4; ++m)
#pragma unroll
                for (int bj = 0; bj < 2; ++bj) {
                    const size_t r = (size_t)(u.pm * 256 + ai * 128 + wr * 64 + m * 16 + fr);
                    const f32x4 v0 = acc[ai][bj][m][0], v1 = acc[ai][bj][m][1];
                    const u32x4 gg = g[m][bj], mm = mo[m][bj];
                    float o[8] = {lo_bf(gg[0]) * v0[0], hi_bf(gg[0]) * v0[1], lo_bf(gg[1]) * v0[2], hi_bf(gg[1]) * v0[3], lo_bf(gg[2]) * v1[0], hi_bf(gg[2]) * v1[1], lo_bf(gg[3]) * v1[2], hi_bf(gg[3]) * v1[3]};
#pragma unroll
                    for (int q = 0; q < 4; ++q) { o[2 * q] += lo_bf(mm[q]); o[2 * q + 1] += hi_bf(mm[q]); }
                    *(u32x4*)(M + r * D + c0 + bj * 128) = (u32x4){pack2(o[0], o[1]), pack2(o[2], o[3]), pack2(o[4], o[5]), pack2(o[6], o[7])};
                }
        }
    }
};
struct GateOrder {
    g8::DenseOrder d;
    DI bool next(int i, g8::Unit& u) const { return d.next(i, u); }
    DI unsigned row_off(const g8::Unit&, int) const { return 0u; }
};
struct EpiGate {
    static constexpr bool PERM = true;
    bf16_t* G;
    DI void operator()(const f32x4 (&acc)[2][2][4][2], const g8::Unit& u, int wr, int wc, int fr, int fq) const {
#pragma unroll
        for (int ai = 0; ai < 2; ++ai)
#pragma unroll
            for (int m = 0; m < 4; ++m) {
                bf16_t* rowp = G + (size_t)(u.pm * 256 + ai * 128 + wr * 64 + m * 16 + fr) * 2048 + u.pn * 256 + wc * 32 + 8 * fq;
#pragma unroll
                for (int bj = 0; bj < 2; ++bj) {
                    const f32x4 v0 = acc[ai][bj][m][0], v1 = acc[ai][bj][m][1];
                    *(u32x4*)(rowp + bj * 128) = (u32x4){pack2(sigmoidf_(v0[0]), sigmoidf_(v0[1])), pack2(sigmoidf_(v0[2]), sigmoidf_(v0[3])), pack2(sigmoidf_(v1[0]), sigmoidf_(v1[1])), pack2(sigmoidf_(v1[2]), sigmoidf_(v1[3]))};
                }
            }
    }
};
template <int PART> DI void phase_merge(const Params& p, int layer, int bid, int nb, char* smem) {
    const bf16_t* hb = p.hb; bf16_t* G = p.gates; bf16_t* M = p.merged;
    const bf16_t* Wg = p.WtIn + ((size_t)layer * CIN + CP) * D;
    G8_LAS unsigned char* lds = (G8_LAS unsigned char*)smem;
    if (PART == 0) {
#pragma unroll
    for (int which = 0; which < 2; ++which) {
        g8::DenseOrder S; S.init(hb, Wg + (size_t)which * 1024 * D, MFULL, D / 256, D, nb, bid);
        g8::gemm8<false>(lds, D, S, EpiGate{G + which * 1024});
    }
    }
    if (PART == 1) {
#pragma unroll
    for (int which = 0; which < 2; ++which) {
        const bf16_t* A = which ? p.orw : p.osb;
        const bf16_t* Bt = (which ? p.WtPrw : p.WtPsb) + (size_t)layer * D * 512;
        g8::DenseOrder S; S.init(A, Bt, MFULL, D / 256, 512, nb, bid);
        g8::gemm8<false>(lds, 512, S, EpiBranch{G + which * 1024, M, which != 0});
    }
    }
    if (PART == 1)
    for (int t = left_first(MFULL * 4 * 2, bid, nb); t < D / 128; t += nb) {
#pragma unroll
        for (int which = 0; which < 2; ++which) {
            const bf16_t* A = which ? p.orw : p.osb; const bf16_t* Gw = p.gleft - (size_t)M0_LEFT * 2048 + which * 1024;
            const bf16_t* Bt = (which ? p.WtPrw : p.WtPsb) + (size_t)layer * D * 512;
            gemm_left32([=](int r) { return A + (size_t)(M0_LEFT + r) * 512; }, Bt, 512, 512, t * 128, smem,
                        [=](int r0, int c, f32x4 v) {
                            const size_t r = (size_t)(M0_LEFT + r0);
                            const u32x2 g = *(const u32x2*)(Gw + r * 2048 + c);
                            float o0 = lo_bf(g[0]) * v[0], o1 = hi_bf(g[0]) * v[1], o2 = lo_bf(g[1]) * v[2], o3 = hi_bf(g[1]) * v[3];
                            u32x2* mp = (u32x2*)(M + r * D + c);
                            if (which) { const u32x2 m = *mp; o0 += lo_bf(m[0]); o1 += hi_bf(m[0]); o2 += lo_bf(m[1]); o3 += hi_bf(m[1]); }
                            *mp = (u32x2){pack2(o0, o1), pack2(o2, o3)};
                        });
        }
    }
}
struct EpiOut {
    static constexpr bool PERM = true;
    bf16_t* hb;
    DI void operator()(const f32x4 (&acc)[2][2][4][2], const g8::Unit& u, int wr, int wc, int fr, int fq) const {
        const int c0 = u.pn * 256 + wc * 32 + 8 * fq;
#pragma unroll
        for (int ai = 0; ai < 2; ++ai) {
            u32x4 hv[4][2];
#pragma unroll
            for (int m = 0; m < 4; ++m)
#pragma unroll
                for (int bj = 0; bj < 2; ++bj) hv[m][bj] = *(const u32x4*)(hb + (size_t)(u.pm * 256 + ai * 128 + wr * 64 + m * 16 + fr) * D + c0 + bj * 128);
#pragma unroll
            for (int m = 0; m < 4; ++m)
#pragma unroll
                for (int bj = 0; bj < 2; ++bj) {
                    const u32x4 h = hv[m][bj]; const f32x4 v0 = acc[ai][bj][m][0], v1 = acc[ai][bj][m][1];
                    *(u32x4*)(hb + (size_t)(u.pm * 256 + ai * 128 + wr * 64 + m * 16 + fr) * D + c0 + bj * 128) =
                        (u32x4){pack2(ALPHA * lo_bf(h[0]) + v0[0], ALPHA * hi_bf(h[0]) + v0[1]), pack2(ALPHA * lo_bf(h[1]) + v0[2], ALPHA * hi_bf(h[1]) + v0[3]),
                                pack2(ALPHA * lo_bf(h[2]) + v1[0], ALPHA * hi_bf(h[2]) + v1[1]), pack2(ALPHA * lo_bf(h[3]) + v1[2], ALPHA * hi_bf(h[3]) + v1[3])};
                }
        }
    }
};
DI void phase_outproj(const Params& p, int layer, int bid, int nb, char* smem) {
    const bf16_t* A = p.merged; bf16_t* const hbres = p.hb;
    const bf16_t* Bt = p.WtOut + (size_t)layer * D * D;
    if (bid == 0 && tid_() < NE) p.counts[tid_()] = 0;
    g8::DenseOrder S; S.init(A, Bt, MFULL, D / 256, D, nb, bid);
    g8::gemm8<false>((G8_LAS unsigned char*)smem, D, S, EpiOut{hbres});
    for (int t = left_first(MFULL * 4, bid, nb); t < D / 128; t += nb)
        gemm_left32([=](int r) { return A + (size_t)(M0_LEFT + r) * D; }, Bt, D, D, t * 128, smem,
                    [=](int r0, int c, f32x4 v) {
                        const int r = M0_LEFT + r0;
                        u32x2* hp = (u32x2*)(hbres + (size_t)r * D + c);
                        const f32x4 h = up4(*hp);
                        *hp = (u32x2){pack2(ALPHA * h[0] + v[0], ALPHA * h[1] + v[1]), pack2(ALPHA * h[2] + v[2], ALPHA * h[3] + v[3])};
                    });
}

constexpr int LN1_ROWB = 2 * D + 16;
constexpr int LN1_WAVE = 8 * LN1_ROWB;
constexpr int LN1_LDS = 8 * LN1_WAVE + 2048;
DI void phase_ln1_router(const Params& p, int layer, int bid, int nb, char* smem) {
    const int tid = tid_(), lane = tid & 63, wid = __builtin_amdgcn_readfirstlane(tid >> 6), fr = lane & 15, fq = lane >> 4;
    char* wl = smem + wid * LN1_WAVE;
    int* sel = (int*)(smem + 8 * LN1_WAVE);
    float* sgt = (float*)(smem + 8 * LN1_WAVE + 640);
    int* sbase = (int*)(smem + 8 * LN1_WAVE + 1280);
    const int nwaves = nb * 8, gw = bid * 8 + wid;
    const int base_n = T / nwaves, extra = T % nwaves;
    const int tok0 = gw * base_n + (gw < extra ? gw : extra), ntok = base_n + (gw < extra ? 1 : 0);
    const int btok0 = bid * 8 * base_n + (bid * 8 < extra ? bid * 8 : extra);
    const float* g1p = p.ln1_g + layer * D; const float* b1p = p.ln1_b + layer * D;
    __syncthreads();
    for (int g0 = 0; g0 < ntok; g0 += 8) {
        const int ng = ntok - g0 < 8 ? ntok - g0 : 8;
        float vn[16];
        { const bf16_t* hf = p.hb + (size_t)(tok0 + g0) * D;
#pragma unroll
          for (int j = 0; j < 4; ++j) { const f32x4 a = up4(*(const u32x2*)(hf + 256 * j + 4 * lane)); vn[4 * j] = a[0]; vn[4 * j + 1] = a[1]; vn[4 * j + 2] = a[2]; vn[4 * j + 3] = a[3]; } }
#pragma unroll 1
        for (int i = 0; i < ng; ++i) {
            const int tok = tok0 + g0 + i;
            float v[16];
#pragma unroll
            for (int q = 0; q < 16; ++q) v[q] = vn[q];
            if (i + 1 < ng) { const bf16_t* hn = p.hb + (size_t)(tok + 1) * D;
#pragma unroll
                for (int j = 0; j < 4; ++j) { const f32x4 a = up4(*(const u32x2*)(hn + 256 * j + 4 * lane)); vn[4 * j] = a[0]; vn[4 * j + 1] = a[1]; vn[4 * j + 2] = a[2]; vn[4 * j + 3] = a[3]; } }
            ln16(v, g1p, b1p, lane);
#pragma unroll
            for (int j = 0; j < 4; ++j) {
                const unsigned h0 = pack2(v[4 * j], v[4 * j + 1]), h1 = pack2(v[4 * j + 2], v[4 * j + 3]);
                *(u32x2*)(p.hb + (size_t)tok * D + 256 * j + 4 * lane) = (u32x2){h0, h1};
                *(u32x2*)(wl + i * LN1_ROWB + (256 * j + 4 * lane) * 2) = (u32x2){h0, h1};
            }
        }
        asm volatile("s_waitcnt lgkmcnt(0)" ::: "memory");
        __builtin_amdgcn_wave_barrier();
        f32x4 acc[2] = {(f32x4){0.f, 0.f, 0.f, 0.f}, (f32x4){0.f, 0.f, 0.f, 0.f}};
        const char* arow = wl + (fr & 7) * LN1_ROWB + fq * 16;
        const bf16_t* whi = p.RwHi + (size_t)fr * D + fq * 8;
#pragma unroll 4
        for (int ks = 0; ks < 32; ++ks) {
            const bf16x8 ah = *(const bf16x8*)(arow + ks * 64);
            const bf16x8 bh = *(const bf16x8*)(whi + ks * 32);
            acc[ks & 1] = __builtin_amdgcn_mfma_f32_16x16x32_bf16(bh, ah, acc[ks & 1], 0, 0, 0);
        }
        float lg[4]; float mx = -3.0e38f;
#pragma unroll
        for (int e = 0; e < 4; ++e) { lg[e] = acc[0][e] + acc[1][e] + p.router_b[4 * fq + e]; mx = fmaxf(mx, lg[e]); }
        mx = fmaxf(mx, __shfl_xor(mx, 16)); mx = fmaxf(mx, __shfl_xor(mx, 32));
        float sum = 0.f;
#pragma unroll
        for (int e = 0; e < 4; ++e) { lg[e] = __expf(lg[e] - mx); sum += lg[e]; }
        sum += __shfl_xor(sum, 16); sum += __shfl_xor(sum, 32);
        const float inv = 1.0f / sum;
        float v1 = -1.f, v2 = -1.f; int i1 = 0, i2 = 0;
#pragma unroll
        for (int e = 0; e < 4; ++e) {
            const float pv = lg[e] * inv;
            if (pv > v1) { v2 = v1; i2 = i1; v1 = pv; i1 = e; } else if (pv > v2) { v2 = pv; i2 = e; }
        }
        const float sc = v1 + v2;
        float bsc = sc; int bg = fq;
#pragma unroll
        for (int m = 16; m <= 32; m <<= 1) {
            const float os = __shfl_xor(bsc, m); const int og = __shfl_xor(bg, m);
            if (os > bsc || (os == bsc && og < bg)) { bsc = os; bg = og; }
        }
        if (bg == fq && fr < ng) {
            const int li = tok0 + g0 + fr - btok0;
            const float gs = 1.0f / (v1 + v2);
            sel[li * 2] = 4 * fq + i1; sel[li * 2 + 1] = 4 * fq + i2; sgt[li * 2] = v1 * gs; sgt[li * 2 + 1] = v2 * gs;
        }
        asm volatile("s_waitcnt lgkmcnt(0)" ::: "memory");
        __builtin_amdgcn_wave_barrier();
    }
    __syncthreads();
    if (wid == 0) {
        const int nbt = 8 * base_n + ((bid * 8 + 8 <= extra) ? 8 : (bid * 8 < extra ? extra - bid * 8 : 0));
        for (int c0 = 0; c0 < nbt; c0 += 64) {
            const int li = c0 + lane; const bool on = li < nbt;
            const int e1 = on ? sel[li * 2] : -1, e2 = on ? sel[li * 2 + 1] : -1;
            const unsigned long long lt = (1ull << lane) - 1ull;
            int r1 = 0, r2 = 0, mycnt = 0;
#pragma unroll
            for (int e = 0; e < NE; ++e) {
                const unsigned long long m1 = __ballot(e1 == e), m2 = __ballot(e2 == e);
                const int c1 = __popcll(m1), c2 = __popcll(m2);
                if (e1 == e) r1 = __popcll(m1 & lt);
                if (e2 == e) r2 = c1 + __popcll(m2 & lt);
                if (lane == e) mycnt = c1 + c2;
            }
            if (lane < NE) sbase[lane] = mycnt > 0 ? atomicAdd(&p.counts[lane], mycnt) : 0;
            asm volatile("s_waitcnt vmcnt(0) lgkmcnt(0)" ::: "memory");
            __builtin_amdgcn_wave_barrier();
            if (on) {
                const int tok = btok0 + li;
                const int s1 = sbase[e1] + r1, s2 = sbase[e2] + r2;
                p.list[e1 * T + s1] = tok * 2; p.list[e2 * T + s2] = tok * 2 + 1;
                p.tokg[tok * 2] = sgt[li * 2]; p.tokg[tok * 2 + 1] = sgt[li * 2 + 1];
            }
            asm volatile("s_waitcnt lgkmcnt(0)" ::: "memory");
            __builtin_amdgcn_wave_barrier();
        }
    }
}

constexpr int MOE_BIG = 8;
template <bool UP> struct MoeOrder {
    const int* counts; const int* list; int G, c; const char* A; const char* B;
    DI bool next(int i, g8::Unit& u) const {
        const int xcd = c & 7, w = c >> 3, mt = (w >> 1) & 7, pn = 2 * (w & 1) + i, esel = xcd + 8 * (w >> 4);
        if (w >= 32 || i >= 2) return false;
        int padp = 0, fe = -1, fc = 0, fp = 0;
#pragma unroll
        for (int e = 0; e < NE; ++e) {
            const int cn = counts[e], ntp = (cn + 255) >> 8, nt = ntp < MOE_BIG ? ntp : MOE_BIG;
            const bool hit = (e == esel) && (mt < nt);
            fe = hit ? e : fe; fc = hit ? cn : fc; fp = hit ? padp + mt : fp;
            padp += ntp;
        }
        fe = __builtin_amdgcn_readfirstlane(fe); fc = __builtin_amdgcn_readfirstlane(fc); fp = __builtin_amdgcn_readfirstlane(fp);
        if (fe < 0) return false;
        u.e = fe; u.slot0 = mt * 256; u.cnt = fc; u.pm = fp; u.pn = pn;
        u.A = UP ? A : A + (size_t)fp * ((size_t)256 * DE * 2);
        u.B = UP ? B + (size_t)fe * ((size_t)1024 * 1024 * 2) + (size_t)pn * ((size_t)256 * D * 2) : B + (size_t)fe * ((size_t)1024 * 512 * 2) + (size_t)pn * ((size_t)256 * DE * 2);
        return true;
    }
    DI unsigned row_off(const g8::Unit& u, int r) const {
        const __amdgpu_buffer_rsrc_t rs = __builtin_amdgcn_make_buffer_rsrc((void*)list, 0, NE * T * 4, 0x00020000);
        const int ent = __builtin_amdgcn_raw_buffer_load_b32(rs, r * 4, (u.e * T + u.slot0) * 4, 0);
        return u.slot0 + r < u.cnt ? (unsigned)(ent >> 1) * (unsigned)(D * 2) : 0u;
    }
};
struct EpiMoeUp {
    static constexpr bool PERM = true;
    bf16_t* hid;
    DI void operator()(const f32x4 (&acc)[2][2][4][2], const g8::Unit& u, int wr, int wc, int fr, int fq) const {
#pragma unroll
        for (int ai = 0; ai < 2; ++ai)
#pragma unroll
            for (int m = 0; m < 4; ++m) {
                const int r = ai * 128 + wr * 64 + m * 16 + fr;
                if (u.slot0 + r >= u.cnt) continue;
                bf16_t* rowp = hid + ((size_t)u.pm * 256 + r) * DE + ((u.pn * 256 + wc * 32 + 8 * fq) >> 1);
#pragma unroll
                for (int bj = 0; bj < 2; ++bj) {
                    const f32x4 v0 = acc[ai][bj][m][0], v1 = acc[ai][bj][m][1];
                    *(u32x2*)(rowp + bj * 64) = (u32x2){pack2(v0[0] * sigmoidf_(v0[0]) * v0[1], v0[2] * sigmoidf_(v0[2]) * v0[3]), pack2(v1[0] * sigmoidf_(v1[0]) * v1[1], v1[2] * sigmoidf_(v1[2]) * v1[3])};
                }
            }
    }
};
struct EpiMoeDown {
    static constexpr bool PERM = true;
    bf16_t* fo; const int* list; const float* tokg;
    DI void operator()(const f32x4 (&acc)[2][2][4][2], const g8::Unit& u, int wr, int wc, int fr, int fq) const {
        int ent[8]; float g[8];
#pragma unroll
        for (int q = 0; q < 8; ++q) {
            const int sl = u.slot0 + (q >> 2) * 128 + wr * 64 + (q & 3) * 16 + fr;
            ent[q] = sl < u.cnt ? list[u.e * T + sl] : -1;
        }
#pragma unroll
        for (int q = 0; q < 8; ++q) g[q] = ent[q] >= 0 ? tokg[ent[q]] : 0.f;
#pragma unroll
        for (int ai = 0; ai < 2; ++ai)
#pragma unroll
            for (int m = 0; m < 4; ++m) {
                const int q = ai * 4 + m;
                if (ent[q] < 0) continue;
                const float gg = g[q];
                bf16_t* rowp = fo + ((size_t)(ent[q] & 1) * TP + (ent[q] >> 1)) * D + u.pn * 256 + wc * 32 + 8 * fq;
#pragma unroll
                for (int bj = 0; bj < 2; ++bj) {
                    const f32x4 v0 = acc[ai][bj][m][0], v1 = acc[ai][bj][m][1];
                    *(u32x4*)(rowp + bj * 128) = (u32x4){pack2(gg * v0[0], gg * v0[1]), pack2(gg * v0[2], gg * v0[3]), pack2(gg * v1[0], gg * v1[1]), pack2(gg * v1[2], gg * v1[3])};
                }
            }
    }
};
DI void phase_moe_up(const Params& p, int bid, int nb, char* smem) {
    const MoeOrder<true> S{p.counts, p.list, nb, bid, (const char*)p.hb, (const char*)p.WtGU};
    g8::gemm8<true>((G8_LAS unsigned char*)smem, D, S, EpiMoeUp{p.hid});
    const bf16_t* hb = p.hb; bf16_t* hid = p.hid; const int* list = p.list;
    int big = 0, padr = 0, job = 0;
#pragma unroll 1
    for (int e = 0; e < NE; ++e) { const int cn = p.counts[e], ntp = (cn + 255) >> 8; big += (ntp < MOE_BIG ? ntp : MOE_BIG) * 4; }
    const int mine = bid; (void)big;
#pragma unroll 1
    for (int e = 0; e < NE; ++e) {
        const int cn = p.counts[e];
        for (int s0 = MOE_BIG * 256; s0 < cn; s0 += 128)
            for (int nt = 0; nt < 8; ++nt, ++job)
                if (job % nb == mine) {
                    const int prow = padr;
                    gemm_tile128([=](int r) { const int sl = s0 + r; return sl < cn ? hb + (size_t)(list[e * T + sl] >> 1) * D : (const bf16_t*)nullptr; },
                                 p.WtGU + (size_t)e * 1024 * 1024, D, D, 0, nt * 128, smem,
                                 [=](int r, int c, f32x4 v) {
                                     const int sl = s0 + r;
                                     if (sl >= cn) return;
                                     *(unsigned*)(hid + (size_t)(prow + sl) * DE + (c >> 1)) = pack2(v[0] * sigmoidf_(v[0]) * v[1], v[2] * sigmoidf_(v[2]) * v[3]);
                                 });
                }
        padr += ((cn + 255) >> 8) * 256;
    }
}
DI void phase_moe_down(const Params& p, int bid, int nb, char* smem) {
    const MoeOrder<false> S{p.counts, p.list, nb, bid, (const char*)p.hid, (const char*)p.WtD};
    g8::gemm8<false>((G8_LAS unsigned char*)smem, DE, S, EpiMoeDown{p.fo, p.list, p.tokg});
    const bf16_t* hid = p.hid; bf16_t* fo = p.fo; const int* list = p.list; const float* tokg = p.tokg;
    int big = 0, padr = 0, job = 0;
#pragma unroll 1
    for (int e = 0; e < NE; ++e) { const int cn = p.counts[e], ntp = (cn + 255) >> 8; big += (ntp < MOE_BIG ? ntp : MOE_BIG) * 4; }
    const int mine = bid; (void)big;
#pragma unroll 1
    for (int e = 0; e < NE; ++e) {
        const int cn = p.counts[e];
        for (int s0 = MOE_BIG * 256; s0 < cn; s0 += 128)
            for (int nt = 0; nt < 8; ++nt, ++job)
                if (job % nb == mine) {
                    const int prow = padr;
                    gemm_tile128([=](int r) { const int sl = s0 + r; return sl < cn ? hid + (size_t)(prow + sl) * DE : (const bf16_t*)nullptr; },
                                 p.WtD + (size_t)e * 1024 * 512, DE, DE, 0, nt * 128, smem,
                                 [=](int r, int c, f32x4 v) {
                                     const int sl = s0 + r;
                                     if (sl >= cn) return;
                                     const int ent = list[e * T + sl];
                                     const float g = tokg[ent];
                                     *(u32x2*)(fo + ((size_t)(ent & 1) * TP + (ent >> 1)) * D + c) = (u32x2){pack2(g * v[0], g * v[1]), pack2(g * v[2], g * v[3])};
                                 });
                }
        padr += ((cn + 255) >> 8) * 256;
    }
}
DI void phase_ln2(const Params& p, int layer, int bid, int nb) {
    const int lane = tid_() & 63, wid = __builtin_amdgcn_readfirstlane(tid_() >> 6);
    const int nwaves = nb * 8, gw = bid * 8 + wid, base_n = T / nwaves, extra = T % nwaves;
    const int tok0 = gw * base_n + (gw < extra ? gw : extra), ntok = base_n + (gw < extra ? 1 : 0);
    u32x2 an[4], f0n[4], f1n[4];
    {
#pragma unroll
        for (int j = 0; j < 4; ++j) {
            an[j] = *(const u32x2*)(p.hb + (size_t)tok0 * D + 256 * j + 4 * lane);
            f0n[j] = *(const u32x2*)(p.fo + (size_t)tok0 * D + 256 * j + 4 * lane); f1n[j] = *(const u32x2*)(p.fo + ((size_t)TP + tok0) * D + 256 * j + 4 * lane);
        }
    }
#pragma unroll 1
    for (int i = 0; i < ntok; ++i) {
        const int tok = tok0 + i;
        float v[16];
#pragma unroll
        for (int j = 0; j < 4; ++j) {
            v[4 * j] = ALPHA * lo_bf(an[j][0]) + lo_bf(f0n[j][0]) + lo_bf(f1n[j][0]); v[4 * j + 1] = ALPHA * hi_bf(an[j][0]) + hi_bf(f0n[j][0]) + hi_bf(f1n[j][0]);
            v[4 * j + 2] = ALPHA * lo_bf(an[j][1]) + lo_bf(f0n[j][1]) + lo_bf(f1n[j][1]); v[4 * j + 3] = ALPHA * hi_bf(an[j][1]) + hi_bf(f0n[j][1]) + hi_bf(f1n[j][1]);
        }
        if (i + 1 < ntok) {
#pragma unroll
            for (int j = 0; j < 4; ++j) {
                an[j] = *(const u32x2*)(p.hb + (size_t)(tok + 1) * D + 256 * j + 4 * lane);
                f0n[j] = *(const u32x2*)(p.fo + (size_t)(tok + 1) * D + 256 * j + 4 * lane); f1n[j] = *(const u32x2*)(p.fo + ((size_t)TP + tok + 1) * D + 256 * j + 4 * lane);
            }
        }
        ln16(v, p.ln2_g + layer * D, p.ln2_b + layer * D, lane);
        if (layer == DEPTH - 1) {
            float* of = hrow_u(p, tok);
#pragma unroll
            for (int j = 0; j < 4; ++j) *(f32x4*)(of + 256 * j + 4 * lane) = (f32x4){v[4 * j], v[4 * j + 1], v[4 * j + 2], v[4 * j + 3]};
        } else store_row_bf(p.hb + (size_t)tok * D, v, lane);
    }
}

extern __shared__ __attribute__((aligned(16))) char dyn_smem[];
constexpr int SMEM_MAIN = R1_LDS > GEMM_LDS ? R1_LDS : GEMM_LDS;
constexpr int SMEM_BYTES = SMEM_MAIN + 16;

__global__ void __launch_bounds__(NTHR, 2) k_forward(Params p) {
    const int bid = blockIdx.x, nb = gridDim.x;
    char* smem = dyn_smem;
    uint4* xbw = (uint4*)(dyn_smem + SMEM_MAIN);
    if (threadIdx.x == 0) *xbw = make_uint4(0u, 0u, 0u, 0u);
    __syncthreads();
    XcdBarrier bar = xcd_barrier_post(p.bar, (volatile LAS unsigned*)xbw);
    phase_prologue_weights(p, bid, nb, smem);
    phase_embed(p, bid, nb);
    xcd_barrier(bar);
    for (int l = 0; l < DEPTH; ++l) {
        phase_inproj(p, l, bid, nb, smem);
        xcd_barrier(bar);
        phase_rwkv_r1<0>(p, l, bid, nb, smem);
        xcd_barrier(bar);
        if (bid < 16) { const int cw = __builtin_amdgcn_readfirstlane(tid_() >> 6); if (cw < 4) phase_rwkv_r2(p, bid * 4 + cw); }
        else {
            const int sbid = bid - 16, snb = nb - 16, heavy = (NBATCH * HEADS * ((L + 127) / 128)) % snb;
            if (sbid >= heavy && sbid < heavy + NBATCH * HEADS) phase_rwkv_r1<1>(p, l, sbid - heavy, 1, smem);
            phase_sb(p, sbid, snb, smem);
        }
        xcd_barrier(bar);
        phase_rwkv_r3(p, l, bid, nb);
        convert_experts(p, l, NE / 2, NE, bid, nb, smem);
        phase_merge<0>(p, l, bid, nb, smem);
        xcd_barrier(bar);
        phase_merge<1>(p, l, bid, nb, smem);
        xcd_barrier(bar);
        phase_outproj(p, l, bid, nb, smem);
        xcd_barrier(bar);
        phase_ln1_router(p, l, bid, nb, smem);
        xcd_barrier(bar);
        phase_moe_up(p, bid, nb, smem);
        xcd_barrier(bar);
        phase_moe_down(p, bid, nb, smem);
        xcd_barrier(bar);
        phase_ln2(p, l, bid, nb);
        xcd_barrier(bar);
    }
}

extern "C" void kernel_launch(void* const* d_in, const int* in_sizes, int n_in, void* d_out, int out_size, void* d_ws, size_t ws_size, hipStream_t stream) {
    (void)in_sizes; (void)n_in; (void)out_size;
    Params p;
    memset(&p, 0, sizeof(p));
    const float* const* in = (const float* const*)d_in;
    p.x = in[0]; p.meta = in[1]; p.emb_g = in[2]; p.emb_b = in[3]; p.w_in = in[4]; p.mu = in[5]; p.w0 = in[6]; p.w_up = in[7]; p.a0 = in[8]; p.a_up = in[9];
    p.g_up = in[10]; p.k_k = in[11]; p.k_a = in[12]; p.r_k = in[13]; p.lnx_g = in[14]; p.lnx_b = in[15]; p.p_sb = in[16]; p.p_rwkv = in[17]; p.w_out = in[18];
    p.ln1_g = in[19]; p.ln1_b = in[20]; p.router_w = in[21]; p.router_b = in[22]; p.ew_gate = in[23]; p.ew_up = in[24]; p.ew_down = in[25]; p.ln2_g = in[26]; p.ln2_b = in[27];
    p.out = (float*)d_out;
    char* ws = (char*)d_ws; size_t o = 0;
    auto take = [&](size_t bytes) { char* r = ws + o; o += (bytes + 255) & ~(size_t)255; return r; };
    p.bar = (unsigned*)take(XCD_BAR_WORDS * sizeof(unsigned));
    p.counts = (int*)take(256);
    p.WtIn = (bf16_t*)take((size_t)DEPTH * CIN * D * 2);
    p.WtPsb = (bf16_t*)take((size_t)DEPTH * D * 512 * 2);
    p.WtPrw = (bf16_t*)take((size_t)DEPTH * D * 512 * 2);
    p.WtOut = (bf16_t*)take((size_t)DEPTH * D * D * 2);
    p.WupT = (bf16_t*)take((size_t)DEPTH * 512 * 64 * 2);
    p.AupT = (bf16_t*)take((size_t)DEPTH * 512 * 64 * 2);
    p.GupT = (bf16_t*)take((size_t)DEPTH * 512 * 128 * 2);
    p.RwHi = (bf16_t*)take((size_t)NE * D * 2);
    p.gleft = (bf16_t*)take((size_t)32 * 2048 * 2);
    {
        const size_t ub = (size_t)NUNIT * 64 * 64 * 2;
        p.WtGU = (bf16_t*)take((size_t)NE * 1024 * 1024 * 2);
        p.WtD = (bf16_t*)take((size_t)NE * 1024 * 512 * 2);
        p.PcG = (bf16_t*)d_out; p.QcG = (bf16_t*)((char*)d_out + ub); p.RhG = (bf16_t*)((char*)d_out + 2 * ub);
        p.Y0G = (bf16_t*)take(ub); p.GG = (bf16_t*)take(ub); p.SG = (bf16_t*)take(ub);
        p.bonG = (float*)take((size_t)NUNIT * 64 * 4);
    }
    p.hb = (bf16_t*)take((size_t)TP * D * 2);
    p.hmeta = (float*)take((size_t)NBATCH * NMETA * D * 4);
    p.P = (bf16_t*)take((size_t)TP * CP * 2);
    p.osb = (bf16_t*)take((size_t)TP * 512 * 2);
    p.orw = (bf16_t*)take((size_t)TP * 512 * 2);
    p.list = (int*)take((size_t)NE * T * 4);
    p.tokg = (float*)take((size_t)T * 2 * 4);
    p.gates = p.P;
    p.merged = p.P + (size_t)TP * 2048;
    p.hid = p.P;
    p.fo = p.P + (size_t)(2 * T + 16 * 256) * DE;
    if (o > ws_size) return;
    static int grid = 0;
    if (!grid) {
        int dev = 0, cus = 0, per_cu = 0;
        (void)hipGetDevice(&dev);
        (void)hipDeviceGetAttribute(&cus, hipDeviceAttributeMultiprocessorCount, dev);
        (void)hipFuncSetAttribute((const void*)k_forward, hipFuncAttributeMaxDynamicSharedMemorySize, SMEM_BYTES);
        (void)hipOccupancyMaxActiveBlocksPerMultiprocessor(&per_cu, k_forward, NTHR, SMEM_BYTES);
        grid = per_cu >= 1 ? cus : 0;
    }
    if (!grid) return;
    (void)hipMemsetAsync(p.bar, 0, XCD_BAR_WORDS * sizeof(unsigned), stream);
    hipLaunchKernelGGL(k_forward, dim3(grid), dim3(NTHR), SMEM_BYTES, stream, p);
}
```

```cpp
#include <hip/hip_runtime.h>
#include <stdint.h>
#include <string.h>

#define DI __device__ __forceinline__
typedef unsigned short bf16_t;
typedef short bf16x8 __attribute__((ext_vector_type(8)));
typedef float f32x4 __attribute__((ext_vector_type(4)));
typedef unsigned u32x4 __attribute__((ext_vector_type(4)));
typedef unsigned u32x2 __attribute__((ext_vector_type(2)));

constexpr int D = 1024, NBATCH = 2, SEQ = 8192, NMETA = 16, L = SEQ + NMETA, T = NBATCH * L, TP = 16640;
constexpr int DEPTH = 2, HEADS = 8, HD = 64;
constexpr int CIN = 5376, CP = 3328;
constexpr int OFF_Q = 0, OFF_K = 512, OFF_V = 1024, OFF_RW = 1536;
constexpr int RW_R = 0, RW_K = 512, RW_V = 1024, RW_WD = 1536, RW_AD = 1600, RW_GD = 1664, RSW = 1792;
constexpr int NE = 16, DE = 512;
constexpr float ALPHA = 1.41421356237309515f;
constexpr float DECAY_SCALE = 0.60653065971263342f;
constexpr int NTHR = 512;

#define XB_TMO      128
#define XB_XCNT(j)  (256  + 64 * (j))
#define XB_XSUB(j)  (1280 + 64 * (j))
#define XB_XGEN(j)  (2304 + 64 * (j))
#define XB_TOP      3328
#define XB_TOPGEN   3392
#define XCD_BAR_WORDS 3456
#define XB_SPIN_CAP (1u << 18)
#define LAS __attribute__((address_space(3)))

__device__ __forceinline__ unsigned xb_ld(unsigned* p)              { return __hip_atomic_load(p, __ATOMIC_RELAXED, __HIP_MEMORY_SCOPE_AGENT); }
__device__ __forceinline__ unsigned xb_add(unsigned* p, unsigned v) { return __hip_atomic_fetch_add(p, v, __ATOMIC_RELAXED, __HIP_MEMORY_SCOPE_AGENT); }
__device__ __forceinline__ unsigned xb_xcc_id() { return (unsigned)__builtin_amdgcn_s_getreg((3 << 11) | 20) & 0xFu; }
#define XB_SPIN(cond, bar) do { unsigned _sp = 0; while (cond) { __builtin_amdgcn_s_sleep(1); \
    if ((++_sp & 255u) == 0u) { if (xb_ld(&(bar)[XB_TMO])) break; if (_sp > XB_SPIN_CAP) { atomicAdd(&(bar)[XB_TMO], 1u); break; } } } } while (0)

struct XcdBarrier {
    unsigned* bar; unsigned x;
    volatile LAS unsigned* st;
};

__device__ __forceinline__ XcdBarrier xcd_barrier_post(unsigned* bar, volatile LAS unsigned* st) {
    XcdBarrier b; b.bar = bar; b.x = xb_xcc_id(); b.st = st;
    if (threadIdx.x == 0) (void)xb_add(&bar[XB_XCNT(b.x)], 1u);
    return b;
}
__device__ __forceinline__ void xcd_barrier_complete(unsigned* bar, unsigned x, unsigned& nloc, unsigned& nx) {
    const unsigned G = gridDim.x * gridDim.y * gridDim.z;
    unsigned sum, cnt, mine, sp = 0u;
    for (;;) {
        sum = 0u; cnt = 0u; mine = 0u;
#pragma unroll
        for (unsigned j = 0; j < 16; ++j) { const unsigned c = xb_ld(&bar[XB_XCNT(j)]); sum += c; cnt += (c > 0u) ? 1u : 0u; mine = (j == x) ? c : mine; }
        if (sum == G) break;
        __builtin_amdgcn_s_sleep(1);
        if ((++sp & 255u) == 0u) { if (xb_ld(&bar[XB_TMO])) break; if (sp > XB_SPIN_CAP) { atomicAdd(&bar[XB_TMO], 1u); break; } }
    }
    nloc = mine > 0u ? mine : 1u; nx = cnt > 0u ? cnt : 1u;
}

__device__ __forceinline__ void xcd_barrier(const XcdBarrier& b) {
    asm volatile("s_waitcnt vmcnt(0)" ::: "memory");
    __syncthreads();
    if (threadIdx.x == 0) {
        unsigned* bar = b.bar;
        unsigned bx = b.x; asm volatile("" : "+s"(bx));
        __builtin_amdgcn_s_waitcnt(0);
        unsigned nloc = b.st[0], nx = b.st[1];
        if (nloc == 0u) { xcd_barrier_complete(bar, bx, nloc, nx); b.st[0] = nloc; b.st[1] = nx; }
        const unsigned old = xb_add(&bar[XB_XSUB(bx)], 1u);
        const unsigned gen = old / nloc;
        if (old + 1u == (gen + 1u) * nloc) {
            __builtin_amdgcn_fence(__ATOMIC_RELEASE, "agent");
            asm volatile("s_waitcnt vmcnt(0)" ::: "memory");
            const unsigned og = xb_add(&bar[XB_TOP], 1u);
            const unsigned tg = og / nx;
            if (og + 1u == (tg + 1u) * nx) xb_add(&bar[XB_TOPGEN], 1u);
            else XB_SPIN(xb_ld(&bar[XB_TOPGEN]) == tg, bar);
            __builtin_amdgcn_fence(__ATOMIC_ACQUIRE, "agent");
            xb_add(&bar[XB_XGEN(bx)], 1u);
            asm volatile("s_waitcnt vmcnt(0)" ::: "memory");
        } else {
            XB_SPIN(xb_ld(&bar[XB_XGEN(bx)]) == gen, bar);
            __builtin_amdgcn_fence(__ATOMIC_ACQUIRE, "agent");
            asm volatile("s_waitcnt vmcnt(0)" ::: "memory");
        }
    }
    __syncthreads();
}


struct Params {
    const float *x, *meta, *emb_g, *emb_b, *w_in, *mu, *w0, *w_up, *a0, *a_up, *g_up, *k_k, *k_a, *r_k, *lnx_g, *lnx_b, *p_sb, *p_rwkv, *w_out,
        *ln1_g, *ln1_b, *router_w, *router_b, *ew_gate, *ew_up, *ew_down, *ln2_g, *ln2_b;
    float* out;
    unsigned* bar;
    int* counts;
    bf16_t *WtIn, *WtPsb, *WtPrw, *WtOut, *WtGU, *WtD, *hb, *P, *osb, *orw, *WupT, *AupT, *GupT;
    bf16_t *PcG, *QcG, *RhG, *Y0G, *GG, *SG;
    bf16_t *RwHi, *gleft;
    float* bonG;
    float* hmeta;
    bf16_t *gates, *merged, *hid, *fo;
    int* list;
    float* tokg;
};

DI float bf2f(bf16_t v) { return __uint_as_float((unsigned)v << 16); }
typedef __bf16 bf16x2_t __attribute__((ext_vector_type(2)));
DI bf16_t f2bf(float f) { return __builtin_bit_cast(bf16_t, (__bf16)f); }
DI unsigned pack2(float lo, float hi) { bf16x2_t v = {(__bf16)lo, (__bf16)hi}; return __builtin_bit_cast(unsigned, v); }
DI float lo_bf(unsigned u) { return __uint_as_float(u << 16); }
DI float hi_bf(unsigned u) { return __uint_as_float(u & 0xFFFF0000u); }
template <int CTRL> DI float dpp_mov(float v) { return __builtin_bit_cast(float, __builtin_amdgcn_update_dpp(0, __builtin_bit_cast(int, v), CTRL, 0xF, 0xF, true)); }
DI float sum8(float v) {
    v += dpp_mov<0xB1>(v);
    v += dpp_mov<0x4E>(v);
    v += dpp_mov<0x141>(v);
    return v;
}
DI float sum16(float v) { v = sum8(v); v += dpp_mov<0x140>(v); return v; }
DI float wave_sum(float v) { v = sum16(v); v += __shfl_xor(v, 16); v += __shfl_xor(v, 32); return v; }
struct Params;
DI const Params& kparams() {
    auto k = __builtin_amdgcn_kernarg_segment_ptr();
    asm volatile("" : "+s"(k));
    return *(const Params*)k;
}
DI int tid_() { int t = threadIdx.x; asm volatile("" : "+v"(t)); return t; }
DI float sigmoidf_(float x) { return __builtin_amdgcn_rcpf(1.0f + __expf(-x)); }
DI float tanhf_(float x) { return 1.0f - 2.0f * __builtin_amdgcn_rcpf(1.0f + __expf(2.0f * x)); }

DI float* hrow2(float* hmeta, float* out, int tok) {
    const int b = tok >= L ? 1 : 0, t = tok - b * L;
    const unsigned long long am = (unsigned long long)(hmeta + (long long)(b * NMETA + t) * D), ao = (unsigned long long)(out + ((long long)b * SEQ + (t - NMETA)) * D);
    const unsigned long long m = 0ull - (unsigned long long)(t < NMETA);
    return (float*)((am & m) | (ao & ~m));
}
DI float* hrow(const Params& p, int tok) { return hrow2(p.hmeta, p.out, tok); }
DI float* hrow_u(const Params& p, int tok) { return hrow2(p.hmeta, p.out, __builtin_amdgcn_readfirstlane(tok)); }

DI void transpose_convert(const float* __restrict__ src, int ld, int K, int N, bf16_t* __restrict__ dst, int mult, int off, int bid, int nb, char* smem, int& rot) {
    float* tile = (float*)smem;
    const int tk = K / 64, tn = N / 256, tid = tid_();
    const int first = (bid - rot % nb + nb) % nb;
    rot += tk * tn;
    for (int t = first; t < tk * tn; t += nb) {
        const int k0 = (t / tn) * 64, n0 = (t % tn) * 256;
        f32x4 v[4][2];
#pragma unroll
        for (int q = 0; q < 4; ++q)
#pragma unroll
            for (int i = 0; i < 2; ++i) v[q][i] = *(const f32x4*)(src + (size_t)(k0 + (tid >> 4) + 32 * i) * ld + n0 + q * 64 + (tid & 15) * 4);
        __syncthreads();
#pragma unroll
        for (int q = 0; q < 4; ++q)
#pragma unroll
            for (int i = 0; i < 2; ++i) {
                float* tp = tile + q * 64 * 65 + ((tid >> 4) + 32 * i) * 65 + (tid & 15) * 4;
                tp[0] = v[q][i][0]; tp[1] = v[q][i][1]; tp[2] = v[q][i][2]; tp[3] = v[q][i][3];
            }
        __syncthreads();
        const int n = tid >> 3, kc = (tid & 7) * 8;
#pragma unroll
        for (int q = 0; q < 4; ++q) {
            const float* tq = tile + q * 64 * 65;
            u32x4 o;
#pragma unroll
            for (int jj = 0; jj < 4; ++jj) o[jj] = pack2(tq[(kc + 2 * jj) * 65 + n], tq[(kc + 2 * jj + 1) * 65 + n]);
            *(u32x4*)(dst + (size_t)((n0 + q * 64 + n) * mult + off) * K + k0 + kc) = o;
        }
    }
}

DI void convert_experts(const Params& p, int layer, int e0, int e1, int bid, int nb, char* smem) {
    int rot = 0;
    for (int e = e0; e < e1; ++e) {
        const size_t eo = ((size_t)layer * NE + e) * (size_t)D * DE;
        transpose_convert(p.ew_gate + eo, DE, D, DE, p.WtGU + (size_t)e * 1024 * 1024, 2, 0, bid, nb, smem, rot);
        transpose_convert(p.ew_up + eo, DE, D, DE, p.WtGU + (size_t)e * 1024 * 1024, 2, 1, bid, nb, smem, rot);
        transpose_convert(p.ew_down + eo, D, DE, D, p.WtD + (size_t)e * 1024 * 512, 1, 0, bid, nb, smem, rot);
    }
}

DI void convert_layer_weights(const Params& p, int l, int bid, int nb, char* smem) {
    int rot = 0;
    transpose_convert(p.w_in + (size_t)l * D * CIN, CIN, D, CIN, p.WtIn + (size_t)l * CIN * D, 1, 0, bid, nb, smem, rot);
    transpose_convert(p.p_sb + (size_t)l * 512 * D, D, 512, D, p.WtPsb + (size_t)l * D * 512, 1, 0, bid, nb, smem, rot);
    transpose_convert(p.p_rwkv + (size_t)l * 512 * D, D, 512, D, p.WtPrw + (size_t)l * D * 512, 1, 0, bid, nb, smem, rot);
    transpose_convert(p.w_out + (size_t)l * D * D, D, D, D, p.WtOut + (size_t)l * D * D, 1, 0, bid, nb, smem, rot);
    transpose_convert(p.w_up + (size_t)l * 64 * 512, 512, 64, 512, p.WupT + (size_t)l * 512 * 64, 1, 0, bid, nb, smem, rot);
    transpose_convert(p.a_up + (size_t)l * 64 * 512, 512, 64, 512, p.AupT + (size_t)l * 512 * 64, 1, 0, bid, nb, smem, rot);
    transpose_convert(p.g_up + (size_t)l * 128 * 512, 512, 128, 512, p.GupT + (size_t)l * 512 * 128, 1, 0, bid, nb, smem, rot);
}
DI void phase_prologue_weights(const Params& p, int bid, int nb, char* smem) {
    for (int i = bid * NTHR + tid_(); i < NE * D; i += nb * NTHR) {
        const int e = i / D, k = i % D;
        p.RwHi[i] = f2bf(p.router_w[(size_t)k * NE + e]);
    }
    for (int l = 0; l < DEPTH; ++l) convert_layer_weights(p, l, bid, nb, smem);
}

DI void ln16(float (&v)[16], const float* __restrict__ g, const float* __restrict__ b, int lane) {
    float s = 0.f;
#pragma unroll
    for (int i = 0; i < 16; ++i) s += v[i];
    const float mean = wave_sum(s) * (1.0f / D);
    float q = 0.f;
#pragma unroll
    for (int i = 0; i < 16; ++i) { v[i] -= mean; q += v[i] * v[i]; }
    const float rstd = rsqrtf(wave_sum(q) * (1.0f / D) + 1e-5f);
#pragma unroll
    for (int j = 0; j < 4; ++j) {
        const f32x4 gv = *(const f32x4*)(g + 256 * j + 4 * lane), bv = *(const f32x4*)(b + 256 * j + 4 * lane);
#pragma unroll
        for (int i = 0; i < 4; ++i) v[4 * j + i] = v[4 * j + i] * rstd * gv[i] + bv[i];
    }
}
DI void store_row_bf(bf16_t* __restrict__ hb, const float (&v)[16], int lane) {
#pragma unroll
    for (int j = 0; j < 4; ++j) *(u32x2*)(hb + 256 * j + 4 * lane) = (u32x2){pack2(v[4 * j], v[4 * j + 1]), pack2(v[4 * j + 2], v[4 * j + 3])};
}
DI void phase_embed(const Params& p, int bid, int nb) {
    const int lane = tid_() & 63, wid = __builtin_amdgcn_readfirstlane(tid_() >> 6);
    const int nwaves = nb * 8, gw = bid * 8 + wid, base_n = T / nwaves, extra = T % nwaves;
    const int tok0 = gw * base_n + (gw < extra ? gw : extra), ntok = base_n + (gw < extra ? 1 : 0);
    auto srcrow = [&](int tok) -> const float* {
        const int tk = __builtin_amdgcn_readfirstlane(tok), b = tk >= L ? 1 : 0, t = tk - b * L;
        const unsigned long long am = (unsigned long long)(p.meta + (long long)t * D), ao = (unsigned long long)(p.x + ((long long)b * SEQ + (t - NMETA)) * D);
        const unsigned long long m = 0ull - (unsigned long long)(t < NMETA);
        return (const float*)((am & m) | (ao & ~m));
    };
    f32x4 an[4];
    { const float* src = srcrow(tok0);
#pragma unroll
      for (int j = 0; j < 4; ++j) an[j] = *(const f32x4*)(src + 256 * j + 4 * lane); }
#pragma unroll 1
    for (int i = 0; i < ntok; ++i) {
        const int tok = tok0 + i;
        float v[16];
#pragma unroll
        for (int j = 0; j < 4; ++j) { v[4 * j] = an[j][0]; v[4 * j + 1] = an[j][1]; v[4 * j + 2] = an[j][2]; v[4 * j + 3] = an[j][3]; }
        if (i + 1 < ntok) { const float* src = srcrow(tok + 1);
#pragma unroll
            for (int j = 0; j < 4; ++j) an[j] = *(const f32x4*)(src + 256 * j + 4 * lane); }
        ln16(v, p.emb_g, p.emb_b, lane);
        store_row_bf(p.hb + (size_t)tok * D, v, lane);
    }
}

constexpr int LDT = 72;
constexpr int GEMM_LDS = 2 * 128 * LDT * 2;
template <class ARow, class Epi>
DI void gemm_tile128(ARow arow, const bf16_t* __restrict__ Bt, int ldb, int K, int m0, int n0, char* smem, Epi epi) {
    const int tid = tid_(), lane = tid & 63, wid = __builtin_amdgcn_readfirstlane(tid >> 6), fr = lane & 15, fq = lane >> 4;
    const int wr = wid >> 1, wc = wid & 1;
    bf16_t* As = (bf16_t*)smem;
    bf16_t* Bs = As + 128 * LDT;
    const bf16_t* ap[2]; const bf16_t* bp[2]; int so[2];
#pragma unroll
    for (int i = 0; i < 2; ++i) {
        const int c = tid + NTHR * i, row = c >> 3, kc = c & 7;
        const bf16_t* ar = arow(m0 + row);
        ap[i] = ar ? ar + kc * 8 : nullptr;
        bp[i] = Bt + (size_t)(n0 + row) * ldb + kc * 8;
        so[i] = row * LDT + kc * 8;
    }
    f32x4 acc[2][4];
#pragma unroll
    for (int mi = 0; mi < 2; ++mi)
#pragma unroll
        for (int ni = 0; ni < 4; ++ni) acc[mi][ni] = (f32x4){0.f, 0.f, 0.f, 0.f};
    u32x4 ra[2], rb[2];
#pragma unroll
    for (int i = 0; i < 2; ++i) { ra[i] = ap[i] ? *(const u32x4*)(ap[i]) : (u32x4){0u, 0u, 0u, 0u}; rb[i] = *(const u32x4*)(bp[i]); }
    for (int k0 = 0; k0 < K; k0 += 64) {
        __syncthreads();
#pragma unroll
        for (int i = 0; i < 2; ++i) { *(u32x4*)(As + so[i]) = ra[i]; *(u32x4*)(Bs + so[i]) = rb[i]; }
        __syncthreads();
        if (k0 + 64 < K) {
#pragma unroll
            for (int i = 0; i < 2; ++i) { ra[i] = ap[i] ? *(const u32x4*)(ap[i] + k0 + 64) : (u32x4){0u, 0u, 0u, 0u}; rb[i] = *(const u32x4*)(bp[i] + k0 + 64); }
        }
#pragma unroll
        for (int ks = 0; ks < 2; ++ks) {
            bf16x8 af[2], bf[4];
#pragma unroll
            for (int mi = 0; mi < 2; ++mi) af[mi] = *(const bf16x8*)(As + (wr * 32 + mi * 16 + fr) * LDT + ks * 32 + fq * 8);
#pragma unroll
            for (int ni = 0; ni < 4; ++ni) bf[ni] = *(const bf16x8*)(Bs + (wc * 64 + ni * 16 + fr) * LDT + ks * 32 + fq * 8);
#pragma unroll
            for (int mi = 0; mi < 2; ++mi)
#pragma unroll
                for (int ni = 0; ni < 4; ++ni) acc[mi][ni] = __builtin_amdgcn_mfma_f32_16x16x32_bf16(bf[ni], af[mi], acc[mi][ni], 0, 0, 0);
        }
    }
#pragma unroll
    for (int mi = 0; mi < 2; ++mi)
#pragma unroll
        for (int ni = 0; ni < 4; ++ni) epi(m0 + wr * 32 + mi * 16 + fr, n0 + wc * 64 + ni * 16 + fq * 4, acc[mi][ni]);
}

namespace g8 {
#define G8_LAS __attribute__((address_space(3)))
constexpr int BM = 256, BK = 64, HALF = 128, HTB = HALF * BK * 2, STAGE_BYTES = 8 * HTB, NXCD = 8, WGM = 8;
DI int lds_byte(int r, int c) { const int st = (r >> 4) * 2 + (c >> 5), rr = r & 15, cc = c & 31, ob = rr * 64 + cc * 2; return st * 1024 + (ob ^ (((ob >> 9) & 1) << 5)); }
DI void stage_rc(int b, int& R, int& C) { const int st = b / 1024, sb = b % 1024, swz = sb ^ (((sb >> 9) & 1) << 5); R = (st >> 1) * 16 + swz / 64; C = (st & 1) * 32 + (swz % 64) / 2; }
DI int perm32(int rho) { const int n = rho >> 4, i = rho & 15; return 8 * (i >> 2) + 4 * n + (i & 3); }
struct Unit { int pm, pn; const char* A; const char* B; int e, slot0, cnt; };

struct DenseOrder {
    int nM, nN, nwg, G, c; const char* A; const char* B; size_t tstep;
    DI void init(const bf16_t* A_, const bf16_t* Bt_, int nM_, int nN_, int K, int G_, int c_) { nM = nM_; nN = nN_; nwg = nM * nN; G = G_; c = c_; A = (const char*)A_; B = (const char*)Bt_; tstep = (size_t)BM * K * 2; }
    DI bool next(int i, Unit& u) const {
        const long Lq = (long)i * G + c; if (Lq >= nwg) return false;
        int wgid = (int)Lq; { const int q = nwg / NXCD, r = nwg % NXCD, xcd = wgid % NXCD, off = wgid / NXCD; wgid = (xcd < r ? xcd * (q + 1) : r * (q + 1) + (xcd - r) * q) + off; }
        const int nig = WGM * nN, gid = wgid / nig, fm = gid * WGM, gsz = (nM - fm) < WGM ? (nM - fm) : WGM;
        u.pm = fm + ((wgid % nig) % gsz); u.pn = (wgid % nig) / gsz; u.A = A + (size_t)u.pm * tstep; u.B = B + (size_t)u.pn * tstep; u.e = 0; u.slot0 = 0; u.cnt = 0; return true;
    }
    DI unsigned row_off(const Unit&, int) const { return 0u; }
};

template <bool GATHER, class Epi, class Sched>
DI void gemm8(G8_LAS unsigned char* lds, const int K, const Sched& S, const Epi& E) {
    const int tid = tid_(), wid = __builtin_amdgcn_readfirstlane(tid >> 6), lane = tid & 63, wr = wid >> 2, wc = wid & 3, fr = lane & 15, fq = lane >> 4;
    const int nt = K / BK;
    int Rr[2], Cc[2]; unsigned voffB[2], voffA[2];
#pragma unroll
    for (int i = 0; i < 2; ++i) { stage_rc(tid * 16 + i * 8192, Rr[i], Cc[i]); const int Rb = Epi::PERM ? ((Rr[i] & ~31) + perm32(Rr[i] & 31)) : Rr[i]; voffB[i] = (unsigned)(Rb * K + Cc[i]) * 2u; voffA[i] = (unsigned)(Rr[i] * K + Cc[i]) * 2u; }
    const size_t kstep = (size_t)(BK * 2), hstep = (size_t)HALF * K * 2;
    const unsigned ldsw = (unsigned)wid * 1024u;
    const int aoff = lds_byte(wr * 64 + fr, fq * 8), boff = lds_byte(wc * 32 + fr, fq * 8);
#define G8_SA(b, h) (((b) * 2 + (h)) * HTB)
#define G8_SB(b, h) ((4 + (b) * 2 + (h)) * HTB)
#define G8_STAGE(bufoff, gbase, voff) do { _Pragma("unroll") for (int _i = 0; _i < 2; ++_i) \
        __builtin_amdgcn_global_load_lds((const unsigned*)((const char*)(gbase) + (voff)[_i]), (G8_LAS unsigned*)(lds + (bufoff) + ldsw + _i * 8192), 16, 0, 0); } while (0)
#define G8_LDA(dst, b, h) do { _Pragma("unroll") for (int m = 0; m < 4; ++m) _Pragma("unroll") for (int k = 0; k < 2; ++k) dst[m][k] = *(const G8_LAS bf16x8*)(lds + G8_SA(b, h) + aoff + m * 2048 + k * 1024); } while (0)
#define G8_LDB(dst, b, h) do { _Pragma("unroll") for (int n = 0; n < 2; ++n) _Pragma("unroll") for (int k = 0; k < 2; ++k) dst[n][k] = *(const G8_LAS bf16x8*)(lds + G8_SB(b, h) + boff + n * 2048 + k * 1024); } while (0)
#define G8_MMA(ai, bj, At, Bt) do { __builtin_amdgcn_s_setprio(1); _Pragma("unroll") for (int m = 0; m < 4; ++m) _Pragma("unroll") for (int n = 0; n < 2; ++n) _Pragma("unroll") for (int k = 0; k < 2; ++k) \
        acc[ai][bj][m][n] = __builtin_amdgcn_mfma_f32_16x16x32_bf16(Bt[n][k], At[m][k], acc[ai][bj][m][n], 0, 0, 0); __builtin_amdgcn_s_setprio(0); } while (0)
#define G8_WAIT_V(n) asm volatile("s_waitcnt vmcnt(" #n ")" ::: "memory")
#define G8_WAIT_L(n) asm volatile("s_waitcnt lgkmcnt(" #n ")" ::: "memory")
#define G8_BAR __builtin_amdgcn_s_barrier()
#define G8_SCHED __builtin_amdgcn_sched_barrier(0)
#define G8_AOFF(dst, un) do { if (GATHER) { _Pragma("unroll") for (int _h = 0; _h < 2; ++_h) _Pragma("unroll") for (int _i = 0; _i < 2; ++_i) \
        dst[_h][_i] = S.row_off(un, _h * HALF + Rr[_i]) + (unsigned)Cc[_i] * 2u; } } while (0)
#define G8_STAGE_A(bufoff, gb, vo, h) do { if (GATHER) { G8_STAGE(bufoff, gb, vo[h]); } else { G8_STAGE(bufoff, (gb) + (h) * hstep, voffA); } } while (0)
    Unit cur, nxt; int ui = 0;
    if (!S.next(0, cur)) return;
    f32x4 acc[2][2][4][2];
#pragma unroll
    for (int a = 0; a < 2; ++a)
#pragma unroll
        for (int b = 0; b < 2; ++b)
#pragma unroll
            for (int m = 0; m < 4; ++m)
#pragma unroll
                for (int n = 0; n < 2; ++n) acc[a][b][m][n] = (f32x4){0.f, 0.f, 0.f, 0.f};
    bf16x8 At[4][2], B0[2][2], B1[2][2];
    unsigned cvA[2][2], nvA[2][2];
    G8_AOFF(cvA, cur);
    const char* cA = cur.A; const char* cB = cur.B;
    G8_STAGE(G8_SB(0, 0), cB, voffB); G8_STAGE_A(G8_SA(0, 0), cA, cvA, 0); G8_STAGE(G8_SB(0, 1), cB + hstep, voffB); G8_STAGE_A(G8_SA(0, 1), cA, cvA, 1);
    if (wr == 1) G8_BAR;
    G8_WAIT_V(4); G8_BAR;
    G8_STAGE(G8_SB(1, 0), cB + kstep, voffB); G8_STAGE_A(G8_SA(1, 0), cA + kstep, cvA, 0); G8_STAGE(G8_SB(1, 1), cB + hstep + kstep, voffB);
    G8_WAIT_V(6); G8_BAR;
    for (;;) {
        const bool has_next = S.next(ui + 1, nxt);
        const char* nA = has_next ? nxt.A : cA; const char* nB = has_next ? nxt.B : cB;
        if (GATHER) {
            if (has_next) { G8_AOFF(nvA, nxt); } else {
#pragma unroll
                for (int h = 0; h < 2; ++h)
#pragma unroll
                    for (int i = 0; i < 2; ++i) nvA[h][i] = cvA[h][i];
            }
        }
        for (int t = 0; t < nt; t += 2) {
            const bool last = (t == nt - 2);
            const char* a1 = cA + (size_t)(t + 1) * kstep;
            const char* a2 = last ? nA : cA + (size_t)(t + 2) * kstep; const char* b2 = last ? nB : cB + (size_t)(t + 2) * kstep;
            const char* a3 = a2 + kstep; const char* b3 = b2 + kstep;

            G8_LDB(B0, 0, 0); G8_SCHED; G8_LDA(At, 0, 0); G8_STAGE_A(G8_SA(1, 1), a1, cvA, 1);
            if (GATHER && last) {
#pragma unroll
                for (int h = 0; h < 2; ++h)
#pragma unroll
                    for (int i = 0; i < 2; ++i) cvA[h][i] = nvA[h][i];
            }
            G8_WAIT_L(8); G8_BAR; G8_WAIT_L(0); G8_MMA(0, 0, At, B0); G8_BAR; G8_SCHED;
            G8_LDB(B1, 0, 1); G8_STAGE(G8_SB(0, 0), b2, voffB);
            G8_BAR; G8_WAIT_L(0); G8_MMA(0, 1, At, B1); G8_BAR;
            G8_LDA(At, 0, 1); G8_STAGE_A(G8_SA(0, 0), a2, cvA, 0);
            G8_BAR; G8_WAIT_L(0); G8_MMA(1, 0, At, B0); G8_BAR; G8_SCHED;
            G8_STAGE(G8_SB(0, 1), b2 + hstep, voffB);
            G8_WAIT_V(6); G8_BAR; G8_MMA(1, 1, At, B1); G8_BAR;
            G8_LDB(B0, 1, 0); G8_SCHED; G8_LDA(At, 1, 0); G8_STAGE_A(G8_SA(0, 1), a2, cvA, 1);
            G8_WAIT_L(8); G8_BAR; G8_WAIT_L(0); G8_MMA(0, 0, At, B0); G8_BAR; G8_SCHED;
            G8_LDB(B1, 1, 1); G8_STAGE(G8_SB(1, 0), b3, voffB);
            G8_BAR; G8_WAIT_L(0); G8_MMA(0, 1, At, B1); G8_BAR;
            G8_LDA(At, 1, 1); G8_STAGE_A(G8_SA(1, 0), a3, cvA, 0);
            G8_BAR; G8_WAIT_L(0); G8_MMA(1, 0, At, B0); G8_BAR; G8_SCHED;
            G8_STAGE(G8_SB(1, 1), b3 + hstep, voffB);
            G8_WAIT_V(6); G8_BAR; G8_MMA(1, 1, At, B1); G8_BAR;
        }
        { int fr2 = fr, fq2 = fq; asm volatile("" : "+v"(fr2), "+v"(fq2)); E(acc, cur, wr, wc, fr2, fq2); }
        if (!has_next) break;
#pragma unroll
        for (int a = 0; a < 2; ++a)
#pragma unroll
            for (int b = 0; b < 2; ++b)
#pragma unroll
                for (int m = 0; m < 4; ++m)
#pragma unroll
                    for (int n = 0; n < 2; ++n) acc[a][b][m][n] = (f32x4){0.f, 0.f, 0.f, 0.f};
        cur = nxt; cA = nA; cB = nB; ++ui;
    }
    G8_WAIT_V(0);
    if (wr == 0) G8_BAR;
    G8_BAR;
#undef G8_SA
#undef G8_SB
#undef G8_STAGE
#undef G8_LDA
#undef G8_LDB
#undef G8_MMA
#undef G8_WAIT_V
#undef G8_WAIT_L
#undef G8_BAR
#undef G8_SCHED
#undef G8_AOFF
#undef G8_STAGE_A
}
}

constexpr int MFULL = 64, M0_LEFT = MFULL * 256;
struct EpiStore {
    static constexpr bool PERM = true;
    bf16_t* O; int ldc; bool sig;
    DI void operator()(const f32x4 (&acc)[2][2][4][2], const g8::Unit& u, int wr, int wc, int fr, int fq) const {
#pragma unroll
        for (int ai = 0; ai < 2; ++ai)
#pragma unroll
            for (int m = 0; m < 4; ++m) {
                bf16_t* rowp = O + (size_t)(u.pm * 256 + ai * 128 + wr * 64 + m * 16 + fr) * ldc + u.pn * 256 + wc * 32 + 8 * fq;
#pragma unroll
                for (int bj = 0; bj < 2; ++bj) {
                    f32x4 v0 = acc[ai][bj][m][0], v1 = acc[ai][bj][m][1];
                    if (sig) {
#pragma unroll
                        for (int e = 0; e < 4; ++e) { v0[e] = sigmoidf_(v0[e]); v1[e] = sigmoidf_(v1[e]); }
                    }
                    *(u32x4*)(rowp + bj * 128) = (u32x4){pack2(v0[0], v0[1]), pack2(v0[2], v0[3]), pack2(v1[0], v1[1]), pack2(v1[2], v1[3])};
                }
            }
    }
};
DI int left_first(int units, int bid, int nb) { return (bid - units % nb + nb) % nb; }

constexpr int LEFT_LDS = 2 * (32 + 128) * LDT * 2;
template <class ARow, class Epi>
DI void gemm_left32(ARow arow, const bf16_t* __restrict__ Bt, int ldb, int K, int n0, char* smem, Epi epi) {
    const int tid = tid_(), lane = tid & 63, wid = __builtin_amdgcn_readfirstlane(tid >> 6), fr = lane & 15, fq = lane >> 4;
    bf16_t* As = (bf16_t*)smem;
    bf16_t* Bs = As + 2 * 32 * LDT;
    const int arow_i = tid >> 4, akc = (tid & 15) * 4;
    const bf16_t* ap = arow(arow_i) + akc;
    const bf16_t* bp[2]; int bso[2];
#pragma unroll
    for (int i = 0; i < 2; ++i) { const int cc = tid + NTHR * i, row = cc >> 3, kc = cc & 7; bp[i] = Bt + (size_t)(n0 + row) * ldb + kc * 8; bso[i] = row * LDT + kc * 8; }
    const int nit = K / 64;
    u32x2 ra[4]; u32x4 rb[4][2];
#define GL_LOAD(slot, it) do { if ((it) < nit) { ra[slot] = *(const u32x2*)(ap + (it) * 64); rb[slot][0] = *(const u32x4*)(bp[0] + (it) * 64); rb[slot][1] = *(const u32x4*)(bp[1] + (it) * 64); } } while (0)
#define GL_WRITE(slot, buf) do { *(u32x2*)(As + (buf) * 32 * LDT + arow_i * LDT + akc) = ra[slot]; *(u32x4*)(Bs + (buf) * 128 * LDT + bso[0]) = rb[slot][0]; *(u32x4*)(Bs + (buf) * 128 * LDT + bso[1]) = rb[slot][1]; } while (0)
    f32x4 acc[2] = {(f32x4){0.f, 0.f, 0.f, 0.f}, (f32x4){0.f, 0.f, 0.f, 0.f}};
    GL_LOAD(0, 0); GL_LOAD(1, 1); GL_LOAD(2, 2); GL_LOAD(3, 3);
    __syncthreads();
    GL_WRITE(0, 0);
    __syncthreads();
#define GL_STEP(slot, it) do { \
        GL_LOAD(slot, (it) + 4); \
        const int buf = (it) & 1; \
        _Pragma("unroll") for (int ks = 0; ks < 2; ++ks) { \
            const bf16x8 bf = *(const bf16x8*)(Bs + buf * 128 * LDT + (wid * 16 + fr) * LDT + ks * 32 + fq * 8); \
            _Pragma("unroll") for (int mt = 0; mt < 2; ++mt) { \
                const bf16x8 af = *(const bf16x8*)(As + buf * 32 * LDT + (mt * 16 + fr) * LDT + ks * 32 + fq * 8); \
                acc[mt] = __builtin_amdgcn_mfma_f32_16x16x32_bf16(bf, af, acc[mt], 0, 0, 0); } } \
        if ((it) + 1 < nit) { GL_WRITE(((slot) + 1) & 3, buf ^ 1); } \
        __syncthreads(); } while (0)
    for (int it = 0; it < nit; it += 4) {
        GL_STEP(0, it);
        if (it + 1 < nit) GL_STEP(1, it + 1);
        if (it + 2 < nit) GL_STEP(2, it + 2);
        if (it + 3 < nit) GL_STEP(3, it + 3);
    }
#undef GL_LOAD
#undef GL_WRITE
#undef GL_STEP
#pragma unroll
    for (int mt = 0; mt < 2; ++mt) epi(mt * 16 + fr, n0 + wid * 16 + fq * 4, acc[mt]);
}

DI void phase_inproj(const Params& p, int layer, int bid, int nb, char* smem) {
    const bf16_t* hb = p.hb; bf16_t* P = p.P;
    const bf16_t* Bt = p.WtIn + (size_t)layer * CIN * D;
    g8::DenseOrder S; S.init(hb, Bt, MFULL, CP / 256, D, nb, bid);
    g8::gemm8<false>((G8_LAS unsigned char*)smem, D, S, EpiStore{P, CP, false});
    {
        constexpr int UNITS = MFULL * (CP / 256);
        const int heavy = UNITS % nb;
        if (heavy > 0 && heavy < nb) { if (bid >= heavy) convert_experts(p, layer, 0, NE / 2, bid - heavy, nb - heavy, smem); }
        else convert_experts(p, layer, 0, NE / 2, bid, nb, smem);
    }
    bf16_t* G = p.gleft - (size_t)M0_LEFT * 2048; const bf16_t* Wg = p.WtIn + ((size_t)layer * CIN + CP) * D;
    for (int t = left_first(MFULL * (CP / 256), bid, nb); t < CP / 128 + 2048 / 128; t += nb) {
        if (t < CP / 128)
            gemm_left32([=](int r) { return hb + (size_t)(M0_LEFT + r) * D; }, Bt, D, D, t * 128, smem,
                        [=](int r, int c, f32x4 v) { *(u32x2*)(P + (size_t)(M0_LEFT + r) * CP + c) = (u32x2){pack2(v[0], v[1]), pack2(v[2], v[3])}; });
        else
            gemm_left32([=](int r) { return hb + (size_t)(M0_LEFT + r) * D; }, Wg, D, D, (t - CP / 128) * 128, smem,
                        [=](int r, int c, f32x4 v) { *(u32x2*)(G + (size_t)(M0_LEFT + r) * 2048 + c) = (u32x2){pack2(sigmoidf_(v[0]), sigmoidf_(v[1])), pack2(sigmoidf_(v[2]), sigmoidf_(v[3]))}; });
    }
}

constexpr int NCHUNK = (L + 63) / 64, NUNIT = NBATCH * HEADS * NCHUNK;
constexpr int LS = 72, RB = 64 * LS * 2;
constexpr int R1_LDS = 16 * RB + 4096 + 7168;
#define RBUF(i) ((bf16_t*)(smem + (i) * RB))
typedef float f32x16 __attribute__((ext_vector_type(16)));

template <int KK> DI f32x4 mm16(const bf16_t* F, int ldf, const bf16_t* S, int lds_, f32x4 acc, int lane) {
    const int fr = lane & 15, fq = lane >> 4;
#pragma unroll
    for (int ks = 0; ks < KK / 32; ++ks) {
        const bf16x8 f = *(const bf16x8*)(F + fr * ldf + ks * 32 + fq * 8);
        const bf16x8 g = *(const bf16x8*)(S + fr * lds_ + ks * 32 + fq * 8);
        acc = __builtin_amdgcn_mfma_f32_16x16x32_bf16(f, g, acc, 0, 0, 0);
    }
    return acc;
}
DI u32x2 pk4(f32x4 v) { return (u32x2){pack2(v[0], v[1]), pack2(v[2], v[3])}; }
DI f32x4 up4(u32x2 v) { return (f32x4){lo_bf(v[0]), hi_bf(v[0]), lo_bf(v[1]), hi_bf(v[1])}; }

typedef short s16x4 __attribute__((ext_vector_type(4)));
DI f32x4 mf16(u32x2 a, u32x2 b, f32x4 c) { return __builtin_amdgcn_mfma_f32_16x16x16bf16_1k(__builtin_bit_cast(s16x4, a), __builtin_bit_cast(s16x4, b), c, 0, 0, 0); }
#define TRI_M(a, b)  (*(const u32x2*)(Mt + (16 * (b) + fr) * LS + 16 * (a) + 4 * fq))
#define TRI_MT(a, b) (*(const u32x2*)(Mr + (16 * (a) + fr) * LS + 16 * (b) + 4 * fq))
#define TRI_ST(c, r, w) (*(u32x2*)(Tb + (16 * (r) + fr) * LS + 16 * (c) + 4 * fq) = (w))
DI void r1_tri_inverse(const bf16_t* Mr, const bf16_t* Mt, bf16_t* Tb, int lane) {
    const int fr = lane & 15, fq = lane >> 4;
    const f32x4 zero = (f32x4){0.f, 0.f, 0.f, 0.f};
    f32x4 eye;
#pragma unroll
    for (int e = 0; e < 4; ++e) eye[e] = (4 * fq + e == fr) ? 1.f : 0.f;
    u32x2 mk[4], mkt[4], y[4], yt[4];
    f32x4 Y[4], YT[4];
#pragma unroll
    for (int a = 0; a < 4; ++a) {
        mk[a] = TRI_M(a, a); mkt[a] = TRI_MT(a, a);
        Y[a] = up4(mk[a]) + eye; YT[a] = up4(mkt[a]) + eye;
        y[a] = pk4(Y[a]); yt[a] = pk4(YT[a]);
    }
    const u32x2 m10 = TRI_M(1, 0), m10t = TRI_MT(1, 0), m32 = TRI_M(3, 2), m20 = TRI_M(2, 0), m21 = TRI_M(2, 1), m30 = TRI_M(3, 0), m31 = TRI_M(3, 1);
#pragma unroll
    for (int k = 0; k < 3; ++k) {
        f32x4 s2[4], s2t[4];
#pragma unroll
        for (int a = 0; a < 4; ++a) { s2[a] = mf16(mkt[a], mk[a], zero); s2t[a] = mf16(mk[a], mkt[a], zero); }
#pragma unroll
        for (int a = 0; a < 4; ++a) { mk[a] = pk4(s2[a]); mkt[a] = pk4(s2t[a]); }
#pragma unroll
        for (int a = 0; a < 4; ++a) { Y[a] = mf16(mkt[a], y[a], Y[a]); YT[a] = mf16(mk[a], yt[a], YT[a]); }
#pragma unroll
        for (int a = 0; a < 4; ++a) { y[a] = pk4(Y[a]); yt[a] = pk4(YT[a]); }
    }
    const u32x2 e1 = pk4(mf16(m10t, y[0], zero));
    const u32x2 e2 = pk4(mf16(m10, yt[1], zero));
    const u32x2 g3 = pk4(mf16(m32, yt[3], zero));
    const u32x2 t10 = pk4(mf16(yt[1], e1, zero));
    const u32x2 t10t = pk4(mf16(y[0], e2, zero));
    const u32x2 t32t = pk4(mf16(y[2], g3, zero));
    const u32x2 h02 = pk4(mf16(m20, yt[2], zero)), h12 = pk4(mf16(m21, yt[2], zero));
    const u32x2 h03 = pk4(mf16(m30, yt[3], mf16(m20, t32t, zero))), h13 = pk4(mf16(m31, yt[3], mf16(m21, t32t, zero)));
    const u32x2 w02 = pk4(mf16(t10, h12, mf16(y[0], h02, zero))), w03 = pk4(mf16(t10, h13, mf16(y[0], h03, zero)));
    const u32x2 w12 = pk4(mf16(y[1], h12, zero)), w13 = pk4(mf16(y[1], h13, zero));
#pragma unroll
    for (int a = 0; a < 4; ++a) TRI_ST(a, a, yt[a]);
    TRI_ST(0, 1, t10t); TRI_ST(2, 3, t32t);
    TRI_ST(0, 2, w02); TRI_ST(0, 3, w03); TRI_ST(1, 2, w12); TRI_ST(1, 3, w13);
    const u32x2 z2 = (u32x2){0u, 0u};
    TRI_ST(1, 0, z2); TRI_ST(3, 2, z2);
}

template <int MODE> DI void phase_rwkv_r1(const Params& p, int layer, int bid, int nb, char* smem) {
    const int wv = __builtin_amdgcn_readfirstlane(tid_() >> 6);
    const f32x4 zero = (f32x4){0.f, 0.f, 0.f, 0.f};
    float* lwT = (float*)RBUF(4);
    float* aT = (float*)RBUF(6);
    float* gt = (float*)(smem + 16 * RB);
    float* gammaC = gt + 512;
    bf16_t* Xt0 = RBUF(14);
    bf16_t* Xt1 = RBUF(4);
    const bf16_t* WupT = p.WupT + (size_t)layer * 512 * 64, *AupT = p.AupT + (size_t)layer * 512 * 64, *GupT = p.GupT + (size_t)layer * 512 * 128;
    float* mu = (float*)(smem + 16 * RB + 4096);
    __syncthreads();
    for (int i = tid_(); i < RSW; i += NTHR) mu[i] = p.mu[(size_t)layer * RSW + i];
    for (int it = 0;; ++it) {
        const int tid = tid_(), lane = tid & 63, fr = lane & 15, fq = lane >> 4;
        int c, bh;
        if (MODE == 0) {
            const int Lq = it * nb + bid, q = Lq >> 3, cb = (q >> 3) * 8 + (Lq & 7);
            if (cb >= NBATCH * (NCHUNK - 1)) break;
            c = cb % (NCHUNK - 1); bh = (cb / (NCHUNK - 1)) * HEADS + (q & 7);
        } else {
            if (it > 0) break;
            c = NCHUNK - 1; bh = bid;
        }
        const int u = bh * NCHUNK + c, h = bh % HEADS, bb = bh / HEADS;
        const size_t tok0 = (size_t)bb * L + c * 64;
        bf16x8 fw[2][2], fa[2][2], fg[2][4];
#pragma unroll
        for (int t2 = 0; t2 < 2; ++t2) {
            const int tl = wv * 2 + t2, pt = tl >> 2, qt = tl & 3;
#pragma unroll
            for (int ks = 0; ks < 2; ++ks) {
                fw[t2][ks] = *(const bf16x8*)(WupT + (size_t)(h * 64 + qt * 16 + fr) * 64 + ks * 32 + fq * 8);
                fa[t2][ks] = *(const bf16x8*)(AupT + (size_t)(h * 64 + pt * 16 + fr) * 64 + ks * 32 + fq * 8);
            }
        }
        __syncthreads();
        {
            const int i = tid >> 3, c8 = (tid & 7) * 8, t = c * 64 + i;
            u32x4 curv[7], prvv[7];
#pragma unroll
            for (int it2 = 0; it2 < 7; ++it2) {
                const int col = (it2 == 0 ? RW_R + h * 64 : it2 == 1 ? RW_K + h * 64 : it2 == 2 ? RW_V + h * 64 : RW_WD + (it2 - 3) * 64) + c8;
                curv[it2] = (u32x4){0u, 0u, 0u, 0u}; prvv[it2] = (u32x4){0u, 0u, 0u, 0u};
                if (t < L) curv[it2] = *(const u32x4*)(p.P + (tok0 + i) * CP + OFF_RW + col);
                if (t < L && t > 0) prvv[it2] = *(const u32x4*)(p.P + (tok0 + i - 1) * CP + OFF_RW + col);
            }
#pragma unroll
            for (int it2 = 0; it2 < 7; ++it2) {
                const int col = (it2 == 0 ? RW_R + h * 64 : it2 == 1 ? RW_K + h * 64 : it2 == 2 ? RW_V + h * 64 : RW_WD + (it2 - 3) * 64) + c8;
                bf16_t* dst = it2 == 0 ? RBUF(8) + i * LS + c8 : it2 == 1 ? RBUF(9) + i * LS + c8 : it2 == 2 ? RBUF(10) + i * LS + c8
                            : it2 == 3 ? RBUF(0) + i * LS + c8 : it2 == 4 ? RBUF(1) + i * LS + c8 : RBUF(2) + i * 136 + (it2 - 5) * 64 + c8;
                const f32x4 m0 = *(const f32x4*)(mu + col), m1 = *(const f32x4*)(mu + col + 4);
                const u32x4 cur = curv[it2], prv = prvv[it2];
                float x[8];
#pragma unroll
                for (int j2 = 0; j2 < 4; ++j2) {
                    const float c0 = lo_bf(cur[j2]), c1 = hi_bf(cur[j2]), p0 = lo_bf(prv[j2]), p1 = hi_bf(prv[j2]);
                    const float mm0 = j2 < 2 ? m0[2 * j2] : m1[2 * j2 - 4], mm1 = j2 < 2 ? m0[2 * j2 + 1] : m1[2 * j2 - 3];
                    x[2 * j2] = c0 + (p0 - c0) * mm0; x[2 * j2 + 1] = c1 + (p1 - c1) * mm1;
                }
                if (it2 == 3) {
#pragma unroll
                    for (int j2 = 0; j2 < 8; ++j2) x[j2] = tanhf_(x[j2]);
                } else if (it2 >= 5) {
#pragma unroll
                    for (int j2 = 0; j2 < 8; ++j2) x[j2] = sigmoidf_(x[j2]);
                }
                *(u32x4*)dst = (u32x4){pack2(x[0], x[1]), pack2(x[2], x[3]), pack2(x[4], x[5]), pack2(x[6], x[7])};
            }
        }
#pragma unroll
        for (int t2 = 0; t2 < 2; ++t2)
#pragma unroll
            for (int ks = 0; ks < 4; ++ks) fg[t2][ks] = *(const bf16x8*)(GupT + (size_t)(h * 64 + ((wv * 2 + t2) >> 2) * 16 + fr) * 128 + ks * 32 + fq * 8);
        __syncthreads();
#pragma unroll
        for (int t2 = 0; t2 < 2; ++t2) {
            const int tl = wv * 2 + t2, pt = tl >> 2, qt = tl & 3;
            f32x4 aw = zero, aa = zero, ag = zero;
#pragma unroll
            for (int ks = 0; ks < 2; ++ks) {
                const bf16x8 xw = *(const bf16x8*)(RBUF(0) + (pt * 16 + fr) * LS + ks * 32 + fq * 8);
                aw = __builtin_amdgcn_mfma_f32_16x16x32_bf16(xw, fw[t2][ks], aw, 0, 0, 0);
                const bf16x8 xa = *(const bf16x8*)(RBUF(1) + (qt * 16 + fr) * LS + ks * 32 + fq * 8);
                aa = __builtin_amdgcn_mfma_f32_16x16x32_bf16(fa[t2][ks], xa, aa, 0, 0, 0);
            }
#pragma unroll
            for (int ks = 0; ks < 4; ++ks) {
                const bf16x8 xg = *(const bf16x8*)(RBUF(2) + (qt * 16 + fr) * 136 + ks * 32 + fq * 8);
                ag = __builtin_amdgcn_mfma_f32_16x16x32_bf16(fg[t2][ks], xg, ag, 0, 0, 0);
            }
            const int ch = qt * 16 + fr;
            const float w0 = p.w0[layer * 512 + h * 64 + ch];
            const f32x4 a0 = *(const f32x4*)(p.a0 + layer * 512 + h * 64 + pt * 16 + fq * 4);
            f32x4 lw, av;
#pragma unroll
            for (int e = 0; e < 4; ++e) { lw[e] = -DECAY_SCALE * sigmoidf_(w0 + aw[e]); av[e] = sigmoidf_(a0[e] + aa[e]); }
            *(f32x4*)(lwT + ch * 68 + pt * 16 + fq * 4) = lw;
            *(f32x4*)(aT + (qt * 16 + fr) * 68 + pt * 16 + fq * 4) = av;
            *(u32x2*)(p.GG + ((size_t)u * 64 + qt * 16 + fr) * 64 + pt * 16 + fq * 4) = pk4(ag);
        }
        __syncthreads();
        {
            const int i = tid >> 3, c8 = (tid & 7) * 8, cg = layer * 512 + h * 64 + c8;
            const u32x4 xr = *(const u32x4*)(RBUF(8) + i * LS + c8), xk = *(const u32x4*)(RBUF(9) + i * LS + c8);
            const f32x4 a0 = *(const f32x4*)(aT + i * 68 + c8), a1 = *(const f32x4*)(aT + i * 68 + c8 + 4);
            const f32x4 kk0 = *(const f32x4*)(p.k_k + cg), kk1 = *(const f32x4*)(p.k_k + cg + 4), ka0 = *(const f32x4*)(p.k_a + cg), ka1 = *(const f32x4*)(p.k_a + cg + 4);
            const f32x4 rk0 = *(const f32x4*)(p.r_k + cg), rk1 = *(const f32x4*)(p.r_k + cg + 4);
            float n2 = 0.f, bon = 0.f;
#pragma unroll
            for (int j = 0; j < 8; ++j) {
                const float r_ = (j & 1) ? hi_bf(xr[j >> 1]) : lo_bf(xr[j >> 1]), k_ = (j & 1) ? hi_bf(xk[j >> 1]) : lo_bf(xk[j >> 1]);
                const float a_ = j < 4 ? a0[j & 3] : a1[j & 3], kkc = j < 4 ? kk0[j & 3] : kk1[j & 3], kac = j < 4 ? ka0[j & 3] : ka1[j & 3], rkc = j < 4 ? rk0[j & 3] : rk1[j & 3];
                const float kkr = k_ * kkc;
                n2 += kkr * kkr;
                bon += r_ * (k_ * (1.0f + (a_ - 1.0f) * kac)) * rkc;
            }
            n2 = sum8(n2); bon = sum8(bon);
            if ((tid & 7) == 0) { gt[576 + i] = 1.0f / fmaxf(sqrtf(n2), 1e-12f); p.bonG[(size_t)u * 64 + i] = bon; }
        }
        __syncthreads();
        {
            const int ch = lane, cg = layer * 512 + h * 64 + ch;
            float lw[8], av[8], cum[8];
            {
                const f32x4 l0 = *(const f32x4*)(lwT + ch * 68 + wv * 8), l1 = *(const f32x4*)(lwT + ch * 68 + wv * 8 + 4);
#pragma unroll
                for (int e = 0; e < 4; ++e) { lw[e] = l0[e]; lw[e + 4] = l1[e]; }
#pragma unroll
                for (int e = 0; e < 8; ++e) av[e] = aT[(wv * 8 + e) * 68 + ch];
            }
            float run = 0.f;
#pragma unroll
            for (int e = 0; e < 8; ++e) { run += lw[e]; cum[e] = run; }
            gt[wv * 64 + ch] = run;
            __syncthreads();
            float offs = 0.f, tot = 0.f;
#pragma unroll
            for (int g2 = 0; g2 < 8; ++g2) { const float gv = gt[g2 * 64 + ch]; offs += g2 < wv ? gv : 0.f; tot += gv; }
            if (wv == 0) gammaC[ch] = __expf(tot);
            const float kkc = p.k_k[cg], kac = p.k_a[cg];
            float at_[8], kt_[8], bt_[8], vt_[8];
#pragma unroll
            for (int e = 0; e < 8; ++e) {
                const int i = wv * 8 + e;
                const float xr = bf2f(RBUF(8)[i * LS + ch]), xk = bf2f(RBUF(9)[i * LS + ch]), xv = bf2f(RBUF(10)[i * LS + ch]);
                const float cm = cum[e] + offs;
                const float kk = xk * kkc * gt[576 + i];
                const float kq = xk * (1.0f + (av[e] - 1.0f) * kac);
                if (c * 64 + i < L) p.orw[(tok0 + i) * 512 + h * 64 + ch] = RBUF(10)[i * LS + ch];
                const float eneg = __expf(-cm), epos = __expf(cm), eexc = __expf(cm - lw[e]);
                at_[e] = -kk * eexc; kt_[e] = kq * eneg; bt_[e] = kk * av[e] * eneg; vt_[e] = xv;
                RBUF(3)[i * LS + ch] = f2bf(xr * epos);
            }
            __syncthreads();
#pragma unroll
            for (int e = 0; e < 8; ++e) {
                const int i = wv * 8 + e;
                RBUF(0)[i * LS + ch] = f2bf(at_[e]); RBUF(1)[i * LS + ch] = f2bf(kt_[e]); RBUF(2)[i * LS + ch] = f2bf(bt_[e]);
            }
            *(u32x4*)(RBUF(11) + ch * LS + wv * 8) = (u32x4){pack2(kt_[0], kt_[1]), pack2(kt_[2], kt_[3]), pack2(kt_[4], kt_[5]), pack2(kt_[6], kt_[7])};
            *(u32x4*)(RBUF(12) + ch * LS + wv * 8) = (u32x4){pack2(bt_[0], bt_[1]), pack2(bt_[2], bt_[3]), pack2(bt_[4], bt_[5]), pack2(bt_[6], bt_[7])};
            *(u32x4*)(RBUF(13) + ch * LS + wv * 8) = (u32x4){pack2(vt_[0], vt_[1]), pack2(vt_[2], vt_[3]), pack2(vt_[4], vt_[5]), pack2(vt_[6], vt_[7])};
            *(u32x4*)(Xt0 + ch * LS + wv * 8) = (u32x4){pack2(at_[0], at_[1]), pack2(at_[2], at_[3]), pack2(at_[4], at_[5]), pack2(at_[6], at_[7])};
        }
        __syncthreads();
#pragma unroll
        for (int prod = 0; prod < 4; ++prod) {
            const bf16_t* F = (prod == 0 || prod == 2) ? RBUF(1) : RBUF(2);
            const bf16_t* S = prod < 2 ? RBUF(0) : RBUF(3);
            bf16_t* O = prod == 0 ? RBUF(6) : prod == 1 ? RBUF(7) : prod == 2 ? RBUF(9) : RBUF(10);
            const int mode = prod < 2 ? 0 : 1;
#pragma unroll
            for (int rep = 0; rep < 2; ++rep) {
                const int tl = wv + 8 * rep, pt = tl >> 2, qt = tl & 3;
                f32x4 acc = zero;
                if (pt <= qt) acc = mm16<64>(F + pt * 16 * LS, LS, S + qt * 16 * LS, LS, zero, lane);
                const int qi = qt * 16 + fr;
#pragma unroll
                for (int e = 0; e < 4; ++e) {
                    const int pi = pt * 16 + fq * 4 + e;
                    const bool keep = mode == 0 ? pi < qi : pi <= qi;
                    acc[e] = keep ? acc[e] : 0.f;
                }
                *(u32x2*)(O + qi * LS + pt * 16 + fq * 4) = pk4(acc);
                if (prod == 1) {
#pragma unroll
                    for (int e = 0; e < 4; ++e) RBUF(8)[(pt * 16 + fq * 4 + e) * LS + qi] = f2bf(acc[e]);
                }
            }
        }
        __syncthreads();
        if (wv == 0) r1_tri_inverse(RBUF(7), RBUF(8), RBUF(0), lane);
        else if (wv >= 4) {
#pragma unroll
            for (int pt = 0; pt < 4; ++pt) {
                const f32x4 x = mm16<64>(RBUF(6) + pt * 16 * LS, LS, RBUF(13) + (wv - 4) * 16 * LS, LS, zero, lane);
                *(u32x2*)(Xt0 + (wv * 16 + fr) * LS + pt * 16 + fq * 4) = pk4(x);
            }
        }
        __syncthreads();
        {
            const bf16_t* Tb = RBUF(0);
            const bf16x8 g0 = *(const bf16x8*)(Xt0 + (wv * 16 + fr) * LS + fq * 8), g1 = *(const bf16x8*)(Xt0 + (wv * 16 + fr) * LS + 32 + fq * 8);
            f32x4 X[4];
#pragma unroll
            for (int pt = 0; pt < 4; ++pt) {
                X[pt] = __builtin_amdgcn_mfma_f32_16x16x32_bf16(*(const bf16x8*)(Tb + (pt * 16 + fr) * LS + fq * 8), g0, zero, 0, 0, 0);
                if (pt >= 2) X[pt] = __builtin_amdgcn_mfma_f32_16x16x32_bf16(*(const bf16x8*)(Tb + (pt * 16 + fr) * LS + 32 + fq * 8), g1, X[pt], 0, 0, 0);
            }
#pragma unroll
            for (int pt = 0; pt < 4; ++pt) *(u32x2*)(Xt0 + (wv * 16 + fr) * LS + pt * 16 + fq * 4) = pk4(X[pt]);
        }
        __syncthreads();
#pragma unroll
        for (int rep = 0; rep < 2; ++rep) {
            const int tl = wv + 8 * rep, pt = tl >> 2, qt = tl & 3;
            const int pi0 = pt * 16 + fq * 4, qi = qt * 16 + fr;
            const size_t go = ((size_t)u * 64 + qi) * 64 + pi0;
            {
                f32x4 acc = mm16<64>(Xt0 + pt * 16 * LS, LS, RBUF(12) + qt * 16 * LS, LS, zero, lane);
                const float gc = gammaC[qi];
#pragma unroll
                for (int e = 0; e < 4; ++e) acc[e] = (acc[e] + (pi0 + e == qi ? 1.f : 0.f)) * gc;
                {
                    const size_t d = (((size_t)u * 8 + (qi >> 4) * 2 + (pi0 >> 5)) * 64 + (qi & 15) + 16 * ((pi0 >> 2) & 3)) * 8 + ((pi0 >> 4) & 1) * 4;
                    *(u32x2*)(p.PcG + d) = pk4(acc);
                }
            }
            {
                f32x4 acc = mm16<64>(RBUF(11) + pt * 16 * LS, LS, RBUF(13) + qt * 16 * LS, LS, zero, lane);
                acc = mm16<64>(RBUF(12) + pt * 16 * LS, LS, Xt0 + (64 + qt * 16) * LS, LS, acc, lane);
                const f32x4 gc = *(const f32x4*)(gammaC + pi0);
#pragma unroll
                for (int e = 0; e < 4; ++e) acc[e] *= gc[e];
                {
                    const size_t d = (((size_t)u * 4 + (qi >> 4)) * 64 + (qi & 15) + 16 * ((pi0 >> 2) & 3)) * 16 + (pi0 >> 4) * 4;
                    *(u32x2*)(p.QcG + d) = pk4(acc);
                }
            }
            {
                f32x4 acc = mm16<64>(Xt0 + pt * 16 * LS, LS, RBUF(10) + qt * 16 * LS, LS, zero, lane);
                const f32x4 rr = up4(*(const u32x2*)(RBUF(3) + qi * LS + pi0));
#pragma unroll
                for (int e = 0; e < 4; ++e) acc[e] += rr[e];
                *(u32x2*)(p.RhG + go) = pk4(acc);
            }
            {
                f32x4 acc = mm16<64>(RBUF(13) + pt * 16 * LS, LS, RBUF(9) + qt * 16 * LS, LS, zero, lane);
                acc = mm16<64>(Xt0 + (64 + pt * 16) * LS, LS, RBUF(10) + qt * 16 * LS, LS, acc, lane);
                *(u32x2*)(p.Y0G + go) = pk4(acc);
            }
        }
    }
}

struct R2Set { u32x4 a[8]; u32x4 q[2]; };
DI void r2_load(R2Set& st, const Params& p, size_t u, int lane, int vq) {
    const bf16_t* qg = p.QcG + ((u * 4 + vq) * 64 + lane) * 16;
    st.q[0] = *(const u32x4*)qg; st.q[1] = *(const u32x4*)(qg + 8);
#pragma unroll
    for (int f = 0; f < 8; ++f) st.a[f] = *(const u32x4*)(p.PcG + ((u * 8 + f) * 64 + lane) * 8);
}
DI void r2_step(f32x4 (&S)[4], const R2Set& st, const Params& p, size_t u, int lane, int vq, bool last) {
    const u32x4 b0 = (u32x4){pack2(S[0][0], S[0][1]), pack2(S[0][2], S[0][3]), pack2(S[1][0], S[1][1]), pack2(S[1][2], S[1][3])};
    const u32x4 b1 = (u32x4){pack2(S[2][0], S[2][1]), pack2(S[2][2], S[2][3]), pack2(S[3][0], S[3][1]), pack2(S[3][2], S[3][3])};
    bf16_t* sg = p.SG + ((u * 4 + vq) * 64 + lane) * 16;
    *(u32x4*)sg = b0; *(u32x4*)(sg + 8) = b1;
    if (last) return;
#pragma unroll
    for (int kt = 0; kt < 4; ++kt) {
        const u32x4 qq = st.q[kt >> 1];
        const unsigned w0 = qq[(kt & 1) * 2], w1 = qq[(kt & 1) * 2 + 1];
        S[kt] = (f32x4){lo_bf(w0), hi_bf(w0), lo_bf(w1), hi_bf(w1)};
    }
    const bf16x8 f0 = __builtin_bit_cast(bf16x8, b0), f1 = __builtin_bit_cast(bf16x8, b1);
#pragma unroll
    for (int kt = 0; kt < 4; ++kt) {
        S[kt] = __builtin_amdgcn_mfma_f32_16x16x32_bf16(__builtin_bit_cast(bf16x8, st.a[kt * 2]), f0, S[kt], 0, 0, 0);
        S[kt] = __builtin_amdgcn_mfma_f32_16x16x32_bf16(__builtin_bit_cast(bf16x8, st.a[kt * 2 + 1]), f1, S[kt], 0, 0, 0);
    }
}
DI void phase_rwkv_r2(const Params& p, int chain) {
    const int lane = tid_() & 63;
    const int bh = chain >> 2, vq = chain & 3;
    const size_t u0 = (size_t)bh * NCHUNK;
    f32x4 S[4];
#pragma unroll
    for (int kt = 0; kt < 4; ++kt) S[kt] = (f32x4){0.f, 0.f, 0.f, 0.f};
    R2Set A, B, C, E;
    r2_load(A, p, u0, lane, vq); r2_load(B, p, u0 + 1, lane, vq); r2_load(C, p, u0 + 2, lane, vq); r2_load(E, p, u0 + 3, lane, vq);
#define R2_ONE(SET, cc) do { r2_step(S, SET, p, u0 + (cc), lane, vq, (cc) == NCHUNK - 1); if ((cc) + 4 < NCHUNK - 1) r2_load(SET, p, u0 + (cc) + 4, lane, vq); } while (0)
#pragma unroll 1
    for (int c = 0; c < NCHUNK; c += 4) {
        R2_ONE(A, c);
        if (c == NCHUNK - 1) break;
        R2_ONE(B, c + 1);
        R2_ONE(C, c + 2);
        R2_ONE(E, c + 3);
    }
#undef R2_ONE
}

DI void phase_rwkv_r3(const Params& p, int layer, int bid, int nb) {
    const int tid = tid_(), lane = tid & 63, wv = __builtin_amdgcn_readfirstlane(tid >> 6), fr = lane & 15, fq = lane >> 4;
    constexpr int TPB = L / 16;
    for (int task = bid * 8 + wv; task < NBATCH * HEADS * TPB; task += nb * 8) {
        const int bh = task / TPB, tt = task % TPB, c = tt >> 2, it = tt & 3, u = bh * NCHUNK + c;
        const int h = bh % HEADS, bb = bh / HEADS;
        const int i = it * 16 + fr, t = c * 64 + i;
        const bool live = t < L;
        const size_t tok = (size_t)bb * L + (live ? t : 0);
        bf16x8 sf[2];
#pragma unroll
        for (int ks = 0; ks < 2; ++ks) sf[ks] = *(const bf16x8*)(p.RhG + ((size_t)u * 64 + i) * 64 + ks * 32 + fq * 8);
        u32x2 s0[4][2], s1[4][2], y0[4], xvv[4], gv[4];
#pragma unroll
        for (int vt = 0; vt < 4; ++vt) {
            const int vv = vt * 16 + fr;
#pragma unroll
            for (int ks = 0; ks < 2; ++ks) {
                const bf16_t* sp = p.SG + (((size_t)u * 4 + vt) * 64 + fr + 32 * (fq & 1)) * 16 + (2 * ks + (fq >> 1)) * 4;
                s0[vt][ks] = *(const u32x2*)sp; s1[vt][ks] = *(const u32x2*)(sp + 16 * 16);
                (void)vv;
            }
            y0[vt] = *(const u32x2*)(p.Y0G + ((size_t)u * 64 + i) * 64 + vt * 16 + fq * 4);
            xvv[vt] = *(const u32x2*)(p.orw + tok * 512 + h * 64 + vt * 16 + fq * 4);
            gv[vt] = *(const u32x2*)(p.GG + ((size_t)u * 64 + i) * 64 + vt * 16 + fq * 4);
        }
        const float bon = p.bonG[(size_t)u * 64 + i];
        f32x4 y[4];
#pragma unroll
        for (int vt = 0; vt < 4; ++vt) {
            y[vt] = up4(y0[vt]);
#pragma unroll
            for (int ks = 0; ks < 2; ++ks) {
                const bf16x8 f = __builtin_bit_cast(bf16x8, ((u32x4){s0[vt][ks][0], s0[vt][ks][1], s1[vt][ks][0], s1[vt][ks][1]}));
                y[vt] = __builtin_amdgcn_mfma_f32_16x16x32_bf16(f, sf[ks], y[vt], 0, 0, 0);
            }
        }
        float s = 0.f;
#pragma unroll
        for (int vt = 0; vt < 4; ++vt) s += (y[vt][0] + y[vt][1]) + (y[vt][2] + y[vt][3]);
        s += __shfl_xor(s, 16); s += __shfl_xor(s, 32);
        const float mean = s * (1.0f / 64.f);
        float q = 0.f;
#pragma unroll
        for (int vt = 0; vt < 4; ++vt)
#pragma unroll
            for (int e = 0; e < 4; ++e) { y[vt][e] -= mean; q += y[vt][e] * y[vt][e]; }
        q += __shfl_xor(q, 16); q += __shfl_xor(q, 32);
        const float rstd = rsqrtf(q * (1.0f / 64.f) + 64e-5f);
        if (live) {
#pragma unroll
            for (int vt = 0; vt < 4; ++vt) {
                const int cg = h * 64 + vt * 16 + fq * 4;
                const f32x4 xv = up4(xvv[vt]), g = up4(gv[vt]);
                const f32x4 lg = *(const f32x4*)(p.lnx_g + layer * 512 + cg), lb = *(const f32x4*)(p.lnx_b + layer * 512 + cg);
                f32x4 o;
#pragma unroll
                for (int e = 0; e < 4; ++e) o[e] = (y[vt][e] * rstd * lg[e] + lb[e] + bon * xv[e]) * g[e];
                *(u32x2*)(p.orw + tok * 512 + cg) = pk4(o);
            }
        }
    }
}

constexpr int SB_LDS = 4 * RB + 64;
DI void phase_sb(const Params& p, int bid0, int nb, char* smem) {
    const int tid = tid_(), lane = tid & 63, wv = __builtin_amdgcn_readfirstlane(tid >> 6), fr = lane & 15, fq = lane >> 4;
    bf16_t* Ks0 = (bf16_t*)smem;
    bf16_t* Vt0 = Ks0 + 2 * 64 * LS;
    int* flags = (int*)(smem + 4 * RB);
    bf16x8 tri[4][2];
#pragma unroll
    for (int st = 0; st < 4; ++st)
#pragma unroll
        for (int k2 = 0; k2 < 2; ++k2)
#pragma unroll
            for (int jj = 0; jj < 8; ++jj) tri[st][k2][jj] = (32 * k2 + 16 * (jj >> 2) + 4 * fq + (jj & 3) > 16 * st + fr) ? (short)0x3F80 : (short)0;
    constexpr int NQB = (L + 127) / 128;
    const int ldkey = tid >> 3, lddc = (tid & 7) * 8;
    for (int u = bid0; u < NBATCH * HEADS * NQB; u += nb) {
        const int bh = u % (NBATCH * HEADS), b = bh / HEADS, h = bh % HEADS, q0 = (NQB - 1 - u / (NBATCH * HEADS)) * 128;
        const int qlo = q0 + 16 * wv, query = qlo + fr;
        const size_t tokb = (size_t)b * L;
        bf16x8 qf[2];
#pragma unroll
        for (int ks = 0; ks < 2; ++ks) qf[ks] = *(const bf16x8*)(p.P + (tokb + query) * CP + OFF_Q + h * 64 + ks * 32 + fq * 8);
        const int qmax = (q0 + 127 < L - 1) ? q0 + 127 : L - 1;
        int kt = (qmax - 1) >> 6;
        float R = 0.f;
        f32x4 ot[4];
#pragma unroll
        for (int dt = 0; dt < 4; ++dt) ot[dt] = (f32x4){0.f, 0.f, 0.f, 0.f};
        bool done = qlo >= L;
        u32x4 kreg, vreg;
        {
            const int s = kt * 64 + ldkey;
            const bf16_t* src = p.P + (tokb + s) * CP + h * 64 + lddc;
            kreg = s < L ? *(const u32x4*)(src + OFF_K) : (u32x4){0u, 0u, 0u, 0u};
            vreg = s < L ? *(const u32x4*)(src + OFF_V) : (u32x4){0u, 0u, 0u, 0u};
        }
        const int vsw = (tid & 7) << 2;
        __syncthreads();
        {
            *(u32x4*)(Ks0 + ldkey * LS + lddc) = kreg;
#pragma unroll
            for (int j = 0; j < 4; ++j) { Vt0[(lddc + 2 * j) * LS + (ldkey ^ vsw)] = (bf16_t)(vreg[j] & 0xFFFFu); Vt0[(lddc + 2 * j + 1) * LS + (ldkey ^ vsw)] = (bf16_t)(vreg[j] >> 16); }
        }
        __syncthreads();
        for (int itile = 0;; ++itile) {
            const bf16_t* Ks = Ks0 + (itile & 1) * 64 * LS; const bf16_t* Vt = Vt0 + (itile & 1) * 64 * LS;
            if (kt > 0) {
                const int s = (kt - 1) * 64 + ldkey;
                const bf16_t* src = p.P + (tokb + s) * CP + h * 64 + lddc;
                kreg = *(const u32x4*)(src + OFF_K); vreg = *(const u32x4*)(src + OFF_V);
            }
            if (!done && kt * 64 < qlo + 15) {
                f32x4 uu[4], lsp[4];
                float tot = 0.f;
                const bool full = kt * 64 + 63 < qlo;
#pragma unroll
                for (int kk = 0; kk < 4; ++kk) {
                    f32x4 z = (f32x4){0.f, 0.f, 0.f, 0.f};
#pragma unroll
                    for (int ks = 0; ks < 2; ++ks) {
                        const bf16x8 f = *(const bf16x8*)(Ks + (16 * kk + fr) * LS + ks * 32 + fq * 8);
                        z = __builtin_amdgcn_mfma_f32_16x16x32_bf16(f, qf[ks], z, 0, 0, 0);
                    }
#pragma unroll
                    for (int e = 0; e < 4; ++e) {
                        const float zz = z[e] * 0.18033688011112042f;
                        const float lsneg = -(fmaxf(zz, 0.f) + __builtin_amdgcn_logf(1.0f + __builtin_amdgcn_exp2f(-fabsf(zz))));
                        if (full) { uu[kk][e] = lsneg; lsp[kk][e] = lsneg + zz; }
                        else {
                            const bool valid = kt * 64 + 16 * kk + 4 * fq + e < query;
                            uu[kk][e] = valid ? lsneg : 0.f;
                            lsp[kk][e] = valid ? lsneg + zz : -1.0e30f;
                        }
                        tot += uu[kk][e];
                    }
                }
                tot += __shfl_xor(tot, 16); tot += __shfl_xor(tot, 32);
                f32x4 rest[4];
#pragma unroll
                for (int st = 0; st < 4; ++st) rest[st] = (f32x4){0.f, 0.f, 0.f, 0.f};
#pragma unroll
                for (int k2 = 0; k2 < 2; ++k2) {
                    u32x4 hi, lo;
#pragma unroll
                    for (int t2 = 0; t2 < 2; ++t2) {
                        const f32x4 a = uu[2 * k2 + t2];
                        const unsigned h0 = pack2(a[0], a[1]), h1 = pack2(a[2], a[3]);
                        hi[2 * t2] = h0; hi[2 * t2 + 1] = h1;
                        lo[2 * t2] = pack2(a[0] - lo_bf(h0), a[1] - hi_bf(h0)); lo[2 * t2 + 1] = pack2(a[2] - lo_bf(h1), a[3] - hi_bf(h1));
                    }
                    const bf16x8 fh = __builtin_bit_cast(bf16x8, hi), fl = __builtin_bit_cast(bf16x8, lo);
#pragma unroll
                    for (int st = 0; st < 4; ++st) {
                        rest[st] = __builtin_amdgcn_mfma_f32_16x16x32_bf16(tri[st][k2], fh, rest[st], 0, 0, 0);
                        rest[st] = __builtin_amdgcn_mfma_f32_16x16x32_bf16(tri[st][k2], fl, rest[st], 0, 0, 0);
                    }
                }
                bf16x8 af[2];
#pragma unroll
                for (int k2 = 0; k2 < 2; ++k2) {
                    u32x4 pk;
#pragma unroll
                    for (int t2 = 0; t2 < 2; ++t2) {
                        const int kk = 2 * k2 + t2;
                        float a4[4];
#pragma unroll
                        for (int e = 0; e < 4; ++e) a4[e] = __builtin_amdgcn_exp2f(lsp[kk][e] + R + rest[kk][e]);
                        pk[2 * t2] = pack2(a4[0], a4[1]); pk[2 * t2 + 1] = pack2(a4[2], a4[3]);
                    }
                    af[k2] = __builtin_bit_cast(bf16x8, pk);
                }
                R += tot;
#pragma unroll
                for (int dt = 0; dt < 4; ++dt)
#pragma unroll
                    for (int k2 = 0; k2 < 2; ++k2) {
                        const int dsw = ((2 * dt + (fr >> 3)) & 7) << 2;
                        const bf16_t* vrow = Vt + (16 * dt + fr) * LS;
                        const u32x2 v0 = *(const u32x2*)(vrow + ((32 * k2 + 4 * fq) ^ dsw)), v1 = *(const u32x2*)(vrow + ((32 * k2 + 16 + 4 * fq) ^ dsw));
                        const bf16x8 f = __builtin_bit_cast(bf16x8, ((u32x4){v0[0], v0[1], v1[0], v1[1]}));
                        ot[dt] = __builtin_amdgcn_mfma_f32_16x16x32_bf16(f, af[k2], ot[dt], 0, 0, 0);
                    }
                done = __all((R < -150.1f) || (query >= L));
            }
            if (kt > 0) {
                bf16_t* Kn = Ks0 + ((itile & 1) ^ 1) * 64 * LS; bf16_t* Vn = Vt0 + ((itile & 1) ^ 1) * 64 * LS;
                *(u32x4*)(Kn + ldkey * LS + lddc) = kreg;
#pragma unroll
                for (int j = 0; j < 4; ++j) { Vn[(lddc + 2 * j) * LS + (ldkey ^ vsw)] = (bf16_t)(vreg[j] & 0xFFFFu); Vn[(lddc + 2 * j + 1) * LS + (ldkey ^ vsw)] = (bf16_t)(vreg[j] >> 16); }
            }
            if (lane == 0) flags[(itile & 1) * 8 + wv] = done ? 1 : 0;
            __syncthreads();
            int alld = 1;
#pragma unroll
            for (int w = 0; w < 8; ++w) alld &= flags[(itile & 1) * 8 + w];
            if (alld || kt == 0) break;
            --kt;
        }
        if (query < L) {
#pragma unroll
            for (int dt = 0; dt < 4; ++dt) *(u32x2*)(p.osb + (tokb + query) * 512 + h * 64 + 16 * dt + 4 * fq) = pk4(ot[dt]);
        }
    }
}

struct EpiBranch {
    static constexpr bool PERM = true;
    const bf16_t* G; bf16_t* M; bool add;
    DI void operator()(const f32x4 (&acc)[2][2][4][2], const g8::Unit& u, int wr, int wc, int fr, int fq) const {
        const int c0 = u.pn * 256 + wc * 32 + 8 * fq;
#pragma unroll
        for (int ai = 0; ai < 2; ++ai) {
            u32x4 g[4][2], mo[4][2];
#pragma unroll
            for (int m = 0; m < 4; ++m)
#pragma unroll
                for (int bj = 0; bj < 2; ++bj) {
                    const size_t r = (size_t)(u.pm * 256 + ai * 128 + wr * 64 + m * 16 + fr);
                    g[m][bj] = *(const u32x4*)(G + r * 2048 + c0 + bj * 128);
                    mo[m][bj] = add ? *(const u32x4*)(M + r * D + c0 + bj * 128) : (u32x4){0u, 0u, 0u, 0u};
                }
#pragma unroll
            for (int m = 0; m < 4; ++m)
#pragma unroll
                for (int bj = 0; bj < 2; ++bj) {
                    const size_t r = (size_t)(u.pm * 256 + ai * 128 + wr * 64 + m * 16 + fr);
                    const f32x4 v0 = acc[ai][bj][m][0], v1 = acc[ai][bj][m][1];
                    const u32x4 gg = g[m][bj], mm = mo[m][bj];
                    float o[8] = {lo_bf(gg[0]) * v0[0], hi_bf(gg[0]) * v0[1], lo_bf(gg[1]) * v0[2], hi_bf(gg[1]) * v0[3], lo_bf(gg[2]) * v1[0], hi_bf(gg[2]) * v1[1], lo_bf(gg[3]) * v1[2], hi_bf(gg[3]) * v1[3]};
#pragma unroll
                    for (int q = 0; q < 4; ++q) { o[2 * q] += lo_bf(mm[q]); o[2 * q + 1] += hi_bf(mm[q]); }
                    *(u32x4*)(M + r * D + c0 + bj * 128) = (u32x4){pack2(o[0], o[1]), pack2(o[2], o[3]), pack2(o[4], o[5]), pack2(o[6], o[7])};
                }
        }
    }
};
struct GateOrder {
    g8::DenseOrder d;
    DI bool next(int i, g8::Unit& u) const { return d.next(i, u); }
    DI unsigned row_off(const g8::Unit&, int) const { return 0u; }
};
struct EpiGate {
    static constexpr bool PERM = true;
    bf16_t* G;
    DI void operator()(const f32x4 (&acc)[2][2][4][2], const g8::Unit& u, int wr, int wc, int fr, int fq) const {
#pragma unroll
        for (int ai = 0; ai < 2; ++ai)
#pragma unroll
            for (int m = 0; m < 4; ++m) {
                bf16_t* rowp = G + (size_t)(u.pm * 256 + ai * 128 + wr * 64 + m * 16 + fr) * 2048 + u.pn * 256 + wc * 32 + 8 * fq;
#pragma unroll
                for (int bj = 0; bj < 2; ++bj) {
                    const f32x4 v0 = acc[ai][bj][m][0], v1 = acc[ai][bj][m][1];
                    *(u32x4*)(rowp + bj * 128) = (u32x4){pack2(sigmoidf_(v0[0]), sigmoidf_(v0[1])), pack2(sigmoidf_(v0[2]), sigmoidf_(v0[3])), pack2(sigmoidf_(v1[0]), sigmoidf_(v1[1])), pack2(sigmoidf_(v1[2]), sigmoidf_(v1[3]))};
                }
            }
    }
};
template <int PART> DI void phase_merge(const Params& p, int layer, int bid, int nb, char* smem) {
    const bf16_t* hb = p.hb; bf16_t* G = p.gates; bf16_t* M = p.merged;
    const bf16_t* Wg = p.WtIn + ((size_t)layer * CIN + CP) * D;
    G8_LAS unsigned char* lds = (G8_LAS unsigned char*)smem;
    if (PART == 0) {
#pragma unroll
    for (int which = 0; which < 2; ++which) {
        g8::DenseOrder S; S.init(hb, Wg + (size_t)which * 1024 * D, MFULL, D / 256, D, nb, bid);
        g8::gemm8<false>(lds, D, S, EpiGate{G + which * 1024});
    }
    }
    if (PART == 1) {
#pragma unroll
    for (int which = 0; which < 2; ++which) {
        const bf16_t* A = which ? p.orw : p.osb;
        const bf16_t* Bt = (which ? p.WtPrw : p.WtPsb) + (size_t)layer * D * 512;
        g8::DenseOrder S; S.init(A, Bt, MFULL, D / 256, 512, nb, bid);
        g8::gemm8<false>(lds, 512, S, EpiBranch{G + which * 1024, M, which != 0});
    }
    }
    if (PART == 1)
    for (int t = left_first(MFULL * 4 * 2, bid, nb); t < D / 128; t += nb) {
#pragma unroll
        for (int which = 0; which < 2; ++which) {
            const bf16_t* A = which ? p.orw : p.osb; const bf16_t* Gw = p.gleft - (size_t)M0_LEFT * 2048 + which * 1024;
            const bf16_t* Bt = (which ? p.WtPrw : p.WtPsb) + (size_t)layer * D * 512;
            gemm_left32([=](int r) { return A + (size_t)(M0_LEFT + r) * 512; }, Bt, 512, 512, t * 128, smem,
                        [=](int r0, int c, f32x4 v) {
                            const size_t r = (size_t)(M0_LEFT + r0);
                            const u32x2 g = *(const u32x2*)(Gw + r * 2048 + c);
                            float o0 = lo_bf(g[0]) * v[0], o1 = hi_bf(g[0]) * v[1], o2 = lo_bf(g[1]) * v[2], o3 = hi_bf(g[1]) * v[3];
                            u32x2* mp = (u32x2*)(M + r * D + c);
                            if (which) { const u32x2 m = *mp; o0 += lo_bf(m[0]); o1 += hi_bf(m[0]); o2 += lo_bf(m[1]); o3 += hi_bf(m[1]); }
                            *mp = (u32x2){pack2(o0, o1), pack2(o2, o3)};
                        });
        }
    }
}
struct EpiOut {
    static constexpr bool PERM = true;
    bf16_t* hb;
    DI void operator()(const f32x4 (&acc)[2][2][4][2], const g8::Unit& u, int wr, int wc, int fr, int fq) const {
        const int c0 = u.pn * 256 + wc * 32 + 8 * fq;
#pragma unroll
        for (int ai = 0; ai < 2; ++ai) {
            u32x4 hv[4][2];
#pragma unroll
            for (int m = 0; m < 4; ++m)
#pragma unroll
                for (int bj = 0; bj < 2; ++bj) hv[m][bj] = *(const u32x4*)(hb + (size_t)(u.pm * 256 + ai * 128 + wr * 64 + m * 16 + fr) * D + c0 + bj * 128);
#pragma unroll
            for (int m = 0; m < 4; ++m)
#pragma unroll
                for (int bj = 0; bj < 2; ++bj) {
                    const u32x4 h = hv[m][bj]; const f32x4 v0 = acc[ai][bj][m][0], v1 = acc[ai][bj][m][1];
                    *(u32x4*)(hb + (size_t)(u.pm * 256 + ai * 128 + wr * 64 + m * 16 + fr) * D + c0 + bj * 128) =
                        (u32x4){pack2(ALPHA * lo_bf(h[0]) + v0[0], ALPHA * hi_bf(h[0]) + v0[1]), pack2(ALPHA * lo_bf(h[1]) + v0[2], ALPHA * hi_bf(h[1]) + v0[3]),
                                pack2(ALPHA * lo_bf(h[2]) + v1[0], ALPHA * hi_bf(h[2]) + v1[1]), pack2(ALPHA * lo_bf(h[3]) + v1[2], ALPHA * hi_bf(h[3]) + v1[3])};
                }
        }
    }
};
DI void phase_outproj(const Params& p, int layer, int bid, int nb, char* smem) {
    const bf16_t* A = p.merged; bf16_t* const hbres = p.hb;
    const bf16_t* Bt = p.WtOut + (size_t)layer * D * D;
    if (bid == 0 && tid_() < NE) p.counts[tid_()] = 0;
    g8::DenseOrder S; S.init(A, Bt, MFULL, D / 256, D, nb, bid);
    g8::gemm8<false>((G8_LAS unsigned char*)smem, D, S, EpiOut{hbres});
    for (int t = left_first(MFULL * 4, bid, nb); t < D / 128; t += nb)
        gemm_left32([=](int r) { return A + (size_t)(M0_LEFT + r) * D; }, Bt, D, D, t * 128, smem,
                    [=](int r0, int c, f32x4 v) {
                        const int r = M0_LEFT + r0;
                        u32x2* hp = (u32x2*)(hbres + (size_t)r * D + c);
                        const f32x4 h = up4(*hp);
                        *hp = (u32x2){pack2(ALPHA * h[0] + v[0], ALPHA * h[1] + v[1]), pack2(ALPHA * h[2] + v[2], ALPHA * h[3] + v[3])};
                    });
}

constexpr int LN1_ROWB = 2 * D + 16;
constexpr int LN1_WAVE = 8 * LN1_ROWB;
constexpr int LN1_LDS = 8 * LN1_WAVE + 2048;
DI void phase_ln1_router(const Params& p, int layer, int bid, int nb, char* smem) {
    const int tid = tid_(), lane = tid & 63, wid = __builtin_amdgcn_readfirstlane(tid >> 6), fr = lane & 15, fq = lane >> 4;
    char* wl = smem + wid * LN1_WAVE;
    int* sel = (int*)(smem + 8 * LN1_WAVE);
    float* sgt = (float*)(smem + 8 * LN1_WAVE + 640);
    int* sbase = (int*)(smem + 8 * LN1_WAVE + 1280);
    const int nwaves = nb * 8, gw = bid * 8 + wid;
    const int base_n = T / nwaves, extra = T % nwaves;
    const int tok0 = gw * base_n + (gw < extra ? gw : extra), ntok = base_n + (gw < extra ? 1 : 0);
    const int btok0 = bid * 8 * base_n + (bid * 8 < extra ? bid * 8 : extra);
    const float* g1p = p.ln1_g + layer * D; const float* b1p = p.ln1_b + layer * D;
    __syncthreads();
    for (int g0 = 0; g0 < ntok; g0 += 8) {
        const int ng = ntok - g0 < 8 ? ntok - g0 : 8;
        float vn[16];
        { const bf16_t* hf = p.hb + (size_t)(tok0 + g0) * D;
#pragma unroll
          for (int j = 0; j < 4; ++j) { const f32x4 a = up4(*(const u32x2*)(hf + 256 * j + 4 * lane)); vn[4 * j] = a[0]; vn[4 * j + 1] = a[1]; vn[4 * j + 2] = a[2]; vn[4 * j + 3] = a[3]; } }
#pragma unroll 1
        for (int i = 0; i < ng; ++i) {
            const int tok = tok0 + g0 + i;
            float v[16];
#pragma unroll
            for (int q = 0; q < 16; ++q) v[q] = vn[q];
            if (i + 1 < ng) { const bf16_t* hn = p.hb + (size_t)(tok + 1) * D;
#pragma unroll
                for (int j = 0; j < 4; ++j) { const f32x4 a = up4(*(const u32x2*)(hn + 256 * j + 4 * lane)); vn[4 * j] = a[0]; vn[4 * j + 1] = a[1]; vn[4 * j + 2] = a[2]; vn[4 * j + 3] = a[3]; } }
            ln16(v, g1p, b1p, lane);
#pragma unroll
            for (int j = 0; j < 4; ++j) {
                const unsigned h0 = pack2(v[4 * j], v[4 * j + 1]), h1 = pack2(v[4 * j + 2], v[4 * j + 3]);
                *(u32x2*)(p.hb + (size_t)tok * D + 256 * j + 4 * lane) = (u32x2){h0, h1};
                *(u32x2*)(wl + i * LN1_ROWB + (256 * j + 4 * lane) * 2) = (u32x2){h0, h1};
            }
        }
        asm volatile("s_waitcnt lgkmcnt(0)" ::: "memory");
        __builtin_amdgcn_wave_barrier();
        f32x4 acc[2] = {(f32x4){0.f, 0.f, 0.f, 0.f}, (f32x4){0.f, 0.f, 0.f, 0.f}};
        const char* arow = wl + (fr & 7) * LN1_ROWB + fq * 16;
        const bf16_t* whi = p.RwHi + (size_t)fr * D + fq * 8;
#pragma unroll 4
        for (int ks = 0; ks < 32; ++ks) {
            const bf16x8 ah = *(const bf16x8*)(arow + ks * 64);
            const bf16x8 bh = *(const bf16x8*)(whi + ks * 32);
            acc[ks & 1] = __builtin_amdgcn_mfma_f32_16x16x32_bf16(bh, ah, acc[ks & 1], 0, 0, 0);
        }
        float lg[4]; float mx = -3.0e38f;
#pragma unroll
        for (int e = 0; e < 4; ++e) { lg[e] = acc[0][e] + acc[1][e] + p.router_b[4 * fq + e]; mx = fmaxf(mx, lg[e]); }
        mx = fmaxf(mx, __shfl_xor(mx, 16)); mx = fmaxf(mx, __shfl_xor(mx, 32));
        float sum = 0.f;
#pragma unroll
        for (int e = 0; e < 4; ++e) { lg[e] = __expf(lg[e] - mx); sum += lg[e]; }
        sum += __shfl_xor(sum, 16); sum += __shfl_xor(sum, 32);
        const float inv = 1.0f / sum;
        float v1 = -1.f, v2 = -1.f; int i1 = 0, i2 = 0;
#pragma unroll
        for (int e = 0; e < 4; ++e) {
            const float pv = lg[e] * inv;
            if (pv > v1) { v2 = v1; i2 = i1; v1 = pv; i1 = e; } else if (pv > v2) { v2 = pv; i2 = e; }
        }
        const float sc = v1 + v2;
        float bsc = sc; int bg = fq;
#pragma unroll
        for (int m = 16; m <= 32; m <<= 1) {
            const float os = __shfl_xor(bsc, m); const int og = __shfl_xor(bg, m);
            if (os > bsc || (os == bsc && og < bg)) { bsc = os; bg = og; }
        }
        if (bg == fq && fr < ng) {
            const int li = tok0 + g0 + fr - btok0;
            const float gs = 1.0f / (v1 + v2);
            sel[li * 2] = 4 * fq + i1; sel[li * 2 + 1] = 4 * fq + i2; sgt[li * 2] = v1 * gs; sgt[li * 2 + 1] = v2 * gs;
        }
        asm volatile("s_waitcnt lgkmcnt(0)" ::: "memory");
        __builtin_amdgcn_wave_barrier();
    }
    __syncthreads();
    if (wid == 0) {
        const int nbt = 8 * base_n + ((bid * 8 + 8 <= extra) ? 8 : (bid * 8 < extra ? extra - bid * 8 : 0));
        for (int c0 = 0; c0 < nbt; c0 += 64) {
            const int li = c0 + lane; const bool on = li < nbt;
            const int e1 = on ? sel[li * 2] : -1, e2 = on ? sel[li * 2 + 1] : -1;
            const unsigned long long lt = (1ull << lane) - 1ull;
            int r1 = 0, r2 = 0, mycnt = 0;
#pragma unroll
            for (int e = 0; e < NE; ++e) {
                const unsigned long long m1 = __ballot(e1 == e), m2 = __ballot(e2 == e);
                const int c1 = __popcll(m1), c2 = __popcll(m2);
                if (e1 == e) r1 = __popcll(m1 & lt);
                if (e2 == e) r2 = c1 + __popcll(m2 & lt);
                if (lane == e) mycnt = c1 + c2;
            }
            if (lane < NE) sbase[lane] = mycnt > 0 ? atomicAdd(&p.counts[lane], mycnt) : 0;
            asm volatile("s_waitcnt vmcnt(0) lgkmcnt(0)" ::: "memory");
            __builtin_amdgcn_wave_barrier();
            if (on) {
                const int tok = btok0 + li;
                const int s1 = sbase[e1] + r1, s2 = sbase[e2] + r2;
                p.list[e1 * T + s1] = tok * 2; p.list[e2 * T + s2] = tok * 2 + 1;
                p.tokg[tok * 2] = sgt[li * 2]; p.tokg[tok * 2 + 1] = sgt[li * 2 + 1];
            }
            asm volatile("s_waitcnt lgkmcnt(0)" ::: "memory");
            __builtin_amdgcn_wave_barrier();
        }
    }
}

constexpr int MOE_BIG = 8;
template <bool UP> struct MoeOrder {
    const int* counts; const int* list; int G, c; const char* A; const char* B;
    DI bool next(int i, g8::Unit& u) const {
        const int xcd = c & 7, w = c >> 3, mt = (w >> 1) & 7, pn = 2 * (w & 1) + i, esel = xcd + 8 * (w >> 4);
        if (w >= 32 || i >= 2) return false;
        int padp = 0, fe = -1, fc = 0, fp = 0;
#pragma unroll
        for (int e = 0; e < NE; ++e) {
            const int cn = counts[e], ntp = (cn + 255) >> 8, nt = ntp < MOE_BIG ? ntp : MOE_BIG;
            const bool hit = (e == esel) && (mt < nt);
            fe = hit ? e : fe; fc = hit ? cn : fc; fp = hit ? padp + mt : fp;
            padp += ntp;
        }
        fe = __builtin_amdgcn_readfirstlane(fe); fc = __builtin_amdgcn_readfirstlane(fc); fp = __builtin_amdgcn_readfirstlane(fp);
        if (fe < 0) return false;
        u.e = fe; u.slot0 = mt * 256; u.cnt = fc; u.pm = fp; u.pn = pn;
        u.A = UP ? A : A + (size_t)fp * ((size_t)256 * DE * 2);
        u.B = UP ? B + (size_t)fe * ((size_t)1024 * 1024 * 2) + (size_t)pn * ((size_t)256 * D * 2) : B + (size_t)fe * ((size_t)1024 * 512 * 2) + (size_t)pn * ((size_t)256 * DE * 2);
        return true;
    }
    DI unsigned row_off(const g8::Unit& u, int r) const {
        const __amdgpu_buffer_rsrc_t rs = __builtin_amdgcn_make_buffer_rsrc((void*)list, 0, NE * T * 4, 0x00020000);
        const int ent = __builtin_amdgcn_raw_buffer_load_b32(rs, r * 4, (u.e * T + u.slot0) * 4, 0);
        return u.slot0 + r < u.cnt ? (unsigned)(ent >> 1) * (unsigned)(D * 2) : 0u;
    }
};
struct EpiMoeUp {
    static constexpr bool PERM = true;
    bf16_t* hid;
    DI void operator()(const f32x4 (&acc)[2][2][4][2], const g8::Unit& u, int wr, int wc, int fr, int fq) const {
#pragma unroll
        for (int ai = 0; ai < 2; ++ai)
#pragma unroll
            for (int m = 0; m < 4; ++m) {
                const int r = ai * 128 + wr * 64 + m * 16 + fr;
                if (u.slot0 + r >= u.cnt) continue;
                bf16_t* rowp = hid + ((size_t)u.pm * 256 + r) * DE + ((u.pn * 256 + wc * 32 + 8 * fq) >> 1);
#pragma unroll
                for (int bj = 0; bj < 2; ++bj) {
                    const f32x4 v0 = acc[ai][bj][m][0], v1 = acc[ai][bj][m][1];
                    *(u32x2*)(rowp + bj * 64) = (u32x2){pack2(v0[0] * sigmoidf_(v0[0]) * v0[1], v0[2] * sigmoidf_(v0[2]) * v0[3]), pack2(v1[0] * sigmoidf_(v1[0]) * v1[1], v1[2] * sigmoidf_(v1[2]) * v1[3])};
                }
            }
    }
};
struct EpiMoeDown {
    static constexpr bool PERM = true;
    bf16_t* fo; const int* list; const float* tokg;
    DI void operator()(const f32x4 (&acc)[2][2][4][2], const g8::Unit& u, int wr, int wc, int fr, int fq) const {
        int ent[8]; float g[8];
#pragma unroll
        for (int q = 0; q < 8; ++q) {
            const int sl = u.slot0 + (q >> 2) * 128 + wr * 64 + (q & 3) * 16 + fr;
            ent[q] = sl < u.cnt ? list[u.e * T + sl] : -1;
        }
#pragma unroll
        for (int q = 0; q < 8; ++q) g[q] = ent[q] >= 0 ? tokg[ent[q]] : 0.f;
#pragma unroll
        for (int ai = 0; ai < 2; ++ai)
#pragma unroll
            for (int m = 0; m < 4; ++m) {
                const int q = ai * 4 + m;
                if (ent[q] < 0) continue;
                const float gg = g[q];
                bf16_t* rowp = fo + ((size_t)(ent[q] & 1) * TP + (ent[q] >> 1)) * D + u.pn * 256 + wc * 32 + 8 * fq;
#pragma unroll
                for (int bj = 0; bj < 2; ++bj) {
                    const f32x4 v0 = acc[ai][bj][m][0], v1 = acc[ai][bj][m][1];
                    *(u32x4*)(rowp + bj * 128) = (u32x4){pack2(gg * v0[0], gg * v0[1]), pack2(gg * v0[2], gg * v0[3]), pack2(gg * v1[0], gg * v1[1]), pack2(gg * v1[2], gg * v1[3])};
                }
            }
    }
};
DI void phase_moe_up(const Params& p, int bid, int nb, char* smem) {
    const MoeOrder<true> S{p.counts, p.list, nb, bid, (const char*)p.hb, (const char*)p.WtGU};
    g8::gemm8<true>((G8_LAS unsigned char*)smem, D, S, EpiMoeUp{p.hid});
    const bf16_t* hb = p.hb; bf16_t* hid = p.hid; const int* list = p.list;
    int big = 0, padr = 0, job = 0;
#pragma unroll 1
    for (int e = 0; e < NE; ++e) { const int cn = p.counts[e], ntp = (cn + 255) >> 8; big += (ntp < MOE_BIG ? ntp : MOE_BIG) * 4; }
    const int mine = bid; (void)big;
#pragma unroll 1
    for (int e = 0; e < NE; ++e) {
        const int cn = p.counts[e];
        for (int s0 = MOE_BIG * 256; s0 < cn; s0 += 128)
            for (int nt = 0; nt < 8; ++nt, ++job)
                if (job % nb == mine) {
                    const int prow = padr;
                    gemm_tile128([=](int r) { const int sl = s0 + r; return sl < cn ? hb + (size_t)(list[e * T + sl] >> 1) * D : (const bf16_t*)nullptr; },
                                 p.WtGU + (size_t)e * 1024 * 1024, D, D, 0, nt * 128, smem,
                                 [=](int r, int c, f32x4 v) {
                                     const int sl = s0 + r;
                                     if (sl >= cn) return;
                                     *(unsigned*)(hid + (size_t)(prow + sl) * DE + (c >> 1)) = pack2(v[0] * sigmoidf_(v[0]) * v[1], v[2] * sigmoidf_(v[2]) * v[3]);
                                 });
                }
        padr += ((cn + 255) >> 8) * 256;
    }
}
DI void phase_moe_down(const Params& p, int bid, int nb, char* smem) {
    const MoeOrder<false> S{p.counts, p.list, nb, bid, (const char*)p.hid, (const char*)p.WtD};
    g8::gemm8<false>((G8_LAS unsigned char*)smem, DE, S, EpiMoeDown{p.fo, p.list, p.tokg});
    const bf16_t* hid = p.hid; bf16_t* fo = p.fo; const int* list = p.list; const float* tokg = p.tokg;
    int big = 0, padr = 0, job = 0;
#pragma unroll 1
    for (int e = 0; e < NE; ++e) { const int cn = p.counts[e], ntp = (cn + 255) >> 8; big += (ntp < MOE_BIG ? ntp : MOE_BIG) * 4; }
    const int mine = bid; (void)big;
#pragma unroll 1
    for (int e = 0; e < NE; ++e) {
        const int cn = p.counts[e];
        for (int s0 = MOE_BIG * 256; s0 < cn; s0 += 128)
            for (int nt = 0; nt < 8; ++nt, ++job)
                if (job % nb == mine) {
                    const int prow = padr;
                    gemm_tile128([=](int r) { const int sl = s0 + r; return sl < cn ? hid + (size_t)(prow + sl) * DE : (const bf16_t*)nullptr; },
                                 p.WtD + (size_t)e * 1024 * 512, DE, DE, 0, nt * 128, smem,
                                 [=](int r, int c, f32x4 v) {
                                     const int sl = s0 + r;
                                     if (sl >= cn) return;
                                     const int ent = list[e * T + sl];
                                     const float g = tokg[ent];
                                     *(u32x2*)(fo + ((size_t)(ent & 1) * TP + (ent >> 1)) * D + c) = (u32x2){pack2(g * v[0], g * v[1]), pack2(g * v[2], g * v[3])};
                                 });
                }
        padr += ((cn + 255) >> 8) * 256;
    }
}
DI void phase_ln2(const Params& p, int layer, int bid, int nb) {
    const int lane = tid_() & 63, wid = __builtin_amdgcn_readfirstlane(tid_() >> 6);
    const int nwaves = nb * 8, gw = bid * 8 + wid, base_n = T / nwaves, extra = T % nwaves;
    const int tok0 = gw * base_n + (gw < extra ? gw : extra), ntok = base_n + (gw < extra ? 1 : 0);
    u32x2 an[4], f0n[4], f1n[4];
    {
#pragma unroll
        for (int j = 0; j < 4; ++j) {
            an[j] = *(const u32x2*)(p.hb + (size_t)tok0 * D + 256 * j + 4 * lane);
            f0n[j] = *(const u32x2*)(p.fo + (size_t)tok0 * D + 256 * j + 4 * lane); f1n[j] = *(const u32x2*)(p.fo + ((size_t)TP + tok0) * D + 256 * j + 4 * lane);
        }
    }
#pragma unroll 1
    for (int i = 0; i < ntok; ++i) {
        const int tok = tok0 + i;
        float v[16];
#pragma unroll
        for (int j = 0; j < 4; ++j) {
            v[4 * j] = ALPHA * lo_bf(an[j][0]) + lo_bf(f0n[j][0]) + lo_bf(f1n[j][0]); v[4 * j + 1] = ALPHA * hi_bf(an[j][0]) + hi_bf(f0n[j][0]) + hi_bf(f1n[j][0]);
            v[4 * j + 2] = ALPHA * lo_bf(an[j][1]) + lo_bf(f0n[j][1]) + lo_bf(f1n[j][1]); v[4 * j + 3] = ALPHA * hi_bf(an[j][1]) + hi_bf(f0n[j][1]) + hi_bf(f1n[j][1]);
        }
        if (i + 1 < ntok) {
#pragma unroll
            for (int j = 0; j < 4; ++j) {
                an[j] = *(const u32x2*)(p.hb + (size_t)(tok + 1) * D + 256 * j + 4 * lane);
                f0n[j] = *(const u32x2*)(p.fo + (size_t)(tok + 1) * D + 256 * j + 4 * lane); f1n[j] = *(const u32x2*)(p.fo + ((size_t)TP + tok + 1) * D + 256 * j + 4 * lane);
            }
        }
        ln16(v, p.ln2_g + layer * D, p.ln2_b + layer * D, lane);
        if (layer == DEPTH - 1) {
            float* of = hrow_u(p, tok);
#pragma unroll
            for (int j = 0; j < 4; ++j) *(f32x4*)(of + 256 * j + 4 * lane) = (f32x4){v[4 * j], v[4 * j + 1], v[4 * j + 2], v[4 * j + 3]};
        } else store_row_bf(p.hb + (size_t)tok * D, v, lane);
    }
}

extern __shared__ __attribute__((aligned(16))) char dyn_smem[];
constexpr int SMEM_MAIN = R1_LDS > GEMM_LDS ? R1_LDS : GEMM_LDS;
constexpr int SMEM_BYTES = SMEM_MAIN + 16;

__global__ void __launch_bounds__(NTHR, 2) k_forward(Params p) {
    const int bid = blockIdx.x, nb = gridDim.x;
    char* smem = dyn_smem;
    uint4* xbw = (uint4*)(dyn_smem + SMEM_MAIN);
    if (threadIdx.x == 0) *xbw = make_uint4(0u, 0u, 0u, 0u);
    __syncthreads();
    XcdBarrier bar = xcd_barrier_post(p.bar, (volatile LAS unsigned*)xbw);
    phase_prologue_weights(p, bid, nb, smem);
    phase_embed(p, bid, nb);
    xcd_barrier(bar);
    for (int l = 0; l < DEPTH; ++l) {
        phase_inproj(p, l, bid, nb, smem);
        xcd_barrier(bar);
        phase_rwkv_r1<0>(p, l, bid, nb, smem);
        xcd_barrier(bar);
        if (bid < 16) { const int cw = __builtin_amdgcn_readfirstlane(tid_() >> 6); if (cw < 4) phase_rwkv_r2(p, bid * 4 + cw); }
        else {
            const int sbid = bid - 16, snb = nb - 16, heavy = (NBATCH * HEADS * ((L + 127) / 128)) % snb;
            if (sbid >= heavy && sbid < heavy + NBATCH * HEADS) phase_rwkv_r1<1>(p, l, sbid - heavy, 1, smem);
            phase_sb(p, sbid, snb, smem);
        }
        xcd_barrier(bar);
        phase_rwkv_r3(p, l, bid, nb);
        convert_experts(p, l, NE / 2, NE, bid, nb, smem);
        phase_merge<0>(p, l, bid, nb, smem);
        xcd_barrier(bar);
        phase_merge<1>(p, l, bid, nb, smem);
        xcd_barrier(bar);
        phase_outproj(p, l, bid, nb, smem);
        xcd_barrier(bar);
        phase_ln1_router(p, l, bid, nb, smem);
        xcd_barrier(bar);
        phase_moe_up(p, bid, nb, smem);
        xcd_barrier(bar);
        phase_moe_down(p, bid, nb, smem);
        xcd_barrier(bar);
        phase_ln2(p, l, bid, nb);
        xcd_barrier(bar);
    }
}

extern "C" void kernel_launch(void* const* d_in, const int* in_sizes, int n_in, void* d_out, int out_size, void* d_ws, size_t ws_size, hipStream_t stream) {
    (void)in_sizes; (void)n_in; (void)out_size;
    Params p;
    memset(&p, 0, sizeof(p));
    const float* const* in = (const float* const*)d_in;
    p.x = in[0]; p.meta = in[1]; p.emb_g = in[2]; p.emb_b = in[3]; p.w_in = in[4]; p.mu = in[5]; p.w0 = in[6]; p.w_up = in[7]; p.a0 = in[8]; p.a_up = in[9];
    p.g_up = in[10]; p.k_k = in[11]; p.k_a = in[12]; p.r_k = in[13]; p.lnx_g = in[14]; p.lnx_b = in[15]; p.p_sb = in[16]; p.p_rwkv = in[17]; p.w_out = in[18];
    p.ln1_g = in[19]; p.ln1_b = in[20]; p.router_w = in[21]; p.router_b = in[22]; p.ew_gate = in[23]; p.ew_up = in[24]; p.ew_down = in[25]; p.ln2_g = in[26]; p.ln2_b = in[27];
    p.out = (float*)d_out;
    char* ws = (char*)d_ws; size_t o = 0;
    auto take = [&](size_t bytes) { char* r = ws + o; o += (bytes + 255) & ~(size_t)255; return r; };
    p.bar = (unsigned*)take(XCD_BAR_WORDS * sizeof(unsigned));
    p.counts = (int*)take(256);
    p.WtIn = (bf16_t*)take((size_t)DEPTH * CIN * D * 2);
    p.WtPsb = (bf16_t*)take((size_t)DEPTH * D * 512 * 2);
    p.WtPrw = (bf16_t*)take((size_t)DEPTH * D * 512 * 2);
    p.WtOut = (bf16_t*)take((size_t)DEPTH * D * D * 2);
    p.WupT = (bf16_t*)take((size_t)DEPTH * 512 * 64 * 2);
    p.AupT = (bf16_t*)take((size_t)DEPTH * 512 * 64 * 2);
    p.GupT = (bf16_t*)take((size_t)DEPTH * 512 * 128 * 2);
    p.RwHi = (bf16_t*)take((size_t)NE * D * 2);
    p.gleft = (bf16_t*)take((size_t)32 * 2048 * 2);
    {
        const size_t ub = (size_t)NUNIT * 64 * 64 * 2;
        p.WtGU = (bf16_t*)take((size_t)NE * 1024 * 1024 * 2);
        p.WtD = (bf16_t*)take((size_t)NE * 1024 * 512 * 2);
        p.PcG = (bf16_t*)d_out; p.QcG = (bf16_t*)((char*)d_out + ub); p.RhG = (bf16_t*)((char*)d_out + 2 * ub);
        p.Y0G = (bf16_t*)take(ub); p.GG = (bf16_t*)take(ub); p.SG = (bf16_t*)take(ub);
        p.bonG = (float*)take((size_t)NUNIT * 64 * 4);
    }
    p.hb = (bf16_t*)take((size_t)TP * D * 2);
    p.hmeta = (float*)take((size_t)NBATCH * NMETA * D * 4);
    p.P = (bf16_t*)take((size_t)TP * CP * 2);
    p.osb = (bf16_t*)take((size_t)TP * 512 * 2);
    p.orw = (bf16_t*)take((size_t)TP * 512 * 2);
    p.list = (int*)take((size_t)NE * T * 4);
    p.tokg = (float*)take((size_t)T * 2 * 4);
    p.gates = p.P;
    p.merged = p.P + (size_t)TP * 2048;
    p.hid = p.P;
    p.fo = p.P + (size_t)(2 * T + 16 * 256) * DE;
    if (o > ws_size) return;
    static int grid = 0;
    if (!grid) {
        int dev = 0, cus = 0, per_cu = 0;
        (void)hipGetDevice(&dev);
        (void)hipDeviceGetAttribute(&cus, hipDeviceAttributeMultiprocessorCount, dev);
        (void)hipFuncSetAttribute((const void*)k_forward, hipFuncAttributeMaxDynamicSharedMemorySize, SMEM_BYTES);
        (void)hipOccupancyMaxActiveBlocksPerMultiprocessor(&per_cu, k_forward, NTHR, SMEM_BYTES);
        grid = per_cu >= 1 ? cus : 0;
    }
    if (!grid) return;
    (void)hipMemsetAsync(p.bar, 0, XCD_BAR_WORDS * sizeof(unsigned), stream);
    hipLaunchKernelGGL(k_forward, dim3(grid), dim3(NTHR), SMEM_BYTES, stream, p);
}
```

```cpp
#include <hip/hip_runtime.h>
#include <stdint.h>
#include <string.h>

#define DI __device__ __forceinline__
typedef unsigned short bf16_t;
typedef short bf16x8 __attribute__((ext_vector_type(8)));
typedef float f32x4 __attribute__((ext_vector_type(4)));
typedef unsigned u32x4 __attribute__((ext_vector_type(4)));
typedef unsigned u32x2 __attribute__((ext_vector_type(2)));

constexpr int D = 1024, NBATCH = 2, SEQ = 8192, NMETA = 16, L = SEQ + NMETA, T = NBATCH * L, TP = 16640;
constexpr int DEPTH = 2, HEADS = 8, HD = 64;
constexpr int CIN = 5376, CP = 3328;
constexpr int OFF_Q = 0, OFF_K = 512, OFF_V = 1024, OFF_RW = 1536;
constexpr int RW_R = 0, RW_K = 512, RW_V = 1024, RW_WD = 1536, RW_AD = 1600, RW_GD = 1664, RSW = 1792;
constexpr int NE = 16, DE = 512;
constexpr float ALPHA = 1.41421356237309515f;
constexpr float DECAY_SCALE = 0.60653065971263342f;
constexpr int NTHR = 512;

#define XB_TMO      128
#define XB_XCNT(j)  (256  + 64 * (j))
#define XB_XSUB(j)  (1280 + 64 * (j))
#define XB_XGEN(j)  (2304 + 64 * (j))
#define XB_TOP      3328
#define XB_TOPGEN   3392
#define XCD_BAR_WORDS 3456
#define XB_SPIN_CAP (1u << 18)
#define LAS __attribute__((address_space(3)))

__device__ __forceinline__ unsigned xb_ld(unsigned* p)              { return __hip_atomic_load(p, __ATOMIC_RELAXED, __HIP_MEMORY_SCOPE_AGENT); }
__device__ __forceinline__ unsigned xb_add(unsigned* p, unsigned v) { return __hip_atomic_fetch_add(p, v, __ATOMIC_RELAXED, __HIP_MEMORY_SCOPE_AGENT); }
__device__ __forceinline__ unsigned xb_xcc_id() { return (unsigned)__builtin_amdgcn_s_getreg((3 << 11) | 20) & 0xFu; }
#define XB_SPIN(cond, bar) do { unsigned _sp = 0; while (cond) { __builtin_amdgcn_s_sleep(1); \
    if ((++_sp & 255u) == 0u) { if (xb_ld(&(bar)[XB_TMO])) break; if (_sp > XB_SPIN_CAP) { atomicAdd(&(bar)[XB_TMO], 1u); break; } } } } while (0)

struct XcdBarrier {
    unsigned* bar; unsigned x;
    volatile LAS unsigned* st;
};

__device__ __forceinline__ XcdBarrier xcd_barrier_post(unsigned* bar, volatile LAS unsigned* st) {
    XcdBarrier b; b.bar = bar; b.x = xb_xcc_id(); b.st = st;
    if (threadIdx.x == 0) (void)xb_add(&bar[XB_XCNT(b.x)], 1u);
    return b;
}
__device__ __forceinline__ void xcd_barrier_complete(unsigned* bar, unsigned x, unsigned& nloc, unsigned& nx) {
    const unsigned G = gridDim.x * gridDim.y * gridDim.z;
    unsigned sum, cnt, mine, sp = 0u;
    for (;;) {
        sum = 0u; cnt = 0u; mine = 0u;
#pragma unroll
        for (unsigned j = 0; j < 16; ++j) { const unsigned c = xb_ld(&bar[XB_XCNT(j)]); sum += c; cnt += (c > 0u) ? 1u : 0u; mine = (j == x) ? c : mine; }
        if (sum == G) break;
        __builtin_amdgcn_s_sleep(1);
        if ((++sp & 255u) == 0u) { if (xb_ld(&bar[XB_TMO])) break; if (sp > XB_SPIN_CAP) { atomicAdd(&bar[XB_TMO], 1u); break; } }
    }
    nloc = mine > 0u ? mine : 1u; nx = cnt > 0u ? cnt : 1u;
}

__device__ __forceinline__ void xcd_barrier(const XcdBarrier& b) {
    asm volatile("s_waitcnt vmcnt(0)" ::: "memory");
    __syncthreads();
    if (threadIdx.x == 0) {
        unsigned* bar = b.bar;
        unsigned bx = b.x; asm volatile("" : "+s"(bx));
        __builtin_amdgcn_s_waitcnt(0);
        unsigned nloc = b.st[0], nx = b.st[1];
        if (nloc == 0u) { xcd_barrier_complete(bar, bx, nloc, nx); b.st[0] = nloc; b.st[1] = nx; }
        const unsigned old = xb_add(&bar[XB_XSUB(bx)], 1u);
        const unsigned gen = old / nloc;
        if (old + 1u == (gen + 1u) * nloc) {
            __builtin_amdgcn_fence(__ATOMIC_RELEASE, "agent");
            asm volatile("s_waitcnt vmcnt(0)" ::: "memory");
            const unsigned og = xb_add(&bar[XB_TOP], 1u);
            const unsigned tg = og / nx;
            if (og + 1u == (tg + 1u) * nx) xb_add(&bar[XB_TOPGEN], 1u);
            else XB_SPIN(xb_ld(&bar[XB_TOPGEN]) == tg, bar);
            __builtin_amdgcn_fence(__ATOMIC_ACQUIRE, "agent");
            xb_add(&bar[XB_XGEN(bx)], 1u);
            asm volatile("s_waitcnt vmcnt(0)" ::: "memory");
        } else {
            XB_SPIN(xb_ld(&bar[XB_XGEN(bx)]) == gen, bar);
            __builtin_amdgcn_fence(__ATOMIC_ACQUIRE, "agent");
            asm volatile("s_waitcnt vmcnt(0)" ::: "memory");
        }
    }
    __syncthreads();
}


struct Params {
    const float *x, *meta, *emb_g, *emb_b, *w_in, *mu, *w0, *w_up, *a0, *a_up, *g_up, *k_k, *k_a, *r_k, *lnx_g, *lnx_b, *p_sb, *p_rwkv, *w_out,
        *ln1_g, *ln1_b, *router_w, *router_b, *ew_gate, *ew_up, *ew_down, *ln2_g, *ln2_b;
    float* out;
    unsigned* bar;
    int* counts;
    bf16_t *WtIn, *WtPsb, *WtPrw, *WtOut, *WtGU, *WtD, *hb, *P, *osb, *orw, *WupT, *AupT, *GupT;
    bf16_t *PcG, *QcG, *RhG, *Y0G, *GG, *SG;
    bf16_t *RwHi, *gleft;
    float* bonG;
    float* hmeta;
    bf16_t *gates, *merged, *hid, *fo;
    int* list;
    float* tokg;
};

DI float bf2f(bf16_t v) { return __uint_as_float((unsigned)v << 16); }
typedef __bf16 bf16x2_t __attribute__((ext_vector_type(2)));
DI bf16_t f2bf(float f) { return __builtin_bit_cast(bf16_t, (__bf16)f); }
DI unsigned pack2(float lo, float hi) { bf16x2_t v = {(__bf16)lo, (__bf16)hi}; return __builtin_bit_cast(unsigned, v); }
DI float lo_bf(unsigned u) { return __uint_as_float(u << 16); }
DI float hi_bf(unsigned u) { return __uint_as_float(u & 0xFFFF0000u); }
template <int CTRL> DI float dpp_mov(float v) { return __builtin_bit_cast(float, __builtin_amdgcn_update_dpp(0, __builtin_bit_cast(int, v), CTRL, 0xF, 0xF, true)); }
DI float sum8(float v) {
    v += dpp_mov<0xB1>(v);
    v += dpp_mov<0x4E>(v);
    v += dpp_mov<0x141>(v);
    return v;
}
DI float sum16(float v) { v = sum8(v); v += dpp_mov<0x140>(v); return v; }
DI float wave_sum(float v) { v = sum16(v); v += __shfl_xor(v, 16); v += __shfl_xor(v, 32); return v; }
struct Params;
DI const Params& kparams() {
    auto k = __builtin_amdgcn_kernarg_segment_ptr();
    asm volatile("" : "+s"(k));
    return *(const Params*)k;
}
DI int tid_() { int t = threadIdx.x; asm volatile("" : "+v"(t)); return t; }
DI float sigmoidf_(float x) { return __builtin_amdgcn_rcpf(1.0f + __expf(-x)); }
DI float tanhf_(float x) { return 1.0f - 2.0f * __builtin_amdgcn_rcpf(1.0f + __expf(2.0f * x)); }

DI float* hrow2(float* hmeta, float* out, int tok) {
    const int b = tok >= L ? 1 : 0, t = tok - b * L;
    const unsigned long long am = (unsigned long long)(hmeta + (long long)(b * NMETA + t) * D), ao = (unsigned long long)(out + ((long long)b * SEQ + (t - NMETA)) * D);
    const unsigned long long m = 0ull - (unsigned long long)(t < NMETA);
    return (float*)((am & m) | (ao & ~m));
}
DI float* hrow(const Params& p, int tok) { return hrow2(p.hmeta, p.out, tok); }
DI float* hrow_u(const Params& p, int tok) { return hrow2(p.hmeta, p.out, __builtin_amdgcn_readfirstlane(tok)); }

DI void transpose_convert(const float* __restrict__ src, int ld, int K, int N, bf16_t* __restrict__ dst, int mult, int off, int bid, int nb, char* smem, int& rot) {
    float* tile = (float*)smem;
    const int tk = K / 64, tn = N / 256, tid = tid_();
    const int first = (bid - rot % nb + nb) % nb;
    rot += tk * tn;
    for (int t = first; t < tk * tn; t += nb) {
        const int k0 = (t / tn) * 64, n0 = (t % tn) * 256;
        f32x4 v[4][2];
#pragma unroll
        for (int q = 0; q < 4; ++q)
#pragma unroll
            for (int i = 0; i < 2; ++i) v[q][i] = *(const f32x4*)(src + (size_t)(k0 + (tid >> 4) + 32 * i) * ld + n0 + q * 64 + (tid & 15) * 4);
        __syncthreads();
#pragma unroll
        for (int q = 0; q < 4; ++q)
#pragma unroll
            for (int i = 0; i < 2; ++i) {
                float* tp = tile + q * 64 * 65 + ((tid >> 4) + 32 * i) * 65 + (tid & 15) * 4;
                tp[0] = v[q][i][0]; tp[1] = v[q][i][1]; tp[2] = v[q][i][2]; tp[3] = v[q][i][3];
            }
        __syncthreads();
        const int n = tid >> 3, kc = (tid & 7) * 8;
#pragma unroll
        for (int q = 0; q < 4; ++q) {
            const float* tq = tile + q * 64 * 65;
            u32x4 o;
#pragma unroll
            for (int jj = 0; jj < 4; ++jj) o[jj] = pack2(tq[(kc + 2 * jj) * 65 + n], tq[(kc + 2 * jj + 1) * 65 + n]);
            *(u32x4*)(dst + (size_t)((n0 + q * 64 + n) * mult + off) * K + k0 + kc) = o;
        }
    }
}

DI void convert_experts(const Params& p, int layer, int e0, int e1, int bid, int nb, char* smem) {
    int rot = 0;
    for (int e = e0; e < e1; ++e) {
        const size_t eo = ((size_t)layer * NE + e) * (size_t)D * DE;
        transpose_convert(p.ew_gate + eo, DE, D, DE, p.WtGU + (size_t)e * 1024 * 1024, 2, 0, bid, nb, smem, rot);
        transpose_convert(p.ew_up + eo, DE, D, DE, p.WtGU + (size_t)e * 1024 * 1024, 2, 1, bid, nb, smem, rot);
        transpose_convert(p.ew_down + eo, D, DE, D, p.WtD + (size_t)e * 1024 * 512, 1, 0, bid, nb, smem, rot);
    }
}

DI void convert_layer_weights(const Params& p, int l, int bid, int nb, char* smem) {
    int rot = 0;
    transpose_convert(p.w_in + (size_t)l * D * CIN, CIN, D, CIN, p.WtIn + (size_t)l * CIN * D, 1, 0, bid, nb, smem, rot);
    transpose_convert(p.p_sb + (size_t)l * 512 * D, D, 512, D, p.WtPsb + (size_t)l * D * 512, 1, 0, bid, nb, smem, rot);
    transpose_convert(p.p_rwkv + (size_t)l * 512 * D, D, 512, D, p.WtPrw + (size_t)l * D * 512, 1, 0, bid, nb, smem, rot);
    transpose_convert(p.w_out + (size_t)l * D * D, D, D, D, p.WtOut + (size_t)l * D * D, 1, 0, bid, nb, smem, rot);
    transpose_convert(p.w_up + (size_t)l * 64 * 512, 512, 64, 512, p.WupT + (size_t)l * 512 * 64, 1, 0, bid, nb, smem, rot);
    transpose_convert(p.a_up + (size_t)l * 64 * 512, 512, 64, 512, p.AupT + (size_t)l * 512 * 64, 1, 0, bid, nb, smem, rot);
    transpose_convert(p.g_up + (size_t)l * 128 * 512, 512, 128, 512, p.GupT + (size_t)l * 512 * 128, 1, 0, bid, nb, smem, rot);
}
DI void phase_prologue_weights(const Params& p, int bid, int nb, char* smem) {
    for (int i = bid * NTHR + tid_(); i < NE * D; i += nb * NTHR) {
        const int e = i / D, k = i % D;
        p.RwHi[i] = f2bf(p.router_w[(size_t)k * NE + e]);
    }
    for (int l = 0; l < DEPTH; ++l) convert_layer_weights(p, l, bid, nb, smem);
}

DI void ln16(float (&v)[16], const float* __restrict__ g, const float* __restrict__ b, int lane) {
    float s = 0.f;
#pragma unroll
    for (int i = 0; i < 16; ++i) s += v[i];
    const float mean = wave_sum(s) * (1.0f / D);
    float q = 0.f;
#pragma unroll
    for (int i = 0; i < 16; ++i) { v[i] -= mean; q += v[i] * v[i]; }
    const float rstd = rsqrtf(wave_sum(q) * (1.0f / D) + 1e-5f);
#pragma unroll
    for (int j = 0; j < 4; ++j) {
        const f32x4 gv = *(const f32x4*)(g + 256 * j + 4 * lane), bv = *(const f32x4*)(b + 256 * j + 4 * lane);
#pragma unroll
        for (int i = 0; i < 4; ++i) v[4 * j + i] = v[4 * j + i] * rstd * gv[i] + bv[i];
    }
}
DI void store_row_bf(bf16_t* __restrict__ hb, const float (&v)[16], int lane) {
#pragma unroll
    for (int j = 0; j < 4; ++j) *(u32x2*)(hb + 256 * j + 4 * lane) = (u32x2){pack2(v[4 * j], v[4 * j + 1]), pack2(v[4 * j + 2], v[4 * j + 3])};
}
DI void phase_embed(const Params& p, int bid, int nb) {
    const int lane = tid_() & 63, wid = __builtin_amdgcn_readfirstlane(tid_() >> 6);
    const int nwaves = nb * 8, gw = bid * 8 + wid, base_n = T / nwaves, extra = T % nwaves;
    const int tok0 = gw * base_n + (gw < extra ? gw : extra), ntok = base_n + (gw < extra ? 1 : 0);
    auto srcrow = [&](int tok) -> const float* {
        const int tk = __builtin_amdgcn_readfirstlane(tok), b = tk >= L ? 1 : 0, t = tk - b * L;
        const unsigned long long am = (unsigned long long)(p.meta + (long long)t * D), ao = (unsigned long long)(p.x + ((long long)b * SEQ + (t - NMETA)) * D);
        const unsigned long long m = 0ull - (unsigned long long)(t < NMETA);
        return (const float*)((am & m) | (ao & ~m));
    };
    f32x4 an[4];
    { const float* src = srcrow(tok0);
#pragma unroll
      for (int j = 0; j < 4; ++j) an[j] = *(const f32x4*)(src + 256 * j + 4 * lane); }
#pragma unroll 1
    for (int i = 0; i < ntok; ++i) {
        const int tok = tok0 + i;
        float v[16];
#pragma unroll
        for (int j = 0; j < 4; ++j) { v[4 * j] = an[j][0]; v[4 * j + 1] = an[j][1]; v[4 * j + 2] = an[j][2]; v[4 * j + 3] = an[j][3]; }
        if (i + 1 < ntok) { const float* src = srcrow(tok + 1);
#pragma unroll
            for (int j = 0; j < 4; ++j) an[j] = *(const f32x4*)(src + 256 * j + 4 * lane); }
        ln16(v, p.emb_g, p.emb_b, lane);
        store_row_bf(p.hb + (size_t)tok * D, v, lane);
    }
}

constexpr int LDT = 72;
constexpr int GEMM_LDS = 2 * 128 * LDT * 2;
template <class ARow, class Epi>
DI void gemm_tile128(ARow arow, const bf16_t* __restrict__ Bt, int ldb, int K, int m0, int n0, char* smem, Epi epi) {
    const int tid = tid_(), lane = tid & 63, wid = __builtin_amdgcn_readfirstlane(tid >> 6), fr = lane & 15, fq = lane >> 4;
    const int wr = wid >> 1, wc = wid & 1;
    bf16_t* As = (bf16_t*)smem;
    bf16_t* Bs = As + 128 * LDT;
    const bf16_t* ap[2]; const bf16_t* bp[2]; int so[2];
#pragma unroll
    for (int i = 0; i < 2; ++i) {
        const int c = tid + NTHR * i, row = c >> 3, kc = c & 7;
        const bf16_t* ar = arow(m0 + row);
        ap[i] = ar ? ar + kc * 8 : nullptr;
        bp[i] = Bt + (size_t)(n0 + row) * ldb + kc * 8;
        so[i] = row * LDT + kc * 8;
    }
    f32x4 acc[2][4];
#pragma unroll
    for (int mi = 0; mi < 2; ++mi)
#pragma unroll
        for (int ni = 0; ni < 4; ++ni) acc[mi][ni] = (f32x4){0.f, 0.f, 0.f, 0.f};
    u32x4 ra[2], rb[2];
#pragma unroll
    for (int i = 0; i < 2; ++i) { ra[i] = ap[i] ? *(const u32x4*)(ap[i]) : (u32x4){0u, 0u, 0u, 0u}; rb[i] = *(const u32x4*)(bp[i]); }
    for (int k0 = 0; k0 < K; k0 += 64) {
        __syncthreads();
#pragma unroll
        for (int i = 0; i < 2; ++i) { *(u32x4*)(As + so[i]) = ra[i]; *(u32x4*)(Bs + so[i]) = rb[i]; }
        __syncthreads();
        if (k0 + 64 < K) {
#pragma unroll
            for (int i = 0; i < 2; ++i) { ra[i] = ap[i] ? *(const u32x4*)(ap[i] + k0 + 64) : (u32x4){0u, 0u, 0u, 0u}; rb[i] = *(const u32x4*)(bp[i] + k0 + 64); }
        }
#pragma unroll
        for (int ks = 0; ks < 2; ++ks) {
            bf16x8 af[2], bf[4];
#pragma unroll
            for (int mi = 0; mi < 2; ++mi) af[mi] = *(const bf16x8*)(As + (wr * 32 + mi * 16 + fr) * LDT + ks * 32 + fq * 8);
#pragma unroll
            for (int ni = 0; ni < 4; ++ni) bf[ni] = *(const bf16x8*)(Bs + (wc * 64 + ni * 16 + fr) * LDT + ks * 32 + fq * 8);
#pragma unroll
            for (int mi = 0; mi < 2; ++mi)
#pragma unroll
                for (int ni = 0; ni < 4; ++ni) acc[mi][ni] = __builtin_amdgcn_mfma_f32_16x16x32_bf16(bf[ni], af[mi], acc[mi][ni], 0, 0, 0);
        }
    }
#pragma unroll
    for (int mi = 0; mi < 2; ++mi)
#pragma unroll
        for (int ni = 0; ni < 4; ++ni) epi(m0 + wr * 32 + mi * 16 + fr, n0 + wc * 64 + ni * 16 + fq * 4, acc[mi][ni]);
}

namespace g8 {
#define G8_LAS __attribute__((address_space(3)))
constexpr int BM = 256, BK = 64, HALF = 128, HTB = HALF * BK * 2, STAGE_BYTES = 8 * HTB, NXCD = 8, WGM = 8;
DI int lds_byte(int r, int c) { const int st = (r >> 4) * 2 + (c >> 5), rr = r & 15, cc = c & 31, ob = rr * 64 + cc * 2; return st * 1024 + (ob ^ (((ob >> 9) & 1) << 5)); }
DI void stage_rc(int b, int& R, int& C) { const int st = b / 1024, sb = b % 1024, swz = sb ^ (((sb >> 9) & 1) << 5); R = (st >> 1) * 16 + swz / 64; C = (st & 1) * 32 + (swz % 64) / 2; }
DI int perm32(int rho) { const int n = rho >> 4, i = rho & 15; return 8 * (i >> 2) + 4 * n + (i & 3); }
struct Unit { int pm, pn; const char* A; const char* B; int e, slot0, cnt; };

struct DenseOrder {
    int nM, nN, nwg, G, c; const char* A; const char* B; size_t tstep;
    DI void init(const bf16_t* A_, const bf16_t* Bt_, int nM_, int nN_, int K, int G_, int c_) { nM = nM_; nN = nN_; nwg = nM * nN; G = G_; c = c_; A = (const char*)A_; B = (const char*)Bt_; tstep = (size_t)BM * K * 2; }
    DI bool next(int i, Unit& u) const {
        const long Lq = (long)i * G + c; if (Lq >= nwg) return false;
        int wgid = (int)Lq; { const int q = nwg / NXCD, r = nwg % NXCD, xcd = wgid % NXCD, off = wgid / NXCD; wgid = (xcd < r ? xcd * (q + 1) : r * (q + 1) + (xcd - r) * q) + off; }
        const int nig = WGM * nN, gid = wgid / nig, fm = gid * WGM, gsz = (nM - fm) < WGM ? (nM - fm) : WGM;
        u.pm = fm + ((wgid % nig) % gsz); u.pn = (wgid % nig) / gsz; u.A = A + (size_t)u.pm * tstep; u.B = B + (size_t)u.pn * tstep; u.e = 0; u.slot0 = 0; u.cnt = 0; return true;
    }
    DI unsigned row_off(const Unit&, int) const { return 0u; }
};

template <bool GATHER, class Epi, class Sched>
DI void gemm8(G8_LAS unsigned char* lds, const int K, const Sched& S, const Epi& E) {
    const int tid = tid_(), wid = __builtin_amdgcn_readfirstlane(tid >> 6), lane = tid & 63, wr = wid >> 2, wc = wid & 3, fr = lane & 15, fq = lane >> 4;
    const int nt = K / BK;
    int Rr[2], Cc[2]; unsigned voffB[2], voffA[2];
#pragma unroll
    for (int i = 0; i < 2; ++i) { stage_rc(tid * 16 + i * 8192, Rr[i], Cc[i]); const int Rb = Epi::PERM ? ((Rr[i] & ~31) + perm32(Rr[i] & 31)) : Rr[i]; voffB[i] = (unsigned)(Rb * K + Cc[i]) * 2u; voffA[i] = (unsigned)(Rr[i] * K + Cc[i]) * 2u; }
    const size_t kstep = (size_t)(BK * 2), hstep = (size_t)HALF * K * 2;
    const unsigned ldsw = (unsigned)wid * 1024u;
    const int aoff = lds_byte(wr * 64 + fr, fq * 8), boff = lds_byte(wc * 32 + fr, fq * 8);
#define G8_SA(b, h) (((b) * 2 + (h)) * HTB)
#define G8_SB(b, h) ((4 + (b) * 2 + (h)) * HTB)
#define G8_STAGE(bufoff, gbase, voff) do { _Pragma("unroll") for (int _i = 0; _i < 2; ++_i) \
        __builtin_amdgcn_global_load_lds((const unsigned*)((const char*)(gbase) + (voff)[_i]), (G8_LAS unsigned*)(lds + (bufoff) + ldsw + _i * 8192), 16, 0, 0); } while (0)
#define G8_LDA(dst, b, h) do { _Pragma("unroll") for (int m = 0; m < 4; ++m) _Pragma("unroll") for (int k = 0; k < 2; ++k) dst[m][k] = *(const G8_LAS bf16x8*)(lds + G8_SA(b, h) + aoff + m * 2048 + k * 1024); } while (0)
#define G8_LDB(dst, b, h) do { _Pragma("unroll") for (int n = 0; n < 2; ++n) _Pragma("unroll") for (int k = 0; k < 2; ++k) dst[n][k] = *(const G8_LAS bf16x8*)(lds + G8_SB(b, h) + boff + n * 2048 + k * 1024); } while (0)
#define G8_MMA(ai, bj, At, Bt) do { __builtin_amdgcn_s_setprio(1); _Pragma("unroll") for (int m = 0; m < 4; ++m) _Pragma("unroll") for (int n = 0; n < 2; ++n) _Pragma("unroll") for (int k = 0; k < 2; ++k) \
        acc[ai][bj][m][n] = __builtin_amdgcn_mfma_f32_16x16x32_bf16(Bt[n][k], At[m][k], acc[ai][bj][m][n], 0, 0, 0); __builtin_amdgcn_s_setprio(0); } while (0)
#define G8_WAIT_V(n) asm volatile("s_waitcnt vmcnt(" #n ")" ::: "memory")
#define G8_WAIT_L(n) asm volatile("s_waitcnt lgkmcnt(" #n ")" ::: "memory")
#define G8_BAR __builtin_amdgcn_s_barrier()
#define G8_SCHED __builtin_amdgcn_sched_barrier(0)
#define G8_AOFF(dst, un) do { if (GATHER) { _Pragma("unroll") for (int _h = 0; _h < 2; ++_h) _Pragma("unroll") for (int _i = 0; _i < 2; ++_i) \
        dst[_h][_i] = S.row_off(un, _h * HALF + Rr[_i]) + (unsigned)Cc[_i] * 2u; } } while (0)
#define G8_STAGE_A(bufoff, gb, vo, h) do { if (GATHER) { G8_STAGE(bufoff, gb, vo[h]); } else { G8_STAGE(bufoff, (gb) + (h) * hstep, voffA); } } while (0)
    Unit cur, nxt; int ui = 0;
    if (!S.next(0, cur)) return;
    f32x4 acc[2][2][4][2];
#pragma unroll
    for (int a = 0; a < 2; ++a)
#pragma unroll
        for (int b = 0; b < 2; ++b)
#pragma unroll
            for (int m = 0; m < 4; ++m)
#pragma unroll
                for (int n = 0; n < 2; ++n) acc[a][b][m][n] = (f32x4){0.f, 0.f, 0.f, 0.f};
    bf16x8 At[4][2], B0[2][2], B1[2][2];
    unsigned cvA[2][2], nvA[2][2];
    G8_AOFF(cvA, cur);
    const char* cA = cur.A; const char* cB = cur.B;
    G8_STAGE(G8_SB(0, 0), cB, voffB); G8_STAGE_A(G8_SA(0, 0), cA, cvA, 0); G8_STAGE(G8_SB(0, 1), cB + hstep, voffB); G8_STAGE_A(G8_SA(0, 1), cA, cvA, 1);
    if (wr == 1) G8_BAR;
    G8_WAIT_V(4); G8_BAR;
    G8_STAGE(G8_SB(1, 0), cB + kstep, voffB); G8_STAGE_A(G8_SA(1, 0), cA + kstep, cvA, 0); G8_STAGE(G8_SB(1, 1), cB + hstep + kstep, voffB);
    G8_WAIT_V(6); G8_BAR;
    for (;;) {
        const bool has_next = S.next(ui + 1, nxt);
        const char* nA = has_next ? nxt.A : cA; const char* nB = has_next ? nxt.B : cB;
        if (GATHER) {
            if (has_next) { G8_AOFF(nvA, nxt); } else {
#pragma unroll
                for (int h = 0; h < 2; ++h)
#pragma unroll
                    for (int i = 0; i < 2; ++i) nvA[h][i] = cvA[h][i];
            }
        }
        for (int t = 0; t < nt; t += 2) {
            const bool last = (t == nt - 2);
            const char* a1 = cA + (size_t)(t + 1) * kstep;
            const char* a2 = last ? nA : cA + (size_t)(t + 2) * kstep; const char* b2 = last ? nB : cB + (size_t)(t + 2) * kstep;
            const char* a3 = a2 + kstep; const char* b3 = b2 + kstep;

            G8_LDB(B0, 0, 0); G8_SCHED; G8_LDA(At, 0, 0); G8_STAGE_A(G8_SA(1, 1), a1, cvA, 1);
            if (GATHER && last) {
#pragma unroll
                for (int h = 0; h < 2; ++h)
#pragma unroll
                    for (int i = 0; i < 2; ++i) cvA[h][i] = nvA[h][i];
            }
            G8_WAIT_L(8); G8_BAR; G8_WAIT_L(0); G8_MMA(0, 0, At, B0); G8_BAR; G8_SCHED;
            G8_LDB(B1, 0, 1); G8_STAGE(G8_SB(0, 0), b2, voffB);
            G8_BAR; G8_WAIT_L(0); G8_MMA(0, 1, At, B1); G8_BAR;
            G8_LDA(At, 0, 1); G8_STAGE_A(G8_SA(0, 0), a2, cvA, 0);
            G8_BAR; G8_WAIT_L(0); G8_MMA(1, 0, At, B0); G8_BAR; G8_SCHED;
            G8_STAGE(G8_SB(0, 1), b2 + hstep, voffB);
            G8_WAIT_V(6); G8_BAR; G8_MMA(1, 1, At, B1); G8_BAR;
            G8_LDB(B0, 1, 0); G8_SCHED; G8_LDA(At, 1, 0); G8_STAGE_A(G8_SA(0, 1), a2, cvA, 1);
            G8_WAIT_L(8); G8_BAR; G8_WAIT_L(0); G8_MMA(0, 0, At, B0); G8_BAR; G8_SCHED;
            G8_LDB(B1, 1, 1); G8_STAGE(G8_SB(1, 0), b3, voffB);
            G8_BAR; G8_WAIT_L(0); G8_MMA(0, 1, At, B1); G8_BAR;
            G8_LDA(At, 1, 1); G8_STAGE_A(G8_SA(1, 0), a3, cvA, 0);
            G8_BAR; G8_WAIT_L(0); G8_MMA(1, 0, At, B0); G8_BAR; G8_SCHED;
            G8_STAGE(G8_SB(1, 1), b3 + hstep, voffB);
            G8_WAIT_V(6); G8_BAR; G8_MMA(1, 1, At, B1); G8_BAR;
        }
        { int fr2 = fr, fq2 = fq; asm volatile("" : "+v"(fr2), "+v"(fq2)); E(acc, cur, wr, wc, fr2, fq2); }
        if (!has_next) break;
#pragma unroll
        for (int a = 0; a < 2; ++a)
#pragma unroll
            for (int b = 0; b < 2; ++b)
#pragma unroll
                for (int m = 0; m < 4; ++m)
#pragma unroll
                    for (int n = 0; n < 2; ++n) acc[a][b][m][n] = (f32x4){0.f, 0.f, 0.f, 0.f};
        cur = nxt; cA = nA; cB = nB; ++ui;
    }
    G8_WAIT_V(0);
    if (wr == 0) G8_BAR;
    G8_BAR;
#undef G8_SA
#undef G8_SB
#undef G8_STAGE
#undef G8_LDA
#undef G8_LDB
#undef G8_MMA
#undef G8_WAIT_V
#undef G8_WAIT_L
#undef G8_BAR
#undef G8_SCHED
#undef G8_AOFF
#undef G8_STAGE_A
}
}

constexpr int MFULL = 64, M0_LEFT = MFULL * 256;
struct EpiStore {
    static constexpr bool PERM = true;
    bf16_t* O; int ldc; bool sig;
    DI void operator()(const f32x4 (&acc)[2][2][4][2], const g8::Unit& u, int wr, int wc, int fr, int fq) const {
#pragma unroll
        for (int ai = 0; ai < 2; ++ai)
#pragma unroll
            for (int m = 0; m < 4; ++m) {
                bf16_t* rowp = O + (size_t)(u.pm * 256 + ai * 128 + wr * 64 + m * 16 + fr) * ldc + u.pn * 256 + wc * 32 + 8 * fq;
#pragma unroll
                for (int bj = 0; bj < 2; ++bj) {
                    f32x4 v0 = acc[ai][bj][m][0], v1 = acc[ai][bj][m][1];
                    if (sig) {
#pragma unroll
                        for (int e = 0; e < 4; ++e) { v0[e] = sigmoidf_(v0[e]); v1[e] = sigmoidf_(v1[e]); }
                    }
                    *(u32x4*)(rowp + bj * 128) = (u32x4){pack2(v0[0], v0[1]), pack2(v0[2], v0[3]), pack2(v1[0], v1[1]), pack2(v1[2], v1[3])};
                }
            }
    }
};
DI int left_first(int units, int bid, int nb) { return (bid - units % nb + nb) % nb; }

constexpr int LEFT_LDS = 2 * (32 + 128) * LDT * 2;
template <class ARow, class Epi>
DI void gemm_left32(ARow arow, const bf16_t* __restrict__ Bt, int ldb, int K, int n0, char* smem, Epi epi) {
    const int tid = tid_(), lane = tid & 63, wid = __builtin_amdgcn_readfirstlane(tid >> 6), fr = lane & 15, fq = lane >> 4;
    bf16_t* As = (bf16_t*)smem;
    bf16_t* Bs = As + 2 * 32 * LDT;
    const int arow_i = tid >> 4, akc = (tid & 15) * 4;
    const bf16_t* ap = arow(arow_i) + akc;
    const bf16_t* bp[2]; int bso[2];
#pragma unroll
    for (int i = 0; i < 2; ++i) { const int cc = tid + NTHR * i, row = cc >> 3, kc = cc & 7; bp[i] = Bt + (size_t)(n0 + row) * ldb + kc * 8; bso[i] = row * LDT + kc * 8; }
    const int nit = K / 64;
    u32x2 ra[4]; u32x4 rb[4][2];
#define GL_LOAD(slot, it) do { if ((it) < nit) { ra[slot] = *(const u32x2*)(ap + (it) * 64); rb[slot][0] = *(const u32x4*)(bp[0] + (it) * 64); rb[slot][1] = *(const u32x4*)(bp[1] + (it) * 64); } } while (0)
#define GL_WRITE(slot, buf) do { *(u32x2*)(As + (buf) * 32 * LDT + arow_i * LDT + akc) = ra[slot]; *(u32x4*)(Bs + (buf) * 128 * LDT + bso[0]) = rb[slot][0]; *(u32x4*)(Bs + (buf) * 128 * LDT + bso[1]) = rb[slot][1]; } while (0)
    f32x4 acc[2] = {(f32x4){0.f, 0.f, 0.f, 0.f}, (f32x4){0.f, 0.f, 0.f, 0.f}};
    GL_LOAD(0, 0); GL_LOAD(1, 1); GL_LOAD(2, 2); GL_LOAD(3, 3);
    __syncthreads();
    GL_WRITE(0, 0);
    __syncthreads();
#define GL_STEP(slot, it) do { \
        GL_LOAD(slot, (it) + 4); \
        const int buf = (it) & 1; \
        _Pragma("unroll") for (int ks = 0; ks < 2; ++ks) { \
            const bf16x8 bf = *(const bf16x8*)(Bs + buf * 128 * LDT + (wid * 16 + fr) * LDT + ks * 32 + fq * 8); \
            _Pragma("unroll") for (int mt = 0; mt < 2; ++mt) { \
                const bf16x8 af = *(const bf16x8*)(As + buf * 32 * LDT + (mt * 16 + fr) * LDT + ks * 32 + fq * 8); \
                acc[mt] = __builtin_amdgcn_mfma_f32_16x16x32_bf16(bf, af, acc[mt], 0, 0, 0); } } \
        if ((it) + 1 < nit) { GL_WRITE(((slot) + 1) & 3, buf ^ 1); } \
        __syncthreads(); } while (0)
    for (int it = 0; it < nit; it += 4) {
        GL_STEP(0, it);
        if (it + 1 < nit) GL_STEP(1, it + 1);
        if (it + 2 < nit) GL_STEP(2, it + 2);
        if (it + 3 < nit) GL_STEP(3, it + 3);
    }
#undef GL_LOAD
#undef GL_WRITE
#undef GL_STEP
#pragma unroll
    for (int mt = 0; mt < 2; ++mt) epi(mt * 16 + fr, n0 + wid * 16 + fq * 4, acc[mt]);
}

DI void phase_inproj(const Params& p, int layer, int bid, int nb, char* smem) {
    const bf16_t* hb = p.hb; bf16_t* P = p.P;
    const bf16_t* Bt = p.WtIn + (size_t)layer * CIN * D;
    g8::DenseOrder S; S.init(hb, Bt, MFULL, CP / 256, D, nb, bid);
    g8::gemm8<false>((G8_LAS unsigned char*)smem, D, S, EpiStore{P, CP, false});
    {
        constexpr int UNITS = MFULL * (CP / 256);
        const int heavy = UNITS % nb;
        if (heavy > 0 && heavy < nb) { if (bid >= heavy) convert_experts(p, layer, 0, NE / 2, bid - heavy, nb - heavy, smem); }
        else convert_experts(p, layer, 0, NE / 2, bid, nb, smem);
    }
    bf16_t* G = p.gleft - (size_t)M0_LEFT * 2048; const bf16_t* Wg = p.WtIn + ((size_t)layer * CIN + CP) * D;
    for (int t = left_first(MFULL * (CP / 256), bid, nb); t < CP / 128 + 2048 / 128; t += nb) {
        if (t < CP / 128)
            gemm_left32([=](int r) { return hb + (size_t)(M0_LEFT + r) * D; }, Bt, D, D, t * 128, smem,
                        [=](int r, int c, f32x4 v) { *(u32x2*)(P + (size_t)(M0_LEFT + r) * CP + c) = (u32x2){pack2(v[0], v[1]), pack2(v[2], v[3])}; });
        else
            gemm_left32([=](int r) { return hb + (size_t)(M0_LEFT + r) * D; }, Wg, D, D, (t - CP / 128) * 128, smem,
                        [=](int r, int c, f32x4 v) { *(u32x2*)(G + (size_t)(M0_LEFT + r) * 2048 + c) = (u32x2){pack2(sigmoidf_(v[0]), sigmoidf_(v[1])), pack2(sigmoidf_(v[2]), sigmoidf_(v[3]))}; });
    }
}

constexpr int NCHUNK = (L + 63) / 64, NUNIT = NBATCH * HEADS * NCHUNK;
constexpr int LS = 72, RB = 64 * LS * 2;
constexpr int R1_LDS = 16 * RB + 4096 + 7168;
#define RBUF(i) ((bf16_t*)(smem + (i) * RB))
typedef float f32x16 __attribute__((ext_vector_type(16)));

template <int KK> DI f32x4 mm16(const bf16_t* F, int ldf, const bf16_t* S, int lds_, f32x4 acc, int lane) {
    const int fr = lane & 15, fq = lane >> 4;
#pragma unroll
    for (int ks = 0; ks < KK / 32; ++ks) {
        const bf16x8 f = *(const bf16x8*)(F + fr * ldf + ks * 32 + fq * 8);
        const bf16x8 g = *(const bf16x8*)(S + fr * lds_ + ks * 32 + fq * 8);
        acc = __builtin_amdgcn_mfma_f32_16x16x32_bf16(f, g, acc, 0, 0, 0);
    }
    return acc;
}
DI u32x2 pk4(f32x4 v) { return (u32x2){pack2(v[0], v[1]), pack2(v[2], v[3])}; }
DI f32x4 up4(u32x2 v) { return (f32x4){lo_bf(v[0]), hi_bf(v[0]), lo_bf(v[1]), hi_bf(v[1])}; }

typedef short s16x4 __attribute__((ext_vector_type(4)));
DI f32x4 mf16(u32x2 a, u32x2 b, f32x4 c) { return __builtin_amdgcn_mfma_f32_16x16x16bf16_1k(__builtin_bit_cast(s16x4, a), __builtin_bit_cast(s16x4, b), c, 0, 0, 0); }
DI void r1_diag_inverse(const bf16_t* Mr, const bf16_t* Mt, bf16_t* Tb, int a, int lane) {
    const int fr = lane & 15, fq = lane >> 4;
    const f32x4 zero = (f32x4){0.f, 0.f, 0.f, 0.f};
    f32x4 eye;
#pragma unroll
    for (int e = 0; e < 4; ++e) eye[e] = (4 * fq + e == fr) ? 1.f : 0.f;
    u32x2 mk = *(const u32x2*)(Mt + (16 * a + fr) * LS + 16 * a + 4 * fq);
    u32x2 mkt = *(const u32x2*)(Mr + (16 * a + fr) * LS + 16 * a + 4 * fq);
    f32x4 YT = up4(mkt) + eye;
    u32x2 yt = pk4(YT);
#pragma unroll
    for (int k = 0; k < 3; ++k) {
        const f32x4 s2 = mf16(mkt, mk, zero);
        if (k < 2) { const f32x4 s2t = mf16(mk, mkt, zero); mkt = pk4(s2t); }
        mk = pk4(s2);
        YT = mf16(mk, yt, YT);
        yt = pk4(YT);
    }
    *(u32x2*)(Tb + (16 * a + fr) * LS + 16 * a + 4 * fq) = yt;
}

template <int MODE> DI void phase_rwkv_r1(const Params& p, int layer, int bid, int nb, char* smem) {
    const int wv = __builtin_amdgcn_readfirstlane(tid_() >> 6);
    const f32x4 zero = (f32x4){0.f, 0.f, 0.f, 0.f};
    float* lwT = (float*)RBUF(4);
    float* aT = (float*)RBUF(6);
    float* gt = (float*)(smem + 16 * RB);
    float* gammaC = gt + 512;
    bf16_t* Xt0 = RBUF(14);
    bf16_t* Xt1 = RBUF(4);
    const bf16_t* WupT = p.WupT + (size_t)layer * 512 * 64, *AupT = p.AupT + (size_t)layer * 512 * 64, *GupT = p.GupT + (size_t)layer * 512 * 128;
    float* mu = (float*)(smem + 16 * RB + 4096);
    __syncthreads();
    for (int i = tid_(); i < RSW; i += NTHR) mu[i] = p.mu[(size_t)layer * RSW + i];
    for (int it = 0;; ++it) {
        const int tid = tid_(), lane = tid & 63, fr = lane & 15, fq = lane >> 4;
        int c, bh;
        if (MODE == 0) {
            const int Lq = it * nb + bid, q = Lq >> 3, cb = (q >> 3) * 8 + (Lq & 7);
            if (cb >= NBATCH * (NCHUNK - 1)) break;
            c = cb % (NCHUNK - 1); bh = (cb / (NCHUNK - 1)) * HEADS + (q & 7);
        } else {
            if (it > 0) break;
            c = NCHUNK - 1; bh = bid;
        }
        const int u = bh * NCHUNK + c, h = bh % HEADS, bb = bh / HEADS;
        const size_t tok0 = (size_t)bb * L + c * 64;
        bf16x8 fw[2][2], fa[2][2], fg[2][4];
#pragma unroll
        for (int t2 = 0; t2 < 2; ++t2) {
            const int tl = wv * 2 + t2, pt = tl >> 2, qt = tl & 3;
#pragma unroll
            for (int ks = 0; ks < 2; ++ks) {
                fw[t2][ks] = *(const bf16x8*)(WupT + (size_t)(h * 64 + qt * 16 + fr) * 64 + ks * 32 + fq * 8);
                fa[t2][ks] = *(const bf16x8*)(AupT + (size_t)(h * 64 + pt * 16 + fr) * 64 + ks * 32 + fq * 8);
            }
        }
        const int cgp = layer * 512 + h * 64 + (tid & 7) * 8, cge = layer * 512 + h * 64 + lane;
        const f32x4 pkk0 = *(const f32x4*)(p.k_k + cgp), pkk1 = *(const f32x4*)(p.k_k + cgp + 4), pka0 = *(const f32x4*)(p.k_a + cgp), pka1 = *(const f32x4*)(p.k_a + cgp + 4);
        const f32x4 prk0 = *(const f32x4*)(p.r_k + cgp), prk1 = *(const f32x4*)(p.r_k + cgp + 4);
        const float ekk = p.k_k[cge], eka = p.k_a[cge];
        float lw0[2]; f32x4 la0[2];
#pragma unroll
        for (int t2 = 0; t2 < 2; ++t2) {
            const int tl = wv * 2 + t2, pt = tl >> 2, qt = tl & 3;
            lw0[t2] = p.w0[layer * 512 + h * 64 + qt * 16 + fr];
            la0[t2] = *(const f32x4*)(p.a0 + layer * 512 + h * 64 + pt * 16 + fq * 4);
        }
        __syncthreads();
        {
            const int i = tid >> 3, c8 = (tid & 7) * 8, t = c * 64 + i;
            u32x4 curv[7], prvv[7];
#pragma unroll
            for (int it2 = 0; it2 < 7; ++it2) {
                const int col = (it2 == 0 ? RW_R + h * 64 : it2 == 1 ? RW_K + h * 64 : it2 == 2 ? RW_V + h * 64 : RW_WD + (it2 - 3) * 64) + c8;
                curv[it2] = (u32x4){0u, 0u, 0u, 0u}; prvv[it2] = (u32x4){0u, 0u, 0u, 0u};
                if (t < L) curv[it2] = *(const u32x4*)(p.P + (tok0 + i) * CP + OFF_RW + col);
                if (t < L && t > 0) prvv[it2] = *(const u32x4*)(p.P + (tok0 + i - 1) * CP + OFF_RW + col);
            }
#pragma unroll
            for (int it2 = 0; it2 < 7; ++it2) {
                const int col = (it2 == 0 ? RW_R + h * 64 : it2 == 1 ? RW_K + h * 64 : it2 == 2 ? RW_V + h * 64 : RW_WD + (it2 - 3) * 64) + c8;
                bf16_t* dst = it2 == 0 ? RBUF(8) + i * LS + c8 : it2 == 1 ? RBUF(9) + i * LS + c8 : it2 == 2 ? RBUF(10) + i * LS + c8
                            : it2 == 3 ? RBUF(0) + i * LS + c8 : it2 == 4 ? RBUF(1) + i * LS + c8 : RBUF(2) + i * 136 + (it2 - 5) * 64 + c8;
                const f32x4 m0 = *(const f32x4*)(mu + col), m1 = *(const f32x4*)(mu + col + 4);
                const u32x4 cur = curv[it2], prv = prvv[it2];
                float x[8];
#pragma unroll
                for (int j2 = 0; j2 < 4; ++j2) {
                    const float c0 = lo_bf(cur[j2]), c1 = hi_bf(cur[j2]), p0 = lo_bf(prv[j2]), p1 = hi_bf(prv[j2]);
                    const float mm0 = j2 < 2 ? m0[2 * j2] : m1[2 * j2 - 4], mm1 = j2 < 2 ? m0[2 * j2 + 1] : m1[2 * j2 - 3];
                    x[2 * j2] = c0 + (p0 - c0) * mm0; x[2 * j2 + 1] = c1 + (p1 - c1) * mm1;
                }
                if (it2 == 3) {
#pragma unroll
                    for (int j2 = 0; j2 < 8; ++j2) x[j2] = tanhf_(x[j2]);
                } else if (it2 >= 5) {
#pragma unroll
                    for (int j2 = 0; j2 < 8; ++j2) x[j2] = sigmoidf_(x[j2]);
                }
                *(u32x4*)dst = (u32x4){pack2(x[0], x[1]), pack2(x[2], x[3]), pack2(x[4], x[5]), pack2(x[6], x[7])};
            }
        }
#pragma unroll
        for (int t2 = 0; t2 < 2; ++t2)
#pragma unroll
            for (int ks = 0; ks < 4; ++ks) fg[t2][ks] = *(const bf16x8*)(GupT + (size_t)(h * 64 + ((wv * 2 + t2) >> 2) * 16 + fr) * 128 + ks * 32 + fq * 8);
        __syncthreads();
#pragma unroll
        for (int t2 = 0; t2 < 2; ++t2) {
            const int tl = wv * 2 + t2, pt = tl >> 2, qt = tl & 3;
            f32x4 aw = zero, aa = zero, ag = zero;
#pragma unroll
            for (int ks = 0; ks < 2; ++ks) {
                const bf16x8 xw = *(const bf16x8*)(RBUF(0) + (pt * 16 + fr) * LS + ks * 32 + fq * 8);
                aw = __builtin_amdgcn_mfma_f32_16x16x32_bf16(xw, fw[t2][ks], aw, 0, 0, 0);
                const bf16x8 xa = *(const bf16x8*)(RBUF(1) + (qt * 16 + fr) * LS + ks * 32 + fq * 8);
                aa = __builtin_amdgcn_mfma_f32_16x16x32_bf16(fa[t2][ks], xa, aa, 0, 0, 0);
            }
#pragma unroll
            for (int ks = 0; ks < 4; ++ks) {
                const bf16x8 xg = *(const bf16x8*)(RBUF(2) + (qt * 16 + fr) * 136 + ks * 32 + fq * 8);
                ag = __builtin_amdgcn_mfma_f32_16x16x32_bf16(fg[t2][ks], xg, ag, 0, 0, 0);
            }
            const int ch = qt * 16 + fr;
            const float w0 = lw0[t2];
            const f32x4 a0 = la0[t2];
            f32x4 lw, av;
#pragma unroll
            for (int e = 0; e < 4; ++e) { lw[e] = -DECAY_SCALE * sigmoidf_(w0 + aw[e]); av[e] = sigmoidf_(a0[e] + aa[e]); }
            *(f32x4*)(lwT + ch * 68 + pt * 16 + fq * 4) = lw;
            *(f32x4*)(aT + (qt * 16 + fr) * 68 + pt * 16 + fq * 4) = av;
            *(u32x2*)(p.GG + ((size_t)u * 64 + qt * 16 + fr) * 64 + pt * 16 + fq * 4) = pk4(ag);
        }
        __syncthreads();
        {
            const int i = tid >> 3, c8 = (tid & 7) * 8;
            const u32x4 xr = *(const u32x4*)(RBUF(8) + i * LS + c8), xk = *(const u32x4*)(RBUF(9) + i * LS + c8);
            const f32x4 a0 = *(const f32x4*)(aT + i * 68 + c8), a1 = *(const f32x4*)(aT + i * 68 + c8 + 4);
            const f32x4 kk0 = pkk0, kk1 = pkk1, ka0 = pka0, ka1 = pka1, rk0 = prk0, rk1 = prk1;
            float n2 = 0.f, bon = 0.f;
#pragma unroll
            for (int j = 0; j < 8; ++j) {
                const float r_ = (j & 1) ? hi_bf(xr[j >> 1]) : lo_bf(xr[j >> 1]), k_ = (j & 1) ? hi_bf(xk[j >> 1]) : lo_bf(xk[j >> 1]);
                const float a_ = j < 4 ? a0[j & 3] : a1[j & 3], kkc = j < 4 ? kk0[j & 3] : kk1[j & 3], kac = j < 4 ? ka0[j & 3] : ka1[j & 3], rkc = j < 4 ? rk0[j & 3] : rk1[j & 3];
                const float kkr = k_ * kkc;
                n2 += kkr * kkr;
                bon += r_ * (k_ * (1.0f + (a_ - 1.0f) * kac)) * rkc;
            }
            n2 = sum8(n2); bon = sum8(bon);
            if ((tid & 7) == 0) { gt[576 + i] = 1.0f / fmaxf(sqrtf(n2), 1e-12f); p.bonG[(size_t)u * 64 + i] = bon; }
        }
        __syncthreads();
        {
            const int ch = lane;
            float lw[8], av[8], cum[8];
            {
                const f32x4 l0 = *(const f32x4*)(lwT + ch * 68 + wv * 8), l1 = *(const f32x4*)(lwT + ch * 68 + wv * 8 + 4);
#pragma unroll
                for (int e = 0; e < 4; ++e) { lw[e] = l0[e]; lw[e + 4] = l1[e]; }
#pragma unroll
                for (int e = 0; e < 8; ++e) av[e] = aT[(wv * 8 + e) * 68 + ch];
            }
            float run = 0.f;
#pragma unroll
            for (int e = 0; e < 8; ++e) { run += lw[e]; cum[e] = run; }
            gt[wv * 64 + ch] = run;
            __syncthreads();
            float offs = 0.f, tot = 0.f;
#pragma unroll
            for (int g2 = 0; g2 < 8; ++g2) { const float gv = gt[g2 * 64 + ch]; offs += g2 < wv ? gv : 0.f; tot += gv; }
            if (wv == 0) gammaC[ch] = __expf(tot);
            const float kkc = ekk, kac = eka;
            float at_[8], kt_[8], bt_[8], vt_[8];
#pragma unroll
            for (int e = 0; e < 8; ++e) {
                const int i = wv * 8 + e;
                const float xr = bf2f(RBUF(8)[i * LS + ch]), xk = bf2f(RBUF(9)[i * LS + ch]), xv = bf2f(RBUF(10)[i * LS + ch]);
                const float cm = cum[e] + offs;
                const float kk = xk * kkc * gt[576 + i];
                const float kq = xk * (1.0f + (av[e] - 1.0f) * kac);
                if (c * 64 + i < L) p.orw[(tok0 + i) * 512 + h * 64 + ch] = RBUF(10)[i * LS + ch];
                const float eneg = __expf(-cm), epos = __expf(cm), eexc = __expf(cm - lw[e]);
                at_[e] = -kk * eexc; kt_[e] = kq * eneg; bt_[e] = kk * av[e] * eneg; vt_[e] = xv;
                RBUF(3)[i * LS + ch] = f2bf(xr * epos);
            }
            __syncthreads();
#pragma unroll
            for (int e = 0; e < 8; ++e) {
                const int i = wv * 8 + e;
                RBUF(0)[i * LS + ch] = f2bf(at_[e]); RBUF(1)[i * LS + ch] = f2bf(kt_[e]); RBUF(2)[i * LS + ch] = f2bf(bt_[e]);
            }
            *(u32x4*)(RBUF(11) + ch * LS + wv * 8) = (u32x4){pack2(kt_[0], kt_[1]), pack2(kt_[2], kt_[3]), pack2(kt_[4], kt_[5]), pack2(kt_[6], kt_[7])};
            *(u32x4*)(RBUF(12) + ch * LS + wv * 8) = (u32x4){pack2(bt_[0], bt_[1]), pack2(bt_[2], bt_[3]), pack2(bt_[4], bt_[5]), pack2(bt_[6], bt_[7])};
            *(u32x4*)(RBUF(13) + ch * LS + wv * 8) = (u32x4){pack2(vt_[0], vt_[1]), pack2(vt_[2], vt_[3]), pack2(vt_[4], vt_[5]), pack2(vt_[6], vt_[7])};
            *(u32x4*)(Xt0 + ch * LS + wv * 8) = (u32x4){pack2(at_[0], at_[1]), pack2(at_[2], at_[3]), pack2(at_[4], at_[5]), pack2(at_[6], at_[7])};
        }
        __syncthreads();
#pragma unroll
        for (int prod = 0; prod < 4; ++prod) {
            const bf16_t* F = (prod == 0 || prod == 2) ? RBUF(1) : RBUF(2);
            const bf16_t* S = prod < 2 ? RBUF(0) : RBUF(3);
            bf16_t* O = prod == 0 ? RBUF(6) : prod == 1 ? RBUF(7) : prod == 2 ? RBUF(9) : RBUF(10);
            const int mode = prod < 2 ? 0 : 1;
#pragma unroll
            for (int rep = 0; rep < 2; ++rep) {
                const int tl = wv + 8 * rep, pt = tl >> 2, qt = tl & 3;
                f32x4 acc = zero;
                if (pt <= qt) acc = mm16<64>(F + pt * 16 * LS, LS, S + qt * 16 * LS, LS, zero, lane);
                const int qi = qt * 16 + fr;
#pragma unroll
                for (int e = 0; e < 4; ++e) {
                    const int pi = pt * 16 + fq * 4 + e;
                    const bool keep = mode == 0 ? pi < qi : pi <= qi;
                    acc[e] = keep ? acc[e] : 0.f;
                }
                *(u32x2*)(O + qi * LS + pt * 16 + fq * 4) = pk4(acc);
                if (prod == 1) {
#pragma unroll
                    for (int e = 0; e < 4; ++e) RBUF(8)[(pt * 16 + fq * 4 + e) * LS + qi] = f2bf(acc[e]);
                }
            }
        }
        __syncthreads();
        f32x4 X[4];
        if (wv < 4) {
            const bf16_t* xp = Xt0 + (wv * 16 + fr) * LS + fq * 4;
#pragma unroll
            for (int a = 0; a < 4; ++a) X[a] = up4(*(const u32x2*)(xp + 16 * a));
            r1_diag_inverse(RBUF(7), RBUF(8), RBUF(0), wv, lane);
        } else {
            const bf16_t* Nr = RBUF(6) + fr * LS + fq * 4;
            const bf16_t* vp = RBUF(13) + ((wv - 4) * 16 + fr) * LS + fq * 4;
            u32x2 vb[4], nn[10];
#pragma unroll
            for (int b = 0; b < 4; ++b) vb[b] = *(const u32x2*)(vp + 16 * b);
#pragma unroll
            for (int a = 0; a < 4; ++a)
#pragma unroll
                for (int b = 0; b <= a; ++b) nn[a * (a + 1) / 2 + b] = *(const u32x2*)(Nr + 16 * a * LS + 16 * b);
#pragma unroll
            for (int a = 0; a < 4; ++a) {
                f32x4 acc = zero;
#pragma unroll
                for (int b = 0; b <= a; ++b) acc = mf16(nn[a * (a + 1) / 2 + b], vb[b], acc);
                X[a] = acc;
            }
        }
        __syncthreads();
        {
            const bf16_t* Tb = RBUF(0), *Mr = RBUF(7);
            bf16_t* xp = Xt0 + (wv * 16 + fr) * LS + fq * 4;
#define FS_M(a, b) (*(const u32x2*)(Mr + (16 * (a) + fr) * LS + 16 * (b) + 4 * fq))
#define FS_D(a)    (*(const u32x2*)(Tb + (16 * (a) + fr) * LS + 16 * (a) + 4 * fq))
            const u32x2 d0 = FS_D(0), d1 = FS_D(1), d2 = FS_D(2), d3 = FS_D(3);
            const u32x2 m10 = FS_M(1, 0), m20 = FS_M(2, 0), m21 = FS_M(2, 1), m30 = FS_M(3, 0), m31 = FS_M(3, 1), m32 = FS_M(3, 2);
            const u32x2 y0 = pk4(mf16(d0, pk4(X[0]), zero));
            const f32x4 t1 = mf16(m10, y0, X[1]);
            f32x4 t2 = mf16(m20, y0, X[2]), t3 = mf16(m30, y0, X[3]);
            const u32x2 y1 = pk4(mf16(d1, pk4(t1), zero));
            t2 = mf16(m21, y1, t2); t3 = mf16(m31, y1, t3);
            const u32x2 y2 = pk4(mf16(d2, pk4(t2), zero));
            t3 = mf16(m32, y2, t3);
            const u32x2 y3 = pk4(mf16(d3, pk4(t3), zero));
            *(u32x2*)xp = y0; *(u32x2*)(xp + 16) = y1; *(u32x2*)(xp + 32) = y2; *(u32x2*)(xp + 48) = y3;
        }
        __syncthreads();
#pragma unroll
        for (int rep = 0; rep < 2; ++rep) {
            const int tl = wv + 8 * rep, pt = tl >> 2, qt = tl & 3;
            const int pi0 = pt * 16 + fq * 4, qi = qt * 16 + fr;
            const size_t go = ((size_t)u * 64 + qi) * 64 + pi0;
            {
                f32x4 acc = mm16<64>(Xt0 + pt * 16 * LS, LS, RBUF(12) + qt * 16 * LS, LS, zero, lane);
                const float gc = gammaC[qi];
#pragma unroll
                for (int e = 0; e < 4; ++e) acc[e] = (acc[e] + (pi0 + e == qi ? 1.f : 0.f)) * gc;
                {
                    const size_t d = (((size_t)u * 8 + (qi >> 4) * 2 + (pi0 >> 5)) * 64 + (qi & 15) + 16 * ((pi0 >> 2) & 3)) * 8 + ((pi0 >> 4) & 1) * 4;
                    *(u32x2*)(p.PcG + d) = pk4(acc);
                }
            }
            {
                f32x4 acc = mm16<64>(RBUF(11) + pt * 16 * LS, LS, RBUF(13) + qt * 16 * LS, LS, zero, lane);
                acc = mm16<64>(RBUF(12) + pt * 16 * LS, LS, Xt0 + (64 + qt * 16) * LS, LS, acc, lane);
                const f32x4 gc = *(const f32x4*)(gammaC + pi0);
#pragma unroll
                for (int e = 0; e < 4; ++e) acc[e] *= gc[e];
                {
                    const size_t d = (((size_t)u * 4 + (qi >> 4)) * 64 + (qi & 15) + 16 * ((pi0 >> 2) & 3)) * 16 + (pi0 >> 4) * 4;
                    *(u32x2*)(p.QcG + d) = pk4(acc);
                }
            }
            {
                f32x4 acc = mm16<64>(Xt0 + pt * 16 * LS, LS, RBUF(10) + qt * 16 * LS, LS, zero, lane);
                const f32x4 rr = up4(*(const u32x2*)(RBUF(3) + qi * LS + pi0));
#pragma unroll
                for (int e = 0; e < 4; ++e) acc[e] += rr[e];
                *(u32x2*)(p.RhG + go) = pk4(acc);
            }
            {
                f32x4 acc = mm16<64>(RBUF(13) + pt * 16 * LS, LS, RBUF(9) + qt * 16 * LS, LS, zero, lane);
                acc = mm16<64>(Xt0 + (64 + pt * 16) * LS, LS, RBUF(10) + qt * 16 * LS, LS, acc, lane);
                *(u32x2*)(p.Y0G + go) = pk4(acc);
            }
        }
    }
}

struct R2Set { u32x4 a[8]; u32x4 q[2]; };
DI void r2_load(R2Set& st, const Params& p, size_t u, int lane, int vq) {
    const bf16_t* qg = p.QcG + ((u * 4 + vq) * 64 + lane) * 16;
    st.q[0] = *(const u32x4*)qg; st.q[1] = *(const u32x4*)(qg + 8);
#pragma unroll
    for (int f = 0; f < 8; ++f) st.a[f] = *(const u32x4*)(p.PcG + ((u * 8 + f) * 64 + lane) * 8);
}
DI void r2_step(f32x4 (&S)[4], const R2Set& st, const Params& p, size_t u, int lane, int vq, bool last) {
    const u32x4 b0 = (u32x4){pack2(S[0][0], S[0][1]), pack2(S[0][2], S[0][3]), pack2(S[1][0], S[1][1]), pack2(S[1][2], S[1][3])};
    const u32x4 b1 = (u32x4){pack2(S[2][0], S[2][1]), pack2(S[2][2], S[2][3]), pack2(S[3][0], S[3][1]), pack2(S[3][2], S[3][3])};
    bf16_t* sg = p.SG + ((u * 4 + vq) * 64 + lane) * 16;
    *(u32x4*)sg = b0; *(u32x4*)(sg + 8) = b1;
    if (last) return;
#pragma unroll
    for (int kt = 0; kt < 4; ++kt) {
        const u32x4 qq = st.q[kt >> 1];
        const unsigned w0 = qq[(kt & 1) * 2], w1 = qq[(kt & 1) * 2 + 1];
        S[kt] = (f32x4){lo_bf(w0), hi_bf(w0), lo_bf(w1), hi_bf(w1)};
    }
    const bf16x8 f0 = __builtin_bit_cast(bf16x8, b0), f1 = __builtin_bit_cast(bf16x8, b1);
#pragma unroll
    for (int kt = 0; kt < 4; ++kt) {
        S[kt] = __builtin_amdgcn_mfma_f32_16x16x32_bf16(__builtin_bit_cast(bf16x8, st.a[kt * 2]), f0, S[kt], 0, 0, 0);
        S[kt] = __builtin_amdgcn_mfma_f32_16x16x32_bf16(__builtin_bit_cast(bf16x8, st.a[kt * 2 + 1]), f1, S[kt], 0, 0, 0);
    }
}
DI void phase_rwkv_r2(const Params& p, int chain) {
    const int lane = tid_() & 63;
    const int bh = chain >> 2, vq = chain & 3;
    const size_t u0 = (size_t)bh * NCHUNK;
    f32x4 S[4];
#pragma unroll
    for (int kt = 0; kt < 4; ++kt) S[kt] = (f32x4){0.f, 0.f, 0.f, 0.f};
    R2Set A, B, C, E;
    r2_load(A, p, u0, lane, vq); r2_load(B, p, u0 + 1, lane, vq); r2_load(C, p, u0 + 2, lane, vq); r2_load(E, p, u0 + 3, lane, vq);
#define R2_ONE(SET, cc) do { r2_step(S, SET, p, u0 + (cc), lane, vq, (cc) == NCHUNK - 1); if ((cc) + 4 < NCHUNK - 1) r2_load(SET, p, u0 + (cc) + 4, lane, vq); } while (0)
#pragma unroll 1
    for (int c = 0; c < NCHUNK; c += 4) {
        R2_ONE(A, c);
        if (c == NCHUNK - 1) break;
        R2_ONE(B, c + 1);
        R2_ONE(C, c + 2);
        R2_ONE(E, c + 3);
    }
#undef R2_ONE
}

DI void phase_rwkv_r3(const Params& p, int layer, int bid, int nb) {
    const int tid = tid_(), lane = tid & 63, wv = __builtin_amdgcn_readfirstlane(tid >> 6), fr = lane & 15, fq = lane >> 4;
    constexpr int TPB = L / 16;
    for (int task = bid * 8 + wv; task < NBATCH * HEADS * TPB; task += nb * 8) {
        const int bh = task / TPB, tt = task % TPB, c = tt >> 2, it = tt & 3, u = bh * NCHUNK + c;
        const int h = bh % HEADS, bb = bh / HEADS;
        const int i = it * 16 + fr, t = c * 64 + i;
        const bool live = t < L;
        const size_t tok = (size_t)bb * L + (live ? t : 0);
        bf16x8 sf[2];
#pragma unroll
        for (int ks = 0; ks < 2; ++ks) sf[ks] = *(const bf16x8*)(p.RhG + ((size_t)u * 64 + i) * 64 + ks * 32 + fq * 8);
        u32x2 s0[4][2], s1[4][2], y0[4], xvv[4], gv[4];
#pragma unroll
        for (int vt = 0; vt < 4; ++vt) {
            const int vv = vt * 16 + fr;
#pragma unroll
            for (int ks = 0; ks < 2; ++ks) {
                const bf16_t* sp = p.SG + (((size_t)u * 4 + vt) * 64 + fr + 32 * (fq & 1)) * 16 + (2 * ks + (fq >> 1)) * 4;
                s0[vt][ks] = *(const u32x2*)sp; s1[vt][ks] = *(const u32x2*)(sp + 16 * 16);
                (void)vv;
            }
            y0[vt] = *(const u32x2*)(p.Y0G + ((size_t)u * 64 + i) * 64 + vt * 16 + fq * 4);
            xvv[vt] = *(const u32x2*)(p.orw + tok * 512 + h * 64 + vt * 16 + fq * 4);
            gv[vt] = *(const u32x2*)(p.GG + ((size_t)u * 64 + i) * 64 + vt * 16 + fq * 4);
        }
        const float bon = p.bonG[(size_t)u * 64 + i];
        f32x4 y[4];
#pragma unroll
        for (int vt = 0; vt < 4; ++vt) {
            y[vt] = up4(y0[vt]);
#pragma unroll
            for (int ks = 0; ks < 2; ++ks) {
                const bf16x8 f = __builtin_bit_cast(bf16x8, ((u32x4){s0[vt][ks][0], s0[vt][ks][1], s1[vt][ks][0], s1[vt][ks][1]}));
                y[vt] = __builtin_amdgcn_mfma_f32_16x16x32_bf16(f, sf[ks], y[vt], 0, 0, 0);
            }
        }
        float s = 0.f;
#pragma unroll
        for (int vt = 0; vt < 4; ++vt) s += (y[vt][0] + y[vt][1]) + (y[vt][2] + y[vt][3]);
        s += __shfl_xor(s, 16); s += __shfl_xor(s, 32);
        const float mean = s * (1.0f / 64.f);
        float q = 0.f;
#pragma unroll
        for (int vt = 0; vt < 4; ++vt)
#pragma unroll
            for (int e = 0; e < 4; ++e) { y[vt][e] -= mean; q += y[vt][e] * y[vt][e]; }
        q += __shfl_xor(q, 16); q += __shfl_xor(q, 32);
        const float rstd = rsqrtf(q * (1.0f / 64.f) + 64e-5f);
        if (live) {
#pragma unroll
            for (int vt = 0; vt < 4; ++vt) {
                const int cg = h * 64 + vt * 16 + fq * 4;
                const f32x4 xv = up4(xvv[vt]), g = up4(gv[vt]);
                const f32x4 lg = *(const f32x4*)(p.lnx_g + layer * 512 + cg), lb = *(const f32x4*)(p.lnx_b + layer * 512 + cg);
                f32x4 o;
#pragma unroll
                for (int e = 0; e < 4; ++e) o[e] = (y[vt][e] * rstd * lg[e] + lb[e] + bon * xv[e]) * g[e];
                *(u32x2*)(p.orw + tok * 512 + cg) = pk4(o);
            }
        }
    }
}

constexpr int SB_LDS = 4 * RB + 64;
DI void phase_sb(const Params& p, int bid0, int nb, char* smem) {
    const int tid = tid_(), lane = tid & 63, wv = __builtin_amdgcn_readfirstlane(tid >> 6), fr = lane & 15, fq = lane >> 4;
    bf16_t* Ks0 = (bf16_t*)smem;
    bf16_t* Vt0 = Ks0 + 2 * 64 * LS;
    int* flags = (int*)(smem + 4 * RB);
    bf16x8 tri[4][2];
#pragma unroll
    for (int st = 0; st < 4; ++st)
#pragma unroll
        for (int k2 = 0; k2 < 2; ++k2)
#pragma unroll
            for (int jj = 0; jj < 8; ++jj) tri[st][k2][jj] = (32 * k2 + 16 * (jj >> 2) + 4 * fq + (jj & 3) > 16 * st + fr) ? (short)0x3F80 : (short)0;
    constexpr int NQB = (L + 127) / 128;
    const int ldkey = tid >> 3, lddc = (tid & 7) * 8;
    for (int u = bid0; u < NBATCH * HEADS * NQB; u += nb) {
        const int bh = u % (NBATCH * HEADS), b = bh / HEADS, h = bh % HEADS, q0 = (NQB - 1 - u / (NBATCH * HEADS)) * 128;
        const int qlo = q0 + 16 * wv, query = qlo + fr;
        const size_t tokb = (size_t)b * L;
        bf16x8 qf[2];
#pragma unroll
        for (int ks = 0; ks < 2; ++ks) qf[ks] = *(const bf16x8*)(p.P + (tokb + query) * CP + OFF_Q + h * 64 + ks * 32 + fq * 8);
        const int qmax = (q0 + 127 < L - 1) ? q0 + 127 : L - 1;
        int kt = (qmax - 1) >> 6;
        float R = 0.f;
        f32x4 ot[4];
#pragma unroll
        for (int dt = 0; dt < 4; ++dt) ot[dt] = (f32x4){0.f, 0.f, 0.f, 0.f};
        bool done = qlo >= L;
        u32x4 kreg, vreg;
        {
            const int s = kt * 64 + ldkey;
            const bf16_t* src = p.P + (tokb + s) * CP + h * 64 + lddc;
            kreg = s < L ? *(const u32x4*)(src + OFF_K) : (u32x4){0u, 0u, 0u, 0u};
            vreg = s < L ? *(const u32x4*)(src + OFF_V) : (u32x4){0u, 0u, 0u, 0u};
        }
        const int vsw = (tid & 7) << 2;
        __syncthreads();
        {
            *(u32x4*)(Ks0 + ldkey * LS + lddc) = kreg;
#pragma unroll
            for (int j = 0; j < 4; ++j) { Vt0[(lddc + 2 * j) * LS + (ldkey ^ vsw)] = (bf16_t)(vreg[j] & 0xFFFFu); Vt0[(lddc + 2 * j + 1) * LS + (ldkey ^ vsw)] = (bf16_t)(vreg[j] >> 16); }
        }
        __syncthreads();
        for (int itile = 0;; ++itile) {
            const bf16_t* Ks = Ks0 + (itile & 1) * 64 * LS; const bf16_t* Vt = Vt0 + (itile & 1) * 64 * LS;
            if (kt > 0) {
                const int s = (kt - 1) * 64 + ldkey;
                const bf16_t* src = p.P + (tokb + s) * CP + h * 64 + lddc;
                kreg = *(const u32x4*)(src + OFF_K); vreg = *(const u32x4*)(src + OFF_V);
            }
            if (!done && kt * 64 < qlo + 15) {
                f32x4 uu[4], lsp[4];
                float tot = 0.f;
                const bool full = kt * 64 + 63 < qlo;
#pragma unroll
                for (int kk = 0; kk < 4; ++kk) {
                    f32x4 z = (f32x4){0.f, 0.f, 0.f, 0.f};
#pragma unroll
                    for (int ks = 0; ks < 2; ++ks) {
                        const bf16x8 f = *(const bf16x8*)(Ks + (16 * kk + fr) * LS + ks * 32 + fq * 8);
                        z = __builtin_amdgcn_mfma_f32_16x16x32_bf16(f, qf[ks], z, 0, 0, 0);
                    }
#pragma unroll
                    for (int e = 0; e < 4; ++e) {
                        const float zz = z[e] * 0.18033688011112042f;
                        const float lsneg = -(fmaxf(zz, 0.f) + __builtin_amdgcn_logf(1.0f + __builtin_amdgcn_exp2f(-fabsf(zz))));
                        if (full) { uu[kk][e] = lsneg; lsp[kk][e] = lsneg + zz; }
                        else {
                            const bool valid = kt * 64 + 16 * kk + 4 * fq + e < query;
                            uu[kk][e] = valid ? lsneg : 0.f;
                            lsp[kk][e] = valid ? lsneg + zz : -1.0e30f;
                        }
                        tot += uu[kk][e];
                    }
                }
                tot += __shfl_xor(tot, 16); tot += __shfl_xor(tot, 32);
                f32x4 rest[4];
#pragma unroll
                for (int st = 0; st < 4; ++st) rest[st] = (f32x4){0.f, 0.f, 0.f, 0.f};
#pragma unroll
                for (int k2 = 0; k2 < 2; ++k2) {
                    u32x4 hi, lo;
#pragma unroll
                    for (int t2 = 0; t2 < 2; ++t2) {
                        const f32x4 a = uu[2 * k2 + t2];
                        const unsigned h0 = pack2(a[0], a[1]), h1 = pack2(a[2], a[3]);
                        hi[2 * t2] = h0; hi[2 * t2 + 1] = h1;
                        lo[2 * t2] = pack2(a[0] - lo_bf(h0), a[1] - hi_bf(h0)); lo[2 * t2 + 1] = pack2(a[2] - lo_bf(h1), a[3] - hi_bf(h1));
                    }
                    const bf16x8 fh = __builtin_bit_cast(bf16x8, hi), fl = __builtin_bit_cast(bf16x8, lo);
#pragma unroll
                    for (int st = 0; st < 4; ++st) {
                        rest[st] = __builtin_amdgcn_mfma_f32_16x16x32_bf16(tri[st][k2], fh, rest[st], 0, 0, 0);
                        rest[st] = __builtin_amdgcn_mfma_f32_16x16x32_bf16(tri[st][k2], fl, rest[st], 0, 0, 0);
                    }
                }
                bf16x8 af[2];
#pragma unroll
                for (int k2 = 0; k2 < 2; ++k2) {
                    u32x4 pk;
#pragma unroll
                    for (int t2 = 0; t2 < 2; ++t2) {
                        const int kk = 2 * k2 + t2;
                        float a4[4];
#pragma unroll
                        for (int e = 0; e < 4; ++e) a4[e] = __builtin_amdgcn_exp2f(lsp[kk][e] + R + rest[kk][e]);
                        pk[2 * t2] = pack2(a4[0], a4[1]); pk[2 * t2 + 1] = pack2(a4[2], a4[3]);
                    }
                    af[k2] = __builtin_bit_cast(bf16x8, pk);
                }
                R += tot;
#pragma unroll
                for (int dt = 0; dt < 4; ++dt)
#pragma unroll
                    for (int k2 = 0; k2 < 2; ++k2) {
                        const int dsw = ((2 * dt + (fr >> 3)) & 7) << 2;
                        const bf16_t* vrow = Vt + (16 * dt + fr) * LS;
                        const u32x2 v0 = *(const u32x2*)(vrow + ((32 * k2 + 4 * fq) ^ dsw)), v1 = *(const u32x2*)(vrow + ((32 * k2 + 16 + 4 * fq) ^ dsw));
                        const bf16x8 f = __builtin_bit_cast(bf16x8, ((u32x4){v0[0], v0[1], v1[0], v1[1]}));
                        ot[dt] = __builtin_amdgcn_mfma_f32_16x16x32_bf16(f, af[k2], ot[dt], 0, 0, 0);
                    }
                done = __all((R < -150.1f) || (query >= L));
            }
            if (kt > 0) {
                bf16_t* Kn = Ks0 + ((itile & 1) ^ 1) * 64 * LS; bf16_t* Vn = Vt0 + ((itile & 1) ^ 1) * 64 * LS;
                *(u32x4*)(Kn + ldkey * LS + lddc) = kreg;
#pragma unroll
                for (int j = 0; j < 4; ++j) { Vn[(lddc + 2 * j) * LS + (ldkey ^ vsw)] = (bf16_t)(vreg[j] & 0xFFFFu); Vn[(lddc + 2 * j + 1) * LS + (ldkey ^ vsw)] = (bf16_t)(vreg[j] >> 16); }
            }
            if (lane == 0) flags[(itile & 1) * 8 + wv] = done ? 1 : 0;
            __syncthreads();
            int alld = 1;
#pragma unroll
            for (int w = 0; w < 8; ++w) alld &= flags[(itile & 1) * 8 + w];
            if (alld || kt == 0) break;
            --kt;
        }
        if (query < L) {
#pragma unroll
            for (int dt = 0; dt < 4; ++dt) *(u32x2*)(p.osb + (tokb + query) * 512 + h * 64 + 16 * dt + 4 * fq) = pk4(ot[dt]);
        }
    }
}

struct EpiBranch {
    static constexpr bool PERM = true;
    const bf16_t* G; bf16_t* M; bool add;
    DI void operator()(const f32x4 (&acc)[2][2][4][2], const g8::Unit& u, int wr, int wc, int fr, int fq) const {
        const int c0 = u.pn * 256 + wc * 32 + 8 * fq;
#pragma unroll
        for (int ai = 0; ai < 2; ++ai) {
            u32x4 g[4][2], mo[4][2];
#pragma unroll
            for (int m = 0; m < 4; ++m)
#pragma unroll
                for (int bj = 0; bj < 2; ++bj) {
                    const size_t r = (size_t)(u.pm * 256 + ai * 128 + wr * 64 + m * 16 + fr);
                    g[m][bj] = *(const u32x4*)(G + r * 2048 + c0 + bj * 128);
                    mo[m][bj] = add ? *(const u32x4*)(M + r * D + c0 + bj * 128) : (u32x4){0u, 0u, 0u, 0u};
                }
#pragma unroll
            for (int m = 0; m < 4; ++m)
#pragma unroll
                for (int bj = 0; bj < 2; ++bj) {
                    const size_t r = (size_t)(u.pm * 256 + ai * 128 + wr * 64 + m * 16 + fr);
                    const f32x4 v0 = acc[ai][bj][m][0], v1 = acc[ai][bj][m][1];
                    const u32x4 gg = g[m][bj], mm = mo[m][bj];
                    float o[8] = {lo_bf(gg[0]) * v0[0], hi_bf(gg[0]) * v0[1], lo_bf(gg[1]) * v0[2], hi_bf(gg[1]) * v0[3], lo_bf(gg[2]) * v1[0], hi_bf(gg[2]) * v1[1], lo_bf(gg[3]) * v1[2], hi_bf(gg[3]) * v1[3]};
#pragma unroll
                    for (int q = 0; q < 4; ++q) { o[2 * q] += lo_bf(mm[q]); o[2 * q + 1] += hi_bf(mm[q]); }
                    *(u32x4*)(M + r * D + c0 + bj * 128) = (u32x4){pack2(o[0], o[1]), pack2(o[2], o[3]), pack2(o[4], o[5]), pack2(o[6], o[7])};
                }
        }
    }
};
struct GateOrder {
    g8::DenseOrder d;
    DI bool next(int i, g8::Unit& u) const { return d.next(i, u); }
    DI unsigned row_off(const g8::Unit&, int) const { return 0u; }
};
struct EpiGate {
    static constexpr bool PERM = true;
    bf16_t* G;
    DI void operator()(const f32x4 (&acc)[2][2][4][2], const g8::Unit& u, int wr, int wc, int fr, int fq) const {
#pragma unroll
        for (int ai = 0; ai < 2; ++ai)
#pragma unroll
            for (int m = 0; m < 4; ++m) {
                bf16_t* rowp = G + (size_t)(u.pm * 256 + ai * 128 + wr * 64 + m * 16 + fr) * 2048 + u.pn * 256 + wc * 32 + 8 * fq;
#pragma unroll
                for (int bj = 0; bj < 2; ++bj) {
                    const f32x4 v0 = acc[ai][bj][m][0], v1 = acc[ai][bj][m][1];
                    *(u32x4*)(rowp + bj * 128) = (u32x4){pack2(sigmoidf_(v0[0]), sigmoidf_(v0[1])), pack2(sigmoidf_(v0[2]), sigmoidf_(v0[3])), pack2(sigmoidf_(v1[0]), sigmoidf_(v1[1])), pack2(sigmoidf_(v1[2]), sigmoidf_(v1[3]))};
                }
            }
    }
};
template <int PART> DI void phase_merge(const Params& p, int layer, int bid, int nb, char* smem) {
    const bf16_t* hb = p.hb; bf16_t* G = p.gates; bf16_t* M = p.merged;
    const bf16_t* Wg = p.WtIn + ((size_t)layer * CIN + CP) * D;
    G8_LAS unsigned char* lds = (G8_LAS unsigned char*)smem;
    if (PART == 0) {
#pragma unroll
    for (int which = 0; which < 2; ++which) {
        g8::DenseOrder S; S.init(hb, Wg + (size_t)which * 1024 * D, MFULL, D / 256, D, nb, bid);
        g8::gemm8<false>(lds, D, S, EpiGate{G + which * 1024});
    }
    }
    if (PART == 1) {
#pragma unroll
    for (int which = 0; which < 2; ++which) {
        const bf16_t* A = which ? p.orw : p.osb;
        const bf16_t* Bt = (which ? p.WtPrw : p.WtPsb) + (size_t)layer * D * 512;
        g8::DenseOrder S; S.init(A, Bt, MFULL, D / 256, 512, nb, bid);
        g8::gemm8<false>(lds, 512, S, EpiBranch{G + which * 1024, M, which != 0});
    }
    }
    if (PART == 1)
    for (int t = left_first(MFULL * 4 * 2, bid, nb); t < D / 128; t += nb) {
#pragma unroll
        for (int which = 0; which < 2; ++which) {
            const bf16_t* A = which ? p.orw : p.osb; const bf16_t* Gw = p.gleft - (size_t)M0_LEFT * 2048 + which * 1024;
            const bf16_t* Bt = (which ? p.WtPrw : p.WtPsb) + (size_t)layer * D * 512;
            gemm_left32([=](int r) { return A + (size_t)(M0_LEFT + r) * 512; }, Bt, 512, 512, t * 128, smem,
                        [=](int r0, int c, f32x4 v) {
                            const size_t r = (size_t)(M0_LEFT + r0);
                            const u32x2 g = *(const u32x2*)(Gw + r * 2048 + c);
                            float o0 = lo_bf(g[0]) * v[0], o1 = hi_bf(g[0]) * v[1], o2 = lo_bf(g[1]) * v[2], o3 = hi_bf(g[1]) * v[3];
                            u32x2* mp = (u32x2*)(M + r * D + c);
                            if (which) { const u32x2 m = *mp; o0 += lo_bf(m[0]); o1 += hi_bf(m[0]); o2 += lo_bf(m[1]); o3 += hi_bf(m[1]); }
                            *mp = (u32x2){pack2(o0, o1), pack2(o2, o3)};
                        });
        }
    }
}
struct EpiOut {
    static constexpr bool PERM = true;
    bf16_t* hb;
    DI void operator()(const f32x4 (&acc)[2][2][4][2], const g8::Unit& u, int wr, int wc, int fr, int fq) const {
        const int c0 = u.pn * 256 + wc * 32 + 8 * fq;
#pragma unroll
        for (int ai = 0; ai < 2; ++ai) {
            u32x4 hv[4][2];
#pragma unroll
            for (int m = 0; m < 4; ++m)
#pragma unroll
                for (int bj = 0; bj < 2; ++bj) hv[m][bj] = *(const u32x4*)(hb + (size_t)(u.pm * 256 + ai * 128 + wr * 64 + m * 16 + fr) * D + c0 + bj * 128);
#pragma unroll
            for (int m = 0; m < 4; ++m)
#pragma unroll
                for (int bj = 0; bj < 2; ++bj) {
                    const u32x4 h = hv[m][bj]; const f32x4 v0 = acc[ai][bj][m][0], v1 = acc[ai][bj][m][1];
                    *(u32x4*)(hb + (size_t)(u.pm * 256 + ai * 128 + wr * 64 + m * 16 + fr) * D + c0 + bj * 128) =
                        (u32x4){pack2(ALPHA * lo_bf(h[0]) + v0[0], ALPHA * hi_bf(h[0]) + v0[1]), pack2(ALPHA * lo_bf(h[1]) + v0[2], ALPHA * hi_bf(h[1]) + v0[3]),
                                pack2(ALPHA * lo_bf(h[2]) + v1[0], ALPHA * hi_bf(h[2]) + v1[1]), pack2(ALPHA * lo_bf(h[3]) + v1[2], ALPHA * hi_bf(h[3]) + v1[3])};
                }
        }
    }
};
DI void phase_outproj(const Params& p, int layer, int bid, int nb, char* smem) {
    const bf16_t* A = p.merged; bf16_t* const hbres = p.hb;
    const bf16_t* Bt = p.WtOut + (size_t)layer * D * D;
    if (bid == 0 && tid_() < NE) p.counts[tid_()] = 0;
    g8::DenseOrder S; S.init(A, Bt, MFULL, D / 256, D, nb, bid);
    g8::gemm8<false>((G8_LAS unsigned char*)smem, D, S, EpiOut{hbres});
    for (int t = left_first(MFULL * 4, bid, nb); t < D / 128; t += nb)
        gemm_left32([=](int r) { return A + (size_t)(M0_LEFT + r) * D; }, Bt, D, D, t * 128, smem,
                    [=](int r0, int c, f32x4 v) {
                        const int r = M0_LEFT + r0;
                        u32x2* hp = (u32x2*)(hbres + (size_t)r * D + c);
                        const f32x4 h = up4(*hp);
                        *hp = (u32x2){pack2(ALPHA * h[0] + v[0], ALPHA * h[1] + v[1]), pack2(ALPHA * h[2] + v[2], ALPHA * h[3] + v[3])};
                    });
}

constexpr int LN1_ROWB = 2 * D + 16;
constexpr int LN1_WAVE = 8 * LN1_ROWB;
constexpr int LN1_LDS = 8 * LN1_WAVE + 2048;
DI void phase_ln1_router(const Params& p, int layer, int bid, int nb, char* smem) {
    const int tid = tid_(), lane = tid & 63, wid = __builtin_amdgcn_readfirstlane(tid >> 6), fr = lane & 15, fq = lane >> 4;
    char* wl = smem + wid * LN1_WAVE;
    int* sel = (int*)(smem + 8 * LN1_WAVE);
    float* sgt = (float*)(smem + 8 * LN1_WAVE + 640);
    int* sbase = (int*)(smem + 8 * LN1_WAVE + 1280);
    const int nwaves = nb * 8, gw = bid * 8 + wid;
    const int base_n = T / nwaves, extra = T % nwaves;
    const int tok0 = gw * base_n + (gw < extra ? gw : extra), ntok = base_n + (gw < extra ? 1 : 0);
    const int btok0 = bid * 8 * base_n + (bid * 8 < extra ? bid * 8 : extra);
    const float* g1p = p.ln1_g + layer * D; const float* b1p = p.ln1_b + layer * D;
    __syncthreads();
    for (int g0 = 0; g0 < ntok; g0 += 8) {
        const int ng = ntok - g0 < 8 ? ntok - g0 : 8;
        float vn[16];
        { const bf16_t* hf = p.hb + (size_t)(tok0 + g0) * D;
#pragma unroll
          for (int j = 0; j < 4; ++j) { const f32x4 a = up4(*(const u32x2*)(hf + 256 * j + 4 * lane)); vn[4 * j] = a[0]; vn[4 * j + 1] = a[1]; vn[4 * j + 2] = a[2]; vn[4 * j + 3] = a[3]; } }
#pragma unroll 1
        for (int i = 0; i < ng; ++i) {
            const int tok = tok0 + g0 + i;
            float v[16];
#pragma unroll
            for (int q = 0; q < 16; ++q) v[q] = vn[q];
            if (i + 1 < ng) { const bf16_t* hn = p.hb + (size_t)(tok + 1) * D;
#pragma unroll
                for (int j = 0; j < 4; ++j) { const f32x4 a = up4(*(const u32x2*)(hn + 256 * j + 4 * lane)); vn[4 * j] = a[0]; vn[4 * j + 1] = a[1]; vn[4 * j + 2] = a[2]; vn[4 * j + 3] = a[3]; } }
            ln16(v, g1p, b1p, lane);
#pragma unroll
            for (int j = 0; j < 4; ++j) {
                const unsigned h0 = pack2(v[4 * j], v[4 * j + 1]), h1 = pack2(v[4 * j + 2], v[4 * j + 3]);
                *(u32x2*)(p.hb + (size_t)tok * D + 256 * j + 4 * lane) = (u32x2){h0, h1};
                *(u32x2*)(wl + i * LN1_ROWB + (256 * j + 4 * lane) * 2) = (u32x2){h0, h1};
            }
        }
        asm volatile("s_waitcnt lgkmcnt(0)" ::: "memory");
        __builtin_amdgcn_wave_barrier();
        f32x4 acc[2] = {(f32x4){0.f, 0.f, 0.f, 0.f}, (f32x4){0.f, 0.f, 0.f, 0.f}};
        const char* arow = wl + (fr & 7) * LN1_ROWB + fq * 16;
        const bf16_t* whi = p.RwHi + (size_t)fr * D + fq * 8;
#pragma unroll 4
        for (int ks = 0; ks < 32; ++ks) {
            const bf16x8 ah = *(const bf16x8*)(arow + ks * 64);
            const bf16x8 bh = *(const bf16x8*)(whi + ks * 32);
            acc[ks & 1] = __builtin_amdgcn_mfma_f32_16x16x32_bf16(bh, ah, acc[ks & 1], 0, 0, 0);
        }
        float lg[4]; float mx = -3.0e38f;
#pragma unroll
        for (int e = 0; e < 4; ++e) { lg[e] = acc[0][e] + acc[1][e] + p.router_b[4 * fq + e]; mx = fmaxf(mx, lg[e]); }
        mx = fmaxf(mx, __shfl_xor(mx, 16)); mx = fmaxf(mx, __shfl_xor(mx, 32));
        float sum = 0.f;
#pragma unroll
        for (int e = 0; e < 4; ++e) { lg[e] = __expf(lg[e] - mx); sum += lg[e]; }
        sum += __shfl_xor(sum, 16); sum += __shfl_xor(sum, 32);
        const float inv = 1.0f / sum;
        float v1 = -1.f, v2 = -1.f; int i1 = 0, i2 = 0;
#pragma unroll
        for (int e = 0; e < 4; ++e) {
            const float pv = lg[e] * inv;
            if (pv > v1) { v2 = v1; i2 = i1; v1 = pv; i1 = e; } else if (pv > v2) { v2 = pv; i2 = e; }
        }
        const float sc = v1 + v2;
        float bsc = sc; int bg = fq;
#pragma unroll
        for (int m = 16; m <= 32; m <<= 1) {
            const float os = __shfl_xor(bsc, m); const int og = __shfl_xor(bg, m);
            if (os > bsc || (os == bsc && og < bg)) { bsc = os; bg = og; }
        }
        if (bg == fq && fr < ng) {
            const int li = tok0 + g0 + fr - btok0;
            const float gs = 1.0f / (v1 + v2);
            sel[li * 2] = 4 * fq + i1; sel[li * 2 + 1] = 4 * fq + i2; sgt[li * 2] = v1 * gs; sgt[li * 2 + 1] = v2 * gs;
        }
        asm volatile("s_waitcnt lgkmcnt(0)" ::: "memory");
        __builtin_amdgcn_wave_barrier();
    }
    __syncthreads();
    if (wid == 0) {
        const int nbt = 8 * base_n + ((bid * 8 + 8 <= extra) ? 8 : (bid * 8 < extra ? extra - bid * 8 : 0));
        for (int c0 = 0; c0 < nbt; c0 += 64) {
            const int li = c0 + lane; const bool on = li < nbt;
            const int e1 = on ? sel[li * 2] : -1, e2 = on ? sel[li * 2 + 1] : -1;
            const unsigned long long lt = (1ull << lane) - 1ull;
            int r1 = 0, r2 = 0, mycnt = 0;
#pragma unroll
            for (int e = 0; e < NE; ++e) {
                const unsigned long long m1 = __ballot(e1 == e), m2 = __ballot(e2 == e);
                const int c1 = __popcll(m1), c2 = __popcll(m2);
                if (e1 == e) r1 = __popcll(m1 & lt);
                if (e2 == e) r2 = c1 + __popcll(m2 & lt);
                if (lane == e) mycnt = c1 + c2;
            }
            if (lane < NE) sbase[lane] = mycnt > 0 ? atomicAdd(&p.counts[lane], mycnt) : 0;
            asm volatile("s_waitcnt vmcnt(0) lgkmcnt(0)" ::: "memory");
            __builtin_amdgcn_wave_barrier();
            if (on) {
                const int tok = btok0 + li;
                const int s1 = sbase[e1] + r1, s2 = sbase[e2] + r2;
                p.list[e1 * T + s1] = tok * 2; p.list[e2 * T + s2] = tok * 2 + 1;
                p.tokg[tok * 2] = sgt[li * 2]; p.tokg[tok * 2 + 1] = sgt[li * 2 + 1];
            }
            asm volatile("s_waitcnt lgkmcnt(0)" ::: "memory");
            __builtin_amdgcn_wave_barrier();
        }
    }
}

constexpr int MOE_BIG = 8;
template <bool UP> struct MoeOrder {
    const int* counts; const int* list; int G, c; const char* A; const char* B;
    DI bool next(int i, g8::Unit& u) const {
        const int xcd = c & 7, w = c >> 3, mt = (w >> 1) & 7, pn = 2 * (w & 1) + i, esel = xcd + 8 * (w >> 4);
        if (w >= 32 || i >= 2) return false;
        int padp = 0, fe = -1, fc = 0, fp = 0;
#pragma unroll
        for (int e = 0; e < NE; ++e) {
            const int cn = counts[e], ntp = (cn + 255) >> 8, nt = ntp < MOE_BIG ? ntp : MOE_BIG;
            const bool hit = (e == esel) && (mt < nt);
            fe = hit ? e : fe; fc = hit ? cn : fc; fp = hit ? padp + mt : fp;
            padp += ntp;
        }
        fe = __builtin_amdgcn_readfirstlane(fe); fc = __builtin_amdgcn_readfirstlane(fc); fp = __builtin_amdgcn_readfirstlane(fp);
        if (fe < 0) return false;
        u.e = fe; u.slot0 = mt * 256; u.cnt = fc; u.pm = fp; u.pn = pn;
        u.A = UP ? A : A + (size_t)fp * ((size_t)256 * DE * 2);
        u.B = UP ? B + (size_t)fe * ((size_t)1024 * 1024 * 2) + (size_t)pn * ((size_t)256 * D * 2) : B + (size_t)fe * ((size_t)1024 * 512 * 2) + (size_t)pn * ((size_t)256 * DE * 2);
        return true;
    }
    DI unsigned row_off(const g8::Unit& u, int r) const {
        const __amdgpu_buffer_rsrc_t rs = __builtin_amdgcn_make_buffer_rsrc((void*)list, 0, NE * T * 4, 0x00020000);
        const int ent = __builtin_amdgcn_raw_buffer_load_b32(rs, r * 4, (u.e * T + u.slot0) * 4, 0);
        return u.slot0 + r < u.cnt ? (unsigned)(ent >> 1) * (unsigned)(D * 2) : 0u;
    }
};
struct EpiMoeUp {
    static constexpr bool PERM = true;
    bf16_t* hid;
    DI void operator()(const f32x4 (&acc)[2][2][4][2], const g8::Unit& u, int wr, int wc, int fr, int fq) const {
#pragma unroll
        for (int ai = 0; ai < 2; ++ai)
#pragma unroll
            for (int m = 0; m < 4; ++m) {
                const int r = ai * 128 + wr * 64 + m * 16 + fr;
                if (u.slot0 + r >= u.cnt) continue;
                bf16_t* rowp = hid + ((size_t)u.pm * 256 + r) * DE + ((u.pn * 256 + wc * 32 + 8 * fq) >> 1);
#pragma unroll
                for (int bj = 0; bj < 2; ++bj) {
                    const f32x4 v0 = acc[ai][bj][m][0], v1 = acc[ai][bj][m][1];
                    *(u32x2*)(rowp + bj * 64) = (u32x2){pack2(v0[0] * sigmoidf_(v0[0]) * v0[1], v0[2] * sigmoidf_(v0[2]) * v0[3]), pack2(v1[0] * sigmoidf_(v1[0]) * v1[1], v1[2] * sigmoidf_(v1[2]) * v1[3])};
                }
            }
    }
};
struct EpiMoeDown {
    static constexpr bool PERM = true;
    bf16_t* fo; const int* list; const float* tokg;
    DI void operator()(const f32x4 (&acc)[2][2][4][2], const g8::Unit& u, int wr, int wc, int fr, int fq) const {
        int ent[8]; float g[8];
#pragma unroll
        for (int q = 0; q < 8; ++q) {
            const int sl = u.slot0 + (q >> 2) * 128 + wr * 64 + (q & 3) * 16 + fr;
            ent[q] = sl < u.cnt ? list[u.e * T + sl] : -1;
        }
#pragma unroll
        for (int q = 0; q < 8; ++q) g[q] = ent[q] >= 0 ? tokg[ent[q]] : 0.f;
#pragma unroll
        for (int ai = 0; ai < 2; ++ai)
#pragma unroll
            for (int m = 0; m < 4; ++m) {
                const int q = ai * 4 + m;
                if (ent[q] < 0) continue;
                const float gg = g[q];
                bf16_t* rowp = fo + ((size_t)(ent[q] & 1) * TP + (ent[q] >> 1)) * D + u.pn * 256 + wc * 32 + 8 * fq;
#pragma unroll
                for (int bj = 0; bj < 2; ++bj) {
                    const f32x4 v0 = acc[ai][bj][m][0], v1 = acc[ai][bj][m][1];
                    *(u32x4*)(rowp + bj * 128) = (u32x4){pack2(gg * v0[0], gg * v0[1]), pack2(gg * v0[2], gg * v0[3]), pack2(gg * v1[0], gg * v1[1]), pack2(gg * v1[2], gg * v1[3])};
                }
            }
    }
};
DI void phase_moe_up(const Params& p, int bid, int nb, char* smem) {
    const MoeOrder<true> S{p.counts, p.list, nb, bid, (const char*)p.hb, (const char*)p.WtGU};
    g8::gemm8<true>((G8_LAS unsigned char*)smem, D, S, EpiMoeUp{p.hid});
    const bf16_t* hb = p.hb; bf16_t* hid = p.hid; const int* list = p.list;
    int big = 0, padr = 0, job = 0;
#pragma unroll 1
    for (int e = 0; e < NE; ++e) { const int cn = p.counts[e], ntp = (cn + 255) >> 8; big += (ntp < MOE_BIG ? ntp : MOE_BIG) * 4; }
    const int mine = bid; (void)big;
#pragma unroll 1
    for (int e = 0; e < NE; ++e) {
        const int cn = p.counts[e];
        for (int s0 = MOE_BIG * 256; s0 < cn; s0 += 128)
            for (int nt = 0; nt < 8; ++nt, ++job)
                if (job % nb == mine) {
                    const int prow = padr;
                    gemm_tile128([=](int r) { const int sl = s0 + r; return sl < cn ? hb + (size_t)(list[e * T + sl] >> 1) * D : (const bf16_t*)nullptr; },
                                 p.WtGU + (size_t)e * 1024 * 1024, D, D, 0, nt * 128, smem,
                                 [=](int r, int c, f32x4 v) {
                                     const int sl = s0 + r;
                                     if (sl >= cn) return;
                                     *(unsigned*)(hid + (size_t)(prow + sl) * DE + (c >> 1)) = pack2(v[0] * sigmoidf_(v[0]) * v[1], v[2] * sigmoidf_(v[2]) * v[3]);
                                 });
                }
        padr += ((cn + 255) >> 8) * 256;
    }
}
DI void phase_moe_down(const Params& p, int bid, int nb, char* smem) {
    const MoeOrder<false> S{p.counts, p.list, nb, bid, (const char*)p.hid, (const char*)p.WtD};
    g8::gemm8<false>((G8_LAS unsigned char*)smem, DE, S, EpiMoeDown{p.fo, p.list, p.tokg});
    const bf16_t* hid = p.hid; bf16_t* fo = p.fo; const int* list = p.list; const float* tokg = p.tokg;
    int big = 0, padr = 0, job = 0;
#pragma unroll 1
    for (int e = 0; e < NE; ++e) { const int cn = p.counts[e], ntp = (cn + 255) >> 8; big += (ntp < MOE_BIG ? ntp : MOE_BIG) * 4; }
    const int mine = bid; (void)big;
#pragma unroll 1
    for (int e = 0; e < NE; ++e) {
        const int cn = p.counts[e];
        for (int s0 = MOE_BIG * 256; s0 < cn; s0 += 128)
            for (int nt = 0; nt < 8; ++nt, ++job)
                if (job % nb == mine) {
                    const int prow = padr;
                    gemm_tile128([=](int r) { const int sl = s0 + r; return sl < cn ? hid + (size_t)(prow + sl) * DE : (const bf16_t*)nullptr; },
                                 p.WtD + (size_t)e * 1024 * 512, DE, DE, 0, nt * 128, smem,
                                 [=](int r, int c, f32x4 v) {
                                     const int sl = s0 + r;
                                     if (sl >= cn) return;
                                     const int ent = list[e * T + sl];
                                     const float g = tokg[ent];
                                     *(u32x2*)(fo + ((size_t)(ent & 1) * TP + (ent >> 1)) * D + c) = (u32x2){pack2(g * v[0], g * v[1]), pack2(g * v[2], g * v[3])};
                                 });
                }
        padr += ((cn + 255) >> 8) * 256;
    }
}
DI void phase_ln2(const Params& p, int layer, int bid, int nb) {
    const int lane = tid_() & 63, wid = __builtin_amdgcn_readfirstlane(tid_() >> 6);
    const int nwaves = nb * 8, gw = bid * 8 + wid, base_n = T / nwaves, extra = T % nwaves;
    const int tok0 = gw * base_n + (gw < extra ? gw : extra), ntok = base_n + (gw < extra ? 1 : 0);
    u32x2 an[4], f0n[4], f1n[4];
    {
#pragma unroll
        for (int j = 0; j < 4; ++j) {
            an[j] = *(const u32x2*)(p.hb + (size_t)tok0 * D + 256 * j + 4 * lane);
            f0n[j] = *(const u32x2*)(p.fo + (size_t)tok0 * D + 256 * j + 4 * lane); f1n[j] = *(const u32x2*)(p.fo + ((size_t)TP + tok0) * D + 256 * j + 4 * lane);
        }
    }
#pragma unroll 1
    for (int i = 0; i < ntok; ++i) {
        const int tok = tok0 + i;
        float v[16];
#pragma unroll
        for (int j = 0; j < 4; ++j) {
            v[4 * j] = ALPHA * lo_bf(an[j][0]) + lo_bf(f0n[j][0]) + lo_bf(f1n[j][0]); v[4 * j + 1] = ALPHA * hi_bf(an[j][0]) + hi_bf(f0n[j][0]) + hi_bf(f1n[j][0]);
            v[4 * j + 2] = ALPHA * lo_bf(an[j][1]) + lo_bf(f0n[j][1]) + lo_bf(f1n[j][1]); v[4 * j + 3] = ALPHA * hi_bf(an[j][1]) + hi_bf(f0n[j][1]) + hi_bf(f1n[j][1]);
        }
        if (i + 1 < ntok) {
#pragma unroll
            for (int j = 0; j < 4; ++j) {
                an[j] = *(const u32x2*)(p.hb + (size_t)(tok + 1) * D + 256 * j + 4 * lane);
                f0n[j] = *(const u32x2*)(p.fo + (size_t)(tok + 1) * D + 256 * j + 4 * lane); f1n[j] = *(const u32x2*)(p.fo + ((size_t)TP + tok + 1) * D + 256 * j + 4 * lane);
            }
        }
        ln16(v, p.ln2_g + layer * D, p.ln2_b + layer * D, lane);
        if (layer == DEPTH - 1) {
            float* of = hrow_u(p, tok);
#pragma unroll
            for (int j = 0; j < 4; ++j) *(f32x4*)(of + 256 * j + 4 * lane) = (f32x4){v[4 * j], v[4 * j + 1], v[4 * j + 2], v[4 * j + 3]};
        } else store_row_bf(p.hb + (size_t)tok * D, v, lane);
    }
}

extern __shared__ __attribute__((aligned(16))) char dyn_smem[];
constexpr int SMEM_MAIN = R1_LDS > GEMM_LDS ? R1_LDS : GEMM_LDS;
constexpr int SMEM_BYTES = SMEM_MAIN + 16;

__global__ void __launch_bounds__(NTHR, 2) k_forward(Params p) {
    const int bid = blockIdx.x, nb = gridDim.x;
    char* smem = dyn_smem;
    uint4* xbw = (uint4*)(dyn_smem + SMEM_MAIN);
    if (threadIdx.x == 0) *xbw = make_uint4(0u, 0u, 0u, 0u);
    __syncthreads();
    XcdBarrier bar = xcd_barrier_post(p.bar, (volatile LAS unsigned*)xbw);
    phase_prologue_weights(p, bid, nb, smem);
    phase_embed(p, bid, nb);
    xcd_barrier(bar);
    for (int l = 0; l < DEPTH; ++l) {
        phase_inproj(p, l, bid, nb, smem);
        xcd_barrier(bar);
        phase_rwkv_r1<0>(p, l, bid, nb, smem);
        xcd_barrier(bar);
        if (bid < 16) { const int cw = __builtin_amdgcn_readfirstlane(tid_() >> 6); if (cw < 4) phase_rwkv_r2(p, bid * 4 + cw); }
        else {
            const int sbid = bid - 16, snb = nb - 16, heavy = (NBATCH * HEADS * ((L + 127) / 128)) % snb;
            if (sbid >= heavy && sbid < heavy + NBATCH * HEADS) phase_rwkv_r1<1>(p, l, sbid - heavy, 1, smem);
            phase_sb(p, sbid, snb, smem);
        }
        xcd_barrier(bar);
        phase_rwkv_r3(p, l, bid, nb);
        convert_experts(p, l, NE / 2, NE, bid, nb, smem);
        phase_merge<0>(p, l, bid, nb, smem);
        xcd_barrier(bar);
        phase_merge<1>(p, l, bid, nb, smem);
        xcd_barrier(bar);
        phase_outproj(p, l, bid, nb, smem);
        xcd_barrier(bar);
        phase_ln1_router(p, l, bid, nb, smem);
        xcd_barrier(bar);
        phase_moe_up(p, bid, nb, smem);
        xcd_barrier(bar);
        phase_moe_down(p, bid, nb, smem);
        xcd_barrier(bar);
        phase_ln2(p, l, bid, nb);
        xcd_barrier(bar);
    }
}

extern "C" void kernel_launch(void* const* d_in, const int* in_sizes, int n_in, void* d_out, int out_size, void* d_ws, size_t ws_size, hipStream_t stream) {
    (void)in_sizes; (void)n_in; (void)out_size;
    Params p;
    memset(&p, 0, sizeof(p));
    const float* const* in = (const float* const*)d_in;
    p.x = in[0]; p.meta = in[1]; p.emb_g = in[2]; p.emb_b = in[3]; p.w_in = in[4]; p.mu = in[5]; p.w0 = in[6]; p.w_up = in[7]; p.a0 = in[8]; p.a_up = in[9];
    p.g_up = in[10]; p.k_k = in[11]; p.k_a = in[12]; p.r_k = in[13]; p.lnx_g = in[14]; p.lnx_b = in[15]; p.p_sb = in[16]; p.p_rwkv = in[17]; p.w_out = in[18];
    p.ln1_g = in[19]; p.ln1_b = in[20]; p.router_w = in[21]; p.router_b = in[22]; p.ew_gate = in[23]; p.ew_up = in[24]; p.ew_down = in[25]; p.ln2_g = in[26]; p.ln2_b = in[27];
    p.out = (float*)d_out;
    char* ws = (char*)d_ws; size_t o = 0;
    auto take = [&](size_t bytes) { char* r = ws + o; o += (bytes + 255) & ~(size_t)255; return r; };
    p.bar = (unsigned*)take(XCD_BAR_WORDS * sizeof(unsigned));
    p.counts = (int*)take(256);
    p.WtIn = (bf16_t*)take((size_t)DEPTH * CIN * D * 2);
    p.WtPsb = (bf16_t*)take((size_t)DEPTH * D * 512 * 2);
    p.WtPrw = (bf16_t*)take((size_t)DEPTH * D * 512 * 2);
    p.WtOut = (bf16_t*)take((size_t)DEPTH * D * D * 2);
    p.WupT = (bf16_t*)take((size_t)DEPTH * 512 * 64 * 2);
    p.AupT = (bf16_t*)take((size_t)DEPTH * 512 * 64 * 2);
    p.GupT = (bf16_t*)take((size_t)DEPTH * 512 * 128 * 2);
    p.RwHi = (bf16_t*)take((size_t)NE * D * 2);
    p.gleft = (bf16_t*)take((size_t)32 * 2048 * 2);
    {
        const size_t ub = (size_t)NUNIT * 64 * 64 * 2;
        p.WtGU = (bf16_t*)take((size_t)NE * 1024 * 1024 * 2);
        p.WtD = (bf16_t*)take((size_t)NE * 1024 * 512 * 2);
        p.PcG = (bf16_t*)d_out; p.QcG = (bf16_t*)((char*)d_out + ub); p.RhG = (bf16_t*)((char*)d_out + 2 * ub);
        p.Y0G = (bf16_t*)take(ub); p.GG = (bf16_t*)take(ub); p.SG = (bf16_t*)take(ub);
        p.bonG = (float*)take((size_t)NUNIT * 64 * 4);
    }
    p.hb = (bf16_t*)take((size_t)TP * D * 2);
    p.hmeta = (float*)take((size_t)NBATCH * NMETA * D * 4);
    p.P = (bf16_t*)take((size_t)TP * CP * 2);
    p.osb = (bf16_t*)take((size_t)TP * 512 * 2);
    p.orw = (bf16_t*)take((size_t)TP * 512 * 2);
    p.list = (int*)take((size_t)NE * T * 4);
    p.tokg = (float*)take((size_t)T * 2 * 4);
    p.gates = p.P;
    p.merged = p.P + (size_t)TP * 2048;
    p.hid = p.P;
    p.fo = p.P + (size_t)(2 * T + 16 * 256) * DE;
    if (o > ws_size) return;
    static int grid = 0;
    if (!grid) {
        int dev = 0, cus = 0, per_cu = 0;
        (void)hipGetDevice(&dev);
        (void)hipDeviceGetAttribute(&cus, hipDeviceAttributeMultiprocessorCount, dev);
        (void)hipFuncSetAttribute((const void*)k_forward, hipFuncAttributeMaxDynamicSharedMemorySize, SMEM_BYTES);
        (void)hipOccupancyMaxActiveBlocksPerMultiprocessor(&per_cu, k_forward, NTHR, SMEM_BYTES);
        grid = per_cu >= 1 ? cus : 0;
    }
    if (!grid) return;
    (void)hipMemsetAsync(p.bar, 0, XCD_BAR_WORDS * sizeof(unsigned), stream);
    hipLaunchKernelGGL(k_forward, dim3(grid), dim3(NTHR), SMEM_BYTES, stream, p);
}
```

```cpp
#include <hip/hip_runtime.h>
#include <stdint.h>
#include <string.h>

#define DI __device__ __forceinline__
typedef unsigned short bf16_t;
typedef short bf16x8 __attribute__((ext_vector_type(8)));
typedef float f32x4 __attribute__((ext_vector_type(4)));
typedef unsigned u32x4 __attribute__((ext_vector_type(4)));
typedef unsigned u32x2 __attribute__((ext_vector_type(2)));

constexpr int D = 1024, NBATCH = 2, SEQ = 8192, NMETA = 16, L = SEQ + NMETA, T = NBATCH * L, TP = 16640;
constexpr int DEPTH = 2, HEADS = 8, HD = 64;
constexpr int CIN = 5376, CP = 3328;
constexpr int OFF_Q = 0, OFF_K = 512, OFF_V = 1024, OFF_RW = 1536;
constexpr int RW_R = 0, RW_K = 512, RW_V = 1024, RW_WD = 1536, RW_AD = 1600, RW_GD = 1664, RSW = 1792;
constexpr int NE = 16, DE = 512;
constexpr float ALPHA = 1.41421356237309515f;
constexpr float DECAY_SCALE = 0.60653065971263342f;
constexpr int NTHR = 512;

#define XB_TMO      128
#define XB_XCNT(j)  (256  + 64 * (j))
#define XB_XSUB(j)  (1280 + 64 * (j))
#define XB_XGEN(j)  (2304 + 64 * (j))
#define XB_TOP      3328
#define XB_TOPGEN   3392
#define XCD_BAR_WORDS 3456
#define XB_SPIN_CAP (1u << 18)
#define LAS __attribute__((address_space(3)))

__device__ __forceinline__ unsigned xb_ld(unsigned* p)              { return __hip_atomic_load(p, __ATOMIC_RELAXED, __HIP_MEMORY_SCOPE_AGENT); }
__device__ __forceinline__ unsigned xb_add(unsigned* p, unsigned v) { return __hip_atomic_fetch_add(p, v, __ATOMIC_RELAXED, __HIP_MEMORY_SCOPE_AGENT); }
__device__ __forceinline__ unsigned xb_xcc_id() { return (unsigned)__builtin_amdgcn_s_getreg((3 << 11) | 20) & 0xFu; }
#define XB_SPIN(cond, bar) do { unsigned _sp = 0; while (cond) { __builtin_amdgcn_s_sleep(1); \
    if ((++_sp & 255u) == 0u) { if (xb_ld(&(bar)[XB_TMO])) break; if (_sp > XB_SPIN_CAP) { atomicAdd(&(bar)[XB_TMO], 1u); break; } } } } while (0)

struct XcdBarrier {
    unsigned* bar; unsigned x;
    volatile LAS unsigned* st;
};

__device__ __forceinline__ XcdBarrier xcd_barrier_post(unsigned* bar, volatile LAS unsigned* st) {
    XcdBarrier b; b.bar = bar; b.x = xb_xcc_id(); b.st = st;
    if (threadIdx.x == 0) (void)xb_add(&bar[XB_XCNT(b.x)], 1u);
    return b;
}
__device__ __forceinline__ void xcd_barrier_complete(unsigned* bar, unsigned x, unsigned& nloc, unsigned& nx) {
    const unsigned G = gridDim.x * gridDim.y * gridDim.z;
    unsigned sum, cnt, mine, sp = 0u;
    for (;;) {
        sum = 0u; cnt = 0u; mine = 0u;
#pragma unroll
        for (unsigned j = 0; j < 16; ++j) { const unsigned c = xb_ld(&bar[XB_XCNT(j)]); sum += c; cnt += (c > 0u) ? 1u : 0u; mine = (j == x) ? c : mine; }
        if (sum == G) break;
        __builtin_amdgcn_s_sleep(1);
        if ((++sp & 255u) == 0u) { if (xb_ld(&bar[XB_TMO])) break; if (sp > XB_SPIN_CAP) { atomicAdd(&bar[XB_TMO], 1u); break; } }
    }
    nloc = mine > 0u ? mine : 1u; nx = cnt > 0u ? cnt : 1u;
}

__device__ __forceinline__ void xcd_barrier(const XcdBarrier& b) {
    asm volatile("s_waitcnt vmcnt(0)" ::: "memory");
    __syncthreads();
    if (threadIdx.x == 0) {
        unsigned* bar = b.bar;
        unsigned bx = b.x; asm volatile("" : "+s"(bx));
        __builtin_amdgcn_s_waitcnt(0);
        unsigned nloc = b.st[0], nx = b.st[1];
        if (nloc == 0u) { xcd_barrier_complete(bar, bx, nloc, nx); b.st[0] = nloc; b.st[1] = nx; }
        const unsigned old = xb_add(&bar[XB_XSUB(bx)], 1u);
        const unsigned gen = old / nloc;
        if (old + 1u == (gen + 1u) * nloc) {
            __builtin_amdgcn_fence(__ATOMIC_RELEASE, "agent");
            asm volatile("s_waitcnt vmcnt(0)" ::: "memory");
            const unsigned og = xb_add(&bar[XB_TOP], 1u);
            const unsigned tg = og / nx;
            if (og + 1u == (tg + 1u) * nx) xb_add(&bar[XB_TOPGEN], 1u);
            else XB_SPIN(xb_ld(&bar[XB_TOPGEN]) == tg, bar);
            __builtin_amdgcn_fence(__ATOMIC_ACQUIRE, "agent");
            xb_add(&bar[XB_XGEN(bx)], 1u);
            asm volatile("s_waitcnt vmcnt(0)" ::: "memory");
        } else {
            XB_SPIN(xb_ld(&bar[XB_XGEN(bx)]) == gen, bar);
            __builtin_amdgcn_fence(__ATOMIC_ACQUIRE, "agent");
            asm volatile("s_waitcnt vmcnt(0)" ::: "memory");
        }
    }
    __syncthreads();
}


struct Params {
    const float *x, *meta, *emb_g, *emb_b, *w_in, *mu, *w0, *w_up, *a0, *a_up, *g_up, *k_k, *k_a, *r_k, *lnx_g, *lnx_b, *p_sb, *p_rwkv, *w_out,
        *ln1_g, *ln1_b, *router_w, *router_b, *ew_gate, *ew_up, *ew_down, *ln2_g, *ln2_b;
    float* out;
    unsigned* bar;
    int* counts;
    bf16_t *WtIn, *WtPsb, *WtPrw, *WtOut, *WtGU, *WtD, *hb, *P, *osb, *orw, *WupT, *AupT, *GupT;
    bf16_t *PcG, *QcG, *RhG, *Y0G, *GG, *SG;
    bf16_t *RwHi, *gleft;
    float* bonG;
    float* hmeta;
    bf16_t *gates, *merged, *hid, *fo;
    int* list;
    float* tokg;
};

DI float bf2f(bf16_t v) { return __uint_as_float((unsigned)v << 16); }
typedef __bf16 bf16x2_t __attribute__((ext_vector_type(2)));
DI bf16_t f2bf(float f) { return __builtin_bit_cast(bf16_t, (__bf16)f); }
DI unsigned pack2(float lo, float hi) { bf16x2_t v = {(__bf16)lo, (__bf16)hi}; return __builtin_bit_cast(unsigned, v); }
DI float lo_bf(unsigned u) { return __uint_as_float(u << 16); }
DI float hi_bf(unsigned u) { return __uint_as_float(u & 0xFFFF0000u); }
template <int CTRL> DI float dpp_mov(float v) { return __builtin_bit_cast(float, __builtin_amdgcn_update_dpp(0, __builtin_bit_cast(int, v), CTRL, 0xF, 0xF, true)); }
DI float sum8(float v) {
    v += dpp_mov<0xB1>(v);
    v += dpp_mov<0x4E>(v);
    v += dpp_mov<0x141>(v);
    return v;
}
DI float sum16(float v) { v = sum8(v); v += dpp_mov<0x140>(v); return v; }
DI float wave_sum(float v) { v = sum16(v); v += __shfl_xor(v, 16); v += __shfl_xor(v, 32); return v; }
struct Params;
DI const Params& kparams() {
    auto k = __builtin_amdgcn_kernarg_segment_ptr();
    asm volatile("" : "+s"(k));
    return *(const Params*)k;
}
DI int tid_() { int t = threadIdx.x; asm volatile("" : "+v"(t)); return t; }
DI float sigmoidf_(float x) { return __builtin_amdgcn_rcpf(1.0f + __expf(-x)); }
DI float tanhf_(float x) { return 1.0f - 2.0f * __builtin_amdgcn_rcpf(1.0f + __expf(2.0f * x)); }

DI float* hrow2(float* hmeta, float* out, int tok) {
    const int b = tok >= L ? 1 : 0, t = tok - b * L;
    const unsigned long long am = (unsigned long long)(hmeta + (long long)(b * NMETA + t) * D), ao = (unsigned long long)(out + ((long long)b * SEQ + (t - NMETA)) * D);
    const unsigned long long m = 0ull - (unsigned long long)(t < NMETA);
    return (float*)((am & m) | (ao & ~m));
}
DI float* hrow(const Params& p, int tok) { return hrow2(p.hmeta, p.out, tok); }
DI float* hrow_u(const Params& p, int tok) { return hrow2(p.hmeta, p.out, __builtin_amdgcn_readfirstlane(tok)); }

DI void transpose_convert(const float* __restrict__ src, int ld, int K, int N, bf16_t* __restrict__ dst, int mult, int off, int bid, int nb, char* smem, int& rot) {
    float* tile = (float*)smem;
    const int tk = K / 64, tn = N / 256, tid = tid_();
    const int first = (bid - rot % nb + nb) % nb;
    rot += tk * tn;
    for (int t = first; t < tk * tn; t += nb) {
        const int k0 = (t / tn) * 64, n0 = (t % tn) * 256;
        f32x4 v[4][2];
#pragma unroll
        for (int q = 0; q < 4; ++q)
#pragma unroll
            for (int i = 0; i < 2; ++i) v[q][i] = *(const f32x4*)(src + (size_t)(k0 + (tid >> 4) + 32 * i) * ld + n0 + q * 64 + (tid & 15) * 4);
        __syncthreads();
#pragma unroll
        for (int q = 0; q < 4; ++q)
#pragma unroll
            for (int i = 0; i < 2; ++i) {
                float* tp = tile + q * 64 * 65 + ((tid >> 4) + 32 * i) * 65 + (tid & 15) * 4;
                tp[0] = v[q][i][0]; tp[1] = v[q][i][1]; tp[2] = v[q][i][2]; tp[3] = v[q][i][3];
            }
        __syncthreads();
        const int n = tid >> 3, kc = (tid & 7) * 8;
#pragma unroll
        for (int q = 0; q < 4; ++q) {
            const float* tq = tile + q * 64 * 65;
            u32x4 o;
#pragma unroll
            for (int jj = 0; jj < 4; ++jj) o[jj] = pack2(tq[(kc + 2 * jj) * 65 + n], tq[(kc + 2 * jj + 1) * 65 + n]);
            *(u32x4*)(dst + (size_t)((n0 + q * 64 + n) * mult + off) * K + k0 + kc) = o;
        }
    }
}

DI void convert_experts(const Params& p, int layer, int e0, int e1, int bid, int nb, char* smem) {
    int rot = 0;
    for (int e = e0; e < e1; ++e) {
        const size_t eo = ((size_t)layer * NE + e) * (size_t)D * DE;
        transpose_convert(p.ew_gate + eo, DE, D, DE, p.WtGU + (size_t)e * 1024 * 1024, 2, 0, bid, nb, smem, rot);
        transpose_convert(p.ew_up + eo, DE, D, DE, p.WtGU + (size_t)e * 1024 * 1024, 2, 1, bid, nb, smem, rot);
        transpose_convert(p.ew_down + eo, D, DE, D, p.WtD + (size_t)e * 1024 * 512, 1, 0, bid, nb, smem, rot);
    }
}

DI void convert_layer_weights(const Params& p, int l, int bid, int nb, char* smem) {
    int rot = 0;
    transpose_convert(p.w_in + (size_t)l * D * CIN, CIN, D, CIN, p.WtIn + (size_t)l * CIN * D, 1, 0, bid, nb, smem, rot);
    transpose_convert(p.p_sb + (size_t)l * 512 * D, D, 512, D, p.WtPsb + (size_t)l * D * 512, 1, 0, bid, nb, smem, rot);
    transpose_convert(p.p_rwkv + (size_t)l * 512 * D, D, 512, D, p.WtPrw + (size_t)l * D * 512, 1, 0, bid, nb, smem, rot);
    transpose_convert(p.w_out + (size_t)l * D * D, D, D, D, p.WtOut + (size_t)l * D * D, 1, 0, bid, nb, smem, rot);
    transpose_convert(p.w_up + (size_t)l * 64 * 512, 512, 64, 512, p.WupT + (size_t)l * 512 * 64, 1, 0, bid, nb, smem, rot);
    transpose_convert(p.a_up + (size_t)l * 64 * 512, 512, 64, 512, p.AupT + (size_t)l * 512 * 64, 1, 0, bid, nb, smem, rot);
    transpose_convert(p.g_up + (size_t)l * 128 * 512, 512, 128, 512, p.GupT + (size_t)l * 512 * 128, 1, 0, bid, nb, smem, rot);
}
DI void phase_prologue_weights(const Params& p, int bid, int nb, char* smem) {
    for (int i = bid * NTHR + tid_(); i < NE * D; i += nb * NTHR) {
        const int e = i / D, k = i % D;
        p.RwHi[i] = f2bf(p.router_w[(size_t)k * NE + e]);
    }
    for (int l = 0; l < DEPTH; ++l) convert_layer_weights(p, l, bid, nb, smem);
}

DI void ln16(float (&v)[16], const float* __restrict__ g, const float* __restrict__ b, int lane) {
    float s = 0.f;
#pragma unroll
    for (int i = 0; i < 16; ++i) s += v[i];
    const float mean = wave_sum(s) * (1.0f / D);
    float q = 0.f;
#pragma unroll
    for (int i = 0; i < 16; ++i) { v[i] -= mean; q += v[i] * v[i]; }
    const float rstd = rsqrtf(wave_sum(q) * (1.0f / D) + 1e-5f);
#pragma unroll
    for (int j = 0; j < 4; ++j) {
        const f32x4 gv = *(const f32x4*)(g + 256 * j + 4 * lane), bv = *(const f32x4*)(b + 256 * j + 4 * lane);
#pragma unroll
        for (int i = 0; i < 4; ++i) v[4 * j + i] = v[4 * j + i] * rstd * gv[i] + bv[i];
    }
}
DI void store_row_bf(bf16_t* __restrict__ hb, const float (&v)[16], int lane) {
#pragma unroll
    for (int j = 0; j < 4; ++j) *(u32x2*)(hb + 256 * j + 4 * lane) = (u32x2){pack2(v[4 * j], v[4 * j + 1]), pack2(v[4 * j + 2], v[4 * j + 3])};
}
DI void phase_embed(const Params& p, int bid, int nb) {
    const int lane = tid_() & 63, wid = __builtin_amdgcn_readfirstlane(tid_() >> 6);
    const int nwaves = nb * 8, gw = bid * 8 + wid, base_n = T / nwaves, extra = T % nwaves;
    const int tok0 = gw * base_n + (gw < extra ? gw : extra), ntok = base_n + (gw < extra ? 1 : 0);
    auto srcrow = [&](int tok) -> const float* {
        const int tk = __builtin_amdgcn_readfirstlane(tok), b = tk >= L ? 1 : 0, t = tk - b * L;
        const unsigned long long am = (unsigned long long)(p.meta + (long long)t * D), ao = (unsigned long long)(p.x + ((long long)b * SEQ + (t - NMETA)) * D);
        const unsigned long long m = 0ull - (unsigned long long)(t < NMETA);
        return (const float*)((am & m) | (ao & ~m));
    };
    f32x4 an[4];
    { const float* src = srcrow(tok0);
#pragma unroll
      for (int j = 0; j < 4; ++j) an[j] = *(const f32x4*)(src + 256 * j + 4 * lane); }
#pragma unroll 1
    for (int i = 0; i < ntok; ++i) {
        const int tok = tok0 + i;
        float v[16];
#pragma unroll
        for (int j = 0; j < 4; ++j) { v[4 * j] = an[j][0]; v[4 * j + 1] = an[j][1]; v[4 * j + 2] = an[j][2]; v[4 * j + 3] = an[j][3]; }
        if (i + 1 < ntok) { const float* src = srcrow(tok + 1);
#pragma unroll
            for (int j = 0; j < 4; ++j) an[j] = *(const f32x4*)(src + 256 * j + 4 * lane); }
        ln16(v, p.emb_g, p.emb_b, lane);
        store_row_bf(p.hb + (size_t)tok * D, v, lane);
    }
}

constexpr int LDT = 72;
constexpr int GEMM_LDS = 2 * 128 * LDT * 2;
template <class ARow, class Epi>
DI void gemm_tile128(ARow arow, const bf16_t* __restrict__ Bt, int ldb, int K, int m0, int n0, char* smem, Epi epi) {
    const int tid = tid_(), lane = tid & 63, wid = __builtin_amdgcn_readfirstlane(tid >> 6), fr = lane & 15, fq = lane >> 4;
    const int wr = wid >> 1, wc = wid & 1;
    bf16_t* As = (bf16_t*)smem;
    bf16_t* Bs = As + 128 * LDT;
    const bf16_t* ap[2]; const bf16_t* bp[2]; int so[2];
#pragma unroll
    for (int i = 0; i < 2; ++i) {
        const int c = tid + NTHR * i, row = c >> 3, kc = c & 7;
        const bf16_t* ar = arow(m0 + row);
        ap[i] = ar ? ar + kc * 8 : nullptr;
        bp[i] = Bt + (size_t)(n0 + row) * ldb + kc * 8;
        so[i] = row * LDT + kc * 8;
    }
    f32x4 acc[2][4];
#pragma unroll
    for (int mi = 0; mi < 2; ++mi)
#pragma unroll
        for (int ni = 0; ni < 4; ++ni) acc[mi][ni] = (f32x4){0.f, 0.f, 0.f, 0.f};
    u32x4 ra[2], rb[2];
#pragma unroll
    for (int i = 0; i < 2; ++i) { ra[i] = ap[i] ? *(const u32x4*)(ap[i]) : (u32x4){0u, 0u, 0u, 0u}; rb[i] = *(const u32x4*)(bp[i]); }
    for (int k0 = 0; k0 < K; k0 += 64) {
        __syncthreads();
#pragma unroll
        for (int i = 0; i < 2; ++i) { *(u32x4*)(As + so[i]) = ra[i]; *(u32x4*)(Bs + so[i]) = rb[i]; }
        __syncthreads();
        if (k0 + 64 < K) {
#pragma unroll
            for (int i = 0; i < 2; ++i) { ra[i] = ap[i] ? *(const u32x4*)(ap[i] + k0 + 64) : (u32x4){0u, 0u, 0u, 0u}; rb[i] = *(const u32x4*)(bp[i] + k0 + 64); }
        }
#pragma unroll
        for (int ks = 0; ks < 2; ++ks) {
            bf16x8 af[2], bf[4];
#pragma unroll
            for (int mi = 0; mi < 2; ++mi) af[mi] = *(const bf16x8*)(As + (wr * 32 + mi * 16 + fr) * LDT + ks * 32 + fq * 8);
#pragma unroll
            for (int ni = 0; ni < 4; ++ni) bf[ni] = *(const bf16x8*)(Bs + (wc * 64 + ni * 16 + fr) * LDT + ks * 32 + fq * 8);
#pragma unroll
            for (int mi = 0; mi < 2; ++mi)
#pragma unroll
                for (int ni = 0; ni < 4; ++ni) acc[mi][ni] = __builtin_amdgcn_mfma_f32_16x16x32_bf16(bf[ni], af[mi], acc[mi][ni], 0, 0, 0);
        }
    }
#pragma unroll
    for (int mi = 0; mi < 2; ++mi)
#pragma unroll
        for (int ni = 0; ni < 4; ++ni) epi(m0 + wr * 32 + mi * 16 + fr, n0 + wc * 64 + ni * 16 + fq * 4, acc[mi][ni]);
}

namespace g8 {
#define G8_LAS __attribute__((address_space(3)))
constexpr int BM = 256, BK = 64, HALF = 128, HTB = HALF * BK * 2, STAGE_BYTES = 8 * HTB, NXCD = 8, WGM = 8;
DI int lds_byte(int r, int c) { const int st = (r >> 4) * 2 + (c >> 5), rr = r & 15, cc = c & 31, ob = rr * 64 + cc * 2; return st * 1024 + (ob ^ (((ob >> 9) & 1) << 5)); }
DI void stage_rc(int b, int& R, int& C) { const int st = b / 1024, sb = b % 1024, swz = sb ^ (((sb >> 9) & 1) << 5); R = (st >> 1) * 16 + swz / 64; C = (st & 1) * 32 + (swz % 64) / 2; }
DI int perm32(int rho) { const int n = rho >> 4, i = rho & 15; return 8 * (i >> 2) + 4 * n + (i & 3); }
struct Unit { int pm, pn; const char* A; const char* B; int e, slot0, cnt; };

struct DenseOrder {
    int nM, nN, nwg, G, c; const char* A; const char* B; size_t tstep;
    DI void init(const bf16_t* A_, const bf16_t* Bt_, int nM_, int nN_, int K, int G_, int c_) { nM = nM_; nN = nN_; nwg = nM * nN; G = G_; c = c_; A = (const char*)A_; B = (const char*)Bt_; tstep = (size_t)BM * K * 2; }
    DI bool next(int i, Unit& u) const {
        const long Lq = (long)i * G + c; if (Lq >= nwg) return false;
        int wgid = (int)Lq; { const int q = nwg / NXCD, r = nwg % NXCD, xcd = wgid % NXCD, off = wgid / NXCD; wgid = (xcd < r ? xcd * (q + 1) : r * (q + 1) + (xcd - r) * q) + off; }
        const int nig = WGM * nN, gid = wgid / nig, fm = gid * WGM, gsz = (nM - fm) < WGM ? (nM - fm) : WGM;
        u.pm = fm + ((wgid % nig) % gsz); u.pn = (wgid % nig) / gsz; u.A = A + (size_t)u.pm * tstep; u.B = B + (size_t)u.pn * tstep; u.e = 0; u.slot0 = 0; u.cnt = 0; return true;
    }
    DI unsigned row_off(const Unit&, int) const { return 0u; }
};

template <bool GATHER, class Epi, class Sched>
DI void gemm8(G8_LAS unsigned char* lds, const int K, const Sched& S, const Epi& E) {
    const int tid = tid_(), wid = __builtin_amdgcn_readfirstlane(tid >> 6), lane = tid & 63, wr = wid >> 2, wc = wid & 3, fr = lane & 15, fq = lane >> 4;
    const int nt = K / BK;
    int Rr[2], Cc[2]; unsigned voffB[2], voffA[2];
#pragma unroll
    for (int i = 0; i < 2; ++i) { stage_rc(tid * 16 + i * 8192, Rr[i], Cc[i]); const int Rb = Epi::PERM ? ((Rr[i] & ~31) + perm32(Rr[i] & 31)) : Rr[i]; voffB[i] = (unsigned)(Rb * K + Cc[i]) * 2u; voffA[i] = (unsigned)(Rr[i] * K + Cc[i]) * 2u; }
    const size_t kstep = (size_t)(BK * 2), hstep = (size_t)HALF * K * 2;
    const unsigned ldsw = (unsigned)wid * 1024u;
    const int aoff = lds_byte(wr * 64 + fr, fq * 8), boff = lds_byte(wc * 32 + fr, fq * 8);
#define G8_SA(b, h) (((b) * 2 + (h)) * HTB)
#define G8_SB(b, h) ((4 + (b) * 2 + (h)) * HTB)
#define G8_STAGE(bufoff, gbase, voff) do { _Pragma("unroll") for (int _i = 0; _i < 2; ++_i) \
        __builtin_amdgcn_global_load_lds((const unsigned*)((const char*)(gbase) + (voff)[_i]), (G8_LAS unsigned*)(lds + (bufoff) + ldsw + _i * 8192), 16, 0, 0); } while (0)
#define G8_LDA(dst, b, h) do { _Pragma("unroll") for (int m = 0; m < 4; ++m) _Pragma("unroll") for (int k = 0; k < 2; ++k) dst[m][k] = *(const G8_LAS bf16x8*)(lds + G8_SA(b, h) + aoff + m * 2048 + k * 1024); } while (0)
#define G8_LDB(dst, b, h) do { _Pragma("unroll") for (int n = 0; n < 2; ++n) _Pragma("unroll") for (int k = 0; k < 2; ++k) dst[n][k] = *(const G8_LAS bf16x8*)(lds + G8_SB(b, h) + boff + n * 2048 + k * 1024); } while (0)
#define G8_MMA(ai, bj, At, Bt) do { __builtin_amdgcn_s_setprio(1); _Pragma("unroll") for (int m = 0; m < 4; ++m) _Pragma("unroll") for (int n = 0; n < 2; ++n) _Pragma("unroll") for (int k = 0; k < 2; ++k) \
        acc[ai][bj][m][n] = __builtin_amdgcn_mfma_f32_16x16x32_bf16(Bt[n][k], At[m][k], acc[ai][bj][m][n], 0, 0, 0); __builtin_amdgcn_s_setprio(0); } while (0)
#define G8_WAIT_V(n) asm volatile("s_waitcnt vmcnt(" #n ")" ::: "memory")
#define G8_WAIT_L(n) asm volatile("s_waitcnt lgkmcnt(" #n ")" ::: "memory")
#define G8_BAR __builtin_amdgcn_s_barrier()
#define G8_SCHED __builtin_amdgcn_sched_barrier(0)
#define G8_AOFF(dst, un) do { if (GATHER) { _Pragma("unroll") for (int _h = 0; _h < 2; ++_h) _Pragma("unroll") for (int _i = 0; _i < 2; ++_i) \
        dst[_h][_i] = S.row_off(un, _h * HALF + Rr[_i]) + (unsigned)Cc[_i] * 2u; } } while (0)
#define G8_STAGE_A(bufoff, gb, vo, h) do { if (GATHER) { G8_STAGE(bufoff, gb, vo[h]); } else { G8_STAGE(bufoff, (gb) + (h) * hstep, voffA); } } while (0)
    Unit cur, nxt; int ui = 0;
    if (!S.next(0, cur)) return;
    f32x4 acc[2][2][4][2];
#pragma unroll
    for (int a = 0; a < 2; ++a)
#pragma unroll
        for (int b = 0; b < 2; ++b)
#pragma unroll
            for (int m = 0; m < 4; ++m)
#pragma unroll
                for (int n = 0; n < 2; ++n) acc[a][b][m][n] = (f32x4){0.f, 0.f, 0.f, 0.f};
    bf16x8 At[4][2], B0[2][2], B1[2][2];
    unsigned cvA[2][2], nvA[2][2];
    G8_AOFF(cvA, cur);
    const char* cA = cur.A; const char* cB = cur.B;
    G8_STAGE(G8_SB(0, 0), cB, voffB); G8_STAGE_A(G8_SA(0, 0), cA, cvA, 0); G8_STAGE(G8_SB(0, 1), cB + hstep, voffB); G8_STAGE_A(G8_SA(0, 1), cA, cvA, 1);
    if (wr == 1) G8_BAR;
    G8_WAIT_V(4); G8_BAR;
    G8_STAGE(G8_SB(1, 0), cB + kstep, voffB); G8_STAGE_A(G8_SA(1, 0), cA + kstep, cvA, 0); G8_STAGE(G8_SB(1, 1), cB + hstep + kstep, voffB);
    G8_WAIT_V(6); G8_BAR;
    for (;;) {
        const bool has_next = S.next(ui + 1, nxt);
        const char* nA = has_next ? nxt.A : cA; const char* nB = has_next ? nxt.B : cB;
        if (GATHER) {
            if (has_next) { G8_AOFF(nvA, nxt); } else {
#pragma unroll
                for (int h = 0; h < 2; ++h)
#pragma unroll
                    for (int i = 0; i < 2; ++i) nvA[h][i] = cvA[h][i];
            }
        }
        for (int t = 0; t < nt; t += 2) {
            const bool last = (t == nt - 2);
            const char* a1 = cA + (size_t)(t + 1) * kstep;
            const char* a2 = last ? nA : cA + (size_t)(t + 2) * kstep; const char* b2 = last ? nB : cB + (size_t)(t + 2) * kstep;
            const char* a3 = a2 + kstep; const char* b3 = b2 + kstep;

            G8_LDB(B0, 0, 0); G8_SCHED; G8_LDA(At, 0, 0); G8_STAGE_A(G8_SA(1, 1), a1, cvA, 1);
            if (GATHER && last) {
#pragma unroll
                for (int h = 0; h < 2; ++h)
#pragma unroll
                    for (int i = 0; i < 2; ++i) cvA[h][i] = nvA[h][i];
            }
            G8_WAIT_L(8); G8_BAR; G8_WAIT_L(0); G8_MMA(0, 0, At, B0); G8_BAR; G8_SCHED;
            G8_LDB(B1, 0, 1); G8_STAGE(G8_SB(0, 0), b2, voffB);
            G8_BAR; G8_WAIT_L(0); G8_MMA(0, 1, At, B1); G8_BAR;
            G8_LDA(At, 0, 1); G8_STAGE_A(G8_SA(0, 0), a2, cvA, 0);
            G8_BAR; G8_WAIT_L(0); G8_MMA(1, 0, At, B0); G8_BAR; G8_SCHED;
            G8_STAGE(G8_SB(0, 1), b2 + hstep, voffB);
            G8_WAIT_V(6); G8_BAR; G8_MMA(1, 1, At, B1); G8_BAR;
            G8_LDB(B0, 1, 0); G8_SCHED; G8_LDA(At, 1, 0); G8_STAGE_A(G8_SA(0, 1), a2, cvA, 1);
            G8_WAIT_L(8); G8_BAR; G8_WAIT_L(0); G8_MMA(0, 0, At, B0); G8_BAR; G8_SCHED;
            G8_LDB(B1, 1, 1); G8_STAGE(G8_SB(1, 0), b3, voffB);
            G8_BAR; G8_WAIT_L(0); G8_MMA(0, 1, At, B1); G8_BAR;
            G8_LDA(At, 1, 1); G8_STAGE_A(G8_SA(1, 0), a3, cvA, 0);
            G8_BAR; G8_WAIT_L(0); G8_MMA(1, 0, At, B0); G8_BAR; G8_SCHED;
            G8_STAGE(G8_SB(1, 1), b3 + hstep, voffB);
            G8_WAIT_V(6); G8_BAR; G8_MMA(1, 1, At, B1); G8_BAR;
        }
        { int fr2 = fr, fq2 = fq; asm volatile("" : "+v"(fr2), "+v"(fq2)); E(acc, cur, wr, wc, fr2, fq2); }
        if (!has_next) break;
#pragma unroll
        for (int a = 0; a < 2; ++a)
#pragma unroll
            for (int b = 0; b < 2; ++b)
#pragma unroll
                for (int m = 0; m < 4; ++m)
#pragma unroll
                    for (int n = 0; n < 2; ++n) acc[a][b][m][n] = (f32x4){0.f, 0.f, 0.f, 0.f};
        cur = nxt; cA = nA; cB = nB; ++ui;
    }
    G8_WAIT_V(0);
    if (wr == 0) G8_BAR;
    G8_BAR;
#undef G8_SA
#undef G8_SB
#undef G8_STAGE
#undef G8_LDA
#undef G8_LDB
#undef G8_MMA
#undef G8_WAIT_V
#undef G8_WAIT_L
#undef G8_BAR
#undef G8_SCHED
#undef G8_AOFF
#undef G8_STAGE_A
}
}

constexpr int MFULL = 64, M0_LEFT = MFULL * 256;
struct EpiStore {
    static constexpr bool PERM = true;
    bf16_t* O; int ldc; bool sig;
    DI void operator()(const f32x4 (&acc)[2][2][4][2], const g8::Unit& u, int wr, int wc, int fr, int fq) const {
#pragma unroll
        for (int ai = 0; ai < 2; ++ai)
#pragma unroll
            for (int m = 0; m < 4; ++m) {
                bf16_t* rowp = O + (size_t)(u.pm * 256 + ai * 128 + wr * 64 + m * 16 + fr) * ldc + u.pn * 256 + wc * 32 + 8 * fq;
#pragma unroll
                for (int bj = 0; bj < 2; ++bj) {
                    f32x4 v0 = acc[ai][bj][m][0], v1 = acc[ai][bj][m][1];
                    if (sig) {
#pragma unroll
                        for (int e = 0; e < 4; ++e) { v0[e] = sigmoidf_(v0[e]); v1[e] = sigmoidf_(v1[e]); }
                    }
                    *(u32x4*)(rowp + bj * 128) = (u32x4){pack2(v0[0], v0[1]), pack2(v0[2], v0[3]), pack2(v1[0], v1[1]), pack2(v1[2], v1[3])};
                }
            }
    }
};
DI int left_first(int units, int bid, int nb) { return (bid - units % nb + nb) % nb; }

constexpr int LEFT_LDS = 2 * (32 + 128) * LDT * 2;
template <class ARow, class Epi>
DI void gemm_left32(ARow arow, const bf16_t* __restrict__ Bt, int ldb, int K, int n0, char* smem, Epi epi) {
    const int tid = tid_(), lane = tid & 63, wid = __builtin_amdgcn_readfirstlane(tid >> 6), fr = lane & 15, fq = lane >> 4;
    bf16_t* As = (bf16_t*)smem;
    bf16_t* Bs = As + 2 * 32 * LDT;
    const int arow_i = tid >> 4, akc = (tid & 15) * 4;
    const bf16_t* ap = arow(arow_i) + akc;
    const bf16_t* bp[2]; int bso[2];
#pragma unroll
    for (int i = 0; i < 2; ++i) { const int cc = tid + NTHR * i, row = cc >> 3, kc = cc & 7; bp[i] = Bt + (size_t)(n0 + row) * ldb + kc * 8; bso[i] = row * LDT + kc * 8; }
    const int nit = K / 64;
    u32x2 ra[4]; u32x4 rb[4][2];
#define GL_LOAD(slot, it) do { if ((it) < nit) { ra[slot] = *(const u32x2*)(ap + (it) * 64); rb[slot][0] = *(const u32x4*)(bp[0] + (it) * 64); rb[slot][1] = *(const u32x4*)(bp[1] + (it) * 64); } } while (0)
#define GL_WRITE(slot, buf) do { *(u32x2*)(As + (buf) * 32 * LDT + arow_i * LDT + akc) = ra[slot]; *(u32x4*)(Bs + (buf) * 128 * LDT + bso[0]) = rb[slot][0]; *(u32x4*)(Bs + (buf) * 128 * LDT + bso[1]) = rb[slot][1]; } while (0)
    f32x4 acc[2] = {(f32x4){0.f, 0.f, 0.f, 0.f}, (f32x4){0.f, 0.f, 0.f, 0.f}};
    GL_LOAD(0, 0); GL_LOAD(1, 1); GL_LOAD(2, 2); GL_LOAD(3, 3);
    __syncthreads();
    GL_WRITE(0, 0);
    __syncthreads();
#define GL_STEP(slot, it) do { \
        GL_LOAD(slot, (it) + 4); \
        const int buf = (it) & 1; \
        _Pragma("unroll") for (int ks = 0; ks < 2; ++ks) { \
            const bf16x8 bf = *(const bf16x8*)(Bs + buf * 128 * LDT + (wid * 16 + fr) * LDT + ks * 32 + fq * 8); \
            _Pragma("unroll") for (int mt = 0; mt < 2; ++mt) { \
                const bf16x8 af = *(const bf16x8*)(As + buf * 32 * LDT + (mt * 16 + fr) * LDT + ks * 32 + fq * 8); \
                acc[mt] = __builtin_amdgcn_mfma_f32_16x16x32_bf16(bf, af, acc[mt], 0, 0, 0); } } \
        if ((it) + 1 < nit) { GL_WRITE(((slot) + 1) & 3, buf ^ 1); } \
        __syncthreads(); } while (0)
    for (int it = 0; it < nit; it += 4) {
        GL_STEP(0, it);
        if (it + 1 < nit) GL_STEP(1, it + 1);
        if (it + 2 < nit) GL_STEP(2, it + 2);
        if (it + 3 < nit) GL_STEP(3, it + 3);
    }
#undef GL_LOAD
#undef GL_WRITE
#undef GL_STEP
#pragma unroll
    for (int mt = 0; mt < 2; ++mt) epi(mt * 16 + fr, n0 + wid * 16 + fq * 4, acc[mt]);
}

DI void phase_inproj(const Params& p, int layer, int bid, int nb, char* smem) {
    const bf16_t* hb = p.hb; bf16_t* P = p.P;
    const bf16_t* Bt = p.WtIn + (size_t)layer * CIN * D;
    g8::DenseOrder S; S.init(hb, Bt, MFULL, CP / 256, D, nb, bid);
    g8::gemm8<false>((G8_LAS unsigned char*)smem, D, S, EpiStore{P, CP, false});
    {
        constexpr int UNITS = MFULL * (CP / 256);
        const int heavy = UNITS % nb;
        if (heavy > 0 && heavy < nb) { if (bid >= heavy) convert_experts(p, layer, 0, NE / 2, bid - heavy, nb - heavy, smem); }
        else convert_experts(p, layer, 0, NE / 2, bid, nb, smem);
    }
    bf16_t* G = p.gleft - (size_t)M0_LEFT * 2048; const bf16_t* Wg = p.WtIn + ((size_t)layer * CIN + CP) * D;
    for (int t = left_first(MFULL * (CP / 256), bid, nb); t < CP / 128 + 2048 / 128; t += nb) {
        if (t < CP / 128)
            gemm_left32([=](int r) { return hb + (size_t)(M0_LEFT + r) * D; }, Bt, D, D, t * 128, smem,
                        [=](int r, int c, f32x4 v) { *(u32x2*)(P + (size_t)(M0_LEFT + r) * CP + c) = (u32x2){pack2(v[0], v[1]), pack2(v[2], v[3])}; });
        else
            gemm_left32([=](int r) { return hb + (size_t)(M0_LEFT + r) * D; }, Wg, D, D, (t - CP / 128) * 128, smem,
                        [=](int r, int c, f32x4 v) { *(u32x2*)(G + (size_t)(M0_LEFT + r) * 2048 + c) = (u32x2){pack2(sigmoidf_(v[0]), sigmoidf_(v[1])), pack2(sigmoidf_(v[2]), sigmoidf_(v[3]))}; });
    }
}

constexpr int NCHUNK = (L + 63) / 64, NUNIT = NBATCH * HEADS * NCHUNK;
constexpr int LS = 72, RB = 64 * LS * 2;
constexpr int R1_LDS = 16 * RB + 4096 + 7168;
#define RBUF(i) ((bf16_t*)(smem + (i) * RB))
typedef float f32x16 __attribute__((ext_vector_type(16)));

template <int KK> DI f32x4 mm16(const bf16_t* F, int ldf, const bf16_t* S, int lds_, f32x4 acc, int lane) {
    const int fr = lane & 15, fq = lane >> 4;
#pragma unroll
    for (int ks = 0; ks < KK / 32; ++ks) {
        const bf16x8 f = *(const bf16x8*)(F + fr * ldf + ks * 32 + fq * 8);
        const bf16x8 g = *(const bf16x8*)(S + fr * lds_ + ks * 32 + fq * 8);
        acc = __builtin_amdgcn_mfma_f32_16x16x32_bf16(f, g, acc, 0, 0, 0);
    }
    return acc;
}
DI u32x2 pk4(f32x4 v) { return (u32x2){pack2(v[0], v[1]), pack2(v[2], v[3])}; }
DI f32x4 up4(u32x2 v) { return (f32x4){lo_bf(v[0]), hi_bf(v[0]), lo_bf(v[1]), hi_bf(v[1])}; }

typedef short s16x4 __attribute__((ext_vector_type(4)));
DI f32x4 mf16(u32x2 a, u32x2 b, f32x4 c) { return __builtin_amdgcn_mfma_f32_16x16x16bf16_1k(__builtin_bit_cast(s16x4, a), __builtin_bit_cast(s16x4, b), c, 0, 0, 0); }
DI void r1_diag_inverse(u32x2 mk, u32x2 mkt, bf16_t* Tb, int a, int lane) {
    const int fr = lane & 15, fq = lane >> 4;
    const f32x4 zero = (f32x4){0.f, 0.f, 0.f, 0.f};
    f32x4 eye;
#pragma unroll
    for (int e = 0; e < 4; ++e) eye[e] = (4 * fq + e == fr) ? 1.f : 0.f;
    f32x4 YT = up4(mkt) + eye;
    u32x2 yt = pk4(YT);
#pragma unroll
    for (int k = 0; k < 3; ++k) {
        const f32x4 s2 = mf16(mkt, mk, zero);
        if (k < 2) { const f32x4 s2t = mf16(mk, mkt, zero); mkt = pk4(s2t); }
        mk = pk4(s2);
        YT = mf16(mk, yt, YT);
        yt = pk4(YT);
    }
    *(u32x2*)(Tb + (16 * a + fr) * LS + 16 * a + 4 * fq) = yt;
}

template <int MODE> DI void phase_rwkv_r1(const Params& p, int layer, int bid, int nb, char* smem) {
    const int wv = __builtin_amdgcn_readfirstlane(tid_() >> 6);
    const f32x4 zero = (f32x4){0.f, 0.f, 0.f, 0.f};
    float* lwT = (float*)RBUF(4);
    float* aT = (float*)RBUF(6);
    float* gt = (float*)(smem + 16 * RB);
    float* gammaC = gt + 512;
    bf16_t* Xt0 = RBUF(14);
    bf16_t* Xt1 = RBUF(4);
    const bf16_t* WupT = p.WupT + (size_t)layer * 512 * 64, *AupT = p.AupT + (size_t)layer * 512 * 64, *GupT = p.GupT + (size_t)layer * 512 * 128;
    float* mu = (float*)(smem + 16 * RB + 4096);
    __syncthreads();
    for (int i = tid_(); i < RSW; i += NTHR) mu[i] = p.mu[(size_t)layer * RSW + i];
    for (int it = 0;; ++it) {
        const int tid = tid_(), lane = tid & 63, fr = lane & 15, fq = lane >> 4;
        int c, bh;
        if (MODE == 0) {
            const int Lq = it * nb + bid, q = Lq >> 3, cb = (q >> 3) * 8 + (Lq & 7);
            if (cb >= NBATCH * (NCHUNK - 1)) break;
            c = cb % (NCHUNK - 1); bh = (cb / (NCHUNK - 1)) * HEADS + (q & 7);
        } else {
            if (it > 0) break;
            c = NCHUNK - 1; bh = bid;
        }
        const int u = bh * NCHUNK + c, h = bh % HEADS, bb = bh / HEADS;
        const size_t tok0 = (size_t)bb * L + c * 64;
        bf16x8 fw[2][2], fa[2][2], fg[2][4];
#pragma unroll
        for (int t2 = 0; t2 < 2; ++t2) {
            const int tl = wv * 2 + t2, pt = tl >> 2, qt = tl & 3;
#pragma unroll
            for (int ks = 0; ks < 2; ++ks) {
                fw[t2][ks] = *(const bf16x8*)(WupT + (size_t)(h * 64 + qt * 16 + fr) * 64 + ks * 32 + fq * 8);
                fa[t2][ks] = *(const bf16x8*)(AupT + (size_t)(h * 64 + pt * 16 + fr) * 64 + ks * 32 + fq * 8);
            }
        }
        const int cgp = layer * 512 + h * 64 + (tid & 7) * 8, cge = layer * 512 + h * 64 + lane;
        const f32x4 pkk0 = *(const f32x4*)(p.k_k + cgp), pkk1 = *(const f32x4*)(p.k_k + cgp + 4), pka0 = *(const f32x4*)(p.k_a + cgp), pka1 = *(const f32x4*)(p.k_a + cgp + 4);
        const f32x4 prk0 = *(const f32x4*)(p.r_k + cgp), prk1 = *(const f32x4*)(p.r_k + cgp + 4);
        const float ekk = p.k_k[cge], eka = p.k_a[cge];
        float lw0[2]; f32x4 la0[2];
#pragma unroll
        for (int t2 = 0; t2 < 2; ++t2) {
            const int tl = wv * 2 + t2, pt = tl >> 2, qt = tl & 3;
            lw0[t2] = p.w0[layer * 512 + h * 64 + qt * 16 + fr];
            la0[t2] = *(const f32x4*)(p.a0 + layer * 512 + h * 64 + pt * 16 + fq * 4);
        }
        __syncthreads();
        {
            const int i = tid >> 3, c8 = (tid & 7) * 8, t = c * 64 + i;
            u32x4 curv[7], prvv[7];
#pragma unroll
            for (int it2 = 0; it2 < 7; ++it2) {
                const int col = (it2 == 0 ? RW_R + h * 64 : it2 == 1 ? RW_K + h * 64 : it2 == 2 ? RW_V + h * 64 : RW_WD + (it2 - 3) * 64) + c8;
                curv[it2] = (u32x4){0u, 0u, 0u, 0u}; prvv[it2] = (u32x4){0u, 0u, 0u, 0u};
                if (t < L) curv[it2] = *(const u32x4*)(p.P + (tok0 + i) * CP + OFF_RW + col);
                if (t < L && t > 0) prvv[it2] = *(const u32x4*)(p.P + (tok0 + i - 1) * CP + OFF_RW + col);
            }
#pragma unroll
            for (int it2 = 0; it2 < 7; ++it2) {
                const int col = (it2 == 0 ? RW_R + h * 64 : it2 == 1 ? RW_K + h * 64 : it2 == 2 ? RW_V + h * 64 : RW_WD + (it2 - 3) * 64) + c8;
                bf16_t* dst = it2 == 0 ? RBUF(8) + i * LS + c8 : it2 == 1 ? RBUF(9) + i * LS + c8 : it2 == 2 ? RBUF(10) + i * LS + c8
                            : it2 == 3 ? RBUF(0) + i * LS + c8 : it2 == 4 ? RBUF(1) + i * LS + c8 : RBUF(2) + i * 136 + (it2 - 5) * 64 + c8;
                const f32x4 m0 = *(const f32x4*)(mu + col), m1 = *(const f32x4*)(mu + col + 4);
                const u32x4 cur = curv[it2], prv = prvv[it2];
                float x[8];
#pragma unroll
                for (int j2 = 0; j2 < 4; ++j2) {
                    const float c0 = lo_bf(cur[j2]), c1 = hi_bf(cur[j2]), p0 = lo_bf(prv[j2]), p1 = hi_bf(prv[j2]);
                    const float mm0 = j2 < 2 ? m0[2 * j2] : m1[2 * j2 - 4], mm1 = j2 < 2 ? m0[2 * j2 + 1] : m1[2 * j2 - 3];
                    x[2 * j2] = c0 + (p0 - c0) * mm0; x[2 * j2 + 1] = c1 + (p1 - c1) * mm1;
                }
                if (it2 == 3) {
#pragma unroll
                    for (int j2 = 0; j2 < 8; ++j2) x[j2] = tanhf_(x[j2]);
                } else if (it2 >= 5) {
#pragma unroll
                    for (int j2 = 0; j2 < 8; ++j2) x[j2] = sigmoidf_(x[j2]);
                }
                *(u32x4*)dst = (u32x4){pack2(x[0], x[1]), pack2(x[2], x[3]), pack2(x[4], x[5]), pack2(x[6], x[7])};
            }
        }
#pragma unroll
        for (int t2 = 0; t2 < 2; ++t2)
#pragma unroll
            for (int ks = 0; ks < 4; ++ks) fg[t2][ks] = *(const bf16x8*)(GupT + (size_t)(h * 64 + ((wv * 2 + t2) >> 2) * 16 + fr) * 128 + ks * 32 + fq * 8);
        __syncthreads();
#pragma unroll
        for (int t2 = 0; t2 < 2; ++t2) {
            const int tl = wv * 2 + t2, pt = tl >> 2, qt = tl & 3;
            f32x4 aw = zero, aa = zero, ag = zero;
#pragma unroll
            for (int ks = 0; ks < 2; ++ks) {
                const bf16x8 xw = *(const bf16x8*)(RBUF(0) + (pt * 16 + fr) * LS + ks * 32 + fq * 8);
                aw = __builtin_amdgcn_mfma_f32_16x16x32_bf16(xw, fw[t2][ks], aw, 0, 0, 0);
                const bf16x8 xa = *(const bf16x8*)(RBUF(1) + (qt * 16 + fr) * LS + ks * 32 + fq * 8);
                aa = __builtin_amdgcn_mfma_f32_16x16x32_bf16(fa[t2][ks], xa, aa, 0, 0, 0);
            }
#pragma unroll
            for (int ks = 0; ks < 4; ++ks) {
                const bf16x8 xg = *(const bf16x8*)(RBUF(2) + (qt * 16 + fr) * 136 + ks * 32 + fq * 8);
                ag = __builtin_amdgcn_mfma_f32_16x16x32_bf16(fg[t2][ks], xg, ag, 0, 0, 0);
            }
            const int ch = qt * 16 + fr;
            const float w0 = lw0[t2];
            const f32x4 a0 = la0[t2];
            f32x4 lw, av;
#pragma unroll
            for (int e = 0; e < 4; ++e) { lw[e] = -DECAY_SCALE * sigmoidf_(w0 + aw[e]); av[e] = sigmoidf_(a0[e] + aa[e]); }
            *(f32x4*)(lwT + ch * 68 + pt * 16 + fq * 4) = lw;
            *(f32x4*)(aT + (qt * 16 + fr) * 68 + pt * 16 + fq * 4) = av;
            *(u32x2*)(p.GG + ((size_t)u * 64 + qt * 16 + fr) * 64 + pt * 16 + fq * 4) = pk4(ag);
        }
        __syncthreads();
        {
            const int i = tid >> 3, c8 = (tid & 7) * 8;
            const u32x4 xr = *(const u32x4*)(RBUF(8) + i * LS + c8), xk = *(const u32x4*)(RBUF(9) + i * LS + c8);
            const f32x4 a0 = *(const f32x4*)(aT + i * 68 + c8), a1 = *(const f32x4*)(aT + i * 68 + c8 + 4);
            const f32x4 kk0 = pkk0, kk1 = pkk1, ka0 = pka0, ka1 = pka1, rk0 = prk0, rk1 = prk1;
            float n2 = 0.f, bon = 0.f;
#pragma unroll
            for (int j = 0; j < 8; ++j) {
                const float r_ = (j & 1) ? hi_bf(xr[j >> 1]) : lo_bf(xr[j >> 1]), k_ = (j & 1) ? hi_bf(xk[j >> 1]) : lo_bf(xk[j >> 1]);
                const float a_ = j < 4 ? a0[j & 3] : a1[j & 3], kkc = j < 4 ? kk0[j & 3] : kk1[j & 3], kac = j < 4 ? ka0[j & 3] : ka1[j & 3], rkc = j < 4 ? rk0[j & 3] : rk1[j & 3];
                const float kkr = k_ * kkc;
                n2 += kkr * kkr;
                bon += r_ * (k_ * (1.0f + (a_ - 1.0f) * kac)) * rkc;
            }
            n2 = sum8(n2); bon = sum8(bon);
            if ((tid & 7) == 0) { gt[576 + i] = 1.0f / fmaxf(sqrtf(n2), 1e-12f); p.bonG[(size_t)u * 64 + i] = bon; }
        }
        __syncthreads();
        {
            const int ch = lane;
            float lw[8], av[8], cum[8];
            {
                const f32x4 l0 = *(const f32x4*)(lwT + ch * 68 + wv * 8), l1 = *(const f32x4*)(lwT + ch * 68 + wv * 8 + 4);
#pragma unroll
                for (int e = 0; e < 4; ++e) { lw[e] = l0[e]; lw[e + 4] = l1[e]; }
#pragma unroll
                for (int e = 0; e < 8; ++e) av[e] = aT[(wv * 8 + e) * 68 + ch];
            }
            float run = 0.f;
#pragma unroll
            for (int e = 0; e < 8; ++e) { run += lw[e]; cum[e] = run; }
            gt[wv * 64 + ch] = run;
            __syncthreads();
            float offs = 0.f, tot = 0.f;
#pragma unroll
            for (int g2 = 0; g2 < 8; ++g2) { const float gv = gt[g2 * 64 + ch]; offs += g2 < wv ? gv : 0.f; tot += gv; }
            if (wv == 0) gammaC[ch] = __expf(tot);
            const float kkc = ekk, kac = eka;
            float at_[8], kt_[8], bt_[8], vt_[8];
#pragma unroll
            for (int e = 0; e < 8; ++e) {
                const int i = wv * 8 + e;
                const float xr = bf2f(RBUF(8)[i * LS + ch]), xk = bf2f(RBUF(9)[i * LS + ch]), xv = bf2f(RBUF(10)[i * LS + ch]);
                const float cm = cum[e] + offs;
                const float kk = xk * kkc * gt[576 + i];
                const float kq = xk * (1.0f + (av[e] - 1.0f) * kac);
                if (c * 64 + i < L) p.orw[(tok0 + i) * 512 + h * 64 + ch] = RBUF(10)[i * LS + ch];
                const float eneg = __expf(-cm), epos = __expf(cm), eexc = __expf(cm - lw[e]);
                at_[e] = -kk * eexc; kt_[e] = kq * eneg; bt_[e] = kk * av[e] * eneg; vt_[e] = xv;
                RBUF(3)[i * LS + ch] = f2bf(xr * epos);
            }
#pragma unroll
            for (int e = 0; e < 8; ++e) {
                const int i = wv * 8 + e;
                RBUF(0)[i * LS + ch] = f2bf(at_[e]); RBUF(1)[i * LS + ch] = f2bf(kt_[e]); RBUF(2)[i * LS + ch] = f2bf(bt_[e]);
            }
            *(u32x4*)(RBUF(11) + ch * LS + wv * 8) = (u32x4){pack2(kt_[0], kt_[1]), pack2(kt_[2], kt_[3]), pack2(kt_[4], kt_[5]), pack2(kt_[6], kt_[7])};
            *(u32x4*)(RBUF(12) + ch * LS + wv * 8) = (u32x4){pack2(bt_[0], bt_[1]), pack2(bt_[2], bt_[3]), pack2(bt_[4], bt_[5]), pack2(bt_[6], bt_[7])};
            *(u32x4*)(RBUF(13) + ch * LS + wv * 8) = (u32x4){pack2(vt_[0], vt_[1]), pack2(vt_[2], vt_[3]), pack2(vt_[4], vt_[5]), pack2(vt_[6], vt_[7])};
            *(u32x4*)(Xt0 + ch * LS + wv * 8) = (u32x4){pack2(at_[0], at_[1]), pack2(at_[2], at_[3]), pack2(at_[4], at_[5]), pack2(at_[6], at_[7])};
        }
        __syncthreads();
#define R1_LDF(buf, row0, ks) (*(const bf16x8*)((buf) + ((row0) + fr) * LS + (ks) * 32 + fq * 8))
        {
            const int qt = wv & 3, qi = qt * 16 + fr, pt0 = wv >> 2;
            bf16x8 sA[2], sR[2], fK[2][2], fB[2][2];
#pragma unroll
            for (int ks = 0; ks < 2; ++ks) { sA[ks] = R1_LDF(RBUF(0), qt * 16, ks); sR[ks] = R1_LDF(RBUF(3), qt * 16, ks); }
#pragma unroll
            for (int rep = 0; rep < 2; ++rep) {
                const int pt = pt0 + 2 * rep;
                if (pt <= qt) {
#pragma unroll
                    for (int ks = 0; ks < 2; ++ks) { fK[rep][ks] = R1_LDF(RBUF(1), pt * 16, ks); fB[rep][ks] = R1_LDF(RBUF(2), pt * 16, ks); }
                }
            }
#pragma unroll
            for (int rep = 0; rep < 2; ++rep) {
                const int pt = pt0 + 2 * rep;
                f32x4 acc[4] = {zero, zero, zero, zero};
                if (pt <= qt) {
#pragma unroll
                    for (int ks = 0; ks < 2; ++ks) {
                        acc[0] = __builtin_amdgcn_mfma_f32_16x16x32_bf16(fK[rep][ks], sA[ks], acc[0], 0, 0, 0);
                        acc[1] = __builtin_amdgcn_mfma_f32_16x16x32_bf16(fB[rep][ks], sA[ks], acc[1], 0, 0, 0);
                        acc[2] = __builtin_amdgcn_mfma_f32_16x16x32_bf16(fK[rep][ks], sR[ks], acc[2], 0, 0, 0);
                        acc[3] = __builtin_amdgcn_mfma_f32_16x16x32_bf16(fB[rep][ks], sR[ks], acc[3], 0, 0, 0);
                    }
                }
#pragma unroll
                for (int prod = 0; prod < 4; ++prod) {
                    bf16_t* O = prod == 0 ? RBUF(6) : prod == 1 ? RBUF(7) : prod == 2 ? RBUF(9) : RBUF(10);
#pragma unroll
                    for (int e = 0; e < 4; ++e) {
                        const int pi = pt * 16 + fq * 4 + e;
                        const bool keep = prod < 2 ? pi < qi : pi <= qi;
                        acc[prod][e] = keep ? acc[prod][e] : 0.f;
                    }
                    *(u32x2*)(O + qi * LS + pt * 16 + fq * 4) = pk4(acc[prod]);
                }
                if (pt == qt) {
                    f32x4 am = zero;
#pragma unroll
                    for (int ks = 0; ks < 2; ++ks) am = __builtin_amdgcn_mfma_f32_16x16x32_bf16(sA[ks], fB[rep][ks], am, 0, 0, 0);
#pragma unroll
                    for (int e = 0; e < 4; ++e) am[e] = (fq * 4 + e > fr) ? am[e] : 0.f;
                    r1_diag_inverse(pk4(am), pk4(acc[1]), RBUF(4), pt, lane);
                }
            }
        }
        __syncthreads();
        f32x4 X[4];
        if (wv < 4) {
            const bf16_t* xp = Xt0 + (wv * 16 + fr) * LS + fq * 4;
#pragma unroll
            for (int a = 0; a < 4; ++a) X[a] = up4(*(const u32x2*)(xp + 16 * a));
        } else {
            const bf16_t* Nr = RBUF(6) + fr * LS + fq * 4;
            const bf16_t* vp = RBUF(13) + ((wv - 4) * 16 + fr) * LS + fq * 4;
            u32x2 vb[4], nn[10];
#pragma unroll
            for (int b = 0; b < 4; ++b) vb[b] = *(const u32x2*)(vp + 16 * b);
#pragma unroll
            for (int a = 0; a < 4; ++a)
#pragma unroll
                for (int b = 0; b <= a; ++b) nn[a * (a + 1) / 2 + b] = *(const u32x2*)(Nr + 16 * a * LS + 16 * b);
#pragma unroll
            for (int a = 0; a < 4; ++a) {
                f32x4 acc = zero;
#pragma unroll
                for (int b = 0; b <= a; ++b) acc = mf16(nn[a * (a + 1) / 2 + b], vb[b], acc);
                X[a] = acc;
            }
        }
        {
            const bf16_t* Tb = RBUF(4), *Mr = RBUF(7);
            bf16_t* xp = Xt0 + (wv * 16 + fr) * LS + fq * 4;
#define FS_M(a, b) (*(const u32x2*)(Mr + (16 * (a) + fr) * LS + 16 * (b) + 4 * fq))
#define FS_D(a)    (*(const u32x2*)(Tb + (16 * (a) + fr) * LS + 16 * (a) + 4 * fq))
            const u32x2 d0 = FS_D(0), d1 = FS_D(1), d2 = FS_D(2), d3 = FS_D(3);
            const u32x2 m10 = FS_M(1, 0), m20 = FS_M(2, 0), m21 = FS_M(2, 1), m30 = FS_M(3, 0), m31 = FS_M(3, 1), m32 = FS_M(3, 2);
            const u32x2 y0 = pk4(mf16(d0, pk4(X[0]), zero));
            const f32x4 t1 = mf16(m10, y0, X[1]);
            f32x4 t2 = mf16(m20, y0, X[2]), t3 = mf16(m30, y0, X[3]);
            const u32x2 y1 = pk4(mf16(d1, pk4(t1), zero));
            t2 = mf16(m21, y1, t2); t3 = mf16(m31, y1, t3);
            const u32x2 y2 = pk4(mf16(d2, pk4(t2), zero));
            t3 = mf16(m32, y2, t3);
            const u32x2 y3 = pk4(mf16(d3, pk4(t3), zero));
            *(u32x2*)xp = y0; *(u32x2*)(xp + 16) = y1; *(u32x2*)(xp + 32) = y2; *(u32x2*)(xp + 48) = y3;
        }
        __syncthreads();
        {
            const int qt = wv & 3, qi = qt * 16 + fr, pt0 = wv >> 2;
            bf16x8 sB12[2], sB13[2], sX1[2], sB10[2], sB9[2], fX0[2][2], fB11[2][2], fB12[2][2], fB13[2][2], fX1[2][2];
#pragma unroll
            for (int ks = 0; ks < 2; ++ks) {
                sB12[ks] = R1_LDF(RBUF(12), qt * 16, ks); sB13[ks] = R1_LDF(RBUF(13), qt * 16, ks); sX1[ks] = R1_LDF(Xt0, 64 + qt * 16, ks);
                sB10[ks] = R1_LDF(RBUF(10), qt * 16, ks); sB9[ks] = R1_LDF(RBUF(9), qt * 16, ks);
            }
#pragma unroll
            for (int rep = 0; rep < 2; ++rep)
#pragma unroll
                for (int ks = 0; ks < 2; ++ks) {
                    const int pt = pt0 + 2 * rep;
                    fX0[rep][ks] = R1_LDF(Xt0, pt * 16, ks); fB11[rep][ks] = R1_LDF(RBUF(11), pt * 16, ks); fB12[rep][ks] = R1_LDF(RBUF(12), pt * 16, ks);
                    fB13[rep][ks] = R1_LDF(RBUF(13), pt * 16, ks); fX1[rep][ks] = R1_LDF(Xt0, 64 + pt * 16, ks);
                }
            const float gcq = gammaC[qi];
#pragma unroll
            for (int rep = 0; rep < 2; ++rep) {
                const int pt = pt0 + 2 * rep, pi0 = pt * 16 + fq * 4;
                const size_t go = ((size_t)u * 64 + qi) * 64 + pi0;
                const f32x4 rr = up4(*(const u32x2*)(RBUF(3) + qi * LS + pi0));
                const f32x4 gcp = *(const f32x4*)(gammaC + pi0);
                f32x4 aP = zero, aQ = zero, aR = zero, aY = zero;
#pragma unroll
                for (int ks = 0; ks < 2; ++ks) {
                    aP = __builtin_amdgcn_mfma_f32_16x16x32_bf16(fX0[rep][ks], sB12[ks], aP, 0, 0, 0);
                    aQ = __builtin_amdgcn_mfma_f32_16x16x32_bf16(fB11[rep][ks], sB13[ks], aQ, 0, 0, 0);
                    aR = __builtin_amdgcn_mfma_f32_16x16x32_bf16(fX0[rep][ks], sB10[ks], aR, 0, 0, 0);
                    aY = __builtin_amdgcn_mfma_f32_16x16x32_bf16(fB13[rep][ks], sB9[ks], aY, 0, 0, 0);
                }
#pragma unroll
                for (int ks = 0; ks < 2; ++ks) {
                    aQ = __builtin_amdgcn_mfma_f32_16x16x32_bf16(fB12[rep][ks], sX1[ks], aQ, 0, 0, 0);
                    aY = __builtin_amdgcn_mfma_f32_16x16x32_bf16(fX1[rep][ks], sB10[ks], aY, 0, 0, 0);
                }
                {
#pragma unroll
                    for (int e = 0; e < 4; ++e) aP[e] = (aP[e] + (pi0 + e == qi ? 1.f : 0.f)) * gcq;
                    const size_t d = (((size_t)u * 8 + (qi >> 4) * 2 + (pi0 >> 5)) * 64 + (qi & 15) + 16 * ((pi0 >> 2) & 3)) * 8 + ((pi0 >> 4) & 1) * 4;
                    *(u32x2*)(p.PcG + d) = pk4(aP);
                }
                {
#pragma unroll
                    for (int e = 0; e < 4; ++e) aQ[e] *= gcp[e];
                    const size_t d = (((size_t)u * 4 + (qi >> 4)) * 64 + (qi & 15) + 16 * ((pi0 >> 2) & 3)) * 16 + (pi0 >> 4) * 4;
                    *(u32x2*)(p.QcG + d) = pk4(aQ);
                }
                {
#pragma unroll
                    for (int e = 0; e < 4; ++e) aR[e] += rr[e];
                    *(u32x2*)(p.RhG + go) = pk4(aR);
                }
                *(u32x2*)(p.Y0G + go) = pk4(aY);
            }
        }
    }
}

struct R2Set { u32x4 a[8]; u32x4 q[2]; };
DI void r2_load(R2Set& st, const Params& p, size_t u, int lane, int vq) {
    const bf16_t* qg = p.QcG + ((u * 4 + vq) * 64 + lane) * 16;
    st.q[0] = *(const u32x4*)qg; st.q[1] = *(const u32x4*)(qg + 8);
#pragma unroll
    for (int f = 0; f < 8; ++f) st.a[f] = *(const u32x4*)(p.PcG + ((u * 8 + f) * 64 + lane) * 8);
}
DI void r2_step(f32x4 (&S)[4], const R2Set& st, const Params& p, size_t u, int lane, int vq, bool last) {
    const u32x4 b0 = (u32x4){pack2(S[0][0], S[0][1]), pack2(S[0][2], S[0][3]), pack2(S[1][0], S[1][1]), pack2(S[1][2], S[1][3])};
    const u32x4 b1 = (u32x4){pack2(S[2][0], S[2][1]), pack2(S[2][2], S[2][3]), pack2(S[3][0], S[3][1]), pack2(S[3][2], S[3][3])};
    bf16_t* sg = p.SG + ((u * 4 + vq) * 64 + lane) * 16;
    *(u32x4*)sg = b0; *(u32x4*)(sg + 8) = b1;
    if (last) return;
#pragma unroll
    for (int kt = 0; kt < 4; ++kt) {
        const u32x4 qq = st.q[kt >> 1];
        const unsigned w0 = qq[(kt & 1) * 2], w1 = qq[(kt & 1) * 2 + 1];
        S[kt] = (f32x4){lo_bf(w0), hi_bf(w0), lo_bf(w1), hi_bf(w1)};
    }
    const bf16x8 f0 = __builtin_bit_cast(bf16x8, b0), f1 = __builtin_bit_cast(bf16x8, b1);
#pragma unroll
    for (int kt = 0; kt < 4; ++kt) {
        S[kt] = __builtin_amdgcn_mfma_f32_16x16x32_bf16(__builtin_bit_cast(bf16x8, st.a[kt * 2]), f0, S[kt], 0, 0, 0);
        S[kt] = __builtin_amdgcn_mfma_f32_16x16x32_bf16(__builtin_bit_cast(bf16x8, st.a[kt * 2 + 1]), f1, S[kt], 0, 0, 0);
    }
}
DI void phase_rwkv_r2(const Params& p, int chain) {
    const int lane = tid_() & 63;
    const int bh = chain >> 2, vq = chain & 3;
    const size_t u0 = (size_t)bh * NCHUNK;
    f32x4 S[4];
#pragma unroll
    for (int kt = 0; kt < 4; ++kt) S[kt] = (f32x4){0.f, 0.f, 0.f, 0.f};
    R2Set A, B, C, E;
    r2_load(A, p, u0, lane, vq); r2_load(B, p, u0 + 1, lane, vq); r2_load(C, p, u0 + 2, lane, vq); r2_load(E, p, u0 + 3, lane, vq);
#define R2_ONE(SET, cc) do { r2_step(S, SET, p, u0 + (cc), lane, vq, (cc) == NCHUNK - 1); if ((cc) + 4 < NCHUNK - 1) r2_load(SET, p, u0 + (cc) + 4, lane, vq); } while (0)
#pragma unroll 1
    for (int c = 0; c < NCHUNK; c += 4) {
        R2_ONE(A, c);
        if (c == NCHUNK - 1) break;
        R2_ONE(B, c + 1);
        R2_ONE(C, c + 2);
        R2_ONE(E, c + 3);
    }
#undef R2_ONE
}

DI void phase_rwkv_r3(const Params& p, int layer, int bid, int nb) {
    const int tid = tid_(), lane = tid & 63, wv = __builtin_amdgcn_readfirstlane(tid >> 6), fr = lane & 15, fq = lane >> 4;
    constexpr int TPB = L / 16;
    for (int task = bid * 8 + wv; task < NBATCH * HEADS * TPB; task += nb * 8) {
        const int bh = task / TPB, tt = task % TPB, c = tt >> 2, it = tt & 3, u = bh * NCHUNK + c;
        const int h = bh % HEADS, bb = bh / HEADS;
        const int i = it * 16 + fr, t = c * 64 + i;
        const bool live = t < L;
        const size_t tok = (size_t)bb * L + (live ? t : 0);
        bf16x8 sf[2];
#pragma unroll
        for (int ks = 0; ks < 2; ++ks) sf[ks] = *(const bf16x8*)(p.RhG + ((size_t)u * 64 + i) * 64 + ks * 32 + fq * 8);
        u32x2 s0[4][2], s1[4][2], y0[4], xvv[4], gv[4];
#pragma unroll
        for (int vt = 0; vt < 4; ++vt) {
            const int vv = vt * 16 + fr;
#pragma unroll
            for (int ks = 0; ks < 2; ++ks) {
                const bf16_t* sp = p.SG + (((size_t)u * 4 + vt) * 64 + fr + 32 * (fq & 1)) * 16 + (2 * ks + (fq >> 1)) * 4;
                s0[vt][ks] = *(const u32x2*)sp; s1[vt][ks] = *(const u32x2*)(sp + 16 * 16);
                (void)vv;
            }
            y0[vt] = *(const u32x2*)(p.Y0G + ((size_t)u * 64 + i) * 64 + vt * 16 + fq * 4);
            xvv[vt] = *(const u32x2*)(p.orw + tok * 512 + h * 64 + vt * 16 + fq * 4);
            gv[vt] = *(const u32x2*)(p.GG + ((size_t)u * 64 + i) * 64 + vt * 16 + fq * 4);
        }
        const float bon = p.bonG[(size_t)u * 64 + i];
        f32x4 y[4];
#pragma unroll
        for (int vt = 0; vt < 4; ++vt) {
            y[vt] = up4(y0[vt]);
#pragma unroll
            for (int ks = 0; ks < 2; ++ks) {
                const bf16x8 f = __builtin_bit_cast(bf16x8, ((u32x4){s0[vt][ks][0], s0[vt][ks][1], s1[vt][ks][0], s1[vt][ks][1]}));
                y[vt] = __builtin_amdgcn_mfma_f32_16x16x32_bf16(f, sf[ks], y[vt], 0, 0, 0);
            }
        }
        float s = 0.f;
#pragma unroll
        for (int vt = 0; vt < 4; ++vt) s += (y[vt][0] + y[vt][1]) + (y[vt][2] + y[vt][3]);
        s += __shfl_xor(s, 16); s += __shfl_xor(s, 32);
        const float mean = s * (1.0f / 64.f);
        float q = 0.f;
#pragma unroll
        for (int vt = 0; vt < 4; ++vt)
#pragma unroll
            for (int e = 0; e < 4; ++e) { y[vt][e] -= mean; q += y[vt][e] * y[vt][e]; }
        q += __shfl_xor(q, 16); q += __shfl_xor(q, 32);
        const float rstd = rsqrtf(q * (1.0f / 64.f) + 64e-5f);
        if (live) {
#pragma unroll
            for (int vt = 0; vt < 4; ++vt) {
                const int cg = h * 64 + vt * 16 + fq * 4;
                const f32x4 xv = up4(xvv[vt]), g = up4(gv[vt]);
                const f32x4 lg = *(const f32x4*)(p.lnx_g + layer * 512 + cg), lb = *(const f32x4*)(p.lnx_b + layer * 512 + cg);
                f32x4 o;
#pragma unroll
                for (int e = 0; e < 4; ++e) o[e] = (y[vt][e] * rstd * lg[e] + lb[e] + bon * xv[e]) * g[e];
                *(u32x2*)(p.orw + tok * 512 + cg) = pk4(o);
            }
        }
    }
}

constexpr int SB_LDS = 4 * RB + 64;
DI void phase_sb(const Params& p, int bid0, int nb, char* smem) {
    const int tid = tid_(), lane = tid & 63, wv = __builtin_amdgcn_readfirstlane(tid >> 6), fr = lane & 15, fq = lane >> 4;
    bf16_t* Ks0 = (bf16_t*)smem;
    bf16_t* Vt0 = Ks0 + 2 * 64 * LS;
    int* flags = (int*)(smem + 4 * RB);
    bf16x8 tri[4][2];
#pragma unroll
    for (int st = 0; st < 4; ++st)
#pragma unroll
        for (int k2 = 0; k2 < 2; ++k2)
#pragma unroll
            for (int jj = 0; jj < 8; ++jj) tri[st][k2][jj] = (32 * k2 + 16 * (jj >> 2) + 4 * fq + (jj & 3) > 16 * st + fr) ? (short)0x3F80 : (short)0;
    constexpr int NQB = (L + 127) / 128;
    const int ldkey = tid >> 3, lddc = (tid & 7) * 8;
    for (int u = bid0; u < NBATCH * HEADS * NQB; u += nb) {
        const int bh = u % (NBATCH * HEADS), b = bh / HEADS, h = bh % HEADS, q0 = (NQB - 1 - u / (NBATCH * HEADS)) * 128;
        const int qlo = q0 + 16 * wv, query = qlo + fr;
        const size_t tokb = (size_t)b * L;
        bf16x8 qf[2];
#pragma unroll
        for (int ks = 0; ks < 2; ++ks) qf[ks] = *(const bf16x8*)(p.P + (tokb + query) * CP + OFF_Q + h * 64 + ks * 32 + fq * 8);
        const int qmax = (q0 + 127 < L - 1) ? q0 + 127 : L - 1;
        int kt = (qmax - 1) >> 6;
        float R = 0.f;
        f32x4 ot[4];
#pragma unroll
        for (int dt = 0; dt < 4; ++dt) ot[dt] = (f32x4){0.f, 0.f, 0.f, 0.f};
        bool done = qlo >= L;
        u32x4 kreg, vreg;
        {
            const int s = kt * 64 + ldkey;
            const bf16_t* src = p.P + (tokb + s) * CP + h * 64 + lddc;
            kreg = s < L ? *(const u32x4*)(src + OFF_K) : (u32x4){0u, 0u, 0u, 0u};
            vreg = s < L ? *(const u32x4*)(src + OFF_V) : (u32x4){0u, 0u, 0u, 0u};
        }
        const int vsw = (tid & 7) << 2;
        __syncthreads();
        {
            *(u32x4*)(Ks0 + ldkey * LS + lddc) = kreg;
#pragma unroll
            for (int j = 0; j < 4; ++j) { Vt0[(lddc + 2 * j) * LS + (ldkey ^ vsw)] = (bf16_t)(vreg[j] & 0xFFFFu); Vt0[(lddc + 2 * j + 1) * LS + (ldkey ^ vsw)] = (bf16_t)(vreg[j] >> 16); }
        }
        __syncthreads();
        for (int itile = 0;; ++itile) {
            const bf16_t* Ks = Ks0 + (itile & 1) * 64 * LS; const bf16_t* Vt = Vt0 + (itile & 1) * 64 * LS;
            if (kt > 0) {
                const int s = (kt - 1) * 64 + ldkey;
                const bf16_t* src = p.P + (tokb + s) * CP + h * 64 + lddc;
                kreg = *(const u32x4*)(src + OFF_K); vreg = *(const u32x4*)(src + OFF_V);
            }
            if (!done && kt * 64 < qlo + 15) {
                f32x4 uu[4], lsp[4];
                float tot = 0.f;
                const bool full = kt * 64 + 63 < qlo;
#pragma unroll
                for (int kk = 0; kk < 4; ++kk) {
                    f32x4 z = (f32x4){0.f, 0.f, 0.f, 0.f};
#pragma unroll
                    for (int ks = 0; ks < 2; ++ks) {
                        const bf16x8 f = *(const bf16x8*)(Ks + (16 * kk + fr) * LS + ks * 32 + fq * 8);
                        z = __builtin_amdgcn_mfma_f32_16x16x32_bf16(f, qf[ks], z, 0, 0, 0);
                    }
#pragma unroll
                    for (int e = 0; e < 4; ++e) {
                        const float zz = z[e] * 0.18033688011112042f;
                        const float lsneg = -(fmaxf(zz, 0.f) + __builtin_amdgcn_logf(1.0f + __builtin_amdgcn_exp2f(-fabsf(zz))));
                        if (full) { uu[kk][e] = lsneg; lsp[kk][e] = lsneg + zz; }
                        else {
                            const bool valid = kt * 64 + 16 * kk + 4 * fq + e < query;
                            uu[kk][e] = valid ? lsneg : 0.f;
                            lsp[kk][e] = valid ? lsneg + zz : -1.0e30f;
                        }
                        tot += uu[kk][e];
                    }
                }
                tot += __shfl_xor(tot, 16); tot += __shfl_xor(tot, 32);
                f32x4 rest[4];
#pragma unroll
                for (int st = 0; st < 4; ++st) rest[st] = (f32x4){0.f, 0.f, 0.f, 0.f};
#pragma unroll
                for (int k2 = 0; k2 < 2; ++k2) {
                    u32x4 hi, lo;
#pragma unroll
                    for (int t2 = 0; t2 < 2; ++t2) {
                        const f32x4 a = uu[2 * k2 + t2];
                        const unsigned h0 = pack2(a[0], a[1]), h1 = pack2(a[2], a[3]);
                        hi[2 * t2] = h0; hi[2 * t2 + 1] = h1;
                        lo[2 * t2] = pack2(a[0] - lo_bf(h0), a[1] - hi_bf(h0)); lo[2 * t2 + 1] = pack2(a[2] - lo_bf(h1), a[3] - hi_bf(h1));
                    }
                    const bf16x8 fh = __builtin_bit_cast(bf16x8, hi), fl = __builtin_bit_cast(bf16x8, lo);
#pragma unroll
                    for (int st = 0; st < 4; ++st) {
                        rest[st] = __builtin_amdgcn_mfma_f32_16x16x32_bf16(tri[st][k2], fh, rest[st], 0, 0, 0);
                        rest[st] = __builtin_amdgcn_mfma_f32_16x16x32_bf16(tri[st][k2], fl, rest[st], 0, 0, 0);
                    }
                }
                bf16x8 af[2];
#pragma unroll
                for (int k2 = 0; k2 < 2; ++k2) {
                    u32x4 pk;
#pragma unroll
                    for (int t2 = 0; t2 < 2; ++t2) {
                        const int kk = 2 * k2 + t2;
                        float a4[4];
#pragma unroll
                        for (int e = 0; e < 4; ++e) a4[e] = __builtin_amdgcn_exp2f(lsp[kk][e] + R + rest[kk][e]);
                        pk[2 * t2] = pack2(a4[0], a4[1]); pk[2 * t2 + 1] = pack2(a4[2], a4[3]);
                    }
                    af[k2] = __builtin_bit_cast(bf16x8, pk);
                }
                R += tot;
#pragma unroll
                for (int dt = 0; dt < 4; ++dt)
#pragma unroll
                    for (int k2 = 0; k2 < 2; ++k2) {
                        const int dsw = ((2 * dt + (fr >> 3)) & 7) << 2;
                        const bf16_t* vrow = Vt + (16 * dt + fr) * LS;
                        const u32x2 v0 = *(const u32x2*)(vrow + ((32 * k2 + 4 * fq) ^ dsw)), v1 = *(const u32x2*)(vrow + ((32 * k2 + 16 + 4 * fq) ^ dsw));
                        const bf16x8 f = __builtin_bit_cast(bf16x8, ((u32x4){v0[0], v0[1], v1[0], v1[1]}));
                        ot[dt] = __builtin_amdgcn_mfma_f32_16x16x32_bf16(f, af[k2], ot[dt], 0, 0, 0);
                    }
                done = __all((R < -150.1f) || (query >= L));
            }
            if (kt > 0) {
                bf16_t* Kn = Ks0 + ((itile & 1) ^ 1) * 64 * LS; bf16_t* Vn = Vt0 + ((itile & 1) ^ 1) * 64 * LS;
                *(u32x4*)(Kn + ldkey * LS + lddc) = kreg;
#pragma unroll
                for (int j = 0; j < 4; ++j) { Vn[(lddc + 2 * j) * LS + (ldkey ^ vsw)] = (bf16_t)(vreg[j] & 0xFFFFu); Vn[(lddc + 2 * j + 1) * LS + (ldkey ^ vsw)] = (bf16_t)(vreg[j] >> 16); }
            }
            if (lane == 0) flags[(itile & 1) * 8 + wv] = done ? 1 : 0;
            __syncthreads();
            int alld = 1;
#pragma unroll
            for (int w = 0; w < 8; ++w) alld &= flags[(itile & 1) * 8 + w];
            if (alld || kt == 0) break;
            --kt;
        }
        if (query < L) {
#pragma unroll
            for (int dt = 0; dt < 4; ++dt) *(u32x2*)(p.osb + (tokb + query) * 512 + h * 64 + 16 * dt + 4 * fq) = pk4(ot[dt]);
        }
    }
}

struct EpiBranch {
    static constexpr bool PERM = true;
    const bf16_t* G; bf16_t* M; bool add;
    DI void operator()(const f32x4 (&acc)[2][2][4][2], const g8::Unit& u, int wr, int wc, int fr, int fq) const {
        const int c0 = u.pn * 256 + wc * 32 + 8 * fq;
#pragma unroll
        for (int ai = 0; ai < 2; ++ai) {
            u32x4 g[4][2], mo[4][2];
#pragma unroll
            for (int m = 0; m < 4; ++m)
#pragma unroll
                for (int bj = 0; bj < 2; ++bj) {
                    const size_t r = (size_t)(u.pm * 256 + ai * 128 + wr * 64 + m * 16 + fr);
                    g[m][bj] = *(const u32x4*)(G + r * 2048 + c0 + bj * 128);
                    mo[m][bj] = add ? *(const u32x4*)(M + r * D + c0 + bj * 128) : (u32x4){0u, 0u, 0u, 0u};
                }
#pragma unroll
            for (int m = 0; m < 4; ++m)
#pragma unroll
                for (int bj = 0; bj < 2; ++bj) {
                    const size_t r = (size_t)(u.pm * 256 + ai * 128 + wr * 64 + m * 16 + fr);
                    const f32x4 v0 = acc[ai][bj][m][0], v1 = acc[ai][bj][m][1];
                    const u32x4 gg = g[m][bj], mm = mo[m][bj];
                    float o[8] = {lo_bf(gg[0]) * v0[0], hi_bf(gg[0]) * v0[1], lo_bf(gg[1]) * v0[2], hi_bf(gg[1]) * v0[3], lo_bf(gg[2]) * v1[0], hi_bf(gg[2]) * v1[1], lo_bf(gg[3]) * v1[2], hi_bf(gg[3]) * v1[3]};
#pragma unroll
                    for (int q = 0; q < 4; ++q) { o[2 * q] += lo_bf(mm[q]); o[2 * q + 1] += hi_bf(mm[q]); }
                    *(u32x4*)(M + r * D + c0 + bj * 128) = (u32x4){pack2(o[0], o[1]), pack2(o[2], o[3]), pack2(o[4], o[5]), pack2(o[6], o[7])};
                }
        }
    }
};
struct GateOrder {
    g8::DenseOrder d;
    DI bool next(int i, g8::Unit& u) const { return d.next(i, u); }
    DI unsigned row_off(const g8::Unit&, int) const { return 0u; }
};
struct EpiGate {
    static constexpr bool PERM = true;
    bf16_t* G;
    DI void operator()(const f32x4 (&acc)[2][2][4][2], const g8::Unit& u, int wr, int wc, int fr, int fq) const {
#pragma unroll
        for (int ai = 0; ai < 2; ++ai)
#pragma unroll
            for (int m = 0; m < 4; ++m) {
                bf16_t* rowp = G + (size_t)(u.pm * 256 + ai * 128 + wr * 64 + m * 16 + fr) * 2048 + u.pn * 256 + wc * 32 + 8 * fq;
#pragma unroll
                for (int bj = 0; bj < 2; ++bj) {
                    const f32x4 v0 = acc[ai][bj][m][0], v1 = acc[ai][bj][m][1];
                    *(u32x4*)(rowp + bj * 128) = (u32x4){pack2(sigmoidf_(v0[0]), sigmoidf_(v0[1])), pack2(sigmoidf_(v0[2]), sigmoidf_(v0[3])), pack2(sigmoidf_(v1[0]), sigmoidf_(v1[1])), pack2(sigmoidf_(v1[2]), sigmoidf_(v1[3]))};
                }
            }
    }
};
template <int PART> DI void phase_merge(const Params& p, int layer, int bid, int nb, char* smem) {
    const bf16_t* hb = p.hb; bf16_t* G = p.gates; bf16_t* M = p.merged;
    const bf16_t* Wg = p.WtIn + ((size_t)layer * CIN + CP) * D;
    G8_LAS unsigned char* lds = (G8_LAS unsigned char*)smem;
    if (PART == 0) {
#pragma unroll
    for (int which = 0; which < 2; ++which) {
        g8::DenseOrder S; S.init(hb, Wg + (size_t)which * 1024 * D, MFULL, D / 256, D, nb, bid);
        g8::gemm8<false>(lds, D, S, EpiGate{G + which * 1024});
    }
    }
    if (PART == 1) {
#pragma unroll
    for (int which = 0; which < 2; ++which) {
        const bf16_t* A = which ? p.orw : p.osb;
        const bf16_t* Bt = (which ? p.WtPrw : p.WtPsb) + (size_t)layer * D * 512;
        g8::DenseOrder S; S.init(A, Bt, MFULL, D / 256, 512, nb, bid);
        g8::gemm8<false>(lds, 512, S, EpiBranch{G + which * 1024, M, which != 0});
    }
    }
    if (PART == 1)
    for (int t = left_first(MFULL * 4 * 2, bid, nb); t < D / 128; t += nb) {
#pragma unroll
        for (int which = 0; which < 2; ++which) {
            const bf16_t* A = which ? p.orw : p.osb; const bf16_t* Gw = p.gleft - (size_t)M0_LEFT * 2048 + which * 1024;
            const bf16_t* Bt = (which ? p.WtPrw : p.WtPsb) + (size_t)layer * D * 512;
            gemm_left32([=](int r) { return A + (size_t)(M0_LEFT + r) * 512; }, Bt, 512, 512, t * 128, smem,
                        [=](int r0, int c, f32x4 v) {
                            const size_t r = (size_t)(M0_LEFT + r0);
                            const u32x2 g = *(const u32x2*)(Gw + r * 2048 + c);
                            float o0 = lo_bf(g[0]) * v[0], o1 = hi_bf(g[0]) * v[1], o2 = lo_bf(g[1]) * v[2], o3 = hi_bf(g[1]) * v[3];
                            u32x2* mp = (u32x2*)(M + r * D + c);
                            if (which) { const u32x2 m = *mp; o0 += lo_bf(m[0]); o1 += hi_bf(m[0]); o2 += lo_bf(m[1]); o3 += hi_bf(m[1]); }
                            *mp = (u32x2){pack2(o0, o1), pack2(o2, o3)};
                        });
        }
    }
}
struct EpiOut {
    static constexpr bool PERM = true;
    bf16_t* hb;
    DI void operator()(const f32x4 (&acc)[2][2][4][2], const g8::Unit& u, int wr, int wc, int fr, int fq) const {
        const int c0 = u.pn * 256 + wc * 32 + 8 * fq;
#pragma unroll
        for (int ai = 0; ai < 2; ++ai) {
            u32x4 hv[4][2];
#pragma unroll
            for (int m = 0; m < 4; ++m)
#pragma unroll
                for (int bj = 0; bj < 2; ++bj) hv[m][bj] = *(const u32x4*)(hb + (size_t)(u.pm * 256 + ai * 128 + wr * 64 + m * 16 + fr) * D + c0 + bj * 128);
#pragma unroll
            for (int m = 0; m < 4; ++m)
#pragma unroll
                for (int bj = 0; bj < 2; ++bj) {
                    const u32x4 h = hv[m][bj]; const f32x4 v0 = acc[ai][bj][m][0], v1 = acc[ai][bj][m][1];
                    *(u32x4*)(hb + (size_t)(u.pm * 256 + ai * 128 + wr * 64 + m * 16 + fr) * D + c0 + bj * 128) =
                        (u32x4){pack2(ALPHA * lo_bf(h[0]) + v0[0], ALPHA * hi_bf(h[0]) + v0[1]), pack2(ALPHA * lo_bf(h[1]) + v0[2], ALPHA * hi_bf(h[1]) + v0[3]),
                                pack2(ALPHA * lo_bf(h[2]) + v1[0], ALPHA * hi_bf(h[2]) + v1[1]), pack2(ALPHA * lo_bf(h[3]) + v1[2], ALPHA * hi_bf(h[3]) + v1[3])};
                }
        }
    }
};
DI void phase_outproj(const Params& p, int layer, int bid, int nb, char* smem) {
    const bf16_t* A = p.merged; bf16_t* const hbres = p.hb;
    const bf16_t* Bt = p.WtOut + (size_t)layer * D * D;
    if (bid == 0 && tid_() < NE) p.counts[tid_()] = 0;
    g8::DenseOrder S; S.init(A, Bt, MFULL, D / 256, D, nb, bid);
    g8::gemm8<false>((G8_LAS unsigned char*)smem, D, S, EpiOut{hbres});
    for (int t = left_first(MFULL * 4, bid, nb); t < D / 128; t += nb)
        gemm_left32([=](int r) { return A + (size_t)(M0_LEFT + r) * D; }, Bt, D, D, t * 128, smem,
                    [=](int r0, int c, f32x4 v) {
                        const int r = M0_LEFT + r0;
                        u32x2* hp = (u32x2*)(hbres + (size_t)r * D + c);
                        const f32x4 h = up4(*hp);
                        *hp = (u32x2){pack2(ALPHA * h[0] + v[0], ALPHA * h[1] + v[1]), pack2(ALPHA * h[2] + v[2], ALPHA * h[3] + v[3])};
                    });
}

constexpr int LN1_ROWB = 2 * D + 16;
constexpr int LN1_WAVE = 8 * LN1_ROWB;
constexpr int LN1_LDS = 8 * LN1_WAVE + 2048;
DI void phase_ln1_router(const Params& p, int layer, int bid, int nb, char* smem) {
    const int tid = tid_(), lane = tid & 63, wid = __builtin_amdgcn_readfirstlane(tid >> 6), fr = lane & 15, fq = lane >> 4;
    char* wl = smem + wid * LN1_WAVE;
    int* sel = (int*)(smem + 8 * LN1_WAVE);
    float* sgt = (float*)(smem + 8 * LN1_WAVE + 640);
    int* sbase = (int*)(smem + 8 * LN1_WAVE + 1280);
    const int nwaves = nb * 8, gw = bid * 8 + wid;
    const int base_n = T / nwaves, extra = T % nwaves;
    const int tok0 = gw * base_n + (gw < extra ? gw : extra), ntok = base_n + (gw < extra ? 1 : 0);
    const int btok0 = bid * 8 * base_n + (bid * 8 < extra ? bid * 8 : extra);
    const float* g1p = p.ln1_g + layer * D; const float* b1p = p.ln1_b + layer * D;
    __syncthreads();
    for (int g0 = 0; g0 < ntok; g0 += 8) {
        const int ng = ntok - g0 < 8 ? ntok - g0 : 8;
        float vn[16];
        { const bf16_t* hf = p.hb + (size_t)(tok0 + g0) * D;
#pragma unroll
          for (int j = 0; j < 4; ++j) { const f32x4 a = up4(*(const u32x2*)(hf + 256 * j + 4 * lane)); vn[4 * j] = a[0]; vn[4 * j + 1] = a[1]; vn[4 * j + 2] = a[2]; vn[4 * j + 3] = a[3]; } }
#pragma unroll 1
        for (int i = 0; i < ng; ++i) {
            const int tok = tok0 + g0 + i;
            float v[16];
#pragma unroll
            for (int q = 0; q < 16; ++q) v[q] = vn[q];
            if (i + 1 < ng) { const bf16_t* hn = p.hb + (size_t)(tok + 1) * D;
#pragma unroll
                for (int j = 0; j < 4; ++j) { const f32x4 a = up4(*(const u32x2*)(hn + 256 * j + 4 * lane)); vn[4 * j] = a[0]; vn[4 * j + 1] = a[1]; vn[4 * j + 2] = a[2]; vn[4 * j + 3] = a[3]; } }
            ln16(v, g1p, b1p, lane);
#pragma unroll
            for (int j = 0; j < 4; ++j) {
                const unsigned h0 = pack2(v[4 * j], v[4 * j + 1]), h1 = pack2(v[4 * j + 2], v[4 * j + 3]);
                *(u32x2*)(p.hb + (size_t)tok * D + 256 * j + 4 * lane) = (u32x2){h0, h1};
                *(u32x2*)(wl + i * LN1_ROWB + (256 * j + 4 * lane) * 2) = (u32x2){h0, h1};
            }
        }
        asm volatile("s_waitcnt lgkmcnt(0)" ::: "memory");
        __builtin_amdgcn_wave_barrier();
        f32x4 acc[2] = {(f32x4){0.f, 0.f, 0.f, 0.f}, (f32x4){0.f, 0.f, 0.f, 0.f}};
        const char* arow = wl + (fr & 7) * LN1_ROWB + fq * 16;
        const bf16_t* whi = p.RwHi + (size_t)fr * D + fq * 8;
#pragma unroll 4
        for (int ks = 0; ks < 32; ++ks) {
            const bf16x8 ah = *(const bf16x8*)(arow + ks * 64);
            const bf16x8 bh = *(const bf16x8*)(whi + ks * 32);
            acc[ks & 1] = __builtin_amdgcn_mfma_f32_16x16x32_bf16(bh, ah, acc[ks & 1], 0, 0, 0);
        }
        float lg[4]; float mx = -3.0e38f;
#pragma unroll
        for (int e = 0; e < 4; ++e) { lg[e] = acc[0][e] + acc[1][e] + p.router_b[4 * fq + e]; mx = fmaxf(mx, lg[e]); }
        mx = fmaxf(mx, __shfl_xor(mx, 16)); mx = fmaxf(mx, __shfl_xor(mx, 32));
        float sum = 0.f;
#pragma unroll
        for (int e = 0; e < 4; ++e) { lg[e] = __expf(lg[e] - mx); sum += lg[e]; }
        sum += __shfl_xor(sum, 16); sum += __shfl_xor(sum, 32);
        const float inv = 1.0f / sum;
        float v1 = -1.f, v2 = -1.f; int i1 = 0, i2 = 0;
#pragma unroll
        for (int e = 0; e < 4; ++e) {
            const float pv = lg[e] * inv;
            if (pv > v1) { v2 = v1; i2 = i1; v1 = pv; i1 = e; } else if (pv > v2) { v2 = pv; i2 = e; }
        }
        const float sc = v1 + v2;
        float bsc = sc; int bg = fq;
#pragma unroll
        for (int m = 16; m <= 32; m <<= 1) {
            const float os = __shfl_xor(bsc, m); const int og = __shfl_xor(bg, m);
            if (os > bsc || (os == bsc && og < bg)) { bsc = os; bg = og; }
        }
        if (bg == fq && fr < ng) {
            const int li = tok0 + g0 + fr - btok0;
            const float gs = 1.0f / (v1 + v2);
            sel[li * 2] = 4 * fq + i1; sel[li * 2 + 1] = 4 * fq + i2; sgt[li * 2] = v1 * gs; sgt[li * 2 + 1] = v2 * gs;
        }
        asm volatile("s_waitcnt lgkmcnt(0)" ::: "memory");
        __builtin_amdgcn_wave_barrier();
    }
    __syncthreads();
    if (wid == 0) {
        const int nbt = 8 * base_n + ((bid * 8 + 8 <= extra) ? 8 : (bid * 8 < extra ? extra - bid * 8 : 0));
        for (int c0 = 0; c0 < nbt; c0 += 64) {
            const int li = c0 + lane; const bool on = li < nbt;
            const int e1 = on ? sel[li * 2] : -1, e2 = on ? sel[li * 2 + 1] : -1;
            const unsigned long long lt = (1ull << lane) - 1ull;
            int r1 = 0, r2 = 0, mycnt = 0;
#pragma unroll
            for (int e = 0; e < NE; ++e) {
                const unsigned long long m1 = __ballot(e1 == e), m2 = __ballot(e2 == e);
                const int c1 = __popcll(m1), c2 = __popcll(m2);
                if (e1 == e) r1 = __popcll(m1 & lt);
                if (e2 == e) r2 = c1 + __popcll(m2 & lt);
                if (lane == e) mycnt = c1 + c2;
            }
            if (lane < NE) sbase[lane] = mycnt > 0 ? atomicAdd(&p.counts[lane], mycnt) : 0;
            asm volatile("s_waitcnt vmcnt(0) lgkmcnt(0)" ::: "memory");
            __builtin_amdgcn_wave_barrier();
            if (on) {
                const int tok = btok0 + li;
                const int s1 = sbase[e1] + r1, s2 = sbase[e2] + r2;
                p.list[e1 * T + s1] = tok * 2; p.list[e2 * T + s2] = tok * 2 + 1;
                p.tokg[tok * 2] = sgt[li * 2]; p.tokg[tok * 2 + 1] = sgt[li * 2 + 1];
            }
            asm volatile("s_waitcnt lgkmcnt(0)" ::: "memory");
            __builtin_amdgcn_wave_barrier();
        }
    }
}

constexpr int MOE_BIG = 8;
template <bool UP> struct MoeOrder {
    const int* counts; const int* list; int G, c; const char* A; const char* B;
    DI bool next(int i, g8::Unit& u) const {
        const int xcd = c & 7, w = c >> 3, mt = (w >> 1) & 7, pn = 2 * (w & 1) + i, esel = xcd + 8 * (w >> 4);
        if (w >= 32 || i >= 2) return false;
        int padp = 0, fe = -1, fc = 0, fp = 0;
#pragma unroll
        for (int e = 0; e < NE; ++e) {
            const int cn = counts[e], ntp = (cn + 255) >> 8, nt = ntp < MOE_BIG ? ntp : MOE_BIG;
            const bool hit = (e == esel) && (mt < nt);
            fe = hit ? e : fe; fc = hit ? cn : fc; fp = hit ? padp + mt : fp;
            padp += ntp;
        }
        fe = __builtin_amdgcn_readfirstlane(fe); fc = __builtin_amdgcn_readfirstlane(fc); fp = __builtin_amdgcn_readfirstlane(fp);
        if (fe < 0) return false;
        u.e = fe; u.slot0 = mt * 256; u.cnt = fc; u.pm = fp; u.pn = pn;
        u.A = UP ? A : A + (size_t)fp * ((size_t)256 * DE * 2);
        u.B = UP ? B + (size_t)fe * ((size_t)1024 * 1024 * 2) + (size_t)pn * ((size_t)256 * D * 2) : B + (size_t)fe * ((size_t)1024 * 512 * 2) + (size_t)pn * ((size_t)256 * DE * 2);
        return true;
    }
    DI unsigned row_off(const g8::Unit& u, int r) const {
        const __amdgpu_buffer_rsrc_t rs = __builtin_amdgcn_make_buffer_rsrc((void*)list, 0, NE * T * 4, 0x00020000);
        const int ent = __builtin_amdgcn_raw_buffer_load_b32(rs, r * 4, (u.e * T + u.slot0) * 4, 0);
        return u.slot0 + r < u.cnt ? (unsigned)(ent >> 1) * (unsigned)(D * 2) : 0u;
    }
};
struct EpiMoeUp {
    static constexpr bool PERM = true;
    bf16_t* hid;
    DI void operator()(const f32x4 (&acc)[2][2][4][2], const g8::Unit& u, int wr, int wc, int fr, int fq) const {
#pragma unroll
        for (int ai = 0; ai < 2; ++ai)
#pragma unroll
            for (int m = 0; m < 4; ++m) {
                const int r = ai * 128 + wr * 64 + m * 16 + fr;
                if (u.slot0 + r >= u.cnt) continue;
                bf16_t* rowp = hid + ((size_t)u.pm * 256 + r) * DE + ((u.pn * 256 + wc * 32 + 8 * fq) >> 1);
#pragma unroll
                for (int bj = 0; bj < 2; ++bj) {
                    const f32x4 v0 = acc[ai][bj][m][0], v1 = acc[ai][bj][m][1];
                    *(u32x2*)(rowp + bj * 64) = (u32x2){pack2(v0[0] * sigmoidf_(v0[0]) * v0[1], v0[2] * sigmoidf_(v0[2]) * v0[3]), pack2(v1[0] * sigmoidf_(v1[0]) * v1[1], v1[2] * sigmoidf_(v1[2]) * v1[3])};
                }
            }
    }
};
struct EpiMoeDown {
    static constexpr bool PERM = true;
    bf16_t* fo; const int* list; const float* tokg;
    DI void operator()(const f32x4 (&acc)[2][2][4][2], const g8::Unit& u, int wr, int wc, int fr, int fq) const {
        int ent[8]; float g[8];
#pragma unroll
        for (int q = 0; q < 8; ++q) {
            const int sl = u.slot0 + (q >> 2) * 128 + wr * 64 + (q & 3) * 16 + fr;
            ent[q] = sl < u.cnt ? list[u.e * T + sl] : -1;
        }
#pragma unroll
        for (int q = 0; q < 8; ++q) g[q] = ent[q] >= 0 ? tokg[ent[q]] : 0.f;
#pragma unroll
        for (int ai = 0; ai < 2; ++ai)
#pragma unroll
            for (int m = 0; m < 4; ++m) {
                const int q = ai * 4 + m;
                if (ent[q] < 0) continue;
                const float gg = g[q];
                bf16_t* rowp = fo + ((size_t)(ent[q] & 1) * TP + (ent[q] >> 1)) * D + u.pn * 256 + wc * 32 + 8 * fq;
#pragma unroll
                for (int bj = 0; bj < 2; ++bj) {
                    const f32x4 v0 = acc[ai][bj][m][0], v1 = acc[ai][bj][m][1];
                    *(u32x4*)(rowp + bj * 128) = (u32x4){pack2(gg * v0[0], gg * v0[1]), pack2(gg * v0[2], gg * v0[3]), pack2(gg * v1[0], gg * v1[1]), pack2(gg * v1[2], gg * v1[3])};
                }
            }
    }
};
DI void phase_moe_up(const Params& p, int bid, int nb, char* smem) {
    const MoeOrder<true> S{p.counts, p.list, nb, bid, (const char*)p.hb, (const char*)p.WtGU};
    g8::gemm8<true>((G8_LAS unsigned char*)smem, D, S, EpiMoeUp{p.hid});
    const bf16_t* hb = p.hb; bf16_t* hid = p.hid; const int* list = p.list;
    int big = 0, padr = 0, job = 0;
#pragma unroll 1
    for (int e = 0; e < NE; ++e) { const int cn = p.counts[e], ntp = (cn + 255) >> 8; big += (ntp < MOE_BIG ? ntp : MOE_BIG) * 4; }
    const int mine = bid; (void)big;
#pragma unroll 1
    for (int e = 0; e < NE; ++e) {
        const int cn = p.counts[e];
        for (int s0 = MOE_BIG * 256; s0 < cn; s0 += 128)
            for (int nt = 0; nt < 8; ++nt, ++job)
                if (job % nb == mine) {
                    const int prow = padr;
                    gemm_tile128([=](int r) { const int sl = s0 + r; return sl < cn ? hb + (size_t)(list[e * T + sl] >> 1) * D : (const bf16_t*)nullptr; },
                                 p.WtGU + (size_t)e * 1024 * 1024, D, D, 0, nt * 128, smem,
                                 [=](int r, int c, f32x4 v) {
                                     const int sl = s0 + r;
                                     if (sl >= cn) return;
                                     *(unsigned*)(hid + (size_t)(prow + sl) * DE + (c >> 1)) = pack2(v[0] * sigmoidf_(v[0]) * v[1], v[2] * sigmoidf_(v[2]) * v[3]);
                                 });
                }
        padr += ((cn + 255) >> 8) * 256;
    }
}
DI void phase_moe_down(const Params& p, int bid, int nb, char* smem) {
    const MoeOrder<false> S{p.counts, p.list, nb, bid, (const char*)p.hid, (const char*)p.WtD};
    g8::gemm8<false>((G8_LAS unsigned char*)smem, DE, S, EpiMoeDown{p.fo, p.list, p.tokg});
    const bf16_t* hid = p.hid; bf16_t* fo = p.fo; const int* list = p.list; const float* tokg = p.tokg;
    int big = 0, padr = 0, job = 0;
#pragma unroll 1
    for (int e = 0; e < NE; ++e) { const int cn = p.counts[e], ntp = (cn + 255) >> 8; big += (ntp < MOE_BIG ? ntp : MOE_BIG) * 4; }
    const int mine = bid; (void)big;
#pragma unroll 1
    for (int e = 0; e < NE; ++e) {
        const int cn = p.counts[e];
        for (int s0 = MOE_BIG * 256; s0 < cn; s0 += 128)
            for (int nt = 0; nt < 8; ++nt, ++job)
                if (job % nb == mine) {
                    const int prow = padr;
                    gemm_tile128([=](int r) { const int sl = s0 + r; return sl < cn ? hid + (size_t)(prow + sl) * DE : (const bf16_t*)nullptr; },
                                 p.WtD + (size_t)e * 1024 * 512, DE, DE, 0, nt * 128, smem,
                                 [=](int r, int c, f32x4 v) {
                                     const int sl = s0 + r;
                                     if (sl >= cn) return;
                                     const int ent = list[e * T + sl];
                                     const float g = tokg[ent];
                                     *(u32x2*)(fo + ((size_t)(ent & 1) * TP + (ent >> 1)) * D + c) = (u32x2){pack2(g * v[0], g * v[1]), pack2(g * v[2], g * v[3])};
                                 });
                }
        padr += ((cn + 255) >> 8) * 256;
    }
}
DI void phase_ln2(const Params& p, int layer, int bid, int nb) {
    const int lane = tid_() & 63, wid = __builtin_amdgcn_readfirstlane(tid_() >> 6);
    const int nwaves = nb * 8, gw = bid * 8 + wid, base_n = T / nwaves, extra = T % nwaves;
    const int tok0 = gw * base_n + (gw < extra ? gw : extra), ntok = base_n + (gw < extra ? 1 : 0);
    u32x2 an[4], f0n[4], f1n[4];
    {
#pragma unroll
        for (int j = 0; j < 4; ++j) {
            an[j] = *(const u32x2*)(p.hb + (size_t)tok0 * D + 256 * j + 4 * lane);
            f0n[j] = *(const u32x2*)(p.fo + (size_t)tok0 * D + 256 * j + 4 * lane); f1n[j] = *(const u32x2*)(p.fo + ((size_t)TP + tok0) * D + 256 * j + 4 * lane);
        }
    }
#pragma unroll 1
    for (int i = 0; i < ntok; ++i) {
        const int tok = tok0 + i;
        float v[16];
#pragma unroll
        for (int j = 0; j < 4; ++j) {
            v[4 * j] = ALPHA * lo_bf(an[j][0]) + lo_bf(f0n[j][0]) + lo_bf(f1n[j][0]); v[4 * j + 1] = ALPHA * hi_bf(an[j][0]) + hi_bf(f0n[j][0]) + hi_bf(f1n[j][0]);
            v[4 * j + 2] = ALPHA * lo_bf(an[j][1]) + lo_bf(f0n[j][1]) + lo_bf(f1n[j][1]); v[4 * j + 3] = ALPHA * hi_bf(an[j][1]) + hi_bf(f0n[j][1]) + hi_bf(f1n[j][1]);
        }
        if (i + 1 < ntok) {
#pragma unroll
            for (int j = 0; j < 4; ++j) {
                an[j] = *(const u32x2*)(p.hb + (size_t)(tok + 1) * D + 256 * j + 4 * lane);
                f0n[j] = *(const u32x2*)(p.fo + (size_t)(tok + 1) * D + 256 * j + 4 * lane); f1n[j] = *(const u32x2*)(p.fo + ((size_t)TP + tok + 1) * D + 256 * j + 4 * lane);
            }
        }
        ln16(v, p.ln2_g + layer * D, p.ln2_b + layer * D, lane);
        if (layer == DEPTH - 1) {
            float* of = hrow_u(p, tok);
#pragma unroll
            for (int j = 0; j < 4; ++j) *(f32x4*)(of + 256 * j + 4 * lane) = (f32x4){v[4 * j], v[4 * j + 1], v[4 * j + 2], v[4 * j + 3]};
        } else store_row_bf(p.hb + (size_t)tok * D, v, lane);
    }
}

extern __shared__ __attribute__((aligned(16))) char dyn_smem[];
constexpr int SMEM_MAIN = R1_LDS > GEMM_LDS ? R1_LDS : GEMM_LDS;
constexpr int SMEM_BYTES = SMEM_MAIN + 16;

__global__ void __launch_bounds__(NTHR, 2) k_forward(Params p) {
    const int bid = blockIdx.x, nb = gridDim.x;
    char* smem = dyn_smem;
    uint4* xbw = (uint4*)(dyn_smem + SMEM_MAIN);
    if (threadIdx.x == 0) *xbw = make_uint4(0u, 0u, 0u, 0u);
    __syncthreads();
    XcdBarrier bar = xcd_barrier_post(p.bar, (volatile LAS unsigned*)xbw);
    phase_prologue_weights(p, bid, nb, smem);
    phase_embed(p, bid, nb);
    xcd_barrier(bar);
    for (int l = 0; l < DEPTH; ++l) {
        phase_inproj(p, l, bid, nb, smem);
        xcd_barrier(bar);
        phase_rwkv_r1<0>(p, l, bid, nb, smem);
        xcd_barrier(bar);
        if (bid < 16) { const int cw = __builtin_amdgcn_readfirstlane(tid_() >> 6); if (cw < 4) phase_rwkv_r2(p, bid * 4 + cw); }
        else {
            const int sbid = bid - 16, snb = nb - 16, heavy = (NBATCH * HEADS * ((L + 127) / 128)) % snb;
            if (sbid >= heavy && sbid < heavy + NBATCH * HEADS) phase_rwkv_r1<1>(p, l, sbid - heavy, 1, smem);
            phase_sb(p, sbid, snb, smem);
        }
        xcd_barrier(bar);
        phase_rwkv_r3(p, l, bid, nb);
        convert_experts(p, l, NE / 2, NE, bid, nb, smem);
        phase_merge<0>(p, l, bid, nb, smem);
        xcd_barrier(bar);
        phase_merge<1>(p, l, bid, nb, smem);
        xcd_barrier(bar);
        phase_outproj(p, l, bid, nb, smem);
        xcd_barrier(bar);
        phase_ln1_router(p, l, bid, nb, smem);
        xcd_barrier(bar);
        phase_moe_up(p, bid, nb, smem);
        xcd_barrier(bar);
        phase_moe_down(p, bid, nb, smem);
        xcd_barrier(bar);
        phase_ln2(p, l, bid, nb);
        xcd_barrier(bar);
    }
}

extern "C" void kernel_launch(void* const* d_in, const int* in_sizes, int n_in, void* d_out, int out_size, void* d_ws, size_t ws_size, hipStream_t stream) {
    (void)in_sizes; (void)n_in; (void)out_size;
    Params p;
    memset(&p, 0, sizeof(p));
    const float* const* in = (const float* const*)d_in;
    p.x = in[0]; p.meta = in[1]; p.emb_g = in[2]; p.emb_b = in[3]; p.w_in = in[4]; p.mu = in[5]; p.w0 = in[6]; p.w_up = in[7]; p.a0 = in[8]; p.a_up = in[9];
    p.g_up = in[10]; p.k_k = in[11]; p.k_a = in[12]; p.r_k = in[13]; p.lnx_g = in[14]; p.lnx_b = in[15]; p.p_sb = in[16]; p.p_rwkv = in[17]; p.w_out = in[18];
    p.ln1_g = in[19]; p.ln1_b = in[20]; p.router_w = in[21]; p.router_b = in[22]; p.ew_gate = in[23]; p.ew_up = in[24]; p.ew_down = in[25]; p.ln2_g = in[26]; p.ln2_b = in[27];
    p.out = (float*)d_out;
    char* ws = (char*)d_ws; size_t o = 0;
    auto take = [&](size_t bytes) { char* r = ws + o; o += (bytes + 255) & ~(size_t)255; return r; };
    p.bar = (unsigned*)take(XCD_BAR_WORDS * sizeof(unsigned));
    p.counts = (int*)take(256);
    p.WtIn = (bf16_t*)take((size_t)DEPTH * CIN * D * 2);
    p.WtPsb = (bf16_t*)take((size_t)DEPTH * D * 512 * 2);
    p.WtPrw = (bf16_t*)take((size_t)DEPTH * D * 512 * 2);
    p.WtOut = (bf16_t*)take((size_t)DEPTH * D * D * 2);
    p.WupT = (bf16_t*)take((size_t)DEPTH * 512 * 64 * 2);
    p.AupT = (bf16_t*)take((size_t)DEPTH * 512 * 64 * 2);
    p.GupT = (bf16_t*)take((size_t)DEPTH * 512 * 128 * 2);
    p.RwHi = (bf16_t*)take((size_t)NE * D * 2);
    p.gleft = (bf16_t*)take((size_t)32 * 2048 * 2);
    {
        const size_t ub = (size_t)NUNIT * 64 * 64 * 2;
        p.WtGU = (bf16_t*)take((size_t)NE * 1024 * 1024 * 2);
        p.WtD = (bf16_t*)take((size_t)NE * 1024 * 512 * 2);
        p.PcG = (bf16_t*)d_out; p.QcG = (bf16_t*)((char*)d_out + ub); p.RhG = (bf16_t*)((char*)d_out + 2 * ub);
        p.Y0G = (bf16_t*)take(ub); p.GG = (bf16_t*)take(ub); p.SG = (bf16_t*)take(ub);
        p.bonG = (float*)take((size_t)NUNIT * 64 * 4);
    }
    p.hb = (bf16_t*)take((size_t)TP * D * 2);
    p.hmeta = (float*)take((size_t)NBATCH * NMETA * D * 4);
    p.P = (bf16_t*)take((size_t)TP * CP * 2);
    p.osb = (bf16_t*)take((size_t)TP * 512 * 2);
    p.orw = (bf16_t*)take((size_t)TP * 512 * 2);
    p.list = (int*)take((size_t)NE * T * 4);
    p.tokg = (float*)take((size_t)T * 2 * 4);
    p.gates = p.P;
    p.merged = p.P + (size_t)TP * 2048;
    p.hid = p.P;
    p.fo = p.P + (size_t)(2 * T + 16 * 256) * DE;
    if (o > ws_size) return;
    static int grid = 0;
    if (!grid) {
        int dev = 0, cus = 0, per_cu = 0;
        (void)hipGetDevice(&dev);
        (void)hipDeviceGetAttribute(&cus, hipDeviceAttributeMultiprocessorCount, dev);
        (void)hipFuncSetAttribute((const void*)k_forward, hipFuncAttributeMaxDynamicSharedMemorySize, SMEM_BYTES);
        (void)hipOccupancyMaxActiveBlocksPerMultiprocessor(&per_cu, k_forward, NTHR, SMEM_BYTES);
        grid = per_cu >= 1 ? cus : 0;
    }
    if (!grid) return;
    (void)hipMemsetAsync(p.bar, 0, XCD_BAR_WORDS * sizeof(unsigned), stream);
    hipLaunchKernelGGL(k_forward, dim3(grid), dim3(NTHR), SMEM_BYTES, stream, p);
}
```

```cpp
#include <hip/hip_runtime.h>
#include <stdint.h>
#include <string.h>

#define DI __device__ __forceinline__
typedef unsigned short bf16_t;
typedef short bf16x8 __attribute__((ext_vector_type(8)));
typedef float f32x4 __attribute__((ext_vector_type(4)));
typedef unsigned u32x4 __attribute__((ext_vector_type(4)));
typedef unsigned u32x2 __attribute__((ext_vector_type(2)));

constexpr int D = 1024, NBATCH = 2, SEQ = 8192, NMETA = 16, L = SEQ + NMETA, T = NBATCH * L, TP = 16640;
constexpr int DEPTH = 2, HEADS = 8, HD = 64;
constexpr int CIN = 5376, CP = 3328;
constexpr int OFF_Q = 0, OFF_K = 512, OFF_V = 1024, OFF_RW = 1536;
constexpr int RW_R = 0, RW_K = 512, RW_V = 1024, RW_WD = 1536, RW_AD = 1600, RW_GD = 1664, RSW = 1792;
constexpr int NE = 16, DE = 512;
constexpr float ALPHA = 1.41421356237309515f;
constexpr float DECAY_SCALE = 0.60653065971263342f;
constexpr int NTHR = 512;

#define XB_TMO      128
#define XB_XCNT(j)  (256  + 64 * (j))
#define XB_XSUB(j)  (1280 + 64 * (j))
#define XB_XGEN(j)  (2304 + 64 * (j))
#define XB_TOP      3328
#define XB_TOPGEN   3392
#define XCD_BAR_WORDS 3456
#define XB_SPIN_CAP (1u << 18)
#define LAS __attribute__((address_space(3)))

__device__ __forceinline__ unsigned xb_ld(unsigned* p)              { return __hip_atomic_load(p, __ATOMIC_RELAXED, __HIP_MEMORY_SCOPE_AGENT); }
__device__ __forceinline__ unsigned xb_add(unsigned* p, unsigned v) { return __hip_atomic_fetch_add(p, v, __ATOMIC_RELAXED, __HIP_MEMORY_SCOPE_AGENT); }
__device__ __forceinline__ unsigned xb_xcc_id() { return (unsigned)__builtin_amdgcn_s_getreg((3 << 11) | 20) & 0xFu; }
#define XB_SPIN(cond, bar) do { unsigned _sp = 0; while (cond) { __builtin_amdgcn_s_sleep(1); \
    if ((++_sp & 255u) == 0u) { if (xb_ld(&(bar)[XB_TMO])) break; if (_sp > XB_SPIN_CAP) { atomicAdd(&(bar)[XB_TMO], 1u); break; } } } } while (0)

struct XcdBarrier {
    unsigned* bar; unsigned x;
    volatile LAS unsigned* st;
};

__device__ __forceinline__ XcdBarrier xcd_barrier_post(unsigned* bar, volatile LAS unsigned* st) {
    XcdBarrier b; b.bar = bar; b.x = xb_xcc_id(); b.st = st;
    if (threadIdx.x == 0) (void)xb_add(&bar[XB_XCNT(b.x)], 1u);
    return b;
}
__device__ __forceinline__ void xcd_barrier_complete(unsigned* bar, unsigned x, unsigned& nloc, unsigned& nx) {
    const unsigned G = gridDim.x * gridDim.y * gridDim.z;
    unsigned sum, cnt, mine, sp = 0u;
    for (;;) {
        sum = 0u; cnt = 0u; mine = 0u;
#pragma unroll
        for (unsigned j = 0; j < 16; ++j) { const unsigned c = xb_ld(&bar[XB_XCNT(j)]); sum += c; cnt += (c > 0u) ? 1u : 0u; mine = (j == x) ? c : mine; }
        if (sum == G) break;
        __builtin_amdgcn_s_sleep(1);
        if ((++sp & 255u) == 0u) { if (xb_ld(&bar[XB_TMO])) break; if (sp > XB_SPIN_CAP) { atomicAdd(&bar[XB_TMO], 1u); break; } }
    }
    nloc = mine > 0u ? mine : 1u; nx = cnt > 0u ? cnt : 1u;
}

__device__ __forceinline__ void xcd_barrier(const XcdBarrier& b) {
    asm volatile("s_waitcnt vmcnt(0)" ::: "memory");
    __syncthreads();
    if (threadIdx.x == 0) {
        unsigned* bar = b.bar;
        unsigned bx = b.x; asm volatile("" : "+s"(bx));
        __builtin_amdgcn_s_waitcnt(0);
        unsigned nloc = b.st[0], nx = b.st[1];
        if (nloc == 0u) { xcd_barrier_complete(bar, bx, nloc, nx); b.st[0] = nloc; b.st[1] = nx; }
        const unsigned old = xb_add(&bar[XB_XSUB(bx)], 1u);
        const unsigned gen = old / nloc;
        if (old + 1u == (gen + 1u) * nloc) {
            __builtin_amdgcn_fence(__ATOMIC_RELEASE, "agent");
            asm volatile("s_waitcnt vmcnt(0)" ::: "memory");
            const unsigned og = xb_add(&bar[XB_TOP], 1u);
            const unsigned tg = og / nx;
            if (og + 1u == (tg + 1u) * nx) xb_add(&bar[XB_TOPGEN], 1u);
            else XB_SPIN(xb_ld(&bar[XB_TOPGEN]) == tg, bar);
            __builtin_amdgcn_fence(__ATOMIC_ACQUIRE, "agent");
            xb_add(&bar[XB_XGEN(bx)], 1u);
            asm volatile("s_waitcnt vmcnt(0)" ::: "memory");
        } else {
            XB_SPIN(xb_ld(&bar[XB_XGEN(bx)]) == gen, bar);
            __builtin_amdgcn_fence(__ATOMIC_ACQUIRE, "agent");
            asm volatile("s_waitcnt vmcnt(0)" ::: "memory");
        }
    }
    __syncthreads();
}


struct Params {
    const float *x, *meta, *emb_g, *emb_b, *w_in, *mu, *w0, *w_up, *a0, *a_up, *g_up, *k_k, *k_a, *r_k, *lnx_g, *lnx_b, *p_sb, *p_rwkv, *w_out,
        *ln1_g, *ln1_b, *router_w, *router_b, *ew_gate, *ew_up, *ew_down, *ln2_g, *ln2_b;
    float* out;
    unsigned* bar;
    int* counts;
    bf16_t *WtIn, *WtPsb, *WtPrw, *WtOut, *WtGU, *WtD, *hb, *P, *osb, *orw, *WupT, *AupT, *GupT;
    bf16_t *PcG, *QcG, *RhG, *Y0G, *GG, *SG;
    bf16_t *RwHi, *gleft;
    float* bonG;
    float* hmeta;
    bf16_t *gates, *merged, *hid, *fo;
    int* list;
    float* tokg;
};

DI float bf2f(bf16_t v) { return __uint_as_float((unsigned)v << 16); }
typedef __bf16 bf16x2_t __attribute__((ext_vector_type(2)));
DI bf16_t f2bf(float f) { return __builtin_bit_cast(bf16_t, (__bf16)f); }
DI unsigned pack2(float lo, float hi) { bf16x2_t v = {(__bf16)lo, (__bf16)hi}; return __builtin_bit_cast(unsigned, v); }
DI float lo_bf(unsigned u) { return __uint_as_float(u << 16); }
DI float hi_bf(unsigned u) { return __uint_as_float(u & 0xFFFF0000u); }
template <int CTRL> DI float dpp_mov(float v) { return __builtin_bit_cast(float, __builtin_amdgcn_update_dpp(0, __builtin_bit_cast(int, v), CTRL, 0xF, 0xF, true)); }
DI float sum8(float v) {
    v += dpp_mov<0xB1>(v);
    v += dpp_mov<0x4E>(v);
    v += dpp_mov<0x141>(v);
    return v;
}
DI float sum16(float v) { v = sum8(v); v += dpp_mov<0x140>(v); return v; }
DI float wave_sum(float v) { v = sum16(v); v += __shfl_xor(v, 16); v += __shfl_xor(v, 32); return v; }
struct Params;
DI const Params& kparams() {
    auto k = __builtin_amdgcn_kernarg_segment_ptr();
    asm volatile("" : "+s"(k));
    return *(const Params*)k;
}
DI int tid_() { int t = threadIdx.x; asm volatile("" : "+v"(t)); return t; }
DI float sigmoidf_(float x) { return __builtin_amdgcn_rcpf(1.0f + __expf(-x)); }
DI float tanhf_(float x) { return 1.0f - 2.0f * __builtin_amdgcn_rcpf(1.0f + __expf(2.0f * x)); }

DI float* hrow2(float* hmeta, float* out, int tok) {
    const int b = tok >= L ? 1 : 0, t = tok - b * L;
    const unsigned long long am = (unsigned long long)(hmeta + (long long)(b * NMETA + t) * D), ao = (unsigned long long)(out + ((long long)b * SEQ + (t - NMETA)) * D);
    const unsigned long long m = 0ull - (unsigned long long)(t < NMETA);
    return (float*)((am & m) | (ao & ~m));
}
DI float* hrow(const Params& p, int tok) { return hrow2(p.hmeta, p.out, tok); }
DI float* hrow_u(const Params& p, int tok) { return hrow2(p.hmeta, p.out, __builtin_amdgcn_readfirstlane(tok)); }

DI void transpose_convert(const float* __restrict__ src, int ld, int K, int N, bf16_t* __restrict__ dst, int mult, int off, int bid, int nb, char* smem, int& rot) {
    float* tile = (float*)smem;
    const int tk = K / 64, tn = N / 256, tid = tid_();
    const int first = (bid - rot % nb + nb) % nb;
    rot += tk * tn;
    for (int t = first; t < tk * tn; t += nb) {
        const int k0 = (t / tn) * 64, n0 = (t % tn) * 256;
        f32x4 v[4][2];
#pragma unroll
        for (int q = 0; q < 4; ++q)
#pragma unroll
            for (int i = 0; i < 2; ++i) v[q][i] = *(const f32x4*)(src + (size_t)(k0 + (tid >> 4) + 32 * i) * ld + n0 + q * 64 + (tid & 15) * 4);
        __syncthreads();
#pragma unroll
        for (int q = 0; q < 4; ++q)
#pragma unroll
            for (int i = 0; i < 2; ++i) {
                float* tp = tile + q * 64 * 65 + ((tid >> 4) + 32 * i) * 65 + (tid & 15) * 4;
                tp[0] = v[q][i][0]; tp[1] = v[q][i][1]; tp[2] = v[q][i][2]; tp[3] = v[q][i][3];
            }
        __syncthreads();
        const int n = tid >> 3, kc = (tid & 7) * 8;
#pragma unroll
        for (int q = 0; q < 4; ++q) {
            const float* tq = tile + q * 64 * 65;
            u32x4 o;
#pragma unroll
            for (int jj = 0; jj < 4; ++jj) o[jj] = pack2(tq[(kc + 2 * jj) * 65 + n], tq[(kc + 2 * jj + 1) * 65 + n]);
            *(u32x4*)(dst + (size_t)((n0 + q * 64 + n) * mult + off) * K + k0 + kc) = o;
        }
    }
}

DI void convert_experts(const Params& p, int layer, int e0, int e1, int bid, int nb, char* smem) {
    int rot = 0;
    for (int e = e0; e < e1; ++e) {
        const size_t eo = ((size_t)layer * NE + e) * (size_t)D * DE;
        transpose_convert(p.ew_gate + eo, DE, D, DE, p.WtGU + (size_t)e * 1024 * 1024, 2, 0, bid, nb, smem, rot);
        transpose_convert(p.ew_up + eo, DE, D, DE, p.WtGU + (size_t)e * 1024 * 1024, 2, 1, bid, nb, smem, rot);
        transpose_convert(p.ew_down + eo, D, DE, D, p.WtD + (size_t)e * 1024 * 512, 1, 0, bid, nb, smem, rot);
    }
}

DI void convert_layer_weights(const Params& p, int l, int bid, int nb, char* smem) {
    int rot = 0;
    transpose_convert(p.w_in + (size_t)l * D * CIN, CIN, D, CIN, p.WtIn + (size_t)l * CIN * D, 1, 0, bid, nb, smem, rot);
    transpose_convert(p.p_sb + (size_t)l * 512 * D, D, 512, D, p.WtPsb + (size_t)l * D * 512, 1, 0, bid, nb, smem, rot);
    transpose_convert(p.p_rwkv + (size_t)l * 512 * D, D, 512, D, p.WtPrw + (size_t)l * D * 512, 1, 0, bid, nb, smem, rot);
    transpose_convert(p.w_out + (size_t)l * D * D, D, D, D, p.WtOut + (size_t)l * D * D, 1, 0, bid, nb, smem, rot);
    transpose_convert(p.w_up + (size_t)l * 64 * 512, 512, 64, 512, p.WupT + (size_t)l * 512 * 64, 1, 0, bid, nb, smem, rot);
    transpose_convert(p.a_up + (size_t)l * 64 * 512, 512, 64, 512, p.AupT + (size_t)l * 512 * 64, 1, 0, bid, nb, smem, rot);
    transpose_convert(p.g_up + (size_t)l * 128 * 512, 512, 128, 512, p.GupT + (size_t)l * 512 * 128, 1, 0, bid, nb, smem, rot);
}
DI void phase_prologue_weights(const Params& p, int bid, int nb, char* smem) {
    for (int i = bid * NTHR + tid_(); i < NE * D; i += nb * NTHR) {
        const int e = i / D, k = i % D;
        p.RwHi[i] = f2bf(p.router_w[(size_t)k * NE + e]);
    }
    convert_layer_weights(p, 0, bid, nb, smem);
}

DI void ln16(float (&v)[16], const float* __restrict__ g, const float* __restrict__ b, int lane) {
    float s = 0.f;
#pragma unroll
    for (int i = 0; i < 16; ++i) s += v[i];
    const float mean = wave_sum(s) * (1.0f / D);
    float q = 0.f;
#pragma unroll
    for (int i = 0; i < 16; ++i) { v[i] -= mean; q += v[i] * v[i]; }
    const float rstd = rsqrtf(wave_sum(q) * (1.0f / D) + 1e-5f);
#pragma unroll
    for (int j = 0; j < 4; ++j) {
        const f32x4 gv = *(const f32x4*)(g + 256 * j + 4 * lane), bv = *(const f32x4*)(b + 256 * j + 4 * lane);
#pragma unroll
        for (int i = 0; i < 4; ++i) v[4 * j + i] = v[4 * j + i] * rstd * gv[i] + bv[i];
    }
}
DI void store_row_bf(bf16_t* __restrict__ hb, const float (&v)[16], int lane) {
#pragma unroll
    for (int j = 0; j < 4; ++j) *(u32x2*)(hb + 256 * j + 4 * lane) = (u32x2){pack2(v[4 * j], v[4 * j + 1]), pack2(v[4 * j + 2], v[4 * j + 3])};
}
template <int NT> DI void embed_rows(const Params& p, int tok0, int lane) {
    float v[NT][16], s[NT], q[NT];
#pragma unroll
    for (int i = 0; i < NT; ++i) {
        const int tk = __builtin_amdgcn_readfirstlane(tok0 + i), b = tk >= L ? 1 : 0, t = tk - b * L;
        const unsigned long long am = (unsigned long long)(p.meta + (long long)t * D), ao = (unsigned long long)(p.x + ((long long)b * SEQ + (t - NMETA)) * D);
        const unsigned long long m = 0ull - (unsigned long long)(t < NMETA);
        const float* src = (const float*)((am & m) | (ao & ~m));
#pragma unroll
        for (int j = 0; j < 4; ++j) { const f32x4 a = *(const f32x4*)(src + 256 * j + 4 * lane); v[i][4 * j] = a[0]; v[i][4 * j + 1] = a[1]; v[i][4 * j + 2] = a[2]; v[i][4 * j + 3] = a[3]; }
    }
    f32x4 gv[4], bv[4];
#pragma unroll
    for (int j = 0; j < 4; ++j) { gv[j] = *(const f32x4*)(p.emb_g + 256 * j + 4 * lane); bv[j] = *(const f32x4*)(p.emb_b + 256 * j + 4 * lane); }
#pragma unroll
    for (int i = 0; i < NT; ++i) {
        s[i] = 0.f;
#pragma unroll
        for (int k = 0; k < 16; ++k) s[i] += v[i][k];
    }
#pragma unroll
    for (int i = 0; i < NT; ++i) s[i] = sum16(s[i]);
#pragma unroll
    for (int i = 0; i < NT; ++i) s[i] += __shfl_xor(s[i], 16);
#pragma unroll
    for (int i = 0; i < NT; ++i) s[i] = (s[i] + __shfl_xor(s[i], 32)) * (1.0f / D);
#pragma unroll
    for (int i = 0; i < NT; ++i) {
        q[i] = 0.f;
#pragma unroll
        for (int k = 0; k < 16; ++k) { v[i][k] -= s[i]; q[i] += v[i][k] * v[i][k]; }
    }
#pragma unroll
    for (int i = 0; i < NT; ++i) q[i] = sum16(q[i]);
#pragma unroll
    for (int i = 0; i < NT; ++i) q[i] += __shfl_xor(q[i], 16);
#pragma unroll
    for (int i = 0; i < NT; ++i) q[i] = rsqrtf((q[i] + __shfl_xor(q[i], 32)) * (1.0f / D) + 1e-5f);
#pragma unroll
    for (int i = 0; i < NT; ++i)
#pragma unroll
        for (int j = 0; j < 4; ++j) {
            float o[4];
#pragma unroll
            for (int k = 0; k < 4; ++k) o[k] = v[i][4 * j + k] * q[i] * gv[j][k] + bv[j][k];
            *(u32x2*)(p.hb + (size_t)(tok0 + i) * D + 256 * j + 4 * lane) = (u32x2){pack2(o[0], o[1]), pack2(o[2], o[3])};
        }
}
DI void phase_embed(const Params& p, int bid, int nb) {
    const int lane = tid_() & 63, wid = __builtin_amdgcn_readfirstlane(tid_() >> 6);
    const int nwaves = nb * 8, gw = bid * 8 + wid, base_n = T / nwaves, extra = T % nwaves;
    const int tok0 = gw * base_n + (gw < extra ? gw : extra), ntok = base_n + (gw < extra ? 1 : 0);
    int i = 0;
    for (; i + 4 <= ntok; i += 4) embed_rows<4>(p, tok0 + i, lane);
    for (; i < ntok; ++i) embed_rows<1>(p, tok0 + i, lane);
}

constexpr int LDT = 72;
constexpr int GEMM_LDS = 2 * 2 * 128 * LDT * 2;
template <class ARow, class Epi>
DI void gemm_tile128(ARow arow, const bf16_t* __restrict__ Bt, int ldb, int K, int m0, int n0, char* smem, Epi epi) {
    const int tid = tid_(), lane = tid & 63, wid = __builtin_amdgcn_readfirstlane(tid >> 6), fr = lane & 15, fq = lane >> 4;
    const int wr = wid >> 1, wc = wid & 1;
    bf16_t* As = (bf16_t*)smem;
    bf16_t* Bs = As + 2 * 128 * LDT;
    const bf16_t* ap[2]; const bf16_t* bp[2]; int so[2];
#pragma unroll
    for (int i = 0; i < 2; ++i) {
        const int c = tid + NTHR * i, row = c >> 3, kc = c & 7;
        ap[i] = arow(m0 + row) + kc * 8;
        bp[i] = Bt + (size_t)(n0 + row) * ldb + kc * 8;
        so[i] = row * LDT + kc * 8;
    }
    f32x4 acc[2][4];
#pragma unroll
    for (int mi = 0; mi < 2; ++mi)
#pragma unroll
        for (int ni = 0; ni < 4; ++ni) acc[mi][ni] = (f32x4){0.f, 0.f, 0.f, 0.f};
    u32x4 ra[8][2], rb[8][2];
    const int nit = K >> 6;
#define GT_LOAD(slot, it) do { const int it_ = (it) < nit ? (it) : nit - 1;   \
        _Pragma("unroll") for (int i = 0; i < 2; ++i) { ra[slot][i] = *(const u32x4*)(ap[i] + it_ * 64); rb[slot][i] = *(const u32x4*)(bp[i] + it_ * 64); } } while (0)
    GT_LOAD(0, 0); GT_LOAD(1, 1); GT_LOAD(2, 2); GT_LOAD(3, 3); GT_LOAD(4, 4); GT_LOAD(5, 5); GT_LOAD(6, 6); GT_LOAD(7, 7);
    __syncthreads();
#define GT_STEP(slot, it) do { \
        bf16_t* Ab = As + ((it) & 1) * 128 * LDT; bf16_t* Bb = Bs + ((it) & 1) * 128 * LDT; \
        _Pragma("unroll") for (int i = 0; i < 2; ++i) { *(u32x4*)(Ab + so[i]) = ra[slot][i]; *(u32x4*)(Bb + so[i]) = rb[slot][i]; } \
        __syncthreads(); \
        GT_LOAD(slot, (it) + 8); \
        _Pragma("unroll") for (int ks = 0; ks < 2; ++ks) { \
            bf16x8 af[2], bf[4]; \
            _Pragma("unroll") for (int mi = 0; mi < 2; ++mi) af[mi] = *(const bf16x8*)(Ab + (wr * 32 + mi * 16 + fr) * LDT + ks * 32 + fq * 8); \
            _Pragma("unroll") for (int ni = 0; ni < 4; ++ni) bf[ni] = *(const bf16x8*)(Bb + (wc * 64 + ni * 16 + fr) * LDT + ks * 32 + fq * 8); \
            _Pragma("unroll") for (int mi = 0; mi < 2; ++mi) _Pragma("unroll") for (int ni = 0; ni < 4; ++ni) acc[mi][ni] = __builtin_amdgcn_mfma_f32_16x16x32_bf16(bf[ni], af[mi], acc[mi][ni], 0, 0, 0); \
        } } while (0)
#pragma unroll 1
    for (int it = 0; it < nit; it += 8) { GT_STEP(0, it); GT_STEP(1, it + 1); GT_STEP(2, it + 2); GT_STEP(3, it + 3); GT_STEP(4, it + 4); GT_STEP(5, it + 5); GT_STEP(6, it + 6); GT_STEP(7, it + 7); }
#undef GT_LOAD
#undef GT_STEP
#pragma unroll
    for (int mi = 0; mi < 2; ++mi)
#pragma unroll
        for (int ni = 0; ni < 4; ++ni) epi(mi, m0 + wr * 32 + mi * 16 + fr, n0 + wc * 64 + ni * 16 + fq * 4, acc[mi][ni]);
}

namespace g8 {
#define G8_LAS __attribute__((address_space(3)))
constexpr int BM = 256, BK = 64, HALF = 128, HTB = HALF * BK * 2, STAGE_BYTES = 8 * HTB, NXCD = 8, WGM = 8;
DI int lds_byte(int r, int c) { const int st = (r >> 4) * 2 + (c >> 5), rr = r & 15, cc = c & 31, ob = rr * 64 + cc * 2; return st * 1024 + (ob ^ (((ob >> 9) & 1) << 5)); }
DI void stage_rc(int b, int& R, int& C) { const int st = b / 1024, sb = b % 1024, swz = sb ^ (((sb >> 9) & 1) << 5); R = (st >> 1) * 16 + swz / 64; C = (st & 1) * 32 + (swz % 64) / 2; }
DI int perm32(int rho) { const int n = rho >> 4, i = rho & 15; return 8 * (i >> 2) + 4 * n + (i & 3); }
struct Unit { int pm, pn; const char* A; const char* B; int e, slot0, cnt; };

struct DenseOrder {
    int nM, nN, nwg, G, c; const char* A; const char* B; size_t tstep;
    DI void init(const bf16_t* A_, const bf16_t* Bt_, int nM_, int nN_, int K, int G_, int c_) { nM = nM_; nN = nN_; nwg = nM * nN; G = G_; c = c_; A = (const char*)A_; B = (const char*)Bt_; tstep = (size_t)BM * K * 2; }
    DI bool next(int i, Unit& u) const {
        const long Lq = (long)i * G + c; if (Lq >= nwg) return false;
        int wgid = (int)Lq; { const int q = nwg / NXCD, r = nwg % NXCD, xcd = wgid % NXCD, off = wgid / NXCD; wgid = (xcd < r ? xcd * (q + 1) : r * (q + 1) + (xcd - r) * q) + off; }
        const int nig = WGM * nN, gid = wgid / nig, fm = gid * WGM, gsz = (nM - fm) < WGM ? (nM - fm) : WGM;
        u.pm = fm + ((wgid % nig) % gsz); u.pn = (wgid % nig) / gsz; u.A = A + (size_t)u.pm * tstep; u.B = B + (size_t)u.pn * tstep; u.e = 0; u.slot0 = 0; u.cnt = 0; return true;
    }
    DI unsigned row_off(const Unit&, int) const { return 0u; }
};

template <bool GATHER, class Epi, class Sched>
DI void gemm8(G8_LAS unsigned char* lds, const int K, const Sched& S, const Epi& E) {
    const int tid = tid_(), wid = __builtin_amdgcn_readfirstlane(tid >> 6), lane = tid & 63, wr = wid >> 2, wc = wid & 3, fr = lane & 15, fq = lane >> 4;
    const int nt = K / BK;
    int Rr[2], Cc[2]; unsigned voffB[2], voffA[2];
#pragma unroll
    for (int i = 0; i < 2; ++i) { stage_rc(tid * 16 + i * 8192, Rr[i], Cc[i]); const int Rb = Epi::PERM ? ((Rr[i] & ~31) + perm32(Rr[i] & 31)) : Rr[i]; voffB[i] = (unsigned)(Rb * K + Cc[i]) * 2u; voffA[i] = (unsigned)(Rr[i] * K + Cc[i]) * 2u; }
    const size_t kstep = (size_t)(BK * 2), hstep = (size_t)HALF * K * 2;
    const unsigned ldsw = (unsigned)wid * 1024u;
    const int aoff = lds_byte(wr * 64 + fr, fq * 8), boff = lds_byte(wc * 32 + fr, fq * 8);
#define G8_SA(b, h) (((b) * 2 + (h)) * HTB)
#define G8_SB(b, h) ((4 + (b) * 2 + (h)) * HTB)
#define G8_STAGE(bufoff, gbase, voff) do { _Pragma("unroll") for (int _i = 0; _i < 2; ++_i) \
        __builtin_amdgcn_global_load_lds((const unsigned*)((const char*)(gbase) + (voff)[_i]), (G8_LAS unsigned*)(lds + (bufoff) + ldsw + _i * 8192), 16, 0, 0); } while (0)
#define G8_LDA(dst, b, h) do { _Pragma("unroll") for (int m = 0; m < 4; ++m) _Pragma("unroll") for (int k = 0; k < 2; ++k) dst[m][k] = *(const G8_LAS bf16x8*)(lds + G8_SA(b, h) + aoff + m * 2048 + k * 1024); } while (0)
#define G8_LDB(dst, b, h) do { _Pragma("unroll") for (int n = 0; n < 2; ++n) _Pragma("unroll") for (int k = 0; k < 2; ++k) dst[n][k] = *(const G8_LAS bf16x8*)(lds + G8_SB(b, h) + boff + n * 2048 + k * 1024); } while (0)
#define G8_MMA(ai, bj, At, Bt) do { __builtin_amdgcn_s_setprio(1); _Pragma("unroll") for (int m = 0; m < 4; ++m) _Pragma("unroll") for (int n = 0; n < 2; ++n) _Pragma("unroll") for (int k = 0; k < 2; ++k) \
        acc[ai][bj][m][n] = __builtin_amdgcn_mfma_f32_16x16x32_bf16(Bt[n][k], At[m][k], acc[ai][bj][m][n], 0, 0, 0); __builtin_amdgcn_s_setprio(0); } while (0)
#define G8_WAIT_V(n) asm volatile("s_waitcnt vmcnt(" #n ")" ::: "memory")
#define G8_WAIT_L(n) asm volatile("s_waitcnt lgkmcnt(" #n ")" ::: "memory")
#define G8_BAR __builtin_amdgcn_s_barrier()
#define G8_SCHED __builtin_amdgcn_sched_barrier(0)
#define G8_AOFF(dst, un) do { if (GATHER) { _Pragma("unroll") for (int _h = 0; _h < 2; ++_h) _Pragma("unroll") for (int _i = 0; _i < 2; ++_i) \
        dst[_h][_i] = S.row_off(un, _h * HALF + Rr[_i]) + (unsigned)Cc[_i] * 2u; } } while (0)
#define G8_STAGE_A(bufoff, gb, vo, h) do { if (GATHER) { G8_STAGE(bufoff, gb, vo[h]); } else { G8_STAGE(bufoff, (gb) + (h) * hstep, voffA); } } while (0)
    Unit cur, nxt; int ui = 0;
    if (!S.next(0, cur)) return;
    f32x4 acc[2][2][4][2];
#pragma unroll
    for (int a = 0; a < 2; ++a)
#pragma unroll
        for (int b = 0; b < 2; ++b)
#pragma unroll
            for (int m = 0; m < 4; ++m)
#pragma unroll
                for (int n = 0; n < 2; ++n) acc[a][b][m][n] = (f32x4){0.f, 0.f, 0.f, 0.f};
    bf16x8 At[4][2], B0[2][2], B1[2][2];
    unsigned cvA[2][2], nvA[2][2];
    G8_AOFF(cvA, cur);
    const char* cA = cur.A; const char* cB = cur.B;
    G8_STAGE(G8_SB(0, 0), cB, voffB); G8_STAGE_A(G8_SA(0, 0), cA, cvA, 0); G8_STAGE(G8_SB(0, 1), cB + hstep, voffB); G8_STAGE_A(G8_SA(0, 1), cA, cvA, 1);
    if (wr == 1) G8_BAR;
    G8_WAIT_V(4); G8_BAR;
    G8_STAGE(G8_SB(1, 0), cB + kstep, voffB); G8_STAGE_A(G8_SA(1, 0), cA + kstep, cvA, 0); G8_STAGE(G8_SB(1, 1), cB + hstep + kstep, voffB);
    G8_WAIT_V(6); G8_BAR;
    for (;;) {
        const bool has_next = S.next(ui + 1, nxt);
        const char* nA = has_next ? nxt.A : cA; const char* nB = has_next ? nxt.B : cB;
        if (GATHER) {
            if (has_next) { G8_AOFF(nvA, nxt); } else {
#pragma unroll
                for (int h = 0; h < 2; ++h)
#pragma unroll
                    for (int i = 0; i < 2; ++i) nvA[h][i] = cvA[h][i];
            }
        }
        for (int t = 0; t < nt; t += 2) {
            const bool last = (t == nt - 2);
            const char* a1 = cA + (size_t)(t + 1) * kstep;
            const char* a2 = last ? nA : cA + (size_t)(t + 2) * kstep; const char* b2 = last ? nB : cB + (size_t)(t + 2) * kstep;
            const char* a3 = a2 + kstep; const char* b3 = b2 + kstep;

            G8_LDB(B0, 0, 0); G8_SCHED; G8_LDA(At, 0, 0); G8_STAGE_A(G8_SA(1, 1), a1, cvA, 1);
            if (GATHER && last) {
#pragma unroll
                for (int h = 0; h < 2; ++h)
#pragma unroll
                    for (int i = 0; i < 2; ++i) cvA[h][i] = nvA[h][i];
            }
            G8_WAIT_L(8); G8_BAR; G8_WAIT_L(0); G8_MMA(0, 0, At, B0); G8_BAR; G8_SCHED;
            G8_LDB(B1, 0, 1); G8_STAGE(G8_SB(0, 0), b2, voffB);
            G8_BAR; G8_WAIT_L(0); G8_MMA(0, 1, At, B1); G8_BAR;
            G8_LDA(At, 0, 1); G8_STAGE_A(G8_SA(0, 0), a2, cvA, 0);
            G8_BAR; G8_WAIT_L(0); G8_MMA(1, 0, At, B0); G8_BAR; G8_SCHED;
            G8_STAGE(G8_SB(0, 1), b2 + hstep, voffB);
            G8_WAIT_V(6); G8_BAR; G8_MMA(1, 1, At, B1); G8_BAR;
            G8_LDB(B0, 1, 0); G8_SCHED; G8_LDA(At, 1, 0); G8_STAGE_A(G8_SA(0, 1), a2, cvA, 1);
            G8_WAIT_L(8); G8_BAR; G8_WAIT_L(0); G8_MMA(0, 0, At, B0); G8_BAR; G8_SCHED;
            G8_LDB(B1, 1, 1); G8_STAGE(G8_SB(1, 0), b3, voffB);
            G8_BAR; G8_WAIT_L(0); G8_MMA(0, 1, At, B1); G8_BAR;
            G8_LDA(At, 1, 1); G8_STAGE_A(G8_SA(1, 0), a3, cvA, 0);
            G8_BAR; G8_WAIT_L(0); G8_MMA(1, 0, At, B0); G8_BAR; G8_SCHED;
            G8_STAGE(G8_SB(1, 1), b3 + hstep, voffB);
            G8_WAIT_V(6); G8_BAR; G8_MMA(1, 1, At, B1); G8_BAR;
        }
        { int fr2 = fr, fq2 = fq; asm volatile("" : "+v"(fr2), "+v"(fq2)); E(acc, cur, wr, wc, fr2, fq2); }
        if (!has_next) break;
#pragma unroll
        for (int a = 0; a < 2; ++a)
#pragma unroll
            for (int b = 0; b < 2; ++b)
#pragma unroll
                for (int m = 0; m < 4; ++m)
#pragma unroll
                    for (int n = 0; n < 2; ++n) acc[a][b][m][n] = (f32x4){0.f, 0.f, 0.f, 0.f};
        cur = nxt; cA = nA; cB = nB; ++ui;
    }
    G8_WAIT_V(0);
    if (wr == 0) G8_BAR;
    G8_BAR;
#undef G8_SA
#undef G8_SB
#undef G8_STAGE
#undef G8_LDA
#undef G8_LDB
#undef G8_MMA
#undef G8_WAIT_V
#undef G8_WAIT_L
#undef G8_BAR
#undef G8_SCHED
#undef G8_AOFF
#undef G8_STAGE_A
}
}

constexpr int MFULL = 64, M0_LEFT = MFULL * 256;
constexpr float SB_KSCALE = 0.18033688011112042f;
struct EpiStore {
    static constexpr bool PERM = true;
    bf16_t* O; int ldc; bool sig;
    DI void operator()(const f32x4 (&acc)[2][2][4][2], const g8::Unit& u, int wr, int wc, int fr, int fq) const {
        const float sc = (!sig && (u.pn == OFF_K / 256 || u.pn == OFF_K / 256 + 1)) ? SB_KSCALE : 1.0f;
#pragma unroll
        for (int ai = 0; ai < 2; ++ai)
#pragma unroll
            for (int m = 0; m < 4; ++m) {
                bf16_t* rowp = O + (size_t)(u.pm * 256 + ai * 128 + wr * 64 + m * 16 + fr) * ldc + u.pn * 256 + wc * 32 + 8 * fq;
#pragma unroll
                for (int bj = 0; bj < 2; ++bj) {
                    f32x4 v0 = acc[ai][bj][m][0] * sc, v1 = acc[ai][bj][m][1] * sc;
                    if (sig) {
#pragma unroll
                        for (int e = 0; e < 4; ++e) { v0[e] = sigmoidf_(v0[e]); v1[e] = sigmoidf_(v1[e]); }
                    }
                    *(u32x4*)(rowp + bj * 128) = (u32x4){pack2(v0[0], v0[1]), pack2(v0[2], v0[3]), pack2(v1[0], v1[1]), pack2(v1[2], v1[3])};
                }
            }
    }
};
DI int left_first(int units, int bid, int nb) { return (bid - units % nb + nb) % nb; }

constexpr int LEFT_LDS = 2 * (32 + 128) * LDT * 2;
template <class ARow, class Epi>
DI void gemm_left32(ARow arow, const bf16_t* __restrict__ Bt, int ldb, int K, int n0, char* smem, Epi epi) {
    const int tid = tid_(), lane = tid & 63, wid = __builtin_amdgcn_readfirstlane(tid >> 6), fr = lane & 15, fq = lane >> 4;
    bf16_t* As = (bf16_t*)smem;
    bf16_t* Bs = As + 2 * 32 * LDT;
    const int arow_i = tid >> 4, akc = (tid & 15) * 4;
    const bf16_t* ap = arow(arow_i) + akc;
    const bf16_t* bp[2]; int bso[2];
#pragma unroll
    for (int i = 0; i < 2; ++i) { const int cc = tid + NTHR * i, row = cc >> 3, kc = cc & 7; bp[i] = Bt + (size_t)(n0 + row) * ldb + kc * 8; bso[i] = row * LDT + kc * 8; }
    const int nit = K / 64;
    u32x2 ra[4]; u32x4 rb[4][2];
#define GL_LOAD(slot, it) do { if ((it) < nit) { ra[slot] = *(const u32x2*)(ap + (it) * 64); rb[slot][0] = *(const u32x4*)(bp[0] + (it) * 64); rb[slot][1] = *(const u32x4*)(bp[1] + (it) * 64); } } while (0)
#define GL_WRITE(slot, buf) do { *(u32x2*)(As + (buf) * 32 * LDT + arow_i * LDT + akc) = ra[slot]; *(u32x4*)(Bs + (buf) * 128 * LDT + bso[0]) = rb[slot][0]; *(u32x4*)(Bs + (buf) * 128 * LDT + bso[1]) = rb[slot][1]; } while (0)
    f32x4 acc[2] = {(f32x4){0.f, 0.f, 0.f, 0.f}, (f32x4){0.f, 0.f, 0.f, 0.f}};
    GL_LOAD(0, 0); GL_LOAD(1, 1); GL_LOAD(2, 2); GL_LOAD(3, 3);
    __syncthreads();
    GL_WRITE(0, 0);
    __syncthreads();
#define GL_STEP(slot, it) do { \
        GL_LOAD(slot, (it) + 4); \
        const int buf = (it) & 1; \
        _Pragma("unroll") for (int ks = 0; ks < 2; ++ks) { \
            const bf16x8 bf = *(const bf16x8*)(Bs + buf * 128 * LDT + (wid * 16 + fr) * LDT + ks * 32 + fq * 8); \
            _Pragma("unroll") for (int mt = 0; mt < 2; ++mt) { \
                const bf16x8 af = *(const bf16x8*)(As + buf * 32 * LDT + (mt * 16 + fr) * LDT + ks * 32 + fq * 8); \
                acc[mt] = __builtin_amdgcn_mfma_f32_16x16x32_bf16(bf, af, acc[mt], 0, 0, 0); } } \
        if ((it) + 1 < nit) { GL_WRITE(((slot) + 1) & 3, buf ^ 1); } \
        __syncthreads(); } while (0)
    for (int it = 0; it < nit; it += 4) {
        GL_STEP(0, it);
        if (it + 1 < nit) GL_STEP(1, it + 1);
        if (it + 2 < nit) GL_STEP(2, it + 2);
        if (it + 3 < nit) GL_STEP(3, it + 3);
    }
#undef GL_LOAD
#undef GL_WRITE
#undef GL_STEP
#pragma unroll
    for (int mt = 0; mt < 2; ++mt) epi(mt * 16 + fr, n0 + wid * 16 + fq * 4, acc[mt]);
}

DI void phase_inproj(const Params& p, int layer, int bid, int nb, char* smem) {
    const bf16_t* hb = p.hb; bf16_t* P = p.P;
    const bf16_t* Bt = p.WtIn + (size_t)layer * CIN * D;
    g8::DenseOrder S; S.init(hb, Bt, MFULL, CP / 256, D, nb, bid);
    g8::gemm8<false>((G8_LAS unsigned char*)smem, D, S, EpiStore{P, CP, false});
    {
        constexpr int UNITS = MFULL * (CP / 256);
        const int heavy = UNITS % nb;
        if (heavy > 0 && heavy < nb) { if (bid >= heavy) convert_experts(p, layer, 0, NE / 2, bid - heavy, nb - heavy, smem); }
        else convert_experts(p, layer, 0, NE / 2, bid, nb, smem);
    }
    bf16_t* G = p.gleft - (size_t)M0_LEFT * 2048; const bf16_t* Wg = p.WtIn + ((size_t)layer * CIN + CP) * D;
    for (int t = left_first(MFULL * (CP / 256), bid, nb); t < CP / 128 + 2048 / 128; t += nb) {
        if (t < CP / 128)
            gemm_left32([=](int r) { return hb + (size_t)(M0_LEFT + r) * D; }, Bt, D, D, t * 128, smem,
                        [=](int r, int c, f32x4 v) { const float sc = (c >= OFF_K && c < OFF_K + 512) ? SB_KSCALE : 1.0f;
                                                     *(u32x2*)(P + (size_t)(M0_LEFT + r) * CP + c) = (u32x2){pack2(v[0] * sc, v[1] * sc), pack2(v[2] * sc, v[3] * sc)}; });
        else
            gemm_left32([=](int r) { return hb + (size_t)(M0_LEFT + r) * D; }, Wg, D, D, (t - CP / 128) * 128, smem,
                        [=](int r, int c, f32x4 v) { *(u32x2*)(G + (size_t)(M0_LEFT + r) * 2048 + c) = (u32x2){pack2(sigmoidf_(v[0]), sigmoidf_(v[1])), pack2(sigmoidf_(v[2]), sigmoidf_(v[3]))}; });
    }
}

constexpr int NCHUNK = (L + 63) / 64, NUNIT = NBATCH * HEADS * NCHUNK;
constexpr int LS = 72, RB = 64 * LS * 2;
constexpr int R1_LDS = 16 * RB + 4096 + 7168;
#define RBUF(i) ((bf16_t*)(smem + (i) * RB))
#define T4OFF(u, rt, ct, ln) (((((size_t)(u) * 16 + (rt) * 4 + (ct)) * 64) + (ln)) * 4)
typedef float f32x16 __attribute__((ext_vector_type(16)));

template <int KK> DI f32x4 mm16(const bf16_t* F, int ldf, const bf16_t* S, int lds_, f32x4 acc, int lane) {
    const int fr = lane & 15, fq = lane >> 4;
#pragma unroll
    for (int ks = 0; ks < KK / 32; ++ks) {
        const bf16x8 f = *(const bf16x8*)(F + fr * ldf + ks * 32 + fq * 8);
        const bf16x8 g = *(const bf16x8*)(S + fr * lds_ + ks * 32 + fq * 8);
        acc = __builtin_amdgcn_mfma_f32_16x16x32_bf16(f, g, acc, 0, 0, 0);
    }
    return acc;
}
DI u32x2 pk4(f32x4 v) { return (u32x2){pack2(v[0], v[1]), pack2(v[2], v[3])}; }
DI f32x4 up4(u32x2 v) { return (f32x4){lo_bf(v[0]), hi_bf(v[0]), lo_bf(v[1]), hi_bf(v[1])}; }

typedef short s16x4 __attribute__((ext_vector_type(4)));
DI f32x4 mf16(u32x2 a, u32x2 b, f32x4 c) { return __builtin_amdgcn_mfma_f32_16x16x16bf16_1k(__builtin_bit_cast(s16x4, a), __builtin_bit_cast(s16x4, b), c, 0, 0, 0); }
DI void r1_diag_inverse(u32x2 mk, u32x2 mkt, bf16_t* Tb, int a, int lane) {
    const int fr = lane & 15, fq = lane >> 4;
    const f32x4 zero = (f32x4){0.f, 0.f, 0.f, 0.f};
    f32x4 eye;
#pragma unroll
    for (int e = 0; e < 4; ++e) eye[e] = (4 * fq + e == fr) ? 1.f : 0.f;
    f32x4 YT = up4(mkt) + eye;
    u32x2 yt = pk4(YT);
#pragma unroll
    for (int k = 0; k < 3; ++k) {
        const f32x4 s2 = mf16(mkt, mk, zero);
        if (k < 2) { const f32x4 s2t = mf16(mk, mkt, zero); mkt = pk4(s2t); }
        mk = pk4(s2);
        YT = mf16(mk, yt, YT);
        yt = pk4(YT);
    }
    *(u32x2*)(Tb + (16 * a + fr) * LS + 16 * a + 4 * fq) = yt;
}

template <int MODE> DI void phase_rwkv_r1(const Params& p, int layer, int bid, int nb, char* smem) {
    const int wv = __builtin_amdgcn_readfirstlane(tid_() >> 6);
    const f32x4 zero = (f32x4){0.f, 0.f, 0.f, 0.f};
    float* lwT = (float*)RBUF(4);
    float* aT = (float*)RBUF(6);
    float* gt = (float*)(smem + 16 * RB);
    float* gammaC = gt + 512;
    bf16_t* Xt0 = RBUF(14);
    bf16_t* Xt1 = RBUF(4);
    const bf16_t* WupT = p.WupT + (size_t)layer * 512 * 64, *AupT = p.AupT + (size_t)layer * 512 * 64, *GupT = p.GupT + (size_t)layer * 512 * 128;
    float* mu = (float*)(smem + 16 * RB + 4096);
    __syncthreads();
    for (int i = tid_(); i < RSW; i += NTHR) mu[i] = p.mu[(size_t)layer * RSW + i];
    for (int it = 0;; ++it) {
        const int tid = tid_(), lane = tid & 63, fr = lane & 15, fq = lane >> 4;
        int c, bh;
        if (MODE == 0) {
            const int Lq = it * nb + bid, q = Lq >> 3, cb = (q >> 3) * 8 + (Lq & 7);
            if (cb >= NBATCH * (NCHUNK - 1)) break;
            c = cb % (NCHUNK - 1); bh = (cb / (NCHUNK - 1)) * HEADS + (q & 7);
        } else {
            if (it > 0) break;
            c = NCHUNK - 1; bh = bid;
        }
        const int u = bh * NCHUNK + c, h = bh % HEADS, bb = bh / HEADS;
        const size_t tok0 = (size_t)bb * L + c * 64;
        bf16x8 fw[2][2], fa[2][2], fg[2][4];
        const int cgp = layer * 512 + h * 64 + (tid & 7) * 8, cge = layer * 512 + h * 64 + lane;
        const f32x4 pkk0 = *(const f32x4*)(p.k_k + cgp), pkk1 = *(const f32x4*)(p.k_k + cgp + 4), pka0 = *(const f32x4*)(p.k_a + cgp), pka1 = *(const f32x4*)(p.k_a + cgp + 4);
        const f32x4 prk0 = *(const f32x4*)(p.r_k + cgp), prk1 = *(const f32x4*)(p.r_k + cgp + 4);
        const float ekk = p.k_k[cge], eka = p.k_a[cge];
        float lw0[2]; f32x4 la0[2];
#pragma unroll
        for (int t2 = 0; t2 < 2; ++t2) {
            const int tl = wv * 2 + t2, pt = tl >> 2, qt = tl & 3;
            lw0[t2] = p.w0[layer * 512 + h * 64 + qt * 16 + fr];
            la0[t2] = *(const f32x4*)(p.a0 + layer * 512 + h * 64 + pt * 16 + fq * 4);
        }
        __syncthreads();
        {
            const int i = tid >> 3, c8 = (tid & 7) * 8, t = c * 64 + i;
            u32x4 curv[7], prvv[7];
#pragma unroll
            for (int it2 = 0; it2 < 7; ++it2) {
                const int col = (it2 == 0 ? RW_R + h * 64 : it2 == 1 ? RW_K + h * 64 : it2 == 2 ? RW_V + h * 64 : RW_WD + (it2 - 3) * 64) + c8;
                curv[it2] = (u32x4){0u, 0u, 0u, 0u}; prvv[it2] = (u32x4){0u, 0u, 0u, 0u};
                if (t < L) curv[it2] = *(const u32x4*)(p.P + (tok0 + i) * CP + OFF_RW + col);
                if (t < L && t > 0) prvv[it2] = *(const u32x4*)(p.P + (tok0 + i - 1) * CP + OFF_RW + col);
            }
#pragma unroll
            for (int it2 = 0; it2 < 7; ++it2) {
                const int col = (it2 == 0 ? RW_R + h * 64 : it2 == 1 ? RW_K + h * 64 : it2 == 2 ? RW_V + h * 64 : RW_WD + (it2 - 3) * 64) + c8;
                bf16_t* dst = it2 == 0 ? RBUF(8) + i * LS + c8 : it2 == 1 ? RBUF(9) + i * LS + c8 : it2 == 2 ? RBUF(10) + i * LS + c8
                            : it2 == 3 ? RBUF(0) + i * LS + c8 : it2 == 4 ? RBUF(1) + i * LS + c8 : RBUF(2) + i * 136 + (it2 - 5) * 64 + c8;
                const f32x4 m0 = *(const f32x4*)(mu + col), m1 = *(const f32x4*)(mu + col + 4);
                const u32x4 cur = curv[it2], prv = prvv[it2];
                float x[8];
#pragma unroll
                for (int j2 = 0; j2 < 4; ++j2) {
                    const float c0 = lo_bf(cur[j2]), c1 = hi_bf(cur[j2]), p0 = lo_bf(prv[j2]), p1 = hi_bf(prv[j2]);
                    const float mm0 = j2 < 2 ? m0[2 * j2] : m1[2 * j2 - 4], mm1 = j2 < 2 ? m0[2 * j2 + 1] : m1[2 * j2 - 3];
                    x[2 * j2] = c0 + (p0 - c0) * mm0; x[2 * j2 + 1] = c1 + (p1 - c1) * mm1;
                }
                if (it2 == 3) {
#pragma unroll
                    for (int j2 = 0; j2 < 8; ++j2) x[j2] = tanhf_(x[j2]);
                } else if (it2 >= 5) {
#pragma unroll
                    for (int j2 = 0; j2 < 8; ++j2) x[j2] = sigmoidf_(x[j2]);
                }
                *(u32x4*)dst = (u32x4){pack2(x[0], x[1]), pack2(x[2], x[3]), pack2(x[4], x[5]), pack2(x[6], x[7])};
            }
        }
#pragma unroll
        for (int t2 = 0; t2 < 2; ++t2) {
            const int tl = wv * 2 + t2, pt = tl >> 2, qt = tl & 3;
#pragma unroll
            for (int ks = 0; ks < 2; ++ks) {
                fw[t2][ks] = *(const bf16x8*)(WupT + (size_t)(h * 64 + qt * 16 + fr) * 64 + ks * 32 + fq * 8);
                fa[t2][ks] = *(const bf16x8*)(AupT + (size_t)(h * 64 + pt * 16 + fr) * 64 + ks * 32 + fq * 8);
            }
#pragma unroll
            for (int ks = 0; ks < 4; ++ks) fg[t2][ks] = *(const bf16x8*)(GupT + (size_t)(h * 64 + pt * 16 + fr) * 128 + ks * 32 + fq * 8);
        }
        __syncthreads();
#pragma unroll
        for (int t2 = 0; t2 < 2; ++t2) {
            const int tl = wv * 2 + t2, pt = tl >> 2, qt = tl & 3;
            f32x4 aw = zero, aa = zero, ag = zero;
#pragma unroll
            for (int ks = 0; ks < 2; ++ks) {
                const bf16x8 xw = *(const bf16x8*)(RBUF(0) + (pt * 16 + fr) * LS + ks * 32 + fq * 8);
                aw = __builtin_amdgcn_mfma_f32_16x16x32_bf16(xw, fw[t2][ks], aw, 0, 0, 0);
                const bf16x8 xa = *(const bf16x8*)(RBUF(1) + (qt * 16 + fr) * LS + ks * 32 + fq * 8);
                aa = __builtin_amdgcn_mfma_f32_16x16x32_bf16(fa[t2][ks], xa, aa, 0, 0, 0);
            }
#pragma unroll
            for (int ks = 0; ks < 4; ++ks) {
                const bf16x8 xg = *(const bf16x8*)(RBUF(2) + (qt * 16 + fr) * 136 + ks * 32 + fq * 8);
                ag = __builtin_amdgcn_mfma_f32_16x16x32_bf16(fg[t2][ks], xg, ag, 0, 0, 0);
            }
            const int ch = qt * 16 + fr;
            const float w0 = lw0[t2];
            const f32x4 a0 = la0[t2];
            f32x4 lw, av;
#pragma unroll
            for (int e = 0; e < 4; ++e) { lw[e] = -DECAY_SCALE * sigmoidf_(w0 + aw[e]); av[e] = sigmoidf_(a0[e] + aa[e]); }
            *(f32x4*)(lwT + ch * 68 + pt * 16 + fq * 4) = lw;
            *(f32x4*)(aT + (qt * 16 + fr) * 68 + pt * 16 + fq * 4) = av;
            *(u32x2*)(p.GG + T4OFF(u, qt, pt, lane)) = pk4(ag);
        }
        __syncthreads();
        {
            const int i = tid >> 3, c8 = (tid & 7) * 8;
            const u32x4 xr = *(const u32x4*)(RBUF(8) + i * LS + c8), xk = *(const u32x4*)(RBUF(9) + i * LS + c8);
            const f32x4 a0 = *(const f32x4*)(aT + i * 68 + c8), a1 = *(const f32x4*)(aT + i * 68 + c8 + 4);
            const f32x4 kk0 = pkk0, kk1 = pkk1, ka0 = pka0, ka1 = pka1, rk0 = prk0, rk1 = prk1;
            float n2 = 0.f, bon = 0.f;
#pragma unroll
            for (int j = 0; j < 8; ++j) {
                const float r_ = (j & 1) ? hi_bf(xr[j >> 1]) : lo_bf(xr[j >> 1]), k_ = (j & 1) ? hi_bf(xk[j >> 1]) : lo_bf(xk[j >> 1]);
                const float a_ = j < 4 ? a0[j & 3] : a1[j & 3], kkc = j < 4 ? kk0[j & 3] : kk1[j & 3], kac = j < 4 ? ka0[j & 3] : ka1[j & 3], rkc = j < 4 ? rk0[j & 3] : rk1[j & 3];
                const float kkr = k_ * kkc;
                n2 += kkr * kkr;
                bon += r_ * (k_ * (1.0f + (a_ - 1.0f) * kac)) * rkc;
            }
            n2 = sum8(n2); bon = sum8(bon);
            if ((tid & 7) == 0) { gt[576 + i] = 1.0f / fmaxf(sqrtf(n2), 1e-12f); p.bonG[(size_t)u * 64 + i] = bon; }
        }
        __syncthreads();
        {
            const int ch = lane;
            float lw[8], av[8], cum[8];
            {
                const f32x4 l0 = *(const f32x4*)(lwT + ch * 68 + wv * 8), l1 = *(const f32x4*)(lwT + ch * 68 + wv * 8 + 4);
#pragma unroll
                for (int e = 0; e < 4; ++e) { lw[e] = l0[e]; lw[e + 4] = l1[e]; }
#pragma unroll
                for (int e = 0; e < 8; ++e) av[e] = aT[(wv * 8 + e) * 68 + ch];
            }
            float run = 0.f;
#pragma unroll
            for (int e = 0; e < 8; ++e) { run += lw[e]; cum[e] = run; }
            gt[wv * 64 + ch] = run;
            __syncthreads();
            float offs = 0.f, tot = 0.f;
#pragma unroll
            for (int g2 = 0; g2 < 8; ++g2) { const float gv = gt[g2 * 64 + ch]; offs += g2 < wv ? gv : 0.f; tot += gv; }
            if (wv == 0) gammaC[ch] = __expf(tot);
            const float kkc = ekk, kac = eka;
            float at_[8], kt_[8], bt_[8], vt_[8];
#pragma unroll
            for (int e = 0; e < 8; ++e) {
                const int i = wv * 8 + e;
                const float xr = bf2f(RBUF(8)[i * LS + ch]), xk = bf2f(RBUF(9)[i * LS + ch]), xv = bf2f(RBUF(10)[i * LS + ch]);
                const float cm = cum[e] + offs;
                const float kk = xk * kkc * gt[576 + i];
                const float kq = xk * (1.0f + (av[e] - 1.0f) * kac);
                const float eneg = __expf(-cm), epos = __expf(cm), eexc = __expf(cm - lw[e]);
                at_[e] = -kk * eexc; kt_[e] = kq * eneg; bt_[e] = kk * av[e] * eneg; vt_[e] = xv;
                RBUF(3)[i * LS + ch] = f2bf(xr * epos);
            }
#pragma unroll
            for (int e = 0; e < 8; ++e) {
                const int i = wv * 8 + e;
                if (c * 64 + i < L) p.orw[(tok0 + i) * 512 + h * 64 + ch] = f2bf(vt_[e]);
            }
#pragma unroll
            for (int e = 0; e < 8; ++e) {
                const int i = wv * 8 + e;
                RBUF(0)[i * LS + ch] = f2bf(at_[e]); RBUF(1)[i * LS + ch] = f2bf(kt_[e]); RBUF(2)[i * LS + ch] = f2bf(bt_[e]);
            }
            *(u32x4*)(RBUF(11) + ch * LS + wv * 8) = (u32x4){pack2(kt_[0], kt_[1]), pack2(kt_[2], kt_[3]), pack2(kt_[4], kt_[5]), pack2(kt_[6], kt_[7])};
            *(u32x4*)(RBUF(12) + ch * LS + wv * 8) = (u32x4){pack2(bt_[0], bt_[1]), pack2(bt_[2], bt_[3]), pack2(bt_[4], bt_[5]), pack2(bt_[6], bt_[7])};
            *(u32x4*)(RBUF(13) + ch * LS + wv * 8) = (u32x4){pack2(vt_[0], vt_[1]), pack2(vt_[2], vt_[3]), pack2(vt_[4], vt_[5]), pack2(vt_[6], vt_[7])};
            *(u32x4*)(Xt0 + ch * LS + wv * 8) = (u32x4){pack2(at_[0], at_[1]), pack2(at_[2], at_[3]), pack2(at_[4], at_[5]), pack2(at_[6], at_[7])};
        }
        __syncthreads();
#define R1_LDF(buf, row0, ks) (*(const bf16x8*)((buf) + ((row0) + fr) * LS + (ks) * 32 + fq * 8))
        {
            const int qt = wv & 3, qi = qt * 16 + fr, pt0 = wv >> 2;
            bf16x8 sA[2], sR[2], fK[2][2], fB[2][2];
#pragma unroll
            for (int ks = 0; ks < 2; ++ks) { sA[ks] = R1_LDF(RBUF(0), qt * 16, ks); sR[ks] = R1_LDF(RBUF(3), qt * 16, ks); }
#pragma unroll
            for (int rep = 0; rep < 2; ++rep) {
                const int pt = pt0 + 2 * rep;
                if (pt <= qt) {
#pragma unroll
                    for (int ks = 0; ks < 2; ++ks) { fK[rep][ks] = R1_LDF(RBUF(1), pt * 16, ks); fB[rep][ks] = R1_LDF(RBUF(2), pt * 16, ks); }
                }
            }
#pragma unroll
            for (int rep = 0; rep < 2; ++rep) {
                const int pt = pt0 + 2 * rep;
                f32x4 acc[4] = {zero, zero, zero, zero};
                if (pt <= qt) {
#pragma unroll
                    for (int ks = 0; ks < 2; ++ks) {
                        acc[0] = __builtin_amdgcn_mfma_f32_16x16x32_bf16(fK[rep][ks], sA[ks], acc[0], 0, 0, 0);
                        acc[1] = __builtin_amdgcn_mfma_f32_16x16x32_bf16(fB[rep][ks], sA[ks], acc[1], 0, 0, 0);
                        acc[2] = __builtin_amdgcn_mfma_f32_16x16x32_bf16(fK[rep][ks], sR[ks], acc[2], 0, 0, 0);
                        acc[3] = __builtin_amdgcn_mfma_f32_16x16x32_bf16(fB[rep][ks], sR[ks], acc[3], 0, 0, 0);
                    }
                }
#pragma unroll
                for (int prod = 0; prod < 4; ++prod) {
                    bf16_t* O = prod == 0 ? RBUF(6) : prod == 1 ? RBUF(7) : prod == 2 ? RBUF(9) : RBUF(10);
#pragma unroll
                    for (int e = 0; e < 4; ++e) {
                        const int pi = pt * 16 + fq * 4 + e;
                        const bool keep = prod < 2 ? pi < qi : pi <= qi;
                        acc[prod][e] = keep ? acc[prod][e] : 0.f;
                    }
                    *(u32x2*)(O + qi * LS + pt * 16 + fq * 4) = pk4(acc[prod]);
                }
                if (pt == qt) {
                    f32x4 am = zero;
#pragma unroll
                    for (int ks = 0; ks < 2; ++ks) am = __builtin_amdgcn_mfma_f32_16x16x32_bf16(sA[ks], fB[rep][ks], am, 0, 0, 0);
#pragma unroll
                    for (int e = 0; e < 4; ++e) am[e] = (fq * 4 + e > fr) ? am[e] : 0.f;
                    r1_diag_inverse(pk4(am), pk4(acc[1]), RBUF(4), pt, lane);
                }
            }
        }
        __syncthreads();
        f32x4 X[4];
        if (wv < 4) {
            const bf16_t* xp = Xt0 + (wv * 16 + fr) * LS + fq * 4;
#pragma unroll
            for (int a = 0; a < 4; ++a) X[a] = up4(*(const u32x2*)(xp + 16 * a));
        } else {
            const bf16_t* Nr = RBUF(6) + fr * LS + fq * 4;
            const bf16_t* vp = RBUF(13) + ((wv - 4) * 16 + fr) * LS + fq * 4;
            u32x2 vb[4], nn[10];
#pragma unroll
            for (int b = 0; b < 4; ++b) vb[b] = *(const u32x2*)(vp + 16 * b);
#pragma unroll
            for (int a = 0; a < 4; ++a)
#pragma unroll
                for (int b = 0; b <= a; ++b) nn[a * (a + 1) / 2 + b] = *(const u32x2*)(Nr + 16 * a * LS + 16 * b);
#pragma unroll
            for (int a = 0; a < 4; ++a) {
                f32x4 acc = zero;
#pragma unroll
                for (int b = 0; b <= a; ++b) acc = mf16(nn[a * (a + 1) / 2 + b], vb[b], acc);
                X[a] = acc;
            }
        }
        {
            const bf16_t* Tb = RBUF(4), *Mr = RBUF(7);
            bf16_t* xp = Xt0 + (wv * 16 + fr) * LS + fq * 4;
#define FS_M(a, b) (*(const u32x2*)(Mr + (16 * (a) + fr) * LS + 16 * (b) + 4 * fq))
#define FS_D(a)    (*(const u32x2*)(Tb + (16 * (a) + fr) * LS + 16 * (a) + 4 * fq))
            const u32x2 d0 = FS_D(0), d1 = FS_D(1), d2 = FS_D(2), d3 = FS_D(3);
            const u32x2 m10 = FS_M(1, 0), m20 = FS_M(2, 0), m21 = FS_M(2, 1), m30 = FS_M(3, 0), m31 = FS_M(3, 1), m32 = FS_M(3, 2);
            const u32x2 y0 = pk4(mf16(d0, pk4(X[0]), zero));
            const f32x4 t1 = mf16(m10, y0, X[1]);
            f32x4 t2 = mf16(m20, y0, X[2]), t3 = mf16(m30, y0, X[3]);
            const u32x2 y1 = pk4(mf16(d1, pk4(t1), zero));
            t2 = mf16(m21, y1, t2); t3 = mf16(m31, y1, t3);
            const u32x2 y2 = pk4(mf16(d2, pk4(t2), zero));
            t3 = mf16(m32, y2, t3);
            const u32x2 y3 = pk4(mf16(d3, pk4(t3), zero));
            *(u32x2*)xp = y0; *(u32x2*)(xp + 16) = y1; *(u32x2*)(xp + 32) = y2; *(u32x2*)(xp + 48) = y3;
        }
        __syncthreads();
        {
            const int qt = wv & 3, qi = qt * 16 + fr, pt0 = wv >> 2;
            bf16x8 sB12[2], sB13[2], sX1[2], sB10[2], sB9[2], fX0[2][2], fB11[2][2], fB12[2][2], fB13[2][2], fX1[2][2];
#pragma unroll
            for (int ks = 0; ks < 2; ++ks) {
                sB12[ks] = R1_LDF(RBUF(12), qt * 16, ks); sB13[ks] = R1_LDF(RBUF(13), qt * 16, ks); sX1[ks] = R1_LDF(Xt0, 64 + qt * 16, ks);
                sB10[ks] = R1_LDF(RBUF(10), qt * 16, ks); sB9[ks] = R1_LDF(RBUF(9), qt * 16, ks);
            }
#pragma unroll
            for (int rep = 0; rep < 2; ++rep)
#pragma unroll
                for (int ks = 0; ks < 2; ++ks) {
                    const int pt = pt0 + 2 * rep;
                    fX0[rep][ks] = R1_LDF(Xt0, pt * 16, ks); fB11[rep][ks] = R1_LDF(RBUF(11), pt * 16, ks); fB12[rep][ks] = R1_LDF(RBUF(12), pt * 16, ks);
                    fB13[rep][ks] = R1_LDF(RBUF(13), pt * 16, ks); fX1[rep][ks] = R1_LDF(Xt0, 64 + pt * 16, ks);
                }
            const float gcq = gammaC[qi];
#pragma unroll
            for (int rep = 0; rep < 2; ++rep) {
                const int pt = pt0 + 2 * rep, pi0 = pt * 16 + fq * 4;
                const size_t go = T4OFF(u, qt, pt, lane);
                const f32x4 rr = up4(*(const u32x2*)(RBUF(3) + qi * LS + pi0));
                const f32x4 gcp = *(const f32x4*)(gammaC + pi0);
                f32x4 aP = zero, aQ = zero, aR = zero, aY = zero;
#pragma unroll
                for (int ks = 0; ks < 2; ++ks) {
                    aP = __builtin_amdgcn_mfma_f32_16x16x32_bf16(fX0[rep][ks], sB12[ks], aP, 0, 0, 0);
                    aQ = __builtin_amdgcn_mfma_f32_16x16x32_bf16(fB11[rep][ks], sB13[ks], aQ, 0, 0, 0);
                    aR = __builtin_amdgcn_mfma_f32_16x16x32_bf16(fX0[rep][ks], sB10[ks], aR, 0, 0, 0);
                    aY = __builtin_amdgcn_mfma_f32_16x16x32_bf16(fB13[rep][ks], sB9[ks], aY, 0, 0, 0);
                }
#pragma unroll
                for (int ks = 0; ks < 2; ++ks) {
                    aQ = __builtin_amdgcn_mfma_f32_16x16x32_bf16(fB12[rep][ks], sX1[ks], aQ, 0, 0, 0);
                    aY = __builtin_amdgcn_mfma_f32_16x16x32_bf16(fX1[rep][ks], sB10[ks], aY, 0, 0, 0);
                }
                {
#pragma unroll
                    for (int e = 0; e < 4; ++e) aP[e] = (aP[e] + (pi0 + e == qi ? 1.f : 0.f)) * gcq;
                    const size_t d = (((size_t)u * 8 + (qi >> 4) * 2 + (pi0 >> 5)) * 64 + (qi & 15) + 16 * ((pi0 >> 2) & 3)) * 8 + ((pi0 >> 4) & 1) * 4;
                    *(u32x2*)(p.PcG + d) = pk4(aP);
                }
                {
#pragma unroll
                    for (int e = 0; e < 4; ++e) aQ[e] *= gcp[e];
                    const size_t d = (((size_t)u * 4 + (qi >> 4)) * 64 + (qi & 15) + 16 * ((pi0 >> 2) & 3)) * 16 + (pi0 >> 4) * 4;
                    *(u32x2*)(p.QcG + d) = pk4(aQ);
                }
                {
#pragma unroll
                    for (int e = 0; e < 4; ++e) aR[e] += rr[e];
                    *(u32x2*)(p.RhG + go) = pk4(aR);
                }
                *(u32x2*)(p.Y0G + go) = pk4(aY);
            }
        }
    }
}

struct R2Set { u32x4 a[8]; u32x4 q[2]; };
DI void r2_load(R2Set& st, const Params& p, size_t u, int lane, int vq) {
    const bf16_t* qg = p.QcG + ((u * 4 + vq) * 64 + lane) * 16;
    st.q[0] = *(const u32x4*)qg; st.q[1] = *(const u32x4*)(qg + 8);
#pragma unroll
    for (int f = 0; f < 8; ++f) st.a[f] = *(const u32x4*)(p.PcG + ((u * 8 + f) * 64 + lane) * 8);
}
DI void r2_step(f32x4 (&S)[4], const R2Set& st, const Params& p, size_t u, int lane, int vq, bool last) {
    const u32x4 b0 = (u32x4){pack2(S[0][0], S[0][1]), pack2(S[0][2], S[0][3]), pack2(S[1][0], S[1][1]), pack2(S[1][2], S[1][3])};
    const u32x4 b1 = (u32x4){pack2(S[2][0], S[2][1]), pack2(S[2][2], S[2][3]), pack2(S[3][0], S[3][1]), pack2(S[3][2], S[3][3])};
    bf16_t* sg = p.SG + ((u * 4 + vq) * 64 + lane) * 16;
    *(u32x4*)sg = b0; *(u32x4*)(sg + 8) = b1;
    if (last) return;
#pragma unroll
    for (int kt = 0; kt < 4; ++kt) {
        const u32x4 qq = st.q[kt >> 1];
        const unsigned w0 = qq[(kt & 1) * 2], w1 = qq[(kt & 1) * 2 + 1];
        S[kt] = (f32x4){lo_bf(w0), hi_bf(w0), lo_bf(w1), hi_bf(w1)};
    }
    const bf16x8 f0 = __builtin_bit_cast(bf16x8, b0), f1 = __builtin_bit_cast(bf16x8, b1);
#pragma unroll
    for (int kt = 0; kt < 4; ++kt) {
        S[kt] = __builtin_amdgcn_mfma_f32_16x16x32_bf16(__builtin_bit_cast(bf16x8, st.a[kt * 2]), f0, S[kt], 0, 0, 0);
        S[kt] = __builtin_amdgcn_mfma_f32_16x16x32_bf16(__builtin_bit_cast(bf16x8, st.a[kt * 2 + 1]), f1, S[kt], 0, 0, 0);
    }
}
DI void phase_rwkv_r2(const Params& p, int chain) {
    const int lane = tid_() & 63;
    const int bh = chain >> 2, vq = chain & 3;
    const size_t u0 = (size_t)bh * NCHUNK;
    f32x4 S[4];
#pragma unroll
    for (int kt = 0; kt < 4; ++kt) S[kt] = (f32x4){0.f, 0.f, 0.f, 0.f};
    R2Set A, B, C, E;
    r2_load(A, p, u0, lane, vq); r2_load(B, p, u0 + 1, lane, vq); r2_load(C, p, u0 + 2, lane, vq); r2_load(E, p, u0 + 3, lane, vq);
#define R2_ONE(SET, cc) do { r2_step(S, SET, p, u0 + (cc), lane, vq, (cc) == NCHUNK - 1); if ((cc) + 4 < NCHUNK - 1) r2_load(SET, p, u0 + (cc) + 4, lane, vq); } while (0)
#pragma unroll 1
    for (int c = 0; c < NCHUNK; c += 4) {
        R2_ONE(A, c);
        if (c == NCHUNK - 1) break;
        R2_ONE(B, c + 1);
        R2_ONE(C, c + 2);
        R2_ONE(E, c + 3);
    }
#undef R2_ONE
}

struct R3Set { bf16x8 sf[2]; u32x2 s0[4][2], s1[4][2], y0[4], xvv[4], gv[4]; float bon; };
constexpr int R3_TPB = L / 16;
DI void r3_load(R3Set& st, const Params& p, int task, int lane) {
    const int fr = lane & 15, fq = lane >> 4;
    const int bh = task / R3_TPB, tt = task % R3_TPB, c = tt >> 2, it = tt & 3, u = bh * NCHUNK + c;
    const int h = bh % HEADS, bb = bh / HEADS;
    const int i = it * 16 + fr, t = c * 64 + i;
    const size_t tok = (size_t)bb * L + (t < L ? t : 0);
#pragma unroll
    for (int ks = 0; ks < 2; ++ks) {
        const bf16_t* rp = p.RhG + T4OFF(u, it, 2 * ks + (fq >> 1), fr + 32 * (fq & 1));
        const u32x2 r0 = *(const u32x2*)rp, r1 = *(const u32x2*)(rp + 16 * 4);
        st.sf[ks] = __builtin_bit_cast(bf16x8, ((u32x4){r0[0], r0[1], r1[0], r1[1]}));
    }
#pragma unroll
    for (int vt = 0; vt < 4; ++vt) {
#pragma unroll
        for (int ks = 0; ks < 2; ++ks) {
            const bf16_t* sp = p.SG + (((size_t)u * 4 + vt) * 64 + fr + 32 * (fq & 1)) * 16 + (2 * ks + (fq >> 1)) * 4;
            st.s0[vt][ks] = *(const u32x2*)sp; st.s1[vt][ks] = *(const u32x2*)(sp + 16 * 16);
        }
        st.y0[vt] = *(const u32x2*)(p.Y0G + T4OFF(u, it, vt, lane));
        st.xvv[vt] = *(const u32x2*)(p.orw + tok * 512 + h * 64 + vt * 16 + fq * 4);
        st.gv[vt] = *(const u32x2*)(p.GG + T4OFF(u, it, vt, lane));
    }
    st.bon = p.bonG[(size_t)u * 64 + i];
}
DI void r3_compute(const R3Set& st, const Params& p, int layer, int task, int lane) {
    const int fr = lane & 15, fq = lane >> 4;
    const int bh = task / R3_TPB, tt = task % R3_TPB, c = tt >> 2, it = tt & 3;
    const int h = bh % HEADS, bb = bh / HEADS;
    const int i = it * 16 + fr, t = c * 64 + i;
    const bool live = t < L;
    const size_t tok = (size_t)bb * L + (live ? t : 0);
    f32x4 y[4];
#pragma unroll
    for (int vt = 0; vt < 4; ++vt) {
        y[vt] = up4(st.y0[vt]);
#pragma unroll
        for (int ks = 0; ks < 2; ++ks) {
            const bf16x8 f = __builtin_bit_cast(bf16x8, ((u32x4){st.s0[vt][ks][0], st.s0[vt][ks][1], st.s1[vt][ks][0], st.s1[vt][ks][1]}));
            y[vt] = __builtin_amdgcn_mfma_f32_16x16x32_bf16(f, st.sf[ks], y[vt], 0, 0, 0);
        }
    }
    float s = 0.f;
#pragma unroll
    for (int vt = 0; vt < 4; ++vt) s += (y[vt][0] + y[vt][1]) + (y[vt][2] + y[vt][3]);
    s += __shfl_xor(s, 16); s += __shfl_xor(s, 32);
    const float mean = s * (1.0f / 64.f);
    float q = 0.f;
#pragma unroll
    for (int vt = 0; vt < 4; ++vt)
#pragma unroll
        for (int e = 0; e < 4; ++e) { y[vt][e] -= mean; q += y[vt][e] * y[vt][e]; }
    q += __shfl_xor(q, 16); q += __shfl_xor(q, 32);
    const float rstd = rsqrtf(q * (1.0f / 64.f) + 64e-5f);
    if (live) {
#pragma unroll
        for (int vt = 0; vt < 4; ++vt) {
            const int cg = h * 64 + vt * 16 + fq * 4;
            const f32x4 xv = up4(st.xvv[vt]), g = up4(st.gv[vt]);
            const f32x4 lg = *(const f32x4*)(p.lnx_g + layer * 512 + cg), lb = *(const f32x4*)(p.lnx_b + layer * 512 + cg);
            f32x4 o;
#pragma unroll
            for (int e = 0; e < 4; ++e) o[e] = (y[vt][e] * rstd * lg[e] + lb[e] + st.bon * xv[e]) * g[e];
            *(u32x2*)(p.orw + tok * 512 + cg) = pk4(o);
        }
    }
}
DI void phase_rwkv_r3(const Params& p, int layer, int bid, int nb) {
    const int tid = tid_(), lane = tid & 63, wv = __builtin_amdgcn_readfirstlane(tid >> 6);
    const int ntask = NBATCH * HEADS * R3_TPB, step = nb * 8;
    int task = bid * 8 + wv;
    if (task >= ntask) return;
    R3Set A, B;
    r3_load(A, p, task, lane);
#pragma unroll 1
    for (;;) {
        const int t1 = task + step;
        if (t1 < ntask) r3_load(B, p, t1, lane);
        r3_compute(A, p, layer, task, lane);
        if (t1 >= ntask) break;
        const int t2 = t1 + step;
        if (t2 < ntask) r3_load(A, p, t2, lane);
        r3_compute(B, p, layer, t1, lane);
        if (t2 >= ntask) break;
        task = t2;
    }
}

template <bool FULL> DI void sb_tile(const bf16_t* Ks, const bf16_t* Vt, const bf16x8 (&qf)[2], const bf16x8 (&tri)[4][2], int kt, int query, int fr, int fq, float& R, f32x4 (&ot)[4]) {
    bf16x8 kf[4][2];
#pragma unroll
    for (int kk = 0; kk < 4; ++kk)
#pragma unroll
        for (int ks = 0; ks < 2; ++ks) kf[kk][ks] = *(const bf16x8*)(Ks + (16 * kk + fr) * LS + ks * 32 + fq * 8);
    f32x4 z[4];
#pragma unroll
    for (int kk = 0; kk < 4; ++kk) z[kk] = __builtin_amdgcn_mfma_f32_16x16x32_bf16(kf[kk][0], qf[0], (f32x4){0.f, 0.f, 0.f, 0.f}, 0, 0, 0);
#pragma unroll
    for (int kk = 0; kk < 4; ++kk) z[kk] = __builtin_amdgcn_mfma_f32_16x16x32_bf16(kf[kk][1], qf[1], z[kk], 0, 0, 0);
    bf16x8 vf[4][2];
#pragma unroll
    for (int dt = 0; dt < 4; ++dt)
#pragma unroll
        for (int k2 = 0; k2 < 2; ++k2) {
            const int dsw = ((2 * dt + (fr >> 3)) & 7) << 2;
            const bf16_t* vrow = Vt + (16 * dt + fr) * LS;
            const u32x2 v0 = *(const u32x2*)(vrow + ((32 * k2 + 4 * fq) ^ dsw)), v1 = *(const u32x2*)(vrow + ((32 * k2 + 16 + 4 * fq) ^ dsw));
            vf[dt][k2] = __builtin_bit_cast(bf16x8, ((u32x4){v0[0], v0[1], v1[0], v1[1]}));
        }
    f32x4 ex[4], uu[4], lsp[4];
#pragma unroll
    for (int kk = 0; kk < 4; ++kk)
#pragma unroll
        for (int e = 0; e < 4; ++e) ex[kk][e] = __builtin_amdgcn_exp2f(-fabsf(z[kk][e]));
#pragma unroll
    for (int kk = 0; kk < 4; ++kk)
#pragma unroll
        for (int e = 0; e < 4; ++e) ex[kk][e] = __builtin_amdgcn_logf(1.0f + ex[kk][e]);
#pragma unroll
    for (int kk = 0; kk < 4; ++kk)
#pragma unroll
        for (int e = 0; e < 4; ++e) {
            const float zz = z[kk][e];
            const float lsneg = -(fmaxf(zz, 0.f) + ex[kk][e]);
            if (FULL) { uu[kk][e] = lsneg; lsp[kk][e] = lsneg + zz; }
            else {
                const bool valid = kt * 64 + 16 * kk + 4 * fq + e < query;
                uu[kk][e] = valid ? lsneg : 0.f;
                lsp[kk][e] = valid ? lsneg + zz : -1.0e30f;
            }
        }
    f32x4 rest[4];
#pragma unroll
    for (int st = 0; st < 4; ++st) rest[st] = (f32x4){0.f, 0.f, 0.f, 0.f};
#pragma unroll
    for (int k2 = 0; k2 < 2; ++k2) {
        u32x4 hi, lo;
#pragma unroll
        for (int t2 = 0; t2 < 2; ++t2) {
            const f32x4 a = uu[2 * k2 + t2];
            const unsigned h0 = pack2(a[0], a[1]), h1 = pack2(a[2], a[3]);
            hi[2 * t2] = h0; hi[2 * t2 + 1] = h1;
            lo[2 * t2] = pack2(a[0] - lo_bf(h0), a[1] - hi_bf(h0)); lo[2 * t2 + 1] = pack2(a[2] - lo_bf(h1), a[3] - hi_bf(h1));
        }
        const bf16x8 fh = __builtin_bit_cast(bf16x8, hi), fl = __builtin_bit_cast(bf16x8, lo);
#pragma unroll
        for (int st = 0; st < 4; ++st) rest[st] = __builtin_amdgcn_mfma_f32_16x16x32_bf16(tri[st][k2], fh, rest[st], 0, 0, 0);
#pragma unroll
        for (int st = 0; st < 4; ++st) rest[st] = __builtin_amdgcn_mfma_f32_16x16x32_bf16(tri[st][k2], fl, rest[st], 0, 0, 0);
    }
    bf16x8 af[2];
#pragma unroll
    for (int k2 = 0; k2 < 2; ++k2) {
        u32x4 pk;
#pragma unroll
        for (int t2 = 0; t2 < 2; ++t2) {
            const int kk = 2 * k2 + t2;
            float a4[4];
#pragma unroll
            for (int e = 0; e < 4; ++e) a4[e] = __builtin_amdgcn_exp2f(lsp[kk][e] + R + rest[kk][e]);
            pk[2 * t2] = pack2(a4[0], a4[1]); pk[2 * t2 + 1] = pack2(a4[2], a4[3]);
        }
        af[k2] = __builtin_bit_cast(bf16x8, pk);
    }
    R += __shfl(rest[0][0] + uu[0][0], fr);
#pragma unroll
    for (int k2 = 0; k2 < 2; ++k2)
#pragma unroll
        for (int dt = 0; dt < 4; ++dt) ot[dt] = __builtin_amdgcn_mfma_f32_16x16x32_bf16(vf[dt][k2], af[k2], ot[dt], 0, 0, 0);
}
constexpr int SB_LDS = 4 * RB + 64;
DI void phase_sb(const Params& p, int bid0, int nb, char* smem) {
    const int tid = tid_(), lane = tid & 63, wv = __builtin_amdgcn_readfirstlane(tid >> 6), fr = lane & 15, fq = lane >> 4;
    bf16_t* Ks0 = (bf16_t*)smem;
    bf16_t* Vt0 = Ks0 + 2 * 64 * LS;
    int* flags = (int*)(smem + 4 * RB);
    bf16x8 tri[4][2];
#pragma unroll
    for (int st = 0; st < 4; ++st)
#pragma unroll
        for (int k2 = 0; k2 < 2; ++k2)
#pragma unroll
            for (int jj = 0; jj < 8; ++jj) tri[st][k2][jj] = (32 * k2 + 16 * (jj >> 2) + 4 * fq + (jj & 3) > 16 * st + fr) ? (short)0x3F80 : (short)0;
    constexpr int NQB = (L + 127) / 128;
    const int ldkey = tid >> 3, lddc = (tid & 7) * 8;
    for (int u = bid0; u < NBATCH * HEADS * NQB; u += nb) {
        const int bh = u % (NBATCH * HEADS), b = bh / HEADS, h = bh % HEADS, q0 = (NQB - 1 - u / (NBATCH * HEADS)) * 128;
        const int qlo = q0 + 16 * wv, query = qlo + fr;
        const size_t tokb = (size_t)b * L;
        bf16x8 qf[2];
#pragma unroll
        for (int ks = 0; ks < 2; ++ks) qf[ks] = *(const bf16x8*)(p.P + (tokb + query) * CP + OFF_Q + h * 64 + ks * 32 + fq * 8);
        const int qmax = (q0 + 127 < L - 1) ? q0 + 127 : L - 1;
        int kt = (qmax - 1) >> 6;
        float R = 0.f;
        f32x4 ot[4];
#pragma unroll
        for (int dt = 0; dt < 4; ++dt) ot[dt] = (f32x4){0.f, 0.f, 0.f, 0.f};
        bool done = qlo >= L;
        u32x4 kreg, vreg;
        {
            const int s = kt * 64 + ldkey;
            const bf16_t* src = p.P + (tokb + s) * CP + h * 64 + lddc;
            kreg = s < L ? *(const u32x4*)(src + OFF_K) : (u32x4){0u, 0u, 0u, 0u};
            vreg = s < L ? *(const u32x4*)(src + OFF_V) : (u32x4){0u, 0u, 0u, 0u};
        }
        const int vsw = (tid & 7) << 2;
        __syncthreads();
        {
            *(u32x4*)(Ks0 + ldkey * LS + lddc) = kreg;
#pragma unroll
            for (int j = 0; j < 4; ++j) { Vt0[(lddc + 2 * j) * LS + (ldkey ^ vsw)] = (bf16_t)(vreg[j] & 0xFFFFu); Vt0[(lddc + 2 * j + 1) * LS + (ldkey ^ vsw)] = (bf16_t)(vreg[j] >> 16); }
        }
        __syncthreads();
        for (int itile = 0;; ++itile) {
            const bf16_t* Ks = Ks0 + (itile & 1) * 64 * LS; const bf16_t* Vt = Vt0 + (itile & 1) * 64 * LS;
            if (kt > 0) {
                const int s = (kt - 1) * 64 + ldkey;
                const bf16_t* src = p.P + (tokb + s) * CP + h * 64 + lddc;
                kreg = *(const u32x4*)(src + OFF_K); vreg = *(const u32x4*)(src + OFF_V);
            }
            if (!done && kt * 64 < qlo + 15) {
                if (kt * 64 + 63 < qlo) sb_tile<true>(Ks, Vt, qf, tri, kt, query, fr, fq, R, ot);
                else sb_tile<false>(Ks, Vt, qf, tri, kt, query, fr, fq, R, ot);
                done = __all((R < -150.1f) || (query >= L));
            }
            if (kt > 0) {
                bf16_t* Kn = Ks0 + ((itile & 1) ^ 1) * 64 * LS; bf16_t* Vn = Vt0 + ((itile & 1) ^ 1) * 64 * LS;
                *(u32x4*)(Kn + ldkey * LS + lddc) = kreg;
#pragma unroll
                for (int j = 0; j < 4; ++j) { Vn[(lddc + 2 * j) * LS + (ldkey ^ vsw)] = (bf16_t)(vreg[j] & 0xFFFFu); Vn[(lddc + 2 * j + 1) * LS + (ldkey ^ vsw)] = (bf16_t)(vreg[j] >> 16); }
            }
            if (lane == 0) flags[(itile & 1) * 8 + wv] = done ? 1 : 0;
            __syncthreads();
            int alld = 1;
#pragma unroll
            for (int w = 0; w < 8; ++w) alld &= flags[(itile & 1) * 8 + w];
            if (alld || kt == 0) break;
            --kt;
        }
        if (query < L) {
#pragma unroll
            for (int dt = 0; dt < 4; ++dt) *(u32x2*)(p.osb + (tokb + query) * 512 + h * 64 + 16 * dt + 4 * fq) = pk4(ot[dt]);
        }
    }
}

#define GATE_OFF(unit, e, wid, ln) ((((size_t)(unit) * 2 + (e)) * 16 * 8 + (wid)) * 512 + (size_t)(ln) * 8)
struct EpiBranch {
    static constexpr bool PERM = true;
    const unsigned char* G0; bf16_t* M; bf16_t* PART;
    DI void operator()(const f32x4 (&acc)[2][2][4][2], const g8::Unit& u, int wr, int wc, int fr, int fq) const {
        const int c0 = u.pn * 256 + wc * 32 + 8 * fq;
        const unsigned char* G = G0 + GATE_OFF(u.pm * 4 + u.pn, u.e, wr * 4 + wc, fr + 16 * fq); const bool add = u.e != 0;
        bf16_t* PT = PART + ((((size_t)(u.pm * 4 + u.pn) * 16 * 8 + (wr * 4 + wc)) * 64 + fr + 16 * fq) * 8);
#pragma unroll
        for (int ai = 0; ai < 2; ++ai) {
            u32x2 g[4][2]; u32x4 mo[4][2];
#pragma unroll
            for (int m = 0; m < 4; ++m)
#pragma unroll
                for (int bj = 0; bj < 2; ++bj) {
                    const size_t r = (size_t)(u.pm * 256 + ai * 128 + wr * 64 + m * 16 + fr);
                    g[m][bj] = *(const u32x2*)(G + (size_t)(ai * 8 + m * 2 + bj) * 4096);
                    mo[m][bj] = add ? *(const u32x4*)(PT + (size_t)(ai * 8 + m * 2 + bj) * 4096) : (u32x4){0u, 0u, 0u, 0u};
                }
#pragma unroll
            for (int m = 0; m < 4; ++m)
#pragma unroll
                for (int bj = 0; bj < 2; ++bj) {
                    const size_t r = (size_t)(u.pm * 256 + ai * 128 + wr * 64 + m * 16 + fr);
                    const f32x4 v0 = acc[ai][bj][m][0], v1 = acc[ai][bj][m][1];
                    const u32x2 gg = g[m][bj]; const u32x4 mm = mo[m][bj];
                    constexpr float GS = 1.0f / 255.0f;
                    float o[8] = {(float)(gg[0] & 255u) * GS * v0[0], (float)((gg[0] >> 8) & 255u) * GS * v0[1], (float)((gg[0] >> 16) & 255u) * GS * v0[2], (float)(gg[0] >> 24) * GS * v0[3],
                                  (float)(gg[1] & 255u) * GS * v1[0], (float)((gg[1] >> 8) & 255u) * GS * v1[1], (float)((gg[1] >> 16) & 255u) * GS * v1[2], (float)(gg[1] >> 24) * GS * v1[3]};
#pragma unroll
                    for (int q = 0; q < 4; ++q) { o[2 * q] += lo_bf(mm[q]); o[2 * q + 1] += hi_bf(mm[q]); }
                    const u32x4 ov = (u32x4){pack2(o[0], o[1]), pack2(o[2], o[3]), pack2(o[4], o[5]), pack2(o[6], o[7])};
                    if (add) *(u32x4*)(M + r * D + c0 + bj * 128) = ov; else *(u32x4*)(PT + (size_t)(ai * 8 + m * 2 + bj) * 4096) = ov;
                }
        }
    }
};
struct PairOrder {
    g8::DenseOrder d0, d1; int n0;
    DI void init(const bf16_t* A0, const bf16_t* B0, const bf16_t* A1, const bf16_t* B1, int nM, int nN, int K, int G, int c) {
        d0.init(A0, B0, nM, nN, K, G, c); d1.init(A1, B1, nM, nN, K, G, c); n0 = c < nM * nN ? (nM * nN - c + G - 1) / G : 0;
    }
    DI bool next(int i, g8::Unit& u) const {
        if (i < n0) { const bool ok = d0.next(i, u); u.e = 0; return ok; }
        const bool ok = d1.next(i - n0, u); u.e = 1; return ok;
    }
    DI unsigned row_off(const g8::Unit&, int) const { return 0u; }
};
DI unsigned gate_q4(float a, float b, float c, float d) {
    const unsigned q0 = (unsigned)(sigmoidf_(a) * 255.0f + 0.5f), q1 = (unsigned)(sigmoidf_(b) * 255.0f + 0.5f), q2 = (unsigned)(sigmoidf_(c) * 255.0f + 0.5f), q3 = (unsigned)(sigmoidf_(d) * 255.0f + 0.5f);
    return q0 | (q1 << 8) | (q2 << 16) | (q3 << 24);
}
struct EpiGate {
    static constexpr bool PERM = true;
    unsigned char* G0;
    DI void operator()(const f32x4 (&acc)[2][2][4][2], const g8::Unit& u, int wr, int wc, int fr, int fq) const {
        unsigned char* G = G0 + GATE_OFF(u.pm * 4 + u.pn, u.e, wr * 4 + wc, fr + 16 * fq);
#pragma unroll
        for (int ai = 0; ai < 2; ++ai)
#pragma unroll
            for (int m = 0; m < 4; ++m)
#pragma unroll
                for (int bj = 0; bj < 2; ++bj) {
                    const f32x4 v0 = acc[ai][bj][m][0], v1 = acc[ai][bj][m][1];
                    *(u32x2*)(G + (size_t)(ai * 8 + m * 2 + bj) * 4096) = (u32x2){gate_q4(v0[0], v0[1], v0[2], v0[3]), gate_q4(v1[0], v1[1], v1[2], v1[3])};
                }
    }
};
template <int PART> DI void phase_merge(const Params& p, int layer, int bid, int nb, char* smem) {
    const bf16_t* hb = p.hb; unsigned char* G = (unsigned char*)p.gates; bf16_t* M = p.merged;
    const bf16_t* Wg = p.WtIn + ((size_t)layer * CIN + CP) * D;
    G8_LAS unsigned char* lds = (G8_LAS unsigned char*)smem;
    if (PART == 0) {
        PairOrder S; S.init(hb, Wg, hb, Wg + (size_t)1024 * D, MFULL, D / 256, D, nb, bid);
        g8::gemm8<false>(lds, D, S, EpiGate{G});
    }
    if (PART == 1) {
        PairOrder S; S.init(p.osb, p.WtPsb + (size_t)layer * D * 512, p.orw, p.WtPrw + (size_t)layer * D * 512, MFULL, D / 256, 512, nb, bid);
        g8::gemm8<false>(lds, 512, S, EpiBranch{G, M, p.gates + (size_t)TP * 1024});
    }
    if (PART == 1)
    for (int t = left_first(MFULL * 4 * 2, bid, nb); t < D / 128; t += nb) {
#pragma unroll
        for (int which = 0; which < 2; ++which) {
            const bf16_t* A = which ? p.orw : p.osb; const bf16_t* Gw = p.gleft - (size_t)M0_LEFT * 2048 + which * 1024;
            const bf16_t* Bt = (which ? p.WtPrw : p.WtPsb) + (size_t)layer * D * 512;
            gemm_left32([=](int r) { return A + (size_t)(M0_LEFT + r) * 512; }, Bt, 512, 512, t * 128, smem,
                        [=](int r0, int c, f32x4 v) {
                            const size_t r = (size_t)(M0_LEFT + r0);
                            const u32x2 g = *(const u32x2*)(Gw + r * 2048 + c);
                            float o0 = lo_bf(g[0]) * v[0], o1 = hi_bf(g[0]) * v[1], o2 = lo_bf(g[1]) * v[2], o3 = hi_bf(g[1]) * v[3];
                            u32x2* mp = (u32x2*)(M + r * D + c);
                            if (which) { const u32x2 m = *mp; o0 += lo_bf(m[0]); o1 += hi_bf(m[0]); o2 += lo_bf(m[1]); o3 += hi_bf(m[1]); }
                            *mp = (u32x2){pack2(o0, o1), pack2(o2, o3)};
                        });
        }
    }
    if (PART == 1) { const int nl = D / 128 < nb ? D / 128 : 0; if (bid >= nl) convert_experts(p, layer, NE / 2, NE / 2 + NE / 4, bid - nl, nb - nl, smem); }
}
struct EpiOut {
    static constexpr bool PERM = true;
    bf16_t* hb;
    DI void operator()(const f32x4 (&acc)[2][2][4][2], const g8::Unit& u, int wr, int wc, int fr, int fq) const {
        const int c0 = u.pn * 256 + wc * 32 + 8 * fq;
#pragma unroll
        for (int ai = 0; ai < 2; ++ai) {
            u32x4 hv[4][2];
#pragma unroll
            for (int m = 0; m < 4; ++m)
#pragma unroll
                for (int bj = 0; bj < 2; ++bj) hv[m][bj] = *(const u32x4*)(hb + (size_t)(u.pm * 256 + ai * 128 + wr * 64 + m * 16 + fr) * D + c0 + bj * 128);
#pragma unroll
            for (int m = 0; m < 4; ++m)
#pragma unroll
                for (int bj = 0; bj < 2; ++bj) {
                    const u32x4 h = hv[m][bj]; const f32x4 v0 = acc[ai][bj][m][0], v1 = acc[ai][bj][m][1];
                    *(u32x4*)(hb + (size_t)(u.pm * 256 + ai * 128 + wr * 64 + m * 16 + fr) * D + c0 + bj * 128) =
                        (u32x4){pack2(ALPHA * lo_bf(h[0]) + v0[0], ALPHA * hi_bf(h[0]) + v0[1]), pack2(ALPHA * lo_bf(h[1]) + v0[2], ALPHA * hi_bf(h[1]) + v0[3]),
                                pack2(ALPHA * lo_bf(h[2]) + v1[0], ALPHA * hi_bf(h[2]) + v1[1]), pack2(ALPHA * lo_bf(h[3]) + v1[2], ALPHA * hi_bf(h[3]) + v1[3])};
                }
        }
    }
};
DI void phase_outproj(const Params& p, int layer, int bid, int nb, char* smem) {
    const bf16_t* A = p.merged; bf16_t* const hbres = p.hb;
    const bf16_t* Bt = p.WtOut + (size_t)layer * D * D;
    if (bid == 0 && tid_() < NE) p.counts[tid_()] = 0;
    g8::DenseOrder S; S.init(A, Bt, MFULL, D / 256, D, nb, bid);
    g8::gemm8<false>((G8_LAS unsigned char*)smem, D, S, EpiOut{hbres});
    for (int t = left_first(MFULL * 4, bid, nb); t < D / 128; t += nb)
        gemm_left32([=](int r) { return A + (size_t)(M0_LEFT + r) * D; }, Bt, D, D, t * 128, smem,
                    [=](int r0, int c, f32x4 v) {
                        const int r = M0_LEFT + r0;
                        u32x2* hp = (u32x2*)(hbres + (size_t)r * D + c);
                        const f32x4 h = up4(*hp);
                        *hp = (u32x2){pack2(ALPHA * h[0] + v[0], ALPHA * h[1] + v[1]), pack2(ALPHA * h[2] + v[2], ALPHA * h[3] + v[3])};
                    });
    { const int nl = D / 128 < nb ? D / 128 : 0; if (bid >= nl) convert_experts(p, layer, NE / 2 + NE / 4, NE, bid - nl, nb - nl, smem); }
}

constexpr int LN1_ROWB = 2 * D + 16;
constexpr int LN1_WAVE = 9 * LN1_ROWB;
constexpr int LN1_LDS = 8 * LN1_WAVE + 2048;
template <int NT> DI void ln1_rows(const Params& p, const float* g1p, const float* b1p, int tok0, char* wl, int lane) {
    u32x2 rw[NT][4];
#pragma unroll
    for (int i = 0; i < NT; ++i)
#pragma unroll
        for (int j = 0; j < 4; ++j) rw[i][j] = *(const u32x2*)(p.hb + (size_t)(tok0 + i) * D + 256 * j + 4 * lane);
    f32x4 gv[4], bv[4];
#pragma unroll
    for (int j = 0; j < 4; ++j) { gv[j] = *(const f32x4*)(g1p + 256 * j + 4 * lane); bv[j] = *(const f32x4*)(b1p + 256 * j + 4 * lane); }
    float v[NT][16], s[NT], q[NT];
#pragma unroll
    for (int i = 0; i < NT; ++i) {
        s[i] = 0.f;
#pragma unroll
        for (int j = 0; j < 4; ++j) { const f32x4 a = up4(rw[i][j]); v[i][4 * j] = a[0]; v[i][4 * j + 1] = a[1]; v[i][4 * j + 2] = a[2]; v[i][4 * j + 3] = a[3]; s[i] += (a[0] + a[1]) + (a[2] + a[3]); }
    }
#pragma unroll
    for (int i = 0; i < NT; ++i) s[i] = sum16(s[i]);
#pragma unroll
    for (int i = 0; i < NT; ++i) s[i] += __shfl_xor(s[i], 16);
#pragma unroll
    for (int i = 0; i < NT; ++i) s[i] = (s[i] + __shfl_xor(s[i], 32)) * (1.0f / D);
#pragma unroll
    for (int i = 0; i < NT; ++i) {
        q[i] = 0.f;
#pragma unroll
        for (int k = 0; k < 16; ++k) { v[i][k] -= s[i]; q[i] += v[i][k] * v[i][k]; }
    }
#pragma unroll
    for (int i = 0; i < NT; ++i) q[i] = sum16(q[i]);
#pragma unroll
    for (int i = 0; i < NT; ++i) q[i] += __shfl_xor(q[i], 16);
#pragma unroll
    for (int i = 0; i < NT; ++i) q[i] = rsqrtf((q[i] + __shfl_xor(q[i], 32)) * (1.0f / D) + 1e-5f);
#pragma unroll
    for (int i = 0; i < NT; ++i)
#pragma unroll
        for (int j = 0; j < 4; ++j) {
            float o[4];
#pragma unroll
            for (int k = 0; k < 4; ++k) o[k] = v[i][4 * j + k] * q[i] * gv[j][k] + bv[j][k];
            const unsigned h0 = pack2(o[0], o[1]), h1 = pack2(o[2], o[3]);
            *(u32x2*)(p.hb + (size_t)(tok0 + i) * D + 256 * j + 4 * lane) = (u32x2){h0, h1};
            *(u32x2*)(wl + i * LN1_ROWB + (256 * j + 4 * lane) * 2) = (u32x2){h0, h1};
        }
}
DI void phase_ln1_router(const Params& p, int layer, int bid, int nb, char* smem) {
    const int tid = tid_(), lane = tid & 63, wid = __builtin_amdgcn_readfirstlane(tid >> 6), fr = lane & 15, fq = lane >> 4;
    char* wl = smem + wid * LN1_WAVE;
    int* sel = (int*)(smem + 8 * LN1_WAVE);
    float* sgt = (float*)(smem + 8 * LN1_WAVE + 640);
    int* sbase = (int*)(smem + 8 * LN1_WAVE + 1280);
    const int nwaves = nb * 8, gw = bid * 8 + wid;
    const int base_n = T / nwaves, extra = T % nwaves;
    const int tok0 = gw * base_n + (gw < extra ? gw : extra), ntok = base_n + (gw < extra ? 1 : 0);
    const int btok0 = bid * 8 * base_n + (bid * 8 < extra ? bid * 8 : extra);
    const float* g1p = p.ln1_g + layer * D; const float* b1p = p.ln1_b + layer * D;
    __syncthreads();
    for (int g0 = 0; g0 < ntok; g0 += 9) {
        const int ng = ntok - g0 < 9 ? ntok - g0 : 9;
        if (ng == 8) ln1_rows<8>(p, g1p, b1p, tok0 + g0, wl, lane);
        else if (ng == 9) ln1_rows<9>(p, g1p, b1p, tok0 + g0, wl, lane);
        else for (int i = 0; i < ng; ++i) ln1_rows<1>(p, g1p, b1p, tok0 + g0 + i, wl + i * LN1_ROWB, lane);
        asm volatile("s_waitcnt lgkmcnt(0)" ::: "memory");
        __builtin_amdgcn_wave_barrier();
        f32x4 acc[2] = {(f32x4){0.f, 0.f, 0.f, 0.f}, (f32x4){0.f, 0.f, 0.f, 0.f}};
        const char* arow = wl + (fr < ng ? fr : 0) * LN1_ROWB + fq * 16;
        const bf16_t* whi = p.RwHi + (size_t)fr * D + fq * 8;
        bf16x8 bh[32];
#pragma unroll
        for (int ks = 0; ks < 32; ++ks) bh[ks] = *(const bf16x8*)(whi + ks * 32);
#pragma unroll
        for (int ks = 0; ks < 32; ++ks) {
            const bf16x8 ah = *(const bf16x8*)(arow + ks * 64);
            acc[ks & 1] = __builtin_amdgcn_mfma_f32_16x16x32_bf16(bh[ks], ah, acc[ks & 1], 0, 0, 0);
        }
        float lg[4]; float mx = -3.0e38f;
#pragma unroll
        for (int e = 0; e < 4; ++e) { lg[e] = acc[0][e] + acc[1][e] + p.router_b[4 * fq + e]; mx = fmaxf(mx, lg[e]); }
        mx = fmaxf(mx, __shfl_xor(mx, 16)); mx = fmaxf(mx, __shfl_xor(mx, 32));
        float sum = 0.f;
#pragma unroll
        for (int e = 0; e < 4; ++e) { lg[e] = __expf(lg[e] - mx); sum += lg[e]; }
        sum += __shfl_xor(sum, 16); sum += __shfl_xor(sum, 32);
        const float inv = 1.0f / sum;
        float v1 = -1.f, v2 = -1.f; int i1 = 0, i2 = 0;
#pragma unroll
        for (int e = 0; e < 4; ++e) {
            const float pv = lg[e] * inv;
            if (pv > v1) { v2 = v1; i2 = i1; v1 = pv; i1 = e; } else if (pv > v2) { v2 = pv; i2 = e; }
        }
        const float sc = v1 + v2;
        float bsc = sc; int bg = fq;
#pragma unroll
        for (int m = 16; m <= 32; m <<= 1) {
            const float os = __shfl_xor(bsc, m); const int og = __shfl_xor(bg, m);
            if (os > bsc || (os == bsc && og < bg)) { bsc = os; bg = og; }
        }
        if (bg == fq && fr < ng) {
            const int li = tok0 + g0 + fr - btok0;
            const float gs = 1.0f / (v1 + v2);
            sel[li * 2] = 4 * fq + i1; sel[li * 2 + 1] = 4 * fq + i2; sgt[li * 2] = v1 * gs; sgt[li * 2 + 1] = v2 * gs;
        }
        asm volatile("s_waitcnt lgkmcnt(0)" ::: "memory");
        __builtin_amdgcn_wave_barrier();
    }
    __syncthreads();
    {
        const int nbt = 8 * base_n + ((bid * 8 + 8 <= extra) ? 8 : (bid * 8 < extra ? extra - bid * 8 : 0));
        for (int c0 = wid * 64; c0 < nbt; c0 += 8 * 64) {
            int* sb = sbase + 16 * wid;
            const int li = c0 + lane; const bool on = li < nbt;
            const int e1 = on ? sel[li * 2] : -1, e2 = on ? sel[li * 2 + 1] : -1;
            const unsigned long long lt = (1ull << lane) - 1ull;
            int r1 = 0, r2 = 0, mycnt = 0;
#pragma unroll
            for (int e = 0; e < NE; ++e) {
                const unsigned long long m1 = __ballot(e1 == e), m2 = __ballot(e2 == e);
                const int c1 = __popcll(m1), c2 = __popcll(m2);
                if (e1 == e) r1 = __popcll(m1 & lt);
                if (e2 == e) r2 = c1 + __popcll(m2 & lt);
                if (lane == e) mycnt = c1 + c2;
            }
            if (lane < NE) sb[lane] = mycnt > 0 ? atomicAdd(&p.counts[lane], mycnt) : 0;
            asm volatile("s_waitcnt vmcnt(0) lgkmcnt(0)" ::: "memory");
            __builtin_amdgcn_wave_barrier();
            if (on) {
                const int tok = btok0 + li;
                const int s1 = sb[e1] + r1, s2 = sb[e2] + r2;
                p.list[e1 * T + s1] = tok * 2; p.list[e2 * T + s2] = tok * 2 + 1;
                p.tokg[tok * 2] = sgt[li * 2]; p.tokg[tok * 2 + 1] = sgt[li * 2 + 1];
            }
            asm volatile("s_waitcnt lgkmcnt(0)" ::: "memory");
            __builtin_amdgcn_wave_barrier();
        }
    }
}

constexpr int MOE_BIG = 8;
template <bool UP> struct MoeOrder {
    const int* counts; const int* list; int G, c; const char* A; const char* B;
    DI bool next(int i, g8::Unit& u) const {
        const int xcd = c & 7, w = c >> 3, mt = (w >> 1) & 7, pn = 2 * (w & 1) + i, esel = xcd + 8 * (w >> 4);
        if (w >= 32 || i >= 2) return false;
        int padp = 0, fe = -1, fc = 0, fp = 0;
#pragma unroll
        for (int e = 0; e < NE; ++e) {
            const int cn = counts[e], ntp = (cn + 255) >> 8, nt = ntp < MOE_BIG ? ntp : MOE_BIG;
            const bool hit = (e == esel) && (mt < nt);
            fe = hit ? e : fe; fc = hit ? cn : fc; fp = hit ? padp + mt : fp;
            padp += ntp;
        }
        fe = __builtin_amdgcn_readfirstlane(fe); fc = __builtin_amdgcn_readfirstlane(fc); fp = __builtin_amdgcn_readfirstlane(fp);
        if (fe < 0) return false;
        u.e = fe; u.slot0 = mt * 256; u.cnt = fc; u.pm = fp; u.pn = pn;
        u.A = UP ? A : A + (size_t)fp * ((size_t)256 * DE * 2);
        u.B = UP ? B + (size_t)fe * ((size_t)1024 * 1024 * 2) + (size_t)pn * ((size_t)256 * D * 2) : B + (size_t)fe * ((size_t)1024 * 512 * 2) + (size_t)pn * ((size_t)256 * DE * 2);
        return true;
    }
    DI unsigned row_off(const g8::Unit& u, int r) const {
        const __amdgpu_buffer_rsrc_t rs = __builtin_amdgcn_make_buffer_rsrc((void*)list, 0, NE * T * 4, 0x00020000);
        const int ent = __builtin_amdgcn_raw_buffer_load_b32(rs, r * 4, (u.e * T + u.slot0) * 4, 0);
        return u.slot0 + r < u.cnt ? (unsigned)(ent >> 1) * (unsigned)(D * 2) : 0u;
    }
};
struct EpiMoeUp {
    static constexpr bool PERM = true;
    bf16_t* hid;
    DI void operator()(const f32x4 (&acc)[2][2][4][2], const g8::Unit& u, int wr, int wc, int fr, int fq) const {
#pragma unroll
        for (int ai = 0; ai < 2; ++ai)
#pragma unroll
            for (int m = 0; m < 4; ++m) {
                const int r = ai * 128 + wr * 64 + m * 16 + fr;
                if (u.slot0 + r >= u.cnt) continue;
                bf16_t* rowp = hid + ((size_t)u.pm * 256 + r) * DE + ((u.pn * 256 + wc * 32 + 8 * fq) >> 1);
#pragma unroll
                for (int bj = 0; bj < 2; ++bj) {
                    const f32x4 v0 = acc[ai][bj][m][0], v1 = acc[ai][bj][m][1];
                    *(u32x2*)(rowp + bj * 64) = (u32x2){pack2(v0[0] * sigmoidf_(v0[0]) * v0[1], v0[2] * sigmoidf_(v0[2]) * v0[3]), pack2(v1[0] * sigmoidf_(v1[0]) * v1[1], v1[2] * sigmoidf_(v1[2]) * v1[3])};
                }
            }
    }
};
struct EpiMoeDown {
    static constexpr bool PERM = true;
    bf16_t* fo; const int* list; const float* tokg;
    DI void operator()(const f32x4 (&acc)[2][2][4][2], const g8::Unit& u, int wr, int wc, int fr, int fq) const {
        int ent[8]; float g[8];
#pragma unroll
        for (int q = 0; q < 8; ++q) {
            const int sl = u.slot0 + (q >> 2) * 128 + wr * 64 + (q & 3) * 16 + fr;
            ent[q] = sl < u.cnt ? list[u.e * T + sl] : -1;
        }
#pragma unroll
        for (int q = 0; q < 8; ++q) g[q] = ent[q] >= 0 ? tokg[ent[q]] : 0.f;
#pragma unroll
        for (int ai = 0; ai < 2; ++ai)
#pragma unroll
            for (int m = 0; m < 4; ++m) {
                const int q = ai * 4 + m;
                if (ent[q] < 0) continue;
                const float gg = g[q];
                bf16_t* rowp = fo + ((size_t)(ent[q] & 1) * TP + (ent[q] >> 1)) * D + u.pn * 256 + wc * 32 + 8 * fq;
#pragma unroll
                for (int bj = 0; bj < 2; ++bj) {
                    const f32x4 v0 = acc[ai][bj][m][0], v1 = acc[ai][bj][m][1];
                    *(u32x4*)(rowp + bj * 128) = (u32x4){pack2(gg * v0[0], gg * v0[1]), pack2(gg * v0[2], gg * v0[3]), pack2(gg * v1[0], gg * v1[1]), pack2(gg * v1[2], gg * v1[3])};
                }
            }
    }
};
DI void phase_moe_up(const Params& p, int layer, int bid, int nb, char* smem) {
    const MoeOrder<true> S{p.counts, p.list, nb, bid, (const char*)p.hb, (const char*)p.WtGU};
    g8::gemm8<true>((G8_LAS unsigned char*)smem, D, S, EpiMoeUp{p.hid});
    const bf16_t* hb = p.hb; bf16_t* hid = p.hid; const int* list = p.list;
    int* cl = (int*)(smem + GEMM_LDS);
    __syncthreads();
    if (tid_() < NE) cl[tid_()] = p.counts[tid_()];
    __syncthreads();
    int padr = 0, job = 0;
    const int mine = bid;
#pragma unroll 1
    for (int e = 0; e < NE; ++e) {
        const int cn = __builtin_amdgcn_readfirstlane(cl[e]);
        for (int s0 = MOE_BIG * 256; s0 < cn; s0 += 128, ++job)
            for (int nt = 0; nt < 8; ++nt)
                if (((job & 7) + 8 * (nt + 8 * ((job >> 3) & 3))) % nb == mine) {
                    const int prow = padr;
                    gemm_tile128([=](int r) { const int sl = s0 + r; return hb + (size_t)(sl < cn ? list[e * T + sl] >> 1 : 0) * D; },
                                 p.WtGU + (size_t)e * 1024 * 1024, D, D, 0, nt * 128, smem,
                                 [=](int, int r, int c, f32x4 v) {
                                     const int sl = s0 + r;
                                     if (sl >= cn) return;
                                     *(unsigned*)(hid + (size_t)(prow + sl) * DE + (c >> 1)) = pack2(v[0] * sigmoidf_(v[0]) * v[1], v[2] * sigmoidf_(v[2]) * v[3]);
                                 });
                }
        padr += ((cn + 255) >> 8) * 256;
    }
    if (layer + 1 < DEPTH) {
        const int groups = (job + 7) >> 3, J = groups < 4 ? groups * 64 : nb;
        if (J < nb) { if (bid >= J) convert_layer_weights(p, layer + 1, bid - J, nb - J, smem); }
        else convert_layer_weights(p, layer + 1, bid, nb, smem);
    }
}
DI void phase_moe_down(const Params& p, int bid, int nb, char* smem) {
    const MoeOrder<false> S{p.counts, p.list, nb, bid, (const char*)p.hid, (const char*)p.WtD};
    g8::gemm8<false>((G8_LAS unsigned char*)smem, DE, S, EpiMoeDown{p.fo, p.list, p.tokg});
    const bf16_t* hid = p.hid; bf16_t* fo = p.fo; const int* list = p.list; const float* tokg = p.tokg;
    int* cl = (int*)(smem + GEMM_LDS);
    __syncthreads();
    if (tid_() < NE) cl[tid_()] = p.counts[tid_()];
    __syncthreads();
    int padr = 0, job = 0;
    const int mine = bid;
#pragma unroll 1
    for (int e = 0; e < NE; ++e) {
        const int cn = __builtin_amdgcn_readfirstlane(cl[e]);
        for (int s0 = MOE_BIG * 256; s0 < cn; s0 += 128, ++job)
            for (int nt = 0; nt < 8; ++nt)
                if (((job & 7) + 8 * (nt + 8 * ((job >> 3) & 3))) % nb == mine) {
                    const int prow = padr;
                    int ent2[2]; float g2[2];
                    { const int t2 = tid_(), rr = ((t2 >> 6) >> 1) * 32 + (t2 & 15);
#pragma unroll
                      for (int mi = 0; mi < 2; ++mi) { const int sl = s0 + rr + mi * 16; ent2[mi] = sl < cn ? list[e * T + sl] : -1; }
#pragma unroll
                      for (int mi = 0; mi < 2; ++mi) g2[mi] = ent2[mi] >= 0 ? tokg[ent2[mi]] : 0.f; }
                    const int e0 = ent2[0], e1 = ent2[1]; const float g0 = g2[0], g1 = g2[1];
                    gemm_tile128([=](int r) { const int sl = s0 + r; return hid + (size_t)(prow + (sl < cn ? sl : 0)) * DE; },
                                 p.WtD + (size_t)e * 1024 * 512, DE, DE, 0, nt * 128, smem,
                                 [=](int mi, int, int c, f32x4 v) {
                                     const int ent = mi ? e1 : e0; const float g = mi ? g1 : g0;
                                     if (ent < 0) return;
                                     *(u32x2*)(fo + ((size_t)(ent & 1) * TP + (ent >> 1)) * D + c) = (u32x2){pack2(g * v[0], g * v[1]), pack2(g * v[2], g * v[3])};
                                 });
                }
        padr += ((cn + 255) >> 8) * 256;
    }
}
DI void phase_ln2(const Params& p, int layer, int bid, int nb) {
    const int lane = tid_() & 63, wid = __builtin_amdgcn_readfirstlane(tid_() >> 6);
    const int nwaves = nb * 8, gw = bid * 8 + wid, base_n = T / nwaves, extra = T % nwaves;
    const int tok0 = gw * base_n + (gw < extra ? gw : extra), ntok = base_n + (gw < extra ? 1 : 0);
    u32x2 an[4], f0n[4], f1n[4];
    {
#pragma unroll
        for (int j = 0; j < 4; ++j) {
            an[j] = *(const u32x2*)(p.hb + (size_t)tok0 * D + 256 * j + 4 * lane);
            f0n[j] = *(const u32x2*)(p.fo + (size_t)tok0 * D + 256 * j + 4 * lane); f1n[j] = *(const u32x2*)(p.fo + ((size_t)TP + tok0) * D + 256 * j + 4 * lane);
        }
    }
#pragma unroll 1
    for (int i = 0; i < ntok; ++i) {
        const int tok = tok0 + i;
        float v[16];
#pragma unroll
        for (int j = 0; j < 4; ++j) {
            v[4 * j] = ALPHA * lo_bf(an[j][0]) + lo_bf(f0n[j][0]) + lo_bf(f1n[j][0]); v[4 * j + 1] = ALPHA * hi_bf(an[j][0]) + hi_bf(f0n[j][0]) + hi_bf(f1n[j][0]);
            v[4 * j + 2] = ALPHA * lo_bf(an[j][1]) + lo_bf(f0n[j][1]) + lo_bf(f1n[j][1]); v[4 * j + 3] = ALPHA * hi_bf(an[j][1]) + hi_bf(f0n[j][1]) + hi_bf(f1n[j][1]);
        }
        if (i + 1 < ntok) {
#pragma unroll
            for (int j = 0; j < 4; ++j) {
                an[j] = *(const u32x2*)(p.hb + (size_t)(tok + 1) * D + 256 * j + 4 * lane);
                f0n[j] = *(const u32x2*)(p.fo + (size_t)(tok + 1) * D + 256 * j + 4 * lane); f1n[j] = *(const u32x2*)(p.fo + ((size_t)TP + tok + 1) * D + 256 * j + 4 * lane);
            }
        }
        ln16(v, p.ln2_g + layer * D, p.ln2_b + layer * D, lane);
        if (layer == DEPTH - 1) {
            float* of = hrow_u(p, tok);
#pragma unroll
            for (int j = 0; j < 4; ++j) *(f32x4*)(of + 256 * j + 4 * lane) = (f32x4){v[4 * j], v[4 * j + 1], v[4 * j + 2], v[4 * j + 3]};
        } else store_row_bf(p.hb + (size_t)tok * D, v, lane);
    }
}

extern __shared__ __attribute__((aligned(16))) char dyn_smem[];
constexpr int SMEM_MAIN = R1_LDS > GEMM_LDS ? R1_LDS : GEMM_LDS;
constexpr int SMEM_BYTES = SMEM_MAIN + 16;

__global__ void __launch_bounds__(NTHR, 2) k_forward(Params p) {
    const int bid = blockIdx.x, nb = gridDim.x;
    char* smem = dyn_smem;
    uint4* xbw = (uint4*)(dyn_smem + SMEM_MAIN);
    if (threadIdx.x == 0) *xbw = make_uint4(0u, 0u, 0u, 0u);
    __syncthreads();
    XcdBarrier bar = xcd_barrier_post(p.bar, (volatile LAS unsigned*)xbw);
    phase_prologue_weights(p, bid, nb, smem);
    phase_embed(p, bid, nb);
    xcd_barrier(bar);
    for (int l = 0; l < DEPTH; ++l) {
        phase_inproj(p, l, bid, nb, smem);
        xcd_barrier(bar);
        phase_rwkv_r1<0>(p, l, bid, nb, smem);
        xcd_barrier(bar);
        constexpr int NCW = 32;
        if (bid < NCW) { const int cw = __builtin_amdgcn_readfirstlane(tid_() >> 6); if (cw < 64 / NCW) phase_rwkv_r2(p, NCW == 32 ? (((bid & 7) + 8 * (bid >> 4)) * 4 + ((bid >> 3) & 1) * 2 + cw) : bid * (64 / NCW) + cw); }
        else {
            const int sbid = bid - NCW, snb = nb - NCW, heavy = (NBATCH * HEADS * ((L + 127) / 128)) % snb;
            if (sbid >= heavy && sbid < heavy + NBATCH * HEADS) phase_rwkv_r1<1>(p, l, sbid - heavy, 1, smem);
            phase_sb(p, sbid, snb, smem);
        }
        xcd_barrier(bar);
        phase_rwkv_r3(p, l, bid, nb);
        phase_merge<0>(p, l, bid, nb, smem);
        xcd_barrier(bar);
        phase_merge<1>(p, l, bid, nb, smem);
        xcd_barrier(bar);
        phase_outproj(p, l, bid, nb, smem);
        xcd_barrier(bar);
        phase_ln1_router(p, l, bid, nb, smem);
        xcd_barrier(bar);
        phase_moe_up(p, l, bid, nb, smem);
        xcd_barrier(bar);
        phase_moe_down(p, bid, nb, smem);
        xcd_barrier(bar);
        phase_ln2(p, l, bid, nb);
        xcd_barrier(bar);
    }
}

extern "C" void kernel_launch(void* const* d_in, const int* in_sizes, int n_in, void* d_out, int out_size, void* d_ws, size_t ws_size, hipStream_t stream) {
    (void)in_sizes; (void)n_in; (void)out_size;
    Params p;
    memset(&p, 0, sizeof(p));
    const float* const* in = (const float* const*)d_in;
    p.x = in[0]; p.meta = in[1]; p.emb_g = in[2]; p.emb_b = in[3]; p.w_in = in[4]; p.mu = in[5]; p.w0 = in[6]; p.w_up = in[7]; p.a0 = in[8]; p.a_up = in[9];
    p.g_up = in[10]; p.k_k = in[11]; p.k_a = in[12]; p.r_k = in[13]; p.lnx_g = in[14]; p.lnx_b = in[15]; p.p_sb = in[16]; p.p_rwkv = in[17]; p.w_out = in[18];
    p.ln1_g = in[19]; p.ln1_b = in[20]; p.router_w = in[21]; p.router_b = in[22]; p.ew_gate = in[23]; p.ew_up = in[24]; p.ew_down = in[25]; p.ln2_g = in[26]; p.ln2_b = in[27];
    p.out = (float*)d_out;
    char* ws = (char*)d_ws; size_t o = 0;
    auto take = [&](size_t bytes) { char* r = ws + o; o += (bytes + 255) & ~(size_t)255; return r; };
    p.bar = (unsigned*)take(XCD_BAR_WORDS * sizeof(unsigned));
    p.counts = (int*)take(256);
    p.WtIn = (bf16_t*)take((size_t)DEPTH * CIN * D * 2);
    p.WtPsb = (bf16_t*)take((size_t)DEPTH * D * 512 * 2);
    p.WtPrw = (bf16_t*)take((size_t)DEPTH * D * 512 * 2);
    p.WtOut = (bf16_t*)take((size_t)DEPTH * D * D * 2);
    p.WupT = (bf16_t*)take((size_t)DEPTH * 512 * 64 * 2);
    p.AupT = (bf16_t*)take((size_t)DEPTH * 512 * 64 * 2);
    p.GupT = (bf16_t*)take((size_t)DEPTH * 512 * 128 * 2);
    p.RwHi = (bf16_t*)take((size_t)NE * D * 2);
    p.gleft = (bf16_t*)take((size_t)32 * 2048 * 2);
    {
        const size_t ub = (size_t)NUNIT * 64 * 64 * 2;
        p.WtGU = (bf16_t*)take((size_t)NE * 1024 * 1024 * 2);
        p.WtD = (bf16_t*)take((size_t)NE * 1024 * 512 * 2);
        p.PcG = (bf16_t*)d_out; p.QcG = (bf16_t*)((char*)d_out + ub); p.RhG = (bf16_t*)((char*)d_out + 2 * ub);
        p.Y0G = (bf16_t*)take(ub); p.GG = (bf16_t*)take(ub); p.SG = (bf16_t*)take(ub);
        p.bonG = (float*)take((size_t)NUNIT * 64 * 4);
    }
    p.hb = (bf16_t*)take((size_t)TP * D * 2);
    p.hmeta = (float*)take((size_t)NBATCH * NMETA * D * 4);
    p.P = (bf16_t*)take((size_t)TP * CP * 2);
    p.osb = (bf16_t*)take((size_t)TP * 512 * 2);
    p.orw = (bf16_t*)take((size_t)TP * 512 * 2);
    p.list = (int*)take((size_t)NE * T * 4);
    p.tokg = (float*)take((size_t)T * 2 * 4);
    p.gates = p.P;
    p.merged = p.P + (size_t)TP * 2048;
    p.hid = p.P;
    p.fo = p.P + (size_t)(2 * T + 16 * 256) * DE;
    if (o > ws_size) return;
    static int grid = 0;
    if (!grid) {
        int dev = 0, cus = 0, per_cu = 0;
        (void)hipGetDevice(&dev);
        (void)hipDeviceGetAttribute(&cus, hipDeviceAttributeMultiprocessorCount, dev);
        (void)hipFuncSetAttribute((const void*)k_forward, hipFuncAttributeMaxDynamicSharedMemorySize, SMEM_BYTES);
        (void)hipOccupancyMaxActiveBlocksPerMultiprocessor(&per_cu, k_forward, NTHR, SMEM_BYTES);
        grid = per_cu >= 1 ? cus : 0;
    }
    if (!grid) return;
    (void)hipMemsetAsync(p.bar, 0, XCD_BAR_WORDS * sizeof(unsigned), stream);
    hipLaunchKernelGGL(k_forward, dim3(grid), dim3(NTHR), SMEM_BYTES, stream, p);
}
```
